# Optimizing an MI355X kernel written in HIP

```python
import jax, jax.numpy as jnp
from jax import lax
import numpy as np

D_MODEL = 2048
BATCH = 2
SEQ = 8192
DEPTH = 2

HEAD_DIM = 128
ROPE_DIM = HEAD_DIM // 4
ROPE_THETA = 500000.0
Q_BLOCK = 128
N_HEADS_A = 8
KV_RANK = 256
NOPE_DIM = HEAD_DIM - ROPE_DIM
N_IDX_HEADS = 16
IDX_DIM = 64
IDX_ROPE_DIM = IDX_DIM // 4
TOPK_MAX = 256
N_HEADS_B = 8
N_HEADS_C = 8
WIDTH_A = N_HEADS_A * HEAD_DIM
WIDTH_B = N_HEADS_B * HEAD_DIM
WIDTH_C = N_HEADS_C * HEAD_DIM
N_BRANCH = 3
N_EXPERTS = 32
TOP_K_EXPERTS = 4
D_EXPERT = 1024
SWIGLU_LIMIT = 7.0
SWIGLU_ALPHA = 1.702
PLE_DIM = 256
LN_EPS = 1e-5
RMS_EPS = 1e-6
DEEPNORM_ALPHA = (2 * DEPTH) ** 0.25
DEEPNORM_BETA = (8 * DEPTH) ** -0.25

IN_SPLITS = (WIDTH_A, KV_RANK, ROPE_DIM, N_IDX_HEADS * IDX_DIM, IDX_DIM, N_IDX_HEADS,
             WIDTH_B, WIDTH_B, WIDTH_B, N_HEADS_B,
             WIDTH_C, WIDTH_C, WIDTH_C,
             N_BRANCH * D_MODEL)
IN_WIDTH = sum(IN_SPLITS)

kernel_name = 'hybrid_dsa_fox_stickbreak_moe_deepnorm'


def split_columns(h):
    parts = []
    start = 0
    for width in IN_SPLITS:
        parts.append(h[..., start:start + width])
        start += width
    return parts


def layer_norm(x, g, b):
    xf = x.astype(jnp.float32)
    mu = jnp.mean(xf, axis=-1, keepdims=True)
    var = jnp.mean(jnp.square(xf - mu), axis=-1, keepdims=True)
    y = (xf - mu) * lax.rsqrt(var + LN_EPS)
    return (y * g.astype(jnp.float32) + b.astype(jnp.float32)).astype(x.dtype)


def rms_norm(x, g):
    xf = x.astype(jnp.float32)
    y = xf * lax.rsqrt(jnp.mean(jnp.square(xf), axis=-1, keepdims=True) + RMS_EPS)
    return (y * g.astype(jnp.float32)).astype(x.dtype)


def rope_tables(seq_len, rot_dim):
    inv_freq = ROPE_THETA ** (-jnp.arange(0, rot_dim, 2, dtype=jnp.float32) / rot_dim)
    ang = jnp.arange(seq_len, dtype=jnp.float32)[:, None] * inv_freq[None, :]
    return jnp.cos(ang), jnp.sin(ang)


def apply_rope(x, cos, sin):
    shape = (1, x.shape[1]) + (1,) * (x.ndim - 3) + (cos.shape[-1],)
    c = cos.reshape(shape)
    s = sin.reshape(shape)
    x1, x2 = jnp.split(x.astype(jnp.float32), 2, axis=-1)
    return jnp.concatenate([x1 * c - x2 * s, x2 * c + x1 * s], axis=-1).astype(x.dtype)


def to_blocks(a):
    b, s = a.shape[:2]
    a = a.reshape((b, s // Q_BLOCK, Q_BLOCK) + a.shape[2:])
    return jnp.moveaxis(a, 1, 0)


def from_blocks(a):
    a = jnp.moveaxis(a, 0, 1)
    return a.reshape((a.shape[0], a.shape[1] * a.shape[2]) + a.shape[3:])


def split_heads(t, n_heads):
    return t.reshape(t.shape[0], t.shape[1], n_heads, HEAD_DIM)


def dsa_attention(q_a, ckv, k_rope, q_idx, k_idx, w_idx, w_uk, w_uv, cos_r, sin_r, cos_i, sin_i):
    B, S = q_a.shape[:2]
    topk = min(TOPK_MAX, S // 4)
    q = q_a.reshape(B, S, N_HEADS_A, HEAD_DIM)
    q_rope = apply_rope(q[..., :ROPE_DIM], cos_r, sin_r)
    q_lat = jnp.einsum('bshn,rhn->bshr', q[..., ROPE_DIM:], w_uk)
    k_rope = apply_rope(k_rope, cos_r, sin_r)
    qi = q_idx.reshape(B, S, N_IDX_HEADS, IDX_DIM)
    qi = jnp.concatenate([apply_rope(qi[..., :IDX_ROPE_DIM], cos_i, sin_i), qi[..., IDX_ROPE_DIM:]], axis=-1)
    ki = jnp.concatenate([apply_rope(k_idx[..., :IDX_ROPE_DIM], cos_i, sin_i), k_idx[..., IDX_ROPE_DIM:]], axis=-1)
    wi = w_idx.astype(jnp.float32) * (N_IDX_HEADS ** -0.5 * IDX_DIM ** -0.5)
    key_pos = jnp.arange(S)
    b_idx = jnp.arange(B)[:, None, None]
    scale = HEAD_DIM ** -0.5

    def block(args):
        qlat_b, qr_b, qi_b, wi_b, pos_b = args
        causal = key_pos[None, :] <= pos_b[:, None]
        dots = jnp.einsum('bthd,bsd->bths', qi_b, ki).astype(jnp.float32)
        score = jnp.einsum('bth,bths->bts', wi_b, jax.nn.relu(dots))
        score = jnp.where(causal[None], score, -jnp.inf)
        _, sel = lax.top_k(score, topk)
        valid = sel <= pos_b[None, :, None]
        c_sel = ckv[b_idx, sel]
        kr_sel = k_rope[b_idx, sel]
        logits = (jnp.einsum('bthr,btkr->bhtk', qlat_b, c_sel)
                  + jnp.einsum('bthe,btke->bhtk', qr_b, kr_sel)).astype(jnp.float32) * scale
        logits = jnp.where(valid[:, None], logits, -jnp.inf)
        probs = jax.nn.softmax(logits, axis=-1).astype(c_sel.dtype)
        o_lat = jnp.einsum('bhtk,btkr->bthr', probs, c_sel)
        return jnp.einsum('bthr,rhv->bthv', o_lat, w_uv)

    pos = key_pos.reshape(-1, Q_BLOCK)
    out = lax.map(block, (to_blocks(q_lat), to_blocks(q_rope), to_blocks(qi), to_blocks(wi), pos))
    return from_blocks(out).reshape(B, S, WIDTH_A)


def forgetting_attention(q, k, v, f_logit, b_forget):
    B, S = q.shape[:2]
    q, k, v = split_heads(q, N_HEADS_B), split_heads(k, N_HEADS_B), split_heads(v, N_HEADS_B)
    log_f = jax.nn.log_sigmoid(f_logit.astype(jnp.float32) + b_forget.astype(jnp.float32))
    cum = lax.cumsum(log_f, axis=1)
    cum_k = jnp.transpose(cum, (0, 2, 1))
    key_pos = jnp.arange(S)
    scale = HEAD_DIM ** -0.5

    def block(args):
        q_b, cum_b, pos_b = args
        causal = key_pos[None, :] <= pos_b[:, None]
        logits = jnp.einsum('bthd,bshd->bhts', q_b, k).astype(jnp.float32) * scale
        logits = logits + jnp.transpose(cum_b, (0, 2, 1))[..., None] - cum_k[:, :, None, :]
        logits = jnp.where(causal, logits, -jnp.inf)
        probs = jax.nn.softmax(logits, axis=-1).astype(v.dtype)
        return jnp.einsum('bhts,bshd->bthd', probs, v)

    pos = key_pos.reshape(-1, Q_BLOCK)
    out = lax.map(block, (to_blocks(q), to_blocks(cum), pos))
    return from_blocks(out).reshape(B, S, WIDTH_B)


def stick_breaking_attention(q, k, v):
    B, S = q.shape[:2]
    q, k, v = split_heads(q, N_HEADS_C), split_heads(k, N_HEADS_C), split_heads(v, N_HEADS_C)
    key_pos = jnp.arange(S)
    scale = HEAD_DIM ** -0.5

    def block(args):
        q_b, pos_b = args
        strict = key_pos[None, :] < pos_b[:, None]
        z = jnp.einsum('bthd,bshd->bhts', q_b, k).astype(jnp.float32) * scale
        log_keep = jnp.where(strict, jax.nn.log_sigmoid(-z), 0.0)
        later = lax.cumsum(log_keep, axis=3, reverse=True) - log_keep
        weights = jnp.where(strict, jnp.exp(jax.nn.log_sigmoid(z) + later), 0.0)
        return jnp.einsum('bhts,bshd->bthd', weights.astype(v.dtype), v)

    pos = key_pos.reshape(-1, Q_BLOCK)
    out = lax.map(block, (to_blocks(q), pos))
    return from_blocks(out).reshape(B, S, WIDTH_C)


def hybrid_mixer(x, w_in, b_forget, g_ckv, w_uk, w_uv, w_br_a, w_br_b, w_br_c, w_out, ropes):
    B, S, D = x.shape
    cos_r, sin_r, cos_i, sin_i = ropes
    h = jnp.einsum('bsd,dc->bsc', x, w_in)
    (q_a, ckv, k_rope, q_idx, k_idx, w_idx,
     q_b, k_b, v_b, f_b, q_c, k_c, v_c, gate_logits) = split_columns(h)
    ckv = rms_norm(ckv, g_ckv)
    o_a = dsa_attention(q_a, ckv, k_rope, q_idx, k_idx, w_idx, w_uk, w_uv, cos_r, sin_r, cos_i, sin_i)
    o_b = forgetting_attention(q_b, k_b, v_b, f_b, b_forget)
    o_c = stick_breaking_attention(q_c, k_c, v_c)
    gates = jax.nn.sigmoid(gate_logits.astype(jnp.float32)).astype(x.dtype).reshape(B, S, N_BRANCH, D)
    merged = (gates[:, :, 0] * (o_a @ w_br_a)
              + gates[:, :, 1] * (o_b @ w_br_b)
              + gates[:, :, 2] * (o_c @ w_br_c))
    return merged @ w_out


def moe_ffn(x, w_router, b_router, w_exp_gate, b_exp_gate, w_exp_up, b_exp_up, w_exp_down, b_exp_down):
    B, S, D = x.shape
    xf = x.reshape(B * S, D)
    logits = (xf @ w_router).astype(jnp.float32) + b_router.astype(jnp.float32)
    top_val, top_idx = lax.top_k(logits, TOP_K_EXPERTS)
    top_w = jax.nn.softmax(top_val, axis=-1)
    combine = jnp.sum(jax.nn.one_hot(top_idx, N_EXPERTS, dtype=jnp.float32) * top_w[..., None], axis=1)

    def expert(acc, params):
        wg, bg, wu, bu, wd, bd, cw = params
        g = jnp.minimum(xf @ wg + bg, SWIGLU_LIMIT)
        u = jnp.clip(xf @ wu + bu, -SWIGLU_LIMIT, SWIGLU_LIMIT)
        hid = (u + 1.0) * (g * jax.nn.sigmoid(SWIGLU_ALPHA * g))
        return acc + cw[:, None].astype(xf.dtype) * (hid @ wd + bd), None

    y, _ = lax.scan(expert, jnp.zeros_like(xf),
                    (w_exp_gate, b_exp_gate, w_exp_up, b_exp_up, w_exp_down, b_exp_down, combine.T))
    return y.reshape(B, S, D)


def setup_inputs(seed: int = 0) -> dict:
    key = jax.random.key(seed)
    ks = jax.random.split(key, 32)
    f32 = jnp.float32

    def nrm(k, shape, scale):
        return jax.random.normal(k, shape, f32) * scale

    L, D, E, F = DEPTH, D_MODEL, N_EXPERTS, D_EXPERT
    return {
        'x': nrm(ks[0], (BATCH, SEQ, D), 1.0),
        'p': nrm(ks[1], (DEPTH, BATCH, SEQ, PLE_DIM), 1.0),
        'w_in': nrm(ks[2], (L, D, IN_WIDTH), D ** -0.5),
        'b_forget': jax.random.uniform(ks[3], (L, N_HEADS_B), f32, 1.0, 4.0),
        'g_ckv': 1.0 + nrm(ks[4], (L, KV_RANK), 0.02),
        'w_uk': nrm(ks[5], (L, KV_RANK, N_HEADS_A, NOPE_DIM), KV_RANK ** -0.5),
        'w_uv': nrm(ks[6], (L, KV_RANK, N_HEADS_A, HEAD_DIM), KV_RANK ** -0.5),
        'w_br_a': nrm(ks[7], (L, WIDTH_A, D), WIDTH_A ** -0.5),
        'w_br_b': nrm(ks[8], (L, WIDTH_B, D), WIDTH_B ** -0.5),
        'w_br_c': nrm(ks[9], (L, WIDTH_C, D), WIDTH_C ** -0.5),
        'w_out': nrm(ks[10], (L, D, D), D ** -0.5 * DEEPNORM_BETA),
        'ln1_g': 1.0 + nrm(ks[11], (L, D), 0.02),
        'ln1_b': nrm(ks[12], (L, D), 0.02),
        'w_router': nrm(ks[13], (L, D, E), D ** -0.5),
        'b_router': nrm(ks[14], (L, E), 0.01),
        'w_exp_gate': nrm(ks[15], (L, E, D, F), D ** -0.5),
        'b_exp_gate': nrm(ks[16], (L, E, F), 0.01),
        'w_exp_up': nrm(ks[17], (L, E, D, F), D ** -0.5),
        'b_exp_up': nrm(ks[18], (L, E, F), 0.01),
        'w_exp_down': nrm(ks[19], (L, E, F, D), F ** -0.5 * DEEPNORM_BETA),
        'b_exp_down': nrm(ks[20], (L, E, D), 0.01),
        'w_ple_gate': nrm(ks[21], (L, D, D), D ** -0.5),
        'w_ple': nrm(ks[22], (L, PLE_DIM, D), PLE_DIM ** -0.5 * DEEPNORM_BETA),
        'ln2_g': 1.0 + nrm(ks[23], (L, D), 0.02),
        'ln2_b': nrm(ks[24], (L, D), 0.02),
    }


def reference(x, p, w_in, b_forget, g_ckv, w_uk, w_uv, w_br_a, w_br_b, w_br_c, w_out, ln1_g, ln1_b,
              w_router, b_router, w_exp_gate, b_exp_gate, w_exp_up, b_exp_up, w_exp_down, b_exp_down,
              w_ple_gate, w_ple, ln2_g, ln2_b):
    S = x.shape[1]
    cos_r, sin_r = rope_tables(S, ROPE_DIM)
    cos_i, sin_i = rope_tables(S, IDX_ROPE_DIM)
    ropes = (cos_r, sin_r, cos_i, sin_i)
    for i in range(DEPTH):
        mix = hybrid_mixer(x, w_in[i], b_forget[i], g_ckv[i], w_uk[i], w_uv[i],
                           w_br_a[i], w_br_b[i], w_br_c[i], w_out[i], ropes)
        x = layer_norm(DEEPNORM_ALPHA * x + mix, ln1_g[i], ln1_b[i])
        h = DEEPNORM_ALPHA * x + moe_ffn(x, w_router[i], b_router[i], w_exp_gate[i], b_exp_gate[i],
                                         w_exp_up[i], b_exp_up[i], w_exp_down[i], b_exp_down[i])
        ple = jax.nn.sigmoid(h @ w_ple_gate[i]) * (p[i] @ w_ple[i])
        x = layer_norm(h + ple, ln2_g[i], ln2_b[i])
    return x
```

```cpp
#include <hip/hip_runtime.h>
#include <stdint.h>
#include <stdio.h>
#include <math.h>

#ifndef PHASES_PER_LAUNCH
#define PHASES_PER_LAUNCH 1
#endif

#define LAS __attribute__((address_space(3)))
typedef unsigned short bf16_t;
typedef short bf16x8 __attribute__((ext_vector_type(8)));
typedef short s16x4 __attribute__((ext_vector_type(4)));
typedef float f32x4 __attribute__((ext_vector_type(4)));
typedef float f32x16 __attribute__((ext_vector_type(16)));
typedef unsigned u32x4 __attribute__((ext_vector_type(4)));
typedef unsigned u32x2 __attribute__((ext_vector_type(2)));

constexpr int NTOK = 16384, DM = 2048, SEQ = 8192, NB = 2, NLAYER = 2;
constexpr int INW = 14712, INWP = 14848;
constexpr int NEXP = 32, DEXP = 1024;
constexpr int PMAX = 65536 + 8192;
constexpr float ALPHA = 1.41421356237309515f;
constexpr float LOG2E = 1.4426950408889634f;
constexpr float SCALE = 0.08838834764831845f;
constexpr float C2 = LOG2E * SCALE;

constexpr size_t MiB = 1ull << 20;
constexpr size_t WS_CTL   = 0;
constexpr size_t WS_W     = 1 * MiB;
constexpr size_t W_IN     = WS_W;
constexpr size_t W_UK2    = W_IN   + (size_t)INWP * 2048 * 2;
constexpr size_t W_UV2    = W_UK2  + 8ull * 256 * 256 * 2;
constexpr size_t W_BRA    = W_UV2  + 4ull * 256 * 512 * 2;
constexpr size_t W_BRB    = W_BRA  + 2048ull * 1024 * 2;
constexpr size_t W_BRC    = W_BRB  + 2048ull * 1024 * 2;
constexpr size_t W_OUT    = W_BRC  + 2048ull * 1024 * 2;
constexpr size_t W_PG     = W_OUT  + 2048ull * 2048 * 2;
constexpr size_t W_PLE    = W_PG   + 2048ull * 2048 * 2;
constexpr size_t W_GU     = W_PLE  + 2048ull * 256 * 2;
constexpr size_t W_DN     = W_GU   + 32ull * 2048 * 2048 * 2;
constexpr size_t W_END    = W_DN   + 32ull * 2048 * 1024 * 2;
constexpr size_t WS_XB    = (W_END + MiB - 1) / MiB * MiB;
constexpr size_t WS_PB    = WS_XB  + (size_t)NTOK * DM * 2;
constexpr size_t WS_CUM   = WS_PB  + 2ull * NTOK * 256 * 2;
constexpr size_t WS_LF    = WS_CUM + 16ull * 8192 * 4;
constexpr size_t WS_R     = WS_LF  + 16ull * 8192 * 4;
constexpr size_t R_SCORES = WS_R;
constexpr size_t R_OLAT   = WS_R;
constexpr size_t R_OA     = WS_R + 64 * MiB;
constexpr size_t R_OB     = WS_R + 96 * MiB;
constexpr size_t R_OC     = WS_R + 128 * MiB;
constexpr size_t R_TMP    = WS_R + 160 * MiB;
constexpr size_t R_MERGED = WS_R + 288 * MiB;
constexpr size_t R_PRE1   = WS_R + 384 * MiB;
constexpr size_t R_QA     = WS_R + 512 * MiB;
constexpr size_t R_QIDX   = WS_R + 544 * MiB;
constexpr size_t R_QKV    = WS_R + 576 * MiB;
constexpr size_t R_GATES  = WS_R + 768 * MiB;
constexpr size_t R_SMALL  = WS_R + 960 * MiB;
constexpr size_t R_QCAT   = WS_R + 992 * MiB;
constexpr size_t R_KCAT   = WS_R + 1064 * MiB;
constexpr size_t R_KI     = WS_R + 1073 * MiB;
constexpr size_t R_WI     = WS_R + 1075 * MiB;
constexpr size_t R_SEL    = WS_R + 1076 * MiB;
constexpr size_t R_NSEL   = WS_R + 1092 * MiB;
constexpr size_t R_END    = WS_R + 1093 * MiB;
constexpr size_t M_XS     = WS_R;
constexpr size_t M_HID    = WS_R + 288 * MiB;
constexpr size_t M_PP     = WS_R + 432 * MiB;
constexpr size_t M_X1F    = WS_R + 512 * MiB;
constexpr size_t M_X1B    = WS_R + 640 * MiB;
constexpr size_t M_HF     = WS_R + 704 * MiB;
constexpr size_t M_HB     = WS_R + 832 * MiB;
constexpr size_t M_TOKE   = WS_R + 896 * MiB;
constexpr size_t M_TOKPOS = M_TOKE + (size_t)NTOK * 16;
constexpr size_t M_TOKW   = M_TOKPOS + (size_t)NTOK * 16;
constexpr size_t M_TOKDST = M_TOKW + (size_t)NTOK * 16;
constexpr size_t M_ROWW   = M_TOKDST + (size_t)NTOK * 16;
constexpr size_t WS_NEED  = R_END;
constexpr int CW_BAR = 0;
constexpr int CW_CNT = 4096;
constexpr int CW_META = 4096 + 64;
constexpr size_t CTL_BYTES = 65536;

constexpr int LDS_BYTES = 152576;
constexpr int LDS_MISC = 151552;

typedef float f32x2 __attribute__((ext_vector_type(2)));
typedef __bf16 bf16n2 __attribute__((ext_vector_type(2)));
__device__ __forceinline__ unsigned cvtpk(float lo, float hi) { f32x2 v = {lo, hi}; bf16n2 b = __builtin_convertvector(v, bf16n2); return __builtin_bit_cast(unsigned, b); }
__device__ __forceinline__ bf16_t f2bf(float x) { return (bf16_t)(cvtpk(x, 0.f) & 0xffffu); }
__device__ __forceinline__ float bf2f(bf16_t b) { return __uint_as_float(((unsigned)b) << 16); }
__device__ __forceinline__ float bflo(unsigned w) { return __uint_as_float(w << 16); }
__device__ __forceinline__ float bfhi(unsigned w) { return __uint_as_float(w & 0xffff0000u); }
__device__ __forceinline__ bf16x8 pack8(f32x4 a, f32x4 b) { u32x4 w = {cvtpk(a[0], a[1]), cvtpk(a[2], a[3]), cvtpk(b[0], b[1]), cvtpk(b[2], b[3])}; return *reinterpret_cast<bf16x8*>(&w); }
__device__ __forceinline__ float sigmoidf_(float x) { return 1.0f / (1.0f + __expf(-x)); }
__device__ __forceinline__ float wave_sum(float v) { for (int o = 32; o > 0; o >>= 1) v += __shfl_xor(v, o); return v; }
__device__ __forceinline__ int crow(int r, int hi) { return (r & 3) + 8 * (r >> 2) + 4 * hi; }
#define SBAR() __builtin_amdgcn_sched_barrier(0)

#define XB_TMO      128
#define XB_XCNT(j)  (256  + 64 * (j))
#define XB_XSUB(j)  (1280 + 64 * (j))
#define XB_XGEN(j)  (2304 + 64 * (j))
#define XB_TOP      3328
#define XB_TOPGEN   3392
#define XCD_BAR_WORDS 3456
#define XB_SPIN_CAP (1u << 22)
__device__ __forceinline__ unsigned xb_ld(unsigned* p)              { return __hip_atomic_load(p, __ATOMIC_RELAXED, __HIP_MEMORY_SCOPE_AGENT); }
__device__ __forceinline__ unsigned xb_add(unsigned* p, unsigned v) { return __hip_atomic_fetch_add(p, v, __ATOMIC_RELAXED, __HIP_MEMORY_SCOPE_AGENT); }
__device__ __forceinline__ unsigned xb_xcc_id() { return (unsigned)__builtin_amdgcn_s_getreg((3 << 11) | 20) & 0xFu; }
#define XB_SPIN(cond, bar) do { unsigned _sp = 0; while (cond) { __builtin_amdgcn_s_sleep(1); \
    if ((++_sp & 255u) == 0u) { if (xb_ld(&(bar)[XB_TMO])) break; if (_sp > XB_SPIN_CAP) { atomicAdd(&(bar)[XB_TMO], 1u); break; } } } } while (0)
struct XcdBarrier { unsigned* bar; unsigned x; volatile LAS unsigned* st; };
__device__ __forceinline__ XcdBarrier xcd_barrier_post(unsigned* bar, volatile LAS unsigned* st) {
    XcdBarrier b; b.bar = bar; b.x = xb_xcc_id(); b.st = st;
    if (threadIdx.x == 0) (void)xb_add(&bar[XB_XCNT(b.x)], 1u);
    return b;
}
__device__ __forceinline__ void xcd_barrier_complete(unsigned* bar, unsigned x, unsigned& nloc, unsigned& nx) {
    const unsigned G = gridDim.x * gridDim.y * gridDim.z;
    unsigned sum, cnt, mine, sp = 0u;
    for (;;) {
        sum = 0u; cnt = 0u; mine = 0u;
#pragma unroll
        for (unsigned j = 0; j < 16; ++j) { const unsigned c = xb_ld(&bar[XB_XCNT(j)]); sum += c; cnt += (c > 0u) ? 1u : 0u; mine = (j == x) ? c : mine; }
        if (sum == G) break;
        __builtin_amdgcn_s_sleep(1);
        if ((++sp & 255u) == 0u) { if (xb_ld(&bar[XB_TMO])) break; if (sp > XB_SPIN_CAP) { atomicAdd(&bar[XB_TMO], 1u); break; } }
    }
    nloc = mine > 0u ? mine : 1u; nx = cnt > 0u ? cnt : 1u;
}
__device__ __forceinline__ void xcd_barrier(const XcdBarrier& b) {
    asm volatile("s_waitcnt vmcnt(0)" ::: "memory");
    __syncthreads();
    if (threadIdx.x == 0) {
        unsigned* bar = b.bar;
        __builtin_amdgcn_s_waitcnt(0);
        unsigned nloc = b.st[0], nx = b.st[1];
        if (nloc == 0u) { xcd_barrier_complete(bar, b.x, nloc, nx); b.st[0] = nloc; b.st[1] = nx; }
        const unsigned old = xb_add(&bar[XB_XSUB(b.x)], 1u);
        const unsigned gen = old / nloc;
        if (old + 1u == (gen + 1u) * nloc) {
            __builtin_amdgcn_fence(__ATOMIC_RELEASE, "agent");
            asm volatile("s_waitcnt vmcnt(0)" ::: "memory");
            const unsigned og = xb_add(&bar[XB_TOP], 1u);
            const unsigned tg = og / nx;
            if (og + 1u == (tg + 1u) * nx) xb_add(&bar[XB_TOPGEN], 1u);
            else XB_SPIN(xb_ld(&bar[XB_TOPGEN]) == tg, bar);
            __builtin_amdgcn_fence(__ATOMIC_ACQUIRE, "agent");
            xb_add(&bar[XB_XGEN(b.x)], 1u);
            asm volatile("s_waitcnt vmcnt(0)" ::: "memory");
        } else {
            XB_SPIN(xb_ld(&bar[XB_XGEN(b.x)]) == gen, bar);
            __builtin_amdgcn_fence(__ATOMIC_ACQUIRE, "agent");
            asm volatile("s_waitcnt vmcnt(0)" ::: "memory");
        }
    }
    __syncthreads();
}

namespace pg8 {
constexpr int BM = 256, BK = 64, HALF = 128, HTB = HALF * BK * 2, STAGE_BYTES = 8 * HTB, NXCD = 8, WGM = 8;
__device__ __forceinline__ int lds_byte(int r, int c) { const int st = (r >> 4) * 2 + (c >> 5), rr = r & 15, cc = c & 31, ob = rr * 64 + cc * 2; return st * 1024 + (ob ^ (((ob >> 9) & 1) << 5)); }
__device__ __forceinline__ void stage_rc(int b, int& R, int& C) { const int st = b / 1024, sb = b % 1024, swz = sb ^ (((sb >> 9) & 1) << 5); R = (st >> 1) * 16 + swz / 64; C = (st & 1) * 32 + (swz % 64) / 2; }
__device__ __forceinline__ int perm32(int rho) { const int n = rho >> 4, i = rho & 15; return 8 * (i >> 2) + 4 * n + (i & 3); }
struct Unit { int pm, pn, e; };
struct SchedS {
    int nM, nN, nwg, G, c; const bf16_t* A; const bf16_t* B; int lda, ldb, a_sh, a_mul;
    __device__ void init(int M, int N, int G_, int c_, const bf16_t* A_, int lda_, const bf16_t* B_, int ldb_, int a_sh_ = 0, int a_mul_ = 0) {
        nM = M / BM; nN = N / BM; nwg = nM * nN; G = G_; c = c_; A = A_; B = B_; lda = lda_; ldb = ldb_; a_sh = a_sh_; a_mul = a_mul_; }
    __device__ __forceinline__ bool next(int i, Unit& u) const {
        const long L = (long)i * G + c; if (L >= nwg) return false;
        int wgid = (int)L; { const int q = nwg / NXCD, r = nwg % NXCD, xcd = wgid % NXCD, off = wgid / NXCD; wgid = (xcd < r ? xcd * (q + 1) : r * (q + 1) + (xcd - r) * q) + off; }
        const int nig = WGM * nN, gid = wgid / nig, fm = gid * WGM, gsz = (nM - fm) < WGM ? (nM - fm) : WGM;
        u.pm = fm + ((wgid % nig) % gsz); u.pn = (wgid % nig) / gsz; u.e = 0;
        return true;
    }
    __device__ __forceinline__ const char* pa(const Unit& u) const { return (const char*)(A + (size_t)u.pm * BM * lda + (size_t)((u.pn >> a_sh) * a_mul)); }
    __device__ __forceinline__ const char* pb(const Unit& u) const { return (const char*)(B + (size_t)u.pn * BM * ldb); }
};
struct SchedM {
    int ntiles, G, c; const bf16_t* A; const bf16_t* W; int lda, ldb; const unsigned* tile_e;
    __device__ void init(const unsigned* meta, int G_, int c_, const bf16_t* A_, int lda_, const bf16_t* W_, int ldb_) {
        ntiles = (int)meta[0]; tile_e = meta + 1; G = G_; c = c_; A = A_; W = W_; lda = lda_; ldb = ldb_; }
    __device__ __forceinline__ bool next(int i, Unit& u) const {
        const long L = (long)i * G + c; if (L >= (long)ntiles * 8) return false;
        u.pm = (int)(L >> 3); u.pn = (int)(L & 7); u.e = (int)tile_e[u.pm];
        return true;
    }
    __device__ __forceinline__ const char* pa(const Unit& u) const { return (const char*)(A + (size_t)u.pm * BM * lda); }
    __device__ __forceinline__ const char* pb(const Unit& u) const { return (const char*)(W + ((size_t)u.e * 2048 + (size_t)u.pn * BM) * ldb); }
};

template <class Epi, class Sched>
__device__ __forceinline__ void gemm_phase(LAS unsigned char* lds, const int K, const int lda, const int ldb, const Sched& S, const Epi& E) {
    int tid = threadIdx.x; asm volatile("" : "+v"(tid));
    const int wid = __builtin_amdgcn_readfirstlane(tid >> 6), lane = tid & 63, wr = wid >> 2, wc = wid & 3, fr = lane & 15, fq = lane >> 4;
    const int nt = K / BK;
    unsigned voffA[2], voffB[2];
#pragma unroll
    for (int i = 0; i < 2; ++i) { int R, C; stage_rc(tid * 16 + i * 8192, R, C); const int Rb = (R & ~31) + perm32(R & 31);
        voffA[i] = (unsigned)(R * lda + C) * 2u; voffB[i] = (unsigned)(Rb * ldb + C) * 2u; }
    const size_t kstep = (size_t)(BK * 2);
    const size_t hstepA = (size_t)HALF * lda * 2, hstepB = (size_t)HALF * ldb * 2;
    const unsigned ldsw = (unsigned)wid * 1024u;
    const int aoff = lds_byte(wr * 64 + fr, fq * 8), boff = lds_byte(wc * 32 + fr, fq * 8);
#define PG8_SA(b, h) (((b) * 2 + (h)) * HTB)
#define PG8_SB(b, h) ((4 + (b) * 2 + (h)) * HTB)
#define PG8_STAGE(bufoff, gbase, voff) do { _Pragma("unroll") for (int _i = 0; _i < 2; ++_i) \
        __builtin_amdgcn_global_load_lds((const unsigned*)((const char*)(gbase) + (voff)[_i]), (LAS unsigned*)(lds + (bufoff) + ldsw + _i * 8192), 16, 0, 0); } while (0)
#define PG8_LDA(dst, b, h) do { _Pragma("unroll") for (int m = 0; m < 4; ++m) _Pragma("unroll") for (int k = 0; k < 2; ++k) dst[m][k] = *(const LAS bf16x8*)(lds + PG8_SA(b, h) + aoff + m * 2048 + k * 1024); } while (0)
#define PG8_LDB(dst, b, h) do { _Pragma("unroll") for (int n = 0; n < 2; ++n) _Pragma("unroll") for (int k = 0; k < 2; ++k) dst[n][k] = *(const LAS bf16x8*)(lds + PG8_SB(b, h) + boff + n * 2048 + k * 1024); } while (0)
#define PG8_MMA(ai, bj, At, Bt) do { __builtin_amdgcn_s_setprio(1); _Pragma("unroll") for (int m = 0; m < 4; ++m) _Pragma("unroll") for (int n = 0; n < 2; ++n) _Pragma("unroll") for (int k = 0; k < 2; ++k) \
        acc[ai][bj][m][n] = __builtin_amdgcn_mfma_f32_16x16x32_bf16(Bt[n][k], At[m][k], acc[ai][bj][m][n], 0, 0, 0); __builtin_amdgcn_s_setprio(0); } while (0)
#define PG8_WAIT_V(n) asm volatile("s_waitcnt vmcnt(" #n ")" ::: "memory")
#define PG8_WAIT_L(n) asm volatile("s_waitcnt lgkmcnt(" #n ")" ::: "memory")
#define PG8_BAR __builtin_amdgcn_s_barrier()
#define PG8_SCHED __builtin_amdgcn_sched_barrier(0)
    Unit cur, nxt; int ui = 0;
    if (!S.next(0, cur)) return;
    f32x4 acc[2][2][4][2];
#pragma unroll
    for (int a = 0; a < 2; ++a)
#pragma unroll
        for (int b = 0; b < 2; ++b)
#pragma unroll
            for (int m = 0; m < 4; ++m)
#pragma unroll
                for (int n = 0; n < 2; ++n) acc[a][b][m][n] = (f32x4){0.f, 0.f, 0.f, 0.f};
    bf16x8 At[4][2], B0[2][2], B1[2][2];
    const char* cA = S.pa(cur); const char* cB = S.pb(cur);
    PG8_STAGE(PG8_SB(0, 0), cB, voffB); PG8_STAGE(PG8_SA(0, 0), cA, voffA); PG8_STAGE(PG8_SB(0, 1), cB + hstepB, voffB); PG8_STAGE(PG8_SA(0, 1), cA + hstepA, voffA);
    if (wr == 1) PG8_BAR;
    PG8_WAIT_V(4); PG8_BAR;
    PG8_STAGE(PG8_SB(1, 0), cB + kstep, voffB); PG8_STAGE(PG8_SA(1, 0), cA + kstep, voffA); PG8_STAGE(PG8_SB(1, 1), cB + hstepB + kstep, voffB);
    PG8_WAIT_V(6); PG8_BAR;
    for (;;) {
        const bool has_next = S.next(ui + 1, nxt);
        const char* nA = has_next ? S.pa(nxt) : cA; const char* nB = has_next ? S.pb(nxt) : cB;
        for (int t = 0; t < nt; t += 2) {
            const bool last = (t == nt - 2);
            const char* a1 = cA + (size_t)(t + 1) * kstep;
            const char* a2 = last ? nA : cA + (size_t)(t + 2) * kstep; const char* b2 = last ? nB : cB + (size_t)(t + 2) * kstep;
            const char* a3 = a2 + kstep; const char* b3 = b2 + kstep;
            PG8_LDB(B0, 0, 0); PG8_SCHED; PG8_LDA(At, 0, 0); PG8_STAGE(PG8_SA(1, 1), a1 + hstepA, voffA);
            PG8_WAIT_L(8); PG8_BAR; PG8_WAIT_L(0); PG8_MMA(0, 0, At, B0); PG8_BAR; PG8_SCHED;
            PG8_LDB(B1, 0, 1); PG8_STAGE(PG8_SB(0, 0), b2, voffB);
            PG8_BAR; PG8_WAIT_L(0); PG8_MMA(0, 1, At, B1); PG8_BAR;
            PG8_LDA(At, 0, 1); PG8_STAGE(PG8_SA(0, 0), a2, voffA);
            PG8_BAR; PG8_WAIT_L(0); PG8_MMA(1, 0, At, B0); PG8_BAR; PG8_SCHED;
            PG8_STAGE(PG8_SB(0, 1), b2 + hstepB, voffB);
            PG8_WAIT_V(6); PG8_BAR; PG8_MMA(1, 1, At, B1); PG8_BAR;
            PG8_LDB(B0, 1, 0); PG8_SCHED; PG8_LDA(At, 1, 0); PG8_STAGE(PG8_SA(0, 1), a2 + hstepA, voffA);
            PG8_WAIT_L(8); PG8_BAR; PG8_WAIT_L(0); PG8_MMA(0, 0, At, B0); PG8_BAR; PG8_SCHED;
            PG8_LDB(B1, 1, 1); PG8_STAGE(PG8_SB(1, 0), b3, voffB);
            PG8_BAR; PG8_WAIT_L(0); PG8_MMA(0, 1, At, B1); PG8_BAR;
            PG8_LDA(At, 1, 1); PG8_STAGE(PG8_SA(1, 0), a3, voffA);
            PG8_BAR; PG8_WAIT_L(0); PG8_MMA(1, 0, At, B0); PG8_BAR; PG8_SCHED;
            PG8_STAGE(PG8_SB(1, 1), b3 + hstepB, voffB);
            PG8_WAIT_V(6); PG8_BAR; PG8_MMA(1, 1, At, B1); PG8_BAR;
        }
        { int frE = fr, fqE = fq; asm volatile("" : "+v"(frE), "+v"(fqE)); E(acc, cur, wr, wc, frE, fqE); }
        if (!has_next) break;
#pragma unroll
        for (int a = 0; a < 2; ++a)
#pragma unroll
            for (int b = 0; b < 2; ++b)
#pragma unroll
                for (int m = 0; m < 4; ++m)
#pragma unroll
                    for (int n = 0; n < 2; ++n) acc[a][b][m][n] = (f32x4){0.f, 0.f, 0.f, 0.f};
        cur = nxt; cA = nA; cB = nB; ++ui;
    }
    PG8_WAIT_V(0);
    if (wr == 0) PG8_BAR;
    PG8_BAR;
#undef PG8_SA
#undef PG8_SB
#undef PG8_STAGE
#undef PG8_LDA
#undef PG8_LDB
#undef PG8_MMA
#undef PG8_WAIT_V
#undef PG8_WAIT_L
#undef PG8_BAR
#undef PG8_SCHED
}

#define EPI_LOOP_ROWS _Pragma("unroll") for (int ai = 0; ai < 2; ++ai) _Pragma("unroll") for (int m = 0; m < 4; ++m)
__device__ __forceinline__ void st_bf16x8(bf16_t* p, f32x4 v0, f32x4 v1) { u32x4 w; w.x = cvtpk(v0[0], v0[1]); w.y = cvtpk(v0[2], v0[3]); w.z = cvtpk(v1[0], v1[1]); w.w = cvtpk(v1[2], v1[3]); *(u32x4*)p = w; }

struct EpiInProj {
    bf16_t* qa; bf16_t* qidx; bf16_t* qkv; bf16_t* gates; float* small_;
    __device__ __forceinline__ void operator()(const f32x4 (&acc)[2][2][4][2], const Unit& u, int wr, int wc, int fr, int fq) const {
        const int pn = u.pn, row0 = u.pm * BM + wr * 64 + fr, lc0 = wc * 32 + fq * 8;
        if (pn < 8) {
            bf16_t* base = (pn < 4 ? qa + pn * 256 : qidx + (pn - 4) * 256) + lc0;
            EPI_LOOP_ROWS { const int row = row0 + ai * HALF + m * 16;
#pragma unroll
                for (int bj = 0; bj < 2; ++bj) st_bf16x8(base + (size_t)row * 1024 + bj * HALF, acc[ai][bj][m][0], acc[ai][bj][m][1]); }
        } else if (pn < 32) {
            const int id = (pn - 8) >> 2, hb = ((pn - 8) & 3) * 2, b = u.pm >> 5;
            bf16_t* base = qkv + (size_t)id * ((size_t)NTOK * 1024) + lc0;
            EPI_LOOP_ROWS { const int row = row0 + ai * HALF + m * 16, s = row & (SEQ - 1);
#pragma unroll
                for (int bj = 0; bj < 2; ++bj) st_bf16x8(base + ((size_t)(b * 8 + hb + bj) * SEQ + s) * 128, acc[ai][bj][m][0], acc[ai][bj][m][1]); }
        } else if (pn < 56) {
            bf16_t* base = gates + (pn - 32) * 256 + lc0;
            EPI_LOOP_ROWS { const int row = row0 + ai * HALF + m * 16;
#pragma unroll
                for (int bj = 0; bj < 2; ++bj) st_bf16x8(base + (size_t)row * 6144 + bj * HALF, acc[ai][bj][m][0], acc[ai][bj][m][1]); }
        } else {
            float* base = small_ + (pn - 56) * 256 + lc0;
            EPI_LOOP_ROWS { const int row = row0 + ai * HALF + m * 16;
#pragma unroll
                for (int bj = 0; bj < 2; ++bj) { float* p = base + (size_t)row * 512 + bj * HALF; *(f32x4*)p = acc[ai][bj][m][0]; *(f32x4*)(p + 4) = acc[ai][bj][m][1]; } }
        }
    }
};
struct EpiBf16 {
    bf16_t* out; int ld, cstep;
    __device__ __forceinline__ void operator()(const f32x4 (&acc)[2][2][4][2], const Unit& u, int wr, int wc, int fr, int fq) const {
        const int row0 = u.pm * BM + wr * 64 + fr; bf16_t* base = out + (size_t)u.pn * cstep + wc * 32 + fq * 8;
        EPI_LOOP_ROWS { const int row = row0 + ai * HALF + m * 16;
#pragma unroll
            for (int bj = 0; bj < 2; ++bj) st_bf16x8(base + (size_t)row * ld + bj * HALF, acc[ai][bj][m][0], acc[ai][bj][m][1]); }
    }
};
template <int MODE> struct EpiBranch {
    const bf16_t* gates; float* tmp; bf16_t* merged; int br;
    __device__ __forceinline__ void operator()(const f32x4 (&acc)[2][2][4][2], const Unit& u, int wr, int wc, int fr, int fq) const {
        const int row0 = u.pm * BM + wr * 64 + fr, col0 = u.pn * BM + wc * 32 + fq * 8;
        EPI_LOOP_ROWS { const int row = row0 + ai * HALF + m * 16;
#pragma unroll
            for (int bj = 0; bj < 2; ++bj) { const int col = col0 + bj * HALF;
                const u32x4 gw = *(const u32x4*)(gates + (size_t)row * 6144 + br * 2048 + col);
                f32x4 v0 = acc[ai][bj][m][0], v1 = acc[ai][bj][m][1];
                v0[0] *= sigmoidf_(bflo(gw.x)); v0[1] *= sigmoidf_(bfhi(gw.x)); v0[2] *= sigmoidf_(bflo(gw.y)); v0[3] *= sigmoidf_(bfhi(gw.y));
                v1[0] *= sigmoidf_(bflo(gw.z)); v1[1] *= sigmoidf_(bfhi(gw.z)); v1[2] *= sigmoidf_(bflo(gw.w)); v1[3] *= sigmoidf_(bfhi(gw.w));
                float* tp = tmp + (size_t)row * 2048 + col;
                if (MODE >= 1) { v0 += *(const f32x4*)tp; v1 += *(const f32x4*)(tp + 4); }
                if (MODE <= 1) { *(f32x4*)tp = v0; *(f32x4*)(tp + 4) = v1; }
                else st_bf16x8(merged + (size_t)row * 2048 + col, v0, v1); } }
    }
};
struct EpiOut {
    const float* res; float* pre;
    __device__ __forceinline__ void operator()(const f32x4 (&acc)[2][2][4][2], const Unit& u, int wr, int wc, int fr, int fq) const {
        const int row0 = u.pm * BM + wr * 64 + fr, col0 = u.pn * BM + wc * 32 + fq * 8;
        EPI_LOOP_ROWS { const int row = row0 + ai * HALF + m * 16;
#pragma unroll
            for (int bj = 0; bj < 2; ++bj) { const size_t o = (size_t)row * 2048 + col0 + bj * HALF;
                const f32x4 r0 = *(const f32x4*)(res + o), r1 = *(const f32x4*)(res + o + 4);
                *(f32x4*)(pre + o) = r0 * ALPHA + acc[ai][bj][m][0]; *(f32x4*)(pre + o + 4) = r1 * ALPHA + acc[ai][bj][m][1]; } }
    }
};
struct EpiGateUp {
    const float* bg; const float* bu; bf16_t* hid;
    __device__ __forceinline__ void operator()(const f32x4 (&acc)[2][2][4][2], const Unit& u, int wr, int wc, int fr, int fq) const {
        const int row0 = u.pm * BM + wr * 64 + fr, j0 = u.pn * 128 + wc * 32 + fq * 8;
        const float* pg = bg + (size_t)u.e * DEXP + j0; const float* pu = bu + (size_t)u.e * DEXP + j0;
        const f32x4 g0b = *(const f32x4*)pg, g1b = *(const f32x4*)(pg + 4), u0b = *(const f32x4*)pu, u1b = *(const f32x4*)(pu + 4);
        EPI_LOOP_ROWS { const int row = row0 + ai * HALF + m * 16;
            f32x4 h0, h1;
#pragma unroll
            for (int j = 0; j < 4; ++j) {
                float g = fminf(acc[ai][0][m][0][j] + g0b[j], 7.0f), uu = fminf(fmaxf(acc[ai][1][m][0][j] + u0b[j], -7.0f), 7.0f);
                h0[j] = (uu + 1.0f) * (g * sigmoidf_(1.702f * g));
                g = fminf(acc[ai][0][m][1][j] + g1b[j], 7.0f); uu = fminf(fmaxf(acc[ai][1][m][1][j] + u1b[j], -7.0f), 7.0f);
                h1[j] = (uu + 1.0f) * (g * sigmoidf_(1.702f * g)); }
            st_bf16x8(hid + (size_t)row * DEXP + j0, h0, h1); }
    }
};
struct EpiDown {
    const float* bd; const float* roww; bf16_t* ys;
    __device__ __forceinline__ void operator()(const f32x4 (&acc)[2][2][4][2], const Unit& u, int wr, int wc, int fr, int fq) const {
        const int row0 = u.pm * BM + wr * 64 + fr, col0 = u.pn * BM + wc * 32 + fq * 8;
        f32x4 b[2][2];
#pragma unroll
        for (int bj = 0; bj < 2; ++bj) { const float* p = bd + (size_t)u.e * DM + col0 + bj * HALF; b[bj][0] = *(const f32x4*)p; b[bj][1] = *(const f32x4*)(p + 4); }
        EPI_LOOP_ROWS { const int row = row0 + ai * HALF + m * 16; const float w = roww[row];
#pragma unroll
            for (int bj = 0; bj < 2; ++bj) st_bf16x8(ys + (size_t)row * 2048 + col0 + bj * HALF, (acc[ai][bj][m][0] + b[bj][0]) * w, (acc[ai][bj][m][1] + b[bj][1]) * w); }
    }
};
struct EpiPleGate {
    const float* hf; const bf16_t* pp; float* pre;
    __device__ __forceinline__ void operator()(const f32x4 (&acc)[2][2][4][2], const Unit& u, int wr, int wc, int fr, int fq) const {
        const int row0 = u.pm * BM + wr * 64 + fr, col0 = u.pn * BM + wc * 32 + fq * 8;
        EPI_LOOP_ROWS { const int row = row0 + ai * HALF + m * 16;
#pragma unroll
            for (int bj = 0; bj < 2; ++bj) { const size_t o = (size_t)row * 2048 + col0 + bj * HALF;
                const u32x4 pw = *(const u32x4*)(pp + o); const f32x4 h0 = *(const f32x4*)(hf + o), h1 = *(const f32x4*)(hf + o + 4);
                const f32x4 a0 = acc[ai][bj][m][0], a1 = acc[ai][bj][m][1]; f32x4 o0, o1;
                o0[0] = h0[0] + sigmoidf_(a0[0]) * bflo(pw.x); o0[1] = h0[1] + sigmoidf_(a0[1]) * bfhi(pw.x); o0[2] = h0[2] + sigmoidf_(a0[2]) * bflo(pw.y); o0[3] = h0[3] + sigmoidf_(a0[3]) * bfhi(pw.y);
                o1[0] = h1[0] + sigmoidf_(a1[0]) * bflo(pw.z); o1[1] = h1[1] + sigmoidf_(a1[1]) * bfhi(pw.z); o1[2] = h1[2] + sigmoidf_(a1[2]) * bflo(pw.w); o1[3] = h1[3] + sigmoidf_(a1[3]) * bfhi(pw.w);
                *(f32x4*)(pre + o) = o0; *(f32x4*)(pre + o + 4) = o1; } }
    }
};
}

struct Params { const float* in[25]; float* out; unsigned char* ws; int ph_lo, ph_hi; };
__constant__ float c_invf_r[16] = {1.000000000e+00f, 4.403665960e-01f, 1.939227432e-01f, 8.539710194e-02f, 3.760603070e-02f, 1.656043902e-02f, 7.292664610e-03f, 3.211445874e-03f, 1.414213562e-03f, 6.227723788e-04f, 2.742481884e-04f, 1.207697351e-04f, 5.318296098e-05f, 2.341999971e-05f, 1.031338616e-05f, 4.541670478e-06f};
__constant__ float c_invf_i[8] = {1.000000000e+00f, 1.939227432e-01f, 3.760603070e-02f, 7.292664610e-03f, 1.414213562e-03f, 2.742481884e-04f, 5.318296098e-05f, 1.031338616e-05f};
constexpr int LDS_PTRS = LDS_MISC + 256;
struct Frame { unsigned char* lds; LAS unsigned char* ldsl; unsigned char* ws; int tid, lane, wid, G, bid;
    __device__ __forceinline__ const float* in(int k) const { const LAS unsigned* t = (const LAS unsigned*)(ldsl + LDS_PTRS) + 2 * k;
        const unsigned lo = __builtin_amdgcn_readfirstlane(t[0]), hi = __builtin_amdgcn_readfirstlane(t[1]); return (const float*)(((unsigned long long)hi << 32) | lo); }
    __device__ __forceinline__ float* out() const { return (float*)in(25); } };
__device__ __forceinline__ Frame fresh(const Frame& F0) { Frame F = F0; int t = threadIdx.x; asm volatile("" : "+v"(t)); F.tid = t; F.lane = t & 63; F.wid = __builtin_amdgcn_readfirstlane(t >> 6); unsigned char* w = F0.ws; asm volatile("" : "+s"(w)); F.ws = w; return F; }

__device__ __forceinline__ void tconv(const Frame& F, const float* src, long src_ld, int K, int ncols, bf16_t* dst, long dst_ld, int& rot) {
    float* tile = (float*)F.lds;
    const int tk = K >> 6, tn = (ncols + 63) >> 6, total = tk * tn, tid = F.tid;
    int start = (F.bid - (rot % F.G) + F.G) % F.G; rot += total;
    const int lr = tid >> 4, lc4 = (tid & 15) * 4, sn = tid >> 3, skc = (tid & 7) * 8;
    for (int t0 = start; t0 < total; t0 += 4 * F.G) {
#pragma unroll
        for (int q = 0; q < 4; ++q) { const int t = t0 + q * F.G;
            if (t < total) { const int k0 = (t % tk) * 64, n0 = (t / tk) * 64; float* tl = tile + q * (64 * 65);
#pragma unroll
                for (int h = 0; h < 2; ++h) { const int k = k0 + lr + 32 * h, col = n0 + lc4;
                    f32x4 v = (f32x4){0.f, 0.f, 0.f, 0.f}; if (col < ncols) v = *(const f32x4*)(src + (size_t)k * src_ld + col);
                    float* p = tl + (lr + 32 * h) * 65 + lc4; p[0] = v[0]; p[1] = v[1]; p[2] = v[2]; p[3] = v[3]; } } }
        __syncthreads();
#pragma unroll
        for (int q = 0; q < 4; ++q) { const int t = t0 + q * F.G;
            if (t < total) { const int k0 = (t % tk) * 64, n0 = (t / tk) * 64; const float* tl = tile + q * (64 * 65);
                if (n0 + sn < ncols) { f32x4 a, b;
#pragma unroll
                    for (int j = 0; j < 4; ++j) { a[j] = tl[(skc + j) * 65 + sn]; b[j] = tl[(skc + 4 + j) * 65 + sn]; }
                    pg8::st_bf16x8(dst + (size_t)(n0 + sn) * dst_ld + k0 + skc, a, b); } } }
        __syncthreads();
    }
}
__device__ __forceinline__ void conv_rows(const Frame& F, const float* src, bf16_t* dst, size_t n8) {
    for (size_t i = (size_t)F.bid * 512 + F.tid; i < n8; i += (size_t)F.G * 512) { const f32x4 a = *(const f32x4*)(src + i * 8), b = *(const f32x4*)(src + i * 8 + 4); pg8::st_bf16x8(dst + i * 8, a, b); }
}
__constant__ int c_so[14] = {0, 1312, 2416, 3440, 4464, 5496, 6520, 7544, 8568, 1024, 1280, 2336, 2400, 5488};
__constant__ int c_dn[14] = {0, 1024, 2048, 3072, 4096, 5120, 6144, 7168, 8192, 14336, 14592, 14624, 14688, 14704};
__constant__ int c_nc[14] = {1024, 1024, 1024, 1024, 1024, 1024, 1024, 1024, 6144, 256, 32, 64, 16, 8};
__device__ __forceinline__ void convert_layer_weights(const Frame& F0, const Params& P, int l) { const Frame F = fresh(F0);
    unsigned char* ws = F.ws; int rot = 0;
    { const float* w = F.in(2) + (size_t)l * DM * INW; bf16_t* d = (bf16_t*)(ws + W_IN);
#pragma unroll 1
      for (int s = 0; s < 14; ++s) tconv(F, w + c_so[s], INW, DM, c_nc[s], d + (size_t)c_dn[s] * DM, DM, rot); }
    tconv(F, F.in(7) + (size_t)l * 1024 * DM, DM, 1024, DM, (bf16_t*)(ws + W_BRA), 1024, rot);
    tconv(F, F.in(8) + (size_t)l * 1024 * DM, DM, 1024, DM, (bf16_t*)(ws + W_BRB), 1024, rot);
    tconv(F, F.in(9) + (size_t)l * 1024 * DM, DM, 1024, DM, (bf16_t*)(ws + W_BRC), 1024, rot);
    tconv(F, F.in(10) + (size_t)l * DM * DM, DM, DM, DM, (bf16_t*)(ws + W_OUT), DM, rot);
    tconv(F, F.in(21) + (size_t)l * DM * DM, DM, DM, DM, (bf16_t*)(ws + W_PG), DM, rot);
    tconv(F, F.in(22) + (size_t)l * 256 * DM, DM, 256, DM, (bf16_t*)(ws + W_PLE), 256, rot);
#pragma unroll 1
    for (int h = 0; h < 8; ++h) tconv(F, F.in(6) + (size_t)l * 256 * 1024 + h * 128, 1024, 256, 128, (bf16_t*)(ws + W_UV2) + ((size_t)(h >> 1) * 256 + (h & 1) * 128) * 512 + (h & 1) * 256, 512, rot);
#pragma unroll 1
    for (int e = 0; e < NEXP; ++e) {
        const float* wg = F.in(15) + ((size_t)l * NEXP + e) * DM * DEXP; const float* wu = F.in(17) + ((size_t)l * NEXP + e) * DM * DEXP;
        bf16_t* d = (bf16_t*)(ws + W_GU) + (size_t)e * 2048 * 2048;
#pragma unroll 1
        for (int jb = 0; jb < 8; ++jb) { tconv(F, wg + jb * 128, DEXP, DM, 128, d + (size_t)(jb * 256) * 2048, 2048, rot); tconv(F, wu + jb * 128, DEXP, DM, 128, d + (size_t)(jb * 256 + 128) * 2048, 2048, rot); }
        tconv(F, F.in(19) + ((size_t)l * NEXP + e) * DEXP * DM, DM, DEXP, DM, (bf16_t*)(ws + W_DN) + (size_t)e * 2048 * 1024, 1024, rot);
    }
    { const float* w = F.in(5) + (size_t)l * 256 * 8 * 96; bf16_t* d = (bf16_t*)(ws + W_UK2);
      for (int i = F.bid * 512 + F.tid; i < 256 * 8 * 96; i += F.G * 512) { const int n = i % 96, h = (i / 96) & 7, r = i / 768; d[((size_t)h * 256 + r) * 256 + (h & 1) * 128 + 32 + n] = f2bf(w[i]); } }
}

__device__ __forceinline__ void rope_cs(float pos, float invf, float& c, float& s) {
    const float a = pos * invf; const double ad = (double)a * 0.15915494309189535; const float fr = (float)(ad - rint(ad));
    s = __builtin_amdgcn_sinf(fr); c = __builtin_amdgcn_cosf(fr);
}
__device__ __forceinline__ void phase_prep(const Frame& F0, const Params& P, int l) { const Frame F = fresh(F0);
    unsigned char* ws = F.ws; const int lane = F.lane;
    const float* smallb = (const float*)(ws + R_SMALL); bf16_t* kcat = (bf16_t*)(ws + R_KCAT); bf16_t* qcat = (bf16_t*)(ws + R_QCAT);
    bf16_t* ki = (bf16_t*)(ws + R_KI); float* wi = (float*)(ws + R_WI); float* lf = (float*)(ws + WS_LF);
    const bf16_t* qa = (const bf16_t*)(ws + R_QA); bf16_t* qidx = (bf16_t*)(ws + R_QIDX);
    const f32x4 gck = *(const f32x4*)(F.in(4) + l * 256 + lane * 4);
    const float bfo = lane < 8 ? F.in(3)[l * 8 + lane] : 0.f;
    const float ifr = c_invf_r[lane & 15], ifi = c_invf_i[lane & 7];
    for (int tok = F.bid * 8 + F.wid; tok < NTOK; tok += F.G * 8) {
        const int s = tok & (SEQ - 1), b = tok >> 13; const float* sm = smallb + (size_t)tok * 512;
        float cr, sr, ci, si; rope_cs((float)s, ifr, cr, sr); rope_cs((float)s, ifi, ci, si);
        { const f32x4 v = *(const f32x4*)(sm + lane * 4); float ss = v[0] * v[0] + v[1] * v[1] + v[2] * v[2] + v[3] * v[3]; ss = wave_sum(ss);
          const float rs = rsqrtf(ss * (1.0f / 256.0f) + 1e-6f); u32x2 w; w.x = cvtpk(v[0] * rs * gck[0], v[1] * rs * gck[1]); w.y = cvtpk(v[2] * rs * gck[2], v[3] * rs * gck[3]);
          *(u32x2*)(kcat + (size_t)tok * 288 + lane * 4) = w; }
        if (lane < 16) { const float x1 = sm[256 + lane], x2 = sm[272 + lane]; kcat[(size_t)tok * 288 + 256 + lane] = f2bf(x1 * cr - x2 * sr); kcat[(size_t)tok * 288 + 272 + lane] = f2bf(x2 * cr + x1 * sr); }
        { float o = sm[288 + lane];
          if (lane < 8) { const float x2 = sm[296 + lane]; o = o * ci - x2 * si; } else if (lane < 16) { const float x1 = sm[288 + lane - 8]; o = o * ci + x1 * si; }
          ki[(size_t)tok * 64 + lane] = f2bf(o); }
        if (lane < 16) wi[(size_t)tok * 16 + lane] = sm[352 + lane] * (1.0f / 32.0f);
        if (lane < 8) { const float f = sm[368 + lane] + bfo; lf[(size_t)(b * 8 + lane) * SEQ + s] = fminf(f, 0.f) - log1pf(__expf(-fabsf(f))); }
#pragma unroll
        for (int pp = 0; pp < 2; ++pp) { const int p = lane + 64 * pp, h = p >> 4, i = p & 15;
            const float x1 = bf2f(qa[(size_t)tok * 1024 + h * 128 + i]), x2 = bf2f(qa[(size_t)tok * 1024 + h * 128 + 16 + i]);
            qcat[(size_t)tok * 2304 + h * 288 + 256 + i] = f2bf(x1 * cr - x2 * sr); qcat[(size_t)tok * 2304 + h * 288 + 272 + i] = f2bf(x2 * cr + x1 * sr); }
#pragma unroll
        for (int pp = 0; pp < 2; ++pp) { const int p = lane + 64 * pp, hh = p >> 3, i = p & 7; bf16_t* q = qidx + (size_t)tok * 1024 + hh * 64;
            const float x1 = bf2f(q[i]), x2 = bf2f(q[8 + i]); q[i] = f2bf(x1 * ci - x2 * si); q[8 + i] = f2bf(x2 * ci + x1 * si); }
    }
}
__device__ __forceinline__ void phase_cumsum(const Frame& F0) { const Frame F = fresh(F0);
    const int gw = F.bid * 8 + F.wid; if (gw >= 16) return;
    const float* lf = (const float*)(F.ws + WS_LF) + (size_t)gw * SEQ; float* cum = (float*)(F.ws + WS_CUM) + (size_t)gw * SEQ;
    const int lane = F.lane; double tot = 0.0;
    for (int j = 0; j < 128; ++j) tot += (double)lf[lane * 128 + j];
    double inc = tot;
    for (int o = 1; o < 64; o <<= 1) { const double n = __shfl_up(inc, o); if (lane >= o) inc += n; }
    double run = inc - tot;
    for (int j = 0; j < 128; ++j) { run += (double)lf[lane * 128 + j]; cum[lane * 128 + j] = (float)run; }
}

__device__ __forceinline__ void idx_group(const Frame& F, int b, int g) {
    const int lane = F.lane, rho = lane & 31, hh = lane >> 5; unsigned char* ws = F.ws;
    const bf16_t* qidx = (const bf16_t*)(ws + R_QIDX); const bf16_t* ki = (const bf16_t*)(ws + R_KI) + (size_t)b * SEQ * 64; const float* wi = (const float*)(ws + R_WI);
    float* scores = (float*)(ws + R_SCORES) + (size_t)b * SEQ * SEQ;
    const int t0 = g * 4;
    bf16x8 af[2][4]; float wv[2][16];
#pragma unroll
    for (int mt = 0; mt < 2; ++mt) {
        const int tokA = b * SEQ + t0 + 2 * mt + ((rho >> 2) & 1), head = (rho & 3) + 4 * (rho >> 3);
#pragma unroll
        for (int kk = 0; kk < 4; ++kk) af[mt][kk] = *(const bf16x8*)(qidx + (size_t)tokA * 1024 + head * 64 + kk * 16 + 8 * hh);
        const float* wp = wi + (size_t)(b * SEQ + t0 + 2 * mt + hh) * 16;
#pragma unroll
        for (int q = 0; q < 4; ++q) { const f32x4 v = *(const f32x4*)(wp + 4 * q); wv[mt][4 * q] = v[0]; wv[mt][4 * q + 1] = v[1]; wv[mt][4 * q + 2] = v[2]; wv[mt][4 * q + 3] = v[3]; }
    }
    const int ntile = (t0 + 3) / 32 + 1;
    bf16x8 bc[4], bn[4];
#pragma unroll
    for (int kk = 0; kk < 4; ++kk) bc[kk] = *(const bf16x8*)(ki + (size_t)rho * 64 + kk * 16 + 8 * hh);
    for (int tl = 0; tl < ntile; ++tl) {
        const int kb = tl * 32, kbn = (tl + 1 < ntile) ? kb + 32 : kb;
#pragma unroll
        for (int kk = 0; kk < 4; ++kk) bn[kk] = *(const bf16x8*)(ki + (size_t)(kbn + rho) * 64 + kk * 16 + 8 * hh);
#pragma unroll
        for (int mt = 0; mt < 2; ++mt) {
            f32x16 acc = {};
#pragma unroll
            for (int kk = 0; kk < 4; ++kk) acc = __builtin_amdgcn_mfma_f32_32x32x16_bf16(af[mt][kk], bc[kk], acc, 0, 0, 0);
            float sc = 0.f;
#pragma unroll
            for (int r = 0; r < 16; ++r) sc = fmaf(wv[mt][r], fmaxf(acc[r], 0.f), sc);
            scores[(size_t)(t0 + 2 * mt + hh) * SEQ + kb + rho] = sc;
        }
#pragma unroll
        for (int kk = 0; kk < 4; ++kk) bc[kk] = bn[kk];
    }
}
__device__ __forceinline__ void phase_idx(const Frame& F0) { const Frame F = fresh(F0);
    for (int gw = F.bid * 8 + F.wid; gw < 2048; gw += F.G * 8) { const int b = gw >> 10, pr = gw & 1023; idx_group(F, b, pr); idx_group(F, b, 2047 - pr); }
}

__device__ __forceinline__ unsigned sortable(float f) { const unsigned u = __float_as_uint(f); return (u & 0x80000000u) ? ~u : (u | 0x80000000u); }
__device__ __forceinline__ void topk_row(const Frame& F, int b, int t) {
    const int lane = F.lane, L = t + 1, tok = b * SEQ + t; unsigned char* ws = F.ws;
    int* sel = (int*)(ws + R_SEL) + (size_t)tok * 256; int* nsel = (int*)(ws + R_NSEL);
    if (lane == 0) nsel[tok] = L < 256 ? L : 256;
    if (L <= 256) { for (int j = lane; j < 256; j += 64) sel[j] = j < L ? j : 0; return; }
    const float* row = (const float*)(ws + R_SCORES) + ((size_t)b * SEQ + t) * SEQ;
    const int nch = (L + 1023) >> 10;
    unsigned u[128];
#pragma unroll
    for (int c = 0; c < 8; ++c) {
        if (c < nch) {
#pragma unroll
            for (int jj = 0; jj < 4; ++jj) { const int j = c * 4 + jj; const f32x4 v = *(const f32x4*)(row + j * 256 + lane * 4);
#pragma unroll
                for (int e = 0; e < 4; ++e) { const int idx = j * 256 + lane * 4 + e; u[j * 4 + e] = idx < L ? sortable(v[e]) : 0u; } }
        } else {
#pragma unroll
            for (int q = 0; q < 16; ++q) u[c * 16 + q] = 0u;
        }
    }
    unsigned T = 0u, thr_gt = 0u; int need_eq = 0; bool early = false;
    for (int bit = 31; bit >= 0; --bit) {
        const unsigned cand = T | (1u << bit); int cnt = 0;
#pragma unroll
        for (int c = 0; c < 8; ++c) if (c < nch) {
#pragma unroll
            for (int q = 0; q < 16; ++q) cnt += __popcll(__ballot(u[c * 16 + q] >= cand)); }
        if (cnt >= 256) { T = cand; if (cnt == 256) { early = true; break; } }
    }
    if (early) { thr_gt = T - 1u; need_eq = 0; }
    else { int gtc = 0;
#pragma unroll
        for (int c = 0; c < 8; ++c) if (c < nch) {
#pragma unroll
            for (int q = 0; q < 16; ++q) gtc += __popcll(__ballot(u[c * 16 + q] > T)); }
        thr_gt = T; need_eq = 256 - gtc; }
    int base = 0, eq_taken = 0;
#pragma unroll
    for (int c = 0; c < 8; ++c) if (c < nch) {
#pragma unroll
        for (int q = 0; q < 16; ++q) { const int rq = c * 16 + q; const unsigned v = u[rq];
            const bool iseq = (v == thr_gt) && (need_eq > 0);
            const unsigned long long meq = __ballot(iseq);
            const int eqr = __popcll(meq & ((1ull << lane) - 1ull));
            const bool take = (v > thr_gt) || (iseq && (eq_taken + eqr < need_eq));
            const unsigned long long mt = __ballot(take);
            const int pos = base + __popcll(mt & ((1ull << lane) - 1ull));
            if (take && pos < 256) sel[pos] = (rq >> 2) * 256 + lane * 4 + (rq & 3);
            base += __popcll(mt); eq_taken += __popcll(meq); } }
}
__device__ __forceinline__ void phase_topk(const Frame& F0) { const Frame F = fresh(F0);
    for (int q = F.bid * 8 + F.wid; q < 8192; q += F.G * 8) { const int b = q >> 12, p = q & 4095; topk_row(F, b, p); topk_row(F, b, SEQ - 1 - p); }
}

namespace att {
constexpr int D = 128, KVBLK = 64, QBLK = 32, SHM_V = 16384, SHM_K = 16384;
constexpr int OFF_K = 2 * SHM_V, OFF_BIAS = 2 * SHM_V + 2 * SHM_K, OFF_WS = OFF_BIAS + 512;
#define KSWZ(row, colB) ((row) * 256 + ((colB) ^ (((row) & 7) << 4)))
__device__ __forceinline__ int v_st(int k, int c) { const int kk = (k & ~0xC) | ((k & 4) << 1) | ((k & 8) >> 1); return ((kk >> 3) * 4 + (c >> 5)) * 512 + ((kk & 7) * 32 + (c & 31)) * 2; }
__device__ __forceinline__ int v_rd_base(int lane) { return ((lane & 3) << 3) | (((lane >> 2) & 3) << 6) | (((lane >> 4) & 1) << 5) | (((lane >> 5) & 1) << 8); }
constexpr int v_rd_off(int d0, int ks, int half) { return d0 * 512 + ks * 4096 + half * 2048; }
template <int KB>
__device__ __forceinline__ void qkt(f32x16& p0, f32x16& p1, const char* K_lds, int r32, int hi, const bf16x8* qr) {
    p0 = f32x16{}; p1 = f32x16{};
    const char* kb[4];
#pragma unroll
    for (int dd = 0; dd < 4; ++dd) kb[dd] = K_lds + KB * SHM_K + KSWZ(r32, (dd * 16 + hi * 8) * 2);
#pragma unroll
    for (int d0 = 0; d0 < 8; ++d0) { const char* a = kb[d0 & 3] + (d0 >> 2) * 128;
        bf16x8 b0 = *reinterpret_cast<const bf16x8*>(a);
        bf16x8 b1 = *reinterpret_cast<const bf16x8*>(a + 32 * 256);
        p0 = __builtin_amdgcn_mfma_f32_32x32x16_bf16(b0, qr[d0], p0, 0, 0, 0);
        p1 = __builtin_amdgcn_mfma_f32_32x32x16_bf16(b1, qr[d0], p1, 0, 0, 0); }
}
template <int VB>
__device__ __forceinline__ void pv_tile(f32x16* o, int vb0, bf16x8 pa0, bf16x8 pa1, bf16x8 pa2, bf16x8 pa3) {
#define TRRD(dst, off) asm volatile("ds_read_b64_tr_b16 %0, %1 offset:%2" : "=&v"(dst) : "v"(vb0), "i"(off) : "memory")
#define PV_D0(d0) do { s16x4 l0, l1, l2, l3, h0, h1, h2, h3; constexpr int b_ = VB * SHM_V + v_rd_off(d0, 0, 0); \
        TRRD(l0, b_); TRRD(h0, b_ + 2048); TRRD(l1, b_ + 4096); TRRD(h1, b_ + 6144); TRRD(l2, b_ + 8192); TRRD(h2, b_ + 10240); TRRD(l3, b_ + 12288); TRRD(h3, b_ + 14336); \
        asm volatile("s_waitcnt lgkmcnt(0)" ::: "memory"); SBAR(); \
        o[d0] = __builtin_amdgcn_mfma_f32_32x32x16_bf16(pa0, (bf16x8){l0[0], l0[1], l0[2], l0[3], h0[0], h0[1], h0[2], h0[3]}, o[d0], 0, 0, 0); \
        o[d0] = __builtin_amdgcn_mfma_f32_32x32x16_bf16(pa1, (bf16x8){l1[0], l1[1], l1[2], l1[3], h1[0], h1[1], h1[2], h1[3]}, o[d0], 0, 0, 0); \
        o[d0] = __builtin_amdgcn_mfma_f32_32x32x16_bf16(pa2, (bf16x8){l2[0], l2[1], l2[2], l2[3], h2[0], h2[1], h2[2], h2[3]}, o[d0], 0, 0, 0); \
        o[d0] = __builtin_amdgcn_mfma_f32_32x32x16_bf16(pa3, (bf16x8){l3[0], l3[1], l3[2], l3[3], h3[0], h3[1], h3[2], h3[3]}, o[d0], 0, 0, 0); } while (0)
    PV_D0(0); PV_D0(1); PV_D0(2); PV_D0(3);
#undef PV_D0
#undef TRRD
}
#define PK4(P, B_, OUT) do { unsigned a0 = cvtpk(P[B_+0], P[B_+1]), a1 = cvtpk(P[B_+2], P[B_+3]); \
        unsigned b0 = cvtpk(P[B_+4], P[B_+5]), b1 = cvtpk(P[B_+6], P[B_+7]); \
        auto r0 = __builtin_amdgcn_permlane32_swap(a0, b0, false, false); auto r1 = __builtin_amdgcn_permlane32_swap(a1, b1, false, false); \
        u32x4 w = {r0[0], r1[0], r0[1], r1[1]}; OUT = *reinterpret_cast<bf16x8*>(&w); } while (0)
__device__ __forceinline__ float swap_max(float x) { auto rr = __builtin_amdgcn_permlane32_swap(__float_as_uint(x), __float_as_uint(x), false, false); return fmaxf(__uint_as_float(rr[0]), __uint_as_float(rr[1])); }
__device__ __forceinline__ float swap_sum(float x) { auto rr = __builtin_amdgcn_permlane32_swap(__float_as_uint(x), __float_as_uint(x), false, false); return __uint_as_float(rr[0]) + __uint_as_float(rr[1]); }
__device__ __forceinline__ float swap_lo(float x) { auto rr = __builtin_amdgcn_permlane32_swap(__float_as_uint(x), __float_as_uint(x), false, false); return __uint_as_float(rr[0]); }


__device__ __forceinline__ void fox_sm(f32x16& p0, f32x16& p1, const float* bl, int kb_, int qlo, int qrow, int hi, int r32, float& m_reg, float& l_reg, f32x16* o, float* al_l,
                                       bf16x8& pa0, bf16x8& pa1, bf16x8& pa2, bf16x8& pa3) {
#pragma unroll
    for (int g = 0; g < 4; ++g) { const f32x4 b0v = *(const f32x4*)(bl + 8 * g + 4 * hi), b1v = *(const f32x4*)(bl + 32 + 8 * g + 4 * hi);
#pragma unroll
        for (int i = 0; i < 4; ++i) { p0[4 * g + i] = fmaf(p0[4 * g + i], C2, b0v[i]); p1[4 * g + i] = fmaf(p1[4 * g + i], C2, b1v[i]); } }
    if (kb_ + KVBLK - 1 > qlo) { const float NEG = -__builtin_inff();
#pragma unroll
        for (int r = 0; r < 16; ++r) { const int key = kb_ + crow(r, hi); if (key > qrow) p0[r] = NEG; if (key + 32 > qrow) p1[r] = NEG; } }
    float pmax = p0[0];
#pragma unroll
    for (int r = 1; r < 16; ++r) pmax = fmaxf(pmax, p0[r]);
#pragma unroll
    for (int r = 0; r < 16; ++r) pmax = fmaxf(pmax, p1[r]);
    pmax = swap_max(pmax);
    const float mn = fmaxf(m_reg, pmax), alpha = __builtin_amdgcn_exp2f(m_reg - mn); m_reg = mn;
    float ps = 0.f;
#pragma unroll
    for (int r = 0; r < 16; ++r) { p0[r] = __builtin_amdgcn_exp2f(p0[r] - mn); p1[r] = __builtin_amdgcn_exp2f(p1[r] - mn); ps += p0[r] + p1[r]; }
    ps = swap_sum(ps); l_reg = l_reg * alpha + ps;
    if (__any(alpha < 1.f)) { if (hi == 0) al_l[r32] = alpha; asm volatile("s_waitcnt lgkmcnt(0)" ::: "memory");
#pragma unroll
        for (int r = 0; r < 16; ++r) { const float a = al_l[crow(r, hi)];
#pragma unroll
            for (int d_ = 0; d_ < 4; ++d_) o[d_][r] *= a; } }
    PK4(p0, 0, pa0); PK4(p0, 8, pa1); PK4(p1, 0, pa2); PK4(p1, 8, pa3);
}
__device__ __forceinline__ void sb_half(f32x16& pz, int keybase, int qrow, int hi, float& R, const bf16x8* triA, bool needmask) {
    f32x16 X;
#pragma unroll
    for (int r = 0; r < 16; ++r) { const float zz = pz[r] * C2; const bool valid = !needmask || (keybase + crow(r, hi) < qrow);
        const float l2 = fmaxf(zz, 0.f) + __builtin_amdgcn_logf(1.0f + __builtin_amdgcn_exp2f(-fabsf(zz)));
        X[r] = valid ? -l2 : 0.f; pz[r] = valid ? zz : -__builtin_inff(); }
    f32x16 Y;
#pragma unroll
    for (int r = 0; r < 16; ++r) Y[r] = R;
#pragma unroll
    for (int s = 0; s < 2; ++s) {
        const unsigned h0 = cvtpk(X[8 * s + 0], X[8 * s + 1]), h1 = cvtpk(X[8 * s + 2], X[8 * s + 3]), h2 = cvtpk(X[8 * s + 4], X[8 * s + 5]), h3 = cvtpk(X[8 * s + 6], X[8 * s + 7]);
        const unsigned l0 = cvtpk(X[8 * s + 0] - bflo(h0), X[8 * s + 1] - bfhi(h0)), l1 = cvtpk(X[8 * s + 2] - bflo(h1), X[8 * s + 3] - bfhi(h1));
        const unsigned l2 = cvtpk(X[8 * s + 4] - bflo(h2), X[8 * s + 5] - bfhi(h2)), l3 = cvtpk(X[8 * s + 6] - bflo(h3), X[8 * s + 7] - bfhi(h3));
        u32x4 wh = {h0, h1, h2, h3}, wl = {l0, l1, l2, l3};
        Y = __builtin_amdgcn_mfma_f32_32x32x16_bf16(triA[s], *reinterpret_cast<bf16x8*>(&wh), Y, 0, 0, 0);
        Y = __builtin_amdgcn_mfma_f32_32x32x16_bf16(triA[s], *reinterpret_cast<bf16x8*>(&wl), Y, 0, 0, 0); }
#pragma unroll
    for (int r = 0; r < 16; ++r) pz[r] = __builtin_amdgcn_exp2f(pz[r] + Y[r]);
    R = swap_lo(Y[0]);
}
__device__ __forceinline__ void sb_sm(f32x16& p0, f32x16& p1, int kb_, int qlo, int qrow, int hi, float& R, const bf16x8* triA, bf16x8& pa0, bf16x8& pa1, bf16x8& pa2, bf16x8& pa3) {
    const bool needmask = (kb_ + KVBLK - 1 >= qlo);
    sb_half(p1, kb_ + 32, qrow, hi, R, triA, needmask);
    sb_half(p0, kb_, qrow, hi, R, triA, needmask);
    PK4(p0, 0, pa0); PK4(p0, 8, pa1); PK4(p1, 0, pa2); PK4(p1, 8, pa3);
}

template <int MODE>
__device__ __forceinline__ void attn_unit(const bf16_t* Q, const bf16_t* Kh, const bf16_t* Vh, const float* cum, bf16_t* O, int P0, char* lds) {
    int tid = threadIdx.x; asm volatile("" : "+v"(tid));
    const int wid = __builtin_amdgcn_readfirstlane(tid >> 6), lane = tid & 63, r32 = lane & 31, hi = lane >> 5;
    const int NT = P0 / KVBLK + 4;
    char* V_lds = lds; char* K_lds = lds + OFF_K; float* bias_l = (float*)(lds + OFF_BIAS);
    float* wsl = (float*)(lds + OFF_WS) + wid * 64; float* li_l = wsl; float* al_l = wsl + 32;
    const int qlo = P0 + wid * QBLK, qrow = qlo + r32;
    bf16x8 qr[8];
#pragma unroll
    for (int d0 = 0; d0 < 8; ++d0) qr[d0] = *(const bf16x8*)(Q + (size_t)qrow * D + d0 * 16 + hi * 8);
    const int sr = tid >> 4, sc = (tid & 15) * 8, vst0 = v_st(sr, sc), vst1 = v_st(32 + sr, sc), kws = KSWZ(sr, sc * 2);
    const int vb0 = (int)(uintptr_t)V_lds + v_rd_base(lane);
    const float cumref = (MODE == 0) ? cum[P0] : 0.f;
    float m_reg = -1e30f, l_reg = 0.f, R = 0.f; f32x16 o[4] = {};
    bf16x8 triA[2];
    if (MODE == 1) {
#pragma unroll
        for (int s = 0; s < 2; ++s)
#pragma unroll
            for (int j = 0; j < 8; ++j) { const int rho = 16 * s + 8 * (j >> 2) + 4 * hi + (j & 3); triA[s][j] = (rho >= r32) ? (short)0x3F80 : (short)0; }
    }
    bf16x8 st_k0, st_k1, st_v0, st_v1; float st_b = 0.f;
#define TILE_KB(t) ((MODE == 0 ? (t) : (NT - 1 - (t))) * KVBLK)
#define SLOAD(kb_) do { st_v0 = *(const bf16x8*)(Vh + (size_t)((kb_) + sr) * D + sc); st_v1 = *(const bf16x8*)(Vh + (size_t)((kb_) + 32 + sr) * D + sc); \
                        st_k0 = *(const bf16x8*)(Kh + (size_t)((kb_) + sr) * D + sc); st_k1 = *(const bf16x8*)(Kh + (size_t)((kb_) + 32 + sr) * D + sc); \
                        if (MODE == 0 && tid < 64) st_b = (cumref - cum[(kb_) + tid]) * LOG2E; } while (0)
#define SWRITE(bf) do { *(bf16x8*)(V_lds + (bf) * SHM_V + vst0) = st_v0; *(bf16x8*)(V_lds + (bf) * SHM_V + vst1) = st_v1; \
                        *(bf16x8*)(K_lds + (bf) * SHM_K + kws) = st_k0; *(bf16x8*)(K_lds + (bf) * SHM_K + kws + 32 * 256) = st_k1; \
                        if (MODE == 0 && tid < 64) bias_l[(bf) * 64 + tid] = st_b; } while (0)
    __syncthreads();
    SLOAD(TILE_KB(0)); SWRITE(0);
    __syncthreads();
    f32x16 p0, p1; bf16x8 pa0, pa1, pa2, pa3;
#define STEP(BUF, t) do { const int kb_ = TILE_KB(t); \
        if ((t) + 1 < NT) SLOAD(TILE_KB((t) + 1)); \
        SBAR(); qkt<BUF>(p0, p1, K_lds, r32, hi, qr); \
        if (MODE == 0) fox_sm(p0, p1, bias_l + (BUF) * 64, kb_, qlo, qrow, hi, r32, m_reg, l_reg, o, al_l, pa0, pa1, pa2, pa3); \
        else sb_sm(p0, p1, kb_, qlo, qrow, hi, R, triA, pa0, pa1, pa2, pa3); \
        SBAR(); pv_tile<BUF>(o, vb0, pa0, pa1, pa2, pa3); \
        if ((t) + 1 < NT) SWRITE((BUF) ^ 1); \
        __syncthreads(); } while (0)
    for (int t = 0; t < NT; t += 2) { STEP(0, t); STEP(1, t + 1); }
#undef STEP
#undef SLOAD
#undef SWRITE
#undef TILE_KB
    float rli[16];
    if (MODE == 0) { if (hi == 0) li_l[r32] = l_reg; asm volatile("s_waitcnt lgkmcnt(0)" ::: "memory");
#pragma unroll
        for (int r = 0; r < 16; ++r) rli[r] = __builtin_amdgcn_rcpf(li_l[crow(r, hi)]); }
    bf16_t* Ow = O + (size_t)(wid * QBLK) * 1024;
#pragma unroll
    for (int r = 0; r < 16; ++r) { const int orow = crow(r, hi);
#pragma unroll
        for (int d0 = 0; d0 < 4; ++d0) { const float v = (MODE == 0) ? o[d0][r] * rli[r] : o[d0][r];
            const float vn = __shfl_xor(v, 1);
            if ((r32 & 1) == 0) *(unsigned*)(Ow + (size_t)orow * 1024 + d0 * 32 + r32) = cvtpk(v, vn); } }
}
}

__device__ __forceinline__ void sparse_query(const Frame& F, int tok, char* ldsw) {
    unsigned char* ws = F.ws; const int lane = F.lane, g = lane >> 4, i16 = lane & 15;
    const bf16_t* qcat = (const bf16_t*)(ws + R_QCAT) + (size_t)tok * 2304; const bf16_t* kbase = (const bf16_t*)(ws + R_KCAT) + (size_t)(tok >> 13) * SEQ * 288;
    const int* sel = (const int*)(ws + R_SEL) + (size_t)tok * 256; const int ns = ((const int*)(ws + R_NSEL))[tok]; const int ntile = (ns + 31) >> 5;
    bf16x8 qf[9];
#pragma unroll
    for (int st = 0; st < 9; ++st) { qf[st] = (bf16x8){0, 0, 0, 0, 0, 0, 0, 0}; if (i16 < 8) qf[st] = *(const bf16x8*)(qcat + i16 * 288 + st * 32 + 8 * g); }
    const int rA = lane >> 2, cq = lane & 3;
    float m = -1e30f, l = 0.f; f32x4 oT[16];
#pragma unroll
    for (int rb = 0; rb < 16; ++rb) oT[rb] = (f32x4){0.f, 0.f, 0.f, 0.f};
    const unsigned ldso = (unsigned)(uintptr_t)ldsw;
    const unsigned vb = ldso + (unsigned)((4 * g + (i16 >> 2)) * 592 + (i16 & 3) * 8);
    constexpr float SC2 = SCALE * LOG2E;
    bf16x8 stg[18];
#define GATHER(tile_) do { const int j0 = (tile_) * 32 + rA, j1 = j0 + 16; const int s0 = j0 < ns ? sel[j0] : 0, s1 = j1 < ns ? sel[j1] : 0; \
        const bf16_t* p0_ = kbase + (size_t)s0 * 288 + cq * 8; const bf16_t* p1_ = kbase + (size_t)s1 * 288 + cq * 8; \
        _Pragma("unroll") for (int c = 0; c < 9; ++c) { stg[2 * c] = *(const bf16x8*)(p0_ + c * 32); stg[2 * c + 1] = *(const bf16x8*)(p1_ + c * 32); } } while (0)
    GATHER(0);
    for (int tile = 0; tile < ntile; ++tile) {
#pragma unroll
        for (int c = 0; c < 9; ++c) { *(bf16x8*)(ldsw + rA * 592 + c * 64 + cq * 16) = stg[2 * c]; *(bf16x8*)(ldsw + (16 + rA) * 592 + c * 64 + cq * 16) = stg[2 * c + 1]; }
        if (tile + 1 < ntile) GATHER(tile + 1);
        asm volatile("s_waitcnt lgkmcnt(0)" ::: "memory"); SBAR();
        f32x4 acc[2];
#pragma unroll
        for (int mt = 0; mt < 2; ++mt) { acc[mt] = (f32x4){0.f, 0.f, 0.f, 0.f};
#pragma unroll
            for (int st = 0; st < 9; ++st) { const bf16x8 a = *(const bf16x8*)(ldsw + (16 * mt + i16) * 592 + st * 64 + g * 16);
                acc[mt] = __builtin_amdgcn_mfma_f32_16x16x32_bf16(a, qf[st], acc[mt], 0, 0, 0); } }
        float tmax = -__builtin_inff();
#pragma unroll
        for (int mt = 0; mt < 2; ++mt)
#pragma unroll
            for (int r = 0; r < 4; ++r) { const int key = tile * 32 + 16 * mt + 4 * g + r; float x = acc[mt][r] * SC2; if (key >= ns) x = -__builtin_inff(); acc[mt][r] = x; tmax = fmaxf(tmax, x); }
        tmax = fmaxf(tmax, __shfl_xor(tmax, 16)); tmax = fmaxf(tmax, __shfl_xor(tmax, 32));
        const float mn = fmaxf(m, tmax), alpha = __builtin_amdgcn_exp2f(m - mn); m = mn;
        float ps = 0.f;
#pragma unroll
        for (int mt = 0; mt < 2; ++mt)
#pragma unroll
            for (int r = 0; r < 4; ++r) { acc[mt][r] = __builtin_amdgcn_exp2f(acc[mt][r] - mn); ps += acc[mt][r]; }
        ps += __shfl_xor(ps, 16); ps += __shfl_xor(ps, 32);
        l = l * alpha + ps;
#pragma unroll
        for (int rb = 0; rb < 16; ++rb) oT[rb] *= alpha;
        const bf16x8 pf = pack8(acc[0], acc[1]);
#define TRRD2(dst, off) asm volatile("ds_read_b64_tr_b16 %0, %1 offset:%2" : "=&v"(dst) : "v"(vb), "i"(off) : "memory")
#define PVRB(rb) do { s16x4 t1, t2; TRRD2(t1, (rb) * 32); TRRD2(t2, (rb) * 32 + 16 * 592); asm volatile("s_waitcnt lgkmcnt(0)" ::: "memory"); SBAR(); \
        oT[rb] = __builtin_amdgcn_mfma_f32_16x16x32_bf16((bf16x8){t1[0], t1[1], t1[2], t1[3], t2[0], t2[1], t2[2], t2[3]}, pf, oT[rb], 0, 0, 0); } while (0)
        PVRB(0); PVRB(1); PVRB(2); PVRB(3); PVRB(4); PVRB(5); PVRB(6); PVRB(7); PVRB(8); PVRB(9); PVRB(10); PVRB(11); PVRB(12); PVRB(13); PVRB(14); PVRB(15);
#undef PVRB
#undef TRRD2
        SBAR();
    }
#undef GATHER
    const float rl = 1.0f / l;
    if (i16 < 8) { bf16_t* op = (bf16_t*)(ws + R_OLAT) + (size_t)tok * 2048 + i16 * 256 + 4 * g;
#pragma unroll
        for (int rb = 0; rb < 16; ++rb) { u32x2 w; w.x = cvtpk(oT[rb][0] * rl, oT[rb][1] * rl); w.y = cvtpk(oT[rb][2] * rl, oT[rb][3] * rl); *(u32x2*)(op + rb * 16) = w; } }
}
#ifdef ATT_SUB
#define ASUB(k) ((k) == ATT_SUB)
#else
#define ASUB(k) true
#endif
__device__ __forceinline__ void phase_attn(const Frame& F0) { const Frame F = fresh(F0);
    unsigned char* ws = F.ws; char* lds = (char*)F.lds;
    const bf16_t* qkv = (const bf16_t*)(ws + R_QKV); const size_t TS = (size_t)NTOK * 1024;
#pragma unroll 1
    for (int mode = 0; mode < 2; ++mode) {
        if (!ASUB(mode)) continue;
#pragma unroll 1
        for (int it = F.bid; it < 256; it += F.G) { const int bh = it >> 4, x = it & 15, b = bh >> 3, h = bh & 7;
            const bf16_t* Q = qkv + (size_t)(mode * 3 + 0) * TS + (size_t)bh * SEQ * 128; const bf16_t* K = qkv + (size_t)(mode * 3 + 1) * TS + (size_t)bh * SEQ * 128; const bf16_t* V = qkv + (size_t)(mode * 3 + 2) * TS + (size_t)bh * SEQ * 128;
            const float* cum = (const float*)(ws + WS_CUM) + (size_t)bh * SEQ;
            bf16_t* Ob = (bf16_t*)(ws + (mode == 0 ? R_OB : R_OC)) + (size_t)b * SEQ * 1024 + h * 128;
#pragma unroll 1
            for (int pass = 0; pass < 2; ++pass) { const int qb = pass ? 31 - x : x, P0 = qb * 256;
                if (mode == 0) att::attn_unit<0>(Q, K, V, cum, Ob + (size_t)P0 * 1024, P0, lds);
                else att::attn_unit<1>(Q, K, V, cum, Ob + (size_t)P0 * 1024, P0, lds); } }
    }
    __syncthreads();
    char* ldsw = lds + F.wid * 18944;
#pragma unroll 1
    for (int tok = F.bid * 8 + F.wid; tok < NTOK; tok += F.G * 8) if (ASUB(2)) sparse_query(F, tok, ldsw);
}

__device__ __forceinline__ void ln_row(const float* src, const float* g, const float* bta, float* of, bf16_t* ob, int lane) {
    f32x4 v[8]; float s = 0.f;
#pragma unroll
    for (int i = 0; i < 8; ++i) { v[i] = *(const f32x4*)(src + (i * 64 + lane) * 4); s += (v[i][0] + v[i][1]) + (v[i][2] + v[i][3]); }
    s = wave_sum(s); const float mu = s * (1.0f / 2048.0f); float q = 0.f;
#pragma unroll
    for (int i = 0; i < 8; ++i) { const f32x4 d = v[i] - mu; q += (d[0] * d[0] + d[1] * d[1]) + (d[2] * d[2] + d[3] * d[3]); }
    q = wave_sum(q); const float rstd = rsqrtf(q * (1.0f / 2048.0f) + 1e-5f);
#pragma unroll
    for (int i = 0; i < 8; ++i) { const int c = (i * 64 + lane) * 4; const f32x4 gg = *(const f32x4*)(g + c), bb = *(const f32x4*)(bta + c); const f32x4 y = (v[i] - mu) * rstd * gg + bb;
        if (of) *(f32x4*)(of + c) = y;
        if (ob) { u32x2 w; w.x = cvtpk(y[0], y[1]); w.y = cvtpk(y[2], y[3]); *(u32x2*)(ob + c) = w; } }
}
__device__ __forceinline__ void phase_ln1_router(const Frame& F0, const Params& P, int l) { const Frame F = fresh(F0);
    unsigned char* ws = F.ws; const int lane = F.lane, wid = F.wid;
    const float* pre1 = (const float*)(ws + R_PRE1); float* x1f = (float*)(ws + M_X1F); bf16_t* x1b = (bf16_t*)(ws + M_X1B);
    const float* g = F.in(11) + l * DM; const float* bt = F.in(12) + l * DM; const float* wr = F.in(13) + (size_t)l * DM * NEXP; const float* br = F.in(14) + l * NEXP;
    unsigned* cnt = (unsigned*)(ws + WS_CTL) + CW_CNT + l * 32;
    int* tok_e = (int*)(ws + M_TOKE); int* tok_pos = (int*)(ws + M_TOKPOS); float* tok_w = (float*)(ws + M_TOKW);
    float* red = (float*)F.lds;
    float* lg = (float*)(F.lds + 32768);
#pragma unroll 1
    for (int blk = F.bid; blk < NTOK / 64; blk += F.G) {
        const int tok0 = blk * 64;
#pragma unroll 1
        for (int i = 0; i < 8; ++i) { const int tok = tok0 + wid * 8 + i; ln_row(pre1 + (size_t)tok * DM, g, bt, x1f + (size_t)tok * DM, x1b + (size_t)tok * DM, lane); }
        asm volatile("s_waitcnt vmcnt(0)" ::: "memory"); __syncthreads();
        { const int grp = wid >> 2, kq = wid & 3, i32 = lane & 31, hk = lane >> 5; f32x16 acc = {};
          const float* arow = x1f + (size_t)(tok0 + grp * 32 + i32) * DM + kq * 512 + 4 * hk; const float* bcol = wr + (size_t)(kq * 512 + 4 * hk) * NEXP + i32;
#pragma unroll 4
          for (int c8 = 0; c8 < 64; ++c8) { const f32x4 a4 = *(const f32x4*)(arow + c8 * 8);
              const float b0 = bcol[(size_t)(c8 * 8 + 0) * NEXP], b1 = bcol[(size_t)(c8 * 8 + 1) * NEXP], b2 = bcol[(size_t)(c8 * 8 + 2) * NEXP], b3 = bcol[(size_t)(c8 * 8 + 3) * NEXP];
              acc = __builtin_amdgcn_mfma_f32_32x32x2f32(a4[0], b0, acc, 0, 0, 0); acc = __builtin_amdgcn_mfma_f32_32x32x2f32(a4[1], b1, acc, 0, 0, 0);
              acc = __builtin_amdgcn_mfma_f32_32x32x2f32(a4[2], b2, acc, 0, 0, 0); acc = __builtin_amdgcn_mfma_f32_32x32x2f32(a4[3], b3, acc, 0, 0, 0); }
#pragma unroll
          for (int r = 0; r < 16; ++r) red[(wid * 16 + r) * 64 + lane] = acc[r]; }
        __syncthreads();
        if ((wid & 3) == 0) { const int grp = wid >> 2, hk = lane >> 5, e = lane & 31; const float be = br[e];
#pragma unroll
            for (int r = 0; r < 16; ++r) { const float v = red[((wid + 0) * 16 + r) * 64 + lane] + red[((wid + 1) * 16 + r) * 64 + lane] + red[((wid + 2) * 16 + r) * 64 + lane] + red[((wid + 3) * 16 + r) * 64 + lane] + be;
                lg[(grp * 32 + crow(r, hk)) * 33 + e] = v; }
            asm volatile("s_waitcnt lgkmcnt(0)" ::: "memory"); SBAR();
            const int tk = lane & 31; float v[32];
#pragma unroll
            for (int e2 = 0; e2 < 32; ++e2) v[e2] = lg[(grp * 32 + tk) * 33 + e2];
            int ek[4]; float vk[4];
#pragma unroll
            for (int k = 0; k < 4; ++k) { float best = -__builtin_inff(); int bi = 0;
#pragma unroll
                for (int e2 = 0; e2 < 32; ++e2) if (v[e2] > best) { best = v[e2]; bi = e2; }
                ek[k] = bi; vk[k] = best;
#pragma unroll
                for (int e2 = 0; e2 < 32; ++e2) v[e2] = (e2 == bi) ? -__builtin_inff() : v[e2]; }
            float wk[4], sw = 0.f;
#pragma unroll
            for (int k = 0; k < 4; ++k) { wk[k] = __expf(vk[k] - vk[0]); sw += wk[k]; }
            const float rs = 1.0f / sw;
            const bool act = lane < 32; unsigned myc = 0u;
#pragma unroll 1
            for (int E = 0; E < 32; ++E) { unsigned c = 0u;
#pragma unroll
                for (int k = 0; k < 4; ++k) c += (unsigned)__popcll(__ballot(act && ek[k] == E));
                if (lane == E) myc = c; }
            unsigned run = 0u; if (lane < 32 && myc > 0u) run = atomicAdd(&cnt[lane], myc);
            int pk[4];
#pragma unroll
            for (int k = 0; k < 4; ++k) { pk[k] = 0;
#pragma unroll 1
                for (int E = 0; E < 32; ++E) { const unsigned long long mm = __ballot(act && ek[k] == E); const unsigned basev = (unsigned)__shfl((int)run, E);
                    if (act && ek[k] == E) pk[k] = (int)(basev + (unsigned)__popcll(mm & ((1ull << lane) - 1ull)));
                    if (lane == E) run += (unsigned)__popcll(mm); } }
            if (act) { const int tok = tok0 + grp * 32 + tk;
#pragma unroll
                for (int k = 0; k < 4; ++k) { tok_e[tok * 4 + k] = ek[k]; tok_pos[tok * 4 + k] = pk[k]; tok_w[tok * 4 + k] = wk[k] * rs; } }
        }
        __syncthreads();
    }
}
__device__ __forceinline__ void phase_moe_gather(const Frame& F0, int l) { const Frame F = fresh(F0);
    unsigned char* ws = F.ws; const int lane = F.lane;
    const unsigned* cnt = (const unsigned*)(ws + WS_CTL) + CW_CNT + l * 32; unsigned* meta = (unsigned*)(ws + WS_CTL) + CW_META + l * 512;
    unsigned* offs = (unsigned*)(F.lds + LDS_MISC + 64);
    if (F.tid == 0) { unsigned o = 0u; for (int e = 0; e < 32; ++e) { offs[e] = o; o += (cnt[e] + 255u) & ~255u; } offs[32] = o;
        if (F.bid == 0) { meta[0] = o >> 8; for (int e = 0; e < 32; ++e) for (unsigned t = offs[e] >> 8; t < (offs[e + 1] >> 8); ++t) meta[1 + t] = (unsigned)e; } }
    __syncthreads();
    const int* tok_e = (const int*)(ws + M_TOKE); const int* tok_pos = (const int*)(ws + M_TOKPOS); const float* tok_w = (const float*)(ws + M_TOKW);
    int* tok_dst = (int*)(ws + M_TOKDST); float* roww = (float*)(ws + M_ROWW);
    const bf16_t* x1b = (const bf16_t*)(ws + M_X1B); bf16_t* xs = (bf16_t*)(ws + M_XS);
    for (int it = F.bid * 8 + F.wid; it < NTOK * 4; it += F.G * 8) { const int tok = it >> 2;
        const int e = tok_e[it]; const unsigned dst = offs[e] + (unsigned)tok_pos[it];
        if (lane == 0) { tok_dst[it] = (int)dst; roww[dst] = tok_w[it]; }
        const u32x4* sp = (const u32x4*)(x1b + (size_t)tok * DM); u32x4* dp = (u32x4*)(xs + (size_t)dst * DM);
#pragma unroll
        for (int i = 0; i < 4; ++i) dp[i * 64 + lane] = sp[i * 64 + lane]; }
    __syncthreads();
}
__device__ __forceinline__ void phase_combine(const Frame& F0) { const Frame F = fresh(F0);
    unsigned char* ws = F.ws; const int lane = F.lane;
    const float* x1f = (const float*)(ws + M_X1F); const bf16_t* ys = (const bf16_t*)(ws + M_XS); const int* tok_dst = (const int*)(ws + M_TOKDST);
    float* hf = (float*)(ws + M_HF); bf16_t* hb = (bf16_t*)(ws + M_HB);
    for (int tok = F.bid * 8 + F.wid; tok < NTOK; tok += F.G * 8) {
        const int d0 = tok_dst[tok * 4], d1 = tok_dst[tok * 4 + 1], d2 = tok_dst[tok * 4 + 2], d3 = tok_dst[tok * 4 + 3];
#pragma unroll
        for (int i = 0; i < 4; ++i) { const int c = (i * 64 + lane) * 8; const size_t o = (size_t)tok * DM + c;
            f32x4 a = *(const f32x4*)(x1f + o) * ALPHA, b = *(const f32x4*)(x1f + o + 4) * ALPHA;
            const u32x4 y0 = *(const u32x4*)(ys + (size_t)d0 * DM + c), y1 = *(const u32x4*)(ys + (size_t)d1 * DM + c), y2 = *(const u32x4*)(ys + (size_t)d2 * DM + c), y3 = *(const u32x4*)(ys + (size_t)d3 * DM + c);
            a[0] += (bflo(y0.x) + bflo(y1.x)) + (bflo(y2.x) + bflo(y3.x)); a[1] += (bfhi(y0.x) + bfhi(y1.x)) + (bfhi(y2.x) + bfhi(y3.x));
            a[2] += (bflo(y0.y) + bflo(y1.y)) + (bflo(y2.y) + bflo(y3.y)); a[3] += (bfhi(y0.y) + bfhi(y1.y)) + (bfhi(y2.y) + bfhi(y3.y));
            b[0] += (bflo(y0.z) + bflo(y1.z)) + (bflo(y2.z) + bflo(y3.z)); b[1] += (bfhi(y0.z) + bfhi(y1.z)) + (bfhi(y2.z) + bfhi(y3.z));
            b[2] += (bflo(y0.w) + bflo(y1.w)) + (bflo(y2.w) + bflo(y3.w)); b[3] += (bfhi(y0.w) + bfhi(y1.w)) + (bfhi(y2.w) + bfhi(y3.w));
            *(f32x4*)(hf + o) = a; *(f32x4*)(hf + o + 4) = b; pg8::st_bf16x8(hb + o, a, b); } }
}
__device__ __forceinline__ void phase_ln2(const Frame& F0, const Params& P, int l) { const Frame F = fresh(F0);
    unsigned char* ws = F.ws; const float* pre2 = (const float*)(ws + M_X1F); bf16_t* xb = (bf16_t*)(ws + WS_XB);
    const float* g = F.in(23) + l * DM; const float* bt = F.in(24) + l * DM;
    for (int tok = F.bid * 8 + F.wid; tok < NTOK; tok += F.G * 8) ln_row(pre2 + (size_t)tok * DM, g, bt, F.out() + (size_t)tok * DM, xb + (size_t)tok * DM, F.lane);
}

constexpr int NPHASE = 1 + 15 * NLAYER;
#ifdef PH_ONLY
#define PEN(kind) ((kind) == PH_ONLY)
#else
#define PEN(kind) true
#endif
#define IN(k) (lo <= (k) && (k) < hi)
#define SEAM(k) do { if (IN((k) + 1)) xcd_barrier(bar); } while (0)

template <int l>
__device__ __forceinline__ void layer_phases(const Frame& F, const Params& P, const XcdBarrier& bar, const int lo, const int hi, unsigned char* ws0) {
    using namespace pg8;

        const int pb = 1 + 15 * l;
        const float* xres = (l == 0) ? F.in(0) : F.out();
        if (IN(pb + 0) && PEN(0)) { unsigned char* ws = ws0; asm volatile("" : "+s"(ws));
            SchedS S; S.init(NTOK, INWP, F.G, F.bid, (const bf16_t*)(ws + WS_XB), DM, (const bf16_t*)(ws + W_IN), DM);
            EpiInProj E{(bf16_t*)(ws + R_QA), (bf16_t*)(ws + R_QIDX), (bf16_t*)(ws + R_QKV), (bf16_t*)(ws + R_GATES), (float*)(ws + R_SMALL)};
            gemm_phase(F.ldsl, DM, DM, DM, S, E); SEAM(pb + 0); }
        if (IN(pb + 1) && PEN(1)) { unsigned char* ws = ws0; asm volatile("" : "+s"(ws));
            phase_prep(F, P, l);
            SchedS S; S.init(NTOK, 2048, F.G, F.bid, (const bf16_t*)(ws + R_QA), 1024, (const bf16_t*)(ws + W_UK2), 256, 1, 256);
            EpiBf16 E{(bf16_t*)(ws + R_QCAT), 2304, 288};
            gemm_phase(F.ldsl, 256, 1024, 256, S, E); SEAM(pb + 1); }
        if (IN(pb + 2) && PEN(2)) { unsigned char* ws = ws0; asm volatile("" : "+s"(ws)); phase_cumsum(F); phase_idx(F); SEAM(pb + 2); }
        if (IN(pb + 3) && PEN(3)) { unsigned char* ws = ws0; asm volatile("" : "+s"(ws)); phase_topk(F); SEAM(pb + 3); }
        if (IN(pb + 4) && PEN(4)) { unsigned char* ws = ws0; asm volatile("" : "+s"(ws)); phase_attn(F); SEAM(pb + 4); }
        if (IN(pb + 5) && PEN(5)) { unsigned char* ws = ws0; asm volatile("" : "+s"(ws));
            { SchedS S; S.init(NTOK, 1024, F.G, F.bid, (const bf16_t*)(ws + R_OLAT), 2048, (const bf16_t*)(ws + W_UV2), 512, 0, 512);
              EpiBf16 E{(bf16_t*)(ws + R_OA), 1024, 256}; gemm_phase(F.ldsl, 512, 2048, 512, S, E); }
            { SchedS S; S.init(NTOK, 2048, F.G, F.bid, (const bf16_t*)(ws + R_OB), 1024, (const bf16_t*)(ws + W_BRB), 1024);
              EpiBranch<0> E{(const bf16_t*)(ws + R_GATES), (float*)(ws + R_TMP), (bf16_t*)(ws + R_MERGED), 1}; gemm_phase(F.ldsl, 1024, 1024, 1024, S, E); }
            { SchedS S; S.init(NTOK, 2048, F.G, F.bid, (const bf16_t*)(ws + R_OC), 1024, (const bf16_t*)(ws + W_BRC), 1024);
              EpiBranch<1> E{(const bf16_t*)(ws + R_GATES), (float*)(ws + R_TMP), (bf16_t*)(ws + R_MERGED), 2}; gemm_phase(F.ldsl, 1024, 1024, 1024, S, E); }
            SEAM(pb + 5); }
        if (IN(pb + 6) && PEN(6)) { unsigned char* ws = ws0; asm volatile("" : "+s"(ws));
            SchedS S; S.init(NTOK, 2048, F.G, F.bid, (const bf16_t*)(ws + R_OA), 1024, (const bf16_t*)(ws + W_BRA), 1024);
            EpiBranch<2> E{(const bf16_t*)(ws + R_GATES), (float*)(ws + R_TMP), (bf16_t*)(ws + R_MERGED), 0}; gemm_phase(F.ldsl, 1024, 1024, 1024, S, E); SEAM(pb + 6); }
        if (IN(pb + 7) && PEN(7)) { unsigned char* ws = ws0; asm volatile("" : "+s"(ws));
            SchedS S; S.init(NTOK, 2048, F.G, F.bid, (const bf16_t*)(ws + R_MERGED), DM, (const bf16_t*)(ws + W_OUT), DM);
            EpiOut E{xres, (float*)(ws + R_PRE1)}; gemm_phase(F.ldsl, DM, DM, DM, S, E); SEAM(pb + 7); }
        if (IN(pb + 8) && PEN(8)) { unsigned char* ws = ws0; asm volatile("" : "+s"(ws)); phase_ln1_router(F, P, l); SEAM(pb + 8); }
        if (IN(pb + 9) && PEN(9)) { unsigned char* ws = ws0; asm volatile("" : "+s"(ws));
            phase_moe_gather(F, l);
            SchedS S; S.init(NTOK, 2048, F.G, F.bid, (const bf16_t*)(ws + WS_PB) + (size_t)l * NTOK * 256, 256, (const bf16_t*)(ws + W_PLE), 256);
            EpiBf16 E{(bf16_t*)(ws + M_PP), 2048, 256}; gemm_phase(F.ldsl, 256, 256, 256, S, E); SEAM(pb + 9); }
        if (IN(pb + 10) && PEN(10)) { unsigned char* ws = ws0; asm volatile("" : "+s"(ws));
            SchedM S; S.init((const unsigned*)(ws + WS_CTL) + CW_META + l * 512, F.G, F.bid, (const bf16_t*)(ws + M_XS), DM, (const bf16_t*)(ws + W_GU), DM);
            EpiGateUp E{F.in(16) + (size_t)l * NEXP * DEXP, F.in(18) + (size_t)l * NEXP * DEXP, (bf16_t*)(ws + M_HID)}; gemm_phase(F.ldsl, DM, DM, DM, S, E); SEAM(pb + 10); }
        if (IN(pb + 11) && PEN(11)) { unsigned char* ws = ws0; asm volatile("" : "+s"(ws));
            SchedM S; S.init((const unsigned*)(ws + WS_CTL) + CW_META + l * 512, F.G, F.bid, (const bf16_t*)(ws + M_HID), DEXP, (const bf16_t*)(ws + W_DN), DEXP);
            EpiDown E{F.in(20) + (size_t)l * NEXP * DM, (const float*)(ws + M_ROWW), (bf16_t*)(ws + M_XS)}; gemm_phase(F.ldsl, DEXP, DEXP, DEXP, S, E); SEAM(pb + 11); }
        if (IN(pb + 12) && PEN(12)) { unsigned char* ws = ws0; asm volatile("" : "+s"(ws)); phase_combine(F); SEAM(pb + 12); }
        if (IN(pb + 13) && PEN(13)) { unsigned char* ws = ws0; asm volatile("" : "+s"(ws));
            SchedS S; S.init(NTOK, 2048, F.G, F.bid, (const bf16_t*)(ws + M_HB), DM, (const bf16_t*)(ws + W_PG), DM);
            EpiPleGate E{(const float*)(ws + M_HF), (const bf16_t*)(ws + M_PP), (float*)(ws + M_X1F)}; gemm_phase(F.ldsl, DM, DM, DM, S, E); SEAM(pb + 13); }
        if (IN(pb + 14) && PEN(14)) { unsigned char* ws = ws0; asm volatile("" : "+s"(ws)); phase_ln2(F, P, l); if (l + 1 < NLAYER) convert_layer_weights(F, P, l + 1); SEAM(pb + 14); }
}
__global__ void __launch_bounds__(512, 2) fwd(Params P) {
    extern __shared__ __attribute__((aligned(16))) unsigned char lds[];
    Frame F; F.lds = lds; F.ldsl = (LAS unsigned char*)lds; F.ws = P.ws; F.tid = threadIdx.x; F.lane = F.tid & 63; F.wid = __builtin_amdgcn_readfirstlane(F.tid >> 6); F.G = gridDim.x; F.bid = blockIdx.x;
    unsigned char* ws0 = P.ws; unsigned char* ws = ws0;
    const bool fused = (P.ph_hi - P.ph_lo) > 1;
    if (F.tid < 4) ((LAS unsigned*)(F.ldsl + LDS_MISC))[F.tid] = 0u;
    if (F.tid == 0) { LAS unsigned long long* t = (LAS unsigned long long*)(F.ldsl + LDS_PTRS);
#pragma unroll
        for (int k = 0; k < 25; ++k) t[k] = (unsigned long long)P.in[k];
        t[25] = (unsigned long long)P.out; }
    __syncthreads();
    XcdBarrier bar; bar.bar = (unsigned*)(ws + WS_CTL) + CW_BAR; bar.x = 0; bar.st = (volatile LAS unsigned*)(F.ldsl + LDS_MISC);
    if (fused) bar = xcd_barrier_post((unsigned*)(ws + WS_CTL) + CW_BAR, (volatile LAS unsigned*)(F.ldsl + LDS_MISC));
    const int lo = P.ph_lo, hi = P.ph_hi;
    using namespace pg8;
    if (IN(0) && PEN(15)) { unsigned char* ws = ws0; asm volatile("" : "+s"(ws));
        conv_rows(F, F.in(0), (bf16_t*)(ws + WS_XB), (size_t)NTOK * DM / 8);
        conv_rows(F, F.in(1), (bf16_t*)(ws + WS_PB), (size_t)2 * NTOK * 256 / 8);
        convert_layer_weights(F, P, 0);
        SEAM(0);
    }
    layer_phases<0>(F, P, bar, lo, hi, ws0);
    layer_phases<1>(F, P, bar, lo, hi, ws0);
}

#ifdef DEBUG_NAN
constexpr int CW_FLAGS = 8192;
__global__ void dbg_scan_bf16(const unsigned short* p, size_t n, unsigned* flag) { unsigned c = 0; for (size_t i = (size_t)blockIdx.x * blockDim.x + threadIdx.x; i < n; i += (size_t)gridDim.x * blockDim.x) if ((p[i] & 0x7F80u) == 0x7F80u) ++c; if (c) atomicAdd(flag, c); }
__global__ void dbg_scan_f32(const unsigned* p, size_t n, unsigned* flag) { unsigned c = 0; for (size_t i = (size_t)blockIdx.x * blockDim.x + threadIdx.x; i < n; i += (size_t)gridDim.x * blockDim.x) if ((p[i] & 0x7F800000u) == 0x7F800000u) ++c; if (c) atomicAdd(flag, c); }
__global__ void dbg_scan_sel(const int* sel, const int* nsel, unsigned* flag) { unsigned c = 0; for (size_t i = (size_t)blockIdx.x * blockDim.x + threadIdx.x; i < (size_t)NTOK * 256; i += (size_t)gridDim.x * blockDim.x) { const int tok = (int)(i >> 8), j = (int)(i & 255), t = tok & (SEQ - 1); const int ns = nsel[tok]; if (j == 0 && ns != (t + 1 < 256 ? t + 1 : 256)) ++c; if (j < ns && (sel[i] < 0 || sel[i] > t)) ++c; } if (c) atomicAdd(flag, c); }
__global__ void dbg_scan_scores(const unsigned* p, unsigned* flag) { unsigned c = 0; for (size_t i = (size_t)blockIdx.x * blockDim.x + threadIdx.x; i < 2ull * SEQ * SEQ; i += (size_t)gridDim.x * blockDim.x) { const int s = (int)(i & (SEQ - 1)), t = (int)((i >> 13) & (SEQ - 1)); if (s <= t && (p[i] & 0x7F800000u) == 0x7F800000u) ++c; } if (c) atomicAdd(flag, c); }
__global__ void dbg_probe_bf16(const unsigned short* p, size_t n, unsigned* cnt, unsigned* minidx) { unsigned c = 0; unsigned mi = 0xFFFFFFFFu; for (size_t i = (size_t)blockIdx.x * blockDim.x + threadIdx.x; i < n; i += (size_t)gridDim.x * blockDim.x) if ((p[i] & 0x7F80u) == 0x7F80u) { ++c; if ((unsigned)i < mi) mi = (unsigned)i; } if (c) { atomicAdd(cnt, c); atomicMax(minidx, ~mi); } }
__global__ void dbg_final(float* out, size_t n, const unsigned* flags) { int code = 0; for (int k = 0; k < 32; ++k) if (flags[k] && !code) code = k + 1; const int mask = (flags[32] ? 1 : 0) | (flags[33] ? 2 : 0) | (flags[34] ? 4 : 0); if (mask) code = 20 + 5 * mask; if (!code) return; for (size_t i = (size_t)blockIdx.x * blockDim.x + threadIdx.x; i < n; i += (size_t)gridDim.x * blockDim.x) out[i] = (float)code; }
#endif
extern "C" void kernel_launch(void* const* d_in, const int* in_sizes, int n_in, void* d_out, int out_size, void* d_ws, size_t ws_size, hipStream_t stream) {
    static int grid = 0;
    if (grid == 0) {
        if (n_in != 25 || out_size != NTOK * DM || ws_size < WS_NEED) { fprintf(stderr, "kernel_launch: unexpected shapes (n_in %d out %d ws %zu need %zu)\n", n_in, out_size, ws_size, (size_t)WS_NEED); grid = -1; return; }
        int dev = 0, cus = 0, per_cu = 0;
        if (hipGetDevice(&dev) != hipSuccess || hipDeviceGetAttribute(&cus, hipDeviceAttributeMultiprocessorCount, dev) != hipSuccess) { grid = -1; return; }
        if (hipFuncSetAttribute((const void*)fwd, hipFuncAttributeMaxDynamicSharedMemorySize, LDS_BYTES) != hipSuccess) { fprintf(stderr, "kernel_launch: hipFuncSetAttribute failed\n"); grid = -1; return; }
        if (hipOccupancyMaxActiveBlocksPerMultiprocessor(&per_cu, (const void*)fwd, 512, LDS_BYTES) != hipSuccess || per_cu < 1) fprintf(stderr, "kernel_launch: occupancy query says %d\n", per_cu);
        (void)hipGetLastError();
        grid = cus;
    }
    if (grid < 0) return;
    unsigned char* ws = (unsigned char*)d_ws;
    hipMemsetAsync(ws + WS_CTL, 0, CTL_BYTES, stream);
    hipMemsetAsync(ws + W_UK2, 0, 8ull * 256 * 256 * 2 + 4ull * 256 * 512 * 2, stream);
    hipMemsetAsync(ws + W_IN + (size_t)INW * 2048 * 2, 0, (size_t)(INWP - INW) * 2048 * 2, stream);
    Params p{};
    for (int i = 0; i < 25; ++i) p.in[i] = (const float*)d_in[i];
    p.out = (float*)d_out; p.ws = ws;
#if PHASES_PER_LAUNCH == 0
    p.ph_lo = 0; p.ph_hi = NPHASE;
    hipLaunchKernelGGL(fwd, dim3(grid), dim3(512), LDS_BYTES, stream, p);
#else
    for (int k = 0; k < NPHASE; ++k) { p.ph_lo = k; p.ph_hi = k + 1; hipLaunchKernelGGL(fwd, dim3(grid), dim3(512), LDS_BYTES, stream, p);
#ifdef DEBUG_NAN
        unsigned* fl = (unsigned*)(ws + WS_CTL) + CW_FLAGS + k;
#define SB16(off, n) hipLaunchKernelGGL(dbg_scan_bf16, dim3(1024), dim3(256), 0, stream, (const unsigned short*)(ws + (off)), (size_t)(n), fl)
#define SF32(off, n) hipLaunchKernelGGL(dbg_scan_f32, dim3(1024), dim3(256), 0, stream, (const unsigned*)(ws + (off)), (size_t)(n), fl)
        if (k == 0) { SB16(WS_XB, (size_t)NTOK * DM); SB16(WS_PB, 2ull * NTOK * 256); SB16(WS_W, (W_END - WS_W) / 2); }
        else { const int kind = (k - 1) % 15;
            if (kind == 0) { SB16(R_QA, (size_t)NTOK * 1024); SB16(R_QIDX, (size_t)NTOK * 1024); SB16(R_QKV, 6ull * NTOK * 1024); SB16(R_GATES, (size_t)NTOK * 6144); SF32(R_SMALL, (size_t)NTOK * 512); }
            if (kind == 1) { SB16(R_QCAT, (size_t)NTOK * 2304); SB16(R_KCAT, (size_t)NTOK * 288); SB16(R_KI, (size_t)NTOK * 64); SB16(R_QIDX, (size_t)NTOK * 1024); SF32(R_WI, (size_t)NTOK * 16); SF32(WS_LF, 16ull * 8192); }
            if (kind == 2) { SF32(WS_CUM, 16ull * 8192); hipLaunchKernelGGL(dbg_scan_scores, dim3(1024), dim3(256), 0, stream, (const unsigned*)(ws + R_SCORES), fl); }
            if (kind == 3) { hipLaunchKernelGGL(dbg_scan_sel, dim3(1024), dim3(256), 0, stream, (const int*)(ws + R_SEL), (const int*)(ws + R_NSEL), fl); }
            if (k == 5) { unsigned* fl0 = fl; fl = (unsigned*)(ws + WS_CTL) + CW_FLAGS + 32; SB16(R_OLAT, (size_t)NTOK * 2048); fl += 1; SB16(R_OB, (size_t)NTOK * 1024); fl += 1; SB16(R_OC, (size_t)NTOK * 1024); fl = fl0; hipLaunchKernelGGL(dbg_probe_bf16, dim3(1024), dim3(256), 0, stream, (const unsigned short*)(ws + R_OC), (size_t)NTOK * 1024, (unsigned*)(ws + WS_CTL) + CW_FLAGS + 40, (unsigned*)(ws + WS_CTL) + CW_FLAGS + 41); }
            if (kind == 5) { SB16(R_OA, (size_t)NTOK * 1024); SF32(R_TMP, (size_t)NTOK * 2048); }
            if (kind == 6) { SB16(R_MERGED, (size_t)NTOK * 2048); }
            if (kind == 7) { SF32(R_PRE1, (size_t)NTOK * 2048); }
            if (kind == 8) { SF32(M_X1F, (size_t)NTOK * 2048); SF32(M_TOKW, (size_t)NTOK * 4); }
            if (kind == 9) { SB16(M_PP, (size_t)NTOK * 2048); }
            if (kind == 12) { SF32(M_HF, (size_t)NTOK * 2048); }
            if (kind == 13) { SF32(M_X1F, (size_t)NTOK * 2048); }
            if (kind == 14) { hipLaunchKernelGGL(dbg_scan_f32, dim3(1024), dim3(256), 0, stream, (const unsigned*)d_out, (size_t)NTOK * DM, fl); if (k + 1 < NPHASE) SB16(WS_W, (W_END - WS_W) / 2); } }
#endif
    }
#ifdef DEBUG_NAN
    hipLaunchKernelGGL(dbg_final, dim3(1024), dim3(256), 0, stream, (float*)d_out, (size_t)NTOK * DM, (const unsigned*)(ws + WS_CTL) + CW_FLAGS);
#endif
#endif
}
```

```cpp
#include <hip/hip_runtime.h>
#include <stdint.h>
#include <stdio.h>
#include <math.h>

#ifndef PHASES_PER_LAUNCH
#define PHASES_PER_LAUNCH 0
#endif

#define LAS __attribute__((address_space(3)))
typedef unsigned short bf16_t;
typedef short bf16x8 __attribute__((ext_vector_type(8)));
typedef short s16x4 __attribute__((ext_vector_type(4)));
typedef float f32x4 __attribute__((ext_vector_type(4)));
typedef float f32x16 __attribute__((ext_vector_type(16)));
typedef unsigned u32x4 __attribute__((ext_vector_type(4)));
typedef unsigned u32x2 __attribute__((ext_vector_type(2)));

constexpr int NTOK = 16384, DM = 2048, SEQ = 8192, NB = 2, NLAYER = 2;
constexpr int INW = 14712, INWP = 14848;
constexpr int NEXP = 32, DEXP = 1024;
constexpr int PMAX = 65536 + 8192;
constexpr float ALPHA = 1.41421356237309515f;
constexpr float LOG2E = 1.4426950408889634f;
constexpr float SCALE = 0.08838834764831845f;
constexpr float C2 = LOG2E * SCALE;

constexpr size_t MiB = 1ull << 20;
constexpr size_t WS_CTL   = 0;
constexpr size_t WS_W     = 1 * MiB;
constexpr size_t W_IN     = WS_W;
constexpr size_t W_UK2    = W_IN   + (size_t)INWP * 2048 * 2;
constexpr size_t W_UV2    = W_UK2  + 8ull * 256 * 256 * 2;
constexpr size_t W_BRA    = W_UV2  + 4ull * 256 * 512 * 2;
constexpr size_t W_BRB    = W_BRA  + 2048ull * 1024 * 2;
constexpr size_t W_BRC    = W_BRB  + 2048ull * 1024 * 2;
constexpr size_t W_OUT    = W_BRC  + 2048ull * 1024 * 2;
constexpr size_t W_PG     = W_OUT  + 2048ull * 2048 * 2;
constexpr size_t W_PLE    = W_PG   + 2048ull * 2048 * 2;
constexpr size_t W_GU     = W_PLE  + 2048ull * 256 * 2;
constexpr size_t W_DN     = W_GU   + 32ull * 2048 * 2048 * 2;
constexpr size_t W_END    = W_DN   + 32ull * 2048 * 1024 * 2;
constexpr size_t WS_XB    = (W_END + MiB - 1) / MiB * MiB;
constexpr size_t WS_PB    = WS_XB  + (size_t)NTOK * DM * 2;
constexpr size_t WS_CUM   = WS_PB  + 2ull * NTOK * 256 * 2;
constexpr size_t WS_LF    = WS_CUM + 16ull * 8192 * 4;
constexpr size_t WS_R     = WS_LF  + 16ull * 8192 * 4;
constexpr size_t R_SCORES = WS_R;
constexpr size_t R_OLAT   = WS_R;
constexpr size_t R_OA     = WS_R + 64 * MiB;
constexpr size_t R_OB     = WS_R + 96 * MiB;
constexpr size_t R_OC     = WS_R + 128 * MiB;
constexpr size_t R_TMP    = WS_R + 160 * MiB;
constexpr size_t R_MERGED = WS_R + 288 * MiB;
constexpr size_t R_PRE1   = WS_R + 384 * MiB;
constexpr size_t R_QA     = WS_R + 512 * MiB;
constexpr size_t R_QIDX   = WS_R + 544 * MiB;
constexpr size_t R_QKV    = WS_R + 576 * MiB;
constexpr size_t R_GATES  = WS_R + 768 * MiB;
constexpr size_t R_SMALL  = WS_R + 960 * MiB;
constexpr size_t R_QCAT   = WS_R + 992 * MiB;
constexpr size_t R_KCAT   = WS_R + 1064 * MiB;
constexpr size_t R_KI     = WS_R + 1073 * MiB;
constexpr size_t R_WI     = WS_R + 1075 * MiB;
constexpr size_t R_SEL    = WS_R + 1076 * MiB;
constexpr size_t R_NSEL   = WS_R + 1092 * MiB;
constexpr size_t R_END    = WS_R + 1093 * MiB;
constexpr size_t M_XS     = WS_R;
constexpr size_t M_HID    = WS_R + 288 * MiB;
constexpr size_t M_PP     = WS_R + 432 * MiB;
constexpr size_t M_X1F    = WS_R + 512 * MiB;
constexpr size_t M_X1B    = WS_R + 640 * MiB;
constexpr size_t M_HF     = WS_R + 704 * MiB;
constexpr size_t M_HB     = WS_R + 832 * MiB;
constexpr size_t M_TOKE   = WS_R + 896 * MiB;
constexpr size_t M_TOKPOS = M_TOKE + (size_t)NTOK * 16;
constexpr size_t M_TOKW   = M_TOKPOS + (size_t)NTOK * 16;
constexpr size_t M_TOKDST = M_TOKW + (size_t)NTOK * 16;
constexpr size_t M_ROWW   = M_TOKDST + (size_t)NTOK * 16;
constexpr size_t WS_NEED  = R_END;
constexpr int CW_BAR = 0;
constexpr int CW_CNT = 4096;
constexpr int CW_META = 4096 + 64;
constexpr size_t CTL_BYTES = 65536;

constexpr int LDS_BYTES = 152576;
constexpr int LDS_MISC = 151552;

typedef float f32x2 __attribute__((ext_vector_type(2)));
typedef __bf16 bf16n2 __attribute__((ext_vector_type(2)));
__device__ __forceinline__ unsigned cvtpk(float lo, float hi) { f32x2 v = {lo, hi}; bf16n2 b = __builtin_convertvector(v, bf16n2); return __builtin_bit_cast(unsigned, b); }
__device__ __forceinline__ bf16_t f2bf(float x) { return (bf16_t)(cvtpk(x, 0.f) & 0xffffu); }
__device__ __forceinline__ float bf2f(bf16_t b) { return __uint_as_float(((unsigned)b) << 16); }
__device__ __forceinline__ float bflo(unsigned w) { return __uint_as_float(w << 16); }
__device__ __forceinline__ float bfhi(unsigned w) { return __uint_as_float(w & 0xffff0000u); }
__device__ __forceinline__ bf16x8 pack8(f32x4 a, f32x4 b) { u32x4 w = {cvtpk(a[0], a[1]), cvtpk(a[2], a[3]), cvtpk(b[0], b[1]), cvtpk(b[2], b[3])}; return *reinterpret_cast<bf16x8*>(&w); }
__device__ __forceinline__ float sigmoidf_(float x) { return 1.0f / (1.0f + __expf(-x)); }
__device__ __forceinline__ float wave_sum(float v) { for (int o = 32; o > 0; o >>= 1) v += __shfl_xor(v, o); return v; }
__device__ __forceinline__ int crow(int r, int hi) { return (r & 3) + 8 * (r >> 2) + 4 * hi; }
#define SBAR() __builtin_amdgcn_sched_barrier(0)

#define XB_TMO      128
#define XB_XCNT(j)  (256  + 64 * (j))
#define XB_XSUB(j)  (1280 + 64 * (j))
#define XB_XGEN(j)  (2304 + 64 * (j))
#define XB_TOP      3328
#define XB_TOPGEN   3392
#define XCD_BAR_WORDS 3456
#define XB_SPIN_CAP (1u << 22)
__device__ __forceinline__ unsigned xb_ld(unsigned* p)              { return __hip_atomic_load(p, __ATOMIC_RELAXED, __HIP_MEMORY_SCOPE_AGENT); }
__device__ __forceinline__ unsigned xb_add(unsigned* p, unsigned v) { return __hip_atomic_fetch_add(p, v, __ATOMIC_RELAXED, __HIP_MEMORY_SCOPE_AGENT); }
__device__ __forceinline__ unsigned xb_xcc_id() { return (unsigned)__builtin_amdgcn_s_getreg((3 << 11) | 20) & 0xFu; }
#define XB_SPIN(cond, bar) do { unsigned _sp = 0; while (cond) { __builtin_amdgcn_s_sleep(1); \
    if ((++_sp & 255u) == 0u) { if (xb_ld(&(bar)[XB_TMO])) break; if (_sp > XB_SPIN_CAP) { atomicAdd(&(bar)[XB_TMO], 1u); break; } } } } while (0)
struct XcdBarrier { unsigned* bar; unsigned x; volatile LAS unsigned* st; };
__device__ __forceinline__ XcdBarrier xcd_barrier_post(unsigned* bar, volatile LAS unsigned* st) {
    XcdBarrier b; b.bar = bar; b.x = xb_xcc_id(); b.st = st;
    if (threadIdx.x == 0) (void)xb_add(&bar[XB_XCNT(b.x)], 1u);
    return b;
}
__device__ __forceinline__ void xcd_barrier_complete(unsigned* bar, unsigned x, unsigned& nloc, unsigned& nx) {
    const unsigned G = gridDim.x * gridDim.y * gridDim.z;
    unsigned sum, cnt, mine, sp = 0u;
    for (;;) {
        sum = 0u; cnt = 0u; mine = 0u;
#pragma unroll
        for (unsigned j = 0; j < 16; ++j) { const unsigned c = xb_ld(&bar[XB_XCNT(j)]); sum += c; cnt += (c > 0u) ? 1u : 0u; mine = (j == x) ? c : mine; }
        if (sum == G) break;
        __builtin_amdgcn_s_sleep(1);
        if ((++sp & 255u) == 0u) { if (xb_ld(&bar[XB_TMO])) break; if (sp > XB_SPIN_CAP) { atomicAdd(&bar[XB_TMO], 1u); break; } }
    }
    nloc = mine > 0u ? mine : 1u; nx = cnt > 0u ? cnt : 1u;
}
__device__ __forceinline__ void xcd_barrier(const XcdBarrier& b) {
    asm volatile("s_waitcnt vmcnt(0)" ::: "memory");
    __syncthreads();
    if (threadIdx.x == 0) {
        unsigned* bar = b.bar;
        __builtin_amdgcn_s_waitcnt(0);
        unsigned nloc = b.st[0], nx = b.st[1];
        if (nloc == 0u) { xcd_barrier_complete(bar, b.x, nloc, nx); b.st[0] = nloc; b.st[1] = nx; }
        const unsigned old = xb_add(&bar[XB_XSUB(b.x)], 1u);
        const unsigned gen = old / nloc;
        if (old + 1u == (gen + 1u) * nloc) {
            __builtin_amdgcn_fence(__ATOMIC_RELEASE, "agent");
            asm volatile("s_waitcnt vmcnt(0)" ::: "memory");
            const unsigned og = xb_add(&bar[XB_TOP], 1u);
            const unsigned tg = og / nx;
            if (og + 1u == (tg + 1u) * nx) xb_add(&bar[XB_TOPGEN], 1u);
            else XB_SPIN(xb_ld(&bar[XB_TOPGEN]) == tg, bar);
            __builtin_amdgcn_fence(__ATOMIC_ACQUIRE, "agent");
            xb_add(&bar[XB_XGEN(b.x)], 1u);
            asm volatile("s_waitcnt vmcnt(0)" ::: "memory");
        } else {
            XB_SPIN(xb_ld(&bar[XB_XGEN(b.x)]) == gen, bar);
            __builtin_amdgcn_fence(__ATOMIC_ACQUIRE, "agent");
            asm volatile("s_waitcnt vmcnt(0)" ::: "memory");
        }
    }
    __syncthreads();
}

namespace pg8 {
constexpr int BM = 256, BK = 64, HALF = 128, HTB = HALF * BK * 2, STAGE_BYTES = 8 * HTB, NXCD = 8, WGM = 8;
__device__ __forceinline__ int lds_byte(int r, int c) { const int st = (r >> 4) * 2 + (c >> 5), rr = r & 15, cc = c & 31, ob = rr * 64 + cc * 2; return st * 1024 + (ob ^ (((ob >> 9) & 1) << 5)); }
__device__ __forceinline__ void stage_rc(int b, int& R, int& C) { const int st = b / 1024, sb = b % 1024, swz = sb ^ (((sb >> 9) & 1) << 5); R = (st >> 1) * 16 + swz / 64; C = (st & 1) * 32 + (swz % 64) / 2; }
__device__ __forceinline__ int perm32(int rho) { const int n = rho >> 4, i = rho & 15; return 8 * (i >> 2) + 4 * n + (i & 3); }
struct Unit { int pm, pn, e; };
struct SchedS {
    int nM, nN, nwg, G, c; const bf16_t* A; const bf16_t* B; int lda, ldb, a_sh, a_mul;
    __device__ void init(int M, int N, int G_, int c_, const bf16_t* A_, int lda_, const bf16_t* B_, int ldb_, int a_sh_ = 0, int a_mul_ = 0) {
        nM = M / BM; nN = N / BM; nwg = nM * nN; G = G_; c = c_; A = A_; B = B_; lda = lda_; ldb = ldb_; a_sh = a_sh_; a_mul = a_mul_; }
    __device__ __forceinline__ bool next(int i, Unit& u) const {
        const long L = (long)i * G + c; if (L >= nwg) return false;
        int wgid = (int)L; { const int q = nwg / NXCD, r = nwg % NXCD, xcd = wgid % NXCD, off = wgid / NXCD; wgid = (xcd < r ? xcd * (q + 1) : r * (q + 1) + (xcd - r) * q) + off; }
        const int nig = WGM * nN, gid = wgid / nig, fm = gid * WGM, gsz = (nM - fm) < WGM ? (nM - fm) : WGM;
        u.pm = fm + ((wgid % nig) % gsz); u.pn = (wgid % nig) / gsz; u.e = 0;
        return true;
    }
    __device__ __forceinline__ const char* pa(const Unit& u) const { return (const char*)(A + (size_t)u.pm * BM * lda + (size_t)((u.pn >> a_sh) * a_mul)); }
    __device__ __forceinline__ const char* pb(const Unit& u) const { return (const char*)(B + (size_t)u.pn * BM * ldb); }
};
struct SchedM {
    int ntiles, G, c; const bf16_t* A; const bf16_t* W; int lda, ldb; const unsigned* tile_e;
    __device__ void init(const unsigned* meta, int G_, int c_, const bf16_t* A_, int lda_, const bf16_t* W_, int ldb_) {
        ntiles = (int)meta[0]; tile_e = meta + 1; G = G_; c = c_; A = A_; W = W_; lda = lda_; ldb = ldb_; }
    __device__ __forceinline__ bool next(int i, Unit& u) const {
        const long L = (long)i * G + c; if (L >= (long)ntiles * 8) return false;
        u.pm = (int)(L >> 3); u.pn = (int)(L & 7); u.e = (int)tile_e[u.pm];
        return true;
    }
    __device__ __forceinline__ const char* pa(const Unit& u) const { return (const char*)(A + (size_t)u.pm * BM * lda); }
    __device__ __forceinline__ const char* pb(const Unit& u) const { return (const char*)(W + ((size_t)u.e * 2048 + (size_t)u.pn * BM) * ldb); }
};

template <class Epi, class Sched>
__device__ __forceinline__ void gemm_phase(LAS unsigned char* lds, const int K, const int lda, const int ldb, const Sched& S, const Epi& E) {
    int tid = threadIdx.x; asm volatile("" : "+v"(tid));
    const int wid = __builtin_amdgcn_readfirstlane(tid >> 6), lane = tid & 63, wr = wid >> 2, wc = wid & 3, fr = lane & 15, fq = lane >> 4;
    const int nt = K / BK;
    unsigned voffA[2], voffB[2];
#pragma unroll
    for (int i = 0; i < 2; ++i) { int R, C; stage_rc(tid * 16 + i * 8192, R, C); const int Rb = (R & ~31) + perm32(R & 31);
        voffA[i] = (unsigned)(R * lda + C) * 2u; voffB[i] = (unsigned)(Rb * ldb + C) * 2u; }
    const size_t kstep = (size_t)(BK * 2);
    const size_t hstepA = (size_t)HALF * lda * 2, hstepB = (size_t)HALF * ldb * 2;
    const unsigned ldsw = (unsigned)wid * 1024u;
    const int aoff = lds_byte(wr * 64 + fr, fq * 8), boff = lds_byte(wc * 32 + fr, fq * 8);
#define PG8_SA(b, h) (((b) * 2 + (h)) * HTB)
#define PG8_SB(b, h) ((4 + (b) * 2 + (h)) * HTB)
#define PG8_STAGE(bufoff, gbase, voff) do { _Pragma("unroll") for (int _i = 0; _i < 2; ++_i) \
        __builtin_amdgcn_global_load_lds((const unsigned*)((const char*)(gbase) + (voff)[_i]), (LAS unsigned*)(lds + (bufoff) + ldsw + _i * 8192), 16, 0, 0); } while (0)
#define PG8_LDA(dst, b, h) do { _Pragma("unroll") for (int m = 0; m < 4; ++m) _Pragma("unroll") for (int k = 0; k < 2; ++k) dst[m][k] = *(const LAS bf16x8*)(lds + PG8_SA(b, h) + aoff + m * 2048 + k * 1024); } while (0)
#define PG8_LDB(dst, b, h) do { _Pragma("unroll") for (int n = 0; n < 2; ++n) _Pragma("unroll") for (int k = 0; k < 2; ++k) dst[n][k] = *(const LAS bf16x8*)(lds + PG8_SB(b, h) + boff + n * 2048 + k * 1024); } while (0)
#define PG8_MMA(ai, bj, At, Bt) do { __builtin_amdgcn_s_setprio(1); _Pragma("unroll") for (int m = 0; m < 4; ++m) _Pragma("unroll") for (int n = 0; n < 2; ++n) _Pragma("unroll") for (int k = 0; k < 2; ++k) \
        acc[ai][bj][m][n] = __builtin_amdgcn_mfma_f32_16x16x32_bf16(Bt[n][k], At[m][k], acc[ai][bj][m][n], 0, 0, 0); __builtin_amdgcn_s_setprio(0); } while (0)
#define PG8_WAIT_V(n) asm volatile("s_waitcnt vmcnt(" #n ")" ::: "memory")
#define PG8_WAIT_L(n) asm volatile("s_waitcnt lgkmcnt(" #n ")" ::: "memory")
#define PG8_BAR __builtin_amdgcn_s_barrier()
#define PG8_SCHED __builtin_amdgcn_sched_barrier(0)
    Unit cur, nxt; int ui = 0;
    if (!S.next(0, cur)) return;
    f32x4 acc[2][2][4][2];
#pragma unroll
    for (int a = 0; a < 2; ++a)
#pragma unroll
        for (int b = 0; b < 2; ++b)
#pragma unroll
            for (int m = 0; m < 4; ++m)
#pragma unroll
                for (int n = 0; n < 2; ++n) acc[a][b][m][n] = (f32x4){0.f, 0.f, 0.f, 0.f};
    bf16x8 At[4][2], B0[2][2], B1[2][2];
    const char* cA = S.pa(cur); const char* cB = S.pb(cur);
    PG8_STAGE(PG8_SB(0, 0), cB, voffB); PG8_STAGE(PG8_SA(0, 0), cA, voffA); PG8_STAGE(PG8_SB(0, 1), cB + hstepB, voffB); PG8_STAGE(PG8_SA(0, 1), cA + hstepA, voffA);
    if (wr == 1) PG8_BAR;
    PG8_WAIT_V(4); PG8_BAR;
    PG8_STAGE(PG8_SB(1, 0), cB + kstep, voffB); PG8_STAGE(PG8_SA(1, 0), cA + kstep, voffA); PG8_STAGE(PG8_SB(1, 1), cB + hstepB + kstep, voffB);
    PG8_WAIT_V(6); PG8_BAR;
    for (;;) {
        const bool has_next = S.next(ui + 1, nxt);
        const char* nA = has_next ? S.pa(nxt) : cA; const char* nB = has_next ? S.pb(nxt) : cB;
        for (int t = 0; t < nt; t += 2) {
            const bool last = (t == nt - 2);
            const char* a1 = cA + (size_t)(t + 1) * kstep;
            const char* a2 = last ? nA : cA + (size_t)(t + 2) * kstep; const char* b2 = last ? nB : cB + (size_t)(t + 2) * kstep;
            const char* a3 = a2 + kstep; const char* b3 = b2 + kstep;
            PG8_LDB(B0, 0, 0); PG8_SCHED; PG8_LDA(At, 0, 0); PG8_STAGE(PG8_SA(1, 1), a1 + hstepA, voffA);
            PG8_WAIT_L(8); PG8_BAR; PG8_WAIT_L(0); PG8_MMA(0, 0, At, B0); PG8_BAR; PG8_SCHED;
            PG8_LDB(B1, 0, 1); PG8_STAGE(PG8_SB(0, 0), b2, voffB);
            PG8_BAR; PG8_WAIT_L(0); PG8_MMA(0, 1, At, B1); PG8_BAR;
            PG8_LDA(At, 0, 1); PG8_STAGE(PG8_SA(0, 0), a2, voffA);
            PG8_BAR; PG8_WAIT_L(0); PG8_MMA(1, 0, At, B0); PG8_BAR; PG8_SCHED;
            PG8_STAGE(PG8_SB(0, 1), b2 + hstepB, voffB);
            PG8_WAIT_V(6); PG8_BAR; PG8_MMA(1, 1, At, B1); PG8_BAR;
            PG8_LDB(B0, 1, 0); PG8_SCHED; PG8_LDA(At, 1, 0); PG8_STAGE(PG8_SA(0, 1), a2 + hstepA, voffA);
            PG8_WAIT_L(8); PG8_BAR; PG8_WAIT_L(0); PG8_MMA(0, 0, At, B0); PG8_BAR; PG8_SCHED;
            PG8_LDB(B1, 1, 1); PG8_STAGE(PG8_SB(1, 0), b3, voffB);
            PG8_BAR; PG8_WAIT_L(0); PG8_MMA(0, 1, At, B1); PG8_BAR;
            PG8_LDA(At, 1, 1); PG8_STAGE(PG8_SA(1, 0), a3, voffA);
            PG8_BAR; PG8_WAIT_L(0); PG8_MMA(1, 0, At, B0); PG8_BAR; PG8_SCHED;
            PG8_STAGE(PG8_SB(1, 1), b3 + hstepB, voffB);
            PG8_WAIT_V(6); PG8_BAR; PG8_MMA(1, 1, At, B1); PG8_BAR;
        }
        { int frE = fr, fqE = fq; asm volatile("" : "+v"(frE), "+v"(fqE)); E(acc, cur, wr, wc, frE, fqE); }
        if (!has_next) break;
#pragma unroll
        for (int a = 0; a < 2; ++a)
#pragma unroll
            for (int b = 0; b < 2; ++b)
#pragma unroll
                for (int m = 0; m < 4; ++m)
#pragma unroll
                    for (int n = 0; n < 2; ++n) acc[a][b][m][n] = (f32x4){0.f, 0.f, 0.f, 0.f};
        cur = nxt; cA = nA; cB = nB; ++ui;
    }
    PG8_WAIT_V(0);
    if (wr == 0) PG8_BAR;
    PG8_BAR;
#undef PG8_SA
#undef PG8_SB
#undef PG8_STAGE
#undef PG8_LDA
#undef PG8_LDB
#undef PG8_MMA
#undef PG8_WAIT_V
#undef PG8_WAIT_L
#undef PG8_BAR
#undef PG8_SCHED
}

#define EPI_LOOP_ROWS _Pragma("unroll") for (int ai = 0; ai < 2; ++ai) _Pragma("unroll") for (int m = 0; m < 4; ++m)
__device__ __forceinline__ void st_bf16x8(bf16_t* p, f32x4 v0, f32x4 v1) { u32x4 w; w.x = cvtpk(v0[0], v0[1]); w.y = cvtpk(v0[2], v0[3]); w.z = cvtpk(v1[0], v1[1]); w.w = cvtpk(v1[2], v1[3]); *(u32x4*)p = w; }

struct EpiInProj {
    bf16_t* qa; bf16_t* qidx; bf16_t* qkv; bf16_t* gates; float* small_;
    __device__ __forceinline__ void operator()(const f32x4 (&acc)[2][2][4][2], const Unit& u, int wr, int wc, int fr, int fq) const {
        const int pn = u.pn, row0 = u.pm * BM + wr * 64 + fr, lc0 = wc * 32 + fq * 8;
        if (pn < 8) {
            bf16_t* base = (pn < 4 ? qa + pn * 256 : qidx + (pn - 4) * 256) + lc0;
            EPI_LOOP_ROWS { const int row = row0 + ai * HALF + m * 16;
#pragma unroll
                for (int bj = 0; bj < 2; ++bj) st_bf16x8(base + (size_t)row * 1024 + bj * HALF, acc[ai][bj][m][0], acc[ai][bj][m][1]); }
        } else if (pn < 32) {
            const int id = (pn - 8) >> 2, hb = ((pn - 8) & 3) * 2, b = u.pm >> 5;
            bf16_t* base = qkv + (size_t)id * ((size_t)NTOK * 1024) + lc0;
            EPI_LOOP_ROWS { const int row = row0 + ai * HALF + m * 16, s = row & (SEQ - 1);
#pragma unroll
                for (int bj = 0; bj < 2; ++bj) st_bf16x8(base + ((size_t)(b * 8 + hb + bj) * SEQ + s) * 128, acc[ai][bj][m][0], acc[ai][bj][m][1]); }
        } else if (pn < 56) {
            bf16_t* base = gates + (pn - 32) * 256 + lc0;
            EPI_LOOP_ROWS { const int row = row0 + ai * HALF + m * 16;
#pragma unroll
                for (int bj = 0; bj < 2; ++bj) st_bf16x8(base + (size_t)row * 6144 + bj * HALF, acc[ai][bj][m][0], acc[ai][bj][m][1]); }
        } else {
            float* base = small_ + (pn - 56) * 256 + lc0;
            EPI_LOOP_ROWS { const int row = row0 + ai * HALF + m * 16;
#pragma unroll
                for (int bj = 0; bj < 2; ++bj) { float* p = base + (size_t)row * 512 + bj * HALF; *(f32x4*)p = acc[ai][bj][m][0]; *(f32x4*)(p + 4) = acc[ai][bj][m][1]; } }
        }
    }
};
struct EpiBf16 {
    bf16_t* out; int ld, cstep;
    __device__ __forceinline__ void operator()(const f32x4 (&acc)[2][2][4][2], const Unit& u, int wr, int wc, int fr, int fq) const {
        const int row0 = u.pm * BM + wr * 64 + fr; bf16_t* base = out + (size_t)u.pn * cstep + wc * 32 + fq * 8;
        EPI_LOOP_ROWS { const int row = row0 + ai * HALF + m * 16;
#pragma unroll
            for (int bj = 0; bj < 2; ++bj) st_bf16x8(base + (size_t)row * ld + bj * HALF, acc[ai][bj][m][0], acc[ai][bj][m][1]); }
    }
};
template <int MODE> struct EpiBranch {
    const bf16_t* gates; float* tmp; bf16_t* merged; int br;
    __device__ __forceinline__ void operator()(const f32x4 (&acc)[2][2][4][2], const Unit& u, int wr, int wc, int fr, int fq) const {
        const int row0 = u.pm * BM + wr * 64 + fr, col0 = u.pn * BM + wc * 32 + fq * 8;
        EPI_LOOP_ROWS { const int row = row0 + ai * HALF + m * 16;
#pragma unroll
            for (int bj = 0; bj < 2; ++bj) { const int col = col0 + bj * HALF;
                const u32x4 gw = *(const u32x4*)(gates + (size_t)row * 6144 + br * 2048 + col);
                f32x4 v0 = acc[ai][bj][m][0], v1 = acc[ai][bj][m][1];
                v0[0] *= sigmoidf_(bflo(gw.x)); v0[1] *= sigmoidf_(bfhi(gw.x)); v0[2] *= sigmoidf_(bflo(gw.y)); v0[3] *= sigmoidf_(bfhi(gw.y));
                v1[0] *= sigmoidf_(bflo(gw.z)); v1[1] *= sigmoidf_(bfhi(gw.z)); v1[2] *= sigmoidf_(bflo(gw.w)); v1[3] *= sigmoidf_(bfhi(gw.w));
                float* tp = tmp + (size_t)row * 2048 + col;
                if (MODE >= 1) { v0 += *(const f32x4*)tp; v1 += *(const f32x4*)(tp + 4); }
                if (MODE <= 1) { *(f32x4*)tp = v0; *(f32x4*)(tp + 4) = v1; }
                else st_bf16x8(merged + (size_t)row * 2048 + col, v0, v1); } }
    }
};
struct EpiOut {
    const float* res; float* pre;
    __device__ __forceinline__ void operator()(const f32x4 (&acc)[2][2][4][2], const Unit& u, int wr, int wc, int fr, int fq) const {
        const int row0 = u.pm * BM + wr * 64 + fr, col0 = u.pn * BM + wc * 32 + fq * 8;
        EPI_LOOP_ROWS { const int row = row0 + ai * HALF + m * 16;
#pragma unroll
            for (int bj = 0; bj < 2; ++bj) { const size_t o = (size_t)row * 2048 + col0 + bj * HALF;
                const f32x4 r0 = *(const f32x4*)(res + o), r1 = *(const f32x4*)(res + o + 4);
                *(f32x4*)(pre + o) = r0 * ALPHA + acc[ai][bj][m][0]; *(f32x4*)(pre + o + 4) = r1 * ALPHA + acc[ai][bj][m][1]; } }
    }
};
struct EpiGateUp {
    const float* bg; const float* bu; bf16_t* hid;
    __device__ __forceinline__ void operator()(const f32x4 (&acc)[2][2][4][2], const Unit& u, int wr, int wc, int fr, int fq) const {
        const int row0 = u.pm * BM + wr * 64 + fr, j0 = u.pn * 128 + wc * 32 + fq * 8;
        const float* pg = bg + (size_t)u.e * DEXP + j0; const float* pu = bu + (size_t)u.e * DEXP + j0;
        const f32x4 g0b = *(const f32x4*)pg, g1b = *(const f32x4*)(pg + 4), u0b = *(const f32x4*)pu, u1b = *(const f32x4*)(pu + 4);
        EPI_LOOP_ROWS { const int row = row0 + ai * HALF + m * 16;
            f32x4 h0, h1;
#pragma unroll
            for (int j = 0; j < 4; ++j) {
                float g = fminf(acc[ai][0][m][0][j] + g0b[j], 7.0f), uu = fminf(fmaxf(acc[ai][1][m][0][j] + u0b[j], -7.0f), 7.0f);
                h0[j] = (uu + 1.0f) * (g * sigmoidf_(1.702f * g));
                g = fminf(acc[ai][0][m][1][j] + g1b[j], 7.0f); uu = fminf(fmaxf(acc[ai][1][m][1][j] + u1b[j], -7.0f), 7.0f);
                h1[j] = (uu + 1.0f) * (g * sigmoidf_(1.702f * g)); }
            st_bf16x8(hid + (size_t)row * DEXP + j0, h0, h1); }
    }
};
struct EpiDown {
    const float* bd; const float* roww; bf16_t* ys;
    __device__ __forceinline__ void operator()(const f32x4 (&acc)[2][2][4][2], const Unit& u, int wr, int wc, int fr, int fq) const {
        const int row0 = u.pm * BM + wr * 64 + fr, col0 = u.pn * BM + wc * 32 + fq * 8;
        f32x4 b[2][2];
#pragma unroll
        for (int bj = 0; bj < 2; ++bj) { const float* p = bd + (size_t)u.e * DM + col0 + bj * HALF; b[bj][0] = *(const f32x4*)p; b[bj][1] = *(const f32x4*)(p + 4); }
        EPI_LOOP_ROWS { const int row = row0 + ai * HALF + m * 16; const float w = roww[row];
#pragma unroll
            for (int bj = 0; bj < 2; ++bj) st_bf16x8(ys + (size_t)row * 2048 + col0 + bj * HALF, (acc[ai][bj][m][0] + b[bj][0]) * w, (acc[ai][bj][m][1] + b[bj][1]) * w); }
    }
};
struct EpiPleGate {
    const float* hf; const bf16_t* pp; float* pre;
    __device__ __forceinline__ void operator()(const f32x4 (&acc)[2][2][4][2], const Unit& u, int wr, int wc, int fr, int fq) const {
        const int row0 = u.pm * BM + wr * 64 + fr, col0 = u.pn * BM + wc * 32 + fq * 8;
        EPI_LOOP_ROWS { const int row = row0 + ai * HALF + m * 16;
#pragma unroll
            for (int bj = 0; bj < 2; ++bj) { const size_t o = (size_t)row * 2048 + col0 + bj * HALF;
                const u32x4 pw = *(const u32x4*)(pp + o); const f32x4 h0 = *(const f32x4*)(hf + o), h1 = *(const f32x4*)(hf + o + 4);
                const f32x4 a0 = acc[ai][bj][m][0], a1 = acc[ai][bj][m][1]; f32x4 o0, o1;
                o0[0] = h0[0] + sigmoidf_(a0[0]) * bflo(pw.x); o0[1] = h0[1] + sigmoidf_(a0[1]) * bfhi(pw.x); o0[2] = h0[2] + sigmoidf_(a0[2]) * bflo(pw.y); o0[3] = h0[3] + sigmoidf_(a0[3]) * bfhi(pw.y);
                o1[0] = h1[0] + sigmoidf_(a1[0]) * bflo(pw.z); o1[1] = h1[1] + sigmoidf_(a1[1]) * bfhi(pw.z); o1[2] = h1[2] + sigmoidf_(a1[2]) * bflo(pw.w); o1[3] = h1[3] + sigmoidf_(a1[3]) * bfhi(pw.w);
                *(f32x4*)(pre + o) = o0; *(f32x4*)(pre + o + 4) = o1; } }
    }
};
}

struct Params { const float* in[25]; float* out; unsigned char* ws; int ph_lo, ph_hi; };
__constant__ float c_invf_r[16] = {1.000000000e+00f, 4.403665960e-01f, 1.939227432e-01f, 8.539710194e-02f, 3.760603070e-02f, 1.656043902e-02f, 7.292664610e-03f, 3.211445874e-03f, 1.414213562e-03f, 6.227723788e-04f, 2.742481884e-04f, 1.207697351e-04f, 5.318296098e-05f, 2.341999971e-05f, 1.031338616e-05f, 4.541670478e-06f};
__constant__ float c_invf_i[8] = {1.000000000e+00f, 1.939227432e-01f, 3.760603070e-02f, 7.292664610e-03f, 1.414213562e-03f, 2.742481884e-04f, 5.318296098e-05f, 1.031338616e-05f};
constexpr int LDS_PTRS = LDS_MISC + 256;
struct Frame { unsigned char* lds; LAS unsigned char* ldsl; unsigned char* ws; int tid, lane, wid, G, bid;
    __device__ __forceinline__ const float* in(int k) const { const LAS unsigned* t = (const LAS unsigned*)(ldsl + LDS_PTRS) + 2 * k;
        const unsigned lo = __builtin_amdgcn_readfirstlane(t[0]), hi = __builtin_amdgcn_readfirstlane(t[1]); return (const float*)(((unsigned long long)hi << 32) | lo); }
    __device__ __forceinline__ float* out() const { return (float*)in(25); } };
__device__ __forceinline__ Frame fresh(const Frame& F0) { Frame F = F0; int t = threadIdx.x; asm volatile("" : "+v"(t)); F.tid = t; F.lane = t & 63; F.wid = __builtin_amdgcn_readfirstlane(t >> 6); unsigned char* w = F0.ws; asm volatile("" : "+s"(w)); F.ws = w; return F; }

__device__ __forceinline__ void tconv(const Frame& F, const float* src, long src_ld, int K, int ncols, bf16_t* dst, long dst_ld, int& rot) {
    float* tile = (float*)F.lds;
    const int tk = K >> 6, tn = (ncols + 63) >> 6, total = tk * tn, tid = F.tid;
    int start = (F.bid - (rot % F.G) + F.G) % F.G; rot += total;
    const int lr = tid >> 4, lc4 = (tid & 15) * 4, sn = tid >> 3, skc = (tid & 7) * 8;
    for (int t0 = start; t0 < total; t0 += 4 * F.G) {
#pragma unroll
        for (int q = 0; q < 4; ++q) { const int t = t0 + q * F.G;
            if (t < total) { const int k0 = (t % tk) * 64, n0 = (t / tk) * 64; float* tl = tile + q * (64 * 65);
#pragma unroll
                for (int h = 0; h < 2; ++h) { const int k = k0 + lr + 32 * h, col = n0 + lc4;
                    f32x4 v = (f32x4){0.f, 0.f, 0.f, 0.f}; if (col < ncols) v = *(const f32x4*)(src + (size_t)k * src_ld + col);
                    float* p = tl + (lr + 32 * h) * 65 + lc4; p[0] = v[0]; p[1] = v[1]; p[2] = v[2]; p[3] = v[3]; } } }
        __syncthreads();
#pragma unroll
        for (int q = 0; q < 4; ++q) { const int t = t0 + q * F.G;
            if (t < total) { const int k0 = (t % tk) * 64, n0 = (t / tk) * 64; const float* tl = tile + q * (64 * 65);
                if (n0 + sn < ncols) { f32x4 a, b;
#pragma unroll
                    for (int j = 0; j < 4; ++j) { a[j] = tl[(skc + j) * 65 + sn]; b[j] = tl[(skc + 4 + j) * 65 + sn]; }
                    pg8::st_bf16x8(dst + (size_t)(n0 + sn) * dst_ld + k0 + skc, a, b); } } }
        __syncthreads();
    }
}
__device__ __forceinline__ void conv_rows(const Frame& F, const float* src, bf16_t* dst, size_t n8) {
    for (size_t i = (size_t)F.bid * 512 + F.tid; i < n8; i += (size_t)F.G * 512) { const f32x4 a = *(const f32x4*)(src + i * 8), b = *(const f32x4*)(src + i * 8 + 4); pg8::st_bf16x8(dst + i * 8, a, b); }
}
__constant__ int c_so[14] = {0, 1312, 2416, 3440, 4464, 5496, 6520, 7544, 8568, 1024, 1280, 2336, 2400, 5488};
__constant__ int c_dn[14] = {0, 1024, 2048, 3072, 4096, 5120, 6144, 7168, 8192, 14336, 14592, 14624, 14688, 14704};
__constant__ int c_nc[14] = {1024, 1024, 1024, 1024, 1024, 1024, 1024, 1024, 6144, 256, 32, 64, 16, 8};
__device__ __forceinline__ void convert_layer_weights(const Frame& F0, const Params& P, int l) { const Frame F = fresh(F0);
    unsigned char* ws = F.ws; int rot = 0;
    { const float* w = F.in(2) + (size_t)l * DM * INW; bf16_t* d = (bf16_t*)(ws + W_IN);
#pragma unroll 1
      for (int s = 0; s < 14; ++s) tconv(F, w + c_so[s], INW, DM, c_nc[s], d + (size_t)c_dn[s] * DM, DM, rot); }
    tconv(F, F.in(7) + (size_t)l * 1024 * DM, DM, 1024, DM, (bf16_t*)(ws + W_BRA), 1024, rot);
    tconv(F, F.in(8) + (size_t)l * 1024 * DM, DM, 1024, DM, (bf16_t*)(ws + W_BRB), 1024, rot);
    tconv(F, F.in(9) + (size_t)l * 1024 * DM, DM, 1024, DM, (bf16_t*)(ws + W_BRC), 1024, rot);
    tconv(F, F.in(10) + (size_t)l * DM * DM, DM, DM, DM, (bf16_t*)(ws + W_OUT), DM, rot);
    tconv(F, F.in(21) + (size_t)l * DM * DM, DM, DM, DM, (bf16_t*)(ws + W_PG), DM, rot);
    tconv(F, F.in(22) + (size_t)l * 256 * DM, DM, 256, DM, (bf16_t*)(ws + W_PLE), 256, rot);
#pragma unroll 1
    for (int h = 0; h < 8; ++h) tconv(F, F.in(6) + (size_t)l * 256 * 1024 + h * 128, 1024, 256, 128, (bf16_t*)(ws + W_UV2) + ((size_t)(h >> 1) * 256 + (h & 1) * 128) * 512 + (h & 1) * 256, 512, rot);
#pragma unroll 1
    for (int e = 0; e < NEXP; ++e) {
        const float* wg = F.in(15) + ((size_t)l * NEXP + e) * DM * DEXP; const float* wu = F.in(17) + ((size_t)l * NEXP + e) * DM * DEXP;
        bf16_t* d = (bf16_t*)(ws + W_GU) + (size_t)e * 2048 * 2048;
#pragma unroll 1
        for (int jb = 0; jb < 8; ++jb) { tconv(F, wg + jb * 128, DEXP, DM, 128, d + (size_t)(jb * 256) * 2048, 2048, rot); tconv(F, wu + jb * 128, DEXP, DM, 128, d + (size_t)(jb * 256 + 128) * 2048, 2048, rot); }
        tconv(F, F.in(19) + ((size_t)l * NEXP + e) * DEXP * DM, DM, DEXP, DM, (bf16_t*)(ws + W_DN) + (size_t)e * 2048 * 1024, 1024, rot);
    }
    { const float* w = F.in(5) + (size_t)l * 256 * 8 * 96; bf16_t* d = (bf16_t*)(ws + W_UK2);
      for (int i = F.bid * 512 + F.tid; i < 256 * 8 * 96; i += F.G * 512) { const int n = i % 96, h = (i / 96) & 7, r = i / 768; d[((size_t)h * 256 + r) * 256 + (h & 1) * 128 + 32 + n] = f2bf(w[i]); } }
}

__device__ __forceinline__ void rope_cs(float pos, float invf, float& c, float& s) {
    const float a = pos * invf; const double ad = (double)a * 0.15915494309189535; const float fr = (float)(ad - rint(ad));
    s = __builtin_amdgcn_sinf(fr); c = __builtin_amdgcn_cosf(fr);
}
__device__ __forceinline__ void phase_prep(const Frame& F0, const Params& P, int l) { const Frame F = fresh(F0);
    unsigned char* ws = F.ws; const int lane = F.lane;
    const float* smallb = (const float*)(ws + R_SMALL); bf16_t* kcat = (bf16_t*)(ws + R_KCAT); bf16_t* qcat = (bf16_t*)(ws + R_QCAT);
    bf16_t* ki = (bf16_t*)(ws + R_KI); float* wi = (float*)(ws + R_WI); float* lf = (float*)(ws + WS_LF);
    const bf16_t* qa = (const bf16_t*)(ws + R_QA); bf16_t* qidx = (bf16_t*)(ws + R_QIDX);
    const f32x4 gck = *(const f32x4*)(F.in(4) + l * 256 + lane * 4);
    const float bfo = lane < 8 ? F.in(3)[l * 8 + lane] : 0.f;
    const float ifr = c_invf_r[lane & 15], ifi = c_invf_i[lane & 7];
    for (int tok = F.bid * 8 + F.wid; tok < NTOK; tok += F.G * 8) {
        const int s = tok & (SEQ - 1), b = tok >> 13; const float* sm = smallb + (size_t)tok * 512;
        float cr, sr, ci, si; rope_cs((float)s, ifr, cr, sr); rope_cs((float)s, ifi, ci, si);
        { const f32x4 v = *(const f32x4*)(sm + lane * 4); float ss = v[0] * v[0] + v[1] * v[1] + v[2] * v[2] + v[3] * v[3]; ss = wave_sum(ss);
          const float rs = rsqrtf(ss * (1.0f / 256.0f) + 1e-6f); u32x2 w; w.x = cvtpk(v[0] * rs * gck[0], v[1] * rs * gck[1]); w.y = cvtpk(v[2] * rs * gck[2], v[3] * rs * gck[3]);
          *(u32x2*)(kcat + (size_t)tok * 288 + lane * 4) = w; }
        if (lane < 16) { const float x1 = sm[256 + lane], x2 = sm[272 + lane]; kcat[(size_t)tok * 288 + 256 + lane] = f2bf(x1 * cr - x2 * sr); kcat[(size_t)tok * 288 + 272 + lane] = f2bf(x2 * cr + x1 * sr); }
        { float o = sm[288 + lane];
          if (lane < 8) { const float x2 = sm[296 + lane]; o = o * ci - x2 * si; } else if (lane < 16) { const float x1 = sm[288 + lane - 8]; o = o * ci + x1 * si; }
          ki[(size_t)tok * 64 + lane] = f2bf(o); }
        if (lane < 16) wi[(size_t)tok * 16 + lane] = sm[352 + lane] * (1.0f / 32.0f);
        if (lane < 8) { const float f = sm[368 + lane] + bfo; lf[(size_t)(b * 8 + lane) * SEQ + s] = fminf(f, 0.f) - log1pf(__expf(-fabsf(f))); }
#pragma unroll
        for (int pp = 0; pp < 2; ++pp) { const int p = lane + 64 * pp, h = p >> 4, i = p & 15;
            const float x1 = bf2f(qa[(size_t)tok * 1024 + h * 128 + i]), x2 = bf2f(qa[(size_t)tok * 1024 + h * 128 + 16 + i]);
            qcat[(size_t)tok * 2304 + h * 288 + 256 + i] = f2bf(x1 * cr - x2 * sr); qcat[(size_t)tok * 2304 + h * 288 + 272 + i] = f2bf(x2 * cr + x1 * sr); }
#pragma unroll
        for (int pp = 0; pp < 2; ++pp) { const int p = lane + 64 * pp, hh = p >> 3, i = p & 7; bf16_t* q = qidx + (size_t)tok * 1024 + hh * 64;
            const float x1 = bf2f(q[i]), x2 = bf2f(q[8 + i]); q[i] = f2bf(x1 * ci - x2 * si); q[8 + i] = f2bf(x2 * ci + x1 * si); }
    }
}
__device__ __forceinline__ void phase_cumsum(const Frame& F0) { const Frame F = fresh(F0);
    const int gw = F.bid * 8 + F.wid; if (gw >= 16) return;
    const float* lf = (const float*)(F.ws + WS_LF) + (size_t)gw * SEQ; float* cum = (float*)(F.ws + WS_CUM) + (size_t)gw * SEQ;
    const int lane = F.lane; double tot = 0.0;
    for (int j = 0; j < 128; ++j) tot += (double)lf[lane * 128 + j];
    double inc = tot;
    for (int o = 1; o < 64; o <<= 1) { const double n = __shfl_up(inc, o); if (lane >= o) inc += n; }
    double run = inc - tot;
    for (int j = 0; j < 128; ++j) { run += (double)lf[lane * 128 + j]; cum[lane * 128 + j] = (float)run; }
}

__device__ __forceinline__ void idx_group(const Frame& F, int b, int g) {
    const int lane = F.lane, rho = lane & 31, hh = lane >> 5; unsigned char* ws = F.ws;
    const bf16_t* qidx = (const bf16_t*)(ws + R_QIDX); const bf16_t* ki = (const bf16_t*)(ws + R_KI) + (size_t)b * SEQ * 64; const float* wi = (const float*)(ws + R_WI);
    float* scores = (float*)(ws + R_SCORES) + (size_t)b * SEQ * SEQ;
    const int t0 = g * 4;
    bf16x8 af[2][4]; float wv[2][16];
#pragma unroll
    for (int mt = 0; mt < 2; ++mt) {
        const int tokA = b * SEQ + t0 + 2 * mt + ((rho >> 2) & 1), head = (rho & 3) + 4 * (rho >> 3);
#pragma unroll
        for (int kk = 0; kk < 4; ++kk) af[mt][kk] = *(const bf16x8*)(qidx + (size_t)tokA * 1024 + head * 64 + kk * 16 + 8 * hh);
        const float* wp = wi + (size_t)(b * SEQ + t0 + 2 * mt + hh) * 16;
#pragma unroll
        for (int q = 0; q < 4; ++q) { const f32x4 v = *(const f32x4*)(wp + 4 * q); wv[mt][4 * q] = v[0]; wv[mt][4 * q + 1] = v[1]; wv[mt][4 * q + 2] = v[2]; wv[mt][4 * q + 3] = v[3]; }
    }
    const int ntile = (t0 + 3) / 32 + 1;
    bf16x8 bc[4], bn[4];
#pragma unroll
    for (int kk = 0; kk < 4; ++kk) bc[kk] = *(const bf16x8*)(ki + (size_t)rho * 64 + kk * 16 + 8 * hh);
    for (int tl = 0; tl < ntile; ++tl) {
        const int kb = tl * 32, kbn = (tl + 1 < ntile) ? kb + 32 : kb;
#pragma unroll
        for (int kk = 0; kk < 4; ++kk) bn[kk] = *(const bf16x8*)(ki + (size_t)(kbn + rho) * 64 + kk * 16 + 8 * hh);
#pragma unroll
        for (int mt = 0; mt < 2; ++mt) {
            f32x16 acc = {};
#pragma unroll
            for (int kk = 0; kk < 4; ++kk) acc = __builtin_amdgcn_mfma_f32_32x32x16_bf16(af[mt][kk], bc[kk], acc, 0, 0, 0);
            float sc = 0.f;
#pragma unroll
            for (int r = 0; r < 16; ++r) sc = fmaf(wv[mt][r], fmaxf(acc[r], 0.f), sc);
            scores[(size_t)(t0 + 2 * mt + hh) * SEQ + kb + rho] = sc;
        }
#pragma unroll
        for (int kk = 0; kk < 4; ++kk) bc[kk] = bn[kk];
    }
}
__device__ __forceinline__ void phase_idx(const Frame& F0) { const Frame F = fresh(F0);
    for (int gw = F.bid * 8 + F.wid; gw < 2048; gw += F.G * 8) { const int b = gw >> 10, pr = gw & 1023; idx_group(F, b, pr); idx_group(F, b, 2047 - pr); }
}

__device__ __forceinline__ unsigned sortable(float f) { const unsigned u = __float_as_uint(f); return (u & 0x80000000u) ? ~u : (u | 0x80000000u); }
__device__ __forceinline__ void topk_row(const Frame& F, int b, int t) {
    const int lane = F.lane, L = t + 1, tok = b * SEQ + t; unsigned char* ws = F.ws;
    int* sel = (int*)(ws + R_SEL) + (size_t)tok * 256; int* nsel = (int*)(ws + R_NSEL);
    if (lane == 0) nsel[tok] = L < 256 ? L : 256;
    if (L <= 256) { for (int j = lane; j < 256; j += 64) sel[j] = j < L ? j : 0; return; }
    const float* row = (const float*)(ws + R_SCORES) + ((size_t)b * SEQ + t) * SEQ;
    const int nch = (L + 1023) >> 10;
    unsigned u[128];
#pragma unroll
    for (int c = 0; c < 8; ++c) {
        if (c < nch) {
#pragma unroll
            for (int jj = 0; jj < 4; ++jj) { const int j = c * 4 + jj; const f32x4 v = *(const f32x4*)(row + j * 256 + lane * 4);
#pragma unroll
                for (int e = 0; e < 4; ++e) { const int idx = j * 256 + lane * 4 + e; u[j * 4 + e] = idx < L ? sortable(v[e]) : 0u; } }
        } else {
#pragma unroll
            for (int q = 0; q < 16; ++q) u[c * 16 + q] = 0u;
        }
    }
    unsigned T = 0u, thr_gt = 0u; int need_eq = 0; bool early = false;
    for (int bit = 31; bit >= 0; --bit) {
        const unsigned cand = T | (1u << bit); int cnt = 0;
#pragma unroll
        for (int c = 0; c < 8; ++c) if (c < nch) {
#pragma unroll
            for (int q = 0; q < 16; ++q) cnt += __popcll(__ballot(u[c * 16 + q] >= cand)); }
        if (cnt >= 256) { T = cand; if (cnt == 256) { early = true; break; } }
    }
    if (early) { thr_gt = T - 1u; need_eq = 0; }
    else { int gtc = 0;
#pragma unroll
        for (int c = 0; c < 8; ++c) if (c < nch) {
#pragma unroll
            for (int q = 0; q < 16; ++q) gtc += __popcll(__ballot(u[c * 16 + q] > T)); }
        thr_gt = T; need_eq = 256 - gtc; }
    int base = 0, eq_taken = 0;
#pragma unroll
    for (int c = 0; c < 8; ++c) if (c < nch) {
#pragma unroll
        for (int q = 0; q < 16; ++q) { const int rq = c * 16 + q; const unsigned v = u[rq];
            const bool iseq = (v == thr_gt) && (need_eq > 0);
            const unsigned long long meq = __ballot(iseq);
            const int eqr = __popcll(meq & ((1ull << lane) - 1ull));
            const bool take = (v > thr_gt) || (iseq && (eq_taken + eqr < need_eq));
            const unsigned long long mt = __ballot(take);
            const int pos = base + __popcll(mt & ((1ull << lane) - 1ull));
            if (take && pos < 256) sel[pos] = (rq >> 2) * 256 + lane * 4 + (rq & 3);
            base += __popcll(mt); eq_taken += __popcll(meq); } }
}
__device__ __forceinline__ void phase_topk(const Frame& F0) { const Frame F = fresh(F0);
    for (int q = F.bid * 8 + F.wid; q < 8192; q += F.G * 8) { const int b = q >> 12, p = q & 4095; topk_row(F, b, p); topk_row(F, b, SEQ - 1 - p); }
}

namespace att {
constexpr int D = 128, KVBLK = 64, QBLK = 32, SHM_V = 16384, SHM_K = 16384;
constexpr int OFF_K = 2 * SHM_V, OFF_BIAS = 2 * SHM_V + 2 * SHM_K, OFF_WS = OFF_BIAS + 512;
#define KSWZ(row, colB) ((row) * 256 + ((colB) ^ (((row) & 7) << 4)))
__device__ __forceinline__ int v_st(int k, int c) { const int kk = (k & ~0xC) | ((k & 4) << 1) | ((k & 8) >> 1); return ((kk >> 3) * 4 + (c >> 5)) * 512 + ((kk & 7) * 32 + (c & 31)) * 2; }
__device__ __forceinline__ int v_rd_base(int lane) { return ((lane & 3) << 3) | (((lane >> 2) & 3) << 6) | (((lane >> 4) & 1) << 5) | (((lane >> 5) & 1) << 8); }
constexpr int v_rd_off(int d0, int ks, int half) { return d0 * 512 + ks * 4096 + half * 2048; }
template <int KB>
__device__ __forceinline__ void qkt(f32x16& p0, f32x16& p1, const char* K_lds, int r32, int hi, const bf16x8* qr) {
    p0 = f32x16{}; p1 = f32x16{};
    const char* kb[4];
#pragma unroll
    for (int dd = 0; dd < 4; ++dd) kb[dd] = K_lds + KB * SHM_K + KSWZ(r32, (dd * 16 + hi * 8) * 2);
#pragma unroll
    for (int d0 = 0; d0 < 8; ++d0) { const char* a = kb[d0 & 3] + (d0 >> 2) * 128;
        bf16x8 b0 = *reinterpret_cast<const bf16x8*>(a);
        bf16x8 b1 = *reinterpret_cast<const bf16x8*>(a + 32 * 256);
        p0 = __builtin_amdgcn_mfma_f32_32x32x16_bf16(b0, qr[d0], p0, 0, 0, 0);
        p1 = __builtin_amdgcn_mfma_f32_32x32x16_bf16(b1, qr[d0], p1, 0, 0, 0); }
}
template <int VB>
__device__ __forceinline__ void pv_tile(f32x16* o, int vb0, bf16x8 pa0, bf16x8 pa1, bf16x8 pa2, bf16x8 pa3) {
#define TRRD(dst, off) asm volatile("ds_read_b64_tr_b16 %0, %1 offset:%2" : "=&v"(dst) : "v"(vb0), "i"(off) : "memory")
#define PV_D0(d0) do { s16x4 l0, l1, l2, l3, h0, h1, h2, h3; constexpr int b_ = VB * SHM_V + v_rd_off(d0, 0, 0); \
        TRRD(l0, b_); TRRD(h0, b_ + 2048); TRRD(l1, b_ + 4096); TRRD(h1, b_ + 6144); TRRD(l2, b_ + 8192); TRRD(h2, b_ + 10240); TRRD(l3, b_ + 12288); TRRD(h3, b_ + 14336); \
        asm volatile("s_waitcnt lgkmcnt(0)" ::: "memory"); SBAR(); \
        o[d0] = __builtin_amdgcn_mfma_f32_32x32x16_bf16(pa0, (bf16x8){l0[0], l0[1], l0[2], l0[3], h0[0], h0[1], h0[2], h0[3]}, o[d0], 0, 0, 0); \
        o[d0] = __builtin_amdgcn_mfma_f32_32x32x16_bf16(pa1, (bf16x8){l1[0], l1[1], l1[2], l1[3], h1[0], h1[1], h1[2], h1[3]}, o[d0], 0, 0, 0); \
        o[d0] = __builtin_amdgcn_mfma_f32_32x32x16_bf16(pa2, (bf16x8){l2[0], l2[1], l2[2], l2[3], h2[0], h2[1], h2[2], h2[3]}, o[d0], 0, 0, 0); \
        o[d0] = __builtin_amdgcn_mfma_f32_32x32x16_bf16(pa3, (bf16x8){l3[0], l3[1], l3[2], l3[3], h3[0], h3[1], h3[2], h3[3]}, o[d0], 0, 0, 0); } while (0)
    PV_D0(0); PV_D0(1); PV_D0(2); PV_D0(3);
#undef PV_D0
#undef TRRD
}
#define PK4(P, B_, OUT) do { unsigned a0 = cvtpk(P[B_+0], P[B_+1]), a1 = cvtpk(P[B_+2], P[B_+3]); \
        unsigned b0 = cvtpk(P[B_+4], P[B_+5]), b1 = cvtpk(P[B_+6], P[B_+7]); \
        auto r0 = __builtin_amdgcn_permlane32_swap(a0, b0, false, false); auto r1 = __builtin_amdgcn_permlane32_swap(a1, b1, false, false); \
        u32x4 w = {r0[0], r1[0], r0[1], r1[1]}; OUT = *reinterpret_cast<bf16x8*>(&w); } while (0)
__device__ __forceinline__ float swap_max(float x) { auto rr = __builtin_amdgcn_permlane32_swap(__float_as_uint(x), __float_as_uint(x), false, false); return fmaxf(__uint_as_float(rr[0]), __uint_as_float(rr[1])); }
__device__ __forceinline__ float swap_sum(float x) { auto rr = __builtin_amdgcn_permlane32_swap(__float_as_uint(x), __float_as_uint(x), false, false); return __uint_as_float(rr[0]) + __uint_as_float(rr[1]); }
__device__ __forceinline__ float swap_lo(float x) { auto rr = __builtin_amdgcn_permlane32_swap(__float_as_uint(x), __float_as_uint(x), false, false); return __uint_as_float(rr[0]); }


__device__ __forceinline__ void fox_sm(f32x16& p0, f32x16& p1, const float* bl, int kb_, int qlo, int qrow, int hi, int r32, float& m_reg, float& l_reg, f32x16* o, float* al_l,
                                       bf16x8& pa0, bf16x8& pa1, bf16x8& pa2, bf16x8& pa3) {
#pragma unroll
    for (int g = 0; g < 4; ++g) { const f32x4 b0v = *(const f32x4*)(bl + 8 * g + 4 * hi), b1v = *(const f32x4*)(bl + 32 + 8 * g + 4 * hi);
#pragma unroll
        for (int i = 0; i < 4; ++i) { p0[4 * g + i] = fmaf(p0[4 * g + i], C2, b0v[i]); p1[4 * g + i] = fmaf(p1[4 * g + i], C2, b1v[i]); } }
    if (kb_ + KVBLK - 1 > qlo) { const float NEG = -__builtin_inff();
#pragma unroll
        for (int r = 0; r < 16; ++r) { const int key = kb_ + crow(r, hi); if (key > qrow) p0[r] = NEG; if (key + 32 > qrow) p1[r] = NEG; } }
    float pmax = p0[0];
#pragma unroll
    for (int r = 1; r < 16; ++r) pmax = fmaxf(pmax, p0[r]);
#pragma unroll
    for (int r = 0; r < 16; ++r) pmax = fmaxf(pmax, p1[r]);
    pmax = swap_max(pmax);
    const float mn = fmaxf(m_reg, pmax), alpha = __builtin_amdgcn_exp2f(m_reg - mn); m_reg = mn;
    float ps = 0.f;
#pragma unroll
    for (int r = 0; r < 16; ++r) { p0[r] = __builtin_amdgcn_exp2f(p0[r] - mn); p1[r] = __builtin_amdgcn_exp2f(p1[r] - mn); ps += p0[r] + p1[r]; }
    ps = swap_sum(ps); l_reg = l_reg * alpha + ps;
    if (__any(alpha < 1.f)) { if (hi == 0) al_l[r32] = alpha; asm volatile("s_waitcnt lgkmcnt(0)" ::: "memory");
#pragma unroll
        for (int r = 0; r < 16; ++r) { const float a = al_l[crow(r, hi)];
#pragma unroll
            for (int d_ = 0; d_ < 4; ++d_) o[d_][r] *= a; } }
    PK4(p0, 0, pa0); PK4(p0, 8, pa1); PK4(p1, 0, pa2); PK4(p1, 8, pa3);
}
__device__ __forceinline__ void sb_half(f32x16& pz, int keybase, int qrow, int hi, float& R, const bf16x8* triA, bool needmask) {
    f32x16 X;
#pragma unroll
    for (int r = 0; r < 16; ++r) { const float zz = pz[r] * C2; const bool valid = !needmask || (keybase + crow(r, hi) < qrow);
        const float l2 = fmaxf(zz, 0.f) + __builtin_amdgcn_logf(1.0f + __builtin_amdgcn_exp2f(-fabsf(zz)));
        X[r] = valid ? -l2 : 0.f; pz[r] = valid ? zz : -__builtin_inff(); }
    f32x16 Y;
#pragma unroll
    for (int r = 0; r < 16; ++r) Y[r] = R;
#pragma unroll
    for (int s = 0; s < 2; ++s) {
        const unsigned h0 = cvtpk(X[8 * s + 0], X[8 * s + 1]), h1 = cvtpk(X[8 * s + 2], X[8 * s + 3]), h2 = cvtpk(X[8 * s + 4], X[8 * s + 5]), h3 = cvtpk(X[8 * s + 6], X[8 * s + 7]);
        const unsigned l0 = cvtpk(X[8 * s + 0] - bflo(h0), X[8 * s + 1] - bfhi(h0)), l1 = cvtpk(X[8 * s + 2] - bflo(h1), X[8 * s + 3] - bfhi(h1));
        const unsigned l2 = cvtpk(X[8 * s + 4] - bflo(h2), X[8 * s + 5] - bfhi(h2)), l3 = cvtpk(X[8 * s + 6] - bflo(h3), X[8 * s + 7] - bfhi(h3));
        u32x4 wh = {h0, h1, h2, h3}, wl = {l0, l1, l2, l3};
        Y = __builtin_amdgcn_mfma_f32_32x32x16_bf16(triA[s], *reinterpret_cast<bf16x8*>(&wh), Y, 0, 0, 0);
        Y = __builtin_amdgcn_mfma_f32_32x32x16_bf16(triA[s], *reinterpret_cast<bf16x8*>(&wl), Y, 0, 0, 0); }
#pragma unroll
    for (int r = 0; r < 16; ++r) pz[r] = __builtin_amdgcn_exp2f(pz[r] + Y[r]);
    R = swap_lo(Y[0]);
}
__device__ __forceinline__ void sb_sm(f32x16& p0, f32x16& p1, int kb_, int qlo, int qrow, int hi, float& R, const bf16x8* triA, bf16x8& pa0, bf16x8& pa1, bf16x8& pa2, bf16x8& pa3) {
    const bool needmask = (kb_ + KVBLK - 1 >= qlo);
    sb_half(p1, kb_ + 32, qrow, hi, R, triA, needmask);
    sb_half(p0, kb_, qrow, hi, R, triA, needmask);
    PK4(p0, 0, pa0); PK4(p0, 8, pa1); PK4(p1, 0, pa2); PK4(p1, 8, pa3);
}

template <int MODE>
__device__ __forceinline__ void attn_unit(const bf16_t* Q, const bf16_t* Kh, const bf16_t* Vh, const float* cum, bf16_t* O, int P0, char* lds) {
    int tid = threadIdx.x; asm volatile("" : "+v"(tid));
    const int wid = __builtin_amdgcn_readfirstlane(tid >> 6), lane = tid & 63, r32 = lane & 31, hi = lane >> 5;
    const int NT = P0 / KVBLK + 4;
    char* V_lds = lds; char* K_lds = lds + OFF_K; float* bias_l = (float*)(lds + OFF_BIAS);
    float* wsl = (float*)(lds + OFF_WS) + wid * 64; float* li_l = wsl; float* al_l = wsl + 32;
    const int qlo = P0 + wid * QBLK, qrow = qlo + r32;
    bf16x8 qr[8];
#pragma unroll
    for (int d0 = 0; d0 < 8; ++d0) qr[d0] = *(const bf16x8*)(Q + (size_t)qrow * D + d0 * 16 + hi * 8);
    const int sr = tid >> 4, sc = (tid & 15) * 8, vst0 = v_st(sr, sc), vst1 = v_st(32 + sr, sc), kws = KSWZ(sr, sc * 2);
    const int vb0 = (int)(uintptr_t)V_lds + v_rd_base(lane);
    const float cumref = (MODE == 0) ? cum[P0] : 0.f;
    float m_reg = -1e30f, l_reg = 0.f, R = 0.f; f32x16 o[4] = {};
    bf16x8 triA[2];
    if (MODE == 1) {
#pragma unroll
        for (int s = 0; s < 2; ++s)
#pragma unroll
            for (int j = 0; j < 8; ++j) { const int rho = 16 * s + 8 * (j >> 2) + 4 * hi + (j & 3); triA[s][j] = (rho >= r32) ? (short)0x3F80 : (short)0; }
    }
    bf16x8 st_k0, st_k1, st_v0, st_v1; float st_b = 0.f;
#define TILE_KB(t) ((MODE == 0 ? (t) : (NT - 1 - (t))) * KVBLK)
#define SLOAD(kb_) do { st_v0 = *(const bf16x8*)(Vh + (size_t)((kb_) + sr) * D + sc); st_v1 = *(const bf16x8*)(Vh + (size_t)((kb_) + 32 + sr) * D + sc); \
                        st_k0 = *(const bf16x8*)(Kh + (size_t)((kb_) + sr) * D + sc); st_k1 = *(const bf16x8*)(Kh + (size_t)((kb_) + 32 + sr) * D + sc); \
                        if (MODE == 0 && tid < 64) st_b = (cumref - cum[(kb_) + tid]) * LOG2E; } while (0)
#define SWRITE(bf) do { *(bf16x8*)(V_lds + (bf) * SHM_V + vst0) = st_v0; *(bf16x8*)(V_lds + (bf) * SHM_V + vst1) = st_v1; \
                        *(bf16x8*)(K_lds + (bf) * SHM_K + kws) = st_k0; *(bf16x8*)(K_lds + (bf) * SHM_K + kws + 32 * 256) = st_k1; \
                        if (MODE == 0 && tid < 64) bias_l[(bf) * 64 + tid] = st_b; } while (0)
    __syncthreads();
    SLOAD(TILE_KB(0)); SWRITE(0);
    __syncthreads();
    f32x16 p0, p1; bf16x8 pa0, pa1, pa2, pa3;
#define STEP(BUF, t) do { const int kb_ = TILE_KB(t); \
        if ((t) + 1 < NT) SLOAD(TILE_KB((t) + 1)); \
        SBAR(); qkt<BUF>(p0, p1, K_lds, r32, hi, qr); \
        if (MODE == 0) fox_sm(p0, p1, bias_l + (BUF) * 64, kb_, qlo, qrow, hi, r32, m_reg, l_reg, o, al_l, pa0, pa1, pa2, pa3); \
        else sb_sm(p0, p1, kb_, qlo, qrow, hi, R, triA, pa0, pa1, pa2, pa3); \
        SBAR(); pv_tile<BUF>(o, vb0, pa0, pa1, pa2, pa3); \
        if ((t) + 1 < NT) SWRITE((BUF) ^ 1); \
        __syncthreads(); } while (0)
    for (int t = 0; t < NT; t += 2) { STEP(0, t); STEP(1, t + 1); }
#undef STEP
#undef SLOAD
#undef SWRITE
#undef TILE_KB
    float rli[16];
    if (MODE == 0) { if (hi == 0) li_l[r32] = l_reg; asm volatile("s_waitcnt lgkmcnt(0)" ::: "memory");
#pragma unroll
        for (int r = 0; r < 16; ++r) rli[r] = __builtin_amdgcn_rcpf(li_l[crow(r, hi)]); }
    bf16_t* Ow = O + (size_t)(wid * QBLK) * 1024;
#pragma unroll
    for (int r = 0; r < 16; ++r) { const int orow = crow(r, hi);
#pragma unroll
        for (int d0 = 0; d0 < 4; ++d0) { const float v = (MODE == 0) ? o[d0][r] * rli[r] : o[d0][r];
            const float vn = __shfl_xor(v, 1);
            if ((r32 & 1) == 0) *(unsigned*)(Ow + (size_t)orow * 1024 + d0 * 32 + r32) = cvtpk(v, vn); } }
}
}

__device__ __forceinline__ void sparse_query(const Frame& F, int tok, char* ldsw) {
    unsigned char* ws = F.ws; const int lane = F.lane, g = lane >> 4, i16 = lane & 15;
    const bf16_t* qcat = (const bf16_t*)(ws + R_QCAT) + (size_t)tok * 2304; const bf16_t* kbase = (const bf16_t*)(ws + R_KCAT) + (size_t)(tok >> 13) * SEQ * 288;
    const int* sel = (const int*)(ws + R_SEL) + (size_t)tok * 256; const int ns = ((const int*)(ws + R_NSEL))[tok]; const int ntile = (ns + 31) >> 5;
    bf16x8 qf[9];
#pragma unroll
    for (int st = 0; st < 9; ++st) { qf[st] = (bf16x8){0, 0, 0, 0, 0, 0, 0, 0}; if (i16 < 8) qf[st] = *(const bf16x8*)(qcat + i16 * 288 + st * 32 + 8 * g); }
    const int rA = lane >> 2, cq = lane & 3;
    float m = -1e30f, l = 0.f; f32x4 oT[16];
#pragma unroll
    for (int rb = 0; rb < 16; ++rb) oT[rb] = (f32x4){0.f, 0.f, 0.f, 0.f};
    const unsigned ldso = (unsigned)(uintptr_t)ldsw;
    const unsigned vb = ldso + (unsigned)((4 * g + (i16 >> 2)) * 592 + (i16 & 3) * 8);
    constexpr float SC2 = SCALE * LOG2E;
    bf16x8 stg[18];
#define GATHER(tile_) do { const int j0 = (tile_) * 32 + rA, j1 = j0 + 16; const int s0 = j0 < ns ? sel[j0] : 0, s1 = j1 < ns ? sel[j1] : 0; \
        const bf16_t* p0_ = kbase + (size_t)s0 * 288 + cq * 8; const bf16_t* p1_ = kbase + (size_t)s1 * 288 + cq * 8; \
        _Pragma("unroll") for (int c = 0; c < 9; ++c) { stg[2 * c] = *(const bf16x8*)(p0_ + c * 32); stg[2 * c + 1] = *(const bf16x8*)(p1_ + c * 32); } } while (0)
    GATHER(0);
    for (int tile = 0; tile < ntile; ++tile) {
#pragma unroll
        for (int c = 0; c < 9; ++c) { *(bf16x8*)(ldsw + rA * 592 + c * 64 + cq * 16) = stg[2 * c]; *(bf16x8*)(ldsw + (16 + rA) * 592 + c * 64 + cq * 16) = stg[2 * c + 1]; }
        if (tile + 1 < ntile) GATHER(tile + 1);
        asm volatile("s_waitcnt lgkmcnt(0)" ::: "memory"); SBAR();
        f32x4 acc[2];
#pragma unroll
        for (int mt = 0; mt < 2; ++mt) { acc[mt] = (f32x4){0.f, 0.f, 0.f, 0.f};
#pragma unroll
            for (int st = 0; st < 9; ++st) { const bf16x8 a = *(const bf16x8*)(ldsw + (16 * mt + i16) * 592 + st * 64 + g * 16);
                acc[mt] = __builtin_amdgcn_mfma_f32_16x16x32_bf16(a, qf[st], acc[mt], 0, 0, 0); } }
        float tmax = -__builtin_inff();
#pragma unroll
        for (int mt = 0; mt < 2; ++mt)
#pragma unroll
            for (int r = 0; r < 4; ++r) { const int key = tile * 32 + 16 * mt + 4 * g + r; float x = acc[mt][r] * SC2; if (key >= ns) x = -__builtin_inff(); acc[mt][r] = x; tmax = fmaxf(tmax, x); }
        tmax = fmaxf(tmax, __shfl_xor(tmax, 16)); tmax = fmaxf(tmax, __shfl_xor(tmax, 32));
        const float mn = fmaxf(m, tmax), alpha = __builtin_amdgcn_exp2f(m - mn); m = mn;
        float ps = 0.f;
#pragma unroll
        for (int mt = 0; mt < 2; ++mt)
#pragma unroll
            for (int r = 0; r < 4; ++r) { acc[mt][r] = __builtin_amdgcn_exp2f(acc[mt][r] - mn); ps += acc[mt][r]; }
        ps += __shfl_xor(ps, 16); ps += __shfl_xor(ps, 32);
        l = l * alpha + ps;
#pragma unroll
        for (int rb = 0; rb < 16; ++rb) oT[rb] *= alpha;
        const bf16x8 pf = pack8(acc[0], acc[1]);
#define TRRD2(dst, off) asm volatile("ds_read_b64_tr_b16 %0, %1 offset:%2" : "=&v"(dst) : "v"(vb), "i"(off) : "memory")
#define PVRB(rb) do { s16x4 t1, t2; TRRD2(t1, (rb) * 32); TRRD2(t2, (rb) * 32 + 16 * 592); asm volatile("s_waitcnt lgkmcnt(0)" ::: "memory"); SBAR(); \
        oT[rb] = __builtin_amdgcn_mfma_f32_16x16x32_bf16((bf16x8){t1[0], t1[1], t1[2], t1[3], t2[0], t2[1], t2[2], t2[3]}, pf, oT[rb], 0, 0, 0); } while (0)
        PVRB(0); PVRB(1); PVRB(2); PVRB(3); PVRB(4); PVRB(5); PVRB(6); PVRB(7); PVRB(8); PVRB(9); PVRB(10); PVRB(11); PVRB(12); PVRB(13); PVRB(14); PVRB(15);
#undef PVRB
#undef TRRD2
        SBAR();
    }
#undef GATHER
    const float rl = 1.0f / l;
    if (i16 < 8) { bf16_t* op = (bf16_t*)(ws + R_OLAT) + (size_t)tok * 2048 + i16 * 256 + 4 * g;
#pragma unroll
        for (int rb = 0; rb < 16; ++rb) { u32x2 w; w.x = cvtpk(oT[rb][0] * rl, oT[rb][1] * rl); w.y = cvtpk(oT[rb][2] * rl, oT[rb][3] * rl); *(u32x2*)(op + rb * 16) = w; } }
}
#ifdef ATT_SUB
#define ASUB(k) ((k) == ATT_SUB)
#else
#define ASUB(k) true
#endif
__device__ __forceinline__ void phase_attn(const Frame& F0) { const Frame F = fresh(F0);
    unsigned char* ws = F.ws; char* lds = (char*)F.lds;
    const bf16_t* qkv = (const bf16_t*)(ws + R_QKV); const size_t TS = (size_t)NTOK * 1024;
#pragma unroll 1
    for (int mode = 0; mode < 2; ++mode) {
        if (!ASUB(mode)) continue;
#pragma unroll 1
        for (int it = F.bid; it < 256; it += F.G) { const int bh = it >> 4, x = it & 15, b = bh >> 3, h = bh & 7;
            const bf16_t* Q = qkv + (size_t)(mode * 3 + 0) * TS + (size_t)bh * SEQ * 128; const bf16_t* K = qkv + (size_t)(mode * 3 + 1) * TS + (size_t)bh * SEQ * 128; const bf16_t* V = qkv + (size_t)(mode * 3 + 2) * TS + (size_t)bh * SEQ * 128;
            const float* cum = (const float*)(ws + WS_CUM) + (size_t)bh * SEQ;
            bf16_t* Ob = (bf16_t*)(ws + (mode == 0 ? R_OB : R_OC)) + (size_t)b * SEQ * 1024 + h * 128;
#pragma unroll 1
            for (int pass = 0; pass < 2; ++pass) { const int qb = pass ? 31 - x : x, P0 = qb * 256;
                if (mode == 0) att::attn_unit<0>(Q, K, V, cum, Ob + (size_t)P0 * 1024, P0, lds);
                else att::attn_unit<1>(Q, K, V, cum, Ob + (size_t)P0 * 1024, P0, lds); } }
    }
    __syncthreads();
    char* ldsw = lds + F.wid * 18944;
#pragma unroll 1
    for (int tok = F.bid * 8 + F.wid; tok < NTOK; tok += F.G * 8) if (ASUB(2)) sparse_query(F, tok, ldsw);
}

__device__ __forceinline__ void ln_row(const float* src, const float* g, const float* bta, float* of, bf16_t* ob, int lane) {
    f32x4 v[8]; float s = 0.f;
#pragma unroll
    for (int i = 0; i < 8; ++i) { v[i] = *(const f32x4*)(src + (i * 64 + lane) * 4); s += (v[i][0] + v[i][1]) + (v[i][2] + v[i][3]); }
    s = wave_sum(s); const float mu = s * (1.0f / 2048.0f); float q = 0.f;
#pragma unroll
    for (int i = 0; i < 8; ++i) { const f32x4 d = v[i] - mu; q += (d[0] * d[0] + d[1] * d[1]) + (d[2] * d[2] + d[3] * d[3]); }
    q = wave_sum(q); const float rstd = rsqrtf(q * (1.0f / 2048.0f) + 1e-5f);
#pragma unroll
    for (int i = 0; i < 8; ++i) { const int c = (i * 64 + lane) * 4; const f32x4 gg = *(const f32x4*)(g + c), bb = *(const f32x4*)(bta + c); const f32x4 y = (v[i] - mu) * rstd * gg + bb;
        if (of) *(f32x4*)(of + c) = y;
        if (ob) { u32x2 w; w.x = cvtpk(y[0], y[1]); w.y = cvtpk(y[2], y[3]); *(u32x2*)(ob + c) = w; } }
}
__device__ __forceinline__ void phase_ln1_router(const Frame& F0, const Params& P, int l) { const Frame F = fresh(F0);
    unsigned char* ws = F.ws; const int lane = F.lane, wid = F.wid;
    const float* pre1 = (const float*)(ws + R_PRE1); float* x1f = (float*)(ws + M_X1F); bf16_t* x1b = (bf16_t*)(ws + M_X1B);
    const float* g = F.in(11) + l * DM; const float* bt = F.in(12) + l * DM; const float* wr = F.in(13) + (size_t)l * DM * NEXP; const float* br = F.in(14) + l * NEXP;
    unsigned* cnt = (unsigned*)(ws + WS_CTL) + CW_CNT + l * 32;
    int* tok_e = (int*)(ws + M_TOKE); int* tok_pos = (int*)(ws + M_TOKPOS); float* tok_w = (float*)(ws + M_TOKW);
    float* red = (float*)F.lds;
    float* lg = (float*)(F.lds + 32768);
#pragma unroll 1
    for (int blk = F.bid; blk < NTOK / 64; blk += F.G) {
        const int tok0 = blk * 64;
#pragma unroll 1
        for (int i = 0; i < 8; ++i) { const int tok = tok0 + wid * 8 + i; ln_row(pre1 + (size_t)tok * DM, g, bt, x1f + (size_t)tok * DM, x1b + (size_t)tok * DM, lane); }
        asm volatile("s_waitcnt vmcnt(0)" ::: "memory"); __syncthreads();
        { const int grp = wid >> 2, kq = wid & 3, i32 = lane & 31, hk = lane >> 5; f32x16 acc = {};
          const float* arow = x1f + (size_t)(tok0 + grp * 32 + i32) * DM + kq * 512 + 4 * hk; const float* bcol = wr + (size_t)(kq * 512 + 4 * hk) * NEXP + i32;
#pragma unroll 4
          for (int c8 = 0; c8 < 64; ++c8) { const f32x4 a4 = *(const f32x4*)(arow + c8 * 8);
              const float b0 = bcol[(size_t)(c8 * 8 + 0) * NEXP], b1 = bcol[(size_t)(c8 * 8 + 1) * NEXP], b2 = bcol[(size_t)(c8 * 8 + 2) * NEXP], b3 = bcol[(size_t)(c8 * 8 + 3) * NEXP];
              acc = __builtin_amdgcn_mfma_f32_32x32x2f32(a4[0], b0, acc, 0, 0, 0); acc = __builtin_amdgcn_mfma_f32_32x32x2f32(a4[1], b1, acc, 0, 0, 0);
              acc = __builtin_amdgcn_mfma_f32_32x32x2f32(a4[2], b2, acc, 0, 0, 0); acc = __builtin_amdgcn_mfma_f32_32x32x2f32(a4[3], b3, acc, 0, 0, 0); }
#pragma unroll
          for (int r = 0; r < 16; ++r) red[(wid * 16 + r) * 64 + lane] = acc[r]; }
        __syncthreads();
        if ((wid & 3) == 0) { const int grp = wid >> 2, hk = lane >> 5, e = lane & 31; const float be = br[e];
#pragma unroll
            for (int r = 0; r < 16; ++r) { const float v = red[((wid + 0) * 16 + r) * 64 + lane] + red[((wid + 1) * 16 + r) * 64 + lane] + red[((wid + 2) * 16 + r) * 64 + lane] + red[((wid + 3) * 16 + r) * 64 + lane] + be;
                lg[(grp * 32 + crow(r, hk)) * 33 + e] = v; }
            asm volatile("s_waitcnt lgkmcnt(0)" ::: "memory"); SBAR();
            const int tk = lane & 31; float v[32];
#pragma unroll
            for (int e2 = 0; e2 < 32; ++e2) v[e2] = lg[(grp * 32 + tk) * 33 + e2];
            int ek[4]; float vk[4];
#pragma unroll
            for (int k = 0; k < 4; ++k) { float best = -__builtin_inff(); int bi = 0;
#pragma unroll
                for (int e2 = 0; e2 < 32; ++e2) if (v[e2] > best) { best = v[e2]; bi = e2; }
                ek[k] = bi; vk[k] = best;
#pragma unroll
                for (int e2 = 0; e2 < 32; ++e2) v[e2] = (e2 == bi) ? -__builtin_inff() : v[e2]; }
            float wk[4], sw = 0.f;
#pragma unroll
            for (int k = 0; k < 4; ++k) { wk[k] = __expf(vk[k] - vk[0]); sw += wk[k]; }
            const float rs = 1.0f / sw;
            const bool act = lane < 32; unsigned myc = 0u;
#pragma unroll 1
            for (int E = 0; E < 32; ++E) { unsigned c = 0u;
#pragma unroll
                for (int k = 0; k < 4; ++k) c += (unsigned)__popcll(__ballot(act && ek[k] == E));
                if (lane == E) myc = c; }
            unsigned run = 0u; if (lane < 32 && myc > 0u) run = atomicAdd(&cnt[lane], myc);
            int pk[4];
#pragma unroll
            for (int k = 0; k < 4; ++k) { pk[k] = 0;
#pragma unroll 1
                for (int E = 0; E < 32; ++E) { const unsigned long long mm = __ballot(act && ek[k] == E); const unsigned basev = (unsigned)__shfl((int)run, E);
                    if (act && ek[k] == E) pk[k] = (int)(basev + (unsigned)__popcll(mm & ((1ull << lane) - 1ull)));
                    if (lane == E) run += (unsigned)__popcll(mm); } }
            if (act) { const int tok = tok0 + grp * 32 + tk;
#pragma unroll
                for (int k = 0; k < 4; ++k) { tok_e[tok * 4 + k] = ek[k]; tok_pos[tok * 4 + k] = pk[k]; tok_w[tok * 4 + k] = wk[k] * rs; } }
        }
        __syncthreads();
    }
}
__device__ __forceinline__ void phase_moe_gather(const Frame& F0, int l) { const Frame F = fresh(F0);
    unsigned char* ws = F.ws; const int lane = F.lane;
    const unsigned* cnt = (const unsigned*)(ws + WS_CTL) + CW_CNT + l * 32; unsigned* meta = (unsigned*)(ws + WS_CTL) + CW_META + l * 512;
    unsigned* offs = (unsigned*)(F.lds + LDS_MISC + 64);
    if (F.tid == 0) { unsigned o = 0u; for (int e = 0; e < 32; ++e) { offs[e] = o; o += (cnt[e] + 255u) & ~255u; } offs[32] = o;
        if (F.bid == 0) { meta[0] = o >> 8; for (int e = 0; e < 32; ++e) for (unsigned t = offs[e] >> 8; t < (offs[e + 1] >> 8); ++t) meta[1 + t] = (unsigned)e; } }
    __syncthreads();
    const int* tok_e = (const int*)(ws + M_TOKE); const int* tok_pos = (const int*)(ws + M_TOKPOS); const float* tok_w = (const float*)(ws + M_TOKW);
    int* tok_dst = (int*)(ws + M_TOKDST); float* roww = (float*)(ws + M_ROWW);
    const bf16_t* x1b = (const bf16_t*)(ws + M_X1B); bf16_t* xs = (bf16_t*)(ws + M_XS);
    for (int it = F.bid * 8 + F.wid; it < NTOK * 4; it += F.G * 8) { const int tok = it >> 2;
        const int e = tok_e[it]; const unsigned dst = offs[e] + (unsigned)tok_pos[it];
        if (lane == 0) { tok_dst[it] = (int)dst; roww[dst] = tok_w[it]; }
        const u32x4* sp = (const u32x4*)(x1b + (size_t)tok * DM); u32x4* dp = (u32x4*)(xs + (size_t)dst * DM);
#pragma unroll
        for (int i = 0; i < 4; ++i) dp[i * 64 + lane] = sp[i * 64 + lane]; }
    __syncthreads();
}
__device__ __forceinline__ void phase_combine(const Frame& F0) { const Frame F = fresh(F0);
    unsigned char* ws = F.ws; const int lane = F.lane;
    const float* x1f = (const float*)(ws + M_X1F); const bf16_t* ys = (const bf16_t*)(ws + M_XS); const int* tok_dst = (const int*)(ws + M_TOKDST);
    float* hf = (float*)(ws + M_HF); bf16_t* hb = (bf16_t*)(ws + M_HB);
    for (int tok = F.bid * 8 + F.wid; tok < NTOK; tok += F.G * 8) {
        const int d0 = tok_dst[tok * 4], d1 = tok_dst[tok * 4 + 1], d2 = tok_dst[tok * 4 + 2], d3 = tok_dst[tok * 4 + 3];
#pragma unroll
        for (int i = 0; i < 4; ++i) { const int c = (i * 64 + lane) * 8; const size_t o = (size_t)tok * DM + c;
            f32x4 a = *(const f32x4*)(x1f + o) * ALPHA, b = *(const f32x4*)(x1f + o + 4) * ALPHA;
            const u32x4 y0 = *(const u32x4*)(ys + (size_t)d0 * DM + c), y1 = *(const u32x4*)(ys + (size_t)d1 * DM + c), y2 = *(const u32x4*)(ys + (size_t)d2 * DM + c), y3 = *(const u32x4*)(ys + (size_t)d3 * DM + c);
            a[0] += (bflo(y0.x) + bflo(y1.x)) + (bflo(y2.x) + bflo(y3.x)); a[1] += (bfhi(y0.x) + bfhi(y1.x)) + (bfhi(y2.x) + bfhi(y3.x));
            a[2] += (bflo(y0.y) + bflo(y1.y)) + (bflo(y2.y) + bflo(y3.y)); a[3] += (bfhi(y0.y) + bfhi(y1.y)) + (bfhi(y2.y) + bfhi(y3.y));
            b[0] += (bflo(y0.z) + bflo(y1.z)) + (bflo(y2.z) + bflo(y3.z)); b[1] += (bfhi(y0.z) + bfhi(y1.z)) + (bfhi(y2.z) + bfhi(y3.z));
            b[2] += (bflo(y0.w) + bflo(y1.w)) + (bflo(y2.w) + bflo(y3.w)); b[3] += (bfhi(y0.w) + bfhi(y1.w)) + (bfhi(y2.w) + bfhi(y3.w));
            *(f32x4*)(hf + o) = a; *(f32x4*)(hf + o + 4) = b; pg8::st_bf16x8(hb + o, a, b); } }
}
__device__ __forceinline__ void phase_ln2(const Frame& F0, const Params& P, int l) { const Frame F = fresh(F0);
    unsigned char* ws = F.ws; const float* pre2 = (const float*)(ws + M_X1F); bf16_t* xb = (bf16_t*)(ws + WS_XB);
    const float* g = F.in(23) + l * DM; const float* bt = F.in(24) + l * DM;
    for (int tok = F.bid * 8 + F.wid; tok < NTOK; tok += F.G * 8) ln_row(pre2 + (size_t)tok * DM, g, bt, F.out() + (size_t)tok * DM, xb + (size_t)tok * DM, F.lane);
}

constexpr int NPHASE = 1 + 15 * NLAYER;
#ifdef PH_ONLY
#define PEN(kind) ((kind) == PH_ONLY)
#else
#define PEN(kind) true
#endif
#define IN(k) (lo <= (k) && (k) < hi)
#define SEAM(k) do { if (IN((k) + 1)) xcd_barrier(bar); } while (0)

template <int l>
__device__ __forceinline__ void layer_phases(const Frame& F, const Params& P, const XcdBarrier& bar, const int lo, const int hi, unsigned char* ws0) {
    using namespace pg8;

        const int pb = 1 + 15 * l;
        const float* xres = (l == 0) ? F.in(0) : F.out();
        if (IN(pb + 0) && PEN(0)) { unsigned char* ws = ws0; asm volatile("" : "+s"(ws));
            SchedS S; S.init(NTOK, INWP, F.G, F.bid, (const bf16_t*)(ws + WS_XB), DM, (const bf16_t*)(ws + W_IN), DM);
            EpiInProj E{(bf16_t*)(ws + R_QA), (bf16_t*)(ws + R_QIDX), (bf16_t*)(ws + R_QKV), (bf16_t*)(ws + R_GATES), (float*)(ws + R_SMALL)};
            gemm_phase(F.ldsl, DM, DM, DM, S, E); SEAM(pb + 0); }
        if (IN(pb + 1) && PEN(1)) { unsigned char* ws = ws0; asm volatile("" : "+s"(ws));
            phase_prep(F, P, l);
            SchedS S; S.init(NTOK, 2048, F.G, F.bid, (const bf16_t*)(ws + R_QA), 1024, (const bf16_t*)(ws + W_UK2), 256, 1, 256);
            EpiBf16 E{(bf16_t*)(ws + R_QCAT), 2304, 288};
            gemm_phase(F.ldsl, 256, 1024, 256, S, E); SEAM(pb + 1); }
        if (IN(pb + 2) && PEN(2)) { unsigned char* ws = ws0; asm volatile("" : "+s"(ws)); phase_cumsum(F); phase_idx(F); SEAM(pb + 2); }
        if (IN(pb + 3) && PEN(3)) { unsigned char* ws = ws0; asm volatile("" : "+s"(ws)); phase_topk(F); SEAM(pb + 3); }
        if (IN(pb + 4) && PEN(4)) { unsigned char* ws = ws0; asm volatile("" : "+s"(ws)); phase_attn(F); SEAM(pb + 4); }
        if (IN(pb + 5) && PEN(5)) { unsigned char* ws = ws0; asm volatile("" : "+s"(ws));
            { SchedS S; S.init(NTOK, 1024, F.G, F.bid, (const bf16_t*)(ws + R_OLAT), 2048, (const bf16_t*)(ws + W_UV2), 512, 0, 512);
              EpiBf16 E{(bf16_t*)(ws + R_OA), 1024, 256}; gemm_phase(F.ldsl, 512, 2048, 512, S, E); }
            { SchedS S; S.init(NTOK, 2048, F.G, F.bid, (const bf16_t*)(ws + R_OB), 1024, (const bf16_t*)(ws + W_BRB), 1024);
              EpiBranch<0> E{(const bf16_t*)(ws + R_GATES), (float*)(ws + R_TMP), (bf16_t*)(ws + R_MERGED), 1}; gemm_phase(F.ldsl, 1024, 1024, 1024, S, E); }
            { SchedS S; S.init(NTOK, 2048, F.G, F.bid, (const bf16_t*)(ws + R_OC), 1024, (const bf16_t*)(ws + W_BRC), 1024);
              EpiBranch<1> E{(const bf16_t*)(ws + R_GATES), (float*)(ws + R_TMP), (bf16_t*)(ws + R_MERGED), 2}; gemm_phase(F.ldsl, 1024, 1024, 1024, S, E); }
            SEAM(pb + 5); }
        if (IN(pb + 6) && PEN(6)) { unsigned char* ws = ws0; asm volatile("" : "+s"(ws));
            SchedS S; S.init(NTOK, 2048, F.G, F.bid, (const bf16_t*)(ws + R_OA), 1024, (const bf16_t*)(ws + W_BRA), 1024);
            EpiBranch<2> E{(const bf16_t*)(ws + R_GATES), (float*)(ws + R_TMP), (bf16_t*)(ws + R_MERGED), 0}; gemm_phase(F.ldsl, 1024, 1024, 1024, S, E); SEAM(pb + 6); }
        if (IN(pb + 7) && PEN(7)) { unsigned char* ws = ws0; asm volatile("" : "+s"(ws));
            SchedS S; S.init(NTOK, 2048, F.G, F.bid, (const bf16_t*)(ws + R_MERGED), DM, (const bf16_t*)(ws + W_OUT), DM);
            EpiOut E{xres, (float*)(ws + R_PRE1)}; gemm_phase(F.ldsl, DM, DM, DM, S, E); SEAM(pb + 7); }
        if (IN(pb + 8) && PEN(8)) { unsigned char* ws = ws0; asm volatile("" : "+s"(ws)); phase_ln1_router(F, P, l); SEAM(pb + 8); }
        if (IN(pb + 9) && PEN(9)) { unsigned char* ws = ws0; asm volatile("" : "+s"(ws));
            phase_moe_gather(F, l);
            SchedS S; S.init(NTOK, 2048, F.G, F.bid, (const bf16_t*)(ws + WS_PB) + (size_t)l * NTOK * 256, 256, (const bf16_t*)(ws + W_PLE), 256);
            EpiBf16 E{(bf16_t*)(ws + M_PP), 2048, 256}; gemm_phase(F.ldsl, 256, 256, 256, S, E); SEAM(pb + 9); }
        if (IN(pb + 10) && PEN(10)) { unsigned char* ws = ws0; asm volatile("" : "+s"(ws));
            SchedM S; S.init((const unsigned*)(ws + WS_CTL) + CW_META + l * 512, F.G, F.bid, (const bf16_t*)(ws + M_XS), DM, (const bf16_t*)(ws + W_GU), DM);
            EpiGateUp E{F.in(16) + (size_t)l * NEXP * DEXP, F.in(18) + (size_t)l * NEXP * DEXP, (bf16_t*)(ws + M_HID)}; gemm_phase(F.ldsl, DM, DM, DM, S, E); SEAM(pb + 10); }
        if (IN(pb + 11) && PEN(11)) { unsigned char* ws = ws0; asm volatile("" : "+s"(ws));
            SchedM S; S.init((const unsigned*)(ws + WS_CTL) + CW_META + l * 512, F.G, F.bid, (const bf16_t*)(ws + M_HID), DEXP, (const bf16_t*)(ws + W_DN), DEXP);
            EpiDown E{F.in(20) + (size_t)l * NEXP * DM, (const float*)(ws + M_ROWW), (bf16_t*)(ws + M_XS)}; gemm_phase(F.ldsl, DEXP, DEXP, DEXP, S, E); SEAM(pb + 11); }
        if (IN(pb + 12) && PEN(12)) { unsigned char* ws = ws0; asm volatile("" : "+s"(ws)); phase_combine(F); SEAM(pb + 12); }
        if (IN(pb + 13) && PEN(13)) { unsigned char* ws = ws0; asm volatile("" : "+s"(ws));
            SchedS S; S.init(NTOK, 2048, F.G, F.bid, (const bf16_t*)(ws + M_HB), DM, (const bf16_t*)(ws + W_PG), DM);
            EpiPleGate E{(const float*)(ws + M_HF), (const bf16_t*)(ws + M_PP), (float*)(ws + M_X1F)}; gemm_phase(F.ldsl, DM, DM, DM, S, E); SEAM(pb + 13); }
        if (IN(pb + 14) && PEN(14)) { unsigned char* ws = ws0; asm volatile("" : "+s"(ws)); phase_ln2(F, P, l); if (l + 1 < NLAYER) convert_layer_weights(F, P, l + 1); SEAM(pb + 14); }
}
__global__ void __launch_bounds__(512, 2) fwd(Params P) {
    extern __shared__ __attribute__((aligned(16))) unsigned char lds[];
    Frame F; F.lds = lds; F.ldsl = (LAS unsigned char*)lds; F.ws = P.ws; F.tid = threadIdx.x; F.lane = F.tid & 63; F.wid = __builtin_amdgcn_readfirstlane(F.tid >> 6); F.G = gridDim.x; F.bid = blockIdx.x;
    unsigned char* ws0 = P.ws; unsigned char* ws = ws0;
    const bool fused = (P.ph_hi - P.ph_lo) > 1;
    if (F.tid < 4) ((LAS unsigned*)(F.ldsl + LDS_MISC))[F.tid] = 0u;
    if (F.tid == 0) { LAS unsigned long long* t = (LAS unsigned long long*)(F.ldsl + LDS_PTRS);
#pragma unroll
        for (int k = 0; k < 25; ++k) t[k] = (unsigned long long)P.in[k];
        t[25] = (unsigned long long)P.out; }
    __syncthreads();
    XcdBarrier bar; bar.bar = (unsigned*)(ws + WS_CTL) + CW_BAR; bar.x = 0; bar.st = (volatile LAS unsigned*)(F.ldsl + LDS_MISC);
    if (fused) bar = xcd_barrier_post((unsigned*)(ws + WS_CTL) + CW_BAR, (volatile LAS unsigned*)(F.ldsl + LDS_MISC));
    const int lo = P.ph_lo, hi = P.ph_hi;
    using namespace pg8;
    if (IN(0) && PEN(15)) { unsigned char* ws = ws0; asm volatile("" : "+s"(ws));
        conv_rows(F, F.in(0), (bf16_t*)(ws + WS_XB), (size_t)NTOK * DM / 8);
        conv_rows(F, F.in(1), (bf16_t*)(ws + WS_PB), (size_t)2 * NTOK * 256 / 8);
        convert_layer_weights(F, P, 0);
        SEAM(0);
    }
    layer_phases<0>(F, P, bar, lo, hi, ws0);
    layer_phases<1>(F, P, bar, lo, hi, ws0);
}

#ifdef DEBUG_NAN
constexpr int CW_FLAGS = 8192;
__global__ void dbg_scan_bf16(const unsigned short* p, size_t n, unsigned* flag) { unsigned c = 0; for (size_t i = (size_t)blockIdx.x * blockDim.x + threadIdx.x; i < n; i += (size_t)gridDim.x * blockDim.x) if ((p[i] & 0x7F80u) == 0x7F80u) ++c; if (c) atomicAdd(flag, c); }
__global__ void dbg_scan_f32(const unsigned* p, size_t n, unsigned* flag) { unsigned c = 0; for (size_t i = (size_t)blockIdx.x * blockDim.x + threadIdx.x; i < n; i += (size_t)gridDim.x * blockDim.x) if ((p[i] & 0x7F800000u) == 0x7F800000u) ++c; if (c) atomicAdd(flag, c); }
__global__ void dbg_scan_sel(const int* sel, const int* nsel, unsigned* flag) { unsigned c = 0; for (size_t i = (size_t)blockIdx.x * blockDim.x + threadIdx.x; i < (size_t)NTOK * 256; i += (size_t)gridDim.x * blockDim.x) { const int tok = (int)(i >> 8), j = (int)(i & 255), t = tok & (SEQ - 1); const int ns = nsel[tok]; if (j == 0 && ns != (t + 1 < 256 ? t + 1 : 256)) ++c; if (j < ns && (sel[i] < 0 || sel[i] > t)) ++c; } if (c) atomicAdd(flag, c); }
__global__ void dbg_scan_scores(const unsigned* p, unsigned* flag) { unsigned c = 0; for (size_t i = (size_t)blockIdx.x * blockDim.x + threadIdx.x; i < 2ull * SEQ * SEQ; i += (size_t)gridDim.x * blockDim.x) { const int s = (int)(i & (SEQ - 1)), t = (int)((i >> 13) & (SEQ - 1)); if (s <= t && (p[i] & 0x7F800000u) == 0x7F800000u) ++c; } if (c) atomicAdd(flag, c); }
__global__ void dbg_probe_bf16(const unsigned short* p, size_t n, unsigned* cnt, unsigned* minidx) { unsigned c = 0; unsigned mi = 0xFFFFFFFFu; for (size_t i = (size_t)blockIdx.x * blockDim.x + threadIdx.x; i < n; i += (size_t)gridDim.x * blockDim.x) if ((p[i] & 0x7F80u) == 0x7F80u) { ++c; if ((unsigned)i < mi) mi = (unsigned)i; } if (c) { atomicAdd(cnt, c); atomicMax(minidx, ~mi); } }
__global__ void dbg_final(float* out, size_t n, const unsigned* flags) { int code = 0; for (int k = 0; k < 32; ++k) if (flags[k] && !code) code = k + 1; const int mask = (flags[32] ? 1 : 0) | (flags[33] ? 2 : 0) | (flags[34] ? 4 : 0); if (mask) code = 20 + 5 * mask; if (!code) return; for (size_t i = (size_t)blockIdx.x * blockDim.x + threadIdx.x; i < n; i += (size_t)gridDim.x * blockDim.x) out[i] = (float)code; }
#endif
extern "C" void kernel_launch(void* const* d_in, const int* in_sizes, int n_in, void* d_out, int out_size, void* d_ws, size_t ws_size, hipStream_t stream) {
    static int grid = 0;
    if (grid == 0) {
        if (n_in != 25 || out_size != NTOK * DM || ws_size < WS_NEED) { fprintf(stderr, "kernel_launch: unexpected shapes (n_in %d out %d ws %zu need %zu)\n", n_in, out_size, ws_size, (size_t)WS_NEED); grid = -1; return; }
        int dev = 0, cus = 0, per_cu = 0;
        if (hipGetDevice(&dev) != hipSuccess || hipDeviceGetAttribute(&cus, hipDeviceAttributeMultiprocessorCount, dev) != hipSuccess) { grid = -1; return; }
        if (hipFuncSetAttribute((const void*)fwd, hipFuncAttributeMaxDynamicSharedMemorySize, LDS_BYTES) != hipSuccess) { fprintf(stderr, "kernel_launch: hipFuncSetAttribute failed\n"); grid = -1; return; }
        if (hipOccupancyMaxActiveBlocksPerMultiprocessor(&per_cu, (const void*)fwd, 512, LDS_BYTES) != hipSuccess || per_cu < 1) fprintf(stderr, "kernel_launch: occupancy query says %d\n", per_cu);
        (void)hipGetLastError();
        grid = cus;
    }
    if (grid < 0) return;
    unsigned char* ws = (unsigned char*)d_ws;
    hipMemsetAsync(ws + WS_CTL, 0, CTL_BYTES, stream);
    hipMemsetAsync(ws + W_UK2, 0, 8ull * 256 * 256 * 2 + 4ull * 256 * 512 * 2, stream);
    hipMemsetAsync(ws + W_IN + (size_t)INW * 2048 * 2, 0, (size_t)(INWP - INW) * 2048 * 2, stream);
    Params p{};
    for (int i = 0; i < 25; ++i) p.in[i] = (const float*)d_in[i];
    p.out = (float*)d_out; p.ws = ws;
#if PHASES_PER_LAUNCH == 0
    p.ph_lo = 0; p.ph_hi = NPHASE;
    hipLaunchKernelGGL(fwd, dim3(grid), dim3(512), LDS_BYTES, stream, p);
#else
    for (int k = 0; k < NPHASE; ++k) { p.ph_lo = k; p.ph_hi = k + 1; hipLaunchKernelGGL(fwd, dim3(grid), dim3(512), LDS_BYTES, stream, p);
#ifdef DEBUG_NAN
        unsigned* fl = (unsigned*)(ws + WS_CTL) + CW_FLAGS + k;
#define SB16(off, n) hipLaunchKernelGGL(dbg_scan_bf16, dim3(1024), dim3(256), 0, stream, (const unsigned short*)(ws + (off)), (size_t)(n), fl)
#define SF32(off, n) hipLaunchKernelGGL(dbg_scan_f32, dim3(1024), dim3(256), 0, stream, (const unsigned*)(ws + (off)), (size_t)(n), fl)
        if (k == 0) { SB16(WS_XB, (size_t)NTOK * DM); SB16(WS_PB, 2ull * NTOK * 256); SB16(WS_W, (W_END - WS_W) / 2); }
        else { const int kind = (k - 1) % 15;
            if (kind == 0) { SB16(R_QA, (size_t)NTOK * 1024); SB16(R_QIDX, (size_t)NTOK * 1024); SB16(R_QKV, 6ull * NTOK * 1024); SB16(R_GATES, (size_t)NTOK * 6144); SF32(R_SMALL, (size_t)NTOK * 512); }
            if (kind == 1) { SB16(R_QCAT, (size_t)NTOK * 2304); SB16(R_KCAT, (size_t)NTOK * 288); SB16(R_KI, (size_t)NTOK * 64); SB16(R_QIDX, (size_t)NTOK * 1024); SF32(R_WI, (size_t)NTOK * 16); SF32(WS_LF, 16ull * 8192); }
            if (kind == 2) { SF32(WS_CUM, 16ull * 8192); hipLaunchKernelGGL(dbg_scan_scores, dim3(1024), dim3(256), 0, stream, (const unsigned*)(ws + R_SCORES), fl); }
            if (kind == 3) { hipLaunchKernelGGL(dbg_scan_sel, dim3(1024), dim3(256), 0, stream, (const int*)(ws + R_SEL), (const int*)(ws + R_NSEL), fl); }
            if (k == 5) { unsigned* fl0 = fl; fl = (unsigned*)(ws + WS_CTL) + CW_FLAGS + 32; SB16(R_OLAT, (size_t)NTOK * 2048); fl += 1; SB16(R_OB, (size_t)NTOK * 1024); fl += 1; SB16(R_OC, (size_t)NTOK * 1024); fl = fl0; hipLaunchKernelGGL(dbg_probe_bf16, dim3(1024), dim3(256), 0, stream, (const unsigned short*)(ws + R_OC), (size_t)NTOK * 1024, (unsigned*)(ws + WS_CTL) + CW_FLAGS + 40, (unsigned*)(ws + WS_CTL) + CW_FLAGS + 41); }
            if (kind == 5) { SB16(R_OA, (size_t)NTOK * 1024); SF32(R_TMP, (size_t)NTOK * 2048); }
            if (kind == 6) { SB16(R_MERGED, (size_t)NTOK * 2048); }
            if (kind == 7) { SF32(R_PRE1, (size_t)NTOK * 2048); }
            if (kind == 8) { SF32(M_X1F, (size_t)NTOK * 2048); SF32(M_TOKW, (size_t)NTOK * 4); }
            if (kind == 9) { SB16(M_PP, (size_t)NTOK * 2048); }
            if (kind == 12) { SF32(M_HF, (size_t)NTOK * 2048); }
            if (kind == 13) { SF32(M_X1F, (size_t)NTOK * 2048); }
            if (kind == 14) { hipLaunchKernelGGL(dbg_scan_f32, dim3(1024), dim3(256), 0, stream, (const unsigned*)d_out, (size_t)NTOK * DM, fl); if (k + 1 < NPHASE) SB16(WS_W, (W_END - WS_W) / 2); } }
#endif
    }
#ifdef DEBUG_NAN
    hipLaunchKernelGGL(dbg_final, dim3(1024), dim3(256), 0, stream, (float*)d_out, (size_t)NTOK * DM, (const unsigned*)(ws + WS_CTL) + CW_FLAGS);
#endif
#endif
}
```

```cpp
#include <hip/hip_runtime.h>
#include <stdint.h>
#include <stdio.h>
#include <math.h>

#ifndef PHASES_PER_LAUNCH
#define PHASES_PER_LAUNCH 0
#endif

#define LAS __attribute__((address_space(3)))
#ifndef REP_MASK
#define REP_MASK 0
#endif
#define NREP(bit) (((REP_MASK) >> (bit)) & 1 ? 2 : 1)
typedef unsigned short bf16_t;
typedef short bf16x8 __attribute__((ext_vector_type(8)));
typedef short s16x4 __attribute__((ext_vector_type(4)));
typedef float f32x4 __attribute__((ext_vector_type(4)));
typedef float f32x16 __attribute__((ext_vector_type(16)));
typedef unsigned u32x4 __attribute__((ext_vector_type(4)));
typedef unsigned u32x2 __attribute__((ext_vector_type(2)));

constexpr int NTOK = 16384, DM = 2048, SEQ = 8192, NB = 2, NLAYER = 2;
constexpr int INW = 14712, INWP = 14848;
constexpr int NEXP = 32, DEXP = 1024;
constexpr int PMAX = 65536 + 8192;
constexpr float ALPHA = 1.41421356237309515f;
constexpr float LOG2E = 1.4426950408889634f;
constexpr float SCALE = 0.08838834764831845f;
constexpr float C2 = LOG2E * SCALE;

constexpr size_t MiB = 1ull << 20;
constexpr size_t WS_CTL   = 0;
constexpr size_t WS_W     = 1 * MiB;
constexpr size_t W_IN     = WS_W;
constexpr size_t W_UK2    = W_IN   + (size_t)INWP * 2048 * 2;
constexpr size_t W_UV2    = W_UK2  + 8ull * 256 * 256 * 2;
constexpr size_t W_BRA    = W_UV2  + 4ull * 256 * 512 * 2;
constexpr size_t W_BRB    = W_BRA  + 2048ull * 1024 * 2;
constexpr size_t W_BRC    = W_BRB  + 2048ull * 1024 * 2;
constexpr size_t W_OUT    = W_BRC  + 2048ull * 1024 * 2;
constexpr size_t W_PG     = W_OUT  + 2048ull * 2048 * 2;
constexpr size_t W_PLE    = W_PG   + 2048ull * 2048 * 2;
constexpr size_t W_GU     = W_PLE  + 2048ull * 256 * 2;
constexpr size_t W_DN     = W_GU   + 32ull * 2048 * 2048 * 2;
constexpr size_t W_END    = W_DN   + 32ull * 2048 * 1024 * 2;
constexpr size_t WS_XB    = (W_END + MiB - 1) / MiB * MiB;
constexpr size_t WS_PB    = WS_XB  + (size_t)NTOK * DM * 2;
constexpr size_t WS_CUM   = WS_PB  + 2ull * NTOK * 256 * 2;
constexpr size_t WS_LF    = WS_CUM + 16ull * 8192 * 4;
constexpr size_t WS_R     = WS_LF  + 16ull * 8192 * 4;
constexpr size_t R_SCORES = WS_R;
constexpr size_t R_OLAT   = WS_R;
constexpr size_t R_OA     = WS_R + 64 * MiB;
constexpr size_t R_OB     = WS_R + 96 * MiB;
constexpr size_t R_OC     = WS_R + 128 * MiB;
constexpr size_t R_TMP    = WS_R + 160 * MiB;
constexpr size_t R_MERGED = WS_R + 288 * MiB;
constexpr size_t R_PRE1   = WS_R + 384 * MiB;
constexpr size_t R_QA     = WS_R + 512 * MiB;
constexpr size_t R_QIDX   = WS_R + 544 * MiB;
constexpr size_t R_QKV    = WS_R + 576 * MiB;
constexpr size_t R_GATES  = WS_R + 768 * MiB;
constexpr size_t R_SMALL  = WS_R + 960 * MiB;
constexpr size_t R_QCAT   = WS_R + 992 * MiB;
constexpr size_t R_KCAT   = WS_R + 1064 * MiB;
constexpr size_t R_KI     = WS_R + 1073 * MiB;
constexpr size_t R_WI     = WS_R + 1075 * MiB;
constexpr size_t R_SEL    = WS_R + 1076 * MiB;
constexpr size_t R_NSEL   = WS_R + 1092 * MiB;
constexpr size_t R_END    = WS_R + 1093 * MiB;
constexpr size_t M_XS     = WS_R;
constexpr size_t M_HID    = WS_R + 288 * MiB;
constexpr size_t M_PP     = WS_R + 432 * MiB;
constexpr size_t M_X1F    = WS_R + 512 * MiB;
constexpr size_t M_X1B    = WS_R + 640 * MiB;
constexpr size_t M_HF     = WS_R + 704 * MiB;
constexpr size_t M_HB     = WS_R + 832 * MiB;
constexpr size_t M_TOKE   = WS_R + 896 * MiB;
constexpr size_t M_TOKPOS = M_TOKE + (size_t)NTOK * 16;
constexpr size_t M_TOKW   = M_TOKPOS + (size_t)NTOK * 16;
constexpr size_t M_TOKDST = M_TOKW + (size_t)NTOK * 16;
constexpr size_t M_ROWW   = M_TOKDST + (size_t)NTOK * 16;
constexpr size_t WS_NEED  = R_END;
constexpr int CW_BAR = 0;
constexpr int CW_CNT = 8192;
constexpr int CW_META = 4096 + 64;
constexpr int CW_QCTR = 6144;
constexpr int CW_KMAX = 6400;
constexpr size_t CTL_BYTES = 65536;

constexpr int LDS_BYTES = 152576;
constexpr int LDS_MISC = 151552;

typedef float f32x2 __attribute__((ext_vector_type(2)));
typedef __bf16 bf16n2 __attribute__((ext_vector_type(2)));
__device__ __forceinline__ unsigned cvtpk(float lo, float hi) { f32x2 v = {lo, hi}; bf16n2 b = __builtin_convertvector(v, bf16n2); return __builtin_bit_cast(unsigned, b); }
__device__ __forceinline__ bf16_t f2bf(float x) { return (bf16_t)(cvtpk(x, 0.f) & 0xffffu); }
__device__ __forceinline__ float bf2f(bf16_t b) { return __uint_as_float(((unsigned)b) << 16); }
__device__ __forceinline__ float bflo(unsigned w) { return __uint_as_float(w << 16); }
__device__ __forceinline__ float bfhi(unsigned w) { return __uint_as_float(w & 0xffff0000u); }
__device__ __forceinline__ bf16x8 pack8(f32x4 a, f32x4 b) { u32x4 w = {cvtpk(a[0], a[1]), cvtpk(a[2], a[3]), cvtpk(b[0], b[1]), cvtpk(b[2], b[3])}; return *reinterpret_cast<bf16x8*>(&w); }
__device__ __forceinline__ float sigmoidf_(float x) { return 1.0f / (1.0f + __expf(-x)); }
__device__ __forceinline__ float wave_sum(float v) { for (int o = 32; o > 0; o >>= 1) v += __shfl_xor(v, o); return v; }
__device__ __forceinline__ int crow(int r, int hi) { return (r & 3) + 8 * (r >> 2) + 4 * hi; }
#define SBAR() __builtin_amdgcn_sched_barrier(0)

#define XB_TMO      128
#define XB_XCNT(j)  (256  + 64 * (j))
#define XB_XSUB(j)  (1280 + 64 * (j))
#define XB_XGEN(j)  (2304 + 64 * (j))
#define XB_TOP      3328
#define XB_TOPGEN   3392
#define XCD_BAR_WORDS 3456
#define XB_SPIN_CAP (1u << 22)
__device__ __forceinline__ unsigned xb_ld(unsigned* p)              { return __hip_atomic_load(p, __ATOMIC_RELAXED, __HIP_MEMORY_SCOPE_AGENT); }
__device__ __forceinline__ unsigned xb_add(unsigned* p, unsigned v) { return __hip_atomic_fetch_add(p, v, __ATOMIC_RELAXED, __HIP_MEMORY_SCOPE_AGENT); }
__device__ __forceinline__ unsigned xb_xcc_id() { return (unsigned)__builtin_amdgcn_s_getreg((3 << 11) | 20) & 0xFu; }
#define XB_SPIN(cond, bar) do { unsigned _sp = 0; while (cond) { __builtin_amdgcn_s_sleep(1); \
    if ((++_sp & 255u) == 0u) { if (xb_ld(&(bar)[XB_TMO])) break; if (_sp > XB_SPIN_CAP) { atomicAdd(&(bar)[XB_TMO], 1u); break; } } } } while (0)
struct XcdBarrier { unsigned* bar; unsigned x; volatile LAS unsigned* st; };
__device__ __forceinline__ XcdBarrier xcd_barrier_post(unsigned* bar, volatile LAS unsigned* st) {
    XcdBarrier b; b.bar = bar; b.x = xb_xcc_id(); b.st = st;
    if (threadIdx.x == 0) (void)xb_add(&bar[XB_XCNT(b.x)], 1u);
    return b;
}
__device__ __forceinline__ void xcd_barrier_complete(unsigned* bar, unsigned x, unsigned& nloc, unsigned& nx) {
    const unsigned G = gridDim.x * gridDim.y * gridDim.z;
    unsigned sum, cnt, mine, sp = 0u;
    for (;;) {
        sum = 0u; cnt = 0u; mine = 0u;
#pragma unroll
        for (unsigned j = 0; j < 16; ++j) { const unsigned c = xb_ld(&bar[XB_XCNT(j)]); sum += c; cnt += (c > 0u) ? 1u : 0u; mine = (j == x) ? c : mine; }
        if (sum == G) break;
        __builtin_amdgcn_s_sleep(1);
        if ((++sp & 255u) == 0u) { if (xb_ld(&bar[XB_TMO])) break; if (sp > XB_SPIN_CAP) { atomicAdd(&bar[XB_TMO], 1u); break; } }
    }
    nloc = mine > 0u ? mine : 1u; nx = cnt > 0u ? cnt : 1u;
}
__device__ __forceinline__ void xcd_barrier(const XcdBarrier& b) {
    asm volatile("s_waitcnt vmcnt(0)" ::: "memory");
    __syncthreads();
    if (threadIdx.x == 0) {
        unsigned* bar = b.bar;
        __builtin_amdgcn_s_waitcnt(0);
        unsigned nloc = b.st[0], nx = b.st[1];
        if (nloc == 0u) { xcd_barrier_complete(bar, b.x, nloc, nx); b.st[0] = nloc; b.st[1] = nx; }
        const unsigned old = xb_add(&bar[XB_XSUB(b.x)], 1u);
        const unsigned gen = old / nloc;
        if (old + 1u == (gen + 1u) * nloc) {
            __builtin_amdgcn_fence(__ATOMIC_RELEASE, "agent");
            asm volatile("s_waitcnt vmcnt(0)" ::: "memory");
            const unsigned og = xb_add(&bar[XB_TOP], 1u);
            const unsigned tg = og / nx;
            if (og + 1u == (tg + 1u) * nx) xb_add(&bar[XB_TOPGEN], 1u);
            else XB_SPIN(xb_ld(&bar[XB_TOPGEN]) == tg, bar);
            __builtin_amdgcn_fence(__ATOMIC_ACQUIRE, "agent");
            xb_add(&bar[XB_XGEN(b.x)], 1u);
            asm volatile("s_waitcnt vmcnt(0)" ::: "memory");
        } else {
            XB_SPIN(xb_ld(&bar[XB_XGEN(b.x)]) == gen, bar);
            __builtin_amdgcn_fence(__ATOMIC_ACQUIRE, "agent");
            asm volatile("s_waitcnt vmcnt(0)" ::: "memory");
        }
    }
    __syncthreads();
}

namespace pg8 {
constexpr int BM = 256, BK = 64, HALF = 128, HTB = HALF * BK * 2, STAGE_BYTES = 8 * HTB, NXCD = 8, WGM = 8;
__device__ __forceinline__ int lds_byte(int r, int c) { const int st = (r >> 4) * 2 + (c >> 5), rr = r & 15, cc = c & 31, ob = rr * 64 + cc * 2; return st * 1024 + (ob ^ (((ob >> 9) & 1) << 5)); }
__device__ __forceinline__ void stage_rc(int b, int& R, int& C) { const int st = b / 1024, sb = b % 1024, swz = sb ^ (((sb >> 9) & 1) << 5); R = (st >> 1) * 16 + swz / 64; C = (st & 1) * 32 + (swz % 64) / 2; }
__device__ __forceinline__ int perm32(int rho) { const int n = rho >> 4, i = rho & 15; return 8 * (i >> 2) + 4 * n + (i & 3); }
struct Unit { int pm, pn, e; };
struct SchedS {
    int nM, nN, nwg, G, c; const bf16_t* A; const bf16_t* B; int lda, ldb, a_sh, a_mul;
    __device__ void init(int M, int N, int G_, int c_, const bf16_t* A_, int lda_, const bf16_t* B_, int ldb_, int a_sh_ = 0, int a_mul_ = 0) {
        nM = M / BM; nN = N / BM; nwg = nM * nN; G = G_; c = c_; A = A_; B = B_; lda = lda_; ldb = ldb_; a_sh = a_sh_; a_mul = a_mul_; }
    __device__ __forceinline__ bool next(int i, Unit& u) const {
        const long L = (long)i * G + c; if (L >= nwg) return false;
        int wgid = (int)L; { const int q = nwg / NXCD, r = nwg % NXCD, xcd = wgid % NXCD, off = wgid / NXCD; wgid = (xcd < r ? xcd * (q + 1) : r * (q + 1) + (xcd - r) * q) + off; }
        const int nig = WGM * nN, gid = wgid / nig, fm = gid * WGM, gsz = (nM - fm) < WGM ? (nM - fm) : WGM;
        u.pm = fm + ((wgid % nig) % gsz); u.pn = (wgid % nig) / gsz; u.e = 0;
        return true;
    }
    __device__ __forceinline__ const char* pa(const Unit& u) const { return (const char*)(A + (size_t)u.pm * BM * lda + (size_t)((u.pn >> a_sh) * a_mul)); }
    __device__ __forceinline__ const char* pb(const Unit& u) const { return (const char*)(B + (size_t)u.pn * BM * ldb); }
};
struct SchedM {
    int ntiles, G, c; const bf16_t* A; const bf16_t* W; int lda, ldb; const unsigned* tile_e;
    __device__ void init(const unsigned* meta, int G_, int c_, const bf16_t* A_, int lda_, const bf16_t* W_, int ldb_) {
        ntiles = (int)meta[0]; tile_e = meta + 1; G = G_; c = c_; A = A_; W = W_; lda = lda_; ldb = ldb_; }
    __device__ __forceinline__ bool next(int i, Unit& u) const {
        const long L = (long)i * G + c; if (L >= (long)ntiles * 8) return false;
        u.pm = (int)(L >> 3); u.pn = (int)(L & 7); u.e = (int)tile_e[u.pm];
        return true;
    }
    __device__ __forceinline__ const char* pa(const Unit& u) const { return (const char*)(A + (size_t)u.pm * BM * lda); }
    __device__ __forceinline__ const char* pb(const Unit& u) const { return (const char*)(W + ((size_t)u.e * 2048 + (size_t)u.pn * BM) * ldb); }
};

template <class Epi, class Sched>
__device__ __forceinline__ void gemm_phase(LAS unsigned char* lds, const int K, const int lda, const int ldb, const Sched& S, const Epi& E) {
    int tid = threadIdx.x; asm volatile("" : "+v"(tid));
    const int wid = __builtin_amdgcn_readfirstlane(tid >> 6), lane = tid & 63, wr = wid >> 2, wc = wid & 3, fr = lane & 15, fq = lane >> 4;
    const int nt = K / BK;
    unsigned voffA[2], voffB[2];
#pragma unroll
    for (int i = 0; i < 2; ++i) { int R, C; stage_rc(tid * 16 + i * 8192, R, C); const int Rb = (R & ~31) + perm32(R & 31);
        voffA[i] = (unsigned)(R * lda + C) * 2u; voffB[i] = (unsigned)(Rb * ldb + C) * 2u; }
    const size_t kstep = (size_t)(BK * 2);
    const size_t hstepA = (size_t)HALF * lda * 2, hstepB = (size_t)HALF * ldb * 2;
    const unsigned ldsw = (unsigned)wid * 1024u;
    const int aoff = lds_byte(wr * 64 + fr, fq * 8), boff = lds_byte(wc * 32 + fr, fq * 8);
#define PG8_SA(b, h) (((b) * 2 + (h)) * HTB)
#define PG8_SB(b, h) ((4 + (b) * 2 + (h)) * HTB)
#define PG8_STAGE(bufoff, gbase, voff) do { _Pragma("unroll") for (int _i = 0; _i < 2; ++_i) \
        __builtin_amdgcn_global_load_lds((const unsigned*)((const char*)(gbase) + (voff)[_i]), (LAS unsigned*)(lds + (bufoff) + ldsw + _i * 8192), 16, 0, 0); } while (0)
#define PG8_LDA(dst, b, h) do { _Pragma("unroll") for (int m = 0; m < 4; ++m) _Pragma("unroll") for (int k = 0; k < 2; ++k) dst[m][k] = *(const LAS bf16x8*)(lds + PG8_SA(b, h) + aoff + m * 2048 + k * 1024); } while (0)
#define PG8_LDB(dst, b, h) do { _Pragma("unroll") for (int n = 0; n < 2; ++n) _Pragma("unroll") for (int k = 0; k < 2; ++k) dst[n][k] = *(const LAS bf16x8*)(lds + PG8_SB(b, h) + boff + n * 2048 + k * 1024); } while (0)
#define PG8_MMA(ai, bj, At, Bt) do { __builtin_amdgcn_s_setprio(1); _Pragma("unroll") for (int m = 0; m < 4; ++m) _Pragma("unroll") for (int n = 0; n < 2; ++n) _Pragma("unroll") for (int k = 0; k < 2; ++k) \
        acc[ai][bj][m][n] = __builtin_amdgcn_mfma_f32_16x16x32_bf16(Bt[n][k], At[m][k], acc[ai][bj][m][n], 0, 0, 0); __builtin_amdgcn_s_setprio(0); } while (0)
#define PG8_WAIT_V(n) asm volatile("s_waitcnt vmcnt(" #n ")" ::: "memory")
#define PG8_WAIT_L(n) asm volatile("s_waitcnt lgkmcnt(" #n ")" ::: "memory")
#define PG8_BAR __builtin_amdgcn_s_barrier()
#define PG8_SCHED __builtin_amdgcn_sched_barrier(0)
    Unit cur, nxt; int ui = 0;
    if (!S.next(0, cur)) return;
    f32x4 acc[2][2][4][2];
#pragma unroll
    for (int a = 0; a < 2; ++a)
#pragma unroll
        for (int b = 0; b < 2; ++b)
#pragma unroll
            for (int m = 0; m < 4; ++m)
#pragma unroll
                for (int n = 0; n < 2; ++n) acc[a][b][m][n] = (f32x4){0.f, 0.f, 0.f, 0.f};
    bf16x8 At[4][2], B0[2][2], B1[2][2];
    const char* cA = S.pa(cur); const char* cB = S.pb(cur);
    PG8_STAGE(PG8_SB(0, 0), cB, voffB); PG8_STAGE(PG8_SA(0, 0), cA, voffA); PG8_STAGE(PG8_SB(0, 1), cB + hstepB, voffB); PG8_STAGE(PG8_SA(0, 1), cA + hstepA, voffA);
    if (wr == 1) PG8_BAR;
    PG8_WAIT_V(4); PG8_BAR;
    PG8_STAGE(PG8_SB(1, 0), cB + kstep, voffB); PG8_STAGE(PG8_SA(1, 0), cA + kstep, voffA); PG8_STAGE(PG8_SB(1, 1), cB + hstepB + kstep, voffB);
    PG8_WAIT_V(6); PG8_BAR;
    for (;;) {
        const bool has_next = S.next(ui + 1, nxt);
        const char* nA = has_next ? S.pa(nxt) : cA; const char* nB = has_next ? S.pb(nxt) : cB;
        for (int t = 0; t < nt; t += 2) {
            const bool last = (t == nt - 2);
            const char* a1 = cA + (size_t)(t + 1) * kstep;
            const char* a2 = last ? nA : cA + (size_t)(t + 2) * kstep; const char* b2 = last ? nB : cB + (size_t)(t + 2) * kstep;
            const char* a3 = a2 + kstep; const char* b3 = b2 + kstep;
            PG8_LDB(B0, 0, 0); PG8_SCHED; PG8_LDA(At, 0, 0); PG8_STAGE(PG8_SA(1, 1), a1 + hstepA, voffA);
            PG8_WAIT_L(8); PG8_BAR; PG8_WAIT_L(0); PG8_MMA(0, 0, At, B0); PG8_BAR; PG8_SCHED;
            PG8_LDB(B1, 0, 1); PG8_STAGE(PG8_SB(0, 0), b2, voffB);
            PG8_BAR; PG8_WAIT_L(0); PG8_MMA(0, 1, At, B1); PG8_BAR;
            PG8_LDA(At, 0, 1); PG8_STAGE(PG8_SA(0, 0), a2, voffA);
            PG8_BAR; PG8_WAIT_L(0); PG8_MMA(1, 0, At, B0); PG8_BAR; PG8_SCHED;
            PG8_STAGE(PG8_SB(0, 1), b2 + hstepB, voffB);
            PG8_WAIT_V(6); PG8_BAR; PG8_MMA(1, 1, At, B1); PG8_BAR;
            PG8_LDB(B0, 1, 0); PG8_SCHED; PG8_LDA(At, 1, 0); PG8_STAGE(PG8_SA(0, 1), a2 + hstepA, voffA);
            PG8_WAIT_L(8); PG8_BAR; PG8_WAIT_L(0); PG8_MMA(0, 0, At, B0); PG8_BAR; PG8_SCHED;
            PG8_LDB(B1, 1, 1); PG8_STAGE(PG8_SB(1, 0), b3, voffB);
            PG8_BAR; PG8_WAIT_L(0); PG8_MMA(0, 1, At, B1); PG8_BAR;
            PG8_LDA(At, 1, 1); PG8_STAGE(PG8_SA(1, 0), a3, voffA);
            PG8_BAR; PG8_WAIT_L(0); PG8_MMA(1, 0, At, B0); PG8_BAR; PG8_SCHED;
            PG8_STAGE(PG8_SB(1, 1), b3 + hstepB, voffB);
            PG8_WAIT_V(6); PG8_BAR; PG8_MMA(1, 1, At, B1); PG8_BAR;
        }
        { int frE = fr, fqE = fq; asm volatile("" : "+v"(frE), "+v"(fqE)); E(acc, cur, wr, wc, frE, fqE); }
        if (!has_next) break;
#pragma unroll
        for (int a = 0; a < 2; ++a)
#pragma unroll
            for (int b = 0; b < 2; ++b)
#pragma unroll
                for (int m = 0; m < 4; ++m)
#pragma unroll
                    for (int n = 0; n < 2; ++n) acc[a][b][m][n] = (f32x4){0.f, 0.f, 0.f, 0.f};
        cur = nxt; cA = nA; cB = nB; ++ui;
    }
    PG8_WAIT_V(0);
    if (wr == 0) PG8_BAR;
    PG8_BAR;
#undef PG8_SA
#undef PG8_SB
#undef PG8_STAGE
#undef PG8_LDA
#undef PG8_LDB
#undef PG8_MMA
#undef PG8_WAIT_V
#undef PG8_WAIT_L
#undef PG8_BAR
#undef PG8_SCHED
}

#define EPI_LOOP_ROWS _Pragma("unroll") for (int ai = 0; ai < 2; ++ai) _Pragma("unroll") for (int m = 0; m < 4; ++m)
__device__ __forceinline__ void st_bf16x8(bf16_t* p, f32x4 v0, f32x4 v1) { u32x4 w; w.x = cvtpk(v0[0], v0[1]); w.y = cvtpk(v0[2], v0[3]); w.z = cvtpk(v1[0], v1[1]); w.w = cvtpk(v1[2], v1[3]); *(u32x4*)p = w; }

struct EpiInProj {
    bf16_t* qa; bf16_t* qidx; bf16_t* qkv; bf16_t* gates; float* small_;
    __device__ __forceinline__ void operator()(const f32x4 (&acc)[2][2][4][2], const Unit& u, int wr, int wc, int fr, int fq) const {
        const int pn = u.pn, row0 = u.pm * BM + wr * 64 + fr, lc0 = wc * 32 + fq * 8;
        if (pn < 8) {
            bf16_t* base = (pn < 4 ? qa + pn * 256 : qidx + (pn - 4) * 256) + lc0;
            EPI_LOOP_ROWS { const int row = row0 + ai * HALF + m * 16;
#pragma unroll
                for (int bj = 0; bj < 2; ++bj) st_bf16x8(base + (size_t)row * 1024 + bj * HALF, acc[ai][bj][m][0], acc[ai][bj][m][1]); }
        } else if (pn < 32) {
            const int id = (pn - 8) >> 2, hb = ((pn - 8) & 3) * 2, b = u.pm >> 5;
            bf16_t* base = qkv + (size_t)id * ((size_t)NTOK * 1024) + lc0;
            EPI_LOOP_ROWS { const int row = row0 + ai * HALF + m * 16, s = row & (SEQ - 1);
#pragma unroll
                for (int bj = 0; bj < 2; ++bj) st_bf16x8(base + ((size_t)(b * 8 + hb + bj) * SEQ + s) * 128, acc[ai][bj][m][0], acc[ai][bj][m][1]); }
        } else if (pn < 56) {
            bf16_t* base = gates + (pn - 32) * 256 + lc0;
            EPI_LOOP_ROWS { const int row = row0 + ai * HALF + m * 16;
#pragma unroll
                for (int bj = 0; bj < 2; ++bj) st_bf16x8(base + (size_t)row * 6144 + bj * HALF, acc[ai][bj][m][0], acc[ai][bj][m][1]); }
        } else {
            float* base = small_ + (pn - 56) * 256 + lc0;
            EPI_LOOP_ROWS { const int row = row0 + ai * HALF + m * 16;
#pragma unroll
                for (int bj = 0; bj < 2; ++bj) { float* p = base + (size_t)row * 512 + bj * HALF; *(f32x4*)p = acc[ai][bj][m][0]; *(f32x4*)(p + 4) = acc[ai][bj][m][1]; } }
        }
    }
};
struct EpiBf16 {
    bf16_t* out; int ld, cstep;
    __device__ __forceinline__ void operator()(const f32x4 (&acc)[2][2][4][2], const Unit& u, int wr, int wc, int fr, int fq) const {
        const int row0 = u.pm * BM + wr * 64 + fr; bf16_t* base = out + (size_t)u.pn * cstep + wc * 32 + fq * 8;
        EPI_LOOP_ROWS { const int row = row0 + ai * HALF + m * 16;
#pragma unroll
            for (int bj = 0; bj < 2; ++bj) st_bf16x8(base + (size_t)row * ld + bj * HALF, acc[ai][bj][m][0], acc[ai][bj][m][1]); }
    }
};
template <int MODE> struct EpiBranch {
    const bf16_t* gates; float* tmp; bf16_t* merged; int br;
    __device__ __forceinline__ void operator()(const f32x4 (&acc)[2][2][4][2], const Unit& u, int wr, int wc, int fr, int fq) const {
        const int row0 = u.pm * BM + wr * 64 + fr, col0 = u.pn * BM + wc * 32 + fq * 8;
        EPI_LOOP_ROWS { const int row = row0 + ai * HALF + m * 16;
#pragma unroll
            for (int bj = 0; bj < 2; ++bj) { const int col = col0 + bj * HALF;
                const u32x4 gw = *(const u32x4*)(gates + (size_t)row * 6144 + br * 2048 + col);
                f32x4 v0 = acc[ai][bj][m][0], v1 = acc[ai][bj][m][1];
                v0[0] *= sigmoidf_(bflo(gw.x)); v0[1] *= sigmoidf_(bfhi(gw.x)); v0[2] *= sigmoidf_(bflo(gw.y)); v0[3] *= sigmoidf_(bfhi(gw.y));
                v1[0] *= sigmoidf_(bflo(gw.z)); v1[1] *= sigmoidf_(bfhi(gw.z)); v1[2] *= sigmoidf_(bflo(gw.w)); v1[3] *= sigmoidf_(bfhi(gw.w));
                float* tp = tmp + (size_t)row * 2048 + col;
                if (MODE >= 1) { v0 += *(const f32x4*)tp; v1 += *(const f32x4*)(tp + 4); }
                if (MODE <= 1) { *(f32x4*)tp = v0; *(f32x4*)(tp + 4) = v1; }
                else st_bf16x8(merged + (size_t)row * 2048 + col, v0, v1); } }
    }
};
struct EpiOut {
    const float* res; float* pre;
    __device__ __forceinline__ void operator()(const f32x4 (&acc)[2][2][4][2], const Unit& u, int wr, int wc, int fr, int fq) const {
        const int row0 = u.pm * BM + wr * 64 + fr, col0 = u.pn * BM + wc * 32 + fq * 8;
        EPI_LOOP_ROWS { const int row = row0 + ai * HALF + m * 16;
#pragma unroll
            for (int bj = 0; bj < 2; ++bj) { const size_t o = (size_t)row * 2048 + col0 + bj * HALF;
                const f32x4 r0 = *(const f32x4*)(res + o), r1 = *(const f32x4*)(res + o + 4);
                *(f32x4*)(pre + o) = r0 * ALPHA + acc[ai][bj][m][0]; *(f32x4*)(pre + o + 4) = r1 * ALPHA + acc[ai][bj][m][1]; } }
    }
};
struct EpiGateUp {
    const float* bg; const float* bu; bf16_t* hid;
    __device__ __forceinline__ void operator()(const f32x4 (&acc)[2][2][4][2], const Unit& u, int wr, int wc, int fr, int fq) const {
        const int row0 = u.pm * BM + wr * 64 + fr, j0 = u.pn * 128 + wc * 32 + fq * 8;
        const float* pg = bg + (size_t)u.e * DEXP + j0; const float* pu = bu + (size_t)u.e * DEXP + j0;
        const f32x4 g0b = *(const f32x4*)pg, g1b = *(const f32x4*)(pg + 4), u0b = *(const f32x4*)pu, u1b = *(const f32x4*)(pu + 4);
        EPI_LOOP_ROWS { const int row = row0 + ai * HALF + m * 16;
            f32x4 h0, h1;
#pragma unroll
            for (int j = 0; j < 4; ++j) {
                float g = fminf(acc[ai][0][m][0][j] + g0b[j], 7.0f), uu = fminf(fmaxf(acc[ai][1][m][0][j] + u0b[j], -7.0f), 7.0f);
                h0[j] = (uu + 1.0f) * (g * sigmoidf_(1.702f * g));
                g = fminf(acc[ai][0][m][1][j] + g1b[j], 7.0f); uu = fminf(fmaxf(acc[ai][1][m][1][j] + u1b[j], -7.0f), 7.0f);
                h1[j] = (uu + 1.0f) * (g * sigmoidf_(1.702f * g)); }
            st_bf16x8(hid + (size_t)row * DEXP + j0, h0, h1); }
    }
};
struct EpiDown {
    const float* bd; const float* roww; bf16_t* ys;
    __device__ __forceinline__ void operator()(const f32x4 (&acc)[2][2][4][2], const Unit& u, int wr, int wc, int fr, int fq) const {
        const int row0 = u.pm * BM + wr * 64 + fr, col0 = u.pn * BM + wc * 32 + fq * 8;
        f32x4 b[2][2];
#pragma unroll
        for (int bj = 0; bj < 2; ++bj) { const float* p = bd + (size_t)u.e * DM + col0 + bj * HALF; b[bj][0] = *(const f32x4*)p; b[bj][1] = *(const f32x4*)(p + 4); }
        EPI_LOOP_ROWS { const int row = row0 + ai * HALF + m * 16; const float w = roww[row];
#pragma unroll
            for (int bj = 0; bj < 2; ++bj) st_bf16x8(ys + (size_t)row * 2048 + col0 + bj * HALF, (acc[ai][bj][m][0] + b[bj][0]) * w, (acc[ai][bj][m][1] + b[bj][1]) * w); }
    }
};
struct EpiPleGate {
    const float* hf; const bf16_t* pp; float* pre;
    __device__ __forceinline__ void operator()(const f32x4 (&acc)[2][2][4][2], const Unit& u, int wr, int wc, int fr, int fq) const {
        const int row0 = u.pm * BM + wr * 64 + fr, col0 = u.pn * BM + wc * 32 + fq * 8;
        EPI_LOOP_ROWS { const int row = row0 + ai * HALF + m * 16;
#pragma unroll
            for (int bj = 0; bj < 2; ++bj) { const size_t o = (size_t)row * 2048 + col0 + bj * HALF;
                const u32x4 pw = *(const u32x4*)(pp + o); const f32x4 h0 = *(const f32x4*)(hf + o), h1 = *(const f32x4*)(hf + o + 4);
                const f32x4 a0 = acc[ai][bj][m][0], a1 = acc[ai][bj][m][1]; f32x4 o0, o1;
                o0[0] = h0[0] + sigmoidf_(a0[0]) * bflo(pw.x); o0[1] = h0[1] + sigmoidf_(a0[1]) * bfhi(pw.x); o0[2] = h0[2] + sigmoidf_(a0[2]) * bflo(pw.y); o0[3] = h0[3] + sigmoidf_(a0[3]) * bfhi(pw.y);
                o1[0] = h1[0] + sigmoidf_(a1[0]) * bflo(pw.z); o1[1] = h1[1] + sigmoidf_(a1[1]) * bfhi(pw.z); o1[2] = h1[2] + sigmoidf_(a1[2]) * bflo(pw.w); o1[3] = h1[3] + sigmoidf_(a1[3]) * bfhi(pw.w);
                *(f32x4*)(pre + o) = o0; *(f32x4*)(pre + o + 4) = o1; } }
    }
};
}

struct Params { const float* in[25]; float* out; unsigned char* ws; int ph_lo, ph_hi; };
__constant__ float c_invf_r[16] = {1.000000000e+00f, 4.403665960e-01f, 1.939227432e-01f, 8.539710194e-02f, 3.760603070e-02f, 1.656043902e-02f, 7.292664610e-03f, 3.211445874e-03f, 1.414213562e-03f, 6.227723788e-04f, 2.742481884e-04f, 1.207697351e-04f, 5.318296098e-05f, 2.341999971e-05f, 1.031338616e-05f, 4.541670478e-06f};
__constant__ float c_invf_i[8] = {1.000000000e+00f, 1.939227432e-01f, 3.760603070e-02f, 7.292664610e-03f, 1.414213562e-03f, 2.742481884e-04f, 5.318296098e-05f, 1.031338616e-05f};
constexpr int LDS_PTRS = LDS_MISC + 256;
struct Frame { unsigned char* lds; LAS unsigned char* ldsl; unsigned char* ws; int tid, lane, wid, G, bid;
    __device__ __forceinline__ const float* in(int k) const { const LAS unsigned* t = (const LAS unsigned*)(ldsl + LDS_PTRS) + 2 * k;
        const unsigned lo = __builtin_amdgcn_readfirstlane(t[0]), hi = __builtin_amdgcn_readfirstlane(t[1]); return (const float*)(((unsigned long long)hi << 32) | lo); }
    __device__ __forceinline__ float* out() const { return (float*)in(25); } };
__device__ __forceinline__ Frame fresh(const Frame& F0) { Frame F = F0; int t = threadIdx.x; asm volatile("" : "+v"(t)); F.tid = t; F.lane = t & 63; F.wid = __builtin_amdgcn_readfirstlane(t >> 6); unsigned char* w = F0.ws; asm volatile("" : "+s"(w)); F.ws = w; return F; }

__device__ __forceinline__ void tconv(const Frame& F, const float* src, long src_ld, int K, int ncols, bf16_t* dst, long dst_ld, int& rot) {
    float* tile = (float*)F.lds;
    const int tk = K >> 6, tn = (ncols + 63) >> 6, total = tk * tn, tid = F.tid;
    int start = (F.bid - (rot % F.G) + F.G) % F.G; rot += total;
    const int lr = tid >> 4, lc4 = (tid & 15) * 4, sn = tid >> 3, skc = (tid & 7) * 8;
    for (int t0 = start; t0 < total; t0 += 4 * F.G) {
#pragma unroll
        for (int q = 0; q < 4; ++q) { const int t = t0 + q * F.G;
            if (t < total) { const int k0 = (t % tk) * 64, n0 = (t / tk) * 64; float* tl = tile + q * (64 * 65);
#pragma unroll
                for (int h = 0; h < 2; ++h) { const int k = k0 + lr + 32 * h, col = n0 + lc4;
                    f32x4 v = (f32x4){0.f, 0.f, 0.f, 0.f}; if (col < ncols) v = *(const f32x4*)(src + (size_t)k * src_ld + col);
                    float* p = tl + (lr + 32 * h) * 65 + lc4; p[0] = v[0]; p[1] = v[1]; p[2] = v[2]; p[3] = v[3]; } } }
        __syncthreads();
#pragma unroll
        for (int q = 0; q < 4; ++q) { const int t = t0 + q * F.G;
            if (t < total) { const int k0 = (t % tk) * 64, n0 = (t / tk) * 64; const float* tl = tile + q * (64 * 65);
                if (n0 + sn < ncols) { f32x4 a, b;
#pragma unroll
                    for (int j = 0; j < 4; ++j) { a[j] = tl[(skc + j) * 65 + sn]; b[j] = tl[(skc + 4 + j) * 65 + sn]; }
                    pg8::st_bf16x8(dst + (size_t)(n0 + sn) * dst_ld + k0 + skc, a, b); } } }
        __syncthreads();
    }
}
__device__ __forceinline__ void conv_rows(const Frame& F, const float* src, bf16_t* dst, size_t n8) {
    for (size_t i = (size_t)F.bid * 512 + F.tid; i < n8; i += (size_t)F.G * 512) { const f32x4 a = *(const f32x4*)(src + i * 8), b = *(const f32x4*)(src + i * 8 + 4); pg8::st_bf16x8(dst + i * 8, a, b); }
}
__constant__ int c_so[14] = {0, 1312, 2416, 3440, 4464, 5496, 6520, 7544, 8568, 1024, 1280, 2336, 2400, 5488};
__constant__ int c_dn[14] = {0, 1024, 2048, 3072, 4096, 5120, 6144, 7168, 8192, 14336, 14592, 14624, 14688, 14704};
__constant__ int c_nc[14] = {1024, 1024, 1024, 1024, 1024, 1024, 1024, 1024, 6144, 256, 32, 64, 16, 8};
__device__ __forceinline__ void convert_layer_weights(const Frame& F0, const Params& P, int l) { const Frame F = fresh(F0);
    unsigned char* ws = F.ws; int rot = 0;
    { const float* w = F.in(2) + (size_t)l * DM * INW; bf16_t* d = (bf16_t*)(ws + W_IN);
#pragma unroll 1
      for (int s = 0; s < 14; ++s) tconv(F, w + c_so[s], INW, DM, c_nc[s], d + (size_t)c_dn[s] * DM, DM, rot); }
    tconv(F, F.in(7) + (size_t)l * 1024 * DM, DM, 1024, DM, (bf16_t*)(ws + W_BRA), 1024, rot);
    tconv(F, F.in(8) + (size_t)l * 1024 * DM, DM, 1024, DM, (bf16_t*)(ws + W_BRB), 1024, rot);
    tconv(F, F.in(9) + (size_t)l * 1024 * DM, DM, 1024, DM, (bf16_t*)(ws + W_BRC), 1024, rot);
    tconv(F, F.in(10) + (size_t)l * DM * DM, DM, DM, DM, (bf16_t*)(ws + W_OUT), DM, rot);
    tconv(F, F.in(21) + (size_t)l * DM * DM, DM, DM, DM, (bf16_t*)(ws + W_PG), DM, rot);
    tconv(F, F.in(22) + (size_t)l * 256 * DM, DM, 256, DM, (bf16_t*)(ws + W_PLE), 256, rot);
#pragma unroll 1
    for (int h = 0; h < 8; ++h) tconv(F, F.in(6) + (size_t)l * 256 * 1024 + h * 128, 1024, 256, 128, (bf16_t*)(ws + W_UV2) + ((size_t)(h >> 1) * 256 + (h & 1) * 128) * 512 + (h & 1) * 256, 512, rot);
#pragma unroll 1
    for (int e = 0; e < NEXP; ++e) {
        const float* wg = F.in(15) + ((size_t)l * NEXP + e) * DM * DEXP; const float* wu = F.in(17) + ((size_t)l * NEXP + e) * DM * DEXP;
        bf16_t* d = (bf16_t*)(ws + W_GU) + (size_t)e * 2048 * 2048;
#pragma unroll 1
        for (int jb = 0; jb < 8; ++jb) { tconv(F, wg + jb * 128, DEXP, DM, 128, d + (size_t)(jb * 256) * 2048, 2048, rot); tconv(F, wu + jb * 128, DEXP, DM, 128, d + (size_t)(jb * 256 + 128) * 2048, 2048, rot); }
        tconv(F, F.in(19) + ((size_t)l * NEXP + e) * DEXP * DM, DM, DEXP, DM, (bf16_t*)(ws + W_DN) + (size_t)e * 2048 * 1024, 1024, rot);
    }
    { const float* w = F.in(5) + (size_t)l * 256 * 8 * 96; bf16_t* d = (bf16_t*)(ws + W_UK2);
      for (int i = F.bid * 512 + F.tid; i < 256 * 8 * 96; i += F.G * 512) { const int n = i % 96, h = (i / 96) & 7, r = i / 768; d[((size_t)h * 256 + r) * 256 + (h & 1) * 128 + 32 + n] = f2bf(w[i]); } }
}

__device__ __forceinline__ void rope_cs(float pos, float invf, float& c, float& s) {
    const float a = pos * invf; const double ad = (double)a * 0.15915494309189535; const float fr = (float)(ad - rint(ad));
    s = __builtin_amdgcn_sinf(fr); c = __builtin_amdgcn_cosf(fr);
}
__device__ __forceinline__ void phase_prep(const Frame& F0, const Params& P, int l) { const Frame F = fresh(F0);
    unsigned char* ws = F.ws; const int lane = F.lane;
    const float* smallb = (const float*)(ws + R_SMALL); bf16_t* kcat = (bf16_t*)(ws + R_KCAT); bf16_t* qcat = (bf16_t*)(ws + R_QCAT);
    bf16_t* ki = (bf16_t*)(ws + R_KI); float* wi = (float*)(ws + R_WI); float* lf = (float*)(ws + WS_LF);
    const bf16_t* qa = (const bf16_t*)(ws + R_QA); bf16_t* qidx = (bf16_t*)(ws + R_QIDX);
    const f32x4 gck = *(const f32x4*)(F.in(4) + l * 256 + lane * 4);
    const float bfo = lane < 8 ? F.in(3)[l * 8 + lane] : 0.f;
    const float ifr = c_invf_r[lane & 15], ifi = c_invf_i[lane & 7];
    for (int tok = F.bid * 8 + F.wid; tok < NTOK; tok += F.G * 8) {
        const int s = tok & (SEQ - 1), b = tok >> 13; const float* sm = smallb + (size_t)tok * 512;
        float cr, sr, ci, si; rope_cs((float)s, ifr, cr, sr); rope_cs((float)s, ifi, ci, si);
        { const f32x4 v = *(const f32x4*)(sm + lane * 4); float ss = v[0] * v[0] + v[1] * v[1] + v[2] * v[2] + v[3] * v[3]; ss = wave_sum(ss);
          const float rs = rsqrtf(ss * (1.0f / 256.0f) + 1e-6f); u32x2 w; w.x = cvtpk(v[0] * rs * gck[0], v[1] * rs * gck[1]); w.y = cvtpk(v[2] * rs * gck[2], v[3] * rs * gck[3]);
          *(u32x2*)(kcat + (size_t)tok * 288 + lane * 4) = w; }
        if (lane < 16) { const float x1 = sm[256 + lane], x2 = sm[272 + lane]; kcat[(size_t)tok * 288 + 256 + lane] = f2bf(x1 * cr - x2 * sr); kcat[(size_t)tok * 288 + 272 + lane] = f2bf(x2 * cr + x1 * sr); }
        { float o = sm[288 + lane];
          if (lane < 8) { const float x2 = sm[296 + lane]; o = o * ci - x2 * si; } else if (lane < 16) { const float x1 = sm[288 + lane - 8]; o = o * ci + x1 * si; }
          ki[(size_t)tok * 64 + lane] = f2bf(o); }
        if (lane < 16) wi[(size_t)tok * 16 + lane] = sm[352 + lane] * (1.0f / 32.0f);
        if (lane < 8) { const float f = sm[368 + lane] + bfo; lf[(size_t)(b * 8 + lane) * SEQ + s] = fminf(f, 0.f) - log1pf(__expf(-fabsf(f))); }
#pragma unroll
        for (int pp = 0; pp < 2; ++pp) { const int p = lane + 64 * pp, h = p >> 4, i = p & 15;
            const float x1 = bf2f(qa[(size_t)tok * 1024 + h * 128 + i]), x2 = bf2f(qa[(size_t)tok * 1024 + h * 128 + 16 + i]);
            qcat[(size_t)tok * 2304 + h * 288 + 256 + i] = f2bf(x1 * cr - x2 * sr); qcat[(size_t)tok * 2304 + h * 288 + 272 + i] = f2bf(x2 * cr + x1 * sr); }
#pragma unroll
        for (int pp = 0; pp < 2; ++pp) { const int p = lane + 64 * pp, hh = p >> 3, i = p & 7; bf16_t* q = qidx + (size_t)tok * 1024 + hh * 64;
            const float x1 = bf2f(q[i]), x2 = bf2f(q[8 + i]); q[i] = f2bf(x1 * ci - x2 * si); q[8 + i] = f2bf(x2 * ci + x1 * si); }
    }
    { const bf16_t* kbt = (const bf16_t*)(ws + R_QKV) + (size_t)NTOK * 1024; unsigned* kmx = (unsigned*)(ws + WS_CTL) + CW_KMAX + l * 16;
#pragma unroll 1
      for (int bh = 0; bh < 16; ++bh) { float mx = 0.f;
          for (int r0 = (F.bid * 8 + F.wid) * 4; r0 < SEQ; r0 += F.G * 32) {
              const u32x4 w = *(const u32x4*)(kbt + ((size_t)bh * SEQ + r0 + (lane >> 4)) * 128 + (lane & 15) * 8);
              float ss = bflo(w.x) * bflo(w.x) + bfhi(w.x) * bfhi(w.x) + bflo(w.y) * bflo(w.y) + bfhi(w.y) * bfhi(w.y) + bflo(w.z) * bflo(w.z) + bfhi(w.z) * bfhi(w.z) + bflo(w.w) * bflo(w.w) + bfhi(w.w) * bfhi(w.w);
              ss += __shfl_xor(ss, 1); ss += __shfl_xor(ss, 2); ss += __shfl_xor(ss, 4); ss += __shfl_xor(ss, 8); mx = fmaxf(mx, ss); }
          mx = fmaxf(mx, __shfl_xor(mx, 16)); mx = fmaxf(mx, __shfl_xor(mx, 32));
          if (lane == 0) ((float*)F.lds)[F.wid * 16 + bh] = mx; }
      __syncthreads();
      if (F.tid < 16) { float mx = 0.f;
#pragma unroll
          for (int w = 0; w < 8; ++w) mx = fmaxf(mx, ((const float*)F.lds)[w * 16 + F.tid]);
          const unsigned bits = __float_as_uint(mx);
          if (bits > __hip_atomic_load(&kmx[F.tid], __ATOMIC_RELAXED, __HIP_MEMORY_SCOPE_AGENT)) atomicMax(&kmx[F.tid], bits); }
      __syncthreads(); }
}
__device__ __forceinline__ void phase_cumsum(const Frame& F0) { const Frame F = fresh(F0);
    const int gw = F.bid * 8 + F.wid; if (gw >= 16) return;
    const float* lf = (const float*)(F.ws + WS_LF) + (size_t)gw * SEQ; float* cum = (float*)(F.ws + WS_CUM) + (size_t)gw * SEQ;
    const int lane = F.lane; double tot = 0.0;
    for (int j = 0; j < 128; ++j) tot += (double)lf[lane * 128 + j];
    double inc = tot;
    for (int o = 1; o < 64; o <<= 1) { const double n = __shfl_up(inc, o); if (lane >= o) inc += n; }
    double run = inc - tot;
    for (int j = 0; j < 128; ++j) { run += (double)lf[lane * 128 + j]; cum[lane * 128 + j] = (float)run; }
}

__device__ __forceinline__ void idx_group(const Frame& F, int b, int g) {
    const int lane = F.lane, rho = lane & 31, hh = lane >> 5; unsigned char* ws = F.ws;
    const bf16_t* qidx = (const bf16_t*)(ws + R_QIDX); const bf16_t* ki = (const bf16_t*)(ws + R_KI) + (size_t)b * SEQ * 64; const float* wi = (const float*)(ws + R_WI);
    float* scores = (float*)(ws + R_SCORES) + (size_t)b * SEQ * SEQ;
    const int t0 = g * 4;
    bf16x8 af[2][4]; float wv[2][16];
#pragma unroll
    for (int mt = 0; mt < 2; ++mt) {
        const int tokA = b * SEQ + t0 + 2 * mt + ((rho >> 2) & 1), head = (rho & 3) + 4 * (rho >> 3);
#pragma unroll
        for (int kk = 0; kk < 4; ++kk) af[mt][kk] = *(const bf16x8*)(qidx + (size_t)tokA * 1024 + head * 64 + kk * 16 + 8 * hh);
        const float* wp = wi + (size_t)(b * SEQ + t0 + 2 * mt + hh) * 16;
#pragma unroll
        for (int q = 0; q < 4; ++q) { const f32x4 v = *(const f32x4*)(wp + 4 * q); wv[mt][4 * q] = v[0]; wv[mt][4 * q + 1] = v[1]; wv[mt][4 * q + 2] = v[2]; wv[mt][4 * q + 3] = v[3]; }
    }
    const int ntile = (t0 + 3) / 32 + 1;
    bf16x8 bc[4], bn[4];
#pragma unroll
    for (int kk = 0; kk < 4; ++kk) bc[kk] = *(const bf16x8*)(ki + (size_t)rho * 64 + kk * 16 + 8 * hh);
    for (int tl = 0; tl < ntile; ++tl) {
        const int kb = tl * 32, kbn = (tl + 1 < ntile) ? kb + 32 : kb;
#pragma unroll
        for (int kk = 0; kk < 4; ++kk) bn[kk] = *(const bf16x8*)(ki + (size_t)(kbn + rho) * 64 + kk * 16 + 8 * hh);
#pragma unroll
        for (int mt = 0; mt < 2; ++mt) {
            f32x16 acc = {};
#pragma unroll
            for (int kk = 0; kk < 4; ++kk) acc = __builtin_amdgcn_mfma_f32_32x32x16_bf16(af[mt][kk], bc[kk], acc, 0, 0, 0);
            float sc = 0.f;
#pragma unroll
            for (int r = 0; r < 16; ++r) sc = fmaf(wv[mt][r], fmaxf(acc[r], 0.f), sc);
            scores[(size_t)(t0 + 2 * mt + hh) * SEQ + kb + rho] = sc;
        }
#pragma unroll
        for (int kk = 0; kk < 4; ++kk) bc[kk] = bn[kk];
    }
}
__device__ __forceinline__ void phase_idx(const Frame& F0) { const Frame F = fresh(F0);
    for (int gw = F.bid * 8 + F.wid; gw < 2048; gw += F.G * 8) { const int b = gw >> 10, pr = gw & 1023; idx_group(F, b, pr); idx_group(F, b, 2047 - pr); }
}

__device__ __forceinline__ unsigned sortable(float f) { const unsigned u = __float_as_uint(f); return (u & 0x80000000u) ? ~u : (u | 0x80000000u); }
__device__ __forceinline__ void topk_row(const Frame& F, int b, int t) {
    const int lane = F.lane, L = t + 1, tok = b * SEQ + t; unsigned char* ws = F.ws;
    int* sel = (int*)(ws + R_SEL) + (size_t)tok * 256; int* nsel = (int*)(ws + R_NSEL);
    if (lane == 0) nsel[tok] = L < 256 ? L : 256;
    if (L <= 256) { for (int j = lane; j < 256; j += 64) sel[j] = j < L ? j : 0; return; }
    const float* row = (const float*)(ws + R_SCORES) + ((size_t)b * SEQ + t) * SEQ;
    const int nch = (L + 1023) >> 10;
    unsigned u[128];
#pragma unroll
    for (int c = 0; c < 8; ++c) {
        if (c < nch) {
#pragma unroll
            for (int jj = 0; jj < 4; ++jj) { const int j = c * 4 + jj; const f32x4 v = *(const f32x4*)(row + j * 256 + lane * 4);
#pragma unroll
                for (int e = 0; e < 4; ++e) { const int idx = j * 256 + lane * 4 + e; u[j * 4 + e] = idx < L ? sortable(v[e]) : 0u; } }
        } else {
#pragma unroll
            for (int q = 0; q < 16; ++q) u[c * 16 + q] = 0u;
        }
    }
    unsigned T = 0u, thr_gt = 0u; int need_eq = 0; bool early = false;
    for (int bit = 31; bit >= 0; --bit) {
        const unsigned cand = T | (1u << bit); int cnt = 0;
#pragma unroll
        for (int c = 0; c < 8; ++c) if (c < nch) {
#pragma unroll
            for (int q = 0; q < 16; ++q) cnt += __popcll(__ballot(u[c * 16 + q] >= cand)); }
        if (cnt >= 256) { T = cand; if (cnt == 256) { early = true; break; } }
    }
    if (early) { thr_gt = T - 1u; need_eq = 0; }
    else { int gtc = 0;
#pragma unroll
        for (int c = 0; c < 8; ++c) if (c < nch) {
#pragma unroll
            for (int q = 0; q < 16; ++q) gtc += __popcll(__ballot(u[c * 16 + q] > T)); }
        thr_gt = T; need_eq = 256 - gtc; }
    int base = 0, eq_taken = 0;
#pragma unroll
    for (int c = 0; c < 8; ++c) if (c < nch) {
#pragma unroll
        for (int q = 0; q < 16; ++q) { const int rq = c * 16 + q; const unsigned v = u[rq];
            const bool iseq = (v == thr_gt) && (need_eq > 0);
            const unsigned long long meq = __ballot(iseq);
            const int eqr = __popcll(meq & ((1ull << lane) - 1ull));
            const bool take = (v > thr_gt) || (iseq && (eq_taken + eqr < need_eq));
            const unsigned long long mt = __ballot(take);
            const int pos = base + __popcll(mt & ((1ull << lane) - 1ull));
            if (take && pos < 256) sel[pos] = (rq >> 2) * 256 + lane * 4 + (rq & 3);
            base += __popcll(mt); eq_taken += __popcll(meq); } }
}
__device__ __forceinline__ void phase_topk(const Frame& F0) { const Frame F = fresh(F0);
    for (int q = F.bid * 8 + F.wid; q < 8192; q += F.G * 8) { const int b = q >> 12, p = q & 4095; topk_row(F, b, p); topk_row(F, b, SEQ - 1 - p); }
}

namespace att {
constexpr int D = 128, KVBLK = 64, QBLK = 32, SHM_V = 16384, SHM_K = 16384;
constexpr int OFF_K = 2 * SHM_V, OFF_BIAS = 2 * SHM_V + 2 * SHM_K, OFF_WS = OFF_BIAS + 512, OFF_FLAGS = OFF_WS + 2048, OFF_QITEM = OFF_FLAGS + 64;
constexpr float EXIT_T = 64.0f;
#define KSWZ(row, colB) ((row) * 256 + ((colB) ^ (((row) & 7) << 4)))
__device__ __forceinline__ int v_st(int k, int c) { const int kk = (k & ~0xC) | ((k & 4) << 1) | ((k & 8) >> 1); return ((kk >> 3) * 4 + (c >> 5)) * 512 + ((kk & 7) * 32 + (c & 31)) * 2; }
__device__ __forceinline__ int v_rd_base(int lane) { return ((lane & 3) << 3) | (((lane >> 2) & 3) << 6) | (((lane >> 4) & 1) << 5) | (((lane >> 5) & 1) << 8); }
constexpr int v_rd_off(int d0, int ks, int half) { return d0 * 512 + ks * 4096 + half * 2048; }
template <int KB>
__device__ __forceinline__ void qkt(f32x16& p0, f32x16& p1, const char* K_lds, int r32, int hi, const bf16x8* qr) {
    p0 = f32x16{}; p1 = f32x16{};
    const char* kb[4];
#pragma unroll
    for (int dd = 0; dd < 4; ++dd) kb[dd] = K_lds + KB * SHM_K + KSWZ(r32, (dd * 16 + hi * 8) * 2);
#pragma unroll
    for (int d0 = 0; d0 < 8; ++d0) { const char* a = kb[d0 & 3] + (d0 >> 2) * 128;
        bf16x8 b0 = *reinterpret_cast<const bf16x8*>(a);
        bf16x8 b1 = *reinterpret_cast<const bf16x8*>(a + 32 * 256);
        p0 = __builtin_amdgcn_mfma_f32_32x32x16_bf16(b0, qr[d0], p0, 0, 0, 0);
        p1 = __builtin_amdgcn_mfma_f32_32x32x16_bf16(b1, qr[d0], p1, 0, 0, 0); }
}
template <int VB>
__device__ __forceinline__ void pv_tile(f32x16* o, int vb0, bf16x8 pa0, bf16x8 pa1, bf16x8 pa2, bf16x8 pa3) {
#define TRRD(dst, off) asm volatile("ds_read_b64_tr_b16 %0, %1 offset:%2" : "=&v"(dst) : "v"(vb0), "i"(off) : "memory")
#define PV_D0(d0) do { s16x4 l0, l1, l2, l3, h0, h1, h2, h3; constexpr int b_ = VB * SHM_V + v_rd_off(d0, 0, 0); \
        TRRD(l0, b_); TRRD(h0, b_ + 2048); TRRD(l1, b_ + 4096); TRRD(h1, b_ + 6144); TRRD(l2, b_ + 8192); TRRD(h2, b_ + 10240); TRRD(l3, b_ + 12288); TRRD(h3, b_ + 14336); \
        asm volatile("s_waitcnt lgkmcnt(0)" ::: "memory"); SBAR(); \
        o[d0] = __builtin_amdgcn_mfma_f32_32x32x16_bf16(pa0, (bf16x8){l0[0], l0[1], l0[2], l0[3], h0[0], h0[1], h0[2], h0[3]}, o[d0], 0, 0, 0); \
        o[d0] = __builtin_amdgcn_mfma_f32_32x32x16_bf16(pa1, (bf16x8){l1[0], l1[1], l1[2], l1[3], h1[0], h1[1], h1[2], h1[3]}, o[d0], 0, 0, 0); \
        o[d0] = __builtin_amdgcn_mfma_f32_32x32x16_bf16(pa2, (bf16x8){l2[0], l2[1], l2[2], l2[3], h2[0], h2[1], h2[2], h2[3]}, o[d0], 0, 0, 0); \
        o[d0] = __builtin_amdgcn_mfma_f32_32x32x16_bf16(pa3, (bf16x8){l3[0], l3[1], l3[2], l3[3], h3[0], h3[1], h3[2], h3[3]}, o[d0], 0, 0, 0); } while (0)
    PV_D0(0); PV_D0(1); PV_D0(2); PV_D0(3);
#undef PV_D0
#undef TRRD
}
#define PK4(P, B_, OUT) do { unsigned a0 = cvtpk(P[B_+0], P[B_+1]), a1 = cvtpk(P[B_+2], P[B_+3]); \
        unsigned b0 = cvtpk(P[B_+4], P[B_+5]), b1 = cvtpk(P[B_+6], P[B_+7]); \
        auto r0 = __builtin_amdgcn_permlane32_swap(a0, b0, false, false); auto r1 = __builtin_amdgcn_permlane32_swap(a1, b1, false, false); \
        u32x4 w = {r0[0], r1[0], r0[1], r1[1]}; OUT = *reinterpret_cast<bf16x8*>(&w); } while (0)
__device__ __forceinline__ float swap_max(float x) { auto rr = __builtin_amdgcn_permlane32_swap(__float_as_uint(x), __float_as_uint(x), false, false); return fmaxf(__uint_as_float(rr[0]), __uint_as_float(rr[1])); }
__device__ __forceinline__ float swap_sum(float x) { auto rr = __builtin_amdgcn_permlane32_swap(__float_as_uint(x), __float_as_uint(x), false, false); return __uint_as_float(rr[0]) + __uint_as_float(rr[1]); }
__device__ __forceinline__ float swap_lo(float x) { auto rr = __builtin_amdgcn_permlane32_swap(__float_as_uint(x), __float_as_uint(x), false, false); return __uint_as_float(rr[0]); }


__device__ __forceinline__ void fox_sm(f32x16& p0, f32x16& p1, const float* bl, int kb_, int qlo, int qrow, int hi, int r32, float& m_reg, float& l_reg, f32x16* o, float* al_l,
                                       bf16x8& pa0, bf16x8& pa1, bf16x8& pa2, bf16x8& pa3) {
#pragma unroll
    for (int g = 0; g < 4; ++g) { const f32x4 b0v = *(const f32x4*)(bl + 8 * g + 4 * hi), b1v = *(const f32x4*)(bl + 32 + 8 * g + 4 * hi);
#pragma unroll
        for (int i = 0; i < 4; ++i) { p0[4 * g + i] = fmaf(p0[4 * g + i], C2, b0v[i]); p1[4 * g + i] = fmaf(p1[4 * g + i], C2, b1v[i]); } }
    if (kb_ + KVBLK - 1 > qlo) { const float NEG = -__builtin_inff();
#pragma unroll
        for (int r = 0; r < 16; ++r) { const int key = kb_ + crow(r, hi); if (key > qrow) p0[r] = NEG; if (key + 32 > qrow) p1[r] = NEG; } }
    float pmax = p0[0];
#pragma unroll
    for (int r = 1; r < 16; ++r) pmax = fmaxf(pmax, p0[r]);
#pragma unroll
    for (int r = 0; r < 16; ++r) pmax = fmaxf(pmax, p1[r]);
    pmax = swap_max(pmax);
    const float mn = fmaxf(m_reg, pmax), alpha = __builtin_amdgcn_exp2f(m_reg - mn); m_reg = mn;
    float ps = 0.f;
#pragma unroll
    for (int r = 0; r < 16; ++r) { p0[r] = __builtin_amdgcn_exp2f(p0[r] - mn); p1[r] = __builtin_amdgcn_exp2f(p1[r] - mn); ps += p0[r] + p1[r]; }
    ps = swap_sum(ps); l_reg = l_reg * alpha + ps;
    if (__any(alpha < 1.f)) { if (hi == 0) al_l[r32] = alpha; asm volatile("s_waitcnt lgkmcnt(0)" ::: "memory");
#pragma unroll
        for (int r = 0; r < 16; ++r) { const float a = al_l[crow(r, hi)];
#pragma unroll
            for (int d_ = 0; d_ < 4; ++d_) o[d_][r] *= a; } }
    PK4(p0, 0, pa0); PK4(p0, 8, pa1); PK4(p1, 0, pa2); PK4(p1, 8, pa3);
}
__device__ __forceinline__ void sb_half(f32x16& pz, int keybase, int qrow, int hi, float& R, const bf16x8* triA, bool needmask) {
    f32x16 X;
#pragma unroll
    for (int r = 0; r < 16; ++r) { const float zz = pz[r] * C2; const bool valid = !needmask || (keybase + crow(r, hi) < qrow);
        const float l2 = fmaxf(zz, 0.f) + __builtin_amdgcn_logf(1.0f + __builtin_amdgcn_exp2f(-fabsf(zz)));
        X[r] = valid ? -l2 : 0.f; pz[r] = valid ? zz : -__builtin_inff(); }
    f32x16 Y;
#pragma unroll
    for (int r = 0; r < 16; ++r) Y[r] = R;
#pragma unroll
    for (int s = 0; s < 2; ++s) {
        const unsigned h0 = cvtpk(X[8 * s + 0], X[8 * s + 1]), h1 = cvtpk(X[8 * s + 2], X[8 * s + 3]), h2 = cvtpk(X[8 * s + 4], X[8 * s + 5]), h3 = cvtpk(X[8 * s + 6], X[8 * s + 7]);
        const unsigned l0 = cvtpk(X[8 * s + 0] - bflo(h0), X[8 * s + 1] - bfhi(h0)), l1 = cvtpk(X[8 * s + 2] - bflo(h1), X[8 * s + 3] - bfhi(h1));
        const unsigned l2 = cvtpk(X[8 * s + 4] - bflo(h2), X[8 * s + 5] - bfhi(h2)), l3 = cvtpk(X[8 * s + 6] - bflo(h3), X[8 * s + 7] - bfhi(h3));
        u32x4 wh = {h0, h1, h2, h3}, wl = {l0, l1, l2, l3};
        Y = __builtin_amdgcn_mfma_f32_32x32x16_bf16(triA[s], *reinterpret_cast<bf16x8*>(&wh), Y, 0, 0, 0);
        Y = __builtin_amdgcn_mfma_f32_32x32x16_bf16(triA[s], *reinterpret_cast<bf16x8*>(&wl), Y, 0, 0, 0); }
#pragma unroll
    for (int r = 0; r < 16; ++r) pz[r] = __builtin_amdgcn_exp2f(pz[r] + Y[r]);
    R = swap_lo(Y[0]);
}
__device__ __forceinline__ void sb_sm(f32x16& p0, f32x16& p1, int kb_, int qlo, int qrow, int hi, float& R, const bf16x8* triA, bf16x8& pa0, bf16x8& pa1, bf16x8& pa2, bf16x8& pa3) {
    const bool needmask = (kb_ + KVBLK - 1 >= qlo);
    sb_half(p1, kb_ + 32, qrow, hi, R, triA, needmask);
    sb_half(p0, kb_, qrow, hi, R, triA, needmask);
    PK4(p0, 0, pa0); PK4(p0, 8, pa1); PK4(p1, 0, pa2); PK4(p1, 8, pa3);
}

template <int MODE>
__device__ __forceinline__ void attn_unit(const bf16_t* Q, const bf16_t* Kh, const bf16_t* Vh, const float* cum, bf16_t* O, int P0, char* lds, float kmaxc) {
    int tid = threadIdx.x; asm volatile("" : "+v"(tid));
    const int wid = __builtin_amdgcn_readfirstlane(tid >> 6), lane = tid & 63, r32 = lane & 31, hi = lane >> 5;
    const int NT = P0 / KVBLK + 4;
    char* V_lds = lds; char* K_lds = lds + OFF_K; float* bias_l = (float*)(lds + OFF_BIAS);
    float* wsl = (float*)(lds + OFF_WS) + wid * 64; float* li_l = wsl; float* al_l = wsl + 32;
    const int qlo = P0 + wid * QBLK, qrow = qlo + r32;
    bf16x8 qr[8];
#pragma unroll
    for (int d0 = 0; d0 < 8; ++d0) qr[d0] = *(const bf16x8*)(Q + (size_t)qrow * D + d0 * 16 + hi * 8);
    const int sr = tid >> 4, sc = (tid & 15) * 8, vst0 = v_st(sr, sc), vst1 = v_st(32 + sr, sc), kws = KSWZ(sr, sc * 2);
    const int vb0 = (int)(uintptr_t)V_lds + v_rd_base(lane);
    const float cumref = (MODE == 0) ? cum[P0] : 0.f;
    int* flg = (int*)(lds + OFF_FLAGS);
    float qn = 0.f;
    if (MODE == 0) { float ss = 0.f;
#pragma unroll
        for (int d0 = 0; d0 < 8; ++d0)
#pragma unroll
            for (int j = 0; j < 8; ++j) { const float x = bf2f((bf16_t)qr[d0][j]); ss = fmaf(x, x, ss); }
        ss = swap_sum(ss); qn = sqrtf(ss) * kmaxc * 1.001f; }
    float m_reg = -1e30f, l_reg = 0.f, R = 0.f; f32x16 o[4] = {};
    bf16x8 triA[2];
    if (MODE == 1) {
#pragma unroll
        for (int s = 0; s < 2; ++s)
#pragma unroll
            for (int j = 0; j < 8; ++j) { const int rho = 16 * s + 8 * (j >> 2) + 4 * hi + (j & 3); triA[s][j] = (rho >= r32) ? (short)0x3F80 : (short)0; }
    }
    bf16x8 st_k0, st_k1, st_v0, st_v1; float st_b = 0.f;
#define TILE_KB(t) ((NT - 1 - (t)) * KVBLK)
#define SLOAD(kb_) do { st_v0 = *(const bf16x8*)(Vh + (size_t)((kb_) + sr) * D + sc); st_v1 = *(const bf16x8*)(Vh + (size_t)((kb_) + 32 + sr) * D + sc); \
                        st_k0 = *(const bf16x8*)(Kh + (size_t)((kb_) + sr) * D + sc); st_k1 = *(const bf16x8*)(Kh + (size_t)((kb_) + 32 + sr) * D + sc); \
                        if (MODE == 0 && tid < 64) st_b = (cumref - cum[(kb_) + tid]) * LOG2E; } while (0)
#define SWRITE(bf) do { *(bf16x8*)(V_lds + (bf) * SHM_V + vst0) = st_v0; *(bf16x8*)(V_lds + (bf) * SHM_V + vst1) = st_v1; \
                        *(bf16x8*)(K_lds + (bf) * SHM_K + kws) = st_k0; *(bf16x8*)(K_lds + (bf) * SHM_K + kws + 32 * 256) = st_k1; \
                        if (MODE == 0 && tid < 64) bias_l[(bf) * 64 + tid] = st_b; } while (0)
    __syncthreads();
    SLOAD(TILE_KB(0)); SWRITE(0);
    __syncthreads();
    f32x16 p0, p1; bf16x8 pa0, pa1, pa2, pa3;
#define STEP(BUF, t) do { const int kb_ = TILE_KB(t); \
        if ((t) + 1 < NT) SLOAD(TILE_KB((t) + 1)); \
        SBAR(); qkt<BUF>(p0, p1, K_lds, r32, hi, qr); \
        if (MODE == 0) fox_sm(p0, p1, bias_l + (BUF) * 64, kb_, qlo, qrow, hi, r32, m_reg, l_reg, o, al_l, pa0, pa1, pa2, pa3); \
        else sb_sm(p0, p1, kb_, qlo, qrow, hi, R, triA, pa0, pa1, pa2, pa3); \
        SBAR(); pv_tile<BUF>(o, vb0, pa0, pa1, pa2, pa3); \
        if ((t) + 1 < NT) SWRITE((BUF) ^ 1); \
        __syncthreads(); } while (0)
    for (int t = 0; t < NT; t += 2) {
        STEP(0, t); STEP(1, t + 1);
        const int kbc = TILE_KB(t + 1); if (kbc == 0) break;
        bool done;
        if (MODE == 0) { const float edge = (cumref - cum[kbc - 1]) * LOG2E; done = (qn + edge - m_reg) < -EXIT_T; }
        else done = R < -EXIT_T;
        const int par = (t >> 1) & 1;
        if (lane == 0) flg[par * 8 + wid] = 0;
        const bool wdone = __all(done);
        if (lane == 0 && wdone) flg[par * 8 + wid] = 1;
        __syncthreads();
        int alld = 1;
#pragma unroll
        for (int w = 0; w < 8; ++w) alld &= flg[par * 8 + w];
        if (alld) break;
    }
    __syncthreads();
#undef STEP
#undef SLOAD
#undef SWRITE
#undef TILE_KB
    float rli[16];
    if (MODE == 0) { if (hi == 0) li_l[r32] = l_reg; asm volatile("s_waitcnt lgkmcnt(0)" ::: "memory");
#pragma unroll
        for (int r = 0; r < 16; ++r) rli[r] = __builtin_amdgcn_rcpf(li_l[crow(r, hi)]); }
    bf16_t* Ow = O + (size_t)(wid * QBLK) * 1024;
#pragma unroll
    for (int r = 0; r < 16; ++r) { const int orow = crow(r, hi);
#pragma unroll
        for (int d0 = 0; d0 < 4; ++d0) { const float v = (MODE == 0) ? o[d0][r] * rli[r] : o[d0][r];
            const float vn = __shfl_xor(v, 1);
            if ((r32 & 1) == 0) *(unsigned*)(Ow + (size_t)orow * 1024 + d0 * 32 + r32) = cvtpk(v, vn); } }
}
}

__device__ __forceinline__ void sparse_query(const Frame& F, int tok, char* ldsw) {
    unsigned char* ws = F.ws; const int lane = F.lane, g = lane >> 4, i16 = lane & 15;
    const bf16_t* qcat = (const bf16_t*)(ws + R_QCAT) + (size_t)tok * 2304; const bf16_t* kbase = (const bf16_t*)(ws + R_KCAT) + (size_t)(tok >> 13) * SEQ * 288;
    const int* sel = (const int*)(ws + R_SEL) + (size_t)tok * 256; const int ns = ((const int*)(ws + R_NSEL))[tok]; const int ntile = (ns + 31) >> 5;
    bf16x8 qf[9];
#pragma unroll
    for (int st = 0; st < 9; ++st) { qf[st] = (bf16x8){0, 0, 0, 0, 0, 0, 0, 0}; if (i16 < 8) qf[st] = *(const bf16x8*)(qcat + i16 * 288 + st * 32 + 8 * g); }
    const int rA = lane >> 2, cq = lane & 3;
    float m = -1e30f, l = 0.f; f32x4 oT[16];
#pragma unroll
    for (int rb = 0; rb < 16; ++rb) oT[rb] = (f32x4){0.f, 0.f, 0.f, 0.f};
    const unsigned ldso = (unsigned)(uintptr_t)ldsw;
    const unsigned vb = ldso + (unsigned)((4 * g + (i16 >> 2)) * 592 + (i16 & 3) * 8);
    constexpr float SC2 = SCALE * LOG2E;
    bf16x8 stg[18];
#define GATHER(tile_) do { const int j0 = (tile_) * 32 + rA, j1 = j0 + 16; const int s0 = j0 < ns ? sel[j0] : 0, s1 = j1 < ns ? sel[j1] : 0; \
        const bf16_t* p0_ = kbase + (size_t)s0 * 288 + cq * 8; const bf16_t* p1_ = kbase + (size_t)s1 * 288 + cq * 8; \
        _Pragma("unroll") for (int c = 0; c < 9; ++c) { stg[2 * c] = *(const bf16x8*)(p0_ + c * 32); stg[2 * c + 1] = *(const bf16x8*)(p1_ + c * 32); } } while (0)
    GATHER(0);
    for (int tile = 0; tile < ntile; ++tile) {
#pragma unroll
        for (int c = 0; c < 9; ++c) { *(bf16x8*)(ldsw + rA * 592 + c * 64 + cq * 16) = stg[2 * c]; *(bf16x8*)(ldsw + (16 + rA) * 592 + c * 64 + cq * 16) = stg[2 * c + 1]; }
        if (tile + 1 < ntile) GATHER(tile + 1);
        asm volatile("s_waitcnt lgkmcnt(0)" ::: "memory"); SBAR();
        f32x4 acc[2];
#pragma unroll
        for (int mt = 0; mt < 2; ++mt) { acc[mt] = (f32x4){0.f, 0.f, 0.f, 0.f};
#pragma unroll
            for (int st = 0; st < 9; ++st) { const bf16x8 a = *(const bf16x8*)(ldsw + (16 * mt + i16) * 592 + st * 64 + g * 16);
                acc[mt] = __builtin_amdgcn_mfma_f32_16x16x32_bf16(a, qf[st], acc[mt], 0, 0, 0); } }
        float tmax = -__builtin_inff();
#pragma unroll
        for (int mt = 0; mt < 2; ++mt)
#pragma unroll
            for (int r = 0; r < 4; ++r) { const int key = tile * 32 + 16 * mt + 4 * g + r; float x = acc[mt][r] * SC2; if (key >= ns) x = -__builtin_inff(); acc[mt][r] = x; tmax = fmaxf(tmax, x); }
        tmax = fmaxf(tmax, __shfl_xor(tmax, 16)); tmax = fmaxf(tmax, __shfl_xor(tmax, 32));
        const float mn = fmaxf(m, tmax), alpha = __builtin_amdgcn_exp2f(m - mn); m = mn;
        float ps = 0.f;
#pragma unroll
        for (int mt = 0; mt < 2; ++mt)
#pragma unroll
            for (int r = 0; r < 4; ++r) { acc[mt][r] = __builtin_amdgcn_exp2f(acc[mt][r] - mn); ps += acc[mt][r]; }
        ps += __shfl_xor(ps, 16); ps += __shfl_xor(ps, 32);
        l = l * alpha + ps;
#pragma unroll
        for (int rb = 0; rb < 16; ++rb) oT[rb] *= alpha;
        const bf16x8 pf = pack8(acc[0], acc[1]);
#define TRRD2(dst, off) asm volatile("ds_read_b64_tr_b16 %0, %1 offset:%2" : "=&v"(dst) : "v"(vb), "i"(off) : "memory")
#define PVRB(rb) do { s16x4 t1, t2; TRRD2(t1, (rb) * 32); TRRD2(t2, (rb) * 32 + 16 * 592); asm volatile("s_waitcnt lgkmcnt(0)" ::: "memory"); SBAR(); \
        oT[rb] = __builtin_amdgcn_mfma_f32_16x16x32_bf16((bf16x8){t1[0], t1[1], t1[2], t1[3], t2[0], t2[1], t2[2], t2[3]}, pf, oT[rb], 0, 0, 0); } while (0)
        PVRB(0); PVRB(1); PVRB(2); PVRB(3); PVRB(4); PVRB(5); PVRB(6); PVRB(7); PVRB(8); PVRB(9); PVRB(10); PVRB(11); PVRB(12); PVRB(13); PVRB(14); PVRB(15);
#undef PVRB
#undef TRRD2
        SBAR();
    }
#undef GATHER
    const float rl = 1.0f / l;
    if (i16 < 8) { bf16_t* op = (bf16_t*)(ws + R_OLAT) + (size_t)tok * 2048 + i16 * 256 + 4 * g;
#pragma unroll
        for (int rb = 0; rb < 16; ++rb) { u32x2 w; w.x = cvtpk(oT[rb][0] * rl, oT[rb][1] * rl); w.y = cvtpk(oT[rb][2] * rl, oT[rb][3] * rl); *(u32x2*)(op + rb * 16) = w; } }
}
#ifdef ATT_SUB
#define ASUB(k) ((k) == ATT_SUB)
#else
#define ASUB(k) true
#endif
__device__ __forceinline__ void phase_attn(const Frame& F0, int l, int rep) { const Frame F = fresh(F0);
    unsigned char* ws = F.ws; char* lds = (char*)F.lds;
    const bf16_t* qkv = (const bf16_t*)(ws + R_QKV); const size_t TS = (size_t)NTOK * 1024;
    unsigned* qctr = (unsigned*)(ws + WS_CTL) + CW_QCTR + l * 64 + rep * 16; const unsigned* kmx = (const unsigned*)(ws + WS_CTL) + CW_KMAX + l * 16;
    int* qitem = (int*)(lds + att::OFF_QITEM);
#pragma unroll 1
    for (;;) {
        __syncthreads();
        if (F.tid == 0) qitem[0] = (int)atomicAdd(qctr, 1u);
        __syncthreads();
        const int it = qitem[0];
        if (it >= 1024) break;
        const int md = it >> 9, j = it & 511, qb = 31 - (j >> 4), bh = j & 15, b = bh >> 3, h = bh & 7, P0 = qb * 256;
        if (!ASUB(md)) continue;
        const bf16_t* Q = qkv + (size_t)(md * 3 + 0) * TS + (size_t)bh * SEQ * 128; const bf16_t* K = qkv + (size_t)(md * 3 + 1) * TS + (size_t)bh * SEQ * 128; const bf16_t* V = qkv + (size_t)(md * 3 + 2) * TS + (size_t)bh * SEQ * 128;
        const float* cum = (const float*)(ws + WS_CUM) + (size_t)bh * SEQ;
        bf16_t* Ob = (bf16_t*)(ws + (md == 0 ? R_OB : R_OC)) + (size_t)b * SEQ * 1024 + h * 128;
        if (md == 0) { const float kmaxc = sqrtf(__uint_as_float(kmx[bh])) * C2; att::attn_unit<0>(Q, K, V, cum, Ob + (size_t)P0 * 1024, P0, lds, kmaxc); }
        else att::attn_unit<1>(Q, K, V, cum, Ob + (size_t)P0 * 1024, P0, lds, 0.f);
    }
    __syncthreads();
    char* ldsw = lds + F.wid * 18944;
#pragma unroll 1
    for (int rep = 0; rep < NREP(2); ++rep)
#pragma unroll 1
    for (int tok = F.bid * 8 + F.wid; tok < NTOK; tok += F.G * 8) if (ASUB(2)) sparse_query(F, tok, ldsw);
}

__device__ __forceinline__ void ln_row(const float* src, const float* g, const float* bta, float* of, bf16_t* ob, int lane) {
    f32x4 v[8]; float s = 0.f;
#pragma unroll
    for (int i = 0; i < 8; ++i) { v[i] = *(const f32x4*)(src + (i * 64 + lane) * 4); s += (v[i][0] + v[i][1]) + (v[i][2] + v[i][3]); }
    s = wave_sum(s); const float mu = s * (1.0f / 2048.0f); float q = 0.f;
#pragma unroll
    for (int i = 0; i < 8; ++i) { const f32x4 d = v[i] - mu; q += (d[0] * d[0] + d[1] * d[1]) + (d[2] * d[2] + d[3] * d[3]); }
    q = wave_sum(q); const float rstd = rsqrtf(q * (1.0f / 2048.0f) + 1e-5f);
#pragma unroll
    for (int i = 0; i < 8; ++i) { const int c = (i * 64 + lane) * 4; const f32x4 gg = *(const f32x4*)(g + c), bb = *(const f32x4*)(bta + c); const f32x4 y = (v[i] - mu) * rstd * gg + bb;
        if (of) *(f32x4*)(of + c) = y;
        if (ob) { u32x2 w; w.x = cvtpk(y[0], y[1]); w.y = cvtpk(y[2], y[3]); *(u32x2*)(ob + c) = w; } }
}
__device__ __forceinline__ void phase_ln1_router(const Frame& F0, const Params& P, int l) { const Frame F = fresh(F0);
    unsigned char* ws = F.ws; const int lane = F.lane, wid = F.wid;
    const float* pre1 = (const float*)(ws + R_PRE1); float* x1f = (float*)(ws + M_X1F); bf16_t* x1b = (bf16_t*)(ws + M_X1B);
    const float* g = F.in(11) + l * DM; const float* bt = F.in(12) + l * DM; const float* wr = F.in(13) + (size_t)l * DM * NEXP; const float* br = F.in(14) + l * NEXP;
    unsigned* cnt = (unsigned*)(ws + WS_CTL) + CW_CNT + l * 2048;
    int* tok_e = (int*)(ws + M_TOKE); int* tok_pos = (int*)(ws + M_TOKPOS); float* tok_w = (float*)(ws + M_TOKW);
    float* red = (float*)F.lds;
    float* lg = (float*)(F.lds + 32768);
#pragma unroll 1
    for (int blk = F.bid; blk < NTOK / 64; blk += F.G) {
        const int tok0 = blk * 64;
#pragma unroll 1
        for (int i = 0; i < 8; ++i) { const int tok = tok0 + wid * 8 + i; ln_row(pre1 + (size_t)tok * DM, g, bt, x1f + (size_t)tok * DM, x1b + (size_t)tok * DM, lane); }
        asm volatile("s_waitcnt vmcnt(0)" ::: "memory"); __syncthreads();
        { const int grp = wid >> 2, kq = wid & 3, i32 = lane & 31, hk = lane >> 5; f32x16 acc = {};
          const float* arow = x1f + (size_t)(tok0 + grp * 32 + i32) * DM + kq * 512 + 4 * hk; const float* bcol = wr + (size_t)(kq * 512 + 4 * hk) * NEXP + i32;
#pragma unroll 4
          for (int c8 = 0; c8 < 64; ++c8) { const f32x4 a4 = *(const f32x4*)(arow + c8 * 8);
              const float b0 = bcol[(size_t)(c8 * 8 + 0) * NEXP], b1 = bcol[(size_t)(c8 * 8 + 1) * NEXP], b2 = bcol[(size_t)(c8 * 8 + 2) * NEXP], b3 = bcol[(size_t)(c8 * 8 + 3) * NEXP];
              acc = __builtin_amdgcn_mfma_f32_32x32x2f32(a4[0], b0, acc, 0, 0, 0); acc = __builtin_amdgcn_mfma_f32_32x32x2f32(a4[1], b1, acc, 0, 0, 0);
              acc = __builtin_amdgcn_mfma_f32_32x32x2f32(a4[2], b2, acc, 0, 0, 0); acc = __builtin_amdgcn_mfma_f32_32x32x2f32(a4[3], b3, acc, 0, 0, 0); }
#pragma unroll
          for (int r = 0; r < 16; ++r) red[(wid * 16 + r) * 64 + lane] = acc[r]; }
        __syncthreads();
        if ((wid & 3) == 0) { const int grp = wid >> 2, hk = lane >> 5, e = lane & 31; const float be = br[e];
#pragma unroll
            for (int r = 0; r < 16; ++r) { const float v = red[((wid + 0) * 16 + r) * 64 + lane] + red[((wid + 1) * 16 + r) * 64 + lane] + red[((wid + 2) * 16 + r) * 64 + lane] + red[((wid + 3) * 16 + r) * 64 + lane] + be;
                lg[(grp * 32 + crow(r, hk)) * 33 + e] = v; }
            asm volatile("s_waitcnt lgkmcnt(0)" ::: "memory"); SBAR();
            const int tk = lane & 31; float v[32];
#pragma unroll
            for (int e2 = 0; e2 < 32; ++e2) v[e2] = lg[(grp * 32 + tk) * 33 + e2];
            int ek[4]; float vk[4];
#pragma unroll
            for (int k = 0; k < 4; ++k) { float best = -__builtin_inff(); int bi = 0;
#pragma unroll
                for (int e2 = 0; e2 < 32; ++e2) if (v[e2] > best) { best = v[e2]; bi = e2; }
                ek[k] = bi; vk[k] = best;
#pragma unroll
                for (int e2 = 0; e2 < 32; ++e2) v[e2] = (e2 == bi) ? -__builtin_inff() : v[e2]; }
            float wk[4], sw = 0.f;
#pragma unroll
            for (int k = 0; k < 4; ++k) { wk[k] = __expf(vk[k] - vk[0]); sw += wk[k]; }
            const float rs = 1.0f / sw;
            const bool act = lane < 32; unsigned myc = 0u;
#pragma unroll 1
            for (int E = 0; E < 32; ++E) { unsigned c = 0u;
#pragma unroll
                for (int k = 0; k < 4; ++k) c += (unsigned)__popcll(__ballot(act && ek[k] == E));
                if (lane == E) myc = c; }
            unsigned run = 0u; if (lane < 32 && myc > 0u) run = atomicAdd(&cnt[lane * 64], myc);
            int pk[4];
#pragma unroll
            for (int k = 0; k < 4; ++k) { pk[k] = 0;
#pragma unroll 1
                for (int E = 0; E < 32; ++E) { const unsigned long long mm = __ballot(act && ek[k] == E); const unsigned basev = (unsigned)__shfl((int)run, E);
                    if (act && ek[k] == E) pk[k] = (int)(basev + (unsigned)__popcll(mm & ((1ull << lane) - 1ull)));
                    if (lane == E) run += (unsigned)__popcll(mm); } }
            if (act) { const int tok = tok0 + grp * 32 + tk;
#pragma unroll
                for (int k = 0; k < 4; ++k) { tok_e[tok * 4 + k] = ek[k]; tok_pos[tok * 4 + k] = pk[k]; tok_w[tok * 4 + k] = wk[k] * rs; } }
        }
        __syncthreads();
    }
}
__device__ __forceinline__ void phase_moe_gather(const Frame& F0, int l) { const Frame F = fresh(F0);
    unsigned char* ws = F.ws; const int lane = F.lane;
    const unsigned* cnt = (const unsigned*)(ws + WS_CTL) + CW_CNT + l * 2048; unsigned* meta = (unsigned*)(ws + WS_CTL) + CW_META + l * 512;
    unsigned* offs = (unsigned*)(F.lds + LDS_MISC + 64);
    if (F.tid == 0) { unsigned o = 0u; for (int e = 0; e < 32; ++e) { offs[e] = o; o += (cnt[e * 64] + 255u) & ~255u; } offs[32] = o;
        if (F.bid == 0) { meta[0] = o >> 8; for (int e = 0; e < 32; ++e) for (unsigned t = offs[e] >> 8; t < (offs[e + 1] >> 8); ++t) meta[1 + t] = (unsigned)e; } }
    __syncthreads();
    const int* tok_e = (const int*)(ws + M_TOKE); const int* tok_pos = (const int*)(ws + M_TOKPOS); const float* tok_w = (const float*)(ws + M_TOKW);
    int* tok_dst = (int*)(ws + M_TOKDST); float* roww = (float*)(ws + M_ROWW);
    const bf16_t* x1b = (const bf16_t*)(ws + M_X1B); bf16_t* xs = (bf16_t*)(ws + M_XS);
    for (int it = F.bid * 8 + F.wid; it < NTOK * 4; it += F.G * 8) { const int tok = it >> 2;
        const int e = tok_e[it]; const unsigned dst = offs[e] + (unsigned)tok_pos[it];
        if (lane == 0) { tok_dst[it] = (int)dst; roww[dst] = tok_w[it]; }
        const u32x4* sp = (const u32x4*)(x1b + (size_t)tok * DM); u32x4* dp = (u32x4*)(xs + (size_t)dst * DM);
#pragma unroll
        for (int i = 0; i < 4; ++i) dp[i * 64 + lane] = sp[i * 64 + lane]; }
    __syncthreads();
}
__device__ __forceinline__ void phase_combine(const Frame& F0) { const Frame F = fresh(F0);
    unsigned char* ws = F.ws; const int lane = F.lane;
    const float* x1f = (const float*)(ws + M_X1F); const bf16_t* ys = (const bf16_t*)(ws + M_XS); const int* tok_dst = (const int*)(ws + M_TOKDST);
    float* hf = (float*)(ws + M_HF); bf16_t* hb = (bf16_t*)(ws + M_HB);
    for (int tok = F.bid * 8 + F.wid; tok < NTOK; tok += F.G * 8) {
        const int d0 = tok_dst[tok * 4], d1 = tok_dst[tok * 4 + 1], d2 = tok_dst[tok * 4 + 2], d3 = tok_dst[tok * 4 + 3];
#pragma unroll
        for (int i = 0; i < 4; ++i) { const int c = (i * 64 + lane) * 8; const size_t o = (size_t)tok * DM + c;
            f32x4 a = *(const f32x4*)(x1f + o) * ALPHA, b = *(const f32x4*)(x1f + o + 4) * ALPHA;
            const u32x4 y0 = *(const u32x4*)(ys + (size_t)d0 * DM + c), y1 = *(const u32x4*)(ys + (size_t)d1 * DM + c), y2 = *(const u32x4*)(ys + (size_t)d2 * DM + c), y3 = *(const u32x4*)(ys + (size_t)d3 * DM + c);
            a[0] += (bflo(y0.x) + bflo(y1.x)) + (bflo(y2.x) + bflo(y3.x)); a[1] += (bfhi(y0.x) + bfhi(y1.x)) + (bfhi(y2.x) + bfhi(y3.x));
            a[2] += (bflo(y0.y) + bflo(y1.y)) + (bflo(y2.y) + bflo(y3.y)); a[3] += (bfhi(y0.y) + bfhi(y1.y)) + (bfhi(y2.y) + bfhi(y3.y));
            b[0] += (bflo(y0.z) + bflo(y1.z)) + (bflo(y2.z) + bflo(y3.z)); b[1] += (bfhi(y0.z) + bfhi(y1.z)) + (bfhi(y2.z) + bfhi(y3.z));
            b[2] += (bflo(y0.w) + bflo(y1.w)) + (bflo(y2.w) + bflo(y3.w)); b[3] += (bfhi(y0.w) + bfhi(y1.w)) + (bfhi(y2.w) + bfhi(y3.w));
            *(f32x4*)(hf + o) = a; *(f32x4*)(hf + o + 4) = b; pg8::st_bf16x8(hb + o, a, b); } }
}
__device__ __forceinline__ void phase_ln2(const Frame& F0, const Params& P, int l) { const Frame F = fresh(F0);
    unsigned char* ws = F.ws; const float* pre2 = (const float*)(ws + M_X1F); bf16_t* xb = (bf16_t*)(ws + WS_XB);
    const float* g = F.in(23) + l * DM; const float* bt = F.in(24) + l * DM;
    for (int tok = F.bid * 8 + F.wid; tok < NTOK; tok += F.G * 8) ln_row(pre2 + (size_t)tok * DM, g, bt, F.out() + (size_t)tok * DM, xb + (size_t)tok * DM, F.lane);
}

constexpr int NPHASE = 1 + 15 * NLAYER;
#ifdef PH_ONLY
#define PEN(kind) ((kind) == PH_ONLY)
#else
#define PEN(kind) true
#endif
#define IN(k) (lo <= (k) && (k) < hi)
#define SEAM(k) do { if (IN((k) + 1)) xcd_barrier(bar); } while (0)

template <int l>
__device__ __forceinline__ void layer_phases(const Frame& F, const Params& P, const XcdBarrier& bar, const int lo, const int hi, unsigned char* ws0) {
    using namespace pg8;

        const int pb = 1 + 15 * l;
        const float* xres = (l == 0) ? F.in(0) : F.out();
        if (IN(pb + 0) && PEN(0)) { unsigned char* ws = ws0; asm volatile("" : "+s"(ws));
            SchedS S; S.init(NTOK, INWP, F.G, F.bid, (const bf16_t*)(ws + WS_XB), DM, (const bf16_t*)(ws + W_IN), DM);
            EpiInProj E{(bf16_t*)(ws + R_QA), (bf16_t*)(ws + R_QIDX), (bf16_t*)(ws + R_QKV), (bf16_t*)(ws + R_GATES), (float*)(ws + R_SMALL)};
            for (int rep = 0; rep < NREP(5); ++rep) gemm_phase(F.ldsl, DM, DM, DM, S, E); SEAM(pb + 0); }
        if (IN(pb + 1) && PEN(1)) { unsigned char* ws = ws0; asm volatile("" : "+s"(ws));
            phase_prep(F, P, l);
            SchedS S; S.init(NTOK, 2048, F.G, F.bid, (const bf16_t*)(ws + R_QA), 1024, (const bf16_t*)(ws + W_UK2), 256, 1, 256);
            EpiBf16 E{(bf16_t*)(ws + R_QCAT), 2304, 288};
            for (int rep = 0; rep < NREP(10); ++rep) gemm_phase(F.ldsl, 256, 1024, 256, S, E); SEAM(pb + 1); }
        if (IN(pb + 2) && PEN(2)) { unsigned char* ws = ws0; asm volatile("" : "+s"(ws)); phase_cumsum(F); for (int rep = 0; rep < NREP(3); ++rep) phase_idx(F); SEAM(pb + 2); }
        if (IN(pb + 3) && PEN(3)) { unsigned char* ws = ws0; asm volatile("" : "+s"(ws)); for (int rep = 0; rep < NREP(4); ++rep) phase_topk(F); SEAM(pb + 3); }
        if (IN(pb + 4) && PEN(4)) { unsigned char* ws = ws0; asm volatile("" : "+s"(ws)); for (int rep = 0; rep < NREP(1); ++rep) phase_attn(F, l, rep); SEAM(pb + 4); }
        if (IN(pb + 5) && PEN(5)) { unsigned char* ws = ws0; asm volatile("" : "+s"(ws));
            { SchedS S; S.init(NTOK, 1024, F.G, F.bid, (const bf16_t*)(ws + R_OLAT), 2048, (const bf16_t*)(ws + W_UV2), 512, 0, 512);
              EpiBf16 E{(bf16_t*)(ws + R_OA), 1024, 256}; for (int rep = 0; rep < NREP(10); ++rep) gemm_phase(F.ldsl, 512, 2048, 512, S, E); }
            { SchedS S; S.init(NTOK, 2048, F.G, F.bid, (const bf16_t*)(ws + R_OB), 1024, (const bf16_t*)(ws + W_BRB), 1024);
              EpiBranch<0> E{(const bf16_t*)(ws + R_GATES), (float*)(ws + R_TMP), (bf16_t*)(ws + R_MERGED), 1}; for (int rep = 0; rep < NREP(11); ++rep) gemm_phase(F.ldsl, 1024, 1024, 1024, S, E); }
            { SchedS S; S.init(NTOK, 2048, F.G, F.bid, (const bf16_t*)(ws + R_OC), 1024, (const bf16_t*)(ws + W_BRC), 1024);
              EpiBranch<1> E{(const bf16_t*)(ws + R_GATES), (float*)(ws + R_TMP), (bf16_t*)(ws + R_MERGED), 2}; gemm_phase(F.ldsl, 1024, 1024, 1024, S, E); }
            SEAM(pb + 5); }
        if (IN(pb + 6) && PEN(6)) { unsigned char* ws = ws0; asm volatile("" : "+s"(ws));
            SchedS S; S.init(NTOK, 2048, F.G, F.bid, (const bf16_t*)(ws + R_OA), 1024, (const bf16_t*)(ws + W_BRA), 1024);
            EpiBranch<2> E{(const bf16_t*)(ws + R_GATES), (float*)(ws + R_TMP), (bf16_t*)(ws + R_MERGED), 0}; for (int rep = 0; rep < NREP(11); ++rep) gemm_phase(F.ldsl, 1024, 1024, 1024, S, E); SEAM(pb + 6); }
        if (IN(pb + 7) && PEN(7)) { unsigned char* ws = ws0; asm volatile("" : "+s"(ws));
            SchedS S; S.init(NTOK, 2048, F.G, F.bid, (const bf16_t*)(ws + R_MERGED), DM, (const bf16_t*)(ws + W_OUT), DM);
            EpiOut E{xres, (float*)(ws + R_PRE1)}; for (int rep = 0; rep < NREP(8); ++rep) gemm_phase(F.ldsl, DM, DM, DM, S, E); SEAM(pb + 7); }
        if (IN(pb + 8) && PEN(8)) { unsigned char* ws = ws0; asm volatile("" : "+s"(ws)); phase_ln1_router(F, P, l); SEAM(pb + 8); }
        if (IN(pb + 9) && PEN(9)) { unsigned char* ws = ws0; asm volatile("" : "+s"(ws));
            for (int rep = 0; rep < NREP(12); ++rep) phase_moe_gather(F, l);
            SchedS S; S.init(NTOK, 2048, F.G, F.bid, (const bf16_t*)(ws + WS_PB) + (size_t)l * NTOK * 256, 256, (const bf16_t*)(ws + W_PLE), 256);
            EpiBf16 E{(bf16_t*)(ws + M_PP), 2048, 256}; for (int rep = 0; rep < NREP(10); ++rep) gemm_phase(F.ldsl, 256, 256, 256, S, E); SEAM(pb + 9); }
        if (IN(pb + 10) && PEN(10)) { unsigned char* ws = ws0; asm volatile("" : "+s"(ws));
            SchedM S; S.init((const unsigned*)(ws + WS_CTL) + CW_META + l * 512, F.G, F.bid, (const bf16_t*)(ws + M_XS), DM, (const bf16_t*)(ws + W_GU), DM);
            EpiGateUp E{F.in(16) + (size_t)l * NEXP * DEXP, F.in(18) + (size_t)l * NEXP * DEXP, (bf16_t*)(ws + M_HID)}; for (int rep = 0; rep < NREP(6); ++rep) gemm_phase(F.ldsl, DM, DM, DM, S, E); SEAM(pb + 10); }
        if (IN(pb + 11) && PEN(11)) { unsigned char* ws = ws0; asm volatile("" : "+s"(ws));
            SchedM S; S.init((const unsigned*)(ws + WS_CTL) + CW_META + l * 512, F.G, F.bid, (const bf16_t*)(ws + M_HID), DEXP, (const bf16_t*)(ws + W_DN), DEXP);
            EpiDown E{F.in(20) + (size_t)l * NEXP * DM, (const float*)(ws + M_ROWW), (bf16_t*)(ws + M_XS)}; for (int rep = 0; rep < NREP(7); ++rep) gemm_phase(F.ldsl, DEXP, DEXP, DEXP, S, E); SEAM(pb + 11); }
        if (IN(pb + 12) && PEN(12)) { unsigned char* ws = ws0; asm volatile("" : "+s"(ws)); for (int rep = 0; rep < NREP(9); ++rep) phase_combine(F); SEAM(pb + 12); }
        if (IN(pb + 13) && PEN(13)) { unsigned char* ws = ws0; asm volatile("" : "+s"(ws));
            SchedS S; S.init(NTOK, 2048, F.G, F.bid, (const bf16_t*)(ws + M_HB), DM, (const bf16_t*)(ws + W_PG), DM);
            EpiPleGate E{(const float*)(ws + M_HF), (const bf16_t*)(ws + M_PP), (float*)(ws + M_X1F)}; for (int rep = 0; rep < NREP(8); ++rep) gemm_phase(F.ldsl, DM, DM, DM, S, E); SEAM(pb + 13); }
        if (IN(pb + 14) && PEN(14)) { unsigned char* ws = ws0; asm volatile("" : "+s"(ws)); for (int rep = 0; rep < NREP(13); ++rep) phase_ln2(F, P, l); if (l + 1 < NLAYER) for (int rep = 0; rep < NREP(0); ++rep) convert_layer_weights(F, P, l + 1); SEAM(pb + 14); }
}
__global__ void __launch_bounds__(512, 2) fwd(Params P) {
    extern __shared__ __attribute__((aligned(16))) unsigned char lds[];
    Frame F; F.lds = lds; F.ldsl = (LAS unsigned char*)lds; F.ws = P.ws; F.tid = threadIdx.x; F.lane = F.tid & 63; F.wid = __builtin_amdgcn_readfirstlane(F.tid >> 6); F.G = gridDim.x; F.bid = blockIdx.x;
    unsigned char* ws0 = P.ws; unsigned char* ws = ws0;
    const bool fused = (P.ph_hi - P.ph_lo) > 1;
    if (F.tid < 4) ((LAS unsigned*)(F.ldsl + LDS_MISC))[F.tid] = 0u;
    if (F.tid == 0) { LAS unsigned long long* t = (LAS unsigned long long*)(F.ldsl + LDS_PTRS);
#pragma unroll
        for (int k = 0; k < 25; ++k) t[k] = (unsigned long long)P.in[k];
        t[25] = (unsigned long long)P.out; }
    __syncthreads();
    XcdBarrier bar; bar.bar = (unsigned*)(ws + WS_CTL) + CW_BAR; bar.x = 0; bar.st = (volatile LAS unsigned*)(F.ldsl + LDS_MISC);
    if (fused) bar = xcd_barrier_post((unsigned*)(ws + WS_CTL) + CW_BAR, (volatile LAS unsigned*)(F.ldsl + LDS_MISC));
    const int lo = P.ph_lo, hi = P.ph_hi;
    using namespace pg8;
    if (IN(0) && PEN(15)) { unsigned char* ws = ws0; asm volatile("" : "+s"(ws));
        conv_rows(F, F.in(0), (bf16_t*)(ws + WS_XB), (size_t)NTOK * DM / 8);
        conv_rows(F, F.in(1), (bf16_t*)(ws + WS_PB), (size_t)2 * NTOK * 256 / 8);
        for (int rep = 0; rep < NREP(0); ++rep) convert_layer_weights(F, P, 0);
        SEAM(0);
    }
    layer_phases<0>(F, P, bar, lo, hi, ws0);
    layer_phases<1>(F, P, bar, lo, hi, ws0);
}

#ifdef DEBUG_NAN
constexpr int CW_FLAGS = 12288;
__global__ void dbg_scan_bf16(const unsigned short* p, size_t n, unsigned* flag) { unsigned c = 0; for (size_t i = (size_t)blockIdx.x * blockDim.x + threadIdx.x; i < n; i += (size_t)gridDim.x * blockDim.x) if ((p[i] & 0x7F80u) == 0x7F80u) ++c; if (c) atomicAdd(flag, c); }
__global__ void dbg_scan_f32(const unsigned* p, size_t n, unsigned* flag) { unsigned c = 0; for (size_t i = (size_t)blockIdx.x * blockDim.x + threadIdx.x; i < n; i += (size_t)gridDim.x * blockDim.x) if ((p[i] & 0x7F800000u) == 0x7F800000u) ++c; if (c) atomicAdd(flag, c); }
__global__ void dbg_scan_sel(const int* sel, const int* nsel, unsigned* flag) { unsigned c = 0; for (size_t i = (size_t)blockIdx.x * blockDim.x + threadIdx.x; i < (size_t)NTOK * 256; i += (size_t)gridDim.x * blockDim.x) { const int tok = (int)(i >> 8), j = (int)(i & 255), t = tok & (SEQ - 1); const int ns = nsel[tok]; if (j == 0 && ns != (t + 1 < 256 ? t + 1 : 256)) ++c; if (j < ns && (sel[i] < 0 || sel[i] > t)) ++c; } if (c) atomicAdd(flag, c); }
__global__ void dbg_scan_scores(const unsigned* p, unsigned* flag) { unsigned c = 0; for (size_t i = (size_t)blockIdx.x * blockDim.x + threadIdx.x; i < 2ull * SEQ * SEQ; i += (size_t)gridDim.x * blockDim.x) { const int s = (int)(i & (SEQ - 1)), t = (int)((i >> 13) & (SEQ - 1)); if (s <= t && (p[i] & 0x7F800000u) == 0x7F800000u) ++c; } if (c) atomicAdd(flag, c); }
__global__ void dbg_probe_bf16(const unsigned short* p, size_t n, unsigned* cnt, unsigned* minidx) { unsigned c = 0; unsigned mi = 0xFFFFFFFFu; for (size_t i = (size_t)blockIdx.x * blockDim.x + threadIdx.x; i < n; i += (size_t)gridDim.x * blockDim.x) if ((p[i] & 0x7F80u) == 0x7F80u) { ++c; if ((unsigned)i < mi) mi = (unsigned)i; } if (c) { atomicAdd(cnt, c); atomicMax(minidx, ~mi); } }
__global__ void dbg_final(float* out, size_t n, const unsigned* flags) { int code = 0; for (int k = 0; k < 32; ++k) if (flags[k] && !code) code = k + 1; const int mask = (flags[32] ? 1 : 0) | (flags[33] ? 2 : 0) | (flags[34] ? 4 : 0); if (mask) code = 20 + 5 * mask; if (!code) return; for (size_t i = (size_t)blockIdx.x * blockDim.x + threadIdx.x; i < n; i += (size_t)gridDim.x * blockDim.x) out[i] = (float)code; }
#endif
extern "C" void kernel_launch(void* const* d_in, const int* in_sizes, int n_in, void* d_out, int out_size, void* d_ws, size_t ws_size, hipStream_t stream) {
    static int grid = 0;
    if (grid == 0) {
        if (n_in != 25 || out_size != NTOK * DM || ws_size < WS_NEED) { fprintf(stderr, "kernel_launch: unexpected shapes (n_in %d out %d ws %zu need %zu)\n", n_in, out_size, ws_size, (size_t)WS_NEED); grid = -1; return; }
        int dev = 0, cus = 0, per_cu = 0;
        if (hipGetDevice(&dev) != hipSuccess || hipDeviceGetAttribute(&cus, hipDeviceAttributeMultiprocessorCount, dev) != hipSuccess) { grid = -1; return; }
        if (hipFuncSetAttribute((const void*)fwd, hipFuncAttributeMaxDynamicSharedMemorySize, LDS_BYTES) != hipSuccess) { fprintf(stderr, "kernel_launch: hipFuncSetAttribute failed\n"); grid = -1; return; }
        if (hipOccupancyMaxActiveBlocksPerMultiprocessor(&per_cu, (const void*)fwd, 512, LDS_BYTES) != hipSuccess || per_cu < 1) fprintf(stderr, "kernel_launch: occupancy query says %d\n", per_cu);
        (void)hipGetLastError();
        grid = cus;
    }
    if (grid < 0) return;
    unsigned char* ws = (unsigned char*)d_ws;
    hipMemsetAsync(ws + WS_CTL, 0, CTL_BYTES, stream);
    hipMemsetAsync(ws + W_UK2, 0, 8ull * 256 * 256 * 2 + 4ull * 256 * 512 * 2, stream);
    hipMemsetAsync(ws + W_IN + (size_t)INW * 2048 * 2, 0, (size_t)(INWP - INW) * 2048 * 2, stream);
    Params p{};
    for (int i = 0; i < 25; ++i) p.in[i] = (const float*)d_in[i];
    p.out = (float*)d_out; p.ws = ws;
#if PHASES_PER_LAUNCH == 0
    p.ph_lo = 0; p.ph_hi = NPHASE;
    hipLaunchKernelGGL(fwd, dim3(grid), dim3(512), LDS_BYTES, stream, p);
#else
    for (int k = 0; k < NPHASE; ++k) { p.ph_lo = k; p.ph_hi = k + 1; hipLaunchKernelGGL(fwd, dim3(grid), dim3(512), LDS_BYTES, stream, p);
#ifdef DEBUG_NAN
        unsigned* fl = (unsigned*)(ws + WS_CTL) + CW_FLAGS + k;
#define SB16(off, n) hipLaunchKernelGGL(dbg_scan_bf16, dim3(1024), dim3(256), 0, stream, (const unsigned short*)(ws + (off)), (size_t)(n), fl)
#define SF32(off, n) hipLaunchKernelGGL(dbg_scan_f32, dim3(1024), dim3(256), 0, stream, (const unsigned*)(ws + (off)), (size_t)(n), fl)
        if (k == 0) { SB16(WS_XB, (size_t)NTOK * DM); SB16(WS_PB, 2ull * NTOK * 256); SB16(WS_W, (W_END - WS_W) / 2); }
        else { const int kind = (k - 1) % 15;
            if (kind == 0) { SB16(R_QA, (size_t)NTOK * 1024); SB16(R_QIDX, (size_t)NTOK * 1024); SB16(R_QKV, 6ull * NTOK * 1024); SB16(R_GATES, (size_t)NTOK * 6144); SF32(R_SMALL, (size_t)NTOK * 512); }
            if (kind == 1) { SB16(R_QCAT, (size_t)NTOK * 2304); SB16(R_KCAT, (size_t)NTOK * 288); SB16(R_KI, (size_t)NTOK * 64); SB16(R_QIDX, (size_t)NTOK * 1024); SF32(R_WI, (size_t)NTOK * 16); SF32(WS_LF, 16ull * 8192); }
            if (kind == 2) { SF32(WS_CUM, 16ull * 8192); hipLaunchKernelGGL(dbg_scan_scores, dim3(1024), dim3(256), 0, stream, (const unsigned*)(ws + R_SCORES), fl); }
            if (kind == 3) { hipLaunchKernelGGL(dbg_scan_sel, dim3(1024), dim3(256), 0, stream, (const int*)(ws + R_SEL), (const int*)(ws + R_NSEL), fl); }
            if (k == 5) { unsigned* fl0 = fl; fl = (unsigned*)(ws + WS_CTL) + CW_FLAGS + 32; SB16(R_OLAT, (size_t)NTOK * 2048); fl += 1; SB16(R_OB, (size_t)NTOK * 1024); fl += 1; SB16(R_OC, (size_t)NTOK * 1024); fl = fl0; hipLaunchKernelGGL(dbg_probe_bf16, dim3(1024), dim3(256), 0, stream, (const unsigned short*)(ws + R_OC), (size_t)NTOK * 1024, (unsigned*)(ws + WS_CTL) + CW_FLAGS + 40, (unsigned*)(ws + WS_CTL) + CW_FLAGS + 41); }
            if (kind == 5) { SB16(R_OA, (size_t)NTOK * 1024); SF32(R_TMP, (size_t)NTOK * 2048); }
            if (kind == 6) { SB16(R_MERGED, (size_t)NTOK * 2048); }
            if (kind == 7) { SF32(R_PRE1, (size_t)NTOK * 2048); }
            if (kind == 8) { SF32(M_X1F, (size_t)NTOK * 2048); SF32(M_TOKW, (size_t)NTOK * 4); }
            if (kind == 9) { SB16(M_PP, (size_t)NTOK * 2048); }
            if (kind == 12) { SF32(M_HF, (size_t)NTOK * 2048); }
            if (kind == 13) { SF32(M_X1F, (size_t)NTOK * 2048); }
            if (kind == 14) { hipLaunchKernelGGL(dbg_scan_f32, dim3(1024), dim3(256), 0, stream, (const unsigned*)d_out, (size_t)NTOK * DM, fl); if (k + 1 < NPHASE) SB16(WS_W, (W_END - WS_W) / 2); } }
#endif
    }
#ifdef DEBUG_NAN
    hipLaunchKernelGGL(dbg_final, dim3(1024), dim3(256), 0, stream, (float*)d_out, (size_t)NTOK * DM, (const unsigned*)(ws + WS_CTL) + CW_FLAGS);
#endif
#endif
}
```

```cpp
#include <hip/hip_runtime.h>
#include <stdint.h>
#include <stdio.h>
#include <math.h>

#ifndef PHASES_PER_LAUNCH
#define PHASES_PER_LAUNCH 0
#endif

#define LAS __attribute__((address_space(3)))
#ifndef REP_MASK
#define REP_MASK 0
#endif
#define NREP(bit) (((REP_MASK) >> (bit)) & 1 ? 2 : 1)
typedef unsigned short bf16_t;
typedef short bf16x8 __attribute__((ext_vector_type(8)));
typedef short s16x4 __attribute__((ext_vector_type(4)));
typedef float f32x4 __attribute__((ext_vector_type(4)));
typedef float f32x16 __attribute__((ext_vector_type(16)));
typedef unsigned u32x4 __attribute__((ext_vector_type(4)));
typedef unsigned u32x2 __attribute__((ext_vector_type(2)));

constexpr int NTOK = 16384, DM = 2048, SEQ = 8192, NB = 2, NLAYER = 2;
constexpr int INW = 14712, INWP = 14848;
constexpr int NEXP = 32, DEXP = 1024;
constexpr int PMAX = 65536 + 8192;
constexpr float ALPHA = 1.41421356237309515f;
constexpr float LOG2E = 1.4426950408889634f;
constexpr float SCALE = 0.08838834764831845f;
constexpr float C2 = LOG2E * SCALE;

constexpr size_t MiB = 1ull << 20;
constexpr size_t WS_CTL   = 0;
constexpr size_t WS_W     = 1 * MiB;
constexpr size_t W_IN     = WS_W;
constexpr size_t W_UK2    = W_IN   + (size_t)INWP * 2048 * 2;
constexpr size_t W_UV2    = W_UK2  + 8ull * 256 * 256 * 2;
constexpr size_t W_BRA    = W_UV2  + 4ull * 256 * 512 * 2;
constexpr size_t W_BRB    = W_BRA  + 2048ull * 1024 * 2;
constexpr size_t W_BRC    = W_BRB  + 2048ull * 1024 * 2;
constexpr size_t W_OUT    = W_BRC  + 2048ull * 1024 * 2;
constexpr size_t W_PG     = W_OUT  + 2048ull * 2048 * 2;
constexpr size_t W_PLE    = W_PG   + 2048ull * 2048 * 2;
constexpr size_t W_GU     = W_PLE  + 2048ull * 256 * 2;
constexpr size_t W_DN     = W_GU   + 32ull * 2048 * 2048 * 2;
constexpr size_t W_END    = W_DN   + 32ull * 2048 * 1024 * 2;
constexpr size_t WS_XB    = (W_END + MiB - 1) / MiB * MiB;
constexpr size_t WS_PB    = WS_XB  + (size_t)NTOK * DM * 2;
constexpr size_t WS_CUM   = WS_PB  + 2ull * NTOK * 256 * 2;
constexpr size_t WS_LF    = WS_CUM + 16ull * 8192 * 4;
constexpr size_t WS_R     = WS_LF  + 16ull * 8192 * 4;
constexpr size_t R_SCORES = WS_R;
constexpr size_t R_OLAT   = WS_R;
constexpr size_t R_OA     = WS_R + 64 * MiB;
constexpr size_t R_OB     = WS_R + 96 * MiB;
constexpr size_t R_OC     = WS_R + 128 * MiB;
constexpr size_t R_TMP    = WS_R + 160 * MiB;
constexpr size_t R_MERGED = WS_R + 288 * MiB;
constexpr size_t R_PRE1   = WS_R + 384 * MiB;
constexpr size_t R_QA     = WS_R + 512 * MiB;
constexpr size_t R_QIDX   = WS_R + 544 * MiB;
constexpr size_t R_QKV    = WS_R + 576 * MiB;
constexpr size_t R_GATES  = WS_R + 768 * MiB;
constexpr size_t R_SMALL  = WS_R + 960 * MiB;
constexpr size_t R_QCAT   = WS_R + 992 * MiB;
constexpr size_t R_KCAT   = WS_R + 1064 * MiB;
constexpr size_t R_KI     = WS_R + 1073 * MiB;
constexpr size_t R_WI     = WS_R + 1075 * MiB;
constexpr size_t R_SEL    = WS_R + 1076 * MiB;
constexpr size_t R_NSEL   = WS_R + 1092 * MiB;
constexpr size_t R_END    = WS_R + 1093 * MiB;
constexpr size_t M_XS     = WS_R;
constexpr size_t M_HID    = WS_R + 288 * MiB;
constexpr size_t M_PP     = WS_R + 432 * MiB;
constexpr size_t M_X1F    = WS_R + 512 * MiB;
constexpr size_t M_X1B    = WS_R + 640 * MiB;
constexpr size_t M_HF     = WS_R + 704 * MiB;
constexpr size_t M_HB     = WS_R + 832 * MiB;
constexpr size_t M_TOKE   = WS_R + 896 * MiB;
constexpr size_t M_TOKPOS = M_TOKE + (size_t)NTOK * 16;
constexpr size_t M_TOKW   = M_TOKPOS + (size_t)NTOK * 16;
constexpr size_t M_TOKDST = M_TOKW + (size_t)NTOK * 16;
constexpr size_t M_ROWW   = M_TOKDST + (size_t)NTOK * 16;
constexpr size_t WS_NEED  = R_END;
constexpr int CW_BAR = 0;
constexpr int CW_CNT = 8192;
constexpr int CW_META = 4096 + 64;
constexpr int CW_QCTR = 6144;
constexpr int CW_KMAX = 6400;
constexpr size_t CTL_BYTES = 65536;

constexpr int LDS_BYTES = 152576;
constexpr int LDS_MISC = 151552;

typedef float f32x2 __attribute__((ext_vector_type(2)));
typedef __bf16 bf16n2 __attribute__((ext_vector_type(2)));
__device__ __forceinline__ unsigned cvtpk(float lo, float hi) { f32x2 v = {lo, hi}; bf16n2 b = __builtin_convertvector(v, bf16n2); return __builtin_bit_cast(unsigned, b); }
__device__ __forceinline__ bf16_t f2bf(float x) { return (bf16_t)(cvtpk(x, 0.f) & 0xffffu); }
__device__ __forceinline__ float bf2f(bf16_t b) { return __uint_as_float(((unsigned)b) << 16); }
__device__ __forceinline__ float bflo(unsigned w) { return __uint_as_float(w << 16); }
__device__ __forceinline__ float bfhi(unsigned w) { return __uint_as_float(w & 0xffff0000u); }
__device__ __forceinline__ bf16x8 pack8(f32x4 a, f32x4 b) { u32x4 w = {cvtpk(a[0], a[1]), cvtpk(a[2], a[3]), cvtpk(b[0], b[1]), cvtpk(b[2], b[3])}; return *reinterpret_cast<bf16x8*>(&w); }
__device__ __forceinline__ float sigmoidf_(float x) { return 1.0f / (1.0f + __expf(-x)); }
__device__ __forceinline__ float wave_sum(float v) { for (int o = 32; o > 0; o >>= 1) v += __shfl_xor(v, o); return v; }
__device__ __forceinline__ int crow(int r, int hi) { return (r & 3) + 8 * (r >> 2) + 4 * hi; }
#define SBAR() __builtin_amdgcn_sched_barrier(0)

#define XB_TMO      128
#define XB_XCNT(j)  (256  + 64 * (j))
#define XB_XSUB(j)  (1280 + 64 * (j))
#define XB_XGEN(j)  (2304 + 64 * (j))
#define XB_TOP      3328
#define XB_TOPGEN   3392
#define XCD_BAR_WORDS 3456
#define XB_SPIN_CAP (1u << 22)
__device__ __forceinline__ unsigned xb_ld(unsigned* p)              { return __hip_atomic_load(p, __ATOMIC_RELAXED, __HIP_MEMORY_SCOPE_AGENT); }
__device__ __forceinline__ unsigned xb_add(unsigned* p, unsigned v) { return __hip_atomic_fetch_add(p, v, __ATOMIC_RELAXED, __HIP_MEMORY_SCOPE_AGENT); }
__device__ __forceinline__ unsigned xb_xcc_id() { return (unsigned)__builtin_amdgcn_s_getreg((3 << 11) | 20) & 0xFu; }
#define XB_SPIN(cond, bar) do { unsigned _sp = 0; while (cond) { __builtin_amdgcn_s_sleep(1); \
    if ((++_sp & 255u) == 0u) { if (xb_ld(&(bar)[XB_TMO])) break; if (_sp > XB_SPIN_CAP) { atomicAdd(&(bar)[XB_TMO], 1u); break; } } } } while (0)
struct XcdBarrier { unsigned* bar; unsigned x; volatile LAS unsigned* st; };
__device__ __forceinline__ XcdBarrier xcd_barrier_post(unsigned* bar, volatile LAS unsigned* st) {
    XcdBarrier b; b.bar = bar; b.x = xb_xcc_id(); b.st = st;
    if (threadIdx.x == 0) (void)xb_add(&bar[XB_XCNT(b.x)], 1u);
    return b;
}
__device__ __forceinline__ void xcd_barrier_complete(unsigned* bar, unsigned x, unsigned& nloc, unsigned& nx) {
    const unsigned G = gridDim.x * gridDim.y * gridDim.z;
    unsigned sum, cnt, mine, sp = 0u;
    for (;;) {
        sum = 0u; cnt = 0u; mine = 0u;
#pragma unroll
        for (unsigned j = 0; j < 16; ++j) { const unsigned c = xb_ld(&bar[XB_XCNT(j)]); sum += c; cnt += (c > 0u) ? 1u : 0u; mine = (j == x) ? c : mine; }
        if (sum == G) break;
        __builtin_amdgcn_s_sleep(1);
        if ((++sp & 255u) == 0u) { if (xb_ld(&bar[XB_TMO])) break; if (sp > XB_SPIN_CAP) { atomicAdd(&bar[XB_TMO], 1u); break; } }
    }
    nloc = mine > 0u ? mine : 1u; nx = cnt > 0u ? cnt : 1u;
}
__device__ __forceinline__ void xcd_barrier(const XcdBarrier& b) {
    asm volatile("s_waitcnt vmcnt(0)" ::: "memory");
    __syncthreads();
    if (threadIdx.x == 0) {
        unsigned* bar = b.bar;
        __builtin_amdgcn_s_waitcnt(0);
        unsigned nloc = b.st[0], nx = b.st[1];
        if (nloc == 0u) { xcd_barrier_complete(bar, b.x, nloc, nx); b.st[0] = nloc; b.st[1] = nx; }
        const unsigned old = xb_add(&bar[XB_XSUB(b.x)], 1u);
        const unsigned gen = old / nloc;
        if (old + 1u == (gen + 1u) * nloc) {
            __builtin_amdgcn_fence(__ATOMIC_RELEASE, "agent");
            asm volatile("s_waitcnt vmcnt(0)" ::: "memory");
            const unsigned og = xb_add(&bar[XB_TOP], 1u);
            const unsigned tg = og / nx;
            if (og + 1u == (tg + 1u) * nx) xb_add(&bar[XB_TOPGEN], 1u);
            else XB_SPIN(xb_ld(&bar[XB_TOPGEN]) == tg, bar);
            __builtin_amdgcn_fence(__ATOMIC_ACQUIRE, "agent");
            xb_add(&bar[XB_XGEN(b.x)], 1u);
            asm volatile("s_waitcnt vmcnt(0)" ::: "memory");
        } else {
            XB_SPIN(xb_ld(&bar[XB_XGEN(b.x)]) == gen, bar);
            __builtin_amdgcn_fence(__ATOMIC_ACQUIRE, "agent");
            asm volatile("s_waitcnt vmcnt(0)" ::: "memory");
        }
    }
    __syncthreads();
}

namespace pg8 {
constexpr int BM = 256, BK = 64, HALF = 128, HTB = HALF * BK * 2, STAGE_BYTES = 8 * HTB, NXCD = 8, WGM = 8;
__device__ __forceinline__ int lds_byte(int r, int c) { const int st = (r >> 4) * 2 + (c >> 5), rr = r & 15, cc = c & 31, ob = rr * 64 + cc * 2; return st * 1024 + (ob ^ (((ob >> 9) & 1) << 5)); }
__device__ __forceinline__ void stage_rc(int b, int& R, int& C) { const int st = b / 1024, sb = b % 1024, swz = sb ^ (((sb >> 9) & 1) << 5); R = (st >> 1) * 16 + swz / 64; C = (st & 1) * 32 + (swz % 64) / 2; }
__device__ __forceinline__ int perm32(int rho) { const int n = rho >> 4, i = rho & 15; return 8 * (i >> 2) + 4 * n + (i & 3); }
struct Unit { int pm, pn, e; };
struct SchedS {
    int nM, nN, nwg, G, c; const bf16_t* A; const bf16_t* B; int lda, ldb, a_sh, a_mul;
    __device__ void init(int M, int N, int G_, int c_, const bf16_t* A_, int lda_, const bf16_t* B_, int ldb_, int a_sh_ = 0, int a_mul_ = 0) {
        nM = M / BM; nN = N / BM; nwg = nM * nN; G = G_; c = c_; A = A_; B = B_; lda = lda_; ldb = ldb_; a_sh = a_sh_; a_mul = a_mul_; }
    __device__ __forceinline__ bool next(int i, Unit& u) const {
        const long L = (long)i * G + c; if (L >= nwg) return false;
        int wgid = (int)L; { const int q = nwg / NXCD, r = nwg % NXCD, xcd = wgid % NXCD, off = wgid / NXCD; wgid = (xcd < r ? xcd * (q + 1) : r * (q + 1) + (xcd - r) * q) + off; }
        const int nig = WGM * nN, gid = wgid / nig, fm = gid * WGM, gsz = (nM - fm) < WGM ? (nM - fm) : WGM;
        u.pm = fm + ((wgid % nig) % gsz); u.pn = (wgid % nig) / gsz; u.e = 0;
        return true;
    }
    __device__ __forceinline__ const char* pa(const Unit& u) const { return (const char*)(A + (size_t)u.pm * BM * lda + (size_t)((u.pn >> a_sh) * a_mul)); }
    __device__ __forceinline__ const char* pb(const Unit& u) const { return (const char*)(B + (size_t)u.pn * BM * ldb); }
};
struct SchedM {
    int ntiles, G, c; const bf16_t* A; const bf16_t* W; int lda, ldb; const unsigned* tile_e;
    __device__ void init(const unsigned* meta, int G_, int c_, const bf16_t* A_, int lda_, const bf16_t* W_, int ldb_) {
        ntiles = (int)meta[0]; tile_e = meta + 1; G = G_; c = c_; A = A_; W = W_; lda = lda_; ldb = ldb_; }
    __device__ __forceinline__ bool next(int i, Unit& u) const {
        const long L = (long)i * G + c; if (L >= (long)ntiles * 8) return false;
        u.pm = (int)(L >> 3); u.pn = (int)(L & 7); u.e = (int)tile_e[u.pm];
        return true;
    }
    __device__ __forceinline__ const char* pa(const Unit& u) const { return (const char*)(A + (size_t)u.pm * BM * lda); }
    __device__ __forceinline__ const char* pb(const Unit& u) const { return (const char*)(W + ((size_t)u.e * 2048 + (size_t)u.pn * BM) * ldb); }
};

template <class Epi, class Sched>
__device__ __forceinline__ void gemm_phase(LAS unsigned char* lds, const int K, const int lda, const int ldb, const Sched& S, const Epi& E) {
    int tid = threadIdx.x; asm volatile("" : "+v"(tid));
    const int wid = __builtin_amdgcn_readfirstlane(tid >> 6), lane = tid & 63, wr = wid >> 2, wc = wid & 3, fr = lane & 15, fq = lane >> 4;
    const int nt = K / BK;
    unsigned voffA[2], voffB[2];
#pragma unroll
    for (int i = 0; i < 2; ++i) { int R, C; stage_rc(tid * 16 + i * 8192, R, C); const int Rb = (R & ~31) + perm32(R & 31);
        voffA[i] = (unsigned)(R * lda + C) * 2u; voffB[i] = (unsigned)(Rb * ldb + C) * 2u; }
    const size_t kstep = (size_t)(BK * 2);
    const size_t hstepA = (size_t)HALF * lda * 2, hstepB = (size_t)HALF * ldb * 2;
    const unsigned ldsw = (unsigned)wid * 1024u;
    const int aoff = lds_byte(wr * 64 + fr, fq * 8), boff = lds_byte(wc * 32 + fr, fq * 8);
#define PG8_SA(b, h) (((b) * 2 + (h)) * HTB)
#define PG8_SB(b, h) ((4 + (b) * 2 + (h)) * HTB)
#define PG8_STAGE(bufoff, gbase, voff) do { _Pragma("unroll") for (int _i = 0; _i < 2; ++_i) \
        __builtin_amdgcn_global_load_lds((const unsigned*)((const char*)(gbase) + (voff)[_i]), (LAS unsigned*)(lds + (bufoff) + ldsw + _i * 8192), 16, 0, 0); } while (0)
#define PG8_LDA(dst, b, h) do { _Pragma("unroll") for (int m = 0; m < 4; ++m) _Pragma("unroll") for (int k = 0; k < 2; ++k) dst[m][k] = *(const LAS bf16x8*)(lds + PG8_SA(b, h) + aoff + m * 2048 + k * 1024); } while (0)
#define PG8_LDB(dst, b, h) do { _Pragma("unroll") for (int n = 0; n < 2; ++n) _Pragma("unroll") for (int k = 0; k < 2; ++k) dst[n][k] = *(const LAS bf16x8*)(lds + PG8_SB(b, h) + boff + n * 2048 + k * 1024); } while (0)
#define PG8_MMA(ai, bj, At, Bt) do { __builtin_amdgcn_s_setprio(1); _Pragma("unroll") for (int m = 0; m < 4; ++m) _Pragma("unroll") for (int n = 0; n < 2; ++n) _Pragma("unroll") for (int k = 0; k < 2; ++k) \
        acc[ai][bj][m][n] = __builtin_amdgcn_mfma_f32_16x16x32_bf16(Bt[n][k], At[m][k], acc[ai][bj][m][n], 0, 0, 0); __builtin_amdgcn_s_setprio(0); } while (0)
#define PG8_WAIT_V(n) asm volatile("s_waitcnt vmcnt(" #n ")" ::: "memory")
#define PG8_WAIT_L(n) asm volatile("s_waitcnt lgkmcnt(" #n ")" ::: "memory")
#define PG8_BAR __builtin_amdgcn_s_barrier()
#define PG8_SCHED __builtin_amdgcn_sched_barrier(0)
    Unit cur, nxt; int ui = 0;
    if (!S.next(0, cur)) return;
    f32x4 acc[2][2][4][2];
#pragma unroll
    for (int a = 0; a < 2; ++a)
#pragma unroll
        for (int b = 0; b < 2; ++b)
#pragma unroll
            for (int m = 0; m < 4; ++m)
#pragma unroll
                for (int n = 0; n < 2; ++n) acc[a][b][m][n] = (f32x4){0.f, 0.f, 0.f, 0.f};
    bf16x8 At[4][2], B0[2][2], B1[2][2];
    const char* cA = S.pa(cur); const char* cB = S.pb(cur);
    PG8_STAGE(PG8_SB(0, 0), cB, voffB); PG8_STAGE(PG8_SA(0, 0), cA, voffA); PG8_STAGE(PG8_SB(0, 1), cB + hstepB, voffB); PG8_STAGE(PG8_SA(0, 1), cA + hstepA, voffA);
    if (wr == 1) PG8_BAR;
    PG8_WAIT_V(4); PG8_BAR;
    PG8_STAGE(PG8_SB(1, 0), cB + kstep, voffB); PG8_STAGE(PG8_SA(1, 0), cA + kstep, voffA); PG8_STAGE(PG8_SB(1, 1), cB + hstepB + kstep, voffB);
    PG8_WAIT_V(6); PG8_BAR;
    for (;;) {
        const bool has_next = S.next(ui + 1, nxt);
        const char* nA = has_next ? S.pa(nxt) : cA; const char* nB = has_next ? S.pb(nxt) : cB;
        for (int t = 0; t < nt; t += 2) {
            const bool last = (t == nt - 2);
            if constexpr (Epi::HAS_MID) { if (t == Epi::MID1 || t == Epi::MID2) { int frM = fr, fqM = fq; asm volatile("" : "+v"(frM), "+v"(fqM)); E.mid(acc, cur, t, wr, wc, frM, fqM); } }
            const char* a1 = cA + (size_t)(t + 1) * kstep;
            const char* a2 = last ? nA : cA + (size_t)(t + 2) * kstep; const char* b2 = last ? nB : cB + (size_t)(t + 2) * kstep;
            const char* a3 = a2 + kstep; const char* b3 = b2 + kstep;
            PG8_LDB(B0, 0, 0); PG8_SCHED; PG8_LDA(At, 0, 0); PG8_STAGE(PG8_SA(1, 1), a1 + hstepA, voffA);
            PG8_WAIT_L(8); PG8_BAR; PG8_WAIT_L(0); PG8_MMA(0, 0, At, B0); PG8_BAR; PG8_SCHED;
            PG8_LDB(B1, 0, 1); PG8_STAGE(PG8_SB(0, 0), b2, voffB);
            PG8_BAR; PG8_WAIT_L(0); PG8_MMA(0, 1, At, B1); PG8_BAR;
            PG8_LDA(At, 0, 1); PG8_STAGE(PG8_SA(0, 0), a2, voffA);
            PG8_BAR; PG8_WAIT_L(0); PG8_MMA(1, 0, At, B0); PG8_BAR; PG8_SCHED;
            PG8_STAGE(PG8_SB(0, 1), b2 + hstepB, voffB);
            PG8_WAIT_V(6); PG8_BAR; PG8_MMA(1, 1, At, B1); PG8_BAR;
            PG8_LDB(B0, 1, 0); PG8_SCHED; PG8_LDA(At, 1, 0); PG8_STAGE(PG8_SA(0, 1), a2 + hstepA, voffA);
            PG8_WAIT_L(8); PG8_BAR; PG8_WAIT_L(0); PG8_MMA(0, 0, At, B0); PG8_BAR; PG8_SCHED;
            PG8_LDB(B1, 1, 1); PG8_STAGE(PG8_SB(1, 0), b3, voffB);
            PG8_BAR; PG8_WAIT_L(0); PG8_MMA(0, 1, At, B1); PG8_BAR;
            PG8_LDA(At, 1, 1); PG8_STAGE(PG8_SA(1, 0), a3, voffA);
            PG8_BAR; PG8_WAIT_L(0); PG8_MMA(1, 0, At, B0); PG8_BAR; PG8_SCHED;
            PG8_STAGE(PG8_SB(1, 1), b3 + hstepB, voffB);
            PG8_WAIT_V(6); PG8_BAR; PG8_MMA(1, 1, At, B1); PG8_BAR;
        }
        { int frE = fr, fqE = fq; asm volatile("" : "+v"(frE), "+v"(fqE)); E(acc, cur, wr, wc, frE, fqE); }
        if (!has_next) break;
#pragma unroll
        for (int a = 0; a < 2; ++a)
#pragma unroll
            for (int b = 0; b < 2; ++b)
#pragma unroll
                for (int m = 0; m < 4; ++m)
#pragma unroll
                    for (int n = 0; n < 2; ++n) acc[a][b][m][n] = (f32x4){0.f, 0.f, 0.f, 0.f};
        cur = nxt; cA = nA; cB = nB; ++ui;
    }
    PG8_WAIT_V(0);
    if (wr == 0) PG8_BAR;
    PG8_BAR;
#undef PG8_SA
#undef PG8_SB
#undef PG8_STAGE
#undef PG8_LDA
#undef PG8_LDB
#undef PG8_MMA
#undef PG8_WAIT_V
#undef PG8_WAIT_L
#undef PG8_BAR
#undef PG8_SCHED
}

#define EPI_LOOP_ROWS _Pragma("unroll") for (int ai = 0; ai < 2; ++ai) _Pragma("unroll") for (int m = 0; m < 4; ++m)
__device__ __forceinline__ void st_bf16x8(bf16_t* p, f32x4 v0, f32x4 v1) { u32x4 w; w.x = cvtpk(v0[0], v0[1]); w.y = cvtpk(v0[2], v0[3]); w.z = cvtpk(v1[0], v1[1]); w.w = cvtpk(v1[2], v1[3]); *(u32x4*)p = w; }

struct EpiInProj {
    static constexpr bool HAS_MID = false;
    bf16_t* qa; bf16_t* qidx; bf16_t* qkv; bf16_t* gates; float* small_;
    __device__ __forceinline__ void operator()(const f32x4 (&acc)[2][2][4][2], const Unit& u, int wr, int wc, int fr, int fq) const {
        const int pn = u.pn, row0 = u.pm * BM + wr * 64 + fr, lc0 = wc * 32 + fq * 8;
        if (pn < 8) {
            bf16_t* base = (pn < 4 ? qa + pn * 256 : qidx + (pn - 4) * 256) + lc0;
            EPI_LOOP_ROWS { const int row = row0 + ai * HALF + m * 16;
#pragma unroll
                for (int bj = 0; bj < 2; ++bj) st_bf16x8(base + (size_t)row * 1024 + bj * HALF, acc[ai][bj][m][0], acc[ai][bj][m][1]); }
        } else if (pn < 32) {
            const int id = (pn - 8) >> 2, hb = ((pn - 8) & 3) * 2, b = u.pm >> 5;
            bf16_t* base = qkv + (size_t)id * ((size_t)NTOK * 1024) + lc0;
            EPI_LOOP_ROWS { const int row = row0 + ai * HALF + m * 16, s = row & (SEQ - 1);
#pragma unroll
                for (int bj = 0; bj < 2; ++bj) st_bf16x8(base + ((size_t)(b * 8 + hb + bj) * SEQ + s) * 128, acc[ai][bj][m][0], acc[ai][bj][m][1]); }
        } else if (pn < 56) {
            bf16_t* base = gates + (pn - 32) * 256 + lc0;
            EPI_LOOP_ROWS { const int row = row0 + ai * HALF + m * 16;
#pragma unroll
                for (int bj = 0; bj < 2; ++bj) st_bf16x8(base + (size_t)row * 6144 + bj * HALF, acc[ai][bj][m][0], acc[ai][bj][m][1]); }
        } else {
            float* base = small_ + (pn - 56) * 256 + lc0;
            EPI_LOOP_ROWS { const int row = row0 + ai * HALF + m * 16;
#pragma unroll
                for (int bj = 0; bj < 2; ++bj) { float* p = base + (size_t)row * 512 + bj * HALF; *(f32x4*)p = acc[ai][bj][m][0]; *(f32x4*)(p + 4) = acc[ai][bj][m][1]; } }
        }
    }
};
struct EpiBf16 {
    static constexpr bool HAS_MID = false;
    bf16_t* out; int ld, cstep;
    __device__ __forceinline__ void operator()(const f32x4 (&acc)[2][2][4][2], const Unit& u, int wr, int wc, int fr, int fq) const {
        const int row0 = u.pm * BM + wr * 64 + fr; bf16_t* base = out + (size_t)u.pn * cstep + wc * 32 + fq * 8;
        EPI_LOOP_ROWS { const int row = row0 + ai * HALF + m * 16;
#pragma unroll
            for (int bj = 0; bj < 2; ++bj) st_bf16x8(base + (size_t)row * ld + bj * HALF, acc[ai][bj][m][0], acc[ai][bj][m][1]); }
    }
};
template <int MODE> struct EpiBranch {
    static constexpr bool HAS_MID = false;
    const bf16_t* gates; float* tmp; bf16_t* merged; int br;
    __device__ __forceinline__ void operator()(const f32x4 (&acc)[2][2][4][2], const Unit& u, int wr, int wc, int fr, int fq) const {
        const int row0 = u.pm * BM + wr * 64 + fr, col0 = u.pn * BM + wc * 32 + fq * 8;
        EPI_LOOP_ROWS { const int row = row0 + ai * HALF + m * 16;
#pragma unroll
            for (int bj = 0; bj < 2; ++bj) { const int col = col0 + bj * HALF;
                const u32x4 gw = *(const u32x4*)(gates + (size_t)row * 6144 + br * 2048 + col);
                f32x4 v0 = acc[ai][bj][m][0], v1 = acc[ai][bj][m][1];
                v0[0] *= sigmoidf_(bflo(gw.x)); v0[1] *= sigmoidf_(bfhi(gw.x)); v0[2] *= sigmoidf_(bflo(gw.y)); v0[3] *= sigmoidf_(bfhi(gw.y));
                v1[0] *= sigmoidf_(bflo(gw.z)); v1[1] *= sigmoidf_(bfhi(gw.z)); v1[2] *= sigmoidf_(bflo(gw.w)); v1[3] *= sigmoidf_(bfhi(gw.w));
                float* tp = tmp + (size_t)row * 2048 + col;
                if (MODE >= 1) { v0 += *(const f32x4*)tp; v1 += *(const f32x4*)(tp + 4); }
                if (MODE <= 1) { *(f32x4*)tp = v0; *(f32x4*)(tp + 4) = v1; }
                else st_bf16x8(merged + (size_t)row * 2048 + col, v0, v1); } }
    }
};
struct EpiBranch3 {
    static constexpr bool HAS_MID = true; static constexpr int MID1 = 16, MID2 = 32;
    const bf16_t* gates; bf16_t* merged;
    __device__ __forceinline__ void mid(f32x4 (&acc)[2][2][4][2], const Unit& u, int t, int wr, int wc, int fr, int fq) const {
        const int row0 = u.pm * BM + wr * 64 + fr, col0 = u.pn * BM + wc * 32 + fq * 8, bn = (t == MID1) ? 0 : 2048;
#pragma unroll
        for (int ai = 0; ai < 2; ++ai)
#pragma unroll
            for (int m = 0; m < 4; ++m) { const int row = row0 + ai * HALF + m * 16;
#pragma unroll
                for (int bj = 0; bj < 2; ++bj) { const bf16_t* gp = gates + (size_t)row * 6144 + bn + col0 + bj * HALF;
                    const u32x4 gn = *(const u32x4*)gp, gd = *(const u32x4*)(gp + 2048);
                    f32x4 r0, r1;
                    r0[0] = (1.f + __expf(-bflo(gd.x))) / (1.f + __expf(-bflo(gn.x))); r0[1] = (1.f + __expf(-bfhi(gd.x))) / (1.f + __expf(-bfhi(gn.x)));
                    r0[2] = (1.f + __expf(-bflo(gd.y))) / (1.f + __expf(-bflo(gn.y))); r0[3] = (1.f + __expf(-bfhi(gd.y))) / (1.f + __expf(-bfhi(gn.y)));
                    r1[0] = (1.f + __expf(-bflo(gd.z))) / (1.f + __expf(-bflo(gn.z))); r1[1] = (1.f + __expf(-bfhi(gd.z))) / (1.f + __expf(-bfhi(gn.z)));
                    r1[2] = (1.f + __expf(-bflo(gd.w))) / (1.f + __expf(-bflo(gn.w))); r1[3] = (1.f + __expf(-bfhi(gd.w))) / (1.f + __expf(-bfhi(gn.w)));
                    acc[ai][bj][m][0] *= r0; acc[ai][bj][m][1] *= r1; } }
    }
    __device__ __forceinline__ void operator()(const f32x4 (&acc)[2][2][4][2], const Unit& u, int wr, int wc, int fr, int fq) const {
        const int row0 = u.pm * BM + wr * 64 + fr, col0 = u.pn * BM + wc * 32 + fq * 8;
#pragma unroll
        for (int ai = 0; ai < 2; ++ai)
#pragma unroll
            for (int m = 0; m < 4; ++m) { const int row = row0 + ai * HALF + m * 16;
#pragma unroll
                for (int bj = 0; bj < 2; ++bj) { const int col = col0 + bj * HALF;
                    const u32x4 gw = *(const u32x4*)(gates + (size_t)row * 6144 + 4096 + col);
                    f32x4 v0 = acc[ai][bj][m][0], v1 = acc[ai][bj][m][1];
                    v0[0] *= sigmoidf_(bflo(gw.x)); v0[1] *= sigmoidf_(bfhi(gw.x)); v0[2] *= sigmoidf_(bflo(gw.y)); v0[3] *= sigmoidf_(bfhi(gw.y));
                    v1[0] *= sigmoidf_(bflo(gw.z)); v1[1] *= sigmoidf_(bfhi(gw.z)); v1[2] *= sigmoidf_(bflo(gw.w)); v1[3] *= sigmoidf_(bfhi(gw.w));
                    st_bf16x8(merged + (size_t)row * 2048 + col, v0, v1); } }
    }
};
struct EpiOut {
    static constexpr bool HAS_MID = false;
    const float* res; float* pre;
    __device__ __forceinline__ void operator()(const f32x4 (&acc)[2][2][4][2], const Unit& u, int wr, int wc, int fr, int fq) const {
        const int row0 = u.pm * BM + wr * 64 + fr, col0 = u.pn * BM + wc * 32 + fq * 8;
        EPI_LOOP_ROWS { const int row = row0 + ai * HALF + m * 16;
#pragma unroll
            for (int bj = 0; bj < 2; ++bj) { const size_t o = (size_t)row * 2048 + col0 + bj * HALF;
                const f32x4 r0 = *(const f32x4*)(res + o), r1 = *(const f32x4*)(res + o + 4);
                *(f32x4*)(pre + o) = r0 * ALPHA + acc[ai][bj][m][0]; *(f32x4*)(pre + o + 4) = r1 * ALPHA + acc[ai][bj][m][1]; } }
    }
};
struct EpiGateUp {
    static constexpr bool HAS_MID = false;
    const float* bg; const float* bu; bf16_t* hid;
    __device__ __forceinline__ void operator()(const f32x4 (&acc)[2][2][4][2], const Unit& u, int wr, int wc, int fr, int fq) const {
        const int row0 = u.pm * BM + wr * 64 + fr, j0 = u.pn * 128 + wc * 32 + fq * 8;
        const float* pg = bg + (size_t)u.e * DEXP + j0; const float* pu = bu + (size_t)u.e * DEXP + j0;
        const f32x4 g0b = *(const f32x4*)pg, g1b = *(const f32x4*)(pg + 4), u0b = *(const f32x4*)pu, u1b = *(const f32x4*)(pu + 4);
        EPI_LOOP_ROWS { const int row = row0 + ai * HALF + m * 16;
            f32x4 h0, h1;
#pragma unroll
            for (int j = 0; j < 4; ++j) {
                float g = fminf(acc[ai][0][m][0][j] + g0b[j], 7.0f), uu = fminf(fmaxf(acc[ai][1][m][0][j] + u0b[j], -7.0f), 7.0f);
                h0[j] = (uu + 1.0f) * (g * sigmoidf_(1.702f * g));
                g = fminf(acc[ai][0][m][1][j] + g1b[j], 7.0f); uu = fminf(fmaxf(acc[ai][1][m][1][j] + u1b[j], -7.0f), 7.0f);
                h1[j] = (uu + 1.0f) * (g * sigmoidf_(1.702f * g)); }
            st_bf16x8(hid + (size_t)row * DEXP + j0, h0, h1); }
    }
};
struct EpiDown {
    static constexpr bool HAS_MID = false;
    const float* bd; const float* roww; bf16_t* ys;
    __device__ __forceinline__ void operator()(const f32x4 (&acc)[2][2][4][2], const Unit& u, int wr, int wc, int fr, int fq) const {
        const int row0 = u.pm * BM + wr * 64 + fr, col0 = u.pn * BM + wc * 32 + fq * 8;
        f32x4 b[2][2];
#pragma unroll
        for (int bj = 0; bj < 2; ++bj) { const float* p = bd + (size_t)u.e * DM + col0 + bj * HALF; b[bj][0] = *(const f32x4*)p; b[bj][1] = *(const f32x4*)(p + 4); }
        EPI_LOOP_ROWS { const int row = row0 + ai * HALF + m * 16; const float w = roww[row];
#pragma unroll
            for (int bj = 0; bj < 2; ++bj) st_bf16x8(ys + (size_t)row * 2048 + col0 + bj * HALF, (acc[ai][bj][m][0] + b[bj][0]) * w, (acc[ai][bj][m][1] + b[bj][1]) * w); }
    }
};
struct EpiPleGate {
    static constexpr bool HAS_MID = false;
    const float* hf; const bf16_t* pp; float* pre;
    __device__ __forceinline__ void operator()(const f32x4 (&acc)[2][2][4][2], const Unit& u, int wr, int wc, int fr, int fq) const {
        const int row0 = u.pm * BM + wr * 64 + fr, col0 = u.pn * BM + wc * 32 + fq * 8;
        EPI_LOOP_ROWS { const int row = row0 + ai * HALF + m * 16;
#pragma unroll
            for (int bj = 0; bj < 2; ++bj) { const size_t o = (size_t)row * 2048 + col0 + bj * HALF;
                const u32x4 pw = *(const u32x4*)(pp + o); const f32x4 h0 = *(const f32x4*)(hf + o), h1 = *(const f32x4*)(hf + o + 4);
                const f32x4 a0 = acc[ai][bj][m][0], a1 = acc[ai][bj][m][1]; f32x4 o0, o1;
                o0[0] = h0[0] + sigmoidf_(a0[0]) * bflo(pw.x); o0[1] = h0[1] + sigmoidf_(a0[1]) * bfhi(pw.x); o0[2] = h0[2] + sigmoidf_(a0[2]) * bflo(pw.y); o0[3] = h0[3] + sigmoidf_(a0[3]) * bfhi(pw.y);
                o1[0] = h1[0] + sigmoidf_(a1[0]) * bflo(pw.z); o1[1] = h1[1] + sigmoidf_(a1[1]) * bfhi(pw.z); o1[2] = h1[2] + sigmoidf_(a1[2]) * bflo(pw.w); o1[3] = h1[3] + sigmoidf_(a1[3]) * bfhi(pw.w);
                *(f32x4*)(pre + o) = o0; *(f32x4*)(pre + o + 4) = o1; } }
    }
};
}

struct Params { const float* in[25]; float* out; unsigned char* ws; int ph_lo, ph_hi; };
__constant__ float c_invf_r[16] = {1.000000000e+00f, 4.403665960e-01f, 1.939227432e-01f, 8.539710194e-02f, 3.760603070e-02f, 1.656043902e-02f, 7.292664610e-03f, 3.211445874e-03f, 1.414213562e-03f, 6.227723788e-04f, 2.742481884e-04f, 1.207697351e-04f, 5.318296098e-05f, 2.341999971e-05f, 1.031338616e-05f, 4.541670478e-06f};
__constant__ float c_invf_i[8] = {1.000000000e+00f, 1.939227432e-01f, 3.760603070e-02f, 7.292664610e-03f, 1.414213562e-03f, 2.742481884e-04f, 5.318296098e-05f, 1.031338616e-05f};
constexpr int LDS_PTRS = LDS_MISC + 256;
struct Frame { unsigned char* lds; LAS unsigned char* ldsl; unsigned char* ws; int tid, lane, wid, G, bid;
    __device__ __forceinline__ const float* in(int k) const { const LAS unsigned* t = (const LAS unsigned*)(ldsl + LDS_PTRS) + 2 * k;
        const unsigned lo = __builtin_amdgcn_readfirstlane(t[0]), hi = __builtin_amdgcn_readfirstlane(t[1]); return (const float*)(((unsigned long long)hi << 32) | lo); }
    __device__ __forceinline__ float* out() const { return (float*)in(25); } };
__device__ __forceinline__ Frame fresh(const Frame& F0) { Frame F = F0; int t = threadIdx.x; asm volatile("" : "+v"(t)); F.tid = t; F.lane = t & 63; F.wid = __builtin_amdgcn_readfirstlane(t >> 6); unsigned char* w = F0.ws; asm volatile("" : "+s"(w)); F.ws = w; return F; }

struct TcTile { const float* src; long sld; bf16_t* dst; long dld; int nvalid; };
template <class Dec>
__device__ __forceinline__ void tconv_run(const Frame& F, int total, const Dec& dec, int& rot) {
    float* tile = (float*)F.lds;
    const int tid = F.tid, G = F.G;
    const int start = (F.bid - (rot % G) + G) % G; rot += total;
    const int lr = tid >> 4, lc4 = (tid & 15) * 4, sn = tid >> 3, skc = (tid & 7) * 8;
    f32x4 v[4][2];
#define TC_ISSUE(t0_) do { _Pragma("unroll") for (int q = 0; q < 4; ++q) { const int t = (t0_) + q * G; \
        if (t < total) { const TcTile ti = dec(t); _Pragma("unroll") for (int h = 0; h < 2; ++h) { v[q][h] = (f32x4){0.f, 0.f, 0.f, 0.f}; \
            if (lc4 < ti.nvalid) v[q][h] = *(const f32x4*)(ti.src + (size_t)(lr + 32 * h) * ti.sld + lc4); } } } } while (0)
    if (start < total) TC_ISSUE(start);
    for (int t0 = start; t0 < total; t0 += 4 * G) {
#pragma unroll
        for (int q = 0; q < 4; ++q) { if (t0 + q * G < total) { float* tl = tile + q * (64 * 65);
#pragma unroll
                for (int h = 0; h < 2; ++h) { float* p = tl + (lr + 32 * h) * 65 + lc4; p[0] = v[q][h][0]; p[1] = v[q][h][1]; p[2] = v[q][h][2]; p[3] = v[q][h][3]; } } }
        __syncthreads();
        if (t0 + 4 * G < total) TC_ISSUE(t0 + 4 * G);
#pragma unroll
        for (int q = 0; q < 4; ++q) { const int t = t0 + q * G;
            if (t < total) { const TcTile ti = dec(t); const float* tl = tile + q * (64 * 65);
                if (sn < ti.nvalid) { f32x4 a, b;
#pragma unroll
                    for (int j = 0; j < 4; ++j) { a[j] = tl[(skc + j) * 65 + sn]; b[j] = tl[(skc + 4 + j) * 65 + sn]; }
                    pg8::st_bf16x8(ti.dst + (size_t)sn * ti.dld + skc, a, b); } } }
        __syncthreads();
    }
#undef TC_ISSUE
}
struct TcMat {
    const float* src; long src_ld; int tk, ncols; bf16_t* dst; long dst_ld;
    __device__ __forceinline__ TcTile operator()(int t) const { const int k0 = (t % tk) * 64, n0 = (t / tk) * 64; TcTile ti;
        ti.src = src + (size_t)k0 * src_ld + n0; ti.sld = src_ld; ti.dst = dst + (size_t)n0 * dst_ld + k0; ti.dld = dst_ld; ti.nvalid = (ncols - n0) < 64 ? (ncols - n0) : 64; return ti; }
};
__device__ __forceinline__ void tconv(const Frame& F, const float* src, long src_ld, int K, int ncols, bf16_t* dst, long dst_ld, int& rot) {
    TcMat d{src, src_ld, K >> 6, ncols, dst, dst_ld}; tconv_run(F, (K >> 6) * ((ncols + 63) >> 6), d, rot);
}
struct TcExperts {
    const float* wg; const float* wu; const float* wd; bf16_t* dgu; bf16_t* ddn;
    __device__ __forceinline__ TcTile operator()(int t) const { const int e = t / 1536, r = t - e * 1536; TcTile ti; ti.nvalid = 64;
        if (r < 1024) { const int k0 = (r & 31) * 64, dt = r >> 5, jb = dt >> 2, gu = (dt >> 1) & 1, half = dt & 1;
            ti.src = (const float*)((unsigned long long)wg + (unsigned long long)gu * ((unsigned long long)wu - (unsigned long long)wg)) + (size_t)e * DM * DEXP + (size_t)k0 * DEXP + jb * 128 + half * 64; ti.sld = DEXP;
            ti.dst = dgu + (size_t)e * 2048 * 2048 + (size_t)(dt * 64) * 2048 + k0; ti.dld = 2048; }
        else { const int r2 = r - 1024, k0 = (r2 & 15) * 64, n0 = (r2 >> 4) * 64;
            ti.src = wd + (size_t)e * DEXP * DM + (size_t)k0 * DM + n0; ti.sld = DM;
            ti.dst = ddn + (size_t)e * 2048 * 1024 + (size_t)n0 * 1024 + k0; ti.dld = 1024; }
        return ti; }
};
__device__ __forceinline__ void conv_rows(const Frame& F, const float* src, bf16_t* dst, size_t n8) {
    for (size_t i = (size_t)F.bid * 512 + F.tid; i < n8; i += (size_t)F.G * 512) { const f32x4 a = *(const f32x4*)(src + i * 8), b = *(const f32x4*)(src + i * 8 + 4); pg8::st_bf16x8(dst + i * 8, a, b); }
}
__constant__ int c_so[14] = {0, 1312, 2416, 3440, 4464, 5496, 6520, 7544, 8568, 1024, 1280, 2336, 2400, 5488};
__constant__ int c_dn[14] = {0, 1024, 2048, 3072, 4096, 5120, 6144, 7168, 8192, 14336, 14592, 14624, 14688, 14704};
__constant__ int c_nc[14] = {1024, 1024, 1024, 1024, 1024, 1024, 1024, 1024, 6144, 256, 32, 64, 16, 8};
__device__ __forceinline__ void convert_layer_weights(const Frame& F0, const Params& P, int l) { const Frame F = fresh(F0);
    unsigned char* ws = F.ws; int rot = 0;
    { const float* w = F.in(2) + (size_t)l * DM * INW; bf16_t* d = (bf16_t*)(ws + W_IN);
#pragma unroll 1
      for (int s = 0; s < 14; ++s) tconv(F, w + c_so[s], INW, DM, c_nc[s], d + (size_t)c_dn[s] * DM, DM, rot); }
    tconv(F, F.in(7) + (size_t)l * 1024 * DM, DM, 1024, DM, (bf16_t*)(ws + W_BRA), 3072, rot);
    tconv(F, F.in(8) + (size_t)l * 1024 * DM, DM, 1024, DM, (bf16_t*)(ws + W_BRA) + 1024, 3072, rot);
    tconv(F, F.in(9) + (size_t)l * 1024 * DM, DM, 1024, DM, (bf16_t*)(ws + W_BRA) + 2048, 3072, rot);
    tconv(F, F.in(10) + (size_t)l * DM * DM, DM, DM, DM, (bf16_t*)(ws + W_OUT), DM, rot);
    tconv(F, F.in(21) + (size_t)l * DM * DM, DM, DM, DM, (bf16_t*)(ws + W_PG), DM, rot);
    tconv(F, F.in(22) + (size_t)l * 256 * DM, DM, 256, DM, (bf16_t*)(ws + W_PLE), 256, rot);
#pragma unroll 1
    for (int h = 0; h < 8; ++h) tconv(F, F.in(6) + (size_t)l * 256 * 1024 + h * 128, 1024, 256, 128, (bf16_t*)(ws + W_UV2) + ((size_t)(h >> 1) * 256 + (h & 1) * 128) * 512 + (h & 1) * 256, 512, rot);
    { TcExperts d{F.in(15) + (size_t)l * NEXP * DM * DEXP, F.in(17) + (size_t)l * NEXP * DM * DEXP, F.in(19) + (size_t)l * NEXP * DEXP * DM, (bf16_t*)(ws + W_GU), (bf16_t*)(ws + W_DN)};
      tconv_run(F, NEXP * 1536, d, rot); }
    { const float* w = F.in(5) + (size_t)l * 256 * 8 * 96; bf16_t* d = (bf16_t*)(ws + W_UK2);
      for (int i = F.bid * 512 + F.tid; i < 256 * 8 * 96; i += F.G * 512) { const int n = i % 96, h = (i / 96) & 7, r = i / 768; d[((size_t)h * 256 + r) * 256 + (h & 1) * 128 + 32 + n] = f2bf(w[i]); } }
}

__device__ __forceinline__ void rope_cs(float pos, float invf, float& c, float& s) {
    const float a = pos * invf; const double ad = (double)a * 0.15915494309189535; const float fr = (float)(ad - rint(ad));
    s = __builtin_amdgcn_sinf(fr); c = __builtin_amdgcn_cosf(fr);
}
__device__ __forceinline__ void phase_prep(const Frame& F0, const Params& P, int l) { const Frame F = fresh(F0);
    unsigned char* ws = F.ws; const int lane = F.lane;
    const float* smallb = (const float*)(ws + R_SMALL); bf16_t* kcat = (bf16_t*)(ws + R_KCAT); bf16_t* qcat = (bf16_t*)(ws + R_QCAT);
    bf16_t* ki = (bf16_t*)(ws + R_KI); float* wi = (float*)(ws + R_WI); float* lf = (float*)(ws + WS_LF);
    const bf16_t* qa = (const bf16_t*)(ws + R_QA); bf16_t* qidx = (bf16_t*)(ws + R_QIDX);
    const f32x4 gck = *(const f32x4*)(F.in(4) + l * 256 + lane * 4);
    const float bfo = lane < 8 ? F.in(3)[l * 8 + lane] : 0.f;
    const float ifr = c_invf_r[lane & 15], ifi = c_invf_i[lane & 7];
    for (int tok = F.bid * 8 + F.wid; tok < NTOK; tok += F.G * 8) {
        const int s = tok & (SEQ - 1), b = tok >> 13; const float* sm = smallb + (size_t)tok * 512;
        float cr, sr, ci, si; rope_cs((float)s, ifr, cr, sr); rope_cs((float)s, ifi, ci, si);
        { const f32x4 v = *(const f32x4*)(sm + lane * 4); float ss = v[0] * v[0] + v[1] * v[1] + v[2] * v[2] + v[3] * v[3]; ss = wave_sum(ss);
          const float rs = rsqrtf(ss * (1.0f / 256.0f) + 1e-6f); u32x2 w; w.x = cvtpk(v[0] * rs * gck[0], v[1] * rs * gck[1]); w.y = cvtpk(v[2] * rs * gck[2], v[3] * rs * gck[3]);
          *(u32x2*)(kcat + (size_t)tok * 288 + lane * 4) = w; }
        if (lane < 16) { const float x1 = sm[256 + lane], x2 = sm[272 + lane]; kcat[(size_t)tok * 288 + 256 + lane] = f2bf(x1 * cr - x2 * sr); kcat[(size_t)tok * 288 + 272 + lane] = f2bf(x2 * cr + x1 * sr); }
        { float o = sm[288 + lane];
          if (lane < 8) { const float x2 = sm[296 + lane]; o = o * ci - x2 * si; } else if (lane < 16) { const float x1 = sm[288 + lane - 8]; o = o * ci + x1 * si; }
          ki[(size_t)tok * 64 + lane] = f2bf(o); }
        if (lane < 16) wi[(size_t)tok * 16 + lane] = sm[352 + lane] * (1.0f / 32.0f);
        if (lane < 8) { const float f = sm[368 + lane] + bfo; lf[(size_t)(b * 8 + lane) * SEQ + s] = fminf(f, 0.f) - log1pf(__expf(-fabsf(f))); }
#pragma unroll
        for (int pp = 0; pp < 2; ++pp) { const int p = lane + 64 * pp, h = p >> 4, i = p & 15;
            const float x1 = bf2f(qa[(size_t)tok * 1024 + h * 128 + i]), x2 = bf2f(qa[(size_t)tok * 1024 + h * 128 + 16 + i]);
            qcat[(size_t)tok * 2304 + h * 288 + 256 + i] = f2bf(x1 * cr - x2 * sr); qcat[(size_t)tok * 2304 + h * 288 + 272 + i] = f2bf(x2 * cr + x1 * sr); }
#pragma unroll
        for (int pp = 0; pp < 2; ++pp) { const int p = lane + 64 * pp, hh = p >> 3, i = p & 7; bf16_t* q = qidx + (size_t)tok * 1024 + hh * 64;
            const float x1 = bf2f(q[i]), x2 = bf2f(q[8 + i]); q[i] = f2bf(x1 * ci - x2 * si); q[8 + i] = f2bf(x2 * ci + x1 * si); }
    }
    { const bf16_t* kbt = (const bf16_t*)(ws + R_QKV) + (size_t)NTOK * 1024; unsigned* kmx = (unsigned*)(ws + WS_CTL) + CW_KMAX + l * 16;
#pragma unroll 1
      for (int bh = 0; bh < 16; ++bh) { float mx = 0.f;
          for (int r0 = (F.bid * 8 + F.wid) * 4; r0 < SEQ; r0 += F.G * 32) {
              const u32x4 w = *(const u32x4*)(kbt + ((size_t)bh * SEQ + r0 + (lane >> 4)) * 128 + (lane & 15) * 8);
              float ss = bflo(w.x) * bflo(w.x) + bfhi(w.x) * bfhi(w.x) + bflo(w.y) * bflo(w.y) + bfhi(w.y) * bfhi(w.y) + bflo(w.z) * bflo(w.z) + bfhi(w.z) * bfhi(w.z) + bflo(w.w) * bflo(w.w) + bfhi(w.w) * bfhi(w.w);
              ss += __shfl_xor(ss, 1); ss += __shfl_xor(ss, 2); ss += __shfl_xor(ss, 4); ss += __shfl_xor(ss, 8); mx = fmaxf(mx, ss); }
          mx = fmaxf(mx, __shfl_xor(mx, 16)); mx = fmaxf(mx, __shfl_xor(mx, 32));
          if (lane == 0) ((float*)F.lds)[F.wid * 16 + bh] = mx; }
      __syncthreads();
      if (F.tid < 16) { float mx = 0.f;
#pragma unroll
          for (int w = 0; w < 8; ++w) mx = fmaxf(mx, ((const float*)F.lds)[w * 16 + F.tid]);
          const unsigned bits = __float_as_uint(mx);
          if (bits > __hip_atomic_load(&kmx[F.tid], __ATOMIC_RELAXED, __HIP_MEMORY_SCOPE_AGENT)) atomicMax(&kmx[F.tid], bits); }
      __syncthreads(); }
}
__device__ __forceinline__ void phase_cumsum(const Frame& F0) { const Frame F = fresh(F0);
    const int gw = F.bid * 8 + F.wid; if (gw >= 16) return;
    const float* lf = (const float*)(F.ws + WS_LF) + (size_t)gw * SEQ; float* cum = (float*)(F.ws + WS_CUM) + (size_t)gw * SEQ;
    const int lane = F.lane; double tot = 0.0;
    for (int j = 0; j < 128; ++j) tot += (double)lf[lane * 128 + j];
    double inc = tot;
    for (int o = 1; o < 64; o <<= 1) { const double n = __shfl_up(inc, o); if (lane >= o) inc += n; }
    double run = inc - tot;
    for (int j = 0; j < 128; ++j) { run += (double)lf[lane * 128 + j]; cum[lane * 128 + j] = (float)run; }
}

__device__ __forceinline__ void idx_group32(const Frame& F, int b, int g) {
    const int tid = F.tid, lane = F.lane, rho = lane & 31, hh = lane >> 5; unsigned char* ws = F.ws;
    const bf16_t* qidx = (const bf16_t*)(ws + R_QIDX); const bf16_t* ki = (const bf16_t*)(ws + R_KI) + (size_t)b * SEQ * 64; const float* wi = (const float*)(ws + R_WI);
    float* scores = (float*)(ws + R_SCORES) + (size_t)b * SEQ * SEQ;
    LAS unsigned char* kl = F.ldsl;
    const int T0 = g * 32, t0 = T0 + F.wid * 4;
    bf16x8 af[2][4]; float wv[2][16];
#pragma unroll
    for (int mt = 0; mt < 2; ++mt) {
        const int tokA = b * SEQ + t0 + 2 * mt + ((rho >> 2) & 1), head = (rho & 3) + 4 * (rho >> 3);
#pragma unroll
        for (int kk = 0; kk < 4; ++kk) af[mt][kk] = *(const bf16x8*)(qidx + (size_t)tokA * 1024 + head * 64 + kk * 16 + 8 * hh);
        const float* wp = wi + (size_t)(b * SEQ + t0 + 2 * mt + hh) * 16;
#pragma unroll
        for (int q = 0; q < 4; ++q) { const f32x4 v = *(const f32x4*)(wp + 4 * q); wv[mt][4 * q] = v[0]; wv[mt][4 * q + 1] = v[1]; wv[mt][4 * q + 2] = v[2]; wv[mt][4 * q + 3] = v[3]; }
    }
    const int nchunk = (T0 + 31) / 128 + 1;
    const int r0 = tid >> 3, p0 = tid & 7;
    const unsigned d0 = (unsigned)(r0 * 128 + ((p0 ^ (r0 & 7)) << 4)), d1 = d0 + 64 * 128;
    u32x4 s0, s1;
    s0 = *(const u32x4*)(ki + (size_t)r0 * 64 + p0 * 8); s1 = *(const u32x4*)(ki + (size_t)(r0 + 64) * 64 + p0 * 8);
    __syncthreads();
    *(LAS u32x4*)(kl + d0) = s0; *(LAS u32x4*)(kl + d1) = s1;
    __syncthreads();
    const unsigned rdo = (unsigned)(rho * 128);
#pragma unroll 1
    for (int c = 0; c < nchunk; ++c) {
        const unsigned bo = (unsigned)(c & 1) * 16384u;
        if (c + 1 < nchunk) { const bf16_t* kp = ki + (size_t)((c + 1) * 128) * 64; s0 = *(const u32x4*)(kp + (size_t)r0 * 64 + p0 * 8); s1 = *(const u32x4*)(kp + (size_t)(r0 + 64) * 64 + p0 * 8); }
#pragma unroll
        for (int tl = 0; tl < 4; ++tl) {
            const int kb = c * 128 + tl * 32;
            if (kb <= t0 + 3) {
                bf16x8 bc[4];
#pragma unroll
                for (int kk = 0; kk < 4; ++kk) bc[kk] = *(const LAS bf16x8*)(kl + bo + tl * 4096 + rdo + (((kk * 2 + hh) ^ (rho & 7)) << 4));
                f32x16 a0 = {}, a1 = {};
#pragma unroll
                for (int kk = 0; kk < 4; ++kk) { a0 = __builtin_amdgcn_mfma_f32_32x32x16_bf16(af[0][kk], bc[kk], a0, 0, 0, 0); a1 = __builtin_amdgcn_mfma_f32_32x32x16_bf16(af[1][kk], bc[kk], a1, 0, 0, 0); }
                float x0 = 0.f, x1 = 0.f, x2 = 0.f, x3 = 0.f, y0 = 0.f, y1 = 0.f, y2 = 0.f, y3 = 0.f;
#pragma unroll
                for (int r = 0; r < 16; r += 4) {
                    x0 = fmaf(wv[0][r], fmaxf(a0[r], 0.f), x0); x1 = fmaf(wv[0][r + 1], fmaxf(a0[r + 1], 0.f), x1); x2 = fmaf(wv[0][r + 2], fmaxf(a0[r + 2], 0.f), x2); x3 = fmaf(wv[0][r + 3], fmaxf(a0[r + 3], 0.f), x3);
                    y0 = fmaf(wv[1][r], fmaxf(a1[r], 0.f), y0); y1 = fmaf(wv[1][r + 1], fmaxf(a1[r + 1], 0.f), y1); y2 = fmaf(wv[1][r + 2], fmaxf(a1[r + 2], 0.f), y2); y3 = fmaf(wv[1][r + 3], fmaxf(a1[r + 3], 0.f), y3); }
                scores[(size_t)(t0 + hh) * SEQ + kb + rho] = (x0 + x1) + (x2 + x3);
                scores[(size_t)(t0 + 2 + hh) * SEQ + kb + rho] = (y0 + y1) + (y2 + y3);
            }
        }
        if (c + 1 < nchunk) { *(LAS u32x4*)(kl + (bo ^ 16384u) + d0) = s0; *(LAS u32x4*)(kl + (bo ^ 16384u) + d1) = s1; }
        __syncthreads();
    }
}
__device__ __forceinline__ void phase_idx(const Frame& F0) { const Frame F = fresh(F0);
#pragma unroll 1
    for (int it = F.bid; it < 256; it += F.G) { const int b = it >> 7, i = it & 127; idx_group32(F, b, i); idx_group32(F, b, 255 - i); }
}

__device__ __forceinline__ unsigned sortable(float f) { const unsigned u = __float_as_uint(f); return (u & 0x80000000u) ? ~u : (u | 0x80000000u); }
__device__ __forceinline__ void topk_row(const Frame& F, int b, int t) {
    const int lane = F.lane, L = t + 1, tok = b * SEQ + t; unsigned char* ws = F.ws;
    int* sel = (int*)(ws + R_SEL) + (size_t)tok * 256; int* nsel = (int*)(ws + R_NSEL);
    if (lane == 0) nsel[tok] = L < 256 ? L : 256;
    if (L <= 256) { for (int j = lane; j < 256; j += 64) sel[j] = j < L ? j : 0; return; }
    const float* row = (const float*)(ws + R_SCORES) + ((size_t)b * SEQ + t) * SEQ;
    const int nch = (L + 1023) >> 10;
    unsigned u[128];
#pragma unroll
    for (int c = 0; c < 8; ++c) {
        if (c < nch) {
#pragma unroll
            for (int jj = 0; jj < 4; ++jj) { const int j = c * 4 + jj; const f32x4 v = *(const f32x4*)(row + j * 256 + lane * 4);
#pragma unroll
                for (int e = 0; e < 4; ++e) { const int idx = j * 256 + lane * 4 + e; u[j * 4 + e] = idx < L ? sortable(v[e]) : 0u; } }
        } else {
#pragma unroll
            for (int q = 0; q < 16; ++q) u[c * 16 + q] = 0u;
        }
    }
    unsigned T = 0u, thr_gt = 0u; int need_eq = 0; bool early = false;
    for (int bit = 31; bit >= 0; --bit) {
        const unsigned cand = T | (1u << bit); int cnt = 0;
#pragma unroll
        for (int c = 0; c < 8; ++c) if (c < nch) {
#pragma unroll
            for (int q = 0; q < 16; ++q) cnt += __popcll(__ballot(u[c * 16 + q] >= cand)); }
        if (cnt >= 256) { T = cand; if (cnt == 256) { early = true; break; } }
    }
    if (early) { thr_gt = T - 1u; need_eq = 0; }
    else { int gtc = 0;
#pragma unroll
        for (int c = 0; c < 8; ++c) if (c < nch) {
#pragma unroll
            for (int q = 0; q < 16; ++q) gtc += __popcll(__ballot(u[c * 16 + q] > T)); }
        thr_gt = T; need_eq = 256 - gtc; }
    int base = 0, eq_taken = 0;
#pragma unroll
    for (int c = 0; c < 8; ++c) if (c < nch) {
#pragma unroll
        for (int q = 0; q < 16; ++q) { const int rq = c * 16 + q; const unsigned v = u[rq];
            const bool iseq = (v == thr_gt) && (need_eq > 0);
            const unsigned long long meq = __ballot(iseq);
            const int eqr = __popcll(meq & ((1ull << lane) - 1ull));
            const bool take = (v > thr_gt) || (iseq && (eq_taken + eqr < need_eq));
            const unsigned long long mt = __ballot(take);
            const int pos = base + __popcll(mt & ((1ull << lane) - 1ull));
            if (take && pos < 256) sel[pos] = (rq >> 2) * 256 + lane * 4 + (rq & 3);
            base += __popcll(mt); eq_taken += __popcll(meq); } }
}
__device__ __forceinline__ void phase_topk(const Frame& F0) { const Frame F = fresh(F0);
    for (int q = F.bid * 8 + F.wid; q < 8192; q += F.G * 8) { const int b = q >> 12, p = q & 4095; topk_row(F, b, p); topk_row(F, b, SEQ - 1 - p); }
}

namespace att {
constexpr int D = 128, KVBLK = 64, QBLK = 32, SHM_V = 16384, SHM_K = 16384;
constexpr int OFF_K = 2 * SHM_V, OFF_BIAS = 2 * SHM_V + 2 * SHM_K, OFF_WS = OFF_BIAS + 512, OFF_FLAGS = OFF_WS + 2048, OFF_QITEM = OFF_FLAGS + 64;
constexpr float EXIT_T = 64.0f;
#define KSWZ(row, colB) ((row) * 256 + ((colB) ^ (((row) & 7) << 4)))
__device__ __forceinline__ int v_st(int k, int c) { const int kk = (k & ~0xC) | ((k & 4) << 1) | ((k & 8) >> 1); return ((kk >> 3) * 4 + (c >> 5)) * 512 + ((kk & 7) * 32 + (c & 31)) * 2; }
__device__ __forceinline__ int v_rd_base(int lane) { return ((lane & 3) << 3) | (((lane >> 2) & 3) << 6) | (((lane >> 4) & 1) << 5) | (((lane >> 5) & 1) << 8); }
constexpr int v_rd_off(int d0, int ks, int half) { return d0 * 512 + ks * 4096 + half * 2048; }
template <int KB>
__device__ __forceinline__ void qkt(f32x16& p0, f32x16& p1, const char* K_lds, int r32, int hi, const bf16x8* qr) {
    p0 = f32x16{}; p1 = f32x16{};
    const char* kb[4];
#pragma unroll
    for (int dd = 0; dd < 4; ++dd) kb[dd] = K_lds + KB * SHM_K + KSWZ(r32, (dd * 16 + hi * 8) * 2);
#pragma unroll
    for (int d0 = 0; d0 < 8; ++d0) { const char* a = kb[d0 & 3] + (d0 >> 2) * 128;
        bf16x8 b0 = *reinterpret_cast<const bf16x8*>(a);
        bf16x8 b1 = *reinterpret_cast<const bf16x8*>(a + 32 * 256);
        p0 = __builtin_amdgcn_mfma_f32_32x32x16_bf16(b0, qr[d0], p0, 0, 0, 0);
        p1 = __builtin_amdgcn_mfma_f32_32x32x16_bf16(b1, qr[d0], p1, 0, 0, 0); }
}
template <int VB>
__device__ __forceinline__ void pv_tile(f32x16* o, int vb0, bf16x8 pa0, bf16x8 pa1, bf16x8 pa2, bf16x8 pa3) {
#define TRRD(dst, off) asm volatile("ds_read_b64_tr_b16 %0, %1 offset:%2" : "=&v"(dst) : "v"(vb0), "i"(off) : "memory")
#define PV_D0(d0) do { s16x4 l0, l1, l2, l3, h0, h1, h2, h3; constexpr int b_ = VB * SHM_V + v_rd_off(d0, 0, 0); \
        TRRD(l0, b_); TRRD(h0, b_ + 2048); TRRD(l1, b_ + 4096); TRRD(h1, b_ + 6144); TRRD(l2, b_ + 8192); TRRD(h2, b_ + 10240); TRRD(l3, b_ + 12288); TRRD(h3, b_ + 14336); \
        asm volatile("s_waitcnt lgkmcnt(0)" ::: "memory"); SBAR(); \
        o[d0] = __builtin_amdgcn_mfma_f32_32x32x16_bf16(pa0, (bf16x8){l0[0], l0[1], l0[2], l0[3], h0[0], h0[1], h0[2], h0[3]}, o[d0], 0, 0, 0); \
        o[d0] = __builtin_amdgcn_mfma_f32_32x32x16_bf16(pa1, (bf16x8){l1[0], l1[1], l1[2], l1[3], h1[0], h1[1], h1[2], h1[3]}, o[d0], 0, 0, 0); \
        o[d0] = __builtin_amdgcn_mfma_f32_32x32x16_bf16(pa2, (bf16x8){l2[0], l2[1], l2[2], l2[3], h2[0], h2[1], h2[2], h2[3]}, o[d0], 0, 0, 0); \
        o[d0] = __builtin_amdgcn_mfma_f32_32x32x16_bf16(pa3, (bf16x8){l3[0], l3[1], l3[2], l3[3], h3[0], h3[1], h3[2], h3[3]}, o[d0], 0, 0, 0); } while (0)
    PV_D0(0); PV_D0(1); PV_D0(2); PV_D0(3);
#undef PV_D0
#undef TRRD
}
#define PK4(P, B_, OUT) do { unsigned a0 = cvtpk(P[B_+0], P[B_+1]), a1 = cvtpk(P[B_+2], P[B_+3]); \
        unsigned b0 = cvtpk(P[B_+4], P[B_+5]), b1 = cvtpk(P[B_+6], P[B_+7]); \
        auto r0 = __builtin_amdgcn_permlane32_swap(a0, b0, false, false); auto r1 = __builtin_amdgcn_permlane32_swap(a1, b1, false, false); \
        u32x4 w = {r0[0], r1[0], r0[1], r1[1]}; OUT = *reinterpret_cast<bf16x8*>(&w); } while (0)
__device__ __forceinline__ float swap_max(float x) { auto rr = __builtin_amdgcn_permlane32_swap(__float_as_uint(x), __float_as_uint(x), false, false); return fmaxf(__uint_as_float(rr[0]), __uint_as_float(rr[1])); }
__device__ __forceinline__ float swap_sum(float x) { auto rr = __builtin_amdgcn_permlane32_swap(__float_as_uint(x), __float_as_uint(x), false, false); return __uint_as_float(rr[0]) + __uint_as_float(rr[1]); }
__device__ __forceinline__ float swap_lo(float x) { auto rr = __builtin_amdgcn_permlane32_swap(__float_as_uint(x), __float_as_uint(x), false, false); return __uint_as_float(rr[0]); }


__device__ __forceinline__ void fox_sm(f32x16& p0, f32x16& p1, const float* bl, int kb_, int qlo, int qrow, int hi, int r32, float& m_reg, float& l_reg, f32x16* o, float* al_l,
                                       bf16x8& pa0, bf16x8& pa1, bf16x8& pa2, bf16x8& pa3) {
#pragma unroll
    for (int g = 0; g < 4; ++g) { const f32x4 b0v = *(const f32x4*)(bl + 8 * g + 4 * hi), b1v = *(const f32x4*)(bl + 32 + 8 * g + 4 * hi);
#pragma unroll
        for (int i = 0; i < 4; ++i) { p0[4 * g + i] = fmaf(p0[4 * g + i], C2, b0v[i]); p1[4 * g + i] = fmaf(p1[4 * g + i], C2, b1v[i]); } }
    if (kb_ + KVBLK - 1 > qlo) { const float NEG = -__builtin_inff();
#pragma unroll
        for (int r = 0; r < 16; ++r) { const int key = kb_ + crow(r, hi); if (key > qrow) p0[r] = NEG; if (key + 32 > qrow) p1[r] = NEG; } }
    float pmax = p0[0];
#pragma unroll
    for (int r = 1; r < 16; ++r) pmax = fmaxf(pmax, p0[r]);
#pragma unroll
    for (int r = 0; r < 16; ++r) pmax = fmaxf(pmax, p1[r]);
    pmax = swap_max(pmax);
    const float mn = fmaxf(m_reg, pmax), alpha = __builtin_amdgcn_exp2f(m_reg - mn); m_reg = mn;
    float ps = 0.f;
#pragma unroll
    for (int r = 0; r < 16; ++r) { p0[r] = __builtin_amdgcn_exp2f(p0[r] - mn); p1[r] = __builtin_amdgcn_exp2f(p1[r] - mn); ps += p0[r] + p1[r]; }
    ps = swap_sum(ps); l_reg = l_reg * alpha + ps;
    if (__any(alpha < 1.f)) { if (hi == 0) al_l[r32] = alpha; asm volatile("s_waitcnt lgkmcnt(0)" ::: "memory");
#pragma unroll
        for (int r = 0; r < 16; ++r) { const float a = al_l[crow(r, hi)];
#pragma unroll
            for (int d_ = 0; d_ < 4; ++d_) o[d_][r] *= a; } }
    PK4(p0, 0, pa0); PK4(p0, 8, pa1); PK4(p1, 0, pa2); PK4(p1, 8, pa3);
}
__device__ __forceinline__ void sb_half(f32x16& pz, int keybase, int qrow, int hi, float& R, const bf16x8* triA, bool needmask) {
    f32x16 X;
#pragma unroll
    for (int r = 0; r < 16; ++r) { const float zz = pz[r] * C2; const bool valid = !needmask || (keybase + crow(r, hi) < qrow);
        const float l2 = fmaxf(zz, 0.f) + __builtin_amdgcn_logf(1.0f + __builtin_amdgcn_exp2f(-fabsf(zz)));
        X[r] = valid ? -l2 : 0.f; pz[r] = valid ? zz : -__builtin_inff(); }
    f32x16 Y;
#pragma unroll
    for (int r = 0; r < 16; ++r) Y[r] = R;
#pragma unroll
    for (int s = 0; s < 2; ++s) {
        const unsigned h0 = cvtpk(X[8 * s + 0], X[8 * s + 1]), h1 = cvtpk(X[8 * s + 2], X[8 * s + 3]), h2 = cvtpk(X[8 * s + 4], X[8 * s + 5]), h3 = cvtpk(X[8 * s + 6], X[8 * s + 7]);
        const unsigned l0 = cvtpk(X[8 * s + 0] - bflo(h0), X[8 * s + 1] - bfhi(h0)), l1 = cvtpk(X[8 * s + 2] - bflo(h1), X[8 * s + 3] - bfhi(h1));
        const unsigned l2 = cvtpk(X[8 * s + 4] - bflo(h2), X[8 * s + 5] - bfhi(h2)), l3 = cvtpk(X[8 * s + 6] - bflo(h3), X[8 * s + 7] - bfhi(h3));
        u32x4 wh = {h0, h1, h2, h3}, wl = {l0, l1, l2, l3};
        Y = __builtin_amdgcn_mfma_f32_32x32x16_bf16(triA[s], *reinterpret_cast<bf16x8*>(&wh), Y, 0, 0, 0);
        Y = __builtin_amdgcn_mfma_f32_32x32x16_bf16(triA[s], *reinterpret_cast<bf16x8*>(&wl), Y, 0, 0, 0); }
#pragma unroll
    for (int r = 0; r < 16; ++r) pz[r] = __builtin_amdgcn_exp2f(pz[r] + Y[r]);
    R = swap_lo(Y[0]);
}
__device__ __forceinline__ void sb_sm(f32x16& p0, f32x16& p1, int kb_, int qlo, int qrow, int hi, float& R, const bf16x8* triA, bf16x8& pa0, bf16x8& pa1, bf16x8& pa2, bf16x8& pa3) {
    const bool needmask = (kb_ + KVBLK - 1 >= qlo);
    sb_half(p1, kb_ + 32, qrow, hi, R, triA, needmask);
    sb_half(p0, kb_, qrow, hi, R, triA, needmask);
    PK4(p0, 0, pa0); PK4(p0, 8, pa1); PK4(p1, 0, pa2); PK4(p1, 8, pa3);
}

template <int MODE>
__device__ __forceinline__ void attn_unit(const bf16_t* Q, const bf16_t* Kh, const bf16_t* Vh, const float* cum, bf16_t* O, int P0, char* lds, float kmaxc) {
    int tid = threadIdx.x; asm volatile("" : "+v"(tid));
    const int wid = __builtin_amdgcn_readfirstlane(tid >> 6), lane = tid & 63, r32 = lane & 31, hi = lane >> 5;
    const int NT = P0 / KVBLK + 4;
    char* V_lds = lds; char* K_lds = lds + OFF_K; float* bias_l = (float*)(lds + OFF_BIAS);
    float* wsl = (float*)(lds + OFF_WS) + wid * 64; float* li_l = wsl; float* al_l = wsl + 32;
    const int qlo = P0 + wid * QBLK, qrow = qlo + r32;
    bf16x8 qr[8];
#pragma unroll
    for (int d0 = 0; d0 < 8; ++d0) qr[d0] = *(const bf16x8*)(Q + (size_t)qrow * D + d0 * 16 + hi * 8);
    const int sr = tid >> 4, sc = (tid & 15) * 8, vst0 = v_st(sr, sc), vst1 = v_st(32 + sr, sc), kws = KSWZ(sr, sc * 2);
    const int vb0 = (int)(uintptr_t)V_lds + v_rd_base(lane);
    const float cumref = (MODE == 0) ? cum[P0] : 0.f;
    int* flg = (int*)(lds + OFF_FLAGS);
    float qn = 0.f;
    if (MODE == 0) { float ss = 0.f;
#pragma unroll
        for (int d0 = 0; d0 < 8; ++d0)
#pragma unroll
            for (int j = 0; j < 8; ++j) { const float x = bf2f((bf16_t)qr[d0][j]); ss = fmaf(x, x, ss); }
        ss = swap_sum(ss); qn = sqrtf(ss) * kmaxc * 1.001f; }
    float m_reg = -1e30f, l_reg = 0.f, R = 0.f; f32x16 o[4] = {};
    bf16x8 triA[2];
    if (MODE == 1) {
#pragma unroll
        for (int s = 0; s < 2; ++s)
#pragma unroll
            for (int j = 0; j < 8; ++j) { const int rho = 16 * s + 8 * (j >> 2) + 4 * hi + (j & 3); triA[s][j] = (rho >= r32) ? (short)0x3F80 : (short)0; }
    }
    bf16x8 st_k0, st_k1, st_v0, st_v1; float st_b = 0.f;
#define TILE_KB(t) ((NT - 1 - (t)) * KVBLK)
#define SLOAD(kb_) do { st_v0 = *(const bf16x8*)(Vh + (size_t)((kb_) + sr) * D + sc); st_v1 = *(const bf16x8*)(Vh + (size_t)((kb_) + 32 + sr) * D + sc); \
                        st_k0 = *(const bf16x8*)(Kh + (size_t)((kb_) + sr) * D + sc); st_k1 = *(const bf16x8*)(Kh + (size_t)((kb_) + 32 + sr) * D + sc); \
                        if (MODE == 0 && tid < 64) st_b = (cumref - cum[(kb_) + tid]) * LOG2E; } while (0)
#define SWRITE(bf) do { *(bf16x8*)(V_lds + (bf) * SHM_V + vst0) = st_v0; *(bf16x8*)(V_lds + (bf) * SHM_V + vst1) = st_v1; \
                        *(bf16x8*)(K_lds + (bf) * SHM_K + kws) = st_k0; *(bf16x8*)(K_lds + (bf) * SHM_K + kws + 32 * 256) = st_k1; \
                        if (MODE == 0 && tid < 64) bias_l[(bf) * 64 + tid] = st_b; } while (0)
    __syncthreads();
    SLOAD(TILE_KB(0)); SWRITE(0);
    __syncthreads();
    f32x16 p0, p1; bf16x8 pa0, pa1, pa2, pa3;
#define STEP(BUF, t) do { const int kb_ = TILE_KB(t); \
        if ((t) + 1 < NT) SLOAD(TILE_KB((t) + 1)); \
        SBAR(); qkt<BUF>(p0, p1, K_lds, r32, hi, qr); \
        if (MODE == 0) fox_sm(p0, p1, bias_l + (BUF) * 64, kb_, qlo, qrow, hi, r32, m_reg, l_reg, o, al_l, pa0, pa1, pa2, pa3); \
        else sb_sm(p0, p1, kb_, qlo, qrow, hi, R, triA, pa0, pa1, pa2, pa3); \
        SBAR(); pv_tile<BUF>(o, vb0, pa0, pa1, pa2, pa3); \
        if ((t) + 1 < NT) SWRITE((BUF) ^ 1); \
        __syncthreads(); } while (0)
    for (int t = 0; t < NT; t += 2) {
        STEP(0, t); STEP(1, t + 1);
        const int kbc = TILE_KB(t + 1); if (kbc == 0) break;
        bool done;
        if (MODE == 0) { const float edge = (cumref - cum[kbc - 1]) * LOG2E; done = (qn + edge - m_reg) < -EXIT_T; }
        else done = R < -EXIT_T;
        const int par = (t >> 1) & 1;
        if (lane == 0) flg[par * 8 + wid] = 0;
        const bool wdone = __all(done);
        if (lane == 0 && wdone) flg[par * 8 + wid] = 1;
        __syncthreads();
        int alld = 1;
#pragma unroll
        for (int w = 0; w < 8; ++w) alld &= flg[par * 8 + w];
        if (alld) break;
    }
    __syncthreads();
#undef STEP
#undef SLOAD
#undef SWRITE
#undef TILE_KB
    float rli[16];
    if (MODE == 0) { if (hi == 0) li_l[r32] = l_reg; asm volatile("s_waitcnt lgkmcnt(0)" ::: "memory");
#pragma unroll
        for (int r = 0; r < 16; ++r) rli[r] = __builtin_amdgcn_rcpf(li_l[crow(r, hi)]); }
    bf16_t* Ow = O + (size_t)(wid * QBLK) * 3072;
#pragma unroll
    for (int r = 0; r < 16; ++r) { const int orow = crow(r, hi);
#pragma unroll
        for (int d0 = 0; d0 < 4; ++d0) { const float v = (MODE == 0) ? o[d0][r] * rli[r] : o[d0][r];
            const float vn = __shfl_xor(v, 1);
            if ((r32 & 1) == 0) *(unsigned*)(Ow + (size_t)orow * 3072 + d0 * 32 + r32) = cvtpk(v, vn); } }
}
}

__device__ __forceinline__ void sparse_query(const Frame& F, int tok, char* ldsw) {
    unsigned char* ws = F.ws; const int lane = F.lane, g = lane >> 4, i16 = lane & 15;
    const bf16_t* qcat = (const bf16_t*)(ws + R_QCAT) + (size_t)tok * 2304; const bf16_t* kbase = (const bf16_t*)(ws + R_KCAT) + (size_t)(tok >> 13) * SEQ * 288;
    const int* sel = (const int*)(ws + R_SEL) + (size_t)tok * 256; const int ns = ((const int*)(ws + R_NSEL))[tok]; const int ntile = (ns + 31) >> 5;
    bf16x8 qf[9];
#pragma unroll
    for (int st = 0; st < 9; ++st) { qf[st] = (bf16x8){0, 0, 0, 0, 0, 0, 0, 0}; if (i16 < 8) qf[st] = *(const bf16x8*)(qcat + i16 * 288 + st * 32 + 8 * g); }
    const int rA = lane >> 2, cq = lane & 3;
    float m = -1e30f, l = 0.f; f32x4 oT[16];
#pragma unroll
    for (int rb = 0; rb < 16; ++rb) oT[rb] = (f32x4){0.f, 0.f, 0.f, 0.f};
    const unsigned ldso = (unsigned)(uintptr_t)ldsw;
    const unsigned vb = ldso + (unsigned)((4 * g + (i16 >> 2)) * 592 + (i16 & 3) * 8);
    constexpr float SC2 = SCALE * LOG2E;
    bf16x8 stg[18];
#define GATHER(tile_) do { const int j0 = (tile_) * 32 + rA, j1 = j0 + 16; const int s0 = j0 < ns ? sel[j0] : 0, s1 = j1 < ns ? sel[j1] : 0; \
        const bf16_t* p0_ = kbase + (size_t)s0 * 288 + cq * 8; const bf16_t* p1_ = kbase + (size_t)s1 * 288 + cq * 8; \
        _Pragma("unroll") for (int c = 0; c < 9; ++c) { stg[2 * c] = *(const bf16x8*)(p0_ + c * 32); stg[2 * c + 1] = *(const bf16x8*)(p1_ + c * 32); } } while (0)
    GATHER(0);
    for (int tile = 0; tile < ntile; ++tile) {
#pragma unroll
        for (int c = 0; c < 9; ++c) { *(bf16x8*)(ldsw + rA * 592 + c * 64 + cq * 16) = stg[2 * c]; *(bf16x8*)(ldsw + (16 + rA) * 592 + c * 64 + cq * 16) = stg[2 * c + 1]; }
        if (tile + 1 < ntile) GATHER(tile + 1);
        asm volatile("s_waitcnt lgkmcnt(0)" ::: "memory"); SBAR();
        f32x4 acc[2];
#pragma unroll
        for (int mt = 0; mt < 2; ++mt) { acc[mt] = (f32x4){0.f, 0.f, 0.f, 0.f};
#pragma unroll
            for (int st = 0; st < 9; ++st) { const bf16x8 a = *(const bf16x8*)(ldsw + (16 * mt + i16) * 592 + st * 64 + g * 16);
                acc[mt] = __builtin_amdgcn_mfma_f32_16x16x32_bf16(a, qf[st], acc[mt], 0, 0, 0); } }
        float tmax = -__builtin_inff();
#pragma unroll
        for (int mt = 0; mt < 2; ++mt)
#pragma unroll
            for (int r = 0; r < 4; ++r) { const int key = tile * 32 + 16 * mt + 4 * g + r; float x = acc[mt][r] * SC2; if (key >= ns) x = -__builtin_inff(); acc[mt][r] = x; tmax = fmaxf(tmax, x); }
        tmax = fmaxf(tmax, __shfl_xor(tmax, 16)); tmax = fmaxf(tmax, __shfl_xor(tmax, 32));
        const float mn = fmaxf(m, tmax), alpha = __builtin_amdgcn_exp2f(m - mn); m = mn;
        float ps = 0.f;
#pragma unroll
        for (int mt = 0; mt < 2; ++mt)
#pragma unroll
            for (int r = 0; r < 4; ++r) { acc[mt][r] = __builtin_amdgcn_exp2f(acc[mt][r] - mn); ps += acc[mt][r]; }
        ps += __shfl_xor(ps, 16); ps += __shfl_xor(ps, 32);
        l = l * alpha + ps;
#pragma unroll
        for (int rb = 0; rb < 16; ++rb) oT[rb] *= alpha;
        const bf16x8 pf = pack8(acc[0], acc[1]);
#define TRRD2(dst, off) asm volatile("ds_read_b64_tr_b16 %0, %1 offset:%2" : "=&v"(dst) : "v"(vb), "i"(off) : "memory")
#define PVRB(rb) do { s16x4 t1, t2; TRRD2(t1, (rb) * 32); TRRD2(t2, (rb) * 32 + 16 * 592); asm volatile("s_waitcnt lgkmcnt(0)" ::: "memory"); SBAR(); \
        oT[rb] = __builtin_amdgcn_mfma_f32_16x16x32_bf16((bf16x8){t1[0], t1[1], t1[2], t1[3], t2[0], t2[1], t2[2], t2[3]}, pf, oT[rb], 0, 0, 0); } while (0)
        PVRB(0); PVRB(1); PVRB(2); PVRB(3); PVRB(4); PVRB(5); PVRB(6); PVRB(7); PVRB(8); PVRB(9); PVRB(10); PVRB(11); PVRB(12); PVRB(13); PVRB(14); PVRB(15);
#undef PVRB
#undef TRRD2
        SBAR();
    }
#undef GATHER
    const float rl = 1.0f / l;
    if (i16 < 8) { bf16_t* op = (bf16_t*)(ws + R_OLAT) + (size_t)tok * 2048 + i16 * 256 + 4 * g;
#pragma unroll
        for (int rb = 0; rb < 16; ++rb) { u32x2 w; w.x = cvtpk(oT[rb][0] * rl, oT[rb][1] * rl); w.y = cvtpk(oT[rb][2] * rl, oT[rb][3] * rl); *(u32x2*)(op + rb * 16) = w; } }
}
#ifdef ATT_SUB
#define ASUB(k) ((k) == ATT_SUB)
#else
#define ASUB(k) true
#endif
__device__ __forceinline__ void phase_attn(const Frame& F0, int l, int rep) { const Frame F = fresh(F0);
    unsigned char* ws = F.ws; char* lds = (char*)F.lds;
    const bf16_t* qkv = (const bf16_t*)(ws + R_QKV); const size_t TS = (size_t)NTOK * 1024;
    unsigned* qctr = (unsigned*)(ws + WS_CTL) + CW_QCTR + l * 64 + rep * 16; const unsigned* kmx = (const unsigned*)(ws + WS_CTL) + CW_KMAX + l * 16;
    int* qitem = (int*)(lds + att::OFF_QITEM);
#pragma unroll 1
    for (;;) {
        __syncthreads();
        if (F.tid == 0) qitem[0] = (int)atomicAdd(qctr, 1u);
        __syncthreads();
        const int it = qitem[0];
        if (it >= 1024) break;
        const int md = it >> 9, j = it & 511, qb = 31 - (j >> 4), bh = j & 15, b = bh >> 3, h = bh & 7, P0 = qb * 256;
        if (!ASUB(md)) continue;
        const bf16_t* Q = qkv + (size_t)(md * 3 + 0) * TS + (size_t)bh * SEQ * 128; const bf16_t* K = qkv + (size_t)(md * 3 + 1) * TS + (size_t)bh * SEQ * 128; const bf16_t* V = qkv + (size_t)(md * 3 + 2) * TS + (size_t)bh * SEQ * 128;
        const float* cum = (const float*)(ws + WS_CUM) + (size_t)bh * SEQ;
        bf16_t* Ob = (bf16_t*)(ws + R_OA) + (size_t)b * SEQ * 3072 + (md + 1) * 1024 + h * 128;
        if (md == 0) { const float kmaxc = sqrtf(__uint_as_float(kmx[bh])) * C2; att::attn_unit<0>(Q, K, V, cum, Ob + (size_t)P0 * 3072, P0, lds, kmaxc); }
        else att::attn_unit<1>(Q, K, V, cum, Ob + (size_t)P0 * 3072, P0, lds, 0.f);
    }
    __syncthreads();
    char* ldsw = lds + F.wid * 18944;
#pragma unroll 1
    for (int rep = 0; rep < NREP(2); ++rep)
#pragma unroll 1
    for (int tok = F.bid * 8 + F.wid; tok < NTOK; tok += F.G * 8) if (ASUB(2)) sparse_query(F, tok, ldsw);
}

__device__ __forceinline__ void ln_row(const float* src, const float* g, const float* bta, float* of, bf16_t* ob, int lane) {
    f32x4 v[8]; float s = 0.f;
#pragma unroll
    for (int i = 0; i < 8; ++i) { v[i] = *(const f32x4*)(src + (i * 64 + lane) * 4); s += (v[i][0] + v[i][1]) + (v[i][2] + v[i][3]); }
    s = wave_sum(s); const float mu = s * (1.0f / 2048.0f); float q = 0.f;
#pragma unroll
    for (int i = 0; i < 8; ++i) { const f32x4 d = v[i] - mu; q += (d[0] * d[0] + d[1] * d[1]) + (d[2] * d[2] + d[3] * d[3]); }
    q = wave_sum(q); const float rstd = rsqrtf(q * (1.0f / 2048.0f) + 1e-5f);
#pragma unroll
    for (int i = 0; i < 8; ++i) { const int c = (i * 64 + lane) * 4; const f32x4 gg = *(const f32x4*)(g + c), bb = *(const f32x4*)(bta + c); const f32x4 y = (v[i] - mu) * rstd * gg + bb;
        if (of) *(f32x4*)(of + c) = y;
        if (ob) { u32x2 w; w.x = cvtpk(y[0], y[1]); w.y = cvtpk(y[2], y[3]); *(u32x2*)(ob + c) = w; } }
}
__device__ __forceinline__ void phase_ln1_router(const Frame& F0, const Params& P, int l) { const Frame F = fresh(F0);
    unsigned char* ws = F.ws; const int lane = F.lane, wid = F.wid;
    const float* pre1 = (const float*)(ws + R_PRE1); float* x1f = (float*)(ws + M_X1F); bf16_t* x1b = (bf16_t*)(ws + M_X1B);
    const float* g = F.in(11) + l * DM; const float* bt = F.in(12) + l * DM; const float* wr = F.in(13) + (size_t)l * DM * NEXP; const float* br = F.in(14) + l * NEXP;
    unsigned* cnt = (unsigned*)(ws + WS_CTL) + CW_CNT + l * 2048;
    int* tok_e = (int*)(ws + M_TOKE); int* tok_pos = (int*)(ws + M_TOKPOS); float* tok_w = (float*)(ws + M_TOKW);
    float* red = (float*)F.lds;
    float* lg = (float*)(F.lds + 32768);
#pragma unroll 1
    for (int blk = F.bid; blk < NTOK / 64; blk += F.G) {
        const int tok0 = blk * 64;
#pragma unroll 1
        for (int i = 0; i < 8; ++i) { const int tok = tok0 + wid * 8 + i; ln_row(pre1 + (size_t)tok * DM, g, bt, x1f + (size_t)tok * DM, x1b + (size_t)tok * DM, lane); }
        asm volatile("s_waitcnt vmcnt(0)" ::: "memory"); __syncthreads();
        { const int grp = wid >> 2, kq = wid & 3, i32 = lane & 31, hk = lane >> 5; f32x16 acc = {};
          const float* arow = x1f + (size_t)(tok0 + grp * 32 + i32) * DM + kq * 512 + 4 * hk; const float* bcol = wr + (size_t)(kq * 512 + 4 * hk) * NEXP + i32;
#pragma unroll 4
          for (int c8 = 0; c8 < 64; ++c8) { const f32x4 a4 = *(const f32x4*)(arow + c8 * 8);
              const float b0 = bcol[(size_t)(c8 * 8 + 0) * NEXP], b1 = bcol[(size_t)(c8 * 8 + 1) * NEXP], b2 = bcol[(size_t)(c8 * 8 + 2) * NEXP], b3 = bcol[(size_t)(c8 * 8 + 3) * NEXP];
              acc = __builtin_amdgcn_mfma_f32_32x32x2f32(a4[0], b0, acc, 0, 0, 0); acc = __builtin_amdgcn_mfma_f32_32x32x2f32(a4[1], b1, acc, 0, 0, 0);
              acc = __builtin_amdgcn_mfma_f32_32x32x2f32(a4[2], b2, acc, 0, 0, 0); acc = __builtin_amdgcn_mfma_f32_32x32x2f32(a4[3], b3, acc, 0, 0, 0); }
#pragma unroll
          for (int r = 0; r < 16; ++r) red[(wid * 16 + r) * 64 + lane] = acc[r]; }
        __syncthreads();
        if ((wid & 3) == 0) { const int grp = wid >> 2, hk = lane >> 5, e = lane & 31; const float be = br[e];
#pragma unroll
            for (int r = 0; r < 16; ++r) { const float v = red[((wid + 0) * 16 + r) * 64 + lane] + red[((wid + 1) * 16 + r) * 64 + lane] + red[((wid + 2) * 16 + r) * 64 + lane] + red[((wid + 3) * 16 + r) * 64 + lane] + be;
                lg[(grp * 32 + crow(r, hk)) * 33 + e] = v; }
            asm volatile("s_waitcnt lgkmcnt(0)" ::: "memory"); SBAR();
            const int tk = lane & 31; float v[32];
#pragma unroll
            for (int e2 = 0; e2 < 32; ++e2) v[e2] = lg[(grp * 32 + tk) * 33 + e2];
            int ek[4]; float vk[4];
#pragma unroll
            for (int k = 0; k < 4; ++k) { float best = -__builtin_inff(); int bi = 0;
#pragma unroll
                for (int e2 = 0; e2 < 32; ++e2) if (v[e2] > best) { best = v[e2]; bi = e2; }
                ek[k] = bi; vk[k] = best;
#pragma unroll
                for (int e2 = 0; e2 < 32; ++e2) v[e2] = (e2 == bi) ? -__builtin_inff() : v[e2]; }
            float wk[4], sw = 0.f;
#pragma unroll
            for (int k = 0; k < 4; ++k) { wk[k] = __expf(vk[k] - vk[0]); sw += wk[k]; }
            const float rs = 1.0f / sw;
            const bool act = lane < 32; unsigned myc = 0u;
#pragma unroll 1
            for (int E = 0; E < 32; ++E) { unsigned c = 0u;
#pragma unroll
                for (int k = 0; k < 4; ++k) c += (unsigned)__popcll(__ballot(act && ek[k] == E));
                if (lane == E) myc = c; }
            unsigned run = 0u; if (lane < 32 && myc > 0u) run = atomicAdd(&cnt[lane * 64], myc);
            int pk[4];
#pragma unroll
            for (int k = 0; k < 4; ++k) { pk[k] = 0;
#pragma unroll 1
                for (int E = 0; E < 32; ++E) { const unsigned long long mm = __ballot(act && ek[k] == E); const unsigned basev = (unsigned)__shfl((int)run, E);
                    if (act && ek[k] == E) pk[k] = (int)(basev + (unsigned)__popcll(mm & ((1ull << lane) - 1ull)));
                    if (lane == E) run += (unsigned)__popcll(mm); } }
            if (act) { const int tok = tok0 + grp * 32 + tk;
#pragma unroll
                for (int k = 0; k < 4; ++k) { tok_e[tok * 4 + k] = ek[k]; tok_pos[tok * 4 + k] = pk[k]; tok_w[tok * 4 + k] = wk[k] * rs; } }
        }
        __syncthreads();
    }
}
__device__ __forceinline__ void phase_moe_gather(const Frame& F0, int l) { const Frame F = fresh(F0);
    unsigned char* ws = F.ws; const int lane = F.lane;
    const unsigned* cnt = (const unsigned*)(ws + WS_CTL) + CW_CNT + l * 2048; unsigned* meta = (unsigned*)(ws + WS_CTL) + CW_META + l * 512;
    unsigned* offs = (unsigned*)(F.lds + LDS_MISC + 64);
    if (F.tid == 0) { unsigned o = 0u; for (int e = 0; e < 32; ++e) { offs[e] = o; o += (cnt[e * 64] + 255u) & ~255u; } offs[32] = o;
        if (F.bid == 0) { meta[0] = o >> 8; for (int e = 0; e < 32; ++e) for (unsigned t = offs[e] >> 8; t < (offs[e + 1] >> 8); ++t) meta[1 + t] = (unsigned)e; } }
    __syncthreads();
    const int* tok_e = (const int*)(ws + M_TOKE); const int* tok_pos = (const int*)(ws + M_TOKPOS); const float* tok_w = (const float*)(ws + M_TOKW);
    int* tok_dst = (int*)(ws + M_TOKDST); float* roww = (float*)(ws + M_ROWW);
    const bf16_t* x1b = (const bf16_t*)(ws + M_X1B); bf16_t* xs = (bf16_t*)(ws + M_XS);
    for (int it = F.bid * 8 + F.wid; it < NTOK * 4; it += F.G * 8) { const int tok = it >> 2;
        const int e = tok_e[it]; const unsigned dst = offs[e] + (unsigned)tok_pos[it];
        if (lane == 0) { tok_dst[it] = (int)dst; roww[dst] = tok_w[it]; }
        const u32x4* sp = (const u32x4*)(x1b + (size_t)tok * DM); u32x4* dp = (u32x4*)(xs + (size_t)dst * DM);
#pragma unroll
        for (int i = 0; i < 4; ++i) dp[i * 64 + lane] = sp[i * 64 + lane]; }
    __syncthreads();
}
__device__ __forceinline__ void phase_combine(const Frame& F0) { const Frame F = fresh(F0);
    unsigned char* ws = F.ws; const int lane = F.lane;
    const float* x1f = (const float*)(ws + M_X1F); const bf16_t* ys = (const bf16_t*)(ws + M_XS); const int* tok_dst = (const int*)(ws + M_TOKDST);
    float* hf = (float*)(ws + M_HF); bf16_t* hb = (bf16_t*)(ws + M_HB);
    for (int tok = F.bid * 8 + F.wid; tok < NTOK; tok += F.G * 8) {
        const int d0 = tok_dst[tok * 4], d1 = tok_dst[tok * 4 + 1], d2 = tok_dst[tok * 4 + 2], d3 = tok_dst[tok * 4 + 3];
#pragma unroll
        for (int i = 0; i < 4; ++i) { const int c = (i * 64 + lane) * 8; const size_t o = (size_t)tok * DM + c;
            f32x4 a = *(const f32x4*)(x1f + o) * ALPHA, b = *(const f32x4*)(x1f + o + 4) * ALPHA;
            const u32x4 y0 = *(const u32x4*)(ys + (size_t)d0 * DM + c), y1 = *(const u32x4*)(ys + (size_t)d1 * DM + c), y2 = *(const u32x4*)(ys + (size_t)d2 * DM + c), y3 = *(const u32x4*)(ys + (size_t)d3 * DM + c);
            a[0] += (bflo(y0.x) + bflo(y1.x)) + (bflo(y2.x) + bflo(y3.x)); a[1] += (bfhi(y0.x) + bfhi(y1.x)) + (bfhi(y2.x) + bfhi(y3.x));
            a[2] += (bflo(y0.y) + bflo(y1.y)) + (bflo(y2.y) + bflo(y3.y)); a[3] += (bfhi(y0.y) + bfhi(y1.y)) + (bfhi(y2.y) + bfhi(y3.y));
            b[0] += (bflo(y0.z) + bflo(y1.z)) + (bflo(y2.z) + bflo(y3.z)); b[1] += (bfhi(y0.z) + bfhi(y1.z)) + (bfhi(y2.z) + bfhi(y3.z));
            b[2] += (bflo(y0.w) + bflo(y1.w)) + (bflo(y2.w) + bflo(y3.w)); b[3] += (bfhi(y0.w) + bfhi(y1.w)) + (bfhi(y2.w) + bfhi(y3.w));
            *(f32x4*)(hf + o) = a; *(f32x4*)(hf + o + 4) = b; pg8::st_bf16x8(hb + o, a, b); } }
}
__device__ __forceinline__ void phase_ln2(const Frame& F0, const Params& P, int l) { const Frame F = fresh(F0);
    unsigned char* ws = F.ws; const float* pre2 = (const float*)(ws + M_X1F); bf16_t* xb = (bf16_t*)(ws + WS_XB);
    const float* g = F.in(23) + l * DM; const float* bt = F.in(24) + l * DM;
    for (int tok = F.bid * 8 + F.wid; tok < NTOK; tok += F.G * 8) ln_row(pre2 + (size_t)tok * DM, g, bt, F.out() + (size_t)tok * DM, xb + (size_t)tok * DM, F.lane);
}

constexpr int NPHASE = 1 + 15 * NLAYER;
#ifdef PH_ONLY
#define PEN(kind) ((kind) == PH_ONLY)
#else
#define PEN(kind) true
#endif
#define IN(k) (lo <= (k) && (k) < hi)
#define SEAM(k) do { if (IN((k) + 1)) xcd_barrier(bar); } while (0)

template <int l>
__device__ __forceinline__ void layer_phases(const Frame& F, const Params& P, const XcdBarrier& bar, const int lo, const int hi, unsigned char* ws0) {
    using namespace pg8;

        const int pb = 1 + 15 * l;
        const float* xres = (l == 0) ? F.in(0) : F.out();
        if (IN(pb + 0) && PEN(0)) { unsigned char* ws = ws0; asm volatile("" : "+s"(ws));
            SchedS S; S.init(NTOK, INWP, F.G, F.bid, (const bf16_t*)(ws + WS_XB), DM, (const bf16_t*)(ws + W_IN), DM);
            EpiInProj E{(bf16_t*)(ws + R_QA), (bf16_t*)(ws + R_QIDX), (bf16_t*)(ws + R_QKV), (bf16_t*)(ws + R_GATES), (float*)(ws + R_SMALL)};
            for (int rep = 0; rep < NREP(5); ++rep) gemm_phase(F.ldsl, DM, DM, DM, S, E); SEAM(pb + 0); }
        if (IN(pb + 1) && PEN(1)) { unsigned char* ws = ws0; asm volatile("" : "+s"(ws));
            phase_prep(F, P, l);
            SchedS S; S.init(NTOK, 2048, F.G, F.bid, (const bf16_t*)(ws + R_QA), 1024, (const bf16_t*)(ws + W_UK2), 256, 1, 256);
            EpiBf16 E{(bf16_t*)(ws + R_QCAT), 2304, 288};
            for (int rep = 0; rep < NREP(10); ++rep) gemm_phase(F.ldsl, 256, 1024, 256, S, E); SEAM(pb + 1); }
        if (IN(pb + 2) && PEN(2)) { unsigned char* ws = ws0; asm volatile("" : "+s"(ws)); phase_cumsum(F); for (int rep = 0; rep < NREP(3); ++rep) phase_idx(F); SEAM(pb + 2); }
        if (IN(pb + 3) && PEN(3)) { unsigned char* ws = ws0; asm volatile("" : "+s"(ws)); for (int rep = 0; rep < NREP(4); ++rep) phase_topk(F); SEAM(pb + 3); }
        if (IN(pb + 4) && PEN(4)) { unsigned char* ws = ws0; asm volatile("" : "+s"(ws)); for (int rep = 0; rep < NREP(1); ++rep) phase_attn(F, l, rep); SEAM(pb + 4); }
        if (IN(pb + 5) && PEN(5)) { unsigned char* ws = ws0; asm volatile("" : "+s"(ws));
            SchedS S; S.init(NTOK, 1024, F.G, F.bid, (const bf16_t*)(ws + R_OLAT), 2048, (const bf16_t*)(ws + W_UV2), 512, 0, 512);
            EpiBf16 E{(bf16_t*)(ws + R_OA), 3072, 256}; for (int rep = 0; rep < NREP(10); ++rep) gemm_phase(F.ldsl, 512, 2048, 512, S, E);
            SEAM(pb + 5); }
        if (IN(pb + 6) && PEN(6)) { unsigned char* ws = ws0; asm volatile("" : "+s"(ws));
            SchedS S; S.init(NTOK, 2048, F.G, F.bid, (const bf16_t*)(ws + R_OA), 3072, (const bf16_t*)(ws + W_BRA), 3072);
            EpiBranch3 E{(const bf16_t*)(ws + R_GATES), (bf16_t*)(ws + R_MERGED)}; for (int rep = 0; rep < NREP(11); ++rep) gemm_phase(F.ldsl, 3072, 3072, 3072, S, E); SEAM(pb + 6); }
        if (IN(pb + 7) && PEN(7)) { unsigned char* ws = ws0; asm volatile("" : "+s"(ws));
            SchedS S; S.init(NTOK, 2048, F.G, F.bid, (const bf16_t*)(ws + R_MERGED), DM, (const bf16_t*)(ws + W_OUT), DM);
            EpiOut E{xres, (float*)(ws + R_PRE1)}; for (int rep = 0; rep < NREP(8); ++rep) gemm_phase(F.ldsl, DM, DM, DM, S, E); SEAM(pb + 7); }
        if (IN(pb + 8) && PEN(8)) { unsigned char* ws = ws0; asm volatile("" : "+s"(ws)); phase_ln1_router(F, P, l); SEAM(pb + 8); }
        if (IN(pb + 9) && PEN(9)) { unsigned char* ws = ws0; asm volatile("" : "+s"(ws));
            for (int rep = 0; rep < NREP(12); ++rep) phase_moe_gather(F, l);
            SchedS S; S.init(NTOK, 2048, F.G, F.bid, (const bf16_t*)(ws + WS_PB) + (size_t)l * NTOK * 256, 256, (const bf16_t*)(ws + W_PLE), 256);
            EpiBf16 E{(bf16_t*)(ws + M_PP), 2048, 256}; for (int rep = 0; rep < NREP(10); ++rep) gemm_phase(F.ldsl, 256, 256, 256, S, E); SEAM(pb + 9); }
        if (IN(pb + 10) && PEN(10)) { unsigned char* ws = ws0; asm volatile("" : "+s"(ws));
            SchedM S; S.init((const unsigned*)(ws + WS_CTL) + CW_META + l * 512, F.G, F.bid, (const bf16_t*)(ws + M_XS), DM, (const bf16_t*)(ws + W_GU), DM);
            EpiGateUp E{F.in(16) + (size_t)l * NEXP * DEXP, F.in(18) + (size_t)l * NEXP * DEXP, (bf16_t*)(ws + M_HID)}; for (int rep = 0; rep < NREP(6); ++rep) gemm_phase(F.ldsl, DM, DM, DM, S, E); SEAM(pb + 10); }
        if (IN(pb + 11) && PEN(11)) { unsigned char* ws = ws0; asm volatile("" : "+s"(ws));
            SchedM S; S.init((const unsigned*)(ws + WS_CTL) + CW_META + l * 512, F.G, F.bid, (const bf16_t*)(ws + M_HID), DEXP, (const bf16_t*)(ws + W_DN), DEXP);
            EpiDown E{F.in(20) + (size_t)l * NEXP * DM, (const float*)(ws + M_ROWW), (bf16_t*)(ws + M_XS)}; for (int rep = 0; rep < NREP(7); ++rep) gemm_phase(F.ldsl, DEXP, DEXP, DEXP, S, E); SEAM(pb + 11); }
        if (IN(pb + 12) && PEN(12)) { unsigned char* ws = ws0; asm volatile("" : "+s"(ws)); for (int rep = 0; rep < NREP(9); ++rep) phase_combine(F); SEAM(pb + 12); }
        if (IN(pb + 13) && PEN(13)) { unsigned char* ws = ws0; asm volatile("" : "+s"(ws));
            SchedS S; S.init(NTOK, 2048, F.G, F.bid, (const bf16_t*)(ws + M_HB), DM, (const bf16_t*)(ws + W_PG), DM);
            EpiPleGate E{(const float*)(ws + M_HF), (const bf16_t*)(ws + M_PP), (float*)(ws + M_X1F)}; for (int rep = 0; rep < NREP(8); ++rep) gemm_phase(F.ldsl, DM, DM, DM, S, E); SEAM(pb + 13); }
        if (IN(pb + 14) && PEN(14)) { unsigned char* ws = ws0; asm volatile("" : "+s"(ws)); for (int rep = 0; rep < NREP(13); ++rep) phase_ln2(F, P, l); if (l + 1 < NLAYER) for (int rep = 0; rep < NREP(0); ++rep) convert_layer_weights(F, P, l + 1); SEAM(pb + 14); }
}
__global__ void __launch_bounds__(512, 2) fwd(Params P) {
    extern __shared__ __attribute__((aligned(16))) unsigned char lds[];
    Frame F; F.lds = lds; F.ldsl = (LAS unsigned char*)lds; F.ws = P.ws; F.tid = threadIdx.x; F.lane = F.tid & 63; F.wid = __builtin_amdgcn_readfirstlane(F.tid >> 6); F.G = gridDim.x; F.bid = blockIdx.x;
    unsigned char* ws0 = P.ws; unsigned char* ws = ws0;
    const bool fused = (P.ph_hi - P.ph_lo) > 1;
    if (F.tid < 4) ((LAS unsigned*)(F.ldsl + LDS_MISC))[F.tid] = 0u;
    if (F.tid == 0) { LAS unsigned long long* t = (LAS unsigned long long*)(F.ldsl + LDS_PTRS);
#pragma unroll
        for (int k = 0; k < 25; ++k) t[k] = (unsigned long long)P.in[k];
        t[25] = (unsigned long long)P.out; }
    __syncthreads();
    XcdBarrier bar; bar.bar = (unsigned*)(ws + WS_CTL) + CW_BAR; bar.x = 0; bar.st = (volatile LAS unsigned*)(F.ldsl + LDS_MISC);
    if (fused) bar = xcd_barrier_post((unsigned*)(ws + WS_CTL) + CW_BAR, (volatile LAS unsigned*)(F.ldsl + LDS_MISC));
    const int lo = P.ph_lo, hi = P.ph_hi;
    using namespace pg8;
    if (IN(0) && PEN(15)) { unsigned char* ws = ws0; asm volatile("" : "+s"(ws));
        conv_rows(F, F.in(0), (bf16_t*)(ws + WS_XB), (size_t)NTOK * DM / 8);
        conv_rows(F, F.in(1), (bf16_t*)(ws + WS_PB), (size_t)2 * NTOK * 256 / 8);
        for (int rep = 0; rep < NREP(0); ++rep) convert_layer_weights(F, P, 0);
        SEAM(0);
    }
    layer_phases<0>(F, P, bar, lo, hi, ws0);
    layer_phases<1>(F, P, bar, lo, hi, ws0);
}

#ifdef DEBUG_NAN
constexpr int CW_FLAGS = 12288;
__global__ void dbg_scan_bf16(const unsigned short* p, size_t n, unsigned* flag) { unsigned c = 0; for (size_t i = (size_t)blockIdx.x * blockDim.x + threadIdx.x; i < n; i += (size_t)gridDim.x * blockDim.x) if ((p[i] & 0x7F80u) == 0x7F80u) ++c; if (c) atomicAdd(flag, c); }
__global__ void dbg_scan_f32(const unsigned* p, size_t n, unsigned* flag) { unsigned c = 0; for (size_t i = (size_t)blockIdx.x * blockDim.x + threadIdx.x; i < n; i += (size_t)gridDim.x * blockDim.x) if ((p[i] & 0x7F800000u) == 0x7F800000u) ++c; if (c) atomicAdd(flag, c); }
__global__ void dbg_scan_sel(const int* sel, const int* nsel, unsigned* flag) { unsigned c = 0; for (size_t i = (size_t)blockIdx.x * blockDim.x + threadIdx.x; i < (size_t)NTOK * 256; i += (size_t)gridDim.x * blockDim.x) { const int tok = (int)(i >> 8), j = (int)(i & 255), t = tok & (SEQ - 1); const int ns = nsel[tok]; if (j == 0 && ns != (t + 1 < 256 ? t + 1 : 256)) ++c; if (j < ns && (sel[i] < 0 || sel[i] > t)) ++c; } if (c) atomicAdd(flag, c); }
__global__ void dbg_scan_scores(const unsigned* p, unsigned* flag) { unsigned c = 0; for (size_t i = (size_t)blockIdx.x * blockDim.x + threadIdx.x; i < 2ull * SEQ * SEQ; i += (size_t)gridDim.x * blockDim.x) { const int s = (int)(i & (SEQ - 1)), t = (int)((i >> 13) & (SEQ - 1)); if (s <= t && (p[i] & 0x7F800000u) == 0x7F800000u) ++c; } if (c) atomicAdd(flag, c); }
__global__ void dbg_probe_bf16(const unsigned short* p, size_t n, unsigned* cnt, unsigned* minidx) { unsigned c = 0; unsigned mi = 0xFFFFFFFFu; for (size_t i = (size_t)blockIdx.x * blockDim.x + threadIdx.x; i < n; i += (size_t)gridDim.x * blockDim.x) if ((p[i] & 0x7F80u) == 0x7F80u) { ++c; if ((unsigned)i < mi) mi = (unsigned)i; } if (c) { atomicAdd(cnt, c); atomicMax(minidx, ~mi); } }
__global__ void dbg_final(float* out, size_t n, const unsigned* flags) { int code = 0; for (int k = 0; k < 32; ++k) if (flags[k] && !code) code = k + 1; const int mask = (flags[32] ? 1 : 0) | (flags[33] ? 2 : 0) | (flags[34] ? 4 : 0); if (mask) code = 20 + 5 * mask; if (!code) return; for (size_t i = (size_t)blockIdx.x * blockDim.x + threadIdx.x; i < n; i += (size_t)gridDim.x * blockDim.x) out[i] = (float)code; }
#endif
extern "C" void kernel_launch(void* const* d_in, const int* in_sizes, int n_in, void* d_out, int out_size, void* d_ws, size_t ws_size, hipStream_t stream) {
    static int grid = 0;
    if (grid == 0) {
        if (n_in != 25 || out_size != NTOK * DM || ws_size < WS_NEED) { fprintf(stderr, "kernel_launch: unexpected shapes (n_in %d out %d ws %zu need %zu)\n", n_in, out_size, ws_size, (size_t)WS_NEED); grid = -1; return; }
        int dev = 0, cus = 0, per_cu = 0;
        if (hipGetDevice(&dev) != hipSuccess || hipDeviceGetAttribute(&cus, hipDeviceAttributeMultiprocessorCount, dev) != hipSuccess) { grid = -1; return; }
        if (hipFuncSetAttribute((const void*)fwd, hipFuncAttributeMaxDynamicSharedMemorySize, LDS_BYTES) != hipSuccess) { fprintf(stderr, "kernel_launch: hipFuncSetAttribute failed\n"); grid = -1; return; }
        if (hipOccupancyMaxActiveBlocksPerMultiprocessor(&per_cu, (const void*)fwd, 512, LDS_BYTES) != hipSuccess || per_cu < 1) fprintf(stderr, "kernel_launch: occupancy query says %d\n", per_cu);
        (void)hipGetLastError();
        grid = cus;
    }
    if (grid < 0) return;
    unsigned char* ws = (unsigned char*)d_ws;
    hipMemsetAsync(ws + WS_CTL, 0, CTL_BYTES, stream);
    hipMemsetAsync(ws + W_UK2, 0, 8ull * 256 * 256 * 2 + 4ull * 256 * 512 * 2, stream);
    hipMemsetAsync(ws + W_IN + (size_t)INW * 2048 * 2, 0, (size_t)(INWP - INW) * 2048 * 2, stream);
    Params p{};
    for (int i = 0; i < 25; ++i) p.in[i] = (const float*)d_in[i];
    p.out = (float*)d_out; p.ws = ws;
#if PHASES_PER_LAUNCH == 0
    p.ph_lo = 0; p.ph_hi = NPHASE;
    hipLaunchKernelGGL(fwd, dim3(grid), dim3(512), LDS_BYTES, stream, p);
#else
    for (int k = 0; k < NPHASE; ++k) { p.ph_lo = k; p.ph_hi = k + 1; hipLaunchKernelGGL(fwd, dim3(grid), dim3(512), LDS_BYTES, stream, p);
#ifdef DEBUG_NAN
        unsigned* fl = (unsigned*)(ws + WS_CTL) + CW_FLAGS + k;
#define SB16(off, n) hipLaunchKernelGGL(dbg_scan_bf16, dim3(1024), dim3(256), 0, stream, (const unsigned short*)(ws + (off)), (size_t)(n), fl)
#define SF32(off, n) hipLaunchKernelGGL(dbg_scan_f32, dim3(1024), dim3(256), 0, stream, (const unsigned*)(ws + (off)), (size_t)(n), fl)
        if (k == 0) { SB16(WS_XB, (size_t)NTOK * DM); SB16(WS_PB, 2ull * NTOK * 256); SB16(WS_W, (W_END - WS_W) / 2); }
        else { const int kind = (k - 1) % 15;
            if (kind == 0) { SB16(R_QA, (size_t)NTOK * 1024); SB16(R_QIDX, (size_t)NTOK * 1024); SB16(R_QKV, 6ull * NTOK * 1024); SB16(R_GATES, (size_t)NTOK * 6144); SF32(R_SMALL, (size_t)NTOK * 512); }
            if (kind == 1) { SB16(R_QCAT, (size_t)NTOK * 2304); SB16(R_KCAT, (size_t)NTOK * 288); SB16(R_KI, (size_t)NTOK * 64); SB16(R_QIDX, (size_t)NTOK * 1024); SF32(R_WI, (size_t)NTOK * 16); SF32(WS_LF, 16ull * 8192); }
            if (kind == 2) { SF32(WS_CUM, 16ull * 8192); hipLaunchKernelGGL(dbg_scan_scores, dim3(1024), dim3(256), 0, stream, (const unsigned*)(ws + R_SCORES), fl); }
            if (kind == 3) { hipLaunchKernelGGL(dbg_scan_sel, dim3(1024), dim3(256), 0, stream, (const int*)(ws + R_SEL), (const int*)(ws + R_NSEL), fl); }
            if (k == 5) { unsigned* fl0 = fl; fl = (unsigned*)(ws + WS_CTL) + CW_FLAGS + 32; SB16(R_OLAT, (size_t)NTOK * 2048); fl += 1; SB16(R_OA, (size_t)NTOK * 3072); fl += 1; fl = fl0; hipLaunchKernelGGL(dbg_probe_bf16, dim3(1024), dim3(256), 0, stream, (const unsigned short*)(ws + R_OC), (size_t)NTOK * 1024, (unsigned*)(ws + WS_CTL) + CW_FLAGS + 40, (unsigned*)(ws + WS_CTL) + CW_FLAGS + 41); }
            if (kind == 5) { SB16(R_OA, (size_t)NTOK * 3072); }
            if (kind == 6) { SB16(R_MERGED, (size_t)NTOK * 2048); }
            if (kind == 7) { SF32(R_PRE1, (size_t)NTOK * 2048); }
            if (kind == 8) { SF32(M_X1F, (size_t)NTOK * 2048); SF32(M_TOKW, (size_t)NTOK * 4); }
            if (kind == 9) { SB16(M_PP, (size_t)NTOK * 2048); }
            if (kind == 12) { SF32(M_HF, (size_t)NTOK * 2048); }
            if (kind == 13) { SF32(M_X1F, (size_t)NTOK * 2048); }
            if (kind == 14) { hipLaunchKernelGGL(dbg_scan_f32, dim3(1024), dim3(256), 0, stream, (const unsigned*)d_out, (size_t)NTOK * DM, fl); if (k + 1 < NPHASE) SB16(WS_W, (W_END - WS_W) / 2); } }
#endif
    }
#ifdef DEBUG_NAN
    hipLaunchKernelGGL(dbg_final, dim3(1024), dim3(256), 0, stream, (float*)d_out, (size_t)NTOK * DM, (const unsigned*)(ws + WS_CTL) + CW_FLAGS);
#endif
#endif
}
```

```cpp
#include <hip/hip_runtime.h>
#include <stdint.h>
#include <stdio.h>
#include <math.h>

#ifndef PHASES_PER_LAUNCH
#define PHASES_PER_LAUNCH 0
#endif

#define LAS __attribute__((address_space(3)))
#ifndef REP_MASK
#define REP_MASK 0
#endif
#define NREP(bit) (((REP_MASK) >> (bit)) & 1 ? 2 : 1)
typedef unsigned short bf16_t;
typedef short bf16x8 __attribute__((ext_vector_type(8)));
typedef short s16x4 __attribute__((ext_vector_type(4)));
typedef float f32x4 __attribute__((ext_vector_type(4)));
typedef float f32x16 __attribute__((ext_vector_type(16)));
typedef unsigned u32x4 __attribute__((ext_vector_type(4)));
typedef unsigned u32x2 __attribute__((ext_vector_type(2)));
typedef int i32x4 __attribute__((ext_vector_type(4)));

constexpr int NTOK = 16384, DM = 2048, SEQ = 8192, NB = 2, NLAYER = 2;
constexpr int INW = 14712, INWP = 14848;
constexpr int NEXP = 32, DEXP = 1024;
constexpr int PMAX = 65536 + 8192;
constexpr float ALPHA = 1.41421356237309515f;
constexpr float LOG2E = 1.4426950408889634f;
constexpr float SCALE = 0.08838834764831845f;
constexpr float C2 = LOG2E * SCALE;

constexpr size_t MiB = 1ull << 20;
constexpr size_t WS_CTL   = 0;
constexpr size_t WS_W     = 1 * MiB;
constexpr size_t W_IN     = WS_W;
constexpr size_t W_ING    = W_IN   + 8192ull * 2048 * 2;
constexpr size_t W_UK2    = W_IN   + (size_t)INWP * 2048 * 2;
constexpr size_t W_UV2    = W_UK2  + 8ull * 256 * 256 * 2;
constexpr size_t W_BRA    = W_UV2  + 4ull * 256 * 512 * 2;
constexpr size_t W_BRB    = W_BRA  + 2048ull * 1024 * 2;
constexpr size_t W_BRC    = W_BRB  + 2048ull * 1024 * 2;
constexpr size_t W_OUT    = W_BRC  + 2048ull * 1024 * 2;
constexpr size_t W_PG     = W_OUT  + 2048ull * 2048 * 2;
constexpr size_t W_PLE    = W_PG   + 2048ull * 2048 * 2;
constexpr size_t W_GU     = W_PLE  + 2048ull * 256 * 2;
constexpr size_t W_DN     = W_GU   + 32ull * 2048 * 2048 * 2;
constexpr size_t W_END    = W_DN   + 32ull * 2048 * 1024 * 2;
constexpr size_t WS_XB    = (W_END + MiB - 1) / MiB * MiB;
constexpr size_t WS_PB    = WS_XB  + (size_t)NTOK * DM * 2;
constexpr size_t WS_CUM   = WS_PB  + 2ull * NTOK * 256 * 2;
constexpr size_t WS_LF    = WS_CUM + 16ull * 8192 * 4;
constexpr size_t WS_XQ    = WS_LF  + 16ull * 8192 * 4;
constexpr size_t WS_XSC   = WS_XQ  + (size_t)NTOK * DM;
constexpr size_t WS_R     = (WS_XSC + (size_t)NTOK * 4 + MiB - 1) / MiB * MiB;
constexpr size_t R_SCORES = WS_R;
constexpr size_t R_OLAT   = WS_R;
constexpr size_t R_OA     = WS_R + 64 * MiB;
constexpr size_t R_OB     = WS_R + 96 * MiB;
constexpr size_t R_OC     = WS_R + 128 * MiB;
constexpr size_t R_TMP    = WS_R + 160 * MiB;
constexpr size_t R_MERGED = WS_R + 288 * MiB;
constexpr size_t R_PRE1   = WS_R + 384 * MiB;
constexpr size_t R_QA     = WS_R + 512 * MiB;
constexpr size_t R_QIDX   = WS_R + 544 * MiB;
constexpr size_t R_QKV    = WS_R + 576 * MiB;
constexpr size_t R_GATES  = WS_R + 768 * MiB;
constexpr size_t R_SMALL  = WS_R + 960 * MiB;
constexpr size_t R_QCAT   = WS_R + 992 * MiB;
constexpr size_t R_KCAT   = WS_R + 1064 * MiB;
constexpr size_t R_KI     = WS_R + 1073 * MiB;
constexpr size_t R_WI     = WS_R + 1075 * MiB;
constexpr size_t R_SEL    = WS_R + 1076 * MiB;
constexpr size_t R_NSEL   = WS_R + 1092 * MiB;
constexpr size_t R_END    = WS_R + 1093 * MiB;
constexpr size_t M_XS     = WS_R;
constexpr size_t M_HID    = WS_R + 288 * MiB;
constexpr size_t M_PP     = WS_R + 432 * MiB;
constexpr size_t M_X1F    = WS_R + 512 * MiB;
constexpr size_t M_X1B    = WS_R + 640 * MiB;
constexpr size_t M_HF     = WS_R + 704 * MiB;
constexpr size_t M_HB     = WS_R + 832 * MiB;
constexpr size_t M_TOKE   = WS_R + 896 * MiB;
constexpr size_t M_TOKPOS = M_TOKE + (size_t)NTOK * 16;
constexpr size_t M_TOKW   = M_TOKPOS + (size_t)NTOK * 16;
constexpr size_t M_TOKDST = M_TOKW + (size_t)NTOK * 16;
constexpr size_t M_ROWW   = M_TOKDST + (size_t)NTOK * 16;
constexpr size_t M_ROWSX  = M_ROWW + (size_t)PMAX * 4;
constexpr size_t M_X1S    = M_ROWSX + (size_t)PMAX * 4;
constexpr size_t M_X1Q    = WS_R + 900 * MiB;
constexpr size_t WS_NEED  = R_END;
constexpr int CW_BAR = 0;
constexpr int CW_CNT = 8192;
constexpr int CW_META = 4096 + 64;
constexpr int CW_QCTR = 6144;
constexpr int CW_WMAX = 6272;
constexpr int CW_WMAXG = 6336;
constexpr int CW_KMAX = 6400;
constexpr size_t CTL_BYTES = 65536;

constexpr int LDS_BYTES = 152576;
constexpr int LDS_MISC = 151552;

typedef float f32x2 __attribute__((ext_vector_type(2)));
typedef __bf16 bf16n2 __attribute__((ext_vector_type(2)));
__device__ __forceinline__ unsigned cvtpk(float lo, float hi) { f32x2 v = {lo, hi}; bf16n2 b = __builtin_convertvector(v, bf16n2); return __builtin_bit_cast(unsigned, b); }
__device__ __forceinline__ bf16_t f2bf(float x) { return (bf16_t)(cvtpk(x, 0.f) & 0xffffu); }
__device__ __forceinline__ float bf2f(bf16_t b) { return __uint_as_float(((unsigned)b) << 16); }
__device__ __forceinline__ float bflo(unsigned w) { return __uint_as_float(w << 16); }
__device__ __forceinline__ float bfhi(unsigned w) { return __uint_as_float(w & 0xffff0000u); }
__device__ __forceinline__ bf16x8 pack8(f32x4 a, f32x4 b) { u32x4 w = {cvtpk(a[0], a[1]), cvtpk(a[2], a[3]), cvtpk(b[0], b[1]), cvtpk(b[2], b[3])}; return *reinterpret_cast<bf16x8*>(&w); }
__device__ __forceinline__ float sigmoidf_(float x) { return 1.0f / (1.0f + __expf(-x)); }
__device__ __forceinline__ float wave_sum(float v) { for (int o = 32; o > 0; o >>= 1) v += __shfl_xor(v, o); return v; }
__device__ __forceinline__ int crow(int r, int hi) { return (r & 3) + 8 * (r >> 2) + 4 * hi; }
#define SBAR() __builtin_amdgcn_sched_barrier(0)

#define XB_TMO      128
#define XB_XCNT(j)  (256  + 64 * (j))
#define XB_XSUB(j)  (1280 + 64 * (j))
#define XB_XGEN(j)  (2304 + 64 * (j))
#define XB_TOP      3328
#define XB_TOPGEN   3392
#define XCD_BAR_WORDS 3456
#define XB_SPIN_CAP (1u << 22)
__device__ __forceinline__ unsigned xb_ld(unsigned* p)              { return __hip_atomic_load(p, __ATOMIC_RELAXED, __HIP_MEMORY_SCOPE_AGENT); }
__device__ __forceinline__ unsigned xb_add(unsigned* p, unsigned v) { return __hip_atomic_fetch_add(p, v, __ATOMIC_RELAXED, __HIP_MEMORY_SCOPE_AGENT); }
__device__ __forceinline__ unsigned xb_xcc_id() { return (unsigned)__builtin_amdgcn_s_getreg((3 << 11) | 20) & 0xFu; }
#define XB_SPIN(cond, bar) do { unsigned _sp = 0; while (cond) { __builtin_amdgcn_s_sleep(1); \
    if ((++_sp & 255u) == 0u) { if (xb_ld(&(bar)[XB_TMO])) break; if (_sp > XB_SPIN_CAP) { atomicAdd(&(bar)[XB_TMO], 1u); break; } } } } while (0)
struct XcdBarrier { unsigned* bar; unsigned x; volatile LAS unsigned* st; };
__device__ __forceinline__ XcdBarrier xcd_barrier_post(unsigned* bar, volatile LAS unsigned* st) {
    XcdBarrier b; b.bar = bar; b.x = xb_xcc_id(); b.st = st;
    if (threadIdx.x == 0) (void)xb_add(&bar[XB_XCNT(b.x)], 1u);
    return b;
}
__device__ __forceinline__ void xcd_barrier_complete(unsigned* bar, unsigned x, unsigned& nloc, unsigned& nx) {
    const unsigned G = gridDim.x * gridDim.y * gridDim.z;
    unsigned sum, cnt, mine, sp = 0u;
    for (;;) {
        sum = 0u; cnt = 0u; mine = 0u;
#pragma unroll
        for (unsigned j = 0; j < 16; ++j) { const unsigned c = xb_ld(&bar[XB_XCNT(j)]); sum += c; cnt += (c > 0u) ? 1u : 0u; mine = (j == x) ? c : mine; }
        if (sum == G) break;
        __builtin_amdgcn_s_sleep(1);
        if ((++sp & 255u) == 0u) { if (xb_ld(&bar[XB_TMO])) break; if (sp > XB_SPIN_CAP) { atomicAdd(&bar[XB_TMO], 1u); break; } }
    }
    nloc = mine > 0u ? mine : 1u; nx = cnt > 0u ? cnt : 1u;
}
__device__ __forceinline__ void xcd_barrier(const XcdBarrier& b) {
    asm volatile("s_waitcnt vmcnt(0)" ::: "memory");
    __syncthreads();
    if (threadIdx.x == 0) {
        unsigned* bar = b.bar;
        __builtin_amdgcn_s_waitcnt(0);
        unsigned nloc = b.st[0], nx = b.st[1];
        if (nloc == 0u) { xcd_barrier_complete(bar, b.x, nloc, nx); b.st[0] = nloc; b.st[1] = nx; }
        const unsigned old = xb_add(&bar[XB_XSUB(b.x)], 1u);
        const unsigned gen = old / nloc;
        if (old + 1u == (gen + 1u) * nloc) {
            __builtin_amdgcn_fence(__ATOMIC_RELEASE, "agent");
            asm volatile("s_waitcnt vmcnt(0)" ::: "memory");
            const unsigned og = xb_add(&bar[XB_TOP], 1u);
            const unsigned tg = og / nx;
            if (og + 1u == (tg + 1u) * nx) xb_add(&bar[XB_TOPGEN], 1u);
            else XB_SPIN(xb_ld(&bar[XB_TOPGEN]) == tg, bar);
            __builtin_amdgcn_fence(__ATOMIC_ACQUIRE, "agent");
            xb_add(&bar[XB_XGEN(b.x)], 1u);
            asm volatile("s_waitcnt vmcnt(0)" ::: "memory");
        } else {
            XB_SPIN(xb_ld(&bar[XB_XGEN(b.x)]) == gen, bar);
            __builtin_amdgcn_fence(__ATOMIC_ACQUIRE, "agent");
            asm volatile("s_waitcnt vmcnt(0)" ::: "memory");
        }
    }
    __syncthreads();
}

namespace pg8 {
constexpr int BM = 256, BK = 64, HALF = 128, HTB = HALF * BK * 2, STAGE_BYTES = 8 * HTB, NXCD = 8, WGM = 8;
__device__ __forceinline__ int lds_byte(int r, int c) { const int st = (r >> 4) * 2 + (c >> 5), rr = r & 15, cc = c & 31, ob = rr * 64 + cc * 2; return st * 1024 + (ob ^ (((ob >> 9) & 1) << 5)); }
__device__ __forceinline__ void stage_rc(int b, int& R, int& C) { const int st = b / 1024, sb = b % 1024, swz = sb ^ (((sb >> 9) & 1) << 5); R = (st >> 1) * 16 + swz / 64; C = (st & 1) * 32 + (swz % 64) / 2; }
__device__ __forceinline__ int perm32(int rho) { const int n = rho >> 4, i = rho & 15; return 8 * (i >> 2) + 4 * n + (i & 3); }
struct Unit { int pm, pn, e; };
struct SchedS {
    int nM, nN, nwg, G, c; const bf16_t* A; const bf16_t* B; int lda, ldb, a_sh, a_mul, skip_from = 1 << 30, skip_by = 0;
    __device__ void init(int M, int N, int G_, int c_, const bf16_t* A_, int lda_, const bf16_t* B_, int ldb_, int a_sh_ = 0, int a_mul_ = 0) {
        nM = M / BM; nN = N / BM; nwg = nM * nN; G = G_; c = c_; A = A_; B = B_; lda = lda_; ldb = ldb_; a_sh = a_sh_; a_mul = a_mul_; }
    __device__ __forceinline__ bool next(int i, Unit& u) const {
        const long L = (long)i * G + c; if (L >= nwg) return false;
        int wgid = (int)L; { const int q = nwg / NXCD, r = nwg % NXCD, xcd = wgid % NXCD, off = wgid / NXCD; wgid = (xcd < r ? xcd * (q + 1) : r * (q + 1) + (xcd - r) * q) + off; }
        const int nig = WGM * nN, gid = wgid / nig, fm = gid * WGM, gsz = (nM - fm) < WGM ? (nM - fm) : WGM;
        u.pm = fm + ((wgid % nig) % gsz); u.pn = (wgid % nig) / gsz; u.e = 0;
        if (u.pn >= skip_from) u.pn += skip_by;
        return true;
    }
    __device__ __forceinline__ const char* pa(const Unit& u) const { return (const char*)(A + (size_t)u.pm * BM * lda + (size_t)((u.pn >> a_sh) * a_mul)); }
    __device__ __forceinline__ const char* pb(const Unit& u) const { return (const char*)(B + (size_t)u.pn * BM * ldb); }
};
struct SchedM {
    int ntiles, G, c; const bf16_t* A; const bf16_t* W; int lda, ldb; const unsigned* tile_e;
    __device__ void init(const unsigned* meta, int G_, int c_, const bf16_t* A_, int lda_, const bf16_t* W_, int ldb_) {
        ntiles = (int)meta[0]; tile_e = meta + 1; G = G_; c = c_; A = A_; W = W_; lda = lda_; ldb = ldb_; }
    __device__ __forceinline__ bool next(int i, Unit& u) const {
        const long L = (long)i * G + c; if (L >= (long)ntiles * 8) return false;
        u.pm = (int)(L >> 3); u.pn = (int)(L & 7); u.e = (int)tile_e[u.pm];
        return true;
    }
    __device__ __forceinline__ const char* pa(const Unit& u) const { return (const char*)(A + (size_t)u.pm * BM * lda); }
    __device__ __forceinline__ const char* pb(const Unit& u) const { return (const char*)(W + ((size_t)u.e * 2048 + (size_t)u.pn * BM) * ldb); }
};

template <class Epi, class Sched>
__device__ __forceinline__ void gemm_phase(LAS unsigned char* lds, const int K, const int lda, const int ldb, const Sched& S, const Epi& E) {
    int tid = threadIdx.x; asm volatile("" : "+v"(tid));
    const int wid = __builtin_amdgcn_readfirstlane(tid >> 6), lane = tid & 63, wr = wid >> 2, wc = wid & 3, fr = lane & 15, fq = lane >> 4;
    const int nt = K / BK;
    unsigned voffA[2], voffB[2];
#pragma unroll
    for (int i = 0; i < 2; ++i) { int R, C; stage_rc(tid * 16 + i * 8192, R, C); const int Rb = (R & ~31) + perm32(R & 31);
        voffA[i] = (unsigned)(R * lda + C) * 2u; voffB[i] = (unsigned)(Rb * ldb + C) * 2u; }
    const size_t kstep = (size_t)(BK * 2);
    const size_t hstepA = (size_t)HALF * lda * 2, hstepB = (size_t)HALF * ldb * 2;
    const unsigned ldsw = (unsigned)wid * 1024u;
    const int aoff = lds_byte(wr * 64 + fr, fq * 8), boff = lds_byte(wc * 32 + fr, fq * 8);
#define PG8_SA(b, h) (((b) * 2 + (h)) * HTB)
#define PG8_SB(b, h) ((4 + (b) * 2 + (h)) * HTB)
#define PG8_STAGE(bufoff, gbase, voff) do { _Pragma("unroll") for (int _i = 0; _i < 2; ++_i) \
        __builtin_amdgcn_global_load_lds((const unsigned*)((const char*)(gbase) + (voff)[_i]), (LAS unsigned*)(lds + (bufoff) + ldsw + _i * 8192), 16, 0, 0); } while (0)
#define PG8_LDA(dst, b, h) do { _Pragma("unroll") for (int m = 0; m < 4; ++m) _Pragma("unroll") for (int k = 0; k < 2; ++k) dst[m][k] = *(const LAS bf16x8*)(lds + PG8_SA(b, h) + aoff + m * 2048 + k * 1024); } while (0)
#define PG8_LDB(dst, b, h) do { _Pragma("unroll") for (int n = 0; n < 2; ++n) _Pragma("unroll") for (int k = 0; k < 2; ++k) dst[n][k] = *(const LAS bf16x8*)(lds + PG8_SB(b, h) + boff + n * 2048 + k * 1024); } while (0)
#define PG8_MMA(ai, bj, At, Bt) do { __builtin_amdgcn_s_setprio(1); _Pragma("unroll") for (int m = 0; m < 4; ++m) _Pragma("unroll") for (int n = 0; n < 2; ++n) _Pragma("unroll") for (int k = 0; k < 2; ++k) \
        { if constexpr (Epi::I8) acc[ai][bj][m][n] = __builtin_bit_cast(f32x4, __builtin_amdgcn_mfma_i32_16x16x64_i8(__builtin_bit_cast(i32x4, Bt[n][k]), __builtin_bit_cast(i32x4, At[m][k]), __builtin_bit_cast(i32x4, acc[ai][bj][m][n]), 0, 0, 0)); \
          else acc[ai][bj][m][n] = __builtin_amdgcn_mfma_f32_16x16x32_bf16(Bt[n][k], At[m][k], acc[ai][bj][m][n], 0, 0, 0); } __builtin_amdgcn_s_setprio(0); } while (0)
#define PG8_WAIT_V(n) asm volatile("s_waitcnt vmcnt(" #n ")" ::: "memory")
#define PG8_WAIT_L(n) asm volatile("s_waitcnt lgkmcnt(" #n ")" ::: "memory")
#define PG8_BAR __builtin_amdgcn_s_barrier()
#define PG8_SCHED __builtin_amdgcn_sched_barrier(0)
    Unit cur, nxt; int ui = 0;
    if (!S.next(0, cur)) return;
    f32x4 acc[2][2][4][2];
#pragma unroll
    for (int a = 0; a < 2; ++a)
#pragma unroll
        for (int b = 0; b < 2; ++b)
#pragma unroll
            for (int m = 0; m < 4; ++m)
#pragma unroll
                for (int n = 0; n < 2; ++n) acc[a][b][m][n] = (f32x4){0.f, 0.f, 0.f, 0.f};
    bf16x8 At[4][2], B0[2][2], B1[2][2];
    const char* cA = S.pa(cur); const char* cB = S.pb(cur);
    PG8_STAGE(PG8_SB(0, 0), cB, voffB); PG8_STAGE(PG8_SA(0, 0), cA, voffA); PG8_STAGE(PG8_SB(0, 1), cB + hstepB, voffB); PG8_STAGE(PG8_SA(0, 1), cA + hstepA, voffA);
    if (wr == 1) PG8_BAR;
    PG8_WAIT_V(4); PG8_BAR;
    PG8_STAGE(PG8_SB(1, 0), cB + kstep, voffB); PG8_STAGE(PG8_SA(1, 0), cA + kstep, voffA); PG8_STAGE(PG8_SB(1, 1), cB + hstepB + kstep, voffB);
    PG8_WAIT_V(6); PG8_BAR;
    for (;;) {
        const bool has_next = S.next(ui + 1, nxt);
        const char* nA = has_next ? S.pa(nxt) : cA; const char* nB = has_next ? S.pb(nxt) : cB;
        for (int t = 0; t < nt; t += 2) {
            const bool last = (t == nt - 2);
            if constexpr (Epi::HAS_MID) { if (t == Epi::MID1 || t == Epi::MID2) { int frM = fr, fqM = fq; asm volatile("" : "+v"(frM), "+v"(fqM)); E.mid(acc, cur, t, wr, wc, frM, fqM); } }
            const char* a1 = cA + (size_t)(t + 1) * kstep;
            const char* a2 = last ? nA : cA + (size_t)(t + 2) * kstep; const char* b2 = last ? nB : cB + (size_t)(t + 2) * kstep;
            const char* a3 = a2 + kstep; const char* b3 = b2 + kstep;
            PG8_LDB(B0, 0, 0); PG8_SCHED; PG8_LDA(At, 0, 0); PG8_STAGE(PG8_SA(1, 1), a1 + hstepA, voffA);
            PG8_WAIT_L(8); PG8_BAR; PG8_WAIT_L(0); PG8_MMA(0, 0, At, B0); PG8_BAR; PG8_SCHED;
            PG8_LDB(B1, 0, 1); PG8_STAGE(PG8_SB(0, 0), b2, voffB);
            PG8_BAR; PG8_WAIT_L(0); PG8_MMA(0, 1, At, B1); PG8_BAR;
            PG8_LDA(At, 0, 1); PG8_STAGE(PG8_SA(0, 0), a2, voffA);
            PG8_BAR; PG8_WAIT_L(0); PG8_MMA(1, 0, At, B0); PG8_BAR; PG8_SCHED;
            PG8_STAGE(PG8_SB(0, 1), b2 + hstepB, voffB);
            PG8_WAIT_V(6); PG8_BAR; PG8_MMA(1, 1, At, B1); PG8_BAR;
            PG8_LDB(B0, 1, 0); PG8_SCHED; PG8_LDA(At, 1, 0); PG8_STAGE(PG8_SA(0, 1), a2 + hstepA, voffA);
            PG8_WAIT_L(8); PG8_BAR; PG8_WAIT_L(0); PG8_MMA(0, 0, At, B0); PG8_BAR; PG8_SCHED;
            PG8_LDB(B1, 1, 1); PG8_STAGE(PG8_SB(1, 0), b3, voffB);
            PG8_BAR; PG8_WAIT_L(0); PG8_MMA(0, 1, At, B1); PG8_BAR;
            PG8_LDA(At, 1, 1); PG8_STAGE(PG8_SA(1, 0), a3, voffA);
            PG8_BAR; PG8_WAIT_L(0); PG8_MMA(1, 0, At, B0); PG8_BAR; PG8_SCHED;
            PG8_STAGE(PG8_SB(1, 1), b3 + hstepB, voffB);
            PG8_WAIT_V(6); PG8_BAR; PG8_MMA(1, 1, At, B1); PG8_BAR;
        }
        { int frE = fr, fqE = fq; asm volatile("" : "+v"(frE), "+v"(fqE)); E(acc, cur, wr, wc, frE, fqE); }
        if (!has_next) break;
#pragma unroll
        for (int a = 0; a < 2; ++a)
#pragma unroll
            for (int b = 0; b < 2; ++b)
#pragma unroll
                for (int m = 0; m < 4; ++m)
#pragma unroll
                    for (int n = 0; n < 2; ++n) acc[a][b][m][n] = (f32x4){0.f, 0.f, 0.f, 0.f};
        cur = nxt; cA = nA; cB = nB; ++ui;
    }
    PG8_WAIT_V(0);
    if (wr == 0) PG8_BAR;
    PG8_BAR;
#undef PG8_SA
#undef PG8_SB
#undef PG8_STAGE
#undef PG8_LDA
#undef PG8_LDB
#undef PG8_MMA
#undef PG8_WAIT_V
#undef PG8_WAIT_L
#undef PG8_BAR
#undef PG8_SCHED
}

#define EPI_LOOP_ROWS _Pragma("unroll") for (int ai = 0; ai < 2; ++ai) _Pragma("unroll") for (int m = 0; m < 4; ++m)
__device__ __forceinline__ void st_bf16x8(bf16_t* p, f32x4 v0, f32x4 v1) { u32x4 w; w.x = cvtpk(v0[0], v0[1]); w.y = cvtpk(v0[2], v0[3]); w.z = cvtpk(v1[0], v1[1]); w.w = cvtpk(v1[2], v1[3]); *(u32x4*)p = w; }

struct EpiInProj {
    static constexpr bool HAS_MID = false; static constexpr bool I8 = false;
    bf16_t* qa; bf16_t* qidx; bf16_t* qkv; bf16_t* gates; float* small_;
    __device__ __forceinline__ void operator()(const f32x4 (&acc)[2][2][4][2], const Unit& u, int wr, int wc, int fr, int fq) const {
        const int pn = u.pn, row0 = u.pm * BM + wr * 64 + fr, lc0 = wc * 32 + fq * 8;
        if (pn < 8) {
            bf16_t* base = (pn < 4 ? qa + pn * 256 : qidx + (pn - 4) * 256) + lc0;
            EPI_LOOP_ROWS { const int row = row0 + ai * HALF + m * 16;
#pragma unroll
                for (int bj = 0; bj < 2; ++bj) st_bf16x8(base + (size_t)row * 1024 + bj * HALF, acc[ai][bj][m][0], acc[ai][bj][m][1]); }
        } else if (pn < 32) {
            const int id = (pn - 8) >> 2, hb = ((pn - 8) & 3) * 2, b = u.pm >> 5;
            bf16_t* base = qkv + (size_t)id * ((size_t)NTOK * 1024) + lc0;
            EPI_LOOP_ROWS { const int row = row0 + ai * HALF + m * 16, s = row & (SEQ - 1);
#pragma unroll
                for (int bj = 0; bj < 2; ++bj) st_bf16x8(base + ((size_t)(b * 8 + hb + bj) * SEQ + s) * 128, acc[ai][bj][m][0], acc[ai][bj][m][1]); }
        } else if (pn < 56) {
            bf16_t* base = gates + (pn - 32) * 256 + lc0;
            EPI_LOOP_ROWS { const int row = row0 + ai * HALF + m * 16;
#pragma unroll
                for (int bj = 0; bj < 2; ++bj) st_bf16x8(base + (size_t)row * 6144 + bj * HALF, acc[ai][bj][m][0], acc[ai][bj][m][1]); }
        } else {
            float* base = small_ + (pn - 56) * 256 + lc0;
            EPI_LOOP_ROWS { const int row = row0 + ai * HALF + m * 16;
#pragma unroll
                for (int bj = 0; bj < 2; ++bj) { float* p = base + (size_t)row * 512 + bj * HALF; *(f32x4*)p = acc[ai][bj][m][0]; *(f32x4*)(p + 4) = acc[ai][bj][m][1]; } }
        }
    }
};
struct EpiGatesI8 {
    static constexpr bool HAS_MID = false; static constexpr bool I8 = true;
    bf16_t* gates; const float* xs; const unsigned* wmaxbits;
    __device__ __forceinline__ void operator()(const f32x4 (&acc)[2][2][4][2], const Unit& u, int wr, int wc, int fr, int fq) const {
        const int row0 = u.pm * BM + wr * 64 + fr; bf16_t* base = gates + u.pn * 256 + wc * 32 + fq * 8;
        const float sw = __uint_as_float(*wmaxbits) * (1.3f / 127.0f);
        EPI_LOOP_ROWS { const int row = row0 + ai * HALF + m * 16; const float sc = xs[row] * sw;
#pragma unroll
            for (int bj = 0; bj < 2; ++bj) { const i32x4 a0 = __builtin_bit_cast(i32x4, acc[ai][bj][m][0]), a1 = __builtin_bit_cast(i32x4, acc[ai][bj][m][1]);
                st_bf16x8(base + (size_t)row * 6144 + bj * HALF, (f32x4){(float)a0[0], (float)a0[1], (float)a0[2], (float)a0[3]} * sc, (f32x4){(float)a1[0], (float)a1[1], (float)a1[2], (float)a1[3]} * sc); } }
    }
};
struct EpiBf16 {
    static constexpr bool HAS_MID = false; static constexpr bool I8 = false;
    bf16_t* out; int ld, cstep;
    __device__ __forceinline__ void operator()(const f32x4 (&acc)[2][2][4][2], const Unit& u, int wr, int wc, int fr, int fq) const {
        const int row0 = u.pm * BM + wr * 64 + fr; bf16_t* base = out + (size_t)u.pn * cstep + wc * 32 + fq * 8;
        EPI_LOOP_ROWS { const int row = row0 + ai * HALF + m * 16;
#pragma unroll
            for (int bj = 0; bj < 2; ++bj) st_bf16x8(base + (size_t)row * ld + bj * HALF, acc[ai][bj][m][0], acc[ai][bj][m][1]); }
    }
};
template <int MODE> struct EpiBranch {
    static constexpr bool HAS_MID = false; static constexpr bool I8 = false;
    const bf16_t* gates; float* tmp; bf16_t* merged; int br;
    __device__ __forceinline__ void operator()(const f32x4 (&acc)[2][2][4][2], const Unit& u, int wr, int wc, int fr, int fq) const {
        const int row0 = u.pm * BM + wr * 64 + fr, col0 = u.pn * BM + wc * 32 + fq * 8;
        EPI_LOOP_ROWS { const int row = row0 + ai * HALF + m * 16;
#pragma unroll
            for (int bj = 0; bj < 2; ++bj) { const int col = col0 + bj * HALF;
                const u32x4 gw = *(const u32x4*)(gates + (size_t)row * 6144 + br * 2048 + col);
                f32x4 v0 = acc[ai][bj][m][0], v1 = acc[ai][bj][m][1];
                v0[0] *= sigmoidf_(bflo(gw.x)); v0[1] *= sigmoidf_(bfhi(gw.x)); v0[2] *= sigmoidf_(bflo(gw.y)); v0[3] *= sigmoidf_(bfhi(gw.y));
                v1[0] *= sigmoidf_(bflo(gw.z)); v1[1] *= sigmoidf_(bfhi(gw.z)); v1[2] *= sigmoidf_(bflo(gw.w)); v1[3] *= sigmoidf_(bfhi(gw.w));
                float* tp = tmp + (size_t)row * 2048 + col;
                if (MODE >= 1) { v0 += *(const f32x4*)tp; v1 += *(const f32x4*)(tp + 4); }
                if (MODE <= 1) { *(f32x4*)tp = v0; *(f32x4*)(tp + 4) = v1; }
                else st_bf16x8(merged + (size_t)row * 2048 + col, v0, v1); } }
    }
};
struct EpiBranch3 {
    static constexpr bool HAS_MID = true; static constexpr bool I8 = false; static constexpr int MID1 = 16, MID2 = 32;
    const bf16_t* gates; bf16_t* merged;
    __device__ __forceinline__ void mid(f32x4 (&acc)[2][2][4][2], const Unit& u, int t, int wr, int wc, int fr, int fq) const {
        const int row0 = u.pm * BM + wr * 64 + fr, col0 = u.pn * BM + wc * 32 + fq * 8, bn = (t == MID1) ? 0 : 2048;
#pragma unroll
        for (int ai = 0; ai < 2; ++ai)
#pragma unroll
            for (int m = 0; m < 4; ++m) { const int row = row0 + ai * HALF + m * 16;
#pragma unroll
                for (int bj = 0; bj < 2; ++bj) { const bf16_t* gp = gates + (size_t)row * 6144 + bn + col0 + bj * HALF;
                    const u32x4 gn = *(const u32x4*)gp, gd = *(const u32x4*)(gp + 2048);
                    f32x4 r0, r1;
                    r0[0] = (1.f + __expf(-bflo(gd.x))) / (1.f + __expf(-bflo(gn.x))); r0[1] = (1.f + __expf(-bfhi(gd.x))) / (1.f + __expf(-bfhi(gn.x)));
                    r0[2] = (1.f + __expf(-bflo(gd.y))) / (1.f + __expf(-bflo(gn.y))); r0[3] = (1.f + __expf(-bfhi(gd.y))) / (1.f + __expf(-bfhi(gn.y)));
                    r1[0] = (1.f + __expf(-bflo(gd.z))) / (1.f + __expf(-bflo(gn.z))); r1[1] = (1.f + __expf(-bfhi(gd.z))) / (1.f + __expf(-bfhi(gn.z)));
                    r1[2] = (1.f + __expf(-bflo(gd.w))) / (1.f + __expf(-bflo(gn.w))); r1[3] = (1.f + __expf(-bfhi(gd.w))) / (1.f + __expf(-bfhi(gn.w)));
                    acc[ai][bj][m][0] *= r0; acc[ai][bj][m][1] *= r1; } }
    }
    __device__ __forceinline__ void operator()(const f32x4 (&acc)[2][2][4][2], const Unit& u, int wr, int wc, int fr, int fq) const {
        const int row0 = u.pm * BM + wr * 64 + fr, col0 = u.pn * BM + wc * 32 + fq * 8;
#pragma unroll
        for (int ai = 0; ai < 2; ++ai)
#pragma unroll
            for (int m = 0; m < 4; ++m) { const int row = row0 + ai * HALF + m * 16;
#pragma unroll
                for (int bj = 0; bj < 2; ++bj) { const int col = col0 + bj * HALF;
                    const u32x4 gw = *(const u32x4*)(gates + (size_t)row * 6144 + 4096 + col);
                    f32x4 v0 = acc[ai][bj][m][0], v1 = acc[ai][bj][m][1];
                    v0[0] *= sigmoidf_(bflo(gw.x)); v0[1] *= sigmoidf_(bfhi(gw.x)); v0[2] *= sigmoidf_(bflo(gw.y)); v0[3] *= sigmoidf_(bfhi(gw.y));
                    v1[0] *= sigmoidf_(bflo(gw.z)); v1[1] *= sigmoidf_(bfhi(gw.z)); v1[2] *= sigmoidf_(bflo(gw.w)); v1[3] *= sigmoidf_(bfhi(gw.w));
                    st_bf16x8(merged + (size_t)row * 2048 + col, v0, v1); } }
    }
};
struct EpiOut {
    static constexpr bool HAS_MID = false; static constexpr bool I8 = false;
    const bf16_t* res; bf16_t* pre;
    __device__ __forceinline__ void operator()(const f32x4 (&acc)[2][2][4][2], const Unit& u, int wr, int wc, int fr, int fq) const {
        const int row0 = u.pm * BM + wr * 64 + fr, col0 = u.pn * BM + wc * 32 + fq * 8;
        EPI_LOOP_ROWS { const int row = row0 + ai * HALF + m * 16;
#pragma unroll
            for (int bj = 0; bj < 2; ++bj) { const size_t o = (size_t)row * 2048 + col0 + bj * HALF;
                const u32x4 rw = *(const u32x4*)(res + o); f32x4 v0 = acc[ai][bj][m][0], v1 = acc[ai][bj][m][1];
                v0[0] += ALPHA * bflo(rw.x); v0[1] += ALPHA * bfhi(rw.x); v0[2] += ALPHA * bflo(rw.y); v0[3] += ALPHA * bfhi(rw.y);
                v1[0] += ALPHA * bflo(rw.z); v1[1] += ALPHA * bfhi(rw.z); v1[2] += ALPHA * bflo(rw.w); v1[3] += ALPHA * bfhi(rw.w);
                st_bf16x8(pre + o, v0, v1); } }
    }
};
struct EpiGateUp {
    static constexpr bool HAS_MID = false; static constexpr bool I8 = false;
    const float* bg; const float* bu; bf16_t* hid;
    __device__ __forceinline__ void operator()(const f32x4 (&acc)[2][2][4][2], const Unit& u, int wr, int wc, int fr, int fq) const {
        const int row0 = u.pm * BM + wr * 64 + fr, j0 = u.pn * 128 + wc * 32 + fq * 8;
        const float* pg = bg + (size_t)u.e * DEXP + j0; const float* pu = bu + (size_t)u.e * DEXP + j0;
        const f32x4 g0b = *(const f32x4*)pg, g1b = *(const f32x4*)(pg + 4), u0b = *(const f32x4*)pu, u1b = *(const f32x4*)(pu + 4);
        EPI_LOOP_ROWS { const int row = row0 + ai * HALF + m * 16;
            f32x4 h0, h1;
#pragma unroll
            for (int j = 0; j < 4; ++j) {
                float g = fminf(acc[ai][0][m][0][j] + g0b[j], 7.0f), uu = fminf(fmaxf(acc[ai][1][m][0][j] + u0b[j], -7.0f), 7.0f);
                h0[j] = (uu + 1.0f) * (g * sigmoidf_(1.702f * g));
                g = fminf(acc[ai][0][m][1][j] + g1b[j], 7.0f); uu = fminf(fmaxf(acc[ai][1][m][1][j] + u1b[j], -7.0f), 7.0f);
                h1[j] = (uu + 1.0f) * (g * sigmoidf_(1.702f * g)); }
            st_bf16x8(hid + (size_t)row * DEXP + j0, h0, h1); }
    }
};
struct EpiGateUpI8 {
    static constexpr bool HAS_MID = false; static constexpr bool I8 = true;
    const float* bg; const float* bu; bf16_t* hid; const float* rowsx; const unsigned* wmaxbits;
    __device__ __forceinline__ void operator()(const f32x4 (&acc)[2][2][4][2], const Unit& u, int wr, int wc, int fr, int fq) const {
        const int row0 = u.pm * BM + wr * 64 + fr, j0 = u.pn * 128 + wc * 32 + fq * 8;
        const float sw = __uint_as_float(*wmaxbits) * (1.3f / 127.0f);
        const float* pg = bg + (size_t)u.e * DEXP + j0; const float* pu = bu + (size_t)u.e * DEXP + j0;
        const f32x4 g0b = *(const f32x4*)pg, g1b = *(const f32x4*)(pg + 4), u0b = *(const f32x4*)pu, u1b = *(const f32x4*)(pu + 4);
        EPI_LOOP_ROWS { const int row = row0 + ai * HALF + m * 16; const float sc = rowsx[row] * sw;
            const i32x4 ag0 = __builtin_bit_cast(i32x4, acc[ai][0][m][0]), ag1 = __builtin_bit_cast(i32x4, acc[ai][0][m][1]), au0 = __builtin_bit_cast(i32x4, acc[ai][1][m][0]), au1 = __builtin_bit_cast(i32x4, acc[ai][1][m][1]);
            f32x4 h0, h1;
#pragma unroll
            for (int j = 0; j < 4; ++j) {
                float g = fminf((float)ag0[j] * sc + g0b[j], 7.0f), uu = fminf(fmaxf((float)au0[j] * sc + u0b[j], -7.0f), 7.0f);
                h0[j] = (uu + 1.0f) * (g * sigmoidf_(1.702f * g));
                g = fminf((float)ag1[j] * sc + g1b[j], 7.0f); uu = fminf(fmaxf((float)au1[j] * sc + u1b[j], -7.0f), 7.0f);
                h1[j] = (uu + 1.0f) * (g * sigmoidf_(1.702f * g)); }
            st_bf16x8(hid + (size_t)row * DEXP + j0, h0, h1); }
    }
};
struct EpiDown {
    static constexpr bool HAS_MID = false; static constexpr bool I8 = false;
    const float* bd; const float* roww; bf16_t* ys;
    __device__ __forceinline__ void operator()(const f32x4 (&acc)[2][2][4][2], const Unit& u, int wr, int wc, int fr, int fq) const {
        const int row0 = u.pm * BM + wr * 64 + fr, col0 = u.pn * BM + wc * 32 + fq * 8;
        f32x4 b[2][2];
#pragma unroll
        for (int bj = 0; bj < 2; ++bj) { const float* p = bd + (size_t)u.e * DM + col0 + bj * HALF; b[bj][0] = *(const f32x4*)p; b[bj][1] = *(const f32x4*)(p + 4); }
        EPI_LOOP_ROWS { const int row = row0 + ai * HALF + m * 16; const float w = roww[row];
#pragma unroll
            for (int bj = 0; bj < 2; ++bj) st_bf16x8(ys + (size_t)row * 2048 + col0 + bj * HALF, (acc[ai][bj][m][0] + b[bj][0]) * w, (acc[ai][bj][m][1] + b[bj][1]) * w); }
    }
};
struct EpiPleGate {
    static constexpr bool HAS_MID = false; static constexpr bool I8 = false;
    const bf16_t* hb; const bf16_t* pp; bf16_t* pre;
    __device__ __forceinline__ void operator()(const f32x4 (&acc)[2][2][4][2], const Unit& u, int wr, int wc, int fr, int fq) const {
        const int row0 = u.pm * BM + wr * 64 + fr, col0 = u.pn * BM + wc * 32 + fq * 8;
        EPI_LOOP_ROWS { const int row = row0 + ai * HALF + m * 16;
#pragma unroll
            for (int bj = 0; bj < 2; ++bj) { const size_t o = (size_t)row * 2048 + col0 + bj * HALF;
                const u32x4 pw = *(const u32x4*)(pp + o), hw = *(const u32x4*)(hb + o);
                const f32x4 a0 = acc[ai][bj][m][0], a1 = acc[ai][bj][m][1]; f32x4 o0, o1;
                o0[0] = bflo(hw.x) + sigmoidf_(a0[0]) * bflo(pw.x); o0[1] = bfhi(hw.x) + sigmoidf_(a0[1]) * bfhi(pw.x); o0[2] = bflo(hw.y) + sigmoidf_(a0[2]) * bflo(pw.y); o0[3] = bfhi(hw.y) + sigmoidf_(a0[3]) * bfhi(pw.y);
                o1[0] = bflo(hw.z) + sigmoidf_(a1[0]) * bflo(pw.z); o1[1] = bfhi(hw.z) + sigmoidf_(a1[1]) * bfhi(pw.z); o1[2] = bflo(hw.w) + sigmoidf_(a1[2]) * bflo(pw.w); o1[3] = bfhi(hw.w) + sigmoidf_(a1[3]) * bfhi(pw.w);
                st_bf16x8(pre + o, o0, o1); } }
    }
};
}

struct Params { const float* in[25]; float* out; unsigned char* ws; int ph_lo, ph_hi; };
__constant__ float c_invf_r[16] = {1.000000000e+00f, 4.403665960e-01f, 1.939227432e-01f, 8.539710194e-02f, 3.760603070e-02f, 1.656043902e-02f, 7.292664610e-03f, 3.211445874e-03f, 1.414213562e-03f, 6.227723788e-04f, 2.742481884e-04f, 1.207697351e-04f, 5.318296098e-05f, 2.341999971e-05f, 1.031338616e-05f, 4.541670478e-06f};
__constant__ float c_invf_i[8] = {1.000000000e+00f, 1.939227432e-01f, 3.760603070e-02f, 7.292664610e-03f, 1.414213562e-03f, 2.742481884e-04f, 5.318296098e-05f, 1.031338616e-05f};
constexpr int LDS_PTRS = LDS_MISC + 256;
struct Frame { unsigned char* lds; LAS unsigned char* ldsl; unsigned char* ws; int tid, lane, wid, G, bid;
    __device__ __forceinline__ const float* in(int k) const { const LAS unsigned* t = (const LAS unsigned*)(ldsl + LDS_PTRS) + 2 * k;
        const unsigned lo = __builtin_amdgcn_readfirstlane(t[0]), hi = __builtin_amdgcn_readfirstlane(t[1]); return (const float*)(((unsigned long long)hi << 32) | lo); }
    __device__ __forceinline__ float* out() const { return (float*)in(25); } };
__device__ __forceinline__ Frame fresh(const Frame& F0) { Frame F = F0; int t = threadIdx.x; asm volatile("" : "+v"(t)); F.tid = t; F.lane = t & 63; F.wid = __builtin_amdgcn_readfirstlane(t >> 6); unsigned char* w = F0.ws; asm volatile("" : "+s"(w)); F.ws = w; return F; }

struct TcTile { const float* src; long sld; bf16_t* dst; long dld; int nvalid; float qinv; };
template <class Dec>
__device__ __forceinline__ void tconv_run(const Frame& F, int total, const Dec& dec, int& rot) {
    float* tile = (float*)F.lds;
    const int tid = F.tid, G = F.G;
    const int start = (F.bid - (rot % G) + G) % G; rot += total;
    const int lr = tid >> 4, lc4 = (tid & 15) * 4, sn = tid >> 3, skc = (tid & 7) * 8;
    f32x4 v[4][2];
#define TC_ISSUE(t0_) do { _Pragma("unroll") for (int q = 0; q < 4; ++q) { const int t = (t0_) + q * G; \
        if (t < total) { const TcTile ti = dec(t); _Pragma("unroll") for (int h = 0; h < 2; ++h) { v[q][h] = (f32x4){0.f, 0.f, 0.f, 0.f}; \
            if (lc4 < ti.nvalid) v[q][h] = *(const f32x4*)(ti.src + (size_t)(lr + 32 * h) * ti.sld + lc4); } } } } while (0)
    if (start < total) TC_ISSUE(start);
    for (int t0 = start; t0 < total; t0 += 4 * G) {
#pragma unroll
        for (int q = 0; q < 4; ++q) { if (t0 + q * G < total) { float* tl = tile + q * (64 * 65);
#pragma unroll
                for (int h = 0; h < 2; ++h) { float* p = tl + (lr + 32 * h) * 65 + lc4; p[0] = v[q][h][0]; p[1] = v[q][h][1]; p[2] = v[q][h][2]; p[3] = v[q][h][3]; } } }
        __syncthreads();
        if (t0 + 4 * G < total) TC_ISSUE(t0 + 4 * G);
#pragma unroll
        for (int q = 0; q < 4; ++q) { const int t = t0 + q * G;
            if (t < total) { const TcTile ti = dec(t); const float* tl = tile + q * (64 * 65);
                if (ti.qinv > 0.f) { if (tid < 256) { const int n8 = tid >> 2, kc = (tid & 3) * 16; u32x4 w;
#pragma unroll
                        for (int d = 0; d < 4; ++d) { unsigned pk = 0u;
#pragma unroll
                            for (int j = 0; j < 4; ++j) { float q = rintf(tl[(kc + d * 4 + j) * 65 + n8] * ti.qinv); q = fminf(fmaxf(q, -127.f), 127.f); pk |= ((unsigned)(int)q & 0xffu) << (8 * j); }
                            w[d] = pk; }
                        *(u32x4*)((unsigned char*)ti.dst + (size_t)n8 * ti.dld + kc) = w; } }
                else if (sn < ti.nvalid) { f32x4 a, b;
#pragma unroll
                    for (int j = 0; j < 4; ++j) { a[j] = tl[(skc + j) * 65 + sn]; b[j] = tl[(skc + 4 + j) * 65 + sn]; }
                    pg8::st_bf16x8(ti.dst + (size_t)sn * ti.dld + skc, a, b); } } }
        __syncthreads();
    }
#undef TC_ISSUE
}
struct TcMat {
    const float* src; long src_ld; int tk, ncols; bf16_t* dst; long dst_ld; float qinv;
    __device__ __forceinline__ TcTile operator()(int t) const { const int k0 = (t % tk) * 64, n0 = (t / tk) * 64; TcTile ti;
        ti.src = src + (size_t)k0 * src_ld + n0; ti.sld = src_ld; ti.dst = qinv > 0.f ? (bf16_t*)((unsigned char*)dst + (size_t)n0 * dst_ld + k0) : dst + (size_t)n0 * dst_ld + k0; ti.dld = dst_ld; ti.nvalid = (ncols - n0) < 64 ? (ncols - n0) : 64; ti.qinv = qinv; return ti; }
};
__device__ __forceinline__ void tconv(const Frame& F, const float* src, long src_ld, int K, int ncols, bf16_t* dst, long dst_ld, int& rot) {
    TcMat d{src, src_ld, K >> 6, ncols, dst, dst_ld, 0.f}; tconv_run(F, (K >> 6) * ((ncols + 63) >> 6), d, rot);
}
struct TcExperts {
    const float* wg; const float* wu; const float* wd; unsigned char* dgu; bf16_t* ddn; float qinv;
    __device__ __forceinline__ TcTile operator()(int t) const { const int e = t / 1536, r = t - e * 1536; TcTile ti; ti.nvalid = 64; ti.qinv = 0.f;
        if (r < 1024) { const int k0 = (r & 31) * 64, dt = r >> 5, jb = dt >> 2, gu = (dt >> 1) & 1, half = dt & 1;
            ti.src = (const float*)((unsigned long long)wg + (unsigned long long)gu * ((unsigned long long)wu - (unsigned long long)wg)) + (size_t)e * DM * DEXP + (size_t)k0 * DEXP + jb * 128 + half * 64; ti.sld = DEXP;
            ti.dst = (bf16_t*)(dgu + (size_t)e * 2048 * 2048 + (size_t)(dt * 64) * 2048 + k0); ti.dld = 2048; ti.qinv = qinv; }
        else { const int r2 = r - 1024, k0 = (r2 & 15) * 64, n0 = (r2 >> 4) * 64;
            ti.src = wd + (size_t)e * DEXP * DM + (size_t)k0 * DM + n0; ti.sld = DM;
            ti.dst = ddn + (size_t)e * 2048 * 1024 + (size_t)n0 * 1024 + k0; ti.dld = 1024; }
        return ti; }
};
__device__ __forceinline__ void sample_wmax(const Frame& F) {
    unsigned* wm = (unsigned*)(F.ws + WS_CTL) + CW_WMAX;
#pragma unroll 1
    for (int l = 0; l < NLAYER; ++l) { float mx = 0.f;
#pragma unroll 1
        for (int which = 0; which < 2; ++which) { const f32x4* p = (const f32x4*)(F.in(which ? 17 : 15) + (size_t)l * NEXP * DM * DEXP);
            for (size_t i = (size_t)F.bid * 512 + F.tid; i < (size_t)NEXP * DM * DEXP / 4 / 64; i += (size_t)F.G * 512) { const f32x4 v = p[i * 64 + (i & 63)];
                mx = fmaxf(mx, fmaxf(fmaxf(fabsf(v[0]), fabsf(v[1])), fmaxf(fabsf(v[2]), fabsf(v[3])))); } }
        for (int o = 32; o > 0; o >>= 1) mx = fmaxf(mx, __shfl_xor(mx, o));
        if (F.lane == 0 && mx > 0.f) atomicMax(&wm[l], __float_as_uint(mx));
        float mg = 0.f; const float* wi_ = F.in(2) + (size_t)l * DM * INW + 8568;
        for (int i = F.bid * 512 + F.tid; i < DM * 1536 / 16; i += F.G * 512) { const int s4 = i * 16 + (i & 15), r = s4 / 1536, c4 = s4 - r * 1536; const f32x4 v = *(const f32x4*)(wi_ + (size_t)r * INW + c4 * 4);
            mg = fmaxf(mg, fmaxf(fmaxf(fabsf(v[0]), fabsf(v[1])), fmaxf(fabsf(v[2]), fabsf(v[3])))); }
        for (int o = 32; o > 0; o >>= 1) mg = fmaxf(mg, __shfl_xor(mg, o));
        if (F.lane == 0 && mg > 0.f) atomicMax(&wm[CW_WMAXG - CW_WMAX + l], __float_as_uint(mg)); }
}
__device__ __forceinline__ void conv_rows(const Frame& F, const float* src, bf16_t* dst, size_t n8) {
    for (size_t i = (size_t)F.bid * 512 + F.tid; i < n8; i += (size_t)F.G * 512) { const f32x4 a = *(const f32x4*)(src + i * 8), b = *(const f32x4*)(src + i * 8 + 4); pg8::st_bf16x8(dst + i * 8, a, b); }
}
__device__ __forceinline__ void quant_rows(const Frame& F, const float* src, bf16_t* xb, unsigned char* xq, float* xsc) {
    const int lane = F.lane;
    for (int tok = F.bid * 8 + F.wid; tok < NTOK; tok += F.G * 8) { f32x4 v[8]; float amax = 0.f;
#pragma unroll
        for (int i = 0; i < 4; ++i) { const int c = (i * 64 + lane) * 8; v[2 * i] = *(const f32x4*)(src + (size_t)tok * DM + c); v[2 * i + 1] = *(const f32x4*)(src + (size_t)tok * DM + c + 4);
            pg8::st_bf16x8(xb + (size_t)tok * DM + c, v[2 * i], v[2 * i + 1]);
#pragma unroll
            for (int h = 0; h < 2; ++h)
#pragma unroll
                for (int j = 0; j < 4; ++j) amax = fmaxf(amax, fabsf(v[2 * i + h][j])); }
        for (int o = 32; o > 0; o >>= 1) amax = fmaxf(amax, __shfl_xor(amax, o));
        amax = fmaxf(amax, 1e-20f); const float qi = 127.0f / amax; if (lane == 0) xsc[tok] = amax * (1.0f / 127.0f);
#pragma unroll
        for (int i = 0; i < 4; ++i) { u32x2 w;
#pragma unroll
            for (int h = 0; h < 2; ++h) { unsigned pk = 0u;
#pragma unroll
                for (int j = 0; j < 4; ++j) pk |= ((unsigned)(int)rintf(v[2 * i + h][j] * qi) & 0xffu) << (8 * j);
                w[h] = pk; }
            *(u32x2*)(xq + (size_t)tok * DM + (i * 64 + lane) * 8) = w; } }
}
__constant__ int c_so[14] = {0, 1312, 2416, 3440, 4464, 5496, 6520, 7544, 8568, 1024, 1280, 2336, 2400, 5488};
__constant__ int c_dn[14] = {0, 1024, 2048, 3072, 4096, 5120, 6144, 7168, 8192, 14336, 14592, 14624, 14688, 14704};
__constant__ int c_nc[14] = {1024, 1024, 1024, 1024, 1024, 1024, 1024, 1024, 6144, 256, 32, 64, 16, 8};
__device__ __forceinline__ void convert_layer_weights(const Frame& F0, const Params& P, int l) { const Frame F = fresh(F0);
    unsigned char* ws = F.ws; int rot = 0;
    { const float* w = F.in(2) + (size_t)l * DM * INW; bf16_t* d = (bf16_t*)(ws + W_IN);
#pragma unroll 1
      for (int s = 0; s < 14; ++s) { if (s == 8) continue; tconv(F, w + c_so[s], INW, DM, c_nc[s], d + (size_t)c_dn[s] * DM, DM, rot); }
      const float wmaxg = __uint_as_float(((const unsigned*)(ws + WS_CTL))[CW_WMAXG + l]);
      TcMat dq{w + 8568, INW, DM >> 6, 6144, (bf16_t*)(ws + W_ING), 2048, 127.0f / (1.3f * wmaxg)}; tconv_run(F, (DM >> 6) * (6144 >> 6), dq, rot); }
    tconv(F, F.in(7) + (size_t)l * 1024 * DM, DM, 1024, DM, (bf16_t*)(ws + W_BRA), 3072, rot);
    tconv(F, F.in(8) + (size_t)l * 1024 * DM, DM, 1024, DM, (bf16_t*)(ws + W_BRA) + 1024, 3072, rot);
    tconv(F, F.in(9) + (size_t)l * 1024 * DM, DM, 1024, DM, (bf16_t*)(ws + W_BRA) + 2048, 3072, rot);
    tconv(F, F.in(10) + (size_t)l * DM * DM, DM, DM, DM, (bf16_t*)(ws + W_OUT), DM, rot);
    tconv(F, F.in(21) + (size_t)l * DM * DM, DM, DM, DM, (bf16_t*)(ws + W_PG), DM, rot);
    tconv(F, F.in(22) + (size_t)l * 256 * DM, DM, 256, DM, (bf16_t*)(ws + W_PLE), 256, rot);
#pragma unroll 1
    for (int h = 0; h < 8; ++h) tconv(F, F.in(6) + (size_t)l * 256 * 1024 + h * 128, 1024, 256, 128, (bf16_t*)(ws + W_UV2) + ((size_t)(h >> 1) * 256 + (h & 1) * 128) * 512 + (h & 1) * 256, 512, rot);
    { const float wmax = __uint_as_float(((const unsigned*)(ws + WS_CTL))[CW_WMAX + l]);
      TcExperts d{F.in(15) + (size_t)l * NEXP * DM * DEXP, F.in(17) + (size_t)l * NEXP * DM * DEXP, F.in(19) + (size_t)l * NEXP * DEXP * DM, (unsigned char*)(ws + W_GU), (bf16_t*)(ws + W_DN), 127.0f / (1.3f * wmax)};
      tconv_run(F, NEXP * 1536, d, rot); }
    { const float* w = F.in(5) + (size_t)l * 256 * 8 * 96; bf16_t* d = (bf16_t*)(ws + W_UK2);
      for (int i = F.bid * 512 + F.tid; i < 256 * 8 * 96; i += F.G * 512) { const int n = i % 96, h = (i / 96) & 7, r = i / 768; d[((size_t)h * 256 + r) * 256 + (h & 1) * 128 + 32 + n] = f2bf(w[i]); } }
}

__device__ __forceinline__ void rope_cs(float pos, float invf, float& c, float& s) {
    const float a = pos * invf; const double ad = (double)a * 0.15915494309189535; const float fr = (float)(ad - rint(ad));
    s = __builtin_amdgcn_sinf(fr); c = __builtin_amdgcn_cosf(fr);
}
__device__ __forceinline__ void phase_prep(const Frame& F0, const Params& P, int l) { const Frame F = fresh(F0);
    unsigned char* ws = F.ws; const int lane = F.lane;
    const float* smallb = (const float*)(ws + R_SMALL); bf16_t* kcat = (bf16_t*)(ws + R_KCAT); bf16_t* qcat = (bf16_t*)(ws + R_QCAT);
    bf16_t* ki = (bf16_t*)(ws + R_KI); float* wi = (float*)(ws + R_WI); float* lf = (float*)(ws + WS_LF);
    const bf16_t* qa = (const bf16_t*)(ws + R_QA); bf16_t* qidx = (bf16_t*)(ws + R_QIDX);
    const f32x4 gck = *(const f32x4*)(F.in(4) + l * 256 + lane * 4);
    const float bfo = lane < 8 ? F.in(3)[l * 8 + lane] : 0.f;
    const float ifr = c_invf_r[lane & 15], ifi = c_invf_i[lane & 7];
    for (int tok = F.bid * 8 + F.wid; tok < NTOK; tok += F.G * 8) {
        const int s = tok & (SEQ - 1), b = tok >> 13; const float* sm = smallb + (size_t)tok * 512;
        float cr, sr, ci, si; rope_cs((float)s, ifr, cr, sr); rope_cs((float)s, ifi, ci, si);
        { const f32x4 v = *(const f32x4*)(sm + lane * 4); float ss = v[0] * v[0] + v[1] * v[1] + v[2] * v[2] + v[3] * v[3]; ss = wave_sum(ss);
          const float rs = rsqrtf(ss * (1.0f / 256.0f) + 1e-6f); u32x2 w; w.x = cvtpk(v[0] * rs * gck[0], v[1] * rs * gck[1]); w.y = cvtpk(v[2] * rs * gck[2], v[3] * rs * gck[3]);
          *(u32x2*)(kcat + (size_t)tok * 288 + lane * 4) = w; }
        if (lane < 16) { const float x1 = sm[256 + lane], x2 = sm[272 + lane]; kcat[(size_t)tok * 288 + 256 + lane] = f2bf(x1 * cr - x2 * sr); kcat[(size_t)tok * 288 + 272 + lane] = f2bf(x2 * cr + x1 * sr); }
        { float o = sm[288 + lane];
          if (lane < 8) { const float x2 = sm[296 + lane]; o = o * ci - x2 * si; } else if (lane < 16) { const float x1 = sm[288 + lane - 8]; o = o * ci + x1 * si; }
          ki[(size_t)tok * 64 + lane] = f2bf(o); }
        if (lane < 16) wi[(size_t)tok * 16 + lane] = sm[352 + lane] * (1.0f / 32.0f);
        if (lane < 8) { const float f = sm[368 + lane] + bfo; lf[(size_t)(b * 8 + lane) * SEQ + s] = fminf(f, 0.f) - log1pf(__expf(-fabsf(f))); }
#pragma unroll
        for (int pp = 0; pp < 2; ++pp) { const int p = lane + 64 * pp, h = p >> 4, i = p & 15;
            const float x1 = bf2f(qa[(size_t)tok * 1024 + h * 128 + i]), x2 = bf2f(qa[(size_t)tok * 1024 + h * 128 + 16 + i]);
            qcat[(size_t)tok * 2304 + h * 288 + 256 + i] = f2bf(x1 * cr - x2 * sr); qcat[(size_t)tok * 2304 + h * 288 + 272 + i] = f2bf(x2 * cr + x1 * sr); }
#pragma unroll
        for (int pp = 0; pp < 2; ++pp) { const int p = lane + 64 * pp, hh = p >> 3, i = p & 7; bf16_t* q = qidx + (size_t)tok * 1024 + hh * 64;
            const float x1 = bf2f(q[i]), x2 = bf2f(q[8 + i]); q[i] = f2bf(x1 * ci - x2 * si); q[8 + i] = f2bf(x2 * ci + x1 * si); }
    }
    { const bf16_t* kbt = (const bf16_t*)(ws + R_QKV) + (size_t)NTOK * 1024; unsigned* kmx = (unsigned*)(ws + WS_CTL) + CW_KMAX + l * 16;
#pragma unroll 1
      for (int bh = 0; bh < 16; ++bh) { float mx = 0.f;
          for (int r0 = (F.bid * 8 + F.wid) * 4; r0 < SEQ; r0 += F.G * 32) {
              const u32x4 w = *(const u32x4*)(kbt + ((size_t)bh * SEQ + r0 + (lane >> 4)) * 128 + (lane & 15) * 8);
              float ss = bflo(w.x) * bflo(w.x) + bfhi(w.x) * bfhi(w.x) + bflo(w.y) * bflo(w.y) + bfhi(w.y) * bfhi(w.y) + bflo(w.z) * bflo(w.z) + bfhi(w.z) * bfhi(w.z) + bflo(w.w) * bflo(w.w) + bfhi(w.w) * bfhi(w.w);
              ss += __shfl_xor(ss, 1); ss += __shfl_xor(ss, 2); ss += __shfl_xor(ss, 4); ss += __shfl_xor(ss, 8); mx = fmaxf(mx, ss); }
          mx = fmaxf(mx, __shfl_xor(mx, 16)); mx = fmaxf(mx, __shfl_xor(mx, 32));
          if (lane == 0) ((float*)F.lds)[F.wid * 16 + bh] = mx; }
      __syncthreads();
      if (F.tid < 16) { float mx = 0.f;
#pragma unroll
          for (int w = 0; w < 8; ++w) mx = fmaxf(mx, ((const float*)F.lds)[w * 16 + F.tid]);
          const unsigned bits = __float_as_uint(mx);
          if (bits > __hip_atomic_load(&kmx[F.tid], __ATOMIC_RELAXED, __HIP_MEMORY_SCOPE_AGENT)) atomicMax(&kmx[F.tid], bits); }
      __syncthreads(); }
}
__device__ __forceinline__ void phase_cumsum(const Frame& F0) { const Frame F = fresh(F0);
    const int gw = F.bid * 8 + F.wid; if (gw >= 16) return;
    const float* lf = (const float*)(F.ws + WS_LF) + (size_t)gw * SEQ; float* cum = (float*)(F.ws + WS_CUM) + (size_t)gw * SEQ;
    const int lane = F.lane; double tot = 0.0;
    for (int j = 0; j < 128; ++j) tot += (double)lf[lane * 128 + j];
    double inc = tot;
    for (int o = 1; o < 64; o <<= 1) { const double n = __shfl_up(inc, o); if (lane >= o) inc += n; }
    double run = inc - tot;
    for (int j = 0; j < 128; ++j) { run += (double)lf[lane * 128 + j]; cum[lane * 128 + j] = (float)run; }
}

__device__ __forceinline__ void idx_unit(const Frame& F, int b, int pi, int half) {
    const int tid = F.tid, lane = F.lane, rho = lane & 31, hh = lane >> 5; unsigned char* ws = F.ws;
    const bf16_t* qidx = (const bf16_t*)(ws + R_QIDX); const bf16_t* ki = (const bf16_t*)(ws + R_KI) + (size_t)b * SEQ * 64; const float* wi = (const float*)(ws + R_WI);
    float* scores = (float*)(ws + R_SCORES) + (size_t)b * SEQ * SEQ;
    LAS unsigned char* kl = F.ldsl;
    const int gl = pi, gh = 127 - pi, nl = (64 * gl + 63) / 128 + 1, nh = (64 * gh + 63) / 128 + 1, tot = nl + nh;
    const int x0 = half ? tot / 2 : 0, x1 = half ? tot : tot / 2;
    bf16x8 af[4][4]; float wv[4][16]; int t0 = 0, curg = -1;
    const int r0 = tid >> 3, p0 = tid & 7;
    const unsigned d0 = (unsigned)(r0 * 128 + ((p0 ^ (r0 & 7)) << 4)), d1 = d0 + 64 * 128;
    u32x4 s0, s1;
    { const int c = x0 < nl ? x0 : x0 - nl; const bf16_t* kp = ki + (size_t)(c * 128) * 64; s0 = *(const u32x4*)(kp + (size_t)r0 * 64 + p0 * 8); s1 = *(const u32x4*)(kp + (size_t)(r0 + 64) * 64 + p0 * 8); }
    __syncthreads();
    *(LAS u32x4*)(kl + d0) = s0; *(LAS u32x4*)(kl + d1) = s1;
    __syncthreads();
    const unsigned rdo = (unsigned)(rho * 128);
#pragma unroll 1
    for (int x = x0; x < x1; ++x) {
        const int g = x < nl ? gl : gh, c = x < nl ? x : x - nl;
        if (g != curg) { curg = g; t0 = g * 64 + F.wid * 8;
#pragma unroll
            for (int mt = 0; mt < 4; ++mt) {
                const int tokA = b * SEQ + t0 + 2 * mt + ((rho >> 2) & 1), head = (rho & 3) + 4 * (rho >> 3);
#pragma unroll
                for (int kk = 0; kk < 4; ++kk) af[mt][kk] = *(const bf16x8*)(qidx + (size_t)tokA * 1024 + head * 64 + kk * 16 + 8 * hh);
                const float* wp = wi + (size_t)(b * SEQ + t0 + 2 * mt + hh) * 16;
#pragma unroll
                for (int q = 0; q < 4; ++q) { const f32x4 v = *(const f32x4*)(wp + 4 * q); wv[mt][4 * q] = v[0]; wv[mt][4 * q + 1] = v[1]; wv[mt][4 * q + 2] = v[2]; wv[mt][4 * q + 3] = v[3]; } } }
        const unsigned bo = (unsigned)((x - x0) & 1) * 16384u;
        if (x + 1 < x1) { const int cn = (x + 1) < nl ? (x + 1) : (x + 1) - nl; const bf16_t* kp = ki + (size_t)(cn * 128) * 64; s0 = *(const u32x4*)(kp + (size_t)r0 * 64 + p0 * 8); s1 = *(const u32x4*)(kp + (size_t)(r0 + 64) * 64 + p0 * 8); }
#pragma unroll
        for (int tl = 0; tl < 4; ++tl) {
            const int kb = c * 128 + tl * 32;
            if (kb <= t0 + 7) {
                bf16x8 bc[4];
#pragma unroll
                for (int kk = 0; kk < 4; ++kk) bc[kk] = *(const LAS bf16x8*)(kl + bo + tl * 4096 + rdo + (((kk * 2 + hh) ^ (rho & 7)) << 4));
                f32x16 a0 = {}, a1 = {}, a2 = {}, a3 = {};
#pragma unroll
                for (int kk = 0; kk < 4; ++kk) { a0 = __builtin_amdgcn_mfma_f32_32x32x16_bf16(af[0][kk], bc[kk], a0, 0, 0, 0); a1 = __builtin_amdgcn_mfma_f32_32x32x16_bf16(af[1][kk], bc[kk], a1, 0, 0, 0);
                                                  a2 = __builtin_amdgcn_mfma_f32_32x32x16_bf16(af[2][kk], bc[kk], a2, 0, 0, 0); a3 = __builtin_amdgcn_mfma_f32_32x32x16_bf16(af[3][kk], bc[kk], a3, 0, 0, 0); }
#define IDX_EPI(A_, mt_) do { float x_0 = 0.f, x_1 = 0.f, x_2 = 0.f, x_3 = 0.f; _Pragma("unroll") for (int r = 0; r < 16; r += 4) { \
                    x_0 = fmaf(wv[mt_][r], fmaxf(A_[r], 0.f), x_0); x_1 = fmaf(wv[mt_][r + 1], fmaxf(A_[r + 1], 0.f), x_1); x_2 = fmaf(wv[mt_][r + 2], fmaxf(A_[r + 2], 0.f), x_2); x_3 = fmaf(wv[mt_][r + 3], fmaxf(A_[r + 3], 0.f), x_3); } \
                    scores[(size_t)(t0 + 2 * (mt_) + hh) * SEQ + kb + rho] = (x_0 + x_1) + (x_2 + x_3); } while (0)
                IDX_EPI(a0, 0); IDX_EPI(a1, 1); IDX_EPI(a2, 2); IDX_EPI(a3, 3);
#undef IDX_EPI
            }
        }
        if (x + 1 < x1) { *(LAS u32x4*)(kl + (bo ^ 16384u) + d0) = s0; *(LAS u32x4*)(kl + (bo ^ 16384u) + d1) = s1; }
        __syncthreads();
    }
}
__device__ __forceinline__ void phase_idx(const Frame& F0) { const Frame F = fresh(F0);
#pragma unroll 1
    for (int it = F.bid; it < 256; it += F.G) { const int b = it >> 7, pi = (it >> 1) & 63, half = it & 1; idx_unit(F, b, pi, half); }
}

__device__ __forceinline__ unsigned sortable(float f) { const unsigned u = __float_as_uint(f); return (u & 0x80000000u) ? ~u : (u | 0x80000000u); }
__device__ __forceinline__ void topk_row(const Frame& F, int b, int t) {
    int lane = F.lane; asm volatile("" : "+v"(lane));
    const int L = t + 1, tok = b * SEQ + t; unsigned char* ws = F.ws;
    int* sel = (int*)(ws + R_SEL) + (size_t)tok * 256; int* nsel = (int*)(ws + R_NSEL);
    if (lane == 0) nsel[tok] = L < 256 ? L : 256;
    if (L <= 256) { for (int j = lane; j < 256; j += 64) sel[j] = j < L ? j : 0; return; }
    const float* row = (const float*)(ws + R_SCORES) + ((size_t)b * SEQ + t) * SEQ;
    const int nch = (L + 1023) >> 10;
#define TOPK_LOAD_ROW() do { _Pragma("unroll") for (int c = 0; c < 8; ++c) { \
        if (c < nch) { _Pragma("unroll") for (int jj = 0; jj < 4; ++jj) { const int j = c * 4 + jj; const f32x4 v = *(const f32x4*)(row + j * 256 + lane * 4); \
                _Pragma("unroll") for (int e_ = 0; e_ < 4; ++e_) { const int idx = j * 256 + lane * 4 + e_; u[j * 4 + e_] = idx < L ? sortable(v[e_]) : 0u; } } } \
        else { _Pragma("unroll") for (int q = 0; q < 16; ++q) u[c * 16 + q] = 0u; } } } while (0)
    unsigned u[128];
    TOPK_LOAD_ROW();
    unsigned g0 = 0u, g1 = 0u, g2 = 0u, g3 = 0u;
#pragma unroll
    for (int c = 0; c < 8; ++c) if (c < nch) {
#pragma unroll
        for (int jj = 0; jj < 4; ++jj) { const int j = c * 4 + jj; g0 = u[4 * j] > g0 ? u[4 * j] : g0; g1 = u[4 * j + 1] > g1 ? u[4 * j + 1] : g1; g2 = u[4 * j + 2] > g2 ? u[4 * j + 2] : g2; g3 = u[4 * j + 3] > g3 ? u[4 * j + 3] : g3; } }
    unsigned tl = g0 < g1 ? g0 : g1; { const unsigned t2 = g2 < g3 ? g2 : g3; tl = tl < t2 ? tl : t2; }
#pragma unroll
    for (int o = 32; o > 0; o >>= 1) { const unsigned x = (unsigned)__shfl_xor((int)tl, o); tl = x < tl ? x : tl; }
    constexpr int CAP = 2048;
    LAS unsigned* candk = (LAS unsigned*)(F.ldsl + F.wid * (CAP * 8)); LAS unsigned* candi = candk + CAP;
    int C = 0;
#pragma unroll
    for (int c = 0; c < 8; ++c) if (c < nch) {
#pragma unroll
        for (int q = 0; q < 16; ++q) { const int rq = c * 16 + q; const bool pr = u[rq] >= tl; const unsigned long long mm = __ballot(pr);
            const int pos = C + __popcll(mm & ((1ull << lane) - 1ull));
            if (pr && pos < CAP) { candk[pos] = u[rq]; candi[pos] = (unsigned)((rq >> 2) * 256 + lane * 4 + (rq & 3)); }
            C += __popcll(mm); if ((q & 3) == 3) SBAR(); } }
    if (C <= CAP) {
        const int ng = (C + 255) >> 8;
        unsigned ck[32]; int ci[32];
#pragma unroll
        for (int g = 0; g < 8; ++g) {
#pragma unroll
            for (int q = 0; q < 4; ++q) { const int r = g * 4 + q, p = r * 64 + lane; ck[r] = 0u; ci[r] = 0;
                if (g < ng && p < C) { ck[r] = candk[p]; ci[r] = (int)candi[p]; } } }
        unsigned T = 0u, thr_gt = 0u; int need_eq = 0; bool early = false;
        for (int bit = 31; bit >= 0; --bit) {
            const unsigned cnd = T | (1u << bit); int cnt = 0;
#pragma unroll
            for (int g = 0; g < 8; ++g) if (g < ng) {
#pragma unroll
                for (int q = 0; q < 4; ++q) cnt += __popcll(__ballot(ck[g * 4 + q] >= cnd)); }
            if (cnt >= 256) { T = cnd; if (cnt == 256) { early = true; break; } }
        }
        if (early) { thr_gt = T - 1u; need_eq = 0; }
        else { int gtc = 0;
#pragma unroll
            for (int g = 0; g < 8; ++g) if (g < ng) {
#pragma unroll
                for (int q = 0; q < 4; ++q) gtc += __popcll(__ballot(ck[g * 4 + q] > T)); }
            thr_gt = T; need_eq = 256 - gtc; }
        int base = 0, eq_taken = 0;
#pragma unroll
        for (int g = 0; g < 8; ++g) if (g < ng) {
#pragma unroll
            for (int q = 0; q < 4; ++q) { const int r = g * 4 + q; const unsigned v = ck[r];
                const bool iseq = (v == thr_gt) && (need_eq > 0);
                const unsigned long long meq = __ballot(iseq);
                const int eqr = __popcll(meq & ((1ull << lane) - 1ull));
                const bool take = (v > thr_gt) || (iseq && (eq_taken + eqr < need_eq));
                const unsigned long long mt = __ballot(take);
                const int pos = base + __popcll(mt & ((1ull << lane) - 1ull));
                if (take && pos < 256) sel[pos] = ci[r];
                base += __popcll(mt); eq_taken += __popcll(meq); } }
        return;
    }
    asm volatile("" ::: "memory");
    TOPK_LOAD_ROW();
    unsigned T = 0u, thr_gt = 0u; int need_eq = 0; bool early = false;
    for (int bit = 31; bit >= 0; --bit) {
        const unsigned cand = T | (1u << bit); int cnt = 0;
#pragma unroll
        for (int c = 0; c < 8; ++c) if (c < nch) {
#pragma unroll
            for (int q = 0; q < 16; ++q) cnt += __popcll(__ballot(u[c * 16 + q] >= cand)); }
        if (cnt >= 256) { T = cand; if (cnt == 256) { early = true; break; } }
    }
    if (early) { thr_gt = T - 1u; need_eq = 0; }
    else { int gtc = 0;
#pragma unroll
        for (int c = 0; c < 8; ++c) if (c < nch) {
#pragma unroll
            for (int q = 0; q < 16; ++q) gtc += __popcll(__ballot(u[c * 16 + q] > T)); }
        thr_gt = T; need_eq = 256 - gtc; }
    int base = 0, eq_taken = 0;
#pragma unroll
    for (int c = 0; c < 8; ++c) if (c < nch) {
#pragma unroll
        for (int q = 0; q < 16; ++q) { const int rq = c * 16 + q; const unsigned v = u[rq];
            const bool iseq = (v == thr_gt) && (need_eq > 0);
            const unsigned long long meq = __ballot(iseq);
            const int eqr = __popcll(meq & ((1ull << lane) - 1ull));
            const bool take = (v > thr_gt) || (iseq && (eq_taken + eqr < need_eq));
            const unsigned long long mt = __ballot(take);
            const int pos = base + __popcll(mt & ((1ull << lane) - 1ull));
            if (take && pos < 256) sel[pos] = (rq >> 2) * 256 + lane * 4 + (rq & 3);
            base += __popcll(mt); eq_taken += __popcll(meq); } }
}
__device__ __forceinline__ void phase_topk(const Frame& F0) { const Frame F = fresh(F0);
    for (int q = F.bid * 8 + F.wid; q < 8192; q += F.G * 8) { const int b = q >> 12, p = q & 4095; topk_row(F, b, p); topk_row(F, b, SEQ - 1 - p); }
}

namespace att {
constexpr int D = 128, KVBLK = 64, QBLK = 32, SHM_V = 16384, SHM_K = 16384;
constexpr int OFF_K = 2 * SHM_V, OFF_BIAS = 2 * SHM_V + 2 * SHM_K, OFF_WS = OFF_BIAS + 512, OFF_FLAGS = OFF_WS + 2048, OFF_QITEM = OFF_FLAGS + 64;
constexpr float EXIT_T = 64.0f;
#define KSWZ(row, colB) ((row) * 256 + ((colB) ^ (((row) & 7) << 4)))
__device__ __forceinline__ int v_st(int k, int c) { const int kk = (k & ~0xC) | ((k & 4) << 1) | ((k & 8) >> 1); return ((kk >> 3) * 4 + (c >> 5)) * 512 + ((kk & 7) * 32 + (c & 31)) * 2; }
__device__ __forceinline__ int v_rd_base(int lane) { return ((lane & 3) << 3) | (((lane >> 2) & 3) << 6) | (((lane >> 4) & 1) << 5) | (((lane >> 5) & 1) << 8); }
constexpr int v_rd_off(int d0, int ks, int half) { return d0 * 512 + ks * 4096 + half * 2048; }
template <int KB>
__device__ __forceinline__ void qkt(f32x16& p0, f32x16& p1, const char* K_lds, int r32, int hi, const bf16x8* qr) {
    p0 = f32x16{}; p1 = f32x16{};
    const char* kb[4];
#pragma unroll
    for (int dd = 0; dd < 4; ++dd) kb[dd] = K_lds + KB * SHM_K + KSWZ(r32, (dd * 16 + hi * 8) * 2);
#pragma unroll
    for (int d0 = 0; d0 < 8; ++d0) { const char* a = kb[d0 & 3] + (d0 >> 2) * 128;
        bf16x8 b0 = *reinterpret_cast<const bf16x8*>(a);
        bf16x8 b1 = *reinterpret_cast<const bf16x8*>(a + 32 * 256);
        p0 = __builtin_amdgcn_mfma_f32_32x32x16_bf16(b0, qr[d0], p0, 0, 0, 0);
        p1 = __builtin_amdgcn_mfma_f32_32x32x16_bf16(b1, qr[d0], p1, 0, 0, 0); }
}
template <int VB>
__device__ __forceinline__ void pv_tile(f32x16* o, int vb0, bf16x8 pa0, bf16x8 pa1, bf16x8 pa2, bf16x8 pa3) {
#define TRRD(dst, off) asm volatile("ds_read_b64_tr_b16 %0, %1 offset:%2" : "=&v"(dst) : "v"(vb0), "i"(off) : "memory")
#define PV_D0(d0) do { s16x4 l0, l1, l2, l3, h0, h1, h2, h3; constexpr int b_ = VB * SHM_V + v_rd_off(d0, 0, 0); \
        TRRD(l0, b_); TRRD(h0, b_ + 2048); TRRD(l1, b_ + 4096); TRRD(h1, b_ + 6144); TRRD(l2, b_ + 8192); TRRD(h2, b_ + 10240); TRRD(l3, b_ + 12288); TRRD(h3, b_ + 14336); \
        asm volatile("s_waitcnt lgkmcnt(0)" ::: "memory"); SBAR(); \
        o[d0] = __builtin_amdgcn_mfma_f32_32x32x16_bf16(pa0, (bf16x8){l0[0], l0[1], l0[2], l0[3], h0[0], h0[1], h0[2], h0[3]}, o[d0], 0, 0, 0); \
        o[d0] = __builtin_amdgcn_mfma_f32_32x32x16_bf16(pa1, (bf16x8){l1[0], l1[1], l1[2], l1[3], h1[0], h1[1], h1[2], h1[3]}, o[d0], 0, 0, 0); \
        o[d0] = __builtin_amdgcn_mfma_f32_32x32x16_bf16(pa2, (bf16x8){l2[0], l2[1], l2[2], l2[3], h2[0], h2[1], h2[2], h2[3]}, o[d0], 0, 0, 0); \
        o[d0] = __builtin_amdgcn_mfma_f32_32x32x16_bf16(pa3, (bf16x8){l3[0], l3[1], l3[2], l3[3], h3[0], h3[1], h3[2], h3[3]}, o[d0], 0, 0, 0); } while (0)
    PV_D0(0); PV_D0(1); PV_D0(2); PV_D0(3);
#undef PV_D0
#undef TRRD
}
#define PK4(P, B_, OUT) do { unsigned a0 = cvtpk(P[B_+0], P[B_+1]), a1 = cvtpk(P[B_+2], P[B_+3]); \
        unsigned b0 = cvtpk(P[B_+4], P[B_+5]), b1 = cvtpk(P[B_+6], P[B_+7]); \
        auto r0 = __builtin_amdgcn_permlane32_swap(a0, b0, false, false); auto r1 = __builtin_amdgcn_permlane32_swap(a1, b1, false, false); \
        u32x4 w = {r0[0], r1[0], r0[1], r1[1]}; OUT = *reinterpret_cast<bf16x8*>(&w); } while (0)
__device__ __forceinline__ float swap_max(float x) { auto rr = __builtin_amdgcn_permlane32_swap(__float_as_uint(x), __float_as_uint(x), false, false); return fmaxf(__uint_as_float(rr[0]), __uint_as_float(rr[1])); }
__device__ __forceinline__ float swap_sum(float x) { auto rr = __builtin_amdgcn_permlane32_swap(__float_as_uint(x), __float_as_uint(x), false, false); return __uint_as_float(rr[0]) + __uint_as_float(rr[1]); }
__device__ __forceinline__ float swap_lo(float x) { auto rr = __builtin_amdgcn_permlane32_swap(__float_as_uint(x), __float_as_uint(x), false, false); return __uint_as_float(rr[0]); }


__device__ __forceinline__ void fox_sm(f32x16& p0, f32x16& p1, const float* bl, int kb_, int qlo, int qrow, int hi, int r32, float& m_reg, float& l_reg, f32x16* o, float* al_l,
                                       bf16x8& pa0, bf16x8& pa1, bf16x8& pa2, bf16x8& pa3) {
#pragma unroll
    for (int g = 0; g < 4; ++g) { const f32x4 b0v = *(const f32x4*)(bl + 8 * g + 4 * hi), b1v = *(const f32x4*)(bl + 32 + 8 * g + 4 * hi);
#pragma unroll
        for (int i = 0; i < 4; ++i) { p0[4 * g + i] = fmaf(p0[4 * g + i], C2, b0v[i]); p1[4 * g + i] = fmaf(p1[4 * g + i], C2, b1v[i]); } }
    if (kb_ + KVBLK - 1 > qlo) { const float NEG = -__builtin_inff();
#pragma unroll
        for (int r = 0; r < 16; ++r) { const int key = kb_ + crow(r, hi); if (key > qrow) p0[r] = NEG; if (key + 32 > qrow) p1[r] = NEG; } }
    float pmax = p0[0];
#pragma unroll
    for (int r = 1; r < 16; ++r) pmax = fmaxf(pmax, p0[r]);
#pragma unroll
    for (int r = 0; r < 16; ++r) pmax = fmaxf(pmax, p1[r]);
    pmax = swap_max(pmax);
    const float mn = fmaxf(m_reg, pmax), alpha = __builtin_amdgcn_exp2f(m_reg - mn); m_reg = mn;
    float ps = 0.f;
#pragma unroll
    for (int r = 0; r < 16; ++r) { p0[r] = __builtin_amdgcn_exp2f(p0[r] - mn); p1[r] = __builtin_amdgcn_exp2f(p1[r] - mn); ps += p0[r] + p1[r]; }
    ps = swap_sum(ps); l_reg = l_reg * alpha + ps;
    if (__any(alpha < 1.f)) { if (hi == 0) al_l[r32] = alpha; asm volatile("s_waitcnt lgkmcnt(0)" ::: "memory");
#pragma unroll
        for (int r = 0; r < 16; ++r) { const float a = al_l[crow(r, hi)];
#pragma unroll
            for (int d_ = 0; d_ < 4; ++d_) o[d_][r] *= a; } }
    PK4(p0, 0, pa0); PK4(p0, 8, pa1); PK4(p1, 0, pa2); PK4(p1, 8, pa3);
}
__device__ __forceinline__ void sb_half(f32x16& pz, int keybase, int qrow, int hi, float& R, const bf16x8* triA, bool needmask) {
    f32x16 X;
#pragma unroll
    for (int r = 0; r < 16; ++r) { const float zz = pz[r] * C2; const bool valid = !needmask || (keybase + crow(r, hi) < qrow);
        const float l2 = fmaxf(zz, 0.f) + __builtin_amdgcn_logf(1.0f + __builtin_amdgcn_exp2f(-fabsf(zz)));
        X[r] = valid ? -l2 : 0.f; pz[r] = valid ? zz : -__builtin_inff(); }
    f32x16 Y;
#pragma unroll
    for (int r = 0; r < 16; ++r) Y[r] = R;
#pragma unroll
    for (int s = 0; s < 2; ++s) {
        const unsigned h0 = cvtpk(X[8 * s + 0], X[8 * s + 1]), h1 = cvtpk(X[8 * s + 2], X[8 * s + 3]), h2 = cvtpk(X[8 * s + 4], X[8 * s + 5]), h3 = cvtpk(X[8 * s + 6], X[8 * s + 7]);
        const unsigned l0 = cvtpk(X[8 * s + 0] - bflo(h0), X[8 * s + 1] - bfhi(h0)), l1 = cvtpk(X[8 * s + 2] - bflo(h1), X[8 * s + 3] - bfhi(h1));
        const unsigned l2 = cvtpk(X[8 * s + 4] - bflo(h2), X[8 * s + 5] - bfhi(h2)), l3 = cvtpk(X[8 * s + 6] - bflo(h3), X[8 * s + 7] - bfhi(h3));
        u32x4 wh = {h0, h1, h2, h3}, wl = {l0, l1, l2, l3};
        Y = __builtin_amdgcn_mfma_f32_32x32x16_bf16(triA[s], *reinterpret_cast<bf16x8*>(&wh), Y, 0, 0, 0);
        Y = __builtin_amdgcn_mfma_f32_32x32x16_bf16(triA[s], *reinterpret_cast<bf16x8*>(&wl), Y, 0, 0, 0); }
#pragma unroll
    for (int r = 0; r < 16; ++r) pz[r] = __builtin_amdgcn_exp2f(pz[r] + Y[r]);
    R = swap_lo(Y[0]);
}
__device__ __forceinline__ void sb_sm(f32x16& p0, f32x16& p1, int kb_, int qlo, int qrow, int hi, float& R, const bf16x8* triA, bf16x8& pa0, bf16x8& pa1, bf16x8& pa2, bf16x8& pa3) {
    const bool needmask = (kb_ + KVBLK - 1 >= qlo);
    sb_half(p1, kb_ + 32, qrow, hi, R, triA, needmask);
    sb_half(p0, kb_, qrow, hi, R, triA, needmask);
    PK4(p0, 0, pa0); PK4(p0, 8, pa1); PK4(p1, 0, pa2); PK4(p1, 8, pa3);
}

template <int MODE>
__device__ __forceinline__ void attn_unit(const bf16_t* Q, const bf16_t* Kh, const bf16_t* Vh, const float* cum, bf16_t* O, int P0, char* lds, float kmaxc) {
    int tid = threadIdx.x; asm volatile("" : "+v"(tid));
    const int wid = __builtin_amdgcn_readfirstlane(tid >> 6), lane = tid & 63, r32 = lane & 31, hi = lane >> 5;
    const int NT = P0 / KVBLK + 4;
    char* V_lds = lds; char* K_lds = lds + OFF_K; float* bias_l = (float*)(lds + OFF_BIAS);
    float* wsl = (float*)(lds + OFF_WS) + wid * 64; float* li_l = wsl; float* al_l = wsl + 32;
    const int qlo = P0 + wid * QBLK, qrow = qlo + r32;
    bf16x8 qr[8];
#pragma unroll
    for (int d0 = 0; d0 < 8; ++d0) qr[d0] = *(const bf16x8*)(Q + (size_t)qrow * D + d0 * 16 + hi * 8);
    const int sr = tid >> 4, sc = (tid & 15) * 8, vst0 = v_st(sr, sc), vst1 = v_st(32 + sr, sc), kws = KSWZ(sr, sc * 2);
    const int vb0 = (int)(uintptr_t)V_lds + v_rd_base(lane);
    const float cumref = (MODE == 0) ? cum[P0] : 0.f;
    int* flg = (int*)(lds + OFF_FLAGS);
    float qn = 0.f;
    if (MODE == 0) { float ss = 0.f;
#pragma unroll
        for (int d0 = 0; d0 < 8; ++d0)
#pragma unroll
            for (int j = 0; j < 8; ++j) { const float x = bf2f((bf16_t)qr[d0][j]); ss = fmaf(x, x, ss); }
        ss = swap_sum(ss); qn = sqrtf(ss) * kmaxc * 1.001f; }
    float m_reg = -1e30f, l_reg = 0.f, R = 0.f; f32x16 o[4] = {};
    bf16x8 triA[2];
    if (MODE == 1) {
#pragma unroll
        for (int s = 0; s < 2; ++s)
#pragma unroll
            for (int j = 0; j < 8; ++j) { const int rho = 16 * s + 8 * (j >> 2) + 4 * hi + (j & 3); triA[s][j] = (rho >= r32) ? (short)0x3F80 : (short)0; }
    }
    bf16x8 st_k0, st_k1, st_v0, st_v1; float st_b = 0.f;
#define TILE_KB(t) ((NT - 1 - (t)) * KVBLK)
#define SLOAD(kb_) do { st_v0 = *(const bf16x8*)(Vh + (size_t)((kb_) + sr) * D + sc); st_v1 = *(const bf16x8*)(Vh + (size_t)((kb_) + 32 + sr) * D + sc); \
                        st_k0 = *(const bf16x8*)(Kh + (size_t)((kb_) + sr) * D + sc); st_k1 = *(const bf16x8*)(Kh + (size_t)((kb_) + 32 + sr) * D + sc); \
                        if (MODE == 0 && tid < 64) st_b = (cumref - cum[(kb_) + tid]) * LOG2E; } while (0)
#define SWRITE(bf) do { *(bf16x8*)(V_lds + (bf) * SHM_V + vst0) = st_v0; *(bf16x8*)(V_lds + (bf) * SHM_V + vst1) = st_v1; \
                        *(bf16x8*)(K_lds + (bf) * SHM_K + kws) = st_k0; *(bf16x8*)(K_lds + (bf) * SHM_K + kws + 32 * 256) = st_k1; \
                        if (MODE == 0 && tid < 64) bias_l[(bf) * 64 + tid] = st_b; } while (0)
    __syncthreads();
    SLOAD(TILE_KB(0)); SWRITE(0);
    __syncthreads();
    f32x16 p0, p1; bf16x8 pa0, pa1, pa2, pa3;
#define STEP(BUF, t) do { const int kb_ = TILE_KB(t); \
        if ((t) + 1 < NT) SLOAD(TILE_KB((t) + 1)); \
        SBAR(); qkt<BUF>(p0, p1, K_lds, r32, hi, qr); \
        if (MODE == 0) fox_sm(p0, p1, bias_l + (BUF) * 64, kb_, qlo, qrow, hi, r32, m_reg, l_reg, o, al_l, pa0, pa1, pa2, pa3); \
        else sb_sm(p0, p1, kb_, qlo, qrow, hi, R, triA, pa0, pa1, pa2, pa3); \
        SBAR(); pv_tile<BUF>(o, vb0, pa0, pa1, pa2, pa3); \
        if ((t) + 1 < NT) SWRITE((BUF) ^ 1); \
        __syncthreads(); } while (0)
    for (int t = 0; t < NT; t += 2) {
        STEP(0, t); STEP(1, t + 1);
        const int kbc = TILE_KB(t + 1); if (kbc == 0) break;
        bool done;
        if (MODE == 0) { const float edge = (cumref - cum[kbc - 1]) * LOG2E; done = (qn + edge - m_reg) < -EXIT_T; }
        else done = R < -EXIT_T;
        const int par = (t >> 1) & 1;
        if (lane == 0) flg[par * 8 + wid] = 0;
        const bool wdone = __all(done);
        if (lane == 0 && wdone) flg[par * 8 + wid] = 1;
        __syncthreads();
        int alld = 1;
#pragma unroll
        for (int w = 0; w < 8; ++w) alld &= flg[par * 8 + w];
        if (alld) break;
    }
    __syncthreads();
#undef STEP
#undef SLOAD
#undef SWRITE
#undef TILE_KB
    float rli[16];
    if (MODE == 0) { if (hi == 0) li_l[r32] = l_reg; asm volatile("s_waitcnt lgkmcnt(0)" ::: "memory");
#pragma unroll
        for (int r = 0; r < 16; ++r) rli[r] = __builtin_amdgcn_rcpf(li_l[crow(r, hi)]); }
    bf16_t* Ow = O + (size_t)(wid * QBLK) * 3072;
#pragma unroll
    for (int r = 0; r < 16; ++r) { const int orow = crow(r, hi);
#pragma unroll
        for (int d0 = 0; d0 < 4; ++d0) { const float v = (MODE == 0) ? o[d0][r] * rli[r] : o[d0][r];
            const float vn = __shfl_xor(v, 1);
            if ((r32 & 1) == 0) *(unsigned*)(Ow + (size_t)orow * 3072 + d0 * 32 + r32) = cvtpk(v, vn); } }
}
}

__device__ __forceinline__ void sparse_query(const Frame& F, int tok, char* ldsw) {
    unsigned char* ws = F.ws; const int lane = F.lane, g = lane >> 4, i16 = lane & 15;
    const bf16_t* qcat = (const bf16_t*)(ws + R_QCAT) + (size_t)tok * 2304; const bf16_t* kbase = (const bf16_t*)(ws + R_KCAT) + (size_t)(tok >> 13) * SEQ * 288;
    const int* sel = (const int*)(ws + R_SEL) + (size_t)tok * 256; const int ns = ((const int*)(ws + R_NSEL))[tok]; const int ntile = (ns + 31) >> 5;
    bf16x8 qf[9];
#pragma unroll
    for (int st = 0; st < 9; ++st) { qf[st] = (bf16x8){0, 0, 0, 0, 0, 0, 0, 0}; if (i16 < 8) qf[st] = *(const bf16x8*)(qcat + i16 * 288 + st * 32 + 8 * g); }
    const int rA = lane >> 2, cq = lane & 3;
    float m = -1e30f, l = 0.f; f32x4 oT[16];
#pragma unroll
    for (int rb = 0; rb < 16; ++rb) oT[rb] = (f32x4){0.f, 0.f, 0.f, 0.f};
    const unsigned ldso = (unsigned)(uintptr_t)ldsw;
    const unsigned vb = ldso + (unsigned)((4 * g + (i16 >> 2)) * 592 + (i16 & 3) * 8);
    constexpr float SC2 = SCALE * LOG2E;
    bf16x8 stg[18];
#define GATHER(tile_) do { const int j0 = (tile_) * 32 + rA, j1 = j0 + 16; const int s0 = j0 < ns ? sel[j0] : 0, s1 = j1 < ns ? sel[j1] : 0; \
        const bf16_t* p0_ = kbase + (size_t)s0 * 288 + cq * 8; const bf16_t* p1_ = kbase + (size_t)s1 * 288 + cq * 8; \
        _Pragma("unroll") for (int c = 0; c < 9; ++c) { stg[2 * c] = *(const bf16x8*)(p0_ + c * 32); stg[2 * c + 1] = *(const bf16x8*)(p1_ + c * 32); } } while (0)
    GATHER(0);
    for (int tile = 0; tile < ntile; ++tile) {
#pragma unroll
        for (int c = 0; c < 9; ++c) { *(bf16x8*)(ldsw + rA * 592 + c * 64 + cq * 16) = stg[2 * c]; *(bf16x8*)(ldsw + (16 + rA) * 592 + c * 64 + cq * 16) = stg[2 * c + 1]; }
        if (tile + 1 < ntile) GATHER(tile + 1);
        asm volatile("s_waitcnt lgkmcnt(0)" ::: "memory"); SBAR();
        f32x4 acc[2];
#pragma unroll
        for (int mt = 0; mt < 2; ++mt) { acc[mt] = (f32x4){0.f, 0.f, 0.f, 0.f};
#pragma unroll
            for (int st = 0; st < 9; ++st) { const bf16x8 a = *(const bf16x8*)(ldsw + (16 * mt + i16) * 592 + st * 64 + g * 16);
                acc[mt] = __builtin_amdgcn_mfma_f32_16x16x32_bf16(a, qf[st], acc[mt], 0, 0, 0); } }
        float tmax = -__builtin_inff();
#pragma unroll
        for (int mt = 0; mt < 2; ++mt)
#pragma unroll
            for (int r = 0; r < 4; ++r) { const int key = tile * 32 + 16 * mt + 4 * g + r; float x = acc[mt][r] * SC2; if (key >= ns) x = -__builtin_inff(); acc[mt][r] = x; tmax = fmaxf(tmax, x); }
        tmax = fmaxf(tmax, __shfl_xor(tmax, 16)); tmax = fmaxf(tmax, __shfl_xor(tmax, 32));
        const float mn = fmaxf(m, tmax), alpha = __builtin_amdgcn_exp2f(m - mn); m = mn;
        float ps = 0.f;
#pragma unroll
        for (int mt = 0; mt < 2; ++mt)
#pragma unroll
            for (int r = 0; r < 4; ++r) { acc[mt][r] = __builtin_amdgcn_exp2f(acc[mt][r] - mn); ps += acc[mt][r]; }
        ps += __shfl_xor(ps, 16); ps += __shfl_xor(ps, 32);
        l = l * alpha + ps;
#pragma unroll
        for (int rb = 0; rb < 16; ++rb) oT[rb] *= alpha;
        const bf16x8 pf = pack8(acc[0], acc[1]);
#define TRRD2(dst, off) asm volatile("ds_read_b64_tr_b16 %0, %1 offset:%2" : "=&v"(dst) : "v"(vb), "i"(off) : "memory")
#define PVRB(rb) do { s16x4 t1, t2; TRRD2(t1, (rb) * 32); TRRD2(t2, (rb) * 32 + 16 * 592); asm volatile("s_waitcnt lgkmcnt(0)" ::: "memory"); SBAR(); \
        oT[rb] = __builtin_amdgcn_mfma_f32_16x16x32_bf16((bf16x8){t1[0], t1[1], t1[2], t1[3], t2[0], t2[1], t2[2], t2[3]}, pf, oT[rb], 0, 0, 0); } while (0)
        PVRB(0); PVRB(1); PVRB(2); PVRB(3); PVRB(4); PVRB(5); PVRB(6); PVRB(7); PVRB(8); PVRB(9); PVRB(10); PVRB(11); PVRB(12); PVRB(13); PVRB(14); PVRB(15);
#undef PVRB
#undef TRRD2
        SBAR();
    }
#undef GATHER
    const float rl = 1.0f / l;
    if (i16 < 8) { bf16_t* op = (bf16_t*)(ws + R_OLAT) + (size_t)tok * 2048 + i16 * 256 + 4 * g;
#pragma unroll
        for (int rb = 0; rb < 16; ++rb) { u32x2 w; w.x = cvtpk(oT[rb][0] * rl, oT[rb][1] * rl); w.y = cvtpk(oT[rb][2] * rl, oT[rb][3] * rl); *(u32x2*)(op + rb * 16) = w; } }
}
#ifdef ATT_SUB
#define ASUB(k) ((k) == ATT_SUB)
#else
#define ASUB(k) true
#endif
__device__ __forceinline__ void phase_attn(const Frame& F0, int l, int rep) { const Frame F = fresh(F0);
    unsigned char* ws = F.ws; char* lds = (char*)F.lds;
    const bf16_t* qkv = (const bf16_t*)(ws + R_QKV); const size_t TS = (size_t)NTOK * 1024;
    unsigned* qctr = (unsigned*)(ws + WS_CTL) + CW_QCTR + l * 64 + rep * 16; const unsigned* kmx = (const unsigned*)(ws + WS_CTL) + CW_KMAX + l * 16;
    int* qitem = (int*)(lds + att::OFF_QITEM);
#pragma unroll 1
    for (;;) {
        __syncthreads();
        if (F.tid == 0) qitem[0] = (int)atomicAdd(qctr, 1u);
        __syncthreads();
        const int it = qitem[0];
        if (it >= 1024) break;
        const int md = it >> 9, j = it & 511, qb = 31 - (j >> 4), bh = j & 15, b = bh >> 3, h = bh & 7, P0 = qb * 256;
        if (!ASUB(md)) continue;
        const bf16_t* Q = qkv + (size_t)(md * 3 + 0) * TS + (size_t)bh * SEQ * 128; const bf16_t* K = qkv + (size_t)(md * 3 + 1) * TS + (size_t)bh * SEQ * 128; const bf16_t* V = qkv + (size_t)(md * 3 + 2) * TS + (size_t)bh * SEQ * 128;
        const float* cum = (const float*)(ws + WS_CUM) + (size_t)bh * SEQ;
        bf16_t* Ob = (bf16_t*)(ws + R_OA) + (size_t)b * SEQ * 3072 + (md + 1) * 1024 + h * 128;
        if (md == 0) { const float kmaxc = sqrtf(__uint_as_float(kmx[bh])) * C2; att::attn_unit<0>(Q, K, V, cum, Ob + (size_t)P0 * 3072, P0, lds, kmaxc); }
        else att::attn_unit<1>(Q, K, V, cum, Ob + (size_t)P0 * 3072, P0, lds, 0.f);
    }
    __syncthreads();
    char* ldsw = lds + F.wid * 18944;
#pragma unroll 1
    for (int rep = 0; rep < NREP(2); ++rep)
#pragma unroll 1
    for (int tok = F.bid * 8 + F.wid; tok < NTOK; tok += F.G * 8) if (ASUB(2)) sparse_query(F, tok, ldsw);
}

__device__ __forceinline__ void ln_row(const bf16_t* src, const float* g, const float* bta, float* of, bf16_t* ob, int lane, unsigned char* oq = nullptr, float* osc = nullptr) {
    f32x4 v[8]; float s = 0.f;
#pragma unroll
    for (int i = 0; i < 4; ++i) { const u32x4 w = *(const u32x4*)(src + (i * 64 + lane) * 8);
        v[2 * i] = (f32x4){bflo(w.x), bfhi(w.x), bflo(w.y), bfhi(w.y)}; v[2 * i + 1] = (f32x4){bflo(w.z), bfhi(w.z), bflo(w.w), bfhi(w.w)};
        s += (v[2 * i][0] + v[2 * i][1]) + (v[2 * i][2] + v[2 * i][3]) + (v[2 * i + 1][0] + v[2 * i + 1][1]) + (v[2 * i + 1][2] + v[2 * i + 1][3]); }
    s = wave_sum(s); const float mu = s * (1.0f / 2048.0f); float q = 0.f;
#pragma unroll
    for (int i = 0; i < 8; ++i) { const f32x4 d = v[i] - mu; q += (d[0] * d[0] + d[1] * d[1]) + (d[2] * d[2] + d[3] * d[3]); }
    q = wave_sum(q); const float rstd = rsqrtf(q * (1.0f / 2048.0f) + 1e-5f);
    float amax = 0.f;
#pragma unroll
    for (int i = 0; i < 4; ++i) { const int c = (i * 64 + lane) * 8; const f32x4 g0 = *(const f32x4*)(g + c), g1 = *(const f32x4*)(g + c + 4), b0 = *(const f32x4*)(bta + c), b1 = *(const f32x4*)(bta + c + 4);
        const f32x4 y0 = (v[2 * i] - mu) * rstd * g0 + b0, y1 = (v[2 * i + 1] - mu) * rstd * g1 + b1; v[2 * i] = y0; v[2 * i + 1] = y1;
        if (of) { *(f32x4*)(of + c) = y0; *(f32x4*)(of + c + 4) = y1; }
        if (ob) pg8::st_bf16x8(ob + c, y0, y1);
        if (oq) { amax = fmaxf(amax, fmaxf(fmaxf(fmaxf(fabsf(y0[0]), fabsf(y0[1])), fmaxf(fabsf(y0[2]), fabsf(y0[3]))), fmaxf(fmaxf(fabsf(y1[0]), fabsf(y1[1])), fmaxf(fabsf(y1[2]), fabsf(y1[3]))))); } }
    if (oq) {
        for (int o = 32; o > 0; o >>= 1) amax = fmaxf(amax, __shfl_xor(amax, o));
        amax = fmaxf(amax, 1e-20f); const float qi = 127.0f / amax; if (lane == 0) *osc = amax * (1.0f / 127.0f);
#pragma unroll
        for (int i = 0; i < 4; ++i) { u32x2 w;
#pragma unroll
            for (int h = 0; h < 2; ++h) { const f32x4 y = v[2 * i + h]; unsigned pk = 0u;
#pragma unroll
                for (int j = 0; j < 4; ++j) pk |= ((unsigned)(int)rintf(y[j] * qi) & 0xffu) << (8 * j);
                w[h] = pk; }
            *(u32x2*)(oq + (i * 64 + lane) * 8) = w; } }
}
__device__ __forceinline__ void phase_ln1_router(const Frame& F0, const Params& P, int l) { const Frame F = fresh(F0);
    unsigned char* ws = F.ws; const int lane = F.lane, wid = F.wid;
    const bf16_t* pre1 = (const bf16_t*)(ws + R_PRE1); float* x1f = (float*)(ws + M_X1F); bf16_t* x1b = (bf16_t*)(ws + M_X1B); unsigned char* x1q = (unsigned char*)(ws + M_X1Q); float* x1s = (float*)(ws + M_X1S);
    const float* g = F.in(11) + l * DM; const float* bt = F.in(12) + l * DM; const float* wr = F.in(13) + (size_t)l * DM * NEXP; const float* br = F.in(14) + l * NEXP;
    unsigned* cnt = (unsigned*)(ws + WS_CTL) + CW_CNT + l * 2048;
    int* tok_e = (int*)(ws + M_TOKE); int* tok_pos = (int*)(ws + M_TOKPOS); float* tok_w = (float*)(ws + M_TOKW);
    float* red = (float*)F.lds;
    float* lg = (float*)(F.lds + 32768);
#pragma unroll 1
    for (int blk = F.bid; blk < NTOK / 64; blk += F.G) {
        const int tok0 = blk * 64;
#pragma unroll 1
        for (int i = 0; i < 8; ++i) { const int tok = tok0 + wid * 8 + i; ln_row(pre1 + (size_t)tok * DM, g, bt, x1f + (size_t)tok * DM, x1b + (size_t)tok * DM, lane, x1q + (size_t)tok * DM, x1s + tok); }
        asm volatile("s_waitcnt vmcnt(0)" ::: "memory"); __syncthreads();
        { const int grp = wid >> 2, kq = wid & 3, i32 = lane & 31, hk = lane >> 5; f32x16 acc = {};
          const float* arow = x1f + (size_t)(tok0 + grp * 32 + i32) * DM + kq * 512 + 4 * hk; const float* bcol = wr + (size_t)(kq * 512 + 4 * hk) * NEXP + i32;
#pragma unroll 4
          for (int c8 = 0; c8 < 64; ++c8) { const f32x4 a4 = *(const f32x4*)(arow + c8 * 8);
              const float b0 = bcol[(size_t)(c8 * 8 + 0) * NEXP], b1 = bcol[(size_t)(c8 * 8 + 1) * NEXP], b2 = bcol[(size_t)(c8 * 8 + 2) * NEXP], b3 = bcol[(size_t)(c8 * 8 + 3) * NEXP];
              acc = __builtin_amdgcn_mfma_f32_32x32x2f32(a4[0], b0, acc, 0, 0, 0); acc = __builtin_amdgcn_mfma_f32_32x32x2f32(a4[1], b1, acc, 0, 0, 0);
              acc = __builtin_amdgcn_mfma_f32_32x32x2f32(a4[2], b2, acc, 0, 0, 0); acc = __builtin_amdgcn_mfma_f32_32x32x2f32(a4[3], b3, acc, 0, 0, 0); }
#pragma unroll
          for (int r = 0; r < 16; ++r) red[(wid * 16 + r) * 64 + lane] = acc[r]; }
        __syncthreads();
        if ((wid & 3) == 0) { const int grp = wid >> 2, hk = lane >> 5, e = lane & 31; const float be = br[e];
#pragma unroll
            for (int r = 0; r < 16; ++r) { const float v = red[((wid + 0) * 16 + r) * 64 + lane] + red[((wid + 1) * 16 + r) * 64 + lane] + red[((wid + 2) * 16 + r) * 64 + lane] + red[((wid + 3) * 16 + r) * 64 + lane] + be;
                lg[(grp * 32 + crow(r, hk)) * 33 + e] = v; }
            asm volatile("s_waitcnt lgkmcnt(0)" ::: "memory"); SBAR();
            const int tk = lane & 31; float v[32];
#pragma unroll
            for (int e2 = 0; e2 < 32; ++e2) v[e2] = lg[(grp * 32 + tk) * 33 + e2];
            int ek[4]; float vk[4];
#pragma unroll
            for (int k = 0; k < 4; ++k) { float best = -__builtin_inff(); int bi = 0;
#pragma unroll
                for (int e2 = 0; e2 < 32; ++e2) if (v[e2] > best) { best = v[e2]; bi = e2; }
                ek[k] = bi; vk[k] = best;
#pragma unroll
                for (int e2 = 0; e2 < 32; ++e2) v[e2] = (e2 == bi) ? -__builtin_inff() : v[e2]; }
            float wk[4], sw = 0.f;
#pragma unroll
            for (int k = 0; k < 4; ++k) { wk[k] = __expf(vk[k] - vk[0]); sw += wk[k]; }
            const float rs = 1.0f / sw;
            const bool act = lane < 32; unsigned myc = 0u;
#pragma unroll 1
            for (int E = 0; E < 32; ++E) { unsigned c = 0u;
#pragma unroll
                for (int k = 0; k < 4; ++k) c += (unsigned)__popcll(__ballot(act && ek[k] == E));
                if (lane == E) myc = c; }
            unsigned run = 0u; if (lane < 32 && myc > 0u) run = atomicAdd(&cnt[lane * 64], myc);
            int pk[4];
#pragma unroll
            for (int k = 0; k < 4; ++k) { pk[k] = 0;
#pragma unroll 1
                for (int E = 0; E < 32; ++E) { const unsigned long long mm = __ballot(act && ek[k] == E); const unsigned basev = (unsigned)__shfl((int)run, E);
                    if (act && ek[k] == E) pk[k] = (int)(basev + (unsigned)__popcll(mm & ((1ull << lane) - 1ull)));
                    if (lane == E) run += (unsigned)__popcll(mm); } }
            if (act) { const int tok = tok0 + grp * 32 + tk;
#pragma unroll
                for (int k = 0; k < 4; ++k) { tok_e[tok * 4 + k] = ek[k]; tok_pos[tok * 4 + k] = pk[k]; tok_w[tok * 4 + k] = wk[k] * rs; } }
        }
        __syncthreads();
    }
}
__device__ __forceinline__ void phase_moe_gather(const Frame& F0, int l) { const Frame F = fresh(F0);
    unsigned char* ws = F.ws; const int lane = F.lane;
    const unsigned* cnt = (const unsigned*)(ws + WS_CTL) + CW_CNT + l * 2048; unsigned* meta = (unsigned*)(ws + WS_CTL) + CW_META + l * 512;
    unsigned* offs = (unsigned*)(F.lds + LDS_MISC + 64);
    if (F.tid == 0) { unsigned o = 0u; for (int e = 0; e < 32; ++e) { offs[e] = o; o += (cnt[e * 64] + 255u) & ~255u; } offs[32] = o;
        if (F.bid == 0) { meta[0] = o >> 8; for (int e = 0; e < 32; ++e) for (unsigned t = offs[e] >> 8; t < (offs[e + 1] >> 8); ++t) meta[1 + t] = (unsigned)e; } }
    __syncthreads();
    const int* tok_e = (const int*)(ws + M_TOKE); const int* tok_pos = (const int*)(ws + M_TOKPOS); const float* tok_w = (const float*)(ws + M_TOKW);
    int* tok_dst = (int*)(ws + M_TOKDST); float* roww = (float*)(ws + M_ROWW);
    const unsigned char* x1q = (const unsigned char*)(ws + M_X1Q); const float* x1s = (const float*)(ws + M_X1S); unsigned char* xs = (unsigned char*)(ws + M_XS); float* rowsx = (float*)(ws + M_ROWSX);
    for (int it = F.bid * 8 + F.wid; it < NTOK * 4; it += F.G * 8) { const int tok = it >> 2;
        const int e = tok_e[it]; const unsigned dst = offs[e] + (unsigned)tok_pos[it];
        if (lane == 0) { tok_dst[it] = (int)dst; roww[dst] = tok_w[it]; rowsx[dst] = x1s[tok]; }
        const u32x4* sp = (const u32x4*)(x1q + (size_t)tok * DM); u32x4* dp = (u32x4*)(xs + (size_t)dst * DM);
#pragma unroll
        for (int i = 0; i < 2; ++i) dp[i * 64 + lane] = sp[i * 64 + lane]; }
    __syncthreads();
}
__device__ __forceinline__ void phase_combine(const Frame& F0) { const Frame F = fresh(F0);
    unsigned char* ws = F.ws; const int lane = F.lane;
    const bf16_t* x1b = (const bf16_t*)(ws + M_X1B); const bf16_t* ys = (const bf16_t*)(ws + M_XS); const int* tok_dst = (const int*)(ws + M_TOKDST);
    bf16_t* hb = (bf16_t*)(ws + M_HB);
    for (int tok = F.bid * 8 + F.wid; tok < NTOK; tok += F.G * 8) {
        const int d0 = tok_dst[tok * 4], d1 = tok_dst[tok * 4 + 1], d2 = tok_dst[tok * 4 + 2], d3 = tok_dst[tok * 4 + 3];
#pragma unroll
        for (int i = 0; i < 4; ++i) { const int c = (i * 64 + lane) * 8; const size_t o = (size_t)tok * DM + c;
            const u32x4 xw = *(const u32x4*)(x1b + o);
            f32x4 a = (f32x4){bflo(xw.x), bfhi(xw.x), bflo(xw.y), bfhi(xw.y)} * ALPHA, b = (f32x4){bflo(xw.z), bfhi(xw.z), bflo(xw.w), bfhi(xw.w)} * ALPHA;
            const u32x4 y0 = *(const u32x4*)(ys + (size_t)d0 * DM + c), y1 = *(const u32x4*)(ys + (size_t)d1 * DM + c), y2 = *(const u32x4*)(ys + (size_t)d2 * DM + c), y3 = *(const u32x4*)(ys + (size_t)d3 * DM + c);
            a[0] += (bflo(y0.x) + bflo(y1.x)) + (bflo(y2.x) + bflo(y3.x)); a[1] += (bfhi(y0.x) + bfhi(y1.x)) + (bfhi(y2.x) + bfhi(y3.x));
            a[2] += (bflo(y0.y) + bflo(y1.y)) + (bflo(y2.y) + bflo(y3.y)); a[3] += (bfhi(y0.y) + bfhi(y1.y)) + (bfhi(y2.y) + bfhi(y3.y));
            b[0] += (bflo(y0.z) + bflo(y1.z)) + (bflo(y2.z) + bflo(y3.z)); b[1] += (bfhi(y0.z) + bfhi(y1.z)) + (bfhi(y2.z) + bfhi(y3.z));
            b[2] += (bflo(y0.w) + bflo(y1.w)) + (bflo(y2.w) + bflo(y3.w)); b[3] += (bfhi(y0.w) + bfhi(y1.w)) + (bfhi(y2.w) + bfhi(y3.w));
            pg8::st_bf16x8(hb + o, a, b); } }
}
__device__ __forceinline__ void phase_ln2(const Frame& F0, const Params& P, int l) { const Frame F = fresh(F0);
    unsigned char* ws = F.ws; const bf16_t* pre2 = (const bf16_t*)(ws + M_X1F); bf16_t* xb = (bf16_t*)(ws + WS_XB);
    const float* g = F.in(23) + l * DM; const float* bt = F.in(24) + l * DM; float* outp = F.out();
    for (int tok = F.bid * 8 + F.wid; tok < NTOK; tok += F.G * 8) ln_row(pre2 + (size_t)tok * DM, g, bt, (l + 1 == NLAYER) ? outp + (size_t)tok * DM : (float*)nullptr, (l + 1 == NLAYER) ? (bf16_t*)nullptr : xb + (size_t)tok * DM, F.lane,
                                                                          (l + 1 == NLAYER) ? (unsigned char*)nullptr : (unsigned char*)(ws + WS_XQ) + (size_t)tok * DM, (l + 1 == NLAYER) ? (float*)nullptr : (float*)(ws + WS_XSC) + tok);
}

constexpr int NPHASE = 2 + 15 * NLAYER;
#ifdef PH_ONLY
#define PEN(kind) ((kind) == PH_ONLY)
#else
#define PEN(kind) true
#endif
#define IN(k) (lo <= (k) && (k) < hi)
#define SEAM(k) do { if (IN((k) + 1)) xcd_barrier(bar); } while (0)

template <int l>
__device__ __forceinline__ void layer_phases(const Frame& F, const Params& P, const XcdBarrier& bar, const int lo, const int hi, unsigned char* ws0) {
    using namespace pg8;

        const int pb = 2 + 15 * l;
        if (IN(pb + 0) && PEN(0)) { unsigned char* ws = ws0; asm volatile("" : "+s"(ws));
            { SchedS S; S.init(NTOK, 34 * 256, F.G, F.bid, (const bf16_t*)(ws + WS_XB), DM, (const bf16_t*)(ws + W_IN), DM); S.skip_from = 32; S.skip_by = 24;
              EpiInProj E{(bf16_t*)(ws + R_QA), (bf16_t*)(ws + R_QIDX), (bf16_t*)(ws + R_QKV), (bf16_t*)(ws + R_GATES), (float*)(ws + R_SMALL)};
              for (int rep = 0; rep < NREP(5); ++rep) gemm_phase(F.ldsl, DM, DM, DM, S, E); }
            { SchedS S; S.init(NTOK, 24 * 256, F.G, F.bid, (const bf16_t*)(ws + WS_XQ), DM / 2, (const bf16_t*)(ws + W_ING), DM / 2);
              EpiGatesI8 E{(bf16_t*)(ws + R_GATES), (const float*)(ws + WS_XSC), (const unsigned*)(ws + WS_CTL) + CW_WMAXG + l};
              for (int rep = 0; rep < NREP(5); ++rep) gemm_phase(F.ldsl, DM / 2, DM / 2, DM / 2, S, E); }
            SEAM(pb + 0); }
        if (IN(pb + 1) && PEN(1)) { unsigned char* ws = ws0; asm volatile("" : "+s"(ws));
            phase_prep(F, P, l);
            SchedS S; S.init(NTOK, 2048, F.G, F.bid, (const bf16_t*)(ws + R_QA), 1024, (const bf16_t*)(ws + W_UK2), 256, 1, 256);
            EpiBf16 E{(bf16_t*)(ws + R_QCAT), 2304, 288};
            for (int rep = 0; rep < NREP(10); ++rep) gemm_phase(F.ldsl, 256, 1024, 256, S, E); SEAM(pb + 1); }
        if (IN(pb + 2) && PEN(2)) { unsigned char* ws = ws0; asm volatile("" : "+s"(ws)); phase_cumsum(F); for (int rep = 0; rep < NREP(3); ++rep) phase_idx(F); SEAM(pb + 2); }
        if (IN(pb + 3) && PEN(3)) { unsigned char* ws = ws0; asm volatile("" : "+s"(ws)); for (int rep = 0; rep < NREP(4); ++rep) phase_topk(F); SEAM(pb + 3); }
        if (IN(pb + 4) && PEN(4)) { unsigned char* ws = ws0; asm volatile("" : "+s"(ws)); for (int rep = 0; rep < NREP(1); ++rep) phase_attn(F, l, rep); SEAM(pb + 4); }
        if (IN(pb + 5) && PEN(5)) { unsigned char* ws = ws0; asm volatile("" : "+s"(ws));
            SchedS S; S.init(NTOK, 1024, F.G, F.bid, (const bf16_t*)(ws + R_OLAT), 2048, (const bf16_t*)(ws + W_UV2), 512, 0, 512);
            EpiBf16 E{(bf16_t*)(ws + R_OA), 3072, 256}; for (int rep = 0; rep < NREP(10); ++rep) gemm_phase(F.ldsl, 512, 2048, 512, S, E);
            SEAM(pb + 5); }
        if (IN(pb + 6) && PEN(6)) { unsigned char* ws = ws0; asm volatile("" : "+s"(ws));
            SchedS S; S.init(NTOK, 2048, F.G, F.bid, (const bf16_t*)(ws + R_OA), 3072, (const bf16_t*)(ws + W_BRA), 3072);
            EpiBranch3 E{(const bf16_t*)(ws + R_GATES), (bf16_t*)(ws + R_MERGED)}; for (int rep = 0; rep < NREP(11); ++rep) gemm_phase(F.ldsl, 3072, 3072, 3072, S, E); SEAM(pb + 6); }
        if (IN(pb + 7) && PEN(7)) { unsigned char* ws = ws0; asm volatile("" : "+s"(ws));
            SchedS S; S.init(NTOK, 2048, F.G, F.bid, (const bf16_t*)(ws + R_MERGED), DM, (const bf16_t*)(ws + W_OUT), DM);
            EpiOut E{(const bf16_t*)(ws + WS_XB), (bf16_t*)(ws + R_PRE1)}; for (int rep = 0; rep < NREP(8); ++rep) gemm_phase(F.ldsl, DM, DM, DM, S, E); SEAM(pb + 7); }
        if (IN(pb + 8) && PEN(8)) { unsigned char* ws = ws0; asm volatile("" : "+s"(ws)); phase_ln1_router(F, P, l); SEAM(pb + 8); }
        if (IN(pb + 9) && PEN(9)) { unsigned char* ws = ws0; asm volatile("" : "+s"(ws));
            for (int rep = 0; rep < NREP(12); ++rep) phase_moe_gather(F, l);
            SchedS S; S.init(NTOK, 2048, F.G, F.bid, (const bf16_t*)(ws + WS_PB) + (size_t)l * NTOK * 256, 256, (const bf16_t*)(ws + W_PLE), 256);
            EpiBf16 E{(bf16_t*)(ws + M_PP), 2048, 256}; for (int rep = 0; rep < NREP(10); ++rep) gemm_phase(F.ldsl, 256, 256, 256, S, E); SEAM(pb + 9); }
        if (IN(pb + 10) && PEN(10)) { unsigned char* ws = ws0; asm volatile("" : "+s"(ws));
            SchedM S; S.init((const unsigned*)(ws + WS_CTL) + CW_META + l * 512, F.G, F.bid, (const bf16_t*)(ws + M_XS), DM / 2, (const bf16_t*)(ws + W_GU), DM / 2);
            EpiGateUpI8 E{F.in(16) + (size_t)l * NEXP * DEXP, F.in(18) + (size_t)l * NEXP * DEXP, (bf16_t*)(ws + M_HID), (const float*)(ws + M_ROWSX), (const unsigned*)(ws + WS_CTL) + CW_WMAX + l};
            for (int rep = 0; rep < NREP(6); ++rep) gemm_phase(F.ldsl, DM / 2, DM / 2, DM / 2, S, E); SEAM(pb + 10); }
        if (IN(pb + 11) && PEN(11)) { unsigned char* ws = ws0; asm volatile("" : "+s"(ws));
            SchedM S; S.init((const unsigned*)(ws + WS_CTL) + CW_META + l * 512, F.G, F.bid, (const bf16_t*)(ws + M_HID), DEXP, (const bf16_t*)(ws + W_DN), DEXP);
            EpiDown E{F.in(20) + (size_t)l * NEXP * DM, (const float*)(ws + M_ROWW), (bf16_t*)(ws + M_XS)}; for (int rep = 0; rep < NREP(7); ++rep) gemm_phase(F.ldsl, DEXP, DEXP, DEXP, S, E); SEAM(pb + 11); }
        if (IN(pb + 12) && PEN(12)) { unsigned char* ws = ws0; asm volatile("" : "+s"(ws)); for (int rep = 0; rep < NREP(9); ++rep) phase_combine(F); SEAM(pb + 12); }
        if (IN(pb + 13) && PEN(13)) { unsigned char* ws = ws0; asm volatile("" : "+s"(ws));
            SchedS S; S.init(NTOK, 2048, F.G, F.bid, (const bf16_t*)(ws + M_HB), DM, (const bf16_t*)(ws + W_PG), DM);
            EpiPleGate E{(const bf16_t*)(ws + M_HB), (const bf16_t*)(ws + M_PP), (bf16_t*)(ws + M_X1F)}; for (int rep = 0; rep < NREP(8); ++rep) gemm_phase(F.ldsl, DM, DM, DM, S, E); SEAM(pb + 13); }
        if (IN(pb + 14) && PEN(14)) { unsigned char* ws = ws0; asm volatile("" : "+s"(ws)); for (int rep = 0; rep < NREP(13); ++rep) phase_ln2(F, P, l); if (l + 1 < NLAYER) for (int rep = 0; rep < NREP(0); ++rep) convert_layer_weights(F, P, l + 1); SEAM(pb + 14); }
}
__global__ void __launch_bounds__(512, 2) fwd(Params P) {
    extern __shared__ __attribute__((aligned(16))) unsigned char lds[];
    Frame F; F.lds = lds; F.ldsl = (LAS unsigned char*)lds; F.ws = P.ws; F.tid = threadIdx.x; F.lane = F.tid & 63; F.wid = __builtin_amdgcn_readfirstlane(F.tid >> 6); F.G = gridDim.x; F.bid = blockIdx.x;
    unsigned char* ws0 = P.ws; unsigned char* ws = ws0;
    const bool fused = (P.ph_hi - P.ph_lo) > 1;
    if (F.tid < 4) ((LAS unsigned*)(F.ldsl + LDS_MISC))[F.tid] = 0u;
    if (F.tid == 0) { LAS unsigned long long* t = (LAS unsigned long long*)(F.ldsl + LDS_PTRS);
#pragma unroll
        for (int k = 0; k < 25; ++k) t[k] = (unsigned long long)P.in[k];
        t[25] = (unsigned long long)P.out; }
    __syncthreads();
    XcdBarrier bar; bar.bar = (unsigned*)(ws + WS_CTL) + CW_BAR; bar.x = 0; bar.st = (volatile LAS unsigned*)(F.ldsl + LDS_MISC);
    if (fused) bar = xcd_barrier_post((unsigned*)(ws + WS_CTL) + CW_BAR, (volatile LAS unsigned*)(F.ldsl + LDS_MISC));
    const int lo = P.ph_lo, hi = P.ph_hi;
    using namespace pg8;
    if (IN(0) && PEN(15)) { unsigned char* ws = ws0; asm volatile("" : "+s"(ws));
        quant_rows(F, F.in(0), (bf16_t*)(ws + WS_XB), (unsigned char*)(ws + WS_XQ), (float*)(ws + WS_XSC));
        conv_rows(F, F.in(1), (bf16_t*)(ws + WS_PB), (size_t)2 * NTOK * 256 / 8);
        sample_wmax(F);
        SEAM(0);
    }
    if (IN(1) && PEN(15)) { for (int rep = 0; rep < NREP(0); ++rep) convert_layer_weights(F, P, 0); SEAM(1); }
    layer_phases<0>(F, P, bar, lo, hi, ws0);
    layer_phases<1>(F, P, bar, lo, hi, ws0);
}

#ifdef DEBUG_NAN
constexpr int CW_FLAGS = 12288;
__global__ void dbg_scan_bf16(const unsigned short* p, size_t n, unsigned* flag) { unsigned c = 0; for (size_t i = (size_t)blockIdx.x * blockDim.x + threadIdx.x; i < n; i += (size_t)gridDim.x * blockDim.x) if ((p[i] & 0x7F80u) == 0x7F80u) ++c; if (c) atomicAdd(flag, c); }
__global__ void dbg_scan_f32(const unsigned* p, size_t n, unsigned* flag) { unsigned c = 0; for (size_t i = (size_t)blockIdx.x * blockDim.x + threadIdx.x; i < n; i += (size_t)gridDim.x * blockDim.x) if ((p[i] & 0x7F800000u) == 0x7F800000u) ++c; if (c) atomicAdd(flag, c); }
__global__ void dbg_scan_sel(const int* sel, const int* nsel, unsigned* flag) { unsigned c = 0; for (size_t i = (size_t)blockIdx.x * blockDim.x + threadIdx.x; i < (size_t)NTOK * 256; i += (size_t)gridDim.x * blockDim.x) { const int tok = (int)(i >> 8), j = (int)(i & 255), t = tok & (SEQ - 1); const int ns = nsel[tok]; if (j == 0 && ns != (t + 1 < 256 ? t + 1 : 256)) ++c; if (j < ns && (sel[i] < 0 || sel[i] > t)) ++c; } if (c) atomicAdd(flag, c); }
__global__ void dbg_scan_scores(const unsigned* p, unsigned* flag) { unsigned c = 0; for (size_t i = (size_t)blockIdx.x * blockDim.x + threadIdx.x; i < 2ull * SEQ * SEQ; i += (size_t)gridDim.x * blockDim.x) { const int s = (int)(i & (SEQ - 1)), t = (int)((i >> 13) & (SEQ - 1)); if (s <= t && (p[i] & 0x7F800000u) == 0x7F800000u) ++c; } if (c) atomicAdd(flag, c); }
__global__ void dbg_probe_bf16(const unsigned short* p, size_t n, unsigned* cnt, unsigned* minidx) { unsigned c = 0; unsigned mi = 0xFFFFFFFFu; for (size_t i = (size_t)blockIdx.x * blockDim.x + threadIdx.x; i < n; i += (size_t)gridDim.x * blockDim.x) if ((p[i] & 0x7F80u) == 0x7F80u) { ++c; if ((unsigned)i < mi) mi = (unsigned)i; } if (c) { atomicAdd(cnt, c); atomicMax(minidx, ~mi); } }
__global__ void dbg_final(float* out, size_t n, const unsigned* flags) { int code = 0; for (int k = 0; k < 32; ++k) if (flags[k] && !code) code = k + 1; const int mask = (flags[32] ? 1 : 0) | (flags[33] ? 2 : 0) | (flags[34] ? 4 : 0); if (mask) code = 20 + 5 * mask; if (!code) return; for (size_t i = (size_t)blockIdx.x * blockDim.x + threadIdx.x; i < n; i += (size_t)gridDim.x * blockDim.x) out[i] = (float)code; }
#endif
extern "C" void kernel_launch(void* const* d_in, const int* in_sizes, int n_in, void* d_out, int out_size, void* d_ws, size_t ws_size, hipStream_t stream) {
    static int grid = 0;
    if (grid == 0) {
        if (n_in != 25 || out_size != NTOK * DM || ws_size < WS_NEED) { fprintf(stderr, "kernel_launch: unexpected shapes (n_in %d out %d ws %zu need %zu)\n", n_in, out_size, ws_size, (size_t)WS_NEED); grid = -1; return; }
        int dev = 0, cus = 0, per_cu = 0;
        if (hipGetDevice(&dev) != hipSuccess || hipDeviceGetAttribute(&cus, hipDeviceAttributeMultiprocessorCount, dev) != hipSuccess) { grid = -1; return; }
        if (hipFuncSetAttribute((const void*)fwd, hipFuncAttributeMaxDynamicSharedMemorySize, LDS_BYTES) != hipSuccess) { fprintf(stderr, "kernel_launch: hipFuncSetAttribute failed\n"); grid = -1; return; }
        if (hipOccupancyMaxActiveBlocksPerMultiprocessor(&per_cu, (const void*)fwd, 512, LDS_BYTES) != hipSuccess || per_cu < 1) fprintf(stderr, "kernel_launch: occupancy query says %d\n", per_cu);
        (void)hipGetLastError();
        grid = cus;
    }
    if (grid < 0) return;
    unsigned char* ws = (unsigned char*)d_ws;
    hipMemsetAsync(ws + WS_CTL, 0, CTL_BYTES, stream);
    hipMemsetAsync(ws + W_UK2, 0, 8ull * 256 * 256 * 2 + 4ull * 256 * 512 * 2, stream);
    hipMemsetAsync(ws + W_IN + (size_t)INW * 2048 * 2, 0, (size_t)(INWP - INW) * 2048 * 2, stream);
    Params p{};
    for (int i = 0; i < 25; ++i) p.in[i] = (const float*)d_in[i];
    p.out = (float*)d_out; p.ws = ws;
#if PHASES_PER_LAUNCH == 0
    p.ph_lo = 0; p.ph_hi = NPHASE;
    hipLaunchKernelGGL(fwd, dim3(grid), dim3(512), LDS_BYTES, stream, p);
#else
    for (int k = 0; k < NPHASE; ++k) { p.ph_lo = k; p.ph_hi = k + 1; hipLaunchKernelGGL(fwd, dim3(grid), dim3(512), LDS_BYTES, stream, p);
#ifdef DEBUG_NAN
        unsigned* fl = (unsigned*)(ws + WS_CTL) + CW_FLAGS + k;
#define SB16(off, n) hipLaunchKernelGGL(dbg_scan_bf16, dim3(1024), dim3(256), 0, stream, (const unsigned short*)(ws + (off)), (size_t)(n), fl)
#define SF32(off, n) hipLaunchKernelGGL(dbg_scan_f32, dim3(1024), dim3(256), 0, stream, (const unsigned*)(ws + (off)), (size_t)(n), fl)
        if (k == 0) { SB16(WS_XB, (size_t)NTOK * DM); SB16(WS_PB, 2ull * NTOK * 256); SB16(WS_W, (W_END - WS_W) / 2); }
        else { const int kind = (k - 1) % 15;
            if (kind == 0) { SB16(R_QA, (size_t)NTOK * 1024); SB16(R_QIDX, (size_t)NTOK * 1024); SB16(R_QKV, 6ull * NTOK * 1024); SB16(R_GATES, (size_t)NTOK * 6144); SF32(R_SMALL, (size_t)NTOK * 512); }
            if (kind == 1) { SB16(R_QCAT, (size_t)NTOK * 2304); SB16(R_KCAT, (size_t)NTOK * 288); SB16(R_KI, (size_t)NTOK * 64); SB16(R_QIDX, (size_t)NTOK * 1024); SF32(R_WI, (size_t)NTOK * 16); SF32(WS_LF, 16ull * 8192); }
            if (kind == 2) { SF32(WS_CUM, 16ull * 8192); hipLaunchKernelGGL(dbg_scan_scores, dim3(1024), dim3(256), 0, stream, (const unsigned*)(ws + R_SCORES), fl); }
            if (kind == 3) { hipLaunchKernelGGL(dbg_scan_sel, dim3(1024), dim3(256), 0, stream, (const int*)(ws + R_SEL), (const int*)(ws + R_NSEL), fl); }
            if (k == 5) { unsigned* fl0 = fl; fl = (unsigned*)(ws + WS_CTL) + CW_FLAGS + 32; SB16(R_OLAT, (size_t)NTOK * 2048); fl += 1; SB16(R_OA, (size_t)NTOK * 3072); fl += 1; fl = fl0; hipLaunchKernelGGL(dbg_probe_bf16, dim3(1024), dim3(256), 0, stream, (const unsigned short*)(ws + R_OC), (size_t)NTOK * 1024, (unsigned*)(ws + WS_CTL) + CW_FLAGS + 40, (unsigned*)(ws + WS_CTL) + CW_FLAGS + 41); }
            if (kind == 5) { SB16(R_OA, (size_t)NTOK * 3072); }
            if (kind == 6) { SB16(R_MERGED, (size_t)NTOK * 2048); }
            if (kind == 7) { SF32(R_PRE1, (size_t)NTOK * 2048); }
            if (kind == 8) { SF32(M_X1F, (size_t)NTOK * 2048); SF32(M_TOKW, (size_t)NTOK * 4); }
            if (kind == 9) { SB16(M_PP, (size_t)NTOK * 2048); }
            if (kind == 12) { SF32(M_HF, (size_t)NTOK * 2048); }
            if (kind == 13) { SF32(M_X1F, (size_t)NTOK * 2048); }
            if (kind == 14) { hipLaunchKernelGGL(dbg_scan_f32, dim3(1024), dim3(256), 0, stream, (const unsigned*)d_out, (size_t)NTOK * DM, fl); if (k + 1 < NPHASE) SB16(WS_W, (W_END - WS_W) / 2); } }
#endif
    }
#ifdef DEBUG_NAN
    hipLaunchKernelGGL(dbg_final, dim3(1024), dim3(256), 0, stream, (float*)d_out, (size_t)NTOK * DM, (const unsigned*)(ws + WS_CTL) + CW_FLAGS);
#endif
#endif
}
```

```cpp
#include <hip/hip_runtime.h>
#include <stdint.h>
#include <stdio.h>
#include <math.h>

#ifndef PHASES_PER_LAUNCH
#define PHASES_PER_LAUNCH 0
#endif

#define LAS __attribute__((address_space(3)))
#define GAS __attribute__((address_space(1)))
#ifndef REP_MASK
#define REP_MASK 0
#endif
#define NREP(bit) (((REP_MASK) >> (bit)) & 1 ? 2 : 1)
typedef unsigned short bf16_t;
typedef short bf16x8 __attribute__((ext_vector_type(8)));
typedef short s16x4 __attribute__((ext_vector_type(4)));
typedef float f32x4 __attribute__((ext_vector_type(4)));
typedef float f32x16 __attribute__((ext_vector_type(16)));
typedef unsigned u32x4 __attribute__((ext_vector_type(4)));
typedef unsigned u32x2 __attribute__((ext_vector_type(2)));
typedef int i32x4 __attribute__((ext_vector_type(4)));

constexpr int NTOK = 16384, DM = 2048, SEQ = 8192, NB = 2, NLAYER = 2;
constexpr int INW = 14712, INWP = 14848;
constexpr int NEXP = 32, DEXP = 1024;
constexpr int PMAX = 65536 + 8192;
constexpr float ALPHA = 1.41421356237309515f;
constexpr float LOG2E = 1.4426950408889634f;
constexpr float SCALE = 0.08838834764831845f;
constexpr float C2 = LOG2E * SCALE;

constexpr size_t MiB = 1ull << 20;
constexpr size_t WS_CTL   = 0;
constexpr size_t WS_W     = 1 * MiB;
constexpr size_t W_IN     = WS_W;
constexpr size_t W_IN8    = W_IN   + 2048ull * 2048 * 2;
constexpr size_t W_UK2    = W_IN   + (size_t)INWP * 2048 * 2;
constexpr size_t W_UV2    = W_UK2  + 8ull * 256 * 256 * 2;
constexpr size_t W_BRA    = W_UV2  + 4ull * 256 * 512 * 2;
constexpr size_t W_BRB    = W_BRA  + 2048ull * 1024 * 2;
constexpr size_t W_BRC    = W_BRB  + 2048ull * 1024 * 2;
constexpr size_t W_OUT    = W_BRC  + 2048ull * 1024 * 2;
constexpr size_t W_PG     = W_OUT  + 2048ull * 2048 * 2;
constexpr size_t W_PLE    = W_PG   + 2048ull * 2048 * 2;
constexpr size_t W_GU     = W_PLE  + 2048ull * 256 * 2;
constexpr size_t W_DN     = W_GU   + 32ull * 2048 * 2048 * 2;
constexpr size_t W_END    = W_DN   + 32ull * 2048 * 1024 * 2;
constexpr size_t WS_XB    = (W_END + MiB - 1) / MiB * MiB;
constexpr size_t WS_PB    = WS_XB  + (size_t)NTOK * DM * 2;
constexpr size_t WS_CUM   = WS_PB  + 2ull * NTOK * 256 * 2;
constexpr size_t WS_LF    = WS_CUM + 16ull * 8192 * 4;
constexpr size_t WS_XQ    = WS_LF  + 16ull * 8192 * 4;
constexpr size_t WS_XSC   = WS_XQ  + (size_t)NTOK * DM;
constexpr size_t WS_R     = (WS_XSC + (size_t)NTOK * 4 + MiB - 1) / MiB * MiB;
constexpr size_t R_SCORES = WS_R;
constexpr size_t R_OLAT   = WS_R;
constexpr size_t R_OA     = WS_R + 64 * MiB;
constexpr size_t R_OB     = WS_R + 96 * MiB;
constexpr size_t R_OC     = WS_R + 128 * MiB;
constexpr size_t R_TMP    = WS_R + 160 * MiB;
constexpr size_t R_MERGED = WS_R + 288 * MiB;
constexpr size_t R_PRE1   = WS_R + 384 * MiB;
constexpr size_t R_QA     = WS_R + 512 * MiB;
constexpr size_t R_QIDX   = WS_R + 544 * MiB;
constexpr size_t R_QKV    = WS_R + 576 * MiB;
constexpr size_t R_GATES  = WS_R + 768 * MiB;
constexpr size_t R_SMALL  = WS_R + 960 * MiB;
constexpr size_t R_QCAT   = WS_R + 992 * MiB;
constexpr size_t R_KCAT   = WS_R + 1064 * MiB;
constexpr size_t R_KI     = WS_R + 1073 * MiB;
constexpr size_t R_WI     = WS_R + 1075 * MiB;
constexpr size_t R_SEL    = WS_R + 1076 * MiB;
constexpr size_t R_NSEL   = WS_R + 1092 * MiB;
constexpr size_t R_END    = WS_R + 1093 * MiB;
constexpr size_t M_XS     = WS_R;
constexpr size_t M_HID    = WS_R + 288 * MiB;
constexpr size_t M_PP     = WS_R + 432 * MiB;
constexpr size_t M_X1F    = WS_R + 512 * MiB;
constexpr size_t M_X1B    = WS_R + 640 * MiB;
constexpr size_t M_HF     = WS_R + 704 * MiB;
constexpr size_t M_HQ     = WS_R + 704 * MiB;
constexpr size_t M_HSC    = WS_R + 736 * MiB;
constexpr size_t M_HB     = WS_R + 832 * MiB;
constexpr size_t M_TOKE   = WS_R + 896 * MiB;
constexpr size_t M_TOKPOS = M_TOKE + (size_t)NTOK * 16;
constexpr size_t M_TOKW   = M_TOKPOS + (size_t)NTOK * 16;
constexpr size_t M_TOKDST = M_TOKW + (size_t)NTOK * 16;
constexpr size_t M_ROWW   = M_TOKDST + (size_t)NTOK * 16;
constexpr size_t M_ROWSX  = M_ROWW + (size_t)PMAX * 4;
constexpr size_t M_X1S    = M_ROWSX + (size_t)PMAX * 4;
constexpr size_t M_X1Q    = WS_R + 900 * MiB;
constexpr size_t WS_NEED  = R_END;
constexpr int CW_BAR = 0;
constexpr int CW_CNT = 8192;
constexpr int CW_META = 4096 + 64;
constexpr int CW_QCTR = 6144;
constexpr int CW_WMAX = 6272;
constexpr int CW_WMAXG = 6336;
constexpr int CW_WMAXP = 6368;
constexpr int CW_KMAX = 6400;
constexpr size_t CTL_BYTES = 65536;

constexpr int LDS_BYTES = 152576;
constexpr int LDS_MISC = 151552;

typedef float f32x2 __attribute__((ext_vector_type(2)));
typedef __bf16 bf16n2 __attribute__((ext_vector_type(2)));
__device__ __forceinline__ unsigned cvtpk(float lo, float hi) { f32x2 v = {lo, hi}; bf16n2 b = __builtin_convertvector(v, bf16n2); return __builtin_bit_cast(unsigned, b); }
__device__ __forceinline__ bf16_t f2bf(float x) { return (bf16_t)(cvtpk(x, 0.f) & 0xffffu); }
__device__ __forceinline__ float bf2f(bf16_t b) { return __uint_as_float(((unsigned)b) << 16); }
__device__ __forceinline__ float bflo(unsigned w) { return __uint_as_float(w << 16); }
__device__ __forceinline__ float bfhi(unsigned w) { return __uint_as_float(w & 0xffff0000u); }
__device__ __forceinline__ bf16x8 pack8(f32x4 a, f32x4 b) { u32x4 w = {cvtpk(a[0], a[1]), cvtpk(a[2], a[3]), cvtpk(b[0], b[1]), cvtpk(b[2], b[3])}; return *reinterpret_cast<bf16x8*>(&w); }
__device__ __forceinline__ float sigmoidf_(float x) { return 1.0f / (1.0f + __expf(-x)); }
__device__ __forceinline__ float wave_sum(float v) { for (int o = 32; o > 0; o >>= 1) v += __shfl_xor(v, o); return v; }
__device__ __forceinline__ int crow(int r, int hi) { return (r & 3) + 8 * (r >> 2) + 4 * hi; }
#define SBAR() __builtin_amdgcn_sched_barrier(0)

#define XB_TMO      128
#define XB_XCNT(j)  (256  + 64 * (j))
#define XB_XSUB(j)  (1280 + 64 * (j))
#define XB_XGEN(j)  (2304 + 64 * (j))
#define XB_TOP      3328
#define XB_TOPGEN   3392
#define XCD_BAR_WORDS 3456
#define XB_SPIN_CAP (1u << 22)
__device__ __forceinline__ unsigned xb_ld(unsigned* p)              { return __hip_atomic_load(p, __ATOMIC_RELAXED, __HIP_MEMORY_SCOPE_AGENT); }
__device__ __forceinline__ unsigned xb_add(unsigned* p, unsigned v) { return __hip_atomic_fetch_add(p, v, __ATOMIC_RELAXED, __HIP_MEMORY_SCOPE_AGENT); }
__device__ __forceinline__ unsigned xb_xcc_id() { return (unsigned)__builtin_amdgcn_s_getreg((3 << 11) | 20) & 0xFu; }
#define XB_SPIN(cond, bar) do { unsigned _sp = 0; while (cond) { __builtin_amdgcn_s_sleep(1); \
    if ((++_sp & 255u) == 0u) { if (xb_ld(&(bar)[XB_TMO])) break; if (_sp > XB_SPIN_CAP) { atomicAdd(&(bar)[XB_TMO], 1u); break; } } } } while (0)
struct XcdBarrier { unsigned* bar; unsigned x; volatile LAS unsigned* st; };
__device__ __forceinline__ XcdBarrier xcd_barrier_post(unsigned* bar, volatile LAS unsigned* st) {
    XcdBarrier b; b.bar = bar; b.x = xb_xcc_id(); b.st = st;
    if (threadIdx.x == 0) (void)xb_add(&bar[XB_XCNT(b.x)], 1u);
    return b;
}
__device__ __forceinline__ void xcd_barrier_complete(unsigned* bar, unsigned x, unsigned& nloc, unsigned& nx) {
    const unsigned G = gridDim.x * gridDim.y * gridDim.z;
    unsigned sum, cnt, mine, sp = 0u;
    for (;;) {
        sum = 0u; cnt = 0u; mine = 0u;
#pragma unroll
        for (unsigned j = 0; j < 16; ++j) { const unsigned c = xb_ld(&bar[XB_XCNT(j)]); sum += c; cnt += (c > 0u) ? 1u : 0u; mine = (j == x) ? c : mine; }
        if (sum == G) break;
        __builtin_amdgcn_s_sleep(1);
        if ((++sp & 255u) == 0u) { if (xb_ld(&bar[XB_TMO])) break; if (sp > XB_SPIN_CAP) { atomicAdd(&bar[XB_TMO], 1u); break; } }
    }
    nloc = mine > 0u ? mine : 1u; nx = cnt > 0u ? cnt : 1u;
}
__device__ __forceinline__ void xcd_barrier(const XcdBarrier& b) {
    asm volatile("s_waitcnt vmcnt(0)" ::: "memory");
    __syncthreads();
    if (threadIdx.x == 0) {
        unsigned* bar = b.bar;
        __builtin_amdgcn_s_waitcnt(0);
        unsigned nloc = b.st[0], nx = b.st[1];
        if (nloc == 0u) { xcd_barrier_complete(bar, b.x, nloc, nx); b.st[0] = nloc; b.st[1] = nx; }
        const unsigned old = xb_add(&bar[XB_XSUB(b.x)], 1u);
        const unsigned gen = old / nloc;
        if (old + 1u == (gen + 1u) * nloc) {
            __builtin_amdgcn_fence(__ATOMIC_RELEASE, "agent");
            asm volatile("s_waitcnt vmcnt(0)" ::: "memory");
            const unsigned og = xb_add(&bar[XB_TOP], 1u);
            const unsigned tg = og / nx;
            if (og + 1u == (tg + 1u) * nx) xb_add(&bar[XB_TOPGEN], 1u);
            else XB_SPIN(xb_ld(&bar[XB_TOPGEN]) == tg, bar);
            __builtin_amdgcn_fence(__ATOMIC_ACQUIRE, "agent");
            xb_add(&bar[XB_XGEN(b.x)], 1u);
            asm volatile("s_waitcnt vmcnt(0)" ::: "memory");
        } else {
            XB_SPIN(xb_ld(&bar[XB_XGEN(b.x)]) == gen, bar);
            __builtin_amdgcn_fence(__ATOMIC_ACQUIRE, "agent");
            asm volatile("s_waitcnt vmcnt(0)" ::: "memory");
        }
    }
    __syncthreads();
}

namespace pg8 {
constexpr int BM = 256, BK = 64, HALF = 128, HTB = HALF * BK * 2, STAGE_BYTES = 8 * HTB, NXCD = 8, WGM = 8;
__device__ __forceinline__ int lds_byte(int r, int c) { const int st = (r >> 4) * 2 + (c >> 5), rr = r & 15, cc = c & 31, ob = rr * 64 + cc * 2; return st * 1024 + (ob ^ (((ob >> 9) & 1) << 5)); }
__device__ __forceinline__ void stage_rc(int b, int& R, int& C) { const int st = b / 1024, sb = b % 1024, swz = sb ^ (((sb >> 9) & 1) << 5); R = (st >> 1) * 16 + swz / 64; C = (st & 1) * 32 + (swz % 64) / 2; }
__device__ __forceinline__ int perm32(int rho) { const int n = rho >> 4, i = rho & 15; return 8 * (i >> 2) + 4 * n + (i & 3); }
struct Unit { int pm, pn, e; };
struct SchedS {
    int nM, nN, nwg, G, c; const bf16_t* A; const bf16_t* B; int lda, ldb, a_sh, a_mul, skip_from = 1 << 30, skip_by = 0, skip_from2 = 1 << 30, skip_by2 = 0, b_compact = 0;
    __device__ void init(int M, int N, int G_, int c_, const bf16_t* A_, int lda_, const bf16_t* B_, int ldb_, int a_sh_ = 0, int a_mul_ = 0) {
        nM = M / BM; nN = N / BM; nwg = nM * nN; G = G_; c = c_; A = A_; B = B_; lda = lda_; ldb = ldb_; a_sh = a_sh_; a_mul = a_mul_; }
    __device__ __forceinline__ bool next(int i, Unit& u) const {
        const long L = (long)i * G + c; if (L >= nwg) return false;
        int wgid = (int)L; { const int q = nwg / NXCD, r = nwg % NXCD, xcd = wgid % NXCD, off = wgid / NXCD; wgid = (xcd < r ? xcd * (q + 1) : r * (q + 1) + (xcd - r) * q) + off; }
        const int nig = WGM * nN, gid = wgid / nig, fm = gid * WGM, gsz = (nM - fm) < WGM ? (nM - fm) : WGM;
        u.pm = fm + ((wgid % nig) % gsz); u.pn = (wgid % nig) / gsz; u.e = 0;
        u.e = u.pn;
        { const int ci = u.pn; if (ci >= skip_from) u.pn += skip_by; if (ci >= skip_from2) u.pn += skip_by2; }
        return true;
    }
    __device__ __forceinline__ const char* pa(const Unit& u) const { return (const char*)(A + (size_t)u.pm * BM * lda + (size_t)((u.pn >> a_sh) * a_mul)); }
    __device__ __forceinline__ const char* pb(const Unit& u) const { return (const char*)(B + (size_t)(b_compact ? u.e : u.pn) * BM * ldb); }
};
struct SchedM {
    int ntiles, G, c; const bf16_t* A; const bf16_t* W; int lda, ldb; const unsigned* tile_e;
    __device__ void init(const unsigned* meta, int G_, int c_, const bf16_t* A_, int lda_, const bf16_t* W_, int ldb_) {
        ntiles = (int)meta[0]; tile_e = meta + 1; G = G_; c = c_; A = A_; W = W_; lda = lda_; ldb = ldb_; }
    __device__ __forceinline__ bool next(int i, Unit& u) const {
        const long L = (long)i * G + c; if (L >= (long)ntiles * 8) return false;
        u.pm = (int)(L >> 3); u.pn = (int)(L & 7); u.e = (int)tile_e[u.pm];
        return true;
    }
    __device__ __forceinline__ const char* pa(const Unit& u) const { return (const char*)(A + (size_t)u.pm * BM * lda); }
    __device__ __forceinline__ const char* pb(const Unit& u) const { return (const char*)(W + ((size_t)u.e * 2048 + (size_t)u.pn * BM) * ldb); }
};

template <class Epi, class Sched>
__device__ __forceinline__ void gemm_phase(LAS unsigned char* lds, const int K, const int lda, const int ldb, const Sched& S, const Epi& E) {
    int tid = threadIdx.x; asm volatile("" : "+v"(tid));
    const int wid = __builtin_amdgcn_readfirstlane(tid >> 6), lane = tid & 63, wr = wid >> 2, wc = wid & 3, fr = lane & 15, fq = lane >> 4;
    const int nt = K / BK;
    unsigned voffA[2], voffB[2];
#pragma unroll
    for (int i = 0; i < 2; ++i) { int R, C; stage_rc(tid * 16 + i * 8192, R, C); const int Rb = (R & ~31) + perm32(R & 31);
        voffA[i] = (unsigned)(R * lda + C) * 2u; voffB[i] = (unsigned)(Rb * ldb + C) * 2u; }
    const size_t kstep = (size_t)(BK * 2);
    const size_t hstepA = (size_t)HALF * lda * 2, hstepB = (size_t)HALF * ldb * 2;
    const unsigned ldsw = (unsigned)wid * 1024u;
    const int aoff = lds_byte(wr * 64 + fr, fq * 8), boff = lds_byte(wc * 32 + fr, fq * 8);
#define PG8_SA(b, h) (((b) * 2 + (h)) * HTB)
#define PG8_SB(b, h) ((4 + (b) * 2 + (h)) * HTB)
#define PG8_STAGE(bufoff, gbase, voff) do { _Pragma("unroll") for (int _i = 0; _i < 2; ++_i) \
        __builtin_amdgcn_global_load_lds((const unsigned*)((const char*)(gbase) + (voff)[_i]), (LAS unsigned*)(lds + (bufoff) + ldsw + _i * 8192), 16, 0, 0); } while (0)
#define PG8_LDA(dst, b, h) do { _Pragma("unroll") for (int m = 0; m < 4; ++m) _Pragma("unroll") for (int k = 0; k < 2; ++k) dst[m][k] = *(const LAS bf16x8*)(lds + PG8_SA(b, h) + aoff + m * 2048 + k * 1024); } while (0)
#define PG8_LDB(dst, b, h) do { _Pragma("unroll") for (int n = 0; n < 2; ++n) _Pragma("unroll") for (int k = 0; k < 2; ++k) dst[n][k] = *(const LAS bf16x8*)(lds + PG8_SB(b, h) + boff + n * 2048 + k * 1024); } while (0)
#define PG8_MMA(ai, bj, At, Bt) do { __builtin_amdgcn_s_setprio(1); _Pragma("unroll") for (int m = 0; m < 4; ++m) _Pragma("unroll") for (int n = 0; n < 2; ++n) _Pragma("unroll") for (int k = 0; k < 2; ++k) \
        { if constexpr (Epi::I8) acc[ai][bj][m][n] = __builtin_bit_cast(f32x4, __builtin_amdgcn_mfma_i32_16x16x64_i8(__builtin_bit_cast(i32x4, Bt[n][k]), __builtin_bit_cast(i32x4, At[m][k]), __builtin_bit_cast(i32x4, acc[ai][bj][m][n]), 0, 0, 0)); \
          else acc[ai][bj][m][n] = __builtin_amdgcn_mfma_f32_16x16x32_bf16(Bt[n][k], At[m][k], acc[ai][bj][m][n], 0, 0, 0); } __builtin_amdgcn_s_setprio(0); } while (0)
#define PG8_WAIT_V(n) asm volatile("s_waitcnt vmcnt(" #n ")" ::: "memory")
#define PG8_WAIT_L(n) asm volatile("s_waitcnt lgkmcnt(" #n ")" ::: "memory")
#define PG8_BAR __builtin_amdgcn_s_barrier()
#define PG8_SCHED __builtin_amdgcn_sched_barrier(0)
    Unit cur, nxt; int ui = 0;
    if (!S.next(0, cur)) return;
    f32x4 acc[2][2][4][2];
#pragma unroll
    for (int a = 0; a < 2; ++a)
#pragma unroll
        for (int b = 0; b < 2; ++b)
#pragma unroll
            for (int m = 0; m < 4; ++m)
#pragma unroll
                for (int n = 0; n < 2; ++n) acc[a][b][m][n] = (f32x4){0.f, 0.f, 0.f, 0.f};
    bf16x8 At[4][2], B0[2][2], B1[2][2];
    const char* cA = S.pa(cur); const char* cB = S.pb(cur);
    PG8_STAGE(PG8_SB(0, 0), cB, voffB); PG8_STAGE(PG8_SA(0, 0), cA, voffA); PG8_STAGE(PG8_SB(0, 1), cB + hstepB, voffB); PG8_STAGE(PG8_SA(0, 1), cA + hstepA, voffA);
    if (wr == 1) PG8_BAR;
    PG8_WAIT_V(4); PG8_BAR;
    PG8_STAGE(PG8_SB(1, 0), cB + kstep, voffB); PG8_STAGE(PG8_SA(1, 0), cA + kstep, voffA); PG8_STAGE(PG8_SB(1, 1), cB + hstepB + kstep, voffB);
    PG8_WAIT_V(6); PG8_BAR;
    for (;;) {
        const bool has_next = S.next(ui + 1, nxt);
        const char* nA = has_next ? S.pa(nxt) : cA; const char* nB = has_next ? S.pb(nxt) : cB;
        for (int t = 0; t < nt; t += 2) {
            const bool last = (t == nt - 2);
            if constexpr (Epi::HAS_MID) { if (t == Epi::MID1 || t == Epi::MID2) { int frM = fr, fqM = fq; asm volatile("" : "+v"(frM), "+v"(fqM)); E.mid(acc, cur, t, wr, wc, frM, fqM); } }
            const char* a1 = cA + (size_t)(t + 1) * kstep;
            const char* a2 = last ? nA : cA + (size_t)(t + 2) * kstep; const char* b2 = last ? nB : cB + (size_t)(t + 2) * kstep;
            const char* a3 = a2 + kstep; const char* b3 = b2 + kstep;
            PG8_LDB(B0, 0, 0); PG8_SCHED; PG8_LDA(At, 0, 0); PG8_STAGE(PG8_SA(1, 1), a1 + hstepA, voffA);
            PG8_WAIT_L(8); PG8_BAR; PG8_WAIT_L(0); PG8_MMA(0, 0, At, B0); PG8_BAR; PG8_SCHED;
            PG8_LDB(B1, 0, 1); PG8_STAGE(PG8_SB(0, 0), b2, voffB);
            PG8_BAR; PG8_WAIT_L(0); PG8_MMA(0, 1, At, B1); PG8_BAR;
            PG8_LDA(At, 0, 1); PG8_STAGE(PG8_SA(0, 0), a2, voffA);
            PG8_BAR; PG8_WAIT_L(0); PG8_MMA(1, 0, At, B0); PG8_BAR; PG8_SCHED;
            PG8_STAGE(PG8_SB(0, 1), b2 + hstepB, voffB);
            PG8_WAIT_V(6); PG8_BAR; PG8_MMA(1, 1, At, B1); PG8_BAR;
            PG8_LDB(B0, 1, 0); PG8_SCHED; PG8_LDA(At, 1, 0); PG8_STAGE(PG8_SA(0, 1), a2 + hstepA, voffA);
            PG8_WAIT_L(8); PG8_BAR; PG8_WAIT_L(0); PG8_MMA(0, 0, At, B0); PG8_BAR; PG8_SCHED;
            PG8_LDB(B1, 1, 1); PG8_STAGE(PG8_SB(1, 0), b3, voffB);
            PG8_BAR; PG8_WAIT_L(0); PG8_MMA(0, 1, At, B1); PG8_BAR;
            PG8_LDA(At, 1, 1); PG8_STAGE(PG8_SA(1, 0), a3, voffA);
            PG8_BAR; PG8_WAIT_L(0); PG8_MMA(1, 0, At, B0); PG8_BAR; PG8_SCHED;
            PG8_STAGE(PG8_SB(1, 1), b3 + hstepB, voffB);
            PG8_WAIT_V(6); PG8_BAR; PG8_MMA(1, 1, At, B1); PG8_BAR;
        }
        { int frE = fr, fqE = fq; asm volatile("" : "+v"(frE), "+v"(fqE)); E(acc, cur, wr, wc, frE, fqE); }
        if (!has_next) break;
#pragma unroll
        for (int a = 0; a < 2; ++a)
#pragma unroll
            for (int b = 0; b < 2; ++b)
#pragma unroll
                for (int m = 0; m < 4; ++m)
#pragma unroll
                    for (int n = 0; n < 2; ++n) acc[a][b][m][n] = (f32x4){0.f, 0.f, 0.f, 0.f};
        cur = nxt; cA = nA; cB = nB; ++ui;
    }
    PG8_WAIT_V(0);
    if (wr == 0) PG8_BAR;
    PG8_BAR;
#undef PG8_SA
#undef PG8_SB
#undef PG8_STAGE
#undef PG8_LDA
#undef PG8_LDB
#undef PG8_MMA
#undef PG8_WAIT_V
#undef PG8_WAIT_L
#undef PG8_BAR
#undef PG8_SCHED
}

#define EPI_LOOP_ROWS _Pragma("unroll") for (int ai = 0; ai < 2; ++ai) _Pragma("unroll") for (int m = 0; m < 4; ++m)
__device__ __forceinline__ void st_bf16x8(bf16_t* p, f32x4 v0, f32x4 v1) { u32x4 w; w.x = cvtpk(v0[0], v0[1]); w.y = cvtpk(v0[2], v0[3]); w.z = cvtpk(v1[0], v1[1]); w.w = cvtpk(v1[2], v1[3]); *(u32x4*)p = w; }

template <bool I8_> struct EpiInProj {
    static constexpr bool HAS_MID = false; static constexpr bool I8 = I8_;
    bf16_t* qa; bf16_t* qidx; bf16_t* qkv; bf16_t* gates; float* small_; const float* xs; const unsigned* wmaxbits;
    __device__ __forceinline__ f32x4 val(const f32x4& a, float sc) const { if constexpr (I8_) { const i32x4 v = __builtin_bit_cast(i32x4, a); return (f32x4){(float)v[0], (float)v[1], (float)v[2], (float)v[3]} * sc; } else return a; }
    __device__ __forceinline__ void operator()(const f32x4 (&acc)[2][2][4][2], const Unit& u, int wr, int wc, int fr, int fq) const {
        const int pn = u.pn, row0 = u.pm * BM + wr * 64 + fr, lc0 = wc * 32 + fq * 8;
        float sw = 0.f; if constexpr (I8_) sw = __uint_as_float(*wmaxbits) * (1.3f / 127.0f);
        if (pn < 8) {
            bf16_t* base = (pn < 4 ? qa + pn * 256 : qidx + (pn - 4) * 256) + lc0;
            EPI_LOOP_ROWS { const int row = row0 + ai * HALF + m * 16; float sc = 0.f; if constexpr (I8_) sc = xs[row] * sw;
#pragma unroll
                for (int bj = 0; bj < 2; ++bj) st_bf16x8(base + (size_t)row * 1024 + bj * HALF, val(acc[ai][bj][m][0], sc), val(acc[ai][bj][m][1], sc)); }
        } else if (pn < 32) {
            const int id = (pn - 8) >> 2, hb = ((pn - 8) & 3) * 2, b = u.pm >> 5;
            bf16_t* base = qkv + (size_t)id * ((size_t)NTOK * 1024) + lc0;
            EPI_LOOP_ROWS { const int row = row0 + ai * HALF + m * 16, s = row & (SEQ - 1); float sc = 0.f; if constexpr (I8_) sc = xs[row] * sw;
#pragma unroll
                for (int bj = 0; bj < 2; ++bj) st_bf16x8(base + ((size_t)(b * 8 + hb + bj) * SEQ + s) * 128, val(acc[ai][bj][m][0], sc), val(acc[ai][bj][m][1], sc)); }
        } else if (pn < 56) {
            bf16_t* base = gates + (pn - 32) * 256 + lc0;
            EPI_LOOP_ROWS { const int row = row0 + ai * HALF + m * 16; float sc = 0.f; if constexpr (I8_) sc = xs[row] * sw;
#pragma unroll
                for (int bj = 0; bj < 2; ++bj) st_bf16x8(base + (size_t)row * 6144 + bj * HALF, val(acc[ai][bj][m][0], sc), val(acc[ai][bj][m][1], sc)); }
        } else {
            float* base = small_ + (pn - 56) * 256 + lc0;
            EPI_LOOP_ROWS { const int row = row0 + ai * HALF + m * 16; float sc = 0.f; if constexpr (I8_) sc = xs[row] * sw;
#pragma unroll
                for (int bj = 0; bj < 2; ++bj) { float* p = base + (size_t)row * 512 + bj * HALF; *(f32x4*)p = val(acc[ai][bj][m][0], sc); *(f32x4*)(p + 4) = val(acc[ai][bj][m][1], sc); } }
        }
    }
};
struct EpiGatesI8 {
    static constexpr bool HAS_MID = false; static constexpr bool I8 = true;
    bf16_t* gates; const float* xs; const unsigned* wmaxbits;
    __device__ __forceinline__ void operator()(const f32x4 (&acc)[2][2][4][2], const Unit& u, int wr, int wc, int fr, int fq) const {
        const int row0 = u.pm * BM + wr * 64 + fr; bf16_t* base = gates + u.pn * 256 + wc * 32 + fq * 8;
        const float sw = __uint_as_float(*wmaxbits) * (1.3f / 127.0f);
        EPI_LOOP_ROWS { const int row = row0 + ai * HALF + m * 16; const float sc = xs[row] * sw;
#pragma unroll
            for (int bj = 0; bj < 2; ++bj) { const i32x4 a0 = __builtin_bit_cast(i32x4, acc[ai][bj][m][0]), a1 = __builtin_bit_cast(i32x4, acc[ai][bj][m][1]);
                st_bf16x8(base + (size_t)row * 6144 + bj * HALF, (f32x4){(float)a0[0], (float)a0[1], (float)a0[2], (float)a0[3]} * sc, (f32x4){(float)a1[0], (float)a1[1], (float)a1[2], (float)a1[3]} * sc); } }
    }
};
struct EpiBf16 {
    static constexpr bool HAS_MID = false; static constexpr bool I8 = false;
    bf16_t* out; int ld, cstep;
    __device__ __forceinline__ void operator()(const f32x4 (&acc)[2][2][4][2], const Unit& u, int wr, int wc, int fr, int fq) const {
        const int row0 = u.pm * BM + wr * 64 + fr; bf16_t* base = out + (size_t)u.pn * cstep + wc * 32 + fq * 8;
        EPI_LOOP_ROWS { const int row = row0 + ai * HALF + m * 16;
#pragma unroll
            for (int bj = 0; bj < 2; ++bj) st_bf16x8(base + (size_t)row * ld + bj * HALF, acc[ai][bj][m][0], acc[ai][bj][m][1]); }
    }
};
template <int MODE> struct EpiBranch {
    static constexpr bool HAS_MID = false; static constexpr bool I8 = false;
    const bf16_t* gates; float* tmp; bf16_t* merged; int br;
    __device__ __forceinline__ void operator()(const f32x4 (&acc)[2][2][4][2], const Unit& u, int wr, int wc, int fr, int fq) const {
        const int row0 = u.pm * BM + wr * 64 + fr, col0 = u.pn * BM + wc * 32 + fq * 8;
        EPI_LOOP_ROWS { const int row = row0 + ai * HALF + m * 16;
#pragma unroll
            for (int bj = 0; bj < 2; ++bj) { const int col = col0 + bj * HALF;
                const u32x4 gw = *(const u32x4*)(gates + (size_t)row * 6144 + br * 2048 + col);
                f32x4 v0 = acc[ai][bj][m][0], v1 = acc[ai][bj][m][1];
                v0[0] *= sigmoidf_(bflo(gw.x)); v0[1] *= sigmoidf_(bfhi(gw.x)); v0[2] *= sigmoidf_(bflo(gw.y)); v0[3] *= sigmoidf_(bfhi(gw.y));
                v1[0] *= sigmoidf_(bflo(gw.z)); v1[1] *= sigmoidf_(bfhi(gw.z)); v1[2] *= sigmoidf_(bflo(gw.w)); v1[3] *= sigmoidf_(bfhi(gw.w));
                float* tp = tmp + (size_t)row * 2048 + col;
                if (MODE >= 1) { v0 += *(const f32x4*)tp; v1 += *(const f32x4*)(tp + 4); }
                if (MODE <= 1) { *(f32x4*)tp = v0; *(f32x4*)(tp + 4) = v1; }
                else st_bf16x8(merged + (size_t)row * 2048 + col, v0, v1); } }
    }
};
struct EpiBranch3 {
    static constexpr bool HAS_MID = true; static constexpr bool I8 = false; static constexpr int MID1 = 16, MID2 = 32;
    const bf16_t* gates; bf16_t* merged;
    __device__ __forceinline__ void mid(f32x4 (&acc)[2][2][4][2], const Unit& u, int t, int wr, int wc, int fr, int fq) const {
        const int row0 = u.pm * BM + wr * 64 + fr, col0 = u.pn * BM + wc * 32 + fq * 8, bn = (t == MID1) ? 0 : 2048;
#pragma unroll
        for (int ai = 0; ai < 2; ++ai)
#pragma unroll
            for (int m = 0; m < 4; ++m) { const int row = row0 + ai * HALF + m * 16;
#pragma unroll
                for (int bj = 0; bj < 2; ++bj) { const bf16_t* gp = gates + (size_t)row * 6144 + bn + col0 + bj * HALF;
                    const u32x4 gn = *(const u32x4*)gp, gd = *(const u32x4*)(gp + 2048);
                    f32x4 r0, r1;
                    r0[0] = (1.f + __expf(-bflo(gd.x))) / (1.f + __expf(-bflo(gn.x))); r0[1] = (1.f + __expf(-bfhi(gd.x))) / (1.f + __expf(-bfhi(gn.x)));
                    r0[2] = (1.f + __expf(-bflo(gd.y))) / (1.f + __expf(-bflo(gn.y))); r0[3] = (1.f + __expf(-bfhi(gd.y))) / (1.f + __expf(-bfhi(gn.y)));
                    r1[0] = (1.f + __expf(-bflo(gd.z))) / (1.f + __expf(-bflo(gn.z))); r1[1] = (1.f + __expf(-bfhi(gd.z))) / (1.f + __expf(-bfhi(gn.z)));
                    r1[2] = (1.f + __expf(-bflo(gd.w))) / (1.f + __expf(-bflo(gn.w))); r1[3] = (1.f + __expf(-bfhi(gd.w))) / (1.f + __expf(-bfhi(gn.w)));
                    acc[ai][bj][m][0] *= r0; acc[ai][bj][m][1] *= r1; } }
    }
    __device__ __forceinline__ void operator()(const f32x4 (&acc)[2][2][4][2], const Unit& u, int wr, int wc, int fr, int fq) const {
        const int row0 = u.pm * BM + wr * 64 + fr, col0 = u.pn * BM + wc * 32 + fq * 8;
#pragma unroll
        for (int ai = 0; ai < 2; ++ai)
#pragma unroll
            for (int m = 0; m < 4; ++m) { const int row = row0 + ai * HALF + m * 16;
#pragma unroll
                for (int bj = 0; bj < 2; ++bj) { const int col = col0 + bj * HALF;
                    const u32x4 gw = *(const u32x4*)(gates + (size_t)row * 6144 + 4096 + col);
                    f32x4 v0 = acc[ai][bj][m][0], v1 = acc[ai][bj][m][1];
                    v0[0] *= sigmoidf_(bflo(gw.x)); v0[1] *= sigmoidf_(bfhi(gw.x)); v0[2] *= sigmoidf_(bflo(gw.y)); v0[3] *= sigmoidf_(bfhi(gw.y));
                    v1[0] *= sigmoidf_(bflo(gw.z)); v1[1] *= sigmoidf_(bfhi(gw.z)); v1[2] *= sigmoidf_(bflo(gw.w)); v1[3] *= sigmoidf_(bfhi(gw.w));
                    st_bf16x8(merged + (size_t)row * 2048 + col, v0, v1); } }
    }
};
struct EpiOut {
    static constexpr bool HAS_MID = false; static constexpr bool I8 = false;
    const bf16_t* res; bf16_t* pre;
    __device__ __forceinline__ void operator()(const f32x4 (&acc)[2][2][4][2], const Unit& u, int wr, int wc, int fr, int fq) const {
        const int row0 = u.pm * BM + wr * 64 + fr, col0 = u.pn * BM + wc * 32 + fq * 8;
        EPI_LOOP_ROWS { const int row = row0 + ai * HALF + m * 16;
#pragma unroll
            for (int bj = 0; bj < 2; ++bj) { const size_t o = (size_t)row * 2048 + col0 + bj * HALF;
                const u32x4 rw = *(const u32x4*)(res + o); f32x4 v0 = acc[ai][bj][m][0], v1 = acc[ai][bj][m][1];
                v0[0] += ALPHA * bflo(rw.x); v0[1] += ALPHA * bfhi(rw.x); v0[2] += ALPHA * bflo(rw.y); v0[3] += ALPHA * bfhi(rw.y);
                v1[0] += ALPHA * bflo(rw.z); v1[1] += ALPHA * bfhi(rw.z); v1[2] += ALPHA * bflo(rw.w); v1[3] += ALPHA * bfhi(rw.w);
                st_bf16x8(pre + o, v0, v1); } }
    }
};
struct EpiGateUp {
    static constexpr bool HAS_MID = false; static constexpr bool I8 = false;
    const float* bg; const float* bu; bf16_t* hid;
    __device__ __forceinline__ void operator()(const f32x4 (&acc)[2][2][4][2], const Unit& u, int wr, int wc, int fr, int fq) const {
        const int row0 = u.pm * BM + wr * 64 + fr, j0 = u.pn * 128 + wc * 32 + fq * 8;
        const float* pg = bg + (size_t)u.e * DEXP + j0; const float* pu = bu + (size_t)u.e * DEXP + j0;
        const f32x4 g0b = *(const f32x4*)pg, g1b = *(const f32x4*)(pg + 4), u0b = *(const f32x4*)pu, u1b = *(const f32x4*)(pu + 4);
        EPI_LOOP_ROWS { const int row = row0 + ai * HALF + m * 16;
            f32x4 h0, h1;
#pragma unroll
            for (int j = 0; j < 4; ++j) {
                float g = fminf(acc[ai][0][m][0][j] + g0b[j], 7.0f), uu = fminf(fmaxf(acc[ai][1][m][0][j] + u0b[j], -7.0f), 7.0f);
                h0[j] = (uu + 1.0f) * (g * sigmoidf_(1.702f * g));
                g = fminf(acc[ai][0][m][1][j] + g1b[j], 7.0f); uu = fminf(fmaxf(acc[ai][1][m][1][j] + u1b[j], -7.0f), 7.0f);
                h1[j] = (uu + 1.0f) * (g * sigmoidf_(1.702f * g)); }
            st_bf16x8(hid + (size_t)row * DEXP + j0, h0, h1); }
    }
};
struct EpiGateUpI8 {
    static constexpr bool HAS_MID = false; static constexpr bool I8 = true;
    const float* bg; const float* bu; bf16_t* hid; const float* rowsx; const unsigned* wmaxbits;
    __device__ __forceinline__ void operator()(const f32x4 (&acc)[2][2][4][2], const Unit& u, int wr, int wc, int fr, int fq) const {
        const int row0 = u.pm * BM + wr * 64 + fr, j0 = u.pn * 128 + wc * 32 + fq * 8;
        const float sw = __uint_as_float(*wmaxbits) * (1.3f / 127.0f);
        const float* pg = bg + (size_t)u.e * DEXP + j0; const float* pu = bu + (size_t)u.e * DEXP + j0;
        const f32x4 g0b = *(const f32x4*)pg, g1b = *(const f32x4*)(pg + 4), u0b = *(const f32x4*)pu, u1b = *(const f32x4*)(pu + 4);
        EPI_LOOP_ROWS { const int row = row0 + ai * HALF + m * 16; const float sc = rowsx[row] * sw;
            const i32x4 ag0 = __builtin_bit_cast(i32x4, acc[ai][0][m][0]), ag1 = __builtin_bit_cast(i32x4, acc[ai][0][m][1]), au0 = __builtin_bit_cast(i32x4, acc[ai][1][m][0]), au1 = __builtin_bit_cast(i32x4, acc[ai][1][m][1]);
            f32x4 h0, h1;
#pragma unroll
            for (int j = 0; j < 4; ++j) {
                float g = fminf((float)ag0[j] * sc + g0b[j], 7.0f), uu = fminf(fmaxf((float)au0[j] * sc + u0b[j], -7.0f), 7.0f);
                h0[j] = (uu + 1.0f) * (g * sigmoidf_(1.702f * g));
                g = fminf((float)ag1[j] * sc + g1b[j], 7.0f); uu = fminf(fmaxf((float)au1[j] * sc + u1b[j], -7.0f), 7.0f);
                h1[j] = (uu + 1.0f) * (g * sigmoidf_(1.702f * g)); }
            st_bf16x8(hid + (size_t)row * DEXP + j0, h0, h1); }
    }
};
struct EpiDown {
    static constexpr bool HAS_MID = false; static constexpr bool I8 = false;
    const float* bd; const float* roww; bf16_t* ys;
    __device__ __forceinline__ void operator()(const f32x4 (&acc)[2][2][4][2], const Unit& u, int wr, int wc, int fr, int fq) const {
        const int row0 = u.pm * BM + wr * 64 + fr, col0 = u.pn * BM + wc * 32 + fq * 8;
        f32x4 b[2][2];
#pragma unroll
        for (int bj = 0; bj < 2; ++bj) { const float* p = bd + (size_t)u.e * DM + col0 + bj * HALF; b[bj][0] = *(const f32x4*)p; b[bj][1] = *(const f32x4*)(p + 4); }
        EPI_LOOP_ROWS { const int row = row0 + ai * HALF + m * 16; const float w = roww[row];
#pragma unroll
            for (int bj = 0; bj < 2; ++bj) st_bf16x8(ys + (size_t)row * 2048 + col0 + bj * HALF, (acc[ai][bj][m][0] + b[bj][0]) * w, (acc[ai][bj][m][1] + b[bj][1]) * w); }
    }
};
struct EpiPleGate {
    static constexpr bool HAS_MID = false; static constexpr bool I8 = false;
    const bf16_t* hb; const bf16_t* pp; bf16_t* pre;
    __device__ __forceinline__ void operator()(const f32x4 (&acc)[2][2][4][2], const Unit& u, int wr, int wc, int fr, int fq) const {
        const int row0 = u.pm * BM + wr * 64 + fr, col0 = u.pn * BM + wc * 32 + fq * 8;
        EPI_LOOP_ROWS { const int row = row0 + ai * HALF + m * 16;
#pragma unroll
            for (int bj = 0; bj < 2; ++bj) { const size_t o = (size_t)row * 2048 + col0 + bj * HALF;
                const u32x4 pw = *(const u32x4*)(pp + o), hw = *(const u32x4*)(hb + o);
                const f32x4 a0 = acc[ai][bj][m][0], a1 = acc[ai][bj][m][1]; f32x4 o0, o1;
                o0[0] = bflo(hw.x) + sigmoidf_(a0[0]) * bflo(pw.x); o0[1] = bfhi(hw.x) + sigmoidf_(a0[1]) * bfhi(pw.x); o0[2] = bflo(hw.y) + sigmoidf_(a0[2]) * bflo(pw.y); o0[3] = bfhi(hw.y) + sigmoidf_(a0[3]) * bfhi(pw.y);
                o1[0] = bflo(hw.z) + sigmoidf_(a1[0]) * bflo(pw.z); o1[1] = bfhi(hw.z) + sigmoidf_(a1[1]) * bfhi(pw.z); o1[2] = bflo(hw.w) + sigmoidf_(a1[2]) * bflo(pw.w); o1[3] = bfhi(hw.w) + sigmoidf_(a1[3]) * bfhi(pw.w);
                st_bf16x8(pre + o, o0, o1); } }
    }
};
struct EpiPleGateI8 {
    static constexpr bool HAS_MID = false; static constexpr bool I8 = true;
    const bf16_t* hb; const bf16_t* pp; bf16_t* pre; const float* hs; const unsigned* wmaxbits;
    __device__ __forceinline__ void operator()(const f32x4 (&acc)[2][2][4][2], const Unit& u, int wr, int wc, int fr, int fq) const {
        const int row0 = u.pm * BM + wr * 64 + fr, col0 = u.pn * BM + wc * 32 + fq * 8;
        const float sw = __uint_as_float(*wmaxbits) * (1.3f / 127.0f);
        EPI_LOOP_ROWS { const int row = row0 + ai * HALF + m * 16; const float sc = hs[row] * sw;
#pragma unroll
            for (int bj = 0; bj < 2; ++bj) { const size_t o = (size_t)row * 2048 + col0 + bj * HALF;
                const u32x4 pw = *(const u32x4*)(pp + o), hw = *(const u32x4*)(hb + o);
                const i32x4 a0 = __builtin_bit_cast(i32x4, acc[ai][bj][m][0]), a1 = __builtin_bit_cast(i32x4, acc[ai][bj][m][1]); f32x4 o0, o1;
                o0[0] = bflo(hw.x) + sigmoidf_((float)a0[0] * sc) * bflo(pw.x); o0[1] = bfhi(hw.x) + sigmoidf_((float)a0[1] * sc) * bfhi(pw.x); o0[2] = bflo(hw.y) + sigmoidf_((float)a0[2] * sc) * bflo(pw.y); o0[3] = bfhi(hw.y) + sigmoidf_((float)a0[3] * sc) * bfhi(pw.y);
                o1[0] = bflo(hw.z) + sigmoidf_((float)a1[0] * sc) * bflo(pw.z); o1[1] = bfhi(hw.z) + sigmoidf_((float)a1[1] * sc) * bfhi(pw.z); o1[2] = bflo(hw.w) + sigmoidf_((float)a1[2] * sc) * bflo(pw.w); o1[3] = bfhi(hw.w) + sigmoidf_((float)a1[3] * sc) * bfhi(pw.w);
                st_bf16x8(pre + o, o0, o1); } }
    }
};
}

struct Params { const float* in[25]; float* out; unsigned char* ws; int ph_lo, ph_hi; };
__constant__ float c_invf_r[16] = {1.000000000e+00f, 4.403665960e-01f, 1.939227432e-01f, 8.539710194e-02f, 3.760603070e-02f, 1.656043902e-02f, 7.292664610e-03f, 3.211445874e-03f, 1.414213562e-03f, 6.227723788e-04f, 2.742481884e-04f, 1.207697351e-04f, 5.318296098e-05f, 2.341999971e-05f, 1.031338616e-05f, 4.541670478e-06f};
__constant__ float c_invf_i[8] = {1.000000000e+00f, 1.939227432e-01f, 3.760603070e-02f, 7.292664610e-03f, 1.414213562e-03f, 2.742481884e-04f, 5.318296098e-05f, 1.031338616e-05f};
constexpr int LDS_PTRS = LDS_MISC + 256;
struct Frame { unsigned char* lds; LAS unsigned char* ldsl; unsigned char* ws; int tid, lane, wid, G, bid;
    __device__ __forceinline__ const float* in(int k) const { const LAS unsigned* t = (const LAS unsigned*)(ldsl + LDS_PTRS) + 2 * k;
        const unsigned lo = __builtin_amdgcn_readfirstlane(t[0]), hi = __builtin_amdgcn_readfirstlane(t[1]); return (const float*)(const GAS float*)(((unsigned long long)hi << 32) | lo); }
    __device__ __forceinline__ float* out() const { return (float*)in(25); } };
__device__ __forceinline__ Frame fresh(const Frame& F0) { Frame F = F0; int t = threadIdx.x; asm volatile("" : "+v"(t)); F.tid = t; F.lane = t & 63; F.wid = __builtin_amdgcn_readfirstlane(t >> 6); size_t z = 0; asm volatile("" : "+s"(z)); F.ws = F0.ws + z; return F; }

struct TcTile { const float* src; long sld; bf16_t* dst; long dld; int nvalid; float qinv; };
template <class Dec>
__device__ __forceinline__ void tconv_run(const Frame& F, int total, const Dec& dec, int& rot) {
    float* tile = (float*)F.lds;
    const int tid = F.tid, G = F.G;
    const int start = (F.bid - (rot % G) + G) % G; rot += total;
    const int lr = tid >> 4, lc4 = (tid & 15) * 4, sn = tid >> 3, skc = (tid & 7) * 8;
    f32x4 v[4][2];
#define TC_ISSUE(t0_) do { _Pragma("unroll") for (int q = 0; q < 4; ++q) { const int t = (t0_) + q * G; \
        if (t < total) { const TcTile ti = dec(t); _Pragma("unroll") for (int h = 0; h < 2; ++h) { v[q][h] = (f32x4){0.f, 0.f, 0.f, 0.f}; \
            if (lc4 < ti.nvalid) v[q][h] = *(const GAS f32x4*)((const GAS float*)ti.src + (size_t)(lr + 32 * h) * ti.sld + lc4); } } } } while (0)
    if (start < total) TC_ISSUE(start);
    for (int t0 = start; t0 < total; t0 += 4 * G) {
#pragma unroll
        for (int q = 0; q < 4; ++q) { if (t0 + q * G < total) { float* tl = tile + q * (64 * 65);
#pragma unroll
                for (int h = 0; h < 2; ++h) { float* p = tl + (lr + 32 * h) * 65 + lc4; p[0] = v[q][h][0]; p[1] = v[q][h][1]; p[2] = v[q][h][2]; p[3] = v[q][h][3]; } } }
        __syncthreads();
        if (t0 + 4 * G < total) TC_ISSUE(t0 + 4 * G);
#pragma unroll
        for (int q = 0; q < 4; ++q) { const int t = t0 + q * G;
            if (t < total) { const TcTile ti = dec(t); const float* tl = tile + q * (64 * 65);
                if (ti.qinv > 0.f) { if (tid < 256) { const int n8 = tid >> 2, kc = (tid & 3) * 16; u32x4 w;
#pragma unroll
                        for (int d = 0; d < 4; ++d) { unsigned pk = 0u;
#pragma unroll
                            for (int j = 0; j < 4; ++j) { float q = rintf(tl[(kc + d * 4 + j) * 65 + n8] * ti.qinv); q = fminf(fmaxf(q, -127.f), 127.f); pk |= ((unsigned)(int)q & 0xffu) << (8 * j); }
                            w[d] = pk; }
                        *(u32x4*)((unsigned char*)ti.dst + (size_t)n8 * ti.dld + kc) = w; } }
                else if (sn < ti.nvalid) { f32x4 a, b;
#pragma unroll
                    for (int j = 0; j < 4; ++j) { a[j] = tl[(skc + j) * 65 + sn]; b[j] = tl[(skc + 4 + j) * 65 + sn]; }
                    pg8::st_bf16x8(ti.dst + (size_t)sn * ti.dld + skc, a, b); } } }
        __syncthreads();
    }
#undef TC_ISSUE
}
struct TcMat {
    const float* src; long src_ld; int tk, ncols; bf16_t* dst; long dst_ld; float qinv;
    __device__ __forceinline__ TcTile operator()(int t) const { const int k0 = (t % tk) * 64, n0 = (t / tk) * 64; TcTile ti;
        ti.src = src + (size_t)k0 * src_ld + n0; ti.sld = src_ld; ti.dst = qinv > 0.f ? (bf16_t*)((unsigned char*)dst + (size_t)n0 * dst_ld + k0) : dst + (size_t)n0 * dst_ld + k0; ti.dld = dst_ld; ti.nvalid = (ncols - n0) < 64 ? (ncols - n0) : 64; ti.qinv = qinv; return ti; }
};
__device__ __forceinline__ void tconv(const Frame& F, const float* src, long src_ld, int K, int ncols, bf16_t* dst, long dst_ld, int& rot) {
    TcMat d{src, src_ld, K >> 6, ncols, dst, dst_ld, 0.f}; tconv_run(F, (K >> 6) * ((ncols + 63) >> 6), d, rot);
}
struct TcExperts {
    const float* wg; const float* wu; const float* wd; unsigned char* dgu; bf16_t* ddn; float qinv;
    __device__ __forceinline__ TcTile operator()(int t) const { const int e = t / 1536, r = t - e * 1536; TcTile ti; ti.nvalid = 64; ti.qinv = 0.f;
        if (r < 1024) { const int k0 = (r & 31) * 64, dt = r >> 5, jb = dt >> 2, gu = (dt >> 1) & 1, half = dt & 1;
            ti.src = (const float*)((unsigned long long)wg + (unsigned long long)gu * ((unsigned long long)wu - (unsigned long long)wg)) + (size_t)e * DM * DEXP + (size_t)k0 * DEXP + jb * 128 + half * 64; ti.sld = DEXP;
            ti.dst = (bf16_t*)(dgu + (size_t)e * 2048 * 2048 + (size_t)(dt * 64) * 2048 + k0); ti.dld = 2048; ti.qinv = qinv; }
        else { const int r2 = r - 1024, k0 = (r2 & 15) * 64, n0 = (r2 >> 4) * 64;
            ti.src = wd + (size_t)e * DEXP * DM + (size_t)k0 * DM + n0; ti.sld = DM;
            ti.dst = ddn + (size_t)e * 2048 * 1024 + (size_t)n0 * 1024 + k0; ti.dld = 1024; }
        return ti; }
};
__device__ __forceinline__ void sample_wmax(const Frame& F) {
    unsigned* wm = (unsigned*)(F.ws + WS_CTL) + CW_WMAX;
#pragma unroll 1
    for (int l = 0; l < NLAYER; ++l) { float mx = 0.f;
#pragma unroll 1
        for (int which = 0; which < 2; ++which) { const f32x4* p = (const f32x4*)(F.in(which ? 17 : 15) + (size_t)l * NEXP * DM * DEXP);
            for (size_t i = (size_t)F.bid * 512 + F.tid; i < (size_t)NEXP * DM * DEXP / 4 / 64; i += (size_t)F.G * 512) { const f32x4 v = p[i * 64 + (i & 63)];
                mx = fmaxf(mx, fmaxf(fmaxf(fabsf(v[0]), fabsf(v[1])), fmaxf(fabsf(v[2]), fabsf(v[3])))); } }
        for (int o = 32; o > 0; o >>= 1) mx = fmaxf(mx, __shfl_xor(mx, o));
        if (F.lane == 0 && mx > 0.f) atomicMax(&wm[l], __float_as_uint(mx));
        float mg = 0.f; const f32x4* wi_ = (const f32x4*)(F.in(2) + (size_t)l * DM * INW);
        for (int i = F.bid * 512 + F.tid; i < DM * (INW / 4) / 16; i += F.G * 512) { const f32x4 v = wi_[(size_t)i * 16 + (i & 15)];
            mg = fmaxf(mg, fmaxf(fmaxf(fabsf(v[0]), fabsf(v[1])), fmaxf(fabsf(v[2]), fabsf(v[3])))); }
        for (int o = 32; o > 0; o >>= 1) mg = fmaxf(mg, __shfl_xor(mg, o));
        if (F.lane == 0 && mg > 0.f) atomicMax(&wm[CW_WMAXG - CW_WMAX + l], __float_as_uint(mg));
        float mp = 0.f; const f32x4* wp_ = (const f32x4*)(F.in(21) + (size_t)l * DM * DM);
        for (int i = F.bid * 512 + F.tid; i < DM * DM / 4 / 16; i += F.G * 512) { const f32x4 v = wp_[i * 16 + (i & 15)];
            mp = fmaxf(mp, fmaxf(fmaxf(fabsf(v[0]), fabsf(v[1])), fmaxf(fabsf(v[2]), fabsf(v[3])))); }
        for (int o = 32; o > 0; o >>= 1) mp = fmaxf(mp, __shfl_xor(mp, o));
        if (F.lane == 0 && mp > 0.f) atomicMax(&wm[CW_WMAXP - CW_WMAX + l], __float_as_uint(mp)); }
}
__device__ __forceinline__ void conv_rows(const Frame& F, const float* src, bf16_t* dst, size_t n8) {
    for (size_t i = (size_t)F.bid * 512 + F.tid; i < n8; i += (size_t)F.G * 512) { const f32x4 a = *(const f32x4*)(src + i * 8), b = *(const f32x4*)(src + i * 8 + 4); pg8::st_bf16x8(dst + i * 8, a, b); }
}
__device__ __forceinline__ void quant_rows(const Frame& F, const float* src, bf16_t* xb, unsigned char* xq, float* xsc) {
    const int lane = F.lane;
    for (int tok = F.bid * 8 + F.wid; tok < NTOK; tok += F.G * 8) { f32x4 v[8]; float amax = 0.f;
#pragma unroll
        for (int i = 0; i < 4; ++i) { const int c = (i * 64 + lane) * 8; v[2 * i] = *(const f32x4*)(src + (size_t)tok * DM + c); v[2 * i + 1] = *(const f32x4*)(src + (size_t)tok * DM + c + 4);
            pg8::st_bf16x8(xb + (size_t)tok * DM + c, v[2 * i], v[2 * i + 1]);
#pragma unroll
            for (int h = 0; h < 2; ++h)
#pragma unroll
                for (int j = 0; j < 4; ++j) amax = fmaxf(amax, fabsf(v[2 * i + h][j])); }
        for (int o = 32; o > 0; o >>= 1) amax = fmaxf(amax, __shfl_xor(amax, o));
        amax = fmaxf(amax, 1e-20f); const float qi = 127.0f / amax; if (lane == 0) xsc[tok] = amax * (1.0f / 127.0f);
#pragma unroll
        for (int i = 0; i < 4; ++i) { u32x2 w;
#pragma unroll
            for (int h = 0; h < 2; ++h) { unsigned pk = 0u;
#pragma unroll
                for (int j = 0; j < 4; ++j) pk |= ((unsigned)(int)rintf(v[2 * i + h][j] * qi) & 0xffu) << (8 * j);
                w[h] = pk; }
            *(u32x2*)(xq + (size_t)tok * DM + (i * 64 + lane) * 8) = w; } }
}
__constant__ int c_so[14] = {0, 1312, 2416, 3440, 4464, 5496, 6520, 7544, 8568, 1024, 1280, 2336, 2400, 5488};
__constant__ int c_dn[14] = {0, 1024, 2048, 3072, 4096, 5120, 6144, 7168, 8192, 14336, 14592, 14624, 14688, 14704};
__constant__ int c_nc[14] = {1024, 1024, 1024, 1024, 1024, 1024, 1024, 1024, 6144, 256, 32, 64, 16, 8};
__device__ __forceinline__ void convert_layer_weights(const Frame& F0, const Params& P, int l) { const Frame F = fresh(F0);
    unsigned char* ws = F.ws; int rot = 0;
    { const float* w = F.in(2) + (size_t)l * DM * INW; bf16_t* d = (bf16_t*)(ws + W_IN);
      const float wmaxg = __uint_as_float(((const unsigned*)(ws + WS_CTL))[CW_WMAXG + l]); const float qinv = 127.0f / (1.3f * wmaxg);
#pragma unroll 1
      for (int s = 0; s < 14; ++s) {
          if (s == 1 || s >= 10) tconv(F, w + c_so[s], INW, DM, c_nc[s], d + (size_t)c_dn[s] * DM, DM, rot);
          else { const int crow = (s == 0) ? 0 : (s <= 7 ? 1024 + (s - 2) * 1024 : (s == 8 ? 7168 : 13312));
              TcMat dq{w + c_so[s], INW, DM >> 6, c_nc[s], (bf16_t*)(ws + W_IN8 + (size_t)crow * 2048), 2048, qinv}; tconv_run(F, (DM >> 6) * (c_nc[s] >> 6), dq, rot); } } }
    tconv(F, F.in(7) + (size_t)l * 1024 * DM, DM, 1024, DM, (bf16_t*)(ws + W_BRA), 3072, rot);
    tconv(F, F.in(8) + (size_t)l * 1024 * DM, DM, 1024, DM, (bf16_t*)(ws + W_BRA) + 1024, 3072, rot);
    tconv(F, F.in(9) + (size_t)l * 1024 * DM, DM, 1024, DM, (bf16_t*)(ws + W_BRA) + 2048, 3072, rot);
    tconv(F, F.in(10) + (size_t)l * DM * DM, DM, DM, DM, (bf16_t*)(ws + W_OUT), DM, rot);
    { const float wmp = __uint_as_float(((const unsigned*)(ws + WS_CTL))[CW_WMAXP + l]);
      TcMat dq{F.in(21) + (size_t)l * DM * DM, DM, DM >> 6, DM, (bf16_t*)(ws + W_PG), 2048, 127.0f / (1.3f * wmp)}; tconv_run(F, (DM >> 6) * (DM >> 6), dq, rot); }
    tconv(F, F.in(22) + (size_t)l * 256 * DM, DM, 256, DM, (bf16_t*)(ws + W_PLE), 256, rot);
#pragma unroll 1
    for (int h = 0; h < 8; ++h) tconv(F, F.in(6) + (size_t)l * 256 * 1024 + h * 128, 1024, 256, 128, (bf16_t*)(ws + W_UV2) + ((size_t)(h >> 1) * 256 + (h & 1) * 128) * 512 + (h & 1) * 256, 512, rot);
    { const float wmax = __uint_as_float(((const unsigned*)(ws + WS_CTL))[CW_WMAX + l]);
      TcExperts d{F.in(15) + (size_t)l * NEXP * DM * DEXP, F.in(17) + (size_t)l * NEXP * DM * DEXP, F.in(19) + (size_t)l * NEXP * DEXP * DM, (unsigned char*)(ws + W_GU), (bf16_t*)(ws + W_DN), 127.0f / (1.3f * wmax)};
      tconv_run(F, NEXP * 1536, d, rot); }
    { const float* w = F.in(5) + (size_t)l * 256 * 8 * 96; bf16_t* d = (bf16_t*)(ws + W_UK2);
      for (int i = F.bid * 512 + F.tid; i < 256 * 8 * 96; i += F.G * 512) { const int n = i % 96, h = (i / 96) & 7, r = i / 768; d[((size_t)h * 256 + r) * 256 + (h & 1) * 128 + 32 + n] = f2bf(w[i]); } }
}

__device__ __forceinline__ void rope_cs(float pos, float invf, float& c, float& s) {
    const float a = pos * invf; const double ad = (double)a * 0.15915494309189535; const float fr = (float)(ad - rint(ad));
    s = __builtin_amdgcn_sinf(fr); c = __builtin_amdgcn_cosf(fr);
}
__device__ __forceinline__ void phase_prep(const Frame& F0, const Params& P, int l) { const Frame F = fresh(F0);
    unsigned char* ws = F.ws; const int lane = F.lane;
    const float* smallb = (const float*)(ws + R_SMALL); bf16_t* kcat = (bf16_t*)(ws + R_KCAT); bf16_t* qcat = (bf16_t*)(ws + R_QCAT);
    bf16_t* ki = (bf16_t*)(ws + R_KI); float* wi = (float*)(ws + R_WI); float* lf = (float*)(ws + WS_LF);
    const bf16_t* qa = (const bf16_t*)(ws + R_QA); bf16_t* qidx = (bf16_t*)(ws + R_QIDX);
    const f32x4 gck = *(const f32x4*)(F.in(4) + l * 256 + lane * 4);
    const float bfo = lane < 8 ? F.in(3)[l * 8 + lane] : 0.f;
    const float ifr = c_invf_r[lane & 15], ifi = c_invf_i[lane & 7];
    for (int tok = F.bid * 8 + F.wid; tok < NTOK; tok += F.G * 8) {
        const int s = tok & (SEQ - 1), b = tok >> 13; const float* sm = smallb + (size_t)tok * 512;
        float cr, sr, ci, si; rope_cs((float)s, ifr, cr, sr); rope_cs((float)s, ifi, ci, si);
        { const f32x4 v = *(const f32x4*)(sm + lane * 4); float ss = v[0] * v[0] + v[1] * v[1] + v[2] * v[2] + v[3] * v[3]; ss = wave_sum(ss);
          const float rs = rsqrtf(ss * (1.0f / 256.0f) + 1e-6f); u32x2 w; w.x = cvtpk(v[0] * rs * gck[0], v[1] * rs * gck[1]); w.y = cvtpk(v[2] * rs * gck[2], v[3] * rs * gck[3]);
          *(u32x2*)(kcat + (size_t)tok * 288 + lane * 4) = w; }
        if (lane < 16) { const float x1 = sm[256 + lane], x2 = sm[272 + lane]; kcat[(size_t)tok * 288 + 256 + lane] = f2bf(x1 * cr - x2 * sr); kcat[(size_t)tok * 288 + 272 + lane] = f2bf(x2 * cr + x1 * sr); }
        { float o = sm[288 + lane];
          if (lane < 8) { const float x2 = sm[296 + lane]; o = o * ci - x2 * si; } else if (lane < 16) { const float x1 = sm[288 + lane - 8]; o = o * ci + x1 * si; }
          ki[(size_t)tok * 64 + lane] = f2bf(o); }
        if (lane < 16) wi[(size_t)tok * 16 + lane] = sm[352 + lane] * (1.0f / 32.0f);
        if (lane < 8) { const float f = sm[368 + lane] + bfo; lf[(size_t)(b * 8 + lane) * SEQ + s] = fminf(f, 0.f) - log1pf(__expf(-fabsf(f))); }
#pragma unroll
        for (int pp = 0; pp < 2; ++pp) { const int p = lane + 64 * pp, h = p >> 4, i = p & 15;
            const float x1 = bf2f(qa[(size_t)tok * 1024 + h * 128 + i]), x2 = bf2f(qa[(size_t)tok * 1024 + h * 128 + 16 + i]);
            qcat[(size_t)tok * 2304 + h * 288 + 256 + i] = f2bf(x1 * cr - x2 * sr); qcat[(size_t)tok * 2304 + h * 288 + 272 + i] = f2bf(x2 * cr + x1 * sr); }
#pragma unroll
        for (int pp = 0; pp < 2; ++pp) { const int p = lane + 64 * pp, hh = p >> 3, i = p & 7; bf16_t* q = qidx + (size_t)tok * 1024 + hh * 64;
            const float x1 = bf2f(q[i]), x2 = bf2f(q[8 + i]); q[i] = f2bf(x1 * ci - x2 * si); q[8 + i] = f2bf(x2 * ci + x1 * si); }
    }
    { const bf16_t* kbt = (const bf16_t*)(ws + R_QKV) + (size_t)NTOK * 1024; unsigned* kmx = (unsigned*)(ws + WS_CTL) + CW_KMAX + l * 16;
#pragma unroll 1
      for (int bh = 0; bh < 16; ++bh) { float mx = 0.f;
          for (int r0 = (F.bid * 8 + F.wid) * 4; r0 < SEQ; r0 += F.G * 32) {
              const u32x4 w = *(const u32x4*)(kbt + ((size_t)bh * SEQ + r0 + (lane >> 4)) * 128 + (lane & 15) * 8);
              float ss = bflo(w.x) * bflo(w.x) + bfhi(w.x) * bfhi(w.x) + bflo(w.y) * bflo(w.y) + bfhi(w.y) * bfhi(w.y) + bflo(w.z) * bflo(w.z) + bfhi(w.z) * bfhi(w.z) + bflo(w.w) * bflo(w.w) + bfhi(w.w) * bfhi(w.w);
              ss += __shfl_xor(ss, 1); ss += __shfl_xor(ss, 2); ss += __shfl_xor(ss, 4); ss += __shfl_xor(ss, 8); mx = fmaxf(mx, ss); }
          mx = fmaxf(mx, __shfl_xor(mx, 16)); mx = fmaxf(mx, __shfl_xor(mx, 32));
          if (lane == 0) ((float*)F.lds)[F.wid * 16 + bh] = mx; }
      __syncthreads();
      if (F.tid < 16) { float mx = 0.f;
#pragma unroll
          for (int w = 0; w < 8; ++w) mx = fmaxf(mx, ((const float*)F.lds)[w * 16 + F.tid]);
          const unsigned bits = __float_as_uint(mx);
          if (bits > __hip_atomic_load(&kmx[F.tid], __ATOMIC_RELAXED, __HIP_MEMORY_SCOPE_AGENT)) atomicMax(&kmx[F.tid], bits); }
      __syncthreads(); }
}
__device__ __forceinline__ void phase_cumsum(const Frame& F0) { const Frame F = fresh(F0);
    const int gw = F.bid * 8 + F.wid; if (gw >= 16) return;
    const float* lf = (const float*)(F.ws + WS_LF) + (size_t)gw * SEQ; float* cum = (float*)(F.ws + WS_CUM) + (size_t)gw * SEQ;
    const int lane = F.lane; double tot = 0.0;
    for (int j = 0; j < 128; ++j) tot += (double)lf[lane * 128 + j];
    double inc = tot;
    for (int o = 1; o < 64; o <<= 1) { const double n = __shfl_up(inc, o); if (lane >= o) inc += n; }
    double run = inc - tot;
    for (int j = 0; j < 128; ++j) { run += (double)lf[lane * 128 + j]; cum[lane * 128 + j] = (float)run; }
}

__device__ __forceinline__ void idx_unit(const Frame& F, int b, int pi, int half) {
    const int tid = F.tid, lane = F.lane, rho = lane & 31, hh = lane >> 5; unsigned char* ws = F.ws;
    const bf16_t* qidx = (const bf16_t*)(ws + R_QIDX); const bf16_t* ki = (const bf16_t*)(ws + R_KI) + (size_t)b * SEQ * 64; const float* wi = (const float*)(ws + R_WI);
    float* scores = (float*)(ws + R_SCORES) + (size_t)b * SEQ * SEQ;
    LAS unsigned char* kl = F.ldsl;
    const int gl = pi, gh = 127 - pi, nl = (64 * gl + 63) / 128 + 1, nh = (64 * gh + 63) / 128 + 1, tot = nl + nh;
    const int x0 = half ? tot / 2 : 0, x1 = half ? tot : tot / 2;
    bf16x8 af[4][4]; float wv[4][16]; int t0 = 0, curg = -1;
    const int r0 = tid >> 3, p0 = tid & 7;
    const unsigned d0 = (unsigned)(r0 * 128 + ((p0 ^ (r0 & 7)) << 4)), d1 = d0 + 64 * 128;
    u32x4 s0, s1;
    { const int c = x0 < nl ? x0 : x0 - nl; const bf16_t* kp = ki + (size_t)(c * 128) * 64; s0 = *(const u32x4*)(kp + (size_t)r0 * 64 + p0 * 8); s1 = *(const u32x4*)(kp + (size_t)(r0 + 64) * 64 + p0 * 8); }
    __syncthreads();
    *(LAS u32x4*)(kl + d0) = s0; *(LAS u32x4*)(kl + d1) = s1;
    __syncthreads();
    const unsigned rdo = (unsigned)(rho * 128);
#pragma unroll 1
    for (int x = x0; x < x1; ++x) {
        const int g = x < nl ? gl : gh, c = x < nl ? x : x - nl;
        if (g != curg) { curg = g; t0 = g * 64 + F.wid * 8;
#pragma unroll
            for (int mt = 0; mt < 4; ++mt) {
                const int tokA = b * SEQ + t0 + 2 * mt + ((rho >> 2) & 1), head = (rho & 3) + 4 * (rho >> 3);
#pragma unroll
                for (int kk = 0; kk < 4; ++kk) af[mt][kk] = *(const bf16x8*)(qidx + (size_t)tokA * 1024 + head * 64 + kk * 16 + 8 * hh);
                const float* wp = wi + (size_t)(b * SEQ + t0 + 2 * mt + hh) * 16;
#pragma unroll
                for (int q = 0; q < 4; ++q) { const f32x4 v = *(const f32x4*)(wp + 4 * q); wv[mt][4 * q] = v[0]; wv[mt][4 * q + 1] = v[1]; wv[mt][4 * q + 2] = v[2]; wv[mt][4 * q + 3] = v[3]; } } }
        const unsigned bo = (unsigned)((x - x0) & 1) * 16384u;
        if (x + 1 < x1) { const int cn = (x + 1) < nl ? (x + 1) : (x + 1) - nl; const bf16_t* kp = ki + (size_t)(cn * 128) * 64; s0 = *(const u32x4*)(kp + (size_t)r0 * 64 + p0 * 8); s1 = *(const u32x4*)(kp + (size_t)(r0 + 64) * 64 + p0 * 8); }
#pragma unroll
        for (int tl = 0; tl < 4; ++tl) {
            const int kb = c * 128 + tl * 32;
            if (kb <= t0 + 7) {
                bf16x8 bc[4];
#pragma unroll
                for (int kk = 0; kk < 4; ++kk) bc[kk] = *(const LAS bf16x8*)(kl + bo + tl * 4096 + rdo + (((kk * 2 + hh) ^ (rho & 7)) << 4));
                f32x16 a0 = {}, a1 = {}, a2 = {}, a3 = {};
#pragma unroll
                for (int kk = 0; kk < 4; ++kk) { a0 = __builtin_amdgcn_mfma_f32_32x32x16_bf16(af[0][kk], bc[kk], a0, 0, 0, 0); a1 = __builtin_amdgcn_mfma_f32_32x32x16_bf16(af[1][kk], bc[kk], a1, 0, 0, 0);
                                                  a2 = __builtin_amdgcn_mfma_f32_32x32x16_bf16(af[2][kk], bc[kk], a2, 0, 0, 0); a3 = __builtin_amdgcn_mfma_f32_32x32x16_bf16(af[3][kk], bc[kk], a3, 0, 0, 0); }
#define IDX_EPI(A_, mt_) do { float x_0 = 0.f, x_1 = 0.f, x_2 = 0.f, x_3 = 0.f; _Pragma("unroll") for (int r = 0; r < 16; r += 4) { \
                    x_0 = fmaf(wv[mt_][r], fmaxf(A_[r], 0.f), x_0); x_1 = fmaf(wv[mt_][r + 1], fmaxf(A_[r + 1], 0.f), x_1); x_2 = fmaf(wv[mt_][r + 2], fmaxf(A_[r + 2], 0.f), x_2); x_3 = fmaf(wv[mt_][r + 3], fmaxf(A_[r + 3], 0.f), x_3); } \
                    scores[(size_t)(t0 + 2 * (mt_) + hh) * SEQ + kb + rho] = (x_0 + x_1) + (x_2 + x_3); } while (0)
                IDX_EPI(a0, 0); IDX_EPI(a1, 1); IDX_EPI(a2, 2); IDX_EPI(a3, 3);
#undef IDX_EPI
            }
        }
        if (x + 1 < x1) { *(LAS u32x4*)(kl + (bo ^ 16384u) + d0) = s0; *(LAS u32x4*)(kl + (bo ^ 16384u) + d1) = s1; }
        __syncthreads();
    }
}
__device__ __forceinline__ void phase_idx(const Frame& F0) { const Frame F = fresh(F0);
#pragma unroll 1
    for (int it = F.bid; it < 256; it += F.G) { const int b = it >> 7, pi = (it >> 1) & 63, half = it & 1; idx_unit(F, b, pi, half); }
}

__device__ __forceinline__ unsigned sortable(float f) { const unsigned u = __float_as_uint(f); return (u & 0x80000000u) ? ~u : (u | 0x80000000u); }
__device__ __forceinline__ void topk_row(const Frame& F, int b, int t) {
    int lane = F.lane; asm volatile("" : "+v"(lane));
    const int L = t + 1, tok = b * SEQ + t; unsigned char* ws = F.ws;
    int* sel = (int*)(ws + R_SEL) + (size_t)tok * 256; int* nsel = (int*)(ws + R_NSEL);
    if (lane == 0) nsel[tok] = L < 256 ? L : 256;
    if (L <= 256) { for (int j = lane; j < 256; j += 64) sel[j] = j < L ? j : 0; return; }
    const float* row = (const float*)(ws + R_SCORES) + ((size_t)b * SEQ + t) * SEQ;
    const int nch = (L + 1023) >> 10;
#define TOPK_LOAD_ROW() do { _Pragma("unroll") for (int c = 0; c < 8; ++c) { \
        if (c < nch) { _Pragma("unroll") for (int jj = 0; jj < 4; ++jj) { const int j = c * 4 + jj; const f32x4 v = *(const f32x4*)(row + j * 256 + lane * 4); \
                _Pragma("unroll") for (int e_ = 0; e_ < 4; ++e_) { const int idx = j * 256 + lane * 4 + e_; u[j * 4 + e_] = idx < L ? sortable(v[e_]) : 0u; } } } \
        else { _Pragma("unroll") for (int q = 0; q < 16; ++q) u[c * 16 + q] = 0u; } } } while (0)
    unsigned u[128];
    TOPK_LOAD_ROW();
    unsigned g0 = 0u, g1 = 0u, g2 = 0u, g3 = 0u;
#pragma unroll
    for (int c = 0; c < 8; ++c) if (c < nch) {
#pragma unroll
        for (int jj = 0; jj < 4; ++jj) { const int j = c * 4 + jj; g0 = u[4 * j] > g0 ? u[4 * j] : g0; g1 = u[4 * j + 1] > g1 ? u[4 * j + 1] : g1; g2 = u[4 * j + 2] > g2 ? u[4 * j + 2] : g2; g3 = u[4 * j + 3] > g3 ? u[4 * j + 3] : g3; } }
    unsigned tl = g0 < g1 ? g0 : g1; { const unsigned t2 = g2 < g3 ? g2 : g3; tl = tl < t2 ? tl : t2; }
#pragma unroll
    for (int o = 32; o > 0; o >>= 1) { const unsigned x = (unsigned)__shfl_xor((int)tl, o); tl = x < tl ? x : tl; }
    constexpr int CAP = 2048;
    LAS unsigned* candk = (LAS unsigned*)(F.ldsl + F.wid * (CAP * 8)); LAS unsigned* candi = candk + CAP;
    int C = 0;
#pragma unroll
    for (int c = 0; c < 8; ++c) if (c < nch) {
#pragma unroll
        for (int q = 0; q < 16; ++q) { const int rq = c * 16 + q; const bool pr = u[rq] >= tl; const unsigned long long mm = __ballot(pr);
            const int pos = C + __popcll(mm & ((1ull << lane) - 1ull));
            if (pr && pos < CAP) { candk[pos] = u[rq]; candi[pos] = (unsigned)((rq >> 2) * 256 + lane * 4 + (rq & 3)); }
            C += __popcll(mm); if ((q & 3) == 3) SBAR(); } }
    if (C <= CAP) {
        const int ng = (C + 255) >> 8;
        unsigned ck[32]; int ci[32];
#pragma unroll
        for (int g = 0; g < 8; ++g) {
#pragma unroll
            for (int q = 0; q < 4; ++q) { const int r = g * 4 + q, p = r * 64 + lane; ck[r] = 0u; ci[r] = 0;
                if (g < ng && p < C) { ck[r] = candk[p]; ci[r] = (int)candi[p]; } } }
        unsigned T = 0u, thr_gt = 0u; int need_eq = 0; bool early = false;
        for (int bit = 31; bit >= 0; --bit) {
            const unsigned cnd = T | (1u << bit); int cnt = 0;
#pragma unroll
            for (int g = 0; g < 8; ++g) if (g < ng) {
#pragma unroll
                for (int q = 0; q < 4; ++q) cnt += __popcll(__ballot(ck[g * 4 + q] >= cnd)); }
            if (cnt >= 256) { T = cnd; if (cnt == 256) { early = true; break; } }
        }
        if (early) { thr_gt = T - 1u; need_eq = 0; }
        else { int gtc = 0;
#pragma unroll
            for (int g = 0; g < 8; ++g) if (g < ng) {
#pragma unroll
                for (int q = 0; q < 4; ++q) gtc += __popcll(__ballot(ck[g * 4 + q] > T)); }
            thr_gt = T; need_eq = 256 - gtc; }
        int base = 0, eq_taken = 0;
#pragma unroll
        for (int g = 0; g < 8; ++g) if (g < ng) {
#pragma unroll
            for (int q = 0; q < 4; ++q) { const int r = g * 4 + q; const unsigned v = ck[r];
                const bool iseq = (v == thr_gt) && (need_eq > 0);
                const unsigned long long meq = __ballot(iseq);
                const int eqr = __popcll(meq & ((1ull << lane) - 1ull));
                const bool take = (v > thr_gt) || (iseq && (eq_taken + eqr < need_eq));
                const unsigned long long mt = __ballot(take);
                const int pos = base + __popcll(mt & ((1ull << lane) - 1ull));
                if (take && pos < 256) sel[pos] = ci[r];
                base += __popcll(mt); eq_taken += __popcll(meq); } }
        return;
    }
    asm volatile("" ::: "memory");
    TOPK_LOAD_ROW();
    unsigned T = 0u, thr_gt = 0u; int need_eq = 0; bool early = false;
    for (int bit = 31; bit >= 0; --bit) {
        const unsigned cand = T | (1u << bit); int cnt = 0;
#pragma unroll
        for (int c = 0; c < 8; ++c) if (c < nch) {
#pragma unroll
            for (int q = 0; q < 16; ++q) cnt += __popcll(__ballot(u[c * 16 + q] >= cand)); }
        if (cnt >= 256) { T = cand; if (cnt == 256) { early = true; break; } }
    }
    if (early) { thr_gt = T - 1u; need_eq = 0; }
    else { int gtc = 0;
#pragma unroll
        for (int c = 0; c < 8; ++c) if (c < nch) {
#pragma unroll
            for (int q = 0; q < 16; ++q) gtc += __popcll(__ballot(u[c * 16 + q] > T)); }
        thr_gt = T; need_eq = 256 - gtc; }
    int base = 0, eq_taken = 0;
#pragma unroll
    for (int c = 0; c < 8; ++c) if (c < nch) {
#pragma unroll
        for (int q = 0; q < 16; ++q) { const int rq = c * 16 + q; const unsigned v = u[rq];
            const bool iseq = (v == thr_gt) && (need_eq > 0);
            const unsigned long long meq = __ballot(iseq);
            const int eqr = __popcll(meq & ((1ull << lane) - 1ull));
            const bool take = (v > thr_gt) || (iseq && (eq_taken + eqr < need_eq));
            const unsigned long long mt = __ballot(take);
            const int pos = base + __popcll(mt & ((1ull << lane) - 1ull));
            if (take && pos < 256) sel[pos] = (rq >> 2) * 256 + lane * 4 + (rq & 3);
            base += __popcll(mt); eq_taken += __popcll(meq); } }
}
__device__ __forceinline__ void phase_topk(const Frame& F0) { const Frame F = fresh(F0);
    for (int q = F.bid * 8 + F.wid; q < 8192; q += F.G * 8) { const int b = q >> 12, p = q & 4095; topk_row(F, b, p); topk_row(F, b, SEQ - 1 - p); }
}

namespace att {
constexpr int D = 128, KVBLK = 64, QBLK = 32, SHM_V = 16384, SHM_K = 16384;
constexpr int OFF_K = 2 * SHM_V, OFF_BIAS = 2 * SHM_V + 2 * SHM_K, OFF_WS = OFF_BIAS + 512, OFF_FLAGS = OFF_WS + 2048, OFF_QITEM = OFF_FLAGS + 64;
constexpr float EXIT_T = 44.0f;
#define KSWZ(row, colB) ((row) * 256 + ((colB) ^ (((row) & 7) << 4)))
__device__ __forceinline__ int v_st(int k, int c) { const int kk = (k & ~0xC) | ((k & 4) << 1) | ((k & 8) >> 1); return ((kk >> 3) * 4 + (c >> 5)) * 512 + ((kk & 7) * 32 + (c & 31)) * 2; }
__device__ __forceinline__ int v_rd_base(int lane) { return ((lane & 3) << 3) | (((lane >> 2) & 3) << 6) | (((lane >> 4) & 1) << 5) | (((lane >> 5) & 1) << 8); }
constexpr int v_rd_off(int d0, int ks, int half) { return d0 * 512 + ks * 4096 + half * 2048; }
template <int KB>
__device__ __forceinline__ void qkt(f32x16& p0, f32x16& p1, const char* K_lds, int r32, int hi, const bf16x8* qr) {
    p0 = f32x16{}; p1 = f32x16{};
    const char* kb[4];
#pragma unroll
    for (int dd = 0; dd < 4; ++dd) kb[dd] = K_lds + KB * SHM_K + KSWZ(r32, (dd * 16 + hi * 8) * 2);
#pragma unroll
    for (int d0 = 0; d0 < 8; ++d0) { const char* a = kb[d0 & 3] + (d0 >> 2) * 128;
        bf16x8 b0 = *reinterpret_cast<const bf16x8*>(a);
        bf16x8 b1 = *reinterpret_cast<const bf16x8*>(a + 32 * 256);
        p0 = __builtin_amdgcn_mfma_f32_32x32x16_bf16(b0, qr[d0], p0, 0, 0, 0);
        p1 = __builtin_amdgcn_mfma_f32_32x32x16_bf16(b1, qr[d0], p1, 0, 0, 0); }
}
template <int VB>
__device__ __forceinline__ void pv_tile(f32x16* o, int vb0, bf16x8 pa0, bf16x8 pa1, bf16x8 pa2, bf16x8 pa3) {
#define TRRD(dst, off) asm volatile("ds_read_b64_tr_b16 %0, %1 offset:%2" : "=&v"(dst) : "v"(vb0), "i"(off) : "memory")
#define PV_D0(d0) do { s16x4 l0, l1, l2, l3, h0, h1, h2, h3; constexpr int b_ = VB * SHM_V + v_rd_off(d0, 0, 0); \
        TRRD(l0, b_); TRRD(h0, b_ + 2048); TRRD(l1, b_ + 4096); TRRD(h1, b_ + 6144); TRRD(l2, b_ + 8192); TRRD(h2, b_ + 10240); TRRD(l3, b_ + 12288); TRRD(h3, b_ + 14336); \
        asm volatile("s_waitcnt lgkmcnt(0)" ::: "memory"); SBAR(); \
        o[d0] = __builtin_amdgcn_mfma_f32_32x32x16_bf16(pa0, (bf16x8){l0[0], l0[1], l0[2], l0[3], h0[0], h0[1], h0[2], h0[3]}, o[d0], 0, 0, 0); \
        o[d0] = __builtin_amdgcn_mfma_f32_32x32x16_bf16(pa1, (bf16x8){l1[0], l1[1], l1[2], l1[3], h1[0], h1[1], h1[2], h1[3]}, o[d0], 0, 0, 0); \
        o[d0] = __builtin_amdgcn_mfma_f32_32x32x16_bf16(pa2, (bf16x8){l2[0], l2[1], l2[2], l2[3], h2[0], h2[1], h2[2], h2[3]}, o[d0], 0, 0, 0); \
        o[d0] = __builtin_amdgcn_mfma_f32_32x32x16_bf16(pa3, (bf16x8){l3[0], l3[1], l3[2], l3[3], h3[0], h3[1], h3[2], h3[3]}, o[d0], 0, 0, 0); } while (0)
    PV_D0(0); PV_D0(1); PV_D0(2); PV_D0(3);
#undef PV_D0
#undef TRRD
}
#define PK4(P, B_, OUT) do { unsigned a0 = cvtpk(P[B_+0], P[B_+1]), a1 = cvtpk(P[B_+2], P[B_+3]); \
        unsigned b0 = cvtpk(P[B_+4], P[B_+5]), b1 = cvtpk(P[B_+6], P[B_+7]); \
        auto r0 = __builtin_amdgcn_permlane32_swap(a0, b0, false, false); auto r1 = __builtin_amdgcn_permlane32_swap(a1, b1, false, false); \
        u32x4 w = {r0[0], r1[0], r0[1], r1[1]}; OUT = *reinterpret_cast<bf16x8*>(&w); } while (0)
__device__ __forceinline__ float swap_max(float x) { auto rr = __builtin_amdgcn_permlane32_swap(__float_as_uint(x), __float_as_uint(x), false, false); return fmaxf(__uint_as_float(rr[0]), __uint_as_float(rr[1])); }
__device__ __forceinline__ float swap_sum(float x) { auto rr = __builtin_amdgcn_permlane32_swap(__float_as_uint(x), __float_as_uint(x), false, false); return __uint_as_float(rr[0]) + __uint_as_float(rr[1]); }
__device__ __forceinline__ float swap_lo(float x) { auto rr = __builtin_amdgcn_permlane32_swap(__float_as_uint(x), __float_as_uint(x), false, false); return __uint_as_float(rr[0]); }


__device__ __forceinline__ void fox_sm(f32x16& p0, f32x16& p1, const float* bl, int kb_, int qlo, int qrow, int hi, int r32, float& m_reg, float& l_reg, f32x16* o, float* al_l,
                                       bf16x8& pa0, bf16x8& pa1, bf16x8& pa2, bf16x8& pa3) {
#pragma unroll
    for (int g = 0; g < 4; ++g) { const f32x4 b0v = *(const f32x4*)(bl + 8 * g + 4 * hi), b1v = *(const f32x4*)(bl + 32 + 8 * g + 4 * hi);
#pragma unroll
        for (int i = 0; i < 4; ++i) { p0[4 * g + i] = fmaf(p0[4 * g + i], C2, b0v[i]); p1[4 * g + i] = fmaf(p1[4 * g + i], C2, b1v[i]); } }
    if (kb_ + KVBLK - 1 > qlo) { const float NEG = -__builtin_inff();
#pragma unroll
        for (int r = 0; r < 16; ++r) { const int key = kb_ + crow(r, hi); if (key > qrow) p0[r] = NEG; if (key + 32 > qrow) p1[r] = NEG; } }
    float pmax = p0[0];
#pragma unroll
    for (int r = 1; r < 16; ++r) pmax = fmaxf(pmax, p0[r]);
#pragma unroll
    for (int r = 0; r < 16; ++r) pmax = fmaxf(pmax, p1[r]);
    pmax = swap_max(pmax);
    const float mn = fmaxf(m_reg, pmax), alpha = __builtin_amdgcn_exp2f(m_reg - mn); m_reg = mn;
    float ps = 0.f;
#pragma unroll
    for (int r = 0; r < 16; ++r) { p0[r] = __builtin_amdgcn_exp2f(p0[r] - mn); p1[r] = __builtin_amdgcn_exp2f(p1[r] - mn); ps += p0[r] + p1[r]; }
    ps = swap_sum(ps); l_reg = l_reg * alpha + ps;
    if (__any(alpha < 1.f)) { if (hi == 0) al_l[r32] = alpha; asm volatile("s_waitcnt lgkmcnt(0)" ::: "memory");
#pragma unroll
        for (int r = 0; r < 16; ++r) { const float a = al_l[crow(r, hi)];
#pragma unroll
            for (int d_ = 0; d_ < 4; ++d_) o[d_][r] *= a; } }
    PK4(p0, 0, pa0); PK4(p0, 8, pa1); PK4(p1, 0, pa2); PK4(p1, 8, pa3);
}
__device__ __forceinline__ void sb_half(f32x16& pz, int keybase, int qrow, int hi, float& R, const bf16x8* triA, bool needmask) {
    f32x16 X;
#pragma unroll
    for (int r = 0; r < 16; ++r) { const float zz = pz[r] * C2; const bool valid = !needmask || (keybase + crow(r, hi) < qrow);
        const float l2 = fmaxf(zz, 0.f) + __builtin_amdgcn_logf(1.0f + __builtin_amdgcn_exp2f(-fabsf(zz)));
        X[r] = valid ? -l2 : 0.f; pz[r] = valid ? zz : -__builtin_inff(); }
    f32x16 Y;
#pragma unroll
    for (int r = 0; r < 16; ++r) Y[r] = R;
#pragma unroll
    for (int s = 0; s < 2; ++s) {
        const unsigned h0 = cvtpk(X[8 * s + 0], X[8 * s + 1]), h1 = cvtpk(X[8 * s + 2], X[8 * s + 3]), h2 = cvtpk(X[8 * s + 4], X[8 * s + 5]), h3 = cvtpk(X[8 * s + 6], X[8 * s + 7]);
        const unsigned l0 = cvtpk(X[8 * s + 0] - bflo(h0), X[8 * s + 1] - bfhi(h0)), l1 = cvtpk(X[8 * s + 2] - bflo(h1), X[8 * s + 3] - bfhi(h1));
        const unsigned l2 = cvtpk(X[8 * s + 4] - bflo(h2), X[8 * s + 5] - bfhi(h2)), l3 = cvtpk(X[8 * s + 6] - bflo(h3), X[8 * s + 7] - bfhi(h3));
        u32x4 wh = {h0, h1, h2, h3}, wl = {l0, l1, l2, l3};
        Y = __builtin_amdgcn_mfma_f32_32x32x16_bf16(triA[s], *reinterpret_cast<bf16x8*>(&wh), Y, 0, 0, 0);
        Y = __builtin_amdgcn_mfma_f32_32x32x16_bf16(triA[s], *reinterpret_cast<bf16x8*>(&wl), Y, 0, 0, 0); }
#pragma unroll
    for (int r = 0; r < 16; ++r) pz[r] = __builtin_amdgcn_exp2f(pz[r] + Y[r]);
    R = swap_lo(Y[0]);
}
__device__ __forceinline__ void sb_sm(f32x16& p0, f32x16& p1, int kb_, int qlo, int qrow, int hi, float& R, const bf16x8* triA, bf16x8& pa0, bf16x8& pa1, bf16x8& pa2, bf16x8& pa3) {
    const bool needmask = (kb_ + KVBLK - 1 >= qlo);
    sb_half(p1, kb_ + 32, qrow, hi, R, triA, needmask);
    sb_half(p0, kb_, qrow, hi, R, triA, needmask);
    PK4(p0, 0, pa0); PK4(p0, 8, pa1); PK4(p1, 0, pa2); PK4(p1, 8, pa3);
}

template <int MODE>
__device__ __forceinline__ void attn_unit(const bf16_t* Q, const bf16_t* Kh, const bf16_t* Vh, const float* cum, bf16_t* O, int P0, char* lds, float kmaxc) {
    int tid = threadIdx.x; asm volatile("" : "+v"(tid));
    const int wid = __builtin_amdgcn_readfirstlane(tid >> 6), lane = tid & 63, r32 = lane & 31, hi = lane >> 5;
    const int NT = P0 / KVBLK + 4;
    char* V_lds = lds; char* K_lds = lds + OFF_K; float* bias_l = (float*)(lds + OFF_BIAS);
    float* wsl = (float*)(lds + OFF_WS) + wid * 64; float* li_l = wsl; float* al_l = wsl + 32;
    const int qlo = P0 + wid * QBLK, qrow = qlo + r32;
    bf16x8 qr[8];
#pragma unroll
    for (int d0 = 0; d0 < 8; ++d0) qr[d0] = *(const bf16x8*)(Q + (size_t)qrow * D + d0 * 16 + hi * 8);
    const int sr = tid >> 4, sc = (tid & 15) * 8, vst0 = v_st(sr, sc), vst1 = v_st(32 + sr, sc), kws = KSWZ(sr, sc * 2);
    const int vb0 = (int)(uintptr_t)V_lds + v_rd_base(lane);
    const float cumref = (MODE == 0) ? cum[P0] : 0.f;
    int* flg = (int*)(lds + OFF_FLAGS);
    float qn = 0.f;
    if (MODE == 0) { float ss = 0.f;
#pragma unroll
        for (int d0 = 0; d0 < 8; ++d0)
#pragma unroll
            for (int j = 0; j < 8; ++j) { const float x = bf2f((bf16_t)qr[d0][j]); ss = fmaf(x, x, ss); }
        ss = swap_sum(ss); qn = sqrtf(ss) * kmaxc * 1.001f; }
    float m_reg = -1e30f, l_reg = 0.f, R = 0.f; f32x16 o[4] = {};
    bf16x8 triA[2];
    if (MODE == 1) {
#pragma unroll
        for (int s = 0; s < 2; ++s)
#pragma unroll
            for (int j = 0; j < 8; ++j) { const int rho = 16 * s + 8 * (j >> 2) + 4 * hi + (j & 3); triA[s][j] = (rho >= r32) ? (short)0x3F80 : (short)0; }
    }
    bf16x8 st_k0, st_k1, st_v0, st_v1; float st_b = 0.f;
#define TILE_KB(t) ((NT - 1 - (t)) * KVBLK)
#define SLOAD(kb_) do { st_v0 = *(const bf16x8*)(Vh + (size_t)((kb_) + sr) * D + sc); st_v1 = *(const bf16x8*)(Vh + (size_t)((kb_) + 32 + sr) * D + sc); \
                        st_k0 = *(const bf16x8*)(Kh + (size_t)((kb_) + sr) * D + sc); st_k1 = *(const bf16x8*)(Kh + (size_t)((kb_) + 32 + sr) * D + sc); \
                        if (MODE == 0 && tid < 64) st_b = (cumref - cum[(kb_) + tid]) * LOG2E; } while (0)
#define SWRITE(bf) do { *(bf16x8*)(V_lds + (bf) * SHM_V + vst0) = st_v0; *(bf16x8*)(V_lds + (bf) * SHM_V + vst1) = st_v1; \
                        *(bf16x8*)(K_lds + (bf) * SHM_K + kws) = st_k0; *(bf16x8*)(K_lds + (bf) * SHM_K + kws + 32 * 256) = st_k1; \
                        if (MODE == 0 && tid < 64) bias_l[(bf) * 64 + tid] = st_b; } while (0)
    __syncthreads();
    SLOAD(TILE_KB(0)); SWRITE(0);
    __syncthreads();
    f32x16 p0, p1; bf16x8 pa0, pa1, pa2, pa3;
#define STEP(BUF, t) do { const int kb_ = TILE_KB(t); \
        if ((t) + 1 < NT) SLOAD(TILE_KB((t) + 1)); \
        SBAR(); qkt<BUF>(p0, p1, K_lds, r32, hi, qr); \
        if (MODE == 0) fox_sm(p0, p1, bias_l + (BUF) * 64, kb_, qlo, qrow, hi, r32, m_reg, l_reg, o, al_l, pa0, pa1, pa2, pa3); \
        else sb_sm(p0, p1, kb_, qlo, qrow, hi, R, triA, pa0, pa1, pa2, pa3); \
        SBAR(); pv_tile<BUF>(o, vb0, pa0, pa1, pa2, pa3); \
        if ((t) + 1 < NT) SWRITE((BUF) ^ 1); \
        __syncthreads(); } while (0)
    for (int t = 0; t < NT; t += 2) {
        STEP(0, t); STEP(1, t + 1);
        const int kbc = TILE_KB(t + 1); if (kbc == 0) break;
        bool done;
        if (MODE == 0) { const float edge = (cumref - cum[kbc - 1]) * LOG2E; done = (qn + edge - m_reg) < -EXIT_T; }
        else done = R < -EXIT_T;
        const int par = (t >> 1) & 1;
        if (lane == 0) flg[par * 8 + wid] = 0;
        const bool wdone = __all(done);
        if (lane == 0 && wdone) flg[par * 8 + wid] = 1;
        __syncthreads();
        int alld = 1;
#pragma unroll
        for (int w = 0; w < 8; ++w) alld &= flg[par * 8 + w];
        if (alld) break;
    }
    __syncthreads();
#undef STEP
#undef SLOAD
#undef SWRITE
#undef TILE_KB
    float rli[16];
    if (MODE == 0) { if (hi == 0) li_l[r32] = l_reg; asm volatile("s_waitcnt lgkmcnt(0)" ::: "memory");
#pragma unroll
        for (int r = 0; r < 16; ++r) rli[r] = __builtin_amdgcn_rcpf(li_l[crow(r, hi)]); }
    bf16_t* Ow = O + (size_t)(wid * QBLK) * 3072;
#pragma unroll
    for (int r = 0; r < 16; ++r) { const int orow = crow(r, hi);
#pragma unroll
        for (int d0 = 0; d0 < 4; ++d0) { const float v = (MODE == 0) ? o[d0][r] * rli[r] : o[d0][r];
            const float vn = __shfl_xor(v, 1);
            if ((r32 & 1) == 0) *(unsigned*)(Ow + (size_t)orow * 3072 + d0 * 32 + r32) = cvtpk(v, vn); } }
}
}

__device__ __forceinline__ void sparse_query(const Frame& F, int tok, char* ldsw) {
    unsigned char* ws = F.ws; const int lane = F.lane, g = lane >> 4, i16 = lane & 15;
    const bf16_t* qcat = (const bf16_t*)(ws + R_QCAT) + (size_t)tok * 2304; const bf16_t* kbase = (const bf16_t*)(ws + R_KCAT) + (size_t)(tok >> 13) * SEQ * 288;
    const int* sel = (const int*)(ws + R_SEL) + (size_t)tok * 256; const int ns = ((const int*)(ws + R_NSEL))[tok]; const int ntile = (ns + 31) >> 5;
    bf16x8 qf[9];
#pragma unroll
    for (int st = 0; st < 9; ++st) { qf[st] = (bf16x8){0, 0, 0, 0, 0, 0, 0, 0}; if (i16 < 8) qf[st] = *(const bf16x8*)(qcat + i16 * 288 + st * 32 + 8 * g); }
    const int rA = lane >> 2, cq = lane & 3;
    float m = -1e30f, l = 0.f; f32x4 oT[16];
#pragma unroll
    for (int rb = 0; rb < 16; ++rb) oT[rb] = (f32x4){0.f, 0.f, 0.f, 0.f};
    const unsigned ldso = (unsigned)(uintptr_t)ldsw;
    const unsigned vb = ldso + (unsigned)((4 * g + (i16 >> 2)) * 592 + (i16 & 3) * 8);
    constexpr float SC2 = SCALE * LOG2E;
    bf16x8 stg[18];
#define GATHER(tile_) do { const int j0 = (tile_) * 32 + rA, j1 = j0 + 16; const int s0 = j0 < ns ? sel[j0] : 0, s1 = j1 < ns ? sel[j1] : 0; \
        const bf16_t* p0_ = kbase + (size_t)s0 * 288 + cq * 8; const bf16_t* p1_ = kbase + (size_t)s1 * 288 + cq * 8; \
        _Pragma("unroll") for (int c = 0; c < 9; ++c) { stg[2 * c] = *(const bf16x8*)(p0_ + c * 32); stg[2 * c + 1] = *(const bf16x8*)(p1_ + c * 32); } } while (0)
    GATHER(0);
    for (int tile = 0; tile < ntile; ++tile) {
#pragma unroll
        for (int c = 0; c < 9; ++c) { *(bf16x8*)(ldsw + rA * 592 + c * 64 + cq * 16) = stg[2 * c]; *(bf16x8*)(ldsw + (16 + rA) * 592 + c * 64 + cq * 16) = stg[2 * c + 1]; }
        if (tile + 1 < ntile) GATHER(tile + 1);
        asm volatile("s_waitcnt lgkmcnt(0)" ::: "memory"); SBAR();
        f32x4 acc[2];
#pragma unroll
        for (int mt = 0; mt < 2; ++mt) { acc[mt] = (f32x4){0.f, 0.f, 0.f, 0.f};
#pragma unroll
            for (int st = 0; st < 9; ++st) { const bf16x8 a = *(const bf16x8*)(ldsw + (16 * mt + i16) * 592 + st * 64 + g * 16);
                acc[mt] = __builtin_amdgcn_mfma_f32_16x16x32_bf16(a, qf[st], acc[mt], 0, 0, 0); } }
        float tmax = -__builtin_inff();
#pragma unroll
        for (int mt = 0; mt < 2; ++mt)
#pragma unroll
            for (int r = 0; r < 4; ++r) { const int key = tile * 32 + 16 * mt + 4 * g + r; float x = acc[mt][r] * SC2; if (key >= ns) x = -__builtin_inff(); acc[mt][r] = x; tmax = fmaxf(tmax, x); }
        tmax = fmaxf(tmax, __shfl_xor(tmax, 16)); tmax = fmaxf(tmax, __shfl_xor(tmax, 32));
        const float mn = fmaxf(m, tmax), alpha = __builtin_amdgcn_exp2f(m - mn); m = mn;
        float ps = 0.f;
#pragma unroll
        for (int mt = 0; mt < 2; ++mt)
#pragma unroll
            for (int r = 0; r < 4; ++r) { acc[mt][r] = __builtin_amdgcn_exp2f(acc[mt][r] - mn); ps += acc[mt][r]; }
        ps += __shfl_xor(ps, 16); ps += __shfl_xor(ps, 32);
        l = l * alpha + ps;
#pragma unroll
        for (int rb = 0; rb < 16; ++rb) oT[rb] *= alpha;
        const bf16x8 pf = pack8(acc[0], acc[1]);
#define TRRD2(dst, off) asm volatile("ds_read_b64_tr_b16 %0, %1 offset:%2" : "=&v"(dst) : "v"(vb), "i"(off) : "memory")
#define PVRB(rb) do { s16x4 t1, t2; TRRD2(t1, (rb) * 32); TRRD2(t2, (rb) * 32 + 16 * 592); asm volatile("s_waitcnt lgkmcnt(0)" ::: "memory"); SBAR(); \
        oT[rb] = __builtin_amdgcn_mfma_f32_16x16x32_bf16((bf16x8){t1[0], t1[1], t1[2], t1[3], t2[0], t2[1], t2[2], t2[3]}, pf, oT[rb], 0, 0, 0); } while (0)
        PVRB(0); PVRB(1); PVRB(2); PVRB(3); PVRB(4); PVRB(5); PVRB(6); PVRB(7); PVRB(8); PVRB(9); PVRB(10); PVRB(11); PVRB(12); PVRB(13); PVRB(14); PVRB(15);
#undef PVRB
#undef TRRD2
        SBAR();
    }
#undef GATHER
    const float rl = 1.0f / l;
    if (i16 < 8) { bf16_t* op = (bf16_t*)(ws + R_OLAT) + (size_t)tok * 2048 + i16 * 256 + 4 * g;
#pragma unroll
        for (int rb = 0; rb < 16; ++rb) { u32x2 w; w.x = cvtpk(oT[rb][0] * rl, oT[rb][1] * rl); w.y = cvtpk(oT[rb][2] * rl, oT[rb][3] * rl); *(u32x2*)(op + rb * 16) = w; } }
}
#ifdef ATT_SUB
#define ASUB(k) ((k) == ATT_SUB)
#else
#define ASUB(k) true
#endif
__device__ __forceinline__ void phase_attn(const Frame& F0, int l, int rep) { const Frame F = fresh(F0);
    unsigned char* ws = F.ws; char* lds = (char*)F.lds;
    const bf16_t* qkv = (const bf16_t*)(ws + R_QKV); const size_t TS = (size_t)NTOK * 1024;
    unsigned* qctr = (unsigned*)(ws + WS_CTL) + CW_QCTR + l * 64 + rep * 16; const unsigned* kmx = (const unsigned*)(ws + WS_CTL) + CW_KMAX + l * 16;
    int* qitem = (int*)(lds + att::OFF_QITEM);
#pragma unroll 1
    for (;;) {
        __syncthreads();
        if (F.tid == 0) qitem[0] = (int)atomicAdd(qctr, 1u);
        __syncthreads();
        const int it = qitem[0];
        if (it >= 1024) break;
        const int md = it >> 9, j = it & 511, qb = 31 - (j >> 4), bh = j & 15, b = bh >> 3, h = bh & 7, P0 = qb * 256;
        if (!ASUB(md)) continue;
        const bf16_t* Q = qkv + (size_t)(md * 3 + 0) * TS + (size_t)bh * SEQ * 128; const bf16_t* K = qkv + (size_t)(md * 3 + 1) * TS + (size_t)bh * SEQ * 128; const bf16_t* V = qkv + (size_t)(md * 3 + 2) * TS + (size_t)bh * SEQ * 128;
        const float* cum = (const float*)(ws + WS_CUM) + (size_t)bh * SEQ;
        bf16_t* Ob = (bf16_t*)(ws + R_OA) + (size_t)b * SEQ * 3072 + (md + 1) * 1024 + h * 128;
        if (md == 0) { const float kmaxc = sqrtf(__uint_as_float(kmx[bh])) * C2; att::attn_unit<0>(Q, K, V, cum, Ob + (size_t)P0 * 3072, P0, lds, kmaxc); }
        else att::attn_unit<1>(Q, K, V, cum, Ob + (size_t)P0 * 3072, P0, lds, 0.f);
    }
    __syncthreads();
    char* ldsw = lds + F.wid * 18944;
#pragma unroll 1
    for (int rep = 0; rep < NREP(2); ++rep)
#pragma unroll 1
    for (int tok = F.bid * 8 + F.wid; tok < NTOK; tok += F.G * 8) if (ASUB(2)) sparse_query(F, tok, ldsw);
}

__device__ __forceinline__ void ln_row(const bf16_t* src, const float* g, const float* bta, float* of, bf16_t* ob, int lane, unsigned char* oq = nullptr, float* osc = nullptr) {
    f32x4 v[8]; float s = 0.f;
#pragma unroll
    for (int i = 0; i < 4; ++i) { const u32x4 w = *(const u32x4*)(src + (i * 64 + lane) * 8);
        v[2 * i] = (f32x4){bflo(w.x), bfhi(w.x), bflo(w.y), bfhi(w.y)}; v[2 * i + 1] = (f32x4){bflo(w.z), bfhi(w.z), bflo(w.w), bfhi(w.w)};
        s += (v[2 * i][0] + v[2 * i][1]) + (v[2 * i][2] + v[2 * i][3]) + (v[2 * i + 1][0] + v[2 * i + 1][1]) + (v[2 * i + 1][2] + v[2 * i + 1][3]); }
    s = wave_sum(s); const float mu = s * (1.0f / 2048.0f); float q = 0.f;
#pragma unroll
    for (int i = 0; i < 8; ++i) { const f32x4 d = v[i] - mu; q += (d[0] * d[0] + d[1] * d[1]) + (d[2] * d[2] + d[3] * d[3]); }
    q = wave_sum(q); const float rstd = rsqrtf(q * (1.0f / 2048.0f) + 1e-5f);
    float amax = 0.f;
#pragma unroll
    for (int i = 0; i < 4; ++i) { const int c = (i * 64 + lane) * 8; const f32x4 g0 = *(const f32x4*)(g + c), g1 = *(const f32x4*)(g + c + 4), b0 = *(const f32x4*)(bta + c), b1 = *(const f32x4*)(bta + c + 4);
        const f32x4 y0 = (v[2 * i] - mu) * rstd * g0 + b0, y1 = (v[2 * i + 1] - mu) * rstd * g1 + b1; v[2 * i] = y0; v[2 * i + 1] = y1;
        if (of) { *(f32x4*)(of + c) = y0; *(f32x4*)(of + c + 4) = y1; }
        if (ob) pg8::st_bf16x8(ob + c, y0, y1);
        if (oq) { amax = fmaxf(amax, fmaxf(fmaxf(fmaxf(fabsf(y0[0]), fabsf(y0[1])), fmaxf(fabsf(y0[2]), fabsf(y0[3]))), fmaxf(fmaxf(fabsf(y1[0]), fabsf(y1[1])), fmaxf(fabsf(y1[2]), fabsf(y1[3]))))); } }
    if (oq) {
        for (int o = 32; o > 0; o >>= 1) amax = fmaxf(amax, __shfl_xor(amax, o));
        amax = fmaxf(amax, 1e-20f); const float qi = 127.0f / amax; if (lane == 0) *osc = amax * (1.0f / 127.0f);
#pragma unroll
        for (int i = 0; i < 4; ++i) { u32x2 w;
#pragma unroll
            for (int h = 0; h < 2; ++h) { const f32x4 y = v[2 * i + h]; unsigned pk = 0u;
#pragma unroll
                for (int j = 0; j < 4; ++j) pk |= ((unsigned)(int)rintf(y[j] * qi) & 0xffu) << (8 * j);
                w[h] = pk; }
            *(u32x2*)(oq + (i * 64 + lane) * 8) = w; } }
}
__device__ __forceinline__ void phase_ln1_router(const Frame& F0, const Params& P, int l) { const Frame F = fresh(F0);
    unsigned char* ws = F.ws; const int lane = F.lane, wid = F.wid;
    const bf16_t* pre1 = (const bf16_t*)(ws + R_PRE1); float* x1f = (float*)(ws + M_X1F); bf16_t* x1b = (bf16_t*)(ws + M_X1B); unsigned char* x1q = (unsigned char*)(ws + M_X1Q); float* x1s = (float*)(ws + M_X1S);
    const float* g = F.in(11) + l * DM; const float* bt = F.in(12) + l * DM; const float* wr = F.in(13) + (size_t)l * DM * NEXP; const float* br = F.in(14) + l * NEXP;
    unsigned* cnt = (unsigned*)(ws + WS_CTL) + CW_CNT + l * 2048;
    int* tok_e = (int*)(ws + M_TOKE); int* tok_pos = (int*)(ws + M_TOKPOS); float* tok_w = (float*)(ws + M_TOKW);
    float* red = (float*)F.lds;
    float* lg = (float*)(F.lds + 32768);
#pragma unroll 1
    for (int blk = F.bid; blk < NTOK / 64; blk += F.G) {
        const int tok0 = blk * 64;
#pragma unroll 1
        for (int i = 0; i < 8; ++i) { const int tok = tok0 + wid * 8 + i; ln_row(pre1 + (size_t)tok * DM, g, bt, x1f + (size_t)tok * DM, x1b + (size_t)tok * DM, lane, x1q + (size_t)tok * DM, x1s + tok); }
        asm volatile("s_waitcnt vmcnt(0)" ::: "memory"); __syncthreads();
        { const int grp = wid >> 2, kq = wid & 3, i32 = lane & 31, hk = lane >> 5; f32x16 acc = {};
          const float* arow = x1f + (size_t)(tok0 + grp * 32 + i32) * DM + kq * 512 + 4 * hk; const float* bcol = wr + (size_t)(kq * 512 + 4 * hk) * NEXP + i32;
#pragma unroll 4
          for (int c8 = 0; c8 < 64; ++c8) { const f32x4 a4 = *(const f32x4*)(arow + c8 * 8);
              const float b0 = bcol[(size_t)(c8 * 8 + 0) * NEXP], b1 = bcol[(size_t)(c8 * 8 + 1) * NEXP], b2 = bcol[(size_t)(c8 * 8 + 2) * NEXP], b3 = bcol[(size_t)(c8 * 8 + 3) * NEXP];
              acc = __builtin_amdgcn_mfma_f32_32x32x2f32(a4[0], b0, acc, 0, 0, 0); acc = __builtin_amdgcn_mfma_f32_32x32x2f32(a4[1], b1, acc, 0, 0, 0);
              acc = __builtin_amdgcn_mfma_f32_32x32x2f32(a4[2], b2, acc, 0, 0, 0); acc = __builtin_amdgcn_mfma_f32_32x32x2f32(a4[3], b3, acc, 0, 0, 0); }
#pragma unroll
          for (int r = 0; r < 16; ++r) red[(wid * 16 + r) * 64 + lane] = acc[r]; }
        __syncthreads();
        if ((wid & 3) == 0) { const int grp = wid >> 2, hk = lane >> 5, e = lane & 31; const float be = br[e];
#pragma unroll
            for (int r = 0; r < 16; ++r) { const float v = red[((wid + 0) * 16 + r) * 64 + lane] + red[((wid + 1) * 16 + r) * 64 + lane] + red[((wid + 2) * 16 + r) * 64 + lane] + red[((wid + 3) * 16 + r) * 64 + lane] + be;
                lg[(grp * 32 + crow(r, hk)) * 33 + e] = v; }
            asm volatile("s_waitcnt lgkmcnt(0)" ::: "memory"); SBAR();
            const int tk = lane & 31; float v[32];
#pragma unroll
            for (int e2 = 0; e2 < 32; ++e2) v[e2] = lg[(grp * 32 + tk) * 33 + e2];
            int ek[4]; float vk[4];
#pragma unroll
            for (int k = 0; k < 4; ++k) { float best = -__builtin_inff(); int bi = 0;
#pragma unroll
                for (int e2 = 0; e2 < 32; ++e2) if (v[e2] > best) { best = v[e2]; bi = e2; }
                ek[k] = bi; vk[k] = best;
#pragma unroll
                for (int e2 = 0; e2 < 32; ++e2) v[e2] = (e2 == bi) ? -__builtin_inff() : v[e2]; }
            float wk[4], sw = 0.f;
#pragma unroll
            for (int k = 0; k < 4; ++k) { wk[k] = __expf(vk[k] - vk[0]); sw += wk[k]; }
            const float rs = 1.0f / sw;
            const bool act = lane < 32; unsigned myc = 0u;
#pragma unroll 1
            for (int E = 0; E < 32; ++E) { unsigned c = 0u;
#pragma unroll
                for (int k = 0; k < 4; ++k) c += (unsigned)__popcll(__ballot(act && ek[k] == E));
                if (lane == E) myc = c; }
            unsigned run = 0u; if (lane < 32 && myc > 0u) run = atomicAdd(&cnt[lane * 64], myc);
            int pk[4];
#pragma unroll
            for (int k = 0; k < 4; ++k) { pk[k] = 0;
#pragma unroll 1
                for (int E = 0; E < 32; ++E) { const unsigned long long mm = __ballot(act && ek[k] == E); const unsigned basev = (unsigned)__shfl((int)run, E);
                    if (act && ek[k] == E) pk[k] = (int)(basev + (unsigned)__popcll(mm & ((1ull << lane) - 1ull)));
                    if (lane == E) run += (unsigned)__popcll(mm); } }
            if (act) { const int tok = tok0 + grp * 32 + tk;
#pragma unroll
                for (int k = 0; k < 4; ++k) { tok_e[tok * 4 + k] = ek[k]; tok_pos[tok * 4 + k] = pk[k]; tok_w[tok * 4 + k] = wk[k] * rs; } }
        }
        __syncthreads();
    }
}
__device__ __forceinline__ void phase_moe_gather(const Frame& F0, int l) { const Frame F = fresh(F0);
    unsigned char* ws = F.ws; const int lane = F.lane;
    const unsigned* cnt = (const unsigned*)(ws + WS_CTL) + CW_CNT + l * 2048; unsigned* meta = (unsigned*)(ws + WS_CTL) + CW_META + l * 512;
    unsigned* offs = (unsigned*)(F.lds + LDS_MISC + 64);
    if (F.tid == 0) { unsigned o = 0u; for (int e = 0; e < 32; ++e) { offs[e] = o; o += (cnt[e * 64] + 255u) & ~255u; } offs[32] = o;
        if (F.bid == 0) { meta[0] = o >> 8; for (int e = 0; e < 32; ++e) for (unsigned t = offs[e] >> 8; t < (offs[e + 1] >> 8); ++t) meta[1 + t] = (unsigned)e; } }
    __syncthreads();
    const int* tok_e = (const int*)(ws + M_TOKE); const int* tok_pos = (const int*)(ws + M_TOKPOS); const float* tok_w = (const float*)(ws + M_TOKW);
    int* tok_dst = (int*)(ws + M_TOKDST); float* roww = (float*)(ws + M_ROWW);
    const unsigned char* x1q = (const unsigned char*)(ws + M_X1Q); const float* x1s = (const float*)(ws + M_X1S); unsigned char* xs = (unsigned char*)(ws + M_XS); float* rowsx = (float*)(ws + M_ROWSX);
    for (int it = F.bid * 8 + F.wid; it < NTOK * 4; it += F.G * 8) { const int tok = it >> 2;
        const int e = tok_e[it]; const unsigned dst = offs[e] + (unsigned)tok_pos[it];
        if (lane == 0) { tok_dst[it] = (int)dst; roww[dst] = tok_w[it]; rowsx[dst] = x1s[tok]; }
        const u32x4* sp = (const u32x4*)(x1q + (size_t)tok * DM); u32x4* dp = (u32x4*)(xs + (size_t)dst * DM);
#pragma unroll
        for (int i = 0; i < 2; ++i) dp[i * 64 + lane] = sp[i * 64 + lane]; }
    __syncthreads();
}
__device__ __forceinline__ void phase_combine(const Frame& F0) { const Frame F = fresh(F0);
    unsigned char* ws = F.ws; const int lane = F.lane;
    const bf16_t* x1b = (const bf16_t*)(ws + M_X1B); const bf16_t* ys = (const bf16_t*)(ws + M_XS); const int* tok_dst = (const int*)(ws + M_TOKDST);
    bf16_t* hb = (bf16_t*)(ws + M_HB); unsigned char* hq = (unsigned char*)(ws + M_HQ); float* hsc = (float*)(ws + M_HSC);
    for (int tok = F.bid * 8 + F.wid; tok < NTOK; tok += F.G * 8) {
        const int d0 = tok_dst[tok * 4], d1 = tok_dst[tok * 4 + 1], d2 = tok_dst[tok * 4 + 2], d3 = tok_dst[tok * 4 + 3];
        f32x4 hv[8]; float amax = 0.f;
#pragma unroll
        for (int i = 0; i < 4; ++i) { const int c = (i * 64 + lane) * 8; const size_t o = (size_t)tok * DM + c;
            const u32x4 xw = *(const u32x4*)(x1b + o);
            f32x4 a = (f32x4){bflo(xw.x), bfhi(xw.x), bflo(xw.y), bfhi(xw.y)} * ALPHA, b = (f32x4){bflo(xw.z), bfhi(xw.z), bflo(xw.w), bfhi(xw.w)} * ALPHA;
            const u32x4 y0 = *(const u32x4*)(ys + (size_t)d0 * DM + c), y1 = *(const u32x4*)(ys + (size_t)d1 * DM + c), y2 = *(const u32x4*)(ys + (size_t)d2 * DM + c), y3 = *(const u32x4*)(ys + (size_t)d3 * DM + c);
            a[0] += (bflo(y0.x) + bflo(y1.x)) + (bflo(y2.x) + bflo(y3.x)); a[1] += (bfhi(y0.x) + bfhi(y1.x)) + (bfhi(y2.x) + bfhi(y3.x));
            a[2] += (bflo(y0.y) + bflo(y1.y)) + (bflo(y2.y) + bflo(y3.y)); a[3] += (bfhi(y0.y) + bfhi(y1.y)) + (bfhi(y2.y) + bfhi(y3.y));
            b[0] += (bflo(y0.z) + bflo(y1.z)) + (bflo(y2.z) + bflo(y3.z)); b[1] += (bfhi(y0.z) + bfhi(y1.z)) + (bfhi(y2.z) + bfhi(y3.z));
            b[2] += (bflo(y0.w) + bflo(y1.w)) + (bflo(y2.w) + bflo(y3.w)); b[3] += (bfhi(y0.w) + bfhi(y1.w)) + (bfhi(y2.w) + bfhi(y3.w));
            pg8::st_bf16x8(hb + o, a, b); hv[2 * i] = a; hv[2 * i + 1] = b;
#pragma unroll
            for (int j = 0; j < 4; ++j) amax = fmaxf(amax, fmaxf(fabsf(a[j]), fabsf(b[j]))); }
        for (int o = 32; o > 0; o >>= 1) amax = fmaxf(amax, __shfl_xor(amax, o));
        amax = fmaxf(amax, 1e-20f); const float qi = 127.0f / amax; if (lane == 0) hsc[tok] = amax * (1.0f / 127.0f);
#pragma unroll
        for (int i = 0; i < 4; ++i) { u32x2 w;
#pragma unroll
            for (int h = 0; h < 2; ++h) { unsigned pk = 0u;
#pragma unroll
                for (int j = 0; j < 4; ++j) pk |= ((unsigned)(int)rintf(hv[2 * i + h][j] * qi) & 0xffu) << (8 * j);
                w[h] = pk; }
            *(u32x2*)(hq + (size_t)tok * DM + (i * 64 + lane) * 8) = w; } }
}
__device__ __forceinline__ void phase_ln2(const Frame& F0, const Params& P, int l) { const Frame F = fresh(F0);
    unsigned char* ws = F.ws; const bf16_t* pre2 = (const bf16_t*)(ws + M_X1F); bf16_t* xb = (bf16_t*)(ws + WS_XB);
    const float* g = F.in(23) + l * DM; const float* bt = F.in(24) + l * DM; float* outp = F.out();
    for (int tok = F.bid * 8 + F.wid; tok < NTOK; tok += F.G * 8) ln_row(pre2 + (size_t)tok * DM, g, bt, (l + 1 == NLAYER) ? outp + (size_t)tok * DM : (float*)nullptr, (l + 1 == NLAYER) ? (bf16_t*)nullptr : xb + (size_t)tok * DM, F.lane,
                                                                          (l + 1 == NLAYER) ? (unsigned char*)nullptr : (unsigned char*)(ws + WS_XQ) + (size_t)tok * DM, (l + 1 == NLAYER) ? (float*)nullptr : (float*)(ws + WS_XSC) + tok);
}

constexpr int NPHASE = 2 + 15 * NLAYER;
#ifdef PH_ONLY
#define PEN(kind) ((kind) == PH_ONLY)
#else
#define PEN(kind) true
#endif
#define IN(k) (lo <= (k) && (k) < hi)
#define SEAM(k) do { if (IN((k) + 1)) xcd_barrier(bar); } while (0)

template <int l>
__device__ __forceinline__ void layer_phases(const Frame& F, const Params& P, const XcdBarrier& bar, const int lo, const int hi, unsigned char* ws0) {
    using namespace pg8;

        const int pb = 2 + 15 * l;
        if (IN(pb + 0) && PEN(0)) { size_t wz = 0; asm volatile("" : "+s"(wz)); unsigned char* ws = ws0 + wz;
            { SchedS S; S.init(NTOK, 5 * 256, F.G, F.bid, (const bf16_t*)(ws + WS_XB), DM, (const bf16_t*)(ws + W_IN), DM); S.skip_from = 0; S.skip_by = 4; S.skip_from2 = 4; S.skip_by2 = 49;
              EpiInProj<false> E{(bf16_t*)(ws + R_QA), (bf16_t*)(ws + R_QIDX), (bf16_t*)(ws + R_QKV), (bf16_t*)(ws + R_GATES), (float*)(ws + R_SMALL), nullptr, nullptr};
              for (int rep = 0; rep < NREP(5); ++rep) gemm_phase(F.ldsl, DM, DM, DM, S, E); }
            { SchedS S; S.init(NTOK, 53 * 256, F.G, (F.bid + F.G / 2) % F.G, (const bf16_t*)(ws + WS_XQ), DM / 2, (const bf16_t*)(ws + W_IN8), DM / 2); S.skip_from = 4; S.skip_by = 4; S.b_compact = 1;
              EpiInProj<true> E{(bf16_t*)(ws + R_QA), (bf16_t*)(ws + R_QIDX), (bf16_t*)(ws + R_QKV), (bf16_t*)(ws + R_GATES), (float*)(ws + R_SMALL), (const float*)(ws + WS_XSC), (const unsigned*)(ws + WS_CTL) + CW_WMAXG + l};
              for (int rep = 0; rep < NREP(5); ++rep) gemm_phase(F.ldsl, DM / 2, DM / 2, DM / 2, S, E); }
            SEAM(pb + 0); }
        if (IN(pb + 1) && PEN(1)) { size_t wz = 0; asm volatile("" : "+s"(wz)); unsigned char* ws = ws0 + wz;
            phase_prep(F, P, l);
            SchedS S; S.init(NTOK, 2048, F.G, F.bid, (const bf16_t*)(ws + R_QA), 1024, (const bf16_t*)(ws + W_UK2), 256, 1, 256);
            EpiBf16 E{(bf16_t*)(ws + R_QCAT), 2304, 288};
            for (int rep = 0; rep < NREP(10); ++rep) gemm_phase(F.ldsl, 256, 1024, 256, S, E); SEAM(pb + 1); }
        if (IN(pb + 2) && PEN(2)) { size_t wz = 0; asm volatile("" : "+s"(wz)); unsigned char* ws = ws0 + wz; phase_cumsum(F); for (int rep = 0; rep < NREP(3); ++rep) phase_idx(F); SEAM(pb + 2); }
        if (IN(pb + 3) && PEN(3)) { size_t wz = 0; asm volatile("" : "+s"(wz)); unsigned char* ws = ws0 + wz; for (int rep = 0; rep < NREP(4); ++rep) phase_topk(F); SEAM(pb + 3); }
        if (IN(pb + 4) && PEN(4)) { size_t wz = 0; asm volatile("" : "+s"(wz)); unsigned char* ws = ws0 + wz; for (int rep = 0; rep < NREP(1); ++rep) phase_attn(F, l, rep); SEAM(pb + 4); }
        if (IN(pb + 5) && PEN(5)) { size_t wz = 0; asm volatile("" : "+s"(wz)); unsigned char* ws = ws0 + wz;
            SchedS S; S.init(NTOK, 1024, F.G, F.bid, (const bf16_t*)(ws + R_OLAT), 2048, (const bf16_t*)(ws + W_UV2), 512, 0, 512);
            EpiBf16 E{(bf16_t*)(ws + R_OA), 3072, 256}; for (int rep = 0; rep < NREP(10); ++rep) gemm_phase(F.ldsl, 512, 2048, 512, S, E);
            SEAM(pb + 5); }
        if (IN(pb + 6) && PEN(6)) { size_t wz = 0; asm volatile("" : "+s"(wz)); unsigned char* ws = ws0 + wz;
            SchedS S; S.init(NTOK, 2048, F.G, F.bid, (const bf16_t*)(ws + R_OA), 3072, (const bf16_t*)(ws + W_BRA), 3072);
            EpiBranch3 E{(const bf16_t*)(ws + R_GATES), (bf16_t*)(ws + R_MERGED)}; for (int rep = 0; rep < NREP(11); ++rep) gemm_phase(F.ldsl, 3072, 3072, 3072, S, E); SEAM(pb + 6); }
        if (IN(pb + 7) && PEN(7)) { size_t wz = 0; asm volatile("" : "+s"(wz)); unsigned char* ws = ws0 + wz;
            SchedS S; S.init(NTOK, 2048, F.G, F.bid, (const bf16_t*)(ws + R_MERGED), DM, (const bf16_t*)(ws + W_OUT), DM);
            EpiOut E{(const bf16_t*)(ws + WS_XB), (bf16_t*)(ws + R_PRE1)}; for (int rep = 0; rep < NREP(8); ++rep) gemm_phase(F.ldsl, DM, DM, DM, S, E); SEAM(pb + 7); }
        if (IN(pb + 8) && PEN(8)) { size_t wz = 0; asm volatile("" : "+s"(wz)); unsigned char* ws = ws0 + wz; phase_ln1_router(F, P, l); SEAM(pb + 8); }
        if (IN(pb + 9) && PEN(9)) { size_t wz = 0; asm volatile("" : "+s"(wz)); unsigned char* ws = ws0 + wz;
            for (int rep = 0; rep < NREP(12); ++rep) phase_moe_gather(F, l);
            SchedS S; S.init(NTOK, 2048, F.G, F.bid, (const bf16_t*)(ws + WS_PB) + (size_t)l * NTOK * 256, 256, (const bf16_t*)(ws + W_PLE), 256);
            EpiBf16 E{(bf16_t*)(ws + M_PP), 2048, 256}; for (int rep = 0; rep < NREP(10); ++rep) gemm_phase(F.ldsl, 256, 256, 256, S, E); SEAM(pb + 9); }
        if (IN(pb + 10) && PEN(10)) { size_t wz = 0; asm volatile("" : "+s"(wz)); unsigned char* ws = ws0 + wz;
            SchedM S; S.init((const unsigned*)(ws + WS_CTL) + CW_META + l * 512, F.G, F.bid, (const bf16_t*)(ws + M_XS), DM / 2, (const bf16_t*)(ws + W_GU), DM / 2);
            EpiGateUpI8 E{F.in(16) + (size_t)l * NEXP * DEXP, F.in(18) + (size_t)l * NEXP * DEXP, (bf16_t*)(ws + M_HID), (const float*)(ws + M_ROWSX), (const unsigned*)(ws + WS_CTL) + CW_WMAX + l};
            for (int rep = 0; rep < NREP(6); ++rep) gemm_phase(F.ldsl, DM / 2, DM / 2, DM / 2, S, E); SEAM(pb + 10); }
        if (IN(pb + 11) && PEN(11)) { size_t wz = 0; asm volatile("" : "+s"(wz)); unsigned char* ws = ws0 + wz;
            SchedM S; S.init((const unsigned*)(ws + WS_CTL) + CW_META + l * 512, F.G, F.bid, (const bf16_t*)(ws + M_HID), DEXP, (const bf16_t*)(ws + W_DN), DEXP);
            EpiDown E{F.in(20) + (size_t)l * NEXP * DM, (const float*)(ws + M_ROWW), (bf16_t*)(ws + M_XS)}; for (int rep = 0; rep < NREP(7); ++rep) gemm_phase(F.ldsl, DEXP, DEXP, DEXP, S, E); SEAM(pb + 11); }
        if (IN(pb + 12) && PEN(12)) { size_t wz = 0; asm volatile("" : "+s"(wz)); unsigned char* ws = ws0 + wz; for (int rep = 0; rep < NREP(9); ++rep) phase_combine(F); SEAM(pb + 12); }
        if (IN(pb + 13) && PEN(13)) { size_t wz = 0; asm volatile("" : "+s"(wz)); unsigned char* ws = ws0 + wz;
            SchedS S; S.init(NTOK, 2048, F.G, F.bid, (const bf16_t*)(ws + M_HQ), DM / 2, (const bf16_t*)(ws + W_PG), DM / 2);
            EpiPleGateI8 E{(const bf16_t*)(ws + M_HB), (const bf16_t*)(ws + M_PP), (bf16_t*)(ws + M_X1F), (const float*)(ws + M_HSC), (const unsigned*)(ws + WS_CTL) + CW_WMAXP + l};
            for (int rep = 0; rep < NREP(8); ++rep) gemm_phase(F.ldsl, DM / 2, DM / 2, DM / 2, S, E); SEAM(pb + 13); }
        if (IN(pb + 14) && PEN(14)) { size_t wz = 0; asm volatile("" : "+s"(wz)); unsigned char* ws = ws0 + wz; for (int rep = 0; rep < NREP(13); ++rep) phase_ln2(F, P, l); if (l + 1 < NLAYER) for (int rep = 0; rep < NREP(0); ++rep) convert_layer_weights(F, P, l + 1); SEAM(pb + 14); }
}
__global__ void __launch_bounds__(512, 2) fwd(Params P) {
    extern __shared__ __attribute__((aligned(16))) unsigned char lds[];
    Frame F; F.lds = lds; F.ldsl = (LAS unsigned char*)lds; F.ws = P.ws; F.tid = threadIdx.x; F.lane = F.tid & 63; F.wid = __builtin_amdgcn_readfirstlane(F.tid >> 6); F.G = gridDim.x; F.bid = blockIdx.x;
    unsigned char* ws0 = P.ws; unsigned char* ws = ws0;
    const bool fused = (P.ph_hi - P.ph_lo) > 1;
    if (F.tid < 4) ((LAS unsigned*)(F.ldsl + LDS_MISC))[F.tid] = 0u;
    if (F.tid == 0) { LAS unsigned long long* t = (LAS unsigned long long*)(F.ldsl + LDS_PTRS);
#pragma unroll
        for (int k = 0; k < 25; ++k) t[k] = (unsigned long long)P.in[k];
        t[25] = (unsigned long long)P.out; }
    __syncthreads();
    XcdBarrier bar; bar.bar = (unsigned*)(ws + WS_CTL) + CW_BAR; bar.x = 0; bar.st = (volatile LAS unsigned*)(F.ldsl + LDS_MISC);
    if (fused) bar = xcd_barrier_post((unsigned*)(ws + WS_CTL) + CW_BAR, (volatile LAS unsigned*)(F.ldsl + LDS_MISC));
    const int lo = P.ph_lo, hi = P.ph_hi;
    using namespace pg8;
    if (IN(0) && PEN(15)) { size_t wz = 0; asm volatile("" : "+s"(wz)); unsigned char* ws = ws0 + wz;
        quant_rows(F, F.in(0), (bf16_t*)(ws + WS_XB), (unsigned char*)(ws + WS_XQ), (float*)(ws + WS_XSC));
        conv_rows(F, F.in(1), (bf16_t*)(ws + WS_PB), (size_t)2 * NTOK * 256 / 8);
        sample_wmax(F);
        SEAM(0);
    }
    if (IN(1) && PEN(15)) { for (int rep = 0; rep < NREP(0); ++rep) convert_layer_weights(F, P, 0); SEAM(1); }
    layer_phases<0>(F, P, bar, lo, hi, ws0);
    layer_phases<1>(F, P, bar, lo, hi, ws0);
}

#ifdef DEBUG_NAN
constexpr int CW_FLAGS = 12288;
__global__ void dbg_scan_bf16(const unsigned short* p, size_t n, unsigned* flag) { unsigned c = 0; for (size_t i = (size_t)blockIdx.x * blockDim.x + threadIdx.x; i < n; i += (size_t)gridDim.x * blockDim.x) if ((p[i] & 0x7F80u) == 0x7F80u) ++c; if (c) atomicAdd(flag, c); }
__global__ void dbg_scan_f32(const unsigned* p, size_t n, unsigned* flag) { unsigned c = 0; for (size_t i = (size_t)blockIdx.x * blockDim.x + threadIdx.x; i < n; i += (size_t)gridDim.x * blockDim.x) if ((p[i] & 0x7F800000u) == 0x7F800000u) ++c; if (c) atomicAdd(flag, c); }
__global__ void dbg_scan_sel(const int* sel, const int* nsel, unsigned* flag) { unsigned c = 0; for (size_t i = (size_t)blockIdx.x * blockDim.x + threadIdx.x; i < (size_t)NTOK * 256; i += (size_t)gridDim.x * blockDim.x) { const int tok = (int)(i >> 8), j = (int)(i & 255), t = tok & (SEQ - 1); const int ns = nsel[tok]; if (j == 0 && ns != (t + 1 < 256 ? t + 1 : 256)) ++c; if (j < ns && (sel[i] < 0 || sel[i] > t)) ++c; } if (c) atomicAdd(flag, c); }
__global__ void dbg_scan_scores(const unsigned* p, unsigned* flag) { unsigned c = 0; for (size_t i = (size_t)blockIdx.x * blockDim.x + threadIdx.x; i < 2ull * SEQ * SEQ; i += (size_t)gridDim.x * blockDim.x) { const int s = (int)(i & (SEQ - 1)), t = (int)((i >> 13) & (SEQ - 1)); if (s <= t && (p[i] & 0x7F800000u) == 0x7F800000u) ++c; } if (c) atomicAdd(flag, c); }
__global__ void dbg_probe_bf16(const unsigned short* p, size_t n, unsigned* cnt, unsigned* minidx) { unsigned c = 0; unsigned mi = 0xFFFFFFFFu; for (size_t i = (size_t)blockIdx.x * blockDim.x + threadIdx.x; i < n; i += (size_t)gridDim.x * blockDim.x) if ((p[i] & 0x7F80u) == 0x7F80u) { ++c; if ((unsigned)i < mi) mi = (unsigned)i; } if (c) { atomicAdd(cnt, c); atomicMax(minidx, ~mi); } }
__global__ void dbg_final(float* out, size_t n, const unsigned* flags) { int code = 0; for (int k = 0; k < 32; ++k) if (flags[k] && !code) code = k + 1; const int mask = (flags[32] ? 1 : 0) | (flags[33] ? 2 : 0) | (flags[34] ? 4 : 0); if (mask) code = 20 + 5 * mask; if (!code) return; for (size_t i = (size_t)blockIdx.x * blockDim.x + threadIdx.x; i < n; i += (size_t)gridDim.x * blockDim.x) out[i] = (float)code; }
#endif
extern "C" void kernel_launch(void* const* d_in, const int* in_sizes, int n_in, void* d_out, int out_size, void* d_ws, size_t ws_size, hipStream_t stream) {
    static int grid = 0;
    if (grid == 0) {
        if (n_in != 25 || out_size != NTOK * DM || ws_size < WS_NEED) { fprintf(stderr, "kernel_launch: unexpected shapes (n_in %d out %d ws %zu need %zu)\n", n_in, out_size, ws_size, (size_t)WS_NEED); grid = -1; return; }
        int dev = 0, cus = 0, per_cu = 0;
        if (hipGetDevice(&dev) != hipSuccess || hipDeviceGetAttribute(&cus, hipDeviceAttributeMultiprocessorCount, dev) != hipSuccess) { grid = -1; return; }
        if (hipFuncSetAttribute((const void*)fwd, hipFuncAttributeMaxDynamicSharedMemorySize, LDS_BYTES) != hipSuccess) { fprintf(stderr, "kernel_launch: hipFuncSetAttribute failed\n"); grid = -1; return; }
        if (hipOccupancyMaxActiveBlocksPerMultiprocessor(&per_cu, (const void*)fwd, 512, LDS_BYTES) != hipSuccess || per_cu < 1) fprintf(stderr, "kernel_launch: occupancy query says %d\n", per_cu);
        (void)hipGetLastError();
        grid = cus;
    }
    if (grid < 0) return;
    unsigned char* ws = (unsigned char*)d_ws;
    hipMemsetAsync(ws + WS_CTL, 0, CTL_BYTES, stream);
    hipMemsetAsync(ws + W_UK2, 0, 8ull * 256 * 256 * 2 + 4ull * 256 * 512 * 2, stream);
    hipMemsetAsync(ws + W_IN + (size_t)INW * 2048 * 2, 0, (size_t)(INWP - INW) * 2048 * 2, stream);
    Params p{};
    for (int i = 0; i < 25; ++i) p.in[i] = (const float*)d_in[i];
    p.out = (float*)d_out; p.ws = ws;
#if PHASES_PER_LAUNCH == 0
    p.ph_lo = 0; p.ph_hi = NPHASE;
    hipLaunchKernelGGL(fwd, dim3(grid), dim3(512), LDS_BYTES, stream, p);
#else
    for (int k = 0; k < NPHASE; ++k) { p.ph_lo = k; p.ph_hi = k + 1; hipLaunchKernelGGL(fwd, dim3(grid), dim3(512), LDS_BYTES, stream, p);
#ifdef DEBUG_NAN
        unsigned* fl = (unsigned*)(ws + WS_CTL) + CW_FLAGS + k;
#define SB16(off, n) hipLaunchKernelGGL(dbg_scan_bf16, dim3(1024), dim3(256), 0, stream, (const unsigned short*)(ws + (off)), (size_t)(n), fl)
#define SF32(off, n) hipLaunchKernelGGL(dbg_scan_f32, dim3(1024), dim3(256), 0, stream, (const unsigned*)(ws + (off)), (size_t)(n), fl)
        if (k == 0) { SB16(WS_XB, (size_t)NTOK * DM); SB16(WS_PB, 2ull * NTOK * 256); SB16(WS_W, (W_END - WS_W) / 2); }
        else { const int kind = (k - 1) % 15;
            if (kind == 0) { SB16(R_QA, (size_t)NTOK * 1024); SB16(R_QIDX, (size_t)NTOK * 1024); SB16(R_QKV, 6ull * NTOK * 1024); SB16(R_GATES, (size_t)NTOK * 6144); SF32(R_SMALL, (size_t)NTOK * 512); }
            if (kind == 1) { SB16(R_QCAT, (size_t)NTOK * 2304); SB16(R_KCAT, (size_t)NTOK * 288); SB16(R_KI, (size_t)NTOK * 64); SB16(R_QIDX, (size_t)NTOK * 1024); SF32(R_WI, (size_t)NTOK * 16); SF32(WS_LF, 16ull * 8192); }
            if (kind == 2) { SF32(WS_CUM, 16ull * 8192); hipLaunchKernelGGL(dbg_scan_scores, dim3(1024), dim3(256), 0, stream, (const unsigned*)(ws + R_SCORES), fl); }
            if (kind == 3) { hipLaunchKernelGGL(dbg_scan_sel, dim3(1024), dim3(256), 0, stream, (const int*)(ws + R_SEL), (const int*)(ws + R_NSEL), fl); }
            if (k == 5) { unsigned* fl0 = fl; fl = (unsigned*)(ws + WS_CTL) + CW_FLAGS + 32; SB16(R_OLAT, (size_t)NTOK * 2048); fl += 1; SB16(R_OA, (size_t)NTOK * 3072); fl += 1; fl = fl0; hipLaunchKernelGGL(dbg_probe_bf16, dim3(1024), dim3(256), 0, stream, (const unsigned short*)(ws + R_OC), (size_t)NTOK * 1024, (unsigned*)(ws + WS_CTL) + CW_FLAGS + 40, (unsigned*)(ws + WS_CTL) + CW_FLAGS + 41); }
            if (kind == 5) { SB16(R_OA, (size_t)NTOK * 3072); }
            if (kind == 6) { SB16(R_MERGED, (size_t)NTOK * 2048); }
            if (kind == 7) { SF32(R_PRE1, (size_t)NTOK * 2048); }
            if (kind == 8) { SF32(M_X1F, (size_t)NTOK * 2048); SF32(M_TOKW, (size_t)NTOK * 4); }
            if (kind == 9) { SB16(M_PP, (size_t)NTOK * 2048); }
            if (kind == 12) { SF32(M_HF, (size_t)NTOK * 2048); }
            if (kind == 13) { SF32(M_X1F, (size_t)NTOK * 2048); }
            if (kind == 14) { hipLaunchKernelGGL(dbg_scan_f32, dim3(1024), dim3(256), 0, stream, (const unsigned*)d_out, (size_t)NTOK * DM, fl); if (k + 1 < NPHASE) SB16(WS_W, (W_END - WS_W) / 2); } }
#endif
    }
#ifdef DEBUG_NAN
    hipLaunchKernelGGL(dbg_final, dim3(1024), dim3(256), 0, stream, (float*)d_out, (size_t)NTOK * DM, (const unsigned*)(ws + WS_CTL) + CW_FLAGS);
#endif
#endif
}
```

```cpp
#include <hip/hip_runtime.h>
#include <stdint.h>
#include <stdio.h>
#include <math.h>

#ifndef PHASES_PER_LAUNCH
#define PHASES_PER_LAUNCH 0
#endif

#define LAS __attribute__((address_space(3)))
#define GAS __attribute__((address_space(1)))
#ifndef REP_MASK
#define REP_MASK 0
#endif
#define NREP(bit) (((REP_MASK) >> (bit)) & 1 ? 2 : 1)
typedef unsigned short bf16_t;
typedef short bf16x8 __attribute__((ext_vector_type(8)));
typedef short s16x4 __attribute__((ext_vector_type(4)));
typedef float f32x4 __attribute__((ext_vector_type(4)));
typedef float f32x16 __attribute__((ext_vector_type(16)));
typedef unsigned u32x4 __attribute__((ext_vector_type(4)));
typedef unsigned u32x2 __attribute__((ext_vector_type(2)));
typedef int i32x4 __attribute__((ext_vector_type(4)));

constexpr int NTOK = 16384, DM = 2048, SEQ = 8192, NB = 2, NLAYER = 2;
constexpr int INW = 14712, INWP = 14848;
constexpr int NEXP = 32, DEXP = 1024;
constexpr int PMAX = 65536 + 8192;
constexpr float ALPHA = 1.41421356237309515f;
constexpr float LOG2E = 1.4426950408889634f;
constexpr float SCALE = 0.08838834764831845f;
constexpr float C2 = LOG2E * SCALE;

constexpr size_t MiB = 1ull << 20;
constexpr size_t WS_CTL   = 0;
constexpr size_t WS_W     = 1 * MiB;
constexpr size_t W_IN     = WS_W;
constexpr size_t W_IN8    = W_IN   + 2048ull * 2048 * 2;
constexpr size_t W_UK2    = W_IN   + (size_t)INWP * 2048 * 2;
constexpr size_t W_UV2    = W_UK2  + 8ull * 256 * 256 * 2;
constexpr size_t W_BRA    = W_UV2  + 4ull * 256 * 512 * 2;
constexpr size_t W_BRB    = W_BRA  + 2048ull * 1024 * 2;
constexpr size_t W_BRC    = W_BRB  + 2048ull * 1024 * 2;
constexpr size_t W_OUT    = W_BRC  + 2048ull * 1024 * 2;
constexpr size_t W_PG     = W_OUT  + 2048ull * 2048 * 2;
constexpr size_t W_PLE    = W_PG   + 2048ull * 2048 * 2;
constexpr size_t W_GU     = W_PLE  + 2048ull * 256 * 2;
constexpr size_t W_DN     = W_GU   + 32ull * 2048 * 2048 * 2;
constexpr size_t W_END    = W_DN   + 32ull * 2048 * 1024 * 2;
constexpr size_t WS_XB    = (W_END + MiB - 1) / MiB * MiB;
constexpr size_t WS_PB    = WS_XB  + (size_t)NTOK * DM * 2;
constexpr size_t WS_CUM   = WS_PB  + 2ull * NTOK * 256 * 2;
constexpr size_t WS_LF    = WS_CUM + 16ull * 8192 * 4;
constexpr size_t WS_XQ    = WS_LF  + 16ull * 8192 * 4;
constexpr size_t WS_XSC   = WS_XQ  + (size_t)NTOK * DM;
constexpr size_t WS_R     = (WS_XSC + (size_t)NTOK * 4 + MiB - 1) / MiB * MiB;
constexpr size_t R_SCORES = WS_R;
constexpr size_t R_OLAT   = WS_R;
constexpr size_t R_OA     = WS_R + 64 * MiB;
constexpr size_t R_OB     = WS_R + 96 * MiB;
constexpr size_t R_OC     = WS_R + 128 * MiB;
constexpr size_t R_TMP    = WS_R + 160 * MiB;
constexpr size_t R_MERGED = WS_R + 288 * MiB;
constexpr size_t R_PRE1   = WS_R + 384 * MiB;
constexpr size_t R_QA     = WS_R + 512 * MiB;
constexpr size_t R_QIDX   = WS_R + 544 * MiB;
constexpr size_t R_QKV    = WS_R + 576 * MiB;
constexpr size_t R_GATES  = WS_R + 768 * MiB;
constexpr size_t R_SMALL  = WS_R + 960 * MiB;
constexpr size_t R_QCAT   = WS_R + 992 * MiB;
constexpr size_t R_KCAT   = WS_R + 1064 * MiB;
constexpr size_t R_KI     = WS_R + 1073 * MiB;
constexpr size_t R_WI     = WS_R + 1075 * MiB;
constexpr size_t R_SEL    = WS_R + 1076 * MiB;
constexpr size_t R_NSEL   = WS_R + 1092 * MiB;
constexpr size_t R_END    = WS_R + 1093 * MiB;
constexpr size_t M_XS     = WS_R;
constexpr size_t M_HID    = WS_R + 288 * MiB;
constexpr size_t M_PP     = WS_R + 432 * MiB;
constexpr size_t M_X1F    = WS_R + 512 * MiB;
constexpr size_t M_X1B    = WS_R + 640 * MiB;
constexpr size_t M_HF     = WS_R + 704 * MiB;
constexpr size_t M_HQ     = WS_R + 704 * MiB;
constexpr size_t M_HSC    = WS_R + 736 * MiB;
constexpr size_t M_HB     = WS_R + 832 * MiB;
constexpr size_t M_TOKE   = WS_R + 896 * MiB;
constexpr size_t M_TOKPOS = M_TOKE + (size_t)NTOK * 16;
constexpr size_t M_TOKW   = M_TOKPOS + (size_t)NTOK * 16;
constexpr size_t M_TOKDST = M_TOKW + (size_t)NTOK * 16;
constexpr size_t M_ROWW   = M_TOKDST + (size_t)NTOK * 16;
constexpr size_t M_ROWSX  = M_ROWW + (size_t)PMAX * 4;
constexpr size_t M_X1S    = M_ROWSX + (size_t)PMAX * 4;
constexpr size_t M_X1Q    = WS_R + 900 * MiB;
constexpr size_t WS_NEED  = R_END;
constexpr int CW_BAR = 0;
constexpr int CW_CNT = 8192;
constexpr int CW_META = 4096 + 64;
constexpr int CW_QCTR = 6144;
constexpr int CW_WMAX = 6272;
constexpr int CW_WMAXG = 6336;
constexpr int CW_WMAXP = 6368;
constexpr int CW_KMAX = 6400;
constexpr size_t CTL_BYTES = 65536;

constexpr int LDS_BYTES = 152576;
constexpr int LDS_MISC = 151552;

typedef float f32x2 __attribute__((ext_vector_type(2)));
typedef __bf16 bf16n2 __attribute__((ext_vector_type(2)));
__device__ __forceinline__ unsigned cvtpk(float lo, float hi) { f32x2 v = {lo, hi}; bf16n2 b = __builtin_convertvector(v, bf16n2); return __builtin_bit_cast(unsigned, b); }
__device__ __forceinline__ bf16_t f2bf(float x) { return (bf16_t)(cvtpk(x, 0.f) & 0xffffu); }
__device__ __forceinline__ float bf2f(bf16_t b) { return __uint_as_float(((unsigned)b) << 16); }
__device__ __forceinline__ float bflo(unsigned w) { return __uint_as_float(w << 16); }
__device__ __forceinline__ float bfhi(unsigned w) { return __uint_as_float(w & 0xffff0000u); }
__device__ __forceinline__ bf16x8 pack8(f32x4 a, f32x4 b) { u32x4 w = {cvtpk(a[0], a[1]), cvtpk(a[2], a[3]), cvtpk(b[0], b[1]), cvtpk(b[2], b[3])}; return *reinterpret_cast<bf16x8*>(&w); }
__device__ __forceinline__ float sigmoidf_(float x) { return 1.0f / (1.0f + __expf(-x)); }
__device__ __forceinline__ float wave_sum(float v) { for (int o = 32; o > 0; o >>= 1) v += __shfl_xor(v, o); return v; }
__device__ __forceinline__ int crow(int r, int hi) { return (r & 3) + 8 * (r >> 2) + 4 * hi; }
#define SBAR() __builtin_amdgcn_sched_barrier(0)

#define XB_TMO      128
#define XB_XCNT(j)  (256  + 64 * (j))
#define XB_XSUB(j)  (1280 + 64 * (j))
#define XB_XGEN(j)  (2304 + 64 * (j))
#define XB_TOP      3328
#define XB_TOPGEN   3392
#define XCD_BAR_WORDS 3456
#define XB_SPIN_CAP (1u << 22)
__device__ __forceinline__ unsigned xb_ld(unsigned* p)              { return __hip_atomic_load(p, __ATOMIC_RELAXED, __HIP_MEMORY_SCOPE_AGENT); }
__device__ __forceinline__ unsigned xb_add(unsigned* p, unsigned v) { return __hip_atomic_fetch_add(p, v, __ATOMIC_RELAXED, __HIP_MEMORY_SCOPE_AGENT); }
__device__ __forceinline__ unsigned xb_xcc_id() { return (unsigned)__builtin_amdgcn_s_getreg((3 << 11) | 20) & 0xFu; }
#define XB_SPIN(cond, bar) do { unsigned _sp = 0; while (cond) { __builtin_amdgcn_s_sleep(1); \
    if ((++_sp & 255u) == 0u) { if (xb_ld(&(bar)[XB_TMO])) break; if (_sp > XB_SPIN_CAP) { atomicAdd(&(bar)[XB_TMO], 1u); break; } } } } while (0)
struct XcdBarrier { unsigned* bar; unsigned x; volatile LAS unsigned* st; };
__device__ __forceinline__ XcdBarrier xcd_barrier_post(unsigned* bar, volatile LAS unsigned* st) {
    XcdBarrier b; b.bar = bar; b.x = xb_xcc_id(); b.st = st;
    if (threadIdx.x == 0) (void)xb_add(&bar[XB_XCNT(b.x)], 1u);
    return b;
}
__device__ __forceinline__ void xcd_barrier_complete(unsigned* bar, unsigned x, unsigned& nloc, unsigned& nx) {
    const unsigned G = gridDim.x * gridDim.y * gridDim.z;
    unsigned sum, cnt, mine, sp = 0u;
    for (;;) {
        sum = 0u; cnt = 0u; mine = 0u;
#pragma unroll
        for (unsigned j = 0; j < 16; ++j) { const unsigned c = xb_ld(&bar[XB_XCNT(j)]); sum += c; cnt += (c > 0u) ? 1u : 0u; mine = (j == x) ? c : mine; }
        if (sum == G) break;
        __builtin_amdgcn_s_sleep(1);
        if ((++sp & 255u) == 0u) { if (xb_ld(&bar[XB_TMO])) break; if (sp > XB_SPIN_CAP) { atomicAdd(&bar[XB_TMO], 1u); break; } }
    }
    nloc = mine > 0u ? mine : 1u; nx = cnt > 0u ? cnt : 1u;
}
__device__ __forceinline__ void xcd_barrier(const XcdBarrier& b) {
    asm volatile("s_waitcnt vmcnt(0)" ::: "memory");
    __syncthreads();
    if (threadIdx.x == 0) {
        unsigned* bar = b.bar;
        __builtin_amdgcn_s_waitcnt(0);
        unsigned nloc = b.st[0], nx = b.st[1];
        if (nloc == 0u) { xcd_barrier_complete(bar, b.x, nloc, nx); b.st[0] = nloc; b.st[1] = nx; }
        const unsigned old = xb_add(&bar[XB_XSUB(b.x)], 1u);
        const unsigned gen = old / nloc;
        if (old + 1u == (gen + 1u) * nloc) {
            __builtin_amdgcn_fence(__ATOMIC_RELEASE, "agent");
            asm volatile("s_waitcnt vmcnt(0)" ::: "memory");
            const unsigned og = xb_add(&bar[XB_TOP], 1u);
            const unsigned tg = og / nx;
            if (og + 1u == (tg + 1u) * nx) xb_add(&bar[XB_TOPGEN], 1u);
            else XB_SPIN(xb_ld(&bar[XB_TOPGEN]) == tg, bar);
            __builtin_amdgcn_fence(__ATOMIC_ACQUIRE, "agent");
            xb_add(&bar[XB_XGEN(b.x)], 1u);
            asm volatile("s_waitcnt vmcnt(0)" ::: "memory");
        } else {
            XB_SPIN(xb_ld(&bar[XB_XGEN(b.x)]) == gen, bar);
            __builtin_amdgcn_fence(__ATOMIC_ACQUIRE, "agent");
            asm volatile("s_waitcnt vmcnt(0)" ::: "memory");
        }
    }
    __syncthreads();
}

namespace pg8 {
constexpr int BM = 256, BK = 64, HALF = 128, HTB = HALF * BK * 2, STAGE_BYTES = 8 * HTB, NXCD = 8, WGM = 8;
__device__ __forceinline__ int lds_byte(int r, int c) { const int st = (r >> 4) * 2 + (c >> 5), rr = r & 15, cc = c & 31, ob = rr * 64 + cc * 2; return st * 1024 + (ob ^ (((ob >> 9) & 1) << 5)); }
__device__ __forceinline__ void stage_rc(int b, int& R, int& C) { const int st = b / 1024, sb = b % 1024, swz = sb ^ (((sb >> 9) & 1) << 5); R = (st >> 1) * 16 + swz / 64; C = (st & 1) * 32 + (swz % 64) / 2; }
__device__ __forceinline__ int perm32(int rho) { const int n = rho >> 4, i = rho & 15; return 8 * (i >> 2) + 4 * n + (i & 3); }
struct Unit { int pm, pn, e; };
struct SchedS {
    int nM, nN, nwg, G, c; const bf16_t* A; const bf16_t* B; int lda, ldb, a_sh, a_mul, skip_from = 1 << 30, skip_by = 0, skip_from2 = 1 << 30, skip_by2 = 0, b_compact = 0;
    __device__ void init(int M, int N, int G_, int c_, const bf16_t* A_, int lda_, const bf16_t* B_, int ldb_, int a_sh_ = 0, int a_mul_ = 0) {
        nM = M / BM; nN = N / BM; nwg = nM * nN; G = G_; c = c_; A = A_; B = B_; lda = lda_; ldb = ldb_; a_sh = a_sh_; a_mul = a_mul_; }
    __device__ __forceinline__ bool next(int i, Unit& u) const {
        const long L = (long)i * G + c; if (L >= nwg) return false;
        int wgid = (int)L; { const int q = nwg / NXCD, r = nwg % NXCD, xcd = wgid % NXCD, off = wgid / NXCD; wgid = (xcd < r ? xcd * (q + 1) : r * (q + 1) + (xcd - r) * q) + off; }
        const int nig = WGM * nN, gid = wgid / nig, fm = gid * WGM, gsz = (nM - fm) < WGM ? (nM - fm) : WGM;
        u.pm = fm + ((wgid % nig) % gsz); u.pn = (wgid % nig) / gsz; u.e = 0;
        u.e = u.pn;
        { const int ci = u.pn; if (ci >= skip_from) u.pn += skip_by; if (ci >= skip_from2) u.pn += skip_by2; }
        return true;
    }
    __device__ __forceinline__ const char* pa(const Unit& u) const { return (const char*)(A + (size_t)u.pm * BM * lda + (size_t)((u.pn >> a_sh) * a_mul)); }
    __device__ __forceinline__ const char* pb(const Unit& u) const { return (const char*)(B + (size_t)(b_compact ? u.e : u.pn) * BM * ldb); }
};
struct SchedM {
    int ntiles, G, c; const bf16_t* A; const bf16_t* W; int lda, ldb; const unsigned* tile_e;
    __device__ void init(const unsigned* meta, int G_, int c_, const bf16_t* A_, int lda_, const bf16_t* W_, int ldb_) {
        ntiles = (int)meta[0]; tile_e = meta + 1; G = G_; c = c_; A = A_; W = W_; lda = lda_; ldb = ldb_; }
    __device__ __forceinline__ bool next(int i, Unit& u) const {
        const long L = (long)i * G + c; if (L >= (long)ntiles * 8) return false;
        u.pm = (int)(L >> 3); u.pn = (int)(L & 7); u.e = (int)tile_e[u.pm];
        return true;
    }
    __device__ __forceinline__ const char* pa(const Unit& u) const { return (const char*)(A + (size_t)u.pm * BM * lda); }
    __device__ __forceinline__ const char* pb(const Unit& u) const { return (const char*)(W + ((size_t)u.e * 2048 + (size_t)u.pn * BM) * ldb); }
};

template <class Epi, class Sched>
__device__ __forceinline__ void gemm_phase(LAS unsigned char* lds, const int K, const int lda, const int ldb, const Sched& S, const Epi& E) {
    int tid = threadIdx.x; asm volatile("" : "+v"(tid));
    const int wid = __builtin_amdgcn_readfirstlane(tid >> 6), lane = tid & 63, wr = wid >> 2, wc = wid & 3, fr = lane & 15, fq = lane >> 4;
    const int nt = K / BK;
    unsigned voffA[2], voffB[2];
#pragma unroll
    for (int i = 0; i < 2; ++i) { int R, C; stage_rc(tid * 16 + i * 8192, R, C); const int Rb = (R & ~31) + perm32(R & 31);
        voffA[i] = (unsigned)(R * lda + C) * 2u; voffB[i] = (unsigned)(Rb * ldb + C) * 2u; }
    const size_t kstep = (size_t)(BK * 2);
    const size_t hstepA = (size_t)HALF * lda * 2, hstepB = (size_t)HALF * ldb * 2;
    const unsigned ldsw = (unsigned)wid * 1024u;
    const int aoff = lds_byte(wr * 64 + fr, fq * 8), boff = lds_byte(wc * 32 + fr, fq * 8);
#define PG8_SA(b, h) (((b) * 2 + (h)) * HTB)
#define PG8_SB(b, h) ((4 + (b) * 2 + (h)) * HTB)
#define PG8_STAGE(bufoff, gbase, voff) do { _Pragma("unroll") for (int _i = 0; _i < 2; ++_i) \
        __builtin_amdgcn_global_load_lds((const unsigned*)((const char*)(gbase) + (voff)[_i]), (LAS unsigned*)(lds + (bufoff) + ldsw + _i * 8192), 16, 0, 0); } while (0)
#define PG8_LDA(dst, b, h) do { _Pragma("unroll") for (int m = 0; m < 4; ++m) _Pragma("unroll") for (int k = 0; k < 2; ++k) dst[m][k] = *(const LAS bf16x8*)(lds + PG8_SA(b, h) + aoff + m * 2048 + k * 1024); } while (0)
#define PG8_LDB(dst, b, h) do { _Pragma("unroll") for (int n = 0; n < 2; ++n) _Pragma("unroll") for (int k = 0; k < 2; ++k) dst[n][k] = *(const LAS bf16x8*)(lds + PG8_SB(b, h) + boff + n * 2048 + k * 1024); } while (0)
#define PG8_MMA(ai, bj, At, Bt) do { __builtin_amdgcn_s_setprio(1); _Pragma("unroll") for (int m = 0; m < 4; ++m) _Pragma("unroll") for (int n = 0; n < 2; ++n) _Pragma("unroll") for (int k = 0; k < 2; ++k) \
        { if constexpr (Epi::I8) acc[ai][bj][m][n] = __builtin_bit_cast(f32x4, __builtin_amdgcn_mfma_i32_16x16x64_i8(__builtin_bit_cast(i32x4, Bt[n][k]), __builtin_bit_cast(i32x4, At[m][k]), __builtin_bit_cast(i32x4, acc[ai][bj][m][n]), 0, 0, 0)); \
          else acc[ai][bj][m][n] = __builtin_amdgcn_mfma_f32_16x16x32_bf16(Bt[n][k], At[m][k], acc[ai][bj][m][n], 0, 0, 0); } __builtin_amdgcn_s_setprio(0); } while (0)
#define PG8_WAIT_V(n) asm volatile("s_waitcnt vmcnt(" #n ")" ::: "memory")
#define PG8_WAIT_L(n) asm volatile("s_waitcnt lgkmcnt(" #n ")" ::: "memory")
#define PG8_BAR __builtin_amdgcn_s_barrier()
#define PG8_SCHED __builtin_amdgcn_sched_barrier(0)
    Unit cur, nxt; int ui = 0;
    if (!S.next(0, cur)) return;
    f32x4 acc[2][2][4][2];
#pragma unroll
    for (int a = 0; a < 2; ++a)
#pragma unroll
        for (int b = 0; b < 2; ++b)
#pragma unroll
            for (int m = 0; m < 4; ++m)
#pragma unroll
                for (int n = 0; n < 2; ++n) acc[a][b][m][n] = (f32x4){0.f, 0.f, 0.f, 0.f};
    bf16x8 At[4][2], B0[2][2], B1[2][2];
    const char* cA = S.pa(cur); const char* cB = S.pb(cur);
    PG8_STAGE(PG8_SB(0, 0), cB, voffB); PG8_STAGE(PG8_SA(0, 0), cA, voffA); PG8_STAGE(PG8_SB(0, 1), cB + hstepB, voffB); PG8_STAGE(PG8_SA(0, 1), cA + hstepA, voffA);
    if (wr == 1) PG8_BAR;
    PG8_WAIT_V(4); PG8_BAR;
    PG8_STAGE(PG8_SB(1, 0), cB + kstep, voffB); PG8_STAGE(PG8_SA(1, 0), cA + kstep, voffA); PG8_STAGE(PG8_SB(1, 1), cB + hstepB + kstep, voffB);
    PG8_WAIT_V(6); PG8_BAR;
    for (;;) {
        const bool has_next = S.next(ui + 1, nxt);
        const char* nA = has_next ? S.pa(nxt) : cA; const char* nB = has_next ? S.pb(nxt) : cB;
        for (int t = 0; t < nt; t += 2) {
            const bool last = (t == nt - 2);
            if constexpr (Epi::HAS_MID) { if (t == Epi::MID1 || t == Epi::MID2) { int frM = fr, fqM = fq; asm volatile("" : "+v"(frM), "+v"(fqM)); E.mid(acc, cur, t, wr, wc, frM, fqM); } }
            const char* a1 = cA + (size_t)(t + 1) * kstep;
            const char* a2 = last ? nA : cA + (size_t)(t + 2) * kstep; const char* b2 = last ? nB : cB + (size_t)(t + 2) * kstep;
            const char* a3 = a2 + kstep; const char* b3 = b2 + kstep;
            PG8_LDB(B0, 0, 0); PG8_SCHED; PG8_LDA(At, 0, 0); PG8_STAGE(PG8_SA(1, 1), a1 + hstepA, voffA);
            PG8_WAIT_L(8); PG8_BAR; PG8_WAIT_L(0); PG8_MMA(0, 0, At, B0); PG8_BAR; PG8_SCHED;
            PG8_LDB(B1, 0, 1); PG8_STAGE(PG8_SB(0, 0), b2, voffB);
            PG8_BAR; PG8_WAIT_L(0); PG8_MMA(0, 1, At, B1); PG8_BAR;
            PG8_LDA(At, 0, 1); PG8_STAGE(PG8_SA(0, 0), a2, voffA);
            PG8_BAR; PG8_WAIT_L(0); PG8_MMA(1, 0, At, B0); PG8_BAR; PG8_SCHED;
            PG8_STAGE(PG8_SB(0, 1), b2 + hstepB, voffB);
            PG8_WAIT_V(6); PG8_BAR; PG8_MMA(1, 1, At, B1); PG8_BAR;
            PG8_LDB(B0, 1, 0); PG8_SCHED; PG8_LDA(At, 1, 0); PG8_STAGE(PG8_SA(0, 1), a2 + hstepA, voffA);
            PG8_WAIT_L(8); PG8_BAR; PG8_WAIT_L(0); PG8_MMA(0, 0, At, B0); PG8_BAR; PG8_SCHED;
            PG8_LDB(B1, 1, 1); PG8_STAGE(PG8_SB(1, 0), b3, voffB);
            PG8_BAR; PG8_WAIT_L(0); PG8_MMA(0, 1, At, B1); PG8_BAR;
            PG8_LDA(At, 1, 1); PG8_STAGE(PG8_SA(1, 0), a3, voffA);
            PG8_BAR; PG8_WAIT_L(0); PG8_MMA(1, 0, At, B0); PG8_BAR; PG8_SCHED;
            PG8_STAGE(PG8_SB(1, 1), b3 + hstepB, voffB);
            PG8_WAIT_V(6); PG8_BAR; PG8_MMA(1, 1, At, B1); PG8_BAR;
        }
        { int frE = fr, fqE = fq; asm volatile("" : "+v"(frE), "+v"(fqE)); E(acc, cur, wr, wc, frE, fqE); }
        if (!has_next) break;
#pragma unroll
        for (int a = 0; a < 2; ++a)
#pragma unroll
            for (int b = 0; b < 2; ++b)
#pragma unroll
                for (int m = 0; m < 4; ++m)
#pragma unroll
                    for (int n = 0; n < 2; ++n) acc[a][b][m][n] = (f32x4){0.f, 0.f, 0.f, 0.f};
        cur = nxt; cA = nA; cB = nB; ++ui;
    }
    PG8_WAIT_V(0);
    if (wr == 0) PG8_BAR;
    PG8_BAR;
#undef PG8_SA
#undef PG8_SB
#undef PG8_STAGE
#undef PG8_LDA
#undef PG8_LDB
#undef PG8_MMA
#undef PG8_WAIT_V
#undef PG8_WAIT_L
#undef PG8_BAR
#undef PG8_SCHED
}

#define EPI_LOOP_ROWS _Pragma("unroll") for (int ai = 0; ai < 2; ++ai) _Pragma("unroll") for (int m = 0; m < 4; ++m)
__device__ __forceinline__ void st_bf16x8(bf16_t* p, f32x4 v0, f32x4 v1) { u32x4 w; w.x = cvtpk(v0[0], v0[1]); w.y = cvtpk(v0[2], v0[3]); w.z = cvtpk(v1[0], v1[1]); w.w = cvtpk(v1[2], v1[3]); *(u32x4*)p = w; }

template <bool I8_> struct EpiInProj {
    static constexpr bool HAS_MID = false; static constexpr bool I8 = I8_;
    bf16_t* qa; bf16_t* qidx; bf16_t* qkv; bf16_t* gates; float* small_; const float* xs; const unsigned* wmaxbits;
    __device__ __forceinline__ f32x4 val(const f32x4& a, float sc) const { if constexpr (I8_) { const i32x4 v = __builtin_bit_cast(i32x4, a); return (f32x4){(float)v[0], (float)v[1], (float)v[2], (float)v[3]} * sc; } else return a; }
    __device__ __forceinline__ void operator()(const f32x4 (&acc)[2][2][4][2], const Unit& u, int wr, int wc, int fr, int fq) const {
        const int pn = u.pn, row0 = u.pm * BM + wr * 64 + fr, lc0 = wc * 32 + fq * 8;
        float sw = 0.f; if constexpr (I8_) sw = __uint_as_float(*wmaxbits) * (1.3f / 127.0f);
        float scs[2][4];
#pragma unroll
        for (int ai = 0; ai < 2; ++ai)
#pragma unroll
            for (int m = 0; m < 4; ++m) { scs[ai][m] = 0.f; if constexpr (I8_) scs[ai][m] = xs[row0 + ai * HALF + m * 16] * sw; }
        if (pn < 8) {
            bf16_t* base = (pn < 4 ? qa + pn * 256 : qidx + (pn - 4) * 256) + lc0;
            EPI_LOOP_ROWS { const int row = row0 + ai * HALF + m * 16; const float sc = scs[ai][m];
#pragma unroll
                for (int bj = 0; bj < 2; ++bj) st_bf16x8(base + (size_t)row * 1024 + bj * HALF, val(acc[ai][bj][m][0], sc), val(acc[ai][bj][m][1], sc)); }
        } else if (pn < 32) {
            const int id = (pn - 8) >> 2, hb = ((pn - 8) & 3) * 2, b = u.pm >> 5;
            bf16_t* base = qkv + (size_t)id * ((size_t)NTOK * 1024) + lc0;
            EPI_LOOP_ROWS { const int row = row0 + ai * HALF + m * 16, s = row & (SEQ - 1); const float sc = scs[ai][m];
#pragma unroll
                for (int bj = 0; bj < 2; ++bj) st_bf16x8(base + ((size_t)(b * 8 + hb + bj) * SEQ + s) * 128, val(acc[ai][bj][m][0], sc), val(acc[ai][bj][m][1], sc)); }
        } else if (pn < 56) {
            bf16_t* base = gates + (pn - 32) * 256 + lc0;
            EPI_LOOP_ROWS { const int row = row0 + ai * HALF + m * 16; const float sc = scs[ai][m];
#pragma unroll
                for (int bj = 0; bj < 2; ++bj) st_bf16x8(base + (size_t)row * 6144 + bj * HALF, val(acc[ai][bj][m][0], sc), val(acc[ai][bj][m][1], sc)); }
        } else {
            float* base = small_ + (pn - 56) * 256 + lc0;
            EPI_LOOP_ROWS { const int row = row0 + ai * HALF + m * 16; const float sc = scs[ai][m];
#pragma unroll
                for (int bj = 0; bj < 2; ++bj) { float* p = base + (size_t)row * 512 + bj * HALF; *(f32x4*)p = val(acc[ai][bj][m][0], sc); *(f32x4*)(p + 4) = val(acc[ai][bj][m][1], sc); } }
        }
    }
};
struct EpiBf16 {
    static constexpr bool HAS_MID = false; static constexpr bool I8 = false;
    bf16_t* out; int ld, cstep;
    __device__ __forceinline__ void operator()(const f32x4 (&acc)[2][2][4][2], const Unit& u, int wr, int wc, int fr, int fq) const {
        const int row0 = u.pm * BM + wr * 64 + fr; bf16_t* base = out + (size_t)u.pn * cstep + wc * 32 + fq * 8;
        EPI_LOOP_ROWS { const int row = row0 + ai * HALF + m * 16;
#pragma unroll
            for (int bj = 0; bj < 2; ++bj) st_bf16x8(base + (size_t)row * ld + bj * HALF, acc[ai][bj][m][0], acc[ai][bj][m][1]); }
    }
};
struct EpiBranch3 {
    static constexpr bool HAS_MID = true; static constexpr bool I8 = false; static constexpr int MID1 = 16, MID2 = 32;
    const bf16_t* gates; bf16_t* merged;
    __device__ __forceinline__ static f32x4 rat(unsigned n0, unsigned n1, unsigned d0, unsigned d1) {
        f32x4 r; r[0] = (1.f + __expf(-bflo(d0))) / (1.f + __expf(-bflo(n0))); r[1] = (1.f + __expf(-bfhi(d0))) / (1.f + __expf(-bfhi(n0)));
        r[2] = (1.f + __expf(-bflo(d1))) / (1.f + __expf(-bflo(n1))); r[3] = (1.f + __expf(-bfhi(d1))) / (1.f + __expf(-bfhi(n1))); return r; }
    __device__ __forceinline__ void mid(f32x4 (&acc)[2][2][4][2], const Unit& u, int t, int wr, int wc, int fr, int fq) const {
        const int row0 = u.pm * BM + wr * 64 + fr, col0 = u.pn * BM + wc * 32 + fq * 8, bn = (t == MID1) ? 0 : 2048;
#pragma unroll
        for (int ai = 0; ai < 2; ++ai) { u32x4 gn[4][2], gd[4][2];
#pragma unroll
            for (int m = 0; m < 4; ++m)
#pragma unroll
                for (int bj = 0; bj < 2; ++bj) { const bf16_t* gp = gates + (size_t)(row0 + ai * HALF + m * 16) * 6144 + bn + col0 + bj * HALF; gn[m][bj] = *(const u32x4*)gp; gd[m][bj] = *(const u32x4*)(gp + 2048); }
#pragma unroll
            for (int m = 0; m < 4; ++m)
#pragma unroll
                for (int bj = 0; bj < 2; ++bj) { acc[ai][bj][m][0] *= rat(gn[m][bj].x, gn[m][bj].y, gd[m][bj].x, gd[m][bj].y); acc[ai][bj][m][1] *= rat(gn[m][bj].z, gn[m][bj].w, gd[m][bj].z, gd[m][bj].w); } }
    }
    __device__ __forceinline__ void operator()(const f32x4 (&acc)[2][2][4][2], const Unit& u, int wr, int wc, int fr, int fq) const {
        const int row0 = u.pm * BM + wr * 64 + fr, col0 = u.pn * BM + wc * 32 + fq * 8;
        u32x4 gl[2][4][2];
        EPI_LOOP_ROWS {
#pragma unroll
            for (int bj = 0; bj < 2; ++bj) gl[ai][m][bj] = *(const u32x4*)(gates + (size_t)(row0 + ai * HALF + m * 16) * 6144 + 4096 + col0 + bj * HALF); }
        EPI_LOOP_ROWS { const int row = row0 + ai * HALF + m * 16;
#pragma unroll
            for (int bj = 0; bj < 2; ++bj) { const int col = col0 + bj * HALF; const u32x4 gw = gl[ai][m][bj];
                f32x4 v0 = acc[ai][bj][m][0], v1 = acc[ai][bj][m][1];
                v0[0] *= sigmoidf_(bflo(gw.x)); v0[1] *= sigmoidf_(bfhi(gw.x)); v0[2] *= sigmoidf_(bflo(gw.y)); v0[3] *= sigmoidf_(bfhi(gw.y));
                v1[0] *= sigmoidf_(bflo(gw.z)); v1[1] *= sigmoidf_(bfhi(gw.z)); v1[2] *= sigmoidf_(bflo(gw.w)); v1[3] *= sigmoidf_(bfhi(gw.w));
                st_bf16x8(merged + (size_t)row * 2048 + col, v0, v1); } }
    }
};
struct EpiOut {
    static constexpr bool HAS_MID = false; static constexpr bool I8 = false;
    const bf16_t* res; bf16_t* pre;
    __device__ __forceinline__ void operator()(const f32x4 (&acc)[2][2][4][2], const Unit& u, int wr, int wc, int fr, int fq) const {
        const int row0 = u.pm * BM + wr * 64 + fr, col0 = u.pn * BM + wc * 32 + fq * 8;
        u32x4 rl[2][4][2];
        EPI_LOOP_ROWS { const int row = row0 + ai * HALF + m * 16;
#pragma unroll
            for (int bj = 0; bj < 2; ++bj) rl[ai][m][bj] = *(const u32x4*)(res + (size_t)row * 2048 + col0 + bj * HALF); }
        EPI_LOOP_ROWS { const int row = row0 + ai * HALF + m * 16;
#pragma unroll
            for (int bj = 0; bj < 2; ++bj) { const size_t o = (size_t)row * 2048 + col0 + bj * HALF;
                const u32x4 rw = rl[ai][m][bj]; f32x4 v0 = acc[ai][bj][m][0], v1 = acc[ai][bj][m][1];
                v0[0] += ALPHA * bflo(rw.x); v0[1] += ALPHA * bfhi(rw.x); v0[2] += ALPHA * bflo(rw.y); v0[3] += ALPHA * bfhi(rw.y);
                v1[0] += ALPHA * bflo(rw.z); v1[1] += ALPHA * bfhi(rw.z); v1[2] += ALPHA * bflo(rw.w); v1[3] += ALPHA * bfhi(rw.w);
                st_bf16x8(pre + o, v0, v1); } }
    }
};
struct EpiGateUpI8 {
    static constexpr bool HAS_MID = false; static constexpr bool I8 = true;
    const float* bg; const float* bu; bf16_t* hid; const float* rowsx; const unsigned* wmaxbits;
    __device__ __forceinline__ void operator()(const f32x4 (&acc)[2][2][4][2], const Unit& u, int wr, int wc, int fr, int fq) const {
        const int row0 = u.pm * BM + wr * 64 + fr, j0 = u.pn * 128 + wc * 32 + fq * 8;
        const float sw = __uint_as_float(*wmaxbits) * (1.3f / 127.0f);
        const float* pg = bg + (size_t)u.e * DEXP + j0; const float* pu = bu + (size_t)u.e * DEXP + j0;
        const f32x4 g0b = *(const f32x4*)pg, g1b = *(const f32x4*)(pg + 4), u0b = *(const f32x4*)pu, u1b = *(const f32x4*)(pu + 4);
        float scs[2][4];
#pragma unroll
        for (int ai = 0; ai < 2; ++ai)
#pragma unroll
            for (int m = 0; m < 4; ++m) scs[ai][m] = rowsx[row0 + ai * HALF + m * 16] * sw;
        EPI_LOOP_ROWS { const int row = row0 + ai * HALF + m * 16; const float sc = scs[ai][m];
            const i32x4 ag0 = __builtin_bit_cast(i32x4, acc[ai][0][m][0]), ag1 = __builtin_bit_cast(i32x4, acc[ai][0][m][1]), au0 = __builtin_bit_cast(i32x4, acc[ai][1][m][0]), au1 = __builtin_bit_cast(i32x4, acc[ai][1][m][1]);
            f32x4 h0, h1;
#pragma unroll
            for (int j = 0; j < 4; ++j) {
                float g = fminf((float)ag0[j] * sc + g0b[j], 7.0f), uu = fminf(fmaxf((float)au0[j] * sc + u0b[j], -7.0f), 7.0f);
                h0[j] = (uu + 1.0f) * (g * sigmoidf_(1.702f * g));
                g = fminf((float)ag1[j] * sc + g1b[j], 7.0f); uu = fminf(fmaxf((float)au1[j] * sc + u1b[j], -7.0f), 7.0f);
                h1[j] = (uu + 1.0f) * (g * sigmoidf_(1.702f * g)); }
            st_bf16x8(hid + (size_t)row * DEXP + j0, h0, h1); }
    }
};
struct EpiDown {
    static constexpr bool HAS_MID = false; static constexpr bool I8 = false;
    const float* bd; const float* roww; bf16_t* ys;
    __device__ __forceinline__ void operator()(const f32x4 (&acc)[2][2][4][2], const Unit& u, int wr, int wc, int fr, int fq) const {
        const int row0 = u.pm * BM + wr * 64 + fr, col0 = u.pn * BM + wc * 32 + fq * 8;
        f32x4 b[2][2];
#pragma unroll
        for (int bj = 0; bj < 2; ++bj) { const float* p = bd + (size_t)u.e * DM + col0 + bj * HALF; b[bj][0] = *(const f32x4*)p; b[bj][1] = *(const f32x4*)(p + 4); }
        float rws[2][4];
#pragma unroll
        for (int ai = 0; ai < 2; ++ai)
#pragma unroll
            for (int m = 0; m < 4; ++m) rws[ai][m] = roww[row0 + ai * HALF + m * 16];
        EPI_LOOP_ROWS { const int row = row0 + ai * HALF + m * 16; const float w = rws[ai][m];
#pragma unroll
            for (int bj = 0; bj < 2; ++bj) st_bf16x8(ys + (size_t)row * 2048 + col0 + bj * HALF, (acc[ai][bj][m][0] + b[bj][0]) * w, (acc[ai][bj][m][1] + b[bj][1]) * w); }
    }
};
struct EpiPleGateI8 {
    static constexpr bool HAS_MID = false; static constexpr bool I8 = true;
    const bf16_t* hb; const bf16_t* pp; bf16_t* pre; const float* hs; const unsigned* wmaxbits;
    __device__ __forceinline__ void operator()(const f32x4 (&acc)[2][2][4][2], const Unit& u, int wr, int wc, int fr, int fq) const {
        const int row0 = u.pm * BM + wr * 64 + fr, col0 = u.pn * BM + wc * 32 + fq * 8;
        const float sw = __uint_as_float(*wmaxbits) * (1.3f / 127.0f);
#pragma unroll
        for (int ai = 0; ai < 2; ++ai) { u32x4 pl[4][2], hl[4][2]; float scs[4];
#pragma unroll
            for (int m = 0; m < 4; ++m) { scs[m] = hs[row0 + ai * HALF + m * 16] * sw;
#pragma unroll
                for (int bj = 0; bj < 2; ++bj) { const size_t o = (size_t)(row0 + ai * HALF + m * 16) * 2048 + col0 + bj * HALF; pl[m][bj] = *(const u32x4*)(pp + o); hl[m][bj] = *(const u32x4*)(hb + o); } }
#pragma unroll
            for (int m = 0; m < 4; ++m) { const float sc = scs[m];
#pragma unroll
                for (int bj = 0; bj < 2; ++bj) { const size_t o = (size_t)(row0 + ai * HALF + m * 16) * 2048 + col0 + bj * HALF; const u32x4 pw = pl[m][bj], hw = hl[m][bj];
                    const i32x4 a0 = __builtin_bit_cast(i32x4, acc[ai][bj][m][0]), a1 = __builtin_bit_cast(i32x4, acc[ai][bj][m][1]); f32x4 o0, o1;
                    o0[0] = bflo(hw.x) + sigmoidf_((float)a0[0] * sc) * bflo(pw.x); o0[1] = bfhi(hw.x) + sigmoidf_((float)a0[1] * sc) * bfhi(pw.x); o0[2] = bflo(hw.y) + sigmoidf_((float)a0[2] * sc) * bflo(pw.y); o0[3] = bfhi(hw.y) + sigmoidf_((float)a0[3] * sc) * bfhi(pw.y);
                    o1[0] = bflo(hw.z) + sigmoidf_((float)a1[0] * sc) * bflo(pw.z); o1[1] = bfhi(hw.z) + sigmoidf_((float)a1[1] * sc) * bfhi(pw.z); o1[2] = bflo(hw.w) + sigmoidf_((float)a1[2] * sc) * bflo(pw.w); o1[3] = bfhi(hw.w) + sigmoidf_((float)a1[3] * sc) * bfhi(pw.w);
                    st_bf16x8(pre + o, o0, o1); } } }
    }
};
}

struct Params { const float* in[25]; float* out; unsigned char* ws; int ph_lo, ph_hi; };
__constant__ float c_invf_r[16] = {1.000000000e+00f, 4.403665960e-01f, 1.939227432e-01f, 8.539710194e-02f, 3.760603070e-02f, 1.656043902e-02f, 7.292664610e-03f, 3.211445874e-03f, 1.414213562e-03f, 6.227723788e-04f, 2.742481884e-04f, 1.207697351e-04f, 5.318296098e-05f, 2.341999971e-05f, 1.031338616e-05f, 4.541670478e-06f};
__constant__ float c_invf_i[8] = {1.000000000e+00f, 1.939227432e-01f, 3.760603070e-02f, 7.292664610e-03f, 1.414213562e-03f, 2.742481884e-04f, 5.318296098e-05f, 1.031338616e-05f};
constexpr int LDS_PTRS = LDS_MISC + 256;
struct Frame { unsigned char* lds; LAS unsigned char* ldsl; unsigned char* ws; int tid, lane, wid, G, bid;
    __device__ __forceinline__ const float* in(int k) const { const LAS unsigned* t = (const LAS unsigned*)(ldsl + LDS_PTRS) + 2 * k;
        const unsigned lo = __builtin_amdgcn_readfirstlane(t[0]), hi = __builtin_amdgcn_readfirstlane(t[1]); return (const float*)(const GAS float*)(((unsigned long long)hi << 32) | lo); }
    __device__ __forceinline__ float* out() const { return (float*)in(25); } };
__device__ __forceinline__ Frame fresh(const Frame& F0) { Frame F = F0; int t = threadIdx.x; asm volatile("" : "+v"(t)); F.tid = t; F.lane = t & 63; F.wid = __builtin_amdgcn_readfirstlane(t >> 6); size_t z = 0; asm volatile("" : "+s"(z)); F.ws = F0.ws + z; return F; }

struct TcTile { const float* src; long sld; bf16_t* dst; long dld; int nvalid; float qinv; };
template <class Dec>
__device__ __forceinline__ void tconv_run(const Frame& F, int total, const Dec& dec, int& rot) {
    float* tile = (float*)F.lds;
    const int tid = F.tid, G = F.G;
    const int start = (F.bid - (rot % G) + G) % G; rot += total;
    const int lr = tid >> 4, lc4 = (tid & 15) * 4, sn = tid >> 3, skc = (tid & 7) * 8;
    f32x4 v[4][2];
#define TC_ISSUE(t0_) do { _Pragma("unroll") for (int q = 0; q < 4; ++q) { const int t = (t0_) + q * G; \
        if (t < total) { const TcTile ti = dec(t); _Pragma("unroll") for (int h = 0; h < 2; ++h) { v[q][h] = (f32x4){0.f, 0.f, 0.f, 0.f}; \
            if (lc4 < ti.nvalid) v[q][h] = *(const GAS f32x4*)((const GAS float*)ti.src + (size_t)(lr + 32 * h) * ti.sld + lc4); } } } } while (0)
    if (start < total) TC_ISSUE(start);
    for (int t0 = start; t0 < total; t0 += 4 * G) {
#pragma unroll
        for (int q = 0; q < 4; ++q) { if (t0 + q * G < total) { float* tl = tile + q * (64 * 65);
#pragma unroll
                for (int h = 0; h < 2; ++h) { float* p = tl + (lr + 32 * h) * 65 + lc4; p[0] = v[q][h][0]; p[1] = v[q][h][1]; p[2] = v[q][h][2]; p[3] = v[q][h][3]; } } }
        __syncthreads();
        if (t0 + 4 * G < total) TC_ISSUE(t0 + 4 * G);
#pragma unroll
        for (int q = 0; q < 4; ++q) { const int t = t0 + q * G;
            if (t < total) { const TcTile ti = dec(t); const float* tl = tile + q * (64 * 65);
                if (ti.qinv > 0.f) { if (tid < 256) { const int n8 = tid >> 2, kc = (tid & 3) * 16; u32x4 w;
#pragma unroll
                        for (int d = 0; d < 4; ++d) { unsigned pk = 0u;
#pragma unroll
                            for (int j = 0; j < 4; ++j) { float q = rintf(tl[(kc + d * 4 + j) * 65 + n8] * ti.qinv); q = fminf(fmaxf(q, -127.f), 127.f); pk |= ((unsigned)(int)q & 0xffu) << (8 * j); }
                            w[d] = pk; }
                        *(u32x4*)((unsigned char*)ti.dst + (size_t)n8 * ti.dld + kc) = w; } }
                else if (sn < ti.nvalid) { f32x4 a, b;
#pragma unroll
                    for (int j = 0; j < 4; ++j) { a[j] = tl[(skc + j) * 65 + sn]; b[j] = tl[(skc + 4 + j) * 65 + sn]; }
                    pg8::st_bf16x8(ti.dst + (size_t)sn * ti.dld + skc, a, b); } } }
        __syncthreads();
    }
#undef TC_ISSUE
}
struct TcMat {
    const float* src; long src_ld; int tk, ncols; bf16_t* dst; long dst_ld; float qinv;
    __device__ __forceinline__ TcTile operator()(int t) const { const int k0 = (t % tk) * 64, n0 = (t / tk) * 64; TcTile ti;
        ti.src = src + (size_t)k0 * src_ld + n0; ti.sld = src_ld; ti.dst = qinv > 0.f ? (bf16_t*)((unsigned char*)dst + (size_t)n0 * dst_ld + k0) : dst + (size_t)n0 * dst_ld + k0; ti.dld = dst_ld; ti.nvalid = (ncols - n0) < 64 ? (ncols - n0) : 64; ti.qinv = qinv; return ti; }
};
__device__ __forceinline__ void tconv(const Frame& F, const float* src, long src_ld, int K, int ncols, bf16_t* dst, long dst_ld, int& rot) {
    TcMat d{src, src_ld, K >> 6, ncols, dst, dst_ld, 0.f}; tconv_run(F, (K >> 6) * ((ncols + 63) >> 6), d, rot);
}
struct TcExperts {
    const float* wg; const float* wu; const float* wd; unsigned char* dgu; bf16_t* ddn; float qinv;
    __device__ __forceinline__ TcTile operator()(int t) const { const int e = t / 1536, r = t - e * 1536; TcTile ti; ti.nvalid = 64; ti.qinv = 0.f;
        if (r < 1024) { const int k0 = (r & 31) * 64, dt = r >> 5, jb = dt >> 2, gu = (dt >> 1) & 1, half = dt & 1;
            ti.src = (const float*)((unsigned long long)wg + (unsigned long long)gu * ((unsigned long long)wu - (unsigned long long)wg)) + (size_t)e * DM * DEXP + (size_t)k0 * DEXP + jb * 128 + half * 64; ti.sld = DEXP;
            ti.dst = (bf16_t*)(dgu + (size_t)e * 2048 * 2048 + (size_t)(dt * 64) * 2048 + k0); ti.dld = 2048; ti.qinv = qinv; }
        else { const int r2 = r - 1024, k0 = (r2 & 15) * 64, n0 = (r2 >> 4) * 64;
            ti.src = wd + (size_t)e * DEXP * DM + (size_t)k0 * DM + n0; ti.sld = DM;
            ti.dst = ddn + (size_t)e * 2048 * 1024 + (size_t)n0 * 1024 + k0; ti.dld = 1024; }
        return ti; }
};
__device__ __forceinline__ void sample_wmax(const Frame& F) {
    unsigned* wm = (unsigned*)(F.ws + WS_CTL) + CW_WMAX;
#pragma unroll 1
    for (int l = 0; l < NLAYER; ++l) { float mx = 0.f;
#pragma unroll 1
        for (int which = 0; which < 2; ++which) { const f32x4* p = (const f32x4*)(F.in(which ? 17 : 15) + (size_t)l * NEXP * DM * DEXP);
            for (size_t i = (size_t)F.bid * 512 + F.tid; i < (size_t)NEXP * DM * DEXP / 4 / 64; i += (size_t)F.G * 512) { const f32x4 v = p[i * 64 + (i & 63)];
                mx = fmaxf(mx, fmaxf(fmaxf(fabsf(v[0]), fabsf(v[1])), fmaxf(fabsf(v[2]), fabsf(v[3])))); } }
        for (int o = 32; o > 0; o >>= 1) mx = fmaxf(mx, __shfl_xor(mx, o));
        if (F.lane == 0 && mx > 0.f) atomicMax(&wm[l], __float_as_uint(mx));
        float mg = 0.f; const f32x4* wi_ = (const f32x4*)(F.in(2) + (size_t)l * DM * INW);
        for (int i = F.bid * 512 + F.tid; i < DM * (INW / 4) / 16; i += F.G * 512) { const f32x4 v = wi_[(size_t)i * 16 + (i & 15)];
            mg = fmaxf(mg, fmaxf(fmaxf(fabsf(v[0]), fabsf(v[1])), fmaxf(fabsf(v[2]), fabsf(v[3])))); }
        for (int o = 32; o > 0; o >>= 1) mg = fmaxf(mg, __shfl_xor(mg, o));
        if (F.lane == 0 && mg > 0.f) atomicMax(&wm[CW_WMAXG - CW_WMAX + l], __float_as_uint(mg));
        float mp = 0.f; const f32x4* wp_ = (const f32x4*)(F.in(21) + (size_t)l * DM * DM);
        for (int i = F.bid * 512 + F.tid; i < DM * DM / 4 / 16; i += F.G * 512) { const f32x4 v = wp_[i * 16 + (i & 15)];
            mp = fmaxf(mp, fmaxf(fmaxf(fabsf(v[0]), fabsf(v[1])), fmaxf(fabsf(v[2]), fabsf(v[3])))); }
        for (int o = 32; o > 0; o >>= 1) mp = fmaxf(mp, __shfl_xor(mp, o));
        if (F.lane == 0 && mp > 0.f) atomicMax(&wm[CW_WMAXP - CW_WMAX + l], __float_as_uint(mp)); }
}
__device__ __forceinline__ void conv_rows(const Frame& F, const float* src, bf16_t* dst, size_t n8) {
    for (size_t i = (size_t)F.bid * 512 + F.tid; i < n8; i += (size_t)F.G * 512) { const f32x4 a = *(const f32x4*)(src + i * 8), b = *(const f32x4*)(src + i * 8 + 4); pg8::st_bf16x8(dst + i * 8, a, b); }
}
__device__ __forceinline__ void quant_rows(const Frame& F, const float* src, bf16_t* xb, unsigned char* xq, float* xsc) {
    const int lane = F.lane;
    for (int tok = F.bid * 8 + F.wid; tok < NTOK; tok += F.G * 8) { f32x4 v[8]; float amax = 0.f;
#pragma unroll
        for (int i = 0; i < 4; ++i) { const int c = (i * 64 + lane) * 8; v[2 * i] = *(const f32x4*)(src + (size_t)tok * DM + c); v[2 * i + 1] = *(const f32x4*)(src + (size_t)tok * DM + c + 4);
            pg8::st_bf16x8(xb + (size_t)tok * DM + c, v[2 * i], v[2 * i + 1]);
#pragma unroll
            for (int h = 0; h < 2; ++h)
#pragma unroll
                for (int j = 0; j < 4; ++j) amax = fmaxf(amax, fabsf(v[2 * i + h][j])); }
        for (int o = 32; o > 0; o >>= 1) amax = fmaxf(amax, __shfl_xor(amax, o));
        amax = fmaxf(amax, 1e-20f); const float qi = 127.0f / amax; if (lane == 0) xsc[tok] = amax * (1.0f / 127.0f);
#pragma unroll
        for (int i = 0; i < 4; ++i) { u32x2 w;
#pragma unroll
            for (int h = 0; h < 2; ++h) { unsigned pk = 0u;
#pragma unroll
                for (int j = 0; j < 4; ++j) pk |= ((unsigned)(int)rintf(v[2 * i + h][j] * qi) & 0xffu) << (8 * j);
                w[h] = pk; }
            *(u32x2*)(xq + (size_t)tok * DM + (i * 64 + lane) * 8) = w; } }
}
__constant__ int c_so[14] = {0, 1312, 2416, 3440, 4464, 5496, 6520, 7544, 8568, 1024, 1280, 2336, 2400, 5488};
__constant__ int c_dn[14] = {0, 1024, 2048, 3072, 4096, 5120, 6144, 7168, 8192, 14336, 14592, 14624, 14688, 14704};
__constant__ int c_nc[14] = {1024, 1024, 1024, 1024, 1024, 1024, 1024, 1024, 6144, 256, 32, 64, 16, 8};
__device__ __forceinline__ void convert_layer_weights(const Frame& F0, const Params& P, int l) { const Frame F = fresh(F0);
    unsigned char* ws = F.ws; int rot = 0;
    { const float* w = F.in(2) + (size_t)l * DM * INW; bf16_t* d = (bf16_t*)(ws + W_IN);
      const float wmaxg = __uint_as_float(((const unsigned*)(ws + WS_CTL))[CW_WMAXG + l]); const float qinv = 127.0f / (1.3f * wmaxg);
#pragma unroll 1
      for (int s = 0; s < 14; ++s) {
          if (s == 1 || s >= 10) tconv(F, w + c_so[s], INW, DM, c_nc[s], d + (size_t)c_dn[s] * DM, DM, rot);
          else { const int crow = (s == 0) ? 0 : (s <= 7 ? 1024 + (s - 2) * 1024 : (s == 8 ? 7168 : 13312));
              TcMat dq{w + c_so[s], INW, DM >> 6, c_nc[s], (bf16_t*)(ws + W_IN8 + (size_t)crow * 2048), 2048, qinv}; tconv_run(F, (DM >> 6) * (c_nc[s] >> 6), dq, rot); } } }
    tconv(F, F.in(7) + (size_t)l * 1024 * DM, DM, 1024, DM, (bf16_t*)(ws + W_BRA), 3072, rot);
    tconv(F, F.in(8) + (size_t)l * 1024 * DM, DM, 1024, DM, (bf16_t*)(ws + W_BRA) + 1024, 3072, rot);
    tconv(F, F.in(9) + (size_t)l * 1024 * DM, DM, 1024, DM, (bf16_t*)(ws + W_BRA) + 2048, 3072, rot);
    tconv(F, F.in(10) + (size_t)l * DM * DM, DM, DM, DM, (bf16_t*)(ws + W_OUT), DM, rot);
    { const float wmp = __uint_as_float(((const unsigned*)(ws + WS_CTL))[CW_WMAXP + l]);
      TcMat dq{F.in(21) + (size_t)l * DM * DM, DM, DM >> 6, DM, (bf16_t*)(ws + W_PG), 2048, 127.0f / (1.3f * wmp)}; tconv_run(F, (DM >> 6) * (DM >> 6), dq, rot); }
    tconv(F, F.in(22) + (size_t)l * 256 * DM, DM, 256, DM, (bf16_t*)(ws + W_PLE), 256, rot);
#pragma unroll 1
    for (int h = 0; h < 8; ++h) tconv(F, F.in(6) + (size_t)l * 256 * 1024 + h * 128, 1024, 256, 128, (bf16_t*)(ws + W_UV2) + ((size_t)(h >> 1) * 256 + (h & 1) * 128) * 512 + (h & 1) * 256, 512, rot);
    { const float wmax = __uint_as_float(((const unsigned*)(ws + WS_CTL))[CW_WMAX + l]);
      TcExperts d{F.in(15) + (size_t)l * NEXP * DM * DEXP, F.in(17) + (size_t)l * NEXP * DM * DEXP, F.in(19) + (size_t)l * NEXP * DEXP * DM, (unsigned char*)(ws + W_GU), (bf16_t*)(ws + W_DN), 127.0f / (1.3f * wmax)};
      tconv_run(F, NEXP * 1536, d, rot); }
    { const float* w = F.in(5) + (size_t)l * 256 * 8 * 96; bf16_t* d = (bf16_t*)(ws + W_UK2);
      for (int i = F.bid * 512 + F.tid; i < 256 * 8 * 96; i += F.G * 512) { const int n = i % 96, h = (i / 96) & 7, r = i / 768; d[((size_t)h * 256 + r) * 256 + (h & 1) * 128 + 32 + n] = f2bf(w[i]); } }
}

__device__ __forceinline__ void rope_cs(float pos, float invf, float& c, float& s) {
    const float a = pos * invf; const double ad = (double)a * 0.15915494309189535; const float fr = (float)(ad - rint(ad));
    s = __builtin_amdgcn_sinf(fr); c = __builtin_amdgcn_cosf(fr);
}
__device__ __forceinline__ void phase_prep(const Frame& F0, const Params& P, int l) { const Frame F = fresh(F0);
    unsigned char* ws = F.ws; const int lane = F.lane;
    const float* smallb = (const float*)(ws + R_SMALL); bf16_t* kcat = (bf16_t*)(ws + R_KCAT); bf16_t* qcat = (bf16_t*)(ws + R_QCAT);
    bf16_t* ki = (bf16_t*)(ws + R_KI); float* wi = (float*)(ws + R_WI); float* lf = (float*)(ws + WS_LF);
    const bf16_t* qa = (const bf16_t*)(ws + R_QA); bf16_t* qidx = (bf16_t*)(ws + R_QIDX);
    const f32x4 gck = *(const f32x4*)(F.in(4) + l * 256 + lane * 4);
    const float bfo = lane < 8 ? F.in(3)[l * 8 + lane] : 0.f;
    const float ifr = c_invf_r[lane & 15], ifi = c_invf_i[lane & 7];
    for (int tok = F.bid * 8 + F.wid; tok < NTOK; tok += F.G * 8) {
        const int s = tok & (SEQ - 1), b = tok >> 13; const float* sm = smallb + (size_t)tok * 512;
        float cr, sr, ci, si; rope_cs((float)s, ifr, cr, sr); rope_cs((float)s, ifi, ci, si);
        { const f32x4 v = *(const f32x4*)(sm + lane * 4); float ss = v[0] * v[0] + v[1] * v[1] + v[2] * v[2] + v[3] * v[3]; ss = wave_sum(ss);
          const float rs = rsqrtf(ss * (1.0f / 256.0f) + 1e-6f); u32x2 w; w.x = cvtpk(v[0] * rs * gck[0], v[1] * rs * gck[1]); w.y = cvtpk(v[2] * rs * gck[2], v[3] * rs * gck[3]);
          *(u32x2*)(kcat + (size_t)tok * 288 + lane * 4) = w; }
        if (lane < 16) { const float x1 = sm[256 + lane], x2 = sm[272 + lane]; kcat[(size_t)tok * 288 + 256 + lane] = f2bf(x1 * cr - x2 * sr); kcat[(size_t)tok * 288 + 272 + lane] = f2bf(x2 * cr + x1 * sr); }
        { float o = sm[288 + lane];
          if (lane < 8) { const float x2 = sm[296 + lane]; o = o * ci - x2 * si; } else if (lane < 16) { const float x1 = sm[288 + lane - 8]; o = o * ci + x1 * si; }
          ki[(size_t)tok * 64 + lane] = f2bf(o); }
        if (lane < 16) wi[(size_t)tok * 16 + lane] = sm[352 + lane] * (1.0f / 32.0f);
        if (lane < 8) { const float f = sm[368 + lane] + bfo; lf[(size_t)(b * 8 + lane) * SEQ + s] = fminf(f, 0.f) - log1pf(__expf(-fabsf(f))); }
#pragma unroll
        for (int pp = 0; pp < 2; ++pp) { const int p = lane + 64 * pp, h = p >> 4, i = p & 15;
            const float x1 = bf2f(qa[(size_t)tok * 1024 + h * 128 + i]), x2 = bf2f(qa[(size_t)tok * 1024 + h * 128 + 16 + i]);
            qcat[(size_t)tok * 2304 + h * 288 + 256 + i] = f2bf(x1 * cr - x2 * sr); qcat[(size_t)tok * 2304 + h * 288 + 272 + i] = f2bf(x2 * cr + x1 * sr); }
#pragma unroll
        for (int pp = 0; pp < 2; ++pp) { const int p = lane + 64 * pp, hh = p >> 3, i = p & 7; bf16_t* q = qidx + (size_t)tok * 1024 + hh * 64;
            const float x1 = bf2f(q[i]), x2 = bf2f(q[8 + i]); q[i] = f2bf(x1 * ci - x2 * si); q[8 + i] = f2bf(x2 * ci + x1 * si); }
    }
    { const bf16_t* kbt = (const bf16_t*)(ws + R_QKV) + (size_t)NTOK * 1024; unsigned* kmx = (unsigned*)(ws + WS_CTL) + CW_KMAX + l * 16;
#pragma unroll 1
      for (int bh = 0; bh < 16; ++bh) { float mx = 0.f;
          for (int r0 = (F.bid * 8 + F.wid) * 4; r0 < SEQ; r0 += F.G * 32) {
              const u32x4 w = *(const u32x4*)(kbt + ((size_t)bh * SEQ + r0 + (lane >> 4)) * 128 + (lane & 15) * 8);
              float ss = bflo(w.x) * bflo(w.x) + bfhi(w.x) * bfhi(w.x) + bflo(w.y) * bflo(w.y) + bfhi(w.y) * bfhi(w.y) + bflo(w.z) * bflo(w.z) + bfhi(w.z) * bfhi(w.z) + bflo(w.w) * bflo(w.w) + bfhi(w.w) * bfhi(w.w);
              ss += __shfl_xor(ss, 1); ss += __shfl_xor(ss, 2); ss += __shfl_xor(ss, 4); ss += __shfl_xor(ss, 8); mx = fmaxf(mx, ss); }
          mx = fmaxf(mx, __shfl_xor(mx, 16)); mx = fmaxf(mx, __shfl_xor(mx, 32));
          if (lane == 0) ((float*)F.lds)[F.wid * 16 + bh] = mx; }
      __syncthreads();
      if (F.tid < 16) { float mx = 0.f;
#pragma unroll
          for (int w = 0; w < 8; ++w) mx = fmaxf(mx, ((const float*)F.lds)[w * 16 + F.tid]);
          const unsigned bits = __float_as_uint(mx);
          if (bits > __hip_atomic_load(&kmx[F.tid], __ATOMIC_RELAXED, __HIP_MEMORY_SCOPE_AGENT)) atomicMax(&kmx[F.tid], bits); }
      __syncthreads(); }
}
__device__ __forceinline__ void phase_cumsum(const Frame& F0) { const Frame F = fresh(F0);
    const int gw = F.bid * 8 + F.wid; if (gw >= 16) return;
    const float* lf = (const float*)(F.ws + WS_LF) + (size_t)gw * SEQ; float* cum = (float*)(F.ws + WS_CUM) + (size_t)gw * SEQ;
    const int lane = F.lane; double tot = 0.0;
    for (int j = 0; j < 128; ++j) tot += (double)lf[lane * 128 + j];
    double inc = tot;
    for (int o = 1; o < 64; o <<= 1) { const double n = __shfl_up(inc, o); if (lane >= o) inc += n; }
    double run = inc - tot;
    for (int j = 0; j < 128; ++j) { run += (double)lf[lane * 128 + j]; cum[lane * 128 + j] = (float)run; }
}

__device__ __forceinline__ void idx_unit(const Frame& F, int b, int pi, int half) {
    const int tid = F.tid, lane = F.lane, rho = lane & 31, hh = lane >> 5; unsigned char* ws = F.ws;
    const bf16_t* qidx = (const bf16_t*)(ws + R_QIDX); const bf16_t* ki = (const bf16_t*)(ws + R_KI) + (size_t)b * SEQ * 64; const float* wi = (const float*)(ws + R_WI);
    float* scores = (float*)(ws + R_SCORES) + (size_t)b * SEQ * SEQ;
    LAS unsigned char* kl = F.ldsl;
    const int gl = pi, gh = 127 - pi, nl = (64 * gl + 63) / 128 + 1, nh = (64 * gh + 63) / 128 + 1, tot = nl + nh;
    const int x0 = half ? tot / 2 : 0, x1 = half ? tot : tot / 2;
    bf16x8 af[4][4]; float wv[4][16]; int t0 = 0, curg = -1;
    const int r0 = tid >> 3, p0 = tid & 7;
    const unsigned d0 = (unsigned)(r0 * 128 + ((p0 ^ (r0 & 7)) << 4)), d1 = d0 + 64 * 128;
    u32x4 s0, s1;
    { const int c = x0 < nl ? x0 : x0 - nl; const bf16_t* kp = ki + (size_t)(c * 128) * 64; s0 = *(const u32x4*)(kp + (size_t)r0 * 64 + p0 * 8); s1 = *(const u32x4*)(kp + (size_t)(r0 + 64) * 64 + p0 * 8); }
    __syncthreads();
    *(LAS u32x4*)(kl + d0) = s0; *(LAS u32x4*)(kl + d1) = s1;
    __syncthreads();
    const unsigned rdo = (unsigned)(rho * 128);
#pragma unroll 1
    for (int x = x0; x < x1; ++x) {
        const int g = x < nl ? gl : gh, c = x < nl ? x : x - nl;
        if (g != curg) { curg = g; t0 = g * 64 + F.wid * 8;
#pragma unroll
            for (int mt = 0; mt < 4; ++mt) {
                const int tokA = b * SEQ + t0 + 2 * mt + ((rho >> 2) & 1), head = (rho & 3) + 4 * (rho >> 3);
#pragma unroll
                for (int kk = 0; kk < 4; ++kk) af[mt][kk] = *(const bf16x8*)(qidx + (size_t)tokA * 1024 + head * 64 + kk * 16 + 8 * hh);
                const float* wp = wi + (size_t)(b * SEQ + t0 + 2 * mt + hh) * 16;
#pragma unroll
                for (int q = 0; q < 4; ++q) { const f32x4 v = *(const f32x4*)(wp + 4 * q); wv[mt][4 * q] = v[0]; wv[mt][4 * q + 1] = v[1]; wv[mt][4 * q + 2] = v[2]; wv[mt][4 * q + 3] = v[3]; } } }
        const unsigned bo = (unsigned)((x - x0) & 1) * 16384u;
        if (x + 1 < x1) { const int cn = (x + 1) < nl ? (x + 1) : (x + 1) - nl; const bf16_t* kp = ki + (size_t)(cn * 128) * 64; s0 = *(const u32x4*)(kp + (size_t)r0 * 64 + p0 * 8); s1 = *(const u32x4*)(kp + (size_t)(r0 + 64) * 64 + p0 * 8); }
#pragma unroll
        for (int tl = 0; tl < 4; ++tl) {
            const int kb = c * 128 + tl * 32;
            if (kb <= t0 + 7) {
                bf16x8 bc[4];
#pragma unroll
                for (int kk = 0; kk < 4; ++kk) bc[kk] = *(const LAS bf16x8*)(kl + bo + tl * 4096 + rdo + (((kk * 2 + hh) ^ (rho & 7)) << 4));
                f32x16 a0 = {}, a1 = {}, a2 = {}, a3 = {};
#pragma unroll
                for (int kk = 0; kk < 4; ++kk) { a0 = __builtin_amdgcn_mfma_f32_32x32x16_bf16(af[0][kk], bc[kk], a0, 0, 0, 0); a1 = __builtin_amdgcn_mfma_f32_32x32x16_bf16(af[1][kk], bc[kk], a1, 0, 0, 0);
                                                  a2 = __builtin_amdgcn_mfma_f32_32x32x16_bf16(af[2][kk], bc[kk], a2, 0, 0, 0); a3 = __builtin_amdgcn_mfma_f32_32x32x16_bf16(af[3][kk], bc[kk], a3, 0, 0, 0); }
#define IDX_EPI(A_, mt_) do { float x_0 = 0.f, x_1 = 0.f, x_2 = 0.f, x_3 = 0.f; _Pragma("unroll") for (int r = 0; r < 16; r += 4) { \
                    x_0 = fmaf(wv[mt_][r], fmaxf(A_[r], 0.f), x_0); x_1 = fmaf(wv[mt_][r + 1], fmaxf(A_[r + 1], 0.f), x_1); x_2 = fmaf(wv[mt_][r + 2], fmaxf(A_[r + 2], 0.f), x_2); x_3 = fmaf(wv[mt_][r + 3], fmaxf(A_[r + 3], 0.f), x_3); } \
                    scores[(size_t)(t0 + 2 * (mt_) + hh) * SEQ + kb + rho] = (x_0 + x_1) + (x_2 + x_3); } while (0)
                IDX_EPI(a0, 0); IDX_EPI(a1, 1); IDX_EPI(a2, 2); IDX_EPI(a3, 3);
#undef IDX_EPI
            }
        }
        if (x + 1 < x1) { *(LAS u32x4*)(kl + (bo ^ 16384u) + d0) = s0; *(LAS u32x4*)(kl + (bo ^ 16384u) + d1) = s1; }
        __syncthreads();
    }
}
__device__ __forceinline__ void phase_idx(const Frame& F0) { const Frame F = fresh(F0);
#pragma unroll 1
    for (int it = F.bid; it < 256; it += F.G) { const int b = it >> 7, pi = (it >> 1) & 63, half = it & 1; idx_unit(F, b, pi, half); }
}

__device__ __forceinline__ unsigned sortable(float f) { const unsigned u = __float_as_uint(f); return (u & 0x80000000u) ? ~u : (u | 0x80000000u); }
__device__ __forceinline__ void topk_row(const Frame& F, int b, int t) {
    int lane = F.lane; asm volatile("" : "+v"(lane));
    const int L = t + 1, tok = b * SEQ + t; unsigned char* ws = F.ws;
    int* sel = (int*)(ws + R_SEL) + (size_t)tok * 256; int* nsel = (int*)(ws + R_NSEL);
    if (lane == 0) nsel[tok] = L < 256 ? L : 256;
    if (L <= 256) { for (int j = lane; j < 256; j += 64) sel[j] = j < L ? j : 0; return; }
    const float* row = (const float*)(ws + R_SCORES) + ((size_t)b * SEQ + t) * SEQ;
    const int nch = (L + 1023) >> 10;
#define TOPK_LOAD_ROW() do { _Pragma("unroll") for (int c = 0; c < 8; ++c) { \
        if (c < nch) { _Pragma("unroll") for (int jj = 0; jj < 4; ++jj) { const int j = c * 4 + jj; const f32x4 v = *(const f32x4*)(row + j * 256 + lane * 4); \
                _Pragma("unroll") for (int e_ = 0; e_ < 4; ++e_) { const int idx = j * 256 + lane * 4 + e_; u[j * 4 + e_] = idx < L ? sortable(v[e_]) : 0u; } } } \
        else { _Pragma("unroll") for (int q = 0; q < 16; ++q) u[c * 16 + q] = 0u; } } } while (0)
    unsigned u[128];
    TOPK_LOAD_ROW();
    unsigned g0 = 0u, g1 = 0u, g2 = 0u, g3 = 0u;
#pragma unroll
    for (int c = 0; c < 8; ++c) if (c < nch) {
#pragma unroll
        for (int jj = 0; jj < 4; ++jj) { const int j = c * 4 + jj; g0 = u[4 * j] > g0 ? u[4 * j] : g0; g1 = u[4 * j + 1] > g1 ? u[4 * j + 1] : g1; g2 = u[4 * j + 2] > g2 ? u[4 * j + 2] : g2; g3 = u[4 * j + 3] > g3 ? u[4 * j + 3] : g3; } }
    unsigned tl = g0 < g1 ? g0 : g1; { const unsigned t2 = g2 < g3 ? g2 : g3; tl = tl < t2 ? tl : t2; }
#pragma unroll
    for (int o = 32; o > 0; o >>= 1) { const unsigned x = (unsigned)__shfl_xor((int)tl, o); tl = x < tl ? x : tl; }
    constexpr int CAP = 2048;
    LAS unsigned* candk = (LAS unsigned*)(F.ldsl + F.wid * (CAP * 8)); LAS unsigned* candi = candk + CAP;
    int C = 0;
#pragma unroll
    for (int c = 0; c < 8; ++c) if (c < nch) {
#pragma unroll
        for (int q = 0; q < 16; ++q) { const int rq = c * 16 + q; const bool pr = u[rq] >= tl; const unsigned long long mm = __ballot(pr);
            const int pos = C + __popcll(mm & ((1ull << lane) - 1ull));
            if (pr && pos < CAP) { candk[pos] = u[rq]; candi[pos] = (unsigned)((rq >> 2) * 256 + lane * 4 + (rq & 3)); }
            C += __popcll(mm); if ((q & 3) == 3) SBAR(); } }
    if (C <= CAP) {
        const int ng = (C + 255) >> 8;
        unsigned ck[32]; int ci[32];
#pragma unroll
        for (int g = 0; g < 8; ++g) {
#pragma unroll
            for (int q = 0; q < 4; ++q) { const int r = g * 4 + q, p = r * 64 + lane; ck[r] = 0u; ci[r] = 0;
                if (g < ng && p < C) { ck[r] = candk[p]; ci[r] = (int)candi[p]; } } }
        unsigned T = 0u, thr_gt = 0u; int need_eq = 0; bool early = false;
        for (int bit = 31; bit >= 0; --bit) {
            const unsigned cnd = T | (1u << bit); int cnt = 0;
#pragma unroll
            for (int g = 0; g < 8; ++g) if (g < ng) {
#pragma unroll
                for (int q = 0; q < 4; ++q) cnt += __popcll(__ballot(ck[g * 4 + q] >= cnd)); }
            if (cnt >= 256) { T = cnd; if (cnt == 256) { early = true; break; } }
        }
        if (early) { thr_gt = T - 1u; need_eq = 0; }
        else { int gtc = 0;
#pragma unroll
            for (int g = 0; g < 8; ++g) if (g < ng) {
#pragma unroll
                for (int q = 0; q < 4; ++q) gtc += __popcll(__ballot(ck[g * 4 + q] > T)); }
            thr_gt = T; need_eq = 256 - gtc; }
        int base = 0, eq_taken = 0;
#pragma unroll
        for (int g = 0; g < 8; ++g) if (g < ng) {
#pragma unroll
            for (int q = 0; q < 4; ++q) { const int r = g * 4 + q; const unsigned v = ck[r];
                const bool iseq = (v == thr_gt) && (need_eq > 0);
                const unsigned long long meq = __ballot(iseq);
                const int eqr = __popcll(meq & ((1ull << lane) - 1ull));
                const bool take = (v > thr_gt) || (iseq && (eq_taken + eqr < need_eq));
                const unsigned long long mt = __ballot(take);
                const int pos = base + __popcll(mt & ((1ull << lane) - 1ull));
                if (take && pos < 256) sel[pos] = ci[r];
                base += __popcll(mt); eq_taken += __popcll(meq); } }
        return;
    }
    asm volatile("" ::: "memory");
    TOPK_LOAD_ROW();
    unsigned T = 0u, thr_gt = 0u; int need_eq = 0; bool early = false;
    for (int bit = 31; bit >= 0; --bit) {
        const unsigned cand = T | (1u << bit); int cnt = 0;
#pragma unroll
        for (int c = 0; c < 8; ++c) if (c < nch) {
#pragma unroll
            for (int q = 0; q < 16; ++q) cnt += __popcll(__ballot(u[c * 16 + q] >= cand)); }
        if (cnt >= 256) { T = cand; if (cnt == 256) { early = true; break; } }
    }
    if (early) { thr_gt = T - 1u; need_eq = 0; }
    else { int gtc = 0;
#pragma unroll
        for (int c = 0; c < 8; ++c) if (c < nch) {
#pragma unroll
            for (int q = 0; q < 16; ++q) gtc += __popcll(__ballot(u[c * 16 + q] > T)); }
        thr_gt = T; need_eq = 256 - gtc; }
    int base = 0, eq_taken = 0;
#pragma unroll
    for (int c = 0; c < 8; ++c) if (c < nch) {
#pragma unroll
        for (int q = 0; q < 16; ++q) { const int rq = c * 16 + q; const unsigned v = u[rq];
            const bool iseq = (v == thr_gt) && (need_eq > 0);
            const unsigned long long meq = __ballot(iseq);
            const int eqr = __popcll(meq & ((1ull << lane) - 1ull));
            const bool take = (v > thr_gt) || (iseq && (eq_taken + eqr < need_eq));
            const unsigned long long mt = __ballot(take);
            const int pos = base + __popcll(mt & ((1ull << lane) - 1ull));
            if (take && pos < 256) sel[pos] = (rq >> 2) * 256 + lane * 4 + (rq & 3);
            base += __popcll(mt); eq_taken += __popcll(meq); } }
}
__device__ __forceinline__ void phase_topk(const Frame& F0) { const Frame F = fresh(F0);
    for (int q = F.bid * 8 + F.wid; q < 8192; q += F.G * 8) { const int b = q >> 12, p = q & 4095; topk_row(F, b, p); topk_row(F, b, SEQ - 1 - p); }
}

namespace att {
constexpr int D = 128, KVBLK = 64, QBLK = 32, SHM_V = 16384, SHM_K = 16384;
constexpr int OFF_K = 2 * SHM_V, OFF_BIAS = 2 * SHM_V + 2 * SHM_K, OFF_WS = OFF_BIAS + 512, OFF_FLAGS = OFF_WS + 2048, OFF_QITEM = OFF_FLAGS + 64;
constexpr float EXIT_T = 44.0f;
#define KSWZ(row, colB) ((row) * 256 + ((colB) ^ (((row) & 7) << 4)))
__device__ __forceinline__ int v_st(int k, int c) { const int kk = (k & ~0xC) | ((k & 4) << 1) | ((k & 8) >> 1); return ((kk >> 3) * 4 + (c >> 5)) * 512 + ((kk & 7) * 32 + (c & 31)) * 2; }
__device__ __forceinline__ int v_rd_base(int lane) { return ((lane & 3) << 3) | (((lane >> 2) & 3) << 6) | (((lane >> 4) & 1) << 5) | (((lane >> 5) & 1) << 8); }
constexpr int v_rd_off(int d0, int ks, int half) { return d0 * 512 + ks * 4096 + half * 2048; }
template <int KB>
__device__ __forceinline__ void qkt(f32x16& p0, f32x16& p1, const char* K_lds, int r32, int hi, const bf16x8* qr) {
    p0 = f32x16{}; p1 = f32x16{};
    const char* kb[4];
#pragma unroll
    for (int dd = 0; dd < 4; ++dd) kb[dd] = K_lds + KB * SHM_K + KSWZ(r32, (dd * 16 + hi * 8) * 2);
#pragma unroll
    for (int d0 = 0; d0 < 8; ++d0) { const char* a = kb[d0 & 3] + (d0 >> 2) * 128;
        bf16x8 b0 = *reinterpret_cast<const bf16x8*>(a);
        bf16x8 b1 = *reinterpret_cast<const bf16x8*>(a + 32 * 256);
        p0 = __builtin_amdgcn_mfma_f32_32x32x16_bf16(b0, qr[d0], p0, 0, 0, 0);
        p1 = __builtin_amdgcn_mfma_f32_32x32x16_bf16(b1, qr[d0], p1, 0, 0, 0); }
}
template <int VB>
__device__ __forceinline__ void pv_tile(f32x16* o, int vb0, bf16x8 pa0, bf16x8 pa1, bf16x8 pa2, bf16x8 pa3) {
#define TRRD(dst, off) asm volatile("ds_read_b64_tr_b16 %0, %1 offset:%2" : "=&v"(dst) : "v"(vb0), "i"(off) : "memory")
#define PV_D0(d0) do { s16x4 l0, l1, l2, l3, h0, h1, h2, h3; constexpr int b_ = VB * SHM_V + v_rd_off(d0, 0, 0); \
        TRRD(l0, b_); TRRD(h0, b_ + 2048); TRRD(l1, b_ + 4096); TRRD(h1, b_ + 6144); TRRD(l2, b_ + 8192); TRRD(h2, b_ + 10240); TRRD(l3, b_ + 12288); TRRD(h3, b_ + 14336); \
        asm volatile("s_waitcnt lgkmcnt(0)" ::: "memory"); SBAR(); \
        o[d0] = __builtin_amdgcn_mfma_f32_32x32x16_bf16(pa0, (bf16x8){l0[0], l0[1], l0[2], l0[3], h0[0], h0[1], h0[2], h0[3]}, o[d0], 0, 0, 0); \
        o[d0] = __builtin_amdgcn_mfma_f32_32x32x16_bf16(pa1, (bf16x8){l1[0], l1[1], l1[2], l1[3], h1[0], h1[1], h1[2], h1[3]}, o[d0], 0, 0, 0); \
        o[d0] = __builtin_amdgcn_mfma_f32_32x32x16_bf16(pa2, (bf16x8){l2[0], l2[1], l2[2], l2[3], h2[0], h2[1], h2[2], h2[3]}, o[d0], 0, 0, 0); \
        o[d0] = __builtin_amdgcn_mfma_f32_32x32x16_bf16(pa3, (bf16x8){l3[0], l3[1], l3[2], l3[3], h3[0], h3[1], h3[2], h3[3]}, o[d0], 0, 0, 0); } while (0)
    PV_D0(0); PV_D0(1); PV_D0(2); PV_D0(3);
#undef PV_D0
#undef TRRD
}
#define PK4(P, B_, OUT) do { unsigned a0 = cvtpk(P[B_+0], P[B_+1]), a1 = cvtpk(P[B_+2], P[B_+3]); \
        unsigned b0 = cvtpk(P[B_+4], P[B_+5]), b1 = cvtpk(P[B_+6], P[B_+7]); \
        auto r0 = __builtin_amdgcn_permlane32_swap(a0, b0, false, false); auto r1 = __builtin_amdgcn_permlane32_swap(a1, b1, false, false); \
        u32x4 w = {r0[0], r1[0], r0[1], r1[1]}; OUT = *reinterpret_cast<bf16x8*>(&w); } while (0)
__device__ __forceinline__ float swap_max(float x) { auto rr = __builtin_amdgcn_permlane32_swap(__float_as_uint(x), __float_as_uint(x), false, false); return fmaxf(__uint_as_float(rr[0]), __uint_as_float(rr[1])); }
__device__ __forceinline__ float swap_sum(float x) { auto rr = __builtin_amdgcn_permlane32_swap(__float_as_uint(x), __float_as_uint(x), false, false); return __uint_as_float(rr[0]) + __uint_as_float(rr[1]); }
__device__ __forceinline__ float swap_lo(float x) { auto rr = __builtin_amdgcn_permlane32_swap(__float_as_uint(x), __float_as_uint(x), false, false); return __uint_as_float(rr[0]); }


__device__ __forceinline__ void fox_sm(f32x16& p0, f32x16& p1, const float* bl, int kb_, int qlo, int qrow, int hi, int r32, float& m_reg, float& l_reg, f32x16* o, float* al_l,
                                       bf16x8& pa0, bf16x8& pa1, bf16x8& pa2, bf16x8& pa3) {
#pragma unroll
    for (int g = 0; g < 4; ++g) { const f32x4 b0v = *(const f32x4*)(bl + 8 * g + 4 * hi), b1v = *(const f32x4*)(bl + 32 + 8 * g + 4 * hi);
#pragma unroll
        for (int i = 0; i < 4; ++i) { p0[4 * g + i] = fmaf(p0[4 * g + i], C2, b0v[i]); p1[4 * g + i] = fmaf(p1[4 * g + i], C2, b1v[i]); } }
    if (kb_ + KVBLK - 1 > qlo) { const float NEG = -__builtin_inff();
#pragma unroll
        for (int r = 0; r < 16; ++r) { const int key = kb_ + crow(r, hi); if (key > qrow) p0[r] = NEG; if (key + 32 > qrow) p1[r] = NEG; } }
    float pmax = p0[0];
#pragma unroll
    for (int r = 1; r < 16; ++r) pmax = fmaxf(pmax, p0[r]);
#pragma unroll
    for (int r = 0; r < 16; ++r) pmax = fmaxf(pmax, p1[r]);
    pmax = swap_max(pmax);
    const float mn = fmaxf(m_reg, pmax), alpha = __builtin_amdgcn_exp2f(m_reg - mn); m_reg = mn;
    float ps = 0.f;
#pragma unroll
    for (int r = 0; r < 16; ++r) { p0[r] = __builtin_amdgcn_exp2f(p0[r] - mn); p1[r] = __builtin_amdgcn_exp2f(p1[r] - mn); ps += p0[r] + p1[r]; }
    ps = swap_sum(ps); l_reg = l_reg * alpha + ps;
    if (__any(alpha < 1.f)) { if (hi == 0) al_l[r32] = alpha; asm volatile("s_waitcnt lgkmcnt(0)" ::: "memory");
#pragma unroll
        for (int r = 0; r < 16; ++r) { const float a = al_l[crow(r, hi)];
#pragma unroll
            for (int d_ = 0; d_ < 4; ++d_) o[d_][r] *= a; } }
    PK4(p0, 0, pa0); PK4(p0, 8, pa1); PK4(p1, 0, pa2); PK4(p1, 8, pa3);
}
__device__ __forceinline__ void sb_half(f32x16& pz, int keybase, int qrow, int hi, float& R, const bf16x8* triA, bool needmask) {
    f32x16 X;
#pragma unroll
    for (int r = 0; r < 16; ++r) { const float zz = pz[r] * C2; const bool valid = !needmask || (keybase + crow(r, hi) < qrow);
        const float l2 = fmaxf(zz, 0.f) + __builtin_amdgcn_logf(1.0f + __builtin_amdgcn_exp2f(-fabsf(zz)));
        X[r] = valid ? -l2 : 0.f; pz[r] = valid ? zz : -__builtin_inff(); }
    f32x16 Y;
#pragma unroll
    for (int r = 0; r < 16; ++r) Y[r] = R;
#pragma unroll
    for (int s = 0; s < 2; ++s) {
        const unsigned h0 = cvtpk(X[8 * s + 0], X[8 * s + 1]), h1 = cvtpk(X[8 * s + 2], X[8 * s + 3]), h2 = cvtpk(X[8 * s + 4], X[8 * s + 5]), h3 = cvtpk(X[8 * s + 6], X[8 * s + 7]);
        const unsigned l0 = cvtpk(X[8 * s + 0] - bflo(h0), X[8 * s + 1] - bfhi(h0)), l1 = cvtpk(X[8 * s + 2] - bflo(h1), X[8 * s + 3] - bfhi(h1));
        const unsigned l2 = cvtpk(X[8 * s + 4] - bflo(h2), X[8 * s + 5] - bfhi(h2)), l3 = cvtpk(X[8 * s + 6] - bflo(h3), X[8 * s + 7] - bfhi(h3));
        u32x4 wh = {h0, h1, h2, h3}, wl = {l0, l1, l2, l3};
        Y = __builtin_amdgcn_mfma_f32_32x32x16_bf16(triA[s], *reinterpret_cast<bf16x8*>(&wh), Y, 0, 0, 0);
        Y = __builtin_amdgcn_mfma_f32_32x32x16_bf16(triA[s], *reinterpret_cast<bf16x8*>(&wl), Y, 0, 0, 0); }
#pragma unroll
    for (int r = 0; r < 16; ++r) pz[r] = __builtin_amdgcn_exp2f(pz[r] + Y[r]);
    R = swap_lo(Y[0]);
}
__device__ __forceinline__ void sb_sm(f32x16& p0, f32x16& p1, int kb_, int qlo, int qrow, int hi, float& R, const bf16x8* triA, bf16x8& pa0, bf16x8& pa1, bf16x8& pa2, bf16x8& pa3) {
    const bool needmask = (kb_ + KVBLK - 1 >= qlo);
    sb_half(p1, kb_ + 32, qrow, hi, R, triA, needmask);
    sb_half(p0, kb_, qrow, hi, R, triA, needmask);
    PK4(p0, 0, pa0); PK4(p0, 8, pa1); PK4(p1, 0, pa2); PK4(p1, 8, pa3);
}

template <int MODE>
__device__ __forceinline__ void attn_unit(const bf16_t* Q, const bf16_t* Kh, const bf16_t* Vh, const float* cum, bf16_t* O, int P0, char* lds, float kmaxc) {
    int tid = threadIdx.x; asm volatile("" : "+v"(tid));
    const int wid = __builtin_amdgcn_readfirstlane(tid >> 6), lane = tid & 63, r32 = lane & 31, hi = lane >> 5;
    const int NT = P0 / KVBLK + 4;
    char* V_lds = lds; char* K_lds = lds + OFF_K; float* bias_l = (float*)(lds + OFF_BIAS);
    float* wsl = (float*)(lds + OFF_WS) + wid * 64; float* li_l = wsl; float* al_l = wsl + 32;
    const int qlo = P0 + wid * QBLK, qrow = qlo + r32;
    bf16x8 qr[8];
#pragma unroll
    for (int d0 = 0; d0 < 8; ++d0) qr[d0] = *(const bf16x8*)(Q + (size_t)qrow * D + d0 * 16 + hi * 8);
    const int sr = tid >> 4, sc = (tid & 15) * 8, vst0 = v_st(sr, sc), vst1 = v_st(32 + sr, sc), kws = KSWZ(sr, sc * 2);
    const int vb0 = (int)(uintptr_t)V_lds + v_rd_base(lane);
    const float cumref = (MODE == 0) ? cum[P0] : 0.f;
    int* flg = (int*)(lds + OFF_FLAGS);
    float qn = 0.f;
    if (MODE == 0) { float ss = 0.f;
#pragma unroll
        for (int d0 = 0; d0 < 8; ++d0)
#pragma unroll
            for (int j = 0; j < 8; ++j) { const float x = bf2f((bf16_t)qr[d0][j]); ss = fmaf(x, x, ss); }
        ss = swap_sum(ss); qn = sqrtf(ss) * kmaxc * 1.001f; }
    float m_reg = -1e30f, l_reg = 0.f, R = 0.f; f32x16 o[4] = {};
    bf16x8 triA[2];
    if (MODE == 1) {
#pragma unroll
        for (int s = 0; s < 2; ++s)
#pragma unroll
            for (int j = 0; j < 8; ++j) { const int rho = 16 * s + 8 * (j >> 2) + 4 * hi + (j & 3); triA[s][j] = (rho >= r32) ? (short)0x3F80 : (short)0; }
    }
    bf16x8 st_k0, st_k1, st_v0, st_v1; float st_b = 0.f;
#define TILE_KB(t) ((NT - 1 - (t)) * KVBLK)
#define SLOAD(kb_) do { st_v0 = *(const bf16x8*)(Vh + (size_t)((kb_) + sr) * D + sc); st_v1 = *(const bf16x8*)(Vh + (size_t)((kb_) + 32 + sr) * D + sc); \
                        st_k0 = *(const bf16x8*)(Kh + (size_t)((kb_) + sr) * D + sc); st_k1 = *(const bf16x8*)(Kh + (size_t)((kb_) + 32 + sr) * D + sc); \
                        if (MODE == 0 && tid < 64) st_b = (cumref - cum[(kb_) + tid]) * LOG2E; } while (0)
#define SWRITE(bf) do { *(bf16x8*)(V_lds + (bf) * SHM_V + vst0) = st_v0; *(bf16x8*)(V_lds + (bf) * SHM_V + vst1) = st_v1; \
                        *(bf16x8*)(K_lds + (bf) * SHM_K + kws) = st_k0; *(bf16x8*)(K_lds + (bf) * SHM_K + kws + 32 * 256) = st_k1; \
                        if (MODE == 0 && tid < 64) bias_l[(bf) * 64 + tid] = st_b; } while (0)
    __syncthreads();
    SLOAD(TILE_KB(0)); SWRITE(0);
    __syncthreads();
    f32x16 p0, p1; bf16x8 pa0, pa1, pa2, pa3;
#define STEP(BUF, t) do { const int kb_ = TILE_KB(t); \
        if ((t) + 1 < NT) SLOAD(TILE_KB((t) + 1)); \
        SBAR(); qkt<BUF>(p0, p1, K_lds, r32, hi, qr); \
        if (MODE == 0) fox_sm(p0, p1, bias_l + (BUF) * 64, kb_, qlo, qrow, hi, r32, m_reg, l_reg, o, al_l, pa0, pa1, pa2, pa3); \
        else sb_sm(p0, p1, kb_, qlo, qrow, hi, R, triA, pa0, pa1, pa2, pa3); \
        SBAR(); pv_tile<BUF>(o, vb0, pa0, pa1, pa2, pa3); \
        if ((t) + 1 < NT) SWRITE((BUF) ^ 1); \
        __syncthreads(); } while (0)
    for (int t = 0; t < NT; t += 2) {
        STEP(0, t); STEP(1, t + 1);
        const int kbc = TILE_KB(t + 1); if (kbc == 0) break;
        bool done;
        if (MODE == 0) { const float edge = (cumref - cum[kbc - 1]) * LOG2E; done = (qn + edge - m_reg) < -EXIT_T; }
        else done = R < -EXIT_T;
        const int par = (t >> 1) & 1;
        if (lane == 0) flg[par * 8 + wid] = 0;
        const bool wdone = __all(done);
        if (lane == 0 && wdone) flg[par * 8 + wid] = 1;
        __syncthreads();
        int alld = 1;
#pragma unroll
        for (int w = 0; w < 8; ++w) alld &= flg[par * 8 + w];
        if (alld) break;
    }
    __syncthreads();
#undef STEP
#undef SLOAD
#undef SWRITE
#undef TILE_KB
    float rli[16];
    if (MODE == 0) { if (hi == 0) li_l[r32] = l_reg; asm volatile("s_waitcnt lgkmcnt(0)" ::: "memory");
#pragma unroll
        for (int r = 0; r < 16; ++r) rli[r] = __builtin_amdgcn_rcpf(li_l[crow(r, hi)]); }
    bf16_t* Ow = O + (size_t)(wid * QBLK) * 3072;
#pragma unroll
    for (int r = 0; r < 16; ++r) { const int orow = crow(r, hi);
#pragma unroll
        for (int d0 = 0; d0 < 4; ++d0) { const float v = (MODE == 0) ? o[d0][r] * rli[r] : o[d0][r];
            const float vn = __shfl_xor(v, 1);
            if ((r32 & 1) == 0) *(unsigned*)(Ow + (size_t)orow * 3072 + d0 * 32 + r32) = cvtpk(v, vn); } }
}
}

__device__ __forceinline__ void sparse_query(const Frame& F, int tok, char* ldsw) {
    unsigned char* ws = F.ws; const int lane = F.lane, g = lane >> 4, i16 = lane & 15;
    const bf16_t* qcat = (const bf16_t*)(ws + R_QCAT) + (size_t)tok * 2304; const bf16_t* kbase = (const bf16_t*)(ws + R_KCAT) + (size_t)(tok >> 13) * SEQ * 288;
    const int* sel = (const int*)(ws + R_SEL) + (size_t)tok * 256; const int ns = ((const int*)(ws + R_NSEL))[tok]; const int ntile = (ns + 31) >> 5;
    bf16x8 qf[9];
#pragma unroll
    for (int st = 0; st < 9; ++st) { qf[st] = (bf16x8){0, 0, 0, 0, 0, 0, 0, 0}; if (i16 < 8) qf[st] = *(const bf16x8*)(qcat + i16 * 288 + st * 32 + 8 * g); }
    const int rA = lane >> 2, cq = lane & 3;
    float m = -1e30f, l = 0.f; f32x4 oT[16];
#pragma unroll
    for (int rb = 0; rb < 16; ++rb) oT[rb] = (f32x4){0.f, 0.f, 0.f, 0.f};
    const unsigned ldso = (unsigned)(uintptr_t)ldsw;
    const unsigned vb = ldso + (unsigned)((4 * g + (i16 >> 2)) * 592 + (i16 & 3) * 8);
    constexpr float SC2 = SCALE * LOG2E;
    bf16x8 stg[18];
#define GATHER(tile_) do { const int j0 = (tile_) * 32 + rA, j1 = j0 + 16; const int s0 = j0 < ns ? sel[j0] : 0, s1 = j1 < ns ? sel[j1] : 0; \
        const bf16_t* p0_ = kbase + (size_t)s0 * 288 + cq * 8; const bf16_t* p1_ = kbase + (size_t)s1 * 288 + cq * 8; \
        _Pragma("unroll") for (int c = 0; c < 9; ++c) { stg[2 * c] = *(const bf16x8*)(p0_ + c * 32); stg[2 * c + 1] = *(const bf16x8*)(p1_ + c * 32); } } while (0)
    GATHER(0);
    for (int tile = 0; tile < ntile; ++tile) {
#pragma unroll
        for (int c = 0; c < 9; ++c) { *(bf16x8*)(ldsw + rA * 592 + c * 64 + cq * 16) = stg[2 * c]; *(bf16x8*)(ldsw + (16 + rA) * 592 + c * 64 + cq * 16) = stg[2 * c + 1]; }
        if (tile + 1 < ntile) GATHER(tile + 1);
        asm volatile("s_waitcnt lgkmcnt(0)" ::: "memory"); SBAR();
        f32x4 acc[2];
#pragma unroll
        for (int mt = 0; mt < 2; ++mt) { acc[mt] = (f32x4){0.f, 0.f, 0.f, 0.f};
#pragma unroll
            for (int st = 0; st < 9; ++st) { const bf16x8 a = *(const bf16x8*)(ldsw + (16 * mt + i16) * 592 + st * 64 + g * 16);
                acc[mt] = __builtin_amdgcn_mfma_f32_16x16x32_bf16(a, qf[st], acc[mt], 0, 0, 0); } }
        float tmax = -__builtin_inff();
#pragma unroll
        for (int mt = 0; mt < 2; ++mt)
#pragma unroll
            for (int r = 0; r < 4; ++r) { const int key = tile * 32 + 16 * mt + 4 * g + r; float x = acc[mt][r] * SC2; if (key >= ns) x = -__builtin_inff(); acc[mt][r] = x; tmax = fmaxf(tmax, x); }
        tmax = fmaxf(tmax, __shfl_xor(tmax, 16)); tmax = fmaxf(tmax, __shfl_xor(tmax, 32));
        const float mn = fmaxf(m, tmax), alpha = __builtin_amdgcn_exp2f(m - mn); m = mn;
        float ps = 0.f;
#pragma unroll
        for (int mt = 0; mt < 2; ++mt)
#pragma unroll
            for (int r = 0; r < 4; ++r) { acc[mt][r] = __builtin_amdgcn_exp2f(acc[mt][r] - mn); ps += acc[mt][r]; }
        ps += __shfl_xor(ps, 16); ps += __shfl_xor(ps, 32);
        l = l * alpha + ps;
#pragma unroll
        for (int rb = 0; rb < 16; ++rb) oT[rb] *= alpha;
        const bf16x8 pf = pack8(acc[0], acc[1]);
#define TRRD2(dst, off) asm volatile("ds_read_b64_tr_b16 %0, %1 offset:%2" : "=&v"(dst) : "v"(vb), "i"(off) : "memory")
#define PVRB4(rb) do { s16x4 ta0, tb0, ta1, tb1, ta2, tb2, ta3, tb3; \
        TRRD2(ta0, ((rb) + 0) * 32); TRRD2(tb0, ((rb) + 0) * 32 + 16 * 592); TRRD2(ta1, ((rb) + 1) * 32); TRRD2(tb1, ((rb) + 1) * 32 + 16 * 592); \
        TRRD2(ta2, ((rb) + 2) * 32); TRRD2(tb2, ((rb) + 2) * 32 + 16 * 592); TRRD2(ta3, ((rb) + 3) * 32); TRRD2(tb3, ((rb) + 3) * 32 + 16 * 592); \
        asm volatile("s_waitcnt lgkmcnt(0)" ::: "memory"); SBAR(); \
        oT[(rb) + 0] = __builtin_amdgcn_mfma_f32_16x16x32_bf16((bf16x8){ta0[0], ta0[1], ta0[2], ta0[3], tb0[0], tb0[1], tb0[2], tb0[3]}, pf, oT[(rb) + 0], 0, 0, 0); \
        oT[(rb) + 1] = __builtin_amdgcn_mfma_f32_16x16x32_bf16((bf16x8){ta1[0], ta1[1], ta1[2], ta1[3], tb1[0], tb1[1], tb1[2], tb1[3]}, pf, oT[(rb) + 1], 0, 0, 0); \
        oT[(rb) + 2] = __builtin_amdgcn_mfma_f32_16x16x32_bf16((bf16x8){ta2[0], ta2[1], ta2[2], ta2[3], tb2[0], tb2[1], tb2[2], tb2[3]}, pf, oT[(rb) + 2], 0, 0, 0); \
        oT[(rb) + 3] = __builtin_amdgcn_mfma_f32_16x16x32_bf16((bf16x8){ta3[0], ta3[1], ta3[2], ta3[3], tb3[0], tb3[1], tb3[2], tb3[3]}, pf, oT[(rb) + 3], 0, 0, 0); } while (0)
        PVRB4(0); PVRB4(4); PVRB4(8); PVRB4(12);
#undef PVRB4
#undef TRRD2
        SBAR();
    }
#undef GATHER
    const float rl = 1.0f / l;
    if (i16 < 8) { bf16_t* op = (bf16_t*)(ws + R_OLAT) + (size_t)tok * 2048 + i16 * 256 + 4 * g;
#pragma unroll
        for (int rb = 0; rb < 16; ++rb) { u32x2 w; w.x = cvtpk(oT[rb][0] * rl, oT[rb][1] * rl); w.y = cvtpk(oT[rb][2] * rl, oT[rb][3] * rl); *(u32x2*)(op + rb * 16) = w; } }
}
#ifdef ATT_SUB
#define ASUB(k) ((k) == ATT_SUB)
#else
#define ASUB(k) true
#endif
__device__ __forceinline__ void phase_attn(const Frame& F0, int l, int rep) { const Frame F = fresh(F0);
    unsigned char* ws = F.ws; char* lds = (char*)F.lds;
    const bf16_t* qkv = (const bf16_t*)(ws + R_QKV); const size_t TS = (size_t)NTOK * 1024;
    unsigned* qctr = (unsigned*)(ws + WS_CTL) + CW_QCTR + l * 64 + rep * 16; const unsigned* kmx = (const unsigned*)(ws + WS_CTL) + CW_KMAX + l * 16;
    int* qitem = (int*)(lds + att::OFF_QITEM);
#pragma unroll 1
    for (;;) {
        __syncthreads();
        if (F.tid == 0) qitem[0] = (int)atomicAdd(qctr, 1u);
        __syncthreads();
        const int it = qitem[0];
        if (it >= 1024) break;
        const int md = it >> 9, j = it & 511, qb = 31 - (j >> 4), bh = j & 15, b = bh >> 3, h = bh & 7, P0 = qb * 256;
        if (!ASUB(md)) continue;
        const bf16_t* Q = qkv + (size_t)(md * 3 + 0) * TS + (size_t)bh * SEQ * 128; const bf16_t* K = qkv + (size_t)(md * 3 + 1) * TS + (size_t)bh * SEQ * 128; const bf16_t* V = qkv + (size_t)(md * 3 + 2) * TS + (size_t)bh * SEQ * 128;
        const float* cum = (const float*)(ws + WS_CUM) + (size_t)bh * SEQ;
        bf16_t* Ob = (bf16_t*)(ws + R_OA) + (size_t)b * SEQ * 3072 + (md + 1) * 1024 + h * 128;
        if (md == 0) { const float kmaxc = sqrtf(__uint_as_float(kmx[bh])) * C2; att::attn_unit<0>(Q, K, V, cum, Ob + (size_t)P0 * 3072, P0, lds, kmaxc); }
        else att::attn_unit<1>(Q, K, V, cum, Ob + (size_t)P0 * 3072, P0, lds, 0.f);
    }
    __syncthreads();
    char* ldsw = lds + F.wid * 18944;
#pragma unroll 1
    for (int rep = 0; rep < NREP(2); ++rep)
#pragma unroll 1
    for (int tok = F.bid * 8 + F.wid; tok < NTOK; tok += F.G * 8) if (ASUB(2)) sparse_query(F, tok, ldsw);
}

__device__ __forceinline__ void ln_row(const bf16_t* src, const float* g, const float* bta, float* of, bf16_t* ob, int lane, unsigned char* oq = nullptr, float* osc = nullptr) {
    f32x4 v[8]; float s = 0.f;
#pragma unroll
    for (int i = 0; i < 4; ++i) { const u32x4 w = *(const u32x4*)(src + (i * 64 + lane) * 8);
        v[2 * i] = (f32x4){bflo(w.x), bfhi(w.x), bflo(w.y), bfhi(w.y)}; v[2 * i + 1] = (f32x4){bflo(w.z), bfhi(w.z), bflo(w.w), bfhi(w.w)};
        s += (v[2 * i][0] + v[2 * i][1]) + (v[2 * i][2] + v[2 * i][3]) + (v[2 * i + 1][0] + v[2 * i + 1][1]) + (v[2 * i + 1][2] + v[2 * i + 1][3]); }
    s = wave_sum(s); const float mu = s * (1.0f / 2048.0f); float q = 0.f;
#pragma unroll
    for (int i = 0; i < 8; ++i) { const f32x4 d = v[i] - mu; q += (d[0] * d[0] + d[1] * d[1]) + (d[2] * d[2] + d[3] * d[3]); }
    q = wave_sum(q); const float rstd = rsqrtf(q * (1.0f / 2048.0f) + 1e-5f);
    float amax = 0.f;
#pragma unroll
    for (int i = 0; i < 4; ++i) { const int c = (i * 64 + lane) * 8; const f32x4 g0 = *(const f32x4*)(g + c), g1 = *(const f32x4*)(g + c + 4), b0 = *(const f32x4*)(bta + c), b1 = *(const f32x4*)(bta + c + 4);
        const f32x4 y0 = (v[2 * i] - mu) * rstd * g0 + b0, y1 = (v[2 * i + 1] - mu) * rstd * g1 + b1; v[2 * i] = y0; v[2 * i + 1] = y1;
        if (of) { *(f32x4*)(of + c) = y0; *(f32x4*)(of + c + 4) = y1; }
        if (ob) pg8::st_bf16x8(ob + c, y0, y1);
        if (oq) { amax = fmaxf(amax, fmaxf(fmaxf(fmaxf(fabsf(y0[0]), fabsf(y0[1])), fmaxf(fabsf(y0[2]), fabsf(y0[3]))), fmaxf(fmaxf(fabsf(y1[0]), fabsf(y1[1])), fmaxf(fabsf(y1[2]), fabsf(y1[3]))))); } }
    if (oq) {
        for (int o = 32; o > 0; o >>= 1) amax = fmaxf(amax, __shfl_xor(amax, o));
        amax = fmaxf(amax, 1e-20f); const float qi = 127.0f / amax; if (lane == 0) *osc = amax * (1.0f / 127.0f);
#pragma unroll
        for (int i = 0; i < 4; ++i) { u32x2 w;
#pragma unroll
            for (int h = 0; h < 2; ++h) { const f32x4 y = v[2 * i + h]; unsigned pk = 0u;
#pragma unroll
                for (int j = 0; j < 4; ++j) pk |= ((unsigned)(int)rintf(y[j] * qi) & 0xffu) << (8 * j);
                w[h] = pk; }
            *(u32x2*)(oq + (i * 64 + lane) * 8) = w; } }
}
__device__ __forceinline__ void phase_ln1_router(const Frame& F0, const Params& P, int l) { const Frame F = fresh(F0);
    unsigned char* ws = F.ws; const int lane = F.lane, wid = F.wid;
    const bf16_t* pre1 = (const bf16_t*)(ws + R_PRE1); float* x1f = (float*)(ws + M_X1F); bf16_t* x1b = (bf16_t*)(ws + M_X1B); unsigned char* x1q = (unsigned char*)(ws + M_X1Q); float* x1s = (float*)(ws + M_X1S);
    const float* g = F.in(11) + l * DM; const float* bt = F.in(12) + l * DM; const float* wr = F.in(13) + (size_t)l * DM * NEXP; const float* br = F.in(14) + l * NEXP;
    unsigned* cnt = (unsigned*)(ws + WS_CTL) + CW_CNT + l * 2048;
    int* tok_e = (int*)(ws + M_TOKE); int* tok_pos = (int*)(ws + M_TOKPOS); float* tok_w = (float*)(ws + M_TOKW);
    float* red = (float*)F.lds;
    float* lg = (float*)(F.lds + 32768);
#pragma unroll 1
    for (int blk = F.bid; blk < NTOK / 64; blk += F.G) {
        const int tok0 = blk * 64;
#pragma unroll 1
        for (int i = 0; i < 8; ++i) { const int tok = tok0 + wid * 8 + i; ln_row(pre1 + (size_t)tok * DM, g, bt, x1f + (size_t)tok * DM, x1b + (size_t)tok * DM, lane, x1q + (size_t)tok * DM, x1s + tok); }
        asm volatile("s_waitcnt vmcnt(0)" ::: "memory"); __syncthreads();
        { const int grp = wid >> 2, kq = wid & 3, i32 = lane & 31, hk = lane >> 5; f32x16 acc = {};
          const float* arow = x1f + (size_t)(tok0 + grp * 32 + i32) * DM + kq * 512 + 4 * hk; const float* bcol = wr + (size_t)(kq * 512 + 4 * hk) * NEXP + i32;
#pragma unroll 4
          for (int c8 = 0; c8 < 64; ++c8) { const f32x4 a4 = *(const f32x4*)(arow + c8 * 8);
              const float b0 = bcol[(size_t)(c8 * 8 + 0) * NEXP], b1 = bcol[(size_t)(c8 * 8 + 1) * NEXP], b2 = bcol[(size_t)(c8 * 8 + 2) * NEXP], b3 = bcol[(size_t)(c8 * 8 + 3) * NEXP];
              acc = __builtin_amdgcn_mfma_f32_32x32x2f32(a4[0], b0, acc, 0, 0, 0); acc = __builtin_amdgcn_mfma_f32_32x32x2f32(a4[1], b1, acc, 0, 0, 0);
              acc = __builtin_amdgcn_mfma_f32_32x32x2f32(a4[2], b2, acc, 0, 0, 0); acc = __builtin_amdgcn_mfma_f32_32x32x2f32(a4[3], b3, acc, 0, 0, 0); }
#pragma unroll
          for (int r = 0; r < 16; ++r) red[(wid * 16 + r) * 64 + lane] = acc[r]; }
        __syncthreads();
        if ((wid & 3) == 0) { const int grp = wid >> 2, hk = lane >> 5, e = lane & 31; const float be = br[e];
#pragma unroll
            for (int r = 0; r < 16; ++r) { const float v = red[((wid + 0) * 16 + r) * 64 + lane] + red[((wid + 1) * 16 + r) * 64 + lane] + red[((wid + 2) * 16 + r) * 64 + lane] + red[((wid + 3) * 16 + r) * 64 + lane] + be;
                lg[(grp * 32 + crow(r, hk)) * 33 + e] = v; }
            asm volatile("s_waitcnt lgkmcnt(0)" ::: "memory"); SBAR();
            const int tk = lane & 31; float v[32];
#pragma unroll
            for (int e2 = 0; e2 < 32; ++e2) v[e2] = lg[(grp * 32 + tk) * 33 + e2];
            int ek[4]; float vk[4];
#pragma unroll
            for (int k = 0; k < 4; ++k) { float best = -__builtin_inff(); int bi = 0;
#pragma unroll
                for (int e2 = 0; e2 < 32; ++e2) if (v[e2] > best) { best = v[e2]; bi = e2; }
                ek[k] = bi; vk[k] = best;
#pragma unroll
                for (int e2 = 0; e2 < 32; ++e2) v[e2] = (e2 == bi) ? -__builtin_inff() : v[e2]; }
            float wk[4], sw = 0.f;
#pragma unroll
            for (int k = 0; k < 4; ++k) { wk[k] = __expf(vk[k] - vk[0]); sw += wk[k]; }
            const float rs = 1.0f / sw;
            const bool act = lane < 32; unsigned myc = 0u;
#pragma unroll 1
            for (int E = 0; E < 32; ++E) { unsigned c = 0u;
#pragma unroll
                for (int k = 0; k < 4; ++k) c += (unsigned)__popcll(__ballot(act && ek[k] == E));
                if (lane == E) myc = c; }
            unsigned run = 0u; if (lane < 32 && myc > 0u) run = atomicAdd(&cnt[lane * 64], myc);
            int pk[4];
#pragma unroll
            for (int k = 0; k < 4; ++k) { pk[k] = 0;
#pragma unroll 1
                for (int E = 0; E < 32; ++E) { const unsigned long long mm = __ballot(act && ek[k] == E); const unsigned basev = (unsigned)__shfl((int)run, E);
                    if (act && ek[k] == E) pk[k] = (int)(basev + (unsigned)__popcll(mm & ((1ull << lane) - 1ull)));
                    if (lane == E) run += (unsigned)__popcll(mm); } }
            if (act) { const int tok = tok0 + grp * 32 + tk;
#pragma unroll
                for (int k = 0; k < 4; ++k) { tok_e[tok * 4 + k] = ek[k]; tok_pos[tok * 4 + k] = pk[k]; tok_w[tok * 4 + k] = wk[k] * rs; } }
        }
        __syncthreads();
    }
}
__device__ __forceinline__ void phase_moe_gather(const Frame& F0, int l) { const Frame F = fresh(F0);
    unsigned char* ws = F.ws; const int lane = F.lane;
    const unsigned* cnt = (const unsigned*)(ws + WS_CTL) + CW_CNT + l * 2048; unsigned* meta = (unsigned*)(ws + WS_CTL) + CW_META + l * 512;
    unsigned* offs = (unsigned*)(F.lds + LDS_MISC + 64);
    if (F.tid == 0) { unsigned o = 0u; for (int e = 0; e < 32; ++e) { offs[e] = o; o += (cnt[e * 64] + 255u) & ~255u; } offs[32] = o;
        if (F.bid == 0) { meta[0] = o >> 8; for (int e = 0; e < 32; ++e) for (unsigned t = offs[e] >> 8; t < (offs[e + 1] >> 8); ++t) meta[1 + t] = (unsigned)e; } }
    __syncthreads();
    const int* tok_e = (const int*)(ws + M_TOKE); const int* tok_pos = (const int*)(ws + M_TOKPOS); const float* tok_w = (const float*)(ws + M_TOKW);
    int* tok_dst = (int*)(ws + M_TOKDST); float* roww = (float*)(ws + M_ROWW);
    const unsigned char* x1q = (const unsigned char*)(ws + M_X1Q); const float* x1s = (const float*)(ws + M_X1S); unsigned char* xs = (unsigned char*)(ws + M_XS); float* rowsx = (float*)(ws + M_ROWSX);
    for (int it = F.bid * 8 + F.wid; it < NTOK * 4; it += F.G * 8) { const int tok = it >> 2;
        const int e = tok_e[it]; const unsigned dst = offs[e] + (unsigned)tok_pos[it];
        if (lane == 0) { tok_dst[it] = (int)dst; roww[dst] = tok_w[it]; rowsx[dst] = x1s[tok]; }
        const u32x4* sp = (const u32x4*)(x1q + (size_t)tok * DM); u32x4* dp = (u32x4*)(xs + (size_t)dst * DM);
#pragma unroll
        for (int i = 0; i < 2; ++i) dp[i * 64 + lane] = sp[i * 64 + lane]; }
    __syncthreads();
}
__device__ __forceinline__ void phase_combine(const Frame& F0) { const Frame F = fresh(F0);
    unsigned char* ws = F.ws; const int lane = F.lane;
    const bf16_t* x1b = (const bf16_t*)(ws + M_X1B); const bf16_t* ys = (const bf16_t*)(ws + M_XS); const int* tok_dst = (const int*)(ws + M_TOKDST);
    bf16_t* hb = (bf16_t*)(ws + M_HB); unsigned char* hq = (unsigned char*)(ws + M_HQ); float* hsc = (float*)(ws + M_HSC);
    for (int tok = F.bid * 8 + F.wid; tok < NTOK; tok += F.G * 8) {
        const int d0 = tok_dst[tok * 4], d1 = tok_dst[tok * 4 + 1], d2 = tok_dst[tok * 4 + 2], d3 = tok_dst[tok * 4 + 3];
        f32x4 hv[8]; float amax = 0.f;
#pragma unroll
        for (int i = 0; i < 4; ++i) { const int c = (i * 64 + lane) * 8; const size_t o = (size_t)tok * DM + c;
            const u32x4 xw = *(const u32x4*)(x1b + o);
            f32x4 a = (f32x4){bflo(xw.x), bfhi(xw.x), bflo(xw.y), bfhi(xw.y)} * ALPHA, b = (f32x4){bflo(xw.z), bfhi(xw.z), bflo(xw.w), bfhi(xw.w)} * ALPHA;
            const u32x4 y0 = *(const u32x4*)(ys + (size_t)d0 * DM + c), y1 = *(const u32x4*)(ys + (size_t)d1 * DM + c), y2 = *(const u32x4*)(ys + (size_t)d2 * DM + c), y3 = *(const u32x4*)(ys + (size_t)d3 * DM + c);
            a[0] += (bflo(y0.x) + bflo(y1.x)) + (bflo(y2.x) + bflo(y3.x)); a[1] += (bfhi(y0.x) + bfhi(y1.x)) + (bfhi(y2.x) + bfhi(y3.x));
            a[2] += (bflo(y0.y) + bflo(y1.y)) + (bflo(y2.y) + bflo(y3.y)); a[3] += (bfhi(y0.y) + bfhi(y1.y)) + (bfhi(y2.y) + bfhi(y3.y));
            b[0] += (bflo(y0.z) + bflo(y1.z)) + (bflo(y2.z) + bflo(y3.z)); b[1] += (bfhi(y0.z) + bfhi(y1.z)) + (bfhi(y2.z) + bfhi(y3.z));
            b[2] += (bflo(y0.w) + bflo(y1.w)) + (bflo(y2.w) + bflo(y3.w)); b[3] += (bfhi(y0.w) + bfhi(y1.w)) + (bfhi(y2.w) + bfhi(y3.w));
            pg8::st_bf16x8(hb + o, a, b); hv[2 * i] = a; hv[2 * i + 1] = b;
#pragma unroll
            for (int j = 0; j < 4; ++j) amax = fmaxf(amax, fmaxf(fabsf(a[j]), fabsf(b[j]))); }
        for (int o = 32; o > 0; o >>= 1) amax = fmaxf(amax, __shfl_xor(amax, o));
        amax = fmaxf(amax, 1e-20f); const float qi = 127.0f / amax; if (lane == 0) hsc[tok] = amax * (1.0f / 127.0f);
#pragma unroll
        for (int i = 0; i < 4; ++i) { u32x2 w;
#pragma unroll
            for (int h = 0; h < 2; ++h) { unsigned pk = 0u;
#pragma unroll
                for (int j = 0; j < 4; ++j) pk |= ((unsigned)(int)rintf(hv[2 * i + h][j] * qi) & 0xffu) << (8 * j);
                w[h] = pk; }
            *(u32x2*)(hq + (size_t)tok * DM + (i * 64 + lane) * 8) = w; } }
}
__device__ __forceinline__ void phase_ln2(const Frame& F0, const Params& P, int l) { const Frame F = fresh(F0);
    unsigned char* ws = F.ws; const bf16_t* pre2 = (const bf16_t*)(ws + M_X1F); bf16_t* xb = (bf16_t*)(ws + WS_XB);
    const float* g = F.in(23) + l * DM; const float* bt = F.in(24) + l * DM; float* outp = F.out();
    for (int tok = F.bid * 8 + F.wid; tok < NTOK; tok += F.G * 8) ln_row(pre2 + (size_t)tok * DM, g, bt, (l + 1 == NLAYER) ? outp + (size_t)tok * DM : (float*)nullptr, (l + 1 == NLAYER) ? (bf16_t*)nullptr : xb + (size_t)tok * DM, F.lane,
                                                                          (l + 1 == NLAYER) ? (unsigned char*)nullptr : (unsigned char*)(ws + WS_XQ) + (size_t)tok * DM, (l + 1 == NLAYER) ? (float*)nullptr : (float*)(ws + WS_XSC) + tok);
}

constexpr int NPHASE = 2 + 15 * NLAYER;
#ifdef PH_ONLY
#define PEN(kind) ((kind) == PH_ONLY)
#else
#define PEN(kind) true
#endif
#define IN(k) (lo <= (k) && (k) < hi)
#define SEAM(k) do { if (IN((k) + 1)) xcd_barrier(bar); } while (0)

template <int l>
__device__ __forceinline__ void layer_phases(const Frame& F, const Params& P, const XcdBarrier& bar, const int lo, const int hi, unsigned char* ws0) {
    using namespace pg8;

        const int pb = 2 + 15 * l;
        if (IN(pb + 0) && PEN(0)) { size_t wz = 0; asm volatile("" : "+s"(wz)); unsigned char* ws = ws0 + wz;
            { SchedS S; S.init(NTOK, 5 * 256, F.G, F.bid, (const bf16_t*)(ws + WS_XB), DM, (const bf16_t*)(ws + W_IN), DM); S.skip_from = 0; S.skip_by = 4; S.skip_from2 = 4; S.skip_by2 = 49;
              EpiInProj<false> E{(bf16_t*)(ws + R_QA), (bf16_t*)(ws + R_QIDX), (bf16_t*)(ws + R_QKV), (bf16_t*)(ws + R_GATES), (float*)(ws + R_SMALL), nullptr, nullptr};
              for (int rep = 0; rep < NREP(5); ++rep) gemm_phase(F.ldsl, DM, DM, DM, S, E); }
            { SchedS S; S.init(NTOK, 53 * 256, F.G, (F.bid + F.G / 2) % F.G, (const bf16_t*)(ws + WS_XQ), DM / 2, (const bf16_t*)(ws + W_IN8), DM / 2); S.skip_from = 4; S.skip_by = 4; S.b_compact = 1;
              EpiInProj<true> E{(bf16_t*)(ws + R_QA), (bf16_t*)(ws + R_QIDX), (bf16_t*)(ws + R_QKV), (bf16_t*)(ws + R_GATES), (float*)(ws + R_SMALL), (const float*)(ws + WS_XSC), (const unsigned*)(ws + WS_CTL) + CW_WMAXG + l};
              for (int rep = 0; rep < NREP(5); ++rep) gemm_phase(F.ldsl, DM / 2, DM / 2, DM / 2, S, E); }
            SEAM(pb + 0); }
        if (IN(pb + 1) && PEN(1)) { size_t wz = 0; asm volatile("" : "+s"(wz)); unsigned char* ws = ws0 + wz;
            phase_prep(F, P, l);
            SchedS S; S.init(NTOK, 2048, F.G, F.bid, (const bf16_t*)(ws + R_QA), 1024, (const bf16_t*)(ws + W_UK2), 256, 1, 256);
            EpiBf16 E{(bf16_t*)(ws + R_QCAT), 2304, 288};
            for (int rep = 0; rep < NREP(10); ++rep) gemm_phase(F.ldsl, 256, 1024, 256, S, E); SEAM(pb + 1); }
        if (IN(pb + 2) && PEN(2)) { size_t wz = 0; asm volatile("" : "+s"(wz)); unsigned char* ws = ws0 + wz; phase_cumsum(F); for (int rep = 0; rep < NREP(3); ++rep) phase_idx(F); SEAM(pb + 2); }
        if (IN(pb + 3) && PEN(3)) { size_t wz = 0; asm volatile("" : "+s"(wz)); unsigned char* ws = ws0 + wz; for (int rep = 0; rep < NREP(4); ++rep) phase_topk(F); SEAM(pb + 3); }
        if (IN(pb + 4) && PEN(4)) { size_t wz = 0; asm volatile("" : "+s"(wz)); unsigned char* ws = ws0 + wz; for (int rep = 0; rep < NREP(1); ++rep) phase_attn(F, l, rep); SEAM(pb + 4); }
        if (IN(pb + 5) && PEN(5)) { size_t wz = 0; asm volatile("" : "+s"(wz)); unsigned char* ws = ws0 + wz;
            SchedS S; S.init(NTOK, 1024, F.G, F.bid, (const bf16_t*)(ws + R_OLAT), 2048, (const bf16_t*)(ws + W_UV2), 512, 0, 512);
            EpiBf16 E{(bf16_t*)(ws + R_OA), 3072, 256}; for (int rep = 0; rep < NREP(10); ++rep) gemm_phase(F.ldsl, 512, 2048, 512, S, E);
            SEAM(pb + 5); }
        if (IN(pb + 6) && PEN(6)) { size_t wz = 0; asm volatile("" : "+s"(wz)); unsigned char* ws = ws0 + wz;
            SchedS S; S.init(NTOK, 2048, F.G, F.bid, (const bf16_t*)(ws + R_OA), 3072, (const bf16_t*)(ws + W_BRA), 3072);
            EpiBranch3 E{(const bf16_t*)(ws + R_GATES), (bf16_t*)(ws + R_MERGED)}; for (int rep = 0; rep < NREP(11); ++rep) gemm_phase(F.ldsl, 3072, 3072, 3072, S, E); SEAM(pb + 6); }
        if (IN(pb + 7) && PEN(7)) { size_t wz = 0; asm volatile("" : "+s"(wz)); unsigned char* ws = ws0 + wz;
            SchedS S; S.init(NTOK, 2048, F.G, F.bid, (const bf16_t*)(ws + R_MERGED), DM, (const bf16_t*)(ws + W_OUT), DM);
            EpiOut E{(const bf16_t*)(ws + WS_XB), (bf16_t*)(ws + R_PRE1)}; for (int rep = 0; rep < NREP(8); ++rep) gemm_phase(F.ldsl, DM, DM, DM, S, E); SEAM(pb + 7); }
        if (IN(pb + 8) && PEN(8)) { size_t wz = 0; asm volatile("" : "+s"(wz)); unsigned char* ws = ws0 + wz; phase_ln1_router(F, P, l); SEAM(pb + 8); }
        if (IN(pb + 9) && PEN(9)) { size_t wz = 0; asm volatile("" : "+s"(wz)); unsigned char* ws = ws0 + wz;
            for (int rep = 0; rep < NREP(12); ++rep) phase_moe_gather(F, l);
            SchedS S; S.init(NTOK, 2048, F.G, F.bid, (const bf16_t*)(ws + WS_PB) + (size_t)l * NTOK * 256, 256, (const bf16_t*)(ws + W_PLE), 256);
            EpiBf16 E{(bf16_t*)(ws + M_PP), 2048, 256}; for (int rep = 0; rep < NREP(10); ++rep) gemm_phase(F.ldsl, 256, 256, 256, S, E); SEAM(pb + 9); }
        if (IN(pb + 10) && PEN(10)) { size_t wz = 0; asm volatile("" : "+s"(wz)); unsigned char* ws = ws0 + wz;
            SchedM S; S.init((const unsigned*)(ws + WS_CTL) + CW_META + l * 512, F.G, F.bid, (const bf16_t*)(ws + M_XS), DM / 2, (const bf16_t*)(ws + W_GU), DM / 2);
            EpiGateUpI8 E{F.in(16) + (size_t)l * NEXP * DEXP, F.in(18) + (size_t)l * NEXP * DEXP, (bf16_t*)(ws + M_HID), (const float*)(ws + M_ROWSX), (const unsigned*)(ws + WS_CTL) + CW_WMAX + l};
            for (int rep = 0; rep < NREP(6); ++rep) gemm_phase(F.ldsl, DM / 2, DM / 2, DM / 2, S, E); SEAM(pb + 10); }
        if (IN(pb + 11) && PEN(11)) { size_t wz = 0; asm volatile("" : "+s"(wz)); unsigned char* ws = ws0 + wz;
            SchedM S; S.init((const unsigned*)(ws + WS_CTL) + CW_META + l * 512, F.G, F.bid, (const bf16_t*)(ws + M_HID), DEXP, (const bf16_t*)(ws + W_DN), DEXP);
            EpiDown E{F.in(20) + (size_t)l * NEXP * DM, (const float*)(ws + M_ROWW), (bf16_t*)(ws + M_XS)}; for (int rep = 0; rep < NREP(7); ++rep) gemm_phase(F.ldsl, DEXP, DEXP, DEXP, S, E); SEAM(pb + 11); }
        if (IN(pb + 12) && PEN(12)) { size_t wz = 0; asm volatile("" : "+s"(wz)); unsigned char* ws = ws0 + wz; for (int rep = 0; rep < NREP(9); ++rep) phase_combine(F); SEAM(pb + 12); }
        if (IN(pb + 13) && PEN(13)) { size_t wz = 0; asm volatile("" : "+s"(wz)); unsigned char* ws = ws0 + wz;
            SchedS S; S.init(NTOK, 2048, F.G, F.bid, (const bf16_t*)(ws + M_HQ), DM / 2, (const bf16_t*)(ws + W_PG), DM / 2);
            EpiPleGateI8 E{(const bf16_t*)(ws + M_HB), (const bf16_t*)(ws + M_PP), (bf16_t*)(ws + M_X1F), (const float*)(ws + M_HSC), (const unsigned*)(ws + WS_CTL) + CW_WMAXP + l};
            for (int rep = 0; rep < NREP(8); ++rep) gemm_phase(F.ldsl, DM / 2, DM / 2, DM / 2, S, E); SEAM(pb + 13); }
        if (IN(pb + 14) && PEN(14)) { size_t wz = 0; asm volatile("" : "+s"(wz)); unsigned char* ws = ws0 + wz; for (int rep = 0; rep < NREP(13); ++rep) phase_ln2(F, P, l); if (l + 1 < NLAYER) for (int rep = 0; rep < NREP(0); ++rep) convert_layer_weights(F, P, l + 1); SEAM(pb + 14); }
}
__global__ void __launch_bounds__(512, 2) fwd(Params P) {
    extern __shared__ __attribute__((aligned(16))) unsigned char lds[];
    Frame F; F.lds = lds; F.ldsl = (LAS unsigned char*)lds; F.ws = P.ws; F.tid = threadIdx.x; F.lane = F.tid & 63; F.wid = __builtin_amdgcn_readfirstlane(F.tid >> 6); F.G = gridDim.x; F.bid = blockIdx.x;
    unsigned char* ws0 = P.ws; unsigned char* ws = ws0;
    const bool fused = (P.ph_hi - P.ph_lo) > 1;
    if (F.tid < 4) ((LAS unsigned*)(F.ldsl + LDS_MISC))[F.tid] = 0u;
    if (F.tid == 0) { LAS unsigned long long* t = (LAS unsigned long long*)(F.ldsl + LDS_PTRS);
#pragma unroll
        for (int k = 0; k < 25; ++k) t[k] = (unsigned long long)P.in[k];
        t[25] = (unsigned long long)P.out; }
    __syncthreads();
    XcdBarrier bar; bar.bar = (unsigned*)(ws + WS_CTL) + CW_BAR; bar.x = 0; bar.st = (volatile LAS unsigned*)(F.ldsl + LDS_MISC);
    if (fused) bar = xcd_barrier_post((unsigned*)(ws + WS_CTL) + CW_BAR, (volatile LAS unsigned*)(F.ldsl + LDS_MISC));
    const int lo = P.ph_lo, hi = P.ph_hi;
    using namespace pg8;
    if (IN(0) && PEN(15)) { size_t wz = 0; asm volatile("" : "+s"(wz)); unsigned char* ws = ws0 + wz;
        quant_rows(F, F.in(0), (bf16_t*)(ws + WS_XB), (unsigned char*)(ws + WS_XQ), (float*)(ws + WS_XSC));
        conv_rows(F, F.in(1), (bf16_t*)(ws + WS_PB), (size_t)2 * NTOK * 256 / 8);
        sample_wmax(F);
        SEAM(0);
    }
    if (IN(1) && PEN(15)) { for (int rep = 0; rep < NREP(0); ++rep) convert_layer_weights(F, P, 0); SEAM(1); }
    layer_phases<0>(F, P, bar, lo, hi, ws0);
    layer_phases<1>(F, P, bar, lo, hi, ws0);
}

#ifdef DEBUG_NAN
constexpr int CW_FLAGS = 12288;
__global__ void dbg_scan_bf16(const unsigned short* p, size_t n, unsigned* flag) { unsigned c = 0; for (size_t i = (size_t)blockIdx.x * blockDim.x + threadIdx.x; i < n; i += (size_t)gridDim.x * blockDim.x) if ((p[i] & 0x7F80u) == 0x7F80u) ++c; if (c) atomicAdd(flag, c); }
__global__ void dbg_scan_f32(const unsigned* p, size_t n, unsigned* flag) { unsigned c = 0; for (size_t i = (size_t)blockIdx.x * blockDim.x + threadIdx.x; i < n; i += (size_t)gridDim.x * blockDim.x) if ((p[i] & 0x7F800000u) == 0x7F800000u) ++c; if (c) atomicAdd(flag, c); }
__global__ void dbg_scan_sel(const int* sel, const int* nsel, unsigned* flag) { unsigned c = 0; for (size_t i = (size_t)blockIdx.x * blockDim.x + threadIdx.x; i < (size_t)NTOK * 256; i += (size_t)gridDim.x * blockDim.x) { const int tok = (int)(i >> 8), j = (int)(i & 255), t = tok & (SEQ - 1); const int ns = nsel[tok]; if (j == 0 && ns != (t + 1 < 256 ? t + 1 : 256)) ++c; if (j < ns && (sel[i] < 0 || sel[i] > t)) ++c; } if (c) atomicAdd(flag, c); }
__global__ void dbg_scan_scores(const unsigned* p, unsigned* flag) { unsigned c = 0; for (size_t i = (size_t)blockIdx.x * blockDim.x + threadIdx.x; i < 2ull * SEQ * SEQ; i += (size_t)gridDim.x * blockDim.x) { const int s = (int)(i & (SEQ - 1)), t = (int)((i >> 13) & (SEQ - 1)); if (s <= t && (p[i] & 0x7F800000u) == 0x7F800000u) ++c; } if (c) atomicAdd(flag, c); }
__global__ void dbg_probe_bf16(const unsigned short* p, size_t n, unsigned* cnt, unsigned* minidx) { unsigned c = 0; unsigned mi = 0xFFFFFFFFu; for (size_t i = (size_t)blockIdx.x * blockDim.x + threadIdx.x; i < n; i += (size_t)gridDim.x * blockDim.x) if ((p[i] & 0x7F80u) == 0x7F80u) { ++c; if ((unsigned)i < mi) mi = (unsigned)i; } if (c) { atomicAdd(cnt, c); atomicMax(minidx, ~mi); } }
__global__ void dbg_final(float* out, size_t n, const unsigned* flags) { int code = 0; for (int k = 0; k < 32; ++k) if (flags[k] && !code) code = k + 1; const int mask = (flags[32] ? 1 : 0) | (flags[33] ? 2 : 0) | (flags[34] ? 4 : 0); if (mask) code = 20 + 5 * mask; if (!code) return; for (size_t i = (size_t)blockIdx.x * blockDim.x + threadIdx.x; i < n; i += (size_t)gridDim.x * blockDim.x) out[i] = (float)code; }
#endif
extern "C" void kernel_launch(void* const* d_in, const int* in_sizes, int n_in, void* d_out, int out_size, void* d_ws, size_t ws_size, hipStream_t stream) {
    static int grid = 0;
    if (grid == 0) {
        if (n_in != 25 || out_size != NTOK * DM || ws_size < WS_NEED) { fprintf(stderr, "kernel_launch: unexpected shapes (n_in %d out %d ws %zu need %zu)\n", n_in, out_size, ws_size, (size_t)WS_NEED); grid = -1; return; }
        int dev = 0, cus = 0, per_cu = 0;
        if (hipGetDevice(&dev) != hipSuccess || hipDeviceGetAttribute(&cus, hipDeviceAttributeMultiprocessorCount, dev) != hipSuccess) { grid = -1; return; }
        if (hipFuncSetAttribute((const void*)fwd, hipFuncAttributeMaxDynamicSharedMemorySize, LDS_BYTES) != hipSuccess) { fprintf(stderr, "kernel_launch: hipFuncSetAttribute failed\n"); grid = -1; return; }
        if (hipOccupancyMaxActiveBlocksPerMultiprocessor(&per_cu, (const void*)fwd, 512, LDS_BYTES) != hipSuccess || per_cu < 1) fprintf(stderr, "kernel_launch: occupancy query says %d\n", per_cu);
        (void)hipGetLastError();
        grid = cus;
    }
    if (grid < 0) return;
    unsigned char* ws = (unsigned char*)d_ws;
    hipMemsetAsync(ws + WS_CTL, 0, CTL_BYTES, stream);
    hipMemsetAsync(ws + W_UK2, 0, 8ull * 256 * 256 * 2 + 4ull * 256 * 512 * 2, stream);
    hipMemsetAsync(ws + W_IN + (size_t)INW * 2048 * 2, 0, (size_t)(INWP - INW) * 2048 * 2, stream);
    Params p{};
    for (int i = 0; i < 25; ++i) p.in[i] = (const float*)d_in[i];
    p.out = (float*)d_out; p.ws = ws;
#if PHASES_PER_LAUNCH == 0
    p.ph_lo = 0; p.ph_hi = NPHASE;
    hipLaunchKernelGGL(fwd, dim3(grid), dim3(512), LDS_BYTES, stream, p);
#else
    for (int k = 0; k < NPHASE; ++k) { p.ph_lo = k; p.ph_hi = k + 1; hipLaunchKernelGGL(fwd, dim3(grid), dim3(512), LDS_BYTES, stream, p);
#ifdef DEBUG_NAN
        unsigned* fl = (unsigned*)(ws + WS_CTL) + CW_FLAGS + k;
#define SB16(off, n) hipLaunchKernelGGL(dbg_scan_bf16, dim3(1024), dim3(256), 0, stream, (const unsigned short*)(ws + (off)), (size_t)(n), fl)
#define SF32(off, n) hipLaunchKernelGGL(dbg_scan_f32, dim3(1024), dim3(256), 0, stream, (const unsigned*)(ws + (off)), (size_t)(n), fl)
        if (k == 0) { SB16(WS_XB, (size_t)NTOK * DM); SB16(WS_PB, 2ull * NTOK * 256); SB16(WS_W, (W_END - WS_W) / 2); }
        else { const int kind = (k - 1) % 15;
            if (kind == 0) { SB16(R_QA, (size_t)NTOK * 1024); SB16(R_QIDX, (size_t)NTOK * 1024); SB16(R_QKV, 6ull * NTOK * 1024); SB16(R_GATES, (size_t)NTOK * 6144); SF32(R_SMALL, (size_t)NTOK * 512); }
            if (kind == 1) { SB16(R_QCAT, (size_t)NTOK * 2304); SB16(R_KCAT, (size_t)NTOK * 288); SB16(R_KI, (size_t)NTOK * 64); SB16(R_QIDX, (size_t)NTOK * 1024); SF32(R_WI, (size_t)NTOK * 16); SF32(WS_LF, 16ull * 8192); }
            if (kind == 2) { SF32(WS_CUM, 16ull * 8192); hipLaunchKernelGGL(dbg_scan_scores, dim3(1024), dim3(256), 0, stream, (const unsigned*)(ws + R_SCORES), fl); }
            if (kind == 3) { hipLaunchKernelGGL(dbg_scan_sel, dim3(1024), dim3(256), 0, stream, (const int*)(ws + R_SEL), (const int*)(ws + R_NSEL), fl); }
            if (k == 5) { unsigned* fl0 = fl; fl = (unsigned*)(ws + WS_CTL) + CW_FLAGS + 32; SB16(R_OLAT, (size_t)NTOK * 2048); fl += 1; SB16(R_OA, (size_t)NTOK * 3072); fl += 1; fl = fl0; hipLaunchKernelGGL(dbg_probe_bf16, dim3(1024), dim3(256), 0, stream, (const unsigned short*)(ws + R_OC), (size_t)NTOK * 1024, (unsigned*)(ws + WS_CTL) + CW_FLAGS + 40, (unsigned*)(ws + WS_CTL) + CW_FLAGS + 41); }
            if (kind == 5) { SB16(R_OA, (size_t)NTOK * 3072); }
            if (kind == 6) { SB16(R_MERGED, (size_t)NTOK * 2048); }
            if (kind == 7) { SF32(R_PRE1, (size_t)NTOK * 2048); }
            if (kind == 8) { SF32(M_X1F, (size_t)NTOK * 2048); SF32(M_TOKW, (size_t)NTOK * 4); }
            if (kind == 9) { SB16(M_PP, (size_t)NTOK * 2048); }
            if (kind == 12) { SF32(M_HF, (size_t)NTOK * 2048); }
            if (kind == 13) { SF32(M_X1F, (size_t)NTOK * 2048); }
            if (kind == 14) { hipLaunchKernelGGL(dbg_scan_f32, dim3(1024), dim3(256), 0, stream, (const unsigned*)d_out, (size_t)NTOK * DM, fl); if (k + 1 < NPHASE) SB16(WS_W, (W_END - WS_W) / 2); } }
#endif
    }
#ifdef DEBUG_NAN
    hipLaunchKernelGGL(dbg_final, dim3(1024), dim3(256), 0, stream, (float*)d_out, (size_t)NTOK * DM, (const unsigned*)(ws + WS_CTL) + CW_FLAGS);
#endif
#endif
}
```

```cpp
#include <hip/hip_runtime.h>
#include <stdint.h>
#include <stdio.h>
#include <math.h>

#ifndef PHASES_PER_LAUNCH
#define PHASES_PER_LAUNCH 0
#endif

#define LAS __attribute__((address_space(3)))
#define GAS __attribute__((address_space(1)))
#ifndef REP_MASK
#define REP_MASK 0
#endif
#define NREP(bit) (((REP_MASK) >> (bit)) & 1 ? 2 : 1)
typedef unsigned short bf16_t;
typedef short bf16x8 __attribute__((ext_vector_type(8)));
typedef short s16x4 __attribute__((ext_vector_type(4)));
typedef float f32x4 __attribute__((ext_vector_type(4)));
typedef float f32x16 __attribute__((ext_vector_type(16)));
typedef unsigned u32x4 __attribute__((ext_vector_type(4)));
typedef unsigned u32x2 __attribute__((ext_vector_type(2)));
typedef int i32x4 __attribute__((ext_vector_type(4)));

constexpr int NTOK = 16384, DM = 2048, SEQ = 8192, NB = 2, NLAYER = 2;
constexpr int INW = 14712, INWP = 14848;
constexpr int NEXP = 32, DEXP = 1024;
constexpr int PMAX = 65536 + 8192;
constexpr float ALPHA = 1.41421356237309515f;
constexpr float LOG2E = 1.4426950408889634f;
constexpr float SCALE = 0.08838834764831845f;
constexpr float C2 = LOG2E * SCALE;

constexpr size_t MiB = 1ull << 20;
constexpr size_t WS_CTL   = 0;
constexpr size_t WS_W     = 1 * MiB;
constexpr size_t W_IN     = WS_W;
constexpr size_t W_IN8    = W_IN   + 2048ull * 2048 * 2;
constexpr size_t W_UK2    = W_IN   + (size_t)INWP * 2048 * 2;
constexpr size_t W_UV2    = W_UK2  + 8ull * 256 * 256 * 2;
constexpr size_t W_BRA    = W_UV2  + 4ull * 256 * 512 * 2;
constexpr size_t W_BRB    = W_BRA  + 2048ull * 1024 * 2;
constexpr size_t W_BRC    = W_BRB  + 2048ull * 1024 * 2;
constexpr size_t W_OUT    = W_BRC  + 2048ull * 1024 * 2;
constexpr size_t W_PG     = W_OUT  + 2048ull * 2048 * 2;
constexpr size_t W_PLE    = W_PG   + 2048ull * 2048 * 2;
constexpr size_t W_GU     = W_PLE  + 2048ull * 256 * 2;
constexpr size_t W_DN     = W_GU   + 32ull * 2048 * 2048 * 2;
constexpr size_t W_END    = W_DN   + 32ull * 2048 * 1024 * 2;
constexpr size_t WS_XB    = (W_END + MiB - 1) / MiB * MiB;
constexpr size_t WS_PB    = WS_XB  + (size_t)NTOK * DM * 2;
constexpr size_t WS_CUM   = WS_PB  + 2ull * NTOK * 256 * 2;
constexpr size_t WS_LF    = WS_CUM + 16ull * 8192 * 4;
constexpr size_t WS_XQ    = WS_LF  + 16ull * 8192 * 4;
constexpr size_t WS_XSC   = WS_XQ  + (size_t)NTOK * DM;
constexpr size_t WS_R     = (WS_XSC + (size_t)NTOK * 4 + MiB - 1) / MiB * MiB;
constexpr size_t R_SCORES = WS_R;
constexpr size_t R_OLAT   = WS_R;
constexpr size_t R_OA     = WS_R + 64 * MiB;
constexpr size_t R_OB     = WS_R + 96 * MiB;
constexpr size_t R_OC     = WS_R + 128 * MiB;
constexpr size_t R_TMP    = WS_R + 160 * MiB;
constexpr size_t R_MERGED = WS_R + 288 * MiB;
constexpr size_t R_PRE1   = WS_R + 384 * MiB;
constexpr size_t R_QA     = WS_R + 512 * MiB;
constexpr size_t R_QIDX   = WS_R + 544 * MiB;
constexpr size_t R_QKV    = WS_R + 576 * MiB;
constexpr size_t R_GATES  = WS_R + 768 * MiB;
constexpr size_t R_SMALL  = WS_R + 960 * MiB;
constexpr size_t R_QCAT   = WS_R + 992 * MiB;
constexpr size_t R_KCAT   = WS_R + 1064 * MiB;
constexpr size_t R_KI     = WS_R + 1073 * MiB;
constexpr size_t R_WI     = WS_R + 1075 * MiB;
constexpr size_t R_SEL    = WS_R + 1076 * MiB;
constexpr size_t R_NSEL   = WS_R + 1092 * MiB;
constexpr size_t R_END    = WS_R + 1093 * MiB;
constexpr size_t M_XS     = WS_R;
constexpr size_t M_HID    = WS_R + 288 * MiB;
constexpr size_t M_PP     = WS_R + 432 * MiB;
constexpr size_t M_X1F    = WS_R + 512 * MiB;
constexpr size_t M_X1B    = WS_R + 640 * MiB;
constexpr size_t M_HF     = WS_R + 704 * MiB;
constexpr size_t M_HQ     = WS_R + 704 * MiB;
constexpr size_t M_HSC    = WS_R + 736 * MiB;
constexpr size_t M_HB     = WS_R + 832 * MiB;
constexpr size_t M_TOKE   = WS_R + 896 * MiB;
constexpr size_t M_TOKPOS = M_TOKE + (size_t)NTOK * 16;
constexpr size_t M_TOKW   = M_TOKPOS + (size_t)NTOK * 16;
constexpr size_t M_TOKDST = M_TOKW + (size_t)NTOK * 16;
constexpr size_t M_ROWW   = M_TOKDST + (size_t)NTOK * 16;
constexpr size_t M_ROWSX  = M_ROWW + (size_t)PMAX * 4;
constexpr size_t M_X1S    = M_ROWSX + (size_t)PMAX * 4;
constexpr size_t M_X1Q    = WS_R + 900 * MiB;
constexpr size_t WS_NEED  = R_END;
constexpr int CW_BAR = 0;
constexpr int CW_CNT = 8192;
constexpr int CW_META = 4096 + 64;
constexpr int CW_QCTR = 6144;
constexpr int CW_WMAX = 6272;
constexpr int CW_WMAXG = 6336;
constexpr int CW_WMAXP = 6368;
constexpr int CW_KMAX = 6400;
constexpr size_t CTL_BYTES = 65536;

constexpr int LDS_BYTES = 152576;
constexpr int LDS_MISC = 151552;

typedef float f32x2 __attribute__((ext_vector_type(2)));
typedef __bf16 bf16n2 __attribute__((ext_vector_type(2)));
__device__ __forceinline__ unsigned cvtpk(float lo, float hi) { f32x2 v = {lo, hi}; bf16n2 b = __builtin_convertvector(v, bf16n2); return __builtin_bit_cast(unsigned, b); }
__device__ __forceinline__ bf16_t f2bf(float x) { return (bf16_t)(cvtpk(x, 0.f) & 0xffffu); }
__device__ __forceinline__ float bf2f(bf16_t b) { return __uint_as_float(((unsigned)b) << 16); }
__device__ __forceinline__ float bflo(unsigned w) { return __uint_as_float(w << 16); }
__device__ __forceinline__ float bfhi(unsigned w) { return __uint_as_float(w & 0xffff0000u); }
__device__ __forceinline__ bf16x8 pack8(f32x4 a, f32x4 b) { u32x4 w = {cvtpk(a[0], a[1]), cvtpk(a[2], a[3]), cvtpk(b[0], b[1]), cvtpk(b[2], b[3])}; return *reinterpret_cast<bf16x8*>(&w); }
__device__ __forceinline__ float sigmoidf_(float x) { return 1.0f / (1.0f + __expf(-x)); }
__device__ __forceinline__ float wave_sum(float v) { for (int o = 32; o > 0; o >>= 1) v += __shfl_xor(v, o); return v; }
__device__ __forceinline__ int crow(int r, int hi) { return (r & 3) + 8 * (r >> 2) + 4 * hi; }
#define SBAR() __builtin_amdgcn_sched_barrier(0)

#define XB_TMO      128
#define XB_XCNT(j)  (256  + 64 * (j))
#define XB_XSUB(j)  (1280 + 64 * (j))
#define XB_XGEN(j)  (2304 + 64 * (j))
#define XB_TOP      3328
#define XB_TOPGEN   3392
#define XCD_BAR_WORDS 3456
#define XB_SPIN_CAP (1u << 22)
__device__ __forceinline__ unsigned xb_ld(unsigned* p)              { return __hip_atomic_load(p, __ATOMIC_RELAXED, __HIP_MEMORY_SCOPE_AGENT); }
__device__ __forceinline__ unsigned xb_add(unsigned* p, unsigned v) { return __hip_atomic_fetch_add(p, v, __ATOMIC_RELAXED, __HIP_MEMORY_SCOPE_AGENT); }
__device__ __forceinline__ unsigned xb_xcc_id() { return (unsigned)__builtin_amdgcn_s_getreg((3 << 11) | 20) & 0xFu; }
#define XB_SPIN(cond, bar) do { unsigned _sp = 0; while (cond) { __builtin_amdgcn_s_sleep(1); \
    if ((++_sp & 255u) == 0u) { if (xb_ld(&(bar)[XB_TMO])) break; if (_sp > XB_SPIN_CAP) { atomicAdd(&(bar)[XB_TMO], 1u); break; } } } } while (0)
struct XcdBarrier { unsigned* bar; unsigned x; volatile LAS unsigned* st; };
__device__ __forceinline__ XcdBarrier xcd_barrier_post(unsigned* bar, volatile LAS unsigned* st) {
    XcdBarrier b; b.bar = bar; b.x = xb_xcc_id(); b.st = st;
    if (threadIdx.x == 0) (void)xb_add(&bar[XB_XCNT(b.x)], 1u);
    return b;
}
__device__ __forceinline__ void xcd_barrier_complete(unsigned* bar, unsigned x, unsigned& nloc, unsigned& nx) {
    const unsigned G = gridDim.x * gridDim.y * gridDim.z;
    unsigned sum, cnt, mine, sp = 0u;
    for (;;) {
        sum = 0u; cnt = 0u; mine = 0u;
#pragma unroll
        for (unsigned j = 0; j < 16; ++j) { const unsigned c = xb_ld(&bar[XB_XCNT(j)]); sum += c; cnt += (c > 0u) ? 1u : 0u; mine = (j == x) ? c : mine; }
        if (sum == G) break;
        __builtin_amdgcn_s_sleep(1);
        if ((++sp & 255u) == 0u) { if (xb_ld(&bar[XB_TMO])) break; if (sp > XB_SPIN_CAP) { atomicAdd(&bar[XB_TMO], 1u); break; } }
    }
    nloc = mine > 0u ? mine : 1u; nx = cnt > 0u ? cnt : 1u;
}
__device__ __forceinline__ void xcd_barrier(const XcdBarrier& b) {
    asm volatile("s_waitcnt vmcnt(0)" ::: "memory");
    __syncthreads();
    if (threadIdx.x == 0) {
        unsigned* bar = b.bar;
        __builtin_amdgcn_s_waitcnt(0);
        unsigned nloc = b.st[0], nx = b.st[1];
        if (nloc == 0u) { xcd_barrier_complete(bar, b.x, nloc, nx); b.st[0] = nloc; b.st[1] = nx; }
        const unsigned old = xb_add(&bar[XB_XSUB(b.x)], 1u);
        const unsigned gen = old / nloc;
        if (old + 1u == (gen + 1u) * nloc) {
            __builtin_amdgcn_fence(__ATOMIC_RELEASE, "agent");
            asm volatile("s_waitcnt vmcnt(0)" ::: "memory");
            const unsigned og = xb_add(&bar[XB_TOP], 1u);
            const unsigned tg = og / nx;
            if (og + 1u == (tg + 1u) * nx) xb_add(&bar[XB_TOPGEN], 1u);
            else XB_SPIN(xb_ld(&bar[XB_TOPGEN]) == tg, bar);
            __builtin_amdgcn_fence(__ATOMIC_ACQUIRE, "agent");
            xb_add(&bar[XB_XGEN(b.x)], 1u);
            asm volatile("s_waitcnt vmcnt(0)" ::: "memory");
        } else {
            XB_SPIN(xb_ld(&bar[XB_XGEN(b.x)]) == gen, bar);
            __builtin_amdgcn_fence(__ATOMIC_ACQUIRE, "agent");
            asm volatile("s_waitcnt vmcnt(0)" ::: "memory");
        }
    }
    __syncthreads();
}

namespace pg8 {
constexpr int BM = 256, BK = 64, HALF = 128, HTB = HALF * BK * 2, STAGE_BYTES = 8 * HTB, NXCD = 8, WGM = 8;
__device__ __forceinline__ int lds_byte(int r, int c) { const int st = (r >> 4) * 2 + (c >> 5), rr = r & 15, cc = c & 31, ob = rr * 64 + cc * 2; return st * 1024 + (ob ^ (((ob >> 9) & 1) << 5)); }
__device__ __forceinline__ void stage_rc(int b, int& R, int& C) { const int st = b / 1024, sb = b % 1024, swz = sb ^ (((sb >> 9) & 1) << 5); R = (st >> 1) * 16 + swz / 64; C = (st & 1) * 32 + (swz % 64) / 2; }
__device__ __forceinline__ int perm32(int rho) { const int n = rho >> 4, i = rho & 15; return 8 * (i >> 2) + 4 * n + (i & 3); }
struct Unit { int pm, pn, e; };
struct SchedS {
    int nM, nN, nwg, G, c; const bf16_t* A; const bf16_t* B; int lda, ldb, a_sh, a_mul, skip_from = 1 << 30, skip_by = 0, skip_from2 = 1 << 30, skip_by2 = 0, b_compact = 0;
    __device__ void init(int M, int N, int G_, int c_, const bf16_t* A_, int lda_, const bf16_t* B_, int ldb_, int a_sh_ = 0, int a_mul_ = 0) {
        nM = M / BM; nN = N / BM; nwg = nM * nN; G = G_; c = c_; A = A_; B = B_; lda = lda_; ldb = ldb_; a_sh = a_sh_; a_mul = a_mul_; }
    __device__ __forceinline__ bool next(int i, Unit& u) const {
        const long L = (long)i * G + c; if (L >= nwg) return false;
        int wgid = (int)L; { const int q = nwg / NXCD, r = nwg % NXCD, xcd = wgid % NXCD, off = wgid / NXCD; wgid = (xcd < r ? xcd * (q + 1) : r * (q + 1) + (xcd - r) * q) + off; }
        const int nig = WGM * nN, gid = wgid / nig, fm = gid * WGM, gsz = (nM - fm) < WGM ? (nM - fm) : WGM;
        u.pm = fm + ((wgid % nig) % gsz); u.pn = (wgid % nig) / gsz; u.e = 0;
        u.e = u.pn;
        { const int ci = u.pn; if (ci >= skip_from) u.pn += skip_by; if (ci >= skip_from2) u.pn += skip_by2; }
        return true;
    }
    __device__ __forceinline__ const char* pa(const Unit& u) const { return (const char*)(A + (size_t)u.pm * BM * lda + (size_t)((u.pn >> a_sh) * a_mul)); }
    __device__ __forceinline__ const char* pb(const Unit& u) const { return (const char*)(B + (size_t)(b_compact ? u.e : u.pn) * BM * ldb); }
};
struct SchedM {
    int ntiles, G, c; const bf16_t* A; const bf16_t* W; int lda, ldb; const unsigned* tile_e;
    __device__ void init(const unsigned* meta, int G_, int c_, const bf16_t* A_, int lda_, const bf16_t* W_, int ldb_) {
        ntiles = (int)meta[0]; tile_e = meta + 1; G = G_; c = c_; A = A_; W = W_; lda = lda_; ldb = ldb_; }
    __device__ __forceinline__ bool next(int i, Unit& u) const {
        const long L = (long)i * G + c; if (L >= (long)ntiles * 8) return false;
        u.pm = (int)(L >> 3); u.pn = (int)(L & 7); u.e = (int)tile_e[u.pm];
        return true;
    }
    __device__ __forceinline__ const char* pa(const Unit& u) const { return (const char*)(A + (size_t)u.pm * BM * lda); }
    __device__ __forceinline__ const char* pb(const Unit& u) const { return (const char*)(W + ((size_t)u.e * 2048 + (size_t)u.pn * BM) * ldb); }
};

template <class Epi, class Sched>
__device__ __forceinline__ void gemm_phase(LAS unsigned char* lds, const int K, const int lda, const int ldb, const Sched& S, const Epi& E) {
    int tid = threadIdx.x; asm volatile("" : "+v"(tid));
    const int wid = __builtin_amdgcn_readfirstlane(tid >> 6), lane = tid & 63, wr = wid >> 2, wc = wid & 3, fr = lane & 15, fq = lane >> 4;
    const int nt = K / BK;
    unsigned voffA[2], voffB[2];
#pragma unroll
    for (int i = 0; i < 2; ++i) { int R, C; stage_rc(tid * 16 + i * 8192, R, C); const int Rb = (R & ~31) + perm32(R & 31);
        voffA[i] = (unsigned)(R * lda + C) * 2u; voffB[i] = (unsigned)(Rb * ldb + C) * 2u; }
    const size_t kstep = (size_t)(BK * 2);
    const size_t hstepA = (size_t)HALF * lda * 2, hstepB = (size_t)HALF * ldb * 2;
    const unsigned ldsw = (unsigned)wid * 1024u;
    const int aoff = lds_byte(wr * 64 + fr, fq * 8), boff = lds_byte(wc * 32 + fr, fq * 8);
#define PG8_SA(b, h) (((b) * 2 + (h)) * HTB)
#define PG8_SB(b, h) ((4 + (b) * 2 + (h)) * HTB)
#define PG8_STAGE(bufoff, gbase, voff) do { _Pragma("unroll") for (int _i = 0; _i < 2; ++_i) \
        __builtin_amdgcn_global_load_lds((const unsigned*)((const char*)(gbase) + (voff)[_i]), (LAS unsigned*)(lds + (bufoff) + ldsw + _i * 8192), 16, 0, 0); } while (0)
#define PG8_LDA(dst, b, h) do { _Pragma("unroll") for (int m = 0; m < 4; ++m) _Pragma("unroll") for (int k = 0; k < 2; ++k) dst[m][k] = *(const LAS bf16x8*)(lds + PG8_SA(b, h) + aoff + m * 2048 + k * 1024); } while (0)
#define PG8_LDB(dst, b, h) do { _Pragma("unroll") for (int n = 0; n < 2; ++n) _Pragma("unroll") for (int k = 0; k < 2; ++k) dst[n][k] = *(const LAS bf16x8*)(lds + PG8_SB(b, h) + boff + n * 2048 + k * 1024); } while (0)
#define PG8_MMA(ai, bj, At, Bt) do { __builtin_amdgcn_s_setprio(1); _Pragma("unroll") for (int m = 0; m < 4; ++m) _Pragma("unroll") for (int n = 0; n < 2; ++n) _Pragma("unroll") for (int k = 0; k < 2; ++k) \
        { if constexpr (Epi::I8) acc[ai][bj][m][n] = __builtin_bit_cast(f32x4, __builtin_amdgcn_mfma_i32_16x16x64_i8(__builtin_bit_cast(i32x4, Bt[n][k]), __builtin_bit_cast(i32x4, At[m][k]), __builtin_bit_cast(i32x4, acc[ai][bj][m][n]), 0, 0, 0)); \
          else acc[ai][bj][m][n] = __builtin_amdgcn_mfma_f32_16x16x32_bf16(Bt[n][k], At[m][k], acc[ai][bj][m][n], 0, 0, 0); } __builtin_amdgcn_s_setprio(0); } while (0)
#define PG8_WAIT_V(n) asm volatile("s_waitcnt vmcnt(" #n ")" ::: "memory")
#define PG8_WAIT_L(n) asm volatile("s_waitcnt lgkmcnt(" #n ")" ::: "memory")
#define PG8_BAR __builtin_amdgcn_s_barrier()
#define PG8_SCHED __builtin_amdgcn_sched_barrier(0)
    Unit cur, nxt; int ui = 0;
    if (!S.next(0, cur)) return;
    f32x4 acc[2][2][4][2];
#pragma unroll
    for (int a = 0; a < 2; ++a)
#pragma unroll
        for (int b = 0; b < 2; ++b)
#pragma unroll
            for (int m = 0; m < 4; ++m)
#pragma unroll
                for (int n = 0; n < 2; ++n) acc[a][b][m][n] = (f32x4){0.f, 0.f, 0.f, 0.f};
    bf16x8 At[4][2], B0[2][2], B1[2][2];
    const char* cA = S.pa(cur); const char* cB = S.pb(cur);
    PG8_STAGE(PG8_SB(0, 0), cB, voffB); PG8_STAGE(PG8_SA(0, 0), cA, voffA); PG8_STAGE(PG8_SB(0, 1), cB + hstepB, voffB); PG8_STAGE(PG8_SA(0, 1), cA + hstepA, voffA);
    if (wr == 1) PG8_BAR;
    PG8_WAIT_V(4); PG8_BAR;
    PG8_STAGE(PG8_SB(1, 0), cB + kstep, voffB); PG8_STAGE(PG8_SA(1, 0), cA + kstep, voffA); PG8_STAGE(PG8_SB(1, 1), cB + hstepB + kstep, voffB);
    PG8_WAIT_V(6); PG8_BAR;
    for (;;) {
        const bool has_next = S.next(ui + 1, nxt);
        const char* nA = has_next ? S.pa(nxt) : cA; const char* nB = has_next ? S.pb(nxt) : cB;
        for (int t = 0; t < nt; t += 2) {
            const bool last = (t == nt - 2);
            if constexpr (Epi::HAS_MID) { if (t == Epi::MID1 || t == Epi::MID2) { int frM = fr, fqM = fq; asm volatile("" : "+v"(frM), "+v"(fqM)); E.mid(acc, cur, t, wr, wc, frM, fqM); } }
            const char* a1 = cA + (size_t)(t + 1) * kstep;
            const char* a2 = last ? nA : cA + (size_t)(t + 2) * kstep; const char* b2 = last ? nB : cB + (size_t)(t + 2) * kstep;
            const char* a3 = a2 + kstep; const char* b3 = b2 + kstep;
            PG8_LDB(B0, 0, 0); PG8_SCHED; PG8_LDA(At, 0, 0); PG8_STAGE(PG8_SA(1, 1), a1 + hstepA, voffA);
            PG8_WAIT_L(8); PG8_BAR; PG8_WAIT_L(0); PG8_MMA(0, 0, At, B0); PG8_BAR; PG8_SCHED;
            PG8_LDB(B1, 0, 1); PG8_STAGE(PG8_SB(0, 0), b2, voffB);
            PG8_BAR; PG8_WAIT_L(0); PG8_MMA(0, 1, At, B1); PG8_BAR;
            PG8_LDA(At, 0, 1); PG8_STAGE(PG8_SA(0, 0), a2, voffA);
            PG8_BAR; PG8_WAIT_L(0); PG8_MMA(1, 0, At, B0); PG8_BAR; PG8_SCHED;
            PG8_STAGE(PG8_SB(0, 1), b2 + hstepB, voffB);
            PG8_WAIT_V(6); PG8_BAR; PG8_MMA(1, 1, At, B1); PG8_BAR;
            PG8_LDB(B0, 1, 0); PG8_SCHED; PG8_LDA(At, 1, 0); PG8_STAGE(PG8_SA(0, 1), a2 + hstepA, voffA);
            PG8_WAIT_L(8); PG8_BAR; PG8_WAIT_L(0); PG8_MMA(0, 0, At, B0); PG8_BAR; PG8_SCHED;
            PG8_LDB(B1, 1, 1); PG8_STAGE(PG8_SB(1, 0), b3, voffB);
            PG8_BAR; PG8_WAIT_L(0); PG8_MMA(0, 1, At, B1); PG8_BAR;
            PG8_LDA(At, 1, 1); PG8_STAGE(PG8_SA(1, 0), a3, voffA);
            PG8_BAR; PG8_WAIT_L(0); PG8_MMA(1, 0, At, B0); PG8_BAR; PG8_SCHED;
            PG8_STAGE(PG8_SB(1, 1), b3 + hstepB, voffB);
            PG8_WAIT_V(6); PG8_BAR; PG8_MMA(1, 1, At, B1); PG8_BAR;
        }
        { int frE = fr, fqE = fq; asm volatile("" : "+v"(frE), "+v"(fqE)); E(acc, cur, wr, wc, frE, fqE); }
        if (!has_next) break;
#pragma unroll
        for (int a = 0; a < 2; ++a)
#pragma unroll
            for (int b = 0; b < 2; ++b)
#pragma unroll
                for (int m = 0; m < 4; ++m)
#pragma unroll
                    for (int n = 0; n < 2; ++n) acc[a][b][m][n] = (f32x4){0.f, 0.f, 0.f, 0.f};
        cur = nxt; cA = nA; cB = nB; ++ui;
    }
    PG8_WAIT_V(0);
    if (wr == 0) PG8_BAR;
    PG8_BAR;
#undef PG8_SA
#undef PG8_SB
#undef PG8_STAGE
#undef PG8_LDA
#undef PG8_LDB
#undef PG8_MMA
#undef PG8_WAIT_V
#undef PG8_WAIT_L
#undef PG8_BAR
#undef PG8_SCHED
}

#define EPI_LOOP_ROWS _Pragma("unroll") for (int ai = 0; ai < 2; ++ai) _Pragma("unroll") for (int m = 0; m < 4; ++m)
__device__ __forceinline__ void st_bf16x8(bf16_t* p, f32x4 v0, f32x4 v1) { u32x4 w; w.x = cvtpk(v0[0], v0[1]); w.y = cvtpk(v0[2], v0[3]); w.z = cvtpk(v1[0], v1[1]); w.w = cvtpk(v1[2], v1[3]); *(u32x4*)p = w; }

template <bool I8_> struct EpiInProj {
    static constexpr bool HAS_MID = false; static constexpr bool I8 = I8_;
    bf16_t* qa; bf16_t* qidx; bf16_t* qkv; bf16_t* gates; float* small_; const float* xs; const unsigned* wmaxbits;
    __device__ __forceinline__ f32x4 val(const f32x4& a, float sc) const { if constexpr (I8_) { const i32x4 v = __builtin_bit_cast(i32x4, a); return (f32x4){(float)v[0], (float)v[1], (float)v[2], (float)v[3]} * sc; } else return a; }
    __device__ __forceinline__ void operator()(const f32x4 (&acc)[2][2][4][2], const Unit& u, int wr, int wc, int fr, int fq) const {
        const int pn = u.pn, row0 = u.pm * BM + wr * 64 + fr, lc0 = wc * 32 + fq * 8;
        float sw = 0.f; if constexpr (I8_) sw = __uint_as_float(*wmaxbits) * (1.3f / 127.0f);
        float scs[2][4];
#pragma unroll
        for (int ai = 0; ai < 2; ++ai)
#pragma unroll
            for (int m = 0; m < 4; ++m) { scs[ai][m] = 0.f; if constexpr (I8_) scs[ai][m] = xs[row0 + ai * HALF + m * 16] * sw; }
        if (pn < 8) {
            bf16_t* base = (pn < 4 ? qa + pn * 256 : qidx + (pn - 4) * 256) + lc0;
            EPI_LOOP_ROWS { const int row = row0 + ai * HALF + m * 16; const float sc = scs[ai][m];
#pragma unroll
                for (int bj = 0; bj < 2; ++bj) st_bf16x8(base + (size_t)row * 1024 + bj * HALF, val(acc[ai][bj][m][0], sc), val(acc[ai][bj][m][1], sc)); }
        } else if (pn < 32) {
            const int id = (pn - 8) >> 2, hb = ((pn - 8) & 3) * 2, b = u.pm >> 5;
            bf16_t* base = qkv + (size_t)id * ((size_t)NTOK * 1024) + lc0;
            EPI_LOOP_ROWS { const int row = row0 + ai * HALF + m * 16, s = row & (SEQ - 1); const float sc = scs[ai][m];
#pragma unroll
                for (int bj = 0; bj < 2; ++bj) st_bf16x8(base + ((size_t)(b * 8 + hb + bj) * SEQ + s) * 128, val(acc[ai][bj][m][0], sc), val(acc[ai][bj][m][1], sc)); }
        } else if (pn < 56) {
            bf16_t* base = gates + (pn - 32) * 256 + lc0;
            EPI_LOOP_ROWS { const int row = row0 + ai * HALF + m * 16; const float sc = scs[ai][m];
#pragma unroll
                for (int bj = 0; bj < 2; ++bj) st_bf16x8(base + (size_t)row * 6144 + bj * HALF, val(acc[ai][bj][m][0], sc), val(acc[ai][bj][m][1], sc)); }
        } else {
            float* base = small_ + (pn - 56) * 256 + lc0;
            EPI_LOOP_ROWS { const int row = row0 + ai * HALF + m * 16; const float sc = scs[ai][m];
#pragma unroll
                for (int bj = 0; bj < 2; ++bj) { float* p = base + (size_t)row * 512 + bj * HALF; *(f32x4*)p = val(acc[ai][bj][m][0], sc); *(f32x4*)(p + 4) = val(acc[ai][bj][m][1], sc); } }
        }
    }
};
struct EpiBf16 {
    static constexpr bool HAS_MID = false; static constexpr bool I8 = false;
    bf16_t* out; int ld, cstep;
    __device__ __forceinline__ void operator()(const f32x4 (&acc)[2][2][4][2], const Unit& u, int wr, int wc, int fr, int fq) const {
        const int row0 = u.pm * BM + wr * 64 + fr; bf16_t* base = out + (size_t)u.pn * cstep + wc * 32 + fq * 8;
        EPI_LOOP_ROWS { const int row = row0 + ai * HALF + m * 16;
#pragma unroll
            for (int bj = 0; bj < 2; ++bj) st_bf16x8(base + (size_t)row * ld + bj * HALF, acc[ai][bj][m][0], acc[ai][bj][m][1]); }
    }
};
struct EpiBranch3 {
    static constexpr bool HAS_MID = true; static constexpr bool I8 = false; static constexpr int MID1 = 16, MID2 = 32;
    const bf16_t* gates; bf16_t* merged;
    __device__ __forceinline__ static f32x4 rat(unsigned n0, unsigned n1, unsigned d0, unsigned d1) {
        f32x4 r; r[0] = (1.f + __expf(-bflo(d0))) / (1.f + __expf(-bflo(n0))); r[1] = (1.f + __expf(-bfhi(d0))) / (1.f + __expf(-bfhi(n0)));
        r[2] = (1.f + __expf(-bflo(d1))) / (1.f + __expf(-bflo(n1))); r[3] = (1.f + __expf(-bfhi(d1))) / (1.f + __expf(-bfhi(n1))); return r; }
    __device__ __forceinline__ void mid(f32x4 (&acc)[2][2][4][2], const Unit& u, int t, int wr, int wc, int fr, int fq) const {
        const int row0 = u.pm * BM + wr * 64 + fr, col0 = u.pn * BM + wc * 32 + fq * 8, bn = (t == MID1) ? 0 : 2048;
#pragma unroll
        for (int ai = 0; ai < 2; ++ai) { u32x4 gn[4][2], gd[4][2];
#pragma unroll
            for (int m = 0; m < 4; ++m)
#pragma unroll
                for (int bj = 0; bj < 2; ++bj) { const bf16_t* gp = gates + (size_t)(row0 + ai * HALF + m * 16) * 6144 + bn + col0 + bj * HALF; gn[m][bj] = *(const u32x4*)gp; gd[m][bj] = *(const u32x4*)(gp + 2048); }
#pragma unroll
            for (int m = 0; m < 4; ++m)
#pragma unroll
                for (int bj = 0; bj < 2; ++bj) { acc[ai][bj][m][0] *= rat(gn[m][bj].x, gn[m][bj].y, gd[m][bj].x, gd[m][bj].y); acc[ai][bj][m][1] *= rat(gn[m][bj].z, gn[m][bj].w, gd[m][bj].z, gd[m][bj].w); } }
    }
    __device__ __forceinline__ void operator()(const f32x4 (&acc)[2][2][4][2], const Unit& u, int wr, int wc, int fr, int fq) const {
        const int row0 = u.pm * BM + wr * 64 + fr, col0 = u.pn * BM + wc * 32 + fq * 8;
        u32x4 gl[2][4][2];
        EPI_LOOP_ROWS {
#pragma unroll
            for (int bj = 0; bj < 2; ++bj) gl[ai][m][bj] = *(const u32x4*)(gates + (size_t)(row0 + ai * HALF + m * 16) * 6144 + 4096 + col0 + bj * HALF); }
        EPI_LOOP_ROWS { const int row = row0 + ai * HALF + m * 16;
#pragma unroll
            for (int bj = 0; bj < 2; ++bj) { const int col = col0 + bj * HALF; const u32x4 gw = gl[ai][m][bj];
                f32x4 v0 = acc[ai][bj][m][0], v1 = acc[ai][bj][m][1];
                v0[0] *= sigmoidf_(bflo(gw.x)); v0[1] *= sigmoidf_(bfhi(gw.x)); v0[2] *= sigmoidf_(bflo(gw.y)); v0[3] *= sigmoidf_(bfhi(gw.y));
                v1[0] *= sigmoidf_(bflo(gw.z)); v1[1] *= sigmoidf_(bfhi(gw.z)); v1[2] *= sigmoidf_(bflo(gw.w)); v1[3] *= sigmoidf_(bfhi(gw.w));
                st_bf16x8(merged + (size_t)row * 2048 + col, v0, v1); } }
    }
};
struct EpiOut {
    static constexpr bool HAS_MID = false; static constexpr bool I8 = false;
    const bf16_t* res; bf16_t* pre;
    __device__ __forceinline__ void operator()(const f32x4 (&acc)[2][2][4][2], const Unit& u, int wr, int wc, int fr, int fq) const {
        const int row0 = u.pm * BM + wr * 64 + fr, col0 = u.pn * BM + wc * 32 + fq * 8;
        u32x4 rl[2][4][2];
        EPI_LOOP_ROWS { const int row = row0 + ai * HALF + m * 16;
#pragma unroll
            for (int bj = 0; bj < 2; ++bj) rl[ai][m][bj] = *(const u32x4*)(res + (size_t)row * 2048 + col0 + bj * HALF); }
        EPI_LOOP_ROWS { const int row = row0 + ai * HALF + m * 16;
#pragma unroll
            for (int bj = 0; bj < 2; ++bj) { const size_t o = (size_t)row * 2048 + col0 + bj * HALF;
                const u32x4 rw = rl[ai][m][bj]; f32x4 v0 = acc[ai][bj][m][0], v1 = acc[ai][bj][m][1];
                v0[0] += ALPHA * bflo(rw.x); v0[1] += ALPHA * bfhi(rw.x); v0[2] += ALPHA * bflo(rw.y); v0[3] += ALPHA * bfhi(rw.y);
                v1[0] += ALPHA * bflo(rw.z); v1[1] += ALPHA * bfhi(rw.z); v1[2] += ALPHA * bflo(rw.w); v1[3] += ALPHA * bfhi(rw.w);
                st_bf16x8(pre + o, v0, v1); } }
    }
};
struct EpiGateUpI8 {
    static constexpr bool HAS_MID = false; static constexpr bool I8 = true;
    const float* bg; const float* bu; bf16_t* hid; const float* rowsx; const unsigned* wmaxbits;
    __device__ __forceinline__ void operator()(const f32x4 (&acc)[2][2][4][2], const Unit& u, int wr, int wc, int fr, int fq) const {
        const int row0 = u.pm * BM + wr * 64 + fr, j0 = u.pn * 128 + wc * 32 + fq * 8;
        const float sw = __uint_as_float(*wmaxbits) * (1.3f / 127.0f);
        const float* pg = bg + (size_t)u.e * DEXP + j0; const float* pu = bu + (size_t)u.e * DEXP + j0;
        const f32x4 g0b = *(const f32x4*)pg, g1b = *(const f32x4*)(pg + 4), u0b = *(const f32x4*)pu, u1b = *(const f32x4*)(pu + 4);
        float scs[2][4];
#pragma unroll
        for (int ai = 0; ai < 2; ++ai)
#pragma unroll
            for (int m = 0; m < 4; ++m) scs[ai][m] = rowsx[row0 + ai * HALF + m * 16] * sw;
        EPI_LOOP_ROWS { const int row = row0 + ai * HALF + m * 16; const float sc = scs[ai][m];
            const i32x4 ag0 = __builtin_bit_cast(i32x4, acc[ai][0][m][0]), ag1 = __builtin_bit_cast(i32x4, acc[ai][0][m][1]), au0 = __builtin_bit_cast(i32x4, acc[ai][1][m][0]), au1 = __builtin_bit_cast(i32x4, acc[ai][1][m][1]);
            f32x4 h0, h1;
#pragma unroll
            for (int j = 0; j < 4; ++j) {
                float g = fminf((float)ag0[j] * sc + g0b[j], 7.0f), uu = fminf(fmaxf((float)au0[j] * sc + u0b[j], -7.0f), 7.0f);
                h0[j] = (uu + 1.0f) * (g * sigmoidf_(1.702f * g));
                g = fminf((float)ag1[j] * sc + g1b[j], 7.0f); uu = fminf(fmaxf((float)au1[j] * sc + u1b[j], -7.0f), 7.0f);
                h1[j] = (uu + 1.0f) * (g * sigmoidf_(1.702f * g)); }
            st_bf16x8(hid + (size_t)row * DEXP + j0, h0, h1); }
    }
};
struct EpiDown {
    static constexpr bool HAS_MID = false; static constexpr bool I8 = false;
    const float* bd; const float* roww; bf16_t* ys;
    __device__ __forceinline__ void operator()(const f32x4 (&acc)[2][2][4][2], const Unit& u, int wr, int wc, int fr, int fq) const {
        const int row0 = u.pm * BM + wr * 64 + fr, col0 = u.pn * BM + wc * 32 + fq * 8;
        f32x4 b[2][2];
#pragma unroll
        for (int bj = 0; bj < 2; ++bj) { const float* p = bd + (size_t)u.e * DM + col0 + bj * HALF; b[bj][0] = *(const f32x4*)p; b[bj][1] = *(const f32x4*)(p + 4); }
        float rws[2][4];
#pragma unroll
        for (int ai = 0; ai < 2; ++ai)
#pragma unroll
            for (int m = 0; m < 4; ++m) rws[ai][m] = roww[row0 + ai * HALF + m * 16];
        EPI_LOOP_ROWS { const int row = row0 + ai * HALF + m * 16; const float w = rws[ai][m];
#pragma unroll
            for (int bj = 0; bj < 2; ++bj) st_bf16x8(ys + (size_t)row * 2048 + col0 + bj * HALF, (acc[ai][bj][m][0] + b[bj][0]) * w, (acc[ai][bj][m][1] + b[bj][1]) * w); }
    }
};
struct EpiPleGateI8 {
    static constexpr bool HAS_MID = false; static constexpr bool I8 = true;
    const bf16_t* hb; const bf16_t* pp; bf16_t* pre; const float* hs; const unsigned* wmaxbits;
    __device__ __forceinline__ void operator()(const f32x4 (&acc)[2][2][4][2], const Unit& u, int wr, int wc, int fr, int fq) const {
        const int row0 = u.pm * BM + wr * 64 + fr, col0 = u.pn * BM + wc * 32 + fq * 8;
        const float sw = __uint_as_float(*wmaxbits) * (1.3f / 127.0f);
#pragma unroll
        for (int ai = 0; ai < 2; ++ai) { u32x4 pl[4][2], hl[4][2]; float scs[4];
#pragma unroll
            for (int m = 0; m < 4; ++m) { scs[m] = hs[row0 + ai * HALF + m * 16] * sw;
#pragma unroll
                for (int bj = 0; bj < 2; ++bj) { const size_t o = (size_t)(row0 + ai * HALF + m * 16) * 2048 + col0 + bj * HALF; pl[m][bj] = *(const u32x4*)(pp + o); hl[m][bj] = *(const u32x4*)(hb + o); } }
#pragma unroll
            for (int m = 0; m < 4; ++m) { const float sc = scs[m];
#pragma unroll
                for (int bj = 0; bj < 2; ++bj) { const size_t o = (size_t)(row0 + ai * HALF + m * 16) * 2048 + col0 + bj * HALF; const u32x4 pw = pl[m][bj], hw = hl[m][bj];
                    const i32x4 a0 = __builtin_bit_cast(i32x4, acc[ai][bj][m][0]), a1 = __builtin_bit_cast(i32x4, acc[ai][bj][m][1]); f32x4 o0, o1;
                    o0[0] = bflo(hw.x) + sigmoidf_((float)a0[0] * sc) * bflo(pw.x); o0[1] = bfhi(hw.x) + sigmoidf_((float)a0[1] * sc) * bfhi(pw.x); o0[2] = bflo(hw.y) + sigmoidf_((float)a0[2] * sc) * bflo(pw.y); o0[3] = bfhi(hw.y) + sigmoidf_((float)a0[3] * sc) * bfhi(pw.y);
                    o1[0] = bflo(hw.z) + sigmoidf_((float)a1[0] * sc) * bflo(pw.z); o1[1] = bfhi(hw.z) + sigmoidf_((float)a1[1] * sc) * bfhi(pw.z); o1[2] = bflo(hw.w) + sigmoidf_((float)a1[2] * sc) * bflo(pw.w); o1[3] = bfhi(hw.w) + sigmoidf_((float)a1[3] * sc) * bfhi(pw.w);
                    st_bf16x8(pre + o, o0, o1); } } }
    }
};
}

struct Params { const float* in[25]; float* out; unsigned char* ws; int ph_lo, ph_hi; };
__constant__ float c_invf_r[16] = {1.000000000e+00f, 4.403665960e-01f, 1.939227432e-01f, 8.539710194e-02f, 3.760603070e-02f, 1.656043902e-02f, 7.292664610e-03f, 3.211445874e-03f, 1.414213562e-03f, 6.227723788e-04f, 2.742481884e-04f, 1.207697351e-04f, 5.318296098e-05f, 2.341999971e-05f, 1.031338616e-05f, 4.541670478e-06f};
__constant__ float c_invf_i[8] = {1.000000000e+00f, 1.939227432e-01f, 3.760603070e-02f, 7.292664610e-03f, 1.414213562e-03f, 2.742481884e-04f, 5.318296098e-05f, 1.031338616e-05f};
constexpr int LDS_PTRS = LDS_MISC + 256;
struct Frame { unsigned char* lds; LAS unsigned char* ldsl; unsigned char* ws; int tid, lane, wid, G, bid;
    __device__ __forceinline__ const float* in(int k) const { const LAS unsigned* t = (const LAS unsigned*)(ldsl + LDS_PTRS) + 2 * k;
        const unsigned lo = __builtin_amdgcn_readfirstlane(t[0]), hi = __builtin_amdgcn_readfirstlane(t[1]); return (const float*)(const GAS float*)(((unsigned long long)hi << 32) | lo); }
    __device__ __forceinline__ float* out() const { return (float*)in(25); } };
__device__ __forceinline__ Frame fresh(const Frame& F0) { Frame F = F0; int t = threadIdx.x; asm volatile("" : "+v"(t)); F.tid = t; F.lane = t & 63; F.wid = __builtin_amdgcn_readfirstlane(t >> 6); size_t z = 0; asm volatile("" : "+s"(z)); F.ws = F0.ws + z; return F; }

struct TcTile { const float* src; long sld; bf16_t* dst; long dld; int nvalid; float qinv; };
template <class Dec>
__device__ __forceinline__ void tconv_run(const Frame& F, int total, const Dec& dec, int& rot) {
    float* tile = (float*)F.lds;
    const int tid = F.tid, G = F.G;
    const int start = (F.bid - (rot % G) + G) % G; rot += total;
    const int lr = tid >> 4, lc4 = (tid & 15) * 4, sn = tid >> 3, skc = (tid & 7) * 8;
    f32x4 v[4][2];
#define TC_ISSUE(t0_) do { _Pragma("unroll") for (int q = 0; q < 4; ++q) { const int t = (t0_) + q * G; \
        if (t < total) { const TcTile ti = dec(t); _Pragma("unroll") for (int h = 0; h < 2; ++h) { v[q][h] = (f32x4){0.f, 0.f, 0.f, 0.f}; \
            if (lc4 < ti.nvalid) v[q][h] = *(const GAS f32x4*)((const GAS float*)ti.src + (size_t)(lr + 32 * h) * ti.sld + lc4); } } } } while (0)
    if (start < total) TC_ISSUE(start);
    for (int t0 = start; t0 < total; t0 += 4 * G) {
#pragma unroll
        for (int q = 0; q < 4; ++q) { if (t0 + q * G < total) { float* tl = tile + q * (64 * 65);
#pragma unroll
                for (int h = 0; h < 2; ++h) { float* p = tl + (lr + 32 * h) * 65 + lc4; p[0] = v[q][h][0]; p[1] = v[q][h][1]; p[2] = v[q][h][2]; p[3] = v[q][h][3]; } } }
        __syncthreads();
        if (t0 + 4 * G < total) TC_ISSUE(t0 + 4 * G);
#pragma unroll
        for (int q = 0; q < 4; ++q) { const int t = t0 + q * G;
            if (t < total) { const TcTile ti = dec(t); const float* tl = tile + q * (64 * 65);
                if (ti.qinv > 0.f) { if (tid < 256) { const int n8 = tid >> 2, kc = (tid & 3) * 16; u32x4 w;
#pragma unroll
                        for (int d = 0; d < 4; ++d) { unsigned pk = 0u;
#pragma unroll
                            for (int j = 0; j < 4; ++j) { float q = rintf(tl[(kc + d * 4 + j) * 65 + n8] * ti.qinv); q = fminf(fmaxf(q, -127.f), 127.f); pk |= ((unsigned)(int)q & 0xffu) << (8 * j); }
                            w[d] = pk; }
                        *(u32x4*)((unsigned char*)ti.dst + (size_t)n8 * ti.dld + kc) = w; } }
                else if (sn < ti.nvalid) { f32x4 a, b;
#pragma unroll
                    for (int j = 0; j < 4; ++j) { a[j] = tl[(skc + j) * 65 + sn]; b[j] = tl[(skc + 4 + j) * 65 + sn]; }
                    pg8::st_bf16x8(ti.dst + (size_t)sn * ti.dld + skc, a, b); } } }
        __syncthreads();
    }
#undef TC_ISSUE
}
struct TcMat {
    const float* src; long src_ld; int tk, ncols; bf16_t* dst; long dst_ld; float qinv;
    __device__ __forceinline__ TcTile operator()(int t) const { const int k0 = (t % tk) * 64, n0 = (t / tk) * 64; TcTile ti;
        ti.src = src + (size_t)k0 * src_ld + n0; ti.sld = src_ld; ti.dst = qinv > 0.f ? (bf16_t*)((unsigned char*)dst + (size_t)n0 * dst_ld + k0) : dst + (size_t)n0 * dst_ld + k0; ti.dld = dst_ld; ti.nvalid = (ncols - n0) < 64 ? (ncols - n0) : 64; ti.qinv = qinv; return ti; }
};
__device__ __forceinline__ void tconv(const Frame& F, const float* src, long src_ld, int K, int ncols, bf16_t* dst, long dst_ld, int& rot) {
    TcMat d{src, src_ld, K >> 6, ncols, dst, dst_ld, 0.f}; tconv_run(F, (K >> 6) * ((ncols + 63) >> 6), d, rot);
}
struct TcExperts {
    const float* wg; const float* wu; const float* wd; unsigned char* dgu; bf16_t* ddn; float qinv;
    __device__ __forceinline__ TcTile operator()(int t) const { const int e = t / 1536, r = t - e * 1536; TcTile ti; ti.nvalid = 64; ti.qinv = 0.f;
        if (r < 1024) { const int k0 = (r & 31) * 64, dt = r >> 5, jb = dt >> 2, gu = (dt >> 1) & 1, half = dt & 1;
            ti.src = (const float*)((unsigned long long)wg + (unsigned long long)gu * ((unsigned long long)wu - (unsigned long long)wg)) + (size_t)e * DM * DEXP + (size_t)k0 * DEXP + jb * 128 + half * 64; ti.sld = DEXP;
            ti.dst = (bf16_t*)(dgu + (size_t)e * 2048 * 2048 + (size_t)(dt * 64) * 2048 + k0); ti.dld = 2048; ti.qinv = qinv; }
        else { const int r2 = r - 1024, k0 = (r2 & 15) * 64, n0 = (r2 >> 4) * 64;
            ti.src = wd + (size_t)e * DEXP * DM + (size_t)k0 * DM + n0; ti.sld = DM;
            ti.dst = ddn + (size_t)e * 2048 * 1024 + (size_t)n0 * 1024 + k0; ti.dld = 1024; }
        return ti; }
};
__device__ __forceinline__ void sample_wmax(const Frame& F) {
    unsigned* wm = (unsigned*)(F.ws + WS_CTL) + CW_WMAX;
#pragma unroll 1
    for (int l = 0; l < NLAYER; ++l) { float mx = 0.f;
#pragma unroll 1
        for (int which = 0; which < 2; ++which) { const f32x4* p = (const f32x4*)(F.in(which ? 17 : 15) + (size_t)l * NEXP * DM * DEXP);
            for (size_t i = (size_t)F.bid * 512 + F.tid; i < (size_t)NEXP * DM * DEXP / 4 / 64; i += (size_t)F.G * 512) { const f32x4 v = p[i * 64 + (i & 63)];
                mx = fmaxf(mx, fmaxf(fmaxf(fabsf(v[0]), fabsf(v[1])), fmaxf(fabsf(v[2]), fabsf(v[3])))); } }
        for (int o = 32; o > 0; o >>= 1) mx = fmaxf(mx, __shfl_xor(mx, o));
        if (F.lane == 0 && mx > 0.f) atomicMax(&wm[l], __float_as_uint(mx));
        float mg = 0.f; const f32x4* wi_ = (const f32x4*)(F.in(2) + (size_t)l * DM * INW);
        for (int i = F.bid * 512 + F.tid; i < DM * (INW / 4) / 16; i += F.G * 512) { const f32x4 v = wi_[(size_t)i * 16 + (i & 15)];
            mg = fmaxf(mg, fmaxf(fmaxf(fabsf(v[0]), fabsf(v[1])), fmaxf(fabsf(v[2]), fabsf(v[3])))); }
        for (int o = 32; o > 0; o >>= 1) mg = fmaxf(mg, __shfl_xor(mg, o));
        if (F.lane == 0 && mg > 0.f) atomicMax(&wm[CW_WMAXG - CW_WMAX + l], __float_as_uint(mg));
        float mp = 0.f; const f32x4* wp_ = (const f32x4*)(F.in(21) + (size_t)l * DM * DM);
        for (int i = F.bid * 512 + F.tid; i < DM * DM / 4 / 16; i += F.G * 512) { const f32x4 v = wp_[i * 16 + (i & 15)];
            mp = fmaxf(mp, fmaxf(fmaxf(fabsf(v[0]), fabsf(v[1])), fmaxf(fabsf(v[2]), fabsf(v[3])))); }
        for (int o = 32; o > 0; o >>= 1) mp = fmaxf(mp, __shfl_xor(mp, o));
        if (F.lane == 0 && mp > 0.f) atomicMax(&wm[CW_WMAXP - CW_WMAX + l], __float_as_uint(mp)); }
}
__device__ __forceinline__ void conv_rows(const Frame& F, const float* src, bf16_t* dst, size_t n8) {
    for (size_t i = (size_t)F.bid * 512 + F.tid; i < n8; i += (size_t)F.G * 512) { const f32x4 a = *(const f32x4*)(src + i * 8), b = *(const f32x4*)(src + i * 8 + 4); pg8::st_bf16x8(dst + i * 8, a, b); }
}
__device__ __forceinline__ void quant_rows(const Frame& F, const float* src, bf16_t* xb, unsigned char* xq, float* xsc) {
    const int lane = F.lane;
    for (int tok = F.bid * 8 + F.wid; tok < NTOK; tok += F.G * 8) { f32x4 v[8]; float amax = 0.f;
#pragma unroll
        for (int i = 0; i < 4; ++i) { const int c = (i * 64 + lane) * 8; v[2 * i] = *(const f32x4*)(src + (size_t)tok * DM + c); v[2 * i + 1] = *(const f32x4*)(src + (size_t)tok * DM + c + 4);
            pg8::st_bf16x8(xb + (size_t)tok * DM + c, v[2 * i], v[2 * i + 1]);
#pragma unroll
            for (int h = 0; h < 2; ++h)
#pragma unroll
                for (int j = 0; j < 4; ++j) amax = fmaxf(amax, fabsf(v[2 * i + h][j])); }
        for (int o = 32; o > 0; o >>= 1) amax = fmaxf(amax, __shfl_xor(amax, o));
        amax = fmaxf(amax, 1e-20f); const float qi = 127.0f / amax; if (lane == 0) xsc[tok] = amax * (1.0f / 127.0f);
#pragma unroll
        for (int i = 0; i < 4; ++i) { u32x2 w;
#pragma unroll
            for (int h = 0; h < 2; ++h) { unsigned pk = 0u;
#pragma unroll
                for (int j = 0; j < 4; ++j) pk |= ((unsigned)(int)rintf(v[2 * i + h][j] * qi) & 0xffu) << (8 * j);
                w[h] = pk; }
            *(u32x2*)(xq + (size_t)tok * DM + (i * 64 + lane) * 8) = w; } }
}
__constant__ int c_so[14] = {0, 1312, 2416, 3440, 4464, 5496, 6520, 7544, 8568, 1024, 1280, 2336, 2400, 5488};
__constant__ int c_dn[14] = {0, 1024, 2048, 3072, 4096, 5120, 6144, 7168, 8192, 14336, 14592, 14624, 14688, 14704};
__constant__ int c_nc[14] = {1024, 1024, 1024, 1024, 1024, 1024, 1024, 1024, 6144, 256, 32, 64, 16, 8};
__device__ __forceinline__ void convert_layer_weights(const Frame& F0, const Params& P, int l) { const Frame F = fresh(F0);
    unsigned char* ws = F.ws; int rot = 0;
    { const float* w = F.in(2) + (size_t)l * DM * INW; bf16_t* d = (bf16_t*)(ws + W_IN);
      const float wmaxg = __uint_as_float(((const unsigned*)(ws + WS_CTL))[CW_WMAXG + l]); const float qinv = 127.0f / (1.3f * wmaxg);
#pragma unroll 1
      for (int s = 0; s < 14; ++s) {
          if (s == 1 || s >= 10) tconv(F, w + c_so[s], INW, DM, c_nc[s], d + (size_t)c_dn[s] * DM, DM, rot);
          else { const int crow = (s == 0) ? 0 : (s <= 7 ? 1024 + (s - 2) * 1024 : (s == 8 ? 7168 : 13312));
              TcMat dq{w + c_so[s], INW, DM >> 6, c_nc[s], (bf16_t*)(ws + W_IN8 + (size_t)crow * 2048), 2048, qinv}; tconv_run(F, (DM >> 6) * (c_nc[s] >> 6), dq, rot); } } }
    tconv(F, F.in(7) + (size_t)l * 1024 * DM, DM, 1024, DM, (bf16_t*)(ws + W_BRA), 3072, rot);
    tconv(F, F.in(8) + (size_t)l * 1024 * DM, DM, 1024, DM, (bf16_t*)(ws + W_BRA) + 1024, 3072, rot);
    tconv(F, F.in(9) + (size_t)l * 1024 * DM, DM, 1024, DM, (bf16_t*)(ws + W_BRA) + 2048, 3072, rot);
    tconv(F, F.in(10) + (size_t)l * DM * DM, DM, DM, DM, (bf16_t*)(ws + W_OUT), DM, rot);
    { const float wmp = __uint_as_float(((const unsigned*)(ws + WS_CTL))[CW_WMAXP + l]);
      TcMat dq{F.in(21) + (size_t)l * DM * DM, DM, DM >> 6, DM, (bf16_t*)(ws + W_PG), 2048, 127.0f / (1.3f * wmp)}; tconv_run(F, (DM >> 6) * (DM >> 6), dq, rot); }
    tconv(F, F.in(22) + (size_t)l * 256 * DM, DM, 256, DM, (bf16_t*)(ws + W_PLE), 256, rot);
#pragma unroll 1
    for (int h = 0; h < 8; ++h) tconv(F, F.in(6) + (size_t)l * 256 * 1024 + h * 128, 1024, 256, 128, (bf16_t*)(ws + W_UV2) + ((size_t)(h >> 1) * 256 + (h & 1) * 128) * 512 + (h & 1) * 256, 512, rot);
    { const float wmax = __uint_as_float(((const unsigned*)(ws + WS_CTL))[CW_WMAX + l]);
      TcExperts d{F.in(15) + (size_t)l * NEXP * DM * DEXP, F.in(17) + (size_t)l * NEXP * DM * DEXP, F.in(19) + (size_t)l * NEXP * DEXP * DM, (unsigned char*)(ws + W_GU), (bf16_t*)(ws + W_DN), 127.0f / (1.3f * wmax)};
      tconv_run(F, NEXP * 1536, d, rot); }
    { const float* w = F.in(5) + (size_t)l * 256 * 8 * 96; bf16_t* d = (bf16_t*)(ws + W_UK2);
      for (int i = F.bid * 512 + F.tid; i < 256 * 8 * 96; i += F.G * 512) { const int n = i % 96, h = (i / 96) & 7, r = i / 768; d[((size_t)h * 256 + r) * 256 + (h & 1) * 128 + 32 + n] = f2bf(w[i]); } }
}

__device__ __forceinline__ void rope_cs(float pos, float invf, float& c, float& s) {
    const float a = pos * invf; const double ad = (double)a * 0.15915494309189535; const float fr = (float)(ad - rint(ad));
    s = __builtin_amdgcn_sinf(fr); c = __builtin_amdgcn_cosf(fr);
}
__device__ __forceinline__ void phase_prep(const Frame& F0, const Params& P, int l) { const Frame F = fresh(F0);
    unsigned char* ws = F.ws; const int lane = F.lane;
    const float* smallb = (const float*)(ws + R_SMALL); bf16_t* kcat = (bf16_t*)(ws + R_KCAT); bf16_t* qcat = (bf16_t*)(ws + R_QCAT);
    bf16_t* ki = (bf16_t*)(ws + R_KI); float* wi = (float*)(ws + R_WI); float* lf = (float*)(ws + WS_LF);
    const bf16_t* qa = (const bf16_t*)(ws + R_QA); bf16_t* qidx = (bf16_t*)(ws + R_QIDX);
    const f32x4 gck = *(const f32x4*)(F.in(4) + l * 256 + lane * 4);
    const float bfo = lane < 8 ? F.in(3)[l * 8 + lane] : 0.f;
    const float ifr = c_invf_r[lane & 15], ifi = c_invf_i[lane & 7];
    for (int tok = F.bid * 8 + F.wid; tok < NTOK; tok += F.G * 8) {
        const int s = tok & (SEQ - 1), b = tok >> 13; const float* sm = smallb + (size_t)tok * 512;
        float cr, sr, ci, si; rope_cs((float)s, ifr, cr, sr); rope_cs((float)s, ifi, ci, si);
        { const f32x4 v = *(const f32x4*)(sm + lane * 4); float ss = v[0] * v[0] + v[1] * v[1] + v[2] * v[2] + v[3] * v[3]; ss = wave_sum(ss);
          const float rs = rsqrtf(ss * (1.0f / 256.0f) + 1e-6f); u32x2 w; w.x = cvtpk(v[0] * rs * gck[0], v[1] * rs * gck[1]); w.y = cvtpk(v[2] * rs * gck[2], v[3] * rs * gck[3]);
          *(u32x2*)(kcat + (size_t)tok * 288 + lane * 4) = w; }
        if (lane < 16) { const float x1 = sm[256 + lane], x2 = sm[272 + lane]; kcat[(size_t)tok * 288 + 256 + lane] = f2bf(x1 * cr - x2 * sr); kcat[(size_t)tok * 288 + 272 + lane] = f2bf(x2 * cr + x1 * sr); }
        { float o = sm[288 + lane];
          if (lane < 8) { const float x2 = sm[296 + lane]; o = o * ci - x2 * si; } else if (lane < 16) { const float x1 = sm[288 + lane - 8]; o = o * ci + x1 * si; }
          ki[(size_t)tok * 64 + lane] = f2bf(o); }
        if (lane < 16) wi[(size_t)tok * 16 + lane] = sm[352 + lane] * (1.0f / 32.0f);
        if (lane < 8) { const float f = sm[368 + lane] + bfo; lf[(size_t)(b * 8 + lane) * SEQ + s] = fminf(f, 0.f) - log1pf(__expf(-fabsf(f))); }
#pragma unroll
        for (int pp = 0; pp < 2; ++pp) { const int p = lane + 64 * pp, h = p >> 4, i = p & 15;
            const float x1 = bf2f(qa[(size_t)tok * 1024 + h * 128 + i]), x2 = bf2f(qa[(size_t)tok * 1024 + h * 128 + 16 + i]);
            qcat[(size_t)tok * 2304 + h * 288 + 256 + i] = f2bf(x1 * cr - x2 * sr); qcat[(size_t)tok * 2304 + h * 288 + 272 + i] = f2bf(x2 * cr + x1 * sr); }
#pragma unroll
        for (int pp = 0; pp < 2; ++pp) { const int p = lane + 64 * pp, hh = p >> 3, i = p & 7; bf16_t* q = qidx + (size_t)tok * 1024 + hh * 64;
            const float x1 = bf2f(q[i]), x2 = bf2f(q[8 + i]); q[i] = f2bf(x1 * ci - x2 * si); q[8 + i] = f2bf(x2 * ci + x1 * si); }
    }
    { const bf16_t* kbt = (const bf16_t*)(ws + R_QKV) + (size_t)NTOK * 1024; unsigned* kmx = (unsigned*)(ws + WS_CTL) + CW_KMAX + l * 16;
#pragma unroll 1
      for (int bh = 0; bh < 16; ++bh) { float mx = 0.f;
          for (int r0 = (F.bid * 8 + F.wid) * 4; r0 < SEQ; r0 += F.G * 32) {
              const u32x4 w = *(const u32x4*)(kbt + ((size_t)bh * SEQ + r0 + (lane >> 4)) * 128 + (lane & 15) * 8);
              float ss = bflo(w.x) * bflo(w.x) + bfhi(w.x) * bfhi(w.x) + bflo(w.y) * bflo(w.y) + bfhi(w.y) * bfhi(w.y) + bflo(w.z) * bflo(w.z) + bfhi(w.z) * bfhi(w.z) + bflo(w.w) * bflo(w.w) + bfhi(w.w) * bfhi(w.w);
              ss += __shfl_xor(ss, 1); ss += __shfl_xor(ss, 2); ss += __shfl_xor(ss, 4); ss += __shfl_xor(ss, 8); mx = fmaxf(mx, ss); }
          mx = fmaxf(mx, __shfl_xor(mx, 16)); mx = fmaxf(mx, __shfl_xor(mx, 32));
          if (lane == 0) ((float*)F.lds)[F.wid * 16 + bh] = mx; }
      __syncthreads();
      if (F.tid < 16) { float mx = 0.f;
#pragma unroll
          for (int w = 0; w < 8; ++w) mx = fmaxf(mx, ((const float*)F.lds)[w * 16 + F.tid]);
          const unsigned bits = __float_as_uint(mx);
          if (bits > __hip_atomic_load(&kmx[F.tid], __ATOMIC_RELAXED, __HIP_MEMORY_SCOPE_AGENT)) atomicMax(&kmx[F.tid], bits); }
      __syncthreads(); }
}
__device__ __forceinline__ void phase_cumsum(const Frame& F0) { const Frame F = fresh(F0);
    const int gw = F.bid * 8 + F.wid; if (gw >= 16) return;
    const float* lf = (const float*)(F.ws + WS_LF) + (size_t)gw * SEQ; float* cum = (float*)(F.ws + WS_CUM) + (size_t)gw * SEQ;
    const int lane = F.lane; double tot = 0.0;
    for (int j = 0; j < 128; ++j) tot += (double)lf[lane * 128 + j];
    double inc = tot;
    for (int o = 1; o < 64; o <<= 1) { const double n = __shfl_up(inc, o); if (lane >= o) inc += n; }
    double run = inc - tot;
    for (int j = 0; j < 128; ++j) { run += (double)lf[lane * 128 + j]; cum[lane * 128 + j] = (float)run; }
}

__device__ __forceinline__ void idx_unit(const Frame& F, int b, int pi, int half) {
    const int tid = F.tid, lane = F.lane, rho = lane & 31, hh = lane >> 5; unsigned char* ws = F.ws;
    const bf16_t* qidx = (const bf16_t*)(ws + R_QIDX); const bf16_t* ki = (const bf16_t*)(ws + R_KI) + (size_t)b * SEQ * 64; const float* wi = (const float*)(ws + R_WI);
    float* scores = (float*)(ws + R_SCORES) + (size_t)b * SEQ * SEQ;
    LAS unsigned char* kl = F.ldsl;
    const int gl = pi, gh = 127 - pi, nl = (64 * gl + 63) / 128 + 1, nh = (64 * gh + 63) / 128 + 1, tot = nl + nh;
    const int x0 = half ? tot / 2 : 0, x1 = half ? tot : tot / 2;
    bf16x8 af[4][4]; float wv[4][16]; int t0 = 0, curg = -1;
    const int r0 = tid >> 3, p0 = tid & 7;
    const unsigned d0 = (unsigned)(r0 * 128 + ((p0 ^ (r0 & 7)) << 4)), d1 = d0 + 64 * 128;
    u32x4 s0, s1;
    { const int c = x0 < nl ? x0 : x0 - nl; const bf16_t* kp = ki + (size_t)(c * 128) * 64; s0 = *(const u32x4*)(kp + (size_t)r0 * 64 + p0 * 8); s1 = *(const u32x4*)(kp + (size_t)(r0 + 64) * 64 + p0 * 8); }
    __syncthreads();
    *(LAS u32x4*)(kl + d0) = s0; *(LAS u32x4*)(kl + d1) = s1;
    __syncthreads();
    const unsigned rdo = (unsigned)(rho * 128);
#pragma unroll 1
    for (int x = x0; x < x1; ++x) {
        const int g = x < nl ? gl : gh, c = x < nl ? x : x - nl;
        if (g != curg) { curg = g; t0 = g * 64 + F.wid * 8;
#pragma unroll
            for (int mt = 0; mt < 4; ++mt) {
                const int tokA = b * SEQ + t0 + 2 * mt + ((rho >> 2) & 1), head = (rho & 3) + 4 * (rho >> 3);
#pragma unroll
                for (int kk = 0; kk < 4; ++kk) af[mt][kk] = *(const bf16x8*)(qidx + (size_t)tokA * 1024 + head * 64 + kk * 16 + 8 * hh);
                const float* wp = wi + (size_t)(b * SEQ + t0 + 2 * mt + hh) * 16;
#pragma unroll
                for (int q = 0; q < 4; ++q) { const f32x4 v = *(const f32x4*)(wp + 4 * q); wv[mt][4 * q] = v[0]; wv[mt][4 * q + 1] = v[1]; wv[mt][4 * q + 2] = v[2]; wv[mt][4 * q + 3] = v[3]; } } }
        const unsigned bo = (unsigned)((x - x0) & 1) * 16384u;
        if (x + 1 < x1) { const int cn = (x + 1) < nl ? (x + 1) : (x + 1) - nl; const bf16_t* kp = ki + (size_t)(cn * 128) * 64; s0 = *(const u32x4*)(kp + (size_t)r0 * 64 + p0 * 8); s1 = *(const u32x4*)(kp + (size_t)(r0 + 64) * 64 + p0 * 8); }
#pragma unroll
        for (int tl = 0; tl < 4; ++tl) {
            const int kb = c * 128 + tl * 32;
            if (kb <= t0 + 7) {
                bf16x8 bc[4];
#pragma unroll
                for (int kk = 0; kk < 4; ++kk) bc[kk] = *(const LAS bf16x8*)(kl + bo + tl * 4096 + rdo + (((kk * 2 + hh) ^ (rho & 7)) << 4));
                f32x16 a0 = {}, a1 = {}, a2 = {}, a3 = {};
#pragma unroll
                for (int kk = 0; kk < 4; ++kk) { a0 = __builtin_amdgcn_mfma_f32_32x32x16_bf16(af[0][kk], bc[kk], a0, 0, 0, 0); a1 = __builtin_amdgcn_mfma_f32_32x32x16_bf16(af[1][kk], bc[kk], a1, 0, 0, 0);
                                                  a2 = __builtin_amdgcn_mfma_f32_32x32x16_bf16(af[2][kk], bc[kk], a2, 0, 0, 0); a3 = __builtin_amdgcn_mfma_f32_32x32x16_bf16(af[3][kk], bc[kk], a3, 0, 0, 0); }
#define IDX_EPI(A_, mt_) do { float x_0 = 0.f, x_1 = 0.f, x_2 = 0.f, x_3 = 0.f; _Pragma("unroll") for (int r = 0; r < 16; r += 4) { \
                    x_0 = fmaf(wv[mt_][r], fmaxf(A_[r], 0.f), x_0); x_1 = fmaf(wv[mt_][r + 1], fmaxf(A_[r + 1], 0.f), x_1); x_2 = fmaf(wv[mt_][r + 2], fmaxf(A_[r + 2], 0.f), x_2); x_3 = fmaf(wv[mt_][r + 3], fmaxf(A_[r + 3], 0.f), x_3); } \
                    scores[(size_t)(t0 + 2 * (mt_) + hh) * SEQ + kb + rho] = (x_0 + x_1) + (x_2 + x_3); } while (0)
                IDX_EPI(a0, 0); IDX_EPI(a1, 1); IDX_EPI(a2, 2); IDX_EPI(a3, 3);
#undef IDX_EPI
            }
        }
        if (x + 1 < x1) { *(LAS u32x4*)(kl + (bo ^ 16384u) + d0) = s0; *(LAS u32x4*)(kl + (bo ^ 16384u) + d1) = s1; }
        __syncthreads();
    }
}
__device__ __forceinline__ void phase_idx(const Frame& F0) { const Frame F = fresh(F0);
#pragma unroll 1
    for (int it = F.bid; it < 256; it += F.G) { const int b = it >> 7, pi = (it >> 1) & 63, half = it & 1; idx_unit(F, b, pi, half); }
}

__device__ __forceinline__ unsigned sortable(float f) { const unsigned u = __float_as_uint(f); return (u & 0x80000000u) ? ~u : (u | 0x80000000u); }
__device__ __forceinline__ void topk_row(const Frame& F, int b, int t) {
    int lane = F.lane; asm volatile("" : "+v"(lane));
    const int L = t + 1, tok = b * SEQ + t; unsigned char* ws = F.ws;
    int* sel = (int*)(ws + R_SEL) + (size_t)tok * 256; int* nsel = (int*)(ws + R_NSEL);
    if (lane == 0) nsel[tok] = L < 256 ? L : 256;
    if (L <= 256) { for (int j = lane; j < 256; j += 64) sel[j] = j < L ? j : 0; return; }
    const float* row = (const float*)(ws + R_SCORES) + ((size_t)b * SEQ + t) * SEQ;
    const int nch = (L + 1023) >> 10;
#define TOPK_LOAD_ROW() do { _Pragma("unroll") for (int c = 0; c < 8; ++c) { \
        if (c < nch) { _Pragma("unroll") for (int jj = 0; jj < 4; ++jj) { const int j = c * 4 + jj; const f32x4 v = *(const f32x4*)(row + j * 256 + lane * 4); \
                _Pragma("unroll") for (int e_ = 0; e_ < 4; ++e_) { const int idx = j * 256 + lane * 4 + e_; u[j * 4 + e_] = idx < L ? sortable(v[e_]) : 0u; } } } \
        else { _Pragma("unroll") for (int q = 0; q < 16; ++q) u[c * 16 + q] = 0u; } } } while (0)
    unsigned u[128];
    TOPK_LOAD_ROW();
    unsigned g0 = 0u, g1 = 0u, g2 = 0u, g3 = 0u;
#pragma unroll
    for (int c = 0; c < 8; ++c) if (c < nch) {
#pragma unroll
        for (int jj = 0; jj < 4; ++jj) { const int j = c * 4 + jj; g0 = u[4 * j] > g0 ? u[4 * j] : g0; g1 = u[4 * j + 1] > g1 ? u[4 * j + 1] : g1; g2 = u[4 * j + 2] > g2 ? u[4 * j + 2] : g2; g3 = u[4 * j + 3] > g3 ? u[4 * j + 3] : g3; } }
    unsigned tl = g0 < g1 ? g0 : g1; { const unsigned t2 = g2 < g3 ? g2 : g3; tl = tl < t2 ? tl : t2; }
#pragma unroll
    for (int o = 32; o > 0; o >>= 1) { const unsigned x = (unsigned)__shfl_xor((int)tl, o); tl = x < tl ? x : tl; }
    constexpr int CAP = 2048;
    LAS unsigned* candk = (LAS unsigned*)(F.ldsl + F.wid * (CAP * 8)); LAS unsigned* candi = candk + CAP;
    int C = 0;
#pragma unroll
    for (int c = 0; c < 8; ++c) if (c < nch) {
#pragma unroll
        for (int q = 0; q < 16; ++q) { const int rq = c * 16 + q; const bool pr = u[rq] >= tl; const unsigned long long mm = __ballot(pr);
            const int pos = C + __popcll(mm & ((1ull << lane) - 1ull));
            if (pr && pos < CAP) { candk[pos] = u[rq]; candi[pos] = (unsigned)((rq >> 2) * 256 + lane * 4 + (rq & 3)); }
            C += __popcll(mm); if ((q & 3) == 3) SBAR(); } }
    if (C <= CAP) {
        const int ng = (C + 255) >> 8;
        unsigned ck[32]; int ci[32];
#pragma unroll
        for (int g = 0; g < 8; ++g) {
#pragma unroll
            for (int q = 0; q < 4; ++q) { const int r = g * 4 + q, p = r * 64 + lane; ck[r] = 0u; ci[r] = 0;
                if (g < ng && p < C) { ck[r] = candk[p]; ci[r] = (int)candi[p]; } } }
        unsigned T = 0u, thr_gt = 0u; int need_eq = 0; bool early = false;
        for (int bit = 31; bit >= 0; --bit) {
            const unsigned cnd = T | (1u << bit); int cnt = 0;
#pragma unroll
            for (int g = 0; g < 8; ++g) if (g < ng) {
#pragma unroll
                for (int q = 0; q < 4; ++q) cnt += __popcll(__ballot(ck[g * 4 + q] >= cnd)); }
            if (cnt >= 256) { T = cnd; if (cnt == 256) { early = true; break; } }
        }
        if (early) { thr_gt = T - 1u; need_eq = 0; }
        else { int gtc = 0;
#pragma unroll
            for (int g = 0; g < 8; ++g) if (g < ng) {
#pragma unroll
                for (int q = 0; q < 4; ++q) gtc += __popcll(__ballot(ck[g * 4 + q] > T)); }
            thr_gt = T; need_eq = 256 - gtc; }
        int base = 0, eq_taken = 0;
#pragma unroll
        for (int g = 0; g < 8; ++g) if (g < ng) {
#pragma unroll
            for (int q = 0; q < 4; ++q) { const int r = g * 4 + q; const unsigned v = ck[r];
                const bool iseq = (v == thr_gt) && (need_eq > 0);
                const unsigned long long meq = __ballot(iseq);
                const int eqr = __popcll(meq & ((1ull << lane) - 1ull));
                const bool take = (v > thr_gt) || (iseq && (eq_taken + eqr < need_eq));
                const unsigned long long mt = __ballot(take);
                const int pos = base + __popcll(mt & ((1ull << lane) - 1ull));
                if (take && pos < 256) sel[pos] = ci[r];
                base += __popcll(mt); eq_taken += __popcll(meq); } }
        return;
    }
    asm volatile("" ::: "memory");
    TOPK_LOAD_ROW();
    unsigned T = 0u, thr_gt = 0u; int need_eq = 0; bool early = false;
    for (int bit = 31; bit >= 0; --bit) {
        const unsigned cand = T | (1u << bit); int cnt = 0;
#pragma unroll
        for (int c = 0; c < 8; ++c) if (c < nch) {
#pragma unroll
            for (int q = 0; q < 16; ++q) cnt += __popcll(__ballot(u[c * 16 + q] >= cand)); }
        if (cnt >= 256) { T = cand; if (cnt == 256) { early = true; break; } }
    }
    if (early) { thr_gt = T - 1u; need_eq = 0; }
    else { int gtc = 0;
#pragma unroll
        for (int c = 0; c < 8; ++c) if (c < nch) {
#pragma unroll
            for (int q = 0; q < 16; ++q) gtc += __popcll(__ballot(u[c * 16 + q] > T)); }
        thr_gt = T; need_eq = 256 - gtc; }
    int base = 0, eq_taken = 0;
#pragma unroll
    for (int c = 0; c < 8; ++c) if (c < nch) {
#pragma unroll
        for (int q = 0; q < 16; ++q) { const int rq = c * 16 + q; const unsigned v = u[rq];
            const bool iseq = (v == thr_gt) && (need_eq > 0);
            const unsigned long long meq = __ballot(iseq);
            const int eqr = __popcll(meq & ((1ull << lane) - 1ull));
            const bool take = (v > thr_gt) || (iseq && (eq_taken + eqr < need_eq));
            const unsigned long long mt = __ballot(take);
            const int pos = base + __popcll(mt & ((1ull << lane) - 1ull));
            if (take && pos < 256) sel[pos] = (rq >> 2) * 256 + lane * 4 + (rq & 3);
            base += __popcll(mt); eq_taken += __popcll(meq); } }
}
__device__ __forceinline__ void phase_topk(const Frame& F0) { const Frame F = fresh(F0);
    for (int q = F.bid * 8 + F.wid; q < 8192; q += F.G * 8) { const int b = q >> 12, p = q & 4095; topk_row(F, b, p); topk_row(F, b, SEQ - 1 - p); }
}

namespace att {
constexpr int D = 128, KVBLK = 64, QBLK = 32, SHM_V = 16384, SHM_K = 16384;
constexpr int OFF_K = 2 * SHM_V, OFF_BIAS = 2 * SHM_V + 2 * SHM_K, OFF_WS = OFF_BIAS + 512, OFF_FLAGS = OFF_WS + 2048, OFF_QITEM = OFF_FLAGS + 64;
constexpr float EXIT_T = 44.0f;
#define KSWZ(row, colB) ((row) * 256 + ((colB) ^ (((row) & 7) << 4)))
__device__ __forceinline__ int v_st(int k, int c) { const int kk = (k & ~0xC) | ((k & 4) << 1) | ((k & 8) >> 1); return ((kk >> 3) * 4 + (c >> 5)) * 512 + ((kk & 7) * 32 + (c & 31)) * 2; }
__device__ __forceinline__ int v_rd_base(int lane) { return ((lane & 3) << 3) | (((lane >> 2) & 3) << 6) | (((lane >> 4) & 1) << 5) | (((lane >> 5) & 1) << 8); }
constexpr int v_rd_off(int d0, int ks, int half) { return d0 * 512 + ks * 4096 + half * 2048; }
template <int KB>
__device__ __forceinline__ void qkt(f32x16& p0, f32x16& p1, const char* K_lds, int r32, int hi, const bf16x8* qr) {
    p0 = f32x16{}; p1 = f32x16{};
    const char* kb[4];
#pragma unroll
    for (int dd = 0; dd < 4; ++dd) kb[dd] = K_lds + KB * SHM_K + KSWZ(r32, (dd * 16 + hi * 8) * 2);
#pragma unroll
    for (int d0 = 0; d0 < 8; ++d0) { const char* a = kb[d0 & 3] + (d0 >> 2) * 128;
        bf16x8 b0 = *reinterpret_cast<const bf16x8*>(a);
        bf16x8 b1 = *reinterpret_cast<const bf16x8*>(a + 32 * 256);
        p0 = __builtin_amdgcn_mfma_f32_32x32x16_bf16(b0, qr[d0], p0, 0, 0, 0);
        p1 = __builtin_amdgcn_mfma_f32_32x32x16_bf16(b1, qr[d0], p1, 0, 0, 0); }
}
template <int VB>
__device__ __forceinline__ void pv_tile(f32x16* o, int vb0, bf16x8 pa0, bf16x8 pa1, bf16x8 pa2, bf16x8 pa3) {
#define TRRD(dst, off) asm volatile("ds_read_b64_tr_b16 %0, %1 offset:%2" : "=&v"(dst) : "v"(vb0), "i"(off) : "memory")
#define PV_D0(d0) do { s16x4 l0, l1, l2, l3, h0, h1, h2, h3; constexpr int b_ = VB * SHM_V + v_rd_off(d0, 0, 0); \
        TRRD(l0, b_); TRRD(h0, b_ + 2048); TRRD(l1, b_ + 4096); TRRD(h1, b_ + 6144); TRRD(l2, b_ + 8192); TRRD(h2, b_ + 10240); TRRD(l3, b_ + 12288); TRRD(h3, b_ + 14336); \
        asm volatile("s_waitcnt lgkmcnt(0)" ::: "memory"); SBAR(); \
        o[d0] = __builtin_amdgcn_mfma_f32_32x32x16_bf16(pa0, (bf16x8){l0[0], l0[1], l0[2], l0[3], h0[0], h0[1], h0[2], h0[3]}, o[d0], 0, 0, 0); \
        o[d0] = __builtin_amdgcn_mfma_f32_32x32x16_bf16(pa1, (bf16x8){l1[0], l1[1], l1[2], l1[3], h1[0], h1[1], h1[2], h1[3]}, o[d0], 0, 0, 0); \
        o[d0] = __builtin_amdgcn_mfma_f32_32x32x16_bf16(pa2, (bf16x8){l2[0], l2[1], l2[2], l2[3], h2[0], h2[1], h2[2], h2[3]}, o[d0], 0, 0, 0); \
        o[d0] = __builtin_amdgcn_mfma_f32_32x32x16_bf16(pa3, (bf16x8){l3[0], l3[1], l3[2], l3[3], h3[0], h3[1], h3[2], h3[3]}, o[d0], 0, 0, 0); } while (0)
    PV_D0(0); PV_D0(1); PV_D0(2); PV_D0(3);
#undef PV_D0
#undef TRRD
}
#define PK4(P, B_, OUT) do { unsigned a0 = cvtpk(P[B_+0], P[B_+1]), a1 = cvtpk(P[B_+2], P[B_+3]); \
        unsigned b0 = cvtpk(P[B_+4], P[B_+5]), b1 = cvtpk(P[B_+6], P[B_+7]); \
        auto r0 = __builtin_amdgcn_permlane32_swap(a0, b0, false, false); auto r1 = __builtin_amdgcn_permlane32_swap(a1, b1, false, false); \
        u32x4 w = {r0[0], r1[0], r0[1], r1[1]}; OUT = *reinterpret_cast<bf16x8*>(&w); } while (0)
__device__ __forceinline__ float swap_max(float x) { auto rr = __builtin_amdgcn_permlane32_swap(__float_as_uint(x), __float_as_uint(x), false, false); return fmaxf(__uint_as_float(rr[0]), __uint_as_float(rr[1])); }
__device__ __forceinline__ float swap_sum(float x) { auto rr = __builtin_amdgcn_permlane32_swap(__float_as_uint(x), __float_as_uint(x), false, false); return __uint_as_float(rr[0]) + __uint_as_float(rr[1]); }
__device__ __forceinline__ float swap_lo(float x) { auto rr = __builtin_amdgcn_permlane32_swap(__float_as_uint(x), __float_as_uint(x), false, false); return __uint_as_float(rr[0]); }


__device__ __forceinline__ void fox_sm(f32x16& p0, f32x16& p1, const float* bl, int kb_, int qlo, int qrow, int hi, int r32, float& m_reg, float& l_reg, f32x16* o, float* al_l,
                                       bf16x8& pa0, bf16x8& pa1, bf16x8& pa2, bf16x8& pa3) {
#pragma unroll
    for (int g = 0; g < 4; ++g) { const f32x4 b0v = *(const f32x4*)(bl + 8 * g + 4 * hi), b1v = *(const f32x4*)(bl + 32 + 8 * g + 4 * hi);
#pragma unroll
        for (int i = 0; i < 4; ++i) { p0[4 * g + i] = fmaf(p0[4 * g + i], C2, b0v[i]); p1[4 * g + i] = fmaf(p1[4 * g + i], C2, b1v[i]); } }
    if (kb_ + KVBLK - 1 > qlo) { const float NEG = -__builtin_inff();
#pragma unroll
        for (int r = 0; r < 16; ++r) { const int key = kb_ + crow(r, hi); if (key > qrow) p0[r] = NEG; if (key + 32 > qrow) p1[r] = NEG; } }
    float pmax = p0[0];
#pragma unroll
    for (int r = 1; r < 16; ++r) pmax = fmaxf(pmax, p0[r]);
#pragma unroll
    for (int r = 0; r < 16; ++r) pmax = fmaxf(pmax, p1[r]);
    pmax = swap_max(pmax);
    const float mn = fmaxf(m_reg, pmax), alpha = __builtin_amdgcn_exp2f(m_reg - mn); m_reg = mn;
    float ps = 0.f;
#pragma unroll
    for (int r = 0; r < 16; ++r) { p0[r] = __builtin_amdgcn_exp2f(p0[r] - mn); p1[r] = __builtin_amdgcn_exp2f(p1[r] - mn); ps += p0[r] + p1[r]; }
    ps = swap_sum(ps); l_reg = l_reg * alpha + ps;
    if (__any(alpha < 1.f)) { if (hi == 0) al_l[r32] = alpha; asm volatile("s_waitcnt lgkmcnt(0)" ::: "memory");
#pragma unroll
        for (int r = 0; r < 16; ++r) { const float a = al_l[crow(r, hi)];
#pragma unroll
            for (int d_ = 0; d_ < 4; ++d_) o[d_][r] *= a; } }
    PK4(p0, 0, pa0); PK4(p0, 8, pa1); PK4(p1, 0, pa2); PK4(p1, 8, pa3);
}
__device__ __forceinline__ void sb_half(f32x16& pz, int keybase, int qrow, int hi, float& R, const bf16x8* triA, bool needmask) {
    f32x16 X;
#pragma unroll
    for (int r = 0; r < 16; ++r) { const float zz = pz[r] * C2; const bool valid = !needmask || (keybase + crow(r, hi) < qrow);
        const float l2 = fmaxf(zz, 0.f) + __builtin_amdgcn_logf(1.0f + __builtin_amdgcn_exp2f(-fabsf(zz)));
        X[r] = valid ? -l2 : 0.f; pz[r] = valid ? zz : -__builtin_inff(); }
    f32x16 Y;
#pragma unroll
    for (int r = 0; r < 16; ++r) Y[r] = R;
#pragma unroll
    for (int s = 0; s < 2; ++s) {
        const unsigned h0 = cvtpk(X[8 * s + 0], X[8 * s + 1]), h1 = cvtpk(X[8 * s + 2], X[8 * s + 3]), h2 = cvtpk(X[8 * s + 4], X[8 * s + 5]), h3 = cvtpk(X[8 * s + 6], X[8 * s + 7]);
        const unsigned l0 = cvtpk(X[8 * s + 0] - bflo(h0), X[8 * s + 1] - bfhi(h0)), l1 = cvtpk(X[8 * s + 2] - bflo(h1), X[8 * s + 3] - bfhi(h1));
        const unsigned l2 = cvtpk(X[8 * s + 4] - bflo(h2), X[8 * s + 5] - bfhi(h2)), l3 = cvtpk(X[8 * s + 6] - bflo(h3), X[8 * s + 7] - bfhi(h3));
        u32x4 wh = {h0, h1, h2, h3}, wl = {l0, l1, l2, l3};
        Y = __builtin_amdgcn_mfma_f32_32x32x16_bf16(triA[s], *reinterpret_cast<bf16x8*>(&wh), Y, 0, 0, 0);
        Y = __builtin_amdgcn_mfma_f32_32x32x16_bf16(triA[s], *reinterpret_cast<bf16x8*>(&wl), Y, 0, 0, 0); }
#pragma unroll
    for (int r = 0; r < 16; ++r) pz[r] = __builtin_amdgcn_exp2f(pz[r] + Y[r]);
    R = swap_lo(Y[0]);
}
__device__ __forceinline__ void sb_sm(f32x16& p0, f32x16& p1, int kb_, int qlo, int qrow, int hi, float& R, const bf16x8* triA, bf16x8& pa0, bf16x8& pa1, bf16x8& pa2, bf16x8& pa3) {
    const bool needmask = (kb_ + KVBLK - 1 >= qlo);
    sb_half(p1, kb_ + 32, qrow, hi, R, triA, needmask);
    sb_half(p0, kb_, qrow, hi, R, triA, needmask);
    PK4(p0, 0, pa0); PK4(p0, 8, pa1); PK4(p1, 0, pa2); PK4(p1, 8, pa3);
}

template <int MODE>
__device__ __forceinline__ void attn_unit(const bf16_t* Q, const bf16_t* Kh, const bf16_t* Vh, const float* cum, bf16_t* O, int P0, char* lds, float kmaxc) {
    int tid = threadIdx.x; asm volatile("" : "+v"(tid));
    const int wid = __builtin_amdgcn_readfirstlane(tid >> 6), lane = tid & 63, r32 = lane & 31, hi = lane >> 5;
    const int NT = P0 / KVBLK + 4;
    char* V_lds = lds; char* K_lds = lds + OFF_K; float* bias_l = (float*)(lds + OFF_BIAS);
    float* wsl = (float*)(lds + OFF_WS) + wid * 64; float* li_l = wsl; float* al_l = wsl + 32;
    const int qlo = P0 + wid * QBLK, qrow = qlo + r32;
    bf16x8 qr[8];
#pragma unroll
    for (int d0 = 0; d0 < 8; ++d0) qr[d0] = *(const bf16x8*)(Q + (size_t)qrow * D + d0 * 16 + hi * 8);
    const int sr = tid >> 4, sc = (tid & 15) * 8, vst0 = v_st(sr, sc), vst1 = v_st(32 + sr, sc), kws = KSWZ(sr, sc * 2);
    const int vb0 = (int)(uintptr_t)V_lds + v_rd_base(lane);
    const float cumref = (MODE == 0) ? cum[P0] : 0.f;
    int* flg = (int*)(lds + OFF_FLAGS);
    float qn = 0.f;
    if (MODE == 0) { float ss = 0.f;
#pragma unroll
        for (int d0 = 0; d0 < 8; ++d0)
#pragma unroll
            for (int j = 0; j < 8; ++j) { const float x = bf2f((bf16_t)qr[d0][j]); ss = fmaf(x, x, ss); }
        ss = swap_sum(ss); qn = sqrtf(ss) * kmaxc * 1.001f; }
    float m_reg = -1e30f, l_reg = 0.f, R = 0.f; f32x16 o[4] = {};
    bf16x8 triA[2];
    if (MODE == 1) {
#pragma unroll
        for (int s = 0; s < 2; ++s)
#pragma unroll
            for (int j = 0; j < 8; ++j) { const int rho = 16 * s + 8 * (j >> 2) + 4 * hi + (j & 3); triA[s][j] = (rho >= r32) ? (short)0x3F80 : (short)0; }
    }
    bf16x8 st_k0, st_k1, st_v0, st_v1; float st_b = 0.f;
#define TILE_KB(t) ((NT - 1 - (t)) * KVBLK)
#define SLOAD(kb_) do { st_v0 = *(const bf16x8*)(Vh + (size_t)((kb_) + sr) * D + sc); st_v1 = *(const bf16x8*)(Vh + (size_t)((kb_) + 32 + sr) * D + sc); \
                        st_k0 = *(const bf16x8*)(Kh + (size_t)((kb_) + sr) * D + sc); st_k1 = *(const bf16x8*)(Kh + (size_t)((kb_) + 32 + sr) * D + sc); \
                        if (MODE == 0 && tid < 64) st_b = (cumref - cum[(kb_) + tid]) * LOG2E; } while (0)
#define SWRITE(bf) do { *(bf16x8*)(V_lds + (bf) * SHM_V + vst0) = st_v0; *(bf16x8*)(V_lds + (bf) * SHM_V + vst1) = st_v1; \
                        *(bf16x8*)(K_lds + (bf) * SHM_K + kws) = st_k0; *(bf16x8*)(K_lds + (bf) * SHM_K + kws + 32 * 256) = st_k1; \
                        if (MODE == 0 && tid < 64) bias_l[(bf) * 64 + tid] = st_b; } while (0)
    __syncthreads();
    SLOAD(TILE_KB(0)); SWRITE(0);
    __syncthreads();
    f32x16 p0, p1; bf16x8 pa0, pa1, pa2, pa3;
#define STEP(BUF, t) do { const int kb_ = TILE_KB(t); \
        if ((t) + 1 < NT) SLOAD(TILE_KB((t) + 1)); \
        SBAR(); qkt<BUF>(p0, p1, K_lds, r32, hi, qr); \
        if (MODE == 0) fox_sm(p0, p1, bias_l + (BUF) * 64, kb_, qlo, qrow, hi, r32, m_reg, l_reg, o, al_l, pa0, pa1, pa2, pa3); \
        else sb_sm(p0, p1, kb_, qlo, qrow, hi, R, triA, pa0, pa1, pa2, pa3); \
        SBAR(); pv_tile<BUF>(o, vb0, pa0, pa1, pa2, pa3); \
        if ((t) + 1 < NT) SWRITE((BUF) ^ 1); \
        __syncthreads(); } while (0)
    for (int t = 0; t < NT; t += 2) {
        STEP(0, t); STEP(1, t + 1);
        const int kbc = TILE_KB(t + 1); if (kbc == 0) break;
        bool done;
        if (MODE == 0) { const float edge = (cumref - cum[kbc - 1]) * LOG2E; done = (qn + edge - m_reg) < -EXIT_T; }
        else done = R < -EXIT_T;
        const int par = (t >> 1) & 1;
        if (lane == 0) flg[par * 8 + wid] = 0;
        const bool wdone = __all(done);
        if (lane == 0 && wdone) flg[par * 8 + wid] = 1;
        __syncthreads();
        int alld = 1;
#pragma unroll
        for (int w = 0; w < 8; ++w) alld &= flg[par * 8 + w];
        if (alld) break;
    }
    __syncthreads();
#undef STEP
#undef SLOAD
#undef SWRITE
#undef TILE_KB
    float rli[16];
    if (MODE == 0) { if (hi == 0) li_l[r32] = l_reg; asm volatile("s_waitcnt lgkmcnt(0)" ::: "memory");
#pragma unroll
        for (int r = 0; r < 16; ++r) rli[r] = __builtin_amdgcn_rcpf(li_l[crow(r, hi)]); }
    bf16_t* Ow = O + (size_t)(wid * QBLK) * 3072;
#pragma unroll
    for (int r = 0; r < 16; ++r) { const int orow = crow(r, hi);
#pragma unroll
        for (int d0 = 0; d0 < 4; ++d0) { const float v = (MODE == 0) ? o[d0][r] * rli[r] : o[d0][r];
            const float vn = __shfl_xor(v, 1);
            if ((r32 & 1) == 0) *(unsigned*)(Ow + (size_t)orow * 3072 + d0 * 32 + r32) = cvtpk(v, vn); } }
}
}

__device__ __forceinline__ void sparse_query(const Frame& F, int tok, char* ldsw) {
    unsigned char* ws = F.ws; const int lane = F.lane, g = lane >> 4, i16 = lane & 15;
    const bf16_t* qcat = (const bf16_t*)(ws + R_QCAT) + (size_t)tok * 2304; const bf16_t* kbase = (const bf16_t*)(ws + R_KCAT) + (size_t)(tok >> 13) * SEQ * 288;
    const int* sel = (const int*)(ws + R_SEL) + (size_t)tok * 256; const int ns = ((const int*)(ws + R_NSEL))[tok]; const int ntile = (ns + 31) >> 5;
    bf16x8 qf[9];
#pragma unroll
    for (int st = 0; st < 9; ++st) { qf[st] = (bf16x8){0, 0, 0, 0, 0, 0, 0, 0}; if (i16 < 8) qf[st] = *(const bf16x8*)(qcat + i16 * 288 + st * 32 + 8 * g); }
    const int rA = lane >> 2, cq = lane & 3;
    float m = -1e30f, l = 0.f; f32x4 oT[16];
#pragma unroll
    for (int rb = 0; rb < 16; ++rb) oT[rb] = (f32x4){0.f, 0.f, 0.f, 0.f};
    const unsigned ldso = (unsigned)(uintptr_t)ldsw;
    const unsigned vb = ldso + (unsigned)((4 * g + (i16 >> 2)) * 592 + (i16 & 3) * 8);
    constexpr float SC2 = SCALE * LOG2E;
    bf16x8 stg[18];
#define GATHER(tile_) do { const int j0 = (tile_) * 32 + rA, j1 = j0 + 16; const int s0 = j0 < ns ? sel[j0] : 0, s1 = j1 < ns ? sel[j1] : 0; \
        const bf16_t* p0_ = kbase + (size_t)s0 * 288 + cq * 8; const bf16_t* p1_ = kbase + (size_t)s1 * 288 + cq * 8; \
        _Pragma("unroll") for (int c = 0; c < 9; ++c) { stg[2 * c] = *(const bf16x8*)(p0_ + c * 32); stg[2 * c + 1] = *(const bf16x8*)(p1_ + c * 32); } } while (0)
    GATHER(0);
    for (int tile = 0; tile < ntile; ++tile) {
#pragma unroll
        for (int c = 0; c < 9; ++c) { *(bf16x8*)(ldsw + rA * 592 + c * 64 + cq * 16) = stg[2 * c]; *(bf16x8*)(ldsw + (16 + rA) * 592 + c * 64 + cq * 16) = stg[2 * c + 1]; }
        if (tile + 1 < ntile) GATHER(tile + 1);
        asm volatile("s_waitcnt lgkmcnt(0)" ::: "memory"); SBAR();
        f32x4 acc[2];
#pragma unroll
        for (int mt = 0; mt < 2; ++mt) { acc[mt] = (f32x4){0.f, 0.f, 0.f, 0.f};
#pragma unroll
            for (int st = 0; st < 9; ++st) { const bf16x8 a = *(const bf16x8*)(ldsw + (16 * mt + i16) * 592 + st * 64 + g * 16);
                acc[mt] = __builtin_amdgcn_mfma_f32_16x16x32_bf16(a, qf[st], acc[mt], 0, 0, 0); } }
        float tmax = -__builtin_inff();
#pragma unroll
        for (int mt = 0; mt < 2; ++mt)
#pragma unroll
            for (int r = 0; r < 4; ++r) { const int key = tile * 32 + 16 * mt + 4 * g + r; float x = acc[mt][r] * SC2; if (key >= ns) x = -__builtin_inff(); acc[mt][r] = x; tmax = fmaxf(tmax, x); }
        tmax = fmaxf(tmax, __shfl_xor(tmax, 16)); tmax = fmaxf(tmax, __shfl_xor(tmax, 32));
        const float mn = fmaxf(m, tmax), alpha = __builtin_amdgcn_exp2f(m - mn); m = mn;
        float ps = 0.f;
#pragma unroll
        for (int mt = 0; mt < 2; ++mt)
#pragma unroll
            for (int r = 0; r < 4; ++r) { acc[mt][r] = __builtin_amdgcn_exp2f(acc[mt][r] - mn); ps += acc[mt][r]; }
        ps += __shfl_xor(ps, 16); ps += __shfl_xor(ps, 32);
        l = l * alpha + ps;
#pragma unroll
        for (int rb = 0; rb < 16; ++rb) oT[rb] *= alpha;
        const bf16x8 pf = pack8(acc[0], acc[1]);
#define TRRD2(dst, off) asm volatile("ds_read_b64_tr_b16 %0, %1 offset:%2" : "=&v"(dst) : "v"(vb), "i"(off) : "memory")
#define PVRB4(rb) do { s16x4 ta0, tb0, ta1, tb1, ta2, tb2, ta3, tb3; \
        TRRD2(ta0, ((rb) + 0) * 32); TRRD2(tb0, ((rb) + 0) * 32 + 16 * 592); TRRD2(ta1, ((rb) + 1) * 32); TRRD2(tb1, ((rb) + 1) * 32 + 16 * 592); \
        TRRD2(ta2, ((rb) + 2) * 32); TRRD2(tb2, ((rb) + 2) * 32 + 16 * 592); TRRD2(ta3, ((rb) + 3) * 32); TRRD2(tb3, ((rb) + 3) * 32 + 16 * 592); \
        asm volatile("s_waitcnt lgkmcnt(0)" ::: "memory"); SBAR(); \
        oT[(rb) + 0] = __builtin_amdgcn_mfma_f32_16x16x32_bf16((bf16x8){ta0[0], ta0[1], ta0[2], ta0[3], tb0[0], tb0[1], tb0[2], tb0[3]}, pf, oT[(rb) + 0], 0, 0, 0); \
        oT[(rb) + 1] = __builtin_amdgcn_mfma_f32_16x16x32_bf16((bf16x8){ta1[0], ta1[1], ta1[2], ta1[3], tb1[0], tb1[1], tb1[2], tb1[3]}, pf, oT[(rb) + 1], 0, 0, 0); \
        oT[(rb) + 2] = __builtin_amdgcn_mfma_f32_16x16x32_bf16((bf16x8){ta2[0], ta2[1], ta2[2], ta2[3], tb2[0], tb2[1], tb2[2], tb2[3]}, pf, oT[(rb) + 2], 0, 0, 0); \
        oT[(rb) + 3] = __builtin_amdgcn_mfma_f32_16x16x32_bf16((bf16x8){ta3[0], ta3[1], ta3[2], ta3[3], tb3[0], tb3[1], tb3[2], tb3[3]}, pf, oT[(rb) + 3], 0, 0, 0); } while (0)
        PVRB4(0); PVRB4(4); PVRB4(8); PVRB4(12);
#undef PVRB4
#undef TRRD2
        SBAR();
    }
#undef GATHER
    const float rl = 1.0f / l;
    if (i16 < 8) { bf16_t* op = (bf16_t*)(ws + R_OLAT) + (size_t)tok * 2048 + i16 * 256 + 4 * g;
#pragma unroll
        for (int rb = 0; rb < 16; ++rb) { u32x2 w; w.x = cvtpk(oT[rb][0] * rl, oT[rb][1] * rl); w.y = cvtpk(oT[rb][2] * rl, oT[rb][3] * rl); *(u32x2*)(op + rb * 16) = w; } }
}
#ifdef ATT_SUB
#define ASUB(k) ((k) == ATT_SUB)
#else
#define ASUB(k) true
#endif
__device__ __forceinline__ void phase_attn(const Frame& F0, int l, int rep) { const Frame F = fresh(F0);
    unsigned char* ws = F.ws; char* lds = (char*)F.lds;
    const bf16_t* qkv = (const bf16_t*)(ws + R_QKV); const size_t TS = (size_t)NTOK * 1024;
    unsigned* qctr = (unsigned*)(ws + WS_CTL) + CW_QCTR + l * 64 + rep * 16; const unsigned* kmx = (const unsigned*)(ws + WS_CTL) + CW_KMAX + l * 16;
    int* qitem = (int*)(lds + att::OFF_QITEM);
    int* hord = qitem + 4;
    if (F.tid < 16) { const float* cumb = (const float*)(ws + WS_CUM); const float mine = -cumb[(size_t)F.tid * SEQ + SEQ - 1]; int rank = 0;
        for (int o = 0; o < 16; ++o) { const float v = -cumb[(size_t)o * SEQ + SEQ - 1]; rank += (v < mine || (v == mine && o < F.tid)) ? 1 : 0; }
        hord[rank] = F.tid; }
#pragma unroll 1
    for (;;) {
        __syncthreads();
        if (F.tid == 0) qitem[0] = (int)atomicAdd(qctr, 1u);
        __syncthreads();
        const int it = qitem[0];
        if (it >= 1024) break;
        const int md = it >> 9, j = it & 511;
        const int qb = md == 0 ? 31 - (j & 31) : 31 - (j >> 4), bh = md == 0 ? hord[j >> 5] : (j & 15), b = bh >> 3, h = bh & 7, P0 = qb * 256;
        if (!ASUB(md)) continue;
        const bf16_t* Q = qkv + (size_t)(md * 3 + 0) * TS + (size_t)bh * SEQ * 128; const bf16_t* K = qkv + (size_t)(md * 3 + 1) * TS + (size_t)bh * SEQ * 128; const bf16_t* V = qkv + (size_t)(md * 3 + 2) * TS + (size_t)bh * SEQ * 128;
        const float* cum = (const float*)(ws + WS_CUM) + (size_t)bh * SEQ;
        bf16_t* Ob = (bf16_t*)(ws + R_OA) + (size_t)b * SEQ * 3072 + (md + 1) * 1024 + h * 128;
        if (md == 0) { const float kmaxc = sqrtf(__uint_as_float(kmx[bh])) * C2; att::attn_unit<0>(Q, K, V, cum, Ob + (size_t)P0 * 3072, P0, lds, kmaxc); }
        else att::attn_unit<1>(Q, K, V, cum, Ob + (size_t)P0 * 3072, P0, lds, 0.f);
    }
    __syncthreads();
    char* ldsw = lds + F.wid * 18944;
#pragma unroll 1
    for (int rep = 0; rep < NREP(2); ++rep)
#pragma unroll 1
    for (int tok = F.bid * 8 + F.wid; tok < NTOK; tok += F.G * 8) if (ASUB(2)) sparse_query(F, tok, ldsw);
}

__device__ __forceinline__ void ln_row(const bf16_t* src, const float* g, const float* bta, float* of, bf16_t* ob, int lane, unsigned char* oq = nullptr, float* osc = nullptr) {
    f32x4 v[8]; float s = 0.f;
#pragma unroll
    for (int i = 0; i < 4; ++i) { const u32x4 w = *(const u32x4*)(src + (i * 64 + lane) * 8);
        v[2 * i] = (f32x4){bflo(w.x), bfhi(w.x), bflo(w.y), bfhi(w.y)}; v[2 * i + 1] = (f32x4){bflo(w.z), bfhi(w.z), bflo(w.w), bfhi(w.w)};
        s += (v[2 * i][0] + v[2 * i][1]) + (v[2 * i][2] + v[2 * i][3]) + (v[2 * i + 1][0] + v[2 * i + 1][1]) + (v[2 * i + 1][2] + v[2 * i + 1][3]); }
    s = wave_sum(s); const float mu = s * (1.0f / 2048.0f); float q = 0.f;
#pragma unroll
    for (int i = 0; i < 8; ++i) { const f32x4 d = v[i] - mu; q += (d[0] * d[0] + d[1] * d[1]) + (d[2] * d[2] + d[3] * d[3]); }
    q = wave_sum(q); const float rstd = rsqrtf(q * (1.0f / 2048.0f) + 1e-5f);
    float amax = 0.f;
#pragma unroll
    for (int i = 0; i < 4; ++i) { const int c = (i * 64 + lane) * 8; const f32x4 g0 = *(const f32x4*)(g + c), g1 = *(const f32x4*)(g + c + 4), b0 = *(const f32x4*)(bta + c), b1 = *(const f32x4*)(bta + c + 4);
        const f32x4 y0 = (v[2 * i] - mu) * rstd * g0 + b0, y1 = (v[2 * i + 1] - mu) * rstd * g1 + b1; v[2 * i] = y0; v[2 * i + 1] = y1;
        if (of) { *(f32x4*)(of + c) = y0; *(f32x4*)(of + c + 4) = y1; }
        if (ob) pg8::st_bf16x8(ob + c, y0, y1);
        if (oq) { amax = fmaxf(amax, fmaxf(fmaxf(fmaxf(fabsf(y0[0]), fabsf(y0[1])), fmaxf(fabsf(y0[2]), fabsf(y0[3]))), fmaxf(fmaxf(fabsf(y1[0]), fabsf(y1[1])), fmaxf(fabsf(y1[2]), fabsf(y1[3]))))); } }
    if (oq) {
        for (int o = 32; o > 0; o >>= 1) amax = fmaxf(amax, __shfl_xor(amax, o));
        amax = fmaxf(amax, 1e-20f); const float qi = 127.0f / amax; if (lane == 0) *osc = amax * (1.0f / 127.0f);
#pragma unroll
        for (int i = 0; i < 4; ++i) { u32x2 w;
#pragma unroll
            for (int h = 0; h < 2; ++h) { const f32x4 y = v[2 * i + h]; unsigned pk = 0u;
#pragma unroll
                for (int j = 0; j < 4; ++j) pk |= ((unsigned)(int)rintf(y[j] * qi) & 0xffu) << (8 * j);
                w[h] = pk; }
            *(u32x2*)(oq + (i * 64 + lane) * 8) = w; } }
}
__device__ __forceinline__ void phase_ln1_router(const Frame& F0, const Params& P, int l) { const Frame F = fresh(F0);
    unsigned char* ws = F.ws; const int lane = F.lane, wid = F.wid;
    const bf16_t* pre1 = (const bf16_t*)(ws + R_PRE1); float* x1f = (float*)(ws + M_X1F); bf16_t* x1b = (bf16_t*)(ws + M_X1B); unsigned char* x1q = (unsigned char*)(ws + M_X1Q); float* x1s = (float*)(ws + M_X1S);
    const float* g = F.in(11) + l * DM; const float* bt = F.in(12) + l * DM; const float* wr = F.in(13) + (size_t)l * DM * NEXP; const float* br = F.in(14) + l * NEXP;
    unsigned* cnt = (unsigned*)(ws + WS_CTL) + CW_CNT + l * 2048;
    int* tok_e = (int*)(ws + M_TOKE); int* tok_pos = (int*)(ws + M_TOKPOS); float* tok_w = (float*)(ws + M_TOKW);
    float* red = (float*)F.lds;
    float* lg = (float*)(F.lds + 32768);
#pragma unroll 1
    for (int blk = F.bid; blk < NTOK / 64; blk += F.G) {
        const int tok0 = blk * 64;
#pragma unroll 1
        for (int i = 0; i < 8; ++i) { const int tok = tok0 + wid * 8 + i; ln_row(pre1 + (size_t)tok * DM, g, bt, x1f + (size_t)tok * DM, x1b + (size_t)tok * DM, lane, x1q + (size_t)tok * DM, x1s + tok); }
        asm volatile("s_waitcnt vmcnt(0)" ::: "memory"); __syncthreads();
        { const int grp = wid >> 2, kq = wid & 3, i32 = lane & 31, hk = lane >> 5; f32x16 acc = {};
          const float* arow = x1f + (size_t)(tok0 + grp * 32 + i32) * DM + kq * 512 + 4 * hk; const float* bcol = wr + (size_t)(kq * 512 + 4 * hk) * NEXP + i32;
#pragma unroll 4
          for (int c8 = 0; c8 < 64; ++c8) { const f32x4 a4 = *(const f32x4*)(arow + c8 * 8);
              const float b0 = bcol[(size_t)(c8 * 8 + 0) * NEXP], b1 = bcol[(size_t)(c8 * 8 + 1) * NEXP], b2 = bcol[(size_t)(c8 * 8 + 2) * NEXP], b3 = bcol[(size_t)(c8 * 8 + 3) * NEXP];
              acc = __builtin_amdgcn_mfma_f32_32x32x2f32(a4[0], b0, acc, 0, 0, 0); acc = __builtin_amdgcn_mfma_f32_32x32x2f32(a4[1], b1, acc, 0, 0, 0);
              acc = __builtin_amdgcn_mfma_f32_32x32x2f32(a4[2], b2, acc, 0, 0, 0); acc = __builtin_amdgcn_mfma_f32_32x32x2f32(a4[3], b3, acc, 0, 0, 0); }
#pragma unroll
          for (int r = 0; r < 16; ++r) red[(wid * 16 + r) * 64 + lane] = acc[r]; }
        __syncthreads();
        if ((wid & 3) == 0) { const int grp = wid >> 2, hk = lane >> 5, e = lane & 31; const float be = br[e];
#pragma unroll
            for (int r = 0; r < 16; ++r) { const float v = red[((wid + 0) * 16 + r) * 64 + lane] + red[((wid + 1) * 16 + r) * 64 + lane] + red[((wid + 2) * 16 + r) * 64 + lane] + red[((wid + 3) * 16 + r) * 64 + lane] + be;
                lg[(grp * 32 + crow(r, hk)) * 33 + e] = v; }
            asm volatile("s_waitcnt lgkmcnt(0)" ::: "memory"); SBAR();
            const int tk = lane & 31; float v[32];
#pragma unroll
            for (int e2 = 0; e2 < 32; ++e2) v[e2] = lg[(grp * 32 + tk) * 33 + e2];
            int ek[4]; float vk[4];
#pragma unroll
            for (int k = 0; k < 4; ++k) { float best = -__builtin_inff(); int bi = 0;
#pragma unroll
                for (int e2 = 0; e2 < 32; ++e2) if (v[e2] > best) { best = v[e2]; bi = e2; }
                ek[k] = bi; vk[k] = best;
#pragma unroll
                for (int e2 = 0; e2 < 32; ++e2) v[e2] = (e2 == bi) ? -__builtin_inff() : v[e2]; }
            float wk[4], sw = 0.f;
#pragma unroll
            for (int k = 0; k < 4; ++k) { wk[k] = __expf(vk[k] - vk[0]); sw += wk[k]; }
            const float rs = 1.0f / sw;
            const bool act = lane < 32; unsigned myc = 0u;
#pragma unroll 1
            for (int E = 0; E < 32; ++E) { unsigned c = 0u;
#pragma unroll
                for (int k = 0; k < 4; ++k) c += (unsigned)__popcll(__ballot(act && ek[k] == E));
                if (lane == E) myc = c; }
            unsigned run = 0u; if (lane < 32 && myc > 0u) run = atomicAdd(&cnt[lane * 64], myc);
            int pk[4];
#pragma unroll
            for (int k = 0; k < 4; ++k) { pk[k] = 0;
#pragma unroll 1
                for (int E = 0; E < 32; ++E) { const unsigned long long mm = __ballot(act && ek[k] == E); const unsigned basev = (unsigned)__shfl((int)run, E);
                    if (act && ek[k] == E) pk[k] = (int)(basev + (unsigned)__popcll(mm & ((1ull << lane) - 1ull)));
                    if (lane == E) run += (unsigned)__popcll(mm); } }
            if (act) { const int tok = tok0 + grp * 32 + tk;
#pragma unroll
                for (int k = 0; k < 4; ++k) { tok_e[tok * 4 + k] = ek[k]; tok_pos[tok * 4 + k] = pk[k]; tok_w[tok * 4 + k] = wk[k] * rs; } }
        }
        __syncthreads();
    }
}
__device__ __forceinline__ void phase_moe_gather(const Frame& F0, int l) { const Frame F = fresh(F0);
    unsigned char* ws = F.ws; const int lane = F.lane;
    const unsigned* cnt = (const unsigned*)(ws + WS_CTL) + CW_CNT + l * 2048; unsigned* meta = (unsigned*)(ws + WS_CTL) + CW_META + l * 512;
    unsigned* offs = (unsigned*)(F.lds + LDS_MISC + 64);
    if (F.tid == 0) { unsigned o = 0u; for (int e = 0; e < 32; ++e) { offs[e] = o; o += (cnt[e * 64] + 255u) & ~255u; } offs[32] = o;
        if (F.bid == 0) { meta[0] = o >> 8; for (int e = 0; e < 32; ++e) for (unsigned t = offs[e] >> 8; t < (offs[e + 1] >> 8); ++t) meta[1 + t] = (unsigned)e; } }
    __syncthreads();
    const int* tok_e = (const int*)(ws + M_TOKE); const int* tok_pos = (const int*)(ws + M_TOKPOS); const float* tok_w = (const float*)(ws + M_TOKW);
    int* tok_dst = (int*)(ws + M_TOKDST); float* roww = (float*)(ws + M_ROWW);
    const unsigned char* x1q = (const unsigned char*)(ws + M_X1Q); const float* x1s = (const float*)(ws + M_X1S); unsigned char* xs = (unsigned char*)(ws + M_XS); float* rowsx = (float*)(ws + M_ROWSX);
    for (int it = F.bid * 8 + F.wid; it < NTOK * 4; it += F.G * 8) { const int tok = it >> 2;
        const int e = tok_e[it]; const unsigned dst = offs[e] + (unsigned)tok_pos[it];
        if (lane == 0) { tok_dst[it] = (int)dst; roww[dst] = tok_w[it]; rowsx[dst] = x1s[tok]; }
        const u32x4* sp = (const u32x4*)(x1q + (size_t)tok * DM); u32x4* dp = (u32x4*)(xs + (size_t)dst * DM);
#pragma unroll
        for (int i = 0; i < 2; ++i) dp[i * 64 + lane] = sp[i * 64 + lane]; }
    __syncthreads();
}
__device__ __forceinline__ void phase_combine(const Frame& F0) { const Frame F = fresh(F0);
    unsigned char* ws = F.ws; const int lane = F.lane;
    const bf16_t* x1b = (const bf16_t*)(ws + M_X1B); const bf16_t* ys = (const bf16_t*)(ws + M_XS); const int* tok_dst = (const int*)(ws + M_TOKDST);
    bf16_t* hb = (bf16_t*)(ws + M_HB); unsigned char* hq = (unsigned char*)(ws + M_HQ); float* hsc = (float*)(ws + M_HSC);
    for (int tok = F.bid * 8 + F.wid; tok < NTOK; tok += F.G * 8) {
        const int d0 = tok_dst[tok * 4], d1 = tok_dst[tok * 4 + 1], d2 = tok_dst[tok * 4 + 2], d3 = tok_dst[tok * 4 + 3];
        f32x4 hv[8]; float amax = 0.f;
#pragma unroll
        for (int i = 0; i < 4; ++i) { const int c = (i * 64 + lane) * 8; const size_t o = (size_t)tok * DM + c;
            const u32x4 xw = *(const u32x4*)(x1b + o);
            f32x4 a = (f32x4){bflo(xw.x), bfhi(xw.x), bflo(xw.y), bfhi(xw.y)} * ALPHA, b = (f32x4){bflo(xw.z), bfhi(xw.z), bflo(xw.w), bfhi(xw.w)} * ALPHA;
            const u32x4 y0 = *(const u32x4*)(ys + (size_t)d0 * DM + c), y1 = *(const u32x4*)(ys + (size_t)d1 * DM + c), y2 = *(const u32x4*)(ys + (size_t)d2 * DM + c), y3 = *(const u32x4*)(ys + (size_t)d3 * DM + c);
            a[0] += (bflo(y0.x) + bflo(y1.x)) + (bflo(y2.x) + bflo(y3.x)); a[1] += (bfhi(y0.x) + bfhi(y1.x)) + (bfhi(y2.x) + bfhi(y3.x));
            a[2] += (bflo(y0.y) + bflo(y1.y)) + (bflo(y2.y) + bflo(y3.y)); a[3] += (bfhi(y0.y) + bfhi(y1.y)) + (bfhi(y2.y) + bfhi(y3.y));
            b[0] += (bflo(y0.z) + bflo(y1.z)) + (bflo(y2.z) + bflo(y3.z)); b[1] += (bfhi(y0.z) + bfhi(y1.z)) + (bfhi(y2.z) + bfhi(y3.z));
            b[2] += (bflo(y0.w) + bflo(y1.w)) + (bflo(y2.w) + bflo(y3.w)); b[3] += (bfhi(y0.w) + bfhi(y1.w)) + (bfhi(y2.w) + bfhi(y3.w));
            pg8::st_bf16x8(hb + o, a, b); hv[2 * i] = a; hv[2 * i + 1] = b;
#pragma unroll
            for (int j = 0; j < 4; ++j) amax = fmaxf(amax, fmaxf(fabsf(a[j]), fabsf(b[j]))); }
        for (int o = 32; o > 0; o >>= 1) amax = fmaxf(amax, __shfl_xor(amax, o));
        amax = fmaxf(amax, 1e-20f); const float qi = 127.0f / amax; if (lane == 0) hsc[tok] = amax * (1.0f / 127.0f);
#pragma unroll
        for (int i = 0; i < 4; ++i) { u32x2 w;
#pragma unroll
            for (int h = 0; h < 2; ++h) { unsigned pk = 0u;
#pragma unroll
                for (int j = 0; j < 4; ++j) pk |= ((unsigned)(int)rintf(hv[2 * i + h][j] * qi) & 0xffu) << (8 * j);
                w[h] = pk; }
            *(u32x2*)(hq + (size_t)tok * DM + (i * 64 + lane) * 8) = w; } }
}
__device__ __forceinline__ void phase_ln2(const Frame& F0, const Params& P, int l) { const Frame F = fresh(F0);
    unsigned char* ws = F.ws; const bf16_t* pre2 = (const bf16_t*)(ws + M_X1F); bf16_t* xb = (bf16_t*)(ws + WS_XB);
    const float* g = F.in(23) + l * DM; const float* bt = F.in(24) + l * DM; float* outp = F.out();
    for (int tok = F.bid * 8 + F.wid; tok < NTOK; tok += F.G * 8) ln_row(pre2 + (size_t)tok * DM, g, bt, (l + 1 == NLAYER) ? outp + (size_t)tok * DM : (float*)nullptr, (l + 1 == NLAYER) ? (bf16_t*)nullptr : xb + (size_t)tok * DM, F.lane,
                                                                          (l + 1 == NLAYER) ? (unsigned char*)nullptr : (unsigned char*)(ws + WS_XQ) + (size_t)tok * DM, (l + 1 == NLAYER) ? (float*)nullptr : (float*)(ws + WS_XSC) + tok);
}

constexpr int NPHASE = 2 + 15 * NLAYER;
#ifdef PH_ONLY
#define PEN(kind) ((kind) == PH_ONLY)
#else
#define PEN(kind) true
#endif
#define IN(k) (lo <= (k) && (k) < hi)
#define SEAM(k) do { if (IN((k) + 1)) xcd_barrier(bar); } while (0)

template <int l>
__device__ __forceinline__ void layer_phases(const Frame& F, const Params& P, const XcdBarrier& bar, const int lo, const int hi, unsigned char* ws0) {
    using namespace pg8;

        const int pb = 2 + 15 * l;
        if (IN(pb + 0) && PEN(0)) { size_t wz = 0; asm volatile("" : "+s"(wz)); unsigned char* ws = ws0 + wz;
            { SchedS S; S.init(NTOK, 5 * 256, F.G, F.bid, (const bf16_t*)(ws + WS_XB), DM, (const bf16_t*)(ws + W_IN), DM); S.skip_from = 0; S.skip_by = 4; S.skip_from2 = 4; S.skip_by2 = 49;
              EpiInProj<false> E{(bf16_t*)(ws + R_QA), (bf16_t*)(ws + R_QIDX), (bf16_t*)(ws + R_QKV), (bf16_t*)(ws + R_GATES), (float*)(ws + R_SMALL), nullptr, nullptr};
              for (int rep = 0; rep < NREP(5); ++rep) gemm_phase(F.ldsl, DM, DM, DM, S, E); }
            { SchedS S; S.init(NTOK, 53 * 256, F.G, (F.bid + F.G / 2) % F.G, (const bf16_t*)(ws + WS_XQ), DM / 2, (const bf16_t*)(ws + W_IN8), DM / 2); S.skip_from = 4; S.skip_by = 4; S.b_compact = 1;
              EpiInProj<true> E{(bf16_t*)(ws + R_QA), (bf16_t*)(ws + R_QIDX), (bf16_t*)(ws + R_QKV), (bf16_t*)(ws + R_GATES), (float*)(ws + R_SMALL), (const float*)(ws + WS_XSC), (const unsigned*)(ws + WS_CTL) + CW_WMAXG + l};
              for (int rep = 0; rep < NREP(5); ++rep) gemm_phase(F.ldsl, DM / 2, DM / 2, DM / 2, S, E); }
            SEAM(pb + 0); }
        if (IN(pb + 1) && PEN(1)) { size_t wz = 0; asm volatile("" : "+s"(wz)); unsigned char* ws = ws0 + wz;
            phase_prep(F, P, l);
            SchedS S; S.init(NTOK, 2048, F.G, F.bid, (const bf16_t*)(ws + R_QA), 1024, (const bf16_t*)(ws + W_UK2), 256, 1, 256);
            EpiBf16 E{(bf16_t*)(ws + R_QCAT), 2304, 288};
            for (int rep = 0; rep < NREP(10); ++rep) gemm_phase(F.ldsl, 256, 1024, 256, S, E); SEAM(pb + 1); }
        if (IN(pb + 2) && PEN(2)) { size_t wz = 0; asm volatile("" : "+s"(wz)); unsigned char* ws = ws0 + wz; phase_cumsum(F); for (int rep = 0; rep < NREP(3); ++rep) phase_idx(F); SEAM(pb + 2); }
        if (IN(pb + 3) && PEN(3)) { size_t wz = 0; asm volatile("" : "+s"(wz)); unsigned char* ws = ws0 + wz; for (int rep = 0; rep < NREP(4); ++rep) phase_topk(F); SEAM(pb + 3); }
        if (IN(pb + 4) && PEN(4)) { size_t wz = 0; asm volatile("" : "+s"(wz)); unsigned char* ws = ws0 + wz; for (int rep = 0; rep < NREP(1); ++rep) phase_attn(F, l, rep); SEAM(pb + 4); }
        if (IN(pb + 5) && PEN(5)) { size_t wz = 0; asm volatile("" : "+s"(wz)); unsigned char* ws = ws0 + wz;
            SchedS S; S.init(NTOK, 1024, F.G, F.bid, (const bf16_t*)(ws + R_OLAT), 2048, (const bf16_t*)(ws + W_UV2), 512, 0, 512);
            EpiBf16 E{(bf16_t*)(ws + R_OA), 3072, 256}; for (int rep = 0; rep < NREP(10); ++rep) gemm_phase(F.ldsl, 512, 2048, 512, S, E);
            SEAM(pb + 5); }
        if (IN(pb + 6) && PEN(6)) { size_t wz = 0; asm volatile("" : "+s"(wz)); unsigned char* ws = ws0 + wz;
            SchedS S; S.init(NTOK, 2048, F.G, F.bid, (const bf16_t*)(ws + R_OA), 3072, (const bf16_t*)(ws + W_BRA), 3072);
            EpiBranch3 E{(const bf16_t*)(ws + R_GATES), (bf16_t*)(ws + R_MERGED)}; for (int rep = 0; rep < NREP(11); ++rep) gemm_phase(F.ldsl, 3072, 3072, 3072, S, E); SEAM(pb + 6); }
        if (IN(pb + 7) && PEN(7)) { size_t wz = 0; asm volatile("" : "+s"(wz)); unsigned char* ws = ws0 + wz;
            SchedS S; S.init(NTOK, 2048, F.G, F.bid, (const bf16_t*)(ws + R_MERGED), DM, (const bf16_t*)(ws + W_OUT), DM);
            EpiOut E{(const bf16_t*)(ws + WS_XB), (bf16_t*)(ws + R_PRE1)}; for (int rep = 0; rep < NREP(8); ++rep) gemm_phase(F.ldsl, DM, DM, DM, S, E); SEAM(pb + 7); }
        if (IN(pb + 8) && PEN(8)) { size_t wz = 0; asm volatile("" : "+s"(wz)); unsigned char* ws = ws0 + wz; phase_ln1_router(F, P, l); SEAM(pb + 8); }
        if (IN(pb + 9) && PEN(9)) { size_t wz = 0; asm volatile("" : "+s"(wz)); unsigned char* ws = ws0 + wz;
            for (int rep = 0; rep < NREP(12); ++rep) phase_moe_gather(F, l);
            SchedS S; S.init(NTOK, 2048, F.G, F.bid, (const bf16_t*)(ws + WS_PB) + (size_t)l * NTOK * 256, 256, (const bf16_t*)(ws + W_PLE), 256);
            EpiBf16 E{(bf16_t*)(ws + M_PP), 2048, 256}; for (int rep = 0; rep < NREP(10); ++rep) gemm_phase(F.ldsl, 256, 256, 256, S, E); SEAM(pb + 9); }
        if (IN(pb + 10) && PEN(10)) { size_t wz = 0; asm volatile("" : "+s"(wz)); unsigned char* ws = ws0 + wz;
            SchedM S; S.init((const unsigned*)(ws + WS_CTL) + CW_META + l * 512, F.G, F.bid, (const bf16_t*)(ws + M_XS), DM / 2, (const bf16_t*)(ws + W_GU), DM / 2);
            EpiGateUpI8 E{F.in(16) + (size_t)l * NEXP * DEXP, F.in(18) + (size_t)l * NEXP * DEXP, (bf16_t*)(ws + M_HID), (const float*)(ws + M_ROWSX), (const unsigned*)(ws + WS_CTL) + CW_WMAX + l};
            for (int rep = 0; rep < NREP(6); ++rep) gemm_phase(F.ldsl, DM / 2, DM / 2, DM / 2, S, E); SEAM(pb + 10); }
        if (IN(pb + 11) && PEN(11)) { size_t wz = 0; asm volatile("" : "+s"(wz)); unsigned char* ws = ws0 + wz;
            SchedM S; S.init((const unsigned*)(ws + WS_CTL) + CW_META + l * 512, F.G, F.bid, (const bf16_t*)(ws + M_HID), DEXP, (const bf16_t*)(ws + W_DN), DEXP);
            EpiDown E{F.in(20) + (size_t)l * NEXP * DM, (const float*)(ws + M_ROWW), (bf16_t*)(ws + M_XS)}; for (int rep = 0; rep < NREP(7); ++rep) gemm_phase(F.ldsl, DEXP, DEXP, DEXP, S, E); SEAM(pb + 11); }
        if (IN(pb + 12) && PEN(12)) { size_t wz = 0; asm volatile("" : "+s"(wz)); unsigned char* ws = ws0 + wz; for (int rep = 0; rep < NREP(9); ++rep) phase_combine(F); SEAM(pb + 12); }
        if (IN(pb + 13) && PEN(13)) { size_t wz = 0; asm volatile("" : "+s"(wz)); unsigned char* ws = ws0 + wz;
            SchedS S; S.init(NTOK, 2048, F.G, F.bid, (const bf16_t*)(ws + M_HQ), DM / 2, (const bf16_t*)(ws + W_PG), DM / 2);
            EpiPleGateI8 E{(const bf16_t*)(ws + M_HB), (const bf16_t*)(ws + M_PP), (bf16_t*)(ws + M_X1F), (const float*)(ws + M_HSC), (const unsigned*)(ws + WS_CTL) + CW_WMAXP + l};
            for (int rep = 0; rep < NREP(8); ++rep) gemm_phase(F.ldsl, DM / 2, DM / 2, DM / 2, S, E); SEAM(pb + 13); }
        if (IN(pb + 14) && PEN(14)) { size_t wz = 0; asm volatile("" : "+s"(wz)); unsigned char* ws = ws0 + wz; for (int rep = 0; rep < NREP(13); ++rep) phase_ln2(F, P, l); if (l + 1 < NLAYER) for (int rep = 0; rep < NREP(0); ++rep) convert_layer_weights(F, P, l + 1); SEAM(pb + 14); }
}
__global__ void __launch_bounds__(512, 2) fwd(Params P) {
    extern __shared__ __attribute__((aligned(16))) unsigned char lds[];
    Frame F; F.lds = lds; F.ldsl = (LAS unsigned char*)lds; F.ws = P.ws; F.tid = threadIdx.x; F.lane = F.tid & 63; F.wid = __builtin_amdgcn_readfirstlane(F.tid >> 6); F.G = gridDim.x; F.bid = blockIdx.x;
    unsigned char* ws0 = P.ws; unsigned char* ws = ws0;
    const bool fused = (P.ph_hi - P.ph_lo) > 1;
    if (F.tid < 4) ((LAS unsigned*)(F.ldsl + LDS_MISC))[F.tid] = 0u;
    if (F.tid == 0) { LAS unsigned long long* t = (LAS unsigned long long*)(F.ldsl + LDS_PTRS);
#pragma unroll
        for (int k = 0; k < 25; ++k) t[k] = (unsigned long long)P.in[k];
        t[25] = (unsigned long long)P.out; }
    __syncthreads();
    XcdBarrier bar; bar.bar = (unsigned*)(ws + WS_CTL) + CW_BAR; bar.x = 0; bar.st = (volatile LAS unsigned*)(F.ldsl + LDS_MISC);
    if (fused) bar = xcd_barrier_post((unsigned*)(ws + WS_CTL) + CW_BAR, (volatile LAS unsigned*)(F.ldsl + LDS_MISC));
    const int lo = P.ph_lo, hi = P.ph_hi;
    using namespace pg8;
    if (IN(0) && PEN(15)) { size_t wz = 0; asm volatile("" : "+s"(wz)); unsigned char* ws = ws0 + wz;
        quant_rows(F, F.in(0), (bf16_t*)(ws + WS_XB), (unsigned char*)(ws + WS_XQ), (float*)(ws + WS_XSC));
        conv_rows(F, F.in(1), (bf16_t*)(ws + WS_PB), (size_t)2 * NTOK * 256 / 8);
        sample_wmax(F);
        SEAM(0);
    }
    if (IN(1) && PEN(15)) { for (int rep = 0; rep < NREP(0); ++rep) convert_layer_weights(F, P, 0); SEAM(1); }
    layer_phases<0>(F, P, bar, lo, hi, ws0);
    layer_phases<1>(F, P, bar, lo, hi, ws0);
}

#ifdef DEBUG_NAN
constexpr int CW_FLAGS = 12288;
__global__ void dbg_scan_bf16(const unsigned short* p, size_t n, unsigned* flag) { unsigned c = 0; for (size_t i = (size_t)blockIdx.x * blockDim.x + threadIdx.x; i < n; i += (size_t)gridDim.x * blockDim.x) if ((p[i] & 0x7F80u) == 0x7F80u) ++c; if (c) atomicAdd(flag, c); }
__global__ void dbg_scan_f32(const unsigned* p, size_t n, unsigned* flag) { unsigned c = 0; for (size_t i = (size_t)blockIdx.x * blockDim.x + threadIdx.x; i < n; i += (size_t)gridDim.x * blockDim.x) if ((p[i] & 0x7F800000u) == 0x7F800000u) ++c; if (c) atomicAdd(flag, c); }
__global__ void dbg_scan_sel(const int* sel, const int* nsel, unsigned* flag) { unsigned c = 0; for (size_t i = (size_t)blockIdx.x * blockDim.x + threadIdx.x; i < (size_t)NTOK * 256; i += (size_t)gridDim.x * blockDim.x) { const int tok = (int)(i >> 8), j = (int)(i & 255), t = tok & (SEQ - 1); const int ns = nsel[tok]; if (j == 0 && ns != (t + 1 < 256 ? t + 1 : 256)) ++c; if (j < ns && (sel[i] < 0 || sel[i] > t)) ++c; } if (c) atomicAdd(flag, c); }
__global__ void dbg_scan_scores(const unsigned* p, unsigned* flag) { unsigned c = 0; for (size_t i = (size_t)blockIdx.x * blockDim.x + threadIdx.x; i < 2ull * SEQ * SEQ; i += (size_t)gridDim.x * blockDim.x) { const int s = (int)(i & (SEQ - 1)), t = (int)((i >> 13) & (SEQ - 1)); if (s <= t && (p[i] & 0x7F800000u) == 0x7F800000u) ++c; } if (c) atomicAdd(flag, c); }
__global__ void dbg_probe_bf16(const unsigned short* p, size_t n, unsigned* cnt, unsigned* minidx) { unsigned c = 0; unsigned mi = 0xFFFFFFFFu; for (size_t i = (size_t)blockIdx.x * blockDim.x + threadIdx.x; i < n; i += (size_t)gridDim.x * blockDim.x) if ((p[i] & 0x7F80u) == 0x7F80u) { ++c; if ((unsigned)i < mi) mi = (unsigned)i; } if (c) { atomicAdd(cnt, c); atomicMax(minidx, ~mi); } }
__global__ void dbg_final(float* out, size_t n, const unsigned* flags) { int code = 0; for (int k = 0; k < 32; ++k) if (flags[k] && !code) code = k + 1; const int mask = (flags[32] ? 1 : 0) | (flags[33] ? 2 : 0) | (flags[34] ? 4 : 0); if (mask) code = 20 + 5 * mask; if (!code) return; for (size_t i = (size_t)blockIdx.x * blockDim.x + threadIdx.x; i < n; i += (size_t)gridDim.x * blockDim.x) out[i] = (float)code; }
#endif
extern "C" void kernel_launch(void* const* d_in, const int* in_sizes, int n_in, void* d_out, int out_size, void* d_ws, size_t ws_size, hipStream_t stream) {
    static int grid = 0;
    if (grid == 0) {
        if (n_in != 25 || out_size != NTOK * DM || ws_size < WS_NEED) { fprintf(stderr, "kernel_launch: unexpected shapes (n_in %d out %d ws %zu need %zu)\n", n_in, out_size, ws_size, (size_t)WS_NEED); grid = -1; return; }
        int dev = 0, cus = 0, per_cu = 0;
        if (hipGetDevice(&dev) != hipSuccess || hipDeviceGetAttribute(&cus, hipDeviceAttributeMultiprocessorCount, dev) != hipSuccess) { grid = -1; return; }
        if (hipFuncSetAttribute((const void*)fwd, hipFuncAttributeMaxDynamicSharedMemorySize, LDS_BYTES) != hipSuccess) { fprintf(stderr, "kernel_launch: hipFuncSetAttribute failed\n"); grid = -1; return; }
        if (hipOccupancyMaxActiveBlocksPerMultiprocessor(&per_cu, (const void*)fwd, 512, LDS_BYTES) != hipSuccess || per_cu < 1) fprintf(stderr, "kernel_launch: occupancy query says %d\n", per_cu);
        (void)hipGetLastError();
        grid = cus;
    }
    if (grid < 0) return;
    unsigned char* ws = (unsigned char*)d_ws;
    hipMemsetAsync(ws + WS_CTL, 0, CTL_BYTES, stream);
    hipMemsetAsync(ws + W_UK2, 0, 8ull * 256 * 256 * 2 + 4ull * 256 * 512 * 2, stream);
    hipMemsetAsync(ws + W_IN + (size_t)INW * 2048 * 2, 0, (size_t)(INWP - INW) * 2048 * 2, stream);
    Params p{};
    for (int i = 0; i < 25; ++i) p.in[i] = (const float*)d_in[i];
    p.out = (float*)d_out; p.ws = ws;
#if PHASES_PER_LAUNCH == 0
    p.ph_lo = 0; p.ph_hi = NPHASE;
    hipLaunchKernelGGL(fwd, dim3(grid), dim3(512), LDS_BYTES, stream, p);
#else
    for (int k = 0; k < NPHASE; ++k) { p.ph_lo = k; p.ph_hi = k + 1; hipLaunchKernelGGL(fwd, dim3(grid), dim3(512), LDS_BYTES, stream, p);
#ifdef DEBUG_NAN
        unsigned* fl = (unsigned*)(ws + WS_CTL) + CW_FLAGS + k;
#define SB16(off, n) hipLaunchKernelGGL(dbg_scan_bf16, dim3(1024), dim3(256), 0, stream, (const unsigned short*)(ws + (off)), (size_t)(n), fl)
#define SF32(off, n) hipLaunchKernelGGL(dbg_scan_f32, dim3(1024), dim3(256), 0, stream, (const unsigned*)(ws + (off)), (size_t)(n), fl)
        if (k == 0) { SB16(WS_XB, (size_t)NTOK * DM); SB16(WS_PB, 2ull * NTOK * 256); SB16(WS_W, (W_END - WS_W) / 2); }
        else { const int kind = (k - 1) % 15;
            if (kind == 0) { SB16(R_QA, (size_t)NTOK * 1024); SB16(R_QIDX, (size_t)NTOK * 1024); SB16(R_QKV, 6ull * NTOK * 1024); SB16(R_GATES, (size_t)NTOK * 6144); SF32(R_SMALL, (size_t)NTOK * 512); }
            if (kind == 1) { SB16(R_QCAT, (size_t)NTOK * 2304); SB16(R_KCAT, (size_t)NTOK * 288); SB16(R_KI, (size_t)NTOK * 64); SB16(R_QIDX, (size_t)NTOK * 1024); SF32(R_WI, (size_t)NTOK * 16); SF32(WS_LF, 16ull * 8192); }
            if (kind == 2) { SF32(WS_CUM, 16ull * 8192); hipLaunchKernelGGL(dbg_scan_scores, dim3(1024), dim3(256), 0, stream, (const unsigned*)(ws + R_SCORES), fl); }
            if (kind == 3) { hipLaunchKernelGGL(dbg_scan_sel, dim3(1024), dim3(256), 0, stream, (const int*)(ws + R_SEL), (const int*)(ws + R_NSEL), fl); }
            if (k == 5) { unsigned* fl0 = fl; fl = (unsigned*)(ws + WS_CTL) + CW_FLAGS + 32; SB16(R_OLAT, (size_t)NTOK * 2048); fl += 1; SB16(R_OA, (size_t)NTOK * 3072); fl += 1; fl = fl0; hipLaunchKernelGGL(dbg_probe_bf16, dim3(1024), dim3(256), 0, stream, (const unsigned short*)(ws + R_OC), (size_t)NTOK * 1024, (unsigned*)(ws + WS_CTL) + CW_FLAGS + 40, (unsigned*)(ws + WS_CTL) + CW_FLAGS + 41); }
            if (kind == 5) { SB16(R_OA, (size_t)NTOK * 3072); }
            if (kind == 6) { SB16(R_MERGED, (size_t)NTOK * 2048); }
            if (kind == 7) { SF32(R_PRE1, (size_t)NTOK * 2048); }
            if (kind == 8) { SF32(M_X1F, (size_t)NTOK * 2048); SF32(M_TOKW, (size_t)NTOK * 4); }
            if (kind == 9) { SB16(M_PP, (size_t)NTOK * 2048); }
            if (kind == 12) { SF32(M_HF, (size_t)NTOK * 2048); }
            if (kind == 13) { SF32(M_X1F, (size_t)NTOK * 2048); }
            if (kind == 14) { hipLaunchKernelGGL(dbg_scan_f32, dim3(1024), dim3(256), 0, stream, (const unsigned*)d_out, (size_t)NTOK * DM, fl); if (k + 1 < NPHASE) SB16(WS_W, (W_END - WS_W) / 2); } }
#endif
    }
#ifdef DEBUG_NAN
    hipLaunchKernelGGL(dbg_final, dim3(1024), dim3(256), 0, stream, (float*)d_out, (size_t)NTOK * DM, (const unsigned*)(ws + WS_CTL) + CW_FLAGS);
#endif
#endif
}
```

```cpp
#include <hip/hip_runtime.h>
#include <stdint.h>
#include <stdio.h>
#include <math.h>

#ifndef PHASES_PER_LAUNCH
#define PHASES_PER_LAUNCH 0
#endif

#define LAS __attribute__((address_space(3)))
#define GAS __attribute__((address_space(1)))
#ifndef REP_MASK
#define REP_MASK 0
#endif
#define NREP(bit) (((REP_MASK) >> (bit)) & 1 ? 2 : 1)
typedef unsigned short bf16_t;
typedef short bf16x8 __attribute__((ext_vector_type(8)));
typedef short s16x4 __attribute__((ext_vector_type(4)));
typedef float f32x4 __attribute__((ext_vector_type(4)));
typedef float f32x16 __attribute__((ext_vector_type(16)));
typedef unsigned u32x4 __attribute__((ext_vector_type(4)));
typedef unsigned u32x2 __attribute__((ext_vector_type(2)));
typedef int i32x4 __attribute__((ext_vector_type(4)));

constexpr int NTOK = 16384, DM = 2048, SEQ = 8192, NB = 2, NLAYER = 2;
constexpr int INW = 14712, INWP = 14848;
constexpr int NEXP = 32, DEXP = 1024;
constexpr int PMAX = 65536 + 8192;
constexpr float ALPHA = 1.41421356237309515f;
constexpr float LOG2E = 1.4426950408889634f;
constexpr float SCALE = 0.08838834764831845f;
constexpr float C2 = LOG2E * SCALE;

constexpr size_t MiB = 1ull << 20;
constexpr size_t WS_CTL   = 0;
constexpr size_t WS_W     = 1 * MiB;
constexpr size_t W_IN     = WS_W;
constexpr size_t W_IN8    = W_IN   + 2048ull * 2048 * 2;
constexpr size_t W_UK2    = W_IN   + (size_t)INWP * 2048 * 2;
constexpr size_t W_UV2    = W_UK2  + 8ull * 256 * 256 * 2;
constexpr size_t W_BRA    = W_UV2  + 4ull * 256 * 512 * 2;
constexpr size_t W_BRB    = W_BRA  + 2048ull * 1024 * 2;
constexpr size_t W_BRC    = W_BRB  + 2048ull * 1024 * 2;
constexpr size_t W_OUT    = W_BRC  + 2048ull * 1024 * 2;
constexpr size_t W_PG     = W_OUT  + 2048ull * 2048 * 2;
constexpr size_t W_PLE    = W_PG   + 2048ull * 2048 * 2;
constexpr size_t W_GU     = W_PLE  + 2048ull * 256 * 2;
constexpr size_t W_DN     = W_GU   + 32ull * 2048 * 2048 * 2;
constexpr size_t W_END    = W_DN   + 32ull * 2048 * 1024 * 2;
constexpr size_t WS_XB    = (W_END + MiB - 1) / MiB * MiB;
constexpr size_t WS_PB    = WS_XB  + (size_t)NTOK * DM * 2;
constexpr size_t WS_CUM   = WS_PB  + 2ull * NTOK * 256 * 2;
constexpr size_t WS_LF    = WS_CUM + 16ull * 8192 * 4;
constexpr size_t WS_XQ    = WS_LF  + 16ull * 8192 * 4;
constexpr size_t WS_XSC   = WS_XQ  + (size_t)NTOK * DM;
constexpr size_t WS_R     = (WS_XSC + (size_t)NTOK * 4 + MiB - 1) / MiB * MiB;
constexpr size_t R_SCORES = WS_R;
constexpr size_t R_OLAT   = WS_R;
constexpr size_t R_OA     = WS_R + 64 * MiB;
constexpr size_t R_OB     = WS_R + 96 * MiB;
constexpr size_t R_OC     = WS_R + 128 * MiB;
constexpr size_t R_TMP    = WS_R + 160 * MiB;
constexpr size_t R_MERGED = WS_R + 288 * MiB;
constexpr size_t R_PRE1   = WS_R + 384 * MiB;
constexpr size_t R_QA     = WS_R + 512 * MiB;
constexpr size_t R_QIDX   = WS_R + 544 * MiB;
constexpr size_t R_QKV    = WS_R + 576 * MiB;
constexpr size_t R_GATES  = WS_R + 768 * MiB;
constexpr size_t R_SMALL  = WS_R + 960 * MiB;
constexpr size_t R_QCAT   = WS_R + 992 * MiB;
constexpr size_t R_KCAT   = WS_R + 1064 * MiB;
constexpr size_t R_KI     = WS_R + 1073 * MiB;
constexpr size_t R_WI     = WS_R + 1075 * MiB;
constexpr size_t R_SEL    = WS_R + 1076 * MiB;
constexpr size_t R_NSEL   = WS_R + 1092 * MiB;
constexpr size_t R_END    = WS_R + 1093 * MiB;
constexpr size_t M_XS     = WS_R;
constexpr size_t M_HID    = WS_R + 288 * MiB;
constexpr size_t M_PP     = WS_R + 432 * MiB;
constexpr size_t M_X1F    = WS_R + 512 * MiB;
constexpr size_t M_X1B    = WS_R + 640 * MiB;
constexpr size_t M_HF     = WS_R + 704 * MiB;
constexpr size_t M_HQ     = WS_R + 704 * MiB;
constexpr size_t M_HSC    = WS_R + 736 * MiB;
constexpr size_t M_HB     = WS_R + 832 * MiB;
constexpr size_t M_TOKE   = WS_R + 896 * MiB;
constexpr size_t M_TOKPOS = M_TOKE + (size_t)NTOK * 16;
constexpr size_t M_TOKW   = M_TOKPOS + (size_t)NTOK * 16;
constexpr size_t M_TOKDST = M_TOKW + (size_t)NTOK * 16;
constexpr size_t M_ROWW   = M_TOKDST + (size_t)NTOK * 16;
constexpr size_t M_ROWSX  = M_ROWW + (size_t)PMAX * 4;
constexpr size_t M_X1S    = M_ROWSX + (size_t)PMAX * 4;
constexpr size_t M_X1Q    = WS_R + 900 * MiB;
constexpr size_t WS_NEED  = R_END;
constexpr int CW_BAR = 0;
constexpr int CW_CNT = 8192;
constexpr int CW_META = 4096 + 64;
constexpr int CW_QCTR = 6144;
constexpr int CW_WMAX = 6272;
constexpr int CW_WMAXG = 6336;
constexpr int CW_WMAXP = 6368;
constexpr int CW_KMAX = 6400;
constexpr size_t CTL_BYTES = 65536;

constexpr int LDS_BYTES = 152576;
constexpr int LDS_MISC = 151552;

typedef float f32x2 __attribute__((ext_vector_type(2)));
typedef __bf16 bf16n2 __attribute__((ext_vector_type(2)));
__device__ __forceinline__ unsigned cvtpk(float lo, float hi) { f32x2 v = {lo, hi}; bf16n2 b = __builtin_convertvector(v, bf16n2); return __builtin_bit_cast(unsigned, b); }
__device__ __forceinline__ bf16_t f2bf(float x) { return (bf16_t)(cvtpk(x, 0.f) & 0xffffu); }
__device__ __forceinline__ float bf2f(bf16_t b) { return __uint_as_float(((unsigned)b) << 16); }
__device__ __forceinline__ float bflo(unsigned w) { return __uint_as_float(w << 16); }
__device__ __forceinline__ float bfhi(unsigned w) { return __uint_as_float(w & 0xffff0000u); }
__device__ __forceinline__ bf16x8 pack8(f32x4 a, f32x4 b) { u32x4 w = {cvtpk(a[0], a[1]), cvtpk(a[2], a[3]), cvtpk(b[0], b[1]), cvtpk(b[2], b[3])}; return *reinterpret_cast<bf16x8*>(&w); }
__device__ __forceinline__ float sigmoidf_(float x) { return 1.0f / (1.0f + __expf(-x)); }
__device__ __forceinline__ float wave_sum(float v) { for (int o = 32; o > 0; o >>= 1) v += __shfl_xor(v, o); return v; }
__device__ __forceinline__ int crow(int r, int hi) { return (r & 3) + 8 * (r >> 2) + 4 * hi; }
#define SBAR() __builtin_amdgcn_sched_barrier(0)

#define XB_TMO      128
#define XB_XCNT(j)  (256  + 64 * (j))
#define XB_XSUB(j)  (1280 + 64 * (j))
#define XB_XGEN(j)  (2304 + 64 * (j))
#define XB_TOP      3328
#define XB_TOPGEN   3392
#define XCD_BAR_WORDS 3456
#define XB_SPIN_CAP (1u << 22)
__device__ __forceinline__ unsigned xb_ld(unsigned* p)              { return __hip_atomic_load(p, __ATOMIC_RELAXED, __HIP_MEMORY_SCOPE_AGENT); }
__device__ __forceinline__ unsigned xb_add(unsigned* p, unsigned v) { return __hip_atomic_fetch_add(p, v, __ATOMIC_RELAXED, __HIP_MEMORY_SCOPE_AGENT); }
__device__ __forceinline__ unsigned xb_xcc_id() { return (unsigned)__builtin_amdgcn_s_getreg((3 << 11) | 20) & 0xFu; }
#define XB_SPIN(cond, bar) do { unsigned _sp = 0; while (cond) { __builtin_amdgcn_s_sleep(1); \
    if ((++_sp & 255u) == 0u) { if (xb_ld(&(bar)[XB_TMO])) break; if (_sp > XB_SPIN_CAP) { atomicAdd(&(bar)[XB_TMO], 1u); break; } } } } while (0)
struct XcdBarrier { unsigned* bar; unsigned x; volatile LAS unsigned* st; };
__device__ __forceinline__ XcdBarrier xcd_barrier_post(unsigned* bar, volatile LAS unsigned* st) {
    XcdBarrier b; b.bar = bar; b.x = xb_xcc_id(); b.st = st;
    if (threadIdx.x == 0) (void)xb_add(&bar[XB_XCNT(b.x)], 1u);
    return b;
}
__device__ __forceinline__ void xcd_barrier_complete(unsigned* bar, unsigned x, unsigned& nloc, unsigned& nx) {
    const unsigned G = gridDim.x * gridDim.y * gridDim.z;
    unsigned sum, cnt, mine, sp = 0u;
    for (;;) {
        sum = 0u; cnt = 0u; mine = 0u;
#pragma unroll
        for (unsigned j = 0; j < 16; ++j) { const unsigned c = xb_ld(&bar[XB_XCNT(j)]); sum += c; cnt += (c > 0u) ? 1u : 0u; mine = (j == x) ? c : mine; }
        if (sum == G) break;
        __builtin_amdgcn_s_sleep(1);
        if ((++sp & 255u) == 0u) { if (xb_ld(&bar[XB_TMO])) break; if (sp > XB_SPIN_CAP) { atomicAdd(&bar[XB_TMO], 1u); break; } }
    }
    nloc = mine > 0u ? mine : 1u; nx = cnt > 0u ? cnt : 1u;
}
__device__ __forceinline__ void xcd_barrier(const XcdBarrier& b) {
    asm volatile("s_waitcnt vmcnt(0)" ::: "memory");
    __syncthreads();
    if (threadIdx.x == 0) {
        unsigned* bar = b.bar;
        __builtin_amdgcn_s_waitcnt(0);
        unsigned nloc = b.st[0], nx = b.st[1];
        if (nloc == 0u) { xcd_barrier_complete(bar, b.x, nloc, nx); b.st[0] = nloc; b.st[1] = nx; }
        const unsigned old = xb_add(&bar[XB_XSUB(b.x)], 1u);
        const unsigned gen = old / nloc;
        if (old + 1u == (gen + 1u) * nloc) {
            __builtin_amdgcn_fence(__ATOMIC_RELEASE, "agent");
            asm volatile("s_waitcnt vmcnt(0)" ::: "memory");
            const unsigned og = xb_add(&bar[XB_TOP], 1u);
            const unsigned tg = og / nx;
            if (og + 1u == (tg + 1u) * nx) xb_add(&bar[XB_TOPGEN], 1u);
            else XB_SPIN(xb_ld(&bar[XB_TOPGEN]) == tg, bar);
            __builtin_amdgcn_fence(__ATOMIC_ACQUIRE, "agent");
            xb_add(&bar[XB_XGEN(b.x)], 1u);
            asm volatile("s_waitcnt vmcnt(0)" ::: "memory");
        } else {
            XB_SPIN(xb_ld(&bar[XB_XGEN(b.x)]) == gen, bar);
            __builtin_amdgcn_fence(__ATOMIC_ACQUIRE, "agent");
            asm volatile("s_waitcnt vmcnt(0)" ::: "memory");
        }
    }
    __syncthreads();
}

namespace pg8 {
constexpr int BM = 256, BK = 64, HALF = 128, HTB = HALF * BK * 2, STAGE_BYTES = 8 * HTB, NXCD = 8, WGM = 8;
__device__ __forceinline__ int lds_byte(int r, int c) { const int st = (r >> 4) * 2 + (c >> 5), rr = r & 15, cc = c & 31, ob = rr * 64 + cc * 2; return st * 1024 + (ob ^ (((ob >> 9) & 1) << 5)); }
__device__ __forceinline__ void stage_rc(int b, int& R, int& C) { const int st = b / 1024, sb = b % 1024, swz = sb ^ (((sb >> 9) & 1) << 5); R = (st >> 1) * 16 + swz / 64; C = (st & 1) * 32 + (swz % 64) / 2; }
__device__ __forceinline__ int perm32(int rho) { const int n = rho >> 4, i = rho & 15; return 8 * (i >> 2) + 4 * n + (i & 3); }
struct Unit { int pm, pn, e; };
struct SchedS {
    int nM, nN, nwg, G, c; const bf16_t* A; const bf16_t* B; int lda, ldb, a_sh, a_mul, skip_from = 1 << 30, skip_by = 0, skip_from2 = 1 << 30, skip_by2 = 0, b_compact = 0;
    __device__ void init(int M, int N, int G_, int c_, const bf16_t* A_, int lda_, const bf16_t* B_, int ldb_, int a_sh_ = 0, int a_mul_ = 0) {
        nM = M / BM; nN = N / BM; nwg = nM * nN; G = G_; c = c_; A = A_; B = B_; lda = lda_; ldb = ldb_; a_sh = a_sh_; a_mul = a_mul_; }
    __device__ __forceinline__ bool next(int i, Unit& u) const {
        const long L = (long)i * G + c; if (L >= nwg) return false;
        int wgid = (int)L; { const int q = nwg / NXCD, r = nwg % NXCD, xcd = wgid % NXCD, off = wgid / NXCD; wgid = (xcd < r ? xcd * (q + 1) : r * (q + 1) + (xcd - r) * q) + off; }
        const int nig = WGM * nN, gid = wgid / nig, fm = gid * WGM, gsz = (nM - fm) < WGM ? (nM - fm) : WGM;
        u.pm = fm + ((wgid % nig) % gsz); u.pn = (wgid % nig) / gsz; u.e = 0;
        u.e = u.pn;
        { const int ci = u.pn; if (ci >= skip_from) u.pn += skip_by; if (ci >= skip_from2) u.pn += skip_by2; }
        return true;
    }
    __device__ __forceinline__ const char* pa(const Unit& u) const { return (const char*)(A + (size_t)u.pm * BM * lda + (size_t)((u.pn >> a_sh) * a_mul)); }
    __device__ __forceinline__ const char* pb(const Unit& u) const { return (const char*)(B + (size_t)(b_compact ? u.e : u.pn) * BM * ldb); }
};
struct SchedM {
    int ntiles, G, c; const bf16_t* A; const bf16_t* W; int lda, ldb; const unsigned* tile_e;
    __device__ void init(const unsigned* meta, int G_, int c_, const bf16_t* A_, int lda_, const bf16_t* W_, int ldb_) {
        ntiles = (int)meta[0]; tile_e = meta + 1; G = G_; c = c_; A = A_; W = W_; lda = lda_; ldb = ldb_; }
    __device__ __forceinline__ bool next(int i, Unit& u) const {
        const long L = (long)i * G + c; if (L >= (long)ntiles * 8) return false;
        u.pm = (int)(L >> 3); u.pn = (int)(L & 7); u.e = (int)tile_e[u.pm];
        return true;
    }
    __device__ __forceinline__ const char* pa(const Unit& u) const { return (const char*)(A + (size_t)u.pm * BM * lda); }
    __device__ __forceinline__ const char* pb(const Unit& u) const { return (const char*)(W + ((size_t)u.e * 2048 + (size_t)u.pn * BM) * ldb); }
};

template <class Epi, class Sched>
__device__ __forceinline__ void gemm_phase(LAS unsigned char* lds, const int K, const int lda, const int ldb, const Sched& S, const Epi& E) {
    int tid = threadIdx.x; asm volatile("" : "+v"(tid));
    const int wid = __builtin_amdgcn_readfirstlane(tid >> 6), lane = tid & 63, wr = wid >> 2, wc = wid & 3, fr = lane & 15, fq = lane >> 4;
    const int nt = K / BK;
    unsigned voffA[2], voffB[2];
#pragma unroll
    for (int i = 0; i < 2; ++i) { int R, C; stage_rc(tid * 16 + i * 8192, R, C); const int Rb = (R & ~31) + perm32(R & 31);
        voffA[i] = (unsigned)(R * lda + C) * 2u; voffB[i] = (unsigned)(Rb * ldb + C) * 2u; }
    const size_t kstep = (size_t)(BK * 2);
    const size_t hstepA = (size_t)HALF * lda * 2, hstepB = (size_t)HALF * ldb * 2;
    const unsigned ldsw = (unsigned)wid * 1024u;
    const int aoff = lds_byte(wr * 64 + fr, fq * 8), boff = lds_byte(wc * 32 + fr, fq * 8);
#define PG8_SA(b, h) (((b) * 2 + (h)) * HTB)
#define PG8_SB(b, h) ((4 + (b) * 2 + (h)) * HTB)
#define PG8_STAGE(bufoff, gbase, voff) do { _Pragma("unroll") for (int _i = 0; _i < 2; ++_i) \
        __builtin_amdgcn_global_load_lds((const unsigned*)((const char*)(gbase) + (voff)[_i]), (LAS unsigned*)(lds + (bufoff) + ldsw + _i * 8192), 16, 0, 0); } while (0)
#define PG8_LDA(dst, b, h) do { _Pragma("unroll") for (int m = 0; m < 4; ++m) _Pragma("unroll") for (int k = 0; k < 2; ++k) dst[m][k] = *(const LAS bf16x8*)(lds + PG8_SA(b, h) + aoff + m * 2048 + k * 1024); } while (0)
#define PG8_LDB(dst, b, h) do { _Pragma("unroll") for (int n = 0; n < 2; ++n) _Pragma("unroll") for (int k = 0; k < 2; ++k) dst[n][k] = *(const LAS bf16x8*)(lds + PG8_SB(b, h) + boff + n * 2048 + k * 1024); } while (0)
#define PG8_MMA(ai, bj, At, Bt) do { __builtin_amdgcn_s_setprio(1); _Pragma("unroll") for (int m = 0; m < 4; ++m) _Pragma("unroll") for (int n = 0; n < 2; ++n) _Pragma("unroll") for (int k = 0; k < 2; ++k) \
        { if constexpr (Epi::I8) acc[ai][bj][m][n] = __builtin_bit_cast(f32x4, __builtin_amdgcn_mfma_i32_16x16x64_i8(__builtin_bit_cast(i32x4, Bt[n][k]), __builtin_bit_cast(i32x4, At[m][k]), __builtin_bit_cast(i32x4, acc[ai][bj][m][n]), 0, 0, 0)); \
          else acc[ai][bj][m][n] = __builtin_amdgcn_mfma_f32_16x16x32_bf16(Bt[n][k], At[m][k], acc[ai][bj][m][n], 0, 0, 0); } __builtin_amdgcn_s_setprio(0); } while (0)
#define PG8_WAIT_V(n) asm volatile("s_waitcnt vmcnt(" #n ")" ::: "memory")
#define PG8_WAIT_L(n) asm volatile("s_waitcnt lgkmcnt(" #n ")" ::: "memory")
#define PG8_BAR __builtin_amdgcn_s_barrier()
#define PG8_SCHED __builtin_amdgcn_sched_barrier(0)
    Unit cur, nxt; int ui = 0;
    if (!S.next(0, cur)) return;
    f32x4 acc[2][2][4][2];
#pragma unroll
    for (int a = 0; a < 2; ++a)
#pragma unroll
        for (int b = 0; b < 2; ++b)
#pragma unroll
            for (int m = 0; m < 4; ++m)
#pragma unroll
                for (int n = 0; n < 2; ++n) acc[a][b][m][n] = (f32x4){0.f, 0.f, 0.f, 0.f};
    bf16x8 At[4][2], B0[2][2], B1[2][2];
    const char* cA = S.pa(cur); const char* cB = S.pb(cur);
    PG8_STAGE(PG8_SB(0, 0), cB, voffB); PG8_STAGE(PG8_SA(0, 0), cA, voffA); PG8_STAGE(PG8_SB(0, 1), cB + hstepB, voffB); PG8_STAGE(PG8_SA(0, 1), cA + hstepA, voffA);
    if (wr == 1) PG8_BAR;
    PG8_WAIT_V(4); PG8_BAR;
    PG8_STAGE(PG8_SB(1, 0), cB + kstep, voffB); PG8_STAGE(PG8_SA(1, 0), cA + kstep, voffA); PG8_STAGE(PG8_SB(1, 1), cB + hstepB + kstep, voffB);
    PG8_WAIT_V(6); PG8_BAR;
    for (;;) {
        const bool has_next = S.next(ui + 1, nxt);
        const char* nA = has_next ? S.pa(nxt) : cA; const char* nB = has_next ? S.pb(nxt) : cB;
        for (int t = 0; t < nt; t += 2) {
            const bool last = (t == nt - 2);
            if constexpr (Epi::HAS_MID) { if (t == Epi::MID1 || t == Epi::MID2) { int frM = fr, fqM = fq; asm volatile("" : "+v"(frM), "+v"(fqM)); E.mid(acc, cur, t, wr, wc, frM, fqM); } }
            const char* a1 = cA + (size_t)(t + 1) * kstep;
            const char* a2 = last ? nA : cA + (size_t)(t + 2) * kstep; const char* b2 = last ? nB : cB + (size_t)(t + 2) * kstep;
            const char* a3 = a2 + kstep; const char* b3 = b2 + kstep;
            PG8_LDB(B0, 0, 0); PG8_SCHED; PG8_LDA(At, 0, 0); PG8_STAGE(PG8_SA(1, 1), a1 + hstepA, voffA);
            PG8_WAIT_L(8); PG8_BAR; PG8_WAIT_L(0); PG8_MMA(0, 0, At, B0); PG8_BAR; PG8_SCHED;
            PG8_LDB(B1, 0, 1); PG8_STAGE(PG8_SB(0, 0), b2, voffB);
            PG8_BAR; PG8_WAIT_L(0); PG8_MMA(0, 1, At, B1); PG8_BAR;
            PG8_LDA(At, 0, 1); PG8_STAGE(PG8_SA(0, 0), a2, voffA);
            PG8_BAR; PG8_WAIT_L(0); PG8_MMA(1, 0, At, B0); PG8_BAR; PG8_SCHED;
            PG8_STAGE(PG8_SB(0, 1), b2 + hstepB, voffB);
            PG8_WAIT_V(6); PG8_BAR; PG8_MMA(1, 1, At, B1); PG8_BAR;
            PG8_LDB(B0, 1, 0); PG8_SCHED; PG8_LDA(At, 1, 0); PG8_STAGE(PG8_SA(0, 1), a2 + hstepA, voffA);
            PG8_WAIT_L(8); PG8_BAR; PG8_WAIT_L(0); PG8_MMA(0, 0, At, B0); PG8_BAR; PG8_SCHED;
            PG8_LDB(B1, 1, 1); PG8_STAGE(PG8_SB(1, 0), b3, voffB);
            PG8_BAR; PG8_WAIT_L(0); PG8_MMA(0, 1, At, B1); PG8_BAR;
            PG8_LDA(At, 1, 1); PG8_STAGE(PG8_SA(1, 0), a3, voffA);
            PG8_BAR; PG8_WAIT_L(0); PG8_MMA(1, 0, At, B0); PG8_BAR; PG8_SCHED;
            PG8_STAGE(PG8_SB(1, 1), b3 + hstepB, voffB);
            PG8_WAIT_V(6); PG8_BAR; PG8_MMA(1, 1, At, B1); PG8_BAR;
        }
        { int frE = fr, fqE = fq; asm volatile("" : "+v"(frE), "+v"(fqE)); E(acc, cur, wr, wc, frE, fqE); }
        if (!has_next) break;
#pragma unroll
        for (int a = 0; a < 2; ++a)
#pragma unroll
            for (int b = 0; b < 2; ++b)
#pragma unroll
                for (int m = 0; m < 4; ++m)
#pragma unroll
                    for (int n = 0; n < 2; ++n) acc[a][b][m][n] = (f32x4){0.f, 0.f, 0.f, 0.f};
        cur = nxt; cA = nA; cB = nB; ++ui;
    }
    PG8_WAIT_V(0);
    if (wr == 0) PG8_BAR;
    PG8_BAR;
#undef PG8_SA
#undef PG8_SB
#undef PG8_STAGE
#undef PG8_LDA
#undef PG8_LDB
#undef PG8_MMA
#undef PG8_WAIT_V
#undef PG8_WAIT_L
#undef PG8_BAR
#undef PG8_SCHED
}

#define EPI_LOOP_ROWS _Pragma("unroll") for (int ai = 0; ai < 2; ++ai) _Pragma("unroll") for (int m = 0; m < 4; ++m)
__device__ __forceinline__ void st_bf16x8(bf16_t* p, f32x4 v0, f32x4 v1) { u32x4 w; w.x = cvtpk(v0[0], v0[1]); w.y = cvtpk(v0[2], v0[3]); w.z = cvtpk(v1[0], v1[1]); w.w = cvtpk(v1[2], v1[3]); *(u32x4*)p = w; }

template <bool I8_> struct EpiInProj {
    static constexpr bool HAS_MID = false; static constexpr bool I8 = I8_;
    bf16_t* qa; bf16_t* qidx; bf16_t* qkv; bf16_t* gates; float* small_; const float* xs; const unsigned* wmaxbits;
    __device__ __forceinline__ f32x4 val(const f32x4& a, float sc) const { if constexpr (I8_) { const i32x4 v = __builtin_bit_cast(i32x4, a); return (f32x4){(float)v[0], (float)v[1], (float)v[2], (float)v[3]} * sc; } else return a; }
    __device__ __forceinline__ void operator()(const f32x4 (&acc)[2][2][4][2], const Unit& u, int wr, int wc, int fr, int fq) const {
        const int pn = u.pn, row0 = u.pm * BM + wr * 64 + fr, lc0 = wc * 32 + fq * 8;
        float sw = 0.f; if constexpr (I8_) sw = __uint_as_float(*wmaxbits) * (1.3f / 127.0f);
        float scs[2][4];
#pragma unroll
        for (int ai = 0; ai < 2; ++ai)
#pragma unroll
            for (int m = 0; m < 4; ++m) { scs[ai][m] = 0.f; if constexpr (I8_) scs[ai][m] = xs[row0 + ai * HALF + m * 16] * sw; }
        if (pn < 8) {
            bf16_t* base = (pn < 4 ? qa + pn * 256 : qidx + (pn - 4) * 256) + lc0;
            EPI_LOOP_ROWS { const int row = row0 + ai * HALF + m * 16; const float sc = scs[ai][m];
#pragma unroll
                for (int bj = 0; bj < 2; ++bj) st_bf16x8(base + (size_t)row * 1024 + bj * HALF, val(acc[ai][bj][m][0], sc), val(acc[ai][bj][m][1], sc)); }
        } else if (pn < 32) {
            const int id = (pn - 8) >> 2, hb = ((pn - 8) & 3) * 2, b = u.pm >> 5;
            bf16_t* base = qkv + (size_t)id * ((size_t)NTOK * 1024) + lc0;
            EPI_LOOP_ROWS { const int row = row0 + ai * HALF + m * 16, s = row & (SEQ - 1); const float sc = scs[ai][m];
#pragma unroll
                for (int bj = 0; bj < 2; ++bj) st_bf16x8(base + ((size_t)(b * 8 + hb + bj) * SEQ + s) * 128, val(acc[ai][bj][m][0], sc), val(acc[ai][bj][m][1], sc)); }
        } else if (pn < 56) {
            bf16_t* base = gates + (pn - 32) * 256 + lc0;
            EPI_LOOP_ROWS { const int row = row0 + ai * HALF + m * 16; const float sc = scs[ai][m];
#pragma unroll
                for (int bj = 0; bj < 2; ++bj) st_bf16x8(base + (size_t)row * 6144 + bj * HALF, val(acc[ai][bj][m][0], sc), val(acc[ai][bj][m][1], sc)); }
        } else {
            float* base = small_ + (pn - 56) * 256 + lc0;
            EPI_LOOP_ROWS { const int row = row0 + ai * HALF + m * 16; const float sc = scs[ai][m];
#pragma unroll
                for (int bj = 0; bj < 2; ++bj) { float* p = base + (size_t)row * 512 + bj * HALF; *(f32x4*)p = val(acc[ai][bj][m][0], sc); *(f32x4*)(p + 4) = val(acc[ai][bj][m][1], sc); } }
        }
    }
};
struct EpiBf16 {
    static constexpr bool HAS_MID = false; static constexpr bool I8 = false;
    bf16_t* out; int ld, cstep;
    __device__ __forceinline__ void operator()(const f32x4 (&acc)[2][2][4][2], const Unit& u, int wr, int wc, int fr, int fq) const {
        const int row0 = u.pm * BM + wr * 64 + fr; bf16_t* base = out + (size_t)u.pn * cstep + wc * 32 + fq * 8;
        EPI_LOOP_ROWS { const int row = row0 + ai * HALF + m * 16;
#pragma unroll
            for (int bj = 0; bj < 2; ++bj) st_bf16x8(base + (size_t)row * ld + bj * HALF, acc[ai][bj][m][0], acc[ai][bj][m][1]); }
    }
};
struct EpiBranch3 {
    static constexpr bool HAS_MID = true; static constexpr bool I8 = false; static constexpr int MID1 = 16, MID2 = 32;
    const bf16_t* gates; bf16_t* merged;
    __device__ __forceinline__ static f32x4 rat(unsigned n0, unsigned n1, unsigned d0, unsigned d1) {
        f32x4 r; r[0] = (1.f + __expf(-bflo(d0))) / (1.f + __expf(-bflo(n0))); r[1] = (1.f + __expf(-bfhi(d0))) / (1.f + __expf(-bfhi(n0)));
        r[2] = (1.f + __expf(-bflo(d1))) / (1.f + __expf(-bflo(n1))); r[3] = (1.f + __expf(-bfhi(d1))) / (1.f + __expf(-bfhi(n1))); return r; }
    __device__ __forceinline__ void mid(f32x4 (&acc)[2][2][4][2], const Unit& u, int t, int wr, int wc, int fr, int fq) const {
        const int row0 = u.pm * BM + wr * 64 + fr, col0 = u.pn * BM + wc * 32 + fq * 8, bn = (t == MID1) ? 0 : 2048;
#pragma unroll
        for (int ai = 0; ai < 2; ++ai) { u32x4 gn[4][2], gd[4][2];
#pragma unroll
            for (int m = 0; m < 4; ++m)
#pragma unroll
                for (int bj = 0; bj < 2; ++bj) { const bf16_t* gp = gates + (size_t)(row0 + ai * HALF + m * 16) * 6144 + bn + col0 + bj * HALF; gn[m][bj] = *(const u32x4*)gp; gd[m][bj] = *(const u32x4*)(gp + 2048); }
#pragma unroll
            for (int m = 0; m < 4; ++m)
#pragma unroll
                for (int bj = 0; bj < 2; ++bj) { acc[ai][bj][m][0] *= rat(gn[m][bj].x, gn[m][bj].y, gd[m][bj].x, gd[m][bj].y); acc[ai][bj][m][1] *= rat(gn[m][bj].z, gn[m][bj].w, gd[m][bj].z, gd[m][bj].w); } }
    }
    __device__ __forceinline__ void operator()(const f32x4 (&acc)[2][2][4][2], const Unit& u, int wr, int wc, int fr, int fq) const {
        const int row0 = u.pm * BM + wr * 64 + fr, col0 = u.pn * BM + wc * 32 + fq * 8;
        u32x4 gl[2][4][2];
        EPI_LOOP_ROWS {
#pragma unroll
            for (int bj = 0; bj < 2; ++bj) gl[ai][m][bj] = *(const u32x4*)(gates + (size_t)(row0 + ai * HALF + m * 16) * 6144 + 4096 + col0 + bj * HALF); }
        EPI_LOOP_ROWS { const int row = row0 + ai * HALF + m * 16;
#pragma unroll
            for (int bj = 0; bj < 2; ++bj) { const int col = col0 + bj * HALF; const u32x4 gw = gl[ai][m][bj];
                f32x4 v0 = acc[ai][bj][m][0], v1 = acc[ai][bj][m][1];
                v0[0] *= sigmoidf_(bflo(gw.x)); v0[1] *= sigmoidf_(bfhi(gw.x)); v0[2] *= sigmoidf_(bflo(gw.y)); v0[3] *= sigmoidf_(bfhi(gw.y));
                v1[0] *= sigmoidf_(bflo(gw.z)); v1[1] *= sigmoidf_(bfhi(gw.z)); v1[2] *= sigmoidf_(bflo(gw.w)); v1[3] *= sigmoidf_(bfhi(gw.w));
                st_bf16x8(merged + (size_t)row * 2048 + col, v0, v1); } }
    }
};
struct EpiOut {
    static constexpr bool HAS_MID = false; static constexpr bool I8 = false;
    const bf16_t* res; bf16_t* pre;
    __device__ __forceinline__ void operator()(const f32x4 (&acc)[2][2][4][2], const Unit& u, int wr, int wc, int fr, int fq) const {
        const int row0 = u.pm * BM + wr * 64 + fr, col0 = u.pn * BM + wc * 32 + fq * 8;
        u32x4 rl[2][4][2];
        EPI_LOOP_ROWS { const int row = row0 + ai * HALF + m * 16;
#pragma unroll
            for (int bj = 0; bj < 2; ++bj) rl[ai][m][bj] = *(const u32x4*)(res + (size_t)row * 2048 + col0 + bj * HALF); }
        EPI_LOOP_ROWS { const int row = row0 + ai * HALF + m * 16;
#pragma unroll
            for (int bj = 0; bj < 2; ++bj) { const size_t o = (size_t)row * 2048 + col0 + bj * HALF;
                const u32x4 rw = rl[ai][m][bj]; f32x4 v0 = acc[ai][bj][m][0], v1 = acc[ai][bj][m][1];
                v0[0] += ALPHA * bflo(rw.x); v0[1] += ALPHA * bfhi(rw.x); v0[2] += ALPHA * bflo(rw.y); v0[3] += ALPHA * bfhi(rw.y);
                v1[0] += ALPHA * bflo(rw.z); v1[1] += ALPHA * bfhi(rw.z); v1[2] += ALPHA * bflo(rw.w); v1[3] += ALPHA * bfhi(rw.w);
                st_bf16x8(pre + o, v0, v1); } }
    }
};
struct EpiGateUpI8 {
    static constexpr bool HAS_MID = false; static constexpr bool I8 = true;
    const float* bg; const float* bu; bf16_t* hid; const float* rowsx; const unsigned* wmaxbits;
    __device__ __forceinline__ void operator()(const f32x4 (&acc)[2][2][4][2], const Unit& u, int wr, int wc, int fr, int fq) const {
        const int row0 = u.pm * BM + wr * 64 + fr, j0 = u.pn * 128 + wc * 32 + fq * 8;
        const float sw = __uint_as_float(*wmaxbits) * (1.3f / 127.0f);
        const float* pg = bg + (size_t)u.e * DEXP + j0; const float* pu = bu + (size_t)u.e * DEXP + j0;
        const f32x4 g0b = *(const f32x4*)pg, g1b = *(const f32x4*)(pg + 4), u0b = *(const f32x4*)pu, u1b = *(const f32x4*)(pu + 4);
        float scs[2][4];
#pragma unroll
        for (int ai = 0; ai < 2; ++ai)
#pragma unroll
            for (int m = 0; m < 4; ++m) scs[ai][m] = rowsx[row0 + ai * HALF + m * 16] * sw;
        EPI_LOOP_ROWS { const int row = row0 + ai * HALF + m * 16; const float sc = scs[ai][m];
            const i32x4 ag0 = __builtin_bit_cast(i32x4, acc[ai][0][m][0]), ag1 = __builtin_bit_cast(i32x4, acc[ai][0][m][1]), au0 = __builtin_bit_cast(i32x4, acc[ai][1][m][0]), au1 = __builtin_bit_cast(i32x4, acc[ai][1][m][1]);
            f32x4 h0, h1;
#pragma unroll
            for (int j = 0; j < 4; ++j) {
                float g = fminf((float)ag0[j] * sc + g0b[j], 7.0f), uu = fminf(fmaxf((float)au0[j] * sc + u0b[j], -7.0f), 7.0f);
                h0[j] = (uu + 1.0f) * (g * sigmoidf_(1.702f * g));
                g = fminf((float)ag1[j] * sc + g1b[j], 7.0f); uu = fminf(fmaxf((float)au1[j] * sc + u1b[j], -7.0f), 7.0f);
                h1[j] = (uu + 1.0f) * (g * sigmoidf_(1.702f * g)); }
            st_bf16x8(hid + (size_t)row * DEXP + j0, h0, h1); }
    }
};
struct EpiDown {
    static constexpr bool HAS_MID = false; static constexpr bool I8 = false;
    const float* bd; const float* roww; bf16_t* ys;
    __device__ __forceinline__ void operator()(const f32x4 (&acc)[2][2][4][2], const Unit& u, int wr, int wc, int fr, int fq) const {
        const int row0 = u.pm * BM + wr * 64 + fr, col0 = u.pn * BM + wc * 32 + fq * 8;
        f32x4 b[2][2];
#pragma unroll
        for (int bj = 0; bj < 2; ++bj) { const float* p = bd + (size_t)u.e * DM + col0 + bj * HALF; b[bj][0] = *(const f32x4*)p; b[bj][1] = *(const f32x4*)(p + 4); }
        float rws[2][4];
#pragma unroll
        for (int ai = 0; ai < 2; ++ai)
#pragma unroll
            for (int m = 0; m < 4; ++m) rws[ai][m] = roww[row0 + ai * HALF + m * 16];
        EPI_LOOP_ROWS { const int row = row0 + ai * HALF + m * 16; const float w = rws[ai][m];
#pragma unroll
            for (int bj = 0; bj < 2; ++bj) st_bf16x8(ys + (size_t)row * 2048 + col0 + bj * HALF, (acc[ai][bj][m][0] + b[bj][0]) * w, (acc[ai][bj][m][1] + b[bj][1]) * w); }
    }
};
struct EpiPleGateI8 {
    static constexpr bool HAS_MID = false; static constexpr bool I8 = true;
    const bf16_t* hb; const bf16_t* pp; bf16_t* pre; const float* hs; const unsigned* wmaxbits;
    __device__ __forceinline__ void operator()(const f32x4 (&acc)[2][2][4][2], const Unit& u, int wr, int wc, int fr, int fq) const {
        const int row0 = u.pm * BM + wr * 64 + fr, col0 = u.pn * BM + wc * 32 + fq * 8;
        const float sw = __uint_as_float(*wmaxbits) * (1.3f / 127.0f);
#pragma unroll
        for (int ai = 0; ai < 2; ++ai) { u32x4 pl[4][2], hl[4][2]; float scs[4];
#pragma unroll
            for (int m = 0; m < 4; ++m) { scs[m] = hs[row0 + ai * HALF + m * 16] * sw;
#pragma unroll
                for (int bj = 0; bj < 2; ++bj) { const size_t o = (size_t)(row0 + ai * HALF + m * 16) * 2048 + col0 + bj * HALF; pl[m][bj] = *(const u32x4*)(pp + o); hl[m][bj] = *(const u32x4*)(hb + o); } }
#pragma unroll
            for (int m = 0; m < 4; ++m) { const float sc = scs[m];
#pragma unroll
                for (int bj = 0; bj < 2; ++bj) { const size_t o = (size_t)(row0 + ai * HALF + m * 16) * 2048 + col0 + bj * HALF; const u32x4 pw = pl[m][bj], hw = hl[m][bj];
                    const i32x4 a0 = __builtin_bit_cast(i32x4, acc[ai][bj][m][0]), a1 = __builtin_bit_cast(i32x4, acc[ai][bj][m][1]); f32x4 o0, o1;
                    o0[0] = bflo(hw.x) + sigmoidf_((float)a0[0] * sc) * bflo(pw.x); o0[1] = bfhi(hw.x) + sigmoidf_((float)a0[1] * sc) * bfhi(pw.x); o0[2] = bflo(hw.y) + sigmoidf_((float)a0[2] * sc) * bflo(pw.y); o0[3] = bfhi(hw.y) + sigmoidf_((float)a0[3] * sc) * bfhi(pw.y);
                    o1[0] = bflo(hw.z) + sigmoidf_((float)a1[0] * sc) * bflo(pw.z); o1[1] = bfhi(hw.z) + sigmoidf_((float)a1[1] * sc) * bfhi(pw.z); o1[2] = bflo(hw.w) + sigmoidf_((float)a1[2] * sc) * bflo(pw.w); o1[3] = bfhi(hw.w) + sigmoidf_((float)a1[3] * sc) * bfhi(pw.w);
                    st_bf16x8(pre + o, o0, o1); } } }
    }
};
}

struct Params { const float* in[25]; float* out; unsigned char* ws; int ph_lo, ph_hi; };
__constant__ float c_invf_r[16] = {1.000000000e+00f, 4.403665960e-01f, 1.939227432e-01f, 8.539710194e-02f, 3.760603070e-02f, 1.656043902e-02f, 7.292664610e-03f, 3.211445874e-03f, 1.414213562e-03f, 6.227723788e-04f, 2.742481884e-04f, 1.207697351e-04f, 5.318296098e-05f, 2.341999971e-05f, 1.031338616e-05f, 4.541670478e-06f};
__constant__ float c_invf_i[8] = {1.000000000e+00f, 1.939227432e-01f, 3.760603070e-02f, 7.292664610e-03f, 1.414213562e-03f, 2.742481884e-04f, 5.318296098e-05f, 1.031338616e-05f};
constexpr int LDS_PTRS = LDS_MISC + 256;
struct Frame { unsigned char* lds; LAS unsigned char* ldsl; unsigned char* ws; int tid, lane, wid, G, bid;
    __device__ __forceinline__ const float* in(int k) const { const LAS unsigned* t = (const LAS unsigned*)(ldsl + LDS_PTRS) + 2 * k;
        const unsigned lo = __builtin_amdgcn_readfirstlane(t[0]), hi = __builtin_amdgcn_readfirstlane(t[1]); return (const float*)(const GAS float*)(((unsigned long long)hi << 32) | lo); }
    __device__ __forceinline__ float* out() const { return (float*)in(25); } };
__device__ __forceinline__ Frame fresh(const Frame& F0) { Frame F = F0; int t = threadIdx.x; asm volatile("" : "+v"(t)); F.tid = t; F.lane = t & 63; F.wid = __builtin_amdgcn_readfirstlane(t >> 6); size_t z = 0; asm volatile("" : "+s"(z)); F.ws = F0.ws + z; return F; }

struct TcTile { const float* src; long sld; bf16_t* dst; long dld; int nvalid; float qinv; };
template <class Dec>
__device__ __forceinline__ void tconv_run(const Frame& F, int total, const Dec& dec, int& rot) {
    float* tile = (float*)F.lds;
    const int tid = F.tid, G = F.G;
    const int start = (F.bid - (rot % G) + G) % G; rot += total;
    const int lr = tid >> 4, lc4 = (tid & 15) * 4, sn = tid >> 3, skc = (tid & 7) * 8;
    f32x4 v[4][2];
#define TC_ISSUE(t0_) do { _Pragma("unroll") for (int q = 0; q < 4; ++q) { const int t = (t0_) + q * G; \
        if (t < total) { const TcTile ti = dec(t); _Pragma("unroll") for (int h = 0; h < 2; ++h) { v[q][h] = (f32x4){0.f, 0.f, 0.f, 0.f}; \
            if (lc4 < ti.nvalid) v[q][h] = *(const GAS f32x4*)((const GAS float*)ti.src + (size_t)(lr + 32 * h) * ti.sld + lc4); } } } } while (0)
    if (start < total) TC_ISSUE(start);
    for (int t0 = start; t0 < total; t0 += 4 * G) {
#pragma unroll
        for (int q = 0; q < 4; ++q) { if (t0 + q * G < total) { float* tl = tile + q * (64 * 65);
#pragma unroll
                for (int h = 0; h < 2; ++h) { float* p = tl + (lr + 32 * h) * 65 + lc4; p[0] = v[q][h][0]; p[1] = v[q][h][1]; p[2] = v[q][h][2]; p[3] = v[q][h][3]; } } }
        __syncthreads();
        if (t0 + 4 * G < total) TC_ISSUE(t0 + 4 * G);
#pragma unroll
        for (int q = 0; q < 4; ++q) { const int t = t0 + q * G;
            if (t < total) { const TcTile ti = dec(t); const float* tl = tile + q * (64 * 65);
                if (ti.qinv > 0.f) { if (tid < 256) { const int n8 = tid >> 2, kc = (tid & 3) * 16; u32x4 w;
#pragma unroll
                        for (int d = 0; d < 4; ++d) { unsigned pk = 0u;
#pragma unroll
                            for (int j = 0; j < 4; ++j) { float q = rintf(tl[(kc + d * 4 + j) * 65 + n8] * ti.qinv); q = fminf(fmaxf(q, -127.f), 127.f); pk |= ((unsigned)(int)q & 0xffu) << (8 * j); }
                            w[d] = pk; }
                        *(u32x4*)((unsigned char*)ti.dst + (size_t)n8 * ti.dld + kc) = w; } }
                else if (sn < ti.nvalid) { f32x4 a, b;
#pragma unroll
                    for (int j = 0; j < 4; ++j) { a[j] = tl[(skc + j) * 65 + sn]; b[j] = tl[(skc + 4 + j) * 65 + sn]; }
                    pg8::st_bf16x8(ti.dst + (size_t)sn * ti.dld + skc, a, b); } } }
        __syncthreads();
    }
#undef TC_ISSUE
}
struct TcMat {
    const float* src; long src_ld; int tk, ncols; bf16_t* dst; long dst_ld; float qinv;
    __device__ __forceinline__ TcTile operator()(int t) const { const int k0 = (t % tk) * 64, n0 = (t / tk) * 64; TcTile ti;
        ti.src = src + (size_t)k0 * src_ld + n0; ti.sld = src_ld; ti.dst = qinv > 0.f ? (bf16_t*)((unsigned char*)dst + (size_t)n0 * dst_ld + k0) : dst + (size_t)n0 * dst_ld + k0; ti.dld = dst_ld; ti.nvalid = (ncols - n0) < 64 ? (ncols - n0) : 64; ti.qinv = qinv; return ti; }
};
__device__ __forceinline__ void tconv(const Frame& F, const float* src, long src_ld, int K, int ncols, bf16_t* dst, long dst_ld, int& rot) {
    TcMat d{src, src_ld, K >> 6, ncols, dst, dst_ld, 0.f}; tconv_run(F, (K >> 6) * ((ncols + 63) >> 6), d, rot);
}
struct TcExperts {
    const float* wg; const float* wu; const float* wd; unsigned char* dgu; bf16_t* ddn; float qinv;
    __device__ __forceinline__ TcTile operator()(int t) const { const int e = t / 1536, r = t - e * 1536; TcTile ti; ti.nvalid = 64; ti.qinv = 0.f;
        if (r < 1024) { const int k0 = (r & 31) * 64, dt = r >> 5, jb = dt >> 2, gu = (dt >> 1) & 1, half = dt & 1;
            ti.src = (const float*)((unsigned long long)wg + (unsigned long long)gu * ((unsigned long long)wu - (unsigned long long)wg)) + (size_t)e * DM * DEXP + (size_t)k0 * DEXP + jb * 128 + half * 64; ti.sld = DEXP;
            ti.dst = (bf16_t*)(dgu + (size_t)e * 2048 * 2048 + (size_t)(dt * 64) * 2048 + k0); ti.dld = 2048; ti.qinv = qinv; }
        else { const int r2 = r - 1024, k0 = (r2 & 15) * 64, n0 = (r2 >> 4) * 64;
            ti.src = wd + (size_t)e * DEXP * DM + (size_t)k0 * DM + n0; ti.sld = DM;
            ti.dst = ddn + (size_t)e * 2048 * 1024 + (size_t)n0 * 1024 + k0; ti.dld = 1024; }
        return ti; }
};
__device__ __forceinline__ void sample_wmax(const Frame& F) {
    unsigned* wm = (unsigned*)(F.ws + WS_CTL) + CW_WMAX;
#pragma unroll 1
    for (int l = 0; l < NLAYER; ++l) { float mx = 0.f;
#pragma unroll 1
        for (int which = 0; which < 2; ++which) { const f32x4* p = (const f32x4*)(F.in(which ? 17 : 15) + (size_t)l * NEXP * DM * DEXP);
            for (size_t i = (size_t)F.bid * 512 + F.tid; i < (size_t)NEXP * DM * DEXP / 4 / 64; i += (size_t)F.G * 512) { const f32x4 v = p[i * 64 + (i & 63)];
                mx = fmaxf(mx, fmaxf(fmaxf(fabsf(v[0]), fabsf(v[1])), fmaxf(fabsf(v[2]), fabsf(v[3])))); } }
        for (int o = 32; o > 0; o >>= 1) mx = fmaxf(mx, __shfl_xor(mx, o));
        if (F.lane == 0 && mx > 0.f) atomicMax(&wm[l], __float_as_uint(mx));
        float mg = 0.f; const f32x4* wi_ = (const f32x4*)(F.in(2) + (size_t)l * DM * INW);
        for (int i = F.bid * 512 + F.tid; i < DM * (INW / 4) / 16; i += F.G * 512) { const f32x4 v = wi_[(size_t)i * 16 + (i & 15)];
            mg = fmaxf(mg, fmaxf(fmaxf(fabsf(v[0]), fabsf(v[1])), fmaxf(fabsf(v[2]), fabsf(v[3])))); }
        for (int o = 32; o > 0; o >>= 1) mg = fmaxf(mg, __shfl_xor(mg, o));
        if (F.lane == 0 && mg > 0.f) atomicMax(&wm[CW_WMAXG - CW_WMAX + l], __float_as_uint(mg));
        float mp = 0.f; const f32x4* wp_ = (const f32x4*)(F.in(21) + (size_t)l * DM * DM);
        for (int i = F.bid * 512 + F.tid; i < DM * DM / 4 / 16; i += F.G * 512) { const f32x4 v = wp_[i * 16 + (i & 15)];
            mp = fmaxf(mp, fmaxf(fmaxf(fabsf(v[0]), fabsf(v[1])), fmaxf(fabsf(v[2]), fabsf(v[3])))); }
        for (int o = 32; o > 0; o >>= 1) mp = fmaxf(mp, __shfl_xor(mp, o));
        if (F.lane == 0 && mp > 0.f) atomicMax(&wm[CW_WMAXP - CW_WMAX + l], __float_as_uint(mp)); }
}
__device__ __forceinline__ void conv_rows(const Frame& F, const float* src, bf16_t* dst, size_t n8) {
    for (size_t i = (size_t)F.bid * 512 + F.tid; i < n8; i += (size_t)F.G * 512) { const f32x4 a = *(const f32x4*)(src + i * 8), b = *(const f32x4*)(src + i * 8 + 4); pg8::st_bf16x8(dst + i * 8, a, b); }
}
__device__ __forceinline__ void quant_rows(const Frame& F, const float* src, bf16_t* xb, unsigned char* xq, float* xsc) {
    const int lane = F.lane;
    for (int tok = F.bid * 8 + F.wid; tok < NTOK; tok += F.G * 8) { f32x4 v[8]; float amax = 0.f;
#pragma unroll
        for (int i = 0; i < 4; ++i) { const int c = (i * 64 + lane) * 8; v[2 * i] = *(const f32x4*)(src + (size_t)tok * DM + c); v[2 * i + 1] = *(const f32x4*)(src + (size_t)tok * DM + c + 4);
            pg8::st_bf16x8(xb + (size_t)tok * DM + c, v[2 * i], v[2 * i + 1]);
#pragma unroll
            for (int h = 0; h < 2; ++h)
#pragma unroll
                for (int j = 0; j < 4; ++j) amax = fmaxf(amax, fabsf(v[2 * i + h][j])); }
        for (int o = 32; o > 0; o >>= 1) amax = fmaxf(amax, __shfl_xor(amax, o));
        amax = fmaxf(amax, 1e-20f); const float qi = 127.0f / amax; if (lane == 0) xsc[tok] = amax * (1.0f / 127.0f);
#pragma unroll
        for (int i = 0; i < 4; ++i) { u32x2 w;
#pragma unroll
            for (int h = 0; h < 2; ++h) { unsigned pk = 0u;
#pragma unroll
                for (int j = 0; j < 4; ++j) pk |= ((unsigned)(int)rintf(v[2 * i + h][j] * qi) & 0xffu) << (8 * j);
                w[h] = pk; }
            *(u32x2*)(xq + (size_t)tok * DM + (i * 64 + lane) * 8) = w; } }
}
__constant__ int c_so[14] = {0, 1312, 2416, 3440, 4464, 5496, 6520, 7544, 8568, 1024, 1280, 2336, 2400, 5488};
__constant__ int c_dn[14] = {0, 1024, 2048, 3072, 4096, 5120, 6144, 7168, 8192, 14336, 14592, 14624, 14688, 14704};
__constant__ int c_nc[14] = {1024, 1024, 1024, 1024, 1024, 1024, 1024, 1024, 6144, 256, 32, 64, 16, 8};
__device__ __forceinline__ void convert_layer_weights(const Frame& F0, const Params& P, int l) { const Frame F = fresh(F0);
    unsigned char* ws = F.ws; int rot = 0;
    { const float* w = F.in(2) + (size_t)l * DM * INW; bf16_t* d = (bf16_t*)(ws + W_IN);
      const float wmaxg = __uint_as_float(((const unsigned*)(ws + WS_CTL))[CW_WMAXG + l]); const float qinv = 127.0f / (1.3f * wmaxg);
#pragma unroll 1
      for (int s = 0; s < 14; ++s) {
          if (s == 1 || s >= 10) tconv(F, w + c_so[s], INW, DM, c_nc[s], d + (size_t)c_dn[s] * DM, DM, rot);
          else { const int crow = (s == 0) ? 0 : (s <= 7 ? 1024 + (s - 2) * 1024 : (s == 8 ? 7168 : 13312));
              TcMat dq{w + c_so[s], INW, DM >> 6, c_nc[s], (bf16_t*)(ws + W_IN8 + (size_t)crow * 2048), 2048, qinv}; tconv_run(F, (DM >> 6) * (c_nc[s] >> 6), dq, rot); } } }
    tconv(F, F.in(7) + (size_t)l * 1024 * DM, DM, 1024, DM, (bf16_t*)(ws + W_BRA), 3072, rot);
    tconv(F, F.in(8) + (size_t)l * 1024 * DM, DM, 1024, DM, (bf16_t*)(ws + W_BRA) + 1024, 3072, rot);
    tconv(F, F.in(9) + (size_t)l * 1024 * DM, DM, 1024, DM, (bf16_t*)(ws + W_BRA) + 2048, 3072, rot);
    tconv(F, F.in(10) + (size_t)l * DM * DM, DM, DM, DM, (bf16_t*)(ws + W_OUT), DM, rot);
    { const float wmp = __uint_as_float(((const unsigned*)(ws + WS_CTL))[CW_WMAXP + l]);
      TcMat dq{F.in(21) + (size_t)l * DM * DM, DM, DM >> 6, DM, (bf16_t*)(ws + W_PG), 2048, 127.0f / (1.3f * wmp)}; tconv_run(F, (DM >> 6) * (DM >> 6), dq, rot); }
    tconv(F, F.in(22) + (size_t)l * 256 * DM, DM, 256, DM, (bf16_t*)(ws + W_PLE), 256, rot);
#pragma unroll 1
    for (int h = 0; h < 8; ++h) tconv(F, F.in(6) + (size_t)l * 256 * 1024 + h * 128, 1024, 256, 128, (bf16_t*)(ws + W_UV2) + ((size_t)(h >> 1) * 256 + (h & 1) * 128) * 512 + (h & 1) * 256, 512, rot);
    { const float wmax = __uint_as_float(((const unsigned*)(ws + WS_CTL))[CW_WMAX + l]);
      TcExperts d{F.in(15) + (size_t)l * NEXP * DM * DEXP, F.in(17) + (size_t)l * NEXP * DM * DEXP, F.in(19) + (size_t)l * NEXP * DEXP * DM, (unsigned char*)(ws + W_GU), (bf16_t*)(ws + W_DN), 127.0f / (1.3f * wmax)};
      tconv_run(F, NEXP * 1536, d, rot); }
    { const float* w = F.in(5) + (size_t)l * 256 * 8 * 96; bf16_t* d = (bf16_t*)(ws + W_UK2);
      for (int i = F.bid * 512 + F.tid; i < 256 * 8 * 96; i += F.G * 512) { const int n = i % 96, h = (i / 96) & 7, r = i / 768; d[((size_t)h * 256 + r) * 256 + (h & 1) * 128 + 32 + n] = f2bf(w[i]); } }
}

__device__ __forceinline__ void rope_cs(float pos, float invf, float& c, float& s) {
    const float a = pos * invf; const double ad = (double)a * 0.15915494309189535; const float fr = (float)(ad - rint(ad));
    s = __builtin_amdgcn_sinf(fr); c = __builtin_amdgcn_cosf(fr);
}
__device__ __forceinline__ void phase_prep(const Frame& F0, const Params& P, int l) { const Frame F = fresh(F0);
    unsigned char* ws = F.ws; const int lane = F.lane;
    const float* smallb = (const float*)(ws + R_SMALL); bf16_t* kcat = (bf16_t*)(ws + R_KCAT); bf16_t* qcat = (bf16_t*)(ws + R_QCAT);
    bf16_t* ki = (bf16_t*)(ws + R_KI); float* wi = (float*)(ws + R_WI); float* lf = (float*)(ws + WS_LF);
    const bf16_t* qa = (const bf16_t*)(ws + R_QA); bf16_t* qidx = (bf16_t*)(ws + R_QIDX);
    const f32x4 gck = *(const f32x4*)(F.in(4) + l * 256 + lane * 4);
    const float bfo = lane < 8 ? F.in(3)[l * 8 + lane] : 0.f;
    const float ifr = c_invf_r[lane & 15], ifi = c_invf_i[lane & 7];
    for (int tok = F.bid * 8 + F.wid; tok < NTOK; tok += F.G * 8) {
        const int s = tok & (SEQ - 1), b = tok >> 13; const float* sm = smallb + (size_t)tok * 512;
        float cr, sr, ci, si; rope_cs((float)s, ifr, cr, sr); rope_cs((float)s, ifi, ci, si);
        { const f32x4 v = *(const f32x4*)(sm + lane * 4); float ss = v[0] * v[0] + v[1] * v[1] + v[2] * v[2] + v[3] * v[3]; ss = wave_sum(ss);
          const float rs = rsqrtf(ss * (1.0f / 256.0f) + 1e-6f); u32x2 w; w.x = cvtpk(v[0] * rs * gck[0], v[1] * rs * gck[1]); w.y = cvtpk(v[2] * rs * gck[2], v[3] * rs * gck[3]);
          *(u32x2*)(kcat + (size_t)tok * 288 + lane * 4) = w; }
        if (lane < 16) { const float x1 = sm[256 + lane], x2 = sm[272 + lane]; kcat[(size_t)tok * 288 + 256 + lane] = f2bf(x1 * cr - x2 * sr); kcat[(size_t)tok * 288 + 272 + lane] = f2bf(x2 * cr + x1 * sr); }
        { float o = sm[288 + lane];
          if (lane < 8) { const float x2 = sm[296 + lane]; o = o * ci - x2 * si; } else if (lane < 16) { const float x1 = sm[288 + lane - 8]; o = o * ci + x1 * si; }
          ki[(size_t)tok * 64 + lane] = f2bf(o); }
        if (lane < 16) wi[(size_t)tok * 16 + lane] = sm[352 + lane] * (1.0f / 32.0f);
        if (lane < 8) { const float f = sm[368 + lane] + bfo; lf[(size_t)(b * 8 + lane) * SEQ + s] = fminf(f, 0.f) - log1pf(__expf(-fabsf(f))); }
#pragma unroll
        for (int pp = 0; pp < 2; ++pp) { const int p = lane + 64 * pp, h = p >> 4, i = p & 15;
            const float x1 = bf2f(qa[(size_t)tok * 1024 + h * 128 + i]), x2 = bf2f(qa[(size_t)tok * 1024 + h * 128 + 16 + i]);
            qcat[(size_t)tok * 2304 + h * 288 + 256 + i] = f2bf(x1 * cr - x2 * sr); qcat[(size_t)tok * 2304 + h * 288 + 272 + i] = f2bf(x2 * cr + x1 * sr); }
#pragma unroll
        for (int pp = 0; pp < 2; ++pp) { const int p = lane + 64 * pp, hh = p >> 3, i = p & 7; bf16_t* q = qidx + (size_t)tok * 1024 + hh * 64;
            const float x1 = bf2f(q[i]), x2 = bf2f(q[8 + i]); q[i] = f2bf(x1 * ci - x2 * si); q[8 + i] = f2bf(x2 * ci + x1 * si); }
    }
    { const bf16_t* kbt = (const bf16_t*)(ws + R_QKV) + (size_t)NTOK * 1024; unsigned* kmx = (unsigned*)(ws + WS_CTL) + CW_KMAX + l * 16;
#pragma unroll 1
      for (int bh = 0; bh < 16; ++bh) { float mx = 0.f;
          for (int r0 = (F.bid * 8 + F.wid) * 4; r0 < SEQ; r0 += F.G * 32) {
              const u32x4 w = *(const u32x4*)(kbt + ((size_t)bh * SEQ + r0 + (lane >> 4)) * 128 + (lane & 15) * 8);
              float ss = bflo(w.x) * bflo(w.x) + bfhi(w.x) * bfhi(w.x) + bflo(w.y) * bflo(w.y) + bfhi(w.y) * bfhi(w.y) + bflo(w.z) * bflo(w.z) + bfhi(w.z) * bfhi(w.z) + bflo(w.w) * bflo(w.w) + bfhi(w.w) * bfhi(w.w);
              ss += __shfl_xor(ss, 1); ss += __shfl_xor(ss, 2); ss += __shfl_xor(ss, 4); ss += __shfl_xor(ss, 8); mx = fmaxf(mx, ss); }
          mx = fmaxf(mx, __shfl_xor(mx, 16)); mx = fmaxf(mx, __shfl_xor(mx, 32));
          if (lane == 0) ((float*)F.lds)[F.wid * 16 + bh] = mx; }
      __syncthreads();
      if (F.tid < 16) { float mx = 0.f;
#pragma unroll
          for (int w = 0; w < 8; ++w) mx = fmaxf(mx, ((const float*)F.lds)[w * 16 + F.tid]);
          const unsigned bits = __float_as_uint(mx);
          if (bits > __hip_atomic_load(&kmx[F.tid], __ATOMIC_RELAXED, __HIP_MEMORY_SCOPE_AGENT)) atomicMax(&kmx[F.tid], bits); }
      __syncthreads(); }
}
__device__ __forceinline__ void phase_cumsum(const Frame& F0) { const Frame F = fresh(F0);
    const int gw = F.bid * 8 + F.wid; if (gw >= 16) return;
    const float* lf = (const float*)(F.ws + WS_LF) + (size_t)gw * SEQ; float* cum = (float*)(F.ws + WS_CUM) + (size_t)gw * SEQ;
    const int lane = F.lane; double tot = 0.0;
    for (int j = 0; j < 128; ++j) tot += (double)lf[lane * 128 + j];
    double inc = tot;
    for (int o = 1; o < 64; o <<= 1) { const double n = __shfl_up(inc, o); if (lane >= o) inc += n; }
    double run = inc - tot;
    for (int j = 0; j < 128; ++j) { run += (double)lf[lane * 128 + j]; cum[lane * 128 + j] = (float)run; }
}

__device__ __forceinline__ void idx_unit(const Frame& F, int b, int pi, int half) {
    const int tid = F.tid, lane = F.lane, rho = lane & 31, hh = lane >> 5; unsigned char* ws = F.ws;
    const bf16_t* qidx = (const bf16_t*)(ws + R_QIDX); const bf16_t* ki = (const bf16_t*)(ws + R_KI) + (size_t)b * SEQ * 64; const float* wi = (const float*)(ws + R_WI);
    float* scores = (float*)(ws + R_SCORES) + (size_t)b * SEQ * SEQ;
    LAS unsigned char* kl = F.ldsl;
    const int gl = pi, gh = 127 - pi, nl = (64 * gl + 63) / 128 + 1, nh = (64 * gh + 63) / 128 + 1, tot = nl + nh;
    const int x0 = half ? tot / 2 : 0, x1 = half ? tot : tot / 2;
    bf16x8 af[4][4]; float wv[4][16]; int t0 = 0, curg = -1;
    const int r0 = tid >> 3, p0 = tid & 7;
    const unsigned d0 = (unsigned)(r0 * 128 + ((p0 ^ (r0 & 7)) << 4)), d1 = d0 + 64 * 128;
    u32x4 s0, s1;
    { const int c = x0 < nl ? x0 : x0 - nl; const bf16_t* kp = ki + (size_t)(c * 128) * 64; s0 = *(const u32x4*)(kp + (size_t)r0 * 64 + p0 * 8); s1 = *(const u32x4*)(kp + (size_t)(r0 + 64) * 64 + p0 * 8); }
    __syncthreads();
    *(LAS u32x4*)(kl + d0) = s0; *(LAS u32x4*)(kl + d1) = s1;
    __syncthreads();
    const unsigned rdo = (unsigned)(rho * 128);
#pragma unroll 1
    for (int x = x0; x < x1; ++x) {
        const int g = x < nl ? gl : gh, c = x < nl ? x : x - nl;
        if (g != curg) { curg = g; t0 = g * 64 + F.wid * 8;
#pragma unroll
            for (int mt = 0; mt < 4; ++mt) {
                const int tokA = b * SEQ + t0 + 2 * mt + ((rho >> 2) & 1), head = (rho & 3) + 4 * (rho >> 3);
#pragma unroll
                for (int kk = 0; kk < 4; ++kk) af[mt][kk] = *(const bf16x8*)(qidx + (size_t)tokA * 1024 + head * 64 + kk * 16 + 8 * hh);
                const float* wp = wi + (size_t)(b * SEQ + t0 + 2 * mt + hh) * 16;
#pragma unroll
                for (int q = 0; q < 4; ++q) { const f32x4 v = *(const f32x4*)(wp + 4 * q); wv[mt][4 * q] = v[0]; wv[mt][4 * q + 1] = v[1]; wv[mt][4 * q + 2] = v[2]; wv[mt][4 * q + 3] = v[3]; } } }
        const unsigned bo = (unsigned)((x - x0) & 1) * 16384u;
        if (x + 1 < x1) { const int cn = (x + 1) < nl ? (x + 1) : (x + 1) - nl; const bf16_t* kp = ki + (size_t)(cn * 128) * 64; s0 = *(const u32x4*)(kp + (size_t)r0 * 64 + p0 * 8); s1 = *(const u32x4*)(kp + (size_t)(r0 + 64) * 64 + p0 * 8); }
#pragma unroll
        for (int tl = 0; tl < 4; ++tl) {
            const int kb = c * 128 + tl * 32;
            if (kb <= t0 + 7) {
                bf16x8 bc[4];
#pragma unroll
                for (int kk = 0; kk < 4; ++kk) bc[kk] = *(const LAS bf16x8*)(kl + bo + tl * 4096 + rdo + (((kk * 2 + hh) ^ (rho & 7)) << 4));
                f32x16 a0 = {}, a1 = {}, a2 = {}, a3 = {};
#pragma unroll
                for (int kk = 0; kk < 4; ++kk) { a0 = __builtin_amdgcn_mfma_f32_32x32x16_bf16(af[0][kk], bc[kk], a0, 0, 0, 0); a1 = __builtin_amdgcn_mfma_f32_32x32x16_bf16(af[1][kk], bc[kk], a1, 0, 0, 0);
                                                  a2 = __builtin_amdgcn_mfma_f32_32x32x16_bf16(af[2][kk], bc[kk], a2, 0, 0, 0); a3 = __builtin_amdgcn_mfma_f32_32x32x16_bf16(af[3][kk], bc[kk], a3, 0, 0, 0); }
#define IDX_EPI(A_, mt_) do { float x_0 = 0.f, x_1 = 0.f, x_2 = 0.f, x_3 = 0.f; _Pragma("unroll") for (int r = 0; r < 16; r += 4) { \
                    x_0 = fmaf(wv[mt_][r], fmaxf(A_[r], 0.f), x_0); x_1 = fmaf(wv[mt_][r + 1], fmaxf(A_[r + 1], 0.f), x_1); x_2 = fmaf(wv[mt_][r + 2], fmaxf(A_[r + 2], 0.f), x_2); x_3 = fmaf(wv[mt_][r + 3], fmaxf(A_[r + 3], 0.f), x_3); } \
                    scores[(size_t)(t0 + 2 * (mt_) + hh) * SEQ + kb + rho] = (x_0 + x_1) + (x_2 + x_3); } while (0)
                IDX_EPI(a0, 0); IDX_EPI(a1, 1); IDX_EPI(a2, 2); IDX_EPI(a3, 3);
#undef IDX_EPI
            }
        }
        if (x + 1 < x1) { *(LAS u32x4*)(kl + (bo ^ 16384u) + d0) = s0; *(LAS u32x4*)(kl + (bo ^ 16384u) + d1) = s1; }
        __syncthreads();
    }
}
__device__ __forceinline__ void phase_idx(const Frame& F0) { const Frame F = fresh(F0);
#pragma unroll 1
    for (int it = F.bid; it < 256; it += F.G) { const int b = it >> 7, pi = (it >> 1) & 63, half = it & 1; idx_unit(F, b, pi, half); }
}

__device__ __forceinline__ unsigned sortable(float f) { const unsigned u = __float_as_uint(f); return (u & 0x80000000u) ? ~u : (u | 0x80000000u); }
__device__ __forceinline__ void topk_row(const Frame& F, int b, int t) {
    int lane = F.lane; asm volatile("" : "+v"(lane));
    const int L = t + 1, tok = b * SEQ + t; unsigned char* ws = F.ws;
    int* sel = (int*)(ws + R_SEL) + (size_t)tok * 256; int* nsel = (int*)(ws + R_NSEL);
    if (lane == 0) nsel[tok] = L < 256 ? L : 256;
    if (L <= 256) { for (int j = lane; j < 256; j += 64) sel[j] = j < L ? j : 0; return; }
    const float* row = (const float*)(ws + R_SCORES) + ((size_t)b * SEQ + t) * SEQ;
    const int nch = (L + 1023) >> 10;
#define TOPK_LOAD_ROW() do { _Pragma("unroll") for (int c = 0; c < 8; ++c) { \
        if (c < nch) { _Pragma("unroll") for (int jj = 0; jj < 4; ++jj) { const int j = c * 4 + jj; const f32x4 v = *(const f32x4*)(row + j * 256 + lane * 4); \
                _Pragma("unroll") for (int e_ = 0; e_ < 4; ++e_) { const int idx = j * 256 + lane * 4 + e_; u[j * 4 + e_] = idx < L ? sortable(v[e_]) : 0u; } } } \
        else { _Pragma("unroll") for (int q = 0; q < 16; ++q) u[c * 16 + q] = 0u; } } } while (0)
    unsigned u[128];
    TOPK_LOAD_ROW();
    unsigned g0 = 0u, g1 = 0u, g2 = 0u, g3 = 0u;
#pragma unroll
    for (int c = 0; c < 8; ++c) if (c < nch) {
#pragma unroll
        for (int jj = 0; jj < 4; ++jj) { const int j = c * 4 + jj; g0 = u[4 * j] > g0 ? u[4 * j] : g0; g1 = u[4 * j + 1] > g1 ? u[4 * j + 1] : g1; g2 = u[4 * j + 2] > g2 ? u[4 * j + 2] : g2; g3 = u[4 * j + 3] > g3 ? u[4 * j + 3] : g3; } }
    unsigned tl = g0 < g1 ? g0 : g1; { const unsigned t2 = g2 < g3 ? g2 : g3; tl = tl < t2 ? tl : t2; }
#pragma unroll
    for (int o = 32; o > 0; o >>= 1) { const unsigned x = (unsigned)__shfl_xor((int)tl, o); tl = x < tl ? x : tl; }
    constexpr int CAP = 2048;
    LAS unsigned* candk = (LAS unsigned*)(F.ldsl + F.wid * (CAP * 8)); LAS unsigned* candi = candk + CAP;
    int C = 0;
#pragma unroll
    for (int c = 0; c < 8; ++c) if (c < nch) {
#pragma unroll
        for (int q = 0; q < 16; ++q) { const int rq = c * 16 + q; const bool pr = u[rq] >= tl; const unsigned long long mm = __ballot(pr);
            const int pos = C + __popcll(mm & ((1ull << lane) - 1ull));
            if (pr && pos < CAP) { candk[pos] = u[rq]; candi[pos] = (unsigned)((rq >> 2) * 256 + lane * 4 + (rq & 3)); }
            C += __popcll(mm); if ((q & 3) == 3) SBAR(); } }
    if (C <= CAP) {
        const int ng = (C + 255) >> 8;
        unsigned ck[32]; int ci[32];
#pragma unroll
        for (int g = 0; g < 8; ++g) {
#pragma unroll
            for (int q = 0; q < 4; ++q) { const int r = g * 4 + q, p = r * 64 + lane; ck[r] = 0u; ci[r] = 0;
                if (g < ng && p < C) { ck[r] = candk[p]; ci[r] = (int)candi[p]; } } }
        unsigned T = 0u, thr_gt = 0u; int need_eq = 0; bool early = false;
        for (int bit = 31; bit >= 0; --bit) {
            const unsigned cnd = T | (1u << bit); int cnt = 0;
#pragma unroll
            for (int g = 0; g < 8; ++g) if (g < ng) {
#pragma unroll
                for (int q = 0; q < 4; ++q) cnt += __popcll(__ballot(ck[g * 4 + q] >= cnd)); }
            if (cnt >= 256) { T = cnd; if (cnt == 256) { early = true; break; } }
        }
        if (early) { thr_gt = T - 1u; need_eq = 0; }
        else { int gtc = 0;
#pragma unroll
            for (int g = 0; g < 8; ++g) if (g < ng) {
#pragma unroll
                for (int q = 0; q < 4; ++q) gtc += __popcll(__ballot(ck[g * 4 + q] > T)); }
            thr_gt = T; need_eq = 256 - gtc; }
        int base = 0, eq_taken = 0;
#pragma unroll
        for (int g = 0; g < 8; ++g) if (g < ng) {
#pragma unroll
            for (int q = 0; q < 4; ++q) { const int r = g * 4 + q; const unsigned v = ck[r];
                const bool iseq = (v == thr_gt) && (need_eq > 0);
                const unsigned long long meq = __ballot(iseq);
                const int eqr = __popcll(meq & ((1ull << lane) - 1ull));
                const bool take = (v > thr_gt) || (iseq && (eq_taken + eqr < need_eq));
                const unsigned long long mt = __ballot(take);
                const int pos = base + __popcll(mt & ((1ull << lane) - 1ull));
                if (take && pos < 256) sel[pos] = ci[r];
                base += __popcll(mt); eq_taken += __popcll(meq); } }
        return;
    }
    asm volatile("" ::: "memory");
    TOPK_LOAD_ROW();
    unsigned T = 0u, thr_gt = 0u; int need_eq = 0; bool early = false;
    for (int bit = 31; bit >= 0; --bit) {
        const unsigned cand = T | (1u << bit); int cnt = 0;
#pragma unroll
        for (int c = 0; c < 8; ++c) if (c < nch) {
#pragma unroll
            for (int q = 0; q < 16; ++q) cnt += __popcll(__ballot(u[c * 16 + q] >= cand)); }
        if (cnt >= 256) { T = cand; if (cnt == 256) { early = true; break; } }
    }
    if (early) { thr_gt = T - 1u; need_eq = 0; }
    else { int gtc = 0;
#pragma unroll
        for (int c = 0; c < 8; ++c) if (c < nch) {
#pragma unroll
            for (int q = 0; q < 16; ++q) gtc += __popcll(__ballot(u[c * 16 + q] > T)); }
        thr_gt = T; need_eq = 256 - gtc; }
    int base = 0, eq_taken = 0;
#pragma unroll
    for (int c = 0; c < 8; ++c) if (c < nch) {
#pragma unroll
        for (int q = 0; q < 16; ++q) { const int rq = c * 16 + q; const unsigned v = u[rq];
            const bool iseq = (v == thr_gt) && (need_eq > 0);
            const unsigned long long meq = __ballot(iseq);
            const int eqr = __popcll(meq & ((1ull << lane) - 1ull));
            const bool take = (v > thr_gt) || (iseq && (eq_taken + eqr < need_eq));
            const unsigned long long mt = __ballot(take);
            const int pos = base + __popcll(mt & ((1ull << lane) - 1ull));
            if (take && pos < 256) sel[pos] = (rq >> 2) * 256 + lane * 4 + (rq & 3);
            base += __popcll(mt); eq_taken += __popcll(meq); } }
}
__device__ __forceinline__ void phase_topk(const Frame& F0) { const Frame F = fresh(F0);
    for (int q = F.bid * 8 + F.wid; q < 8192; q += F.G * 8) { const int b = q >> 12, p = q & 4095; topk_row(F, b, p); topk_row(F, b, SEQ - 1 - p); }
}

namespace att {
constexpr int D = 128, KVBLK = 64, QBLK = 32, SHM_V = 16384, SHM_K = 16384;
constexpr int OFF_K = 2 * SHM_V, OFF_BIAS = 2 * SHM_V + 2 * SHM_K, OFF_WS = OFF_BIAS + 512, OFF_FLAGS = OFF_WS + 2048, OFF_QITEM = OFF_FLAGS + 64;
constexpr float EXIT_T = 44.0f;
#define KSWZ(row, colB) ((row) * 256 + ((colB) ^ (((row) & 7) << 4)))
__device__ __forceinline__ int v_st(int k, int c) { const int kk = (k & ~0xC) | ((k & 4) << 1) | ((k & 8) >> 1); return ((kk >> 3) * 4 + (c >> 5)) * 512 + ((kk & 7) * 32 + (c & 31)) * 2; }
__device__ __forceinline__ int v_rd_base(int lane) { return ((lane & 3) << 3) | (((lane >> 2) & 3) << 6) | (((lane >> 4) & 1) << 5) | (((lane >> 5) & 1) << 8); }
constexpr int v_rd_off(int d0, int ks, int half) { return d0 * 512 + ks * 4096 + half * 2048; }
template <int KB>
__device__ __forceinline__ void qkt(f32x16& p0, f32x16& p1, const char* K_lds, int r32, int hi, const bf16x8* qr) {
    p0 = f32x16{}; p1 = f32x16{};
    const char* kb[4];
#pragma unroll
    for (int dd = 0; dd < 4; ++dd) kb[dd] = K_lds + KB * SHM_K + KSWZ(r32, (dd * 16 + hi * 8) * 2);
#pragma unroll
    for (int d0 = 0; d0 < 8; ++d0) { const char* a = kb[d0 & 3] + (d0 >> 2) * 128;
        bf16x8 b0 = *reinterpret_cast<const bf16x8*>(a);
        bf16x8 b1 = *reinterpret_cast<const bf16x8*>(a + 32 * 256);
        p0 = __builtin_amdgcn_mfma_f32_32x32x16_bf16(b0, qr[d0], p0, 0, 0, 0);
        p1 = __builtin_amdgcn_mfma_f32_32x32x16_bf16(b1, qr[d0], p1, 0, 0, 0); }
}
template <int VB>
__device__ __forceinline__ void pv_tile(f32x16* o, int vb0, bf16x8 pa0, bf16x8 pa1, bf16x8 pa2, bf16x8 pa3) {
#define TRRD(dst, off) asm volatile("ds_read_b64_tr_b16 %0, %1 offset:%2" : "=&v"(dst) : "v"(vb0), "i"(off) : "memory")
#define PV_D0(d0) do { s16x4 l0, l1, l2, l3, h0, h1, h2, h3; constexpr int b_ = VB * SHM_V + v_rd_off(d0, 0, 0); \
        TRRD(l0, b_); TRRD(h0, b_ + 2048); TRRD(l1, b_ + 4096); TRRD(h1, b_ + 6144); TRRD(l2, b_ + 8192); TRRD(h2, b_ + 10240); TRRD(l3, b_ + 12288); TRRD(h3, b_ + 14336); \
        asm volatile("s_waitcnt lgkmcnt(0)" ::: "memory"); SBAR(); \
        o[d0] = __builtin_amdgcn_mfma_f32_32x32x16_bf16(pa0, (bf16x8){l0[0], l0[1], l0[2], l0[3], h0[0], h0[1], h0[2], h0[3]}, o[d0], 0, 0, 0); \
        o[d0] = __builtin_amdgcn_mfma_f32_32x32x16_bf16(pa1, (bf16x8){l1[0], l1[1], l1[2], l1[3], h1[0], h1[1], h1[2], h1[3]}, o[d0], 0, 0, 0); \
        o[d0] = __builtin_amdgcn_mfma_f32_32x32x16_bf16(pa2, (bf16x8){l2[0], l2[1], l2[2], l2[3], h2[0], h2[1], h2[2], h2[3]}, o[d0], 0, 0, 0); \
        o[d0] = __builtin_amdgcn_mfma_f32_32x32x16_bf16(pa3, (bf16x8){l3[0], l3[1], l3[2], l3[3], h3[0], h3[1], h3[2], h3[3]}, o[d0], 0, 0, 0); } while (0)
    PV_D0(0); PV_D0(1); PV_D0(2); PV_D0(3);
#undef PV_D0
#undef TRRD
}
#define PK4(P, B_, OUT) do { unsigned a0 = cvtpk(P[B_+0], P[B_+1]), a1 = cvtpk(P[B_+2], P[B_+3]); \
        unsigned b0 = cvtpk(P[B_+4], P[B_+5]), b1 = cvtpk(P[B_+6], P[B_+7]); \
        auto r0 = __builtin_amdgcn_permlane32_swap(a0, b0, false, false); auto r1 = __builtin_amdgcn_permlane32_swap(a1, b1, false, false); \
        u32x4 w = {r0[0], r1[0], r0[1], r1[1]}; OUT = *reinterpret_cast<bf16x8*>(&w); } while (0)
__device__ __forceinline__ float swap_max(float x) { auto rr = __builtin_amdgcn_permlane32_swap(__float_as_uint(x), __float_as_uint(x), false, false); return fmaxf(__uint_as_float(rr[0]), __uint_as_float(rr[1])); }
__device__ __forceinline__ float swap_sum(float x) { auto rr = __builtin_amdgcn_permlane32_swap(__float_as_uint(x), __float_as_uint(x), false, false); return __uint_as_float(rr[0]) + __uint_as_float(rr[1]); }
__device__ __forceinline__ float swap_lo(float x) { auto rr = __builtin_amdgcn_permlane32_swap(__float_as_uint(x), __float_as_uint(x), false, false); return __uint_as_float(rr[0]); }


__device__ __forceinline__ void fox_sm(f32x16& p0, f32x16& p1, const float* bl, int kb_, int qlo, int qrow, int hi, int r32, float& m_reg, float& l_reg, f32x16* o, float* al_l,
                                       bf16x8& pa0, bf16x8& pa1, bf16x8& pa2, bf16x8& pa3) {
#pragma unroll
    for (int g = 0; g < 4; ++g) { const f32x4 b0v = *(const f32x4*)(bl + 8 * g + 4 * hi), b1v = *(const f32x4*)(bl + 32 + 8 * g + 4 * hi);
#pragma unroll
        for (int i = 0; i < 4; ++i) { p0[4 * g + i] = fmaf(p0[4 * g + i], C2, b0v[i]); p1[4 * g + i] = fmaf(p1[4 * g + i], C2, b1v[i]); } }
    if (kb_ + KVBLK - 1 > qlo) { const float NEG = -__builtin_inff();
#pragma unroll
        for (int r = 0; r < 16; ++r) { const int key = kb_ + crow(r, hi); if (key > qrow) p0[r] = NEG; if (key + 32 > qrow) p1[r] = NEG; } }
    float pmax = p0[0];
#pragma unroll
    for (int r = 1; r < 16; ++r) pmax = fmaxf(pmax, p0[r]);
#pragma unroll
    for (int r = 0; r < 16; ++r) pmax = fmaxf(pmax, p1[r]);
    pmax = swap_max(pmax);
    const float mn = fmaxf(m_reg, pmax), alpha = __builtin_amdgcn_exp2f(m_reg - mn); m_reg = mn;
    float ps = 0.f;
#pragma unroll
    for (int r = 0; r < 16; ++r) { p0[r] = __builtin_amdgcn_exp2f(p0[r] - mn); p1[r] = __builtin_amdgcn_exp2f(p1[r] - mn); ps += p0[r] + p1[r]; }
    ps = swap_sum(ps); l_reg = l_reg * alpha + ps;
    if (__any(alpha < 1.f)) { if (hi == 0) al_l[r32] = alpha; asm volatile("s_waitcnt lgkmcnt(0)" ::: "memory");
#pragma unroll
        for (int r = 0; r < 16; ++r) { const float a = al_l[crow(r, hi)];
#pragma unroll
            for (int d_ = 0; d_ < 4; ++d_) o[d_][r] *= a; } }
    PK4(p0, 0, pa0); PK4(p0, 8, pa1); PK4(p1, 0, pa2); PK4(p1, 8, pa3);
}
__device__ __forceinline__ void sb_half(f32x16& pz, int keybase, int qrow, int hi, float& R, const bf16x8* triA, bool needmask) {
    f32x16 X;
#pragma unroll
    for (int r = 0; r < 16; ++r) { const float zz = pz[r] * C2; const bool valid = !needmask || (keybase + crow(r, hi) < qrow);
        const float l2 = fmaxf(zz, 0.f) + __builtin_amdgcn_logf(1.0f + __builtin_amdgcn_exp2f(-fabsf(zz)));
        X[r] = valid ? -l2 : 0.f; pz[r] = valid ? zz : -__builtin_inff(); }
    f32x16 Y;
#pragma unroll
    for (int r = 0; r < 16; ++r) Y[r] = R;
#pragma unroll
    for (int s = 0; s < 2; ++s) {
        const unsigned h0 = cvtpk(X[8 * s + 0], X[8 * s + 1]), h1 = cvtpk(X[8 * s + 2], X[8 * s + 3]), h2 = cvtpk(X[8 * s + 4], X[8 * s + 5]), h3 = cvtpk(X[8 * s + 6], X[8 * s + 7]);
        const unsigned l0 = cvtpk(X[8 * s + 0] - bflo(h0), X[8 * s + 1] - bfhi(h0)), l1 = cvtpk(X[8 * s + 2] - bflo(h1), X[8 * s + 3] - bfhi(h1));
        const unsigned l2 = cvtpk(X[8 * s + 4] - bflo(h2), X[8 * s + 5] - bfhi(h2)), l3 = cvtpk(X[8 * s + 6] - bflo(h3), X[8 * s + 7] - bfhi(h3));
        u32x4 wh = {h0, h1, h2, h3}, wl = {l0, l1, l2, l3};
        Y = __builtin_amdgcn_mfma_f32_32x32x16_bf16(triA[s], *reinterpret_cast<bf16x8*>(&wh), Y, 0, 0, 0);
        Y = __builtin_amdgcn_mfma_f32_32x32x16_bf16(triA[s], *reinterpret_cast<bf16x8*>(&wl), Y, 0, 0, 0); }
#pragma unroll
    for (int r = 0; r < 16; ++r) pz[r] = __builtin_amdgcn_exp2f(pz[r] + Y[r]);
    R = swap_lo(Y[0]);
}
__device__ __forceinline__ void sb_sm(f32x16& p0, f32x16& p1, int kb_, int qlo, int qrow, int hi, float& R, const bf16x8* triA, bf16x8& pa0, bf16x8& pa1, bf16x8& pa2, bf16x8& pa3) {
    const bool needmask = (kb_ + KVBLK - 1 >= qlo);
    sb_half(p1, kb_ + 32, qrow, hi, R, triA, needmask);
    sb_half(p0, kb_, qrow, hi, R, triA, needmask);
    PK4(p0, 0, pa0); PK4(p0, 8, pa1); PK4(p1, 0, pa2); PK4(p1, 8, pa3);
}

template <int MODE>
__device__ __forceinline__ void attn_unit(const bf16_t* Q, const bf16_t* Kh, const bf16_t* Vh, const float* cum, bf16_t* O, int P0, char* lds, float kmaxc) {
    int tid = threadIdx.x; asm volatile("" : "+v"(tid));
    const int wid = __builtin_amdgcn_readfirstlane(tid >> 6), lane = tid & 63, r32 = lane & 31, hi = lane >> 5;
    const int NT = P0 / KVBLK + 4;
    char* V_lds = lds; char* K_lds = lds + OFF_K; float* bias_l = (float*)(lds + OFF_BIAS);
    float* wsl = (float*)(lds + OFF_WS) + wid * 64; float* li_l = wsl; float* al_l = wsl + 32;
    const int qlo = P0 + wid * QBLK, qrow = qlo + r32;
    bf16x8 qr[8];
#pragma unroll
    for (int d0 = 0; d0 < 8; ++d0) qr[d0] = *(const bf16x8*)(Q + (size_t)qrow * D + d0 * 16 + hi * 8);
    const int sr = tid >> 4, sc = (tid & 15) * 8, vst0 = v_st(sr, sc), vst1 = v_st(32 + sr, sc), kws = KSWZ(sr, sc * 2);
    const int vb0 = (int)(uintptr_t)V_lds + v_rd_base(lane);
    const float cumref = (MODE == 0) ? cum[P0] : 0.f;
    int* flg = (int*)(lds + OFF_FLAGS);
    float qn = 0.f;
    if (MODE == 0) { float ss = 0.f;
#pragma unroll
        for (int d0 = 0; d0 < 8; ++d0)
#pragma unroll
            for (int j = 0; j < 8; ++j) { const float x = bf2f((bf16_t)qr[d0][j]); ss = fmaf(x, x, ss); }
        ss = swap_sum(ss); qn = sqrtf(ss) * kmaxc * 1.001f; }
    float m_reg = -1e30f, l_reg = 0.f, R = 0.f; f32x16 o[4] = {};
    bf16x8 triA[2];
    if (MODE == 1) {
#pragma unroll
        for (int s = 0; s < 2; ++s)
#pragma unroll
            for (int j = 0; j < 8; ++j) { const int rho = 16 * s + 8 * (j >> 2) + 4 * hi + (j & 3); triA[s][j] = (rho >= r32) ? (short)0x3F80 : (short)0; }
    }
    bf16x8 st_k0, st_k1, st_v0, st_v1; float st_b = 0.f;
#define TILE_KB(t) ((NT - 1 - (t)) * KVBLK)
#define SLOAD(kb_) do { st_v0 = *(const bf16x8*)(Vh + (size_t)((kb_) + sr) * D + sc); st_v1 = *(const bf16x8*)(Vh + (size_t)((kb_) + 32 + sr) * D + sc); \
                        st_k0 = *(const bf16x8*)(Kh + (size_t)((kb_) + sr) * D + sc); st_k1 = *(const bf16x8*)(Kh + (size_t)((kb_) + 32 + sr) * D + sc); \
                        if (MODE == 0 && tid < 64) st_b = (cumref - cum[(kb_) + tid]) * LOG2E; } while (0)
#define SWRITE(bf) do { *(bf16x8*)(V_lds + (bf) * SHM_V + vst0) = st_v0; *(bf16x8*)(V_lds + (bf) * SHM_V + vst1) = st_v1; \
                        *(bf16x8*)(K_lds + (bf) * SHM_K + kws) = st_k0; *(bf16x8*)(K_lds + (bf) * SHM_K + kws + 32 * 256) = st_k1; \
                        if (MODE == 0 && tid < 64) bias_l[(bf) * 64 + tid] = st_b; } while (0)
    __syncthreads();
    SLOAD(TILE_KB(0)); SWRITE(0);
    __syncthreads();
    f32x16 p0, p1; bf16x8 pa0, pa1, pa2, pa3;
#define STEP(BUF, t) do { const int kb_ = TILE_KB(t); \
        if ((t) + 1 < NT) SLOAD(TILE_KB((t) + 1)); \
        SBAR(); qkt<BUF>(p0, p1, K_lds, r32, hi, qr); \
        if (MODE == 0) fox_sm(p0, p1, bias_l + (BUF) * 64, kb_, qlo, qrow, hi, r32, m_reg, l_reg, o, al_l, pa0, pa1, pa2, pa3); \
        else sb_sm(p0, p1, kb_, qlo, qrow, hi, R, triA, pa0, pa1, pa2, pa3); \
        SBAR(); pv_tile<BUF>(o, vb0, pa0, pa1, pa2, pa3); \
        if ((t) + 1 < NT) SWRITE((BUF) ^ 1); \
        __syncthreads(); } while (0)
    for (int t = 0; t < NT; t += 2) {
        STEP(0, t); STEP(1, t + 1);
        const int kbc = TILE_KB(t + 1); if (kbc == 0) break;
        bool done;
        if (MODE == 0) { const float edge = (cumref - cum[kbc - 1]) * LOG2E; done = (qn + edge - m_reg) < -EXIT_T; }
        else done = R < -EXIT_T;
        const int par = (t >> 1) & 1;
        if (lane == 0) flg[par * 8 + wid] = 0;
        const bool wdone = __all(done);
        if (lane == 0 && wdone) flg[par * 8 + wid] = 1;
        __syncthreads();
        int alld = 1;
#pragma unroll
        for (int w = 0; w < 8; ++w) alld &= flg[par * 8 + w];
        if (alld) break;
    }
    __syncthreads();
#undef STEP
#undef SLOAD
#undef SWRITE
#undef TILE_KB
    float rli[16];
    if (MODE == 0) { if (hi == 0) li_l[r32] = l_reg; asm volatile("s_waitcnt lgkmcnt(0)" ::: "memory");
#pragma unroll
        for (int r = 0; r < 16; ++r) rli[r] = __builtin_amdgcn_rcpf(li_l[crow(r, hi)]); }
    bf16_t* Ow = O + (size_t)(wid * QBLK) * 3072;
#pragma unroll
    for (int r = 0; r < 16; ++r) { const int orow = crow(r, hi);
#pragma unroll
        for (int d0 = 0; d0 < 4; ++d0) { const float v = (MODE == 0) ? o[d0][r] * rli[r] : o[d0][r];
            const float vn = __shfl_xor(v, 1);
            if ((r32 & 1) == 0) *(unsigned*)(Ow + (size_t)orow * 3072 + d0 * 32 + r32) = cvtpk(v, vn); } }
}
}

__device__ __forceinline__ void sparse_query(const Frame& F, int tok, char* ldsw) {
    unsigned char* ws = F.ws; const int lane = F.lane, g = lane >> 4, i16 = lane & 15;
    const bf16_t* qcat = (const bf16_t*)(ws + R_QCAT) + (size_t)tok * 2304; const bf16_t* kbase = (const bf16_t*)(ws + R_KCAT) + (size_t)(tok >> 13) * SEQ * 288;
    const int* sel = (const int*)(ws + R_SEL) + (size_t)tok * 256; const int ns = ((const int*)(ws + R_NSEL))[tok]; const int ntile = (ns + 31) >> 5;
    bf16x8 qf[9];
#pragma unroll
    for (int st = 0; st < 9; ++st) { qf[st] = (bf16x8){0, 0, 0, 0, 0, 0, 0, 0}; if (i16 < 8) qf[st] = *(const bf16x8*)(qcat + i16 * 288 + st * 32 + 8 * g); }
    const int rA = lane >> 2, cq = lane & 3;
    float m = -1e30f, l = 0.f; f32x4 oT[16];
#pragma unroll
    for (int rb = 0; rb < 16; ++rb) oT[rb] = (f32x4){0.f, 0.f, 0.f, 0.f};
    const unsigned ldso = (unsigned)(uintptr_t)ldsw;
    const unsigned vb = ldso + (unsigned)((4 * g + (i16 >> 2)) * 592 + (i16 & 3) * 8);
    constexpr float SC2 = SCALE * LOG2E;
    bf16x8 stg[18];
#define GATHER(tile_) do { const int j0 = (tile_) * 32 + rA, j1 = j0 + 16; const int s0 = j0 < ns ? sel[j0] : 0, s1 = j1 < ns ? sel[j1] : 0; \
        const bf16_t* p0_ = kbase + (size_t)s0 * 288 + cq * 8; const bf16_t* p1_ = kbase + (size_t)s1 * 288 + cq * 8; \
        _Pragma("unroll") for (int c = 0; c < 9; ++c) { stg[2 * c] = *(const bf16x8*)(p0_ + c * 32); stg[2 * c + 1] = *(const bf16x8*)(p1_ + c * 32); } } while (0)
    GATHER(0);
    for (int tile = 0; tile < ntile; ++tile) {
#pragma unroll
        for (int c = 0; c < 9; ++c) { *(bf16x8*)(ldsw + rA * 592 + c * 64 + cq * 16) = stg[2 * c]; *(bf16x8*)(ldsw + (16 + rA) * 592 + c * 64 + cq * 16) = stg[2 * c + 1]; }
        if (tile + 1 < ntile) GATHER(tile + 1);
        asm volatile("s_waitcnt lgkmcnt(0)" ::: "memory"); SBAR();
        f32x4 acc[2];
#pragma unroll
        for (int mt = 0; mt < 2; ++mt) { acc[mt] = (f32x4){0.f, 0.f, 0.f, 0.f};
#pragma unroll
            for (int st = 0; st < 9; ++st) { const bf16x8 a = *(const bf16x8*)(ldsw + (16 * mt + i16) * 592 + st * 64 + g * 16);
                acc[mt] = __builtin_amdgcn_mfma_f32_16x16x32_bf16(a, qf[st], acc[mt], 0, 0, 0); } }
        float tmax = -__builtin_inff();
#pragma unroll
        for (int mt = 0; mt < 2; ++mt)
#pragma unroll
            for (int r = 0; r < 4; ++r) { const int key = tile * 32 + 16 * mt + 4 * g + r; float x = acc[mt][r] * SC2; if (key >= ns) x = -__builtin_inff(); acc[mt][r] = x; tmax = fmaxf(tmax, x); }
        tmax = fmaxf(tmax, __shfl_xor(tmax, 16)); tmax = fmaxf(tmax, __shfl_xor(tmax, 32));
        const float mn = fmaxf(m, tmax), alpha = __builtin_amdgcn_exp2f(m - mn); m = mn;
        float ps = 0.f;
#pragma unroll
        for (int mt = 0; mt < 2; ++mt)
#pragma unroll
            for (int r = 0; r < 4; ++r) { acc[mt][r] = __builtin_amdgcn_exp2f(acc[mt][r] - mn); ps += acc[mt][r]; }
        ps += __shfl_xor(ps, 16); ps += __shfl_xor(ps, 32);
        l = l * alpha + ps;
#pragma unroll
        for (int rb = 0; rb < 16; ++rb) oT[rb] *= alpha;
        const bf16x8 pf = pack8(acc[0], acc[1]);
#define TRRD2(dst, off) asm volatile("ds_read_b64_tr_b16 %0, %1 offset:%2" : "=&v"(dst) : "v"(vb), "i"(off) : "memory")
#define PVRB4(rb) do { s16x4 ta0, tb0, ta1, tb1, ta2, tb2, ta3, tb3; \
        TRRD2(ta0, ((rb) + 0) * 32); TRRD2(tb0, ((rb) + 0) * 32 + 16 * 592); TRRD2(ta1, ((rb) + 1) * 32); TRRD2(tb1, ((rb) + 1) * 32 + 16 * 592); \
        TRRD2(ta2, ((rb) + 2) * 32); TRRD2(tb2, ((rb) + 2) * 32 + 16 * 592); TRRD2(ta3, ((rb) + 3) * 32); TRRD2(tb3, ((rb) + 3) * 32 + 16 * 592); \
        asm volatile("s_waitcnt lgkmcnt(0)" ::: "memory"); SBAR(); \
        oT[(rb) + 0] = __builtin_amdgcn_mfma_f32_16x16x32_bf16((bf16x8){ta0[0], ta0[1], ta0[2], ta0[3], tb0[0], tb0[1], tb0[2], tb0[3]}, pf, oT[(rb) + 0], 0, 0, 0); \
        oT[(rb) + 1] = __builtin_amdgcn_mfma_f32_16x16x32_bf16((bf16x8){ta1[0], ta1[1], ta1[2], ta1[3], tb1[0], tb1[1], tb1[2], tb1[3]}, pf, oT[(rb) + 1], 0, 0, 0); \
        oT[(rb) + 2] = __builtin_amdgcn_mfma_f32_16x16x32_bf16((bf16x8){ta2[0], ta2[1], ta2[2], ta2[3], tb2[0], tb2[1], tb2[2], tb2[3]}, pf, oT[(rb) + 2], 0, 0, 0); \
        oT[(rb) + 3] = __builtin_amdgcn_mfma_f32_16x16x32_bf16((bf16x8){ta3[0], ta3[1], ta3[2], ta3[3], tb3[0], tb3[1], tb3[2], tb3[3]}, pf, oT[(rb) + 3], 0, 0, 0); } while (0)
        PVRB4(0); PVRB4(4); PVRB4(8); PVRB4(12);
#undef PVRB4
#undef TRRD2
        SBAR();
    }
#undef GATHER
    const float rl = 1.0f / l;
    if (i16 < 8) { bf16_t* op = (bf16_t*)(ws + R_OLAT) + (size_t)tok * 2048 + i16 * 256 + 4 * g;
#pragma unroll
        for (int rb = 0; rb < 16; ++rb) { u32x2 w; w.x = cvtpk(oT[rb][0] * rl, oT[rb][1] * rl); w.y = cvtpk(oT[rb][2] * rl, oT[rb][3] * rl); *(u32x2*)(op + rb * 16) = w; } }
}
#ifdef ATT_SUB
#define ASUB(k) ((k) == ATT_SUB)
#else
#define ASUB(k) true
#endif
__device__ __forceinline__ void phase_attn(const Frame& F0, int l, int rep) { const Frame F = fresh(F0);
    unsigned char* ws = F.ws; char* lds = (char*)F.lds;
    const bf16_t* qkv = (const bf16_t*)(ws + R_QKV); const size_t TS = (size_t)NTOK * 1024;
    unsigned* qctr = (unsigned*)(ws + WS_CTL) + CW_QCTR + l * 64 + rep * 16; const unsigned* kmx = (const unsigned*)(ws + WS_CTL) + CW_KMAX + l * 16;
    int* qitem = (int*)(lds + att::OFF_QITEM);
    int* hord = qitem + 4;
    if (F.tid < 16) { const float* cumb = (const float*)(ws + WS_CUM); const float mine = -cumb[(size_t)F.tid * SEQ + SEQ - 1]; int rank = 0;
        for (int o = 0; o < 16; ++o) { const float v = -cumb[(size_t)o * SEQ + SEQ - 1]; rank += (v < mine || (v == mine && o < F.tid)) ? 1 : 0; }
        hord[rank] = F.tid; }
#pragma unroll 1
    for (;;) {
        __syncthreads();
        if (F.tid == 0) qitem[0] = (int)atomicAdd(qctr, 1u);
        __syncthreads();
        const int it = qitem[0];
        if (it >= 1024) break;
        const int md = it >> 9, j = it & 511;
        const int qb = md == 0 ? 31 - (j & 31) : 31 - (j >> 4), bh = md == 0 ? hord[j >> 5] : (j & 15), b = bh >> 3, h = bh & 7, P0 = qb * 256;
        if (!ASUB(md)) continue;
        const bf16_t* Q = qkv + (size_t)(md * 3 + 0) * TS + (size_t)bh * SEQ * 128; const bf16_t* K = qkv + (size_t)(md * 3 + 1) * TS + (size_t)bh * SEQ * 128; const bf16_t* V = qkv + (size_t)(md * 3 + 2) * TS + (size_t)bh * SEQ * 128;
        const float* cum = (const float*)(ws + WS_CUM) + (size_t)bh * SEQ;
        bf16_t* Ob = (bf16_t*)(ws + R_OA) + (size_t)b * SEQ * 3072 + (md + 1) * 1024 + h * 128;
        if (md == 0) { const float kmaxc = sqrtf(__uint_as_float(kmx[bh])) * C2; att::attn_unit<0>(Q, K, V, cum, Ob + (size_t)P0 * 3072, P0, lds, kmaxc); }
        else att::attn_unit<1>(Q, K, V, cum, Ob + (size_t)P0 * 3072, P0, lds, 0.f);
    }
    __syncthreads();
    char* ldsw = lds + F.wid * 18944;
#pragma unroll 1
    for (int rep = 0; rep < NREP(2); ++rep)
#pragma unroll 1
    for (int tok = F.bid * 8 + F.wid; tok < NTOK; tok += F.G * 8) if (ASUB(2)) sparse_query(F, tok, ldsw);
}

__device__ __forceinline__ void ln_row(const bf16_t* src, const float* g, const float* bta, float* of, bf16_t* ob, int lane, unsigned char* oq = nullptr, float* osc = nullptr, float* ost = nullptr) {
    f32x4 v[8]; float s = 0.f;
#pragma unroll
    for (int i = 0; i < 4; ++i) { const u32x4 w = *(const u32x4*)(src + (i * 64 + lane) * 8);
        v[2 * i] = (f32x4){bflo(w.x), bfhi(w.x), bflo(w.y), bfhi(w.y)}; v[2 * i + 1] = (f32x4){bflo(w.z), bfhi(w.z), bflo(w.w), bfhi(w.w)};
        s += (v[2 * i][0] + v[2 * i][1]) + (v[2 * i][2] + v[2 * i][3]) + (v[2 * i + 1][0] + v[2 * i + 1][1]) + (v[2 * i + 1][2] + v[2 * i + 1][3]); }
    s = wave_sum(s); const float mu = s * (1.0f / 2048.0f); float q = 0.f;
#pragma unroll
    for (int i = 0; i < 8; ++i) { const f32x4 d = v[i] - mu; q += (d[0] * d[0] + d[1] * d[1]) + (d[2] * d[2] + d[3] * d[3]); }
    q = wave_sum(q); const float rstd = rsqrtf(q * (1.0f / 2048.0f) + 1e-5f);
    if (ost && lane == 0) { ost[0] = mu; ost[1] = rstd; }
    float amax = 0.f;
#pragma unroll
    for (int i = 0; i < 4; ++i) { const int c = (i * 64 + lane) * 8; const f32x4 g0 = *(const f32x4*)(g + c), g1 = *(const f32x4*)(g + c + 4), b0 = *(const f32x4*)(bta + c), b1 = *(const f32x4*)(bta + c + 4);
        const f32x4 y0 = (v[2 * i] - mu) * rstd * g0 + b0, y1 = (v[2 * i + 1] - mu) * rstd * g1 + b1; v[2 * i] = y0; v[2 * i + 1] = y1;
        if (of) { *(f32x4*)(of + c) = y0; *(f32x4*)(of + c + 4) = y1; }
        if (ob) pg8::st_bf16x8(ob + c, y0, y1);
        if (oq) { amax = fmaxf(amax, fmaxf(fmaxf(fmaxf(fabsf(y0[0]), fabsf(y0[1])), fmaxf(fabsf(y0[2]), fabsf(y0[3]))), fmaxf(fmaxf(fabsf(y1[0]), fabsf(y1[1])), fmaxf(fabsf(y1[2]), fabsf(y1[3]))))); } }
    if (oq) {
        for (int o = 32; o > 0; o >>= 1) amax = fmaxf(amax, __shfl_xor(amax, o));
        amax = fmaxf(amax, 1e-20f); const float qi = 127.0f / amax; if (lane == 0) *osc = amax * (1.0f / 127.0f);
#pragma unroll
        for (int i = 0; i < 4; ++i) { u32x2 w;
#pragma unroll
            for (int h = 0; h < 2; ++h) { const f32x4 y = v[2 * i + h]; unsigned pk = 0u;
#pragma unroll
                for (int j = 0; j < 4; ++j) pk |= ((unsigned)(int)rintf(y[j] * qi) & 0xffu) << (8 * j);
                w[h] = pk; }
            *(u32x2*)(oq + (i * 64 + lane) * 8) = w; } }
}
__device__ __forceinline__ void phase_ln1_router(const Frame& F0, const Params& P, int l) { const Frame F = fresh(F0);
    unsigned char* ws = F.ws; const int lane = F.lane, wid = F.wid;
    const bf16_t* pre1 = (const bf16_t*)(ws + R_PRE1); float* x1f = (float*)(ws + M_X1F); bf16_t* x1b = (bf16_t*)(ws + M_X1B); unsigned char* x1q = (unsigned char*)(ws + M_X1Q); float* x1s = (float*)(ws + M_X1S);
    const float* g = F.in(11) + l * DM; const float* bt = F.in(12) + l * DM; const float* wr = F.in(13) + (size_t)l * DM * NEXP; const float* br = F.in(14) + l * NEXP;
    unsigned* cnt = (unsigned*)(ws + WS_CTL) + CW_CNT + l * 2048;
    int* tok_e = (int*)(ws + M_TOKE); int* tok_pos = (int*)(ws + M_TOKPOS); float* tok_w = (float*)(ws + M_TOKW);
    float* red = (float*)F.lds;
    float* lg = (float*)(F.lds + 32768); float* stats = (float*)(F.lds + 32768 + 16384);
#pragma unroll 1
    for (int blk = F.bid; blk < NTOK / 64; blk += F.G) {
        const int tok0 = blk * 64;
#pragma unroll 1
        for (int i = 0; i < 8; ++i) { const int tok = tok0 + wid * 8 + i; ln_row(pre1 + (size_t)tok * DM, g, bt, (float*)nullptr, x1b + (size_t)tok * DM, lane, x1q + (size_t)tok * DM, x1s + tok, stats + 2 * (wid * 8 + i)); }
        asm volatile("s_waitcnt vmcnt(0)" ::: "memory"); __syncthreads();
        { const int grp = wid >> 2, kq = wid & 3, i32 = lane & 31, hk = lane >> 5; f32x16 acc = {};
          const bf16_t* arow = pre1 + (size_t)(tok0 + grp * 32 + i32) * DM + kq * 512 + 4 * hk; const float* bcol = wr + (size_t)(kq * 512 + 4 * hk) * NEXP + i32;
          const float* gp = g + kq * 512 + 4 * hk; const float* bp = bt + kq * 512 + 4 * hk; const float mu = stats[2 * (grp * 32 + i32)], rstd = stats[2 * (grp * 32 + i32) + 1];
#pragma unroll 4
          for (int c8 = 0; c8 < 64; ++c8) { const u32x2 xw = *(const u32x2*)(arow + c8 * 8); const f32x4 g4 = *(const f32x4*)(gp + c8 * 8), b4 = *(const f32x4*)(bp + c8 * 8);
              const f32x4 a4 = ((f32x4){bflo(xw.x), bfhi(xw.x), bflo(xw.y), bfhi(xw.y)} - mu) * rstd * g4 + b4;
              const float b0 = bcol[(size_t)(c8 * 8 + 0) * NEXP], b1 = bcol[(size_t)(c8 * 8 + 1) * NEXP], b2 = bcol[(size_t)(c8 * 8 + 2) * NEXP], b3 = bcol[(size_t)(c8 * 8 + 3) * NEXP];
              acc = __builtin_amdgcn_mfma_f32_32x32x2f32(a4[0], b0, acc, 0, 0, 0); acc = __builtin_amdgcn_mfma_f32_32x32x2f32(a4[1], b1, acc, 0, 0, 0);
              acc = __builtin_amdgcn_mfma_f32_32x32x2f32(a4[2], b2, acc, 0, 0, 0); acc = __builtin_amdgcn_mfma_f32_32x32x2f32(a4[3], b3, acc, 0, 0, 0); }
#pragma unroll
          for (int r = 0; r < 16; ++r) red[(wid * 16 + r) * 64 + lane] = acc[r]; }
        __syncthreads();
        if ((wid & 3) == 0) { const int grp = wid >> 2, hk = lane >> 5, e = lane & 31; const float be = br[e];
#pragma unroll
            for (int r = 0; r < 16; ++r) { const float v = red[((wid + 0) * 16 + r) * 64 + lane] + red[((wid + 1) * 16 + r) * 64 + lane] + red[((wid + 2) * 16 + r) * 64 + lane] + red[((wid + 3) * 16 + r) * 64 + lane] + be;
                lg[(grp * 32 + crow(r, hk)) * 33 + e] = v; }
            asm volatile("s_waitcnt lgkmcnt(0)" ::: "memory"); SBAR();
            const int tk = lane & 31; float v[32];
#pragma unroll
            for (int e2 = 0; e2 < 32; ++e2) v[e2] = lg[(grp * 32 + tk) * 33 + e2];
            int ek[4]; float vk[4];
#pragma unroll
            for (int k = 0; k < 4; ++k) { float best = -__builtin_inff(); int bi = 0;
#pragma unroll
                for (int e2 = 0; e2 < 32; ++e2) if (v[e2] > best) { best = v[e2]; bi = e2; }
                ek[k] = bi; vk[k] = best;
#pragma unroll
                for (int e2 = 0; e2 < 32; ++e2) v[e2] = (e2 == bi) ? -__builtin_inff() : v[e2]; }
            float wk[4], sw = 0.f;
#pragma unroll
            for (int k = 0; k < 4; ++k) { wk[k] = __expf(vk[k] - vk[0]); sw += wk[k]; }
            const float rs = 1.0f / sw;
            const bool act = lane < 32; unsigned myc = 0u;
#pragma unroll 1
            for (int E = 0; E < 32; ++E) { unsigned c = 0u;
#pragma unroll
                for (int k = 0; k < 4; ++k) c += (unsigned)__popcll(__ballot(act && ek[k] == E));
                if (lane == E) myc = c; }
            unsigned run = 0u; if (lane < 32 && myc > 0u) run = atomicAdd(&cnt[lane * 64], myc);
            int pk[4];
#pragma unroll
            for (int k = 0; k < 4; ++k) { pk[k] = 0;
#pragma unroll 1
                for (int E = 0; E < 32; ++E) { const unsigned long long mm = __ballot(act && ek[k] == E); const unsigned basev = (unsigned)__shfl((int)run, E);
                    if (act && ek[k] == E) pk[k] = (int)(basev + (unsigned)__popcll(mm & ((1ull << lane) - 1ull)));
                    if (lane == E) run += (unsigned)__popcll(mm); } }
            if (act) { const int tok = tok0 + grp * 32 + tk;
#pragma unroll
                for (int k = 0; k < 4; ++k) { tok_e[tok * 4 + k] = ek[k]; tok_pos[tok * 4 + k] = pk[k]; tok_w[tok * 4 + k] = wk[k] * rs; } }
        }
        __syncthreads();
    }
}
__device__ __forceinline__ void phase_moe_gather(const Frame& F0, int l) { const Frame F = fresh(F0);
    unsigned char* ws = F.ws; const int lane = F.lane;
    const unsigned* cnt = (const unsigned*)(ws + WS_CTL) + CW_CNT + l * 2048; unsigned* meta = (unsigned*)(ws + WS_CTL) + CW_META + l * 512;
    unsigned* offs = (unsigned*)(F.lds + LDS_MISC + 64);
    if (F.tid == 0) { unsigned o = 0u; for (int e = 0; e < 32; ++e) { offs[e] = o; o += (cnt[e * 64] + 255u) & ~255u; } offs[32] = o;
        if (F.bid == 0) { meta[0] = o >> 8; for (int e = 0; e < 32; ++e) for (unsigned t = offs[e] >> 8; t < (offs[e + 1] >> 8); ++t) meta[1 + t] = (unsigned)e; } }
    __syncthreads();
    const int* tok_e = (const int*)(ws + M_TOKE); const int* tok_pos = (const int*)(ws + M_TOKPOS); const float* tok_w = (const float*)(ws + M_TOKW);
    int* tok_dst = (int*)(ws + M_TOKDST); float* roww = (float*)(ws + M_ROWW);
    const unsigned char* x1q = (const unsigned char*)(ws + M_X1Q); const float* x1s = (const float*)(ws + M_X1S); unsigned char* xs = (unsigned char*)(ws + M_XS); float* rowsx = (float*)(ws + M_ROWSX);
    for (int it = F.bid * 8 + F.wid; it < NTOK * 4; it += F.G * 8) { const int tok = it >> 2;
        const int e = tok_e[it]; const unsigned dst = offs[e] + (unsigned)tok_pos[it];
        if (lane == 0) { tok_dst[it] = (int)dst; roww[dst] = tok_w[it]; rowsx[dst] = x1s[tok]; }
        const u32x4* sp = (const u32x4*)(x1q + (size_t)tok * DM); u32x4* dp = (u32x4*)(xs + (size_t)dst * DM);
#pragma unroll
        for (int i = 0; i < 2; ++i) dp[i * 64 + lane] = sp[i * 64 + lane]; }
    __syncthreads();
}
__device__ __forceinline__ void phase_combine(const Frame& F0) { const Frame F = fresh(F0);
    unsigned char* ws = F.ws; const int lane = F.lane;
    const bf16_t* x1b = (const bf16_t*)(ws + M_X1B); const bf16_t* ys = (const bf16_t*)(ws + M_XS); const int* tok_dst = (const int*)(ws + M_TOKDST);
    bf16_t* hb = (bf16_t*)(ws + M_HB); unsigned char* hq = (unsigned char*)(ws + M_HQ); float* hsc = (float*)(ws + M_HSC);
    for (int tok = F.bid * 8 + F.wid; tok < NTOK; tok += F.G * 8) {
        const int d0 = tok_dst[tok * 4], d1 = tok_dst[tok * 4 + 1], d2 = tok_dst[tok * 4 + 2], d3 = tok_dst[tok * 4 + 3];
        f32x4 hv[8]; float amax = 0.f;
#pragma unroll
        for (int i = 0; i < 4; ++i) { const int c = (i * 64 + lane) * 8; const size_t o = (size_t)tok * DM + c;
            const u32x4 xw = *(const u32x4*)(x1b + o);
            f32x4 a = (f32x4){bflo(xw.x), bfhi(xw.x), bflo(xw.y), bfhi(xw.y)} * ALPHA, b = (f32x4){bflo(xw.z), bfhi(xw.z), bflo(xw.w), bfhi(xw.w)} * ALPHA;
            const u32x4 y0 = *(const u32x4*)(ys + (size_t)d0 * DM + c), y1 = *(const u32x4*)(ys + (size_t)d1 * DM + c), y2 = *(const u32x4*)(ys + (size_t)d2 * DM + c), y3 = *(const u32x4*)(ys + (size_t)d3 * DM + c);
            a[0] += (bflo(y0.x) + bflo(y1.x)) + (bflo(y2.x) + bflo(y3.x)); a[1] += (bfhi(y0.x) + bfhi(y1.x)) + (bfhi(y2.x) + bfhi(y3.x));
            a[2] += (bflo(y0.y) + bflo(y1.y)) + (bflo(y2.y) + bflo(y3.y)); a[3] += (bfhi(y0.y) + bfhi(y1.y)) + (bfhi(y2.y) + bfhi(y3.y));
            b[0] += (bflo(y0.z) + bflo(y1.z)) + (bflo(y2.z) + bflo(y3.z)); b[1] += (bfhi(y0.z) + bfhi(y1.z)) + (bfhi(y2.z) + bfhi(y3.z));
            b[2] += (bflo(y0.w) + bflo(y1.w)) + (bflo(y2.w) + bflo(y3.w)); b[3] += (bfhi(y0.w) + bfhi(y1.w)) + (bfhi(y2.w) + bfhi(y3.w));
            pg8::st_bf16x8(hb + o, a, b); hv[2 * i] = a; hv[2 * i + 1] = b;
#pragma unroll
            for (int j = 0; j < 4; ++j) amax = fmaxf(amax, fmaxf(fabsf(a[j]), fabsf(b[j]))); }
        for (int o = 32; o > 0; o >>= 1) amax = fmaxf(amax, __shfl_xor(amax, o));
        amax = fmaxf(amax, 1e-20f); const float qi = 127.0f / amax; if (lane == 0) hsc[tok] = amax * (1.0f / 127.0f);
#pragma unroll
        for (int i = 0; i < 4; ++i) { u32x2 w;
#pragma unroll
            for (int h = 0; h < 2; ++h) { unsigned pk = 0u;
#pragma unroll
                for (int j = 0; j < 4; ++j) pk |= ((unsigned)(int)rintf(hv[2 * i + h][j] * qi) & 0xffu) << (8 * j);
                w[h] = pk; }
            *(u32x2*)(hq + (size_t)tok * DM + (i * 64 + lane) * 8) = w; } }
}
__device__ __forceinline__ void phase_ln2(const Frame& F0, const Params& P, int l) { const Frame F = fresh(F0);
    unsigned char* ws = F.ws; const bf16_t* pre2 = (const bf16_t*)(ws + M_X1F); bf16_t* xb = (bf16_t*)(ws + WS_XB);
    const float* g = F.in(23) + l * DM; const float* bt = F.in(24) + l * DM; float* outp = F.out();
    for (int tok = F.bid * 8 + F.wid; tok < NTOK; tok += F.G * 8) ln_row(pre2 + (size_t)tok * DM, g, bt, (l + 1 == NLAYER) ? outp + (size_t)tok * DM : (float*)nullptr, (l + 1 == NLAYER) ? (bf16_t*)nullptr : xb + (size_t)tok * DM, F.lane,
                                                                          (l + 1 == NLAYER) ? (unsigned char*)nullptr : (unsigned char*)(ws + WS_XQ) + (size_t)tok * DM, (l + 1 == NLAYER) ? (float*)nullptr : (float*)(ws + WS_XSC) + tok);
}

constexpr int NPHASE = 2 + 15 * NLAYER;
#ifdef PH_ONLY
#define PEN(kind) ((kind) == PH_ONLY)
#else
#define PEN(kind) true
#endif
#define IN(k) (lo <= (k) && (k) < hi)
#define SEAM(k) do { if (IN((k) + 1)) xcd_barrier(bar); } while (0)

template <int l>
__device__ __forceinline__ void layer_phases(const Frame& F, const Params& P, const XcdBarrier& bar, const int lo, const int hi, unsigned char* ws0) {
    using namespace pg8;

        const int pb = 2 + 15 * l;
        if (IN(pb + 0) && PEN(0)) { size_t wz = 0; asm volatile("" : "+s"(wz)); unsigned char* ws = ws0 + wz;
            { SchedS S; S.init(NTOK, 5 * 256, F.G, F.bid, (const bf16_t*)(ws + WS_XB), DM, (const bf16_t*)(ws + W_IN), DM); S.skip_from = 0; S.skip_by = 4; S.skip_from2 = 4; S.skip_by2 = 49;
              EpiInProj<false> E{(bf16_t*)(ws + R_QA), (bf16_t*)(ws + R_QIDX), (bf16_t*)(ws + R_QKV), (bf16_t*)(ws + R_GATES), (float*)(ws + R_SMALL), nullptr, nullptr};
              for (int rep = 0; rep < NREP(5); ++rep) gemm_phase(F.ldsl, DM, DM, DM, S, E); }
            { SchedS S; S.init(NTOK, 53 * 256, F.G, (F.bid + F.G / 2) % F.G, (const bf16_t*)(ws + WS_XQ), DM / 2, (const bf16_t*)(ws + W_IN8), DM / 2); S.skip_from = 4; S.skip_by = 4; S.b_compact = 1;
              EpiInProj<true> E{(bf16_t*)(ws + R_QA), (bf16_t*)(ws + R_QIDX), (bf16_t*)(ws + R_QKV), (bf16_t*)(ws + R_GATES), (float*)(ws + R_SMALL), (const float*)(ws + WS_XSC), (const unsigned*)(ws + WS_CTL) + CW_WMAXG + l};
              for (int rep = 0; rep < NREP(5); ++rep) gemm_phase(F.ldsl, DM / 2, DM / 2, DM / 2, S, E); }
            SEAM(pb + 0); }
        if (IN(pb + 1) && PEN(1)) { size_t wz = 0; asm volatile("" : "+s"(wz)); unsigned char* ws = ws0 + wz;
            phase_prep(F, P, l);
            SchedS S; S.init(NTOK, 2048, F.G, F.bid, (const bf16_t*)(ws + R_QA), 1024, (const bf16_t*)(ws + W_UK2), 256, 1, 256);
            EpiBf16 E{(bf16_t*)(ws + R_QCAT), 2304, 288};
            for (int rep = 0; rep < NREP(10); ++rep) gemm_phase(F.ldsl, 256, 1024, 256, S, E); SEAM(pb + 1); }
        if (IN(pb + 2) && PEN(2)) { size_t wz = 0; asm volatile("" : "+s"(wz)); unsigned char* ws = ws0 + wz; phase_cumsum(F); for (int rep = 0; rep < NREP(3); ++rep) phase_idx(F); SEAM(pb + 2); }
        if (IN(pb + 3) && PEN(3)) { size_t wz = 0; asm volatile("" : "+s"(wz)); unsigned char* ws = ws0 + wz; for (int rep = 0; rep < NREP(4); ++rep) phase_topk(F); SEAM(pb + 3); }
        if (IN(pb + 4) && PEN(4)) { size_t wz = 0; asm volatile("" : "+s"(wz)); unsigned char* ws = ws0 + wz; for (int rep = 0; rep < NREP(1); ++rep) phase_attn(F, l, rep); SEAM(pb + 4); }
        if (IN(pb + 5) && PEN(5)) { size_t wz = 0; asm volatile("" : "+s"(wz)); unsigned char* ws = ws0 + wz;
            SchedS S; S.init(NTOK, 1024, F.G, F.bid, (const bf16_t*)(ws + R_OLAT), 2048, (const bf16_t*)(ws + W_UV2), 512, 0, 512);
            EpiBf16 E{(bf16_t*)(ws + R_OA), 3072, 256}; for (int rep = 0; rep < NREP(10); ++rep) gemm_phase(F.ldsl, 512, 2048, 512, S, E);
            SEAM(pb + 5); }
        if (IN(pb + 6) && PEN(6)) { size_t wz = 0; asm volatile("" : "+s"(wz)); unsigned char* ws = ws0 + wz;
            SchedS S; S.init(NTOK, 2048, F.G, F.bid, (const bf16_t*)(ws + R_OA), 3072, (const bf16_t*)(ws + W_BRA), 3072);
            EpiBranch3 E{(const bf16_t*)(ws + R_GATES), (bf16_t*)(ws + R_MERGED)}; for (int rep = 0; rep < NREP(11); ++rep) gemm_phase(F.ldsl, 3072, 3072, 3072, S, E); SEAM(pb + 6); }
        if (IN(pb + 7) && PEN(7)) { size_t wz = 0; asm volatile("" : "+s"(wz)); unsigned char* ws = ws0 + wz;
            SchedS S; S.init(NTOK, 2048, F.G, F.bid, (const bf16_t*)(ws + R_MERGED), DM, (const bf16_t*)(ws + W_OUT), DM);
            EpiOut E{(const bf16_t*)(ws + WS_XB), (bf16_t*)(ws + R_PRE1)}; for (int rep = 0; rep < NREP(8); ++rep) gemm_phase(F.ldsl, DM, DM, DM, S, E); SEAM(pb + 7); }
        if (IN(pb + 8) && PEN(8)) { size_t wz = 0; asm volatile("" : "+s"(wz)); unsigned char* ws = ws0 + wz; phase_ln1_router(F, P, l); SEAM(pb + 8); }
        if (IN(pb + 9) && PEN(9)) { size_t wz = 0; asm volatile("" : "+s"(wz)); unsigned char* ws = ws0 + wz;
            for (int rep = 0; rep < NREP(12); ++rep) phase_moe_gather(F, l);
            SchedS S; S.init(NTOK, 2048, F.G, F.bid, (const bf16_t*)(ws + WS_PB) + (size_t)l * NTOK * 256, 256, (const bf16_t*)(ws + W_PLE), 256);
            EpiBf16 E{(bf16_t*)(ws + M_PP), 2048, 256}; for (int rep = 0; rep < NREP(10); ++rep) gemm_phase(F.ldsl, 256, 256, 256, S, E); SEAM(pb + 9); }
        if (IN(pb + 10) && PEN(10)) { size_t wz = 0; asm volatile("" : "+s"(wz)); unsigned char* ws = ws0 + wz;
            SchedM S; S.init((const unsigned*)(ws + WS_CTL) + CW_META + l * 512, F.G, F.bid, (const bf16_t*)(ws + M_XS), DM / 2, (const bf16_t*)(ws + W_GU), DM / 2);
            EpiGateUpI8 E{F.in(16) + (size_t)l * NEXP * DEXP, F.in(18) + (size_t)l * NEXP * DEXP, (bf16_t*)(ws + M_HID), (const float*)(ws + M_ROWSX), (const unsigned*)(ws + WS_CTL) + CW_WMAX + l};
            for (int rep = 0; rep < NREP(6); ++rep) gemm_phase(F.ldsl, DM / 2, DM / 2, DM / 2, S, E); SEAM(pb + 10); }
        if (IN(pb + 11) && PEN(11)) { size_t wz = 0; asm volatile("" : "+s"(wz)); unsigned char* ws = ws0 + wz;
            SchedM S; S.init((const unsigned*)(ws + WS_CTL) + CW_META + l * 512, F.G, F.bid, (const bf16_t*)(ws + M_HID), DEXP, (const bf16_t*)(ws + W_DN), DEXP);
            EpiDown E{F.in(20) + (size_t)l * NEXP * DM, (const float*)(ws + M_ROWW), (bf16_t*)(ws + M_XS)}; for (int rep = 0; rep < NREP(7); ++rep) gemm_phase(F.ldsl, DEXP, DEXP, DEXP, S, E); SEAM(pb + 11); }
        if (IN(pb + 12) && PEN(12)) { size_t wz = 0; asm volatile("" : "+s"(wz)); unsigned char* ws = ws0 + wz; for (int rep = 0; rep < NREP(9); ++rep) phase_combine(F); SEAM(pb + 12); }
        if (IN(pb + 13) && PEN(13)) { size_t wz = 0; asm volatile("" : "+s"(wz)); unsigned char* ws = ws0 + wz;
            SchedS S; S.init(NTOK, 2048, F.G, F.bid, (const bf16_t*)(ws + M_HQ), DM / 2, (const bf16_t*)(ws + W_PG), DM / 2);
            EpiPleGateI8 E{(const bf16_t*)(ws + M_HB), (const bf16_t*)(ws + M_PP), (bf16_t*)(ws + M_X1F), (const float*)(ws + M_HSC), (const unsigned*)(ws + WS_CTL) + CW_WMAXP + l};
            for (int rep = 0; rep < NREP(8); ++rep) gemm_phase(F.ldsl, DM / 2, DM / 2, DM / 2, S, E); SEAM(pb + 13); }
        if (IN(pb + 14) && PEN(14)) { size_t wz = 0; asm volatile("" : "+s"(wz)); unsigned char* ws = ws0 + wz; for (int rep = 0; rep < NREP(13); ++rep) phase_ln2(F, P, l); if (l + 1 < NLAYER) for (int rep = 0; rep < NREP(0); ++rep) convert_layer_weights(F, P, l + 1); SEAM(pb + 14); }
}
__global__ void __launch_bounds__(512, 2) fwd(Params P) {
    extern __shared__ __attribute__((aligned(16))) unsigned char lds[];
    Frame F; F.lds = lds; F.ldsl = (LAS unsigned char*)lds; F.ws = P.ws; F.tid = threadIdx.x; F.lane = F.tid & 63; F.wid = __builtin_amdgcn_readfirstlane(F.tid >> 6); F.G = gridDim.x; F.bid = blockIdx.x;
    unsigned char* ws0 = P.ws; unsigned char* ws = ws0;
    const bool fused = (P.ph_hi - P.ph_lo) > 1;
    if (F.tid < 4) ((LAS unsigned*)(F.ldsl + LDS_MISC))[F.tid] = 0u;
    if (F.tid == 0) { LAS unsigned long long* t = (LAS unsigned long long*)(F.ldsl + LDS_PTRS);
#pragma unroll
        for (int k = 0; k < 25; ++k) t[k] = (unsigned long long)P.in[k];
        t[25] = (unsigned long long)P.out; }
    __syncthreads();
    XcdBarrier bar; bar.bar = (unsigned*)(ws + WS_CTL) + CW_BAR; bar.x = 0; bar.st = (volatile LAS unsigned*)(F.ldsl + LDS_MISC);
    if (fused) bar = xcd_barrier_post((unsigned*)(ws + WS_CTL) + CW_BAR, (volatile LAS unsigned*)(F.ldsl + LDS_MISC));
    const int lo = P.ph_lo, hi = P.ph_hi;
    using namespace pg8;
    if (IN(0) && PEN(15)) { size_t wz = 0; asm volatile("" : "+s"(wz)); unsigned char* ws = ws0 + wz;
        quant_rows(F, F.in(0), (bf16_t*)(ws + WS_XB), (unsigned char*)(ws + WS_XQ), (float*)(ws + WS_XSC));
        conv_rows(F, F.in(1), (bf16_t*)(ws + WS_PB), (size_t)2 * NTOK * 256 / 8);
        sample_wmax(F);
        SEAM(0);
    }
    if (IN(1) && PEN(15)) { for (int rep = 0; rep < NREP(0); ++rep) convert_layer_weights(F, P, 0); SEAM(1); }
    layer_phases<0>(F, P, bar, lo, hi, ws0);
    layer_phases<1>(F, P, bar, lo, hi, ws0);
}

#ifdef DEBUG_NAN
constexpr int CW_FLAGS = 12288;
__global__ void dbg_scan_bf16(const unsigned short* p, size_t n, unsigned* flag) { unsigned c = 0; for (size_t i = (size_t)blockIdx.x * blockDim.x + threadIdx.x; i < n; i += (size_t)gridDim.x * blockDim.x) if ((p[i] & 0x7F80u) == 0x7F80u) ++c; if (c) atomicAdd(flag, c); }
__global__ void dbg_scan_f32(const unsigned* p, size_t n, unsigned* flag) { unsigned c = 0; for (size_t i = (size_t)blockIdx.x * blockDim.x + threadIdx.x; i < n; i += (size_t)gridDim.x * blockDim.x) if ((p[i] & 0x7F800000u) == 0x7F800000u) ++c; if (c) atomicAdd(flag, c); }
__global__ void dbg_scan_sel(const int* sel, const int* nsel, unsigned* flag) { unsigned c = 0; for (size_t i = (size_t)blockIdx.x * blockDim.x + threadIdx.x; i < (size_t)NTOK * 256; i += (size_t)gridDim.x * blockDim.x) { const int tok = (int)(i >> 8), j = (int)(i & 255), t = tok & (SEQ - 1); const int ns = nsel[tok]; if (j == 0 && ns != (t + 1 < 256 ? t + 1 : 256)) ++c; if (j < ns && (sel[i] < 0 || sel[i] > t)) ++c; } if (c) atomicAdd(flag, c); }
__global__ void dbg_scan_scores(const unsigned* p, unsigned* flag) { unsigned c = 0; for (size_t i = (size_t)blockIdx.x * blockDim.x + threadIdx.x; i < 2ull * SEQ * SEQ; i += (size_t)gridDim.x * blockDim.x) { const int s = (int)(i & (SEQ - 1)), t = (int)((i >> 13) & (SEQ - 1)); if (s <= t && (p[i] & 0x7F800000u) == 0x7F800000u) ++c; } if (c) atomicAdd(flag, c); }
__global__ void dbg_probe_bf16(const unsigned short* p, size_t n, unsigned* cnt, unsigned* minidx) { unsigned c = 0; unsigned mi = 0xFFFFFFFFu; for (size_t i = (size_t)blockIdx.x * blockDim.x + threadIdx.x; i < n; i += (size_t)gridDim.x * blockDim.x) if ((p[i] & 0x7F80u) == 0x7F80u) { ++c; if ((unsigned)i < mi) mi = (unsigned)i; } if (c) { atomicAdd(cnt, c); atomicMax(minidx, ~mi); } }
__global__ void dbg_final(float* out, size_t n, const unsigned* flags) { int code = 0; for (int k = 0; k < 32; ++k) if (flags[k] && !code) code = k + 1; const int mask = (flags[32] ? 1 : 0) | (flags[33] ? 2 : 0) | (flags[34] ? 4 : 0); if (mask) code = 20 + 5 * mask; if (!code) return; for (size_t i = (size_t)blockIdx.x * blockDim.x + threadIdx.x; i < n; i += (size_t)gridDim.x * blockDim.x) out[i] = (float)code; }
#endif
extern "C" void kernel_launch(void* const* d_in, const int* in_sizes, int n_in, void* d_out, int out_size, void* d_ws, size_t ws_size, hipStream_t stream) {
    static int grid = 0;
    if (grid == 0) {
        if (n_in != 25 || out_size != NTOK * DM || ws_size < WS_NEED) { fprintf(stderr, "kernel_launch: unexpected shapes (n_in %d out %d ws %zu need %zu)\n", n_in, out_size, ws_size, (size_t)WS_NEED); grid = -1; return; }
        int dev = 0, cus = 0, per_cu = 0;
        if (hipGetDevice(&dev) != hipSuccess || hipDeviceGetAttribute(&cus, hipDeviceAttributeMultiprocessorCount, dev) != hipSuccess) { grid = -1; return; }
        if (hipFuncSetAttribute((const void*)fwd, hipFuncAttributeMaxDynamicSharedMemorySize, LDS_BYTES) != hipSuccess) { fprintf(stderr, "kernel_launch: hipFuncSetAttribute failed\n"); grid = -1; return; }
        if (hipOccupancyMaxActiveBlocksPerMultiprocessor(&per_cu, (const void*)fwd, 512, LDS_BYTES) != hipSuccess || per_cu < 1) fprintf(stderr, "kernel_launch: occupancy query says %d\n", per_cu);
        (void)hipGetLastError();
        grid = cus;
    }
    if (grid < 0) return;
    unsigned char* ws = (unsigned char*)d_ws;
    hipMemsetAsync(ws + WS_CTL, 0, CTL_BYTES, stream);
    hipMemsetAsync(ws + W_UK2, 0, 8ull * 256 * 256 * 2 + 4ull * 256 * 512 * 2, stream);
    hipMemsetAsync(ws + W_IN + (size_t)INW * 2048 * 2, 0, (size_t)(INWP - INW) * 2048 * 2, stream);
    Params p{};
    for (int i = 0; i < 25; ++i) p.in[i] = (const float*)d_in[i];
    p.out = (float*)d_out; p.ws = ws;
#if PHASES_PER_LAUNCH == 0
    p.ph_lo = 0; p.ph_hi = NPHASE;
    hipLaunchKernelGGL(fwd, dim3(grid), dim3(512), LDS_BYTES, stream, p);
#else
    for (int k = 0; k < NPHASE; ++k) { p.ph_lo = k; p.ph_hi = k + 1; hipLaunchKernelGGL(fwd, dim3(grid), dim3(512), LDS_BYTES, stream, p);
#ifdef DEBUG_NAN
        unsigned* fl = (unsigned*)(ws + WS_CTL) + CW_FLAGS + k;
#define SB16(off, n) hipLaunchKernelGGL(dbg_scan_bf16, dim3(1024), dim3(256), 0, stream, (const unsigned short*)(ws + (off)), (size_t)(n), fl)
#define SF32(off, n) hipLaunchKernelGGL(dbg_scan_f32, dim3(1024), dim3(256), 0, stream, (const unsigned*)(ws + (off)), (size_t)(n), fl)
        if (k == 0) { SB16(WS_XB, (size_t)NTOK * DM); SB16(WS_PB, 2ull * NTOK * 256); SB16(WS_W, (W_END - WS_W) / 2); }
        else { const int kind = (k - 1) % 15;
            if (kind == 0) { SB16(R_QA, (size_t)NTOK * 1024); SB16(R_QIDX, (size_t)NTOK * 1024); SB16(R_QKV, 6ull * NTOK * 1024); SB16(R_GATES, (size_t)NTOK * 6144); SF32(R_SMALL, (size_t)NTOK * 512); }
            if (kind == 1) { SB16(R_QCAT, (size_t)NTOK * 2304); SB16(R_KCAT, (size_t)NTOK * 288); SB16(R_KI, (size_t)NTOK * 64); SB16(R_QIDX, (size_t)NTOK * 1024); SF32(R_WI, (size_t)NTOK * 16); SF32(WS_LF, 16ull * 8192); }
            if (kind == 2) { SF32(WS_CUM, 16ull * 8192); hipLaunchKernelGGL(dbg_scan_scores, dim3(1024), dim3(256), 0, stream, (const unsigned*)(ws + R_SCORES), fl); }
            if (kind == 3) { hipLaunchKernelGGL(dbg_scan_sel, dim3(1024), dim3(256), 0, stream, (const int*)(ws + R_SEL), (const int*)(ws + R_NSEL), fl); }
            if (k == 5) { unsigned* fl0 = fl; fl = (unsigned*)(ws + WS_CTL) + CW_FLAGS + 32; SB16(R_OLAT, (size_t)NTOK * 2048); fl += 1; SB16(R_OA, (size_t)NTOK * 3072); fl += 1; fl = fl0; hipLaunchKernelGGL(dbg_probe_bf16, dim3(1024), dim3(256), 0, stream, (const unsigned short*)(ws + R_OC), (size_t)NTOK * 1024, (unsigned*)(ws + WS_CTL) + CW_FLAGS + 40, (unsigned*)(ws + WS_CTL) + CW_FLAGS + 41); }
            if (kind == 5) { SB16(R_OA, (size_t)NTOK * 3072); }
            if (kind == 6) { SB16(R_MERGED, (size_t)NTOK * 2048); }
            if (kind == 7) { SF32(R_PRE1, (size_t)NTOK * 2048); }
            if (kind == 8) { SF32(M_X1F, (size_t)NTOK * 2048); SF32(M_TOKW, (size_t)NTOK * 4); }
            if (kind == 9) { SB16(M_PP, (size_t)NTOK * 2048); }
            if (kind == 12) { SF32(M_HF, (size_t)NTOK * 2048); }
            if (kind == 13) { SF32(M_X1F, (size_t)NTOK * 2048); }
            if (kind == 14) { hipLaunchKernelGGL(dbg_scan_f32, dim3(1024), dim3(256), 0, stream, (const unsigned*)d_out, (size_t)NTOK * DM, fl); if (k + 1 < NPHASE) SB16(WS_W, (W_END - WS_W) / 2); } }
#endif
    }
#ifdef DEBUG_NAN
    hipLaunchKernelGGL(dbg_final, dim3(1024), dim3(256), 0, stream, (float*)d_out, (size_t)NTOK * DM, (const unsigned*)(ws + WS_CTL) + CW_FLAGS);
#endif
#endif
}
```

```cpp
#include <hip/hip_runtime.h>
#include <stdint.h>
#include <stdio.h>
#include <math.h>

#ifndef PHASES_PER_LAUNCH
#define PHASES_PER_LAUNCH 0
#endif

#define LAS __attribute__((address_space(3)))
#define GAS __attribute__((address_space(1)))
#ifndef REP_MASK
#define REP_MASK 0
#endif
#define NREP(bit) (((REP_MASK) >> (bit)) & 1 ? 2 : 1)
typedef unsigned short bf16_t;
typedef short bf16x8 __attribute__((ext_vector_type(8)));
typedef short s16x4 __attribute__((ext_vector_type(4)));
typedef float f32x4 __attribute__((ext_vector_type(4)));
typedef float f32x16 __attribute__((ext_vector_type(16)));
typedef unsigned u32x4 __attribute__((ext_vector_type(4)));
typedef unsigned u32x2 __attribute__((ext_vector_type(2)));
typedef int i32x4 __attribute__((ext_vector_type(4)));

constexpr int NTOK = 16384, DM = 2048, SEQ = 8192, NB = 2, NLAYER = 2;
constexpr int INW = 14712, INWP = 14848;
constexpr int NEXP = 32, DEXP = 1024;
constexpr int PMAX = 65536 + 8192;
constexpr float ALPHA = 1.41421356237309515f;
constexpr float LOG2E = 1.4426950408889634f;
constexpr float SCALE = 0.08838834764831845f;
constexpr float C2 = LOG2E * SCALE;

constexpr size_t MiB = 1ull << 20;
constexpr size_t WS_CTL   = 0;
constexpr size_t WS_W     = 1 * MiB;
constexpr size_t W_IN     = WS_W;
constexpr size_t W_IN8    = W_IN   + 2048ull * 2048 * 2;
constexpr size_t W_UK2    = W_IN   + (size_t)INWP * 2048 * 2;
constexpr size_t W_UV2    = W_UK2  + 8ull * 256 * 256 * 2;
constexpr size_t W_BRA    = W_UV2  + 4ull * 256 * 512 * 2;
constexpr size_t W_BRB    = W_BRA  + 2048ull * 1024 * 2;
constexpr size_t W_BRC    = W_BRB  + 2048ull * 1024 * 2;
constexpr size_t W_OUT    = W_BRC  + 2048ull * 1024 * 2;
constexpr size_t W_PG     = W_OUT  + 2048ull * 2048 * 2;
constexpr size_t W_PLE    = W_PG   + 2048ull * 2048 * 2;
constexpr size_t W_GU     = W_PLE  + 2048ull * 256 * 2;
constexpr size_t W_DN     = W_GU   + 32ull * 2048 * 2048 * 2;
constexpr size_t W_END    = W_DN   + 32ull * 2048 * 1024 * 2;
constexpr size_t WS_XB    = (W_END + MiB - 1) / MiB * MiB;
constexpr size_t WS_PB    = WS_XB  + (size_t)NTOK * DM * 2;
constexpr size_t WS_CUM   = WS_PB  + 2ull * NTOK * 256 * 2;
constexpr size_t WS_LF    = WS_CUM + 16ull * 8192 * 4;
constexpr size_t WS_XQ    = WS_LF  + 16ull * 8192 * 4;
constexpr size_t WS_XSC   = WS_XQ  + (size_t)NTOK * DM;
constexpr size_t WS_R     = (WS_XSC + (size_t)NTOK * 4 + MiB - 1) / MiB * MiB;
constexpr size_t R_SCORES = WS_R;
constexpr size_t R_OLAT   = WS_R;
constexpr size_t R_OA     = WS_R + 64 * MiB;
constexpr size_t R_OB     = WS_R + 96 * MiB;
constexpr size_t R_OC     = WS_R + 128 * MiB;
constexpr size_t R_TMP    = WS_R + 160 * MiB;
constexpr size_t R_MERGED = WS_R + 288 * MiB;
constexpr size_t R_PRE1   = WS_R + 384 * MiB;
constexpr size_t R_QA     = WS_R + 512 * MiB;
constexpr size_t R_QIDX   = WS_R + 544 * MiB;
constexpr size_t R_QKV    = WS_R + 576 * MiB;
constexpr size_t R_GATES  = WS_R + 768 * MiB;
constexpr size_t R_SMALL  = WS_R + 960 * MiB;
constexpr size_t R_QCAT   = WS_R + 992 * MiB;
constexpr size_t R_KCAT   = WS_R + 1064 * MiB;
constexpr size_t R_KI     = WS_R + 1073 * MiB;
constexpr size_t R_WI     = WS_R + 1075 * MiB;
constexpr size_t R_SEL    = WS_R + 1076 * MiB;
constexpr size_t R_NSEL   = WS_R + 1092 * MiB;
constexpr size_t R_END    = WS_R + 1093 * MiB;
constexpr size_t M_XS     = WS_R;
constexpr size_t M_HID    = WS_R + 288 * MiB;
constexpr size_t M_PP     = WS_R + 432 * MiB;
constexpr size_t M_X1F    = WS_R + 512 * MiB;
constexpr size_t M_X1B    = WS_R + 640 * MiB;
constexpr size_t M_HF     = WS_R + 704 * MiB;
constexpr size_t M_HQ     = WS_R + 704 * MiB;
constexpr size_t M_HSC    = WS_R + 736 * MiB;
constexpr size_t M_HB     = WS_R + 832 * MiB;
constexpr size_t M_TOKE   = WS_R + 896 * MiB;
constexpr size_t M_TOKPOS = M_TOKE + (size_t)NTOK * 16;
constexpr size_t M_TOKW   = M_TOKPOS + (size_t)NTOK * 16;
constexpr size_t M_TOKDST = M_TOKW + (size_t)NTOK * 16;
constexpr size_t M_ROWW   = M_TOKDST + (size_t)NTOK * 16;
constexpr size_t M_ROWSX  = M_ROWW + (size_t)PMAX * 4;
constexpr size_t M_X1S    = M_ROWSX + (size_t)PMAX * 4;
constexpr size_t M_X1Q    = WS_R + 900 * MiB;
constexpr size_t WS_NEED  = R_END;
constexpr int CW_BAR = 0;
constexpr int CW_CNT = 8192;
constexpr int CW_META = 4096 + 64;
constexpr int CW_QCTR = 6144;
constexpr int CW_WMAX = 6272;
constexpr int CW_WMAXG = 6336;
constexpr int CW_WMAXP = 6368;
constexpr int CW_KMAX = 6400;
constexpr size_t CTL_BYTES = 65536;

constexpr int LDS_BYTES = 152576;
constexpr int LDS_MISC = 151552;

typedef float f32x2 __attribute__((ext_vector_type(2)));
typedef __bf16 bf16n2 __attribute__((ext_vector_type(2)));
__device__ __forceinline__ unsigned cvtpk(float lo, float hi) { f32x2 v = {lo, hi}; bf16n2 b = __builtin_convertvector(v, bf16n2); return __builtin_bit_cast(unsigned, b); }
__device__ __forceinline__ bf16_t f2bf(float x) { return (bf16_t)(cvtpk(x, 0.f) & 0xffffu); }
__device__ __forceinline__ float bf2f(bf16_t b) { return __uint_as_float(((unsigned)b) << 16); }
__device__ __forceinline__ float bflo(unsigned w) { return __uint_as_float(w << 16); }
__device__ __forceinline__ float bfhi(unsigned w) { return __uint_as_float(w & 0xffff0000u); }
__device__ __forceinline__ bf16x8 pack8(f32x4 a, f32x4 b) { u32x4 w = {cvtpk(a[0], a[1]), cvtpk(a[2], a[3]), cvtpk(b[0], b[1]), cvtpk(b[2], b[3])}; return *reinterpret_cast<bf16x8*>(&w); }
__device__ __forceinline__ float sigmoidf_(float x) { return 1.0f / (1.0f + __expf(-x)); }
__device__ __forceinline__ float wave_sum(float v) { for (int o = 32; o > 0; o >>= 1) v += __shfl_xor(v, o); return v; }
__device__ __forceinline__ int crow(int r, int hi) { return (r & 3) + 8 * (r >> 2) + 4 * hi; }
#define SBAR() __builtin_amdgcn_sched_barrier(0)

#define XB_TMO      128
#define XB_XCNT(j)  (256  + 64 * (j))
#define XB_XSUB(j)  (1280 + 64 * (j))
#define XB_XGEN(j)  (2304 + 64 * (j))
#define XB_TOP      3328
#define XB_TOPGEN   3392
#define XCD_BAR_WORDS 3456
#define XB_SPIN_CAP (1u << 22)
__device__ __forceinline__ unsigned xb_ld(unsigned* p)              { return __hip_atomic_load(p, __ATOMIC_RELAXED, __HIP_MEMORY_SCOPE_AGENT); }
__device__ __forceinline__ unsigned xb_add(unsigned* p, unsigned v) { return __hip_atomic_fetch_add(p, v, __ATOMIC_RELAXED, __HIP_MEMORY_SCOPE_AGENT); }
__device__ __forceinline__ unsigned xb_xcc_id() { return (unsigned)__builtin_amdgcn_s_getreg((3 << 11) | 20) & 0xFu; }
#define XB_SPIN(cond, bar) do { unsigned _sp = 0; while (cond) { __builtin_amdgcn_s_sleep(1); \
    if ((++_sp & 255u) == 0u) { if (xb_ld(&(bar)[XB_TMO])) break; if (_sp > XB_SPIN_CAP) { atomicAdd(&(bar)[XB_TMO], 1u); break; } } } } while (0)
struct XcdBarrier { unsigned* bar; unsigned x; volatile LAS unsigned* st; };
__device__ __forceinline__ XcdBarrier xcd_barrier_post(unsigned* bar, volatile LAS unsigned* st) {
    XcdBarrier b; b.bar = bar; b.x = xb_xcc_id(); b.st = st;
    if (threadIdx.x == 0) (void)xb_add(&bar[XB_XCNT(b.x)], 1u);
    return b;
}
__device__ __forceinline__ void xcd_barrier_complete(unsigned* bar, unsigned x, unsigned& nloc, unsigned& nx) {
    const unsigned G = gridDim.x * gridDim.y * gridDim.z;
    unsigned sum, cnt, mine, sp = 0u;
    for (;;) {
        sum = 0u; cnt = 0u; mine = 0u;
#pragma unroll
        for (unsigned j = 0; j < 16; ++j) { const unsigned c = xb_ld(&bar[XB_XCNT(j)]); sum += c; cnt += (c > 0u) ? 1u : 0u; mine = (j == x) ? c : mine; }
        if (sum == G) break;
        __builtin_amdgcn_s_sleep(1);
        if ((++sp & 255u) == 0u) { if (xb_ld(&bar[XB_TMO])) break; if (sp > XB_SPIN_CAP) { atomicAdd(&bar[XB_TMO], 1u); break; } }
    }
    nloc = mine > 0u ? mine : 1u; nx = cnt > 0u ? cnt : 1u;
}
__device__ __forceinline__ void xcd_barrier(const XcdBarrier& b) {
    asm volatile("s_waitcnt vmcnt(0)" ::: "memory");
    __syncthreads();
    if (threadIdx.x == 0) {
        unsigned* bar = b.bar;
        __builtin_amdgcn_s_waitcnt(0);
        unsigned nloc = b.st[0], nx = b.st[1];
        if (nloc == 0u) { xcd_barrier_complete(bar, b.x, nloc, nx); b.st[0] = nloc; b.st[1] = nx; }
        const unsigned old = xb_add(&bar[XB_XSUB(b.x)], 1u);
        const unsigned gen = old / nloc;
        if (old + 1u == (gen + 1u) * nloc) {
            __builtin_amdgcn_fence(__ATOMIC_RELEASE, "agent");
            asm volatile("s_waitcnt vmcnt(0)" ::: "memory");
            const unsigned og = xb_add(&bar[XB_TOP], 1u);
            const unsigned tg = og / nx;
            if (og + 1u == (tg + 1u) * nx) xb_add(&bar[XB_TOPGEN], 1u);
            else XB_SPIN(xb_ld(&bar[XB_TOPGEN]) == tg, bar);
            __builtin_amdgcn_fence(__ATOMIC_ACQUIRE, "agent");
            xb_add(&bar[XB_XGEN(b.x)], 1u);
            asm volatile("s_waitcnt vmcnt(0)" ::: "memory");
        } else {
            XB_SPIN(xb_ld(&bar[XB_XGEN(b.x)]) == gen, bar);
            __builtin_amdgcn_fence(__ATOMIC_ACQUIRE, "agent");
            asm volatile("s_waitcnt vmcnt(0)" ::: "memory");
        }
    }
    __syncthreads();
}

namespace pg8 {
constexpr int BM = 256, BK = 64, HALF = 128, HTB = HALF * BK * 2, STAGE_BYTES = 8 * HTB, NXCD = 8, WGM = 8;
__device__ __forceinline__ int lds_byte(int r, int c) { const int st = (r >> 4) * 2 + (c >> 5), rr = r & 15, cc = c & 31, ob = rr * 64 + cc * 2; return st * 1024 + (ob ^ (((ob >> 9) & 1) << 5)); }
__device__ __forceinline__ void stage_rc(int b, int& R, int& C) { const int st = b / 1024, sb = b % 1024, swz = sb ^ (((sb >> 9) & 1) << 5); R = (st >> 1) * 16 + swz / 64; C = (st & 1) * 32 + (swz % 64) / 2; }
__device__ __forceinline__ int perm32(int rho) { const int n = rho >> 4, i = rho & 15; return 8 * (i >> 2) + 4 * n + (i & 3); }
struct Unit { int pm, pn, e; };
struct SchedS {
    int nM, nN, nwg, G, c; const bf16_t* A; const bf16_t* B; int lda, ldb, a_sh, a_mul, skip_from = 1 << 30, skip_by = 0, skip_from2 = 1 << 30, skip_by2 = 0, b_compact = 0;
    __device__ void init(int M, int N, int G_, int c_, const bf16_t* A_, int lda_, const bf16_t* B_, int ldb_, int a_sh_ = 0, int a_mul_ = 0) {
        nM = M / BM; nN = N / BM; nwg = nM * nN; G = G_; c = c_; A = A_; B = B_; lda = lda_; ldb = ldb_; a_sh = a_sh_; a_mul = a_mul_; }
    __device__ __forceinline__ bool next(int i, Unit& u) const {
        const long L = (long)i * G + c; if (L >= nwg) return false;
        int wgid = (int)L; { const int q = nwg / NXCD, r = nwg % NXCD, xcd = wgid % NXCD, off = wgid / NXCD; wgid = (xcd < r ? xcd * (q + 1) : r * (q + 1) + (xcd - r) * q) + off; }
        const int nig = WGM * nN, gid = wgid / nig, fm = gid * WGM, gsz = (nM - fm) < WGM ? (nM - fm) : WGM;
        u.pm = fm + ((wgid % nig) % gsz); u.pn = (wgid % nig) / gsz; u.e = 0;
        u.e = u.pn;
        { const int ci = u.pn; if (ci >= skip_from) u.pn += skip_by; if (ci >= skip_from2) u.pn += skip_by2; }
        return true;
    }
    __device__ __forceinline__ const char* pa(const Unit& u) const { return (const char*)(A + (size_t)u.pm * BM * lda + (size_t)((u.pn >> a_sh) * a_mul)); }
    __device__ __forceinline__ const char* pb(const Unit& u) const { return (const char*)(B + (size_t)(b_compact ? u.e : u.pn) * BM * ldb); }
};
struct SchedM {
    int ntiles, G, c; const bf16_t* A; const bf16_t* W; int lda, ldb; const unsigned* tile_e;
    __device__ void init(const unsigned* meta, int G_, int c_, const bf16_t* A_, int lda_, const bf16_t* W_, int ldb_) {
        ntiles = (int)meta[0]; tile_e = meta + 1; G = G_; c = c_; A = A_; W = W_; lda = lda_; ldb = ldb_; }
    __device__ __forceinline__ bool next(int i, Unit& u) const {
        const long L = (long)i * G + c; if (L >= (long)ntiles * 8) return false;
        u.pm = (int)(L >> 3); u.pn = (int)(L & 7); u.e = (int)tile_e[u.pm];
        return true;
    }
    __device__ __forceinline__ const char* pa(const Unit& u) const { return (const char*)(A + (size_t)u.pm * BM * lda); }
    __device__ __forceinline__ const char* pb(const Unit& u) const { return (const char*)(W + ((size_t)u.e * 2048 + (size_t)u.pn * BM) * ldb); }
};

template <class Epi, class Sched>
__device__ __forceinline__ void gemm_phase(LAS unsigned char* lds, const int K, const int lda, const int ldb, const Sched& S, const Epi& E) {
    int tid = threadIdx.x; asm volatile("" : "+v"(tid));
    const int wid = __builtin_amdgcn_readfirstlane(tid >> 6), lane = tid & 63, wr = wid >> 2, wc = wid & 3, fr = lane & 15, fq = lane >> 4;
    const int nt = K / BK;
    unsigned voffA[2], voffB[2];
#pragma unroll
    for (int i = 0; i < 2; ++i) { int R, C; stage_rc(tid * 16 + i * 8192, R, C); const int Rb = (R & ~31) + perm32(R & 31);
        voffA[i] = (unsigned)(R * lda + C) * 2u; voffB[i] = (unsigned)(Rb * ldb + C) * 2u; }
    const size_t kstep = (size_t)(BK * 2);
    const size_t hstepA = (size_t)HALF * lda * 2, hstepB = (size_t)HALF * ldb * 2;
    const unsigned ldsw = (unsigned)wid * 1024u;
    const int aoff = lds_byte(wr * 64 + fr, fq * 8), boff = lds_byte(wc * 32 + fr, fq * 8);
#define PG8_SA(b, h) (((b) * 2 + (h)) * HTB)
#define PG8_SB(b, h) ((4 + (b) * 2 + (h)) * HTB)
#define PG8_STAGE(bufoff, gbase, voff) do { _Pragma("unroll") for (int _i = 0; _i < 2; ++_i) \
        __builtin_amdgcn_global_load_lds((const unsigned*)((const char*)(gbase) + (voff)[_i]), (LAS unsigned*)(lds + (bufoff) + ldsw + _i * 8192), 16, 0, 0); } while (0)
#define PG8_LDA(dst, b, h) do { _Pragma("unroll") for (int m = 0; m < 4; ++m) _Pragma("unroll") for (int k = 0; k < 2; ++k) dst[m][k] = *(const LAS bf16x8*)(lds + PG8_SA(b, h) + aoff + m * 2048 + k * 1024); } while (0)
#define PG8_LDB(dst, b, h) do { _Pragma("unroll") for (int n = 0; n < 2; ++n) _Pragma("unroll") for (int k = 0; k < 2; ++k) dst[n][k] = *(const LAS bf16x8*)(lds + PG8_SB(b, h) + boff + n * 2048 + k * 1024); } while (0)
#define PG8_MMA(ai, bj, At, Bt) do { __builtin_amdgcn_s_setprio(1); _Pragma("unroll") for (int m = 0; m < 4; ++m) _Pragma("unroll") for (int n = 0; n < 2; ++n) _Pragma("unroll") for (int k = 0; k < 2; ++k) \
        { if constexpr (Epi::I8) acc[ai][bj][m][n] = __builtin_bit_cast(f32x4, __builtin_amdgcn_mfma_i32_16x16x64_i8(__builtin_bit_cast(i32x4, Bt[n][k]), __builtin_bit_cast(i32x4, At[m][k]), __builtin_bit_cast(i32x4, acc[ai][bj][m][n]), 0, 0, 0)); \
          else acc[ai][bj][m][n] = __builtin_amdgcn_mfma_f32_16x16x32_bf16(Bt[n][k], At[m][k], acc[ai][bj][m][n], 0, 0, 0); } __builtin_amdgcn_s_setprio(0); } while (0)
#define PG8_WAIT_V(n) asm volatile("s_waitcnt vmcnt(" #n ")" ::: "memory")
#define PG8_WAIT_L(n) asm volatile("s_waitcnt lgkmcnt(" #n ")" ::: "memory")
#define PG8_BAR __builtin_amdgcn_s_barrier()
#define PG8_SCHED __builtin_amdgcn_sched_barrier(0)
    Unit cur, nxt; int ui = 0;
    if (!S.next(0, cur)) return;
    f32x4 acc[2][2][4][2];
#pragma unroll
    for (int a = 0; a < 2; ++a)
#pragma unroll
        for (int b = 0; b < 2; ++b)
#pragma unroll
            for (int m = 0; m < 4; ++m)
#pragma unroll
                for (int n = 0; n < 2; ++n) acc[a][b][m][n] = (f32x4){0.f, 0.f, 0.f, 0.f};
    bf16x8 At[4][2], B0[2][2], B1[2][2];
    const char* cA = S.pa(cur); const char* cB = S.pb(cur);
    PG8_STAGE(PG8_SB(0, 0), cB, voffB); PG8_STAGE(PG8_SA(0, 0), cA, voffA); PG8_STAGE(PG8_SB(0, 1), cB + hstepB, voffB); PG8_STAGE(PG8_SA(0, 1), cA + hstepA, voffA);
    if (wr == 1) PG8_BAR;
    PG8_WAIT_V(4); PG8_BAR;
    PG8_STAGE(PG8_SB(1, 0), cB + kstep, voffB); PG8_STAGE(PG8_SA(1, 0), cA + kstep, voffA); PG8_STAGE(PG8_SB(1, 1), cB + hstepB + kstep, voffB);
    PG8_WAIT_V(6); PG8_BAR;
    for (;;) {
        const bool has_next = S.next(ui + 1, nxt);
        const char* nA = has_next ? S.pa(nxt) : cA; const char* nB = has_next ? S.pb(nxt) : cB;
        for (int t = 0; t < nt; t += 2) {
            const bool last = (t == nt - 2);
            if constexpr (Epi::HAS_MID) { if (t == Epi::MID1 || t == Epi::MID2) { int frM = fr, fqM = fq; asm volatile("" : "+v"(frM), "+v"(fqM)); E.mid(acc, cur, t, wr, wc, frM, fqM); } }
            const char* a1 = cA + (size_t)(t + 1) * kstep;
            const char* a2 = last ? nA : cA + (size_t)(t + 2) * kstep; const char* b2 = last ? nB : cB + (size_t)(t + 2) * kstep;
            const char* a3 = a2 + kstep; const char* b3 = b2 + kstep;
            PG8_LDB(B0, 0, 0); PG8_SCHED; PG8_LDA(At, 0, 0); PG8_STAGE(PG8_SA(1, 1), a1 + hstepA, voffA);
            PG8_WAIT_L(8); PG8_BAR; PG8_WAIT_L(0); PG8_MMA(0, 0, At, B0); PG8_BAR; PG8_SCHED;
            PG8_LDB(B1, 0, 1); PG8_STAGE(PG8_SB(0, 0), b2, voffB);
            PG8_BAR; PG8_WAIT_L(0); PG8_MMA(0, 1, At, B1); PG8_BAR;
            PG8_LDA(At, 0, 1); PG8_STAGE(PG8_SA(0, 0), a2, voffA);
            PG8_BAR; PG8_WAIT_L(0); PG8_MMA(1, 0, At, B0); PG8_BAR; PG8_SCHED;
            PG8_STAGE(PG8_SB(0, 1), b2 + hstepB, voffB);
            PG8_WAIT_V(6); PG8_BAR; PG8_MMA(1, 1, At, B1); PG8_BAR;
            PG8_LDB(B0, 1, 0); PG8_SCHED; PG8_LDA(At, 1, 0); PG8_STAGE(PG8_SA(0, 1), a2 + hstepA, voffA);
            PG8_WAIT_L(8); PG8_BAR; PG8_WAIT_L(0); PG8_MMA(0, 0, At, B0); PG8_BAR; PG8_SCHED;
            PG8_LDB(B1, 1, 1); PG8_STAGE(PG8_SB(1, 0), b3, voffB);
            PG8_BAR; PG8_WAIT_L(0); PG8_MMA(0, 1, At, B1); PG8_BAR;
            PG8_LDA(At, 1, 1); PG8_STAGE(PG8_SA(1, 0), a3, voffA);
            PG8_BAR; PG8_WAIT_L(0); PG8_MMA(1, 0, At, B0); PG8_BAR; PG8_SCHED;
            PG8_STAGE(PG8_SB(1, 1), b3 + hstepB, voffB);
            PG8_WAIT_V(6); PG8_BAR; PG8_MMA(1, 1, At, B1); PG8_BAR;
        }
        { int frE = fr, fqE = fq; asm volatile("" : "+v"(frE), "+v"(fqE)); E(acc, cur, wr, wc, frE, fqE); }
        if (!has_next) break;
#pragma unroll
        for (int a = 0; a < 2; ++a)
#pragma unroll
            for (int b = 0; b < 2; ++b)
#pragma unroll
                for (int m = 0; m < 4; ++m)
#pragma unroll
                    for (int n = 0; n < 2; ++n) acc[a][b][m][n] = (f32x4){0.f, 0.f, 0.f, 0.f};
        cur = nxt; cA = nA; cB = nB; ++ui;
    }
    PG8_WAIT_V(0);
    if (wr == 0) PG8_BAR;
    PG8_BAR;
#undef PG8_SA
#undef PG8_SB
#undef PG8_STAGE
#undef PG8_LDA
#undef PG8_LDB
#undef PG8_MMA
#undef PG8_WAIT_V
#undef PG8_WAIT_L
#undef PG8_BAR
#undef PG8_SCHED
}

#define EPI_LOOP_ROWS _Pragma("unroll") for (int ai = 0; ai < 2; ++ai) _Pragma("unroll") for (int m = 0; m < 4; ++m)
__device__ __forceinline__ void st_bf16x8(bf16_t* p, f32x4 v0, f32x4 v1) { u32x4 w; w.x = cvtpk(v0[0], v0[1]); w.y = cvtpk(v0[2], v0[3]); w.z = cvtpk(v1[0], v1[1]); w.w = cvtpk(v1[2], v1[3]); *(u32x4*)p = w; }

template <bool I8_> struct EpiInProj {
    static constexpr bool HAS_MID = false; static constexpr bool I8 = I8_;
    bf16_t* qa; bf16_t* qidx; bf16_t* qkv; bf16_t* gates; float* small_; const float* xs; const unsigned* wmaxbits;
    __device__ __forceinline__ f32x4 val(const f32x4& a, float sc) const { if constexpr (I8_) { const i32x4 v = __builtin_bit_cast(i32x4, a); return (f32x4){(float)v[0], (float)v[1], (float)v[2], (float)v[3]} * sc; } else return a; }
    __device__ __forceinline__ void operator()(const f32x4 (&acc)[2][2][4][2], const Unit& u, int wr, int wc, int fr, int fq) const {
        const int pn = u.pn, row0 = u.pm * BM + wr * 64 + fr, lc0 = wc * 32 + fq * 8;
        float sw = 0.f; if constexpr (I8_) sw = __uint_as_float(*wmaxbits) * (1.3f / 127.0f);
        float scs[2][4];
#pragma unroll
        for (int ai = 0; ai < 2; ++ai)
#pragma unroll
            for (int m = 0; m < 4; ++m) { scs[ai][m] = 0.f; if constexpr (I8_) scs[ai][m] = xs[row0 + ai * HALF + m * 16] * sw; }
        if (pn < 8) {
            bf16_t* base = (pn < 4 ? qa + pn * 256 : qidx + (pn - 4) * 256) + lc0;
            EPI_LOOP_ROWS { const int row = row0 + ai * HALF + m * 16; const float sc = scs[ai][m];
#pragma unroll
                for (int bj = 0; bj < 2; ++bj) st_bf16x8(base + (size_t)row * 1024 + bj * HALF, val(acc[ai][bj][m][0], sc), val(acc[ai][bj][m][1], sc)); }
        } else if (pn < 32) {
            const int id = (pn - 8) >> 2, hb = ((pn - 8) & 3) * 2, b = u.pm >> 5;
            bf16_t* base = qkv + (size_t)id * ((size_t)NTOK * 1024) + lc0;
            EPI_LOOP_ROWS { const int row = row0 + ai * HALF + m * 16, s = row & (SEQ - 1); const float sc = scs[ai][m];
#pragma unroll
                for (int bj = 0; bj < 2; ++bj) st_bf16x8(base + ((size_t)(b * 8 + hb + bj) * SEQ + s) * 128, val(acc[ai][bj][m][0], sc), val(acc[ai][bj][m][1], sc)); }
        } else if (pn < 56) {
            unsigned char* base = (unsigned char*)gates + (pn - 32) * 256 + lc0;
            EPI_LOOP_ROWS { const int row = row0 + ai * HALF + m * 16; const float sc = scs[ai][m];
#pragma unroll
                for (int bj = 0; bj < 2; ++bj) { const f32x4 v0 = val(acc[ai][bj][m][0], sc), v1 = val(acc[ai][bj][m][1], sc); u32x2 w; unsigned p0 = 0u, p1 = 0u;
#pragma unroll
                    for (int j = 0; j < 4; ++j) { p0 |= (unsigned)(int)fmaxf(rintf(255.0f * sigmoidf_(v0[j])), 1.0f) << (8 * j); p1 |= (unsigned)(int)fmaxf(rintf(255.0f * sigmoidf_(v1[j])), 1.0f) << (8 * j); }
                    w.x = p0; w.y = p1; *(u32x2*)(base + (size_t)row * 6144 + bj * HALF) = w; } }
        } else {
            float* base = small_ + (pn - 56) * 256 + lc0;
            EPI_LOOP_ROWS { const int row = row0 + ai * HALF + m * 16; const float sc = scs[ai][m];
#pragma unroll
                for (int bj = 0; bj < 2; ++bj) { float* p = base + (size_t)row * 512 + bj * HALF; *(f32x4*)p = val(acc[ai][bj][m][0], sc); *(f32x4*)(p + 4) = val(acc[ai][bj][m][1], sc); } }
        }
    }
};
struct EpiBf16 {
    static constexpr bool HAS_MID = false; static constexpr bool I8 = false;
    bf16_t* out; int ld, cstep;
    __device__ __forceinline__ void operator()(const f32x4 (&acc)[2][2][4][2], const Unit& u, int wr, int wc, int fr, int fq) const {
        const int row0 = u.pm * BM + wr * 64 + fr; bf16_t* base = out + (size_t)u.pn * cstep + wc * 32 + fq * 8;
        EPI_LOOP_ROWS { const int row = row0 + ai * HALF + m * 16;
#pragma unroll
            for (int bj = 0; bj < 2; ++bj) st_bf16x8(base + (size_t)row * ld + bj * HALF, acc[ai][bj][m][0], acc[ai][bj][m][1]); }
    }
};
struct EpiBranch3 {
    static constexpr bool HAS_MID = true; static constexpr bool I8 = false; static constexpr int MID1 = 16, MID2 = 32;
    const unsigned char* gates; bf16_t* merged;
    __device__ __forceinline__ static f32x4 rat(unsigned n, unsigned d) {
        f32x4 r; r[0] = (float)(n & 255u) * __builtin_amdgcn_rcpf((float)(d & 255u)); r[1] = (float)((n >> 8) & 255u) * __builtin_amdgcn_rcpf((float)((d >> 8) & 255u));
        r[2] = (float)((n >> 16) & 255u) * __builtin_amdgcn_rcpf((float)((d >> 16) & 255u)); r[3] = (float)(n >> 24) * __builtin_amdgcn_rcpf((float)(d >> 24)); return r; }
    __device__ __forceinline__ void mid(f32x4 (&acc)[2][2][4][2], const Unit& u, int t, int wr, int wc, int fr, int fq) const {
        const int row0 = u.pm * BM + wr * 64 + fr, col0 = u.pn * BM + wc * 32 + fq * 8, bn = (t == MID1) ? 0 : 2048;
        u32x2 gn[2][4][2], gd[2][4][2];
        EPI_LOOP_ROWS {
#pragma unroll
            for (int bj = 0; bj < 2; ++bj) { const unsigned char* gp = gates + (size_t)(row0 + ai * HALF + m * 16) * 6144 + bn + col0 + bj * HALF; gn[ai][m][bj] = *(const u32x2*)gp; gd[ai][m][bj] = *(const u32x2*)(gp + 2048); } }
        EPI_LOOP_ROWS {
#pragma unroll
            for (int bj = 0; bj < 2; ++bj) { acc[ai][bj][m][0] *= rat(gn[ai][m][bj].x, gd[ai][m][bj].x); acc[ai][bj][m][1] *= rat(gn[ai][m][bj].y, gd[ai][m][bj].y); } }
    }
    __device__ __forceinline__ void operator()(const f32x4 (&acc)[2][2][4][2], const Unit& u, int wr, int wc, int fr, int fq) const {
        const int row0 = u.pm * BM + wr * 64 + fr, col0 = u.pn * BM + wc * 32 + fq * 8;
        u32x2 gl[2][4][2];
        EPI_LOOP_ROWS {
#pragma unroll
            for (int bj = 0; bj < 2; ++bj) gl[ai][m][bj] = *(const u32x2*)(gates + (size_t)(row0 + ai * HALF + m * 16) * 6144 + 4096 + col0 + bj * HALF); }
        EPI_LOOP_ROWS { const int row = row0 + ai * HALF + m * 16;
#pragma unroll
            for (int bj = 0; bj < 2; ++bj) { const int col = col0 + bj * HALF; const u32x2 gw = gl[ai][m][bj]; constexpr float I255 = 1.0f / 255.0f;
                f32x4 v0 = acc[ai][bj][m][0], v1 = acc[ai][bj][m][1];
                v0[0] *= (float)(gw.x & 255u) * I255; v0[1] *= (float)((gw.x >> 8) & 255u) * I255; v0[2] *= (float)((gw.x >> 16) & 255u) * I255; v0[3] *= (float)(gw.x >> 24) * I255;
                v1[0] *= (float)(gw.y & 255u) * I255; v1[1] *= (float)((gw.y >> 8) & 255u) * I255; v1[2] *= (float)((gw.y >> 16) & 255u) * I255; v1[3] *= (float)(gw.y >> 24) * I255;
                st_bf16x8(merged + (size_t)row * 2048 + col, v0, v1); } }
    }
};
struct EpiOut {
    static constexpr bool HAS_MID = false; static constexpr bool I8 = false;
    const bf16_t* res; bf16_t* pre;
    __device__ __forceinline__ void operator()(const f32x4 (&acc)[2][2][4][2], const Unit& u, int wr, int wc, int fr, int fq) const {
        const int row0 = u.pm * BM + wr * 64 + fr, col0 = u.pn * BM + wc * 32 + fq * 8;
        u32x4 rl[2][4][2];
        EPI_LOOP_ROWS { const int row = row0 + ai * HALF + m * 16;
#pragma unroll
            for (int bj = 0; bj < 2; ++bj) rl[ai][m][bj] = *(const u32x4*)(res + (size_t)row * 2048 + col0 + bj * HALF); }
        EPI_LOOP_ROWS { const int row = row0 + ai * HALF + m * 16;
#pragma unroll
            for (int bj = 0; bj < 2; ++bj) { const size_t o = (size_t)row * 2048 + col0 + bj * HALF;
                const u32x4 rw = rl[ai][m][bj]; f32x4 v0 = acc[ai][bj][m][0], v1 = acc[ai][bj][m][1];
                v0[0] += ALPHA * bflo(rw.x); v0[1] += ALPHA * bfhi(rw.x); v0[2] += ALPHA * bflo(rw.y); v0[3] += ALPHA * bfhi(rw.y);
                v1[0] += ALPHA * bflo(rw.z); v1[1] += ALPHA * bfhi(rw.z); v1[2] += ALPHA * bflo(rw.w); v1[3] += ALPHA * bfhi(rw.w);
                st_bf16x8(pre + o, v0, v1); } }
    }
};
struct EpiGateUpI8 {
    static constexpr bool HAS_MID = false; static constexpr bool I8 = true;
    const float* bg; const float* bu; bf16_t* hid; const float* rowsx; const unsigned* wmaxbits;
    __device__ __forceinline__ void operator()(const f32x4 (&acc)[2][2][4][2], const Unit& u, int wr, int wc, int fr, int fq) const {
        const int row0 = u.pm * BM + wr * 64 + fr, j0 = u.pn * 128 + wc * 32 + fq * 8;
        const float sw = __uint_as_float(*wmaxbits) * (1.3f / 127.0f);
        const float* pg = bg + (size_t)u.e * DEXP + j0; const float* pu = bu + (size_t)u.e * DEXP + j0;
        const f32x4 g0b = *(const f32x4*)pg, g1b = *(const f32x4*)(pg + 4), u0b = *(const f32x4*)pu, u1b = *(const f32x4*)(pu + 4);
        float scs[2][4];
#pragma unroll
        for (int ai = 0; ai < 2; ++ai)
#pragma unroll
            for (int m = 0; m < 4; ++m) scs[ai][m] = rowsx[row0 + ai * HALF + m * 16] * sw;
        EPI_LOOP_ROWS { const int row = row0 + ai * HALF + m * 16; const float sc = scs[ai][m];
            const i32x4 ag0 = __builtin_bit_cast(i32x4, acc[ai][0][m][0]), ag1 = __builtin_bit_cast(i32x4, acc[ai][0][m][1]), au0 = __builtin_bit_cast(i32x4, acc[ai][1][m][0]), au1 = __builtin_bit_cast(i32x4, acc[ai][1][m][1]);
            f32x4 h0, h1;
#pragma unroll
            for (int j = 0; j < 4; ++j) {
                float g = fminf((float)ag0[j] * sc + g0b[j], 7.0f), uu = fminf(fmaxf((float)au0[j] * sc + u0b[j], -7.0f), 7.0f);
                h0[j] = (uu + 1.0f) * (g * sigmoidf_(1.702f * g));
                g = fminf((float)ag1[j] * sc + g1b[j], 7.0f); uu = fminf(fmaxf((float)au1[j] * sc + u1b[j], -7.0f), 7.0f);
                h1[j] = (uu + 1.0f) * (g * sigmoidf_(1.702f * g)); }
            st_bf16x8(hid + (size_t)row * DEXP + j0, h0, h1); }
    }
};
struct EpiDown {
    static constexpr bool HAS_MID = false; static constexpr bool I8 = false;
    const float* bd; const float* roww; bf16_t* ys;
    __device__ __forceinline__ void operator()(const f32x4 (&acc)[2][2][4][2], const Unit& u, int wr, int wc, int fr, int fq) const {
        const int row0 = u.pm * BM + wr * 64 + fr, col0 = u.pn * BM + wc * 32 + fq * 8;
        f32x4 b[2][2];
#pragma unroll
        for (int bj = 0; bj < 2; ++bj) { const float* p = bd + (size_t)u.e * DM + col0 + bj * HALF; b[bj][0] = *(const f32x4*)p; b[bj][1] = *(const f32x4*)(p + 4); }
        float rws[2][4];
#pragma unroll
        for (int ai = 0; ai < 2; ++ai)
#pragma unroll
            for (int m = 0; m < 4; ++m) rws[ai][m] = roww[row0 + ai * HALF + m * 16];
        EPI_LOOP_ROWS { const int row = row0 + ai * HALF + m * 16; const float w = rws[ai][m];
#pragma unroll
            for (int bj = 0; bj < 2; ++bj) st_bf16x8(ys + (size_t)row * 2048 + col0 + bj * HALF, (acc[ai][bj][m][0] + b[bj][0]) * w, (acc[ai][bj][m][1] + b[bj][1]) * w); }
    }
};
struct EpiPleGateI8 {
    static constexpr bool HAS_MID = false; static constexpr bool I8 = true;
    const bf16_t* hb; const bf16_t* pp; bf16_t* pre; const float* hs; const unsigned* wmaxbits;
    __device__ __forceinline__ void operator()(const f32x4 (&acc)[2][2][4][2], const Unit& u, int wr, int wc, int fr, int fq) const {
        const int row0 = u.pm * BM + wr * 64 + fr, col0 = u.pn * BM + wc * 32 + fq * 8;
        const float sw = __uint_as_float(*wmaxbits) * (1.3f / 127.0f);
#pragma unroll
        for (int ai = 0; ai < 2; ++ai) { u32x4 pl[4][2], hl[4][2]; float scs[4];
#pragma unroll
            for (int m = 0; m < 4; ++m) { scs[m] = hs[row0 + ai * HALF + m * 16] * sw;
#pragma unroll
                for (int bj = 0; bj < 2; ++bj) { const size_t o = (size_t)(row0 + ai * HALF + m * 16) * 2048 + col0 + bj * HALF; pl[m][bj] = *(const u32x4*)(pp + o); hl[m][bj] = *(const u32x4*)(hb + o); } }
#pragma unroll
            for (int m = 0; m < 4; ++m) { const float sc = scs[m];
#pragma unroll
                for (int bj = 0; bj < 2; ++bj) { const size_t o = (size_t)(row0 + ai * HALF + m * 16) * 2048 + col0 + bj * HALF; const u32x4 pw = pl[m][bj], hw = hl[m][bj];
                    const i32x4 a0 = __builtin_bit_cast(i32x4, acc[ai][bj][m][0]), a1 = __builtin_bit_cast(i32x4, acc[ai][bj][m][1]); f32x4 o0, o1;
                    o0[0] = bflo(hw.x) + sigmoidf_((float)a0[0] * sc) * bflo(pw.x); o0[1] = bfhi(hw.x) + sigmoidf_((float)a0[1] * sc) * bfhi(pw.x); o0[2] = bflo(hw.y) + sigmoidf_((float)a0[2] * sc) * bflo(pw.y); o0[3] = bfhi(hw.y) + sigmoidf_((float)a0[3] * sc) * bfhi(pw.y);
                    o1[0] = bflo(hw.z) + sigmoidf_((float)a1[0] * sc) * bflo(pw.z); o1[1] = bfhi(hw.z) + sigmoidf_((float)a1[1] * sc) * bfhi(pw.z); o1[2] = bflo(hw.w) + sigmoidf_((float)a1[2] * sc) * bflo(pw.w); o1[3] = bfhi(hw.w) + sigmoidf_((float)a1[3] * sc) * bfhi(pw.w);
                    st_bf16x8(pre + o, o0, o1); } } }
    }
};
}

struct Params { const float* in[25]; float* out; unsigned char* ws; int ph_lo, ph_hi; };
__constant__ float c_invf_r[16] = {1.000000000e+00f, 4.403665960e-01f, 1.939227432e-01f, 8.539710194e-02f, 3.760603070e-02f, 1.656043902e-02f, 7.292664610e-03f, 3.211445874e-03f, 1.414213562e-03f, 6.227723788e-04f, 2.742481884e-04f, 1.207697351e-04f, 5.318296098e-05f, 2.341999971e-05f, 1.031338616e-05f, 4.541670478e-06f};
__constant__ float c_invf_i[8] = {1.000000000e+00f, 1.939227432e-01f, 3.760603070e-02f, 7.292664610e-03f, 1.414213562e-03f, 2.742481884e-04f, 5.318296098e-05f, 1.031338616e-05f};
constexpr int LDS_PTRS = LDS_MISC + 256;
struct Frame { unsigned char* lds; LAS unsigned char* ldsl; unsigned char* ws; int tid, lane, wid, G, bid;
    __device__ __forceinline__ const float* in(int k) const { const LAS unsigned* t = (const LAS unsigned*)(ldsl + LDS_PTRS) + 2 * k;
        const unsigned lo = __builtin_amdgcn_readfirstlane(t[0]), hi = __builtin_amdgcn_readfirstlane(t[1]); return (const float*)(const GAS float*)(((unsigned long long)hi << 32) | lo); }
    __device__ __forceinline__ float* out() const { return (float*)in(25); } };
__device__ __forceinline__ Frame fresh(const Frame& F0) { Frame F = F0; int t = threadIdx.x; asm volatile("" : "+v"(t)); F.tid = t; F.lane = t & 63; F.wid = __builtin_amdgcn_readfirstlane(t >> 6); size_t z = 0; asm volatile("" : "+s"(z)); F.ws = F0.ws + z; return F; }

struct TcTile { const float* src; long sld; bf16_t* dst; long dld; int nvalid; float qinv; };
template <class Dec>
__device__ __forceinline__ void tconv_run(const Frame& F, int total, const Dec& dec, int& rot) {
    float* tile = (float*)F.lds;
    const int tid = F.tid, G = F.G;
    const int start = (F.bid - (rot % G) + G) % G; rot += total;
    const int lr = tid >> 4, lc4 = (tid & 15) * 4, sn = tid >> 3, skc = (tid & 7) * 8;
    f32x4 v[4][2];
#define TC_ISSUE(t0_) do { _Pragma("unroll") for (int q = 0; q < 4; ++q) { const int t = (t0_) + q * G; \
        if (t < total) { const TcTile ti = dec(t); _Pragma("unroll") for (int h = 0; h < 2; ++h) { v[q][h] = (f32x4){0.f, 0.f, 0.f, 0.f}; \
            if (lc4 < ti.nvalid) v[q][h] = *(const GAS f32x4*)((const GAS float*)ti.src + (size_t)(lr + 32 * h) * ti.sld + lc4); } } } } while (0)
    if (start < total) TC_ISSUE(start);
    for (int t0 = start; t0 < total; t0 += 4 * G) {
#pragma unroll
        for (int q = 0; q < 4; ++q) { if (t0 + q * G < total) { float* tl = tile + q * (64 * 65);
#pragma unroll
                for (int h = 0; h < 2; ++h) { float* p = tl + (lr + 32 * h) * 65 + lc4; p[0] = v[q][h][0]; p[1] = v[q][h][1]; p[2] = v[q][h][2]; p[3] = v[q][h][3]; } } }
        __syncthreads();
        if (t0 + 4 * G < total) TC_ISSUE(t0 + 4 * G);
#pragma unroll
        for (int q = 0; q < 4; ++q) { const int t = t0 + q * G;
            if (t < total) { const TcTile ti = dec(t); const float* tl = tile + q * (64 * 65);
                if (ti.qinv > 0.f) { if (tid < 256) { const int n8 = tid >> 2, kc = (tid & 3) * 16; u32x4 w;
#pragma unroll
                        for (int d = 0; d < 4; ++d) { unsigned pk = 0u;
#pragma unroll
                            for (int j = 0; j < 4; ++j) { float q = rintf(tl[(kc + d * 4 + j) * 65 + n8] * ti.qinv); q = fminf(fmaxf(q, -127.f), 127.f); pk |= ((unsigned)(int)q & 0xffu) << (8 * j); }
                            w[d] = pk; }
                        *(u32x4*)((unsigned char*)ti.dst + (size_t)n8 * ti.dld + kc) = w; } }
                else if (sn < ti.nvalid) { f32x4 a, b;
#pragma unroll
                    for (int j = 0; j < 4; ++j) { a[j] = tl[(skc + j) * 65 + sn]; b[j] = tl[(skc + 4 + j) * 65 + sn]; }
                    pg8::st_bf16x8(ti.dst + (size_t)sn * ti.dld + skc, a, b); } } }
        __syncthreads();
    }
#undef TC_ISSUE
}
struct TcMat {
    const float* src; long src_ld; int tk, ncols; bf16_t* dst; long dst_ld; float qinv;
    __device__ __forceinline__ TcTile operator()(int t) const { const int k0 = (t % tk) * 64, n0 = (t / tk) * 64; TcTile ti;
        ti.src = src + (size_t)k0 * src_ld + n0; ti.sld = src_ld; ti.dst = qinv > 0.f ? (bf16_t*)((unsigned char*)dst + (size_t)n0 * dst_ld + k0) : dst + (size_t)n0 * dst_ld + k0; ti.dld = dst_ld; ti.nvalid = (ncols - n0) < 64 ? (ncols - n0) : 64; ti.qinv = qinv; return ti; }
};
__device__ __forceinline__ void tconv(const Frame& F, const float* src, long src_ld, int K, int ncols, bf16_t* dst, long dst_ld, int& rot) {
    TcMat d{src, src_ld, K >> 6, ncols, dst, dst_ld, 0.f}; tconv_run(F, (K >> 6) * ((ncols + 63) >> 6), d, rot);
}
struct TcExperts {
    const float* wg; const float* wu; const float* wd; unsigned char* dgu; bf16_t* ddn; float qinv;
    __device__ __forceinline__ TcTile operator()(int t) const { const int e = t / 1536, r = t - e * 1536; TcTile ti; ti.nvalid = 64; ti.qinv = 0.f;
        if (r < 1024) { const int k0 = (r & 31) * 64, dt = r >> 5, jb = dt >> 2, gu = (dt >> 1) & 1, half = dt & 1;
            ti.src = (const float*)((unsigned long long)wg + (unsigned long long)gu * ((unsigned long long)wu - (unsigned long long)wg)) + (size_t)e * DM * DEXP + (size_t)k0 * DEXP + jb * 128 + half * 64; ti.sld = DEXP;
            ti.dst = (bf16_t*)(dgu + (size_t)e * 2048 * 2048 + (size_t)(dt * 64) * 2048 + k0); ti.dld = 2048; ti.qinv = qinv; }
        else { const int r2 = r - 1024, k0 = (r2 & 15) * 64, n0 = (r2 >> 4) * 64;
            ti.src = wd + (size_t)e * DEXP * DM + (size_t)k0 * DM + n0; ti.sld = DM;
            ti.dst = ddn + (size_t)e * 2048 * 1024 + (size_t)n0 * 1024 + k0; ti.dld = 1024; }
        return ti; }
};
__device__ __forceinline__ void sample_wmax(const Frame& F) {
    unsigned* wm = (unsigned*)(F.ws + WS_CTL) + CW_WMAX;
#pragma unroll 1
    for (int l = 0; l < NLAYER; ++l) { float mx = 0.f;
#pragma unroll 1
        for (int which = 0; which < 2; ++which) { const f32x4* p = (const f32x4*)(F.in(which ? 17 : 15) + (size_t)l * NEXP * DM * DEXP);
            for (size_t i = (size_t)F.bid * 512 + F.tid; i < (size_t)NEXP * DM * DEXP / 4 / 64; i += (size_t)F.G * 512) { const f32x4 v = p[i * 64 + (i & 63)];
                mx = fmaxf(mx, fmaxf(fmaxf(fabsf(v[0]), fabsf(v[1])), fmaxf(fabsf(v[2]), fabsf(v[3])))); } }
        for (int o = 32; o > 0; o >>= 1) mx = fmaxf(mx, __shfl_xor(mx, o));
        if (F.lane == 0 && mx > 0.f) atomicMax(&wm[l], __float_as_uint(mx));
        float mg = 0.f; const f32x4* wi_ = (const f32x4*)(F.in(2) + (size_t)l * DM * INW);
        for (int i = F.bid * 512 + F.tid; i < DM * (INW / 4) / 16; i += F.G * 512) { const f32x4 v = wi_[(size_t)i * 16 + (i & 15)];
            mg = fmaxf(mg, fmaxf(fmaxf(fabsf(v[0]), fabsf(v[1])), fmaxf(fabsf(v[2]), fabsf(v[3])))); }
        for (int o = 32; o > 0; o >>= 1) mg = fmaxf(mg, __shfl_xor(mg, o));
        if (F.lane == 0 && mg > 0.f) atomicMax(&wm[CW_WMAXG - CW_WMAX + l], __float_as_uint(mg));
        float mp = 0.f; const f32x4* wp_ = (const f32x4*)(F.in(21) + (size_t)l * DM * DM);
        for (int i = F.bid * 512 + F.tid; i < DM * DM / 4 / 16; i += F.G * 512) { const f32x4 v = wp_[i * 16 + (i & 15)];
            mp = fmaxf(mp, fmaxf(fmaxf(fabsf(v[0]), fabsf(v[1])), fmaxf(fabsf(v[2]), fabsf(v[3])))); }
        for (int o = 32; o > 0; o >>= 1) mp = fmaxf(mp, __shfl_xor(mp, o));
        if (F.lane == 0 && mp > 0.f) atomicMax(&wm[CW_WMAXP - CW_WMAX + l], __float_as_uint(mp)); }
}
__device__ __forceinline__ void conv_rows(const Frame& F, const float* src, bf16_t* dst, size_t n8) {
    for (size_t i = (size_t)F.bid * 512 + F.tid; i < n8; i += (size_t)F.G * 512) { const f32x4 a = *(const f32x4*)(src + i * 8), b = *(const f32x4*)(src + i * 8 + 4); pg8::st_bf16x8(dst + i * 8, a, b); }
}
__device__ __forceinline__ void quant_rows(const Frame& F, const float* src, bf16_t* xb, unsigned char* xq, float* xsc) {
    const int lane = F.lane;
    for (int tok = F.bid * 8 + F.wid; tok < NTOK; tok += F.G * 8) { f32x4 v[8]; float amax = 0.f;
#pragma unroll
        for (int i = 0; i < 4; ++i) { const int c = (i * 64 + lane) * 8; v[2 * i] = *(const f32x4*)(src + (size_t)tok * DM + c); v[2 * i + 1] = *(const f32x4*)(src + (size_t)tok * DM + c + 4);
            pg8::st_bf16x8(xb + (size_t)tok * DM + c, v[2 * i], v[2 * i + 1]);
#pragma unroll
            for (int h = 0; h < 2; ++h)
#pragma unroll
                for (int j = 0; j < 4; ++j) amax = fmaxf(amax, fabsf(v[2 * i + h][j])); }
        for (int o = 32; o > 0; o >>= 1) amax = fmaxf(amax, __shfl_xor(amax, o));
        amax = fmaxf(amax, 1e-20f); const float qi = 127.0f / amax; if (lane == 0) xsc[tok] = amax * (1.0f / 127.0f);
#pragma unroll
        for (int i = 0; i < 4; ++i) { u32x2 w;
#pragma unroll
            for (int h = 0; h < 2; ++h) { unsigned pk = 0u;
#pragma unroll
                for (int j = 0; j < 4; ++j) pk |= ((unsigned)(int)rintf(v[2 * i + h][j] * qi) & 0xffu) << (8 * j);
                w[h] = pk; }
            *(u32x2*)(xq + (size_t)tok * DM + (i * 64 + lane) * 8) = w; } }
}
__constant__ int c_so[14] = {0, 1312, 2416, 3440, 4464, 5496, 6520, 7544, 8568, 1024, 1280, 2336, 2400, 5488};
__constant__ int c_dn[14] = {0, 1024, 2048, 3072, 4096, 5120, 6144, 7168, 8192, 14336, 14592, 14624, 14688, 14704};
__constant__ int c_nc[14] = {1024, 1024, 1024, 1024, 1024, 1024, 1024, 1024, 6144, 256, 32, 64, 16, 8};
__device__ __forceinline__ void convert_layer_weights(const Frame& F0, const Params& P, int l) { const Frame F = fresh(F0);
    unsigned char* ws = F.ws; int rot = 0;
    { const float* w = F.in(2) + (size_t)l * DM * INW; bf16_t* d = (bf16_t*)(ws + W_IN);
      const float wmaxg = __uint_as_float(((const unsigned*)(ws + WS_CTL))[CW_WMAXG + l]); const float qinv = 127.0f / (1.3f * wmaxg);
#pragma unroll 1
      for (int s = 0; s < 14; ++s) {
          if (s == 1 || s >= 10) tconv(F, w + c_so[s], INW, DM, c_nc[s], d + (size_t)c_dn[s] * DM, DM, rot);
          else { const int crow = (s == 0) ? 0 : (s <= 7 ? 1024 + (s - 2) * 1024 : (s == 8 ? 7168 : 13312));
              TcMat dq{w + c_so[s], INW, DM >> 6, c_nc[s], (bf16_t*)(ws + W_IN8 + (size_t)crow * 2048), 2048, qinv}; tconv_run(F, (DM >> 6) * (c_nc[s] >> 6), dq, rot); } } }
    tconv(F, F.in(7) + (size_t)l * 1024 * DM, DM, 1024, DM, (bf16_t*)(ws + W_BRA), 3072, rot);
    tconv(F, F.in(8) + (size_t)l * 1024 * DM, DM, 1024, DM, (bf16_t*)(ws + W_BRA) + 1024, 3072, rot);
    tconv(F, F.in(9) + (size_t)l * 1024 * DM, DM, 1024, DM, (bf16_t*)(ws + W_BRA) + 2048, 3072, rot);
    tconv(F, F.in(10) + (size_t)l * DM * DM, DM, DM, DM, (bf16_t*)(ws + W_OUT), DM, rot);
    { const float wmp = __uint_as_float(((const unsigned*)(ws + WS_CTL))[CW_WMAXP + l]);
      TcMat dq{F.in(21) + (size_t)l * DM * DM, DM, DM >> 6, DM, (bf16_t*)(ws + W_PG), 2048, 127.0f / (1.3f * wmp)}; tconv_run(F, (DM >> 6) * (DM >> 6), dq, rot); }
    tconv(F, F.in(22) + (size_t)l * 256 * DM, DM, 256, DM, (bf16_t*)(ws + W_PLE), 256, rot);
#pragma unroll 1
    for (int h = 0; h < 8; ++h) tconv(F, F.in(6) + (size_t)l * 256 * 1024 + h * 128, 1024, 256, 128, (bf16_t*)(ws + W_UV2) + ((size_t)(h >> 1) * 256 + (h & 1) * 128) * 512 + (h & 1) * 256, 512, rot);
    { const float wmax = __uint_as_float(((const unsigned*)(ws + WS_CTL))[CW_WMAX + l]);
      TcExperts d{F.in(15) + (size_t)l * NEXP * DM * DEXP, F.in(17) + (size_t)l * NEXP * DM * DEXP, F.in(19) + (size_t)l * NEXP * DEXP * DM, (unsigned char*)(ws + W_GU), (bf16_t*)(ws + W_DN), 127.0f / (1.3f * wmax)};
      tconv_run(F, NEXP * 1536, d, rot); }
    { const float* w = F.in(5) + (size_t)l * 256 * 8 * 96; bf16_t* d = (bf16_t*)(ws + W_UK2);
      for (int i = F.bid * 512 + F.tid; i < 256 * 8 * 96; i += F.G * 512) { const int n = i % 96, h = (i / 96) & 7, r = i / 768; d[((size_t)h * 256 + r) * 256 + (h & 1) * 128 + 32 + n] = f2bf(w[i]); } }
}

__device__ __forceinline__ void rope_cs(float pos, float invf, float& c, float& s) {
    const float a = pos * invf; const double ad = (double)a * 0.15915494309189535; const float fr = (float)(ad - rint(ad));
    s = __builtin_amdgcn_sinf(fr); c = __builtin_amdgcn_cosf(fr);
}
__device__ __forceinline__ void phase_prep(const Frame& F0, const Params& P, int l) { const Frame F = fresh(F0);
    unsigned char* ws = F.ws; const int lane = F.lane;
    const float* smallb = (const float*)(ws + R_SMALL); bf16_t* kcat = (bf16_t*)(ws + R_KCAT); bf16_t* qcat = (bf16_t*)(ws + R_QCAT);
    bf16_t* ki = (bf16_t*)(ws + R_KI); float* wi = (float*)(ws + R_WI); float* lf = (float*)(ws + WS_LF);
    const bf16_t* qa = (const bf16_t*)(ws + R_QA); bf16_t* qidx = (bf16_t*)(ws + R_QIDX);
    const f32x4 gck = *(const f32x4*)(F.in(4) + l * 256 + lane * 4);
    const float bfo = lane < 8 ? F.in(3)[l * 8 + lane] : 0.f;
    const float ifr = c_invf_r[lane & 15], ifi = c_invf_i[lane & 7];
    for (int tok = F.bid * 8 + F.wid; tok < NTOK; tok += F.G * 8) {
        const int s = tok & (SEQ - 1), b = tok >> 13; const float* sm = smallb + (size_t)tok * 512;
        float cr, sr, ci, si; rope_cs((float)s, ifr, cr, sr); rope_cs((float)s, ifi, ci, si);
        { const f32x4 v = *(const f32x4*)(sm + lane * 4); float ss = v[0] * v[0] + v[1] * v[1] + v[2] * v[2] + v[3] * v[3]; ss = wave_sum(ss);
          const float rs = rsqrtf(ss * (1.0f / 256.0f) + 1e-6f); u32x2 w; w.x = cvtpk(v[0] * rs * gck[0], v[1] * rs * gck[1]); w.y = cvtpk(v[2] * rs * gck[2], v[3] * rs * gck[3]);
          *(u32x2*)(kcat + (size_t)tok * 288 + lane * 4) = w; }
        if (lane < 16) { const float x1 = sm[256 + lane], x2 = sm[272 + lane]; kcat[(size_t)tok * 288 + 256 + lane] = f2bf(x1 * cr - x2 * sr); kcat[(size_t)tok * 288 + 272 + lane] = f2bf(x2 * cr + x1 * sr); }
        { float o = sm[288 + lane];
          if (lane < 8) { const float x2 = sm[296 + lane]; o = o * ci - x2 * si; } else if (lane < 16) { const float x1 = sm[288 + lane - 8]; o = o * ci + x1 * si; }
          ki[(size_t)tok * 64 + lane] = f2bf(o); }
        if (lane < 16) wi[(size_t)tok * 16 + lane] = sm[352 + lane] * (1.0f / 32.0f);
        if (lane < 8) { const float f = sm[368 + lane] + bfo; lf[(size_t)(b * 8 + lane) * SEQ + s] = fminf(f, 0.f) - log1pf(__expf(-fabsf(f))); }
#pragma unroll
        for (int pp = 0; pp < 2; ++pp) { const int p = lane + 64 * pp, h = p >> 4, i = p & 15;
            const float x1 = bf2f(qa[(size_t)tok * 1024 + h * 128 + i]), x2 = bf2f(qa[(size_t)tok * 1024 + h * 128 + 16 + i]);
            qcat[(size_t)tok * 2304 + h * 288 + 256 + i] = f2bf(x1 * cr - x2 * sr); qcat[(size_t)tok * 2304 + h * 288 + 272 + i] = f2bf(x2 * cr + x1 * sr); }
#pragma unroll
        for (int pp = 0; pp < 2; ++pp) { const int p = lane + 64 * pp, hh = p >> 3, i = p & 7; bf16_t* q = qidx + (size_t)tok * 1024 + hh * 64;
            const float x1 = bf2f(q[i]), x2 = bf2f(q[8 + i]); q[i] = f2bf(x1 * ci - x2 * si); q[8 + i] = f2bf(x2 * ci + x1 * si); }
    }
    { const bf16_t* kbt = (const bf16_t*)(ws + R_QKV) + (size_t)NTOK * 1024; unsigned* kmx = (unsigned*)(ws + WS_CTL) + CW_KMAX + l * 16;
#pragma unroll 1
      for (int bh = 0; bh < 16; ++bh) { float mx = 0.f;
          for (int r0 = (F.bid * 8 + F.wid) * 4; r0 < SEQ; r0 += F.G * 32) {
              const u32x4 w = *(const u32x4*)(kbt + ((size_t)bh * SEQ + r0 + (lane >> 4)) * 128 + (lane & 15) * 8);
              float ss = bflo(w.x) * bflo(w.x) + bfhi(w.x) * bfhi(w.x) + bflo(w.y) * bflo(w.y) + bfhi(w.y) * bfhi(w.y) + bflo(w.z) * bflo(w.z) + bfhi(w.z) * bfhi(w.z) + bflo(w.w) * bflo(w.w) + bfhi(w.w) * bfhi(w.w);
              ss += __shfl_xor(ss, 1); ss += __shfl_xor(ss, 2); ss += __shfl_xor(ss, 4); ss += __shfl_xor(ss, 8); mx = fmaxf(mx, ss); }
          mx = fmaxf(mx, __shfl_xor(mx, 16)); mx = fmaxf(mx, __shfl_xor(mx, 32));
          if (lane == 0) ((float*)F.lds)[F.wid * 16 + bh] = mx; }
      __syncthreads();
      if (F.tid < 16) { float mx = 0.f;
#pragma unroll
          for (int w = 0; w < 8; ++w) mx = fmaxf(mx, ((const float*)F.lds)[w * 16 + F.tid]);
          const unsigned bits = __float_as_uint(mx);
          if (bits > __hip_atomic_load(&kmx[F.tid], __ATOMIC_RELAXED, __HIP_MEMORY_SCOPE_AGENT)) atomicMax(&kmx[F.tid], bits); }
      __syncthreads(); }
}
__device__ __forceinline__ void phase_cumsum(const Frame& F0) { const Frame F = fresh(F0);
    const int gw = F.bid * 8 + F.wid; if (gw >= 16) return;
    const float* lf = (const float*)(F.ws + WS_LF) + (size_t)gw * SEQ; float* cum = (float*)(F.ws + WS_CUM) + (size_t)gw * SEQ;
    const int lane = F.lane; double tot = 0.0;
    for (int j = 0; j < 128; ++j) tot += (double)lf[lane * 128 + j];
    double inc = tot;
    for (int o = 1; o < 64; o <<= 1) { const double n = __shfl_up(inc, o); if (lane >= o) inc += n; }
    double run = inc - tot;
    for (int j = 0; j < 128; ++j) { run += (double)lf[lane * 128 + j]; cum[lane * 128 + j] = (float)run; }
}

__device__ __forceinline__ void idx_unit(const Frame& F, int b, int pi, int half) {
    const int tid = F.tid, lane = F.lane, rho = lane & 31, hh = lane >> 5; unsigned char* ws = F.ws;
    const bf16_t* qidx = (const bf16_t*)(ws + R_QIDX); const bf16_t* ki = (const bf16_t*)(ws + R_KI) + (size_t)b * SEQ * 64; const float* wi = (const float*)(ws + R_WI);
    float* scores = (float*)(ws + R_SCORES) + (size_t)b * SEQ * SEQ;
    LAS unsigned char* kl = F.ldsl;
    const int gl = pi, gh = 127 - pi, nl = (64 * gl + 63) / 128 + 1, nh = (64 * gh + 63) / 128 + 1, tot = nl + nh;
    const int x0 = half ? tot / 2 : 0, x1 = half ? tot : tot / 2;
    bf16x8 af[4][4]; float wv[4][16]; int t0 = 0, curg = -1;
    const int r0 = tid >> 3, p0 = tid & 7;
    const unsigned d0 = (unsigned)(r0 * 128 + ((p0 ^ (r0 & 7)) << 4)), d1 = d0 + 64 * 128;
    u32x4 s0, s1;
    { const int c = x0 < nl ? x0 : x0 - nl; const bf16_t* kp = ki + (size_t)(c * 128) * 64; s0 = *(const u32x4*)(kp + (size_t)r0 * 64 + p0 * 8); s1 = *(const u32x4*)(kp + (size_t)(r0 + 64) * 64 + p0 * 8); }
    __syncthreads();
    *(LAS u32x4*)(kl + d0) = s0; *(LAS u32x4*)(kl + d1) = s1;
    __syncthreads();
    const unsigned rdo = (unsigned)(rho * 128);
#pragma unroll 1
    for (int x = x0; x < x1; ++x) {
        const int g = x < nl ? gl : gh, c = x < nl ? x : x - nl;
        if (g != curg) { curg = g; t0 = g * 64 + F.wid * 8;
#pragma unroll
            for (int mt = 0; mt < 4; ++mt) {
                const int tokA = b * SEQ + t0 + 2 * mt + ((rho >> 2) & 1), head = (rho & 3) + 4 * (rho >> 3);
#pragma unroll
                for (int kk = 0; kk < 4; ++kk) af[mt][kk] = *(const bf16x8*)(qidx + (size_t)tokA * 1024 + head * 64 + kk * 16 + 8 * hh);
                const float* wp = wi + (size_t)(b * SEQ + t0 + 2 * mt + hh) * 16;
#pragma unroll
                for (int q = 0; q < 4; ++q) { const f32x4 v = *(const f32x4*)(wp + 4 * q); wv[mt][4 * q] = v[0]; wv[mt][4 * q + 1] = v[1]; wv[mt][4 * q + 2] = v[2]; wv[mt][4 * q + 3] = v[3]; } } }
        const unsigned bo = (unsigned)((x - x0) & 1) * 16384u;
        if (x + 1 < x1) { const int cn = (x + 1) < nl ? (x + 1) : (x + 1) - nl; const bf16_t* kp = ki + (size_t)(cn * 128) * 64; s0 = *(const u32x4*)(kp + (size_t)r0 * 64 + p0 * 8); s1 = *(const u32x4*)(kp + (size_t)(r0 + 64) * 64 + p0 * 8); }
#pragma unroll
        for (int tl = 0; tl < 4; ++tl) {
            const int kb = c * 128 + tl * 32;
            if (kb <= t0 + 7) {
                bf16x8 bc[4];
#pragma unroll
                for (int kk = 0; kk < 4; ++kk) bc[kk] = *(const LAS bf16x8*)(kl + bo + tl * 4096 + rdo + (((kk * 2 + hh) ^ (rho & 7)) << 4));
                f32x16 a0 = {}, a1 = {}, a2 = {}, a3 = {};
#pragma unroll
                for (int kk = 0; kk < 4; ++kk) { a0 = __builtin_amdgcn_mfma_f32_32x32x16_bf16(af[0][kk], bc[kk], a0, 0, 0, 0); a1 = __builtin_amdgcn_mfma_f32_32x32x16_bf16(af[1][kk], bc[kk], a1, 0, 0, 0);
                                                  a2 = __builtin_amdgcn_mfma_f32_32x32x16_bf16(af[2][kk], bc[kk], a2, 0, 0, 0); a3 = __builtin_amdgcn_mfma_f32_32x32x16_bf16(af[3][kk], bc[kk], a3, 0, 0, 0); }
#define IDX_EPI(A_, mt_) do { float x_0 = 0.f, x_1 = 0.f, x_2 = 0.f, x_3 = 0.f; _Pragma("unroll") for (int r = 0; r < 16; r += 4) { \
                    x_0 = fmaf(wv[mt_][r], fmaxf(A_[r], 0.f), x_0); x_1 = fmaf(wv[mt_][r + 1], fmaxf(A_[r + 1], 0.f), x_1); x_2 = fmaf(wv[mt_][r + 2], fmaxf(A_[r + 2], 0.f), x_2); x_3 = fmaf(wv[mt_][r + 3], fmaxf(A_[r + 3], 0.f), x_3); } \
                    scores[(size_t)(t0 + 2 * (mt_) + hh) * SEQ + kb + rho] = (x_0 + x_1) + (x_2 + x_3); } while (0)
                IDX_EPI(a0, 0); IDX_EPI(a1, 1); IDX_EPI(a2, 2); IDX_EPI(a3, 3);
#undef IDX_EPI
            }
        }
        if (x + 1 < x1) { *(LAS u32x4*)(kl + (bo ^ 16384u) + d0) = s0; *(LAS u32x4*)(kl + (bo ^ 16384u) + d1) = s1; }
        __syncthreads();
    }
}
__device__ __forceinline__ void phase_idx(const Frame& F0) { const Frame F = fresh(F0);
#pragma unroll 1
    for (int it = F.bid; it < 256; it += F.G) { const int b = it >> 7, pi = (it >> 1) & 63, half = it & 1; idx_unit(F, b, pi, half); }
}

__device__ __forceinline__ unsigned sortable(float f) { const unsigned u = __float_as_uint(f); return (u & 0x80000000u) ? ~u : (u | 0x80000000u); }
__device__ __forceinline__ void topk_row(const Frame& F, int b, int t) {
    int lane = F.lane; asm volatile("" : "+v"(lane));
    const int L = t + 1, tok = b * SEQ + t; unsigned char* ws = F.ws;
    int* sel = (int*)(ws + R_SEL) + (size_t)tok * 256; int* nsel = (int*)(ws + R_NSEL);
    if (lane == 0) nsel[tok] = L < 256 ? L : 256;
    if (L <= 256) { for (int j = lane; j < 256; j += 64) sel[j] = j < L ? j : 0; return; }
    const float* row = (const float*)(ws + R_SCORES) + ((size_t)b * SEQ + t) * SEQ;
    const int nch = (L + 1023) >> 10;
#define TOPK_LOAD_ROW() do { _Pragma("unroll") for (int c = 0; c < 8; ++c) { \
        if (c < nch) { _Pragma("unroll") for (int jj = 0; jj < 4; ++jj) { const int j = c * 4 + jj; const f32x4 v = *(const f32x4*)(row + j * 256 + lane * 4); \
                _Pragma("unroll") for (int e_ = 0; e_ < 4; ++e_) { const int idx = j * 256 + lane * 4 + e_; u[j * 4 + e_] = idx < L ? sortable(v[e_]) : 0u; } } } \
        else { _Pragma("unroll") for (int q = 0; q < 16; ++q) u[c * 16 + q] = 0u; } } } while (0)
    unsigned u[128];
    TOPK_LOAD_ROW();
    unsigned g0 = 0u, g1 = 0u, g2 = 0u, g3 = 0u;
#pragma unroll
    for (int c = 0; c < 8; ++c) if (c < nch) {
#pragma unroll
        for (int jj = 0; jj < 4; ++jj) { const int j = c * 4 + jj; g0 = u[4 * j] > g0 ? u[4 * j] : g0; g1 = u[4 * j + 1] > g1 ? u[4 * j + 1] : g1; g2 = u[4 * j + 2] > g2 ? u[4 * j + 2] : g2; g3 = u[4 * j + 3] > g3 ? u[4 * j + 3] : g3; } }
    unsigned tl = g0 < g1 ? g0 : g1; { const unsigned t2 = g2 < g3 ? g2 : g3; tl = tl < t2 ? tl : t2; }
#pragma unroll
    for (int o = 32; o > 0; o >>= 1) { const unsigned x = (unsigned)__shfl_xor((int)tl, o); tl = x < tl ? x : tl; }
    constexpr int CAP = 2048;
    LAS unsigned* candk = (LAS unsigned*)(F.ldsl + F.wid * (CAP * 8)); LAS unsigned* candi = candk + CAP;
    int C = 0;
#pragma unroll
    for (int c = 0; c < 8; ++c) if (c < nch) {
#pragma unroll
        for (int q = 0; q < 16; ++q) { const int rq = c * 16 + q; const bool pr = u[rq] >= tl; const unsigned long long mm = __ballot(pr);
            const int pos = C + __popcll(mm & ((1ull << lane) - 1ull));
            if (pr && pos < CAP) { candk[pos] = u[rq]; candi[pos] = (unsigned)((rq >> 2) * 256 + lane * 4 + (rq & 3)); }
            C += __popcll(mm); if ((q & 3) == 3) SBAR(); } }
    if (C <= CAP) {
        const int ng = (C + 255) >> 8;
        unsigned ck[32]; int ci[32];
#pragma unroll
        for (int g = 0; g < 8; ++g) {
#pragma unroll
            for (int q = 0; q < 4; ++q) { const int r = g * 4 + q, p = r * 64 + lane; ck[r] = 0u; ci[r] = 0;
                if (g < ng && p < C) { ck[r] = candk[p]; ci[r] = (int)candi[p]; } } }
        unsigned T = 0u, thr_gt = 0u; int need_eq = 0; bool early = false;
        for (int bit = 31; bit >= 0; --bit) {
            const unsigned cnd = T | (1u << bit); int cnt = 0;
#pragma unroll
            for (int g = 0; g < 8; ++g) if (g < ng) {
#pragma unroll
                for (int q = 0; q < 4; ++q) cnt += __popcll(__ballot(ck[g * 4 + q] >= cnd)); }
            if (cnt >= 256) { T = cnd; if (cnt == 256) { early = true; break; } }
        }
        if (early) { thr_gt = T - 1u; need_eq = 0; }
        else { int gtc = 0;
#pragma unroll
            for (int g = 0; g < 8; ++g) if (g < ng) {
#pragma unroll
                for (int q = 0; q < 4; ++q) gtc += __popcll(__ballot(ck[g * 4 + q] > T)); }
            thr_gt = T; need_eq = 256 - gtc; }
        int base = 0, eq_taken = 0;
#pragma unroll
        for (int g = 0; g < 8; ++g) if (g < ng) {
#pragma unroll
            for (int q = 0; q < 4; ++q) { const int r = g * 4 + q; const unsigned v = ck[r];
                const bool iseq = (v == thr_gt) && (need_eq > 0);
                const unsigned long long meq = __ballot(iseq);
                const int eqr = __popcll(meq & ((1ull << lane) - 1ull));
                const bool take = (v > thr_gt) || (iseq && (eq_taken + eqr < need_eq));
                const unsigned long long mt = __ballot(take);
                const int pos = base + __popcll(mt & ((1ull << lane) - 1ull));
                if (take && pos < 256) sel[pos] = ci[r];
                base += __popcll(mt); eq_taken += __popcll(meq); } }
        return;
    }
    asm volatile("" ::: "memory");
    TOPK_LOAD_ROW();
    unsigned T = 0u, thr_gt = 0u; int need_eq = 0; bool early = false;
    for (int bit = 31; bit >= 0; --bit) {
        const unsigned cand = T | (1u << bit); int cnt = 0;
#pragma unroll
        for (int c = 0; c < 8; ++c) if (c < nch) {
#pragma unroll
            for (int q = 0; q < 16; ++q) cnt += __popcll(__ballot(u[c * 16 + q] >= cand)); }
        if (cnt >= 256) { T = cand; if (cnt == 256) { early = true; break; } }
    }
    if (early) { thr_gt = T - 1u; need_eq = 0; }
    else { int gtc = 0;
#pragma unroll
        for (int c = 0; c < 8; ++c) if (c < nch) {
#pragma unroll
            for (int q = 0; q < 16; ++q) gtc += __popcll(__ballot(u[c * 16 + q] > T)); }
        thr_gt = T; need_eq = 256 - gtc; }
    int base = 0, eq_taken = 0;
#pragma unroll
    for (int c = 0; c < 8; ++c) if (c < nch) {
#pragma unroll
        for (int q = 0; q < 16; ++q) { const int rq = c * 16 + q; const unsigned v = u[rq];
            const bool iseq = (v == thr_gt) && (need_eq > 0);
            const unsigned long long meq = __ballot(iseq);
            const int eqr = __popcll(meq & ((1ull << lane) - 1ull));
            const bool take = (v > thr_gt) || (iseq && (eq_taken + eqr < need_eq));
            const unsigned long long mt = __ballot(take);
            const int pos = base + __popcll(mt & ((1ull << lane) - 1ull));
            if (take && pos < 256) sel[pos] = (rq >> 2) * 256 + lane * 4 + (rq & 3);
            base += __popcll(mt); eq_taken += __popcll(meq); } }
}
__device__ __forceinline__ void phase_topk(const Frame& F0) { const Frame F = fresh(F0);
    for (int q = F.bid * 8 + F.wid; q < 8192; q += F.G * 8) { const int b = q >> 12, p = q & 4095; topk_row(F, b, p); topk_row(F, b, SEQ - 1 - p); }
}

namespace att {
constexpr int D = 128, KVBLK = 64, QBLK = 32, SHM_V = 16384, SHM_K = 16384;
constexpr int OFF_K = 2 * SHM_V, OFF_BIAS = 2 * SHM_V + 2 * SHM_K, OFF_WS = OFF_BIAS + 512, OFF_FLAGS = OFF_WS + 2048, OFF_QITEM = OFF_FLAGS + 64;
constexpr float EXIT_T = 44.0f;
#define KSWZ(row, colB) ((row) * 256 + ((colB) ^ (((row) & 7) << 4)))
__device__ __forceinline__ int v_st(int k, int c) { const int kk = (k & ~0xC) | ((k & 4) << 1) | ((k & 8) >> 1); return ((kk >> 3) * 4 + (c >> 5)) * 512 + ((kk & 7) * 32 + (c & 31)) * 2; }
__device__ __forceinline__ int v_rd_base(int lane) { return ((lane & 3) << 3) | (((lane >> 2) & 3) << 6) | (((lane >> 4) & 1) << 5) | (((lane >> 5) & 1) << 8); }
constexpr int v_rd_off(int d0, int ks, int half) { return d0 * 512 + ks * 4096 + half * 2048; }
template <int KB>
__device__ __forceinline__ void qkt(f32x16& p0, f32x16& p1, const char* K_lds, int r32, int hi, const bf16x8* qr) {
    p0 = f32x16{}; p1 = f32x16{};
    const char* kb[4];
#pragma unroll
    for (int dd = 0; dd < 4; ++dd) kb[dd] = K_lds + KB * SHM_K + KSWZ(r32, (dd * 16 + hi * 8) * 2);
#pragma unroll
    for (int d0 = 0; d0 < 8; ++d0) { const char* a = kb[d0 & 3] + (d0 >> 2) * 128;
        bf16x8 b0 = *reinterpret_cast<const bf16x8*>(a);
        bf16x8 b1 = *reinterpret_cast<const bf16x8*>(a + 32 * 256);
        p0 = __builtin_amdgcn_mfma_f32_32x32x16_bf16(b0, qr[d0], p0, 0, 0, 0);
        p1 = __builtin_amdgcn_mfma_f32_32x32x16_bf16(b1, qr[d0], p1, 0, 0, 0); }
}
template <int VB>
__device__ __forceinline__ void pv_tile(f32x16* o, int vb0, bf16x8 pa0, bf16x8 pa1, bf16x8 pa2, bf16x8 pa3) {
#define TRRD(dst, off) asm volatile("ds_read_b64_tr_b16 %0, %1 offset:%2" : "=&v"(dst) : "v"(vb0), "i"(off) : "memory")
#define PV_D0(d0) do { s16x4 l0, l1, l2, l3, h0, h1, h2, h3; constexpr int b_ = VB * SHM_V + v_rd_off(d0, 0, 0); \
        TRRD(l0, b_); TRRD(h0, b_ + 2048); TRRD(l1, b_ + 4096); TRRD(h1, b_ + 6144); TRRD(l2, b_ + 8192); TRRD(h2, b_ + 10240); TRRD(l3, b_ + 12288); TRRD(h3, b_ + 14336); \
        asm volatile("s_waitcnt lgkmcnt(0)" ::: "memory"); SBAR(); \
        o[d0] = __builtin_amdgcn_mfma_f32_32x32x16_bf16(pa0, (bf16x8){l0[0], l0[1], l0[2], l0[3], h0[0], h0[1], h0[2], h0[3]}, o[d0], 0, 0, 0); \
        o[d0] = __builtin_amdgcn_mfma_f32_32x32x16_bf16(pa1, (bf16x8){l1[0], l1[1], l1[2], l1[3], h1[0], h1[1], h1[2], h1[3]}, o[d0], 0, 0, 0); \
        o[d0] = __builtin_amdgcn_mfma_f32_32x32x16_bf16(pa2, (bf16x8){l2[0], l2[1], l2[2], l2[3], h2[0], h2[1], h2[2], h2[3]}, o[d0], 0, 0, 0); \
        o[d0] = __builtin_amdgcn_mfma_f32_32x32x16_bf16(pa3, (bf16x8){l3[0], l3[1], l3[2], l3[3], h3[0], h3[1], h3[2], h3[3]}, o[d0], 0, 0, 0); } while (0)
    PV_D0(0); PV_D0(1); PV_D0(2); PV_D0(3);
#undef PV_D0
#undef TRRD
}
#define PK4(P, B_, OUT) do { unsigned a0 = cvtpk(P[B_+0], P[B_+1]), a1 = cvtpk(P[B_+2], P[B_+3]); \
        unsigned b0 = cvtpk(P[B_+4], P[B_+5]), b1 = cvtpk(P[B_+6], P[B_+7]); \
        auto r0 = __builtin_amdgcn_permlane32_swap(a0, b0, false, false); auto r1 = __builtin_amdgcn_permlane32_swap(a1, b1, false, false); \
        u32x4 w = {r0[0], r1[0], r0[1], r1[1]}; OUT = *reinterpret_cast<bf16x8*>(&w); } while (0)
__device__ __forceinline__ float swap_max(float x) { auto rr = __builtin_amdgcn_permlane32_swap(__float_as_uint(x), __float_as_uint(x), false, false); return fmaxf(__uint_as_float(rr[0]), __uint_as_float(rr[1])); }
__device__ __forceinline__ float swap_sum(float x) { auto rr = __builtin_amdgcn_permlane32_swap(__float_as_uint(x), __float_as_uint(x), false, false); return __uint_as_float(rr[0]) + __uint_as_float(rr[1]); }
__device__ __forceinline__ float swap_lo(float x) { auto rr = __builtin_amdgcn_permlane32_swap(__float_as_uint(x), __float_as_uint(x), false, false); return __uint_as_float(rr[0]); }


__device__ __forceinline__ void fox_sm(f32x16& p0, f32x16& p1, const float* bl, int kb_, int qlo, int qrow, int hi, int r32, float& m_reg, float& l_reg, f32x16* o, float* al_l,
                                       bf16x8& pa0, bf16x8& pa1, bf16x8& pa2, bf16x8& pa3) {
#pragma unroll
    for (int g = 0; g < 4; ++g) { const f32x4 b0v = *(const f32x4*)(bl + 8 * g + 4 * hi), b1v = *(const f32x4*)(bl + 32 + 8 * g + 4 * hi);
#pragma unroll
        for (int i = 0; i < 4; ++i) { p0[4 * g + i] = fmaf(p0[4 * g + i], C2, b0v[i]); p1[4 * g + i] = fmaf(p1[4 * g + i], C2, b1v[i]); } }
    if (kb_ + KVBLK - 1 > qlo) { const float NEG = -__builtin_inff();
#pragma unroll
        for (int r = 0; r < 16; ++r) { const int key = kb_ + crow(r, hi); if (key > qrow) p0[r] = NEG; if (key + 32 > qrow) p1[r] = NEG; } }
    float pmax = p0[0];
#pragma unroll
    for (int r = 1; r < 16; ++r) pmax = fmaxf(pmax, p0[r]);
#pragma unroll
    for (int r = 0; r < 16; ++r) pmax = fmaxf(pmax, p1[r]);
    pmax = swap_max(pmax);
    const float mn = fmaxf(m_reg, pmax), alpha = __builtin_amdgcn_exp2f(m_reg - mn); m_reg = mn;
    float ps = 0.f;
#pragma unroll
    for (int r = 0; r < 16; ++r) { p0[r] = __builtin_amdgcn_exp2f(p0[r] - mn); p1[r] = __builtin_amdgcn_exp2f(p1[r] - mn); ps += p0[r] + p1[r]; }
    ps = swap_sum(ps); l_reg = l_reg * alpha + ps;
    if (__any(alpha < 1.f)) { if (hi == 0) al_l[r32] = alpha; asm volatile("s_waitcnt lgkmcnt(0)" ::: "memory");
#pragma unroll
        for (int r = 0; r < 16; ++r) { const float a = al_l[crow(r, hi)];
#pragma unroll
            for (int d_ = 0; d_ < 4; ++d_) o[d_][r] *= a; } }
    PK4(p0, 0, pa0); PK4(p0, 8, pa1); PK4(p1, 0, pa2); PK4(p1, 8, pa3);
}
__device__ __forceinline__ void sb_half(f32x16& pz, int keybase, int qrow, int hi, float& R, const bf16x8* triA, bool needmask) {
    f32x16 X;
#pragma unroll
    for (int r = 0; r < 16; ++r) { const float zz = pz[r] * C2; const bool valid = !needmask || (keybase + crow(r, hi) < qrow);
        const float l2 = fmaxf(zz, 0.f) + __builtin_amdgcn_logf(1.0f + __builtin_amdgcn_exp2f(-fabsf(zz)));
        X[r] = valid ? -l2 : 0.f; pz[r] = valid ? zz : -__builtin_inff(); }
    f32x16 Y;
#pragma unroll
    for (int r = 0; r < 16; ++r) Y[r] = R;
#pragma unroll
    for (int s = 0; s < 2; ++s) {
        const unsigned h0 = cvtpk(X[8 * s + 0], X[8 * s + 1]), h1 = cvtpk(X[8 * s + 2], X[8 * s + 3]), h2 = cvtpk(X[8 * s + 4], X[8 * s + 5]), h3 = cvtpk(X[8 * s + 6], X[8 * s + 7]);
        const unsigned l0 = cvtpk(X[8 * s + 0] - bflo(h0), X[8 * s + 1] - bfhi(h0)), l1 = cvtpk(X[8 * s + 2] - bflo(h1), X[8 * s + 3] - bfhi(h1));
        const unsigned l2 = cvtpk(X[8 * s + 4] - bflo(h2), X[8 * s + 5] - bfhi(h2)), l3 = cvtpk(X[8 * s + 6] - bflo(h3), X[8 * s + 7] - bfhi(h3));
        u32x4 wh = {h0, h1, h2, h3}, wl = {l0, l1, l2, l3};
        Y = __builtin_amdgcn_mfma_f32_32x32x16_bf16(triA[s], *reinterpret_cast<bf16x8*>(&wh), Y, 0, 0, 0);
        Y = __builtin_amdgcn_mfma_f32_32x32x16_bf16(triA[s], *reinterpret_cast<bf16x8*>(&wl), Y, 0, 0, 0); }
#pragma unroll
    for (int r = 0; r < 16; ++r) pz[r] = __builtin_amdgcn_exp2f(pz[r] + Y[r]);
    R = swap_lo(Y[0]);
}
__device__ __forceinline__ void sb_sm(f32x16& p0, f32x16& p1, int kb_, int qlo, int qrow, int hi, float& R, const bf16x8* triA, bf16x8& pa0, bf16x8& pa1, bf16x8& pa2, bf16x8& pa3) {
    const bool needmask = (kb_ + KVBLK - 1 >= qlo);
    sb_half(p1, kb_ + 32, qrow, hi, R, triA, needmask);
    sb_half(p0, kb_, qrow, hi, R, triA, needmask);
    PK4(p0, 0, pa0); PK4(p0, 8, pa1); PK4(p1, 0, pa2); PK4(p1, 8, pa3);
}

template <int MODE>
__device__ __forceinline__ void attn_unit(const bf16_t* Q, const bf16_t* Kh, const bf16_t* Vh, const float* cum, bf16_t* O, int P0, char* lds, float kmaxc) {
    int tid = threadIdx.x; asm volatile("" : "+v"(tid));
    const int wid = __builtin_amdgcn_readfirstlane(tid >> 6), lane = tid & 63, r32 = lane & 31, hi = lane >> 5;
    const int NT = P0 / KVBLK + 4;
    char* V_lds = lds; char* K_lds = lds + OFF_K; float* bias_l = (float*)(lds + OFF_BIAS);
    float* wsl = (float*)(lds + OFF_WS) + wid * 64; float* li_l = wsl; float* al_l = wsl + 32;
    const int qlo = P0 + wid * QBLK, qrow = qlo + r32;
    bf16x8 qr[8];
#pragma unroll
    for (int d0 = 0; d0 < 8; ++d0) qr[d0] = *(const bf16x8*)(Q + (size_t)qrow * D + d0 * 16 + hi * 8);
    const int sr = tid >> 4, sc = (tid & 15) * 8, vst0 = v_st(sr, sc), vst1 = v_st(32 + sr, sc), kws = KSWZ(sr, sc * 2);
    const int vb0 = (int)(uintptr_t)V_lds + v_rd_base(lane);
    const float cumref = (MODE == 0) ? cum[P0] : 0.f;
    int* flg = (int*)(lds + OFF_FLAGS);
    float qn = 0.f;
    if (MODE == 0) { float ss = 0.f;
#pragma unroll
        for (int d0 = 0; d0 < 8; ++d0)
#pragma unroll
            for (int j = 0; j < 8; ++j) { const float x = bf2f((bf16_t)qr[d0][j]); ss = fmaf(x, x, ss); }
        ss = swap_sum(ss); qn = sqrtf(ss) * kmaxc * 1.001f; }
    float m_reg = -1e30f, l_reg = 0.f, R = 0.f; f32x16 o[4] = {};
    bf16x8 triA[2];
    if (MODE == 1) {
#pragma unroll
        for (int s = 0; s < 2; ++s)
#pragma unroll
            for (int j = 0; j < 8; ++j) { const int rho = 16 * s + 8 * (j >> 2) + 4 * hi + (j & 3); triA[s][j] = (rho >= r32) ? (short)0x3F80 : (short)0; }
    }
    bf16x8 st_k0, st_k1, st_v0, st_v1; float st_b = 0.f;
#define TILE_KB(t) ((NT - 1 - (t)) * KVBLK)
#define SLOAD(kb_) do { st_v0 = *(const bf16x8*)(Vh + (size_t)((kb_) + sr) * D + sc); st_v1 = *(const bf16x8*)(Vh + (size_t)((kb_) + 32 + sr) * D + sc); \
                        st_k0 = *(const bf16x8*)(Kh + (size_t)((kb_) + sr) * D + sc); st_k1 = *(const bf16x8*)(Kh + (size_t)((kb_) + 32 + sr) * D + sc); \
                        if (MODE == 0 && tid < 64) st_b = (cumref - cum[(kb_) + tid]) * LOG2E; } while (0)
#define SWRITE(bf) do { *(bf16x8*)(V_lds + (bf) * SHM_V + vst0) = st_v0; *(bf16x8*)(V_lds + (bf) * SHM_V + vst1) = st_v1; \
                        *(bf16x8*)(K_lds + (bf) * SHM_K + kws) = st_k0; *(bf16x8*)(K_lds + (bf) * SHM_K + kws + 32 * 256) = st_k1; \
                        if (MODE == 0 && tid < 64) bias_l[(bf) * 64 + tid] = st_b; } while (0)
    __syncthreads();
    SLOAD(TILE_KB(0)); SWRITE(0);
    __syncthreads();
    f32x16 p0, p1; bf16x8 pa0, pa1, pa2, pa3;
#define STEP(BUF, t) do { const int kb_ = TILE_KB(t); \
        if ((t) + 1 < NT) SLOAD(TILE_KB((t) + 1)); \
        SBAR(); qkt<BUF>(p0, p1, K_lds, r32, hi, qr); \
        if (MODE == 0) fox_sm(p0, p1, bias_l + (BUF) * 64, kb_, qlo, qrow, hi, r32, m_reg, l_reg, o, al_l, pa0, pa1, pa2, pa3); \
        else sb_sm(p0, p1, kb_, qlo, qrow, hi, R, triA, pa0, pa1, pa2, pa3); \
        SBAR(); pv_tile<BUF>(o, vb0, pa0, pa1, pa2, pa3); \
        if ((t) + 1 < NT) SWRITE((BUF) ^ 1); \
        __syncthreads(); } while (0)
    for (int t = 0; t < NT; t += 2) {
        STEP(0, t); STEP(1, t + 1);
        const int kbc = TILE_KB(t + 1); if (kbc == 0) break;
        bool done;
        if (MODE == 0) { const float edge = (cumref - cum[kbc - 1]) * LOG2E; done = (qn + edge - m_reg) < -EXIT_T; }
        else done = R < -EXIT_T;
        const int par = (t >> 1) & 1;
        if (lane == 0) flg[par * 8 + wid] = 0;
        const bool wdone = __all(done);
        if (lane == 0 && wdone) flg[par * 8 + wid] = 1;
        __syncthreads();
        int alld = 1;
#pragma unroll
        for (int w = 0; w < 8; ++w) alld &= flg[par * 8 + w];
        if (alld) break;
    }
    __syncthreads();
#undef STEP
#undef SLOAD
#undef SWRITE
#undef TILE_KB
    float rli[16];
    if (MODE == 0) { if (hi == 0) li_l[r32] = l_reg; asm volatile("s_waitcnt lgkmcnt(0)" ::: "memory");
#pragma unroll
        for (int r = 0; r < 16; ++r) rli[r] = __builtin_amdgcn_rcpf(li_l[crow(r, hi)]); }
    bf16_t* Ow = O + (size_t)(wid * QBLK) * 3072;
#pragma unroll
    for (int r = 0; r < 16; ++r) { const int orow = crow(r, hi);
#pragma unroll
        for (int d0 = 0; d0 < 4; ++d0) { const float v = (MODE == 0) ? o[d0][r] * rli[r] : o[d0][r];
            const float vn = __shfl_xor(v, 1);
            if ((r32 & 1) == 0) *(unsigned*)(Ow + (size_t)orow * 3072 + d0 * 32 + r32) = cvtpk(v, vn); } }
}
}

__device__ __forceinline__ void sparse_query(const Frame& F, int tok, char* ldsw) {
    unsigned char* ws = F.ws; const int lane = F.lane, g = lane >> 4, i16 = lane & 15;
    const bf16_t* qcat = (const bf16_t*)(ws + R_QCAT) + (size_t)tok * 2304; const bf16_t* kbase = (const bf16_t*)(ws + R_KCAT) + (size_t)(tok >> 13) * SEQ * 288;
    const int* sel = (const int*)(ws + R_SEL) + (size_t)tok * 256; const int ns = ((const int*)(ws + R_NSEL))[tok]; const int ntile = (ns + 31) >> 5;
    bf16x8 qf[9];
#pragma unroll
    for (int st = 0; st < 9; ++st) { qf[st] = (bf16x8){0, 0, 0, 0, 0, 0, 0, 0}; if (i16 < 8) qf[st] = *(const bf16x8*)(qcat + i16 * 288 + st * 32 + 8 * g); }
    const int rA = lane >> 2, cq = lane & 3;
    float m = -1e30f, l = 0.f; f32x4 oT[16];
#pragma unroll
    for (int rb = 0; rb < 16; ++rb) oT[rb] = (f32x4){0.f, 0.f, 0.f, 0.f};
    const unsigned ldso = (unsigned)(uintptr_t)ldsw;
    const unsigned vb = ldso + (unsigned)((4 * g + (i16 >> 2)) * 592 + (i16 & 3) * 8);
    constexpr float SC2 = SCALE * LOG2E;
    bf16x8 stg[18];
#define GATHER(tile_) do { const int j0 = (tile_) * 32 + rA, j1 = j0 + 16; const int s0 = j0 < ns ? sel[j0] : 0, s1 = j1 < ns ? sel[j1] : 0; \
        const bf16_t* p0_ = kbase + (size_t)s0 * 288 + cq * 8; const bf16_t* p1_ = kbase + (size_t)s1 * 288 + cq * 8; \
        _Pragma("unroll") for (int c = 0; c < 9; ++c) { stg[2 * c] = *(const bf16x8*)(p0_ + c * 32); stg[2 * c + 1] = *(const bf16x8*)(p1_ + c * 32); } } while (0)
    GATHER(0);
    for (int tile = 0; tile < ntile; ++tile) {
#pragma unroll
        for (int c = 0; c < 9; ++c) { *(bf16x8*)(ldsw + rA * 592 + c * 64 + cq * 16) = stg[2 * c]; *(bf16x8*)(ldsw + (16 + rA) * 592 + c * 64 + cq * 16) = stg[2 * c + 1]; }
        if (tile + 1 < ntile) GATHER(tile + 1);
        asm volatile("s_waitcnt lgkmcnt(0)" ::: "memory"); SBAR();
        f32x4 acc[2];
#pragma unroll
        for (int mt = 0; mt < 2; ++mt) { acc[mt] = (f32x4){0.f, 0.f, 0.f, 0.f};
#pragma unroll
            for (int st = 0; st < 9; ++st) { const bf16x8 a = *(const bf16x8*)(ldsw + (16 * mt + i16) * 592 + st * 64 + g * 16);
                acc[mt] = __builtin_amdgcn_mfma_f32_16x16x32_bf16(a, qf[st], acc[mt], 0, 0, 0); } }
        float tmax = -__builtin_inff();
#pragma unroll
        for (int mt = 0; mt < 2; ++mt)
#pragma unroll
            for (int r = 0; r < 4; ++r) { const int key = tile * 32 + 16 * mt + 4 * g + r; float x = acc[mt][r] * SC2; if (key >= ns) x = -__builtin_inff(); acc[mt][r] = x; tmax = fmaxf(tmax, x); }
        tmax = fmaxf(tmax, __shfl_xor(tmax, 16)); tmax = fmaxf(tmax, __shfl_xor(tmax, 32));
        const float mn = fmaxf(m, tmax), alpha = __builtin_amdgcn_exp2f(m - mn); m = mn;
        float ps = 0.f;
#pragma unroll
        for (int mt = 0; mt < 2; ++mt)
#pragma unroll
            for (int r = 0; r < 4; ++r) { acc[mt][r] = __builtin_amdgcn_exp2f(acc[mt][r] - mn); ps += acc[mt][r]; }
        ps += __shfl_xor(ps, 16); ps += __shfl_xor(ps, 32);
        l = l * alpha + ps;
#pragma unroll
        for (int rb = 0; rb < 16; ++rb) oT[rb] *= alpha;
        const bf16x8 pf = pack8(acc[0], acc[1]);
#define TRRD2(dst, off) asm volatile("ds_read_b64_tr_b16 %0, %1 offset:%2" : "=&v"(dst) : "v"(vb), "i"(off) : "memory")
#define PVRB4(rb) do { s16x4 ta0, tb0, ta1, tb1, ta2, tb2, ta3, tb3; \
        TRRD2(ta0, ((rb) + 0) * 32); TRRD2(tb0, ((rb) + 0) * 32 + 16 * 592); TRRD2(ta1, ((rb) + 1) * 32); TRRD2(tb1, ((rb) + 1) * 32 + 16 * 592); \
        TRRD2(ta2, ((rb) + 2) * 32); TRRD2(tb2, ((rb) + 2) * 32 + 16 * 592); TRRD2(ta3, ((rb) + 3) * 32); TRRD2(tb3, ((rb) + 3) * 32 + 16 * 592); \
        asm volatile("s_waitcnt lgkmcnt(0)" ::: "memory"); SBAR(); \
        oT[(rb) + 0] = __builtin_amdgcn_mfma_f32_16x16x32_bf16((bf16x8){ta0[0], ta0[1], ta0[2], ta0[3], tb0[0], tb0[1], tb0[2], tb0[3]}, pf, oT[(rb) + 0], 0, 0, 0); \
        oT[(rb) + 1] = __builtin_amdgcn_mfma_f32_16x16x32_bf16((bf16x8){ta1[0], ta1[1], ta1[2], ta1[3], tb1[0], tb1[1], tb1[2], tb1[3]}, pf, oT[(rb) + 1], 0, 0, 0); \
        oT[(rb) + 2] = __builtin_amdgcn_mfma_f32_16x16x32_bf16((bf16x8){ta2[0], ta2[1], ta2[2], ta2[3], tb2[0], tb2[1], tb2[2], tb2[3]}, pf, oT[(rb) + 2], 0, 0, 0); \
        oT[(rb) + 3] = __builtin_amdgcn_mfma_f32_16x16x32_bf16((bf16x8){ta3[0], ta3[1], ta3[2], ta3[3], tb3[0], tb3[1], tb3[2], tb3[3]}, pf, oT[(rb) + 3], 0, 0, 0); } while (0)
        PVRB4(0); PVRB4(4); PVRB4(8); PVRB4(12);
#undef PVRB4
#undef TRRD2
        SBAR();
    }
#undef GATHER
    const float rl = 1.0f / l;
    if (i16 < 8) { bf16_t* op = (bf16_t*)(ws + R_OLAT) + (size_t)tok * 2048 + i16 * 256 + 4 * g;
#pragma unroll
        for (int rb = 0; rb < 16; ++rb) { u32x2 w; w.x = cvtpk(oT[rb][0] * rl, oT[rb][1] * rl); w.y = cvtpk(oT[rb][2] * rl, oT[rb][3] * rl); *(u32x2*)(op + rb * 16) = w; } }
}
#ifdef ATT_SUB
#define ASUB(k) ((k) == ATT_SUB)
#else
#define ASUB(k) true
#endif
__device__ __forceinline__ void phase_attn(const Frame& F0, int l, int rep) { const Frame F = fresh(F0);
    unsigned char* ws = F.ws; char* lds = (char*)F.lds;
    const bf16_t* qkv = (const bf16_t*)(ws + R_QKV); const size_t TS = (size_t)NTOK * 1024;
    unsigned* qctr = (unsigned*)(ws + WS_CTL) + CW_QCTR + l * 64 + rep * 16; const unsigned* kmx = (const unsigned*)(ws + WS_CTL) + CW_KMAX + l * 16;
    int* qitem = (int*)(lds + att::OFF_QITEM);
    int* hord = qitem + 4;
    if (F.tid < 16) { const float* cumb = (const float*)(ws + WS_CUM); const float mine = -cumb[(size_t)F.tid * SEQ + SEQ - 1]; int rank = 0;
        for (int o = 0; o < 16; ++o) { const float v = -cumb[(size_t)o * SEQ + SEQ - 1]; rank += (v < mine || (v == mine && o < F.tid)) ? 1 : 0; }
        hord[rank] = F.tid; }
#pragma unroll 1
    for (;;) {
        __syncthreads();
        if (F.tid == 0) qitem[0] = (int)atomicAdd(qctr, 1u);
        __syncthreads();
        const int it = qitem[0];
        if (it >= 1024) break;
        const int md = it >> 9, j = it & 511;
        const int qb = md == 0 ? 31 - (j & 31) : 31 - (j >> 4), bh = md == 0 ? hord[j >> 5] : (j & 15), b = bh >> 3, h = bh & 7, P0 = qb * 256;
        if (!ASUB(md)) continue;
        const bf16_t* Q = qkv + (size_t)(md * 3 + 0) * TS + (size_t)bh * SEQ * 128; const bf16_t* K = qkv + (size_t)(md * 3 + 1) * TS + (size_t)bh * SEQ * 128; const bf16_t* V = qkv + (size_t)(md * 3 + 2) * TS + (size_t)bh * SEQ * 128;
        const float* cum = (const float*)(ws + WS_CUM) + (size_t)bh * SEQ;
        bf16_t* Ob = (bf16_t*)(ws + R_OA) + (size_t)b * SEQ * 3072 + (md + 1) * 1024 + h * 128;
        if (md == 0) { const float kmaxc = sqrtf(__uint_as_float(kmx[bh])) * C2; att::attn_unit<0>(Q, K, V, cum, Ob + (size_t)P0 * 3072, P0, lds, kmaxc); }
        else att::attn_unit<1>(Q, K, V, cum, Ob + (size_t)P0 * 3072, P0, lds, 0.f);
    }
    __syncthreads();
    char* ldsw = lds + F.wid * 18944;
#pragma unroll 1
    for (int rep = 0; rep < NREP(2); ++rep)
#pragma unroll 1
    for (int tok = F.bid * 8 + F.wid; tok < NTOK; tok += F.G * 8) if (ASUB(2)) sparse_query(F, tok, ldsw);
}

__device__ __forceinline__ void ln_row(const bf16_t* src, const float* g, const float* bta, float* of, bf16_t* ob, int lane, unsigned char* oq = nullptr, float* osc = nullptr, float* ost = nullptr) {
    f32x4 v[8]; float s = 0.f;
#pragma unroll
    for (int i = 0; i < 4; ++i) { const u32x4 w = *(const u32x4*)(src + (i * 64 + lane) * 8);
        v[2 * i] = (f32x4){bflo(w.x), bfhi(w.x), bflo(w.y), bfhi(w.y)}; v[2 * i + 1] = (f32x4){bflo(w.z), bfhi(w.z), bflo(w.w), bfhi(w.w)};
        s += (v[2 * i][0] + v[2 * i][1]) + (v[2 * i][2] + v[2 * i][3]) + (v[2 * i + 1][0] + v[2 * i + 1][1]) + (v[2 * i + 1][2] + v[2 * i + 1][3]); }
    s = wave_sum(s); const float mu = s * (1.0f / 2048.0f); float q = 0.f;
#pragma unroll
    for (int i = 0; i < 8; ++i) { const f32x4 d = v[i] - mu; q += (d[0] * d[0] + d[1] * d[1]) + (d[2] * d[2] + d[3] * d[3]); }
    q = wave_sum(q); const float rstd = rsqrtf(q * (1.0f / 2048.0f) + 1e-5f);
    if (ost && lane == 0) { ost[0] = mu; ost[1] = rstd; }
    float amax = 0.f;
#pragma unroll
    for (int i = 0; i < 4; ++i) { const int c = (i * 64 + lane) * 8; const f32x4 g0 = *(const f32x4*)(g + c), g1 = *(const f32x4*)(g + c + 4), b0 = *(const f32x4*)(bta + c), b1 = *(const f32x4*)(bta + c + 4);
        const f32x4 y0 = (v[2 * i] - mu) * rstd * g0 + b0, y1 = (v[2 * i + 1] - mu) * rstd * g1 + b1; v[2 * i] = y0; v[2 * i + 1] = y1;
        if (of) { *(f32x4*)(of + c) = y0; *(f32x4*)(of + c + 4) = y1; }
        if (ob) pg8::st_bf16x8(ob + c, y0, y1);
        if (oq) { amax = fmaxf(amax, fmaxf(fmaxf(fmaxf(fabsf(y0[0]), fabsf(y0[1])), fmaxf(fabsf(y0[2]), fabsf(y0[3]))), fmaxf(fmaxf(fabsf(y1[0]), fabsf(y1[1])), fmaxf(fabsf(y1[2]), fabsf(y1[3]))))); } }
    if (oq) {
        for (int o = 32; o > 0; o >>= 1) amax = fmaxf(amax, __shfl_xor(amax, o));
        amax = fmaxf(amax, 1e-20f); const float qi = 127.0f / amax; if (lane == 0) *osc = amax * (1.0f / 127.0f);
#pragma unroll
        for (int i = 0; i < 4; ++i) { u32x2 w;
#pragma unroll
            for (int h = 0; h < 2; ++h) { const f32x4 y = v[2 * i + h]; unsigned pk = 0u;
#pragma unroll
                for (int j = 0; j < 4; ++j) pk |= ((unsigned)(int)rintf(y[j] * qi) & 0xffu) << (8 * j);
                w[h] = pk; }
            *(u32x2*)(oq + (i * 64 + lane) * 8) = w; } }
}
__device__ __forceinline__ void phase_ln1_router(const Frame& F0, const Params& P, int l) { const Frame F = fresh(F0);
    unsigned char* ws = F.ws; const int lane = F.lane, wid = F.wid;
    const bf16_t* pre1 = (const bf16_t*)(ws + R_PRE1); float* x1f = (float*)(ws + M_X1F); bf16_t* x1b = (bf16_t*)(ws + M_X1B); unsigned char* x1q = (unsigned char*)(ws + M_X1Q); float* x1s = (float*)(ws + M_X1S);
    const float* g = F.in(11) + l * DM; const float* bt = F.in(12) + l * DM; const float* wr = F.in(13) + (size_t)l * DM * NEXP; const float* br = F.in(14) + l * NEXP;
    unsigned* cnt = (unsigned*)(ws + WS_CTL) + CW_CNT + l * 2048;
    int* tok_e = (int*)(ws + M_TOKE); int* tok_pos = (int*)(ws + M_TOKPOS); float* tok_w = (float*)(ws + M_TOKW);
    float* red = (float*)F.lds;
    float* lg = (float*)(F.lds + 32768); float* stats = (float*)(F.lds + 32768 + 16384);
#pragma unroll 1
    for (int blk = F.bid; blk < NTOK / 64; blk += F.G) {
        const int tok0 = blk * 64;
#pragma unroll 1
        for (int i = 0; i < 8; ++i) { const int tok = tok0 + wid * 8 + i; ln_row(pre1 + (size_t)tok * DM, g, bt, (float*)nullptr, x1b + (size_t)tok * DM, lane, x1q + (size_t)tok * DM, x1s + tok, stats + 2 * (wid * 8 + i)); }
        asm volatile("s_waitcnt vmcnt(0)" ::: "memory"); __syncthreads();
        { const int grp = wid >> 2, kq = wid & 3, i32 = lane & 31, hk = lane >> 5; f32x16 acc = {};
          const bf16_t* arow = pre1 + (size_t)(tok0 + grp * 32 + i32) * DM + kq * 512 + 4 * hk; const float* bcol = wr + (size_t)(kq * 512 + 4 * hk) * NEXP + i32;
          const float* gp = g + kq * 512 + 4 * hk; const float* bp = bt + kq * 512 + 4 * hk; const float mu = stats[2 * (grp * 32 + i32)], rstd = stats[2 * (grp * 32 + i32) + 1];
#pragma unroll 4
          for (int c8 = 0; c8 < 64; ++c8) { const u32x2 xw = *(const u32x2*)(arow + c8 * 8); const f32x4 g4 = *(const f32x4*)(gp + c8 * 8), b4 = *(const f32x4*)(bp + c8 * 8);
              const f32x4 a4 = ((f32x4){bflo(xw.x), bfhi(xw.x), bflo(xw.y), bfhi(xw.y)} - mu) * rstd * g4 + b4;
              const float b0 = bcol[(size_t)(c8 * 8 + 0) * NEXP], b1 = bcol[(size_t)(c8 * 8 + 1) * NEXP], b2 = bcol[(size_t)(c8 * 8 + 2) * NEXP], b3 = bcol[(size_t)(c8 * 8 + 3) * NEXP];
              acc = __builtin_amdgcn_mfma_f32_32x32x2f32(a4[0], b0, acc, 0, 0, 0); acc = __builtin_amdgcn_mfma_f32_32x32x2f32(a4[1], b1, acc, 0, 0, 0);
              acc = __builtin_amdgcn_mfma_f32_32x32x2f32(a4[2], b2, acc, 0, 0, 0); acc = __builtin_amdgcn_mfma_f32_32x32x2f32(a4[3], b3, acc, 0, 0, 0); }
#pragma unroll
          for (int r = 0; r < 16; ++r) red[(wid * 16 + r) * 64 + lane] = acc[r]; }
        __syncthreads();
        if ((wid & 3) == 0) { const int grp = wid >> 2, hk = lane >> 5, e = lane & 31; const float be = br[e];
#pragma unroll
            for (int r = 0; r < 16; ++r) { const float v = red[((wid + 0) * 16 + r) * 64 + lane] + red[((wid + 1) * 16 + r) * 64 + lane] + red[((wid + 2) * 16 + r) * 64 + lane] + red[((wid + 3) * 16 + r) * 64 + lane] + be;
                lg[(grp * 32 + crow(r, hk)) * 33 + e] = v; }
            asm volatile("s_waitcnt lgkmcnt(0)" ::: "memory"); SBAR();
            const int tk = lane & 31; float v[32];
#pragma unroll
            for (int e2 = 0; e2 < 32; ++e2) v[e2] = lg[(grp * 32 + tk) * 33 + e2];
            int ek[4]; float vk[4];
#pragma unroll
            for (int k = 0; k < 4; ++k) { float best = -__builtin_inff(); int bi = 0;
#pragma unroll
                for (int e2 = 0; e2 < 32; ++e2) if (v[e2] > best) { best = v[e2]; bi = e2; }
                ek[k] = bi; vk[k] = best;
#pragma unroll
                for (int e2 = 0; e2 < 32; ++e2) v[e2] = (e2 == bi) ? -__builtin_inff() : v[e2]; }
            float wk[4], sw = 0.f;
#pragma unroll
            for (int k = 0; k < 4; ++k) { wk[k] = __expf(vk[k] - vk[0]); sw += wk[k]; }
            const float rs = 1.0f / sw;
            const bool act = lane < 32; unsigned myc = 0u;
#pragma unroll 1
            for (int E = 0; E < 32; ++E) { unsigned c = 0u;
#pragma unroll
                for (int k = 0; k < 4; ++k) c += (unsigned)__popcll(__ballot(act && ek[k] == E));
                if (lane == E) myc = c; }
            unsigned run = 0u; if (lane < 32 && myc > 0u) run = atomicAdd(&cnt[lane * 64], myc);
            int pk[4];
#pragma unroll
            for (int k = 0; k < 4; ++k) { pk[k] = 0;
#pragma unroll 1
                for (int E = 0; E < 32; ++E) { const unsigned long long mm = __ballot(act && ek[k] == E); const unsigned basev = (unsigned)__shfl((int)run, E);
                    if (act && ek[k] == E) pk[k] = (int)(basev + (unsigned)__popcll(mm & ((1ull << lane) - 1ull)));
                    if (lane == E) run += (unsigned)__popcll(mm); } }
            if (act) { const int tok = tok0 + grp * 32 + tk;
#pragma unroll
                for (int k = 0; k < 4; ++k) { tok_e[tok * 4 + k] = ek[k]; tok_pos[tok * 4 + k] = pk[k]; tok_w[tok * 4 + k] = wk[k] * rs; } }
        }
        __syncthreads();
    }
}
__device__ __forceinline__ void phase_moe_gather(const Frame& F0, int l) { const Frame F = fresh(F0);
    unsigned char* ws = F.ws; const int lane = F.lane;
    const unsigned* cnt = (const unsigned*)(ws + WS_CTL) + CW_CNT + l * 2048; unsigned* meta = (unsigned*)(ws + WS_CTL) + CW_META + l * 512;
    unsigned* offs = (unsigned*)(F.lds + LDS_MISC + 64);
    if (F.tid == 0) { unsigned o = 0u; for (int e = 0; e < 32; ++e) { offs[e] = o; o += (cnt[e * 64] + 255u) & ~255u; } offs[32] = o;
        if (F.bid == 0) { meta[0] = o >> 8; for (int e = 0; e < 32; ++e) for (unsigned t = offs[e] >> 8; t < (offs[e + 1] >> 8); ++t) meta[1 + t] = (unsigned)e; } }
    __syncthreads();
    const int* tok_e = (const int*)(ws + M_TOKE); const int* tok_pos = (const int*)(ws + M_TOKPOS); const float* tok_w = (const float*)(ws + M_TOKW);
    int* tok_dst = (int*)(ws + M_TOKDST); float* roww = (float*)(ws + M_ROWW);
    const unsigned char* x1q = (const unsigned char*)(ws + M_X1Q); const float* x1s = (const float*)(ws + M_X1S); unsigned char* xs = (unsigned char*)(ws + M_XS); float* rowsx = (float*)(ws + M_ROWSX);
    for (int it = F.bid * 8 + F.wid; it < NTOK * 4; it += F.G * 8) { const int tok = it >> 2;
        const int e = tok_e[it]; const unsigned dst = offs[e] + (unsigned)tok_pos[it];
        if (lane == 0) { tok_dst[it] = (int)dst; roww[dst] = tok_w[it]; rowsx[dst] = x1s[tok]; }
        const u32x4* sp = (const u32x4*)(x1q + (size_t)tok * DM); u32x4* dp = (u32x4*)(xs + (size_t)dst * DM);
#pragma unroll
        for (int i = 0; i < 2; ++i) dp[i * 64 + lane] = sp[i * 64 + lane]; }
    __syncthreads();
}
__device__ __forceinline__ void phase_combine(const Frame& F0) { const Frame F = fresh(F0);
    unsigned char* ws = F.ws; const int lane = F.lane;
    const bf16_t* x1b = (const bf16_t*)(ws + M_X1B); const bf16_t* ys = (const bf16_t*)(ws + M_XS); const int* tok_dst = (const int*)(ws + M_TOKDST);
    bf16_t* hb = (bf16_t*)(ws + M_HB); unsigned char* hq = (unsigned char*)(ws + M_HQ); float* hsc = (float*)(ws + M_HSC);
    for (int tok = F.bid * 8 + F.wid; tok < NTOK; tok += F.G * 8) {
        const int d0 = tok_dst[tok * 4], d1 = tok_dst[tok * 4 + 1], d2 = tok_dst[tok * 4 + 2], d3 = tok_dst[tok * 4 + 3];
        f32x4 hv[8]; float amax = 0.f;
#pragma unroll
        for (int i = 0; i < 4; ++i) { const int c = (i * 64 + lane) * 8; const size_t o = (size_t)tok * DM + c;
            const u32x4 xw = *(const u32x4*)(x1b + o);
            f32x4 a = (f32x4){bflo(xw.x), bfhi(xw.x), bflo(xw.y), bfhi(xw.y)} * ALPHA, b = (f32x4){bflo(xw.z), bfhi(xw.z), bflo(xw.w), bfhi(xw.w)} * ALPHA;
            const u32x4 y0 = *(const u32x4*)(ys + (size_t)d0 * DM + c), y1 = *(const u32x4*)(ys + (size_t)d1 * DM + c), y2 = *(const u32x4*)(ys + (size_t)d2 * DM + c), y3 = *(const u32x4*)(ys + (size_t)d3 * DM + c);
            a[0] += (bflo(y0.x) + bflo(y1.x)) + (bflo(y2.x) + bflo(y3.x)); a[1] += (bfhi(y0.x) + bfhi(y1.x)) + (bfhi(y2.x) + bfhi(y3.x));
            a[2] += (bflo(y0.y) + bflo(y1.y)) + (bflo(y2.y) + bflo(y3.y)); a[3] += (bfhi(y0.y) + bfhi(y1.y)) + (bfhi(y2.y) + bfhi(y3.y));
            b[0] += (bflo(y0.z) + bflo(y1.z)) + (bflo(y2.z) + bflo(y3.z)); b[1] += (bfhi(y0.z) + bfhi(y1.z)) + (bfhi(y2.z) + bfhi(y3.z));
            b[2] += (bflo(y0.w) + bflo(y1.w)) + (bflo(y2.w) + bflo(y3.w)); b[3] += (bfhi(y0.w) + bfhi(y1.w)) + (bfhi(y2.w) + bfhi(y3.w));
            pg8::st_bf16x8(hb + o, a, b); hv[2 * i] = a; hv[2 * i + 1] = b;
#pragma unroll
            for (int j = 0; j < 4; ++j) amax = fmaxf(amax, fmaxf(fabsf(a[j]), fabsf(b[j]))); }
        for (int o = 32; o > 0; o >>= 1) amax = fmaxf(amax, __shfl_xor(amax, o));
        amax = fmaxf(amax, 1e-20f); const float qi = 127.0f / amax; if (lane == 0) hsc[tok] = amax * (1.0f / 127.0f);
#pragma unroll
        for (int i = 0; i < 4; ++i) { u32x2 w;
#pragma unroll
            for (int h = 0; h < 2; ++h) { unsigned pk = 0u;
#pragma unroll
                for (int j = 0; j < 4; ++j) pk |= ((unsigned)(int)rintf(hv[2 * i + h][j] * qi) & 0xffu) << (8 * j);
                w[h] = pk; }
            *(u32x2*)(hq + (size_t)tok * DM + (i * 64 + lane) * 8) = w; } }
}
__device__ __forceinline__ void phase_ln2(const Frame& F0, const Params& P, int l) { const Frame F = fresh(F0);
    unsigned char* ws = F.ws; const bf16_t* pre2 = (const bf16_t*)(ws + M_X1F); bf16_t* xb = (bf16_t*)(ws + WS_XB);
    const float* g = F.in(23) + l * DM; const float* bt = F.in(24) + l * DM; float* outp = F.out();
    for (int tok = F.bid * 8 + F.wid; tok < NTOK; tok += F.G * 8) ln_row(pre2 + (size_t)tok * DM, g, bt, (l + 1 == NLAYER) ? outp + (size_t)tok * DM : (float*)nullptr, (l + 1 == NLAYER) ? (bf16_t*)nullptr : xb + (size_t)tok * DM, F.lane,
                                                                          (l + 1 == NLAYER) ? (unsigned char*)nullptr : (unsigned char*)(ws + WS_XQ) + (size_t)tok * DM, (l + 1 == NLAYER) ? (float*)nullptr : (float*)(ws + WS_XSC) + tok);
}

constexpr int NPHASE = 2 + 15 * NLAYER;
#ifdef PH_ONLY
#define PEN(kind) ((kind) == PH_ONLY)
#else
#define PEN(kind) true
#endif
#define IN(k) (lo <= (k) && (k) < hi)
#define SEAM(k) do { if (IN((k) + 1)) xcd_barrier(bar); } while (0)

template <int l>
__device__ __forceinline__ void layer_phases(const Frame& F, const Params& P, const XcdBarrier& bar, const int lo, const int hi, unsigned char* ws0) {
    using namespace pg8;

        const int pb = 2 + 15 * l;
        if (IN(pb + 0) && PEN(0)) { size_t wz = 0; asm volatile("" : "+s"(wz)); unsigned char* ws = ws0 + wz;
            { SchedS S; S.init(NTOK, 5 * 256, F.G, F.bid, (const bf16_t*)(ws + WS_XB), DM, (const bf16_t*)(ws + W_IN), DM); S.skip_from = 0; S.skip_by = 4; S.skip_from2 = 4; S.skip_by2 = 49;
              EpiInProj<false> E{(bf16_t*)(ws + R_QA), (bf16_t*)(ws + R_QIDX), (bf16_t*)(ws + R_QKV), (bf16_t*)(ws + R_GATES), (float*)(ws + R_SMALL), nullptr, nullptr};
              for (int rep = 0; rep < NREP(5); ++rep) gemm_phase(F.ldsl, DM, DM, DM, S, E); }
            { SchedS S; S.init(NTOK, 53 * 256, F.G, (F.bid + F.G / 2) % F.G, (const bf16_t*)(ws + WS_XQ), DM / 2, (const bf16_t*)(ws + W_IN8), DM / 2); S.skip_from = 4; S.skip_by = 4; S.b_compact = 1;
              EpiInProj<true> E{(bf16_t*)(ws + R_QA), (bf16_t*)(ws + R_QIDX), (bf16_t*)(ws + R_QKV), (bf16_t*)(ws + R_GATES), (float*)(ws + R_SMALL), (const float*)(ws + WS_XSC), (const unsigned*)(ws + WS_CTL) + CW_WMAXG + l};
              for (int rep = 0; rep < NREP(5); ++rep) gemm_phase(F.ldsl, DM / 2, DM / 2, DM / 2, S, E); }
            SEAM(pb + 0); }
        if (IN(pb + 1) && PEN(1)) { size_t wz = 0; asm volatile("" : "+s"(wz)); unsigned char* ws = ws0 + wz;
            phase_prep(F, P, l);
            SchedS S; S.init(NTOK, 2048, F.G, F.bid, (const bf16_t*)(ws + R_QA), 1024, (const bf16_t*)(ws + W_UK2), 256, 1, 256);
            EpiBf16 E{(bf16_t*)(ws + R_QCAT), 2304, 288};
            for (int rep = 0; rep < NREP(10); ++rep) gemm_phase(F.ldsl, 256, 1024, 256, S, E); SEAM(pb + 1); }
        if (IN(pb + 2) && PEN(2)) { size_t wz = 0; asm volatile("" : "+s"(wz)); unsigned char* ws = ws0 + wz; phase_cumsum(F); for (int rep = 0; rep < NREP(3); ++rep) phase_idx(F); SEAM(pb + 2); }
        if (IN(pb + 3) && PEN(3)) { size_t wz = 0; asm volatile("" : "+s"(wz)); unsigned char* ws = ws0 + wz; for (int rep = 0; rep < NREP(4); ++rep) phase_topk(F); SEAM(pb + 3); }
        if (IN(pb + 4) && PEN(4)) { size_t wz = 0; asm volatile("" : "+s"(wz)); unsigned char* ws = ws0 + wz; for (int rep = 0; rep < NREP(1); ++rep) phase_attn(F, l, rep); SEAM(pb + 4); }
        if (IN(pb + 5) && PEN(5)) { size_t wz = 0; asm volatile("" : "+s"(wz)); unsigned char* ws = ws0 + wz;
            SchedS S; S.init(NTOK, 1024, F.G, F.bid, (const bf16_t*)(ws + R_OLAT), 2048, (const bf16_t*)(ws + W_UV2), 512, 0, 512);
            EpiBf16 E{(bf16_t*)(ws + R_OA), 3072, 256}; for (int rep = 0; rep < NREP(10); ++rep) gemm_phase(F.ldsl, 512, 2048, 512, S, E);
            SEAM(pb + 5); }
        if (IN(pb + 6) && PEN(6)) { size_t wz = 0; asm volatile("" : "+s"(wz)); unsigned char* ws = ws0 + wz;
            SchedS S; S.init(NTOK, 2048, F.G, F.bid, (const bf16_t*)(ws + R_OA), 3072, (const bf16_t*)(ws + W_BRA), 3072);
            EpiBranch3 E{(const unsigned char*)(ws + R_GATES), (bf16_t*)(ws + R_MERGED)}; for (int rep = 0; rep < NREP(11); ++rep) gemm_phase(F.ldsl, 3072, 3072, 3072, S, E); SEAM(pb + 6); }
        if (IN(pb + 7) && PEN(7)) { size_t wz = 0; asm volatile("" : "+s"(wz)); unsigned char* ws = ws0 + wz;
            SchedS S; S.init(NTOK, 2048, F.G, F.bid, (const bf16_t*)(ws + R_MERGED), DM, (const bf16_t*)(ws + W_OUT), DM);
            EpiOut E{(const bf16_t*)(ws + WS_XB), (bf16_t*)(ws + R_PRE1)}; for (int rep = 0; rep < NREP(8); ++rep) gemm_phase(F.ldsl, DM, DM, DM, S, E); SEAM(pb + 7); }
        if (IN(pb + 8) && PEN(8)) { size_t wz = 0; asm volatile("" : "+s"(wz)); unsigned char* ws = ws0 + wz; phase_ln1_router(F, P, l); SEAM(pb + 8); }
        if (IN(pb + 9) && PEN(9)) { size_t wz = 0; asm volatile("" : "+s"(wz)); unsigned char* ws = ws0 + wz;
            for (int rep = 0; rep < NREP(12); ++rep) phase_moe_gather(F, l);
            SchedS S; S.init(NTOK, 2048, F.G, F.bid, (const bf16_t*)(ws + WS_PB) + (size_t)l * NTOK * 256, 256, (const bf16_t*)(ws + W_PLE), 256);
            EpiBf16 E{(bf16_t*)(ws + M_PP), 2048, 256}; for (int rep = 0; rep < NREP(10); ++rep) gemm_phase(F.ldsl, 256, 256, 256, S, E); SEAM(pb + 9); }
        if (IN(pb + 10) && PEN(10)) { size_t wz = 0; asm volatile("" : "+s"(wz)); unsigned char* ws = ws0 + wz;
            SchedM S; S.init((const unsigned*)(ws + WS_CTL) + CW_META + l * 512, F.G, F.bid, (const bf16_t*)(ws + M_XS), DM / 2, (const bf16_t*)(ws + W_GU), DM / 2);
            EpiGateUpI8 E{F.in(16) + (size_t)l * NEXP * DEXP, F.in(18) + (size_t)l * NEXP * DEXP, (bf16_t*)(ws + M_HID), (const float*)(ws + M_ROWSX), (const unsigned*)(ws + WS_CTL) + CW_WMAX + l};
            for (int rep = 0; rep < NREP(6); ++rep) gemm_phase(F.ldsl, DM / 2, DM / 2, DM / 2, S, E); SEAM(pb + 10); }
        if (IN(pb + 11) && PEN(11)) { size_t wz = 0; asm volatile("" : "+s"(wz)); unsigned char* ws = ws0 + wz;
            SchedM S; S.init((const unsigned*)(ws + WS_CTL) + CW_META + l * 512, F.G, F.bid, (const bf16_t*)(ws + M_HID), DEXP, (const bf16_t*)(ws + W_DN), DEXP);
            EpiDown E{F.in(20) + (size_t)l * NEXP * DM, (const float*)(ws + M_ROWW), (bf16_t*)(ws + M_XS)}; for (int rep = 0; rep < NREP(7); ++rep) gemm_phase(F.ldsl, DEXP, DEXP, DEXP, S, E); SEAM(pb + 11); }
        if (IN(pb + 12) && PEN(12)) { size_t wz = 0; asm volatile("" : "+s"(wz)); unsigned char* ws = ws0 + wz; for (int rep = 0; rep < NREP(9); ++rep) phase_combine(F); SEAM(pb + 12); }
        if (IN(pb + 13) && PEN(13)) { size_t wz = 0; asm volatile("" : "+s"(wz)); unsigned char* ws = ws0 + wz;
            SchedS S; S.init(NTOK, 2048, F.G, F.bid, (const bf16_t*)(ws + M_HQ), DM / 2, (const bf16_t*)(ws + W_PG), DM / 2);
            EpiPleGateI8 E{(const bf16_t*)(ws + M_HB), (const bf16_t*)(ws + M_PP), (bf16_t*)(ws + M_X1F), (const float*)(ws + M_HSC), (const unsigned*)(ws + WS_CTL) + CW_WMAXP + l};
            for (int rep = 0; rep < NREP(8); ++rep) gemm_phase(F.ldsl, DM / 2, DM / 2, DM / 2, S, E); SEAM(pb + 13); }
        if (IN(pb + 14) && PEN(14)) { size_t wz = 0; asm volatile("" : "+s"(wz)); unsigned char* ws = ws0 + wz; for (int rep = 0; rep < NREP(13); ++rep) phase_ln2(F, P, l); if (l + 1 < NLAYER) for (int rep = 0; rep < NREP(0); ++rep) convert_layer_weights(F, P, l + 1); SEAM(pb + 14); }
}
__global__ void __launch_bounds__(512, 2) fwd(Params P) {
    extern __shared__ __attribute__((aligned(16))) unsigned char lds[];
    Frame F; F.lds = lds; F.ldsl = (LAS unsigned char*)lds; F.ws = P.ws; F.tid = threadIdx.x; F.lane = F.tid & 63; F.wid = __builtin_amdgcn_readfirstlane(F.tid >> 6); F.G = gridDim.x; F.bid = blockIdx.x;
    unsigned char* ws0 = P.ws; unsigned char* ws = ws0;
    const bool fused = (P.ph_hi - P.ph_lo) > 1;
    if (F.tid < 4) ((LAS unsigned*)(F.ldsl + LDS_MISC))[F.tid] = 0u;
    if (F.tid == 0) { LAS unsigned long long* t = (LAS unsigned long long*)(F.ldsl + LDS_PTRS);
#pragma unroll
        for (int k = 0; k < 25; ++k) t[k] = (unsigned long long)P.in[k];
        t[25] = (unsigned long long)P.out; }
    __syncthreads();
    XcdBarrier bar; bar.bar = (unsigned*)(ws + WS_CTL) + CW_BAR; bar.x = 0; bar.st = (volatile LAS unsigned*)(F.ldsl + LDS_MISC);
    if (fused) bar = xcd_barrier_post((unsigned*)(ws + WS_CTL) + CW_BAR, (volatile LAS unsigned*)(F.ldsl + LDS_MISC));
    const int lo = P.ph_lo, hi = P.ph_hi;
    using namespace pg8;
    if (IN(0) && PEN(15)) { size_t wz = 0; asm volatile("" : "+s"(wz)); unsigned char* ws = ws0 + wz;
        quant_rows(F, F.in(0), (bf16_t*)(ws + WS_XB), (unsigned char*)(ws + WS_XQ), (float*)(ws + WS_XSC));
        conv_rows(F, F.in(1), (bf16_t*)(ws + WS_PB), (size_t)2 * NTOK * 256 / 8);
        sample_wmax(F);
        SEAM(0);
    }
    if (IN(1) && PEN(15)) { for (int rep = 0; rep < NREP(0); ++rep) convert_layer_weights(F, P, 0); SEAM(1); }
    layer_phases<0>(F, P, bar, lo, hi, ws0);
    layer_phases<1>(F, P, bar, lo, hi, ws0);
}

#ifdef DEBUG_NAN
constexpr int CW_FLAGS = 12288;
__global__ void dbg_scan_bf16(const unsigned short* p, size_t n, unsigned* flag) { unsigned c = 0; for (size_t i = (size_t)blockIdx.x * blockDim.x + threadIdx.x; i < n; i += (size_t)gridDim.x * blockDim.x) if ((p[i] & 0x7F80u) == 0x7F80u) ++c; if (c) atomicAdd(flag, c); }
__global__ void dbg_scan_f32(const unsigned* p, size_t n, unsigned* flag) { unsigned c = 0; for (size_t i = (size_t)blockIdx.x * blockDim.x + threadIdx.x; i < n; i += (size_t)gridDim.x * blockDim.x) if ((p[i] & 0x7F800000u) == 0x7F800000u) ++c; if (c) atomicAdd(flag, c); }
__global__ void dbg_scan_sel(const int* sel, const int* nsel, unsigned* flag) { unsigned c = 0; for (size_t i = (size_t)blockIdx.x * blockDim.x + threadIdx.x; i < (size_t)NTOK * 256; i += (size_t)gridDim.x * blockDim.x) { const int tok = (int)(i >> 8), j = (int)(i & 255), t = tok & (SEQ - 1); const int ns = nsel[tok]; if (j == 0 && ns != (t + 1 < 256 ? t + 1 : 256)) ++c; if (j < ns && (sel[i] < 0 || sel[i] > t)) ++c; } if (c) atomicAdd(flag, c); }
__global__ void dbg_scan_scores(const unsigned* p, unsigned* flag) { unsigned c = 0; for (size_t i = (size_t)blockIdx.x * blockDim.x + threadIdx.x; i < 2ull * SEQ * SEQ; i += (size_t)gridDim.x * blockDim.x) { const int s = (int)(i & (SEQ - 1)), t = (int)((i >> 13) & (SEQ - 1)); if (s <= t && (p[i] & 0x7F800000u) == 0x7F800000u) ++c; } if (c) atomicAdd(flag, c); }
__global__ void dbg_probe_bf16(const unsigned short* p, size_t n, unsigned* cnt, unsigned* minidx) { unsigned c = 0; unsigned mi = 0xFFFFFFFFu; for (size_t i = (size_t)blockIdx.x * blockDim.x + threadIdx.x; i < n; i += (size_t)gridDim.x * blockDim.x) if ((p[i] & 0x7F80u) == 0x7F80u) { ++c; if ((unsigned)i < mi) mi = (unsigned)i; } if (c) { atomicAdd(cnt, c); atomicMax(minidx, ~mi); } }
__global__ void dbg_final(float* out, size_t n, const unsigned* flags) { int code = 0; for (int k = 0; k < 32; ++k) if (flags[k] && !code) code = k + 1; const int mask = (flags[32] ? 1 : 0) | (flags[33] ? 2 : 0) | (flags[34] ? 4 : 0); if (mask) code = 20 + 5 * mask; if (!code) return; for (size_t i = (size_t)blockIdx.x * blockDim.x + threadIdx.x; i < n; i += (size_t)gridDim.x * blockDim.x) out[i] = (float)code; }
#endif
extern "C" void kernel_launch(void* const* d_in, const int* in_sizes, int n_in, void* d_out, int out_size, void* d_ws, size_t ws_size, hipStream_t stream) {
    static int grid = 0;
    if (grid == 0) {
        if (n_in != 25 || out_size != NTOK * DM || ws_size < WS_NEED) { fprintf(stderr, "kernel_launch: unexpected shapes (n_in %d out %d ws %zu need %zu)\n", n_in, out_size, ws_size, (size_t)WS_NEED); grid = -1; return; }
        int dev = 0, cus = 0, per_cu = 0;
        if (hipGetDevice(&dev) != hipSuccess || hipDeviceGetAttribute(&cus, hipDeviceAttributeMultiprocessorCount, dev) != hipSuccess) { grid = -1; return; }
        if (hipFuncSetAttribute((const void*)fwd, hipFuncAttributeMaxDynamicSharedMemorySize, LDS_BYTES) != hipSuccess) { fprintf(stderr, "kernel_launch: hipFuncSetAttribute failed\n"); grid = -1; return; }
        if (hipOccupancyMaxActiveBlocksPerMultiprocessor(&per_cu, (const void*)fwd, 512, LDS_BYTES) != hipSuccess || per_cu < 1) fprintf(stderr, "kernel_launch: occupancy query says %d\n", per_cu);
        (void)hipGetLastError();
        grid = cus;
    }
    if (grid < 0) return;
    unsigned char* ws = (unsigned char*)d_ws;
    hipMemsetAsync(ws + WS_CTL, 0, CTL_BYTES, stream);
    hipMemsetAsync(ws + W_UK2, 0, 8ull * 256 * 256 * 2 + 4ull * 256 * 512 * 2, stream);
    hipMemsetAsync(ws + W_IN + (size_t)INW * 2048 * 2, 0, (size_t)(INWP - INW) * 2048 * 2, stream);
    Params p{};
    for (int i = 0; i < 25; ++i) p.in[i] = (const float*)d_in[i];
    p.out = (float*)d_out; p.ws = ws;
#if PHASES_PER_LAUNCH == 0
    p.ph_lo = 0; p.ph_hi = NPHASE;
    hipLaunchKernelGGL(fwd, dim3(grid), dim3(512), LDS_BYTES, stream, p);
#else
    for (int k = 0; k < NPHASE; ++k) { p.ph_lo = k; p.ph_hi = k + 1; hipLaunchKernelGGL(fwd, dim3(grid), dim3(512), LDS_BYTES, stream, p);
#ifdef DEBUG_NAN
        unsigned* fl = (unsigned*)(ws + WS_CTL) + CW_FLAGS + k;
#define SB16(off, n) hipLaunchKernelGGL(dbg_scan_bf16, dim3(1024), dim3(256), 0, stream, (const unsigned short*)(ws + (off)), (size_t)(n), fl)
#define SF32(off, n) hipLaunchKernelGGL(dbg_scan_f32, dim3(1024), dim3(256), 0, stream, (const unsigned*)(ws + (off)), (size_t)(n), fl)
        if (k == 0) { SB16(WS_XB, (size_t)NTOK * DM); SB16(WS_PB, 2ull * NTOK * 256); SB16(WS_W, (W_END - WS_W) / 2); }
        else { const int kind = (k - 1) % 15;
            if (kind == 0) { SB16(R_QA, (size_t)NTOK * 1024); SB16(R_QIDX, (size_t)NTOK * 1024); SB16(R_QKV, 6ull * NTOK * 1024); SB16(R_GATES, (size_t)NTOK * 6144); SF32(R_SMALL, (size_t)NTOK * 512); }
            if (kind == 1) { SB16(R_QCAT, (size_t)NTOK * 2304); SB16(R_KCAT, (size_t)NTOK * 288); SB16(R_KI, (size_t)NTOK * 64); SB16(R_QIDX, (size_t)NTOK * 1024); SF32(R_WI, (size_t)NTOK * 16); SF32(WS_LF, 16ull * 8192); }
            if (kind == 2) { SF32(WS_CUM, 16ull * 8192); hipLaunchKernelGGL(dbg_scan_scores, dim3(1024), dim3(256), 0, stream, (const unsigned*)(ws + R_SCORES), fl); }
            if (kind == 3) { hipLaunchKernelGGL(dbg_scan_sel, dim3(1024), dim3(256), 0, stream, (const int*)(ws + R_SEL), (const int*)(ws + R_NSEL), fl); }
            if (k == 5) { unsigned* fl0 = fl; fl = (unsigned*)(ws + WS_CTL) + CW_FLAGS + 32; SB16(R_OLAT, (size_t)NTOK * 2048); fl += 1; SB16(R_OA, (size_t)NTOK * 3072); fl += 1; fl = fl0; hipLaunchKernelGGL(dbg_probe_bf16, dim3(1024), dim3(256), 0, stream, (const unsigned short*)(ws + R_OC), (size_t)NTOK * 1024, (unsigned*)(ws + WS_CTL) + CW_FLAGS + 40, (unsigned*)(ws + WS_CTL) + CW_FLAGS + 41); }
            if (kind == 5) { SB16(R_OA, (size_t)NTOK * 3072); }
            if (kind == 6) { SB16(R_MERGED, (size_t)NTOK * 2048); }
            if (kind == 7) { SF32(R_PRE1, (size_t)NTOK * 2048); }
            if (kind == 8) { SF32(M_X1F, (size_t)NTOK * 2048); SF32(M_TOKW, (size_t)NTOK * 4); }
            if (kind == 9) { SB16(M_PP, (size_t)NTOK * 2048); }
            if (kind == 12) { SF32(M_HF, (size_t)NTOK * 2048); }
            if (kind == 13) { SF32(M_X1F, (size_t)NTOK * 2048); }
            if (kind == 14) { hipLaunchKernelGGL(dbg_scan_f32, dim3(1024), dim3(256), 0, stream, (const unsigned*)d_out, (size_t)NTOK * DM, fl); if (k + 1 < NPHASE) SB16(WS_W, (W_END - WS_W) / 2); } }
#endif
    }
#ifdef DEBUG_NAN
    hipLaunchKernelGGL(dbg_final, dim3(1024), dim3(256), 0, stream, (float*)d_out, (size_t)NTOK * DM, (const unsigned*)(ws + WS_CTL) + CW_FLAGS);
#endif
#endif
}
```

```cpp
#include <hip/hip_runtime.h>
#include <stdint.h>
#include <stdio.h>
#include <math.h>

#ifndef PHASES_PER_LAUNCH
#define PHASES_PER_LAUNCH 0
#endif

#define LAS __attribute__((address_space(3)))
#define GAS __attribute__((address_space(1)))
#ifndef REP_MASK
#define REP_MASK 0
#endif
#define NREP(bit) (((REP_MASK) >> (bit)) & 1 ? 2 : 1)
typedef unsigned short bf16_t;
typedef short bf16x8 __attribute__((ext_vector_type(8)));
typedef short s16x4 __attribute__((ext_vector_type(4)));
typedef float f32x4 __attribute__((ext_vector_type(4)));
typedef float f32x16 __attribute__((ext_vector_type(16)));
typedef unsigned u32x4 __attribute__((ext_vector_type(4)));
typedef unsigned u32x2 __attribute__((ext_vector_type(2)));
typedef int i32x4 __attribute__((ext_vector_type(4)));

constexpr int NTOK = 16384, DM = 2048, SEQ = 8192, NB = 2, NLAYER = 2;
constexpr int INW = 14712, INWP = 14848;
constexpr int NEXP = 32, DEXP = 1024;
constexpr int PMAX = 65536 + 8192;
constexpr float ALPHA = 1.41421356237309515f;
constexpr float LOG2E = 1.4426950408889634f;
constexpr float SCALE = 0.08838834764831845f;
constexpr float C2 = LOG2E * SCALE;

constexpr size_t MiB = 1ull << 20;
constexpr size_t WS_CTL   = 0;
constexpr size_t WS_W     = 1 * MiB;
constexpr size_t W_IN     = WS_W;
constexpr size_t W_IN8    = W_IN   + 2048ull * 2048 * 2;
constexpr size_t W_UK2    = W_IN   + (size_t)INWP * 2048 * 2;
constexpr size_t W_UV2    = W_UK2  + 8ull * 256 * 256 * 2;
constexpr size_t W_BRA    = W_UV2  + 4ull * 256 * 512 * 2;
constexpr size_t W_BRB    = W_BRA  + 2048ull * 1024 * 2;
constexpr size_t W_BRC    = W_BRB  + 2048ull * 1024 * 2;
constexpr size_t W_OUT    = W_BRC  + 2048ull * 1024 * 2;
constexpr size_t W_PG     = W_OUT  + 2048ull * 2048 * 2;
constexpr size_t W_PLE    = W_PG   + 2048ull * 2048 * 2;
constexpr size_t W_GU     = W_PLE  + 2048ull * 256 * 2;
constexpr size_t W_DN     = W_GU   + 32ull * 2048 * 2048 * 2;
constexpr size_t W_END    = W_DN   + 32ull * 2048 * 1024 * 2;
constexpr size_t WS_XB    = (W_END + MiB - 1) / MiB * MiB;
constexpr size_t WS_PB    = WS_XB  + (size_t)NTOK * DM * 2;
constexpr size_t WS_CUM   = WS_PB  + 2ull * NTOK * 256 * 2;
constexpr size_t WS_LF    = WS_CUM + 16ull * 8192 * 4;
constexpr size_t WS_XQ    = WS_LF  + 16ull * 8192 * 4;
constexpr size_t WS_XSC   = WS_XQ  + (size_t)NTOK * DM;
constexpr size_t WS_R     = (WS_XSC + (size_t)NTOK * 4 + MiB - 1) / MiB * MiB;
constexpr size_t R_SCORES = WS_R;
constexpr size_t R_OLAT   = WS_R;
constexpr size_t R_OA     = WS_R + 64 * MiB;
constexpr size_t R_OB     = WS_R + 96 * MiB;
constexpr size_t R_OC     = WS_R + 128 * MiB;
constexpr size_t R_TMP    = WS_R + 160 * MiB;
constexpr size_t R_MERGED = WS_R + 288 * MiB;
constexpr size_t R_PRE1   = WS_R + 384 * MiB;
constexpr size_t R_QA     = WS_R + 512 * MiB;
constexpr size_t R_QIDX   = WS_R + 544 * MiB;
constexpr size_t R_QKV    = WS_R + 576 * MiB;
constexpr size_t R_GATES  = WS_R + 768 * MiB;
constexpr size_t R_SMALL  = WS_R + 960 * MiB;
constexpr size_t R_QCAT   = WS_R + 992 * MiB;
constexpr size_t R_KCAT   = WS_R + 1064 * MiB;
constexpr size_t R_KI     = WS_R + 1073 * MiB;
constexpr size_t R_WI     = WS_R + 1075 * MiB;
constexpr size_t R_SEL    = WS_R + 1076 * MiB;
constexpr size_t R_NSEL   = WS_R + 1092 * MiB;
constexpr size_t R_END    = WS_R + 1093 * MiB;
constexpr size_t M_XS     = WS_R;
constexpr size_t M_HID    = WS_R + 288 * MiB;
constexpr size_t M_PP     = WS_R + 432 * MiB;
constexpr size_t M_X1F    = WS_R + 512 * MiB;
constexpr size_t M_X1B    = WS_R + 640 * MiB;
constexpr size_t M_HF     = WS_R + 704 * MiB;
constexpr size_t M_HQ     = WS_R + 704 * MiB;
constexpr size_t M_HSC    = WS_R + 736 * MiB;
constexpr size_t M_HB     = WS_R + 832 * MiB;
constexpr size_t M_TOKE   = WS_R + 896 * MiB;
constexpr size_t M_TOKPOS = M_TOKE + (size_t)NTOK * 16;
constexpr size_t M_TOKW   = M_TOKPOS + (size_t)NTOK * 16;
constexpr size_t M_TOKDST = M_TOKW + (size_t)NTOK * 16;
constexpr size_t M_ROWW   = M_TOKDST + (size_t)NTOK * 16;
constexpr size_t M_ROWSX  = M_ROWW + (size_t)PMAX * 4;
constexpr size_t M_X1S    = M_ROWSX + (size_t)PMAX * 4;
constexpr size_t M_X1Q    = WS_R + 900 * MiB;
constexpr size_t WS_NEED  = R_END;
constexpr int CW_BAR = 0;
constexpr int CW_CNT = 8192;
constexpr int CW_META = 4096 + 64;
constexpr int CW_QCTR = 6144;
constexpr int CW_WMAX = 6272;
constexpr int CW_WMAXG = 6336;
constexpr int CW_WMAXP = 6368;
constexpr int CW_KMAX = 6400;
constexpr size_t CTL_BYTES = 65536;

constexpr int LDS_BYTES = 152576;
constexpr int LDS_MISC = 151552;

typedef float f32x2 __attribute__((ext_vector_type(2)));
typedef __bf16 bf16n2 __attribute__((ext_vector_type(2)));
__device__ __forceinline__ unsigned cvtpk(float lo, float hi) { f32x2 v = {lo, hi}; bf16n2 b = __builtin_convertvector(v, bf16n2); return __builtin_bit_cast(unsigned, b); }
__device__ __forceinline__ bf16_t f2bf(float x) { return (bf16_t)(cvtpk(x, 0.f) & 0xffffu); }
__device__ __forceinline__ float bf2f(bf16_t b) { return __uint_as_float(((unsigned)b) << 16); }
__device__ __forceinline__ float bflo(unsigned w) { return __uint_as_float(w << 16); }
__device__ __forceinline__ float bfhi(unsigned w) { return __uint_as_float(w & 0xffff0000u); }
__device__ __forceinline__ bf16x8 pack8(f32x4 a, f32x4 b) { u32x4 w = {cvtpk(a[0], a[1]), cvtpk(a[2], a[3]), cvtpk(b[0], b[1]), cvtpk(b[2], b[3])}; return *reinterpret_cast<bf16x8*>(&w); }
__device__ __forceinline__ float sigmoidf_(float x) { return 1.0f / (1.0f + __expf(-x)); }
__device__ __forceinline__ float wave_sum(float v) { for (int o = 32; o > 0; o >>= 1) v += __shfl_xor(v, o); return v; }
__device__ __forceinline__ int crow(int r, int hi) { return (r & 3) + 8 * (r >> 2) + 4 * hi; }
#define SBAR() __builtin_amdgcn_sched_barrier(0)

#define XB_TMO      128
#define XB_XCNT(j)  (256  + 64 * (j))
#define XB_XSUB(j)  (1280 + 64 * (j))
#define XB_XGEN(j)  (2304 + 64 * (j))
#define XB_TOP      3328
#define XB_TOPGEN   3392
#define XCD_BAR_WORDS 3456
#define XB_SPIN_CAP (1u << 22)
__device__ __forceinline__ unsigned xb_ld(unsigned* p)              { return __hip_atomic_load(p, __ATOMIC_RELAXED, __HIP_MEMORY_SCOPE_AGENT); }
__device__ __forceinline__ unsigned xb_add(unsigned* p, unsigned v) { return __hip_atomic_fetch_add(p, v, __ATOMIC_RELAXED, __HIP_MEMORY_SCOPE_AGENT); }
__device__ __forceinline__ unsigned xb_xcc_id() { return (unsigned)__builtin_amdgcn_s_getreg((3 << 11) | 20) & 0xFu; }
#define XB_SPIN(cond, bar) do { unsigned _sp = 0; while (cond) { __builtin_amdgcn_s_sleep(1); \
    if ((++_sp & 255u) == 0u) { if (xb_ld(&(bar)[XB_TMO])) break; if (_sp > XB_SPIN_CAP) { atomicAdd(&(bar)[XB_TMO], 1u); break; } } } } while (0)
struct XcdBarrier { unsigned* bar; unsigned x; volatile LAS unsigned* st; };
__device__ __forceinline__ XcdBarrier xcd_barrier_post(unsigned* bar, volatile LAS unsigned* st) {
    XcdBarrier b; b.bar = bar; b.x = xb_xcc_id(); b.st = st;
    if (threadIdx.x == 0) (void)xb_add(&bar[XB_XCNT(b.x)], 1u);
    return b;
}
__device__ __forceinline__ void xcd_barrier_complete(unsigned* bar, unsigned x, unsigned& nloc, unsigned& nx) {
    const unsigned G = gridDim.x * gridDim.y * gridDim.z;
    unsigned sum, cnt, mine, sp = 0u;
    for (;;) {
        sum = 0u; cnt = 0u; mine = 0u;
#pragma unroll
        for (unsigned j = 0; j < 16; ++j) { const unsigned c = xb_ld(&bar[XB_XCNT(j)]); sum += c; cnt += (c > 0u) ? 1u : 0u; mine = (j == x) ? c : mine; }
        if (sum == G) break;
        __builtin_amdgcn_s_sleep(1);
        if ((++sp & 255u) == 0u) { if (xb_ld(&bar[XB_TMO])) break; if (sp > XB_SPIN_CAP) { atomicAdd(&bar[XB_TMO], 1u); break; } }
    }
    nloc = mine > 0u ? mine : 1u; nx = cnt > 0u ? cnt : 1u;
}
__device__ __forceinline__ void xcd_barrier(const XcdBarrier& b) {
    asm volatile("s_waitcnt vmcnt(0)" ::: "memory");
    __syncthreads();
    if (threadIdx.x == 0) {
        unsigned* bar = b.bar;
        __builtin_amdgcn_s_waitcnt(0);
        unsigned nloc = b.st[0], nx = b.st[1];
        if (nloc == 0u) { xcd_barrier_complete(bar, b.x, nloc, nx); b.st[0] = nloc; b.st[1] = nx; }
        const unsigned old = xb_add(&bar[XB_XSUB(b.x)], 1u);
        const unsigned gen = old / nloc;
        if (old + 1u == (gen + 1u) * nloc) {
            __builtin_amdgcn_fence(__ATOMIC_RELEASE, "agent");
            asm volatile("s_waitcnt vmcnt(0)" ::: "memory");
            const unsigned og = xb_add(&bar[XB_TOP], 1u);
            const unsigned tg = og / nx;
            if (og + 1u == (tg + 1u) * nx) xb_add(&bar[XB_TOPGEN], 1u);
            else XB_SPIN(xb_ld(&bar[XB_TOPGEN]) == tg, bar);
            __builtin_amdgcn_fence(__ATOMIC_ACQUIRE, "agent");
            xb_add(&bar[XB_XGEN(b.x)], 1u);
            asm volatile("s_waitcnt vmcnt(0)" ::: "memory");
        } else {
            XB_SPIN(xb_ld(&bar[XB_XGEN(b.x)]) == gen, bar);
            __builtin_amdgcn_fence(__ATOMIC_ACQUIRE, "agent");
            asm volatile("s_waitcnt vmcnt(0)" ::: "memory");
        }
    }
    __syncthreads();
}

namespace pg8 {
constexpr int BM = 256, BK = 64, HALF = 128, HTB = HALF * BK * 2, STAGE_BYTES = 8 * HTB, NXCD = 8, WGM = 8;
__device__ __forceinline__ int lds_byte(int r, int c) { const int st = (r >> 4) * 2 + (c >> 5), rr = r & 15, cc = c & 31, ob = rr * 64 + cc * 2; return st * 1024 + (ob ^ (((ob >> 9) & 1) << 5)); }
__device__ __forceinline__ void stage_rc(int b, int& R, int& C) { const int st = b / 1024, sb = b % 1024, swz = sb ^ (((sb >> 9) & 1) << 5); R = (st >> 1) * 16 + swz / 64; C = (st & 1) * 32 + (swz % 64) / 2; }
__device__ __forceinline__ int perm32(int rho) { const int n = rho >> 4, i = rho & 15; return 8 * (i >> 2) + 4 * n + (i & 3); }
struct Unit { int pm, pn, e; };
struct SchedS {
    int nM, nN, nwg, G, c; const bf16_t* A; const bf16_t* B; int lda, ldb, a_sh, a_mul, skip_from = 1 << 30, skip_by = 0, skip_from2 = 1 << 30, skip_by2 = 0, b_compact = 0;
    __device__ void init(int M, int N, int G_, int c_, const bf16_t* A_, int lda_, const bf16_t* B_, int ldb_, int a_sh_ = 0, int a_mul_ = 0) {
        nM = M / BM; nN = N / BM; nwg = nM * nN; G = G_; c = c_; A = A_; B = B_; lda = lda_; ldb = ldb_; a_sh = a_sh_; a_mul = a_mul_; }
    __device__ __forceinline__ bool next(int i, Unit& u) const {
        const long L = (long)i * G + c; if (L >= nwg) return false;
        int wgid = (int)L; { const int q = nwg / NXCD, r = nwg % NXCD, xcd = wgid % NXCD, off = wgid / NXCD; wgid = (xcd < r ? xcd * (q + 1) : r * (q + 1) + (xcd - r) * q) + off; }
        const int nig = WGM * nN, gid = wgid / nig, fm = gid * WGM, gsz = (nM - fm) < WGM ? (nM - fm) : WGM;
        u.pm = fm + ((wgid % nig) % gsz); u.pn = (wgid % nig) / gsz; u.e = 0;
        u.e = u.pn;
        { const int ci = u.pn; if (ci >= skip_from) u.pn += skip_by; if (ci >= skip_from2) u.pn += skip_by2; }
        return true;
    }
    __device__ __forceinline__ const char* pa(const Unit& u) const { return (const char*)(A + (size_t)u.pm * BM * lda + (size_t)((u.pn >> a_sh) * a_mul)); }
    __device__ __forceinline__ const char* pb(const Unit& u) const { return (const char*)(B + (size_t)(b_compact ? u.e : u.pn) * BM * ldb); }
};
struct SchedM {
    int ntiles, G, c; const bf16_t* A; const bf16_t* W; int lda, ldb; const unsigned* tile_e;
    __device__ void init(const unsigned* meta, int G_, int c_, const bf16_t* A_, int lda_, const bf16_t* W_, int ldb_) {
        ntiles = (int)meta[0]; tile_e = meta + 1; G = G_; c = c_; A = A_; W = W_; lda = lda_; ldb = ldb_; }
    __device__ __forceinline__ bool next(int i, Unit& u) const {
        const long L = (long)i * G + c; if (L >= (long)ntiles * 8) return false;
        u.pm = (int)(L >> 3); u.pn = (int)(L & 7); u.e = (int)tile_e[u.pm];
        return true;
    }
    __device__ __forceinline__ const char* pa(const Unit& u) const { return (const char*)(A + (size_t)u.pm * BM * lda); }
    __device__ __forceinline__ const char* pb(const Unit& u) const { return (const char*)(W + ((size_t)u.e * 2048 + (size_t)u.pn * BM) * ldb); }
};

template <class Epi, class Sched>
__device__ __forceinline__ void gemm_phase(LAS unsigned char* lds, const int K, const int lda, const int ldb, const Sched& S, const Epi& E) {
    int tid = threadIdx.x; asm volatile("" : "+v"(tid));
    const int wid = __builtin_amdgcn_readfirstlane(tid >> 6), lane = tid & 63, wr = wid >> 2, wc = wid & 3, fr = lane & 15, fq = lane >> 4;
    const int nt = K / BK;
    unsigned voffA[2], voffB[2];
#pragma unroll
    for (int i = 0; i < 2; ++i) { int R, C; stage_rc(tid * 16 + i * 8192, R, C); const int Rb = (R & ~31) + perm32(R & 31);
        voffA[i] = (unsigned)(R * lda + C) * 2u; voffB[i] = (unsigned)(Rb * ldb + C) * 2u; }
    const size_t kstep = (size_t)(BK * 2);
    const size_t hstepA = (size_t)HALF * lda * 2, hstepB = (size_t)HALF * ldb * 2;
    const unsigned ldsw = (unsigned)wid * 1024u;
    const int aoff = lds_byte(wr * 64 + fr, fq * 8), boff = lds_byte(wc * 32 + fr, fq * 8);
#define PG8_SA(b, h) (((b) * 2 + (h)) * HTB)
#define PG8_SB(b, h) ((4 + (b) * 2 + (h)) * HTB)
#define PG8_STAGE(bufoff, gbase, voff) do { _Pragma("unroll") for (int _i = 0; _i < 2; ++_i) \
        __builtin_amdgcn_global_load_lds((const unsigned*)((const char*)(gbase) + (voff)[_i]), (LAS unsigned*)(lds + (bufoff) + ldsw + _i * 8192), 16, 0, 0); } while (0)
#define PG8_LDA(dst, b, h) do { _Pragma("unroll") for (int m = 0; m < 4; ++m) _Pragma("unroll") for (int k = 0; k < 2; ++k) dst[m][k] = *(const LAS bf16x8*)(lds + PG8_SA(b, h) + aoff + m * 2048 + k * 1024); } while (0)
#define PG8_LDB(dst, b, h) do { _Pragma("unroll") for (int n = 0; n < 2; ++n) _Pragma("unroll") for (int k = 0; k < 2; ++k) dst[n][k] = *(const LAS bf16x8*)(lds + PG8_SB(b, h) + boff + n * 2048 + k * 1024); } while (0)
#define PG8_MMA(ai, bj, At, Bt) do { __builtin_amdgcn_s_setprio(1); _Pragma("unroll") for (int m = 0; m < 4; ++m) _Pragma("unroll") for (int n = 0; n < 2; ++n) _Pragma("unroll") for (int k = 0; k < 2; ++k) \
        { if constexpr (Epi::I8) acc[ai][bj][m][n] = __builtin_bit_cast(f32x4, __builtin_amdgcn_mfma_i32_16x16x64_i8(__builtin_bit_cast(i32x4, Bt[n][k]), __builtin_bit_cast(i32x4, At[m][k]), __builtin_bit_cast(i32x4, acc[ai][bj][m][n]), 0, 0, 0)); \
          else acc[ai][bj][m][n] = __builtin_amdgcn_mfma_f32_16x16x32_bf16(Bt[n][k], At[m][k], acc[ai][bj][m][n], 0, 0, 0); } __builtin_amdgcn_s_setprio(0); } while (0)
#define PG8_WAIT_V(n) asm volatile("s_waitcnt vmcnt(" #n ")" ::: "memory")
#define PG8_WAIT_L(n) asm volatile("s_waitcnt lgkmcnt(" #n ")" ::: "memory")
#define PG8_BAR __builtin_amdgcn_s_barrier()
#define PG8_SCHED __builtin_amdgcn_sched_barrier(0)
    Unit cur, nxt; int ui = 0;
    if (!S.next(0, cur)) return;
    f32x4 acc[2][2][4][2];
#pragma unroll
    for (int a = 0; a < 2; ++a)
#pragma unroll
        for (int b = 0; b < 2; ++b)
#pragma unroll
            for (int m = 0; m < 4; ++m)
#pragma unroll
                for (int n = 0; n < 2; ++n) acc[a][b][m][n] = (f32x4){0.f, 0.f, 0.f, 0.f};
    bf16x8 At[4][2], B0[2][2], B1[2][2];
    const char* cA = S.pa(cur); const char* cB = S.pb(cur);
    PG8_STAGE(PG8_SB(0, 0), cB, voffB); PG8_STAGE(PG8_SA(0, 0), cA, voffA); PG8_STAGE(PG8_SB(0, 1), cB + hstepB, voffB); PG8_STAGE(PG8_SA(0, 1), cA + hstepA, voffA);
    if (wr == 1) PG8_BAR;
    PG8_WAIT_V(4); PG8_BAR;
    PG8_STAGE(PG8_SB(1, 0), cB + kstep, voffB); PG8_STAGE(PG8_SA(1, 0), cA + kstep, voffA); PG8_STAGE(PG8_SB(1, 1), cB + hstepB + kstep, voffB);
    PG8_WAIT_V(6); PG8_BAR;
    for (;;) {
        const bool has_next = S.next(ui + 1, nxt);
        const char* nA = has_next ? S.pa(nxt) : cA; const char* nB = has_next ? S.pb(nxt) : cB;
        for (int t = 0; t < nt; t += 2) {
            const bool last = (t == nt - 2);
            if constexpr (Epi::HAS_MID) { if (t == Epi::MID1 || t == Epi::MID2) { int frM = fr, fqM = fq; asm volatile("" : "+v"(frM), "+v"(fqM)); E.mid(acc, cur, t, wr, wc, frM, fqM); } }
            const char* a1 = cA + (size_t)(t + 1) * kstep;
            const char* a2 = last ? nA : cA + (size_t)(t + 2) * kstep; const char* b2 = last ? nB : cB + (size_t)(t + 2) * kstep;
            const char* a3 = a2 + kstep; const char* b3 = b2 + kstep;
            PG8_LDB(B0, 0, 0); PG8_SCHED; PG8_LDA(At, 0, 0); PG8_STAGE(PG8_SA(1, 1), a1 + hstepA, voffA);
            PG8_WAIT_L(8); PG8_BAR; PG8_WAIT_L(0); PG8_MMA(0, 0, At, B0); PG8_BAR; PG8_SCHED;
            PG8_LDB(B1, 0, 1); PG8_STAGE(PG8_SB(0, 0), b2, voffB);
            PG8_BAR; PG8_WAIT_L(0); PG8_MMA(0, 1, At, B1); PG8_BAR;
            PG8_LDA(At, 0, 1); PG8_STAGE(PG8_SA(0, 0), a2, voffA);
            PG8_BAR; PG8_WAIT_L(0); PG8_MMA(1, 0, At, B0); PG8_BAR; PG8_SCHED;
            PG8_STAGE(PG8_SB(0, 1), b2 + hstepB, voffB);
            PG8_WAIT_V(6); PG8_BAR; PG8_MMA(1, 1, At, B1); PG8_BAR;
            PG8_LDB(B0, 1, 0); PG8_SCHED; PG8_LDA(At, 1, 0); PG8_STAGE(PG8_SA(0, 1), a2 + hstepA, voffA);
            PG8_WAIT_L(8); PG8_BAR; PG8_WAIT_L(0); PG8_MMA(0, 0, At, B0); PG8_BAR; PG8_SCHED;
            PG8_LDB(B1, 1, 1); PG8_STAGE(PG8_SB(1, 0), b3, voffB);
            PG8_BAR; PG8_WAIT_L(0); PG8_MMA(0, 1, At, B1); PG8_BAR;
            PG8_LDA(At, 1, 1); PG8_STAGE(PG8_SA(1, 0), a3, voffA);
            PG8_BAR; PG8_WAIT_L(0); PG8_MMA(1, 0, At, B0); PG8_BAR; PG8_SCHED;
            PG8_STAGE(PG8_SB(1, 1), b3 + hstepB, voffB);
            PG8_WAIT_V(6); PG8_BAR; PG8_MMA(1, 1, At, B1); PG8_BAR;
        }
        { int frE = fr, fqE = fq; asm volatile("" : "+v"(frE), "+v"(fqE)); E(acc, cur, wr, wc, frE, fqE); }
        if (!has_next) break;
#pragma unroll
        for (int a = 0; a < 2; ++a)
#pragma unroll
            for (int b = 0; b < 2; ++b)
#pragma unroll
                for (int m = 0; m < 4; ++m)
#pragma unroll
                    for (int n = 0; n < 2; ++n) acc[a][b][m][n] = (f32x4){0.f, 0.f, 0.f, 0.f};
        cur = nxt; cA = nA; cB = nB; ++ui;
    }
    PG8_WAIT_V(0);
    if (wr == 0) PG8_BAR;
    PG8_BAR;
#undef PG8_SA
#undef PG8_SB
#undef PG8_STAGE
#undef PG8_LDA
#undef PG8_LDB
#undef PG8_MMA
#undef PG8_WAIT_V
#undef PG8_WAIT_L
#undef PG8_BAR
#undef PG8_SCHED
}

#define EPI_LOOP_ROWS _Pragma("unroll") for (int ai = 0; ai < 2; ++ai) _Pragma("unroll") for (int m = 0; m < 4; ++m)
__device__ __forceinline__ void st_bf16x8(bf16_t* p, f32x4 v0, f32x4 v1) { u32x4 w; w.x = cvtpk(v0[0], v0[1]); w.y = cvtpk(v0[2], v0[3]); w.z = cvtpk(v1[0], v1[1]); w.w = cvtpk(v1[2], v1[3]); *(u32x4*)p = w; }

template <bool I8_> struct EpiInProj {
    static constexpr bool HAS_MID = false; static constexpr bool I8 = I8_;
    bf16_t* qa; bf16_t* qidx; bf16_t* qkv; bf16_t* gates; float* small_; const float* xs; const unsigned* wmaxbits;
    __device__ __forceinline__ f32x4 val(const f32x4& a, float sc) const { if constexpr (I8_) { const i32x4 v = __builtin_bit_cast(i32x4, a); return (f32x4){(float)v[0], (float)v[1], (float)v[2], (float)v[3]} * sc; } else return a; }
    __device__ __forceinline__ void operator()(const f32x4 (&acc)[2][2][4][2], const Unit& u, int wr, int wc, int fr, int fq) const {
        const int pn = u.pn, row0 = u.pm * BM + wr * 64 + fr, lc0 = wc * 32 + fq * 8;
        float sw = 0.f; if constexpr (I8_) sw = __uint_as_float(*wmaxbits) * (1.3f / 127.0f);
        float scs[2][4];
#pragma unroll
        for (int ai = 0; ai < 2; ++ai)
#pragma unroll
            for (int m = 0; m < 4; ++m) { scs[ai][m] = 0.f; if constexpr (I8_) scs[ai][m] = xs[row0 + ai * HALF + m * 16] * sw; }
        if (pn < 8) {
            bf16_t* base = (pn < 4 ? qa + pn * 256 : qidx + (pn - 4) * 256) + lc0;
            EPI_LOOP_ROWS { const int row = row0 + ai * HALF + m * 16; const float sc = scs[ai][m];
#pragma unroll
                for (int bj = 0; bj < 2; ++bj) st_bf16x8(base + (size_t)row * 1024 + bj * HALF, val(acc[ai][bj][m][0], sc), val(acc[ai][bj][m][1], sc)); }
        } else if (pn < 32) {
            const int id = (pn - 8) >> 2, hb = ((pn - 8) & 3) * 2, b = u.pm >> 5;
            bf16_t* base = qkv + (size_t)id * ((size_t)NTOK * 1024) + lc0;
            EPI_LOOP_ROWS { const int row = row0 + ai * HALF + m * 16, s = row & (SEQ - 1); const float sc = scs[ai][m];
#pragma unroll
                for (int bj = 0; bj < 2; ++bj) st_bf16x8(base + ((size_t)(b * 8 + hb + bj) * SEQ + s) * 128, val(acc[ai][bj][m][0], sc), val(acc[ai][bj][m][1], sc)); }
        } else if (pn < 56) {
            unsigned char* base = (unsigned char*)gates + (pn - 32) * 256 + lc0;
            EPI_LOOP_ROWS { const int row = row0 + ai * HALF + m * 16; const float sc = scs[ai][m];
#pragma unroll
                for (int bj = 0; bj < 2; ++bj) { const f32x4 v0 = val(acc[ai][bj][m][0], sc), v1 = val(acc[ai][bj][m][1], sc); u32x2 w; unsigned p0 = 0u, p1 = 0u;
#pragma unroll
                    for (int j = 0; j < 4; ++j) { p0 |= (unsigned)(int)fmaxf(rintf(255.0f * sigmoidf_(v0[j])), 1.0f) << (8 * j); p1 |= (unsigned)(int)fmaxf(rintf(255.0f * sigmoidf_(v1[j])), 1.0f) << (8 * j); }
                    w.x = p0; w.y = p1; *(u32x2*)(base + (size_t)row * 6144 + bj * HALF) = w; } }
        } else {
            float* base = small_ + (pn - 56) * 256 + lc0;
            EPI_LOOP_ROWS { const int row = row0 + ai * HALF + m * 16; const float sc = scs[ai][m];
#pragma unroll
                for (int bj = 0; bj < 2; ++bj) { float* p = base + (size_t)row * 512 + bj * HALF; *(f32x4*)p = val(acc[ai][bj][m][0], sc); *(f32x4*)(p + 4) = val(acc[ai][bj][m][1], sc); } }
        }
    }
};
struct EpiBf16 {
    static constexpr bool HAS_MID = false; static constexpr bool I8 = false;
    bf16_t* out; int ld, cstep;
    __device__ __forceinline__ void operator()(const f32x4 (&acc)[2][2][4][2], const Unit& u, int wr, int wc, int fr, int fq) const {
        const int row0 = u.pm * BM + wr * 64 + fr; bf16_t* base = out + (size_t)u.pn * cstep + wc * 32 + fq * 8;
        EPI_LOOP_ROWS { const int row = row0 + ai * HALF + m * 16;
#pragma unroll
            for (int bj = 0; bj < 2; ++bj) st_bf16x8(base + (size_t)row * ld + bj * HALF, acc[ai][bj][m][0], acc[ai][bj][m][1]); }
    }
};
struct EpiBranch3 {
    static constexpr bool HAS_MID = true; static constexpr bool I8 = false; static constexpr int MID1 = 16, MID2 = 32;
    const unsigned char* gates; bf16_t* merged;
    __device__ __forceinline__ static f32x4 rat(unsigned n, unsigned d) {
        f32x4 r; r[0] = (float)(n & 255u) * __builtin_amdgcn_rcpf((float)(d & 255u)); r[1] = (float)((n >> 8) & 255u) * __builtin_amdgcn_rcpf((float)((d >> 8) & 255u));
        r[2] = (float)((n >> 16) & 255u) * __builtin_amdgcn_rcpf((float)((d >> 16) & 255u)); r[3] = (float)(n >> 24) * __builtin_amdgcn_rcpf((float)(d >> 24)); return r; }
    __device__ __forceinline__ void mid(f32x4 (&acc)[2][2][4][2], const Unit& u, int t, int wr, int wc, int fr, int fq) const {
        const int row0 = u.pm * BM + wr * 64 + fr, col0 = u.pn * BM + wc * 32 + fq * 8, bn = (t == MID1) ? 0 : 2048;
        u32x2 gn[2][4][2], gd[2][4][2];
        EPI_LOOP_ROWS {
#pragma unroll
            for (int bj = 0; bj < 2; ++bj) { const unsigned char* gp = gates + (size_t)(row0 + ai * HALF + m * 16) * 6144 + bn + col0 + bj * HALF; gn[ai][m][bj] = *(const u32x2*)gp; gd[ai][m][bj] = *(const u32x2*)(gp + 2048); } }
        EPI_LOOP_ROWS {
#pragma unroll
            for (int bj = 0; bj < 2; ++bj) { acc[ai][bj][m][0] *= rat(gn[ai][m][bj].x, gd[ai][m][bj].x); acc[ai][bj][m][1] *= rat(gn[ai][m][bj].y, gd[ai][m][bj].y); } }
    }
    __device__ __forceinline__ void operator()(const f32x4 (&acc)[2][2][4][2], const Unit& u, int wr, int wc, int fr, int fq) const {
        const int row0 = u.pm * BM + wr * 64 + fr, col0 = u.pn * BM + wc * 32 + fq * 8;
        u32x2 gl[2][4][2];
        EPI_LOOP_ROWS {
#pragma unroll
            for (int bj = 0; bj < 2; ++bj) gl[ai][m][bj] = *(const u32x2*)(gates + (size_t)(row0 + ai * HALF + m * 16) * 6144 + 4096 + col0 + bj * HALF); }
        EPI_LOOP_ROWS { const int row = row0 + ai * HALF + m * 16;
#pragma unroll
            for (int bj = 0; bj < 2; ++bj) { const int col = col0 + bj * HALF; const u32x2 gw = gl[ai][m][bj]; constexpr float I255 = 1.0f / 255.0f;
                f32x4 v0 = acc[ai][bj][m][0], v1 = acc[ai][bj][m][1];
                v0[0] *= (float)(gw.x & 255u) * I255; v0[1] *= (float)((gw.x >> 8) & 255u) * I255; v0[2] *= (float)((gw.x >> 16) & 255u) * I255; v0[3] *= (float)(gw.x >> 24) * I255;
                v1[0] *= (float)(gw.y & 255u) * I255; v1[1] *= (float)((gw.y >> 8) & 255u) * I255; v1[2] *= (float)((gw.y >> 16) & 255u) * I255; v1[3] *= (float)(gw.y >> 24) * I255;
                st_bf16x8(merged + (size_t)row * 2048 + col, v0, v1); } }
    }
};
struct EpiOut {
    static constexpr bool HAS_MID = false; static constexpr bool I8 = false;
    const bf16_t* res; bf16_t* pre;
    __device__ __forceinline__ void operator()(const f32x4 (&acc)[2][2][4][2], const Unit& u, int wr, int wc, int fr, int fq) const {
        const int row0 = u.pm * BM + wr * 64 + fr, col0 = u.pn * BM + wc * 32 + fq * 8;
        u32x4 rl[2][4][2];
        EPI_LOOP_ROWS { const int row = row0 + ai * HALF + m * 16;
#pragma unroll
            for (int bj = 0; bj < 2; ++bj) rl[ai][m][bj] = *(const u32x4*)(res + (size_t)row * 2048 + col0 + bj * HALF); }
        EPI_LOOP_ROWS { const int row = row0 + ai * HALF + m * 16;
#pragma unroll
            for (int bj = 0; bj < 2; ++bj) { const size_t o = (size_t)row * 2048 + col0 + bj * HALF;
                const u32x4 rw = rl[ai][m][bj]; f32x4 v0 = acc[ai][bj][m][0], v1 = acc[ai][bj][m][1];
                v0[0] += ALPHA * bflo(rw.x); v0[1] += ALPHA * bfhi(rw.x); v0[2] += ALPHA * bflo(rw.y); v0[3] += ALPHA * bfhi(rw.y);
                v1[0] += ALPHA * bflo(rw.z); v1[1] += ALPHA * bfhi(rw.z); v1[2] += ALPHA * bflo(rw.w); v1[3] += ALPHA * bfhi(rw.w);
                st_bf16x8(pre + o, v0, v1); } }
    }
};
struct EpiGateUpI8 {
    static constexpr bool HAS_MID = false; static constexpr bool I8 = true;
    const float* bg; const float* bu; bf16_t* hid; const float* rowsx; const unsigned* wmaxbits;
    __device__ __forceinline__ void operator()(const f32x4 (&acc)[2][2][4][2], const Unit& u, int wr, int wc, int fr, int fq) const {
        const int row0 = u.pm * BM + wr * 64 + fr, j0 = u.pn * 128 + wc * 32 + fq * 8;
        const float sw = __uint_as_float(*wmaxbits) * (1.3f / 127.0f);
        const float* pg = bg + (size_t)u.e * DEXP + j0; const float* pu = bu + (size_t)u.e * DEXP + j0;
        const f32x4 g0b = *(const f32x4*)pg, g1b = *(const f32x4*)(pg + 4), u0b = *(const f32x4*)pu, u1b = *(const f32x4*)(pu + 4);
        float scs[2][4];
#pragma unroll
        for (int ai = 0; ai < 2; ++ai)
#pragma unroll
            for (int m = 0; m < 4; ++m) scs[ai][m] = rowsx[row0 + ai * HALF + m * 16] * sw;
        EPI_LOOP_ROWS { const int row = row0 + ai * HALF + m * 16; const float sc = scs[ai][m];
            const i32x4 ag0 = __builtin_bit_cast(i32x4, acc[ai][0][m][0]), ag1 = __builtin_bit_cast(i32x4, acc[ai][0][m][1]), au0 = __builtin_bit_cast(i32x4, acc[ai][1][m][0]), au1 = __builtin_bit_cast(i32x4, acc[ai][1][m][1]);
            f32x4 h0, h1;
#pragma unroll
            for (int j = 0; j < 4; ++j) {
                float g = fminf((float)ag0[j] * sc + g0b[j], 7.0f), uu = fminf(fmaxf((float)au0[j] * sc + u0b[j], -7.0f), 7.0f);
                h0[j] = (uu + 1.0f) * (g * sigmoidf_(1.702f * g));
                g = fminf((float)ag1[j] * sc + g1b[j], 7.0f); uu = fminf(fmaxf((float)au1[j] * sc + u1b[j], -7.0f), 7.0f);
                h1[j] = (uu + 1.0f) * (g * sigmoidf_(1.702f * g)); }
            st_bf16x8(hid + (size_t)row * DEXP + j0, h0, h1); }
    }
};
struct EpiDown {
    static constexpr bool HAS_MID = false; static constexpr bool I8 = false;
    const float* bd; const float* roww; bf16_t* ys;
    __device__ __forceinline__ void operator()(const f32x4 (&acc)[2][2][4][2], const Unit& u, int wr, int wc, int fr, int fq) const {
        const int row0 = u.pm * BM + wr * 64 + fr, col0 = u.pn * BM + wc * 32 + fq * 8;
        f32x4 b[2][2];
#pragma unroll
        for (int bj = 0; bj < 2; ++bj) { const float* p = bd + (size_t)u.e * DM + col0 + bj * HALF; b[bj][0] = *(const f32x4*)p; b[bj][1] = *(const f32x4*)(p + 4); }
        float rws[2][4];
#pragma unroll
        for (int ai = 0; ai < 2; ++ai)
#pragma unroll
            for (int m = 0; m < 4; ++m) rws[ai][m] = roww[row0 + ai * HALF + m * 16];
        EPI_LOOP_ROWS { const int row = row0 + ai * HALF + m * 16; const float w = rws[ai][m];
#pragma unroll
            for (int bj = 0; bj < 2; ++bj) st_bf16x8(ys + (size_t)row * 2048 + col0 + bj * HALF, (acc[ai][bj][m][0] + b[bj][0]) * w, (acc[ai][bj][m][1] + b[bj][1]) * w); }
    }
};
struct EpiPleGateI8 {
    static constexpr bool HAS_MID = false; static constexpr bool I8 = true;
    const bf16_t* hb; const bf16_t* pp; bf16_t* pre; const float* hs; const unsigned* wmaxbits;
    __device__ __forceinline__ void operator()(const f32x4 (&acc)[2][2][4][2], const Unit& u, int wr, int wc, int fr, int fq) const {
        const int row0 = u.pm * BM + wr * 64 + fr, col0 = u.pn * BM + wc * 32 + fq * 8;
        const float sw = __uint_as_float(*wmaxbits) * (1.3f / 127.0f);
#pragma unroll
        for (int ai = 0; ai < 2; ++ai) { u32x4 pl[4][2], hl[4][2]; float scs[4];
#pragma unroll
            for (int m = 0; m < 4; ++m) { scs[m] = hs[row0 + ai * HALF + m * 16] * sw;
#pragma unroll
                for (int bj = 0; bj < 2; ++bj) { const size_t o = (size_t)(row0 + ai * HALF + m * 16) * 2048 + col0 + bj * HALF; pl[m][bj] = *(const u32x4*)(pp + o); hl[m][bj] = *(const u32x4*)(hb + o); } }
#pragma unroll
            for (int m = 0; m < 4; ++m) { const float sc = scs[m];
#pragma unroll
                for (int bj = 0; bj < 2; ++bj) { const size_t o = (size_t)(row0 + ai * HALF + m * 16) * 2048 + col0 + bj * HALF; const u32x4 pw = pl[m][bj], hw = hl[m][bj];
                    const i32x4 a0 = __builtin_bit_cast(i32x4, acc[ai][bj][m][0]), a1 = __builtin_bit_cast(i32x4, acc[ai][bj][m][1]); f32x4 o0, o1;
                    o0[0] = bflo(hw.x) + sigmoidf_((float)a0[0] * sc) * bflo(pw.x); o0[1] = bfhi(hw.x) + sigmoidf_((float)a0[1] * sc) * bfhi(pw.x); o0[2] = bflo(hw.y) + sigmoidf_((float)a0[2] * sc) * bflo(pw.y); o0[3] = bfhi(hw.y) + sigmoidf_((float)a0[3] * sc) * bfhi(pw.y);
                    o1[0] = bflo(hw.z) + sigmoidf_((float)a1[0] * sc) * bflo(pw.z); o1[1] = bfhi(hw.z) + sigmoidf_((float)a1[1] * sc) * bfhi(pw.z); o1[2] = bflo(hw.w) + sigmoidf_((float)a1[2] * sc) * bflo(pw.w); o1[3] = bfhi(hw.w) + sigmoidf_((float)a1[3] * sc) * bfhi(pw.w);
                    st_bf16x8(pre + o, o0, o1); } } }
    }
};
}

struct Params { const float* in[25]; float* out; unsigned char* ws; int ph_lo, ph_hi; };
__constant__ float c_invf_r[16] = {1.000000000e+00f, 4.403665960e-01f, 1.939227432e-01f, 8.539710194e-02f, 3.760603070e-02f, 1.656043902e-02f, 7.292664610e-03f, 3.211445874e-03f, 1.414213562e-03f, 6.227723788e-04f, 2.742481884e-04f, 1.207697351e-04f, 5.318296098e-05f, 2.341999971e-05f, 1.031338616e-05f, 4.541670478e-06f};
__constant__ float c_invf_i[8] = {1.000000000e+00f, 1.939227432e-01f, 3.760603070e-02f, 7.292664610e-03f, 1.414213562e-03f, 2.742481884e-04f, 5.318296098e-05f, 1.031338616e-05f};
constexpr int LDS_PTRS = LDS_MISC + 256;
struct Frame { unsigned char* lds; LAS unsigned char* ldsl; unsigned char* ws; int tid, lane, wid, G, bid;
    __device__ __forceinline__ const float* in(int k) const { const LAS unsigned* t = (const LAS unsigned*)(ldsl + LDS_PTRS) + 2 * k;
        const unsigned lo = __builtin_amdgcn_readfirstlane(t[0]), hi = __builtin_amdgcn_readfirstlane(t[1]); return (const float*)(const GAS float*)(((unsigned long long)hi << 32) | lo); }
    __device__ __forceinline__ float* out() const { return (float*)in(25); } };
__device__ __forceinline__ Frame fresh(const Frame& F0) { Frame F = F0; int t = threadIdx.x; asm volatile("" : "+v"(t)); F.tid = t; F.lane = t & 63; F.wid = __builtin_amdgcn_readfirstlane(t >> 6); size_t z = 0; asm volatile("" : "+s"(z)); F.ws = F0.ws + z; return F; }

struct TcTile { const float* src; long sld; bf16_t* dst; long dld; int nvalid; float qinv; };
template <class Dec>
__device__ __forceinline__ void tconv_run(const Frame& F, int total, const Dec& dec, int& rot) {
    float* tile = (float*)F.lds;
    const int tid = F.tid, G = F.G;
    const int start = (F.bid - (rot % G) + G) % G; rot += total;
    const int lr = tid >> 4, lc4 = (tid & 15) * 4, sn = tid >> 3, skc = (tid & 7) * 8;
    f32x4 v[4][2];
#define TC_ISSUE(t0_) do { _Pragma("unroll") for (int q = 0; q < 4; ++q) { const int t = (t0_) + q * G; \
        if (t < total) { const TcTile ti = dec(t); _Pragma("unroll") for (int h = 0; h < 2; ++h) { v[q][h] = (f32x4){0.f, 0.f, 0.f, 0.f}; \
            if (lc4 < ti.nvalid) v[q][h] = *(const GAS f32x4*)((const GAS float*)ti.src + (size_t)(lr + 32 * h) * ti.sld + lc4); } } } } while (0)
    if (start < total) TC_ISSUE(start);
    for (int t0 = start; t0 < total; t0 += 4 * G) {
#pragma unroll
        for (int q = 0; q < 4; ++q) { if (t0 + q * G < total) { float* tl = tile + q * (64 * 65);
#pragma unroll
                for (int h = 0; h < 2; ++h) { float* p = tl + (lr + 32 * h) * 65 + lc4; p[0] = v[q][h][0]; p[1] = v[q][h][1]; p[2] = v[q][h][2]; p[3] = v[q][h][3]; } } }
        __syncthreads();
        if (t0 + 4 * G < total) TC_ISSUE(t0 + 4 * G);
#pragma unroll
        for (int q = 0; q < 4; ++q) { const int t = t0 + q * G;
            if (t < total) { const TcTile ti = dec(t); const float* tl = tile + q * (64 * 65);
                if (ti.qinv > 0.f) { if (tid < 256) { const int n8 = tid >> 2, kc = (tid & 3) * 16; u32x4 w;
#pragma unroll
                        for (int d = 0; d < 4; ++d) { unsigned pk = 0u;
#pragma unroll
                            for (int j = 0; j < 4; ++j) { float q = rintf(tl[(kc + d * 4 + j) * 65 + n8] * ti.qinv); q = fminf(fmaxf(q, -127.f), 127.f); pk |= ((unsigned)(int)q & 0xffu) << (8 * j); }
                            w[d] = pk; }
                        *(u32x4*)((unsigned char*)ti.dst + (size_t)n8 * ti.dld + kc) = w; } }
                else if (sn < ti.nvalid) { f32x4 a, b;
#pragma unroll
                    for (int j = 0; j < 4; ++j) { a[j] = tl[(skc + j) * 65 + sn]; b[j] = tl[(skc + 4 + j) * 65 + sn]; }
                    pg8::st_bf16x8(ti.dst + (size_t)sn * ti.dld + skc, a, b); } } }
        __syncthreads();
    }
#undef TC_ISSUE
}
struct TcMat {
    const float* src; long src_ld; int tk, ncols; bf16_t* dst; long dst_ld; float qinv;
    __device__ __forceinline__ TcTile operator()(int t) const { const int k0 = (t % tk) * 64, n0 = (t / tk) * 64; TcTile ti;
        ti.src = src + (size_t)k0 * src_ld + n0; ti.sld = src_ld; ti.dst = qinv > 0.f ? (bf16_t*)((unsigned char*)dst + (size_t)n0 * dst_ld + k0) : dst + (size_t)n0 * dst_ld + k0; ti.dld = dst_ld; ti.nvalid = (ncols - n0) < 64 ? (ncols - n0) : 64; ti.qinv = qinv; return ti; }
};
__device__ __forceinline__ void tconv(const Frame& F, const float* src, long src_ld, int K, int ncols, bf16_t* dst, long dst_ld, int& rot) {
    TcMat d{src, src_ld, K >> 6, ncols, dst, dst_ld, 0.f}; tconv_run(F, (K >> 6) * ((ncols + 63) >> 6), d, rot);
}
struct TcExperts {
    const float* wg; const float* wu; const float* wd; unsigned char* dgu; bf16_t* ddn; float qinv;
    __device__ __forceinline__ TcTile operator()(int t) const { const int e = t / 1536, r = t - e * 1536; TcTile ti; ti.nvalid = 64; ti.qinv = 0.f;
        if (r < 1024) { const int k0 = (r & 31) * 64, dt = r >> 5, jb = dt >> 2, gu = (dt >> 1) & 1, half = dt & 1;
            ti.src = (const float*)((unsigned long long)wg + (unsigned long long)gu * ((unsigned long long)wu - (unsigned long long)wg)) + (size_t)e * DM * DEXP + (size_t)k0 * DEXP + jb * 128 + half * 64; ti.sld = DEXP;
            ti.dst = (bf16_t*)(dgu + (size_t)e * 2048 * 2048 + (size_t)(dt * 64) * 2048 + k0); ti.dld = 2048; ti.qinv = qinv; }
        else { const int r2 = r - 1024, k0 = (r2 & 15) * 64, n0 = (r2 >> 4) * 64;
            ti.src = wd + (size_t)e * DEXP * DM + (size_t)k0 * DM + n0; ti.sld = DM;
            ti.dst = ddn + (size_t)e * 2048 * 1024 + (size_t)n0 * 1024 + k0; ti.dld = 1024; }
        return ti; }
};
__device__ __forceinline__ void sample_wmax(const Frame& F) {
    unsigned* wm = (unsigned*)(F.ws + WS_CTL) + CW_WMAX;
#pragma unroll 1
    for (int l = 0; l < NLAYER; ++l) { float mx = 0.f;
#pragma unroll 1
        for (int which = 0; which < 2; ++which) { const f32x4* p = (const f32x4*)(F.in(which ? 17 : 15) + (size_t)l * NEXP * DM * DEXP);
            for (size_t i = (size_t)F.bid * 512 + F.tid; i < (size_t)NEXP * DM * DEXP / 4 / 64; i += (size_t)F.G * 512) { const f32x4 v = p[i * 64 + (i & 63)];
                mx = fmaxf(mx, fmaxf(fmaxf(fabsf(v[0]), fabsf(v[1])), fmaxf(fabsf(v[2]), fabsf(v[3])))); } }
        for (int o = 32; o > 0; o >>= 1) mx = fmaxf(mx, __shfl_xor(mx, o));
        if (F.lane == 0 && mx > 0.f) atomicMax(&wm[l], __float_as_uint(mx));
        float mg = 0.f; const f32x4* wi_ = (const f32x4*)(F.in(2) + (size_t)l * DM * INW);
        for (int i = F.bid * 512 + F.tid; i < DM * (INW / 4) / 16; i += F.G * 512) { const f32x4 v = wi_[(size_t)i * 16 + (i & 15)];
            mg = fmaxf(mg, fmaxf(fmaxf(fabsf(v[0]), fabsf(v[1])), fmaxf(fabsf(v[2]), fabsf(v[3])))); }
        for (int o = 32; o > 0; o >>= 1) mg = fmaxf(mg, __shfl_xor(mg, o));
        if (F.lane == 0 && mg > 0.f) atomicMax(&wm[CW_WMAXG - CW_WMAX + l], __float_as_uint(mg));
        float mp = 0.f; const f32x4* wp_ = (const f32x4*)(F.in(21) + (size_t)l * DM * DM);
        for (int i = F.bid * 512 + F.tid; i < DM * DM / 4 / 16; i += F.G * 512) { const f32x4 v = wp_[i * 16 + (i & 15)];
            mp = fmaxf(mp, fmaxf(fmaxf(fabsf(v[0]), fabsf(v[1])), fmaxf(fabsf(v[2]), fabsf(v[3])))); }
        for (int o = 32; o > 0; o >>= 1) mp = fmaxf(mp, __shfl_xor(mp, o));
        if (F.lane == 0 && mp > 0.f) atomicMax(&wm[CW_WMAXP - CW_WMAX + l], __float_as_uint(mp)); }
}
__device__ __forceinline__ void conv_rows(const Frame& F, const float* src, bf16_t* dst, size_t n8) {
    for (size_t i = (size_t)F.bid * 512 + F.tid; i < n8; i += (size_t)F.G * 512) { const f32x4 a = *(const f32x4*)(src + i * 8), b = *(const f32x4*)(src + i * 8 + 4); pg8::st_bf16x8(dst + i * 8, a, b); }
}
__device__ __forceinline__ void quant_rows(const Frame& F, const float* src, bf16_t* xb, unsigned char* xq, float* xsc) {
    const int lane = F.lane;
    for (int tok = F.bid * 8 + F.wid; tok < NTOK; tok += F.G * 8) { f32x4 v[8]; float amax = 0.f;
#pragma unroll
        for (int i = 0; i < 4; ++i) { const int c = (i * 64 + lane) * 8; v[2 * i] = *(const f32x4*)(src + (size_t)tok * DM + c); v[2 * i + 1] = *(const f32x4*)(src + (size_t)tok * DM + c + 4);
            pg8::st_bf16x8(xb + (size_t)tok * DM + c, v[2 * i], v[2 * i + 1]);
#pragma unroll
            for (int h = 0; h < 2; ++h)
#pragma unroll
                for (int j = 0; j < 4; ++j) amax = fmaxf(amax, fabsf(v[2 * i + h][j])); }
        for (int o = 32; o > 0; o >>= 1) amax = fmaxf(amax, __shfl_xor(amax, o));
        amax = fmaxf(amax, 1e-20f); const float qi = 127.0f / amax; if (lane == 0) xsc[tok] = amax * (1.0f / 127.0f);
#pragma unroll
        for (int i = 0; i < 4; ++i) { u32x2 w;
#pragma unroll
            for (int h = 0; h < 2; ++h) { unsigned pk = 0u;
#pragma unroll
                for (int j = 0; j < 4; ++j) pk |= ((unsigned)(int)rintf(v[2 * i + h][j] * qi) & 0xffu) << (8 * j);
                w[h] = pk; }
            *(u32x2*)(xq + (size_t)tok * DM + (i * 64 + lane) * 8) = w; } }
}
__constant__ int c_so[14] = {0, 1312, 2416, 3440, 4464, 5496, 6520, 7544, 8568, 1024, 1280, 2336, 2400, 5488};
__constant__ int c_dn[14] = {0, 1024, 2048, 3072, 4096, 5120, 6144, 7168, 8192, 14336, 14592, 14624, 14688, 14704};
__constant__ int c_nc[14] = {1024, 1024, 1024, 1024, 1024, 1024, 1024, 1024, 6144, 256, 32, 64, 16, 8};
__device__ __forceinline__ void convert_layer_weights(const Frame& F0, const Params& P, int l) { const Frame F = fresh(F0);
    unsigned char* ws = F.ws; int rot = 0;
    { const float* w = F.in(2) + (size_t)l * DM * INW; bf16_t* d = (bf16_t*)(ws + W_IN);
      const float wmaxg = __uint_as_float(((const unsigned*)(ws + WS_CTL))[CW_WMAXG + l]); const float qinv = 127.0f / (1.3f * fmaxf(wmaxg, 1e-30f));
#pragma unroll 1
      for (int s = 0; s < 14; ++s) {
          if (s == 1 || s >= 10) tconv(F, w + c_so[s], INW, DM, c_nc[s], d + (size_t)c_dn[s] * DM, DM, rot);
          else { const int crow = (s == 0) ? 0 : (s <= 7 ? 1024 + (s - 2) * 1024 : (s == 8 ? 7168 : 13312));
              TcMat dq{w + c_so[s], INW, DM >> 6, c_nc[s], (bf16_t*)(ws + W_IN8 + (size_t)crow * 2048), 2048, qinv}; tconv_run(F, (DM >> 6) * (c_nc[s] >> 6), dq, rot); } } }
    tconv(F, F.in(7) + (size_t)l * 1024 * DM, DM, 1024, DM, (bf16_t*)(ws + W_BRA), 3072, rot);
    tconv(F, F.in(8) + (size_t)l * 1024 * DM, DM, 1024, DM, (bf16_t*)(ws + W_BRA) + 1024, 3072, rot);
    tconv(F, F.in(9) + (size_t)l * 1024 * DM, DM, 1024, DM, (bf16_t*)(ws + W_BRA) + 2048, 3072, rot);
    tconv(F, F.in(10) + (size_t)l * DM * DM, DM, DM, DM, (bf16_t*)(ws + W_OUT), DM, rot);
    { const float wmp = __uint_as_float(((const unsigned*)(ws + WS_CTL))[CW_WMAXP + l]);
      TcMat dq{F.in(21) + (size_t)l * DM * DM, DM, DM >> 6, DM, (bf16_t*)(ws + W_PG), 2048, 127.0f / (1.3f * fmaxf(wmp, 1e-30f))}; tconv_run(F, (DM >> 6) * (DM >> 6), dq, rot); }
    tconv(F, F.in(22) + (size_t)l * 256 * DM, DM, 256, DM, (bf16_t*)(ws + W_PLE), 256, rot);
#pragma unroll 1
    for (int h = 0; h < 8; ++h) tconv(F, F.in(6) + (size_t)l * 256 * 1024 + h * 128, 1024, 256, 128, (bf16_t*)(ws + W_UV2) + ((size_t)(h >> 1) * 256 + (h & 1) * 128) * 512 + (h & 1) * 256, 512, rot);
    { const float wmax = __uint_as_float(((const unsigned*)(ws + WS_CTL))[CW_WMAX + l]);
      TcExperts d{F.in(15) + (size_t)l * NEXP * DM * DEXP, F.in(17) + (size_t)l * NEXP * DM * DEXP, F.in(19) + (size_t)l * NEXP * DEXP * DM, (unsigned char*)(ws + W_GU), (bf16_t*)(ws + W_DN), 127.0f / (1.3f * fmaxf(wmax, 1e-30f))};
      tconv_run(F, NEXP * 1536, d, rot); }
    { const float* w = F.in(5) + (size_t)l * 256 * 8 * 96; bf16_t* d = (bf16_t*)(ws + W_UK2);
      for (int i = F.bid * 512 + F.tid; i < 256 * 8 * 96; i += F.G * 512) { const int n = i % 96, h = (i / 96) & 7, r = i / 768; d[((size_t)h * 256 + r) * 256 + (h & 1) * 128 + 32 + n] = f2bf(w[i]); } }
}

__device__ __forceinline__ void rope_cs(float pos, float invf, float& c, float& s) {
    const float a = pos * invf; const double ad = (double)a * 0.15915494309189535; const float fr = (float)(ad - rint(ad));
    s = __builtin_amdgcn_sinf(fr); c = __builtin_amdgcn_cosf(fr);
}
__device__ __forceinline__ void phase_prep(const Frame& F0, const Params& P, int l) { const Frame F = fresh(F0);
    unsigned char* ws = F.ws; const int lane = F.lane;
    const float* smallb = (const float*)(ws + R_SMALL); bf16_t* kcat = (bf16_t*)(ws + R_KCAT); bf16_t* qcat = (bf16_t*)(ws + R_QCAT);
    bf16_t* ki = (bf16_t*)(ws + R_KI); float* wi = (float*)(ws + R_WI); float* lf = (float*)(ws + WS_LF);
    const bf16_t* qa = (const bf16_t*)(ws + R_QA); bf16_t* qidx = (bf16_t*)(ws + R_QIDX);
    const f32x4 gck = *(const f32x4*)(F.in(4) + l * 256 + lane * 4);
    const float bfo = lane < 8 ? F.in(3)[l * 8 + lane] : 0.f;
    const float ifr = c_invf_r[lane & 15], ifi = c_invf_i[lane & 7];
    for (int tok = F.bid * 8 + F.wid; tok < NTOK; tok += F.G * 8) {
        const int s = tok & (SEQ - 1), b = tok >> 13; const float* sm = smallb + (size_t)tok * 512;
        float cr, sr, ci, si; rope_cs((float)s, ifr, cr, sr); rope_cs((float)s, ifi, ci, si);
        { const f32x4 v = *(const f32x4*)(sm + lane * 4); float ss = v[0] * v[0] + v[1] * v[1] + v[2] * v[2] + v[3] * v[3]; ss = wave_sum(ss);
          const float rs = rsqrtf(ss * (1.0f / 256.0f) + 1e-6f); u32x2 w; w.x = cvtpk(v[0] * rs * gck[0], v[1] * rs * gck[1]); w.y = cvtpk(v[2] * rs * gck[2], v[3] * rs * gck[3]);
          *(u32x2*)(kcat + (size_t)tok * 288 + lane * 4) = w; }
        if (lane < 16) { const float x1 = sm[256 + lane], x2 = sm[272 + lane]; kcat[(size_t)tok * 288 + 256 + lane] = f2bf(x1 * cr - x2 * sr); kcat[(size_t)tok * 288 + 272 + lane] = f2bf(x2 * cr + x1 * sr); }
        { float o = sm[288 + lane];
          if (lane < 8) { const float x2 = sm[296 + lane]; o = o * ci - x2 * si; } else if (lane < 16) { const float x1 = sm[288 + lane - 8]; o = o * ci + x1 * si; }
          ki[(size_t)tok * 64 + lane] = f2bf(o); }
        if (lane < 16) wi[(size_t)tok * 16 + lane] = sm[352 + lane] * (1.0f / 32.0f);
        if (lane < 8) { const float f = sm[368 + lane] + bfo; lf[(size_t)(b * 8 + lane) * SEQ + s] = fminf(f, 0.f) - log1pf(__expf(-fabsf(f))); }
#pragma unroll
        for (int pp = 0; pp < 2; ++pp) { const int p = lane + 64 * pp, h = p >> 4, i = p & 15;
            const float x1 = bf2f(qa[(size_t)tok * 1024 + h * 128 + i]), x2 = bf2f(qa[(size_t)tok * 1024 + h * 128 + 16 + i]);
            qcat[(size_t)tok * 2304 + h * 288 + 256 + i] = f2bf(x1 * cr - x2 * sr); qcat[(size_t)tok * 2304 + h * 288 + 272 + i] = f2bf(x2 * cr + x1 * sr); }
#pragma unroll
        for (int pp = 0; pp < 2; ++pp) { const int p = lane + 64 * pp, hh = p >> 3, i = p & 7; bf16_t* q = qidx + (size_t)tok * 1024 + hh * 64;
            const float x1 = bf2f(q[i]), x2 = bf2f(q[8 + i]); q[i] = f2bf(x1 * ci - x2 * si); q[8 + i] = f2bf(x2 * ci + x1 * si); }
    }
    { const bf16_t* kbt = (const bf16_t*)(ws + R_QKV) + (size_t)NTOK * 1024; unsigned* kmx = (unsigned*)(ws + WS_CTL) + CW_KMAX + l * 16;
#pragma unroll 1
      for (int bh = 0; bh < 16; ++bh) { float mx = 0.f;
          for (int r0 = (F.bid * 8 + F.wid) * 4; r0 < SEQ; r0 += F.G * 32) {
              const u32x4 w = *(const u32x4*)(kbt + ((size_t)bh * SEQ + r0 + (lane >> 4)) * 128 + (lane & 15) * 8);
              float ss = bflo(w.x) * bflo(w.x) + bfhi(w.x) * bfhi(w.x) + bflo(w.y) * bflo(w.y) + bfhi(w.y) * bfhi(w.y) + bflo(w.z) * bflo(w.z) + bfhi(w.z) * bfhi(w.z) + bflo(w.w) * bflo(w.w) + bfhi(w.w) * bfhi(w.w);
              ss += __shfl_xor(ss, 1); ss += __shfl_xor(ss, 2); ss += __shfl_xor(ss, 4); ss += __shfl_xor(ss, 8); mx = fmaxf(mx, ss); }
          mx = fmaxf(mx, __shfl_xor(mx, 16)); mx = fmaxf(mx, __shfl_xor(mx, 32));
          if (lane == 0) ((float*)F.lds)[F.wid * 16 + bh] = mx; }
      __syncthreads();
      if (F.tid < 16) { float mx = 0.f;
#pragma unroll
          for (int w = 0; w < 8; ++w) mx = fmaxf(mx, ((const float*)F.lds)[w * 16 + F.tid]);
          const unsigned bits = __float_as_uint(mx);
          if (bits > __hip_atomic_load(&kmx[F.tid], __ATOMIC_RELAXED, __HIP_MEMORY_SCOPE_AGENT)) atomicMax(&kmx[F.tid], bits); }
      __syncthreads(); }
}
__device__ __forceinline__ void phase_cumsum(const Frame& F0) { const Frame F = fresh(F0);
    const int gw = F.bid * 8 + F.wid; if (gw >= 16) return;
    const float* lf = (const float*)(F.ws + WS_LF) + (size_t)gw * SEQ; float* cum = (float*)(F.ws + WS_CUM) + (size_t)gw * SEQ;
    const int lane = F.lane; double tot = 0.0;
    for (int j = 0; j < 128; ++j) tot += (double)lf[lane * 128 + j];
    double inc = tot;
    for (int o = 1; o < 64; o <<= 1) { const double n = __shfl_up(inc, o); if (lane >= o) inc += n; }
    double run = inc - tot;
    for (int j = 0; j < 128; ++j) { run += (double)lf[lane * 128 + j]; cum[lane * 128 + j] = (float)run; }
}

__device__ __forceinline__ void idx_unit(const Frame& F, int b, int pi, int half) {
    const int tid = F.tid, lane = F.lane, rho = lane & 31, hh = lane >> 5; unsigned char* ws = F.ws;
    const bf16_t* qidx = (const bf16_t*)(ws + R_QIDX); const bf16_t* ki = (const bf16_t*)(ws + R_KI) + (size_t)b * SEQ * 64; const float* wi = (const float*)(ws + R_WI);
    float* scores = (float*)(ws + R_SCORES) + (size_t)b * SEQ * SEQ;
    LAS unsigned char* kl = F.ldsl;
    const int gl = pi, gh = 127 - pi, nl = (64 * gl + 63) / 128 + 1, nh = (64 * gh + 63) / 128 + 1, tot = nl + nh;
    const int x0 = half ? tot / 2 : 0, x1 = half ? tot : tot / 2;
    bf16x8 af[4][4]; float wv[4][16]; int t0 = 0, curg = -1;
    const int r0 = tid >> 3, p0 = tid & 7;
    const unsigned d0 = (unsigned)(r0 * 128 + ((p0 ^ (r0 & 7)) << 4)), d1 = d0 + 64 * 128;
    u32x4 s0, s1;
    { const int c = x0 < nl ? x0 : x0 - nl; const bf16_t* kp = ki + (size_t)(c * 128) * 64; s0 = *(const u32x4*)(kp + (size_t)r0 * 64 + p0 * 8); s1 = *(const u32x4*)(kp + (size_t)(r0 + 64) * 64 + p0 * 8); }
    __syncthreads();
    *(LAS u32x4*)(kl + d0) = s0; *(LAS u32x4*)(kl + d1) = s1;
    __syncthreads();
    const unsigned rdo = (unsigned)(rho * 128);
#pragma unroll 1
    for (int x = x0; x < x1; ++x) {
        const int g = x < nl ? gl : gh, c = x < nl ? x : x - nl;
        if (g != curg) { curg = g; t0 = g * 64 + F.wid * 8;
#pragma unroll
            for (int mt = 0; mt < 4; ++mt) {
                const int tokA = b * SEQ + t0 + 2 * mt + ((rho >> 2) & 1), head = (rho & 3) + 4 * (rho >> 3);
#pragma unroll
                for (int kk = 0; kk < 4; ++kk) af[mt][kk] = *(const bf16x8*)(qidx + (size_t)tokA * 1024 + head * 64 + kk * 16 + 8 * hh);
                const float* wp = wi + (size_t)(b * SEQ + t0 + 2 * mt + hh) * 16;
#pragma unroll
                for (int q = 0; q < 4; ++q) { const f32x4 v = *(const f32x4*)(wp + 4 * q); wv[mt][4 * q] = v[0]; wv[mt][4 * q + 1] = v[1]; wv[mt][4 * q + 2] = v[2]; wv[mt][4 * q + 3] = v[3]; } } }
        const unsigned bo = (unsigned)((x - x0) & 1) * 16384u;
        if (x + 1 < x1) { const int cn = (x + 1) < nl ? (x + 1) : (x + 1) - nl; const bf16_t* kp = ki + (size_t)(cn * 128) * 64; s0 = *(const u32x4*)(kp + (size_t)r0 * 64 + p0 * 8); s1 = *(const u32x4*)(kp + (size_t)(r0 + 64) * 64 + p0 * 8); }
#pragma unroll
        for (int tl = 0; tl < 4; ++tl) {
            const int kb = c * 128 + tl * 32;
            if (kb <= t0 + 7) {
                bf16x8 bc[4];
#pragma unroll
                for (int kk = 0; kk < 4; ++kk) bc[kk] = *(const LAS bf16x8*)(kl + bo + tl * 4096 + rdo + (((kk * 2 + hh) ^ (rho & 7)) << 4));
                f32x16 a0 = {}, a1 = {}, a2 = {}, a3 = {};
#pragma unroll
                for (int kk = 0; kk < 4; ++kk) { a0 = __builtin_amdgcn_mfma_f32_32x32x16_bf16(af[0][kk], bc[kk], a0, 0, 0, 0); a1 = __builtin_amdgcn_mfma_f32_32x32x16_bf16(af[1][kk], bc[kk], a1, 0, 0, 0);
                                                  a2 = __builtin_amdgcn_mfma_f32_32x32x16_bf16(af[2][kk], bc[kk], a2, 0, 0, 0); a3 = __builtin_amdgcn_mfma_f32_32x32x16_bf16(af[3][kk], bc[kk], a3, 0, 0, 0); }
#define IDX_EPI(A_, mt_) do { float x_0 = 0.f, x_1 = 0.f, x_2 = 0.f, x_3 = 0.f; _Pragma("unroll") for (int r = 0; r < 16; r += 4) { \
                    x_0 = fmaf(wv[mt_][r], fmaxf(A_[r], 0.f), x_0); x_1 = fmaf(wv[mt_][r + 1], fmaxf(A_[r + 1], 0.f), x_1); x_2 = fmaf(wv[mt_][r + 2], fmaxf(A_[r + 2], 0.f), x_2); x_3 = fmaf(wv[mt_][r + 3], fmaxf(A_[r + 3], 0.f), x_3); } \
                    scores[(size_t)(t0 + 2 * (mt_) + hh) * SEQ + kb + rho] = (x_0 + x_1) + (x_2 + x_3); } while (0)
                IDX_EPI(a0, 0); IDX_EPI(a1, 1); IDX_EPI(a2, 2); IDX_EPI(a3, 3);
#undef IDX_EPI
            }
        }
        if (x + 1 < x1) { *(LAS u32x4*)(kl + (bo ^ 16384u) + d0) = s0; *(LAS u32x4*)(kl + (bo ^ 16384u) + d1) = s1; }
        __syncthreads();
    }
}
__device__ __forceinline__ void phase_idx(const Frame& F0) { const Frame F = fresh(F0);
#pragma unroll 1
    for (int it = F.bid; it < 256; it += F.G) { const int b = it >> 7, pi = (it >> 1) & 63, half = it & 1; idx_unit(F, b, pi, half); }
}

__device__ __forceinline__ unsigned sortable(float f) { const unsigned u = __float_as_uint(f); return (u & 0x80000000u) ? ~u : (u | 0x80000000u); }
__device__ __forceinline__ void topk_row(const Frame& F, int b, int t) {
    int lane = F.lane; asm volatile("" : "+v"(lane));
    const int L = t + 1, tok = b * SEQ + t; unsigned char* ws = F.ws;
    int* sel = (int*)(ws + R_SEL) + (size_t)tok * 256; int* nsel = (int*)(ws + R_NSEL);
    if (lane == 0) nsel[tok] = L < 256 ? L : 256;
    if (L <= 256) { for (int j = lane; j < 256; j += 64) sel[j] = j < L ? j : 0; return; }
    const float* row = (const float*)(ws + R_SCORES) + ((size_t)b * SEQ + t) * SEQ;
    const int nch = (L + 1023) >> 10;
#define TOPK_LOAD_ROW() do { _Pragma("unroll") for (int c = 0; c < 8; ++c) { \
        if (c < nch) { _Pragma("unroll") for (int jj = 0; jj < 4; ++jj) { const int j = c * 4 + jj; const f32x4 v = *(const f32x4*)(row + j * 256 + lane * 4); \
                _Pragma("unroll") for (int e_ = 0; e_ < 4; ++e_) { const int idx = j * 256 + lane * 4 + e_; u[j * 4 + e_] = idx < L ? sortable(v[e_]) : 0u; } } } \
        else { _Pragma("unroll") for (int q = 0; q < 16; ++q) u[c * 16 + q] = 0u; } } } while (0)
    unsigned u[128];
    TOPK_LOAD_ROW();
    unsigned g0 = 0u, g1 = 0u, g2 = 0u, g3 = 0u;
#pragma unroll
    for (int c = 0; c < 8; ++c) if (c < nch) {
#pragma unroll
        for (int jj = 0; jj < 4; ++jj) { const int j = c * 4 + jj; g0 = u[4 * j] > g0 ? u[4 * j] : g0; g1 = u[4 * j + 1] > g1 ? u[4 * j + 1] : g1; g2 = u[4 * j + 2] > g2 ? u[4 * j + 2] : g2; g3 = u[4 * j + 3] > g3 ? u[4 * j + 3] : g3; } }
    unsigned tl = g0 < g1 ? g0 : g1; { const unsigned t2 = g2 < g3 ? g2 : g3; tl = tl < t2 ? tl : t2; }
#pragma unroll
    for (int o = 32; o > 0; o >>= 1) { const unsigned x = (unsigned)__shfl_xor((int)tl, o); tl = x < tl ? x : tl; }
    constexpr int CAP = 2048;
    LAS unsigned* candk = (LAS unsigned*)(F.ldsl + F.wid * (CAP * 8)); LAS unsigned* candi = candk + CAP;
    int C = 0;
#pragma unroll
    for (int c = 0; c < 8; ++c) if (c < nch) {
#pragma unroll
        for (int q = 0; q < 16; ++q) { const int rq = c * 16 + q; const bool pr = u[rq] >= tl; const unsigned long long mm = __ballot(pr);
            const int pos = C + __popcll(mm & ((1ull << lane) - 1ull));
            if (pr && pos < CAP) { candk[pos] = u[rq]; candi[pos] = (unsigned)((rq >> 2) * 256 + lane * 4 + (rq & 3)); }
            C += __popcll(mm); if ((q & 3) == 3) SBAR(); } }
    if (C <= CAP) {
        const int ng = (C + 255) >> 8;
        unsigned ck[32]; int ci[32];
#pragma unroll
        for (int g = 0; g < 8; ++g) {
#pragma unroll
            for (int q = 0; q < 4; ++q) { const int r = g * 4 + q, p = r * 64 + lane; ck[r] = 0u; ci[r] = 0;
                if (g < ng && p < C) { ck[r] = candk[p]; ci[r] = (int)candi[p]; } } }
        unsigned T = 0u, thr_gt = 0u; int need_eq = 0; bool early = false;
        for (int bit = 31; bit >= 0; --bit) {
            const unsigned cnd = T | (1u << bit); int cnt = 0;
#pragma unroll
            for (int g = 0; g < 8; ++g) if (g < ng) {
#pragma unroll
                for (int q = 0; q < 4; ++q) cnt += __popcll(__ballot(ck[g * 4 + q] >= cnd)); }
            if (cnt >= 256) { T = cnd; if (cnt == 256) { early = true; break; } }
        }
        if (early) { thr_gt = T - 1u; need_eq = 0; }
        else { int gtc = 0;
#pragma unroll
            for (int g = 0; g < 8; ++g) if (g < ng) {
#pragma unroll
                for (int q = 0; q < 4; ++q) gtc += __popcll(__ballot(ck[g * 4 + q] > T)); }
            thr_gt = T; need_eq = 256 - gtc; }
        int base = 0, eq_taken = 0;
#pragma unroll
        for (int g = 0; g < 8; ++g) if (g < ng) {
#pragma unroll
            for (int q = 0; q < 4; ++q) { const int r = g * 4 + q; const unsigned v = ck[r];
                const bool iseq = (v == thr_gt) && (need_eq > 0);
                const unsigned long long meq = __ballot(iseq);
                const int eqr = __popcll(meq & ((1ull << lane) - 1ull));
                const bool take = (v > thr_gt) || (iseq && (eq_taken + eqr < need_eq));
                const unsigned long long mt = __ballot(take);
                const int pos = base + __popcll(mt & ((1ull << lane) - 1ull));
                if (take && pos < 256) sel[pos] = ci[r];
                base += __popcll(mt); eq_taken += __popcll(meq); } }
        return;
    }
    asm volatile("" ::: "memory");
    TOPK_LOAD_ROW();
    unsigned T = 0u, thr_gt = 0u; int need_eq = 0; bool early = false;
    for (int bit = 31; bit >= 0; --bit) {
        const unsigned cand = T | (1u << bit); int cnt = 0;
#pragma unroll
        for (int c = 0; c < 8; ++c) if (c < nch) {
#pragma unroll
            for (int q = 0; q < 16; ++q) cnt += __popcll(__ballot(u[c * 16 + q] >= cand)); }
        if (cnt >= 256) { T = cand; if (cnt == 256) { early = true; break; } }
    }
    if (early) { thr_gt = T - 1u; need_eq = 0; }
    else { int gtc = 0;
#pragma unroll
        for (int c = 0; c < 8; ++c) if (c < nch) {
#pragma unroll
            for (int q = 0; q < 16; ++q) gtc += __popcll(__ballot(u[c * 16 + q] > T)); }
        thr_gt = T; need_eq = 256 - gtc; }
    int base = 0, eq_taken = 0;
#pragma unroll
    for (int c = 0; c < 8; ++c) if (c < nch) {
#pragma unroll
        for (int q = 0; q < 16; ++q) { const int rq = c * 16 + q; const unsigned v = u[rq];
            const bool iseq = (v == thr_gt) && (need_eq > 0);
            const unsigned long long meq = __ballot(iseq);
            const int eqr = __popcll(meq & ((1ull << lane) - 1ull));
            const bool take = (v > thr_gt) || (iseq && (eq_taken + eqr < need_eq));
            const unsigned long long mt = __ballot(take);
            const int pos = base + __popcll(mt & ((1ull << lane) - 1ull));
            if (take && pos < 256) sel[pos] = (rq >> 2) * 256 + lane * 4 + (rq & 3);
            base += __popcll(mt); eq_taken += __popcll(meq); } }
}
__device__ __forceinline__ void phase_topk(const Frame& F0) { const Frame F = fresh(F0);
    for (int q = F.bid * 8 + F.wid; q < 8192; q += F.G * 8) { const int b = q >> 12, p = q & 4095; topk_row(F, b, p); topk_row(F, b, SEQ - 1 - p); }
}

namespace att {
constexpr int D = 128, KVBLK = 64, QBLK = 32, SHM_V = 16384, SHM_K = 16384;
constexpr int OFF_K = 2 * SHM_V, OFF_BIAS = 2 * SHM_V + 2 * SHM_K, OFF_WS = OFF_BIAS + 512, OFF_FLAGS = OFF_WS + 2048, OFF_QITEM = OFF_FLAGS + 64;
constexpr float EXIT_T = 44.0f;
#define KSWZ(row, colB) ((row) * 256 + ((colB) ^ (((row) & 7) << 4)))
__device__ __forceinline__ int v_st(int k, int c) { const int kk = (k & ~0xC) | ((k & 4) << 1) | ((k & 8) >> 1); return ((kk >> 3) * 4 + (c >> 5)) * 512 + ((kk & 7) * 32 + (c & 31)) * 2; }
__device__ __forceinline__ int v_rd_base(int lane) { return ((lane & 3) << 3) | (((lane >> 2) & 3) << 6) | (((lane >> 4) & 1) << 5) | (((lane >> 5) & 1) << 8); }
constexpr int v_rd_off(int d0, int ks, int half) { return d0 * 512 + ks * 4096 + half * 2048; }
template <int KB>
__device__ __forceinline__ void qkt(f32x16& p0, f32x16& p1, const char* K_lds, int r32, int hi, const bf16x8* qr) {
    p0 = f32x16{}; p1 = f32x16{};
    const char* kb[4];
#pragma unroll
    for (int dd = 0; dd < 4; ++dd) kb[dd] = K_lds + KB * SHM_K + KSWZ(r32, (dd * 16 + hi * 8) * 2);
#pragma unroll
    for (int d0 = 0; d0 < 8; ++d0) { const char* a = kb[d0 & 3] + (d0 >> 2) * 128;
        bf16x8 b0 = *reinterpret_cast<const bf16x8*>(a);
        bf16x8 b1 = *reinterpret_cast<const bf16x8*>(a + 32 * 256);
        p0 = __builtin_amdgcn_mfma_f32_32x32x16_bf16(b0, qr[d0], p0, 0, 0, 0);
        p1 = __builtin_amdgcn_mfma_f32_32x32x16_bf16(b1, qr[d0], p1, 0, 0, 0); }
}
template <int VB>
__device__ __forceinline__ void pv_tile(f32x16* o, int vb0, bf16x8 pa0, bf16x8 pa1, bf16x8 pa2, bf16x8 pa3) {
#define TRRD(dst, off) asm volatile("ds_read_b64_tr_b16 %0, %1 offset:%2" : "=&v"(dst) : "v"(vb0), "i"(off) : "memory")
#define PV_D0(d0) do { s16x4 l0, l1, l2, l3, h0, h1, h2, h3; constexpr int b_ = VB * SHM_V + v_rd_off(d0, 0, 0); \
        TRRD(l0, b_); TRRD(h0, b_ + 2048); TRRD(l1, b_ + 4096); TRRD(h1, b_ + 6144); TRRD(l2, b_ + 8192); TRRD(h2, b_ + 10240); TRRD(l3, b_ + 12288); TRRD(h3, b_ + 14336); \
        asm volatile("s_waitcnt lgkmcnt(0)" ::: "memory"); SBAR(); \
        o[d0] = __builtin_amdgcn_mfma_f32_32x32x16_bf16(pa0, (bf16x8){l0[0], l0[1], l0[2], l0[3], h0[0], h0[1], h0[2], h0[3]}, o[d0], 0, 0, 0); \
        o[d0] = __builtin_amdgcn_mfma_f32_32x32x16_bf16(pa1, (bf16x8){l1[0], l1[1], l1[2], l1[3], h1[0], h1[1], h1[2], h1[3]}, o[d0], 0, 0, 0); \
        o[d0] = __builtin_amdgcn_mfma_f32_32x32x16_bf16(pa2, (bf16x8){l2[0], l2[1], l2[2], l2[3], h2[0], h2[1], h2[2], h2[3]}, o[d0], 0, 0, 0); \
        o[d0] = __builtin_amdgcn_mfma_f32_32x32x16_bf16(pa3, (bf16x8){l3[0], l3[1], l3[2], l3[3], h3[0], h3[1], h3[2], h3[3]}, o[d0], 0, 0, 0); } while (0)
    PV_D0(0); PV_D0(1); PV_D0(2); PV_D0(3);
#undef PV_D0
#undef TRRD
}
#define PK4(P, B_, OUT) do { unsigned a0 = cvtpk(P[B_+0], P[B_+1]), a1 = cvtpk(P[B_+2], P[B_+3]); \
        unsigned b0 = cvtpk(P[B_+4], P[B_+5]), b1 = cvtpk(P[B_+6], P[B_+7]); \
        auto r0 = __builtin_amdgcn_permlane32_swap(a0, b0, false, false); auto r1 = __builtin_amdgcn_permlane32_swap(a1, b1, false, false); \
        u32x4 w = {r0[0], r1[0], r0[1], r1[1]}; OUT = *reinterpret_cast<bf16x8*>(&w); } while (0)
__device__ __forceinline__ float swap_max(float x) { auto rr = __builtin_amdgcn_permlane32_swap(__float_as_uint(x), __float_as_uint(x), false, false); return fmaxf(__uint_as_float(rr[0]), __uint_as_float(rr[1])); }
__device__ __forceinline__ float swap_sum(float x) { auto rr = __builtin_amdgcn_permlane32_swap(__float_as_uint(x), __float_as_uint(x), false, false); return __uint_as_float(rr[0]) + __uint_as_float(rr[1]); }
__device__ __forceinline__ float swap_lo(float x) { auto rr = __builtin_amdgcn_permlane32_swap(__float_as_uint(x), __float_as_uint(x), false, false); return __uint_as_float(rr[0]); }


__device__ __forceinline__ void fox_sm(f32x16& p0, f32x16& p1, const float* bl, int kb_, int qlo, int qrow, int hi, int r32, float& m_reg, float& l_reg, f32x16* o, float* al_l,
                                       bf16x8& pa0, bf16x8& pa1, bf16x8& pa2, bf16x8& pa3) {
#pragma unroll
    for (int g = 0; g < 4; ++g) { const f32x4 b0v = *(const f32x4*)(bl + 8 * g + 4 * hi), b1v = *(const f32x4*)(bl + 32 + 8 * g + 4 * hi);
#pragma unroll
        for (int i = 0; i < 4; ++i) { p0[4 * g + i] = fmaf(p0[4 * g + i], C2, b0v[i]); p1[4 * g + i] = fmaf(p1[4 * g + i], C2, b1v[i]); } }
    if (kb_ + KVBLK - 1 > qlo) { const float NEG = -__builtin_inff();
#pragma unroll
        for (int r = 0; r < 16; ++r) { const int key = kb_ + crow(r, hi); if (key > qrow) p0[r] = NEG; if (key + 32 > qrow) p1[r] = NEG; } }
    float pmax = p0[0];
#pragma unroll
    for (int r = 1; r < 16; ++r) pmax = fmaxf(pmax, p0[r]);
#pragma unroll
    for (int r = 0; r < 16; ++r) pmax = fmaxf(pmax, p1[r]);
    pmax = swap_max(pmax);
    const float mn = fmaxf(m_reg, pmax), alpha = __builtin_amdgcn_exp2f(m_reg - mn); m_reg = mn;
    float ps = 0.f;
#pragma unroll
    for (int r = 0; r < 16; ++r) { p0[r] = __builtin_amdgcn_exp2f(p0[r] - mn); p1[r] = __builtin_amdgcn_exp2f(p1[r] - mn); ps += p0[r] + p1[r]; }
    ps = swap_sum(ps); l_reg = l_reg * alpha + ps;
    if (__any(alpha < 1.f)) { if (hi == 0) al_l[r32] = alpha; asm volatile("s_waitcnt lgkmcnt(0)" ::: "memory");
#pragma unroll
        for (int r = 0; r < 16; ++r) { const float a = al_l[crow(r, hi)];
#pragma unroll
            for (int d_ = 0; d_ < 4; ++d_) o[d_][r] *= a; } }
    PK4(p0, 0, pa0); PK4(p0, 8, pa1); PK4(p1, 0, pa2); PK4(p1, 8, pa3);
}
__device__ __forceinline__ void sb_half(f32x16& pz, int keybase, int qrow, int hi, float& R, const bf16x8* triA, bool needmask) {
    f32x16 X;
#pragma unroll
    for (int r = 0; r < 16; ++r) { const float zz = pz[r] * C2; const bool valid = !needmask || (keybase + crow(r, hi) < qrow);
        const float l2 = fmaxf(zz, 0.f) + __builtin_amdgcn_logf(1.0f + __builtin_amdgcn_exp2f(-fabsf(zz)));
        X[r] = valid ? -l2 : 0.f; pz[r] = valid ? zz : -__builtin_inff(); }
    f32x16 Y;
#pragma unroll
    for (int r = 0; r < 16; ++r) Y[r] = R;
#pragma unroll
    for (int s = 0; s < 2; ++s) {
        const unsigned h0 = cvtpk(X[8 * s + 0], X[8 * s + 1]), h1 = cvtpk(X[8 * s + 2], X[8 * s + 3]), h2 = cvtpk(X[8 * s + 4], X[8 * s + 5]), h3 = cvtpk(X[8 * s + 6], X[8 * s + 7]);
        const unsigned l0 = cvtpk(X[8 * s + 0] - bflo(h0), X[8 * s + 1] - bfhi(h0)), l1 = cvtpk(X[8 * s + 2] - bflo(h1), X[8 * s + 3] - bfhi(h1));
        const unsigned l2 = cvtpk(X[8 * s + 4] - bflo(h2), X[8 * s + 5] - bfhi(h2)), l3 = cvtpk(X[8 * s + 6] - bflo(h3), X[8 * s + 7] - bfhi(h3));
        u32x4 wh = {h0, h1, h2, h3}, wl = {l0, l1, l2, l3};
        Y = __builtin_amdgcn_mfma_f32_32x32x16_bf16(triA[s], *reinterpret_cast<bf16x8*>(&wh), Y, 0, 0, 0);
        Y = __builtin_amdgcn_mfma_f32_32x32x16_bf16(triA[s], *reinterpret_cast<bf16x8*>(&wl), Y, 0, 0, 0); }
#pragma unroll
    for (int r = 0; r < 16; ++r) pz[r] = __builtin_amdgcn_exp2f(pz[r] + Y[r]);
    R = swap_lo(Y[0]);
}
__device__ __forceinline__ void sb_sm(f32x16& p0, f32x16& p1, int kb_, int qlo, int qrow, int hi, float& R, const bf16x8* triA, bf16x8& pa0, bf16x8& pa1, bf16x8& pa2, bf16x8& pa3) {
    const bool needmask = (kb_ + KVBLK - 1 >= qlo);
    sb_half(p1, kb_ + 32, qrow, hi, R, triA, needmask);
    sb_half(p0, kb_, qrow, hi, R, triA, needmask);
    PK4(p0, 0, pa0); PK4(p0, 8, pa1); PK4(p1, 0, pa2); PK4(p1, 8, pa3);
}

template <int MODE>
__device__ __forceinline__ void attn_unit(const bf16_t* Q, const bf16_t* Kh, const bf16_t* Vh, const float* cum, bf16_t* O, int P0, char* lds, float kmaxc) {
    int tid = threadIdx.x; asm volatile("" : "+v"(tid));
    const int wid = __builtin_amdgcn_readfirstlane(tid >> 6), lane = tid & 63, r32 = lane & 31, hi = lane >> 5;
    const int NT = P0 / KVBLK + 4;
    char* V_lds = lds; char* K_lds = lds + OFF_K; float* bias_l = (float*)(lds + OFF_BIAS);
    float* wsl = (float*)(lds + OFF_WS) + wid * 64; float* li_l = wsl; float* al_l = wsl + 32;
    const int qlo = P0 + wid * QBLK, qrow = qlo + r32;
    bf16x8 qr[8];
#pragma unroll
    for (int d0 = 0; d0 < 8; ++d0) qr[d0] = *(const bf16x8*)(Q + (size_t)qrow * D + d0 * 16 + hi * 8);
    const int sr = tid >> 4, sc = (tid & 15) * 8, vst0 = v_st(sr, sc), vst1 = v_st(32 + sr, sc), kws = KSWZ(sr, sc * 2);
    const int vb0 = (int)(uintptr_t)V_lds + v_rd_base(lane);
    const float cumref = (MODE == 0) ? cum[P0] : 0.f;
    int* flg = (int*)(lds + OFF_FLAGS);
    float qn = 0.f;
    if (MODE == 0) { float ss = 0.f;
#pragma unroll
        for (int d0 = 0; d0 < 8; ++d0)
#pragma unroll
            for (int j = 0; j < 8; ++j) { const float x = bf2f((bf16_t)qr[d0][j]); ss = fmaf(x, x, ss); }
        ss = swap_sum(ss); qn = sqrtf(ss) * kmaxc * 1.001f; }
    float m_reg = -1e30f, l_reg = 0.f, R = 0.f; f32x16 o[4] = {};
    bf16x8 triA[2];
    if (MODE == 1) {
#pragma unroll
        for (int s = 0; s < 2; ++s)
#pragma unroll
            for (int j = 0; j < 8; ++j) { const int rho = 16 * s + 8 * (j >> 2) + 4 * hi + (j & 3); triA[s][j] = (rho >= r32) ? (short)0x3F80 : (short)0; }
    }
    bf16x8 st_k0, st_k1, st_v0, st_v1; float st_b = 0.f;
#define TILE_KB(t) ((NT - 1 - (t)) * KVBLK)
#define SLOAD(kb_) do { st_v0 = *(const bf16x8*)(Vh + (size_t)((kb_) + sr) * D + sc); st_v1 = *(const bf16x8*)(Vh + (size_t)((kb_) + 32 + sr) * D + sc); \
                        st_k0 = *(const bf16x8*)(Kh + (size_t)((kb_) + sr) * D + sc); st_k1 = *(const bf16x8*)(Kh + (size_t)((kb_) + 32 + sr) * D + sc); \
                        if (MODE == 0 && tid < 64) st_b = (cumref - cum[(kb_) + tid]) * LOG2E; } while (0)
#define SWRITE(bf) do { *(bf16x8*)(V_lds + (bf) * SHM_V + vst0) = st_v0; *(bf16x8*)(V_lds + (bf) * SHM_V + vst1) = st_v1; \
                        *(bf16x8*)(K_lds + (bf) * SHM_K + kws) = st_k0; *(bf16x8*)(K_lds + (bf) * SHM_K + kws + 32 * 256) = st_k1; \
                        if (MODE == 0 && tid < 64) bias_l[(bf) * 64 + tid] = st_b; } while (0)
    __syncthreads();
    SLOAD(TILE_KB(0)); SWRITE(0);
    __syncthreads();
    f32x16 p0, p1; bf16x8 pa0, pa1, pa2, pa3;
#define STEP(BUF, t) do { const int kb_ = TILE_KB(t); \
        if ((t) + 1 < NT) SLOAD(TILE_KB((t) + 1)); \
        SBAR(); qkt<BUF>(p0, p1, K_lds, r32, hi, qr); \
        if (MODE == 0) fox_sm(p0, p1, bias_l + (BUF) * 64, kb_, qlo, qrow, hi, r32, m_reg, l_reg, o, al_l, pa0, pa1, pa2, pa3); \
        else sb_sm(p0, p1, kb_, qlo, qrow, hi, R, triA, pa0, pa1, pa2, pa3); \
        SBAR(); pv_tile<BUF>(o, vb0, pa0, pa1, pa2, pa3); \
        if ((t) + 1 < NT) SWRITE((BUF) ^ 1); \
        __syncthreads(); } while (0)
    for (int t = 0; t < NT; t += 2) {
        STEP(0, t); STEP(1, t + 1);
        const int kbc = TILE_KB(t + 1); if (kbc == 0) break;
        bool done;
        if (MODE == 0) { const float edge = (cumref - cum[kbc - 1]) * LOG2E; done = (qn + edge - m_reg) < -EXIT_T; }
        else done = R < -EXIT_T;
        const int par = (t >> 1) & 1;
        if (lane == 0) flg[par * 8 + wid] = 0;
        const bool wdone = __all(done);
        if (lane == 0 && wdone) flg[par * 8 + wid] = 1;
        __syncthreads();
        int alld = 1;
#pragma unroll
        for (int w = 0; w < 8; ++w) alld &= flg[par * 8 + w];
        if (alld) break;
    }
    __syncthreads();
#undef STEP
#undef SLOAD
#undef SWRITE
#undef TILE_KB
    float rli[16];
    if (MODE == 0) { if (hi == 0) li_l[r32] = l_reg; asm volatile("s_waitcnt lgkmcnt(0)" ::: "memory");
#pragma unroll
        for (int r = 0; r < 16; ++r) rli[r] = __builtin_amdgcn_rcpf(li_l[crow(r, hi)]); }
    bf16_t* Ow = O + (size_t)(wid * QBLK) * 3072;
#pragma unroll
    for (int r = 0; r < 16; ++r) { const int orow = crow(r, hi);
#pragma unroll
        for (int d0 = 0; d0 < 4; ++d0) { const float v = (MODE == 0) ? o[d0][r] * rli[r] : o[d0][r];
            const float vn = __shfl_xor(v, 1);
            if ((r32 & 1) == 0) *(unsigned*)(Ow + (size_t)orow * 3072 + d0 * 32 + r32) = cvtpk(v, vn); } }
}
}

__device__ __forceinline__ void sparse_query(const Frame& F, int tok, char* ldsw) {
    unsigned char* ws = F.ws; const int lane = F.lane, g = lane >> 4, i16 = lane & 15;
    const bf16_t* qcat = (const bf16_t*)(ws + R_QCAT) + (size_t)tok * 2304; const bf16_t* kbase = (const bf16_t*)(ws + R_KCAT) + (size_t)(tok >> 13) * SEQ * 288;
    const int* sel = (const int*)(ws + R_SEL) + (size_t)tok * 256; const int ns = ((const int*)(ws + R_NSEL))[tok]; const int ntile = (ns + 31) >> 5;
    bf16x8 qf[9];
#pragma unroll
    for (int st = 0; st < 9; ++st) { qf[st] = (bf16x8){0, 0, 0, 0, 0, 0, 0, 0}; if (i16 < 8) qf[st] = *(const bf16x8*)(qcat + i16 * 288 + st * 32 + 8 * g); }
    const int rA = lane >> 2, cq = lane & 3;
    float m = -1e30f, l = 0.f; f32x4 oT[16];
#pragma unroll
    for (int rb = 0; rb < 16; ++rb) oT[rb] = (f32x4){0.f, 0.f, 0.f, 0.f};
    const unsigned ldso = (unsigned)(uintptr_t)ldsw;
    const unsigned vb = ldso + (unsigned)((4 * g + (i16 >> 2)) * 592 + (i16 & 3) * 8);
    constexpr float SC2 = SCALE * LOG2E;
    bf16x8 stg[18];
#define GATHER(tile_) do { const int j0 = (tile_) * 32 + rA, j1 = j0 + 16; const int s0 = j0 < ns ? sel[j0] : 0, s1 = j1 < ns ? sel[j1] : 0; \
        const bf16_t* p0_ = kbase + (size_t)s0 * 288 + cq * 8; const bf16_t* p1_ = kbase + (size_t)s1 * 288 + cq * 8; \
        _Pragma("unroll") for (int c = 0; c < 9; ++c) { stg[2 * c] = *(const bf16x8*)(p0_ + c * 32); stg[2 * c + 1] = *(const bf16x8*)(p1_ + c * 32); } } while (0)
    GATHER(0);
    for (int tile = 0; tile < ntile; ++tile) {
#pragma unroll
        for (int c = 0; c < 9; ++c) { *(bf16x8*)(ldsw + rA * 592 + c * 64 + cq * 16) = stg[2 * c]; *(bf16x8*)(ldsw + (16 + rA) * 592 + c * 64 + cq * 16) = stg[2 * c + 1]; }
        if (tile + 1 < ntile) GATHER(tile + 1);
        asm volatile("s_waitcnt lgkmcnt(0)" ::: "memory"); SBAR();
        f32x4 acc[2];
#pragma unroll
        for (int mt = 0; mt < 2; ++mt) { acc[mt] = (f32x4){0.f, 0.f, 0.f, 0.f};
#pragma unroll
            for (int st = 0; st < 9; ++st) { const bf16x8 a = *(const bf16x8*)(ldsw + (16 * mt + i16) * 592 + st * 64 + g * 16);
                acc[mt] = __builtin_amdgcn_mfma_f32_16x16x32_bf16(a, qf[st], acc[mt], 0, 0, 0); } }
        float tmax = -__builtin_inff();
#pragma unroll
        for (int mt = 0; mt < 2; ++mt)
#pragma unroll
            for (int r = 0; r < 4; ++r) { const int key = tile * 32 + 16 * mt + 4 * g + r; float x = acc[mt][r] * SC2; if (key >= ns) x = -__builtin_inff(); acc[mt][r] = x; tmax = fmaxf(tmax, x); }
        tmax = fmaxf(tmax, __shfl_xor(tmax, 16)); tmax = fmaxf(tmax, __shfl_xor(tmax, 32));
        const float mn = fmaxf(m, tmax), alpha = __builtin_amdgcn_exp2f(m - mn); m = mn;
        float ps = 0.f;
#pragma unroll
        for (int mt = 0; mt < 2; ++mt)
#pragma unroll
            for (int r = 0; r < 4; ++r) { acc[mt][r] = __builtin_amdgcn_exp2f(acc[mt][r] - mn); ps += acc[mt][r]; }
        ps += __shfl_xor(ps, 16); ps += __shfl_xor(ps, 32);
        l = l * alpha + ps;
#pragma unroll
        for (int rb = 0; rb < 16; ++rb) oT[rb] *= alpha;
        const bf16x8 pf = pack8(acc[0], acc[1]);
#define TRRD2(dst, off) asm volatile("ds_read_b64_tr_b16 %0, %1 offset:%2" : "=&v"(dst) : "v"(vb), "i"(off) : "memory")
#define PVRB4(rb) do { s16x4 ta0, tb0, ta1, tb1, ta2, tb2, ta3, tb3; \
        TRRD2(ta0, ((rb) + 0) * 32); TRRD2(tb0, ((rb) + 0) * 32 + 16 * 592); TRRD2(ta1, ((rb) + 1) * 32); TRRD2(tb1, ((rb) + 1) * 32 + 16 * 592); \
        TRRD2(ta2, ((rb) + 2) * 32); TRRD2(tb2, ((rb) + 2) * 32 + 16 * 592); TRRD2(ta3, ((rb) + 3) * 32); TRRD2(tb3, ((rb) + 3) * 32 + 16 * 592); \
        asm volatile("s_waitcnt lgkmcnt(0)" ::: "memory"); SBAR(); \
        oT[(rb) + 0] = __builtin_amdgcn_mfma_f32_16x16x32_bf16((bf16x8){ta0[0], ta0[1], ta0[2], ta0[3], tb0[0], tb0[1], tb0[2], tb0[3]}, pf, oT[(rb) + 0], 0, 0, 0); \
        oT[(rb) + 1] = __builtin_amdgcn_mfma_f32_16x16x32_bf16((bf16x8){ta1[0], ta1[1], ta1[2], ta1[3], tb1[0], tb1[1], tb1[2], tb1[3]}, pf, oT[(rb) + 1], 0, 0, 0); \
        oT[(rb) + 2] = __builtin_amdgcn_mfma_f32_16x16x32_bf16((bf16x8){ta2[0], ta2[1], ta2[2], ta2[3], tb2[0], tb2[1], tb2[2], tb2[3]}, pf, oT[(rb) + 2], 0, 0, 0); \
        oT[(rb) + 3] = __builtin_amdgcn_mfma_f32_16x16x32_bf16((bf16x8){ta3[0], ta3[1], ta3[2], ta3[3], tb3[0], tb3[1], tb3[2], tb3[3]}, pf, oT[(rb) + 3], 0, 0, 0); } while (0)
        PVRB4(0); PVRB4(4); PVRB4(8); PVRB4(12);
#undef PVRB4
#undef TRRD2
        SBAR();
    }
#undef GATHER
    const float rl = 1.0f / l;
    if (i16 < 8) { bf16_t* op = (bf16_t*)(ws + R_OLAT) + (size_t)tok * 2048 + i16 * 256 + 4 * g;
#pragma unroll
        for (int rb = 0; rb < 16; ++rb) { u32x2 w; w.x = cvtpk(oT[rb][0] * rl, oT[rb][1] * rl); w.y = cvtpk(oT[rb][2] * rl, oT[rb][3] * rl); *(u32x2*)(op + rb * 16) = w; } }
}
#ifdef ATT_SUB
#define ASUB(k) ((k) == ATT_SUB)
#else
#define ASUB(k) true
#endif
__device__ __forceinline__ void phase_attn(const Frame& F0, int l, int rep) { const Frame F = fresh(F0);
    unsigned char* ws = F.ws; char* lds = (char*)F.lds;
    const bf16_t* qkv = (const bf16_t*)(ws + R_QKV); const size_t TS = (size_t)NTOK * 1024;
    unsigned* qctr = (unsigned*)(ws + WS_CTL) + CW_QCTR + l * 64 + rep * 16; const unsigned* kmx = (const unsigned*)(ws + WS_CTL) + CW_KMAX + l * 16;
    int* qitem = (int*)(lds + att::OFF_QITEM);
    int* hord = qitem + 4;
    if (F.tid < 16) { const float* cumb = (const float*)(ws + WS_CUM); const float mine = -cumb[(size_t)F.tid * SEQ + SEQ - 1]; int rank = 0;
        for (int o = 0; o < 16; ++o) { const float v = -cumb[(size_t)o * SEQ + SEQ - 1]; rank += (v < mine || (v == mine && o < F.tid)) ? 1 : 0; }
        hord[rank] = F.tid; }
#pragma unroll 1
    for (;;) {
        __syncthreads();
        if (F.tid == 0) qitem[0] = (int)atomicAdd(qctr, 1u);
        __syncthreads();
        const int it = qitem[0];
        if (it >= 1024) break;
        const int md = it >> 9, j = it & 511;
        const int qb = md == 0 ? 31 - (j & 31) : 31 - (j >> 4), bh = md == 0 ? hord[j >> 5] : (j & 15), b = bh >> 3, h = bh & 7, P0 = qb * 256;
        if (!ASUB(md)) continue;
        const bf16_t* Q = qkv + (size_t)(md * 3 + 0) * TS + (size_t)bh * SEQ * 128; const bf16_t* K = qkv + (size_t)(md * 3 + 1) * TS + (size_t)bh * SEQ * 128; const bf16_t* V = qkv + (size_t)(md * 3 + 2) * TS + (size_t)bh * SEQ * 128;
        const float* cum = (const float*)(ws + WS_CUM) + (size_t)bh * SEQ;
        bf16_t* Ob = (bf16_t*)(ws + R_OA) + (size_t)b * SEQ * 3072 + (md + 1) * 1024 + h * 128;
        if (md == 0) { const float kmaxc = sqrtf(__uint_as_float(kmx[bh])) * C2; att::attn_unit<0>(Q, K, V, cum, Ob + (size_t)P0 * 3072, P0, lds, kmaxc); }
        else att::attn_unit<1>(Q, K, V, cum, Ob + (size_t)P0 * 3072, P0, lds, 0.f);
    }
    __syncthreads();
    char* ldsw = lds + F.wid * 18944;
#pragma unroll 1
    for (int rep = 0; rep < NREP(2); ++rep)
#pragma unroll 1
    for (int tok = F.bid * 8 + F.wid; tok < NTOK; tok += F.G * 8) if (ASUB(2)) sparse_query(F, tok, ldsw);
}

__device__ __forceinline__ void ln_row(const bf16_t* src, const float* g, const float* bta, float* of, bf16_t* ob, int lane, unsigned char* oq = nullptr, float* osc = nullptr, float* ost = nullptr) {
    f32x4 v[8]; float s = 0.f;
#pragma unroll
    for (int i = 0; i < 4; ++i) { const u32x4 w = *(const u32x4*)(src + (i * 64 + lane) * 8);
        v[2 * i] = (f32x4){bflo(w.x), bfhi(w.x), bflo(w.y), bfhi(w.y)}; v[2 * i + 1] = (f32x4){bflo(w.z), bfhi(w.z), bflo(w.w), bfhi(w.w)};
        s += (v[2 * i][0] + v[2 * i][1]) + (v[2 * i][2] + v[2 * i][3]) + (v[2 * i + 1][0] + v[2 * i + 1][1]) + (v[2 * i + 1][2] + v[2 * i + 1][3]); }
    s = wave_sum(s); const float mu = s * (1.0f / 2048.0f); float q = 0.f;
#pragma unroll
    for (int i = 0; i < 8; ++i) { const f32x4 d = v[i] - mu; q += (d[0] * d[0] + d[1] * d[1]) + (d[2] * d[2] + d[3] * d[3]); }
    q = wave_sum(q); const float rstd = rsqrtf(q * (1.0f / 2048.0f) + 1e-5f);
    if (ost && lane == 0) { ost[0] = mu; ost[1] = rstd; }
    float amax = 0.f;
#pragma unroll
    for (int i = 0; i < 4; ++i) { const int c = (i * 64 + lane) * 8; const f32x4 g0 = *(const f32x4*)(g + c), g1 = *(const f32x4*)(g + c + 4), b0 = *(const f32x4*)(bta + c), b1 = *(const f32x4*)(bta + c + 4);
        const f32x4 y0 = (v[2 * i] - mu) * rstd * g0 + b0, y1 = (v[2 * i + 1] - mu) * rstd * g1 + b1; v[2 * i] = y0; v[2 * i + 1] = y1;
        if (of) { *(f32x4*)(of + c) = y0; *(f32x4*)(of + c + 4) = y1; }
        if (ob) pg8::st_bf16x8(ob + c, y0, y1);
        if (oq) { amax = fmaxf(amax, fmaxf(fmaxf(fmaxf(fabsf(y0[0]), fabsf(y0[1])), fmaxf(fabsf(y0[2]), fabsf(y0[3]))), fmaxf(fmaxf(fabsf(y1[0]), fabsf(y1[1])), fmaxf(fabsf(y1[2]), fabsf(y1[3]))))); } }
    if (oq) {
        for (int o = 32; o > 0; o >>= 1) amax = fmaxf(amax, __shfl_xor(amax, o));
        amax = fmaxf(amax, 1e-20f); const float qi = 127.0f / amax; if (lane == 0) *osc = amax * (1.0f / 127.0f);
#pragma unroll
        for (int i = 0; i < 4; ++i) { u32x2 w;
#pragma unroll
            for (int h = 0; h < 2; ++h) { const f32x4 y = v[2 * i + h]; unsigned pk = 0u;
#pragma unroll
                for (int j = 0; j < 4; ++j) pk |= ((unsigned)(int)rintf(y[j] * qi) & 0xffu) << (8 * j);
                w[h] = pk; }
            *(u32x2*)(oq + (i * 64 + lane) * 8) = w; } }
}
__device__ __forceinline__ void phase_ln1_router(const Frame& F0, const Params& P, int l) { const Frame F = fresh(F0);
    unsigned char* ws = F.ws; const int lane = F.lane, wid = F.wid;
    const bf16_t* pre1 = (const bf16_t*)(ws + R_PRE1); float* x1f = (float*)(ws + M_X1F); bf16_t* x1b = (bf16_t*)(ws + M_X1B); unsigned char* x1q = (unsigned char*)(ws + M_X1Q); float* x1s = (float*)(ws + M_X1S);
    const float* g = F.in(11) + l * DM; const float* bt = F.in(12) + l * DM; const float* wr = F.in(13) + (size_t)l * DM * NEXP; const float* br = F.in(14) + l * NEXP;
    unsigned* cnt = (unsigned*)(ws + WS_CTL) + CW_CNT + l * 2048;
    int* tok_e = (int*)(ws + M_TOKE); int* tok_pos = (int*)(ws + M_TOKPOS); float* tok_w = (float*)(ws + M_TOKW);
    float* red = (float*)F.lds;
    float* lg = (float*)(F.lds + 32768); float* stats = (float*)(F.lds + 32768 + 16384);
#pragma unroll 1
    for (int blk = F.bid; blk < NTOK / 64; blk += F.G) {
        const int tok0 = blk * 64;
#pragma unroll 1
        for (int i = 0; i < 8; ++i) { const int tok = tok0 + wid * 8 + i; ln_row(pre1 + (size_t)tok * DM, g, bt, (float*)nullptr, x1b + (size_t)tok * DM, lane, x1q + (size_t)tok * DM, x1s + tok, stats + 2 * (wid * 8 + i)); }
        asm volatile("s_waitcnt vmcnt(0)" ::: "memory"); __syncthreads();
        { const int grp = wid >> 2, kq = wid & 3, i32 = lane & 31, hk = lane >> 5; f32x16 acc = {};
          const bf16_t* arow = pre1 + (size_t)(tok0 + grp * 32 + i32) * DM + kq * 512 + 4 * hk; const float* bcol = wr + (size_t)(kq * 512 + 4 * hk) * NEXP + i32;
          const float* gp = g + kq * 512 + 4 * hk; const float* bp = bt + kq * 512 + 4 * hk; const float mu = stats[2 * (grp * 32 + i32)], rstd = stats[2 * (grp * 32 + i32) + 1];
#pragma unroll 4
          for (int c8 = 0; c8 < 64; ++c8) { const u32x2 xw = *(const u32x2*)(arow + c8 * 8); const f32x4 g4 = *(const f32x4*)(gp + c8 * 8), b4 = *(const f32x4*)(bp + c8 * 8);
              const f32x4 a4 = ((f32x4){bflo(xw.x), bfhi(xw.x), bflo(xw.y), bfhi(xw.y)} - mu) * rstd * g4 + b4;
              const float b0 = bcol[(size_t)(c8 * 8 + 0) * NEXP], b1 = bcol[(size_t)(c8 * 8 + 1) * NEXP], b2 = bcol[(size_t)(c8 * 8 + 2) * NEXP], b3 = bcol[(size_t)(c8 * 8 + 3) * NEXP];
              acc = __builtin_amdgcn_mfma_f32_32x32x2f32(a4[0], b0, acc, 0, 0, 0); acc = __builtin_amdgcn_mfma_f32_32x32x2f32(a4[1], b1, acc, 0, 0, 0);
              acc = __builtin_amdgcn_mfma_f32_32x32x2f32(a4[2], b2, acc, 0, 0, 0); acc = __builtin_amdgcn_mfma_f32_32x32x2f32(a4[3], b3, acc, 0, 0, 0); }
#pragma unroll
          for (int r = 0; r < 16; ++r) red[(wid * 16 + r) * 64 + lane] = acc[r]; }
        __syncthreads();
        if ((wid & 3) == 0) { const int grp = wid >> 2, hk = lane >> 5, e = lane & 31; const float be = br[e];
#pragma unroll
            for (int r = 0; r < 16; ++r) { const float v = red[((wid + 0) * 16 + r) * 64 + lane] + red[((wid + 1) * 16 + r) * 64 + lane] + red[((wid + 2) * 16 + r) * 64 + lane] + red[((wid + 3) * 16 + r) * 64 + lane] + be;
                lg[(grp * 32 + crow(r, hk)) * 33 + e] = v; }
            asm volatile("s_waitcnt lgkmcnt(0)" ::: "memory"); SBAR();
            const int tk = lane & 31; float v[32];
#pragma unroll
            for (int e2 = 0; e2 < 32; ++e2) v[e2] = lg[(grp * 32 + tk) * 33 + e2];
            int ek[4]; float vk[4];
#pragma unroll
            for (int k = 0; k < 4; ++k) { float best = -__builtin_inff(); int bi = 0;
#pragma unroll
                for (int e2 = 0; e2 < 32; ++e2) if (v[e2] > best) { best = v[e2]; bi = e2; }
                ek[k] = bi; vk[k] = best;
#pragma unroll
                for (int e2 = 0; e2 < 32; ++e2) v[e2] = (e2 == bi) ? -__builtin_inff() : v[e2]; }
            float wk[4], sw = 0.f;
#pragma unroll
            for (int k = 0; k < 4; ++k) { wk[k] = __expf(vk[k] - vk[0]); sw += wk[k]; }
            const float rs = 1.0f / sw;
            const bool act = lane < 32; unsigned myc = 0u;
#pragma unroll 1
            for (int E = 0; E < 32; ++E) { unsigned c = 0u;
#pragma unroll
                for (int k = 0; k < 4; ++k) c += (unsigned)__popcll(__ballot(act && ek[k] == E));
                if (lane == E) myc = c; }
            unsigned run = 0u; if (lane < 32 && myc > 0u) run = atomicAdd(&cnt[lane * 64], myc);
            int pk[4];
#pragma unroll
            for (int k = 0; k < 4; ++k) { pk[k] = 0;
#pragma unroll 1
                for (int E = 0; E < 32; ++E) { const unsigned long long mm = __ballot(act && ek[k] == E); const unsigned basev = (unsigned)__shfl((int)run, E);
                    if (act && ek[k] == E) pk[k] = (int)(basev + (unsigned)__popcll(mm & ((1ull << lane) - 1ull)));
                    if (lane == E) run += (unsigned)__popcll(mm); } }
            if (act) { const int tok = tok0 + grp * 32 + tk;
#pragma unroll
                for (int k = 0; k < 4; ++k) { tok_e[tok * 4 + k] = ek[k]; tok_pos[tok * 4 + k] = pk[k]; tok_w[tok * 4 + k] = wk[k] * rs; } }
        }
        __syncthreads();
    }
}
__device__ __forceinline__ void phase_moe_gather(const Frame& F0, int l) { const Frame F = fresh(F0);
    unsigned char* ws = F.ws; const int lane = F.lane;
    const unsigned* cnt = (const unsigned*)(ws + WS_CTL) + CW_CNT + l * 2048; unsigned* meta = (unsigned*)(ws + WS_CTL) + CW_META + l * 512;
    unsigned* offs = (unsigned*)(F.lds + LDS_MISC + 64);
    if (F.tid == 0) { unsigned o = 0u; for (int e = 0; e < 32; ++e) { offs[e] = o; o += (cnt[e * 64] + 255u) & ~255u; } offs[32] = o;
        if (F.bid == 0) { meta[0] = o >> 8; for (int e = 0; e < 32; ++e) for (unsigned t = offs[e] >> 8; t < (offs[e + 1] >> 8); ++t) meta[1 + t] = (unsigned)e; } }
    __syncthreads();
    const int* tok_e = (const int*)(ws + M_TOKE); const int* tok_pos = (const int*)(ws + M_TOKPOS); const float* tok_w = (const float*)(ws + M_TOKW);
    int* tok_dst = (int*)(ws + M_TOKDST); float* roww = (float*)(ws + M_ROWW);
    const unsigned char* x1q = (const unsigned char*)(ws + M_X1Q); const float* x1s = (const float*)(ws + M_X1S); unsigned char* xs = (unsigned char*)(ws + M_XS); float* rowsx = (float*)(ws + M_ROWSX);
    for (int it = F.bid * 8 + F.wid; it < NTOK * 4; it += F.G * 8) { const int tok = it >> 2;
        const int e = tok_e[it]; const unsigned dst = offs[e] + (unsigned)tok_pos[it];
        if (lane == 0) { tok_dst[it] = (int)dst; roww[dst] = tok_w[it]; rowsx[dst] = x1s[tok]; }
        const u32x4* sp = (const u32x4*)(x1q + (size_t)tok * DM); u32x4* dp = (u32x4*)(xs + (size_t)dst * DM);
#pragma unroll
        for (int i = 0; i < 2; ++i) dp[i * 64 + lane] = sp[i * 64 + lane]; }
    __syncthreads();
}
__device__ __forceinline__ void phase_combine(const Frame& F0) { const Frame F = fresh(F0);
    unsigned char* ws = F.ws; const int lane = F.lane;
    const bf16_t* x1b = (const bf16_t*)(ws + M_X1B); const bf16_t* ys = (const bf16_t*)(ws + M_XS); const int* tok_dst = (const int*)(ws + M_TOKDST);
    bf16_t* hb = (bf16_t*)(ws + M_HB); unsigned char* hq = (unsigned char*)(ws + M_HQ); float* hsc = (float*)(ws + M_HSC);
    for (int tok = F.bid * 8 + F.wid; tok < NTOK; tok += F.G * 8) {
        const int d0 = tok_dst[tok * 4], d1 = tok_dst[tok * 4 + 1], d2 = tok_dst[tok * 4 + 2], d3 = tok_dst[tok * 4 + 3];
        f32x4 hv[8]; float amax = 0.f;
#pragma unroll
        for (int i = 0; i < 4; ++i) { const int c = (i * 64 + lane) * 8; const size_t o = (size_t)tok * DM + c;
            const u32x4 xw = *(const u32x4*)(x1b + o);
            f32x4 a = (f32x4){bflo(xw.x), bfhi(xw.x), bflo(xw.y), bfhi(xw.y)} * ALPHA, b = (f32x4){bflo(xw.z), bfhi(xw.z), bflo(xw.w), bfhi(xw.w)} * ALPHA;
            const u32x4 y0 = *(const u32x4*)(ys + (size_t)d0 * DM + c), y1 = *(const u32x4*)(ys + (size_t)d1 * DM + c), y2 = *(const u32x4*)(ys + (size_t)d2 * DM + c), y3 = *(const u32x4*)(ys + (size_t)d3 * DM + c);
            a[0] += (bflo(y0.x) + bflo(y1.x)) + (bflo(y2.x) + bflo(y3.x)); a[1] += (bfhi(y0.x) + bfhi(y1.x)) + (bfhi(y2.x) + bfhi(y3.x));
            a[2] += (bflo(y0.y) + bflo(y1.y)) + (bflo(y2.y) + bflo(y3.y)); a[3] += (bfhi(y0.y) + bfhi(y1.y)) + (bfhi(y2.y) + bfhi(y3.y));
            b[0] += (bflo(y0.z) + bflo(y1.z)) + (bflo(y2.z) + bflo(y3.z)); b[1] += (bfhi(y0.z) + bfhi(y1.z)) + (bfhi(y2.z) + bfhi(y3.z));
            b[2] += (bflo(y0.w) + bflo(y1.w)) + (bflo(y2.w) + bflo(y3.w)); b[3] += (bfhi(y0.w) + bfhi(y1.w)) + (bfhi(y2.w) + bfhi(y3.w));
            pg8::st_bf16x8(hb + o, a, b); hv[2 * i] = a; hv[2 * i + 1] = b;
#pragma unroll
            for (int j = 0; j < 4; ++j) amax = fmaxf(amax, fmaxf(fabsf(a[j]), fabsf(b[j]))); }
        for (int o = 32; o > 0; o >>= 1) amax = fmaxf(amax, __shfl_xor(amax, o));
        amax = fmaxf(amax, 1e-20f); const float qi = 127.0f / amax; if (lane == 0) hsc[tok] = amax * (1.0f / 127.0f);
#pragma unroll
        for (int i = 0; i < 4; ++i) { u32x2 w;
#pragma unroll
            for (int h = 0; h < 2; ++h) { unsigned pk = 0u;
#pragma unroll
                for (int j = 0; j < 4; ++j) pk |= ((unsigned)(int)rintf(hv[2 * i + h][j] * qi) & 0xffu) << (8 * j);
                w[h] = pk; }
            *(u32x2*)(hq + (size_t)tok * DM + (i * 64 + lane) * 8) = w; } }
}
__device__ __forceinline__ void phase_ln2(const Frame& F0, const Params& P, int l) { const Frame F = fresh(F0);
    unsigned char* ws = F.ws; const bf16_t* pre2 = (const bf16_t*)(ws + M_X1F); bf16_t* xb = (bf16_t*)(ws + WS_XB);
    const float* g = F.in(23) + l * DM; const float* bt = F.in(24) + l * DM; float* outp = F.out();
    for (int tok = F.bid * 8 + F.wid; tok < NTOK; tok += F.G * 8) ln_row(pre2 + (size_t)tok * DM, g, bt, (l + 1 == NLAYER) ? outp + (size_t)tok * DM : (float*)nullptr, (l + 1 == NLAYER) ? (bf16_t*)nullptr : xb + (size_t)tok * DM, F.lane,
                                                                          (l + 1 == NLAYER) ? (unsigned char*)nullptr : (unsigned char*)(ws + WS_XQ) + (size_t)tok * DM, (l + 1 == NLAYER) ? (float*)nullptr : (float*)(ws + WS_XSC) + tok);
}

constexpr int NPHASE = 2 + 15 * NLAYER;
#ifdef PH_ONLY
#define PEN(kind) ((kind) == PH_ONLY)
#else
#define PEN(kind) true
#endif
#define IN(k) (lo <= (k) && (k) < hi)
#define SEAM(k) do { if (IN((k) + 1)) xcd_barrier(bar); } while (0)

template <int l>
__device__ __forceinline__ void layer_phases(const Frame& F, const Params& P, const XcdBarrier& bar, const int lo, const int hi, unsigned char* ws0) {
    using namespace pg8;

        const int pb = 2 + 15 * l;
        if (IN(pb + 0) && PEN(0)) { size_t wz = 0; asm volatile("" : "+s"(wz)); unsigned char* ws = ws0 + wz;
            { SchedS S; S.init(NTOK, 5 * 256, F.G, F.bid, (const bf16_t*)(ws + WS_XB), DM, (const bf16_t*)(ws + W_IN), DM); S.skip_from = 0; S.skip_by = 4; S.skip_from2 = 4; S.skip_by2 = 49;
              EpiInProj<false> E{(bf16_t*)(ws + R_QA), (bf16_t*)(ws + R_QIDX), (bf16_t*)(ws + R_QKV), (bf16_t*)(ws + R_GATES), (float*)(ws + R_SMALL), nullptr, nullptr};
              for (int rep = 0; rep < NREP(5); ++rep) gemm_phase(F.ldsl, DM, DM, DM, S, E); }
            { SchedS S; S.init(NTOK, 53 * 256, F.G, (F.bid + F.G / 2) % F.G, (const bf16_t*)(ws + WS_XQ), DM / 2, (const bf16_t*)(ws + W_IN8), DM / 2); S.skip_from = 4; S.skip_by = 4; S.b_compact = 1;
              EpiInProj<true> E{(bf16_t*)(ws + R_QA), (bf16_t*)(ws + R_QIDX), (bf16_t*)(ws + R_QKV), (bf16_t*)(ws + R_GATES), (float*)(ws + R_SMALL), (const float*)(ws + WS_XSC), (const unsigned*)(ws + WS_CTL) + CW_WMAXG + l};
              for (int rep = 0; rep < NREP(5); ++rep) gemm_phase(F.ldsl, DM / 2, DM / 2, DM / 2, S, E); }
            SEAM(pb + 0); }
        if (IN(pb + 1) && PEN(1)) { size_t wz = 0; asm volatile("" : "+s"(wz)); unsigned char* ws = ws0 + wz;
            phase_prep(F, P, l);
            SchedS S; S.init(NTOK, 2048, F.G, F.bid, (const bf16_t*)(ws + R_QA), 1024, (const bf16_t*)(ws + W_UK2), 256, 1, 256);
            EpiBf16 E{(bf16_t*)(ws + R_QCAT), 2304, 288};
            for (int rep = 0; rep < NREP(10); ++rep) gemm_phase(F.ldsl, 256, 1024, 256, S, E); SEAM(pb + 1); }
        if (IN(pb + 2) && PEN(2)) { size_t wz = 0; asm volatile("" : "+s"(wz)); unsigned char* ws = ws0 + wz; phase_cumsum(F); for (int rep = 0; rep < NREP(3); ++rep) phase_idx(F); SEAM(pb + 2); }
        if (IN(pb + 3) && PEN(3)) { size_t wz = 0; asm volatile("" : "+s"(wz)); unsigned char* ws = ws0 + wz; for (int rep = 0; rep < NREP(4); ++rep) phase_topk(F); SEAM(pb + 3); }
        if (IN(pb + 4) && PEN(4)) { size_t wz = 0; asm volatile("" : "+s"(wz)); unsigned char* ws = ws0 + wz; for (int rep = 0; rep < NREP(1); ++rep) phase_attn(F, l, rep); SEAM(pb + 4); }
        if (IN(pb + 5) && PEN(5)) { size_t wz = 0; asm volatile("" : "+s"(wz)); unsigned char* ws = ws0 + wz;
            SchedS S; S.init(NTOK, 1024, F.G, F.bid, (const bf16_t*)(ws + R_OLAT), 2048, (const bf16_t*)(ws + W_UV2), 512, 0, 512);
            EpiBf16 E{(bf16_t*)(ws + R_OA), 3072, 256}; for (int rep = 0; rep < NREP(10); ++rep) gemm_phase(F.ldsl, 512, 2048, 512, S, E);
            SEAM(pb + 5); }
        if (IN(pb + 6) && PEN(6)) { size_t wz = 0; asm volatile("" : "+s"(wz)); unsigned char* ws = ws0 + wz;
            SchedS S; S.init(NTOK, 2048, F.G, F.bid, (const bf16_t*)(ws + R_OA), 3072, (const bf16_t*)(ws + W_BRA), 3072);
            EpiBranch3 E{(const unsigned char*)(ws + R_GATES), (bf16_t*)(ws + R_MERGED)}; for (int rep = 0; rep < NREP(11); ++rep) gemm_phase(F.ldsl, 3072, 3072, 3072, S, E); SEAM(pb + 6); }
        if (IN(pb + 7) && PEN(7)) { size_t wz = 0; asm volatile("" : "+s"(wz)); unsigned char* ws = ws0 + wz;
            SchedS S; S.init(NTOK, 2048, F.G, F.bid, (const bf16_t*)(ws + R_MERGED), DM, (const bf16_t*)(ws + W_OUT), DM);
            EpiOut E{(const bf16_t*)(ws + WS_XB), (bf16_t*)(ws + R_PRE1)}; for (int rep = 0; rep < NREP(8); ++rep) gemm_phase(F.ldsl, DM, DM, DM, S, E); SEAM(pb + 7); }
        if (IN(pb + 8) && PEN(8)) { size_t wz = 0; asm volatile("" : "+s"(wz)); unsigned char* ws = ws0 + wz; phase_ln1_router(F, P, l); SEAM(pb + 8); }
        if (IN(pb + 9) && PEN(9)) { size_t wz = 0; asm volatile("" : "+s"(wz)); unsigned char* ws = ws0 + wz;
            for (int rep = 0; rep < NREP(12); ++rep) phase_moe_gather(F, l);
            SchedS S; S.init(NTOK, 2048, F.G, F.bid, (const bf16_t*)(ws + WS_PB) + (size_t)l * NTOK * 256, 256, (const bf16_t*)(ws + W_PLE), 256);
            EpiBf16 E{(bf16_t*)(ws + M_PP), 2048, 256}; for (int rep = 0; rep < NREP(10); ++rep) gemm_phase(F.ldsl, 256, 256, 256, S, E); SEAM(pb + 9); }
        if (IN(pb + 10) && PEN(10)) { size_t wz = 0; asm volatile("" : "+s"(wz)); unsigned char* ws = ws0 + wz;
            SchedM S; S.init((const unsigned*)(ws + WS_CTL) + CW_META + l * 512, F.G, F.bid, (const bf16_t*)(ws + M_XS), DM / 2, (const bf16_t*)(ws + W_GU), DM / 2);
            EpiGateUpI8 E{F.in(16) + (size_t)l * NEXP * DEXP, F.in(18) + (size_t)l * NEXP * DEXP, (bf16_t*)(ws + M_HID), (const float*)(ws + M_ROWSX), (const unsigned*)(ws + WS_CTL) + CW_WMAX + l};
            for (int rep = 0; rep < NREP(6); ++rep) gemm_phase(F.ldsl, DM / 2, DM / 2, DM / 2, S, E); SEAM(pb + 10); }
        if (IN(pb + 11) && PEN(11)) { size_t wz = 0; asm volatile("" : "+s"(wz)); unsigned char* ws = ws0 + wz;
            SchedM S; S.init((const unsigned*)(ws + WS_CTL) + CW_META + l * 512, F.G, F.bid, (const bf16_t*)(ws + M_HID), DEXP, (const bf16_t*)(ws + W_DN), DEXP);
            EpiDown E{F.in(20) + (size_t)l * NEXP * DM, (const float*)(ws + M_ROWW), (bf16_t*)(ws + M_XS)}; for (int rep = 0; rep < NREP(7); ++rep) gemm_phase(F.ldsl, DEXP, DEXP, DEXP, S, E); SEAM(pb + 11); }
        if (IN(pb + 12) && PEN(12)) { size_t wz = 0; asm volatile("" : "+s"(wz)); unsigned char* ws = ws0 + wz; for (int rep = 0; rep < NREP(9); ++rep) phase_combine(F); SEAM(pb + 12); }
        if (IN(pb + 13) && PEN(13)) { size_t wz = 0; asm volatile("" : "+s"(wz)); unsigned char* ws = ws0 + wz;
            SchedS S; S.init(NTOK, 2048, F.G, F.bid, (const bf16_t*)(ws + M_HQ), DM / 2, (const bf16_t*)(ws + W_PG), DM / 2);
            EpiPleGateI8 E{(const bf16_t*)(ws + M_HB), (const bf16_t*)(ws + M_PP), (bf16_t*)(ws + M_X1F), (const float*)(ws + M_HSC), (const unsigned*)(ws + WS_CTL) + CW_WMAXP + l};
            for (int rep = 0; rep < NREP(8); ++rep) gemm_phase(F.ldsl, DM / 2, DM / 2, DM / 2, S, E); SEAM(pb + 13); }
        if (IN(pb + 14) && PEN(14)) { size_t wz = 0; asm volatile("" : "+s"(wz)); unsigned char* ws = ws0 + wz; for (int rep = 0; rep < NREP(13); ++rep) phase_ln2(F, P, l); if (l + 1 < NLAYER) for (int rep = 0; rep < NREP(0); ++rep) convert_layer_weights(F, P, l + 1); SEAM(pb + 14); }
}
__global__ void __launch_bounds__(512, 2) fwd(Params P) {
    extern __shared__ __attribute__((aligned(16))) unsigned char lds[];
    Frame F; F.lds = lds; F.ldsl = (LAS unsigned char*)lds; F.ws = P.ws; F.tid = threadIdx.x; F.lane = F.tid & 63; F.wid = __builtin_amdgcn_readfirstlane(F.tid >> 6); F.G = gridDim.x; F.bid = blockIdx.x;
    unsigned char* ws0 = P.ws; unsigned char* ws = ws0;
    const bool fused = (P.ph_hi - P.ph_lo) > 1;
    if (F.tid < 4) ((LAS unsigned*)(F.ldsl + LDS_MISC))[F.tid] = 0u;
    if (F.tid == 0) { LAS unsigned long long* t = (LAS unsigned long long*)(F.ldsl + LDS_PTRS);
#pragma unroll
        for (int k = 0; k < 25; ++k) t[k] = (unsigned long long)P.in[k];
        t[25] = (unsigned long long)P.out; }
    __syncthreads();
    XcdBarrier bar; bar.bar = (unsigned*)(ws + WS_CTL) + CW_BAR; bar.x = 0; bar.st = (volatile LAS unsigned*)(F.ldsl + LDS_MISC);
    if (fused) bar = xcd_barrier_post((unsigned*)(ws + WS_CTL) + CW_BAR, (volatile LAS unsigned*)(F.ldsl + LDS_MISC));
    const int lo = P.ph_lo, hi = P.ph_hi;
    using namespace pg8;
    if (IN(0) && PEN(15)) { size_t wz = 0; asm volatile("" : "+s"(wz)); unsigned char* ws = ws0 + wz;
        quant_rows(F, F.in(0), (bf16_t*)(ws + WS_XB), (unsigned char*)(ws + WS_XQ), (float*)(ws + WS_XSC));
        conv_rows(F, F.in(1), (bf16_t*)(ws + WS_PB), (size_t)2 * NTOK * 256 / 8);
        sample_wmax(F);
        SEAM(0);
    }
    if (IN(1) && PEN(15)) { for (int rep = 0; rep < NREP(0); ++rep) convert_layer_weights(F, P, 0); SEAM(1); }
    layer_phases<0>(F, P, bar, lo, hi, ws0);
    layer_phases<1>(F, P, bar, lo, hi, ws0);
}

#ifdef DEBUG_NAN
constexpr int CW_FLAGS = 12288;
__global__ void dbg_scan_bf16(const unsigned short* p, size_t n, unsigned* flag) { unsigned c = 0; for (size_t i = (size_t)blockIdx.x * blockDim.x + threadIdx.x; i < n; i += (size_t)gridDim.x * blockDim.x) if ((p[i] & 0x7F80u) == 0x7F80u) ++c; if (c) atomicAdd(flag, c); }
__global__ void dbg_scan_f32(const unsigned* p, size_t n, unsigned* flag) { unsigned c = 0; for (size_t i = (size_t)blockIdx.x * blockDim.x + threadIdx.x; i < n; i += (size_t)gridDim.x * blockDim.x) if ((p[i] & 0x7F800000u) == 0x7F800000u) ++c; if (c) atomicAdd(flag, c); }
__global__ void dbg_scan_sel(const int* sel, const int* nsel, unsigned* flag) { unsigned c = 0; for (size_t i = (size_t)blockIdx.x * blockDim.x + threadIdx.x; i < (size_t)NTOK * 256; i += (size_t)gridDim.x * blockDim.x) { const int tok = (int)(i >> 8), j = (int)(i & 255), t = tok & (SEQ - 1); const int ns = nsel[tok]; if (j == 0 && ns != (t + 1 < 256 ? t + 1 : 256)) ++c; if (j < ns && (sel[i] < 0 || sel[i] > t)) ++c; } if (c) atomicAdd(flag, c); }
__global__ void dbg_scan_scores(const unsigned* p, unsigned* flag) { unsigned c = 0; for (size_t i = (size_t)blockIdx.x * blockDim.x + threadIdx.x; i < 2ull * SEQ * SEQ; i += (size_t)gridDim.x * blockDim.x) { const int s = (int)(i & (SEQ - 1)), t = (int)((i >> 13) & (SEQ - 1)); if (s <= t && (p[i] & 0x7F800000u) == 0x7F800000u) ++c; } if (c) atomicAdd(flag, c); }
__global__ void dbg_probe_bf16(const unsigned short* p, size_t n, unsigned* cnt, unsigned* minidx) { unsigned c = 0; unsigned mi = 0xFFFFFFFFu; for (size_t i = (size_t)blockIdx.x * blockDim.x + threadIdx.x; i < n; i += (size_t)gridDim.x * blockDim.x) if ((p[i] & 0x7F80u) == 0x7F80u) { ++c; if ((unsigned)i < mi) mi = (unsigned)i; } if (c) { atomicAdd(cnt, c); atomicMax(minidx, ~mi); } }
__global__ void dbg_final(float* out, size_t n, const unsigned* flags) { int code = 0; for (int k = 0; k < 32; ++k) if (flags[k] && !code) code = k + 1; const int mask = (flags[32] ? 1 : 0) | (flags[33] ? 2 : 0) | (flags[34] ? 4 : 0); if (mask) code = 20 + 5 * mask; if (!code) return; for (size_t i = (size_t)blockIdx.x * blockDim.x + threadIdx.x; i < n; i += (size_t)gridDim.x * blockDim.x) out[i] = (float)code; }
#endif
extern "C" void kernel_launch(void* const* d_in, const int* in_sizes, int n_in, void* d_out, int out_size, void* d_ws, size_t ws_size, hipStream_t stream) {
    static int grid = 0;
    if (grid == 0) {
        if (n_in != 25 || out_size != NTOK * DM || ws_size < WS_NEED) { fprintf(stderr, "kernel_launch: unexpected shapes (n_in %d out %d ws %zu need %zu)\n", n_in, out_size, ws_size, (size_t)WS_NEED); grid = -1; return; }
        int dev = 0, cus = 0, per_cu = 0;
        if (hipGetDevice(&dev) != hipSuccess || hipDeviceGetAttribute(&cus, hipDeviceAttributeMultiprocessorCount, dev) != hipSuccess) { grid = -1; return; }
        if (hipFuncSetAttribute((const void*)fwd, hipFuncAttributeMaxDynamicSharedMemorySize, LDS_BYTES) != hipSuccess) { fprintf(stderr, "kernel_launch: hipFuncSetAttribute failed\n"); grid = -1; return; }
        if (hipOccupancyMaxActiveBlocksPerMultiprocessor(&per_cu, (const void*)fwd, 512, LDS_BYTES) != hipSuccess || per_cu < 1) fprintf(stderr, "kernel_launch: occupancy query says %d\n", per_cu);
        (void)hipGetLastError();
        grid = cus;
    }
    if (grid < 0) return;
    unsigned char* ws = (unsigned char*)d_ws;
    hipMemsetAsync(ws + WS_CTL, 0, CTL_BYTES, stream);
    hipMemsetAsync(ws + W_UK2, 0, 8ull * 256 * 256 * 2 + 4ull * 256 * 512 * 2, stream);
    hipMemsetAsync(ws + W_IN + (size_t)INW * 2048 * 2, 0, (size_t)(INWP - INW) * 2048 * 2, stream);
    Params p{};
    for (int i = 0; i < 25; ++i) p.in[i] = (const float*)d_in[i];
    p.out = (float*)d_out; p.ws = ws;
#if PHASES_PER_LAUNCH == 0
    p.ph_lo = 0; p.ph_hi = NPHASE;
    hipLaunchKernelGGL(fwd, dim3(grid), dim3(512), LDS_BYTES, stream, p);
#else
    for (int k = 0; k < NPHASE; ++k) { p.ph_lo = k; p.ph_hi = k + 1; hipLaunchKernelGGL(fwd, dim3(grid), dim3(512), LDS_BYTES, stream, p);
#ifdef DEBUG_NAN
        unsigned* fl = (unsigned*)(ws + WS_CTL) + CW_FLAGS + k;
#define SB16(off, n) hipLaunchKernelGGL(dbg_scan_bf16, dim3(1024), dim3(256), 0, stream, (const unsigned short*)(ws + (off)), (size_t)(n), fl)
#define SF32(off, n) hipLaunchKernelGGL(dbg_scan_f32, dim3(1024), dim3(256), 0, stream, (const unsigned*)(ws + (off)), (size_t)(n), fl)
        if (k == 0) { SB16(WS_XB, (size_t)NTOK * DM); SB16(WS_PB, 2ull * NTOK * 256); SB16(WS_W, (W_END - WS_W) / 2); }
        else { const int kind = (k - 1) % 15;
            if (kind == 0) { SB16(R_QA, (size_t)NTOK * 1024); SB16(R_QIDX, (size_t)NTOK * 1024); SB16(R_QKV, 6ull * NTOK * 1024); SB16(R_GATES, (size_t)NTOK * 6144); SF32(R_SMALL, (size_t)NTOK * 512); }
            if (kind == 1) { SB16(R_QCAT, (size_t)NTOK * 2304); SB16(R_KCAT, (size_t)NTOK * 288); SB16(R_KI, (size_t)NTOK * 64); SB16(R_QIDX, (size_t)NTOK * 1024); SF32(R_WI, (size_t)NTOK * 16); SF32(WS_LF, 16ull * 8192); }
            if (kind == 2) { SF32(WS_CUM, 16ull * 8192); hipLaunchKernelGGL(dbg_scan_scores, dim3(1024), dim3(256), 0, stream, (const unsigned*)(ws + R_SCORES), fl); }
            if (kind == 3) { hipLaunchKernelGGL(dbg_scan_sel, dim3(1024), dim3(256), 0, stream, (const int*)(ws + R_SEL), (const int*)(ws + R_NSEL), fl); }
            if (k == 5) { unsigned* fl0 = fl; fl = (unsigned*)(ws + WS_CTL) + CW_FLAGS + 32; SB16(R_OLAT, (size_t)NTOK * 2048); fl += 1; SB16(R_OA, (size_t)NTOK * 3072); fl += 1; fl = fl0; hipLaunchKernelGGL(dbg_probe_bf16, dim3(1024), dim3(256), 0, stream, (const unsigned short*)(ws + R_OC), (size_t)NTOK * 1024, (unsigned*)(ws + WS_CTL) + CW_FLAGS + 40, (unsigned*)(ws + WS_CTL) + CW_FLAGS + 41); }
            if (kind == 5) { SB16(R_OA, (size_t)NTOK * 3072); }
            if (kind == 6) { SB16(R_MERGED, (size_t)NTOK * 2048); }
            if (kind == 7) { SF32(R_PRE1, (size_t)NTOK * 2048); }
            if (kind == 8) { SF32(M_X1F, (size_t)NTOK * 2048); SF32(M_TOKW, (size_t)NTOK * 4); }
            if (kind == 9) { SB16(M_PP, (size_t)NTOK * 2048); }
            if (kind == 12) { SF32(M_HF, (size_t)NTOK * 2048); }
            if (kind == 13) { SF32(M_X1F, (size_t)NTOK * 2048); }
            if (kind == 14) { hipLaunchKernelGGL(dbg_scan_f32, dim3(1024), dim3(256), 0, stream, (const unsigned*)d_out, (size_t)NTOK * DM, fl); if (k + 1 < NPHASE) SB16(WS_W, (W_END - WS_W) / 2); } }
#endif
    }
#ifdef DEBUG_NAN
    hipLaunchKernelGGL(dbg_final, dim3(1024), dim3(256), 0, stream, (float*)d_out, (size_t)NTOK * DM, (const unsigned*)(ws + WS_CTL) + CW_FLAGS);
#endif
#endif
}
```

```cpp
#include <hip/hip_runtime.h>
#include <stdint.h>
#include <stdio.h>
#include <math.h>

#ifndef PHASES_PER_LAUNCH
#define PHASES_PER_LAUNCH 0
#endif

#define LAS __attribute__((address_space(3)))
#define GAS __attribute__((address_space(1)))
#ifndef REP_MASK
#define REP_MASK 0
#endif
#define NREP(bit) (((REP_MASK) >> (bit)) & 1 ? 2 : 1)
typedef unsigned short bf16_t;
typedef short bf16x8 __attribute__((ext_vector_type(8)));
typedef short s16x4 __attribute__((ext_vector_type(4)));
typedef float f32x4 __attribute__((ext_vector_type(4)));
typedef float f32x16 __attribute__((ext_vector_type(16)));
typedef unsigned u32x4 __attribute__((ext_vector_type(4)));
typedef unsigned u32x2 __attribute__((ext_vector_type(2)));
typedef int i32x4 __attribute__((ext_vector_type(4)));

constexpr int NTOK = 16384, DM = 2048, SEQ = 8192, NB = 2, NLAYER = 2;
constexpr int INW = 14712, INWP = 14848;
constexpr int NEXP = 32, DEXP = 1024;
constexpr int PMAX = 65536 + 8192;
constexpr float ALPHA = 1.41421356237309515f;
constexpr float LOG2E = 1.4426950408889634f;
constexpr float SCALE = 0.08838834764831845f;
constexpr float C2 = LOG2E * SCALE;

constexpr size_t MiB = 1ull << 20;
constexpr size_t WS_CTL   = 0;
constexpr size_t WS_W     = 1 * MiB;
constexpr size_t W_IN     = WS_W;
constexpr size_t W_IN8    = W_IN   + 2048ull * 2048 * 2;
constexpr size_t W_UK2    = W_IN   + (size_t)INWP * 2048 * 2;
constexpr size_t W_UV2    = W_UK2  + 8ull * 256 * 256 * 2;
constexpr size_t W_BRA    = W_UV2  + 4ull * 256 * 512 * 2;
constexpr size_t W_BRB    = W_BRA  + 2048ull * 1024 * 2;
constexpr size_t W_BRC    = W_BRB  + 2048ull * 1024 * 2;
constexpr size_t W_OUT    = W_BRC  + 2048ull * 1024 * 2;
constexpr size_t W_PG     = W_OUT  + 2048ull * 2048 * 2;
constexpr size_t W_PLE    = W_PG   + 2048ull * 2048 * 2;
constexpr size_t W_GU     = W_PLE  + 2048ull * 256 * 2;
constexpr size_t W_DN     = W_GU   + 32ull * 2048 * 2048 * 2;
constexpr size_t W_END    = W_DN   + 32ull * 2048 * 1024 * 2;
constexpr size_t WS_XB    = (W_END + MiB - 1) / MiB * MiB;
constexpr size_t WS_PB    = WS_XB  + (size_t)NTOK * DM * 2;
constexpr size_t WS_CUM   = WS_PB  + 2ull * NTOK * 256 * 2;
constexpr size_t WS_LF    = WS_CUM + 16ull * 8192 * 4;
constexpr size_t WS_XQ    = WS_LF  + 16ull * 8192 * 4;
constexpr size_t WS_XSC   = WS_XQ  + (size_t)NTOK * DM;
constexpr size_t WS_R     = (WS_XSC + (size_t)NTOK * 4 + MiB - 1) / MiB * MiB;
constexpr size_t R_SCORES = WS_R;
constexpr size_t R_OLAT   = WS_R;
constexpr size_t R_OA     = WS_R + 64 * MiB;
constexpr size_t R_OB     = WS_R + 96 * MiB;
constexpr size_t R_OC     = WS_R + 128 * MiB;
constexpr size_t R_TMP    = WS_R + 160 * MiB;
constexpr size_t R_MERGED = WS_R + 288 * MiB;
constexpr size_t R_PRE1   = WS_R + 384 * MiB;
constexpr size_t R_QA     = WS_R + 512 * MiB;
constexpr size_t R_QIDX   = WS_R + 544 * MiB;
constexpr size_t R_QKV    = WS_R + 576 * MiB;
constexpr size_t R_GATES  = WS_R + 768 * MiB;
constexpr size_t R_SMALL  = WS_R + 960 * MiB;
constexpr size_t R_QCAT   = WS_R + 992 * MiB;
constexpr size_t R_KCAT   = WS_R + 1064 * MiB;
constexpr size_t R_KI     = WS_R + 1073 * MiB;
constexpr size_t R_WI     = WS_R + 1075 * MiB;
constexpr size_t R_SEL    = WS_R + 1076 * MiB;
constexpr size_t R_NSEL   = WS_R + 1092 * MiB;
constexpr size_t R_END    = WS_R + 1093 * MiB;
constexpr size_t M_XS     = WS_R;
constexpr size_t M_HID    = WS_R + 288 * MiB;
constexpr size_t M_PP     = WS_R + 432 * MiB;
constexpr size_t M_X1F    = WS_R + 512 * MiB;
constexpr size_t M_X1B    = WS_R + 640 * MiB;
constexpr size_t M_HF     = WS_R + 704 * MiB;
constexpr size_t M_HQ     = WS_R + 704 * MiB;
constexpr size_t M_HSC    = WS_R + 736 * MiB;
constexpr size_t M_HB     = WS_R + 832 * MiB;
constexpr size_t M_TOKE   = WS_R + 896 * MiB;
constexpr size_t M_TOKPOS = M_TOKE + (size_t)NTOK * 16;
constexpr size_t M_TOKW   = M_TOKPOS + (size_t)NTOK * 16;
constexpr size_t M_TOKDST = M_TOKW + (size_t)NTOK * 16;
constexpr size_t M_ROWW   = M_TOKDST + (size_t)NTOK * 16;
constexpr size_t M_ROWSX  = M_ROWW + (size_t)PMAX * 4;
constexpr size_t M_X1S    = M_ROWSX + (size_t)PMAX * 4;
constexpr size_t M_X1Q    = WS_R + 900 * MiB;
constexpr size_t M_HM     = WS_R + 740 * MiB;
constexpr size_t M_H8     = WS_R + 752 * MiB;
constexpr size_t M_H8S    = WS_R + 826 * MiB;
constexpr size_t WS_NEED  = R_END;
constexpr int CW_BAR = 0;
constexpr int CW_CNT = 8192;
constexpr int CW_META = 4096 + 64;
constexpr int CW_QCTR = 6144;
constexpr int CW_WMAX = 6272;
constexpr int CW_WMAXG = 6336;
constexpr int CW_WMAXP = 6368;
constexpr int CW_WMAXD = 6384;
constexpr int CW_KMAX = 6400;
constexpr size_t CTL_BYTES = 65536;

constexpr int LDS_BYTES = 152576;
constexpr int LDS_MISC = 151552;

typedef float f32x2 __attribute__((ext_vector_type(2)));
typedef __bf16 bf16n2 __attribute__((ext_vector_type(2)));
__device__ __forceinline__ unsigned cvtpk(float lo, float hi) { f32x2 v = {lo, hi}; bf16n2 b = __builtin_convertvector(v, bf16n2); return __builtin_bit_cast(unsigned, b); }
__device__ __forceinline__ bf16_t f2bf(float x) { return (bf16_t)(cvtpk(x, 0.f) & 0xffffu); }
__device__ __forceinline__ float bf2f(bf16_t b) { return __uint_as_float(((unsigned)b) << 16); }
__device__ __forceinline__ float bflo(unsigned w) { return __uint_as_float(w << 16); }
__device__ __forceinline__ float bfhi(unsigned w) { return __uint_as_float(w & 0xffff0000u); }
__device__ __forceinline__ bf16x8 pack8(f32x4 a, f32x4 b) { u32x4 w = {cvtpk(a[0], a[1]), cvtpk(a[2], a[3]), cvtpk(b[0], b[1]), cvtpk(b[2], b[3])}; return *reinterpret_cast<bf16x8*>(&w); }
__device__ __forceinline__ float sigmoidf_(float x) { return 1.0f / (1.0f + __expf(-x)); }
__device__ __forceinline__ float wave_sum(float v) { for (int o = 32; o > 0; o >>= 1) v += __shfl_xor(v, o); return v; }
__device__ __forceinline__ int crow(int r, int hi) { return (r & 3) + 8 * (r >> 2) + 4 * hi; }
#define SBAR() __builtin_amdgcn_sched_barrier(0)

#define XB_TMO      128
#define XB_XCNT(j)  (256  + 64 * (j))
#define XB_XSUB(j)  (1280 + 64 * (j))
#define XB_XGEN(j)  (2304 + 64 * (j))
#define XB_TOP      3328
#define XB_TOPGEN   3392
#define XCD_BAR_WORDS 3456
#define XB_SPIN_CAP (1u << 22)
__device__ __forceinline__ unsigned xb_ld(unsigned* p)              { return __hip_atomic_load(p, __ATOMIC_RELAXED, __HIP_MEMORY_SCOPE_AGENT); }
__device__ __forceinline__ unsigned xb_add(unsigned* p, unsigned v) { return __hip_atomic_fetch_add(p, v, __ATOMIC_RELAXED, __HIP_MEMORY_SCOPE_AGENT); }
__device__ __forceinline__ unsigned xb_xcc_id() { return (unsigned)__builtin_amdgcn_s_getreg((3 << 11) | 20) & 0xFu; }
#define XB_SPIN(cond, bar) do { unsigned _sp = 0; while (cond) { __builtin_amdgcn_s_sleep(1); \
    if ((++_sp & 255u) == 0u) { if (xb_ld(&(bar)[XB_TMO])) break; if (_sp > XB_SPIN_CAP) { atomicAdd(&(bar)[XB_TMO], 1u); break; } } } } while (0)
struct XcdBarrier { unsigned* bar; unsigned x; volatile LAS unsigned* st; };
__device__ __forceinline__ XcdBarrier xcd_barrier_post(unsigned* bar, volatile LAS unsigned* st) {
    XcdBarrier b; b.bar = bar; b.x = xb_xcc_id(); b.st = st;
    if (threadIdx.x == 0) (void)xb_add(&bar[XB_XCNT(b.x)], 1u);
    return b;
}
__device__ __forceinline__ void xcd_barrier_complete(unsigned* bar, unsigned x, unsigned& nloc, unsigned& nx) {
    const unsigned G = gridDim.x * gridDim.y * gridDim.z;
    unsigned sum, cnt, mine, sp = 0u;
    for (;;) {
        sum = 0u; cnt = 0u; mine = 0u;
#pragma unroll
        for (unsigned j = 0; j < 16; ++j) { const unsigned c = xb_ld(&bar[XB_XCNT(j)]); sum += c; cnt += (c > 0u) ? 1u : 0u; mine = (j == x) ? c : mine; }
        if (sum == G) break;
        __builtin_amdgcn_s_sleep(1);
        if ((++sp & 255u) == 0u) { if (xb_ld(&bar[XB_TMO])) break; if (sp > XB_SPIN_CAP) { atomicAdd(&bar[XB_TMO], 1u); break; } }
    }
    nloc = mine > 0u ? mine : 1u; nx = cnt > 0u ? cnt : 1u;
}
__device__ __forceinline__ void xcd_barrier(const XcdBarrier& b) {
    asm volatile("s_waitcnt vmcnt(0)" ::: "memory");
    __syncthreads();
    if (threadIdx.x == 0) {
        unsigned* bar = b.bar;
        __builtin_amdgcn_s_waitcnt(0);
        unsigned nloc = b.st[0], nx = b.st[1];
        if (nloc == 0u) { xcd_barrier_complete(bar, b.x, nloc, nx); b.st[0] = nloc; b.st[1] = nx; }
        const unsigned old = xb_add(&bar[XB_XSUB(b.x)], 1u);
        const unsigned gen = old / nloc;
        if (old + 1u == (gen + 1u) * nloc) {
            __builtin_amdgcn_fence(__ATOMIC_RELEASE, "agent");
            asm volatile("s_waitcnt vmcnt(0)" ::: "memory");
            const unsigned og = xb_add(&bar[XB_TOP], 1u);
            const unsigned tg = og / nx;
            if (og + 1u == (tg + 1u) * nx) xb_add(&bar[XB_TOPGEN], 1u);
            else XB_SPIN(xb_ld(&bar[XB_TOPGEN]) == tg, bar);
            __builtin_amdgcn_fence(__ATOMIC_ACQUIRE, "agent");
            xb_add(&bar[XB_XGEN(b.x)], 1u);
            asm volatile("s_waitcnt vmcnt(0)" ::: "memory");
        } else {
            XB_SPIN(xb_ld(&bar[XB_XGEN(b.x)]) == gen, bar);
            __builtin_amdgcn_fence(__ATOMIC_ACQUIRE, "agent");
            asm volatile("s_waitcnt vmcnt(0)" ::: "memory");
        }
    }
    __syncthreads();
}

namespace pg8 {
constexpr int BM = 256, BK = 64, HALF = 128, HTB = HALF * BK * 2, STAGE_BYTES = 8 * HTB, NXCD = 8, WGM = 8;
__device__ __forceinline__ int lds_byte(int r, int c) { const int st = (r >> 4) * 2 + (c >> 5), rr = r & 15, cc = c & 31, ob = rr * 64 + cc * 2; return st * 1024 + (ob ^ (((ob >> 9) & 1) << 5)); }
__device__ __forceinline__ void stage_rc(int b, int& R, int& C) { const int st = b / 1024, sb = b % 1024, swz = sb ^ (((sb >> 9) & 1) << 5); R = (st >> 1) * 16 + swz / 64; C = (st & 1) * 32 + (swz % 64) / 2; }
__device__ __forceinline__ int perm32(int rho) { const int n = rho >> 4, i = rho & 15; return 8 * (i >> 2) + 4 * n + (i & 3); }
struct Unit { int pm, pn, e; };
struct SchedS {
    int nM, nN, nwg, G, c; const bf16_t* A; const bf16_t* B; int lda, ldb, a_sh, a_mul, skip_from = 1 << 30, skip_by = 0, skip_from2 = 1 << 30, skip_by2 = 0, b_compact = 0;
    __device__ void init(int M, int N, int G_, int c_, const bf16_t* A_, int lda_, const bf16_t* B_, int ldb_, int a_sh_ = 0, int a_mul_ = 0) {
        nM = M / BM; nN = N / BM; nwg = nM * nN; G = G_; c = c_; A = A_; B = B_; lda = lda_; ldb = ldb_; a_sh = a_sh_; a_mul = a_mul_; }
    __device__ __forceinline__ bool next(int i, Unit& u) const {
        const long L = (long)i * G + c; if (L >= nwg) return false;
        int wgid = (int)L; { const int q = nwg / NXCD, r = nwg % NXCD, xcd = wgid % NXCD, off = wgid / NXCD; wgid = (xcd < r ? xcd * (q + 1) : r * (q + 1) + (xcd - r) * q) + off; }
        const int nig = WGM * nN, gid = wgid / nig, fm = gid * WGM, gsz = (nM - fm) < WGM ? (nM - fm) : WGM;
        u.pm = fm + ((wgid % nig) % gsz); u.pn = (wgid % nig) / gsz; u.e = 0;
        u.e = u.pn;
        { const int ci = u.pn; if (ci >= skip_from) u.pn += skip_by; if (ci >= skip_from2) u.pn += skip_by2; }
        return true;
    }
    __device__ __forceinline__ const char* pa(const Unit& u) const { return (const char*)(A + (size_t)u.pm * BM * lda + (size_t)((u.pn >> a_sh) * a_mul)); }
    __device__ __forceinline__ const char* pb(const Unit& u) const { return (const char*)(B + (size_t)(b_compact ? u.e : u.pn) * BM * ldb); }
};
struct SchedM {
    int ntiles, G, c; const bf16_t* A; const bf16_t* W; int lda, ldb; const unsigned* tile_e;
    __device__ void init(const unsigned* meta, int G_, int c_, const bf16_t* A_, int lda_, const bf16_t* W_, int ldb_) {
        ntiles = (int)meta[0]; tile_e = meta + 1; G = G_; c = c_; A = A_; W = W_; lda = lda_; ldb = ldb_; }
    __device__ __forceinline__ bool next(int i, Unit& u) const {
        const long L = (long)i * G + c; if (L >= (long)ntiles * 8) return false;
        u.pm = (int)(L >> 3); u.pn = (int)(L & 7); u.e = (int)tile_e[u.pm];
        return true;
    }
    __device__ __forceinline__ const char* pa(const Unit& u) const { return (const char*)(A + (size_t)u.pm * BM * lda); }
    __device__ __forceinline__ const char* pb(const Unit& u) const { return (const char*)(W + ((size_t)u.e * 2048 + (size_t)u.pn * BM) * ldb); }
};

template <class Epi, class Sched>
__device__ __forceinline__ void gemm_phase(LAS unsigned char* lds, const int K, const int lda, const int ldb, const Sched& S, const Epi& E) {
    int tid = threadIdx.x; asm volatile("" : "+v"(tid));
    const int wid = __builtin_amdgcn_readfirstlane(tid >> 6), lane = tid & 63, wr = wid >> 2, wc = wid & 3, fr = lane & 15, fq = lane >> 4;
    const int nt = K / BK;
    unsigned voffA[2], voffB[2];
#pragma unroll
    for (int i = 0; i < 2; ++i) { int R, C; stage_rc(tid * 16 + i * 8192, R, C); const int Rb = (R & ~31) + perm32(R & 31);
        voffA[i] = (unsigned)(R * lda + C) * 2u; voffB[i] = (unsigned)(Rb * ldb + C) * 2u; }
    const size_t kstep = (size_t)(BK * 2);
    const size_t hstepA = (size_t)HALF * lda * 2, hstepB = (size_t)HALF * ldb * 2;
    const unsigned ldsw = (unsigned)wid * 1024u;
    const int aoff = lds_byte(wr * 64 + fr, fq * 8), boff = lds_byte(wc * 32 + fr, fq * 8);
#define PG8_SA(b, h) (((b) * 2 + (h)) * HTB)
#define PG8_SB(b, h) ((4 + (b) * 2 + (h)) * HTB)
#define PG8_STAGE(bufoff, gbase, voff) do { _Pragma("unroll") for (int _i = 0; _i < 2; ++_i) \
        __builtin_amdgcn_global_load_lds((const unsigned*)((const char*)(gbase) + (voff)[_i]), (LAS unsigned*)(lds + (bufoff) + ldsw + _i * 8192), 16, 0, 0); } while (0)
#define PG8_LDA(dst, b, h) do { _Pragma("unroll") for (int m = 0; m < 4; ++m) _Pragma("unroll") for (int k = 0; k < 2; ++k) dst[m][k] = *(const LAS bf16x8*)(lds + PG8_SA(b, h) + aoff + m * 2048 + k * 1024); } while (0)
#define PG8_LDB(dst, b, h) do { _Pragma("unroll") for (int n = 0; n < 2; ++n) _Pragma("unroll") for (int k = 0; k < 2; ++k) dst[n][k] = *(const LAS bf16x8*)(lds + PG8_SB(b, h) + boff + n * 2048 + k * 1024); } while (0)
#define PG8_MMA(ai, bj, At, Bt) do { __builtin_amdgcn_s_setprio(1); _Pragma("unroll") for (int m = 0; m < 4; ++m) _Pragma("unroll") for (int n = 0; n < 2; ++n) _Pragma("unroll") for (int k = 0; k < 2; ++k) \
        { if constexpr (Epi::I8) acc[ai][bj][m][n] = __builtin_bit_cast(f32x4, __builtin_amdgcn_mfma_i32_16x16x64_i8(__builtin_bit_cast(i32x4, Bt[n][k]), __builtin_bit_cast(i32x4, At[m][k]), __builtin_bit_cast(i32x4, acc[ai][bj][m][n]), 0, 0, 0)); \
          else acc[ai][bj][m][n] = __builtin_amdgcn_mfma_f32_16x16x32_bf16(Bt[n][k], At[m][k], acc[ai][bj][m][n], 0, 0, 0); } __builtin_amdgcn_s_setprio(0); } while (0)
#define PG8_WAIT_V(n) asm volatile("s_waitcnt vmcnt(" #n ")" ::: "memory")
#define PG8_WAIT_L(n) asm volatile("s_waitcnt lgkmcnt(" #n ")" ::: "memory")
#define PG8_BAR __builtin_amdgcn_s_barrier()
#define PG8_SCHED __builtin_amdgcn_sched_barrier(0)
    Unit cur, nxt; int ui = 0;
    if (!S.next(0, cur)) return;
    f32x4 acc[2][2][4][2];
#pragma unroll
    for (int a = 0; a < 2; ++a)
#pragma unroll
        for (int b = 0; b < 2; ++b)
#pragma unroll
            for (int m = 0; m < 4; ++m)
#pragma unroll
                for (int n = 0; n < 2; ++n) acc[a][b][m][n] = (f32x4){0.f, 0.f, 0.f, 0.f};
    bf16x8 At[4][2], B0[2][2], B1[2][2];
    const char* cA = S.pa(cur); const char* cB = S.pb(cur);
    PG8_STAGE(PG8_SB(0, 0), cB, voffB); PG8_STAGE(PG8_SA(0, 0), cA, voffA); PG8_STAGE(PG8_SB(0, 1), cB + hstepB, voffB); PG8_STAGE(PG8_SA(0, 1), cA + hstepA, voffA);
    if (wr == 1) PG8_BAR;
    PG8_WAIT_V(4); PG8_BAR;
    PG8_STAGE(PG8_SB(1, 0), cB + kstep, voffB); PG8_STAGE(PG8_SA(1, 0), cA + kstep, voffA); PG8_STAGE(PG8_SB(1, 1), cB + hstepB + kstep, voffB);
    PG8_WAIT_V(6); PG8_BAR;
    for (;;) {
        const bool has_next = S.next(ui + 1, nxt);
        const char* nA = has_next ? S.pa(nxt) : cA; const char* nB = has_next ? S.pb(nxt) : cB;
        for (int t = 0; t < nt; t += 2) {
            const bool last = (t == nt - 2);
            if constexpr (Epi::HAS_MID) { if (t == Epi::MID1 || t == Epi::MID2) { int frM = fr, fqM = fq; asm volatile("" : "+v"(frM), "+v"(fqM)); E.mid(acc, cur, t, wr, wc, frM, fqM); } }
            const char* a1 = cA + (size_t)(t + 1) * kstep;
            const char* a2 = last ? nA : cA + (size_t)(t + 2) * kstep; const char* b2 = last ? nB : cB + (size_t)(t + 2) * kstep;
            const char* a3 = a2 + kstep; const char* b3 = b2 + kstep;
            PG8_LDB(B0, 0, 0); PG8_SCHED; PG8_LDA(At, 0, 0); PG8_STAGE(PG8_SA(1, 1), a1 + hstepA, voffA);
            PG8_WAIT_L(8); PG8_BAR; PG8_WAIT_L(0); PG8_MMA(0, 0, At, B0); PG8_BAR; PG8_SCHED;
            PG8_LDB(B1, 0, 1); PG8_STAGE(PG8_SB(0, 0), b2, voffB);
            PG8_BAR; PG8_WAIT_L(0); PG8_MMA(0, 1, At, B1); PG8_BAR;
            PG8_LDA(At, 0, 1); PG8_STAGE(PG8_SA(0, 0), a2, voffA);
            PG8_BAR; PG8_WAIT_L(0); PG8_MMA(1, 0, At, B0); PG8_BAR; PG8_SCHED;
            PG8_STAGE(PG8_SB(0, 1), b2 + hstepB, voffB);
            PG8_WAIT_V(6); PG8_BAR; PG8_MMA(1, 1, At, B1); PG8_BAR;
            PG8_LDB(B0, 1, 0); PG8_SCHED; PG8_LDA(At, 1, 0); PG8_STAGE(PG8_SA(0, 1), a2 + hstepA, voffA);
            PG8_WAIT_L(8); PG8_BAR; PG8_WAIT_L(0); PG8_MMA(0, 0, At, B0); PG8_BAR; PG8_SCHED;
            PG8_LDB(B1, 1, 1); PG8_STAGE(PG8_SB(1, 0), b3, voffB);
            PG8_BAR; PG8_WAIT_L(0); PG8_MMA(0, 1, At, B1); PG8_BAR;
            PG8_LDA(At, 1, 1); PG8_STAGE(PG8_SA(1, 0), a3, voffA);
            PG8_BAR; PG8_WAIT_L(0); PG8_MMA(1, 0, At, B0); PG8_BAR; PG8_SCHED;
            PG8_STAGE(PG8_SB(1, 1), b3 + hstepB, voffB);
            PG8_WAIT_V(6); PG8_BAR; PG8_MMA(1, 1, At, B1); PG8_BAR;
        }
        { int frE = fr, fqE = fq; asm volatile("" : "+v"(frE), "+v"(fqE)); E(acc, cur, wr, wc, frE, fqE); }
        if (!has_next) break;
#pragma unroll
        for (int a = 0; a < 2; ++a)
#pragma unroll
            for (int b = 0; b < 2; ++b)
#pragma unroll
                for (int m = 0; m < 4; ++m)
#pragma unroll
                    for (int n = 0; n < 2; ++n) acc[a][b][m][n] = (f32x4){0.f, 0.f, 0.f, 0.f};
        cur = nxt; cA = nA; cB = nB; ++ui;
    }
    PG8_WAIT_V(0);
    if (wr == 0) PG8_BAR;
    PG8_BAR;
#undef PG8_SA
#undef PG8_SB
#undef PG8_STAGE
#undef PG8_LDA
#undef PG8_LDB
#undef PG8_MMA
#undef PG8_WAIT_V
#undef PG8_WAIT_L
#undef PG8_BAR
#undef PG8_SCHED
}

#define EPI_LOOP_ROWS _Pragma("unroll") for (int ai = 0; ai < 2; ++ai) _Pragma("unroll") for (int m = 0; m < 4; ++m)
__device__ __forceinline__ void st_bf16x8(bf16_t* p, f32x4 v0, f32x4 v1) { u32x4 w; w.x = cvtpk(v0[0], v0[1]); w.y = cvtpk(v0[2], v0[3]); w.z = cvtpk(v1[0], v1[1]); w.w = cvtpk(v1[2], v1[3]); *(u32x4*)p = w; }

template <bool I8_> struct EpiInProj {
    static constexpr bool HAS_MID = false; static constexpr bool I8 = I8_;
    bf16_t* qa; bf16_t* qidx; bf16_t* qkv; bf16_t* gates; float* small_; const float* xs; const unsigned* wmaxbits;
    __device__ __forceinline__ f32x4 val(const f32x4& a, float sc) const { if constexpr (I8_) { const i32x4 v = __builtin_bit_cast(i32x4, a); return (f32x4){(float)v[0], (float)v[1], (float)v[2], (float)v[3]} * sc; } else return a; }
    __device__ __forceinline__ void operator()(const f32x4 (&acc)[2][2][4][2], const Unit& u, int wr, int wc, int fr, int fq) const {
        const int pn = u.pn, row0 = u.pm * BM + wr * 64 + fr, lc0 = wc * 32 + fq * 8;
        float sw = 0.f; if constexpr (I8_) sw = __uint_as_float(*wmaxbits) * (1.3f / 127.0f);
        float scs[2][4];
#pragma unroll
        for (int ai = 0; ai < 2; ++ai)
#pragma unroll
            for (int m = 0; m < 4; ++m) { scs[ai][m] = 0.f; if constexpr (I8_) scs[ai][m] = xs[row0 + ai * HALF + m * 16] * sw; }
        if (pn < 8) {
            bf16_t* base = (pn < 4 ? qa + pn * 256 : qidx + (pn - 4) * 256) + lc0;
            EPI_LOOP_ROWS { const int row = row0 + ai * HALF + m * 16; const float sc = scs[ai][m];
#pragma unroll
                for (int bj = 0; bj < 2; ++bj) st_bf16x8(base + (size_t)row * 1024 + bj * HALF, val(acc[ai][bj][m][0], sc), val(acc[ai][bj][m][1], sc)); }
        } else if (pn < 32) {
            const int id = (pn - 8) >> 2, hb = ((pn - 8) & 3) * 2, b = u.pm >> 5;
            bf16_t* base = qkv + (size_t)id * ((size_t)NTOK * 1024) + lc0;
            EPI_LOOP_ROWS { const int row = row0 + ai * HALF + m * 16, s = row & (SEQ - 1); const float sc = scs[ai][m];
#pragma unroll
                for (int bj = 0; bj < 2; ++bj) st_bf16x8(base + ((size_t)(b * 8 + hb + bj) * SEQ + s) * 128, val(acc[ai][bj][m][0], sc), val(acc[ai][bj][m][1], sc)); }
        } else if (pn < 56) {
            unsigned char* base = (unsigned char*)gates + (pn - 32) * 256 + lc0;
            EPI_LOOP_ROWS { const int row = row0 + ai * HALF + m * 16; const float sc = scs[ai][m];
#pragma unroll
                for (int bj = 0; bj < 2; ++bj) { const f32x4 v0 = val(acc[ai][bj][m][0], sc), v1 = val(acc[ai][bj][m][1], sc); u32x2 w; unsigned p0 = 0u, p1 = 0u;
#pragma unroll
                    for (int j = 0; j < 4; ++j) { p0 |= (unsigned)(int)fmaxf(rintf(255.0f * sigmoidf_(v0[j])), 1.0f) << (8 * j); p1 |= (unsigned)(int)fmaxf(rintf(255.0f * sigmoidf_(v1[j])), 1.0f) << (8 * j); }
                    w.x = p0; w.y = p1; *(u32x2*)(base + (size_t)row * 6144 + bj * HALF) = w; } }
        } else {
            float* base = small_ + (pn - 56) * 256 + lc0;
            EPI_LOOP_ROWS { const int row = row0 + ai * HALF + m * 16; const float sc = scs[ai][m];
#pragma unroll
                for (int bj = 0; bj < 2; ++bj) { float* p = base + (size_t)row * 512 + bj * HALF; *(f32x4*)p = val(acc[ai][bj][m][0], sc); *(f32x4*)(p + 4) = val(acc[ai][bj][m][1], sc); } }
        }
    }
};
struct EpiBf16 {
    static constexpr bool HAS_MID = false; static constexpr bool I8 = false;
    bf16_t* out; int ld, cstep;
    __device__ __forceinline__ void operator()(const f32x4 (&acc)[2][2][4][2], const Unit& u, int wr, int wc, int fr, int fq) const {
        const int row0 = u.pm * BM + wr * 64 + fr; bf16_t* base = out + (size_t)u.pn * cstep + wc * 32 + fq * 8;
        EPI_LOOP_ROWS { const int row = row0 + ai * HALF + m * 16;
#pragma unroll
            for (int bj = 0; bj < 2; ++bj) st_bf16x8(base + (size_t)row * ld + bj * HALF, acc[ai][bj][m][0], acc[ai][bj][m][1]); }
    }
};
struct EpiBranch3 {
    static constexpr bool HAS_MID = true; static constexpr bool I8 = false; static constexpr int MID1 = 16, MID2 = 32;
    const unsigned char* gates; bf16_t* merged;
    __device__ __forceinline__ static f32x4 rat(unsigned n, unsigned d) {
        f32x4 r; r[0] = (float)(n & 255u) * __builtin_amdgcn_rcpf((float)(d & 255u)); r[1] = (float)((n >> 8) & 255u) * __builtin_amdgcn_rcpf((float)((d >> 8) & 255u));
        r[2] = (float)((n >> 16) & 255u) * __builtin_amdgcn_rcpf((float)((d >> 16) & 255u)); r[3] = (float)(n >> 24) * __builtin_amdgcn_rcpf((float)(d >> 24)); return r; }
    __device__ __forceinline__ void mid(f32x4 (&acc)[2][2][4][2], const Unit& u, int t, int wr, int wc, int fr, int fq) const {
        const int row0 = u.pm * BM + wr * 64 + fr, col0 = u.pn * BM + wc * 32 + fq * 8, bn = (t == MID1) ? 0 : 2048;
        u32x2 gn[2][4][2], gd[2][4][2];
        EPI_LOOP_ROWS {
#pragma unroll
            for (int bj = 0; bj < 2; ++bj) { const unsigned char* gp = gates + (size_t)(row0 + ai * HALF + m * 16) * 6144 + bn + col0 + bj * HALF; gn[ai][m][bj] = *(const u32x2*)gp; gd[ai][m][bj] = *(const u32x2*)(gp + 2048); } }
        EPI_LOOP_ROWS {
#pragma unroll
            for (int bj = 0; bj < 2; ++bj) { acc[ai][bj][m][0] *= rat(gn[ai][m][bj].x, gd[ai][m][bj].x); acc[ai][bj][m][1] *= rat(gn[ai][m][bj].y, gd[ai][m][bj].y); } }
    }
    __device__ __forceinline__ void operator()(const f32x4 (&acc)[2][2][4][2], const Unit& u, int wr, int wc, int fr, int fq) const {
        const int row0 = u.pm * BM + wr * 64 + fr, col0 = u.pn * BM + wc * 32 + fq * 8;
        u32x2 gl[2][4][2];
        EPI_LOOP_ROWS {
#pragma unroll
            for (int bj = 0; bj < 2; ++bj) gl[ai][m][bj] = *(const u32x2*)(gates + (size_t)(row0 + ai * HALF + m * 16) * 6144 + 4096 + col0 + bj * HALF); }
        EPI_LOOP_ROWS { const int row = row0 + ai * HALF + m * 16;
#pragma unroll
            for (int bj = 0; bj < 2; ++bj) { const int col = col0 + bj * HALF; const u32x2 gw = gl[ai][m][bj]; constexpr float I255 = 1.0f / 255.0f;
                f32x4 v0 = acc[ai][bj][m][0], v1 = acc[ai][bj][m][1];
                v0[0] *= (float)(gw.x & 255u) * I255; v0[1] *= (float)((gw.x >> 8) & 255u) * I255; v0[2] *= (float)((gw.x >> 16) & 255u) * I255; v0[3] *= (float)(gw.x >> 24) * I255;
                v1[0] *= (float)(gw.y & 255u) * I255; v1[1] *= (float)((gw.y >> 8) & 255u) * I255; v1[2] *= (float)((gw.y >> 16) & 255u) * I255; v1[3] *= (float)(gw.y >> 24) * I255;
                st_bf16x8(merged + (size_t)row * 2048 + col, v0, v1); } }
    }
};
struct EpiOut {
    static constexpr bool HAS_MID = false; static constexpr bool I8 = false;
    const bf16_t* res; bf16_t* pre;
    __device__ __forceinline__ void operator()(const f32x4 (&acc)[2][2][4][2], const Unit& u, int wr, int wc, int fr, int fq) const {
        const int row0 = u.pm * BM + wr * 64 + fr, col0 = u.pn * BM + wc * 32 + fq * 8;
        u32x4 rl[2][4][2];
        EPI_LOOP_ROWS { const int row = row0 + ai * HALF + m * 16;
#pragma unroll
            for (int bj = 0; bj < 2; ++bj) rl[ai][m][bj] = *(const u32x4*)(res + (size_t)row * 2048 + col0 + bj * HALF); }
        EPI_LOOP_ROWS { const int row = row0 + ai * HALF + m * 16;
#pragma unroll
            for (int bj = 0; bj < 2; ++bj) { const size_t o = (size_t)row * 2048 + col0 + bj * HALF;
                const u32x4 rw = rl[ai][m][bj]; f32x4 v0 = acc[ai][bj][m][0], v1 = acc[ai][bj][m][1];
                v0[0] += ALPHA * bflo(rw.x); v0[1] += ALPHA * bfhi(rw.x); v0[2] += ALPHA * bflo(rw.y); v0[3] += ALPHA * bfhi(rw.y);
                v1[0] += ALPHA * bflo(rw.z); v1[1] += ALPHA * bfhi(rw.z); v1[2] += ALPHA * bflo(rw.w); v1[3] += ALPHA * bfhi(rw.w);
                st_bf16x8(pre + o, v0, v1); } }
    }
};
struct EpiGateUpI8 {
    static constexpr bool HAS_MID = false; static constexpr bool I8 = true;
    const float* bg; const float* bu; bf16_t* hid; const float* rowsx; const unsigned* wmaxbits; float* hm;
    __device__ __forceinline__ void operator()(const f32x4 (&acc)[2][2][4][2], const Unit& u, int wr, int wc, int fr, int fq) const {
        const int row0 = u.pm * BM + wr * 64 + fr, j0 = u.pn * 128 + wc * 32 + fq * 8;
        const float sw = __uint_as_float(*wmaxbits) * (1.3f / 127.0f);
        const float* pg = bg + (size_t)u.e * DEXP + j0; const float* pu = bu + (size_t)u.e * DEXP + j0;
        const f32x4 g0b = *(const f32x4*)pg, g1b = *(const f32x4*)(pg + 4), u0b = *(const f32x4*)pu, u1b = *(const f32x4*)(pu + 4);
        float scs[2][4];
#pragma unroll
        for (int ai = 0; ai < 2; ++ai)
#pragma unroll
            for (int m = 0; m < 4; ++m) scs[ai][m] = rowsx[row0 + ai * HALF + m * 16] * sw;
        EPI_LOOP_ROWS { const int row = row0 + ai * HALF + m * 16; const float sc = scs[ai][m];
            const i32x4 ag0 = __builtin_bit_cast(i32x4, acc[ai][0][m][0]), ag1 = __builtin_bit_cast(i32x4, acc[ai][0][m][1]), au0 = __builtin_bit_cast(i32x4, acc[ai][1][m][0]), au1 = __builtin_bit_cast(i32x4, acc[ai][1][m][1]);
            f32x4 h0, h1;
#pragma unroll
            for (int j = 0; j < 4; ++j) {
                float g = fminf((float)ag0[j] * sc + g0b[j], 7.0f), uu = fminf(fmaxf((float)au0[j] * sc + u0b[j], -7.0f), 7.0f);
                h0[j] = (uu + 1.0f) * (g * sigmoidf_(1.702f * g));
                g = fminf((float)ag1[j] * sc + g1b[j], 7.0f); uu = fminf(fmaxf((float)au1[j] * sc + u1b[j], -7.0f), 7.0f);
                h1[j] = (uu + 1.0f) * (g * sigmoidf_(1.702f * g)); }
            st_bf16x8(hid + (size_t)row * DEXP + j0, h0, h1);
            float am = fmaxf(fmaxf(fmaxf(fabsf(h0[0]), fabsf(h0[1])), fmaxf(fabsf(h0[2]), fabsf(h0[3]))), fmaxf(fmaxf(fabsf(h1[0]), fabsf(h1[1])), fmaxf(fabsf(h1[2]), fabsf(h1[3]))));
            am = fmaxf(am, __shfl_xor(am, 16)); am = fmaxf(am, __shfl_xor(am, 32));
            if (fq == 0) hm[(size_t)row * 32 + u.pn * 4 + wc] = am; }
    }
};
struct EpiDown {
    static constexpr bool HAS_MID = false; static constexpr bool I8 = false;
    const float* bd; const float* roww; bf16_t* ys;
    __device__ __forceinline__ void operator()(const f32x4 (&acc)[2][2][4][2], const Unit& u, int wr, int wc, int fr, int fq) const {
        const int row0 = u.pm * BM + wr * 64 + fr, col0 = u.pn * BM + wc * 32 + fq * 8;
        f32x4 b[2][2];
#pragma unroll
        for (int bj = 0; bj < 2; ++bj) { const float* p = bd + (size_t)u.e * DM + col0 + bj * HALF; b[bj][0] = *(const f32x4*)p; b[bj][1] = *(const f32x4*)(p + 4); }
        float rws[2][4];
#pragma unroll
        for (int ai = 0; ai < 2; ++ai)
#pragma unroll
            for (int m = 0; m < 4; ++m) rws[ai][m] = roww[row0 + ai * HALF + m * 16];
        EPI_LOOP_ROWS { const int row = row0 + ai * HALF + m * 16; const float w = rws[ai][m];
#pragma unroll
            for (int bj = 0; bj < 2; ++bj) st_bf16x8(ys + (size_t)row * 2048 + col0 + bj * HALF, (acc[ai][bj][m][0] + b[bj][0]) * w, (acc[ai][bj][m][1] + b[bj][1]) * w); }
    }
};
struct EpiDownI8 {
    static constexpr bool HAS_MID = false; static constexpr bool I8 = true;
    const float* bd; const float* roww; bf16_t* ys; const float* h8s; const unsigned* wmaxbits;
    __device__ __forceinline__ void operator()(const f32x4 (&acc)[2][2][4][2], const Unit& u, int wr, int wc, int fr, int fq) const {
        const int row0 = u.pm * BM + wr * 64 + fr, col0 = u.pn * BM + wc * 32 + fq * 8;
        const float sw = __uint_as_float(*wmaxbits) * (1.3f / 127.0f);
        f32x4 b[2][2];
#pragma unroll
        for (int bj = 0; bj < 2; ++bj) { const float* p = bd + (size_t)u.e * DM + col0 + bj * HALF; b[bj][0] = *(const f32x4*)p; b[bj][1] = *(const f32x4*)(p + 4); }
        float rws[2][4], scs[2][4];
#pragma unroll
        for (int ai = 0; ai < 2; ++ai)
#pragma unroll
            for (int m = 0; m < 4; ++m) { rws[ai][m] = roww[row0 + ai * HALF + m * 16]; scs[ai][m] = h8s[row0 + ai * HALF + m * 16] * sw; }
        EPI_LOOP_ROWS { const int row = row0 + ai * HALF + m * 16; const float w = rws[ai][m], sc = scs[ai][m];
#pragma unroll
            for (int bj = 0; bj < 2; ++bj) { const i32x4 a0 = __builtin_bit_cast(i32x4, acc[ai][bj][m][0]), a1 = __builtin_bit_cast(i32x4, acc[ai][bj][m][1]);
                const f32x4 v0 = (f32x4){(float)a0[0], (float)a0[1], (float)a0[2], (float)a0[3]} * sc, v1 = (f32x4){(float)a1[0], (float)a1[1], (float)a1[2], (float)a1[3]} * sc;
                st_bf16x8(ys + (size_t)row * 2048 + col0 + bj * HALF, (v0 + b[bj][0]) * w, (v1 + b[bj][1]) * w); } }
    }
};
struct EpiPleGateI8 {
    static constexpr bool HAS_MID = false; static constexpr bool I8 = true;
    const bf16_t* hb; const bf16_t* pp; bf16_t* pre; const float* hs; const unsigned* wmaxbits;
    __device__ __forceinline__ void operator()(const f32x4 (&acc)[2][2][4][2], const Unit& u, int wr, int wc, int fr, int fq) const {
        const int row0 = u.pm * BM + wr * 64 + fr, col0 = u.pn * BM + wc * 32 + fq * 8;
        const float sw = __uint_as_float(*wmaxbits) * (1.3f / 127.0f);
#pragma unroll
        for (int ai = 0; ai < 2; ++ai) { u32x4 pl[4][2], hl[4][2]; float scs[4];
#pragma unroll
            for (int m = 0; m < 4; ++m) { scs[m] = hs[row0 + ai * HALF + m * 16] * sw;
#pragma unroll
                for (int bj = 0; bj < 2; ++bj) { const size_t o = (size_t)(row0 + ai * HALF + m * 16) * 2048 + col0 + bj * HALF; pl[m][bj] = *(const u32x4*)(pp + o); hl[m][bj] = *(const u32x4*)(hb + o); } }
#pragma unroll
            for (int m = 0; m < 4; ++m) { const float sc = scs[m];
#pragma unroll
                for (int bj = 0; bj < 2; ++bj) { const size_t o = (size_t)(row0 + ai * HALF + m * 16) * 2048 + col0 + bj * HALF; const u32x4 pw = pl[m][bj], hw = hl[m][bj];
                    const i32x4 a0 = __builtin_bit_cast(i32x4, acc[ai][bj][m][0]), a1 = __builtin_bit_cast(i32x4, acc[ai][bj][m][1]); f32x4 o0, o1;
                    o0[0] = bflo(hw.x) + sigmoidf_((float)a0[0] * sc) * bflo(pw.x); o0[1] = bfhi(hw.x) + sigmoidf_((float)a0[1] * sc) * bfhi(pw.x); o0[2] = bflo(hw.y) + sigmoidf_((float)a0[2] * sc) * bflo(pw.y); o0[3] = bfhi(hw.y) + sigmoidf_((float)a0[3] * sc) * bfhi(pw.y);
                    o1[0] = bflo(hw.z) + sigmoidf_((float)a1[0] * sc) * bflo(pw.z); o1[1] = bfhi(hw.z) + sigmoidf_((float)a1[1] * sc) * bfhi(pw.z); o1[2] = bflo(hw.w) + sigmoidf_((float)a1[2] * sc) * bflo(pw.w); o1[3] = bfhi(hw.w) + sigmoidf_((float)a1[3] * sc) * bfhi(pw.w);
                    st_bf16x8(pre + o, o0, o1); } } }
    }
};
}

struct Params { const float* in[25]; float* out; unsigned char* ws; int ph_lo, ph_hi; };
__constant__ float c_invf_r[16] = {1.000000000e+00f, 4.403665960e-01f, 1.939227432e-01f, 8.539710194e-02f, 3.760603070e-02f, 1.656043902e-02f, 7.292664610e-03f, 3.211445874e-03f, 1.414213562e-03f, 6.227723788e-04f, 2.742481884e-04f, 1.207697351e-04f, 5.318296098e-05f, 2.341999971e-05f, 1.031338616e-05f, 4.541670478e-06f};
__constant__ float c_invf_i[8] = {1.000000000e+00f, 1.939227432e-01f, 3.760603070e-02f, 7.292664610e-03f, 1.414213562e-03f, 2.742481884e-04f, 5.318296098e-05f, 1.031338616e-05f};
constexpr int LDS_PTRS = LDS_MISC + 256;
struct Frame { unsigned char* lds; LAS unsigned char* ldsl; unsigned char* ws; int tid, lane, wid, G, bid;
    __device__ __forceinline__ const float* in(int k) const { const LAS unsigned* t = (const LAS unsigned*)(ldsl + LDS_PTRS) + 2 * k;
        const unsigned lo = __builtin_amdgcn_readfirstlane(t[0]), hi = __builtin_amdgcn_readfirstlane(t[1]); return (const float*)(const GAS float*)(((unsigned long long)hi << 32) | lo); }
    __device__ __forceinline__ float* out() const { return (float*)in(25); } };
__device__ __forceinline__ Frame fresh(const Frame& F0) { Frame F = F0; int t = threadIdx.x; asm volatile("" : "+v"(t)); F.tid = t; F.lane = t & 63; F.wid = __builtin_amdgcn_readfirstlane(t >> 6); size_t z = 0; asm volatile("" : "+s"(z)); F.ws = F0.ws + z; return F; }

struct TcTile { const float* src; long sld; bf16_t* dst; long dld; int nvalid; float qinv; };
template <class Dec>
__device__ __forceinline__ void tconv_run(const Frame& F, int total, const Dec& dec, int& rot) {
    float* tile = (float*)F.lds;
    const int tid = F.tid, G = F.G;
    const int start = (F.bid - (rot % G) + G) % G; rot += total;
    const int lr = tid >> 4, lc4 = (tid & 15) * 4, sn = tid >> 3, skc = (tid & 7) * 8;
    f32x4 v[4][2];
#define TC_ISSUE(t0_) do { _Pragma("unroll") for (int q = 0; q < 4; ++q) { const int t = (t0_) + q * G; \
        if (t < total) { const TcTile ti = dec(t); _Pragma("unroll") for (int h = 0; h < 2; ++h) { v[q][h] = (f32x4){0.f, 0.f, 0.f, 0.f}; \
            if (lc4 < ti.nvalid) v[q][h] = *(const GAS f32x4*)((const GAS float*)ti.src + (size_t)(lr + 32 * h) * ti.sld + lc4); } } } } while (0)
    if (start < total) TC_ISSUE(start);
    for (int t0 = start; t0 < total; t0 += 4 * G) {
#pragma unroll
        for (int q = 0; q < 4; ++q) { if (t0 + q * G < total) { float* tl = tile + q * (64 * 65);
#pragma unroll
                for (int h = 0; h < 2; ++h) { float* p = tl + (lr + 32 * h) * 65 + lc4; p[0] = v[q][h][0]; p[1] = v[q][h][1]; p[2] = v[q][h][2]; p[3] = v[q][h][3]; } } }
        __syncthreads();
        if (t0 + 4 * G < total) TC_ISSUE(t0 + 4 * G);
#pragma unroll
        for (int q = 0; q < 4; ++q) { const int t = t0 + q * G;
            if (t < total) { const TcTile ti = dec(t); const float* tl = tile + q * (64 * 65);
                if (ti.qinv > 0.f) { if (tid < 256) { const int n8 = tid >> 2, kc = (tid & 3) * 16; u32x4 w;
#pragma unroll
                        for (int d = 0; d < 4; ++d) { unsigned pk = 0u;
#pragma unroll
                            for (int j = 0; j < 4; ++j) { float q = rintf(tl[(kc + d * 4 + j) * 65 + n8] * ti.qinv); q = fminf(fmaxf(q, -127.f), 127.f); pk |= ((unsigned)(int)q & 0xffu) << (8 * j); }
                            w[d] = pk; }
                        *(u32x4*)((unsigned char*)ti.dst + (size_t)n8 * ti.dld + kc) = w; } }
                else if (sn < ti.nvalid) { f32x4 a, b;
#pragma unroll
                    for (int j = 0; j < 4; ++j) { a[j] = tl[(skc + j) * 65 + sn]; b[j] = tl[(skc + 4 + j) * 65 + sn]; }
                    pg8::st_bf16x8(ti.dst + (size_t)sn * ti.dld + skc, a, b); } } }
        __syncthreads();
    }
#undef TC_ISSUE
}
struct TcMat {
    const float* src; long src_ld; int tk, ncols; bf16_t* dst; long dst_ld; float qinv;
    __device__ __forceinline__ TcTile operator()(int t) const { const int k0 = (t % tk) * 64, n0 = (t / tk) * 64; TcTile ti;
        ti.src = src + (size_t)k0 * src_ld + n0; ti.sld = src_ld; ti.dst = qinv > 0.f ? (bf16_t*)((unsigned char*)dst + (size_t)n0 * dst_ld + k0) : dst + (size_t)n0 * dst_ld + k0; ti.dld = dst_ld; ti.nvalid = (ncols - n0) < 64 ? (ncols - n0) : 64; ti.qinv = qinv; return ti; }
};
__device__ __forceinline__ void tconv(const Frame& F, const float* src, long src_ld, int K, int ncols, bf16_t* dst, long dst_ld, int& rot) {
    TcMat d{src, src_ld, K >> 6, ncols, dst, dst_ld, 0.f}; tconv_run(F, (K >> 6) * ((ncols + 63) >> 6), d, rot);
}
struct TcExperts {
    const float* wg; const float* wu; const float* wd; unsigned char* dgu; unsigned char* ddn; float qinv, qinvd;
    __device__ __forceinline__ TcTile operator()(int t) const { const int e = t / 1536, r = t - e * 1536; TcTile ti; ti.nvalid = 64; ti.qinv = 0.f;
        if (r < 1024) { const int k0 = (r & 31) * 64, dt = r >> 5, jb = dt >> 2, gu = (dt >> 1) & 1, half = dt & 1;
            ti.src = (const float*)((unsigned long long)wg + (unsigned long long)gu * ((unsigned long long)wu - (unsigned long long)wg)) + (size_t)e * DM * DEXP + (size_t)k0 * DEXP + jb * 128 + half * 64; ti.sld = DEXP;
            ti.dst = (bf16_t*)(dgu + (size_t)e * 2048 * 2048 + (size_t)(dt * 64) * 2048 + k0); ti.dld = 2048; ti.qinv = qinv; }
        else { const int r2 = r - 1024, k0 = (r2 & 15) * 64, n0 = (r2 >> 4) * 64;
            ti.src = wd + (size_t)e * DEXP * DM + (size_t)k0 * DM + n0; ti.sld = DM;
            ti.dst = (bf16_t*)(ddn + (size_t)e * 2048 * 1024 + (size_t)n0 * 1024 + k0); ti.dld = 1024; ti.qinv = qinvd; }
        return ti; }
};
__device__ __forceinline__ void sample_wmax(const Frame& F) {
    unsigned* wm = (unsigned*)(F.ws + WS_CTL) + CW_WMAX;
#pragma unroll 1
    for (int l = 0; l < NLAYER; ++l) { float mx = 0.f;
#pragma unroll 1
        for (int which = 0; which < 2; ++which) { const f32x4* p = (const f32x4*)(F.in(which ? 17 : 15) + (size_t)l * NEXP * DM * DEXP);
            for (size_t i = (size_t)F.bid * 512 + F.tid; i < (size_t)NEXP * DM * DEXP / 4 / 64; i += (size_t)F.G * 512) { const f32x4 v = p[i * 64 + (i & 63)];
                mx = fmaxf(mx, fmaxf(fmaxf(fabsf(v[0]), fabsf(v[1])), fmaxf(fabsf(v[2]), fabsf(v[3])))); } }
        for (int o = 32; o > 0; o >>= 1) mx = fmaxf(mx, __shfl_xor(mx, o));
        if (F.lane == 0 && mx > 0.f) atomicMax(&wm[l], __float_as_uint(mx));
        float mg = 0.f; const f32x4* wi_ = (const f32x4*)(F.in(2) + (size_t)l * DM * INW);
        for (int i = F.bid * 512 + F.tid; i < DM * (INW / 4) / 16; i += F.G * 512) { const f32x4 v = wi_[(size_t)i * 16 + (i & 15)];
            mg = fmaxf(mg, fmaxf(fmaxf(fabsf(v[0]), fabsf(v[1])), fmaxf(fabsf(v[2]), fabsf(v[3])))); }
        for (int o = 32; o > 0; o >>= 1) mg = fmaxf(mg, __shfl_xor(mg, o));
        if (F.lane == 0 && mg > 0.f) atomicMax(&wm[CW_WMAXG - CW_WMAX + l], __float_as_uint(mg));
        float mp = 0.f; const f32x4* wp_ = (const f32x4*)(F.in(21) + (size_t)l * DM * DM);
        for (int i = F.bid * 512 + F.tid; i < DM * DM / 4 / 16; i += F.G * 512) { const f32x4 v = wp_[i * 16 + (i & 15)];
            mp = fmaxf(mp, fmaxf(fmaxf(fabsf(v[0]), fabsf(v[1])), fmaxf(fabsf(v[2]), fabsf(v[3])))); }
        for (int o = 32; o > 0; o >>= 1) mp = fmaxf(mp, __shfl_xor(mp, o));
        if (F.lane == 0 && mp > 0.f) atomicMax(&wm[CW_WMAXP - CW_WMAX + l], __float_as_uint(mp));
        float md = 0.f; const f32x4* wd_ = (const f32x4*)(F.in(19) + (size_t)l * NEXP * DEXP * DM);
        for (size_t i = (size_t)F.bid * 512 + F.tid; i < (size_t)NEXP * DEXP * DM / 4 / 64; i += (size_t)F.G * 512) { const f32x4 v = wd_[i * 64 + (i & 63)];
            md = fmaxf(md, fmaxf(fmaxf(fabsf(v[0]), fabsf(v[1])), fmaxf(fabsf(v[2]), fabsf(v[3])))); }
        for (int o = 32; o > 0; o >>= 1) md = fmaxf(md, __shfl_xor(md, o));
        if (F.lane == 0 && md > 0.f) atomicMax(&wm[CW_WMAXD - CW_WMAX + l], __float_as_uint(md)); }
}
__device__ __forceinline__ void conv_rows(const Frame& F, const float* src, bf16_t* dst, size_t n8) {
    for (size_t i = (size_t)F.bid * 512 + F.tid; i < n8; i += (size_t)F.G * 512) { const f32x4 a = *(const f32x4*)(src + i * 8), b = *(const f32x4*)(src + i * 8 + 4); pg8::st_bf16x8(dst + i * 8, a, b); }
}
__device__ __forceinline__ void quant_rows(const Frame& F, const float* src, bf16_t* xb, unsigned char* xq, float* xsc) {
    const int lane = F.lane;
    for (int tok = F.bid * 8 + F.wid; tok < NTOK; tok += F.G * 8) { f32x4 v[8]; float amax = 0.f;
#pragma unroll
        for (int i = 0; i < 4; ++i) { const int c = (i * 64 + lane) * 8; v[2 * i] = *(const f32x4*)(src + (size_t)tok * DM + c); v[2 * i + 1] = *(const f32x4*)(src + (size_t)tok * DM + c + 4);
            pg8::st_bf16x8(xb + (size_t)tok * DM + c, v[2 * i], v[2 * i + 1]);
#pragma unroll
            for (int h = 0; h < 2; ++h)
#pragma unroll
                for (int j = 0; j < 4; ++j) amax = fmaxf(amax, fabsf(v[2 * i + h][j])); }
        for (int o = 32; o > 0; o >>= 1) amax = fmaxf(amax, __shfl_xor(amax, o));
        amax = fmaxf(amax, 1e-20f); const float qi = 127.0f / amax; if (lane == 0) xsc[tok] = amax * (1.0f / 127.0f);
#pragma unroll
        for (int i = 0; i < 4; ++i) { u32x2 w;
#pragma unroll
            for (int h = 0; h < 2; ++h) { unsigned pk = 0u;
#pragma unroll
                for (int j = 0; j < 4; ++j) pk |= ((unsigned)(int)rintf(v[2 * i + h][j] * qi) & 0xffu) << (8 * j);
                w[h] = pk; }
            *(u32x2*)(xq + (size_t)tok * DM + (i * 64 + lane) * 8) = w; } }
}
__constant__ int c_so[14] = {0, 1312, 2416, 3440, 4464, 5496, 6520, 7544, 8568, 1024, 1280, 2336, 2400, 5488};
__constant__ int c_dn[14] = {0, 1024, 2048, 3072, 4096, 5120, 6144, 7168, 8192, 14336, 14592, 14624, 14688, 14704};
__constant__ int c_nc[14] = {1024, 1024, 1024, 1024, 1024, 1024, 1024, 1024, 6144, 256, 32, 64, 16, 8};
__device__ __forceinline__ void convert_layer_weights(const Frame& F0, const Params& P, int l) { const Frame F = fresh(F0);
    unsigned char* ws = F.ws; int rot = 0;
    { const float* w = F.in(2) + (size_t)l * DM * INW; bf16_t* d = (bf16_t*)(ws + W_IN);
      const float wmaxg = __uint_as_float(((const unsigned*)(ws + WS_CTL))[CW_WMAXG + l]); const float qinv = 127.0f / (1.3f * fmaxf(wmaxg, 1e-30f));
#pragma unroll 1
      for (int s = 0; s < 14; ++s) {
          if (s == 1 || s >= 10) tconv(F, w + c_so[s], INW, DM, c_nc[s], d + (size_t)c_dn[s] * DM, DM, rot);
          else { const int crow = (s == 0) ? 0 : (s <= 7 ? 1024 + (s - 2) * 1024 : (s == 8 ? 7168 : 13312));
              TcMat dq{w + c_so[s], INW, DM >> 6, c_nc[s], (bf16_t*)(ws + W_IN8 + (size_t)crow * 2048), 2048, qinv}; tconv_run(F, (DM >> 6) * (c_nc[s] >> 6), dq, rot); } } }
    tconv(F, F.in(7) + (size_t)l * 1024 * DM, DM, 1024, DM, (bf16_t*)(ws + W_BRA), 3072, rot);
    tconv(F, F.in(8) + (size_t)l * 1024 * DM, DM, 1024, DM, (bf16_t*)(ws + W_BRA) + 1024, 3072, rot);
    tconv(F, F.in(9) + (size_t)l * 1024 * DM, DM, 1024, DM, (bf16_t*)(ws + W_BRA) + 2048, 3072, rot);
    tconv(F, F.in(10) + (size_t)l * DM * DM, DM, DM, DM, (bf16_t*)(ws + W_OUT), DM, rot);
    { const float wmp = __uint_as_float(((const unsigned*)(ws + WS_CTL))[CW_WMAXP + l]);
      TcMat dq{F.in(21) + (size_t)l * DM * DM, DM, DM >> 6, DM, (bf16_t*)(ws + W_PG), 2048, 127.0f / (1.3f * fmaxf(wmp, 1e-30f))}; tconv_run(F, (DM >> 6) * (DM >> 6), dq, rot); }
    tconv(F, F.in(22) + (size_t)l * 256 * DM, DM, 256, DM, (bf16_t*)(ws + W_PLE), 256, rot);
#pragma unroll 1
    for (int h = 0; h < 8; ++h) tconv(F, F.in(6) + (size_t)l * 256 * 1024 + h * 128, 1024, 256, 128, (bf16_t*)(ws + W_UV2) + ((size_t)(h >> 1) * 256 + (h & 1) * 128) * 512 + (h & 1) * 256, 512, rot);
    { const float wmax = __uint_as_float(((const unsigned*)(ws + WS_CTL))[CW_WMAX + l]);
      const float wmaxd = __uint_as_float(((const unsigned*)(ws + WS_CTL))[CW_WMAXD + l]);
      TcExperts d{F.in(15) + (size_t)l * NEXP * DM * DEXP, F.in(17) + (size_t)l * NEXP * DM * DEXP, F.in(19) + (size_t)l * NEXP * DEXP * DM, (unsigned char*)(ws + W_GU), (unsigned char*)(ws + W_DN), 127.0f / (1.3f * fmaxf(wmax, 1e-30f)), 127.0f / (1.3f * fmaxf(wmaxd, 1e-30f))};
      tconv_run(F, NEXP * 1536, d, rot); }
    { const float* w = F.in(5) + (size_t)l * 256 * 8 * 96; bf16_t* d = (bf16_t*)(ws + W_UK2);
      for (int i = F.bid * 512 + F.tid; i < 256 * 8 * 96; i += F.G * 512) { const int n = i % 96, h = (i / 96) & 7, r = i / 768; d[((size_t)h * 256 + r) * 256 + (h & 1) * 128 + 32 + n] = f2bf(w[i]); } }
}

__device__ __forceinline__ void rope_cs(float pos, float invf, float& c, float& s) {
    const float a = pos * invf; const double ad = (double)a * 0.15915494309189535; const float fr = (float)(ad - rint(ad));
    s = __builtin_amdgcn_sinf(fr); c = __builtin_amdgcn_cosf(fr);
}
__device__ __forceinline__ void phase_prep(const Frame& F0, const Params& P, int l) { const Frame F = fresh(F0);
    unsigned char* ws = F.ws; const int lane = F.lane;
    const float* smallb = (const float*)(ws + R_SMALL); bf16_t* kcat = (bf16_t*)(ws + R_KCAT); bf16_t* qcat = (bf16_t*)(ws + R_QCAT);
    bf16_t* ki = (bf16_t*)(ws + R_KI); float* wi = (float*)(ws + R_WI); float* lf = (float*)(ws + WS_LF);
    const bf16_t* qa = (const bf16_t*)(ws + R_QA); bf16_t* qidx = (bf16_t*)(ws + R_QIDX);
    const f32x4 gck = *(const f32x4*)(F.in(4) + l * 256 + lane * 4);
    const float bfo = lane < 8 ? F.in(3)[l * 8 + lane] : 0.f;
    const float ifr = c_invf_r[lane & 15], ifi = c_invf_i[lane & 7];
    for (int tok = F.bid * 8 + F.wid; tok < NTOK; tok += F.G * 8) {
        const int s = tok & (SEQ - 1), b = tok >> 13; const float* sm = smallb + (size_t)tok * 512;
        float cr, sr, ci, si; rope_cs((float)s, ifr, cr, sr); rope_cs((float)s, ifi, ci, si);
        { const f32x4 v = *(const f32x4*)(sm + lane * 4); float ss = v[0] * v[0] + v[1] * v[1] + v[2] * v[2] + v[3] * v[3]; ss = wave_sum(ss);
          const float rs = rsqrtf(ss * (1.0f / 256.0f) + 1e-6f); u32x2 w; w.x = cvtpk(v[0] * rs * gck[0], v[1] * rs * gck[1]); w.y = cvtpk(v[2] * rs * gck[2], v[3] * rs * gck[3]);
          *(u32x2*)(kcat + (size_t)tok * 288 + lane * 4) = w; }
        if (lane < 16) { const float x1 = sm[256 + lane], x2 = sm[272 + lane]; kcat[(size_t)tok * 288 + 256 + lane] = f2bf(x1 * cr - x2 * sr); kcat[(size_t)tok * 288 + 272 + lane] = f2bf(x2 * cr + x1 * sr); }
        { float o = sm[288 + lane];
          if (lane < 8) { const float x2 = sm[296 + lane]; o = o * ci - x2 * si; } else if (lane < 16) { const float x1 = sm[288 + lane - 8]; o = o * ci + x1 * si; }
          ki[(size_t)tok * 64 + lane] = f2bf(o); }
        if (lane < 16) wi[(size_t)tok * 16 + lane] = sm[352 + lane] * (1.0f / 32.0f);
        if (lane < 8) { const float f = sm[368 + lane] + bfo; lf[(size_t)(b * 8 + lane) * SEQ + s] = fminf(f, 0.f) - log1pf(__expf(-fabsf(f))); }
#pragma unroll
        for (int pp = 0; pp < 2; ++pp) { const int p = lane + 64 * pp, h = p >> 4, i = p & 15;
            const float x1 = bf2f(qa[(size_t)tok * 1024 + h * 128 + i]), x2 = bf2f(qa[(size_t)tok * 1024 + h * 128 + 16 + i]);
            qcat[(size_t)tok * 2304 + h * 288 + 256 + i] = f2bf(x1 * cr - x2 * sr); qcat[(size_t)tok * 2304 + h * 288 + 272 + i] = f2bf(x2 * cr + x1 * sr); }
#pragma unroll
        for (int pp = 0; pp < 2; ++pp) { const int p = lane + 64 * pp, hh = p >> 3, i = p & 7; bf16_t* q = qidx + (size_t)tok * 1024 + hh * 64;
            const float x1 = bf2f(q[i]), x2 = bf2f(q[8 + i]); q[i] = f2bf(x1 * ci - x2 * si); q[8 + i] = f2bf(x2 * ci + x1 * si); }
    }
    { const bf16_t* kbt = (const bf16_t*)(ws + R_QKV) + (size_t)NTOK * 1024; unsigned* kmx = (unsigned*)(ws + WS_CTL) + CW_KMAX + l * 16;
#pragma unroll 1
      for (int bh = 0; bh < 16; ++bh) { float mx = 0.f;
          for (int r0 = (F.bid * 8 + F.wid) * 4; r0 < SEQ; r0 += F.G * 32) {
              const u32x4 w = *(const u32x4*)(kbt + ((size_t)bh * SEQ + r0 + (lane >> 4)) * 128 + (lane & 15) * 8);
              float ss = bflo(w.x) * bflo(w.x) + bfhi(w.x) * bfhi(w.x) + bflo(w.y) * bflo(w.y) + bfhi(w.y) * bfhi(w.y) + bflo(w.z) * bflo(w.z) + bfhi(w.z) * bfhi(w.z) + bflo(w.w) * bflo(w.w) + bfhi(w.w) * bfhi(w.w);
              ss += __shfl_xor(ss, 1); ss += __shfl_xor(ss, 2); ss += __shfl_xor(ss, 4); ss += __shfl_xor(ss, 8); mx = fmaxf(mx, ss); }
          mx = fmaxf(mx, __shfl_xor(mx, 16)); mx = fmaxf(mx, __shfl_xor(mx, 32));
          if (lane == 0) ((float*)F.lds)[F.wid * 16 + bh] = mx; }
      __syncthreads();
      if (F.tid < 16) { float mx = 0.f;
#pragma unroll
          for (int w = 0; w < 8; ++w) mx = fmaxf(mx, ((const float*)F.lds)[w * 16 + F.tid]);
          const unsigned bits = __float_as_uint(mx);
          if (bits > __hip_atomic_load(&kmx[F.tid], __ATOMIC_RELAXED, __HIP_MEMORY_SCOPE_AGENT)) atomicMax(&kmx[F.tid], bits); }
      __syncthreads(); }
}
__device__ __forceinline__ void phase_cumsum(const Frame& F0) { const Frame F = fresh(F0);
    const int gw = F.bid * 8 + F.wid; if (gw >= 16) return;
    const float* lf = (const float*)(F.ws + WS_LF) + (size_t)gw * SEQ; float* cum = (float*)(F.ws + WS_CUM) + (size_t)gw * SEQ;
    const int lane = F.lane; double tot = 0.0;
    for (int j = 0; j < 128; ++j) tot += (double)lf[lane * 128 + j];
    double inc = tot;
    for (int o = 1; o < 64; o <<= 1) { const double n = __shfl_up(inc, o); if (lane >= o) inc += n; }
    double run = inc - tot;
    for (int j = 0; j < 128; ++j) { run += (double)lf[lane * 128 + j]; cum[lane * 128 + j] = (float)run; }
}

__device__ __forceinline__ void idx_unit(const Frame& F, int b, int pi, int half) {
    const int tid = F.tid, lane = F.lane, rho = lane & 31, hh = lane >> 5; unsigned char* ws = F.ws;
    const bf16_t* qidx = (const bf16_t*)(ws + R_QIDX); const bf16_t* ki = (const bf16_t*)(ws + R_KI) + (size_t)b * SEQ * 64; const float* wi = (const float*)(ws + R_WI);
    float* scores = (float*)(ws + R_SCORES) + (size_t)b * SEQ * SEQ;
    LAS unsigned char* kl = F.ldsl;
    const int gl = pi, gh = 127 - pi, nl = (64 * gl + 63) / 128 + 1, nh = (64 * gh + 63) / 128 + 1, tot = nl + nh;
    const int x0 = half ? tot / 2 : 0, x1 = half ? tot : tot / 2;
    bf16x8 af[4][4]; float wv[4][16]; int t0 = 0, curg = -1;
    const int r0 = tid >> 3, p0 = tid & 7;
    const unsigned d0 = (unsigned)(r0 * 128 + ((p0 ^ (r0 & 7)) << 4)), d1 = d0 + 64 * 128;
    u32x4 s0, s1;
    { const int c = x0 < nl ? x0 : x0 - nl; const bf16_t* kp = ki + (size_t)(c * 128) * 64; s0 = *(const u32x4*)(kp + (size_t)r0 * 64 + p0 * 8); s1 = *(const u32x4*)(kp + (size_t)(r0 + 64) * 64 + p0 * 8); }
    __syncthreads();
    *(LAS u32x4*)(kl + d0) = s0; *(LAS u32x4*)(kl + d1) = s1;
    __syncthreads();
    const unsigned rdo = (unsigned)(rho * 128);
#pragma unroll 1
    for (int x = x0; x < x1; ++x) {
        const int g = x < nl ? gl : gh, c = x < nl ? x : x - nl;
        if (g != curg) { curg = g; t0 = g * 64 + F.wid * 8;
#pragma unroll
            for (int mt = 0; mt < 4; ++mt) {
                const int tokA = b * SEQ + t0 + 2 * mt + ((rho >> 2) & 1), head = (rho & 3) + 4 * (rho >> 3);
#pragma unroll
                for (int kk = 0; kk < 4; ++kk) af[mt][kk] = *(const bf16x8*)(qidx + (size_t)tokA * 1024 + head * 64 + kk * 16 + 8 * hh);
                const float* wp = wi + (size_t)(b * SEQ + t0 + 2 * mt + hh) * 16;
#pragma unroll
                for (int q = 0; q < 4; ++q) { const f32x4 v = *(const f32x4*)(wp + 4 * q); wv[mt][4 * q] = v[0]; wv[mt][4 * q + 1] = v[1]; wv[mt][4 * q + 2] = v[2]; wv[mt][4 * q + 3] = v[3]; } } }
        const unsigned bo = (unsigned)((x - x0) & 1) * 16384u;
        if (x + 1 < x1) { const int cn = (x + 1) < nl ? (x + 1) : (x + 1) - nl; const bf16_t* kp = ki + (size_t)(cn * 128) * 64; s0 = *(const u32x4*)(kp + (size_t)r0 * 64 + p0 * 8); s1 = *(const u32x4*)(kp + (size_t)(r0 + 64) * 64 + p0 * 8); }
#pragma unroll
        for (int tl = 0; tl < 4; ++tl) {
            const int kb = c * 128 + tl * 32;
            if (kb <= t0 + 7) {
                bf16x8 bc[4];
#pragma unroll
                for (int kk = 0; kk < 4; ++kk) bc[kk] = *(const LAS bf16x8*)(kl + bo + tl * 4096 + rdo + (((kk * 2 + hh) ^ (rho & 7)) << 4));
                f32x16 a0 = {}, a1 = {}, a2 = {}, a3 = {};
#pragma unroll
                for (int kk = 0; kk < 4; ++kk) { a0 = __builtin_amdgcn_mfma_f32_32x32x16_bf16(af[0][kk], bc[kk], a0, 0, 0, 0); a1 = __builtin_amdgcn_mfma_f32_32x32x16_bf16(af[1][kk], bc[kk], a1, 0, 0, 0);
                                                  a2 = __builtin_amdgcn_mfma_f32_32x32x16_bf16(af[2][kk], bc[kk], a2, 0, 0, 0); a3 = __builtin_amdgcn_mfma_f32_32x32x16_bf16(af[3][kk], bc[kk], a3, 0, 0, 0); }
#define IDX_EPI(A_, mt_) do { float x_0 = 0.f, x_1 = 0.f, x_2 = 0.f, x_3 = 0.f; _Pragma("unroll") for (int r = 0; r < 16; r += 4) { \
                    x_0 = fmaf(wv[mt_][r], fmaxf(A_[r], 0.f), x_0); x_1 = fmaf(wv[mt_][r + 1], fmaxf(A_[r + 1], 0.f), x_1); x_2 = fmaf(wv[mt_][r + 2], fmaxf(A_[r + 2], 0.f), x_2); x_3 = fmaf(wv[mt_][r + 3], fmaxf(A_[r + 3], 0.f), x_3); } \
                    scores[(size_t)(t0 + 2 * (mt_) + hh) * SEQ + kb + rho] = (x_0 + x_1) + (x_2 + x_3); } while (0)
                IDX_EPI(a0, 0); IDX_EPI(a1, 1); IDX_EPI(a2, 2); IDX_EPI(a3, 3);
#undef IDX_EPI
            }
        }
        if (x + 1 < x1) { *(LAS u32x4*)(kl + (bo ^ 16384u) + d0) = s0; *(LAS u32x4*)(kl + (bo ^ 16384u) + d1) = s1; }
        __syncthreads();
    }
}
__device__ __forceinline__ void phase_idx(const Frame& F0) { const Frame F = fresh(F0);
#pragma unroll 1
    for (int it = F.bid; it < 256; it += F.G) { const int b = it >> 7, pi = (it >> 1) & 63, half = it & 1; idx_unit(F, b, pi, half); }
}

__device__ __forceinline__ unsigned sortable(float f) { const unsigned u = __float_as_uint(f); return (u & 0x80000000u) ? ~u : (u | 0x80000000u); }
__device__ __forceinline__ void topk_row(const Frame& F, int b, int t) {
    int lane = F.lane; asm volatile("" : "+v"(lane));
    const int L = t + 1, tok = b * SEQ + t; unsigned char* ws = F.ws;
    int* sel = (int*)(ws + R_SEL) + (size_t)tok * 256; int* nsel = (int*)(ws + R_NSEL);
    if (lane == 0) nsel[tok] = L < 256 ? L : 256;
    if (L <= 256) { for (int j = lane; j < 256; j += 64) sel[j] = j < L ? j : 0; return; }
    const float* row = (const float*)(ws + R_SCORES) + ((size_t)b * SEQ + t) * SEQ;
    const int nch = (L + 1023) >> 10;
#define TOPK_LOAD_ROW() do { _Pragma("unroll") for (int c = 0; c < 8; ++c) { \
        if (c < nch) { _Pragma("unroll") for (int jj = 0; jj < 4; ++jj) { const int j = c * 4 + jj; const f32x4 v = *(const f32x4*)(row + j * 256 + lane * 4); \
                _Pragma("unroll") for (int e_ = 0; e_ < 4; ++e_) { const int idx = j * 256 + lane * 4 + e_; u[j * 4 + e_] = idx < L ? sortable(v[e_]) : 0u; } } } \
        else { _Pragma("unroll") for (int q = 0; q < 16; ++q) u[c * 16 + q] = 0u; } } } while (0)
    unsigned u[128];
    TOPK_LOAD_ROW();
    unsigned g0 = 0u, g1 = 0u, g2 = 0u, g3 = 0u;
#pragma unroll
    for (int c = 0; c < 8; ++c) if (c < nch) {
#pragma unroll
        for (int jj = 0; jj < 4; ++jj) { const int j = c * 4 + jj; g0 = u[4 * j] > g0 ? u[4 * j] : g0; g1 = u[4 * j + 1] > g1 ? u[4 * j + 1] : g1; g2 = u[4 * j + 2] > g2 ? u[4 * j + 2] : g2; g3 = u[4 * j + 3] > g3 ? u[4 * j + 3] : g3; } }
    unsigned tl = g0 < g1 ? g0 : g1; { const unsigned t2 = g2 < g3 ? g2 : g3; tl = tl < t2 ? tl : t2; }
#pragma unroll
    for (int o = 32; o > 0; o >>= 1) { const unsigned x = (unsigned)__shfl_xor((int)tl, o); tl = x < tl ? x : tl; }
    constexpr int CAP = 2048;
    LAS unsigned* candk = (LAS unsigned*)(F.ldsl + F.wid * (CAP * 8)); LAS unsigned* candi = candk + CAP;
    int C = 0;
#pragma unroll
    for (int c = 0; c < 8; ++c) if (c < nch) {
#pragma unroll
        for (int q = 0; q < 16; ++q) { const int rq = c * 16 + q; const bool pr = u[rq] >= tl; const unsigned long long mm = __ballot(pr);
            const int pos = C + __popcll(mm & ((1ull << lane) - 1ull));
            if (pr && pos < CAP) { candk[pos] = u[rq]; candi[pos] = (unsigned)((rq >> 2) * 256 + lane * 4 + (rq & 3)); }
            C += __popcll(mm); if ((q & 3) == 3) SBAR(); } }
    if (C <= CAP) {
        const int ng = (C + 255) >> 8;
        unsigned ck[32]; int ci[32];
#pragma unroll
        for (int g = 0; g < 8; ++g) {
#pragma unroll
            for (int q = 0; q < 4; ++q) { const int r = g * 4 + q, p = r * 64 + lane; ck[r] = 0u; ci[r] = 0;
                if (g < ng && p < C) { ck[r] = candk[p]; ci[r] = (int)candi[p]; } } }
        unsigned T = 0u, thr_gt = 0u; int need_eq = 0; bool early = false;
        for (int bit = 31; bit >= 0; --bit) {
            const unsigned cnd = T | (1u << bit); int cnt = 0;
#pragma unroll
            for (int g = 0; g < 8; ++g) if (g < ng) {
#pragma unroll
                for (int q = 0; q < 4; ++q) cnt += __popcll(__ballot(ck[g * 4 + q] >= cnd)); }
            if (cnt >= 256) { T = cnd; if (cnt == 256) { early = true; break; } }
        }
        if (early) { thr_gt = T - 1u; need_eq = 0; }
        else { int gtc = 0;
#pragma unroll
            for (int g = 0; g < 8; ++g) if (g < ng) {
#pragma unroll
                for (int q = 0; q < 4; ++q) gtc += __popcll(__ballot(ck[g * 4 + q] > T)); }
            thr_gt = T; need_eq = 256 - gtc; }
        int base = 0, eq_taken = 0;
#pragma unroll
        for (int g = 0; g < 8; ++g) if (g < ng) {
#pragma unroll
            for (int q = 0; q < 4; ++q) { const int r = g * 4 + q; const unsigned v = ck[r];
                const bool iseq = (v == thr_gt) && (need_eq > 0);
                const unsigned long long meq = __ballot(iseq);
                const int eqr = __popcll(meq & ((1ull << lane) - 1ull));
                const bool take = (v > thr_gt) || (iseq && (eq_taken + eqr < need_eq));
                const unsigned long long mt = __ballot(take);
                const int pos = base + __popcll(mt & ((1ull << lane) - 1ull));
                if (take && pos < 256) sel[pos] = ci[r];
                base += __popcll(mt); eq_taken += __popcll(meq); } }
        return;
    }
    asm volatile("" ::: "memory");
    TOPK_LOAD_ROW();
    unsigned T = 0u, thr_gt = 0u; int need_eq = 0; bool early = false;
    for (int bit = 31; bit >= 0; --bit) {
        const unsigned cand = T | (1u << bit); int cnt = 0;
#pragma unroll
        for (int c = 0; c < 8; ++c) if (c < nch) {
#pragma unroll
            for (int q = 0; q < 16; ++q) cnt += __popcll(__ballot(u[c * 16 + q] >= cand)); }
        if (cnt >= 256) { T = cand; if (cnt == 256) { early = true; break; } }
    }
    if (early) { thr_gt = T - 1u; need_eq = 0; }
    else { int gtc = 0;
#pragma unroll
        for (int c = 0; c < 8; ++c) if (c < nch) {
#pragma unroll
            for (int q = 0; q < 16; ++q) gtc += __popcll(__ballot(u[c * 16 + q] > T)); }
        thr_gt = T; need_eq = 256 - gtc; }
    int base = 0, eq_taken = 0;
#pragma unroll
    for (int c = 0; c < 8; ++c) if (c < nch) {
#pragma unroll
        for (int q = 0; q < 16; ++q) { const int rq = c * 16 + q; const unsigned v = u[rq];
            const bool iseq = (v == thr_gt) && (need_eq > 0);
            const unsigned long long meq = __ballot(iseq);
            const int eqr = __popcll(meq & ((1ull << lane) - 1ull));
            const bool take = (v > thr_gt) || (iseq && (eq_taken + eqr < need_eq));
            const unsigned long long mt = __ballot(take);
            const int pos = base + __popcll(mt & ((1ull << lane) - 1ull));
            if (take && pos < 256) sel[pos] = (rq >> 2) * 256 + lane * 4 + (rq & 3);
            base += __popcll(mt); eq_taken += __popcll(meq); } }
}
__device__ __forceinline__ void phase_topk(const Frame& F0) { const Frame F = fresh(F0);
    for (int q = F.bid * 8 + F.wid; q < 8192; q += F.G * 8) { const int b = q >> 12, p = q & 4095; topk_row(F, b, p); topk_row(F, b, SEQ - 1 - p); }
}

namespace att {
constexpr int D = 128, KVBLK = 64, QBLK = 32, SHM_V = 16384, SHM_K = 16384;
constexpr int OFF_K = 2 * SHM_V, OFF_BIAS = 2 * SHM_V + 2 * SHM_K, OFF_WS = OFF_BIAS + 512, OFF_FLAGS = OFF_WS + 2048, OFF_QITEM = OFF_FLAGS + 64;
constexpr float EXIT_T = 44.0f;
#define KSWZ(row, colB) ((row) * 256 + ((colB) ^ (((row) & 7) << 4)))
__device__ __forceinline__ int v_st(int k, int c) { const int kk = (k & ~0xC) | ((k & 4) << 1) | ((k & 8) >> 1); return ((kk >> 3) * 4 + (c >> 5)) * 512 + ((kk & 7) * 32 + (c & 31)) * 2; }
__device__ __forceinline__ int v_rd_base(int lane) { return ((lane & 3) << 3) | (((lane >> 2) & 3) << 6) | (((lane >> 4) & 1) << 5) | (((lane >> 5) & 1) << 8); }
constexpr int v_rd_off(int d0, int ks, int half) { return d0 * 512 + ks * 4096 + half * 2048; }
template <int KB>
__device__ __forceinline__ void qkt(f32x16& p0, f32x16& p1, const char* K_lds, int r32, int hi, const bf16x8* qr) {
    p0 = f32x16{}; p1 = f32x16{};
    const char* kb[4];
#pragma unroll
    for (int dd = 0; dd < 4; ++dd) kb[dd] = K_lds + KB * SHM_K + KSWZ(r32, (dd * 16 + hi * 8) * 2);
#pragma unroll
    for (int d0 = 0; d0 < 8; ++d0) { const char* a = kb[d0 & 3] + (d0 >> 2) * 128;
        bf16x8 b0 = *reinterpret_cast<const bf16x8*>(a);
        bf16x8 b1 = *reinterpret_cast<const bf16x8*>(a + 32 * 256);
        p0 = __builtin_amdgcn_mfma_f32_32x32x16_bf16(b0, qr[d0], p0, 0, 0, 0);
        p1 = __builtin_amdgcn_mfma_f32_32x32x16_bf16(b1, qr[d0], p1, 0, 0, 0); }
}
template <int VB>
__device__ __forceinline__ void pv_tile(f32x16* o, int vb0, bf16x8 pa0, bf16x8 pa1, bf16x8 pa2, bf16x8 pa3) {
#define TRRD(dst, off) asm volatile("ds_read_b64_tr_b16 %0, %1 offset:%2" : "=&v"(dst) : "v"(vb0), "i"(off) : "memory")
#define PV_D0(d0) do { s16x4 l0, l1, l2, l3, h0, h1, h2, h3; constexpr int b_ = VB * SHM_V + v_rd_off(d0, 0, 0); \
        TRRD(l0, b_); TRRD(h0, b_ + 2048); TRRD(l1, b_ + 4096); TRRD(h1, b_ + 6144); TRRD(l2, b_ + 8192); TRRD(h2, b_ + 10240); TRRD(l3, b_ + 12288); TRRD(h3, b_ + 14336); \
        asm volatile("s_waitcnt lgkmcnt(0)" ::: "memory"); SBAR(); \
        o[d0] = __builtin_amdgcn_mfma_f32_32x32x16_bf16(pa0, (bf16x8){l0[0], l0[1], l0[2], l0[3], h0[0], h0[1], h0[2], h0[3]}, o[d0], 0, 0, 0); \
        o[d0] = __builtin_amdgcn_mfma_f32_32x32x16_bf16(pa1, (bf16x8){l1[0], l1[1], l1[2], l1[3], h1[0], h1[1], h1[2], h1[3]}, o[d0], 0, 0, 0); \
        o[d0] = __builtin_amdgcn_mfma_f32_32x32x16_bf16(pa2, (bf16x8){l2[0], l2[1], l2[2], l2[3], h2[0], h2[1], h2[2], h2[3]}, o[d0], 0, 0, 0); \
        o[d0] = __builtin_amdgcn_mfma_f32_32x32x16_bf16(pa3, (bf16x8){l3[0], l3[1], l3[2], l3[3], h3[0], h3[1], h3[2], h3[3]}, o[d0], 0, 0, 0); } while (0)
    PV_D0(0); PV_D0(1); PV_D0(2); PV_D0(3);
#undef PV_D0
#undef TRRD
}
#define PK4(P, B_, OUT) do { unsigned a0 = cvtpk(P[B_+0], P[B_+1]), a1 = cvtpk(P[B_+2], P[B_+3]); \
        unsigned b0 = cvtpk(P[B_+4], P[B_+5]), b1 = cvtpk(P[B_+6], P[B_+7]); \
        auto r0 = __builtin_amdgcn_permlane32_swap(a0, b0, false, false); auto r1 = __builtin_amdgcn_permlane32_swap(a1, b1, false, false); \
        u32x4 w = {r0[0], r1[0], r0[1], r1[1]}; OUT = *reinterpret_cast<bf16x8*>(&w); } while (0)
__device__ __forceinline__ float swap_max(float x) { auto rr = __builtin_amdgcn_permlane32_swap(__float_as_uint(x), __float_as_uint(x), false, false); return fmaxf(__uint_as_float(rr[0]), __uint_as_float(rr[1])); }
__device__ __forceinline__ float swap_sum(float x) { auto rr = __builtin_amdgcn_permlane32_swap(__float_as_uint(x), __float_as_uint(x), false, false); return __uint_as_float(rr[0]) + __uint_as_float(rr[1]); }
__device__ __forceinline__ float swap_lo(float x) { auto rr = __builtin_amdgcn_permlane32_swap(__float_as_uint(x), __float_as_uint(x), false, false); return __uint_as_float(rr[0]); }


__device__ __forceinline__ void fox_sm(f32x16& p0, f32x16& p1, const float* bl, int kb_, int qlo, int qrow, int hi, int r32, float& m_reg, float& l_reg, f32x16* o, float* al_l,
                                       bf16x8& pa0, bf16x8& pa1, bf16x8& pa2, bf16x8& pa3) {
#pragma unroll
    for (int g = 0; g < 4; ++g) { const f32x4 b0v = *(const f32x4*)(bl + 8 * g + 4 * hi), b1v = *(const f32x4*)(bl + 32 + 8 * g + 4 * hi);
#pragma unroll
        for (int i = 0; i < 4; ++i) { p0[4 * g + i] = fmaf(p0[4 * g + i], C2, b0v[i]); p1[4 * g + i] = fmaf(p1[4 * g + i], C2, b1v[i]); } }
    if (kb_ + KVBLK - 1 > qlo) { const float NEG = -__builtin_inff();
#pragma unroll
        for (int r = 0; r < 16; ++r) { const int key = kb_ + crow(r, hi); if (key > qrow) p0[r] = NEG; if (key + 32 > qrow) p1[r] = NEG; } }
    float pmax = p0[0];
#pragma unroll
    for (int r = 1; r < 16; ++r) pmax = fmaxf(pmax, p0[r]);
#pragma unroll
    for (int r = 0; r < 16; ++r) pmax = fmaxf(pmax, p1[r]);
    pmax = swap_max(pmax);
    const float mn = fmaxf(m_reg, pmax), alpha = __builtin_amdgcn_exp2f(m_reg - mn); m_reg = mn;
    float ps = 0.f;
#pragma unroll
    for (int r = 0; r < 16; ++r) { p0[r] = __builtin_amdgcn_exp2f(p0[r] - mn); p1[r] = __builtin_amdgcn_exp2f(p1[r] - mn); ps += p0[r] + p1[r]; }
    ps = swap_sum(ps); l_reg = l_reg * alpha + ps;
    if (__any(alpha < 1.f)) { if (hi == 0) al_l[r32] = alpha; asm volatile("s_waitcnt lgkmcnt(0)" ::: "memory");
#pragma unroll
        for (int r = 0; r < 16; ++r) { const float a = al_l[crow(r, hi)];
#pragma unroll
            for (int d_ = 0; d_ < 4; ++d_) o[d_][r] *= a; } }
    PK4(p0, 0, pa0); PK4(p0, 8, pa1); PK4(p1, 0, pa2); PK4(p1, 8, pa3);
}
__device__ __forceinline__ void sb_half(f32x16& pz, int keybase, int qrow, int hi, float& R, const bf16x8* triA, bool needmask) {
    f32x16 X;
#pragma unroll
    for (int r = 0; r < 16; ++r) { const float zz = pz[r] * C2; const bool valid = !needmask || (keybase + crow(r, hi) < qrow);
        const float l2 = fmaxf(zz, 0.f) + __builtin_amdgcn_logf(1.0f + __builtin_amdgcn_exp2f(-fabsf(zz)));
        X[r] = valid ? -l2 : 0.f; pz[r] = valid ? zz : -__builtin_inff(); }
    f32x16 Y;
#pragma unroll
    for (int r = 0; r < 16; ++r) Y[r] = R;
#pragma unroll
    for (int s = 0; s < 2; ++s) {
        const unsigned h0 = cvtpk(X[8 * s + 0], X[8 * s + 1]), h1 = cvtpk(X[8 * s + 2], X[8 * s + 3]), h2 = cvtpk(X[8 * s + 4], X[8 * s + 5]), h3 = cvtpk(X[8 * s + 6], X[8 * s + 7]);
        const unsigned l0 = cvtpk(X[8 * s + 0] - bflo(h0), X[8 * s + 1] - bfhi(h0)), l1 = cvtpk(X[8 * s + 2] - bflo(h1), X[8 * s + 3] - bfhi(h1));
        const unsigned l2 = cvtpk(X[8 * s + 4] - bflo(h2), X[8 * s + 5] - bfhi(h2)), l3 = cvtpk(X[8 * s + 6] - bflo(h3), X[8 * s + 7] - bfhi(h3));
        u32x4 wh = {h0, h1, h2, h3}, wl = {l0, l1, l2, l3};
        Y = __builtin_amdgcn_mfma_f32_32x32x16_bf16(triA[s], *reinterpret_cast<bf16x8*>(&wh), Y, 0, 0, 0);
        Y = __builtin_amdgcn_mfma_f32_32x32x16_bf16(triA[s], *reinterpret_cast<bf16x8*>(&wl), Y, 0, 0, 0); }
#pragma unroll
    for (int r = 0; r < 16; ++r) pz[r] = __builtin_amdgcn_exp2f(pz[r] + Y[r]);
    R = swap_lo(Y[0]);
}
__device__ __forceinline__ void sb_sm(f32x16& p0, f32x16& p1, int kb_, int qlo, int qrow, int hi, float& R, const bf16x8* triA, bf16x8& pa0, bf16x8& pa1, bf16x8& pa2, bf16x8& pa3) {
    const bool needmask = (kb_ + KVBLK - 1 >= qlo);
    sb_half(p1, kb_ + 32, qrow, hi, R, triA, needmask);
    sb_half(p0, kb_, qrow, hi, R, triA, needmask);
    PK4(p0, 0, pa0); PK4(p0, 8, pa1); PK4(p1, 0, pa2); PK4(p1, 8, pa3);
}

template <int MODE>
__device__ __forceinline__ void attn_unit(const bf16_t* Q, const bf16_t* Kh, const bf16_t* Vh, const float* cum, bf16_t* O, int P0, char* lds, float kmaxc) {
    int tid = threadIdx.x; asm volatile("" : "+v"(tid));
    const int wid = __builtin_amdgcn_readfirstlane(tid >> 6), lane = tid & 63, r32 = lane & 31, hi = lane >> 5;
    const int NT = P0 / KVBLK + 4;
    char* V_lds = lds; char* K_lds = lds + OFF_K; float* bias_l = (float*)(lds + OFF_BIAS);
    float* wsl = (float*)(lds + OFF_WS) + wid * 64; float* li_l = wsl; float* al_l = wsl + 32;
    const int qlo = P0 + wid * QBLK, qrow = qlo + r32;
    bf16x8 qr[8];
#pragma unroll
    for (int d0 = 0; d0 < 8; ++d0) qr[d0] = *(const bf16x8*)(Q + (size_t)qrow * D + d0 * 16 + hi * 8);
    const int sr = tid >> 4, sc = (tid & 15) * 8, vst0 = v_st(sr, sc), vst1 = v_st(32 + sr, sc), kws = KSWZ(sr, sc * 2);
    const int vb0 = (int)(uintptr_t)V_lds + v_rd_base(lane);
    const float cumref = (MODE == 0) ? cum[P0] : 0.f;
    int* flg = (int*)(lds + OFF_FLAGS);
    float qn = 0.f;
    if (MODE == 0) { float ss = 0.f;
#pragma unroll
        for (int d0 = 0; d0 < 8; ++d0)
#pragma unroll
            for (int j = 0; j < 8; ++j) { const float x = bf2f((bf16_t)qr[d0][j]); ss = fmaf(x, x, ss); }
        ss = swap_sum(ss); qn = sqrtf(ss) * kmaxc * 1.001f; }
    float m_reg = -1e30f, l_reg = 0.f, R = 0.f; f32x16 o[4] = {};
    bf16x8 triA[2];
    if (MODE == 1) {
#pragma unroll
        for (int s = 0; s < 2; ++s)
#pragma unroll
            for (int j = 0; j < 8; ++j) { const int rho = 16 * s + 8 * (j >> 2) + 4 * hi + (j & 3); triA[s][j] = (rho >= r32) ? (short)0x3F80 : (short)0; }
    }
    bf16x8 st_k0, st_k1, st_v0, st_v1; float st_b = 0.f;
#define TILE_KB(t) ((NT - 1 - (t)) * KVBLK)
#define SLOAD(kb_) do { st_v0 = *(const bf16x8*)(Vh + (size_t)((kb_) + sr) * D + sc); st_v1 = *(const bf16x8*)(Vh + (size_t)((kb_) + 32 + sr) * D + sc); \
                        st_k0 = *(const bf16x8*)(Kh + (size_t)((kb_) + sr) * D + sc); st_k1 = *(const bf16x8*)(Kh + (size_t)((kb_) + 32 + sr) * D + sc); \
                        if (MODE == 0 && tid < 64) st_b = (cumref - cum[(kb_) + tid]) * LOG2E; } while (0)
#define SWRITE(bf) do { *(bf16x8*)(V_lds + (bf) * SHM_V + vst0) = st_v0; *(bf16x8*)(V_lds + (bf) * SHM_V + vst1) = st_v1; \
                        *(bf16x8*)(K_lds + (bf) * SHM_K + kws) = st_k0; *(bf16x8*)(K_lds + (bf) * SHM_K + kws + 32 * 256) = st_k1; \
                        if (MODE == 0 && tid < 64) bias_l[(bf) * 64 + tid] = st_b; } while (0)
    __syncthreads();
    SLOAD(TILE_KB(0)); SWRITE(0);
    __syncthreads();
    f32x16 p0, p1; bf16x8 pa0, pa1, pa2, pa3;
#define STEP(BUF, t) do { const int kb_ = TILE_KB(t); \
        if ((t) + 1 < NT) SLOAD(TILE_KB((t) + 1)); \
        SBAR(); qkt<BUF>(p0, p1, K_lds, r32, hi, qr); \
        if (MODE == 0) fox_sm(p0, p1, bias_l + (BUF) * 64, kb_, qlo, qrow, hi, r32, m_reg, l_reg, o, al_l, pa0, pa1, pa2, pa3); \
        else sb_sm(p0, p1, kb_, qlo, qrow, hi, R, triA, pa0, pa1, pa2, pa3); \
        SBAR(); pv_tile<BUF>(o, vb0, pa0, pa1, pa2, pa3); \
        if ((t) + 1 < NT) SWRITE((BUF) ^ 1); \
        __syncthreads(); } while (0)
    for (int t = 0; t < NT; t += 2) {
        STEP(0, t); STEP(1, t + 1);
        const int kbc = TILE_KB(t + 1); if (kbc == 0) break;
        bool done;
        if (MODE == 0) { const float edge = (cumref - cum[kbc - 1]) * LOG2E; done = (qn + edge - m_reg) < -EXIT_T; }
        else done = R < -EXIT_T;
        const int par = (t >> 1) & 1;
        if (lane == 0) flg[par * 8 + wid] = 0;
        const bool wdone = __all(done);
        if (lane == 0 && wdone) flg[par * 8 + wid] = 1;
        __syncthreads();
        int alld = 1;
#pragma unroll
        for (int w = 0; w < 8; ++w) alld &= flg[par * 8 + w];
        if (alld) break;
    }
    __syncthreads();
#undef STEP
#undef SLOAD
#undef SWRITE
#undef TILE_KB
    float rli[16];
    if (MODE == 0) { if (hi == 0) li_l[r32] = l_reg; asm volatile("s_waitcnt lgkmcnt(0)" ::: "memory");
#pragma unroll
        for (int r = 0; r < 16; ++r) rli[r] = __builtin_amdgcn_rcpf(li_l[crow(r, hi)]); }
    bf16_t* Ow = O + (size_t)(wid * QBLK) * 3072;
#pragma unroll
    for (int r = 0; r < 16; ++r) { const int orow = crow(r, hi);
#pragma unroll
        for (int d0 = 0; d0 < 4; ++d0) { const float v = (MODE == 0) ? o[d0][r] * rli[r] : o[d0][r];
            const float vn = __shfl_xor(v, 1);
            if ((r32 & 1) == 0) *(unsigned*)(Ow + (size_t)orow * 3072 + d0 * 32 + r32) = cvtpk(v, vn); } }
}
}

__device__ __forceinline__ void sparse_query(const Frame& F, int tok, char* ldsw) {
    unsigned char* ws = F.ws; const int lane = F.lane, g = lane >> 4, i16 = lane & 15;
    const bf16_t* qcat = (const bf16_t*)(ws + R_QCAT) + (size_t)tok * 2304; const bf16_t* kbase = (const bf16_t*)(ws + R_KCAT) + (size_t)(tok >> 13) * SEQ * 288;
    const int* sel = (const int*)(ws + R_SEL) + (size_t)tok * 256; const int ns = ((const int*)(ws + R_NSEL))[tok]; const int ntile = (ns + 31) >> 5;
    bf16x8 qf[9];
#pragma unroll
    for (int st = 0; st < 9; ++st) { qf[st] = (bf16x8){0, 0, 0, 0, 0, 0, 0, 0}; if (i16 < 8) qf[st] = *(const bf16x8*)(qcat + i16 * 288 + st * 32 + 8 * g); }
    const int rA = lane >> 2, cq = lane & 3;
    float m = -1e30f, l = 0.f; f32x4 oT[16];
#pragma unroll
    for (int rb = 0; rb < 16; ++rb) oT[rb] = (f32x4){0.f, 0.f, 0.f, 0.f};
    const unsigned ldso = (unsigned)(uintptr_t)ldsw;
    const unsigned vb = ldso + (unsigned)((4 * g + (i16 >> 2)) * 592 + (i16 & 3) * 8);
    constexpr float SC2 = SCALE * LOG2E;
    bf16x8 stg[18];
#define GATHER(tile_) do { const int j0 = (tile_) * 32 + rA, j1 = j0 + 16; const int s0 = j0 < ns ? sel[j0] : 0, s1 = j1 < ns ? sel[j1] : 0; \
        const bf16_t* p0_ = kbase + (size_t)s0 * 288 + cq * 8; const bf16_t* p1_ = kbase + (size_t)s1 * 288 + cq * 8; \
        _Pragma("unroll") for (int c = 0; c < 9; ++c) { stg[2 * c] = *(const bf16x8*)(p0_ + c * 32); stg[2 * c + 1] = *(const bf16x8*)(p1_ + c * 32); } } while (0)
    GATHER(0);
    for (int tile = 0; tile < ntile; ++tile) {
#pragma unroll
        for (int c = 0; c < 9; ++c) { *(bf16x8*)(ldsw + rA * 592 + c * 64 + cq * 16) = stg[2 * c]; *(bf16x8*)(ldsw + (16 + rA) * 592 + c * 64 + cq * 16) = stg[2 * c + 1]; }
        if (tile + 1 < ntile) GATHER(tile + 1);
        asm volatile("s_waitcnt lgkmcnt(0)" ::: "memory"); SBAR();
        f32x4 acc[2];
#pragma unroll
        for (int mt = 0; mt < 2; ++mt) { acc[mt] = (f32x4){0.f, 0.f, 0.f, 0.f};
#pragma unroll
            for (int st = 0; st < 9; ++st) { const bf16x8 a = *(const bf16x8*)(ldsw + (16 * mt + i16) * 592 + st * 64 + g * 16);
                acc[mt] = __builtin_amdgcn_mfma_f32_16x16x32_bf16(a, qf[st], acc[mt], 0, 0, 0); } }
        float tmax = -__builtin_inff();
#pragma unroll
        for (int mt = 0; mt < 2; ++mt)
#pragma unroll
            for (int r = 0; r < 4; ++r) { const int key = tile * 32 + 16 * mt + 4 * g + r; float x = acc[mt][r] * SC2; if (key >= ns) x = -__builtin_inff(); acc[mt][r] = x; tmax = fmaxf(tmax, x); }
        tmax = fmaxf(tmax, __shfl_xor(tmax, 16)); tmax = fmaxf(tmax, __shfl_xor(tmax, 32));
        const float mn = fmaxf(m, tmax), alpha = __builtin_amdgcn_exp2f(m - mn); m = mn;
        float ps = 0.f;
#pragma unroll
        for (int mt = 0; mt < 2; ++mt)
#pragma unroll
            for (int r = 0; r < 4; ++r) { acc[mt][r] = __builtin_amdgcn_exp2f(acc[mt][r] - mn); ps += acc[mt][r]; }
        ps += __shfl_xor(ps, 16); ps += __shfl_xor(ps, 32);
        l = l * alpha + ps;
#pragma unroll
        for (int rb = 0; rb < 16; ++rb) oT[rb] *= alpha;
        const bf16x8 pf = pack8(acc[0], acc[1]);
#define TRRD2(dst, off) asm volatile("ds_read_b64_tr_b16 %0, %1 offset:%2" : "=&v"(dst) : "v"(vb), "i"(off) : "memory")
#define PVRB4(rb) do { s16x4 ta0, tb0, ta1, tb1, ta2, tb2, ta3, tb3; \
        TRRD2(ta0, ((rb) + 0) * 32); TRRD2(tb0, ((rb) + 0) * 32 + 16 * 592); TRRD2(ta1, ((rb) + 1) * 32); TRRD2(tb1, ((rb) + 1) * 32 + 16 * 592); \
        TRRD2(ta2, ((rb) + 2) * 32); TRRD2(tb2, ((rb) + 2) * 32 + 16 * 592); TRRD2(ta3, ((rb) + 3) * 32); TRRD2(tb3, ((rb) + 3) * 32 + 16 * 592); \
        asm volatile("s_waitcnt lgkmcnt(0)" ::: "memory"); SBAR(); \
        oT[(rb) + 0] = __builtin_amdgcn_mfma_f32_16x16x32_bf16((bf16x8){ta0[0], ta0[1], ta0[2], ta0[3], tb0[0], tb0[1], tb0[2], tb0[3]}, pf, oT[(rb) + 0], 0, 0, 0); \
        oT[(rb) + 1] = __builtin_amdgcn_mfma_f32_16x16x32_bf16((bf16x8){ta1[0], ta1[1], ta1[2], ta1[3], tb1[0], tb1[1], tb1[2], tb1[3]}, pf, oT[(rb) + 1], 0, 0, 0); \
        oT[(rb) + 2] = __builtin_amdgcn_mfma_f32_16x16x32_bf16((bf16x8){ta2[0], ta2[1], ta2[2], ta2[3], tb2[0], tb2[1], tb2[2], tb2[3]}, pf, oT[(rb) + 2], 0, 0, 0); \
        oT[(rb) + 3] = __builtin_amdgcn_mfma_f32_16x16x32_bf16((bf16x8){ta3[0], ta3[1], ta3[2], ta3[3], tb3[0], tb3[1], tb3[2], tb3[3]}, pf, oT[(rb) + 3], 0, 0, 0); } while (0)
        PVRB4(0); PVRB4(4); PVRB4(8); PVRB4(12);
#undef PVRB4
#undef TRRD2
        SBAR();
    }
#undef GATHER
    const float rl = 1.0f / l;
    if (i16 < 8) { bf16_t* op = (bf16_t*)(ws + R_OLAT) + (size_t)tok * 2048 + i16 * 256 + 4 * g;
#pragma unroll
        for (int rb = 0; rb < 16; ++rb) { u32x2 w; w.x = cvtpk(oT[rb][0] * rl, oT[rb][1] * rl); w.y = cvtpk(oT[rb][2] * rl, oT[rb][3] * rl); *(u32x2*)(op + rb * 16) = w; } }
}
#ifdef ATT_SUB
#define ASUB(k) ((k) == ATT_SUB)
#else
#define ASUB(k) true
#endif
__device__ __forceinline__ void phase_attn(const Frame& F0, int l, int rep) { const Frame F = fresh(F0);
    unsigned char* ws = F.ws; char* lds = (char*)F.lds;
    const bf16_t* qkv = (const bf16_t*)(ws + R_QKV); const size_t TS = (size_t)NTOK * 1024;
    unsigned* qctr = (unsigned*)(ws + WS_CTL) + CW_QCTR + l * 64 + rep * 16; const unsigned* kmx = (const unsigned*)(ws + WS_CTL) + CW_KMAX + l * 16;
    int* qitem = (int*)(lds + att::OFF_QITEM);
    int* hord = qitem + 4;
    if (F.tid < 16) { const float* cumb = (const float*)(ws + WS_CUM); const float mine = -cumb[(size_t)F.tid * SEQ + SEQ - 1]; int rank = 0;
        for (int o = 0; o < 16; ++o) { const float v = -cumb[(size_t)o * SEQ + SEQ - 1]; rank += (v < mine || (v == mine && o < F.tid)) ? 1 : 0; }
        hord[rank] = F.tid; }
#pragma unroll 1
    for (;;) {
        __syncthreads();
        if (F.tid == 0) qitem[0] = (int)atomicAdd(qctr, 1u);
        __syncthreads();
        const int it = qitem[0];
        if (it >= 1024) break;
        const int md = it >> 9, j = it & 511;
        const int qb = md == 0 ? 31 - (j & 31) : 31 - (j >> 4), bh = md == 0 ? hord[j >> 5] : (j & 15), b = bh >> 3, h = bh & 7, P0 = qb * 256;
        if (!ASUB(md)) continue;
        const bf16_t* Q = qkv + (size_t)(md * 3 + 0) * TS + (size_t)bh * SEQ * 128; const bf16_t* K = qkv + (size_t)(md * 3 + 1) * TS + (size_t)bh * SEQ * 128; const bf16_t* V = qkv + (size_t)(md * 3 + 2) * TS + (size_t)bh * SEQ * 128;
        const float* cum = (const float*)(ws + WS_CUM) + (size_t)bh * SEQ;
        bf16_t* Ob = (bf16_t*)(ws + R_OA) + (size_t)b * SEQ * 3072 + (md + 1) * 1024 + h * 128;
        if (md == 0) { const float kmaxc = sqrtf(__uint_as_float(kmx[bh])) * C2; att::attn_unit<0>(Q, K, V, cum, Ob + (size_t)P0 * 3072, P0, lds, kmaxc); }
        else att::attn_unit<1>(Q, K, V, cum, Ob + (size_t)P0 * 3072, P0, lds, 0.f);
    }
    __syncthreads();
    char* ldsw = lds + F.wid * 18944;
#pragma unroll 1
    for (int rep = 0; rep < NREP(2); ++rep)
#pragma unroll 1
    for (int tok = F.bid * 8 + F.wid; tok < NTOK; tok += F.G * 8) if (ASUB(2)) sparse_query(F, tok, ldsw);
}

__device__ __forceinline__ void ln_row(const bf16_t* src, const float* g, const float* bta, float* of, bf16_t* ob, int lane, unsigned char* oq = nullptr, float* osc = nullptr, float* ost = nullptr) {
    f32x4 v[8]; float s = 0.f;
#pragma unroll
    for (int i = 0; i < 4; ++i) { const u32x4 w = *(const u32x4*)(src + (i * 64 + lane) * 8);
        v[2 * i] = (f32x4){bflo(w.x), bfhi(w.x), bflo(w.y), bfhi(w.y)}; v[2 * i + 1] = (f32x4){bflo(w.z), bfhi(w.z), bflo(w.w), bfhi(w.w)};
        s += (v[2 * i][0] + v[2 * i][1]) + (v[2 * i][2] + v[2 * i][3]) + (v[2 * i + 1][0] + v[2 * i + 1][1]) + (v[2 * i + 1][2] + v[2 * i + 1][3]); }
    s = wave_sum(s); const float mu = s * (1.0f / 2048.0f); float q = 0.f;
#pragma unroll
    for (int i = 0; i < 8; ++i) { const f32x4 d = v[i] - mu; q += (d[0] * d[0] + d[1] * d[1]) + (d[2] * d[2] + d[3] * d[3]); }
    q = wave_sum(q); const float rstd = rsqrtf(q * (1.0f / 2048.0f) + 1e-5f);
    if (ost && lane == 0) { ost[0] = mu; ost[1] = rstd; }
    float amax = 0.f;
#pragma unroll
    for (int i = 0; i < 4; ++i) { const int c = (i * 64 + lane) * 8; const f32x4 g0 = *(const f32x4*)(g + c), g1 = *(const f32x4*)(g + c + 4), b0 = *(const f32x4*)(bta + c), b1 = *(const f32x4*)(bta + c + 4);
        const f32x4 y0 = (v[2 * i] - mu) * rstd * g0 + b0, y1 = (v[2 * i + 1] - mu) * rstd * g1 + b1; v[2 * i] = y0; v[2 * i + 1] = y1;
        if (of) { *(f32x4*)(of + c) = y0; *(f32x4*)(of + c + 4) = y1; }
        if (ob) pg8::st_bf16x8(ob + c, y0, y1);
        if (oq) { amax = fmaxf(amax, fmaxf(fmaxf(fmaxf(fabsf(y0[0]), fabsf(y0[1])), fmaxf(fabsf(y0[2]), fabsf(y0[3]))), fmaxf(fmaxf(fabsf(y1[0]), fabsf(y1[1])), fmaxf(fabsf(y1[2]), fabsf(y1[3]))))); } }
    if (oq) {
        for (int o = 32; o > 0; o >>= 1) amax = fmaxf(amax, __shfl_xor(amax, o));
        amax = fmaxf(amax, 1e-20f); const float qi = 127.0f / amax; if (lane == 0) *osc = amax * (1.0f / 127.0f);
#pragma unroll
        for (int i = 0; i < 4; ++i) { u32x2 w;
#pragma unroll
            for (int h = 0; h < 2; ++h) { const f32x4 y = v[2 * i + h]; unsigned pk = 0u;
#pragma unroll
                for (int j = 0; j < 4; ++j) pk |= ((unsigned)(int)rintf(y[j] * qi) & 0xffu) << (8 * j);
                w[h] = pk; }
            *(u32x2*)(oq + (i * 64 + lane) * 8) = w; } }
}
__device__ __forceinline__ void phase_ln1_router(const Frame& F0, const Params& P, int l) { const Frame F = fresh(F0);
    unsigned char* ws = F.ws; const int lane = F.lane, wid = F.wid;
    const bf16_t* pre1 = (const bf16_t*)(ws + R_PRE1); float* x1f = (float*)(ws + M_X1F); bf16_t* x1b = (bf16_t*)(ws + M_X1B); unsigned char* x1q = (unsigned char*)(ws + M_X1Q); float* x1s = (float*)(ws + M_X1S);
    const float* g = F.in(11) + l * DM; const float* bt = F.in(12) + l * DM; const float* wr = F.in(13) + (size_t)l * DM * NEXP; const float* br = F.in(14) + l * NEXP;
    unsigned* cnt = (unsigned*)(ws + WS_CTL) + CW_CNT + l * 2048;
    int* tok_e = (int*)(ws + M_TOKE); int* tok_pos = (int*)(ws + M_TOKPOS); float* tok_w = (float*)(ws + M_TOKW);
    float* red = (float*)F.lds;
    float* lg = (float*)(F.lds + 32768); float* stats = (float*)(F.lds + 32768 + 16384);
#pragma unroll 1
    for (int blk = F.bid; blk < NTOK / 64; blk += F.G) {
        const int tok0 = blk * 64;
#pragma unroll 1
        for (int i = 0; i < 8; ++i) { const int tok = tok0 + wid * 8 + i; ln_row(pre1 + (size_t)tok * DM, g, bt, (float*)nullptr, x1b + (size_t)tok * DM, lane, x1q + (size_t)tok * DM, x1s + tok, stats + 2 * (wid * 8 + i)); }
        asm volatile("s_waitcnt vmcnt(0)" ::: "memory"); __syncthreads();
        { const int grp = wid >> 2, kq = wid & 3, i32 = lane & 31, hk = lane >> 5; f32x16 acc = {};
          const bf16_t* arow = pre1 + (size_t)(tok0 + grp * 32 + i32) * DM + kq * 512 + 4 * hk; const float* bcol = wr + (size_t)(kq * 512 + 4 * hk) * NEXP + i32;
          const float* gp = g + kq * 512 + 4 * hk; const float* bp = bt + kq * 512 + 4 * hk; const float mu = stats[2 * (grp * 32 + i32)], rstd = stats[2 * (grp * 32 + i32) + 1];
#pragma unroll 4
          for (int c8 = 0; c8 < 64; ++c8) { const u32x2 xw = *(const u32x2*)(arow + c8 * 8); const f32x4 g4 = *(const f32x4*)(gp + c8 * 8), b4 = *(const f32x4*)(bp + c8 * 8);
              const f32x4 a4 = ((f32x4){bflo(xw.x), bfhi(xw.x), bflo(xw.y), bfhi(xw.y)} - mu) * rstd * g4 + b4;
              const float b0 = bcol[(size_t)(c8 * 8 + 0) * NEXP], b1 = bcol[(size_t)(c8 * 8 + 1) * NEXP], b2 = bcol[(size_t)(c8 * 8 + 2) * NEXP], b3 = bcol[(size_t)(c8 * 8 + 3) * NEXP];
              acc = __builtin_amdgcn_mfma_f32_32x32x2f32(a4[0], b0, acc, 0, 0, 0); acc = __builtin_amdgcn_mfma_f32_32x32x2f32(a4[1], b1, acc, 0, 0, 0);
              acc = __builtin_amdgcn_mfma_f32_32x32x2f32(a4[2], b2, acc, 0, 0, 0); acc = __builtin_amdgcn_mfma_f32_32x32x2f32(a4[3], b3, acc, 0, 0, 0); }
#pragma unroll
          for (int r = 0; r < 16; ++r) red[(wid * 16 + r) * 64 + lane] = acc[r]; }
        __syncthreads();
        if ((wid & 3) == 0) { const int grp = wid >> 2, hk = lane >> 5, e = lane & 31; const float be = br[e];
#pragma unroll
            for (int r = 0; r < 16; ++r) { const float v = red[((wid + 0) * 16 + r) * 64 + lane] + red[((wid + 1) * 16 + r) * 64 + lane] + red[((wid + 2) * 16 + r) * 64 + lane] + red[((wid + 3) * 16 + r) * 64 + lane] + be;
                lg[(grp * 32 + crow(r, hk)) * 33 + e] = v; }
            asm volatile("s_waitcnt lgkmcnt(0)" ::: "memory"); SBAR();
            const int tk = lane & 31; float v[32];
#pragma unroll
            for (int e2 = 0; e2 < 32; ++e2) v[e2] = lg[(grp * 32 + tk) * 33 + e2];
            int ek[4]; float vk[4];
#pragma unroll
            for (int k = 0; k < 4; ++k) { float best = -__builtin_inff(); int bi = 0;
#pragma unroll
                for (int e2 = 0; e2 < 32; ++e2) if (v[e2] > best) { best = v[e2]; bi = e2; }
                ek[k] = bi; vk[k] = best;
#pragma unroll
                for (int e2 = 0; e2 < 32; ++e2) v[e2] = (e2 == bi) ? -__builtin_inff() : v[e2]; }
            float wk[4], sw = 0.f;
#pragma unroll
            for (int k = 0; k < 4; ++k) { wk[k] = __expf(vk[k] - vk[0]); sw += wk[k]; }
            const float rs = 1.0f / sw;
            const bool act = lane < 32; unsigned myc = 0u;
#pragma unroll 1
            for (int E = 0; E < 32; ++E) { unsigned c = 0u;
#pragma unroll
                for (int k = 0; k < 4; ++k) c += (unsigned)__popcll(__ballot(act && ek[k] == E));
                if (lane == E) myc = c; }
            unsigned run = 0u; if (lane < 32 && myc > 0u) run = atomicAdd(&cnt[lane * 64], myc);
            int pk[4];
#pragma unroll
            for (int k = 0; k < 4; ++k) { pk[k] = 0;
#pragma unroll 1
                for (int E = 0; E < 32; ++E) { const unsigned long long mm = __ballot(act && ek[k] == E); const unsigned basev = (unsigned)__shfl((int)run, E);
                    if (act && ek[k] == E) pk[k] = (int)(basev + (unsigned)__popcll(mm & ((1ull << lane) - 1ull)));
                    if (lane == E) run += (unsigned)__popcll(mm); } }
            if (act) { const int tok = tok0 + grp * 32 + tk;
#pragma unroll
                for (int k = 0; k < 4; ++k) { tok_e[tok * 4 + k] = ek[k]; tok_pos[tok * 4 + k] = pk[k]; tok_w[tok * 4 + k] = wk[k] * rs; } }
        }
        __syncthreads();
    }
}
__device__ __forceinline__ void phase_moe_gather(const Frame& F0, int l) { const Frame F = fresh(F0);
    unsigned char* ws = F.ws; const int lane = F.lane;
    const unsigned* cnt = (const unsigned*)(ws + WS_CTL) + CW_CNT + l * 2048; unsigned* meta = (unsigned*)(ws + WS_CTL) + CW_META + l * 512;
    unsigned* offs = (unsigned*)(F.lds + LDS_MISC + 64);
    if (F.tid == 0) { unsigned o = 0u; for (int e = 0; e < 32; ++e) { offs[e] = o; o += (cnt[e * 64] + 255u) & ~255u; } offs[32] = o;
        if (F.bid == 0) { meta[0] = o >> 8; for (int e = 0; e < 32; ++e) for (unsigned t = offs[e] >> 8; t < (offs[e + 1] >> 8); ++t) meta[1 + t] = (unsigned)e; } }
    __syncthreads();
    const int* tok_e = (const int*)(ws + M_TOKE); const int* tok_pos = (const int*)(ws + M_TOKPOS); const float* tok_w = (const float*)(ws + M_TOKW);
    int* tok_dst = (int*)(ws + M_TOKDST); float* roww = (float*)(ws + M_ROWW);
    const unsigned char* x1q = (const unsigned char*)(ws + M_X1Q); const float* x1s = (const float*)(ws + M_X1S); unsigned char* xs = (unsigned char*)(ws + M_XS); float* rowsx = (float*)(ws + M_ROWSX);
    for (int it = F.bid * 8 + F.wid; it < NTOK * 4; it += F.G * 8) { const int tok = it >> 2;
        const int e = tok_e[it]; const unsigned dst = offs[e] + (unsigned)tok_pos[it];
        if (lane == 0) { tok_dst[it] = (int)dst; roww[dst] = tok_w[it]; rowsx[dst] = x1s[tok]; }
        const u32x4* sp = (const u32x4*)(x1q + (size_t)tok * DM); u32x4* dp = (u32x4*)(xs + (size_t)dst * DM);
#pragma unroll
        for (int i = 0; i < 2; ++i) dp[i * 64 + lane] = sp[i * 64 + lane]; }
    __syncthreads();
}
__device__ __forceinline__ void phase_quant_h(const Frame& F0, int l) { const Frame F = fresh(F0);
    unsigned char* ws = F.ws; const int lane = F.lane;
    const int nrows = (int)((const unsigned*)(ws + WS_CTL))[CW_META + l * 512] * 256;
    const float* hm = (const float*)(ws + M_HM); const bf16_t* hid = (const bf16_t*)(ws + M_HID); unsigned char* h8 = (unsigned char*)(ws + M_H8); float* h8s = (float*)(ws + M_H8S);
    for (int row = F.bid * 8 + F.wid; row < nrows; row += F.G * 8) {
        float am = hm[(size_t)row * 32 + (lane & 31)];
        const u32x4 a = *(const u32x4*)(hid + (size_t)row * DEXP + lane * 16), b = *(const u32x4*)(hid + (size_t)row * DEXP + lane * 16 + 8);
        for (int o = 16; o > 0; o >>= 1) am = fmaxf(am, __shfl_xor(am, o));
        am = fmaxf(am, 1e-20f); const float qi = 127.0f / am; if (lane == 0) h8s[row] = am * (1.0f / 127.0f);
        const unsigned wv[8] = {a.x, a.y, a.z, a.w, b.x, b.y, b.z, b.w}; u32x4 w;
#pragma unroll
        for (int d = 0; d < 4; ++d) { unsigned pk = 0u;
#pragma unroll
            for (int j = 0; j < 2; ++j) { const unsigned x = wv[d * 2 + j];
                const float q0 = fminf(fmaxf(rintf(bflo(x) * qi), -127.f), 127.f), q1 = fminf(fmaxf(rintf(bfhi(x) * qi), -127.f), 127.f);
                pk |= (((unsigned)(int)q0 & 0xffu) | (((unsigned)(int)q1 & 0xffu) << 8)) << (16 * j); }
            w[d] = pk; }
        *(u32x4*)(h8 + (size_t)row * DEXP + lane * 16) = w; }
}
__device__ __forceinline__ void phase_combine(const Frame& F0) { const Frame F = fresh(F0);
    unsigned char* ws = F.ws; const int lane = F.lane;
    const bf16_t* x1b = (const bf16_t*)(ws + M_X1B); const bf16_t* ys = (const bf16_t*)(ws + M_XS); const int* tok_dst = (const int*)(ws + M_TOKDST);
    bf16_t* hb = (bf16_t*)(ws + M_HB); unsigned char* hq = (unsigned char*)(ws + M_HQ); float* hsc = (float*)(ws + M_HSC);
    for (int tok = F.bid * 8 + F.wid; tok < NTOK; tok += F.G * 8) {
        const int d0 = tok_dst[tok * 4], d1 = tok_dst[tok * 4 + 1], d2 = tok_dst[tok * 4 + 2], d3 = tok_dst[tok * 4 + 3];
        f32x4 hv[8]; float amax = 0.f;
#pragma unroll
        for (int i = 0; i < 4; ++i) { const int c = (i * 64 + lane) * 8; const size_t o = (size_t)tok * DM + c;
            const u32x4 xw = *(const u32x4*)(x1b + o);
            f32x4 a = (f32x4){bflo(xw.x), bfhi(xw.x), bflo(xw.y), bfhi(xw.y)} * ALPHA, b = (f32x4){bflo(xw.z), bfhi(xw.z), bflo(xw.w), bfhi(xw.w)} * ALPHA;
            const u32x4 y0 = *(const u32x4*)(ys + (size_t)d0 * DM + c), y1 = *(const u32x4*)(ys + (size_t)d1 * DM + c), y2 = *(const u32x4*)(ys + (size_t)d2 * DM + c), y3 = *(const u32x4*)(ys + (size_t)d3 * DM + c);
            a[0] += (bflo(y0.x) + bflo(y1.x)) + (bflo(y2.x) + bflo(y3.x)); a[1] += (bfhi(y0.x) + bfhi(y1.x)) + (bfhi(y2.x) + bfhi(y3.x));
            a[2] += (bflo(y0.y) + bflo(y1.y)) + (bflo(y2.y) + bflo(y3.y)); a[3] += (bfhi(y0.y) + bfhi(y1.y)) + (bfhi(y2.y) + bfhi(y3.y));
            b[0] += (bflo(y0.z) + bflo(y1.z)) + (bflo(y2.z) + bflo(y3.z)); b[1] += (bfhi(y0.z) + bfhi(y1.z)) + (bfhi(y2.z) + bfhi(y3.z));
            b[2] += (bflo(y0.w) + bflo(y1.w)) + (bflo(y2.w) + bflo(y3.w)); b[3] += (bfhi(y0.w) + bfhi(y1.w)) + (bfhi(y2.w) + bfhi(y3.w));
            pg8::st_bf16x8(hb + o, a, b); hv[2 * i] = a; hv[2 * i + 1] = b;
#pragma unroll
            for (int j = 0; j < 4; ++j) amax = fmaxf(amax, fmaxf(fabsf(a[j]), fabsf(b[j]))); }
        for (int o = 32; o > 0; o >>= 1) amax = fmaxf(amax, __shfl_xor(amax, o));
        amax = fmaxf(amax, 1e-20f); const float qi = 127.0f / amax; if (lane == 0) hsc[tok] = amax * (1.0f / 127.0f);
#pragma unroll
        for (int i = 0; i < 4; ++i) { u32x2 w;
#pragma unroll
            for (int h = 0; h < 2; ++h) { unsigned pk = 0u;
#pragma unroll
                for (int j = 0; j < 4; ++j) pk |= ((unsigned)(int)rintf(hv[2 * i + h][j] * qi) & 0xffu) << (8 * j);
                w[h] = pk; }
            *(u32x2*)(hq + (size_t)tok * DM + (i * 64 + lane) * 8) = w; } }
}
__device__ __forceinline__ void phase_ln2(const Frame& F0, const Params& P, int l) { const Frame F = fresh(F0);
    unsigned char* ws = F.ws; const bf16_t* pre2 = (const bf16_t*)(ws + M_X1F); bf16_t* xb = (bf16_t*)(ws + WS_XB);
    const float* g = F.in(23) + l * DM; const float* bt = F.in(24) + l * DM; float* outp = F.out();
    for (int tok = F.bid * 8 + F.wid; tok < NTOK; tok += F.G * 8) ln_row(pre2 + (size_t)tok * DM, g, bt, (l + 1 == NLAYER) ? outp + (size_t)tok * DM : (float*)nullptr, (l + 1 == NLAYER) ? (bf16_t*)nullptr : xb + (size_t)tok * DM, F.lane,
                                                                          (l + 1 == NLAYER) ? (unsigned char*)nullptr : (unsigned char*)(ws + WS_XQ) + (size_t)tok * DM, (l + 1 == NLAYER) ? (float*)nullptr : (float*)(ws + WS_XSC) + tok);
}

constexpr int NPHASE = 2 + 15 * NLAYER;
#ifdef PH_ONLY
#define PEN(kind) ((kind) == PH_ONLY)
#else
#define PEN(kind) true
#endif
#define IN(k) (lo <= (k) && (k) < hi)
#define SEAM(k) do { if (IN((k) + 1)) xcd_barrier(bar); } while (0)

template <int l>
__device__ __forceinline__ void layer_phases(const Frame& F, const Params& P, const XcdBarrier& bar, const int lo, const int hi, unsigned char* ws0) {
    using namespace pg8;

        const int pb = 2 + 15 * l;
        if (IN(pb + 0) && PEN(0)) { size_t wz = 0; asm volatile("" : "+s"(wz)); unsigned char* ws = ws0 + wz;
            { SchedS S; S.init(NTOK, 5 * 256, F.G, F.bid, (const bf16_t*)(ws + WS_XB), DM, (const bf16_t*)(ws + W_IN), DM); S.skip_from = 0; S.skip_by = 4; S.skip_from2 = 4; S.skip_by2 = 49;
              EpiInProj<false> E{(bf16_t*)(ws + R_QA), (bf16_t*)(ws + R_QIDX), (bf16_t*)(ws + R_QKV), (bf16_t*)(ws + R_GATES), (float*)(ws + R_SMALL), nullptr, nullptr};
              for (int rep = 0; rep < NREP(5); ++rep) gemm_phase(F.ldsl, DM, DM, DM, S, E); }
            { SchedS S; S.init(NTOK, 53 * 256, F.G, (F.bid + F.G / 2) % F.G, (const bf16_t*)(ws + WS_XQ), DM / 2, (const bf16_t*)(ws + W_IN8), DM / 2); S.skip_from = 4; S.skip_by = 4; S.b_compact = 1;
              EpiInProj<true> E{(bf16_t*)(ws + R_QA), (bf16_t*)(ws + R_QIDX), (bf16_t*)(ws + R_QKV), (bf16_t*)(ws + R_GATES), (float*)(ws + R_SMALL), (const float*)(ws + WS_XSC), (const unsigned*)(ws + WS_CTL) + CW_WMAXG + l};
              for (int rep = 0; rep < NREP(5); ++rep) gemm_phase(F.ldsl, DM / 2, DM / 2, DM / 2, S, E); }
            SEAM(pb + 0); }
        if (IN(pb + 1) && PEN(1)) { size_t wz = 0; asm volatile("" : "+s"(wz)); unsigned char* ws = ws0 + wz;
            phase_prep(F, P, l);
            SchedS S; S.init(NTOK, 2048, F.G, F.bid, (const bf16_t*)(ws + R_QA), 1024, (const bf16_t*)(ws + W_UK2), 256, 1, 256);
            EpiBf16 E{(bf16_t*)(ws + R_QCAT), 2304, 288};
            for (int rep = 0; rep < NREP(10); ++rep) gemm_phase(F.ldsl, 256, 1024, 256, S, E); SEAM(pb + 1); }
        if (IN(pb + 2) && PEN(2)) { size_t wz = 0; asm volatile("" : "+s"(wz)); unsigned char* ws = ws0 + wz; phase_cumsum(F); for (int rep = 0; rep < NREP(3); ++rep) phase_idx(F); SEAM(pb + 2); }
        if (IN(pb + 3) && PEN(3)) { size_t wz = 0; asm volatile("" : "+s"(wz)); unsigned char* ws = ws0 + wz; for (int rep = 0; rep < NREP(4); ++rep) phase_topk(F); SEAM(pb + 3); }
        if (IN(pb + 4) && PEN(4)) { size_t wz = 0; asm volatile("" : "+s"(wz)); unsigned char* ws = ws0 + wz; for (int rep = 0; rep < NREP(1); ++rep) phase_attn(F, l, rep); SEAM(pb + 4); }
        if (IN(pb + 5) && PEN(5)) { size_t wz = 0; asm volatile("" : "+s"(wz)); unsigned char* ws = ws0 + wz;
            SchedS S; S.init(NTOK, 1024, F.G, F.bid, (const bf16_t*)(ws + R_OLAT), 2048, (const bf16_t*)(ws + W_UV2), 512, 0, 512);
            EpiBf16 E{(bf16_t*)(ws + R_OA), 3072, 256}; for (int rep = 0; rep < NREP(10); ++rep) gemm_phase(F.ldsl, 512, 2048, 512, S, E);
            SEAM(pb + 5); }
        if (IN(pb + 6) && PEN(6)) { size_t wz = 0; asm volatile("" : "+s"(wz)); unsigned char* ws = ws0 + wz;
            SchedS S; S.init(NTOK, 2048, F.G, F.bid, (const bf16_t*)(ws + R_OA), 3072, (const bf16_t*)(ws + W_BRA), 3072);
            EpiBranch3 E{(const unsigned char*)(ws + R_GATES), (bf16_t*)(ws + R_MERGED)}; for (int rep = 0; rep < NREP(11); ++rep) gemm_phase(F.ldsl, 3072, 3072, 3072, S, E); SEAM(pb + 6); }
        if (IN(pb + 7) && PEN(7)) { size_t wz = 0; asm volatile("" : "+s"(wz)); unsigned char* ws = ws0 + wz;
            SchedS S; S.init(NTOK, 2048, F.G, F.bid, (const bf16_t*)(ws + R_MERGED), DM, (const bf16_t*)(ws + W_OUT), DM);
            EpiOut E{(const bf16_t*)(ws + WS_XB), (bf16_t*)(ws + R_PRE1)}; for (int rep = 0; rep < NREP(8); ++rep) gemm_phase(F.ldsl, DM, DM, DM, S, E); SEAM(pb + 7); }
        if (IN(pb + 8) && PEN(8)) { size_t wz = 0; asm volatile("" : "+s"(wz)); unsigned char* ws = ws0 + wz; phase_ln1_router(F, P, l); SEAM(pb + 8); }
        if (IN(pb + 9) && PEN(9)) { size_t wz = 0; asm volatile("" : "+s"(wz)); unsigned char* ws = ws0 + wz;
            for (int rep = 0; rep < NREP(12); ++rep) phase_moe_gather(F, l);
            SchedS S; S.init(NTOK, 2048, F.G, F.bid, (const bf16_t*)(ws + WS_PB) + (size_t)l * NTOK * 256, 256, (const bf16_t*)(ws + W_PLE), 256);
            EpiBf16 E{(bf16_t*)(ws + M_PP), 2048, 256}; for (int rep = 0; rep < NREP(10); ++rep) gemm_phase(F.ldsl, 256, 256, 256, S, E); SEAM(pb + 9); }
        if (IN(pb + 10) && PEN(10)) { size_t wz = 0; asm volatile("" : "+s"(wz)); unsigned char* ws = ws0 + wz;
            SchedM S; S.init((const unsigned*)(ws + WS_CTL) + CW_META + l * 512, F.G, F.bid, (const bf16_t*)(ws + M_XS), DM / 2, (const bf16_t*)(ws + W_GU), DM / 2);
            EpiGateUpI8 E{F.in(16) + (size_t)l * NEXP * DEXP, F.in(18) + (size_t)l * NEXP * DEXP, (bf16_t*)(ws + M_HID), (const float*)(ws + M_ROWSX), (const unsigned*)(ws + WS_CTL) + CW_WMAX + l, (float*)(ws + M_HM)};
            for (int rep = 0; rep < NREP(6); ++rep) gemm_phase(F.ldsl, DM / 2, DM / 2, DM / 2, S, E); SEAM(pb + 10); }
        if (IN(pb + 11) && PEN(11)) { size_t wz = 0; asm volatile("" : "+s"(wz)); unsigned char* ws = ws0 + wz;
            phase_quant_h(F, l); xcd_barrier(bar);
            SchedM S; S.init((const unsigned*)(ws + WS_CTL) + CW_META + l * 512, F.G, F.bid, (const bf16_t*)(ws + M_H8), DEXP / 2, (const bf16_t*)(ws + W_DN), DEXP / 2);
            EpiDownI8 E{F.in(20) + (size_t)l * NEXP * DM, (const float*)(ws + M_ROWW), (bf16_t*)(ws + M_XS), (const float*)(ws + M_H8S), (const unsigned*)(ws + WS_CTL) + CW_WMAXD + l};
            for (int rep = 0; rep < NREP(7); ++rep) gemm_phase(F.ldsl, DEXP / 2, DEXP / 2, DEXP / 2, S, E); SEAM(pb + 11); }
        if (IN(pb + 12) && PEN(12)) { size_t wz = 0; asm volatile("" : "+s"(wz)); unsigned char* ws = ws0 + wz; for (int rep = 0; rep < NREP(9); ++rep) phase_combine(F); SEAM(pb + 12); }
        if (IN(pb + 13) && PEN(13)) { size_t wz = 0; asm volatile("" : "+s"(wz)); unsigned char* ws = ws0 + wz;
            SchedS S; S.init(NTOK, 2048, F.G, F.bid, (const bf16_t*)(ws + M_HQ), DM / 2, (const bf16_t*)(ws + W_PG), DM / 2);
            EpiPleGateI8 E{(const bf16_t*)(ws + M_HB), (const bf16_t*)(ws + M_PP), (bf16_t*)(ws + M_X1F), (const float*)(ws + M_HSC), (const unsigned*)(ws + WS_CTL) + CW_WMAXP + l};
            for (int rep = 0; rep < NREP(8); ++rep) gemm_phase(F.ldsl, DM / 2, DM / 2, DM / 2, S, E); SEAM(pb + 13); }
        if (IN(pb + 14) && PEN(14)) { size_t wz = 0; asm volatile("" : "+s"(wz)); unsigned char* ws = ws0 + wz; for (int rep = 0; rep < NREP(13); ++rep) phase_ln2(F, P, l); if (l + 1 < NLAYER) for (int rep = 0; rep < NREP(0); ++rep) convert_layer_weights(F, P, l + 1); SEAM(pb + 14); }
}
__global__ void __launch_bounds__(512, 2) fwd(Params P) {
    extern __shared__ __attribute__((aligned(16))) unsigned char lds[];
    Frame F; F.lds = lds; F.ldsl = (LAS unsigned char*)lds; F.ws = P.ws; F.tid = threadIdx.x; F.lane = F.tid & 63; F.wid = __builtin_amdgcn_readfirstlane(F.tid >> 6); F.G = gridDim.x; F.bid = blockIdx.x;
    unsigned char* ws0 = P.ws; unsigned char* ws = ws0;
    const bool fused = (P.ph_hi - P.ph_lo) > 1;
    if (F.tid < 4) ((LAS unsigned*)(F.ldsl + LDS_MISC))[F.tid] = 0u;
    if (F.tid == 0) { LAS unsigned long long* t = (LAS unsigned long long*)(F.ldsl + LDS_PTRS);
#pragma unroll
        for (int k = 0; k < 25; ++k) t[k] = (unsigned long long)P.in[k];
        t[25] = (unsigned long long)P.out; }
    __syncthreads();
    XcdBarrier bar; bar.bar = (unsigned*)(ws + WS_CTL) + CW_BAR; bar.x = 0; bar.st = (volatile LAS unsigned*)(F.ldsl + LDS_MISC);
    if (fused) bar = xcd_barrier_post((unsigned*)(ws + WS_CTL) + CW_BAR, (volatile LAS unsigned*)(F.ldsl + LDS_MISC));
    const int lo = P.ph_lo, hi = P.ph_hi;
    using namespace pg8;
    if (IN(0) && PEN(15)) { size_t wz = 0; asm volatile("" : "+s"(wz)); unsigned char* ws = ws0 + wz;
        quant_rows(F, F.in(0), (bf16_t*)(ws + WS_XB), (unsigned char*)(ws + WS_XQ), (float*)(ws + WS_XSC));
        conv_rows(F, F.in(1), (bf16_t*)(ws + WS_PB), (size_t)2 * NTOK * 256 / 8);
        sample_wmax(F);
        SEAM(0);
    }
    if (IN(1) && PEN(15)) { for (int rep = 0; rep < NREP(0); ++rep) convert_layer_weights(F, P, 0); SEAM(1); }
    layer_phases<0>(F, P, bar, lo, hi, ws0);
    layer_phases<1>(F, P, bar, lo, hi, ws0);
}

#ifdef DEBUG_NAN
constexpr int CW_FLAGS = 12288;
__global__ void dbg_scan_bf16(const unsigned short* p, size_t n, unsigned* flag) { unsigned c = 0; for (size_t i = (size_t)blockIdx.x * blockDim.x + threadIdx.x; i < n; i += (size_t)gridDim.x * blockDim.x) if ((p[i] & 0x7F80u) == 0x7F80u) ++c; if (c) atomicAdd(flag, c); }
__global__ void dbg_scan_f32(const unsigned* p, size_t n, unsigned* flag) { unsigned c = 0; for (size_t i = (size_t)blockIdx.x * blockDim.x + threadIdx.x; i < n; i += (size_t)gridDim.x * blockDim.x) if ((p[i] & 0x7F800000u) == 0x7F800000u) ++c; if (c) atomicAdd(flag, c); }
__global__ void dbg_scan_sel(const int* sel, const int* nsel, unsigned* flag) { unsigned c = 0; for (size_t i = (size_t)blockIdx.x * blockDim.x + threadIdx.x; i < (size_t)NTOK * 256; i += (size_t)gridDim.x * blockDim.x) { const int tok = (int)(i >> 8), j = (int)(i & 255), t = tok & (SEQ - 1); const int ns = nsel[tok]; if (j == 0 && ns != (t + 1 < 256 ? t + 1 : 256)) ++c; if (j < ns && (sel[i] < 0 || sel[i] > t)) ++c; } if (c) atomicAdd(flag, c); }
__global__ void dbg_scan_scores(const unsigned* p, unsigned* flag) { unsigned c = 0; for (size_t i = (size_t)blockIdx.x * blockDim.x + threadIdx.x; i < 2ull * SEQ * SEQ; i += (size_t)gridDim.x * blockDim.x) { const int s = (int)(i & (SEQ - 1)), t = (int)((i >> 13) & (SEQ - 1)); if (s <= t && (p[i] & 0x7F800000u) == 0x7F800000u) ++c; } if (c) atomicAdd(flag, c); }
__global__ void dbg_probe_bf16(const unsigned short* p, size_t n, unsigned* cnt, unsigned* minidx) { unsigned c = 0; unsigned mi = 0xFFFFFFFFu; for (size_t i = (size_t)blockIdx.x * blockDim.x + threadIdx.x; i < n; i += (size_t)gridDim.x * blockDim.x) if ((p[i] & 0x7F80u) == 0x7F80u) { ++c; if ((unsigned)i < mi) mi = (unsigned)i; } if (c) { atomicAdd(cnt, c); atomicMax(minidx, ~mi); } }
__global__ void dbg_final(float* out, size_t n, const unsigned* flags) { int code = 0; for (int k = 0; k < 32; ++k) if (flags[k] && !code) code = k + 1; const int mask = (flags[32] ? 1 : 0) | (flags[33] ? 2 : 0) | (flags[34] ? 4 : 0); if (mask) code = 20 + 5 * mask; if (!code) return; for (size_t i = (size_t)blockIdx.x * blockDim.x + threadIdx.x; i < n; i += (size_t)gridDim.x * blockDim.x) out[i] = (float)code; }
#endif
extern "C" void kernel_launch(void* const* d_in, const int* in_sizes, int n_in, void* d_out, int out_size, void* d_ws, size_t ws_size, hipStream_t stream) {
    static int grid = 0;
    if (grid == 0) {
        if (n_in != 25 || out_size != NTOK * DM || ws_size < WS_NEED) { fprintf(stderr, "kernel_launch: unexpected shapes (n_in %d out %d ws %zu need %zu)\n", n_in, out_size, ws_size, (size_t)WS_NEED); grid = -1; return; }
        int dev = 0, cus = 0, per_cu = 0;
        if (hipGetDevice(&dev) != hipSuccess || hipDeviceGetAttribute(&cus, hipDeviceAttributeMultiprocessorCount, dev) != hipSuccess) { grid = -1; return; }
        if (hipFuncSetAttribute((const void*)fwd, hipFuncAttributeMaxDynamicSharedMemorySize, LDS_BYTES) != hipSuccess) { fprintf(stderr, "kernel_launch: hipFuncSetAttribute failed\n"); grid = -1; return; }
        if (hipOccupancyMaxActiveBlocksPerMultiprocessor(&per_cu, (const void*)fwd, 512, LDS_BYTES) != hipSuccess || per_cu < 1) fprintf(stderr, "kernel_launch: occupancy query says %d\n", per_cu);
        (void)hipGetLastError();
        grid = cus;
    }
    if (grid < 0) return;
    unsigned char* ws = (unsigned char*)d_ws;
    hipMemsetAsync(ws + WS_CTL, 0, CTL_BYTES, stream);
    hipMemsetAsync(ws + W_UK2, 0, 8ull * 256 * 256 * 2 + 4ull * 256 * 512 * 2, stream);
    hipMemsetAsync(ws + W_IN + (size_t)INW * 2048 * 2, 0, (size_t)(INWP - INW) * 2048 * 2, stream);
    Params p{};
    for (int i = 0; i < 25; ++i) p.in[i] = (const float*)d_in[i];
    p.out = (float*)d_out; p.ws = ws;
#if PHASES_PER_LAUNCH == 0
    p.ph_lo = 0; p.ph_hi = NPHASE;
    hipLaunchKernelGGL(fwd, dim3(grid), dim3(512), LDS_BYTES, stream, p);
#else
    for (int k = 0; k < NPHASE; ++k) { p.ph_lo = k; p.ph_hi = k + 1; hipLaunchKernelGGL(fwd, dim3(grid), dim3(512), LDS_BYTES, stream, p);
#ifdef DEBUG_NAN
        unsigned* fl = (unsigned*)(ws + WS_CTL) + CW_FLAGS + k;
#define SB16(off, n) hipLaunchKernelGGL(dbg_scan_bf16, dim3(1024), dim3(256), 0, stream, (const unsigned short*)(ws + (off)), (size_t)(n), fl)
#define SF32(off, n) hipLaunchKernelGGL(dbg_scan_f32, dim3(1024), dim3(256), 0, stream, (const unsigned*)(ws + (off)), (size_t)(n), fl)
        if (k == 0) { SB16(WS_XB, (size_t)NTOK * DM); SB16(WS_PB, 2ull * NTOK * 256); SB16(WS_W, (W_END - WS_W) / 2); }
        else { const int kind = (k - 1) % 15;
            if (kind == 0) { SB16(R_QA, (size_t)NTOK * 1024); SB16(R_QIDX, (size_t)NTOK * 1024); SB16(R_QKV, 6ull * NTOK * 1024); SB16(R_GATES, (size_t)NTOK * 6144); SF32(R_SMALL, (size_t)NTOK * 512); }
            if (kind == 1) { SB16(R_QCAT, (size_t)NTOK * 2304); SB16(R_KCAT, (size_t)NTOK * 288); SB16(R_KI, (size_t)NTOK * 64); SB16(R_QIDX, (size_t)NTOK * 1024); SF32(R_WI, (size_t)NTOK * 16); SF32(WS_LF, 16ull * 8192); }
            if (kind == 2) { SF32(WS_CUM, 16ull * 8192); hipLaunchKernelGGL(dbg_scan_scores, dim3(1024), dim3(256), 0, stream, (const unsigned*)(ws + R_SCORES), fl); }
            if (kind == 3) { hipLaunchKernelGGL(dbg_scan_sel, dim3(1024), dim3(256), 0, stream, (const int*)(ws + R_SEL), (const int*)(ws + R_NSEL), fl); }
            if (k == 5) { unsigned* fl0 = fl; fl = (unsigned*)(ws + WS_CTL) + CW_FLAGS + 32; SB16(R_OLAT, (size_t)NTOK * 2048); fl += 1; SB16(R_OA, (size_t)NTOK * 3072); fl += 1; fl = fl0; hipLaunchKernelGGL(dbg_probe_bf16, dim3(1024), dim3(256), 0, stream, (const unsigned short*)(ws + R_OC), (size_t)NTOK * 1024, (unsigned*)(ws + WS_CTL) + CW_FLAGS + 40, (unsigned*)(ws + WS_CTL) + CW_FLAGS + 41); }
            if (kind == 5) { SB16(R_OA, (size_t)NTOK * 3072); }
            if (kind == 6) { SB16(R_MERGED, (size_t)NTOK * 2048); }
            if (kind == 7) { SF32(R_PRE1, (size_t)NTOK * 2048); }
            if (kind == 8) { SF32(M_X1F, (size_t)NTOK * 2048); SF32(M_TOKW, (size_t)NTOK * 4); }
            if (kind == 9) { SB16(M_PP, (size_t)NTOK * 2048); }
            if (kind == 12) { SF32(M_HF, (size_t)NTOK * 2048); }
            if (kind == 13) { SF32(M_X1F, (size_t)NTOK * 2048); }
            if (kind == 14) { hipLaunchKernelGGL(dbg_scan_f32, dim3(1024), dim3(256), 0, stream, (const unsigned*)d_out, (size_t)NTOK * DM, fl); if (k + 1 < NPHASE) SB16(WS_W, (W_END - WS_W) / 2); } }
#endif
    }
#ifdef DEBUG_NAN
    hipLaunchKernelGGL(dbg_final, dim3(1024), dim3(256), 0, stream, (float*)d_out, (size_t)NTOK * DM, (const unsigned*)(ws + WS_CTL) + CW_FLAGS);
#endif
#endif
}
```

```cpp
#include <hip/hip_runtime.h>
#include <stdint.h>
#include <stdio.h>
#include <math.h>

#ifndef PHASES_PER_LAUNCH
#define PHASES_PER_LAUNCH 0
#endif

#define LAS __attribute__((address_space(3)))
#define GAS __attribute__((address_space(1)))
#ifndef REP_MASK
#define REP_MASK 0
#endif
#define NREP(bit) (((REP_MASK) >> (bit)) & 1 ? 2 : 1)
typedef unsigned short bf16_t;
typedef short bf16x8 __attribute__((ext_vector_type(8)));
typedef short s16x4 __attribute__((ext_vector_type(4)));
typedef float f32x4 __attribute__((ext_vector_type(4)));
typedef float f32x16 __attribute__((ext_vector_type(16)));
typedef unsigned u32x4 __attribute__((ext_vector_type(4)));
typedef unsigned u32x2 __attribute__((ext_vector_type(2)));
typedef int i32x4 __attribute__((ext_vector_type(4)));

constexpr int NTOK = 16384, DM = 2048, SEQ = 8192, NB = 2, NLAYER = 2;
constexpr int INW = 14712, INWP = 14848;
constexpr int NEXP = 32, DEXP = 1024;
constexpr int PMAX = 65536 + 8192;
constexpr float ALPHA = 1.41421356237309515f;
constexpr float LOG2E = 1.4426950408889634f;
constexpr float SCALE = 0.08838834764831845f;
constexpr float C2 = LOG2E * SCALE;

constexpr size_t MiB = 1ull << 20;
constexpr size_t WS_CTL   = 0;
constexpr size_t WS_W     = 1 * MiB;
constexpr size_t W_IN     = WS_W;
constexpr size_t W_IN8    = W_IN   + 2048ull * 2048 * 2;
constexpr size_t W_UK2    = W_IN   + (size_t)INWP * 2048 * 2;
constexpr size_t W_UV2    = W_UK2  + 8ull * 256 * 256 * 2;
constexpr size_t W_BRA    = W_UV2  + 4ull * 256 * 512 * 2;
constexpr size_t W_BRB    = W_BRA  + 2048ull * 1024 * 2;
constexpr size_t W_BRC    = W_BRB  + 2048ull * 1024 * 2;
constexpr size_t W_OUT    = W_BRC  + 2048ull * 1024 * 2;
constexpr size_t W_PG     = W_OUT  + 2048ull * 2048 * 2;
constexpr size_t W_PLE    = W_PG   + 2048ull * 2048 * 2;
constexpr size_t W_GU     = W_PLE  + 2048ull * 256 * 2;
constexpr size_t W_DN     = W_GU   + 32ull * 2048 * 2048 * 2;
constexpr size_t W_END    = W_DN   + 32ull * 2048 * 1024 * 2;
constexpr size_t WS_XB    = (W_END + MiB - 1) / MiB * MiB;
constexpr size_t WS_PB    = WS_XB  + (size_t)NTOK * DM * 2;
constexpr size_t WS_CUM   = WS_PB  + 2ull * NTOK * 256 * 2;
constexpr size_t WS_LF    = WS_CUM + 16ull * 8192 * 4;
constexpr size_t WS_XQ    = WS_LF  + 16ull * 8192 * 4;
constexpr size_t WS_XSC   = WS_XQ  + (size_t)NTOK * DM;
constexpr size_t WS_R     = (WS_XSC + (size_t)NTOK * 4 + MiB - 1) / MiB * MiB;
constexpr size_t R_SCORES = WS_R;
constexpr size_t R_OLAT   = WS_R;
constexpr size_t R_OA     = WS_R + 64 * MiB;
constexpr size_t R_OB     = WS_R + 96 * MiB;
constexpr size_t R_OC     = WS_R + 128 * MiB;
constexpr size_t R_TMP    = WS_R + 160 * MiB;
constexpr size_t R_MERGED = WS_R + 288 * MiB;
constexpr size_t R_PRE1   = WS_R + 384 * MiB;
constexpr size_t R_QA     = WS_R + 512 * MiB;
constexpr size_t R_QIDX   = WS_R + 544 * MiB;
constexpr size_t R_QKV    = WS_R + 576 * MiB;
constexpr size_t R_GATES  = WS_R + 768 * MiB;
constexpr size_t R_SMALL  = WS_R + 960 * MiB;
constexpr size_t R_QCAT   = WS_R + 992 * MiB;
constexpr size_t R_KCAT   = WS_R + 1064 * MiB;
constexpr size_t R_KI     = WS_R + 1073 * MiB;
constexpr size_t R_WI     = WS_R + 1075 * MiB;
constexpr size_t R_SEL    = WS_R + 1076 * MiB;
constexpr size_t R_NSEL   = WS_R + 1092 * MiB;
constexpr size_t R_END    = WS_R + 1093 * MiB;
constexpr size_t M_XS     = WS_R;
constexpr size_t M_HID    = WS_R + 288 * MiB;
constexpr size_t M_PP     = WS_R + 432 * MiB;
constexpr size_t M_X1F    = WS_R + 512 * MiB;
constexpr size_t M_X1B    = WS_R + 640 * MiB;
constexpr size_t M_HF     = WS_R + 704 * MiB;
constexpr size_t M_HQ     = WS_R + 704 * MiB;
constexpr size_t M_HSC    = WS_R + 736 * MiB;
constexpr size_t M_HB     = WS_R + 832 * MiB;
constexpr size_t M_TOKE   = WS_R + 896 * MiB;
constexpr size_t M_TOKPOS = M_TOKE + (size_t)NTOK * 16;
constexpr size_t M_TOKW   = M_TOKPOS + (size_t)NTOK * 16;
constexpr size_t M_TOKDST = M_TOKW + (size_t)NTOK * 16;
constexpr size_t M_ROWW   = M_TOKDST + (size_t)NTOK * 16;
constexpr size_t M_ROWSX  = M_ROWW + (size_t)PMAX * 4;
constexpr size_t M_X1S    = M_ROWSX + (size_t)PMAX * 4;
constexpr size_t M_X1Q    = WS_R + 900 * MiB;
constexpr size_t M_HM     = WS_R + 740 * MiB;
constexpr size_t M_H8     = WS_R + 752 * MiB;
constexpr size_t M_H8S    = WS_R + 826 * MiB;
constexpr size_t WS_NEED  = R_END;
constexpr int CW_BAR = 0;
constexpr int CW_CNT = 8192;
constexpr int CW_META = 4096 + 64;
constexpr int CW_QCTR = 6144;
constexpr int CW_WMAX = 6272;
constexpr int CW_WMAXG = 6336;
constexpr int CW_WMAXP = 6368;
constexpr int CW_WMAXD = 6384;
constexpr int CW_KMAX = 6400;
constexpr size_t CTL_BYTES = 65536;

constexpr int LDS_BYTES = 152576;
constexpr int LDS_MISC = 151552;

typedef float f32x2 __attribute__((ext_vector_type(2)));
typedef __bf16 bf16n2 __attribute__((ext_vector_type(2)));
__device__ __forceinline__ unsigned cvtpk(float lo, float hi) { f32x2 v = {lo, hi}; bf16n2 b = __builtin_convertvector(v, bf16n2); return __builtin_bit_cast(unsigned, b); }
__device__ __forceinline__ bf16_t f2bf(float x) { return (bf16_t)(cvtpk(x, 0.f) & 0xffffu); }
__device__ __forceinline__ float bf2f(bf16_t b) { return __uint_as_float(((unsigned)b) << 16); }
__device__ __forceinline__ float bflo(unsigned w) { return __uint_as_float(w << 16); }
__device__ __forceinline__ float bfhi(unsigned w) { return __uint_as_float(w & 0xffff0000u); }
__device__ __forceinline__ bf16x8 pack8(f32x4 a, f32x4 b) { u32x4 w = {cvtpk(a[0], a[1]), cvtpk(a[2], a[3]), cvtpk(b[0], b[1]), cvtpk(b[2], b[3])}; return *reinterpret_cast<bf16x8*>(&w); }
__device__ __forceinline__ float sigmoidf_(float x) { return 1.0f / (1.0f + __expf(-x)); }
__device__ __forceinline__ float wave_sum(float v) { for (int o = 32; o > 0; o >>= 1) v += __shfl_xor(v, o); return v; }
__device__ __forceinline__ int crow(int r, int hi) { return (r & 3) + 8 * (r >> 2) + 4 * hi; }
#define SBAR() __builtin_amdgcn_sched_barrier(0)

#define XB_TMO      128
#define XB_XCNT(j)  (256  + 64 * (j))
#define XB_XSUB(j)  (1280 + 64 * (j))
#define XB_XGEN(j)  (2304 + 64 * (j))
#define XB_TOP      3328
#define XB_TOPGEN   3392
#define XCD_BAR_WORDS 3456
#define XB_SPIN_CAP (1u << 22)
__device__ __forceinline__ unsigned xb_ld(unsigned* p)              { return __hip_atomic_load(p, __ATOMIC_RELAXED, __HIP_MEMORY_SCOPE_AGENT); }
__device__ __forceinline__ unsigned xb_add(unsigned* p, unsigned v) { return __hip_atomic_fetch_add(p, v, __ATOMIC_RELAXED, __HIP_MEMORY_SCOPE_AGENT); }
__device__ __forceinline__ unsigned xb_xcc_id() { return (unsigned)__builtin_amdgcn_s_getreg((3 << 11) | 20) & 0xFu; }
#define XB_SPIN(cond, bar) do { unsigned _sp = 0; while (cond) { __builtin_amdgcn_s_sleep(1); \
    if ((++_sp & 255u) == 0u) { if (xb_ld(&(bar)[XB_TMO])) break; if (_sp > XB_SPIN_CAP) { atomicAdd(&(bar)[XB_TMO], 1u); break; } } } } while (0)
struct XcdBarrier { unsigned* bar; unsigned x; volatile LAS unsigned* st; };
__device__ __forceinline__ XcdBarrier xcd_barrier_post(unsigned* bar, volatile LAS unsigned* st) {
    XcdBarrier b; b.bar = bar; b.x = xb_xcc_id(); b.st = st;
    if (threadIdx.x == 0) (void)xb_add(&bar[XB_XCNT(b.x)], 1u);
    return b;
}
__device__ __forceinline__ void xcd_barrier_complete(unsigned* bar, unsigned x, unsigned& nloc, unsigned& nx) {
    const unsigned G = gridDim.x * gridDim.y * gridDim.z;
    unsigned sum, cnt, mine, sp = 0u;
    for (;;) {
        sum = 0u; cnt = 0u; mine = 0u;
#pragma unroll
        for (unsigned j = 0; j < 16; ++j) { const unsigned c = xb_ld(&bar[XB_XCNT(j)]); sum += c; cnt += (c > 0u) ? 1u : 0u; mine = (j == x) ? c : mine; }
        if (sum == G) break;
        __builtin_amdgcn_s_sleep(1);
        if ((++sp & 255u) == 0u) { if (xb_ld(&bar[XB_TMO])) break; if (sp > XB_SPIN_CAP) { atomicAdd(&bar[XB_TMO], 1u); break; } }
    }
    nloc = mine > 0u ? mine : 1u; nx = cnt > 0u ? cnt : 1u;
}
__device__ __forceinline__ void xcd_barrier(const XcdBarrier& b) {
    asm volatile("s_waitcnt vmcnt(0)" ::: "memory");
    __syncthreads();
    if (threadIdx.x == 0) {
        unsigned* bar = b.bar;
        __builtin_amdgcn_s_waitcnt(0);
        unsigned nloc = b.st[0], nx = b.st[1];
        if (nloc == 0u) { xcd_barrier_complete(bar, b.x, nloc, nx); b.st[0] = nloc; b.st[1] = nx; }
        const unsigned old = xb_add(&bar[XB_XSUB(b.x)], 1u);
        const unsigned gen = old / nloc;
        if (old + 1u == (gen + 1u) * nloc) {
            __builtin_amdgcn_fence(__ATOMIC_RELEASE, "agent");
            asm volatile("s_waitcnt vmcnt(0)" ::: "memory");
            const unsigned og = xb_add(&bar[XB_TOP], 1u);
            const unsigned tg = og / nx;
            if (og + 1u == (tg + 1u) * nx) xb_add(&bar[XB_TOPGEN], 1u);
            else XB_SPIN(xb_ld(&bar[XB_TOPGEN]) == tg, bar);
            __builtin_amdgcn_fence(__ATOMIC_ACQUIRE, "agent");
            xb_add(&bar[XB_XGEN(b.x)], 1u);
            asm volatile("s_waitcnt vmcnt(0)" ::: "memory");
        } else {
            XB_SPIN(xb_ld(&bar[XB_XGEN(b.x)]) == gen, bar);
            __builtin_amdgcn_fence(__ATOMIC_ACQUIRE, "agent");
            asm volatile("s_waitcnt vmcnt(0)" ::: "memory");
        }
    }
    __syncthreads();
}

namespace pg8 {
constexpr int BM = 256, BK = 64, HALF = 128, HTB = HALF * BK * 2, STAGE_BYTES = 8 * HTB, NXCD = 8, WGM = 8;
__device__ __forceinline__ int lds_byte(int r, int c) { const int st = (r >> 4) * 2 + (c >> 5), rr = r & 15, cc = c & 31, ob = rr * 64 + cc * 2; return st * 1024 + (ob ^ (((ob >> 9) & 1) << 5)); }
__device__ __forceinline__ void stage_rc(int b, int& R, int& C) { const int st = b / 1024, sb = b % 1024, swz = sb ^ (((sb >> 9) & 1) << 5); R = (st >> 1) * 16 + swz / 64; C = (st & 1) * 32 + (swz % 64) / 2; }
__device__ __forceinline__ int perm32(int rho) { const int n = rho >> 4, i = rho & 15; return 8 * (i >> 2) + 4 * n + (i & 3); }
struct Unit { int pm, pn, e; };
struct SchedS {
    int nM, nN, nwg, G, c; const bf16_t* A; const bf16_t* B; int lda, ldb, a_sh, a_mul, skip_from = 1 << 30, skip_by = 0, skip_from2 = 1 << 30, skip_by2 = 0, b_compact = 0;
    __device__ void init(int M, int N, int G_, int c_, const bf16_t* A_, int lda_, const bf16_t* B_, int ldb_, int a_sh_ = 0, int a_mul_ = 0) {
        nM = M / BM; nN = N / BM; nwg = nM * nN; G = G_; c = c_; A = A_; B = B_; lda = lda_; ldb = ldb_; a_sh = a_sh_; a_mul = a_mul_; }
    __device__ __forceinline__ bool next(int i, Unit& u) const {
        const long L = (long)i * G + c; if (L >= nwg) return false;
        int wgid = (int)L; { const int q = nwg / NXCD, r = nwg % NXCD, xcd = wgid % NXCD, off = wgid / NXCD; wgid = (xcd < r ? xcd * (q + 1) : r * (q + 1) + (xcd - r) * q) + off; }
        const int nig = WGM * nN, gid = wgid / nig, fm = gid * WGM, gsz = (nM - fm) < WGM ? (nM - fm) : WGM;
        u.pm = fm + ((wgid % nig) % gsz); u.pn = (wgid % nig) / gsz; u.e = 0;
        u.e = u.pn;
        { const int ci = u.pn; if (ci >= skip_from) u.pn += skip_by; if (ci >= skip_from2) u.pn += skip_by2; }
        return true;
    }
    __device__ __forceinline__ const char* pa(const Unit& u) const { return (const char*)(A + (size_t)u.pm * BM * lda + (size_t)((u.pn >> a_sh) * a_mul)); }
    __device__ __forceinline__ const char* pb(const Unit& u) const { return (const char*)(B + (size_t)(b_compact ? u.e : u.pn) * BM * ldb); }
};
struct SchedM {
    int ntiles, G, c; const bf16_t* A; const bf16_t* W; int lda, ldb; const unsigned* tile_e;
    __device__ void init(const unsigned* meta, int G_, int c_, const bf16_t* A_, int lda_, const bf16_t* W_, int ldb_) {
        ntiles = (int)meta[0]; tile_e = meta + 1; G = G_; c = c_; A = A_; W = W_; lda = lda_; ldb = ldb_; }
    __device__ __forceinline__ bool next(int i, Unit& u) const {
        const long L = (long)i * G + c; if (L >= (long)ntiles * 8) return false;
        u.pm = (int)(L >> 3); u.pn = (int)(L & 7); u.e = (int)tile_e[u.pm];
        return true;
    }
    __device__ __forceinline__ const char* pa(const Unit& u) const { return (const char*)(A + (size_t)u.pm * BM * lda); }
    __device__ __forceinline__ const char* pb(const Unit& u) const { return (const char*)(W + ((size_t)u.e * 2048 + (size_t)u.pn * BM) * ldb); }
};

template <class Epi, class Sched>
__device__ __forceinline__ void gemm_phase(LAS unsigned char* lds, const int K, const int lda, const int ldb, const Sched& S, const Epi& E) {
    int tid = threadIdx.x; asm volatile("" : "+v"(tid));
    const int wid = __builtin_amdgcn_readfirstlane(tid >> 6), lane = tid & 63, wr = wid >> 2, wc = wid & 3, fr = lane & 15, fq = lane >> 4;
    const int nt = K / BK;
    unsigned voffA[2], voffB[2];
#pragma unroll
    for (int i = 0; i < 2; ++i) { int R, C; stage_rc(tid * 16 + i * 8192, R, C); const int Rb = (R & ~31) + perm32(R & 31);
        voffA[i] = (unsigned)(R * lda + C) * 2u; voffB[i] = (unsigned)(Rb * ldb + C) * 2u; }
    const size_t kstep = (size_t)(BK * 2);
    const size_t hstepA = (size_t)HALF * lda * 2, hstepB = (size_t)HALF * ldb * 2;
    const unsigned ldsw = (unsigned)wid * 1024u;
    const int aoff = lds_byte(wr * 64 + fr, fq * 8), boff = lds_byte(wc * 32 + fr, fq * 8);
#define PG8_SA(b, h) (((b) * 2 + (h)) * HTB)
#define PG8_SB(b, h) ((4 + (b) * 2 + (h)) * HTB)
#define PG8_STAGE(bufoff, gbase, voff) do { _Pragma("unroll") for (int _i = 0; _i < 2; ++_i) \
        __builtin_amdgcn_global_load_lds((const unsigned*)((const char*)(gbase) + (voff)[_i]), (LAS unsigned*)(lds + (bufoff) + ldsw + _i * 8192), 16, 0, 0); } while (0)
#define PG8_LDA(dst, b, h) do { _Pragma("unroll") for (int m = 0; m < 4; ++m) _Pragma("unroll") for (int k = 0; k < 2; ++k) dst[m][k] = *(const LAS bf16x8*)(lds + PG8_SA(b, h) + aoff + m * 2048 + k * 1024); } while (0)
#define PG8_LDB(dst, b, h) do { _Pragma("unroll") for (int n = 0; n < 2; ++n) _Pragma("unroll") for (int k = 0; k < 2; ++k) dst[n][k] = *(const LAS bf16x8*)(lds + PG8_SB(b, h) + boff + n * 2048 + k * 1024); } while (0)
#define PG8_MMA(ai, bj, At, Bt) do { __builtin_amdgcn_s_setprio(1); _Pragma("unroll") for (int m = 0; m < 4; ++m) _Pragma("unroll") for (int n = 0; n < 2; ++n) _Pragma("unroll") for (int k = 0; k < 2; ++k) \
        { if constexpr (Epi::I8) acc[ai][bj][m][n] = __builtin_bit_cast(f32x4, __builtin_amdgcn_mfma_i32_16x16x64_i8(__builtin_bit_cast(i32x4, Bt[n][k]), __builtin_bit_cast(i32x4, At[m][k]), __builtin_bit_cast(i32x4, acc[ai][bj][m][n]), 0, 0, 0)); \
          else acc[ai][bj][m][n] = __builtin_amdgcn_mfma_f32_16x16x32_bf16(Bt[n][k], At[m][k], acc[ai][bj][m][n], 0, 0, 0); } __builtin_amdgcn_s_setprio(0); } while (0)
#define PG8_WAIT_V(n) asm volatile("s_waitcnt vmcnt(" #n ")" ::: "memory")
#define PG8_WAIT_L(n) asm volatile("s_waitcnt lgkmcnt(" #n ")" ::: "memory")
#define PG8_BAR __builtin_amdgcn_s_barrier()
#define PG8_SCHED __builtin_amdgcn_sched_barrier(0)
    Unit cur, nxt; int ui = 0;
    if (!S.next(0, cur)) return;
    f32x4 acc[2][2][4][2];
#pragma unroll
    for (int a = 0; a < 2; ++a)
#pragma unroll
        for (int b = 0; b < 2; ++b)
#pragma unroll
            for (int m = 0; m < 4; ++m)
#pragma unroll
                for (int n = 0; n < 2; ++n) acc[a][b][m][n] = (f32x4){0.f, 0.f, 0.f, 0.f};
    bf16x8 At[4][2], B0[2][2], B1[2][2];
    const char* cA = S.pa(cur); const char* cB = S.pb(cur);
    PG8_STAGE(PG8_SB(0, 0), cB, voffB); PG8_STAGE(PG8_SA(0, 0), cA, voffA); PG8_STAGE(PG8_SB(0, 1), cB + hstepB, voffB); PG8_STAGE(PG8_SA(0, 1), cA + hstepA, voffA);
    if (wr == 1) PG8_BAR;
    PG8_WAIT_V(4); PG8_BAR;
    PG8_STAGE(PG8_SB(1, 0), cB + kstep, voffB); PG8_STAGE(PG8_SA(1, 0), cA + kstep, voffA); PG8_STAGE(PG8_SB(1, 1), cB + hstepB + kstep, voffB);
    PG8_WAIT_V(6); PG8_BAR;
    for (;;) {
        const bool has_next = S.next(ui + 1, nxt);
        const char* nA = has_next ? S.pa(nxt) : cA; const char* nB = has_next ? S.pb(nxt) : cB;
        for (int t = 0; t < nt; t += 2) {
            const bool last = (t == nt - 2);
            if constexpr (Epi::HAS_MID) { if (t == Epi::MID1 || t == Epi::MID2) { int frM = fr, fqM = fq; asm volatile("" : "+v"(frM), "+v"(fqM)); E.mid(acc, cur, t, wr, wc, frM, fqM); } }
            const char* a1 = cA + (size_t)(t + 1) * kstep;
            const char* a2 = last ? nA : cA + (size_t)(t + 2) * kstep; const char* b2 = last ? nB : cB + (size_t)(t + 2) * kstep;
            const char* a3 = a2 + kstep; const char* b3 = b2 + kstep;
            PG8_LDB(B0, 0, 0); PG8_SCHED; PG8_LDA(At, 0, 0); PG8_STAGE(PG8_SA(1, 1), a1 + hstepA, voffA);
            PG8_WAIT_L(8); PG8_BAR; PG8_WAIT_L(0); PG8_MMA(0, 0, At, B0); PG8_BAR; PG8_SCHED;
            PG8_LDB(B1, 0, 1); PG8_STAGE(PG8_SB(0, 0), b2, voffB);
            PG8_BAR; PG8_WAIT_L(0); PG8_MMA(0, 1, At, B1); PG8_BAR;
            PG8_LDA(At, 0, 1); PG8_STAGE(PG8_SA(0, 0), a2, voffA);
            PG8_BAR; PG8_WAIT_L(0); PG8_MMA(1, 0, At, B0); PG8_BAR; PG8_SCHED;
            PG8_STAGE(PG8_SB(0, 1), b2 + hstepB, voffB);
            PG8_WAIT_V(6); PG8_BAR; PG8_MMA(1, 1, At, B1); PG8_BAR;
            PG8_LDB(B0, 1, 0); PG8_SCHED; PG8_LDA(At, 1, 0); PG8_STAGE(PG8_SA(0, 1), a2 + hstepA, voffA);
            PG8_WAIT_L(8); PG8_BAR; PG8_WAIT_L(0); PG8_MMA(0, 0, At, B0); PG8_BAR; PG8_SCHED;
            PG8_LDB(B1, 1, 1); PG8_STAGE(PG8_SB(1, 0), b3, voffB);
            PG8_BAR; PG8_WAIT_L(0); PG8_MMA(0, 1, At, B1); PG8_BAR;
            PG8_LDA(At, 1, 1); PG8_STAGE(PG8_SA(1, 0), a3, voffA);
            PG8_BAR; PG8_WAIT_L(0); PG8_MMA(1, 0, At, B0); PG8_BAR; PG8_SCHED;
            PG8_STAGE(PG8_SB(1, 1), b3 + hstepB, voffB);
            PG8_WAIT_V(6); PG8_BAR; PG8_MMA(1, 1, At, B1); PG8_BAR;
        }
        { int frE = fr, fqE = fq; asm volatile("" : "+v"(frE), "+v"(fqE)); E(acc, cur, wr, wc, frE, fqE); }
        if (!has_next) break;
#pragma unroll
        for (int a = 0; a < 2; ++a)
#pragma unroll
            for (int b = 0; b < 2; ++b)
#pragma unroll
                for (int m = 0; m < 4; ++m)
#pragma unroll
                    for (int n = 0; n < 2; ++n) acc[a][b][m][n] = (f32x4){0.f, 0.f, 0.f, 0.f};
        cur = nxt; cA = nA; cB = nB; ++ui;
    }
    PG8_WAIT_V(0);
    if (wr == 0) PG8_BAR;
    PG8_BAR;
#undef PG8_SA
#undef PG8_SB
#undef PG8_STAGE
#undef PG8_LDA
#undef PG8_LDB
#undef PG8_MMA
#undef PG8_WAIT_V
#undef PG8_WAIT_L
#undef PG8_BAR
#undef PG8_SCHED
}

#define EPI_LOOP_ROWS _Pragma("unroll") for (int ai = 0; ai < 2; ++ai) _Pragma("unroll") for (int m = 0; m < 4; ++m)
__device__ __forceinline__ void st_bf16x8(bf16_t* p, f32x4 v0, f32x4 v1) { u32x4 w; w.x = cvtpk(v0[0], v0[1]); w.y = cvtpk(v0[2], v0[3]); w.z = cvtpk(v1[0], v1[1]); w.w = cvtpk(v1[2], v1[3]); *(u32x4*)p = w; }

template <bool I8_> struct EpiInProj {
    static constexpr bool HAS_MID = false; static constexpr bool I8 = I8_;
    bf16_t* qa; bf16_t* qidx; bf16_t* qkv; bf16_t* gates; float* small_; const float* xs; const unsigned* wmaxbits;
    __device__ __forceinline__ f32x4 val(const f32x4& a, float sc) const { if constexpr (I8_) { const i32x4 v = __builtin_bit_cast(i32x4, a); return (f32x4){(float)v[0], (float)v[1], (float)v[2], (float)v[3]} * sc; } else return a; }
    __device__ __forceinline__ void operator()(const f32x4 (&acc)[2][2][4][2], const Unit& u, int wr, int wc, int fr, int fq) const {
        const int pn = u.pn, row0 = u.pm * BM + wr * 64 + fr, lc0 = wc * 32 + fq * 8;
        float sw = 0.f; if constexpr (I8_) sw = __uint_as_float(*wmaxbits) * (1.3f / 127.0f);
        float scs[2][4];
#pragma unroll
        for (int ai = 0; ai < 2; ++ai)
#pragma unroll
            for (int m = 0; m < 4; ++m) { scs[ai][m] = 0.f; if constexpr (I8_) scs[ai][m] = xs[row0 + ai * HALF + m * 16] * sw; }
        if (pn < 8) {
            bf16_t* base = (pn < 4 ? qa + pn * 256 : qidx + (pn - 4) * 256) + lc0;
            EPI_LOOP_ROWS { const int row = row0 + ai * HALF + m * 16; const float sc = scs[ai][m];
#pragma unroll
                for (int bj = 0; bj < 2; ++bj) st_bf16x8(base + (size_t)row * 1024 + bj * HALF, val(acc[ai][bj][m][0], sc), val(acc[ai][bj][m][1], sc)); }
        } else if (pn < 32) {
            const int id = (pn - 8) >> 2, hb = ((pn - 8) & 3) * 2, b = u.pm >> 5;
            bf16_t* base = qkv + (size_t)id * ((size_t)NTOK * 1024) + lc0;
            EPI_LOOP_ROWS { const int row = row0 + ai * HALF + m * 16, s = row & (SEQ - 1); const float sc = scs[ai][m];
#pragma unroll
                for (int bj = 0; bj < 2; ++bj) st_bf16x8(base + ((size_t)(b * 8 + hb + bj) * SEQ + s) * 128, val(acc[ai][bj][m][0], sc), val(acc[ai][bj][m][1], sc)); }
        } else if (pn < 56) {
            unsigned char* base = (unsigned char*)gates + (pn - 32) * 256 + lc0;
            EPI_LOOP_ROWS { const int row = row0 + ai * HALF + m * 16; const float sc = scs[ai][m];
#pragma unroll
                for (int bj = 0; bj < 2; ++bj) { const f32x4 v0 = val(acc[ai][bj][m][0], sc), v1 = val(acc[ai][bj][m][1], sc); u32x2 w; unsigned p0 = 0u, p1 = 0u;
#pragma unroll
                    for (int j = 0; j < 4; ++j) { p0 |= (unsigned)(int)fmaxf(rintf(255.0f * sigmoidf_(v0[j])), 1.0f) << (8 * j); p1 |= (unsigned)(int)fmaxf(rintf(255.0f * sigmoidf_(v1[j])), 1.0f) << (8 * j); }
                    w.x = p0; w.y = p1; *(u32x2*)(base + (size_t)row * 6144 + bj * HALF) = w; } }
        } else {
            float* base = small_ + (pn - 56) * 256 + lc0;
            EPI_LOOP_ROWS { const int row = row0 + ai * HALF + m * 16; const float sc = scs[ai][m];
#pragma unroll
                for (int bj = 0; bj < 2; ++bj) { float* p = base + (size_t)row * 512 + bj * HALF; *(f32x4*)p = val(acc[ai][bj][m][0], sc); *(f32x4*)(p + 4) = val(acc[ai][bj][m][1], sc); } }
        }
    }
};
struct EpiBf16 {
    static constexpr bool HAS_MID = false; static constexpr bool I8 = false;
    bf16_t* out; int ld, cstep;
    __device__ __forceinline__ void operator()(const f32x4 (&acc)[2][2][4][2], const Unit& u, int wr, int wc, int fr, int fq) const {
        const int row0 = u.pm * BM + wr * 64 + fr; bf16_t* base = out + (size_t)u.pn * cstep + wc * 32 + fq * 8;
        EPI_LOOP_ROWS { const int row = row0 + ai * HALF + m * 16;
#pragma unroll
            for (int bj = 0; bj < 2; ++bj) st_bf16x8(base + (size_t)row * ld + bj * HALF, acc[ai][bj][m][0], acc[ai][bj][m][1]); }
    }
};
struct EpiBranch3 {
    static constexpr bool HAS_MID = true; static constexpr bool I8 = false; static constexpr int MID1 = 16, MID2 = 32;
    const unsigned char* gates; bf16_t* merged;
    __device__ __forceinline__ static f32x4 rat(unsigned n, unsigned d) {
        f32x4 r; r[0] = (float)(n & 255u) * __builtin_amdgcn_rcpf((float)(d & 255u)); r[1] = (float)((n >> 8) & 255u) * __builtin_amdgcn_rcpf((float)((d >> 8) & 255u));
        r[2] = (float)((n >> 16) & 255u) * __builtin_amdgcn_rcpf((float)((d >> 16) & 255u)); r[3] = (float)(n >> 24) * __builtin_amdgcn_rcpf((float)(d >> 24)); return r; }
    __device__ __forceinline__ void mid(f32x4 (&acc)[2][2][4][2], const Unit& u, int t, int wr, int wc, int fr, int fq) const {
        const int row0 = u.pm * BM + wr * 64 + fr, col0 = u.pn * BM + wc * 32 + fq * 8, bn = (t == MID1) ? 0 : 2048;
        u32x2 gn[2][4][2], gd[2][4][2];
        EPI_LOOP_ROWS {
#pragma unroll
            for (int bj = 0; bj < 2; ++bj) { const unsigned char* gp = gates + (size_t)(row0 + ai * HALF + m * 16) * 6144 + bn + col0 + bj * HALF; gn[ai][m][bj] = *(const u32x2*)gp; gd[ai][m][bj] = *(const u32x2*)(gp + 2048); } }
        EPI_LOOP_ROWS {
#pragma unroll
            for (int bj = 0; bj < 2; ++bj) { acc[ai][bj][m][0] *= rat(gn[ai][m][bj].x, gd[ai][m][bj].x); acc[ai][bj][m][1] *= rat(gn[ai][m][bj].y, gd[ai][m][bj].y); } }
    }
    __device__ __forceinline__ void operator()(const f32x4 (&acc)[2][2][4][2], const Unit& u, int wr, int wc, int fr, int fq) const {
        const int row0 = u.pm * BM + wr * 64 + fr, col0 = u.pn * BM + wc * 32 + fq * 8;
        u32x2 gl[2][4][2];
        EPI_LOOP_ROWS {
#pragma unroll
            for (int bj = 0; bj < 2; ++bj) gl[ai][m][bj] = *(const u32x2*)(gates + (size_t)(row0 + ai * HALF + m * 16) * 6144 + 4096 + col0 + bj * HALF); }
        EPI_LOOP_ROWS { const int row = row0 + ai * HALF + m * 16;
#pragma unroll
            for (int bj = 0; bj < 2; ++bj) { const int col = col0 + bj * HALF; const u32x2 gw = gl[ai][m][bj]; constexpr float I255 = 1.0f / 255.0f;
                f32x4 v0 = acc[ai][bj][m][0], v1 = acc[ai][bj][m][1];
                v0[0] *= (float)(gw.x & 255u) * I255; v0[1] *= (float)((gw.x >> 8) & 255u) * I255; v0[2] *= (float)((gw.x >> 16) & 255u) * I255; v0[3] *= (float)(gw.x >> 24) * I255;
                v1[0] *= (float)(gw.y & 255u) * I255; v1[1] *= (float)((gw.y >> 8) & 255u) * I255; v1[2] *= (float)((gw.y >> 16) & 255u) * I255; v1[3] *= (float)(gw.y >> 24) * I255;
                st_bf16x8(merged + (size_t)row * 2048 + col, v0, v1); } }
    }
};
struct EpiOut {
    static constexpr bool HAS_MID = false; static constexpr bool I8 = false;
    const bf16_t* res; bf16_t* pre;
    __device__ __forceinline__ void operator()(const f32x4 (&acc)[2][2][4][2], const Unit& u, int wr, int wc, int fr, int fq) const {
        const int row0 = u.pm * BM + wr * 64 + fr, col0 = u.pn * BM + wc * 32 + fq * 8;
        u32x4 rl[2][4][2];
        EPI_LOOP_ROWS { const int row = row0 + ai * HALF + m * 16;
#pragma unroll
            for (int bj = 0; bj < 2; ++bj) rl[ai][m][bj] = *(const u32x4*)(res + (size_t)row * 2048 + col0 + bj * HALF); }
        EPI_LOOP_ROWS { const int row = row0 + ai * HALF + m * 16;
#pragma unroll
            for (int bj = 0; bj < 2; ++bj) { const size_t o = (size_t)row * 2048 + col0 + bj * HALF;
                const u32x4 rw = rl[ai][m][bj]; f32x4 v0 = acc[ai][bj][m][0], v1 = acc[ai][bj][m][1];
                v0[0] += ALPHA * bflo(rw.x); v0[1] += ALPHA * bfhi(rw.x); v0[2] += ALPHA * bflo(rw.y); v0[3] += ALPHA * bfhi(rw.y);
                v1[0] += ALPHA * bflo(rw.z); v1[1] += ALPHA * bfhi(rw.z); v1[2] += ALPHA * bflo(rw.w); v1[3] += ALPHA * bfhi(rw.w);
                st_bf16x8(pre + o, v0, v1); } }
    }
};
struct EpiGateUpI8 {
    static constexpr bool HAS_MID = false; static constexpr bool I8 = true;
    const float* bg; const float* bu; bf16_t* hid; const float* rowsx; const unsigned* wmaxbits; float* hm;
    __device__ __forceinline__ void operator()(const f32x4 (&acc)[2][2][4][2], const Unit& u, int wr, int wc, int fr, int fq) const {
        const int row0 = u.pm * BM + wr * 64 + fr, j0 = u.pn * 128 + wc * 32 + fq * 8;
        const float sw = __uint_as_float(*wmaxbits) * (1.3f / 127.0f);
        const float* pg = bg + (size_t)u.e * DEXP + j0; const float* pu = bu + (size_t)u.e * DEXP + j0;
        const f32x4 g0b = *(const f32x4*)pg, g1b = *(const f32x4*)(pg + 4), u0b = *(const f32x4*)pu, u1b = *(const f32x4*)(pu + 4);
        float scs[2][4];
#pragma unroll
        for (int ai = 0; ai < 2; ++ai)
#pragma unroll
            for (int m = 0; m < 4; ++m) scs[ai][m] = rowsx[row0 + ai * HALF + m * 16] * sw;
        EPI_LOOP_ROWS { const int row = row0 + ai * HALF + m * 16; const float sc = scs[ai][m];
            const i32x4 ag0 = __builtin_bit_cast(i32x4, acc[ai][0][m][0]), ag1 = __builtin_bit_cast(i32x4, acc[ai][0][m][1]), au0 = __builtin_bit_cast(i32x4, acc[ai][1][m][0]), au1 = __builtin_bit_cast(i32x4, acc[ai][1][m][1]);
            f32x4 h0, h1;
#pragma unroll
            for (int j = 0; j < 4; ++j) {
                float g = fminf((float)ag0[j] * sc + g0b[j], 7.0f), uu = fminf(fmaxf((float)au0[j] * sc + u0b[j], -7.0f), 7.0f);
                h0[j] = (uu + 1.0f) * (g * sigmoidf_(1.702f * g));
                g = fminf((float)ag1[j] * sc + g1b[j], 7.0f); uu = fminf(fmaxf((float)au1[j] * sc + u1b[j], -7.0f), 7.0f);
                h1[j] = (uu + 1.0f) * (g * sigmoidf_(1.702f * g)); }
            st_bf16x8(hid + (size_t)row * DEXP + j0, h0, h1);
            float am = fmaxf(fmaxf(fmaxf(fabsf(h0[0]), fabsf(h0[1])), fmaxf(fabsf(h0[2]), fabsf(h0[3]))), fmaxf(fmaxf(fabsf(h1[0]), fabsf(h1[1])), fmaxf(fabsf(h1[2]), fabsf(h1[3]))));
            am = fmaxf(am, __shfl_xor(am, 16)); am = fmaxf(am, __shfl_xor(am, 32));
            if (fq == 0) hm[(size_t)row * 32 + u.pn * 4 + wc] = am; }
    }
};
struct EpiDown {
    static constexpr bool HAS_MID = false; static constexpr bool I8 = false;
    const float* bd; const float* roww; bf16_t* ys;
    __device__ __forceinline__ void operator()(const f32x4 (&acc)[2][2][4][2], const Unit& u, int wr, int wc, int fr, int fq) const {
        const int row0 = u.pm * BM + wr * 64 + fr, col0 = u.pn * BM + wc * 32 + fq * 8;
        f32x4 b[2][2];
#pragma unroll
        for (int bj = 0; bj < 2; ++bj) { const float* p = bd + (size_t)u.e * DM + col0 + bj * HALF; b[bj][0] = *(const f32x4*)p; b[bj][1] = *(const f32x4*)(p + 4); }
        float rws[2][4];
#pragma unroll
        for (int ai = 0; ai < 2; ++ai)
#pragma unroll
            for (int m = 0; m < 4; ++m) rws[ai][m] = roww[row0 + ai * HALF + m * 16];
        EPI_LOOP_ROWS { const int row = row0 + ai * HALF + m * 16; const float w = rws[ai][m];
#pragma unroll
            for (int bj = 0; bj < 2; ++bj) st_bf16x8(ys + (size_t)row * 2048 + col0 + bj * HALF, (acc[ai][bj][m][0] + b[bj][0]) * w, (acc[ai][bj][m][1] + b[bj][1]) * w); }
    }
};
struct EpiDownI8 {
    static constexpr bool HAS_MID = false; static constexpr bool I8 = true;
    const float* bd; const float* roww; bf16_t* ys; const float* h8s; const unsigned* wmaxbits;
    __device__ __forceinline__ void operator()(const f32x4 (&acc)[2][2][4][2], const Unit& u, int wr, int wc, int fr, int fq) const {
        const int row0 = u.pm * BM + wr * 64 + fr, col0 = u.pn * BM + wc * 32 + fq * 8;
        const float sw = __uint_as_float(*wmaxbits) * (1.3f / 127.0f);
        f32x4 b[2][2];
#pragma unroll
        for (int bj = 0; bj < 2; ++bj) { const float* p = bd + (size_t)u.e * DM + col0 + bj * HALF; b[bj][0] = *(const f32x4*)p; b[bj][1] = *(const f32x4*)(p + 4); }
        float rws[2][4], scs[2][4];
#pragma unroll
        for (int ai = 0; ai < 2; ++ai)
#pragma unroll
            for (int m = 0; m < 4; ++m) { rws[ai][m] = roww[row0 + ai * HALF + m * 16]; scs[ai][m] = h8s[row0 + ai * HALF + m * 16] * sw; }
        EPI_LOOP_ROWS { const int row = row0 + ai * HALF + m * 16; const float w = rws[ai][m], sc = scs[ai][m];
#pragma unroll
            for (int bj = 0; bj < 2; ++bj) { const i32x4 a0 = __builtin_bit_cast(i32x4, acc[ai][bj][m][0]), a1 = __builtin_bit_cast(i32x4, acc[ai][bj][m][1]);
                const f32x4 v0 = (f32x4){(float)a0[0], (float)a0[1], (float)a0[2], (float)a0[3]} * sc, v1 = (f32x4){(float)a1[0], (float)a1[1], (float)a1[2], (float)a1[3]} * sc;
                st_bf16x8(ys + (size_t)row * 2048 + col0 + bj * HALF, (v0 + b[bj][0]) * w, (v1 + b[bj][1]) * w); } }
    }
};
struct EpiPleGateI8 {
    static constexpr bool HAS_MID = false; static constexpr bool I8 = true;
    const bf16_t* hb; const bf16_t* pp; bf16_t* pre; const float* hs; const unsigned* wmaxbits;
    __device__ __forceinline__ void operator()(const f32x4 (&acc)[2][2][4][2], const Unit& u, int wr, int wc, int fr, int fq) const {
        const int row0 = u.pm * BM + wr * 64 + fr, col0 = u.pn * BM + wc * 32 + fq * 8;
        const float sw = __uint_as_float(*wmaxbits) * (1.3f / 127.0f);
#pragma unroll
        for (int ai = 0; ai < 2; ++ai) { u32x4 pl[4][2], hl[4][2]; float scs[4];
#pragma unroll
            for (int m = 0; m < 4; ++m) { scs[m] = hs[row0 + ai * HALF + m * 16] * sw;
#pragma unroll
                for (int bj = 0; bj < 2; ++bj) { const size_t o = (size_t)(row0 + ai * HALF + m * 16) * 2048 + col0 + bj * HALF; pl[m][bj] = *(const u32x4*)(pp + o); hl[m][bj] = *(const u32x4*)(hb + o); } }
#pragma unroll
            for (int m = 0; m < 4; ++m) { const float sc = scs[m];
#pragma unroll
                for (int bj = 0; bj < 2; ++bj) { const size_t o = (size_t)(row0 + ai * HALF + m * 16) * 2048 + col0 + bj * HALF; const u32x4 pw = pl[m][bj], hw = hl[m][bj];
                    const i32x4 a0 = __builtin_bit_cast(i32x4, acc[ai][bj][m][0]), a1 = __builtin_bit_cast(i32x4, acc[ai][bj][m][1]); f32x4 o0, o1;
                    o0[0] = bflo(hw.x) + sigmoidf_((float)a0[0] * sc) * bflo(pw.x); o0[1] = bfhi(hw.x) + sigmoidf_((float)a0[1] * sc) * bfhi(pw.x); o0[2] = bflo(hw.y) + sigmoidf_((float)a0[2] * sc) * bflo(pw.y); o0[3] = bfhi(hw.y) + sigmoidf_((float)a0[3] * sc) * bfhi(pw.y);
                    o1[0] = bflo(hw.z) + sigmoidf_((float)a1[0] * sc) * bflo(pw.z); o1[1] = bfhi(hw.z) + sigmoidf_((float)a1[1] * sc) * bfhi(pw.z); o1[2] = bflo(hw.w) + sigmoidf_((float)a1[2] * sc) * bflo(pw.w); o1[3] = bfhi(hw.w) + sigmoidf_((float)a1[3] * sc) * bfhi(pw.w);
                    st_bf16x8(pre + o, o0, o1); } } }
    }
};
}

struct Params { const float* in[25]; float* out; unsigned char* ws; int ph_lo, ph_hi; };
__constant__ float c_invf_r[16] = {1.000000000e+00f, 4.403665960e-01f, 1.939227432e-01f, 8.539710194e-02f, 3.760603070e-02f, 1.656043902e-02f, 7.292664610e-03f, 3.211445874e-03f, 1.414213562e-03f, 6.227723788e-04f, 2.742481884e-04f, 1.207697351e-04f, 5.318296098e-05f, 2.341999971e-05f, 1.031338616e-05f, 4.541670478e-06f};
__constant__ float c_invf_i[8] = {1.000000000e+00f, 1.939227432e-01f, 3.760603070e-02f, 7.292664610e-03f, 1.414213562e-03f, 2.742481884e-04f, 5.318296098e-05f, 1.031338616e-05f};
constexpr int LDS_PTRS = LDS_MISC + 256;
struct Frame { unsigned char* lds; LAS unsigned char* ldsl; unsigned char* ws; int tid, lane, wid, G, bid;
    __device__ __forceinline__ const float* in(int k) const { const LAS unsigned* t = (const LAS unsigned*)(ldsl + LDS_PTRS) + 2 * k;
        const unsigned lo = __builtin_amdgcn_readfirstlane(t[0]), hi = __builtin_amdgcn_readfirstlane(t[1]); return (const float*)(const GAS float*)(((unsigned long long)hi << 32) | lo); }
    __device__ __forceinline__ float* out() const { return (float*)in(25); } };
__device__ __forceinline__ Frame fresh(const Frame& F0) { Frame F = F0; int t = threadIdx.x; asm volatile("" : "+v"(t)); F.tid = t; F.lane = t & 63; F.wid = __builtin_amdgcn_readfirstlane(t >> 6); size_t z = 0; asm volatile("" : "+s"(z)); F.ws = F0.ws + z; return F; }

struct TcTile { const float* src; long sld; bf16_t* dst; long dld; int nvalid; float qinv; };
template <class Dec>
__device__ __forceinline__ void tconv_run(const Frame& F, int total, const Dec& dec, int& rot) {
    float* tile = (float*)F.lds;
    const int tid = F.tid, G = F.G;
    const int start = (F.bid - (rot % G) + G) % G; rot += total >> 2;
    const int lr = tid >> 4, lc4 = (tid & 15) * 4, sn = tid >> 3, skc = (tid & 7) * 8;
    f32x4 v[4][2];
#define TC_ISSUE(t0_) do { _Pragma("unroll") for (int q = 0; q < 4; ++q) { const int t = (t0_) * 4 + q; \
        if (t < total) { const TcTile ti = dec(dec.remap(t)); _Pragma("unroll") for (int h = 0; h < 2; ++h) { v[q][h] = (f32x4){0.f, 0.f, 0.f, 0.f}; \
            if (lc4 < ti.nvalid) v[q][h] = *(const GAS f32x4*)((const GAS float*)ti.src + (size_t)(lr + 32 * h) * ti.sld + lc4); } } } } while (0)
    if (start * 4 < total) TC_ISSUE(start);
    for (int t0 = start; t0 * 4 < total; t0 += G) {
#pragma unroll
        for (int q = 0; q < 4; ++q) { if (t0 * 4 + q < total) { float* tl = tile + q * (64 * 65);
#pragma unroll
                for (int h = 0; h < 2; ++h) { float* p = tl + (lr + 32 * h) * 65 + lc4; p[0] = v[q][h][0]; p[1] = v[q][h][1]; p[2] = v[q][h][2]; p[3] = v[q][h][3]; } } }
        __syncthreads();
        if ((t0 + G) * 4 < total) TC_ISSUE(t0 + G);
#pragma unroll
        for (int q = 0; q < 4; ++q) { const int t = t0 * 4 + q;
            if (t < total) { const TcTile ti = dec(dec.remap(t)); const float* tl = tile + q * (64 * 65);
                if (ti.qinv > 0.f) { if (tid < 256) { const int n8 = tid >> 2, kc = (tid & 3) * 16; u32x4 w;
#pragma unroll
                        for (int d = 0; d < 4; ++d) { unsigned pk = 0u;
#pragma unroll
                            for (int j = 0; j < 4; ++j) { float q = rintf(tl[(kc + d * 4 + j) * 65 + n8] * ti.qinv); q = fminf(fmaxf(q, -127.f), 127.f); pk |= ((unsigned)(int)q & 0xffu) << (8 * j); }
                            w[d] = pk; }
                        *(u32x4*)((unsigned char*)ti.dst + (size_t)n8 * ti.dld + kc) = w; } }
                else if (sn < ti.nvalid) { f32x4 a, b;
#pragma unroll
                    for (int j = 0; j < 4; ++j) { a[j] = tl[(skc + j) * 65 + sn]; b[j] = tl[(skc + 4 + j) * 65 + sn]; }
                    pg8::st_bf16x8(ti.dst + (size_t)sn * ti.dld + skc, a, b); } } }
        __syncthreads();
    }
#undef TC_ISSUE
}
struct TcMat {
    const float* src; long src_ld; int tk, ncols; bf16_t* dst; long dst_ld; float qinv;
    __device__ __forceinline__ int remap(int i) const { const int ntn = (ncols + 63) >> 6; if (ntn & 1) return i;
        const int g = i >> 2, q = i & 3, tkh = tk >> 1, gk = g % tkh, gn = g / tkh; return (2 * gn + (q >> 1)) * tk + 2 * gk + (q & 1); }
    __device__ __forceinline__ TcTile operator()(int t) const { const int k0 = (t % tk) * 64, n0 = (t / tk) * 64; TcTile ti;
        ti.src = src + (size_t)k0 * src_ld + n0; ti.sld = src_ld; ti.dst = qinv > 0.f ? (bf16_t*)((unsigned char*)dst + (size_t)n0 * dst_ld + k0) : dst + (size_t)n0 * dst_ld + k0; ti.dld = dst_ld; ti.nvalid = (ncols - n0) < 64 ? (ncols - n0) : 64; ti.qinv = qinv; return ti; }
};
__device__ __forceinline__ void tconv(const Frame& F, const float* src, long src_ld, int K, int ncols, bf16_t* dst, long dst_ld, int& rot) {
    TcMat d{src, src_ld, K >> 6, ncols, dst, dst_ld, 0.f}; tconv_run(F, (K >> 6) * ((ncols + 63) >> 6), d, rot);
}
struct TcExperts {
    const float* wg; const float* wu; const float* wd; unsigned char* dgu; unsigned char* ddn; float qinv, qinvd;
    __device__ __forceinline__ int remap(int i) const { const int e = i / 1536, ri = i - e * 1536;
        if (ri < 1024) { const int g = ri >> 2, q = ri & 3, gk = g & 15, gn = g >> 4; return e * 1536 + (2 * gn + (q >> 1)) * 32 + 2 * gk + (q & 1); }
        const int r2 = ri - 1024, g = r2 >> 2, q = r2 & 3, gk = g & 7, gn = g >> 3; return e * 1536 + 1024 + (2 * gn + (q >> 1)) * 16 + 2 * gk + (q & 1); }
    __device__ __forceinline__ TcTile operator()(int t) const { const int e = t / 1536, r = t - e * 1536; TcTile ti; ti.nvalid = 64; ti.qinv = 0.f;
        if (r < 1024) { const int k0 = (r & 31) * 64, dt = r >> 5, jb = dt >> 2, gu = (dt >> 1) & 1, half = dt & 1;
            ti.src = (const float*)((unsigned long long)wg + (unsigned long long)gu * ((unsigned long long)wu - (unsigned long long)wg)) + (size_t)e * DM * DEXP + (size_t)k0 * DEXP + jb * 128 + half * 64; ti.sld = DEXP;
            ti.dst = (bf16_t*)(dgu + (size_t)e * 2048 * 2048 + (size_t)(dt * 64) * 2048 + k0); ti.dld = 2048; ti.qinv = qinv; }
        else { const int r2 = r - 1024, k0 = (r2 & 15) * 64, n0 = (r2 >> 4) * 64;
            ti.src = wd + (size_t)e * DEXP * DM + (size_t)k0 * DM + n0; ti.sld = DM;
            ti.dst = (bf16_t*)(ddn + (size_t)e * 2048 * 1024 + (size_t)n0 * 1024 + k0); ti.dld = 1024; ti.qinv = qinvd; }
        return ti; }
};
__device__ __forceinline__ void sample_wmax(const Frame& F) {
    unsigned* wm = (unsigned*)(F.ws + WS_CTL) + CW_WMAX;
#pragma unroll 1
    for (int l = 0; l < NLAYER; ++l) { float mx = 0.f;
#pragma unroll 1
        for (int which = 0; which < 2; ++which) { const f32x4* p = (const f32x4*)(F.in(which ? 17 : 15) + (size_t)l * NEXP * DM * DEXP);
            for (size_t i = (size_t)F.bid * 512 + F.tid; i < (size_t)NEXP * DM * DEXP / 4 / 64; i += (size_t)F.G * 512) { const f32x4 v = p[i * 64 + (i & 63)];
                mx = fmaxf(mx, fmaxf(fmaxf(fabsf(v[0]), fabsf(v[1])), fmaxf(fabsf(v[2]), fabsf(v[3])))); } }
        for (int o = 32; o > 0; o >>= 1) mx = fmaxf(mx, __shfl_xor(mx, o));
        if (F.lane == 0 && mx > 0.f) atomicMax(&wm[l], __float_as_uint(mx));
        float mg = 0.f; const f32x4* wi_ = (const f32x4*)(F.in(2) + (size_t)l * DM * INW);
        for (int i = F.bid * 512 + F.tid; i < DM * (INW / 4) / 16; i += F.G * 512) { const f32x4 v = wi_[(size_t)i * 16 + (i & 15)];
            mg = fmaxf(mg, fmaxf(fmaxf(fabsf(v[0]), fabsf(v[1])), fmaxf(fabsf(v[2]), fabsf(v[3])))); }
        for (int o = 32; o > 0; o >>= 1) mg = fmaxf(mg, __shfl_xor(mg, o));
        if (F.lane == 0 && mg > 0.f) atomicMax(&wm[CW_WMAXG - CW_WMAX + l], __float_as_uint(mg));
        float mp = 0.f; const f32x4* wp_ = (const f32x4*)(F.in(21) + (size_t)l * DM * DM);
        for (int i = F.bid * 512 + F.tid; i < DM * DM / 4 / 16; i += F.G * 512) { const f32x4 v = wp_[i * 16 + (i & 15)];
            mp = fmaxf(mp, fmaxf(fmaxf(fabsf(v[0]), fabsf(v[1])), fmaxf(fabsf(v[2]), fabsf(v[3])))); }
        for (int o = 32; o > 0; o >>= 1) mp = fmaxf(mp, __shfl_xor(mp, o));
        if (F.lane == 0 && mp > 0.f) atomicMax(&wm[CW_WMAXP - CW_WMAX + l], __float_as_uint(mp));
        float md = 0.f; const f32x4* wd_ = (const f32x4*)(F.in(19) + (size_t)l * NEXP * DEXP * DM);
        for (size_t i = (size_t)F.bid * 512 + F.tid; i < (size_t)NEXP * DEXP * DM / 4 / 64; i += (size_t)F.G * 512) { const f32x4 v = wd_[i * 64 + (i & 63)];
            md = fmaxf(md, fmaxf(fmaxf(fabsf(v[0]), fabsf(v[1])), fmaxf(fabsf(v[2]), fabsf(v[3])))); }
        for (int o = 32; o > 0; o >>= 1) md = fmaxf(md, __shfl_xor(md, o));
        if (F.lane == 0 && md > 0.f) atomicMax(&wm[CW_WMAXD - CW_WMAX + l], __float_as_uint(md)); }
}
__device__ __forceinline__ void conv_rows(const Frame& F, const float* src, bf16_t* dst, size_t n8) {
    for (size_t i = (size_t)F.bid * 512 + F.tid; i < n8; i += (size_t)F.G * 512) { const f32x4 a = *(const f32x4*)(src + i * 8), b = *(const f32x4*)(src + i * 8 + 4); pg8::st_bf16x8(dst + i * 8, a, b); }
}
__device__ __forceinline__ void quant_rows(const Frame& F, const float* src, bf16_t* xb, unsigned char* xq, float* xsc) {
    const int lane = F.lane;
    for (int tok = F.bid * 8 + F.wid; tok < NTOK; tok += F.G * 8) { f32x4 v[8]; float amax = 0.f;
#pragma unroll
        for (int i = 0; i < 4; ++i) { const int c = (i * 64 + lane) * 8; v[2 * i] = *(const f32x4*)(src + (size_t)tok * DM + c); v[2 * i + 1] = *(const f32x4*)(src + (size_t)tok * DM + c + 4);
            pg8::st_bf16x8(xb + (size_t)tok * DM + c, v[2 * i], v[2 * i + 1]);
#pragma unroll
            for (int h = 0; h < 2; ++h)
#pragma unroll
                for (int j = 0; j < 4; ++j) amax = fmaxf(amax, fabsf(v[2 * i + h][j])); }
        for (int o = 32; o > 0; o >>= 1) amax = fmaxf(amax, __shfl_xor(amax, o));
        amax = fmaxf(amax, 1e-20f); const float qi = 127.0f / amax; if (lane == 0) xsc[tok] = amax * (1.0f / 127.0f);
#pragma unroll
        for (int i = 0; i < 4; ++i) { u32x2 w;
#pragma unroll
            for (int h = 0; h < 2; ++h) { unsigned pk = 0u;
#pragma unroll
                for (int j = 0; j < 4; ++j) pk |= ((unsigned)(int)rintf(v[2 * i + h][j] * qi) & 0xffu) << (8 * j);
                w[h] = pk; }
            *(u32x2*)(xq + (size_t)tok * DM + (i * 64 + lane) * 8) = w; } }
}
__constant__ int c_so[14] = {0, 1312, 2416, 3440, 4464, 5496, 6520, 7544, 8568, 1024, 1280, 2336, 2400, 5488};
__constant__ int c_dn[14] = {0, 1024, 2048, 3072, 4096, 5120, 6144, 7168, 8192, 14336, 14592, 14624, 14688, 14704};
__constant__ int c_nc[14] = {1024, 1024, 1024, 1024, 1024, 1024, 1024, 1024, 6144, 256, 32, 64, 16, 8};
__device__ __forceinline__ void convert_layer_weights(const Frame& F0, const Params& P, int l) { const Frame F = fresh(F0);
    unsigned char* ws = F.ws; int rot = 0;
    { const float* w = F.in(2) + (size_t)l * DM * INW; bf16_t* d = (bf16_t*)(ws + W_IN);
      const float wmaxg = __uint_as_float(((const unsigned*)(ws + WS_CTL))[CW_WMAXG + l]); const float qinv = 127.0f / (1.3f * fmaxf(wmaxg, 1e-30f));
#pragma unroll 1
      for (int s = 0; s < 14; ++s) {
          if (s == 1 || s >= 10) tconv(F, w + c_so[s], INW, DM, c_nc[s], d + (size_t)c_dn[s] * DM, DM, rot);
          else { const int crow = (s == 0) ? 0 : (s <= 7 ? 1024 + (s - 2) * 1024 : (s == 8 ? 7168 : 13312));
              TcMat dq{w + c_so[s], INW, DM >> 6, c_nc[s], (bf16_t*)(ws + W_IN8 + (size_t)crow * 2048), 2048, qinv}; tconv_run(F, (DM >> 6) * (c_nc[s] >> 6), dq, rot); } } }
    tconv(F, F.in(7) + (size_t)l * 1024 * DM, DM, 1024, DM, (bf16_t*)(ws + W_BRA), 3072, rot);
    tconv(F, F.in(8) + (size_t)l * 1024 * DM, DM, 1024, DM, (bf16_t*)(ws + W_BRA) + 1024, 3072, rot);
    tconv(F, F.in(9) + (size_t)l * 1024 * DM, DM, 1024, DM, (bf16_t*)(ws + W_BRA) + 2048, 3072, rot);
    tconv(F, F.in(10) + (size_t)l * DM * DM, DM, DM, DM, (bf16_t*)(ws + W_OUT), DM, rot);
    { const float wmp = __uint_as_float(((const unsigned*)(ws + WS_CTL))[CW_WMAXP + l]);
      TcMat dq{F.in(21) + (size_t)l * DM * DM, DM, DM >> 6, DM, (bf16_t*)(ws + W_PG), 2048, 127.0f / (1.3f * fmaxf(wmp, 1e-30f))}; tconv_run(F, (DM >> 6) * (DM >> 6), dq, rot); }
    tconv(F, F.in(22) + (size_t)l * 256 * DM, DM, 256, DM, (bf16_t*)(ws + W_PLE), 256, rot);
#pragma unroll 1
    for (int h = 0; h < 8; ++h) tconv(F, F.in(6) + (size_t)l * 256 * 1024 + h * 128, 1024, 256, 128, (bf16_t*)(ws + W_UV2) + ((size_t)(h >> 1) * 256 + (h & 1) * 128) * 512 + (h & 1) * 256, 512, rot);
    { const float wmax = __uint_as_float(((const unsigned*)(ws + WS_CTL))[CW_WMAX + l]);
      const float wmaxd = __uint_as_float(((const unsigned*)(ws + WS_CTL))[CW_WMAXD + l]);
      TcExperts d{F.in(15) + (size_t)l * NEXP * DM * DEXP, F.in(17) + (size_t)l * NEXP * DM * DEXP, F.in(19) + (size_t)l * NEXP * DEXP * DM, (unsigned char*)(ws + W_GU), (unsigned char*)(ws + W_DN), 127.0f / (1.3f * fmaxf(wmax, 1e-30f)), 127.0f / (1.3f * fmaxf(wmaxd, 1e-30f))};
      tconv_run(F, NEXP * 1536, d, rot); }
    { const float* w = F.in(5) + (size_t)l * 256 * 8 * 96; bf16_t* d = (bf16_t*)(ws + W_UK2);
      for (int i = F.bid * 512 + F.tid; i < 256 * 8 * 96; i += F.G * 512) { const int n = i % 96, h = (i / 96) & 7, r = i / 768; d[((size_t)h * 256 + r) * 256 + (h & 1) * 128 + 32 + n] = f2bf(w[i]); } }
}

__device__ __forceinline__ void rope_cs(float pos, float invf, float& c, float& s) {
    const float a = pos * invf; const double ad = (double)a * 0.15915494309189535; const float fr = (float)(ad - rint(ad));
    s = __builtin_amdgcn_sinf(fr); c = __builtin_amdgcn_cosf(fr);
}
__device__ __forceinline__ void phase_prep(const Frame& F0, const Params& P, int l) { const Frame F = fresh(F0);
    unsigned char* ws = F.ws; const int lane = F.lane;
    const float* smallb = (const float*)(ws + R_SMALL); bf16_t* kcat = (bf16_t*)(ws + R_KCAT); bf16_t* qcat = (bf16_t*)(ws + R_QCAT);
    bf16_t* ki = (bf16_t*)(ws + R_KI); float* wi = (float*)(ws + R_WI); float* lf = (float*)(ws + WS_LF);
    const bf16_t* qa = (const bf16_t*)(ws + R_QA); bf16_t* qidx = (bf16_t*)(ws + R_QIDX);
    const f32x4 gck = *(const f32x4*)(F.in(4) + l * 256 + lane * 4);
    const float bfo = lane < 8 ? F.in(3)[l * 8 + lane] : 0.f;
    const float ifr = c_invf_r[lane & 15], ifi = c_invf_i[lane & 7];
    for (int tok = F.bid * 8 + F.wid; tok < NTOK; tok += F.G * 8) {
        const int s = tok & (SEQ - 1), b = tok >> 13; const float* sm = smallb + (size_t)tok * 512;
        float cr, sr, ci, si; rope_cs((float)s, ifr, cr, sr); rope_cs((float)s, ifi, ci, si);
        { const f32x4 v = *(const f32x4*)(sm + lane * 4); float ss = v[0] * v[0] + v[1] * v[1] + v[2] * v[2] + v[3] * v[3]; ss = wave_sum(ss);
          const float rs = rsqrtf(ss * (1.0f / 256.0f) + 1e-6f); u32x2 w; w.x = cvtpk(v[0] * rs * gck[0], v[1] * rs * gck[1]); w.y = cvtpk(v[2] * rs * gck[2], v[3] * rs * gck[3]);
          *(u32x2*)(kcat + (size_t)tok * 288 + lane * 4) = w; }
        if (lane < 16) { const float x1 = sm[256 + lane], x2 = sm[272 + lane]; kcat[(size_t)tok * 288 + 256 + lane] = f2bf(x1 * cr - x2 * sr); kcat[(size_t)tok * 288 + 272 + lane] = f2bf(x2 * cr + x1 * sr); }
        { float o = sm[288 + lane];
          if (lane < 8) { const float x2 = sm[296 + lane]; o = o * ci - x2 * si; } else if (lane < 16) { const float x1 = sm[288 + lane - 8]; o = o * ci + x1 * si; }
          ki[(size_t)tok * 64 + lane] = f2bf(o); }
        if (lane < 16) wi[(size_t)tok * 16 + lane] = sm[352 + lane] * (1.0f / 32.0f);
        if (lane < 8) { const float f = sm[368 + lane] + bfo; lf[(size_t)(b * 8 + lane) * SEQ + s] = fminf(f, 0.f) - log1pf(__expf(-fabsf(f))); }
#pragma unroll
        for (int pp = 0; pp < 2; ++pp) { const int p = lane + 64 * pp, h = p >> 4, i = p & 15;
            const float x1 = bf2f(qa[(size_t)tok * 1024 + h * 128 + i]), x2 = bf2f(qa[(size_t)tok * 1024 + h * 128 + 16 + i]);
            qcat[(size_t)tok * 2304 + h * 288 + 256 + i] = f2bf(x1 * cr - x2 * sr); qcat[(size_t)tok * 2304 + h * 288 + 272 + i] = f2bf(x2 * cr + x1 * sr); }
#pragma unroll
        for (int pp = 0; pp < 2; ++pp) { const int p = lane + 64 * pp, hh = p >> 3, i = p & 7; bf16_t* q = qidx + (size_t)tok * 1024 + hh * 64;
            const float x1 = bf2f(q[i]), x2 = bf2f(q[8 + i]); q[i] = f2bf(x1 * ci - x2 * si); q[8 + i] = f2bf(x2 * ci + x1 * si); }
    }
    { const bf16_t* kbt = (const bf16_t*)(ws + R_QKV) + (size_t)NTOK * 1024; unsigned* kmx = (unsigned*)(ws + WS_CTL) + CW_KMAX + l * 16;
#pragma unroll 1
      for (int bh = 0; bh < 16; ++bh) { float mx = 0.f;
          for (int r0 = (F.bid * 8 + F.wid) * 4; r0 < SEQ; r0 += F.G * 32) {
              const u32x4 w = *(const u32x4*)(kbt + ((size_t)bh * SEQ + r0 + (lane >> 4)) * 128 + (lane & 15) * 8);
              float ss = bflo(w.x) * bflo(w.x) + bfhi(w.x) * bfhi(w.x) + bflo(w.y) * bflo(w.y) + bfhi(w.y) * bfhi(w.y) + bflo(w.z) * bflo(w.z) + bfhi(w.z) * bfhi(w.z) + bflo(w.w) * bflo(w.w) + bfhi(w.w) * bfhi(w.w);
              ss += __shfl_xor(ss, 1); ss += __shfl_xor(ss, 2); ss += __shfl_xor(ss, 4); ss += __shfl_xor(ss, 8); mx = fmaxf(mx, ss); }
          mx = fmaxf(mx, __shfl_xor(mx, 16)); mx = fmaxf(mx, __shfl_xor(mx, 32));
          if (lane == 0) ((float*)F.lds)[F.wid * 16 + bh] = mx; }
      __syncthreads();
      if (F.tid < 16) { float mx = 0.f;
#pragma unroll
          for (int w = 0; w < 8; ++w) mx = fmaxf(mx, ((const float*)F.lds)[w * 16 + F.tid]);
          const unsigned bits = __float_as_uint(mx);
          if (bits > __hip_atomic_load(&kmx[F.tid], __ATOMIC_RELAXED, __HIP_MEMORY_SCOPE_AGENT)) atomicMax(&kmx[F.tid], bits); }
      __syncthreads(); }
}
__device__ __forceinline__ void phase_cumsum(const Frame& F0) { const Frame F = fresh(F0);
    const int gw = F.bid * 8 + F.wid; if (gw >= 16) return;
    const float* lf = (const float*)(F.ws + WS_LF) + (size_t)gw * SEQ; float* cum = (float*)(F.ws + WS_CUM) + (size_t)gw * SEQ;
    const int lane = F.lane; double tot = 0.0;
    for (int j = 0; j < 128; ++j) tot += (double)lf[lane * 128 + j];
    double inc = tot;
    for (int o = 1; o < 64; o <<= 1) { const double n = __shfl_up(inc, o); if (lane >= o) inc += n; }
    double run = inc - tot;
    for (int j = 0; j < 128; ++j) { run += (double)lf[lane * 128 + j]; cum[lane * 128 + j] = (float)run; }
}

__device__ __forceinline__ void idx_unit(const Frame& F, int b, int pi, int half) {
    const int tid = F.tid, lane = F.lane, rho = lane & 31, hh = lane >> 5; unsigned char* ws = F.ws;
    const bf16_t* qidx = (const bf16_t*)(ws + R_QIDX); const bf16_t* ki = (const bf16_t*)(ws + R_KI) + (size_t)b * SEQ * 64; const float* wi = (const float*)(ws + R_WI);
    float* scores = (float*)(ws + R_SCORES) + (size_t)b * SEQ * SEQ;
    LAS unsigned char* kl = F.ldsl;
    const int gl = pi, gh = 127 - pi, nl = (64 * gl + 63) / 128 + 1, nh = (64 * gh + 63) / 128 + 1, tot = nl + nh;
    const int x0 = half ? tot / 2 : 0, x1 = half ? tot : tot / 2;
    bf16x8 af[4][4]; float wv[4][16]; int t0 = 0, curg = -1;
    const int r0 = tid >> 3, p0 = tid & 7;
    const unsigned d0 = (unsigned)(r0 * 128 + ((p0 ^ (r0 & 7)) << 4)), d1 = d0 + 64 * 128;
    u32x4 s0, s1;
    { const int c = x0 < nl ? x0 : x0 - nl; const bf16_t* kp = ki + (size_t)(c * 128) * 64; s0 = *(const u32x4*)(kp + (size_t)r0 * 64 + p0 * 8); s1 = *(const u32x4*)(kp + (size_t)(r0 + 64) * 64 + p0 * 8); }
    __syncthreads();
    *(LAS u32x4*)(kl + d0) = s0; *(LAS u32x4*)(kl + d1) = s1;
    __syncthreads();
    const unsigned rdo = (unsigned)(rho * 128);
#pragma unroll 1
    for (int x = x0; x < x1; ++x) {
        const int g = x < nl ? gl : gh, c = x < nl ? x : x - nl;
        if (g != curg) { curg = g; t0 = g * 64 + F.wid * 8;
#pragma unroll
            for (int mt = 0; mt < 4; ++mt) {
                const int tokA = b * SEQ + t0 + 2 * mt + ((rho >> 2) & 1), head = (rho & 3) + 4 * (rho >> 3);
#pragma unroll
                for (int kk = 0; kk < 4; ++kk) af[mt][kk] = *(const bf16x8*)(qidx + (size_t)tokA * 1024 + head * 64 + kk * 16 + 8 * hh);
                const float* wp = wi + (size_t)(b * SEQ + t0 + 2 * mt + hh) * 16;
#pragma unroll
                for (int q = 0; q < 4; ++q) { const f32x4 v = *(const f32x4*)(wp + 4 * q); wv[mt][4 * q] = v[0]; wv[mt][4 * q + 1] = v[1]; wv[mt][4 * q + 2] = v[2]; wv[mt][4 * q + 3] = v[3]; } } }
        const unsigned bo = (unsigned)((x - x0) & 1) * 16384u;
        if (x + 1 < x1) { const int cn = (x + 1) < nl ? (x + 1) : (x + 1) - nl; const bf16_t* kp = ki + (size_t)(cn * 128) * 64; s0 = *(const u32x4*)(kp + (size_t)r0 * 64 + p0 * 8); s1 = *(const u32x4*)(kp + (size_t)(r0 + 64) * 64 + p0 * 8); }
#pragma unroll
        for (int tl = 0; tl < 4; ++tl) {
            const int kb = c * 128 + tl * 32;
            if (kb <= t0 + 7) {
                bf16x8 bc[4];
#pragma unroll
                for (int kk = 0; kk < 4; ++kk) bc[kk] = *(const LAS bf16x8*)(kl + bo + tl * 4096 + rdo + (((kk * 2 + hh) ^ (rho & 7)) << 4));
                f32x16 a0 = {}, a1 = {}, a2 = {}, a3 = {};
#pragma unroll
                for (int kk = 0; kk < 4; ++kk) { a0 = __builtin_amdgcn_mfma_f32_32x32x16_bf16(af[0][kk], bc[kk], a0, 0, 0, 0); a1 = __builtin_amdgcn_mfma_f32_32x32x16_bf16(af[1][kk], bc[kk], a1, 0, 0, 0);
                                                  a2 = __builtin_amdgcn_mfma_f32_32x32x16_bf16(af[2][kk], bc[kk], a2, 0, 0, 0); a3 = __builtin_amdgcn_mfma_f32_32x32x16_bf16(af[3][kk], bc[kk], a3, 0, 0, 0); }
#define IDX_EPI(A_, mt_) do { float x_0 = 0.f, x_1 = 0.f, x_2 = 0.f, x_3 = 0.f; _Pragma("unroll") for (int r = 0; r < 16; r += 4) { \
                    x_0 = fmaf(wv[mt_][r], fmaxf(A_[r], 0.f), x_0); x_1 = fmaf(wv[mt_][r + 1], fmaxf(A_[r + 1], 0.f), x_1); x_2 = fmaf(wv[mt_][r + 2], fmaxf(A_[r + 2], 0.f), x_2); x_3 = fmaf(wv[mt_][r + 3], fmaxf(A_[r + 3], 0.f), x_3); } \
                    scores[(size_t)(t0 + 2 * (mt_) + hh) * SEQ + kb + rho] = (x_0 + x_1) + (x_2 + x_3); } while (0)
                IDX_EPI(a0, 0); IDX_EPI(a1, 1); IDX_EPI(a2, 2); IDX_EPI(a3, 3);
#undef IDX_EPI
            }
        }
        if (x + 1 < x1) { *(LAS u32x4*)(kl + (bo ^ 16384u) + d0) = s0; *(LAS u32x4*)(kl + (bo ^ 16384u) + d1) = s1; }
        __syncthreads();
    }
}
__device__ __forceinline__ void phase_idx(const Frame& F0) { const Frame F = fresh(F0);
#pragma unroll 1
    for (int it = F.bid; it < 256; it += F.G) { const int b = it >> 7, pi = (it >> 1) & 63, half = it & 1; idx_unit(F, b, pi, half); }
}

__device__ __forceinline__ unsigned sortable(float f) { const unsigned u = __float_as_uint(f); return (u & 0x80000000u) ? ~u : (u | 0x80000000u); }
__device__ __forceinline__ void topk_row(const Frame& F, int b, int t) {
    int lane = F.lane; asm volatile("" : "+v"(lane));
    const int L = t + 1, tok = b * SEQ + t; unsigned char* ws = F.ws;
    int* sel = (int*)(ws + R_SEL) + (size_t)tok * 256; int* nsel = (int*)(ws + R_NSEL);
    if (lane == 0) nsel[tok] = L < 256 ? L : 256;
    if (L <= 256) { for (int j = lane; j < 256; j += 64) sel[j] = j < L ? j : 0; return; }
    const float* row = (const float*)(ws + R_SCORES) + ((size_t)b * SEQ + t) * SEQ;
    const int nch = (L + 1023) >> 10;
#define TOPK_LOAD_ROW() do { _Pragma("unroll") for (int c = 0; c < 8; ++c) { \
        if (c < nch) { _Pragma("unroll") for (int jj = 0; jj < 4; ++jj) { const int j = c * 4 + jj; const f32x4 v = *(const f32x4*)(row + j * 256 + lane * 4); \
                _Pragma("unroll") for (int e_ = 0; e_ < 4; ++e_) { const int idx = j * 256 + lane * 4 + e_; u[j * 4 + e_] = idx < L ? sortable(v[e_]) : 0u; } } } \
        else { _Pragma("unroll") for (int q = 0; q < 16; ++q) u[c * 16 + q] = 0u; } } } while (0)
    unsigned u[128];
    TOPK_LOAD_ROW();
    unsigned g0 = 0u, g1 = 0u, g2 = 0u, g3 = 0u;
#pragma unroll
    for (int c = 0; c < 8; ++c) if (c < nch) {
#pragma unroll
        for (int jj = 0; jj < 4; ++jj) { const int j = c * 4 + jj; g0 = u[4 * j] > g0 ? u[4 * j] : g0; g1 = u[4 * j + 1] > g1 ? u[4 * j + 1] : g1; g2 = u[4 * j + 2] > g2 ? u[4 * j + 2] : g2; g3 = u[4 * j + 3] > g3 ? u[4 * j + 3] : g3; } }
    unsigned tl = g0 < g1 ? g0 : g1; { const unsigned t2 = g2 < g3 ? g2 : g3; tl = tl < t2 ? tl : t2; }
#pragma unroll
    for (int o = 32; o > 0; o >>= 1) { const unsigned x = (unsigned)__shfl_xor((int)tl, o); tl = x < tl ? x : tl; }
    constexpr int CAP = 2048;
    LAS unsigned* candk = (LAS unsigned*)(F.ldsl + F.wid * (CAP * 8)); LAS unsigned* candi = candk + CAP;
    int C = 0;
#pragma unroll
    for (int c = 0; c < 8; ++c) if (c < nch) {
#pragma unroll
        for (int q = 0; q < 16; ++q) { const int rq = c * 16 + q; const bool pr = u[rq] >= tl; const unsigned long long mm = __ballot(pr);
            const int pos = C + __popcll(mm & ((1ull << lane) - 1ull));
            if (pr && pos < CAP) { candk[pos] = u[rq]; candi[pos] = (unsigned)((rq >> 2) * 256 + lane * 4 + (rq & 3)); }
            C += __popcll(mm); if ((q & 3) == 3) SBAR(); } }
    if (C <= CAP) {
        const int ng = (C + 255) >> 8;
        unsigned ck[32]; int ci[32];
#pragma unroll
        for (int g = 0; g < 8; ++g) {
#pragma unroll
            for (int q = 0; q < 4; ++q) { const int r = g * 4 + q, p = r * 64 + lane; ck[r] = 0u; ci[r] = 0;
                if (g < ng && p < C) { ck[r] = candk[p]; ci[r] = (int)candi[p]; } } }
        unsigned T = 0u, thr_gt = 0u; int need_eq = 0; bool early = false;
        for (int bit = 31; bit >= 0; --bit) {
            const unsigned cnd = T | (1u << bit); int cnt = 0;
#pragma unroll
            for (int g = 0; g < 8; ++g) if (g < ng) {
#pragma unroll
                for (int q = 0; q < 4; ++q) cnt += __popcll(__ballot(ck[g * 4 + q] >= cnd)); }
            if (cnt >= 256) { T = cnd; if (cnt == 256) { early = true; break; } }
        }
        if (early) { thr_gt = T - 1u; need_eq = 0; }
        else { int gtc = 0;
#pragma unroll
            for (int g = 0; g < 8; ++g) if (g < ng) {
#pragma unroll
                for (int q = 0; q < 4; ++q) gtc += __popcll(__ballot(ck[g * 4 + q] > T)); }
            thr_gt = T; need_eq = 256 - gtc; }
        int base = 0, eq_taken = 0;
#pragma unroll
        for (int g = 0; g < 8; ++g) if (g < ng) {
#pragma unroll
            for (int q = 0; q < 4; ++q) { const int r = g * 4 + q; const unsigned v = ck[r];
                const bool iseq = (v == thr_gt) && (need_eq > 0);
                const unsigned long long meq = __ballot(iseq);
                const int eqr = __popcll(meq & ((1ull << lane) - 1ull));
                const bool take = (v > thr_gt) || (iseq && (eq_taken + eqr < need_eq));
                const unsigned long long mt = __ballot(take);
                const int pos = base + __popcll(mt & ((1ull << lane) - 1ull));
                if (take && pos < 256) sel[pos] = ci[r];
                base += __popcll(mt); eq_taken += __popcll(meq); } }
        return;
    }
    asm volatile("" ::: "memory");
    TOPK_LOAD_ROW();
    unsigned T = 0u, thr_gt = 0u; int need_eq = 0; bool early = false;
    for (int bit = 31; bit >= 0; --bit) {
        const unsigned cand = T | (1u << bit); int cnt = 0;
#pragma unroll
        for (int c = 0; c < 8; ++c) if (c < nch) {
#pragma unroll
            for (int q = 0; q < 16; ++q) cnt += __popcll(__ballot(u[c * 16 + q] >= cand)); }
        if (cnt >= 256) { T = cand; if (cnt == 256) { early = true; break; } }
    }
    if (early) { thr_gt = T - 1u; need_eq = 0; }
    else { int gtc = 0;
#pragma unroll
        for (int c = 0; c < 8; ++c) if (c < nch) {
#pragma unroll
            for (int q = 0; q < 16; ++q) gtc += __popcll(__ballot(u[c * 16 + q] > T)); }
        thr_gt = T; need_eq = 256 - gtc; }
    int base = 0, eq_taken = 0;
#pragma unroll
    for (int c = 0; c < 8; ++c) if (c < nch) {
#pragma unroll
        for (int q = 0; q < 16; ++q) { const int rq = c * 16 + q; const unsigned v = u[rq];
            const bool iseq = (v == thr_gt) && (need_eq > 0);
            const unsigned long long meq = __ballot(iseq);
            const int eqr = __popcll(meq & ((1ull << lane) - 1ull));
            const bool take = (v > thr_gt) || (iseq && (eq_taken + eqr < need_eq));
            const unsigned long long mt = __ballot(take);
            const int pos = base + __popcll(mt & ((1ull << lane) - 1ull));
            if (take && pos < 256) sel[pos] = (rq >> 2) * 256 + lane * 4 + (rq & 3);
            base += __popcll(mt); eq_taken += __popcll(meq); } }
}
__device__ __forceinline__ void phase_topk(const Frame& F0) { const Frame F = fresh(F0);
    for (int q = F.bid * 8 + F.wid; q < 8192; q += F.G * 8) { const int b = q >> 12, p = q & 4095; topk_row(F, b, p); topk_row(F, b, SEQ - 1 - p); }
}

namespace att {
constexpr int D = 128, KVBLK = 64, QBLK = 32, SHM_V = 16384, SHM_K = 16384;
constexpr int OFF_K = 2 * SHM_V, OFF_BIAS = 2 * SHM_V + 2 * SHM_K, OFF_WS = OFF_BIAS + 512, OFF_FLAGS = OFF_WS + 2048, OFF_QITEM = OFF_FLAGS + 64;
constexpr float EXIT_T = 44.0f;
#define KSWZ(row, colB) ((row) * 256 + ((colB) ^ (((row) & 7) << 4)))
__device__ __forceinline__ int v_st(int k, int c) { const int kk = (k & ~0xC) | ((k & 4) << 1) | ((k & 8) >> 1); return ((kk >> 3) * 4 + (c >> 5)) * 512 + ((kk & 7) * 32 + (c & 31)) * 2; }
__device__ __forceinline__ int v_rd_base(int lane) { return ((lane & 3) << 3) | (((lane >> 2) & 3) << 6) | (((lane >> 4) & 1) << 5) | (((lane >> 5) & 1) << 8); }
constexpr int v_rd_off(int d0, int ks, int half) { return d0 * 512 + ks * 4096 + half * 2048; }
template <int KB>
__device__ __forceinline__ void qkt(f32x16& p0, f32x16& p1, const char* K_lds, int r32, int hi, const bf16x8* qr) {
    p0 = f32x16{}; p1 = f32x16{};
    const char* kb[4];
#pragma unroll
    for (int dd = 0; dd < 4; ++dd) kb[dd] = K_lds + KB * SHM_K + KSWZ(r32, (dd * 16 + hi * 8) * 2);
#pragma unroll
    for (int d0 = 0; d0 < 8; ++d0) { const char* a = kb[d0 & 3] + (d0 >> 2) * 128;
        bf16x8 b0 = *reinterpret_cast<const bf16x8*>(a);
        bf16x8 b1 = *reinterpret_cast<const bf16x8*>(a + 32 * 256);
        p0 = __builtin_amdgcn_mfma_f32_32x32x16_bf16(b0, qr[d0], p0, 0, 0, 0);
        p1 = __builtin_amdgcn_mfma_f32_32x32x16_bf16(b1, qr[d0], p1, 0, 0, 0); }
}
template <int VB>
__device__ __forceinline__ void pv_tile(f32x16* o, int vb0, bf16x8 pa0, bf16x8 pa1, bf16x8 pa2, bf16x8 pa3) {
#define TRRD(dst, off) asm volatile("ds_read_b64_tr_b16 %0, %1 offset:%2" : "=&v"(dst) : "v"(vb0), "i"(off) : "memory")
#define PV_D0(d0) do { s16x4 l0, l1, l2, l3, h0, h1, h2, h3; constexpr int b_ = VB * SHM_V + v_rd_off(d0, 0, 0); \
        TRRD(l0, b_); TRRD(h0, b_ + 2048); TRRD(l1, b_ + 4096); TRRD(h1, b_ + 6144); TRRD(l2, b_ + 8192); TRRD(h2, b_ + 10240); TRRD(l3, b_ + 12288); TRRD(h3, b_ + 14336); \
        asm volatile("s_waitcnt lgkmcnt(0)" ::: "memory"); SBAR(); \
        o[d0] = __builtin_amdgcn_mfma_f32_32x32x16_bf16(pa0, (bf16x8){l0[0], l0[1], l0[2], l0[3], h0[0], h0[1], h0[2], h0[3]}, o[d0], 0, 0, 0); \
        o[d0] = __builtin_amdgcn_mfma_f32_32x32x16_bf16(pa1, (bf16x8){l1[0], l1[1], l1[2], l1[3], h1[0], h1[1], h1[2], h1[3]}, o[d0], 0, 0, 0); \
        o[d0] = __builtin_amdgcn_mfma_f32_32x32x16_bf16(pa2, (bf16x8){l2[0], l2[1], l2[2], l2[3], h2[0], h2[1], h2[2], h2[3]}, o[d0], 0, 0, 0); \
        o[d0] = __builtin_amdgcn_mfma_f32_32x32x16_bf16(pa3, (bf16x8){l3[0], l3[1], l3[2], l3[3], h3[0], h3[1], h3[2], h3[3]}, o[d0], 0, 0, 0); } while (0)
    PV_D0(0); PV_D0(1); PV_D0(2); PV_D0(3);
#undef PV_D0
#undef TRRD
}
#define PK4(P, B_, OUT) do { unsigned a0 = cvtpk(P[B_+0], P[B_+1]), a1 = cvtpk(P[B_+2], P[B_+3]); \
        unsigned b0 = cvtpk(P[B_+4], P[B_+5]), b1 = cvtpk(P[B_+6], P[B_+7]); \
        auto r0 = __builtin_amdgcn_permlane32_swap(a0, b0, false, false); auto r1 = __builtin_amdgcn_permlane32_swap(a1, b1, false, false); \
        u32x4 w = {r0[0], r1[0], r0[1], r1[1]}; OUT = *reinterpret_cast<bf16x8*>(&w); } while (0)
__device__ __forceinline__ float swap_max(float x) { auto rr = __builtin_amdgcn_permlane32_swap(__float_as_uint(x), __float_as_uint(x), false, false); return fmaxf(__uint_as_float(rr[0]), __uint_as_float(rr[1])); }
__device__ __forceinline__ float swap_sum(float x) { auto rr = __builtin_amdgcn_permlane32_swap(__float_as_uint(x), __float_as_uint(x), false, false); return __uint_as_float(rr[0]) + __uint_as_float(rr[1]); }
__device__ __forceinline__ float swap_lo(float x) { auto rr = __builtin_amdgcn_permlane32_swap(__float_as_uint(x), __float_as_uint(x), false, false); return __uint_as_float(rr[0]); }


__device__ __forceinline__ void fox_sm(f32x16& p0, f32x16& p1, const float* bl, int kb_, int qlo, int qrow, int hi, int r32, float& m_reg, float& l_reg, f32x16* o, float* al_l,
                                       bf16x8& pa0, bf16x8& pa1, bf16x8& pa2, bf16x8& pa3) {
#pragma unroll
    for (int g = 0; g < 4; ++g) { const f32x4 b0v = *(const f32x4*)(bl + 8 * g + 4 * hi), b1v = *(const f32x4*)(bl + 32 + 8 * g + 4 * hi);
#pragma unroll
        for (int i = 0; i < 4; ++i) { p0[4 * g + i] = fmaf(p0[4 * g + i], C2, b0v[i]); p1[4 * g + i] = fmaf(p1[4 * g + i], C2, b1v[i]); } }
    if (kb_ + KVBLK - 1 > qlo) { const float NEG = -__builtin_inff();
#pragma unroll
        for (int r = 0; r < 16; ++r) { const int key = kb_ + crow(r, hi); if (key > qrow) p0[r] = NEG; if (key + 32 > qrow) p1[r] = NEG; } }
    float pmax = p0[0];
#pragma unroll
    for (int r = 1; r < 16; ++r) pmax = fmaxf(pmax, p0[r]);
#pragma unroll
    for (int r = 0; r < 16; ++r) pmax = fmaxf(pmax, p1[r]);
    pmax = swap_max(pmax);
    const float mn = fmaxf(m_reg, pmax), alpha = __builtin_amdgcn_exp2f(m_reg - mn); m_reg = mn;
    float ps = 0.f;
#pragma unroll
    for (int r = 0; r < 16; ++r) { p0[r] = __builtin_amdgcn_exp2f(p0[r] - mn); p1[r] = __builtin_amdgcn_exp2f(p1[r] - mn); ps += p0[r] + p1[r]; }
    ps = swap_sum(ps); l_reg = l_reg * alpha + ps;
    if (__any(alpha < 1.f)) { if (hi == 0) al_l[r32] = alpha; asm volatile("s_waitcnt lgkmcnt(0)" ::: "memory");
#pragma unroll
        for (int r = 0; r < 16; ++r) { const float a = al_l[crow(r, hi)];
#pragma unroll
            for (int d_ = 0; d_ < 4; ++d_) o[d_][r] *= a; } }
    PK4(p0, 0, pa0); PK4(p0, 8, pa1); PK4(p1, 0, pa2); PK4(p1, 8, pa3);
}
__device__ __forceinline__ void sb_half(f32x16& pz, int keybase, int qrow, int hi, float& R, const bf16x8* triA, bool needmask) {
    f32x16 X;
#pragma unroll
    for (int r = 0; r < 16; ++r) { const float zz = pz[r] * C2; const bool valid = !needmask || (keybase + crow(r, hi) < qrow);
        const float l2 = fmaxf(zz, 0.f) + __builtin_amdgcn_logf(1.0f + __builtin_amdgcn_exp2f(-fabsf(zz)));
        X[r] = valid ? -l2 : 0.f; pz[r] = valid ? zz : -__builtin_inff(); }
    f32x16 Y;
#pragma unroll
    for (int r = 0; r < 16; ++r) Y[r] = R;
#pragma unroll
    for (int s = 0; s < 2; ++s) {
        const unsigned h0 = cvtpk(X[8 * s + 0], X[8 * s + 1]), h1 = cvtpk(X[8 * s + 2], X[8 * s + 3]), h2 = cvtpk(X[8 * s + 4], X[8 * s + 5]), h3 = cvtpk(X[8 * s + 6], X[8 * s + 7]);
        const unsigned l0 = cvtpk(X[8 * s + 0] - bflo(h0), X[8 * s + 1] - bfhi(h0)), l1 = cvtpk(X[8 * s + 2] - bflo(h1), X[8 * s + 3] - bfhi(h1));
        const unsigned l2 = cvtpk(X[8 * s + 4] - bflo(h2), X[8 * s + 5] - bfhi(h2)), l3 = cvtpk(X[8 * s + 6] - bflo(h3), X[8 * s + 7] - bfhi(h3));
        u32x4 wh = {h0, h1, h2, h3}, wl = {l0, l1, l2, l3};
        Y = __builtin_amdgcn_mfma_f32_32x32x16_bf16(triA[s], *reinterpret_cast<bf16x8*>(&wh), Y, 0, 0, 0);
        Y = __builtin_amdgcn_mfma_f32_32x32x16_bf16(triA[s], *reinterpret_cast<bf16x8*>(&wl), Y, 0, 0, 0); }
#pragma unroll
    for (int r = 0; r < 16; ++r) pz[r] = __builtin_amdgcn_exp2f(pz[r] + Y[r]);
    R = swap_lo(Y[0]);
}
__device__ __forceinline__ void sb_sm(f32x16& p0, f32x16& p1, int kb_, int qlo, int qrow, int hi, float& R, const bf16x8* triA, bf16x8& pa0, bf16x8& pa1, bf16x8& pa2, bf16x8& pa3) {
    const bool needmask = (kb_ + KVBLK - 1 >= qlo);
    sb_half(p1, kb_ + 32, qrow, hi, R, triA, needmask);
    sb_half(p0, kb_, qrow, hi, R, triA, needmask);
    PK4(p0, 0, pa0); PK4(p0, 8, pa1); PK4(p1, 0, pa2); PK4(p1, 8, pa3);
}

template <int MODE>
__device__ __forceinline__ void attn_unit(const bf16_t* Q, const bf16_t* Kh, const bf16_t* Vh, const float* cum, bf16_t* O, int P0, char* lds, float kmaxc) {
    int tid = threadIdx.x; asm volatile("" : "+v"(tid));
    const int wid = __builtin_amdgcn_readfirstlane(tid >> 6), lane = tid & 63, r32 = lane & 31, hi = lane >> 5;
    const int NT = P0 / KVBLK + 4;
    char* V_lds = lds; char* K_lds = lds + OFF_K; float* bias_l = (float*)(lds + OFF_BIAS);
    float* wsl = (float*)(lds + OFF_WS) + wid * 64; float* li_l = wsl; float* al_l = wsl + 32;
    const int qlo = P0 + wid * QBLK, qrow = qlo + r32;
    bf16x8 qr[8];
#pragma unroll
    for (int d0 = 0; d0 < 8; ++d0) qr[d0] = *(const bf16x8*)(Q + (size_t)qrow * D + d0 * 16 + hi * 8);
    const int sr = tid >> 4, sc = (tid & 15) * 8, vst0 = v_st(sr, sc), vst1 = v_st(32 + sr, sc), kws = KSWZ(sr, sc * 2);
    const int vb0 = (int)(uintptr_t)V_lds + v_rd_base(lane);
    const float cumref = (MODE == 0) ? cum[P0] : 0.f;
    int* flg = (int*)(lds + OFF_FLAGS);
    float qn = 0.f;
    if (MODE == 0) { float ss = 0.f;
#pragma unroll
        for (int d0 = 0; d0 < 8; ++d0)
#pragma unroll
            for (int j = 0; j < 8; ++j) { const float x = bf2f((bf16_t)qr[d0][j]); ss = fmaf(x, x, ss); }
        ss = swap_sum(ss); qn = sqrtf(ss) * kmaxc * 1.001f; }
    float m_reg = -1e30f, l_reg = 0.f, R = 0.f; f32x16 o[4] = {};
    bf16x8 triA[2];
    if (MODE == 1) {
#pragma unroll
        for (int s = 0; s < 2; ++s)
#pragma unroll
            for (int j = 0; j < 8; ++j) { const int rho = 16 * s + 8 * (j >> 2) + 4 * hi + (j & 3); triA[s][j] = (rho >= r32) ? (short)0x3F80 : (short)0; }
    }
    bf16x8 st_k0, st_k1, st_v0, st_v1; float st_b = 0.f;
#define TILE_KB(t) ((NT - 1 - (t)) * KVBLK)
#define SLOAD(kb_) do { st_v0 = *(const bf16x8*)(Vh + (size_t)((kb_) + sr) * D + sc); st_v1 = *(const bf16x8*)(Vh + (size_t)((kb_) + 32 + sr) * D + sc); \
                        st_k0 = *(const bf16x8*)(Kh + (size_t)((kb_) + sr) * D + sc); st_k1 = *(const bf16x8*)(Kh + (size_t)((kb_) + 32 + sr) * D + sc); \
                        if (MODE == 0 && tid < 64) st_b = (cumref - cum[(kb_) + tid]) * LOG2E; } while (0)
#define SWRITE(bf) do { *(bf16x8*)(V_lds + (bf) * SHM_V + vst0) = st_v0; *(bf16x8*)(V_lds + (bf) * SHM_V + vst1) = st_v1; \
                        *(bf16x8*)(K_lds + (bf) * SHM_K + kws) = st_k0; *(bf16x8*)(K_lds + (bf) * SHM_K + kws + 32 * 256) = st_k1; \
                        if (MODE == 0 && tid < 64) bias_l[(bf) * 64 + tid] = st_b; } while (0)
    __syncthreads();
    SLOAD(TILE_KB(0)); SWRITE(0);
    __syncthreads();
    f32x16 p0, p1; bf16x8 pa0, pa1, pa2, pa3;
#define STEP(BUF, t) do { const int kb_ = TILE_KB(t); \
        if ((t) + 1 < NT) SLOAD(TILE_KB((t) + 1)); \
        SBAR(); qkt<BUF>(p0, p1, K_lds, r32, hi, qr); \
        if (MODE == 0) fox_sm(p0, p1, bias_l + (BUF) * 64, kb_, qlo, qrow, hi, r32, m_reg, l_reg, o, al_l, pa0, pa1, pa2, pa3); \
        else sb_sm(p0, p1, kb_, qlo, qrow, hi, R, triA, pa0, pa1, pa2, pa3); \
        SBAR(); pv_tile<BUF>(o, vb0, pa0, pa1, pa2, pa3); \
        if ((t) + 1 < NT) SWRITE((BUF) ^ 1); \
        __syncthreads(); } while (0)
    for (int t = 0; t < NT; t += 2) {
        STEP(0, t); STEP(1, t + 1);
        const int kbc = TILE_KB(t + 1); if (kbc == 0) break;
        bool done;
        if (MODE == 0) { const float edge = (cumref - cum[kbc - 1]) * LOG2E; done = (qn + edge - m_reg) < -EXIT_T; }
        else done = R < -EXIT_T;
        const int par = (t >> 1) & 1;
        if (lane == 0) flg[par * 8 + wid] = 0;
        const bool wdone = __all(done);
        if (lane == 0 && wdone) flg[par * 8 + wid] = 1;
        __syncthreads();
        int alld = 1;
#pragma unroll
        for (int w = 0; w < 8; ++w) alld &= flg[par * 8 + w];
        if (alld) break;
    }
    __syncthreads();
#undef STEP
#undef SLOAD
#undef SWRITE
#undef TILE_KB
    float rli[16];
    if (MODE == 0) { if (hi == 0) li_l[r32] = l_reg; asm volatile("s_waitcnt lgkmcnt(0)" ::: "memory");
#pragma unroll
        for (int r = 0; r < 16; ++r) rli[r] = __builtin_amdgcn_rcpf(li_l[crow(r, hi)]); }
    bf16_t* Ow = O + (size_t)(wid * QBLK) * 3072;
#pragma unroll
    for (int r = 0; r < 16; ++r) { const int orow = crow(r, hi);
#pragma unroll
        for (int d0 = 0; d0 < 4; ++d0) { const float v = (MODE == 0) ? o[d0][r] * rli[r] : o[d0][r];
            const float vn = __shfl_xor(v, 1);
            if ((r32 & 1) == 0) *(unsigned*)(Ow + (size_t)orow * 3072 + d0 * 32 + r32) = cvtpk(v, vn); } }
}
}

__device__ __forceinline__ void sparse_query(const Frame& F, int tok, char* ldsw) {
    unsigned char* ws = F.ws; const int lane = F.lane, g = lane >> 4, i16 = lane & 15;
    const bf16_t* qcat = (const bf16_t*)(ws + R_QCAT) + (size_t)tok * 2304; const bf16_t* kbase = (const bf16_t*)(ws + R_KCAT) + (size_t)(tok >> 13) * SEQ * 288;
    const int* sel = (const int*)(ws + R_SEL) + (size_t)tok * 256; const int ns = ((const int*)(ws + R_NSEL))[tok]; const int ntile = (ns + 31) >> 5;
    bf16x8 qf[9];
#pragma unroll
    for (int st = 0; st < 9; ++st) { qf[st] = (bf16x8){0, 0, 0, 0, 0, 0, 0, 0}; if (i16 < 8) qf[st] = *(const bf16x8*)(qcat + i16 * 288 + st * 32 + 8 * g); }
    const int rA = lane >> 2, cq = lane & 3;
    float m = -1e30f, l = 0.f; f32x4 oT[16];
#pragma unroll
    for (int rb = 0; rb < 16; ++rb) oT[rb] = (f32x4){0.f, 0.f, 0.f, 0.f};
    const unsigned ldso = (unsigned)(uintptr_t)ldsw;
    const unsigned vb = ldso + (unsigned)((4 * g + (i16 >> 2)) * 592 + (i16 & 3) * 8);
    constexpr float SC2 = SCALE * LOG2E;
    bf16x8 stg[18];
#define GATHER(tile_) do { const int j0 = (tile_) * 32 + rA, j1 = j0 + 16; const int s0 = j0 < ns ? sel[j0] : 0, s1 = j1 < ns ? sel[j1] : 0; \
        const bf16_t* p0_ = kbase + (size_t)s0 * 288 + cq * 8; const bf16_t* p1_ = kbase + (size_t)s1 * 288 + cq * 8; \
        _Pragma("unroll") for (int c = 0; c < 9; ++c) { stg[2 * c] = *(const bf16x8*)(p0_ + c * 32); stg[2 * c + 1] = *(const bf16x8*)(p1_ + c * 32); } } while (0)
    GATHER(0);
    for (int tile = 0; tile < ntile; ++tile) {
#pragma unroll
        for (int c = 0; c < 9; ++c) { *(bf16x8*)(ldsw + rA * 592 + c * 64 + cq * 16) = stg[2 * c]; *(bf16x8*)(ldsw + (16 + rA) * 592 + c * 64 + cq * 16) = stg[2 * c + 1]; }
        if (tile + 1 < ntile) GATHER(tile + 1);
        asm volatile("s_waitcnt lgkmcnt(0)" ::: "memory"); SBAR();
        f32x4 acc[2];
#pragma unroll
        for (int mt = 0; mt < 2; ++mt) { acc[mt] = (f32x4){0.f, 0.f, 0.f, 0.f};
#pragma unroll
            for (int st = 0; st < 9; ++st) { const bf16x8 a = *(const bf16x8*)(ldsw + (16 * mt + i16) * 592 + st * 64 + g * 16);
                acc[mt] = __builtin_amdgcn_mfma_f32_16x16x32_bf16(a, qf[st], acc[mt], 0, 0, 0); } }
        float tmax = -__builtin_inff();
#pragma unroll
        for (int mt = 0; mt < 2; ++mt)
#pragma unroll
            for (int r = 0; r < 4; ++r) { const int key = tile * 32 + 16 * mt + 4 * g + r; float x = acc[mt][r] * SC2; if (key >= ns) x = -__builtin_inff(); acc[mt][r] = x; tmax = fmaxf(tmax, x); }
        tmax = fmaxf(tmax, __shfl_xor(tmax, 16)); tmax = fmaxf(tmax, __shfl_xor(tmax, 32));
        const float mn = fmaxf(m, tmax), alpha = __builtin_amdgcn_exp2f(m - mn); m = mn;
        float ps = 0.f;
#pragma unroll
        for (int mt = 0; mt < 2; ++mt)
#pragma unroll
            for (int r = 0; r < 4; ++r) { acc[mt][r] = __builtin_amdgcn_exp2f(acc[mt][r] - mn); ps += acc[mt][r]; }
        ps += __shfl_xor(ps, 16); ps += __shfl_xor(ps, 32);
        l = l * alpha + ps;
#pragma unroll
        for (int rb = 0; rb < 16; ++rb) oT[rb] *= alpha;
        const bf16x8 pf = pack8(acc[0], acc[1]);
#define TRRD2(dst, off) asm volatile("ds_read_b64_tr_b16 %0, %1 offset:%2" : "=&v"(dst) : "v"(vb), "i"(off) : "memory")
#define PVRB4(rb) do { s16x4 ta0, tb0, ta1, tb1, ta2, tb2, ta3, tb3; \
        TRRD2(ta0, ((rb) + 0) * 32); TRRD2(tb0, ((rb) + 0) * 32 + 16 * 592); TRRD2(ta1, ((rb) + 1) * 32); TRRD2(tb1, ((rb) + 1) * 32 + 16 * 592); \
        TRRD2(ta2, ((rb) + 2) * 32); TRRD2(tb2, ((rb) + 2) * 32 + 16 * 592); TRRD2(ta3, ((rb) + 3) * 32); TRRD2(tb3, ((rb) + 3) * 32 + 16 * 592); \
        asm volatile("s_waitcnt lgkmcnt(0)" ::: "memory"); SBAR(); \
        oT[(rb) + 0] = __builtin_amdgcn_mfma_f32_16x16x32_bf16((bf16x8){ta0[0], ta0[1], ta0[2], ta0[3], tb0[0], tb0[1], tb0[2], tb0[3]}, pf, oT[(rb) + 0], 0, 0, 0); \
        oT[(rb) + 1] = __builtin_amdgcn_mfma_f32_16x16x32_bf16((bf16x8){ta1[0], ta1[1], ta1[2], ta1[3], tb1[0], tb1[1], tb1[2], tb1[3]}, pf, oT[(rb) + 1], 0, 0, 0); \
        oT[(rb) + 2] = __builtin_amdgcn_mfma_f32_16x16x32_bf16((bf16x8){ta2[0], ta2[1], ta2[2], ta2[3], tb2[0], tb2[1], tb2[2], tb2[3]}, pf, oT[(rb) + 2], 0, 0, 0); \
        oT[(rb) + 3] = __builtin_amdgcn_mfma_f32_16x16x32_bf16((bf16x8){ta3[0], ta3[1], ta3[2], ta3[3], tb3[0], tb3[1], tb3[2], tb3[3]}, pf, oT[(rb) + 3], 0, 0, 0); } while (0)
        PVRB4(0); PVRB4(4); PVRB4(8); PVRB4(12);
#undef PVRB4
#undef TRRD2
        SBAR();
    }
#undef GATHER
    const float rl = 1.0f / l;
    if (i16 < 8) { bf16_t* op = (bf16_t*)(ws + R_OLAT) + (size_t)tok * 2048 + i16 * 256 + 4 * g;
#pragma unroll
        for (int rb = 0; rb < 16; ++rb) { u32x2 w; w.x = cvtpk(oT[rb][0] * rl, oT[rb][1] * rl); w.y = cvtpk(oT[rb][2] * rl, oT[rb][3] * rl); *(u32x2*)(op + rb * 16) = w; } }
}
#ifdef ATT_SUB
#define ASUB(k) ((k) == ATT_SUB)
#else
#define ASUB(k) true
#endif
__device__ __forceinline__ void phase_attn(const Frame& F0, int l, int rep) { const Frame F = fresh(F0);
    unsigned char* ws = F.ws; char* lds = (char*)F.lds;
    const bf16_t* qkv = (const bf16_t*)(ws + R_QKV); const size_t TS = (size_t)NTOK * 1024;
    unsigned* qctr = (unsigned*)(ws + WS_CTL) + CW_QCTR + l * 64 + rep * 16; const unsigned* kmx = (const unsigned*)(ws + WS_CTL) + CW_KMAX + l * 16;
    int* qitem = (int*)(lds + att::OFF_QITEM);
    int* hord = qitem + 4;
    if (F.tid < 16) { const float* cumb = (const float*)(ws + WS_CUM); const float mine = -cumb[(size_t)F.tid * SEQ + SEQ - 1]; int rank = 0;
        for (int o = 0; o < 16; ++o) { const float v = -cumb[(size_t)o * SEQ + SEQ - 1]; rank += (v < mine || (v == mine && o < F.tid)) ? 1 : 0; }
        hord[rank] = F.tid; }
#pragma unroll 1
    for (;;) {
        __syncthreads();
        if (F.tid == 0) qitem[0] = (int)atomicAdd(qctr, 1u);
        __syncthreads();
        const int it = qitem[0];
        if (it >= 1024) break;
        const int md = it >> 9, j = it & 511;
        const int qb = md == 0 ? 31 - (j & 31) : 31 - (j >> 4), bh = md == 0 ? hord[j >> 5] : (j & 15), b = bh >> 3, h = bh & 7, P0 = qb * 256;
        if (!ASUB(md)) continue;
        const bf16_t* Q = qkv + (size_t)(md * 3 + 0) * TS + (size_t)bh * SEQ * 128; const bf16_t* K = qkv + (size_t)(md * 3 + 1) * TS + (size_t)bh * SEQ * 128; const bf16_t* V = qkv + (size_t)(md * 3 + 2) * TS + (size_t)bh * SEQ * 128;
        const float* cum = (const float*)(ws + WS_CUM) + (size_t)bh * SEQ;
        bf16_t* Ob = (bf16_t*)(ws + R_OA) + (size_t)b * SEQ * 3072 + (md + 1) * 1024 + h * 128;
        if (md == 0) { const float kmaxc = sqrtf(__uint_as_float(kmx[bh])) * C2; att::attn_unit<0>(Q, K, V, cum, Ob + (size_t)P0 * 3072, P0, lds, kmaxc); }
        else att::attn_unit<1>(Q, K, V, cum, Ob + (size_t)P0 * 3072, P0, lds, 0.f);
    }
    __syncthreads();
    char* ldsw = lds + F.wid * 18944;
#pragma unroll 1
    for (int rep = 0; rep < NREP(2); ++rep)
#pragma unroll 1
    for (int tok = F.bid * 8 + F.wid; tok < NTOK; tok += F.G * 8) if (ASUB(2)) sparse_query(F, tok, ldsw);
}

__device__ __forceinline__ void ln_row(const bf16_t* src, const float* g, const float* bta, float* of, bf16_t* ob, int lane, unsigned char* oq = nullptr, float* osc = nullptr, float* ost = nullptr) {
    f32x4 v[8]; float s = 0.f;
#pragma unroll
    for (int i = 0; i < 4; ++i) { const u32x4 w = *(const u32x4*)(src + (i * 64 + lane) * 8);
        v[2 * i] = (f32x4){bflo(w.x), bfhi(w.x), bflo(w.y), bfhi(w.y)}; v[2 * i + 1] = (f32x4){bflo(w.z), bfhi(w.z), bflo(w.w), bfhi(w.w)};
        s += (v[2 * i][0] + v[2 * i][1]) + (v[2 * i][2] + v[2 * i][3]) + (v[2 * i + 1][0] + v[2 * i + 1][1]) + (v[2 * i + 1][2] + v[2 * i + 1][3]); }
    s = wave_sum(s); const float mu = s * (1.0f / 2048.0f); float q = 0.f;
#pragma unroll
    for (int i = 0; i < 8; ++i) { const f32x4 d = v[i] - mu; q += (d[0] * d[0] + d[1] * d[1]) + (d[2] * d[2] + d[3] * d[3]); }
    q = wave_sum(q); const float rstd = rsqrtf(q * (1.0f / 2048.0f) + 1e-5f);
    if (ost && lane == 0) { ost[0] = mu; ost[1] = rstd; }
    float amax = 0.f;
#pragma unroll
    for (int i = 0; i < 4; ++i) { const int c = (i * 64 + lane) * 8; const f32x4 g0 = *(const f32x4*)(g + c), g1 = *(const f32x4*)(g + c + 4), b0 = *(const f32x4*)(bta + c), b1 = *(const f32x4*)(bta + c + 4);
        const f32x4 y0 = (v[2 * i] - mu) * rstd * g0 + b0, y1 = (v[2 * i + 1] - mu) * rstd * g1 + b1; v[2 * i] = y0; v[2 * i + 1] = y1;
        if (of) { *(f32x4*)(of + c) = y0; *(f32x4*)(of + c + 4) = y1; }
        if (ob) pg8::st_bf16x8(ob + c, y0, y1);
        if (oq) { amax = fmaxf(amax, fmaxf(fmaxf(fmaxf(fabsf(y0[0]), fabsf(y0[1])), fmaxf(fabsf(y0[2]), fabsf(y0[3]))), fmaxf(fmaxf(fabsf(y1[0]), fabsf(y1[1])), fmaxf(fabsf(y1[2]), fabsf(y1[3]))))); } }
    if (oq) {
        for (int o = 32; o > 0; o >>= 1) amax = fmaxf(amax, __shfl_xor(amax, o));
        amax = fmaxf(amax, 1e-20f); const float qi = 127.0f / amax; if (lane == 0) *osc = amax * (1.0f / 127.0f);
#pragma unroll
        for (int i = 0; i < 4; ++i) { u32x2 w;
#pragma unroll
            for (int h = 0; h < 2; ++h) { const f32x4 y = v[2 * i + h]; unsigned pk = 0u;
#pragma unroll
                for (int j = 0; j < 4; ++j) pk |= ((unsigned)(int)rintf(y[j] * qi) & 0xffu) << (8 * j);
                w[h] = pk; }
            *(u32x2*)(oq + (i * 64 + lane) * 8) = w; } }
}
__device__ __forceinline__ void phase_ln1_router(const Frame& F0, const Params& P, int l) { const Frame F = fresh(F0);
    unsigned char* ws = F.ws; const int lane = F.lane, wid = F.wid;
    const bf16_t* pre1 = (const bf16_t*)(ws + R_PRE1); float* x1f = (float*)(ws + M_X1F); bf16_t* x1b = (bf16_t*)(ws + M_X1B); unsigned char* x1q = (unsigned char*)(ws + M_X1Q); float* x1s = (float*)(ws + M_X1S);
    const float* g = F.in(11) + l * DM; const float* bt = F.in(12) + l * DM; const float* wr = F.in(13) + (size_t)l * DM * NEXP; const float* br = F.in(14) + l * NEXP;
    unsigned* cnt = (unsigned*)(ws + WS_CTL) + CW_CNT + l * 2048;
    int* tok_e = (int*)(ws + M_TOKE); int* tok_pos = (int*)(ws + M_TOKPOS); float* tok_w = (float*)(ws + M_TOKW);
    float* red = (float*)F.lds;
    float* lg = (float*)(F.lds + 32768); float* stats = (float*)(F.lds + 32768 + 16384);
#pragma unroll 1
    for (int blk = F.bid; blk < NTOK / 64; blk += F.G) {
        const int tok0 = blk * 64;
#pragma unroll 1
        for (int i = 0; i < 8; ++i) { const int tok = tok0 + wid * 8 + i; ln_row(pre1 + (size_t)tok * DM, g, bt, (float*)nullptr, x1b + (size_t)tok * DM, lane, x1q + (size_t)tok * DM, x1s + tok, stats + 2 * (wid * 8 + i)); }
        asm volatile("s_waitcnt vmcnt(0)" ::: "memory"); __syncthreads();
        { const int grp = wid >> 2, kq = wid & 3, i32 = lane & 31, hk = lane >> 5; f32x16 acc = {};
          const bf16_t* arow = pre1 + (size_t)(tok0 + grp * 32 + i32) * DM + kq * 512 + 4 * hk; const float* bcol = wr + (size_t)(kq * 512 + 4 * hk) * NEXP + i32;
          const float* gp = g + kq * 512 + 4 * hk; const float* bp = bt + kq * 512 + 4 * hk; const float mu = stats[2 * (grp * 32 + i32)], rstd = stats[2 * (grp * 32 + i32) + 1];
#pragma unroll 4
          for (int c8 = 0; c8 < 64; ++c8) { const u32x2 xw = *(const u32x2*)(arow + c8 * 8); const f32x4 g4 = *(const f32x4*)(gp + c8 * 8), b4 = *(const f32x4*)(bp + c8 * 8);
              const f32x4 a4 = ((f32x4){bflo(xw.x), bfhi(xw.x), bflo(xw.y), bfhi(xw.y)} - mu) * rstd * g4 + b4;
              const float b0 = bcol[(size_t)(c8 * 8 + 0) * NEXP], b1 = bcol[(size_t)(c8 * 8 + 1) * NEXP], b2 = bcol[(size_t)(c8 * 8 + 2) * NEXP], b3 = bcol[(size_t)(c8 * 8 + 3) * NEXP];
              acc = __builtin_amdgcn_mfma_f32_32x32x2f32(a4[0], b0, acc, 0, 0, 0); acc = __builtin_amdgcn_mfma_f32_32x32x2f32(a4[1], b1, acc, 0, 0, 0);
              acc = __builtin_amdgcn_mfma_f32_32x32x2f32(a4[2], b2, acc, 0, 0, 0); acc = __builtin_amdgcn_mfma_f32_32x32x2f32(a4[3], b3, acc, 0, 0, 0); }
#pragma unroll
          for (int r = 0; r < 16; ++r) red[(wid * 16 + r) * 64 + lane] = acc[r]; }
        __syncthreads();
        if ((wid & 3) == 0) { const int grp = wid >> 2, hk = lane >> 5, e = lane & 31; const float be = br[e];
#pragma unroll
            for (int r = 0; r < 16; ++r) { const float v = red[((wid + 0) * 16 + r) * 64 + lane] + red[((wid + 1) * 16 + r) * 64 + lane] + red[((wid + 2) * 16 + r) * 64 + lane] + red[((wid + 3) * 16 + r) * 64 + lane] + be;
                lg[(grp * 32 + crow(r, hk)) * 33 + e] = v; }
            asm volatile("s_waitcnt lgkmcnt(0)" ::: "memory"); SBAR();
            const int tk = lane & 31; float v[32];
#pragma unroll
            for (int e2 = 0; e2 < 32; ++e2) v[e2] = lg[(grp * 32 + tk) * 33 + e2];
            int ek[4]; float vk[4];
#pragma unroll
            for (int k = 0; k < 4; ++k) { float best = -__builtin_inff(); int bi = 0;
#pragma unroll
                for (int e2 = 0; e2 < 32; ++e2) if (v[e2] > best) { best = v[e2]; bi = e2; }
                ek[k] = bi; vk[k] = best;
#pragma unroll
                for (int e2 = 0; e2 < 32; ++e2) v[e2] = (e2 == bi) ? -__builtin_inff() : v[e2]; }
            float wk[4], sw = 0.f;
#pragma unroll
            for (int k = 0; k < 4; ++k) { wk[k] = __expf(vk[k] - vk[0]); sw += wk[k]; }
            const float rs = 1.0f / sw;
            const bool act = lane < 32; unsigned myc = 0u;
#pragma unroll 1
            for (int E = 0; E < 32; ++E) { unsigned c = 0u;
#pragma unroll
                for (int k = 0; k < 4; ++k) c += (unsigned)__popcll(__ballot(act && ek[k] == E));
                if (lane == E) myc = c; }
            unsigned run = 0u; if (lane < 32 && myc > 0u) run = atomicAdd(&cnt[lane * 64], myc);
            int pk[4];
#pragma unroll
            for (int k = 0; k < 4; ++k) { pk[k] = 0;
#pragma unroll 1
                for (int E = 0; E < 32; ++E) { const unsigned long long mm = __ballot(act && ek[k] == E); const unsigned basev = (unsigned)__shfl((int)run, E);
                    if (act && ek[k] == E) pk[k] = (int)(basev + (unsigned)__popcll(mm & ((1ull << lane) - 1ull)));
                    if (lane == E) run += (unsigned)__popcll(mm); } }
            if (act) { const int tok = tok0 + grp * 32 + tk;
#pragma unroll
                for (int k = 0; k < 4; ++k) { tok_e[tok * 4 + k] = ek[k]; tok_pos[tok * 4 + k] = pk[k]; tok_w[tok * 4 + k] = wk[k] * rs; } }
        }
        __syncthreads();
    }
}
__device__ __forceinline__ void phase_moe_gather(const Frame& F0, int l) { const Frame F = fresh(F0);
    unsigned char* ws = F.ws; const int lane = F.lane;
    const unsigned* cnt = (const unsigned*)(ws + WS_CTL) + CW_CNT + l * 2048; unsigned* meta = (unsigned*)(ws + WS_CTL) + CW_META + l * 512;
    unsigned* offs = (unsigned*)(F.lds + LDS_MISC + 64);
    if (F.tid == 0) { unsigned o = 0u; for (int e = 0; e < 32; ++e) { offs[e] = o; o += (cnt[e * 64] + 255u) & ~255u; } offs[32] = o;
        if (F.bid == 0) { meta[0] = o >> 8; for (int e = 0; e < 32; ++e) for (unsigned t = offs[e] >> 8; t < (offs[e + 1] >> 8); ++t) meta[1 + t] = (unsigned)e; } }
    __syncthreads();
    const int* tok_e = (const int*)(ws + M_TOKE); const int* tok_pos = (const int*)(ws + M_TOKPOS); const float* tok_w = (const float*)(ws + M_TOKW);
    int* tok_dst = (int*)(ws + M_TOKDST); float* roww = (float*)(ws + M_ROWW);
    const unsigned char* x1q = (const unsigned char*)(ws + M_X1Q); const float* x1s = (const float*)(ws + M_X1S); unsigned char* xs = (unsigned char*)(ws + M_XS); float* rowsx = (float*)(ws + M_ROWSX);
    for (int it = F.bid * 8 + F.wid; it < NTOK * 4; it += F.G * 8) { const int tok = it >> 2;
        const int e = tok_e[it]; const unsigned dst = offs[e] + (unsigned)tok_pos[it];
        if (lane == 0) { tok_dst[it] = (int)dst; roww[dst] = tok_w[it]; rowsx[dst] = x1s[tok]; }
        const u32x4* sp = (const u32x4*)(x1q + (size_t)tok * DM); u32x4* dp = (u32x4*)(xs + (size_t)dst * DM);
#pragma unroll
        for (int i = 0; i < 2; ++i) dp[i * 64 + lane] = sp[i * 64 + lane]; }
    __syncthreads();
}
__device__ __forceinline__ void phase_quant_h(const Frame& F0, int l) { const Frame F = fresh(F0);
    unsigned char* ws = F.ws; const int lane = F.lane;
    const int nrows = (int)((const unsigned*)(ws + WS_CTL))[CW_META + l * 512] * 256;
    const float* hm = (const float*)(ws + M_HM); const bf16_t* hid = (const bf16_t*)(ws + M_HID); unsigned char* h8 = (unsigned char*)(ws + M_H8); float* h8s = (float*)(ws + M_H8S);
    for (int row = F.bid * 8 + F.wid; row < nrows; row += F.G * 8) {
        float am = hm[(size_t)row * 32 + (lane & 31)];
        const u32x4 a = *(const u32x4*)(hid + (size_t)row * DEXP + lane * 16), b = *(const u32x4*)(hid + (size_t)row * DEXP + lane * 16 + 8);
        for (int o = 16; o > 0; o >>= 1) am = fmaxf(am, __shfl_xor(am, o));
        am = fmaxf(am, 1e-20f); const float qi = 127.0f / am; if (lane == 0) h8s[row] = am * (1.0f / 127.0f);
        const unsigned wv[8] = {a.x, a.y, a.z, a.w, b.x, b.y, b.z, b.w}; u32x4 w;
#pragma unroll
        for (int d = 0; d < 4; ++d) { unsigned pk = 0u;
#pragma unroll
            for (int j = 0; j < 2; ++j) { const unsigned x = wv[d * 2 + j];
                const float q0 = fminf(fmaxf(rintf(bflo(x) * qi), -127.f), 127.f), q1 = fminf(fmaxf(rintf(bfhi(x) * qi), -127.f), 127.f);
                pk |= (((unsigned)(int)q0 & 0xffu) | (((unsigned)(int)q1 & 0xffu) << 8)) << (16 * j); }
            w[d] = pk; }
        *(u32x4*)(h8 + (size_t)row * DEXP + lane * 16) = w; }
}
__device__ __forceinline__ void phase_combine(const Frame& F0) { const Frame F = fresh(F0);
    unsigned char* ws = F.ws; const int lane = F.lane;
    const bf16_t* x1b = (const bf16_t*)(ws + M_X1B); const bf16_t* ys = (const bf16_t*)(ws + M_XS); const int* tok_dst = (const int*)(ws + M_TOKDST);
    bf16_t* hb = (bf16_t*)(ws + M_HB); unsigned char* hq = (unsigned char*)(ws + M_HQ); float* hsc = (float*)(ws + M_HSC);
    for (int tok = F.bid * 8 + F.wid; tok < NTOK; tok += F.G * 8) {
        const int d0 = tok_dst[tok * 4], d1 = tok_dst[tok * 4 + 1], d2 = tok_dst[tok * 4 + 2], d3 = tok_dst[tok * 4 + 3];
        f32x4 hv[8]; float amax = 0.f;
#pragma unroll
        for (int i = 0; i < 4; ++i) { const int c = (i * 64 + lane) * 8; const size_t o = (size_t)tok * DM + c;
            const u32x4 xw = *(const u32x4*)(x1b + o);
            f32x4 a = (f32x4){bflo(xw.x), bfhi(xw.x), bflo(xw.y), bfhi(xw.y)} * ALPHA, b = (f32x4){bflo(xw.z), bfhi(xw.z), bflo(xw.w), bfhi(xw.w)} * ALPHA;
            const u32x4 y0 = *(const u32x4*)(ys + (size_t)d0 * DM + c), y1 = *(const u32x4*)(ys + (size_t)d1 * DM + c), y2 = *(const u32x4*)(ys + (size_t)d2 * DM + c), y3 = *(const u32x4*)(ys + (size_t)d3 * DM + c);
            a[0] += (bflo(y0.x) + bflo(y1.x)) + (bflo(y2.x) + bflo(y3.x)); a[1] += (bfhi(y0.x) + bfhi(y1.x)) + (bfhi(y2.x) + bfhi(y3.x));
            a[2] += (bflo(y0.y) + bflo(y1.y)) + (bflo(y2.y) + bflo(y3.y)); a[3] += (bfhi(y0.y) + bfhi(y1.y)) + (bfhi(y2.y) + bfhi(y3.y));
            b[0] += (bflo(y0.z) + bflo(y1.z)) + (bflo(y2.z) + bflo(y3.z)); b[1] += (bfhi(y0.z) + bfhi(y1.z)) + (bfhi(y2.z) + bfhi(y3.z));
            b[2] += (bflo(y0.w) + bflo(y1.w)) + (bflo(y2.w) + bflo(y3.w)); b[3] += (bfhi(y0.w) + bfhi(y1.w)) + (bfhi(y2.w) + bfhi(y3.w));
            pg8::st_bf16x8(hb + o, a, b); hv[2 * i] = a; hv[2 * i + 1] = b;
#pragma unroll
            for (int j = 0; j < 4; ++j) amax = fmaxf(amax, fmaxf(fabsf(a[j]), fabsf(b[j]))); }
        for (int o = 32; o > 0; o >>= 1) amax = fmaxf(amax, __shfl_xor(amax, o));
        amax = fmaxf(amax, 1e-20f); const float qi = 127.0f / amax; if (lane == 0) hsc[tok] = amax * (1.0f / 127.0f);
#pragma unroll
        for (int i = 0; i < 4; ++i) { u32x2 w;
#pragma unroll
            for (int h = 0; h < 2; ++h) { unsigned pk = 0u;
#pragma unroll
                for (int j = 0; j < 4; ++j) pk |= ((unsigned)(int)rintf(hv[2 * i + h][j] * qi) & 0xffu) << (8 * j);
                w[h] = pk; }
            *(u32x2*)(hq + (size_t)tok * DM + (i * 64 + lane) * 8) = w; } }
}
__device__ __forceinline__ void phase_ln2(const Frame& F0, const Params& P, int l) { const Frame F = fresh(F0);
    unsigned char* ws = F.ws; const bf16_t* pre2 = (const bf16_t*)(ws + M_X1F); bf16_t* xb = (bf16_t*)(ws + WS_XB);
    const float* g = F.in(23) + l * DM; const float* bt = F.in(24) + l * DM; float* outp = F.out();
    for (int tok = F.bid * 8 + F.wid; tok < NTOK; tok += F.G * 8) ln_row(pre2 + (size_t)tok * DM, g, bt, (l + 1 == NLAYER) ? outp + (size_t)tok * DM : (float*)nullptr, (l + 1 == NLAYER) ? (bf16_t*)nullptr : xb + (size_t)tok * DM, F.lane,
                                                                          (l + 1 == NLAYER) ? (unsigned char*)nullptr : (unsigned char*)(ws + WS_XQ) + (size_t)tok * DM, (l + 1 == NLAYER) ? (float*)nullptr : (float*)(ws + WS_XSC) + tok);
}

constexpr int NPHASE = 2 + 15 * NLAYER;
#ifdef PH_ONLY
#define PEN(kind) ((kind) == PH_ONLY)
#else
#define PEN(kind) true
#endif
#define IN(k) (lo <= (k) && (k) < hi)
#define SEAM(k) do { if (IN((k) + 1)) xcd_barrier(bar); } while (0)

template <int l>
__device__ __forceinline__ void layer_phases(const Frame& F, const Params& P, const XcdBarrier& bar, const int lo, const int hi, unsigned char* ws0) {
    using namespace pg8;

        const int pb = 2 + 15 * l;
        if (IN(pb + 0) && PEN(0)) { size_t wz = 0; asm volatile("" : "+s"(wz)); unsigned char* ws = ws0 + wz;
            { SchedS S; S.init(NTOK, 5 * 256, F.G, F.bid, (const bf16_t*)(ws + WS_XB), DM, (const bf16_t*)(ws + W_IN), DM); S.skip_from = 0; S.skip_by = 4; S.skip_from2 = 4; S.skip_by2 = 49;
              EpiInProj<false> E{(bf16_t*)(ws + R_QA), (bf16_t*)(ws + R_QIDX), (bf16_t*)(ws + R_QKV), (bf16_t*)(ws + R_GATES), (float*)(ws + R_SMALL), nullptr, nullptr};
              for (int rep = 0; rep < NREP(5); ++rep) gemm_phase(F.ldsl, DM, DM, DM, S, E); }
            { SchedS S; S.init(NTOK, 53 * 256, F.G, (F.bid + F.G / 2) % F.G, (const bf16_t*)(ws + WS_XQ), DM / 2, (const bf16_t*)(ws + W_IN8), DM / 2); S.skip_from = 4; S.skip_by = 4; S.b_compact = 1;
              EpiInProj<true> E{(bf16_t*)(ws + R_QA), (bf16_t*)(ws + R_QIDX), (bf16_t*)(ws + R_QKV), (bf16_t*)(ws + R_GATES), (float*)(ws + R_SMALL), (const float*)(ws + WS_XSC), (const unsigned*)(ws + WS_CTL) + CW_WMAXG + l};
              for (int rep = 0; rep < NREP(5); ++rep) gemm_phase(F.ldsl, DM / 2, DM / 2, DM / 2, S, E); }
            SEAM(pb + 0); }
        if (IN(pb + 1) && PEN(1)) { size_t wz = 0; asm volatile("" : "+s"(wz)); unsigned char* ws = ws0 + wz;
            phase_prep(F, P, l);
            SchedS S; S.init(NTOK, 2048, F.G, F.bid, (const bf16_t*)(ws + R_QA), 1024, (const bf16_t*)(ws + W_UK2), 256, 1, 256);
            EpiBf16 E{(bf16_t*)(ws + R_QCAT), 2304, 288};
            for (int rep = 0; rep < NREP(10); ++rep) gemm_phase(F.ldsl, 256, 1024, 256, S, E); SEAM(pb + 1); }
        if (IN(pb + 2) && PEN(2)) { size_t wz = 0; asm volatile("" : "+s"(wz)); unsigned char* ws = ws0 + wz; phase_cumsum(F); for (int rep = 0; rep < NREP(3); ++rep) phase_idx(F); SEAM(pb + 2); }
        if (IN(pb + 3) && PEN(3)) { size_t wz = 0; asm volatile("" : "+s"(wz)); unsigned char* ws = ws0 + wz; for (int rep = 0; rep < NREP(4); ++rep) phase_topk(F); SEAM(pb + 3); }
        if (IN(pb + 4) && PEN(4)) { size_t wz = 0; asm volatile("" : "+s"(wz)); unsigned char* ws = ws0 + wz; for (int rep = 0; rep < NREP(1); ++rep) phase_attn(F, l, rep); SEAM(pb + 4); }
        if (IN(pb + 5) && PEN(5)) { size_t wz = 0; asm volatile("" : "+s"(wz)); unsigned char* ws = ws0 + wz;
            SchedS S; S.init(NTOK, 1024, F.G, F.bid, (const bf16_t*)(ws + R_OLAT), 2048, (const bf16_t*)(ws + W_UV2), 512, 0, 512);
            EpiBf16 E{(bf16_t*)(ws + R_OA), 3072, 256}; for (int rep = 0; rep < NREP(10); ++rep) gemm_phase(F.ldsl, 512, 2048, 512, S, E);
            SEAM(pb + 5); }
        if (IN(pb + 6) && PEN(6)) { size_t wz = 0; asm volatile("" : "+s"(wz)); unsigned char* ws = ws0 + wz;
            SchedS S; S.init(NTOK, 2048, F.G, F.bid, (const bf16_t*)(ws + R_OA), 3072, (const bf16_t*)(ws + W_BRA), 3072);
            EpiBranch3 E{(const unsigned char*)(ws + R_GATES), (bf16_t*)(ws + R_MERGED)}; for (int rep = 0; rep < NREP(11); ++rep) gemm_phase(F.ldsl, 3072, 3072, 3072, S, E); SEAM(pb + 6); }
        if (IN(pb + 7) && PEN(7)) { size_t wz = 0; asm volatile("" : "+s"(wz)); unsigned char* ws = ws0 + wz;
            SchedS S; S.init(NTOK, 2048, F.G, F.bid, (const bf16_t*)(ws + R_MERGED), DM, (const bf16_t*)(ws + W_OUT), DM);
            EpiOut E{(const bf16_t*)(ws + WS_XB), (bf16_t*)(ws + R_PRE1)}; for (int rep = 0; rep < NREP(8); ++rep) gemm_phase(F.ldsl, DM, DM, DM, S, E); SEAM(pb + 7); }
        if (IN(pb + 8) && PEN(8)) { size_t wz = 0; asm volatile("" : "+s"(wz)); unsigned char* ws = ws0 + wz; phase_ln1_router(F, P, l); SEAM(pb + 8); }
        if (IN(pb + 9) && PEN(9)) { size_t wz = 0; asm volatile("" : "+s"(wz)); unsigned char* ws = ws0 + wz;
            for (int rep = 0; rep < NREP(12); ++rep) phase_moe_gather(F, l);
            SchedS S; S.init(NTOK, 2048, F.G, F.bid, (const bf16_t*)(ws + WS_PB) + (size_t)l * NTOK * 256, 256, (const bf16_t*)(ws + W_PLE), 256);
            EpiBf16 E{(bf16_t*)(ws + M_PP), 2048, 256}; for (int rep = 0; rep < NREP(10); ++rep) gemm_phase(F.ldsl, 256, 256, 256, S, E); SEAM(pb + 9); }
        if (IN(pb + 10) && PEN(10)) { size_t wz = 0; asm volatile("" : "+s"(wz)); unsigned char* ws = ws0 + wz;
            SchedM S; S.init((const unsigned*)(ws + WS_CTL) + CW_META + l * 512, F.G, F.bid, (const bf16_t*)(ws + M_XS), DM / 2, (const bf16_t*)(ws + W_GU), DM / 2);
            EpiGateUpI8 E{F.in(16) + (size_t)l * NEXP * DEXP, F.in(18) + (size_t)l * NEXP * DEXP, (bf16_t*)(ws + M_HID), (const float*)(ws + M_ROWSX), (const unsigned*)(ws + WS_CTL) + CW_WMAX + l, (float*)(ws + M_HM)};
            for (int rep = 0; rep < NREP(6); ++rep) gemm_phase(F.ldsl, DM / 2, DM / 2, DM / 2, S, E); SEAM(pb + 10); }
        if (IN(pb + 11) && PEN(11)) { size_t wz = 0; asm volatile("" : "+s"(wz)); unsigned char* ws = ws0 + wz;
            phase_quant_h(F, l); xcd_barrier(bar);
            SchedM S; S.init((const unsigned*)(ws + WS_CTL) + CW_META + l * 512, F.G, F.bid, (const bf16_t*)(ws + M_H8), DEXP / 2, (const bf16_t*)(ws + W_DN), DEXP / 2);
            EpiDownI8 E{F.in(20) + (size_t)l * NEXP * DM, (const float*)(ws + M_ROWW), (bf16_t*)(ws + M_XS), (const float*)(ws + M_H8S), (const unsigned*)(ws + WS_CTL) + CW_WMAXD + l};
            for (int rep = 0; rep < NREP(7); ++rep) gemm_phase(F.ldsl, DEXP / 2, DEXP / 2, DEXP / 2, S, E); SEAM(pb + 11); }
        if (IN(pb + 12) && PEN(12)) { size_t wz = 0; asm volatile("" : "+s"(wz)); unsigned char* ws = ws0 + wz; for (int rep = 0; rep < NREP(9); ++rep) phase_combine(F); SEAM(pb + 12); }
        if (IN(pb + 13) && PEN(13)) { size_t wz = 0; asm volatile("" : "+s"(wz)); unsigned char* ws = ws0 + wz;
            SchedS S; S.init(NTOK, 2048, F.G, F.bid, (const bf16_t*)(ws + M_HQ), DM / 2, (const bf16_t*)(ws + W_PG), DM / 2);
            EpiPleGateI8 E{(const bf16_t*)(ws + M_HB), (const bf16_t*)(ws + M_PP), (bf16_t*)(ws + M_X1F), (const float*)(ws + M_HSC), (const unsigned*)(ws + WS_CTL) + CW_WMAXP + l};
            for (int rep = 0; rep < NREP(8); ++rep) gemm_phase(F.ldsl, DM / 2, DM / 2, DM / 2, S, E); SEAM(pb + 13); }
        if (IN(pb + 14) && PEN(14)) { size_t wz = 0; asm volatile("" : "+s"(wz)); unsigned char* ws = ws0 + wz; for (int rep = 0; rep < NREP(13); ++rep) phase_ln2(F, P, l); if (l + 1 < NLAYER) for (int rep = 0; rep < NREP(0); ++rep) convert_layer_weights(F, P, l + 1); SEAM(pb + 14); }
}
__global__ void __launch_bounds__(512, 2) fwd(Params P) {
    extern __shared__ __attribute__((aligned(16))) unsigned char lds[];
    Frame F; F.lds = lds; F.ldsl = (LAS unsigned char*)lds; F.ws = P.ws; F.tid = threadIdx.x; F.lane = F.tid & 63; F.wid = __builtin_amdgcn_readfirstlane(F.tid >> 6); F.G = gridDim.x; F.bid = blockIdx.x;
    unsigned char* ws0 = P.ws; unsigned char* ws = ws0;
    const bool fused = (P.ph_hi - P.ph_lo) > 1;
    if (F.tid < 4) ((LAS unsigned*)(F.ldsl + LDS_MISC))[F.tid] = 0u;
    if (F.tid == 0) { LAS unsigned long long* t = (LAS unsigned long long*)(F.ldsl + LDS_PTRS);
#pragma unroll
        for (int k = 0; k < 25; ++k) t[k] = (unsigned long long)P.in[k];
        t[25] = (unsigned long long)P.out; }
    __syncthreads();
    XcdBarrier bar; bar.bar = (unsigned*)(ws + WS_CTL) + CW_BAR; bar.x = 0; bar.st = (volatile LAS unsigned*)(F.ldsl + LDS_MISC);
    if (fused) bar = xcd_barrier_post((unsigned*)(ws + WS_CTL) + CW_BAR, (volatile LAS unsigned*)(F.ldsl + LDS_MISC));
    const int lo = P.ph_lo, hi = P.ph_hi;
    using namespace pg8;
    if (IN(0) && PEN(15)) { size_t wz = 0; asm volatile("" : "+s"(wz)); unsigned char* ws = ws0 + wz;
        quant_rows(F, F.in(0), (bf16_t*)(ws + WS_XB), (unsigned char*)(ws + WS_XQ), (float*)(ws + WS_XSC));
        conv_rows(F, F.in(1), (bf16_t*)(ws + WS_PB), (size_t)2 * NTOK * 256 / 8);
        sample_wmax(F);
        SEAM(0);
    }
    if (IN(1) && PEN(15)) { for (int rep = 0; rep < NREP(0); ++rep) convert_layer_weights(F, P, 0); SEAM(1); }
    layer_phases<0>(F, P, bar, lo, hi, ws0);
    layer_phases<1>(F, P, bar, lo, hi, ws0);
}

#ifdef DEBUG_NAN
constexpr int CW_FLAGS = 12288;
__global__ void dbg_scan_bf16(const unsigned short* p, size_t n, unsigned* flag) { unsigned c = 0; for (size_t i = (size_t)blockIdx.x * blockDim.x + threadIdx.x; i < n; i += (size_t)gridDim.x * blockDim.x) if ((p[i] & 0x7F80u) == 0x7F80u) ++c; if (c) atomicAdd(flag, c); }
__global__ void dbg_scan_f32(const unsigned* p, size_t n, unsigned* flag) { unsigned c = 0; for (size_t i = (size_t)blockIdx.x * blockDim.x + threadIdx.x; i < n; i += (size_t)gridDim.x * blockDim.x) if ((p[i] & 0x7F800000u) == 0x7F800000u) ++c; if (c) atomicAdd(flag, c); }
__global__ void dbg_scan_sel(const int* sel, const int* nsel, unsigned* flag) { unsigned c = 0; for (size_t i = (size_t)blockIdx.x * blockDim.x + threadIdx.x; i < (size_t)NTOK * 256; i += (size_t)gridDim.x * blockDim.x) { const int tok = (int)(i >> 8), j = (int)(i & 255), t = tok & (SEQ - 1); const int ns = nsel[tok]; if (j == 0 && ns != (t + 1 < 256 ? t + 1 : 256)) ++c; if (j < ns && (sel[i] < 0 || sel[i] > t)) ++c; } if (c) atomicAdd(flag, c); }
__global__ void dbg_scan_scores(const unsigned* p, unsigned* flag) { unsigned c = 0; for (size_t i = (size_t)blockIdx.x * blockDim.x + threadIdx.x; i < 2ull * SEQ * SEQ; i += (size_t)gridDim.x * blockDim.x) { const int s = (int)(i & (SEQ - 1)), t = (int)((i >> 13) & (SEQ - 1)); if (s <= t && (p[i] & 0x7F800000u) == 0x7F800000u) ++c; } if (c) atomicAdd(flag, c); }
__global__ void dbg_probe_bf16(const unsigned short* p, size_t n, unsigned* cnt, unsigned* minidx) { unsigned c = 0; unsigned mi = 0xFFFFFFFFu; for (size_t i = (size_t)blockIdx.x * blockDim.x + threadIdx.x; i < n; i += (size_t)gridDim.x * blockDim.x) if ((p[i] & 0x7F80u) == 0x7F80u) { ++c; if ((unsigned)i < mi) mi = (unsigned)i; } if (c) { atomicAdd(cnt, c); atomicMax(minidx, ~mi); } }
__global__ void dbg_final(float* out, size_t n, const unsigned* flags) { int code = 0; for (int k = 0; k < 32; ++k) if (flags[k] && !code) code = k + 1; const int mask = (flags[32] ? 1 : 0) | (flags[33] ? 2 : 0) | (flags[34] ? 4 : 0); if (mask) code = 20 + 5 * mask; if (!code) return; for (size_t i = (size_t)blockIdx.x * blockDim.x + threadIdx.x; i < n; i += (size_t)gridDim.x * blockDim.x) out[i] = (float)code; }
#endif
extern "C" void kernel_launch(void* const* d_in, const int* in_sizes, int n_in, void* d_out, int out_size, void* d_ws, size_t ws_size, hipStream_t stream) {
    static int grid = 0;
    if (grid == 0) {
        if (n_in != 25 || out_size != NTOK * DM || ws_size < WS_NEED) { fprintf(stderr, "kernel_launch: unexpected shapes (n_in %d out %d ws %zu need %zu)\n", n_in, out_size, ws_size, (size_t)WS_NEED); grid = -1; return; }
        int dev = 0, cus = 0, per_cu = 0;
        if (hipGetDevice(&dev) != hipSuccess || hipDeviceGetAttribute(&cus, hipDeviceAttributeMultiprocessorCount, dev) != hipSuccess) { grid = -1; return; }
        if (hipFuncSetAttribute((const void*)fwd, hipFuncAttributeMaxDynamicSharedMemorySize, LDS_BYTES) != hipSuccess) { fprintf(stderr, "kernel_launch: hipFuncSetAttribute failed\n"); grid = -1; return; }
        if (hipOccupancyMaxActiveBlocksPerMultiprocessor(&per_cu, (const void*)fwd, 512, LDS_BYTES) != hipSuccess || per_cu < 1) fprintf(stderr, "kernel_launch: occupancy query says %d\n", per_cu);
        (void)hipGetLastError();
        grid = cus;
    }
    if (grid < 0) return;
    unsigned char* ws = (unsigned char*)d_ws;
    hipMemsetAsync(ws + WS_CTL, 0, CTL_BYTES, stream);
    hipMemsetAsync(ws + W_UK2, 0, 8ull * 256 * 256 * 2 + 4ull * 256 * 512 * 2, stream);
    hipMemsetAsync(ws + W_IN + (size_t)INW * 2048 * 2, 0, (size_t)(INWP - INW) * 2048 * 2, stream);
    Params p{};
    for (int i = 0; i < 25; ++i) p.in[i] = (const float*)d_in[i];
    p.out = (float*)d_out; p.ws = ws;
#if PHASES_PER_LAUNCH == 0
    p.ph_lo = 0; p.ph_hi = NPHASE;
    hipLaunchKernelGGL(fwd, dim3(grid), dim3(512), LDS_BYTES, stream, p);
#else
    for (int k = 0; k < NPHASE; ++k) { p.ph_lo = k; p.ph_hi = k + 1; hipLaunchKernelGGL(fwd, dim3(grid), dim3(512), LDS_BYTES, stream, p);
#ifdef DEBUG_NAN
        unsigned* fl = (unsigned*)(ws + WS_CTL) + CW_FLAGS + k;
#define SB16(off, n) hipLaunchKernelGGL(dbg_scan_bf16, dim3(1024), dim3(256), 0, stream, (const unsigned short*)(ws + (off)), (size_t)(n), fl)
#define SF32(off, n) hipLaunchKernelGGL(dbg_scan_f32, dim3(1024), dim3(256), 0, stream, (const unsigned*)(ws + (off)), (size_t)(n), fl)
        if (k == 0) { SB16(WS_XB, (size_t)NTOK * DM); SB16(WS_PB, 2ull * NTOK * 256); SB16(WS_W, (W_END - WS_W) / 2); }
        else { const int kind = (k - 1) % 15;
            if (kind == 0) { SB16(R_QA, (size_t)NTOK * 1024); SB16(R_QIDX, (size_t)NTOK * 1024); SB16(R_QKV, 6ull * NTOK * 1024); SB16(R_GATES, (size_t)NTOK * 6144); SF32(R_SMALL, (size_t)NTOK * 512); }
            if (kind == 1) { SB16(R_QCAT, (size_t)NTOK * 2304); SB16(R_KCAT, (size_t)NTOK * 288); SB16(R_KI, (size_t)NTOK * 64); SB16(R_QIDX, (size_t)NTOK * 1024); SF32(R_WI, (size_t)NTOK * 16); SF32(WS_LF, 16ull * 8192); }
            if (kind == 2) { SF32(WS_CUM, 16ull * 8192); hipLaunchKernelGGL(dbg_scan_scores, dim3(1024), dim3(256), 0, stream, (const unsigned*)(ws + R_SCORES), fl); }
            if (kind == 3) { hipLaunchKernelGGL(dbg_scan_sel, dim3(1024), dim3(256), 0, stream, (const int*)(ws + R_SEL), (const int*)(ws + R_NSEL), fl); }
            if (k == 5) { unsigned* fl0 = fl; fl = (unsigned*)(ws + WS_CTL) + CW_FLAGS + 32; SB16(R_OLAT, (size_t)NTOK * 2048); fl += 1; SB16(R_OA, (size_t)NTOK * 3072); fl += 1; fl = fl0; hipLaunchKernelGGL(dbg_probe_bf16, dim3(1024), dim3(256), 0, stream, (const unsigned short*)(ws + R_OC), (size_t)NTOK * 1024, (unsigned*)(ws + WS_CTL) + CW_FLAGS + 40, (unsigned*)(ws + WS_CTL) + CW_FLAGS + 41); }
            if (kind == 5) { SB16(R_OA, (size_t)NTOK * 3072); }
            if (kind == 6) { SB16(R_MERGED, (size_t)NTOK * 2048); }
            if (kind == 7) { SF32(R_PRE1, (size_t)NTOK * 2048); }
            if (kind == 8) { SF32(M_X1F, (size_t)NTOK * 2048); SF32(M_TOKW, (size_t)NTOK * 4); }
            if (kind == 9) { SB16(M_PP, (size_t)NTOK * 2048); }
            if (kind == 12) { SF32(M_HF, (size_t)NTOK * 2048); }
            if (kind == 13) { SF32(M_X1F, (size_t)NTOK * 2048); }
            if (kind == 14) { hipLaunchKernelGGL(dbg_scan_f32, dim3(1024), dim3(256), 0, stream, (const unsigned*)d_out, (size_t)NTOK * DM, fl); if (k + 1 < NPHASE) SB16(WS_W, (W_END - WS_W) / 2); } }
#endif
    }
#ifdef DEBUG_NAN
    hipLaunchKernelGGL(dbg_final, dim3(1024), dim3(256), 0, stream, (float*)d_out, (size_t)NTOK * DM, (const unsigned*)(ws + WS_CTL) + CW_FLAGS);
#endif
#endif
}
```

```cpp
#include <hip/hip_runtime.h>
#include <stdint.h>
#include <stdio.h>
#include <math.h>

#ifndef PHASES_PER_LAUNCH
#define PHASES_PER_LAUNCH 0
#endif

#define LAS __attribute__((address_space(3)))
#define GAS __attribute__((address_space(1)))
#ifndef REP_MASK
#define REP_MASK 0
#endif
#define NREP(bit) (((REP_MASK) >> (bit)) & 1 ? 2 : 1)
typedef unsigned short bf16_t;
typedef short bf16x8 __attribute__((ext_vector_type(8)));
typedef short s16x4 __attribute__((ext_vector_type(4)));
typedef float f32x4 __attribute__((ext_vector_type(4)));
typedef float f32x16 __attribute__((ext_vector_type(16)));
typedef unsigned u32x4 __attribute__((ext_vector_type(4)));
typedef unsigned u32x2 __attribute__((ext_vector_type(2)));
typedef int i32x4 __attribute__((ext_vector_type(4)));

constexpr int NTOK = 16384, DM = 2048, SEQ = 8192, NB = 2, NLAYER = 2;
constexpr int INW = 14712, INWP = 14848;
constexpr int NEXP = 32, DEXP = 1024;
constexpr int PMAX = 65536 + 8192;
constexpr float ALPHA = 1.41421356237309515f;
constexpr float LOG2E = 1.4426950408889634f;
constexpr float SCALE = 0.08838834764831845f;
constexpr float C2 = LOG2E * SCALE;

constexpr size_t MiB = 1ull << 20;
constexpr size_t WS_CTL   = 0;
constexpr size_t WS_W     = 1 * MiB;
constexpr size_t W_IN     = WS_W;
constexpr size_t W_IN8    = W_IN   + 2048ull * 2048 * 2;
constexpr size_t W_UK2    = W_IN   + (size_t)INWP * 2048 * 2;
constexpr size_t W_UV2    = W_UK2  + 8ull * 256 * 256 * 2;
constexpr size_t W_BRA    = W_UV2  + 4ull * 256 * 512 * 2;
constexpr size_t W_BRB    = W_BRA  + 2048ull * 1024 * 2;
constexpr size_t W_BRC    = W_BRB  + 2048ull * 1024 * 2;
constexpr size_t W_OUT    = W_BRC  + 2048ull * 1024 * 2;
constexpr size_t W_PG     = W_OUT  + 2048ull * 2048 * 2;
constexpr size_t W_PLE    = W_PG   + 2048ull * 2048 * 2;
constexpr size_t W_GU     = W_PLE  + 2048ull * 256 * 2;
constexpr size_t W_DN     = W_GU   + 32ull * 2048 * 2048 * 2;
constexpr size_t W_END    = W_DN   + 32ull * 2048 * 1024 * 2;
constexpr size_t WS_XB    = (W_END + MiB - 1) / MiB * MiB;
constexpr size_t WS_PB    = WS_XB  + (size_t)NTOK * DM * 2;
constexpr size_t WS_CUM   = WS_PB  + 2ull * NTOK * 256 * 2;
constexpr size_t WS_LF    = WS_CUM + 16ull * 8192 * 4;
constexpr size_t WS_XQ    = WS_LF  + 16ull * 8192 * 4;
constexpr size_t WS_XSC   = WS_XQ  + (size_t)NTOK * DM;
constexpr size_t WS_R     = (WS_XSC + (size_t)NTOK * 4 + MiB - 1) / MiB * MiB;
constexpr size_t R_SCORES = WS_R;
constexpr size_t R_OLAT   = WS_R;
constexpr size_t R_OA     = WS_R + 64 * MiB;
constexpr size_t R_OB     = WS_R + 96 * MiB;
constexpr size_t R_OC     = WS_R + 128 * MiB;
constexpr size_t R_TMP    = WS_R + 160 * MiB;
constexpr size_t R_MERGED = WS_R + 288 * MiB;
constexpr size_t R_PRE1   = WS_R + 384 * MiB;
constexpr size_t R_QA     = WS_R + 512 * MiB;
constexpr size_t R_QIDX   = WS_R + 544 * MiB;
constexpr size_t R_QKV    = WS_R + 576 * MiB;
constexpr size_t R_GATES  = WS_R + 768 * MiB;
constexpr size_t R_SMALL  = WS_R + 960 * MiB;
constexpr size_t R_QCAT   = WS_R + 992 * MiB;
constexpr size_t R_KCAT   = WS_R + 1064 * MiB;
constexpr size_t R_KI     = WS_R + 1073 * MiB;
constexpr size_t R_WI     = WS_R + 1075 * MiB;
constexpr size_t R_SEL    = WS_R + 1076 * MiB;
constexpr size_t R_NSEL   = WS_R + 1092 * MiB;
constexpr size_t R_END    = WS_R + 1093 * MiB;
constexpr size_t M_XS     = WS_R;
constexpr size_t M_HID    = WS_R + 288 * MiB;
constexpr size_t M_PP     = WS_R + 432 * MiB;
constexpr size_t M_X1F    = WS_R + 512 * MiB;
constexpr size_t M_X1B    = WS_R + 640 * MiB;
constexpr size_t M_HF     = WS_R + 704 * MiB;
constexpr size_t M_HQ     = WS_R + 704 * MiB;
constexpr size_t M_HSC    = WS_R + 736 * MiB;
constexpr size_t M_HB     = WS_R + 832 * MiB;
constexpr size_t M_TOKE   = WS_R + 896 * MiB;
constexpr size_t M_TOKPOS = M_TOKE + (size_t)NTOK * 16;
constexpr size_t M_TOKW   = M_TOKPOS + (size_t)NTOK * 16;
constexpr size_t M_TOKDST = M_TOKW + (size_t)NTOK * 16;
constexpr size_t M_ROWW   = M_TOKDST + (size_t)NTOK * 16;
constexpr size_t M_ROWSX  = M_ROWW + (size_t)PMAX * 4;
constexpr size_t M_X1S    = M_ROWSX + (size_t)PMAX * 4;
constexpr size_t M_X1Q    = WS_R + 900 * MiB;
constexpr size_t M_ROWTOK = WS_R + 750 * MiB;
constexpr size_t M_HM     = WS_R + 740 * MiB;
constexpr size_t M_H8     = WS_R + 752 * MiB;
constexpr size_t M_H8S    = WS_R + 826 * MiB;
constexpr size_t WS_NEED  = R_END;
constexpr int CW_BAR = 0;
constexpr int CW_CNT = 8192;
constexpr int CW_META = 4096 + 64;
constexpr int CW_QCTR = 6144;
constexpr int CW_WMAX = 6272;
constexpr int CW_WMAXG = 6336;
constexpr int CW_WMAXP = 6368;
constexpr int CW_WMAXD = 6384;
constexpr int CW_KMAX = 6400;
constexpr size_t CTL_BYTES = 65536;

constexpr int LDS_BYTES = 152576;
constexpr int LDS_MISC = 151552;

typedef float f32x2 __attribute__((ext_vector_type(2)));
typedef __bf16 bf16n2 __attribute__((ext_vector_type(2)));
__device__ __forceinline__ unsigned cvtpk(float lo, float hi) { f32x2 v = {lo, hi}; bf16n2 b = __builtin_convertvector(v, bf16n2); return __builtin_bit_cast(unsigned, b); }
__device__ __forceinline__ bf16_t f2bf(float x) { return (bf16_t)(cvtpk(x, 0.f) & 0xffffu); }
__device__ __forceinline__ float bf2f(bf16_t b) { return __uint_as_float(((unsigned)b) << 16); }
__device__ __forceinline__ float bflo(unsigned w) { return __uint_as_float(w << 16); }
__device__ __forceinline__ float bfhi(unsigned w) { return __uint_as_float(w & 0xffff0000u); }
__device__ __forceinline__ bf16x8 pack8(f32x4 a, f32x4 b) { u32x4 w = {cvtpk(a[0], a[1]), cvtpk(a[2], a[3]), cvtpk(b[0], b[1]), cvtpk(b[2], b[3])}; return *reinterpret_cast<bf16x8*>(&w); }
__device__ __forceinline__ float sigmoidf_(float x) { return 1.0f / (1.0f + __expf(-x)); }
__device__ __forceinline__ float wave_sum(float v) { for (int o = 32; o > 0; o >>= 1) v += __shfl_xor(v, o); return v; }
__device__ __forceinline__ int crow(int r, int hi) { return (r & 3) + 8 * (r >> 2) + 4 * hi; }
#define SBAR() __builtin_amdgcn_sched_barrier(0)

#define XB_TMO      128
#define XB_XCNT(j)  (256  + 64 * (j))
#define XB_XSUB(j)  (1280 + 64 * (j))
#define XB_XGEN(j)  (2304 + 64 * (j))
#define XB_TOP      3328
#define XB_TOPGEN   3392
#define XCD_BAR_WORDS 3456
#define XB_SPIN_CAP (1u << 22)
__device__ __forceinline__ unsigned xb_ld(unsigned* p)              { return __hip_atomic_load(p, __ATOMIC_RELAXED, __HIP_MEMORY_SCOPE_AGENT); }
__device__ __forceinline__ unsigned xb_add(unsigned* p, unsigned v) { return __hip_atomic_fetch_add(p, v, __ATOMIC_RELAXED, __HIP_MEMORY_SCOPE_AGENT); }
__device__ __forceinline__ unsigned xb_xcc_id() { return (unsigned)__builtin_amdgcn_s_getreg((3 << 11) | 20) & 0xFu; }
#define XB_SPIN(cond, bar) do { unsigned _sp = 0; while (cond) { __builtin_amdgcn_s_sleep(1); \
    if ((++_sp & 255u) == 0u) { if (xb_ld(&(bar)[XB_TMO])) break; if (_sp > XB_SPIN_CAP) { atomicAdd(&(bar)[XB_TMO], 1u); break; } } } } while (0)
struct XcdBarrier { unsigned* bar; unsigned x; volatile LAS unsigned* st; };
__device__ __forceinline__ XcdBarrier xcd_barrier_post(unsigned* bar, volatile LAS unsigned* st) {
    XcdBarrier b; b.bar = bar; b.x = xb_xcc_id(); b.st = st;
    if (threadIdx.x == 0) (void)xb_add(&bar[XB_XCNT(b.x)], 1u);
    return b;
}
__device__ __forceinline__ void xcd_barrier_complete(unsigned* bar, unsigned x, unsigned& nloc, unsigned& nx) {
    const unsigned G = gridDim.x * gridDim.y * gridDim.z;
    unsigned sum, cnt, mine, sp = 0u;
    for (;;) {
        sum = 0u; cnt = 0u; mine = 0u;
#pragma unroll
        for (unsigned j = 0; j < 16; ++j) { const unsigned c = xb_ld(&bar[XB_XCNT(j)]); sum += c; cnt += (c > 0u) ? 1u : 0u; mine = (j == x) ? c : mine; }
        if (sum == G) break;
        __builtin_amdgcn_s_sleep(1);
        if ((++sp & 255u) == 0u) { if (xb_ld(&bar[XB_TMO])) break; if (sp > XB_SPIN_CAP) { atomicAdd(&bar[XB_TMO], 1u); break; } }
    }
    nloc = mine > 0u ? mine : 1u; nx = cnt > 0u ? cnt : 1u;
}
__device__ __forceinline__ void xcd_barrier(const XcdBarrier& b) {
    asm volatile("s_waitcnt vmcnt(0)" ::: "memory");
    __syncthreads();
    if (threadIdx.x == 0) {
        unsigned* bar = b.bar;
        __builtin_amdgcn_s_waitcnt(0);
        unsigned nloc = b.st[0], nx = b.st[1];
        if (nloc == 0u) { xcd_barrier_complete(bar, b.x, nloc, nx); b.st[0] = nloc; b.st[1] = nx; }
        const unsigned old = xb_add(&bar[XB_XSUB(b.x)], 1u);
        const unsigned gen = old / nloc;
        if (old + 1u == (gen + 1u) * nloc) {
            __builtin_amdgcn_fence(__ATOMIC_RELEASE, "agent");
            asm volatile("s_waitcnt vmcnt(0)" ::: "memory");
            const unsigned og = xb_add(&bar[XB_TOP], 1u);
            const unsigned tg = og / nx;
            if (og + 1u == (tg + 1u) * nx) xb_add(&bar[XB_TOPGEN], 1u);
            else XB_SPIN(xb_ld(&bar[XB_TOPGEN]) == tg, bar);
            __builtin_amdgcn_fence(__ATOMIC_ACQUIRE, "agent");
            xb_add(&bar[XB_XGEN(b.x)], 1u);
            asm volatile("s_waitcnt vmcnt(0)" ::: "memory");
        } else {
            XB_SPIN(xb_ld(&bar[XB_XGEN(b.x)]) == gen, bar);
            __builtin_amdgcn_fence(__ATOMIC_ACQUIRE, "agent");
            asm volatile("s_waitcnt vmcnt(0)" ::: "memory");
        }
    }
    __syncthreads();
}

namespace pg8 {
constexpr int BM = 256, BK = 64, HALF = 128, HTB = HALF * BK * 2, STAGE_BYTES = 8 * HTB, NXCD = 8, WGM = 8;
__device__ __forceinline__ int lds_byte(int r, int c) { const int st = (r >> 4) * 2 + (c >> 5), rr = r & 15, cc = c & 31, ob = rr * 64 + cc * 2; return st * 1024 + (ob ^ (((ob >> 9) & 1) << 5)); }
__device__ __forceinline__ void stage_rc(int b, int& R, int& C) { const int st = b / 1024, sb = b % 1024, swz = sb ^ (((sb >> 9) & 1) << 5); R = (st >> 1) * 16 + swz / 64; C = (st & 1) * 32 + (swz % 64) / 2; }
__device__ __forceinline__ int perm32(int rho) { const int n = rho >> 4, i = rho & 15; return 8 * (i >> 2) + 4 * n + (i & 3); }
struct Unit { int pm, pn, e; };
struct SchedS {
    static constexpr bool GATHER = false;
    int nM, nN, nwg, G, c; const bf16_t* A; const bf16_t* B; int lda, ldb, a_sh, a_mul, skip_from = 1 << 30, skip_by = 0, skip_from2 = 1 << 30, skip_by2 = 0, b_compact = 0;
    __device__ void init(int M, int N, int G_, int c_, const bf16_t* A_, int lda_, const bf16_t* B_, int ldb_, int a_sh_ = 0, int a_mul_ = 0) {
        nM = M / BM; nN = N / BM; nwg = nM * nN; G = G_; c = c_; A = A_; B = B_; lda = lda_; ldb = ldb_; a_sh = a_sh_; a_mul = a_mul_; }
    __device__ __forceinline__ bool next(int i, Unit& u) const {
        const long L = (long)i * G + c; if (L >= nwg) return false;
        int wgid = (int)L; { const int q = nwg / NXCD, r = nwg % NXCD, xcd = wgid % NXCD, off = wgid / NXCD; wgid = (xcd < r ? xcd * (q + 1) : r * (q + 1) + (xcd - r) * q) + off; }
        const int nig = WGM * nN, gid = wgid / nig, fm = gid * WGM, gsz = (nM - fm) < WGM ? (nM - fm) : WGM;
        u.pm = fm + ((wgid % nig) % gsz); u.pn = (wgid % nig) / gsz; u.e = 0;
        u.e = u.pn;
        { const int ci = u.pn; if (ci >= skip_from) u.pn += skip_by; if (ci >= skip_from2) u.pn += skip_by2; }
        return true;
    }
    __device__ __forceinline__ const char* pa(const Unit& u) const { return (const char*)(A + (size_t)u.pm * BM * lda + (size_t)((u.pn >> a_sh) * a_mul)); }
    __device__ __forceinline__ const char* pb(const Unit& u) const { return (const char*)(B + (size_t)(b_compact ? u.e : u.pn) * BM * ldb); }
};
struct SchedM {
    static constexpr bool GATHER = false;
    int ntiles, G, c; const bf16_t* A; const bf16_t* W; int lda, ldb; const unsigned* tile_e;
    __device__ void init(const unsigned* meta, int G_, int c_, const bf16_t* A_, int lda_, const bf16_t* W_, int ldb_) {
        ntiles = (int)meta[0]; tile_e = meta + 1; G = G_; c = c_; A = A_; W = W_; lda = lda_; ldb = ldb_; }
    __device__ __forceinline__ bool next(int i, Unit& u) const {
        const long L = (long)i * G + c; if (L >= (long)ntiles * 8) return false;
        u.pm = (int)(L >> 3); u.pn = (int)(L & 7); u.e = (int)tile_e[u.pm];
        return true;
    }
    __device__ __forceinline__ const char* pa(const Unit& u) const { return (const char*)(A + (size_t)u.pm * BM * lda); }
    __device__ __forceinline__ const char* pb(const Unit& u) const { return (const char*)(W + ((size_t)u.e * 2048 + (size_t)u.pn * BM) * ldb); }
};

constexpr int GTAB_OFF = 131072;
struct SchedMG {
    static constexpr bool GATHER = true;
    int ntiles, G, c; const bf16_t* A; const bf16_t* W; int lda, ldb; const unsigned* tile_e;
    __device__ __forceinline__ void init(const unsigned* meta, int G_, int c_, const bf16_t* A_, int lda_, const bf16_t* W_, int ldb_) {
        ntiles = (int)meta[0]; tile_e = meta + 1; G = G_; c = c_; A = A_; W = W_; lda = lda_; ldb = ldb_; }
    __device__ __forceinline__ bool next(int i, Unit& u) const {
        const long L = (long)i * G + c; if (L >= (long)ntiles * 8) return false;
        u.pm = (int)(L >> 3); u.pn = (int)(L & 7); u.e = (int)tile_e[u.pm];
        return true;
    }
    __device__ __forceinline__ const char* pa(const Unit& u) const { return (const char*)A; }
    __device__ __forceinline__ const char* pb(const Unit& u) const { return (const char*)(W + ((size_t)u.e * 2048 + (size_t)u.pn * BM) * ldb); }
};

template <class Epi, class Sched>
__device__ __forceinline__ void gemm_phase(LAS unsigned char* lds, const int K, const int lda, const int ldb, const Sched& S, const Epi& E) {
    int tid = threadIdx.x; asm volatile("" : "+v"(tid));
    const int wid = __builtin_amdgcn_readfirstlane(tid >> 6), lane = tid & 63, wr = wid >> 2, wc = wid & 3, fr = lane & 15, fq = lane >> 4;
    const int nt = K / BK;
    constexpr bool GA = Sched::GATHER;
    unsigned voffA[2], voffB[2]; int gR[2]; unsigned gC[2];
#pragma unroll
    for (int i = 0; i < 2; ++i) { int R, C; stage_rc(tid * 16 + i * 8192, R, C); const int Rb = (R & ~31) + perm32(R & 31);
        voffA[i] = (unsigned)(R * lda + C) * 2u; voffB[i] = (unsigned)(Rb * ldb + C) * 2u; gR[i] = R; gC[i] = (unsigned)C * 2u; }
    unsigned gv[2][2] = {{0u, 0u}, {0u, 0u}}, gn[2][2] = {{0u, 0u}, {0u, 0u}};
    LAS const unsigned* gtab = (LAS const unsigned*)(lds + GTAB_OFF);
#define PG8_GLOAD(dst, uidx) do { _Pragma("unroll") for (int h_ = 0; h_ < 2; ++h_) _Pragma("unroll") for (int i_ = 0; i_ < 2; ++i_) dst[h_][i_] = gtab[(uidx) * 256 + h_ * 128 + gR[i_]] + gC[i_]; } while (0)
#define PG8_STAGE_A(bufoff, ptr, h, nx) do { if constexpr (GA) { unsigned vo_[2] = {(nx) ? gn[h][0] : gv[h][0], (nx) ? gn[h][1] : gv[h][1]}; PG8_STAGE(bufoff, ptr, vo_); } \
        else { PG8_STAGE(bufoff, (ptr) + (h) * hstepA, voffA); } } while (0)
    const size_t kstep = (size_t)(BK * 2);
    const size_t hstepA = (size_t)HALF * lda * 2, hstepB = (size_t)HALF * ldb * 2;
    const unsigned ldsw = (unsigned)wid * 1024u;
    const int aoff = lds_byte(wr * 64 + fr, fq * 8), boff = lds_byte(wc * 32 + fr, fq * 8);
#define PG8_SA(b, h) (((b) * 2 + (h)) * HTB)
#define PG8_SB(b, h) ((4 + (b) * 2 + (h)) * HTB)
#define PG8_STAGE(bufoff, gbase, voff) do { _Pragma("unroll") for (int _i = 0; _i < 2; ++_i) \
        __builtin_amdgcn_global_load_lds((const unsigned*)((const char*)(gbase) + (voff)[_i]), (LAS unsigned*)(lds + (bufoff) + ldsw + _i * 8192), 16, 0, 0); } while (0)
#define PG8_LDA(dst, b, h) do { _Pragma("unroll") for (int m = 0; m < 4; ++m) _Pragma("unroll") for (int k = 0; k < 2; ++k) dst[m][k] = *(const LAS bf16x8*)(lds + PG8_SA(b, h) + aoff + m * 2048 + k * 1024); } while (0)
#define PG8_LDB(dst, b, h) do { _Pragma("unroll") for (int n = 0; n < 2; ++n) _Pragma("unroll") for (int k = 0; k < 2; ++k) dst[n][k] = *(const LAS bf16x8*)(lds + PG8_SB(b, h) + boff + n * 2048 + k * 1024); } while (0)
#define PG8_MMA(ai, bj, At, Bt) do { __builtin_amdgcn_s_setprio(1); _Pragma("unroll") for (int m = 0; m < 4; ++m) _Pragma("unroll") for (int n = 0; n < 2; ++n) _Pragma("unroll") for (int k = 0; k < 2; ++k) \
        { if constexpr (Epi::I8) acc[ai][bj][m][n] = __builtin_bit_cast(f32x4, __builtin_amdgcn_mfma_i32_16x16x64_i8(__builtin_bit_cast(i32x4, Bt[n][k]), __builtin_bit_cast(i32x4, At[m][k]), __builtin_bit_cast(i32x4, acc[ai][bj][m][n]), 0, 0, 0)); \
          else acc[ai][bj][m][n] = __builtin_amdgcn_mfma_f32_16x16x32_bf16(Bt[n][k], At[m][k], acc[ai][bj][m][n], 0, 0, 0); } __builtin_amdgcn_s_setprio(0); } while (0)
#define PG8_WAIT_V(n) asm volatile("s_waitcnt vmcnt(" #n ")" ::: "memory")
#define PG8_WAIT_L(n) asm volatile("s_waitcnt lgkmcnt(" #n ")" ::: "memory")
#define PG8_BAR __builtin_amdgcn_s_barrier()
#define PG8_SCHED __builtin_amdgcn_sched_barrier(0)
    Unit cur, nxt; int ui = 0;
    if (!S.next(0, cur)) return;
    f32x4 acc[2][2][4][2];
#pragma unroll
    for (int a = 0; a < 2; ++a)
#pragma unroll
        for (int b = 0; b < 2; ++b)
#pragma unroll
            for (int m = 0; m < 4; ++m)
#pragma unroll
                for (int n = 0; n < 2; ++n) acc[a][b][m][n] = (f32x4){0.f, 0.f, 0.f, 0.f};
    bf16x8 At[4][2], B0[2][2], B1[2][2];
    const char* cA = S.pa(cur); const char* cB = S.pb(cur);
    if constexpr (GA) { PG8_GLOAD(gv, 0); }
    PG8_STAGE(PG8_SB(0, 0), cB, voffB); PG8_STAGE_A(PG8_SA(0, 0), cA, 0, false); PG8_STAGE(PG8_SB(0, 1), cB + hstepB, voffB); PG8_STAGE_A(PG8_SA(0, 1), cA, 1, false);
    if (wr == 1) PG8_BAR;
    PG8_WAIT_V(4); PG8_BAR;
    PG8_STAGE(PG8_SB(1, 0), cB + kstep, voffB); PG8_STAGE_A(PG8_SA(1, 0), cA + kstep, 0, false); PG8_STAGE(PG8_SB(1, 1), cB + hstepB + kstep, voffB);
    PG8_WAIT_V(6); PG8_BAR;
    for (;;) {
        const bool has_next = S.next(ui + 1, nxt);
        const char* nA = has_next ? S.pa(nxt) : cA; const char* nB = has_next ? S.pb(nxt) : cB;
        if constexpr (GA) { if (has_next) { PG8_GLOAD(gn, ui + 1); } else {
#pragma unroll
                for (int h_ = 0; h_ < 2; ++h_) { gn[h_][0] = gv[h_][0]; gn[h_][1] = gv[h_][1]; } }
            asm volatile("" : "+v"(gn[0][0]), "+v"(gn[0][1]), "+v"(gn[1][0]), "+v"(gn[1][1])); }
        for (int t = 0; t < nt; t += 2) {
            const bool last = (t == nt - 2);
            if constexpr (Epi::HAS_MID) { if (t == Epi::MID1 || t == Epi::MID2) { int frM = fr, fqM = fq; asm volatile("" : "+v"(frM), "+v"(fqM)); E.mid(acc, cur, t, wr, wc, frM, fqM); } }
            const char* a1 = cA + (size_t)(t + 1) * kstep;
            const char* a2 = last ? nA : cA + (size_t)(t + 2) * kstep; const char* b2 = last ? nB : cB + (size_t)(t + 2) * kstep;
            const char* a3 = a2 + kstep; const char* b3 = b2 + kstep;
            PG8_LDB(B0, 0, 0); PG8_SCHED; PG8_LDA(At, 0, 0); PG8_STAGE_A(PG8_SA(1, 1), a1, 1, false);
            PG8_WAIT_L(8); PG8_BAR; PG8_WAIT_L(0); PG8_MMA(0, 0, At, B0); PG8_BAR; PG8_SCHED;
            PG8_LDB(B1, 0, 1); PG8_STAGE(PG8_SB(0, 0), b2, voffB);
            PG8_BAR; PG8_WAIT_L(0); PG8_MMA(0, 1, At, B1); PG8_BAR;
            PG8_LDA(At, 0, 1); PG8_STAGE_A(PG8_SA(0, 0), a2, 0, last);
            PG8_BAR; PG8_WAIT_L(0); PG8_MMA(1, 0, At, B0); PG8_BAR; PG8_SCHED;
            PG8_STAGE(PG8_SB(0, 1), b2 + hstepB, voffB);
            PG8_WAIT_V(6); PG8_BAR; PG8_MMA(1, 1, At, B1); PG8_BAR;
            PG8_LDB(B0, 1, 0); PG8_SCHED; PG8_LDA(At, 1, 0); PG8_STAGE_A(PG8_SA(0, 1), a2, 1, last);
            PG8_WAIT_L(8); PG8_BAR; PG8_WAIT_L(0); PG8_MMA(0, 0, At, B0); PG8_BAR; PG8_SCHED;
            PG8_LDB(B1, 1, 1); PG8_STAGE(PG8_SB(1, 0), b3, voffB);
            PG8_BAR; PG8_WAIT_L(0); PG8_MMA(0, 1, At, B1); PG8_BAR;
            PG8_LDA(At, 1, 1); PG8_STAGE_A(PG8_SA(1, 0), a3, 0, last);
            PG8_BAR; PG8_WAIT_L(0); PG8_MMA(1, 0, At, B0); PG8_BAR; PG8_SCHED;
            PG8_STAGE(PG8_SB(1, 1), b3 + hstepB, voffB);
            PG8_WAIT_V(6); PG8_BAR; PG8_MMA(1, 1, At, B1); PG8_BAR;
        }
        { int frE = fr, fqE = fq; asm volatile("" : "+v"(frE), "+v"(fqE)); E(acc, cur, wr, wc, frE, fqE); }
        if (!has_next) break;
#pragma unroll
        for (int a = 0; a < 2; ++a)
#pragma unroll
            for (int b = 0; b < 2; ++b)
#pragma unroll
                for (int m = 0; m < 4; ++m)
#pragma unroll
                    for (int n = 0; n < 2; ++n) acc[a][b][m][n] = (f32x4){0.f, 0.f, 0.f, 0.f};
        cur = nxt; cA = nA; cB = nB; ++ui;
        if constexpr (GA) {
#pragma unroll
            for (int h_ = 0; h_ < 2; ++h_) { gv[h_][0] = gn[h_][0]; gv[h_][1] = gn[h_][1]; } }
    }
    PG8_WAIT_V(0);
    if (wr == 0) PG8_BAR;
    PG8_BAR;
#undef PG8_SA
#undef PG8_SB
#undef PG8_STAGE
#undef PG8_STAGE_A
#undef PG8_GLOAD
#undef PG8_LDA
#undef PG8_LDB
#undef PG8_MMA
#undef PG8_WAIT_V
#undef PG8_WAIT_L
#undef PG8_BAR
#undef PG8_SCHED
}

#define EPI_LOOP_ROWS _Pragma("unroll") for (int ai = 0; ai < 2; ++ai) _Pragma("unroll") for (int m = 0; m < 4; ++m)
__device__ __forceinline__ void st_bf16x8(bf16_t* p, f32x4 v0, f32x4 v1) { u32x4 w; w.x = cvtpk(v0[0], v0[1]); w.y = cvtpk(v0[2], v0[3]); w.z = cvtpk(v1[0], v1[1]); w.w = cvtpk(v1[2], v1[3]); *(u32x4*)p = w; }

template <bool I8_> struct EpiInProj {
    static constexpr bool HAS_MID = false; static constexpr bool I8 = I8_;
    bf16_t* qa; bf16_t* qidx; bf16_t* qkv; bf16_t* gates; float* small_; const float* xs; const unsigned* wmaxbits;
    __device__ __forceinline__ f32x4 val(const f32x4& a, float sc) const { if constexpr (I8_) { const i32x4 v = __builtin_bit_cast(i32x4, a); return (f32x4){(float)v[0], (float)v[1], (float)v[2], (float)v[3]} * sc; } else return a; }
    __device__ __forceinline__ void operator()(const f32x4 (&acc)[2][2][4][2], const Unit& u, int wr, int wc, int fr, int fq) const {
        const int pn = u.pn, row0 = u.pm * BM + wr * 64 + fr, lc0 = wc * 32 + fq * 8;
        float sw = 0.f; if constexpr (I8_) sw = __uint_as_float(*wmaxbits) * (1.3f / 127.0f);
        float scs[2][4];
#pragma unroll
        for (int ai = 0; ai < 2; ++ai)
#pragma unroll
            for (int m = 0; m < 4; ++m) { scs[ai][m] = 0.f; if constexpr (I8_) scs[ai][m] = xs[row0 + ai * HALF + m * 16] * sw; }
        if (pn < 8) {
            bf16_t* base = (pn < 4 ? qa + pn * 256 : qidx + (pn - 4) * 256) + lc0;
            EPI_LOOP_ROWS { const int row = row0 + ai * HALF + m * 16; const float sc = scs[ai][m];
#pragma unroll
                for (int bj = 0; bj < 2; ++bj) st_bf16x8(base + (size_t)row * 1024 + bj * HALF, val(acc[ai][bj][m][0], sc), val(acc[ai][bj][m][1], sc)); }
        } else if (pn < 32) {
            const int id = (pn - 8) >> 2, hb = ((pn - 8) & 3) * 2, b = u.pm >> 5;
            bf16_t* base = qkv + (size_t)id * ((size_t)NTOK * 1024) + lc0;
            EPI_LOOP_ROWS { const int row = row0 + ai * HALF + m * 16, s = row & (SEQ - 1); const float sc = scs[ai][m];
#pragma unroll
                for (int bj = 0; bj < 2; ++bj) st_bf16x8(base + ((size_t)(b * 8 + hb + bj) * SEQ + s) * 128, val(acc[ai][bj][m][0], sc), val(acc[ai][bj][m][1], sc)); }
        } else if (pn < 56) {
            unsigned char* base = (unsigned char*)gates + (pn - 32) * 256 + lc0;
            EPI_LOOP_ROWS { const int row = row0 + ai * HALF + m * 16; const float sc = scs[ai][m];
#pragma unroll
                for (int bj = 0; bj < 2; ++bj) { const f32x4 v0 = val(acc[ai][bj][m][0], sc), v1 = val(acc[ai][bj][m][1], sc); u32x2 w; unsigned p0 = 0u, p1 = 0u;
#pragma unroll
                    for (int j = 0; j < 4; ++j) { p0 |= (unsigned)(int)fmaxf(rintf(255.0f * sigmoidf_(v0[j])), 1.0f) << (8 * j); p1 |= (unsigned)(int)fmaxf(rintf(255.0f * sigmoidf_(v1[j])), 1.0f) << (8 * j); }
                    w.x = p0; w.y = p1; *(u32x2*)(base + (size_t)row * 6144 + bj * HALF) = w; } }
        } else {
            float* base = small_ + (pn - 56) * 256 + lc0;
            EPI_LOOP_ROWS { const int row = row0 + ai * HALF + m * 16; const float sc = scs[ai][m];
#pragma unroll
                for (int bj = 0; bj < 2; ++bj) { float* p = base + (size_t)row * 512 + bj * HALF; *(f32x4*)p = val(acc[ai][bj][m][0], sc); *(f32x4*)(p + 4) = val(acc[ai][bj][m][1], sc); } }
        }
    }
};
struct EpiBf16 {
    static constexpr bool HAS_MID = false; static constexpr bool I8 = false;
    bf16_t* out; int ld, cstep;
    __device__ __forceinline__ void operator()(const f32x4 (&acc)[2][2][4][2], const Unit& u, int wr, int wc, int fr, int fq) const {
        const int row0 = u.pm * BM + wr * 64 + fr; bf16_t* base = out + (size_t)u.pn * cstep + wc * 32 + fq * 8;
        EPI_LOOP_ROWS { const int row = row0 + ai * HALF + m * 16;
#pragma unroll
            for (int bj = 0; bj < 2; ++bj) st_bf16x8(base + (size_t)row * ld + bj * HALF, acc[ai][bj][m][0], acc[ai][bj][m][1]); }
    }
};
struct EpiBranch3 {
    static constexpr bool HAS_MID = true; static constexpr bool I8 = false; static constexpr int MID1 = 16, MID2 = 32;
    const unsigned char* gates; bf16_t* merged;
    __device__ __forceinline__ static f32x4 rat(unsigned n, unsigned d) {
        f32x4 r; r[0] = (float)(n & 255u) * __builtin_amdgcn_rcpf((float)(d & 255u)); r[1] = (float)((n >> 8) & 255u) * __builtin_amdgcn_rcpf((float)((d >> 8) & 255u));
        r[2] = (float)((n >> 16) & 255u) * __builtin_amdgcn_rcpf((float)((d >> 16) & 255u)); r[3] = (float)(n >> 24) * __builtin_amdgcn_rcpf((float)(d >> 24)); return r; }
    __device__ __forceinline__ void mid(f32x4 (&acc)[2][2][4][2], const Unit& u, int t, int wr, int wc, int fr, int fq) const {
        const int row0 = u.pm * BM + wr * 64 + fr, col0 = u.pn * BM + wc * 32 + fq * 8, bn = (t == MID1) ? 0 : 2048;
        u32x2 gn[2][4][2], gd[2][4][2];
        EPI_LOOP_ROWS {
#pragma unroll
            for (int bj = 0; bj < 2; ++bj) { const unsigned char* gp = gates + (size_t)(row0 + ai * HALF + m * 16) * 6144 + bn + col0 + bj * HALF; gn[ai][m][bj] = *(const u32x2*)gp; gd[ai][m][bj] = *(const u32x2*)(gp + 2048); } }
        EPI_LOOP_ROWS {
#pragma unroll
            for (int bj = 0; bj < 2; ++bj) { acc[ai][bj][m][0] *= rat(gn[ai][m][bj].x, gd[ai][m][bj].x); acc[ai][bj][m][1] *= rat(gn[ai][m][bj].y, gd[ai][m][bj].y); } }
    }
    __device__ __forceinline__ void operator()(const f32x4 (&acc)[2][2][4][2], const Unit& u, int wr, int wc, int fr, int fq) const {
        const int row0 = u.pm * BM + wr * 64 + fr, col0 = u.pn * BM + wc * 32 + fq * 8;
        u32x2 gl[2][4][2];
        EPI_LOOP_ROWS {
#pragma unroll
            for (int bj = 0; bj < 2; ++bj) gl[ai][m][bj] = *(const u32x2*)(gates + (size_t)(row0 + ai * HALF + m * 16) * 6144 + 4096 + col0 + bj * HALF); }
        EPI_LOOP_ROWS { const int row = row0 + ai * HALF + m * 16;
#pragma unroll
            for (int bj = 0; bj < 2; ++bj) { const int col = col0 + bj * HALF; const u32x2 gw = gl[ai][m][bj]; constexpr float I255 = 1.0f / 255.0f;
                f32x4 v0 = acc[ai][bj][m][0], v1 = acc[ai][bj][m][1];
                v0[0] *= (float)(gw.x & 255u) * I255; v0[1] *= (float)((gw.x >> 8) & 255u) * I255; v0[2] *= (float)((gw.x >> 16) & 255u) * I255; v0[3] *= (float)(gw.x >> 24) * I255;
                v1[0] *= (float)(gw.y & 255u) * I255; v1[1] *= (float)((gw.y >> 8) & 255u) * I255; v1[2] *= (float)((gw.y >> 16) & 255u) * I255; v1[3] *= (float)(gw.y >> 24) * I255;
                st_bf16x8(merged + (size_t)row * 2048 + col, v0, v1); } }
    }
};
struct EpiOut {
    static constexpr bool HAS_MID = false; static constexpr bool I8 = false;
    const bf16_t* res; bf16_t* pre;
    __device__ __forceinline__ void operator()(const f32x4 (&acc)[2][2][4][2], const Unit& u, int wr, int wc, int fr, int fq) const {
        const int row0 = u.pm * BM + wr * 64 + fr, col0 = u.pn * BM + wc * 32 + fq * 8;
        u32x4 rl[2][4][2];
        EPI_LOOP_ROWS { const int row = row0 + ai * HALF + m * 16;
#pragma unroll
            for (int bj = 0; bj < 2; ++bj) rl[ai][m][bj] = *(const u32x4*)(res + (size_t)row * 2048 + col0 + bj * HALF); }
        EPI_LOOP_ROWS { const int row = row0 + ai * HALF + m * 16;
#pragma unroll
            for (int bj = 0; bj < 2; ++bj) { const size_t o = (size_t)row * 2048 + col0 + bj * HALF;
                const u32x4 rw = rl[ai][m][bj]; f32x4 v0 = acc[ai][bj][m][0], v1 = acc[ai][bj][m][1];
                v0[0] += ALPHA * bflo(rw.x); v0[1] += ALPHA * bfhi(rw.x); v0[2] += ALPHA * bflo(rw.y); v0[3] += ALPHA * bfhi(rw.y);
                v1[0] += ALPHA * bflo(rw.z); v1[1] += ALPHA * bfhi(rw.z); v1[2] += ALPHA * bflo(rw.w); v1[3] += ALPHA * bfhi(rw.w);
                st_bf16x8(pre + o, v0, v1); } }
    }
};
struct EpiGateUpI8 {
    static constexpr bool HAS_MID = false; static constexpr bool I8 = true;
    const float* bg; const float* bu; bf16_t* hid; const float* rowsx; const unsigned* wmaxbits; float* hm;
    __device__ __forceinline__ void operator()(const f32x4 (&acc)[2][2][4][2], const Unit& u, int wr, int wc, int fr, int fq) const {
        const int row0 = u.pm * BM + wr * 64 + fr, j0 = u.pn * 128 + wc * 32 + fq * 8;
        const float sw = __uint_as_float(*wmaxbits) * (1.3f / 127.0f);
        const float* pg = bg + (size_t)u.e * DEXP + j0; const float* pu = bu + (size_t)u.e * DEXP + j0;
        const f32x4 g0b = *(const f32x4*)pg, g1b = *(const f32x4*)(pg + 4), u0b = *(const f32x4*)pu, u1b = *(const f32x4*)(pu + 4);
        float scs[2][4];
#pragma unroll
        for (int ai = 0; ai < 2; ++ai)
#pragma unroll
            for (int m = 0; m < 4; ++m) scs[ai][m] = rowsx[row0 + ai * HALF + m * 16] * sw;
        EPI_LOOP_ROWS { const int row = row0 + ai * HALF + m * 16; const float sc = scs[ai][m];
            const i32x4 ag0 = __builtin_bit_cast(i32x4, acc[ai][0][m][0]), ag1 = __builtin_bit_cast(i32x4, acc[ai][0][m][1]), au0 = __builtin_bit_cast(i32x4, acc[ai][1][m][0]), au1 = __builtin_bit_cast(i32x4, acc[ai][1][m][1]);
            f32x4 h0, h1;
#pragma unroll
            for (int j = 0; j < 4; ++j) {
                float g = fminf((float)ag0[j] * sc + g0b[j], 7.0f), uu = fminf(fmaxf((float)au0[j] * sc + u0b[j], -7.0f), 7.0f);
                h0[j] = (uu + 1.0f) * (g * sigmoidf_(1.702f * g));
                g = fminf((float)ag1[j] * sc + g1b[j], 7.0f); uu = fminf(fmaxf((float)au1[j] * sc + u1b[j], -7.0f), 7.0f);
                h1[j] = (uu + 1.0f) * (g * sigmoidf_(1.702f * g)); }
            st_bf16x8(hid + (size_t)row * DEXP + j0, h0, h1);
            float am = fmaxf(fmaxf(fmaxf(fabsf(h0[0]), fabsf(h0[1])), fmaxf(fabsf(h0[2]), fabsf(h0[3]))), fmaxf(fmaxf(fabsf(h1[0]), fabsf(h1[1])), fmaxf(fabsf(h1[2]), fabsf(h1[3]))));
            am = fmaxf(am, __shfl_xor(am, 16)); am = fmaxf(am, __shfl_xor(am, 32));
            if (fq == 0) hm[(size_t)row * 32 + u.pn * 4 + wc] = am; }
    }
};
struct EpiDown {
    static constexpr bool HAS_MID = false; static constexpr bool I8 = false;
    const float* bd; const float* roww; bf16_t* ys;
    __device__ __forceinline__ void operator()(const f32x4 (&acc)[2][2][4][2], const Unit& u, int wr, int wc, int fr, int fq) const {
        const int row0 = u.pm * BM + wr * 64 + fr, col0 = u.pn * BM + wc * 32 + fq * 8;
        f32x4 b[2][2];
#pragma unroll
        for (int bj = 0; bj < 2; ++bj) { const float* p = bd + (size_t)u.e * DM + col0 + bj * HALF; b[bj][0] = *(const f32x4*)p; b[bj][1] = *(const f32x4*)(p + 4); }
        float rws[2][4];
#pragma unroll
        for (int ai = 0; ai < 2; ++ai)
#pragma unroll
            for (int m = 0; m < 4; ++m) rws[ai][m] = roww[row0 + ai * HALF + m * 16];
        EPI_LOOP_ROWS { const int row = row0 + ai * HALF + m * 16; const float w = rws[ai][m];
#pragma unroll
            for (int bj = 0; bj < 2; ++bj) st_bf16x8(ys + (size_t)row * 2048 + col0 + bj * HALF, (acc[ai][bj][m][0] + b[bj][0]) * w, (acc[ai][bj][m][1] + b[bj][1]) * w); }
    }
};
struct EpiDownI8 {
    static constexpr bool HAS_MID = false; static constexpr bool I8 = true;
    const float* bd; const float* roww; bf16_t* ys; const float* h8s; const unsigned* wmaxbits;
    __device__ __forceinline__ void operator()(const f32x4 (&acc)[2][2][4][2], const Unit& u, int wr, int wc, int fr, int fq) const {
        const int row0 = u.pm * BM + wr * 64 + fr, col0 = u.pn * BM + wc * 32 + fq * 8;
        const float sw = __uint_as_float(*wmaxbits) * (1.3f / 127.0f);
        f32x4 b[2][2];
#pragma unroll
        for (int bj = 0; bj < 2; ++bj) { const float* p = bd + (size_t)u.e * DM + col0 + bj * HALF; b[bj][0] = *(const f32x4*)p; b[bj][1] = *(const f32x4*)(p + 4); }
        float rws[2][4], scs[2][4];
#pragma unroll
        for (int ai = 0; ai < 2; ++ai)
#pragma unroll
            for (int m = 0; m < 4; ++m) { rws[ai][m] = roww[row0 + ai * HALF + m * 16]; scs[ai][m] = h8s[row0 + ai * HALF + m * 16] * sw; }
        EPI_LOOP_ROWS { const int row = row0 + ai * HALF + m * 16; const float w = rws[ai][m], sc = scs[ai][m];
#pragma unroll
            for (int bj = 0; bj < 2; ++bj) { const i32x4 a0 = __builtin_bit_cast(i32x4, acc[ai][bj][m][0]), a1 = __builtin_bit_cast(i32x4, acc[ai][bj][m][1]);
                const f32x4 v0 = (f32x4){(float)a0[0], (float)a0[1], (float)a0[2], (float)a0[3]} * sc, v1 = (f32x4){(float)a1[0], (float)a1[1], (float)a1[2], (float)a1[3]} * sc;
                st_bf16x8(ys + (size_t)row * 2048 + col0 + bj * HALF, (v0 + b[bj][0]) * w, (v1 + b[bj][1]) * w); } }
    }
};
struct EpiPleGateI8 {
    static constexpr bool HAS_MID = false; static constexpr bool I8 = true;
    const bf16_t* hb; const bf16_t* pp; bf16_t* pre; const float* hs; const unsigned* wmaxbits;
    __device__ __forceinline__ void operator()(const f32x4 (&acc)[2][2][4][2], const Unit& u, int wr, int wc, int fr, int fq) const {
        const int row0 = u.pm * BM + wr * 64 + fr, col0 = u.pn * BM + wc * 32 + fq * 8;
        const float sw = __uint_as_float(*wmaxbits) * (1.3f / 127.0f);
#pragma unroll
        for (int ai = 0; ai < 2; ++ai) { u32x4 pl[4][2], hl[4][2]; float scs[4];
#pragma unroll
            for (int m = 0; m < 4; ++m) { scs[m] = hs[row0 + ai * HALF + m * 16] * sw;
#pragma unroll
                for (int bj = 0; bj < 2; ++bj) { const size_t o = (size_t)(row0 + ai * HALF + m * 16) * 2048 + col0 + bj * HALF; pl[m][bj] = *(const u32x4*)(pp + o); hl[m][bj] = *(const u32x4*)(hb + o); } }
#pragma unroll
            for (int m = 0; m < 4; ++m) { const float sc = scs[m];
#pragma unroll
                for (int bj = 0; bj < 2; ++bj) { const size_t o = (size_t)(row0 + ai * HALF + m * 16) * 2048 + col0 + bj * HALF; const u32x4 pw = pl[m][bj], hw = hl[m][bj];
                    const i32x4 a0 = __builtin_bit_cast(i32x4, acc[ai][bj][m][0]), a1 = __builtin_bit_cast(i32x4, acc[ai][bj][m][1]); f32x4 o0, o1;
                    o0[0] = bflo(hw.x) + sigmoidf_((float)a0[0] * sc) * bflo(pw.x); o0[1] = bfhi(hw.x) + sigmoidf_((float)a0[1] * sc) * bfhi(pw.x); o0[2] = bflo(hw.y) + sigmoidf_((float)a0[2] * sc) * bflo(pw.y); o0[3] = bfhi(hw.y) + sigmoidf_((float)a0[3] * sc) * bfhi(pw.y);
                    o1[0] = bflo(hw.z) + sigmoidf_((float)a1[0] * sc) * bflo(pw.z); o1[1] = bfhi(hw.z) + sigmoidf_((float)a1[1] * sc) * bfhi(pw.z); o1[2] = bflo(hw.w) + sigmoidf_((float)a1[2] * sc) * bflo(pw.w); o1[3] = bfhi(hw.w) + sigmoidf_((float)a1[3] * sc) * bfhi(pw.w);
                    st_bf16x8(pre + o, o0, o1); } } }
    }
};
}

struct Params { const float* in[25]; float* out; unsigned char* ws; int ph_lo, ph_hi; };
__constant__ float c_invf_r[16] = {1.000000000e+00f, 4.403665960e-01f, 1.939227432e-01f, 8.539710194e-02f, 3.760603070e-02f, 1.656043902e-02f, 7.292664610e-03f, 3.211445874e-03f, 1.414213562e-03f, 6.227723788e-04f, 2.742481884e-04f, 1.207697351e-04f, 5.318296098e-05f, 2.341999971e-05f, 1.031338616e-05f, 4.541670478e-06f};
__constant__ float c_invf_i[8] = {1.000000000e+00f, 1.939227432e-01f, 3.760603070e-02f, 7.292664610e-03f, 1.414213562e-03f, 2.742481884e-04f, 5.318296098e-05f, 1.031338616e-05f};
constexpr int LDS_PTRS = LDS_MISC + 256;
struct Frame { unsigned char* lds; LAS unsigned char* ldsl; unsigned char* ws; int tid, lane, wid, G, bid;
    __device__ __forceinline__ const float* in(int k) const { const LAS unsigned* t = (const LAS unsigned*)(ldsl + LDS_PTRS) + 2 * k;
        const unsigned lo = __builtin_amdgcn_readfirstlane(t[0]), hi = __builtin_amdgcn_readfirstlane(t[1]); return (const float*)(const GAS float*)(((unsigned long long)hi << 32) | lo); }
    __device__ __forceinline__ float* out() const { return (float*)in(25); } };
__device__ __forceinline__ Frame fresh(const Frame& F0) { Frame F = F0; int t = threadIdx.x; asm volatile("" : "+v"(t)); F.tid = t; F.lane = t & 63; F.wid = __builtin_amdgcn_readfirstlane(t >> 6); size_t z = 0; asm volatile("" : "+s"(z)); F.ws = F0.ws + z; return F; }

struct TcTile { const float* src; long sld; bf16_t* dst; long dld; int nvalid; float qinv; };
template <class Dec>
__device__ __forceinline__ void tconv_run(const Frame& F, int total, const Dec& dec, int& rot) {
    float* tile = (float*)F.lds;
    const int tid = F.tid, G = F.G;
    const int start = (F.bid - (rot % G) + G) % G; rot += total >> 2;
    const int lr = tid >> 4, lc4 = (tid & 15) * 4, sn = tid >> 3, skc = (tid & 7) * 8;
    f32x4 v[4][2];
#define TC_ISSUE(t0_) do { _Pragma("unroll") for (int q = 0; q < 4; ++q) { const int t = (t0_) * 4 + q; \
        if (t < total) { const TcTile ti = dec(dec.remap(t)); _Pragma("unroll") for (int h = 0; h < 2; ++h) { v[q][h] = (f32x4){0.f, 0.f, 0.f, 0.f}; \
            if (lc4 < ti.nvalid) v[q][h] = *(const GAS f32x4*)((const GAS float*)ti.src + (size_t)(lr + 32 * h) * ti.sld + lc4); } } } } while (0)
    if (start * 4 < total) TC_ISSUE(start);
    for (int t0 = start; t0 * 4 < total; t0 += G) {
#pragma unroll
        for (int q = 0; q < 4; ++q) { if (t0 * 4 + q < total) { float* tl = tile + q * (64 * 65);
#pragma unroll
                for (int h = 0; h < 2; ++h) { float* p = tl + (lr + 32 * h) * 65 + lc4; p[0] = v[q][h][0]; p[1] = v[q][h][1]; p[2] = v[q][h][2]; p[3] = v[q][h][3]; } } }
        __syncthreads();
        if ((t0 + G) * 4 < total) TC_ISSUE(t0 + G);
#pragma unroll
        for (int q = 0; q < 4; ++q) { const int t = t0 * 4 + q;
            if (t < total) { const TcTile ti = dec(dec.remap(t)); const float* tl = tile + q * (64 * 65);
                if (ti.qinv > 0.f) { if (tid < 256) { const int n8 = tid >> 2, kc = (tid & 3) * 16; u32x4 w;
#pragma unroll
                        for (int d = 0; d < 4; ++d) { unsigned pk = 0u;
#pragma unroll
                            for (int j = 0; j < 4; ++j) { float q = rintf(tl[(kc + d * 4 + j) * 65 + n8] * ti.qinv); q = fminf(fmaxf(q, -127.f), 127.f); pk |= ((unsigned)(int)q & 0xffu) << (8 * j); }
                            w[d] = pk; }
                        *(u32x4*)((unsigned char*)ti.dst + (size_t)n8 * ti.dld + kc) = w; } }
                else if (sn < ti.nvalid) { f32x4 a, b;
#pragma unroll
                    for (int j = 0; j < 4; ++j) { a[j] = tl[(skc + j) * 65 + sn]; b[j] = tl[(skc + 4 + j) * 65 + sn]; }
                    pg8::st_bf16x8(ti.dst + (size_t)sn * ti.dld + skc, a, b); } } }
        __syncthreads();
    }
#undef TC_ISSUE
}
struct TcMat {
    const float* src; long src_ld; int tk, ncols; bf16_t* dst; long dst_ld; float qinv;
    __device__ __forceinline__ int remap(int i) const { const int ntn = (ncols + 63) >> 6; if (ntn & 1) return i;
        const int g = i >> 2, q = i & 3, tkh = tk >> 1, gk = g % tkh, gn = g / tkh; return (2 * gn + (q >> 1)) * tk + 2 * gk + (q & 1); }
    __device__ __forceinline__ TcTile operator()(int t) const { const int k0 = (t % tk) * 64, n0 = (t / tk) * 64; TcTile ti;
        ti.src = src + (size_t)k0 * src_ld + n0; ti.sld = src_ld; ti.dst = qinv > 0.f ? (bf16_t*)((unsigned char*)dst + (size_t)n0 * dst_ld + k0) : dst + (size_t)n0 * dst_ld + k0; ti.dld = dst_ld; ti.nvalid = (ncols - n0) < 64 ? (ncols - n0) : 64; ti.qinv = qinv; return ti; }
};
__device__ __forceinline__ void tconv(const Frame& F, const float* src, long src_ld, int K, int ncols, bf16_t* dst, long dst_ld, int& rot) {
    TcMat d{src, src_ld, K >> 6, ncols, dst, dst_ld, 0.f}; tconv_run(F, (K >> 6) * ((ncols + 63) >> 6), d, rot);
}
struct TcExperts {
    const float* wg; const float* wu; const float* wd; unsigned char* dgu; unsigned char* ddn; float qinv, qinvd;
    __device__ __forceinline__ int remap(int i) const { const int e = i / 1536, ri = i - e * 1536;
        if (ri < 1024) { const int g = ri >> 2, q = ri & 3, gk = g & 15, gn = g >> 4; return e * 1536 + (2 * gn + (q >> 1)) * 32 + 2 * gk + (q & 1); }
        const int r2 = ri - 1024, g = r2 >> 2, q = r2 & 3, gk = g & 7, gn = g >> 3; return e * 1536 + 1024 + (2 * gn + (q >> 1)) * 16 + 2 * gk + (q & 1); }
    __device__ __forceinline__ TcTile operator()(int t) const { const int e = t / 1536, r = t - e * 1536; TcTile ti; ti.nvalid = 64; ti.qinv = 0.f;
        if (r < 1024) { const int k0 = (r & 31) * 64, dt = r >> 5, jb = dt >> 2, gu = (dt >> 1) & 1, half = dt & 1;
            ti.src = (const float*)((unsigned long long)wg + (unsigned long long)gu * ((unsigned long long)wu - (unsigned long long)wg)) + (size_t)e * DM * DEXP + (size_t)k0 * DEXP + jb * 128 + half * 64; ti.sld = DEXP;
            ti.dst = (bf16_t*)(dgu + (size_t)e * 2048 * 2048 + (size_t)(dt * 64) * 2048 + k0); ti.dld = 2048; ti.qinv = qinv; }
        else { const int r2 = r - 1024, k0 = (r2 & 15) * 64, n0 = (r2 >> 4) * 64;
            ti.src = wd + (size_t)e * DEXP * DM + (size_t)k0 * DM + n0; ti.sld = DM;
            ti.dst = (bf16_t*)(ddn + (size_t)e * 2048 * 1024 + (size_t)n0 * 1024 + k0); ti.dld = 1024; ti.qinv = qinvd; }
        return ti; }
};
__device__ __forceinline__ void sample_wmax(const Frame& F) {
    unsigned* wm = (unsigned*)(F.ws + WS_CTL) + CW_WMAX;
#pragma unroll 1
    for (int l = 0; l < NLAYER; ++l) { float mx = 0.f;
#pragma unroll 1
        for (int which = 0; which < 2; ++which) { const f32x4* p = (const f32x4*)(F.in(which ? 17 : 15) + (size_t)l * NEXP * DM * DEXP);
            for (size_t i = (size_t)F.bid * 512 + F.tid; i < (size_t)NEXP * DM * DEXP / 4 / 64; i += (size_t)F.G * 512) { const size_t j = i >> 3; const f32x4 v = p[j * 512 + 8 * (j & 63) + (i & 7)];
                mx = fmaxf(mx, fmaxf(fmaxf(fabsf(v[0]), fabsf(v[1])), fmaxf(fabsf(v[2]), fabsf(v[3])))); } }
        for (int o = 32; o > 0; o >>= 1) mx = fmaxf(mx, __shfl_xor(mx, o));
        if (F.lane == 0 && mx > 0.f) atomicMax(&wm[l], __float_as_uint(mx));
        float mg = 0.f; const f32x4* wi_ = (const f32x4*)(F.in(2) + (size_t)l * DM * INW);
        for (int i = F.bid * 512 + F.tid; i < DM * (INW / 4) / 16; i += F.G * 512) { const size_t j = (size_t)(i >> 3); const f32x4 v = wi_[j * 128 + 8 * (j & 15) + (i & 7)];
            mg = fmaxf(mg, fmaxf(fmaxf(fabsf(v[0]), fabsf(v[1])), fmaxf(fabsf(v[2]), fabsf(v[3])))); }
        for (int o = 32; o > 0; o >>= 1) mg = fmaxf(mg, __shfl_xor(mg, o));
        if (F.lane == 0 && mg > 0.f) atomicMax(&wm[CW_WMAXG - CW_WMAX + l], __float_as_uint(mg));
        float mp = 0.f; const f32x4* wp_ = (const f32x4*)(F.in(21) + (size_t)l * DM * DM);
        for (int i = F.bid * 512 + F.tid; i < DM * DM / 4 / 16; i += F.G * 512) { const int j = i >> 3; const f32x4 v = wp_[j * 128 + 8 * (j & 15) + (i & 7)];
            mp = fmaxf(mp, fmaxf(fmaxf(fabsf(v[0]), fabsf(v[1])), fmaxf(fabsf(v[2]), fabsf(v[3])))); }
        for (int o = 32; o > 0; o >>= 1) mp = fmaxf(mp, __shfl_xor(mp, o));
        if (F.lane == 0 && mp > 0.f) atomicMax(&wm[CW_WMAXP - CW_WMAX + l], __float_as_uint(mp));
        float md = 0.f; const f32x4* wd_ = (const f32x4*)(F.in(19) + (size_t)l * NEXP * DEXP * DM);
        for (size_t i = (size_t)F.bid * 512 + F.tid; i < (size_t)NEXP * DEXP * DM / 4 / 64; i += (size_t)F.G * 512) { const size_t j = i >> 3; const f32x4 v = wd_[j * 512 + 8 * (j & 63) + (i & 7)];
            md = fmaxf(md, fmaxf(fmaxf(fabsf(v[0]), fabsf(v[1])), fmaxf(fabsf(v[2]), fabsf(v[3])))); }
        for (int o = 32; o > 0; o >>= 1) md = fmaxf(md, __shfl_xor(md, o));
        if (F.lane == 0 && md > 0.f) atomicMax(&wm[CW_WMAXD - CW_WMAX + l], __float_as_uint(md)); }
}
__device__ __forceinline__ void conv_rows(const Frame& F, const float* src, bf16_t* dst, size_t n8) {
    for (size_t i = (size_t)F.bid * 512 + F.tid; i < n8; i += (size_t)F.G * 512) { const f32x4 a = *(const f32x4*)(src + i * 8), b = *(const f32x4*)(src + i * 8 + 4); pg8::st_bf16x8(dst + i * 8, a, b); }
}
__device__ __forceinline__ void quant_rows(const Frame& F, const float* src, bf16_t* xb, unsigned char* xq, float* xsc) {
    const int lane = F.lane;
    for (int tok = F.bid * 8 + F.wid; tok < NTOK; tok += F.G * 8) { f32x4 v[8]; float amax = 0.f;
#pragma unroll
        for (int i = 0; i < 4; ++i) { const int c = (i * 64 + lane) * 8; v[2 * i] = *(const f32x4*)(src + (size_t)tok * DM + c); v[2 * i + 1] = *(const f32x4*)(src + (size_t)tok * DM + c + 4);
            pg8::st_bf16x8(xb + (size_t)tok * DM + c, v[2 * i], v[2 * i + 1]);
#pragma unroll
            for (int h = 0; h < 2; ++h)
#pragma unroll
                for (int j = 0; j < 4; ++j) amax = fmaxf(amax, fabsf(v[2 * i + h][j])); }
        for (int o = 32; o > 0; o >>= 1) amax = fmaxf(amax, __shfl_xor(amax, o));
        amax = fmaxf(amax, 1e-20f); const float qi = 127.0f / amax; if (lane == 0) xsc[tok] = amax * (1.0f / 127.0f);
#pragma unroll
        for (int i = 0; i < 4; ++i) { u32x2 w;
#pragma unroll
            for (int h = 0; h < 2; ++h) { unsigned pk = 0u;
#pragma unroll
                for (int j = 0; j < 4; ++j) pk |= ((unsigned)(int)rintf(v[2 * i + h][j] * qi) & 0xffu) << (8 * j);
                w[h] = pk; }
            *(u32x2*)(xq + (size_t)tok * DM + (i * 64 + lane) * 8) = w; } }
}
__constant__ int c_so[14] = {0, 1312, 2416, 3440, 4464, 5496, 6520, 7544, 8568, 1024, 1280, 2336, 2400, 5488};
__constant__ int c_dn[14] = {0, 1024, 2048, 3072, 4096, 5120, 6144, 7168, 8192, 14336, 14592, 14624, 14688, 14704};
__constant__ int c_nc[14] = {1024, 1024, 1024, 1024, 1024, 1024, 1024, 1024, 6144, 256, 32, 64, 16, 8};
__device__ __forceinline__ void convert_layer_weights(const Frame& F0, const Params& P, int l) { const Frame F = fresh(F0);
    unsigned char* ws = F.ws; int rot = 0;
    { const float* w = F.in(2) + (size_t)l * DM * INW; bf16_t* d = (bf16_t*)(ws + W_IN);
      const float wmaxg = __uint_as_float(((const unsigned*)(ws + WS_CTL))[CW_WMAXG + l]); const float qinv = 127.0f / (1.3f * fmaxf(wmaxg, 1e-30f));
#pragma unroll 1
      for (int s = 0; s < 14; ++s) {
          if (s == 1 || s >= 10) tconv(F, w + c_so[s], INW, DM, c_nc[s], d + (size_t)c_dn[s] * DM, DM, rot);
          else { const int crow = (s == 0) ? 0 : (s <= 7 ? 1024 + (s - 2) * 1024 : (s == 8 ? 7168 : 13312));
              TcMat dq{w + c_so[s], INW, DM >> 6, c_nc[s], (bf16_t*)(ws + W_IN8 + (size_t)crow * 2048), 2048, qinv}; tconv_run(F, (DM >> 6) * (c_nc[s] >> 6), dq, rot); } } }
    tconv(F, F.in(7) + (size_t)l * 1024 * DM, DM, 1024, DM, (bf16_t*)(ws + W_BRA), 3072, rot);
    tconv(F, F.in(8) + (size_t)l * 1024 * DM, DM, 1024, DM, (bf16_t*)(ws + W_BRA) + 1024, 3072, rot);
    tconv(F, F.in(9) + (size_t)l * 1024 * DM, DM, 1024, DM, (bf16_t*)(ws + W_BRA) + 2048, 3072, rot);
    tconv(F, F.in(10) + (size_t)l * DM * DM, DM, DM, DM, (bf16_t*)(ws + W_OUT), DM, rot);
    { const float wmp = __uint_as_float(((const unsigned*)(ws + WS_CTL))[CW_WMAXP + l]);
      TcMat dq{F.in(21) + (size_t)l * DM * DM, DM, DM >> 6, DM, (bf16_t*)(ws + W_PG), 2048, 127.0f / (1.3f * fmaxf(wmp, 1e-30f))}; tconv_run(F, (DM >> 6) * (DM >> 6), dq, rot); }
    tconv(F, F.in(22) + (size_t)l * 256 * DM, DM, 256, DM, (bf16_t*)(ws + W_PLE), 256, rot);
#pragma unroll 1
    for (int h = 0; h < 8; ++h) tconv(F, F.in(6) + (size_t)l * 256 * 1024 + h * 128, 1024, 256, 128, (bf16_t*)(ws + W_UV2) + ((size_t)(h >> 1) * 256 + (h & 1) * 128) * 512 + (h & 1) * 256, 512, rot);
    { const float wmax = __uint_as_float(((const unsigned*)(ws + WS_CTL))[CW_WMAX + l]);
      const float wmaxd = __uint_as_float(((const unsigned*)(ws + WS_CTL))[CW_WMAXD + l]);
      TcExperts d{F.in(15) + (size_t)l * NEXP * DM * DEXP, F.in(17) + (size_t)l * NEXP * DM * DEXP, F.in(19) + (size_t)l * NEXP * DEXP * DM, (unsigned char*)(ws + W_GU), (unsigned char*)(ws + W_DN), 127.0f / (1.3f * fmaxf(wmax, 1e-30f)), 127.0f / (1.3f * fmaxf(wmaxd, 1e-30f))};
      tconv_run(F, NEXP * 1536, d, rot); }
    { const float* w = F.in(5) + (size_t)l * 256 * 8 * 96; bf16_t* d = (bf16_t*)(ws + W_UK2);
      for (int i = F.bid * 512 + F.tid; i < 256 * 8 * 96; i += F.G * 512) { const int n = i % 96, h = (i / 96) & 7, r = i / 768; d[((size_t)h * 256 + r) * 256 + (h & 1) * 128 + 32 + n] = f2bf(w[i]); } }
}

__device__ __forceinline__ void rope_cs(float pos, float invf, float& c, float& s) {
    const float a = pos * invf; const double ad = (double)a * 0.15915494309189535; const float fr = (float)(ad - rint(ad));
    s = __builtin_amdgcn_sinf(fr); c = __builtin_amdgcn_cosf(fr);
}
__device__ __forceinline__ void phase_prep(const Frame& F0, const Params& P, int l) { const Frame F = fresh(F0);
    unsigned char* ws = F.ws; const int lane = F.lane;
    const float* smallb = (const float*)(ws + R_SMALL); bf16_t* kcat = (bf16_t*)(ws + R_KCAT); bf16_t* qcat = (bf16_t*)(ws + R_QCAT);
    bf16_t* ki = (bf16_t*)(ws + R_KI); float* wi = (float*)(ws + R_WI); float* lf = (float*)(ws + WS_LF);
    const bf16_t* qa = (const bf16_t*)(ws + R_QA); bf16_t* qidx = (bf16_t*)(ws + R_QIDX);
    const f32x4 gck = *(const f32x4*)(F.in(4) + l * 256 + lane * 4);
    const float bfo = lane < 8 ? F.in(3)[l * 8 + lane] : 0.f;
    const float ifr = c_invf_r[lane & 15], ifi = c_invf_i[lane & 7];
    for (int tok = F.bid * 8 + F.wid; tok < NTOK; tok += F.G * 8) {
        const int s = tok & (SEQ - 1), b = tok >> 13; const float* sm = smallb + (size_t)tok * 512;
        float cr, sr, ci, si; rope_cs((float)s, ifr, cr, sr); rope_cs((float)s, ifi, ci, si);
        { const f32x4 v = *(const f32x4*)(sm + lane * 4); float ss = v[0] * v[0] + v[1] * v[1] + v[2] * v[2] + v[3] * v[3]; ss = wave_sum(ss);
          const float rs = rsqrtf(ss * (1.0f / 256.0f) + 1e-6f); u32x2 w; w.x = cvtpk(v[0] * rs * gck[0], v[1] * rs * gck[1]); w.y = cvtpk(v[2] * rs * gck[2], v[3] * rs * gck[3]);
          *(u32x2*)(kcat + (size_t)tok * 288 + lane * 4) = w; }
        if (lane < 16) { const float x1 = sm[256 + lane], x2 = sm[272 + lane]; kcat[(size_t)tok * 288 + 256 + lane] = f2bf(x1 * cr - x2 * sr); kcat[(size_t)tok * 288 + 272 + lane] = f2bf(x2 * cr + x1 * sr); }
        { float o = sm[288 + lane];
          if (lane < 8) { const float x2 = sm[296 + lane]; o = o * ci - x2 * si; } else if (lane < 16) { const float x1 = sm[288 + lane - 8]; o = o * ci + x1 * si; }
          ki[(size_t)tok * 64 + lane] = f2bf(o); }
        if (lane < 16) wi[(size_t)tok * 16 + lane] = sm[352 + lane] * (1.0f / 32.0f);
        if (lane < 8) { const float f = sm[368 + lane] + bfo; lf[(size_t)(b * 8 + lane) * SEQ + s] = fminf(f, 0.f) - log1pf(__expf(-fabsf(f))); }
#pragma unroll
        for (int pp = 0; pp < 2; ++pp) { const int p = lane + 64 * pp, h = p >> 4, i = p & 15;
            const float x1 = bf2f(qa[(size_t)tok * 1024 + h * 128 + i]), x2 = bf2f(qa[(size_t)tok * 1024 + h * 128 + 16 + i]);
            qcat[(size_t)tok * 2304 + h * 288 + 256 + i] = f2bf(x1 * cr - x2 * sr); qcat[(size_t)tok * 2304 + h * 288 + 272 + i] = f2bf(x2 * cr + x1 * sr); }
#pragma unroll
        for (int pp = 0; pp < 2; ++pp) { const int p = lane + 64 * pp, hh = p >> 3, i = p & 7; bf16_t* q = qidx + (size_t)tok * 1024 + hh * 64;
            const float x1 = bf2f(q[i]), x2 = bf2f(q[8 + i]); q[i] = f2bf(x1 * ci - x2 * si); q[8 + i] = f2bf(x2 * ci + x1 * si); }
    }
    { const bf16_t* kbt = (const bf16_t*)(ws + R_QKV) + (size_t)NTOK * 1024; unsigned* kmx = (unsigned*)(ws + WS_CTL) + CW_KMAX + l * 16;
#pragma unroll 1
      for (int bh = 0; bh < 16; ++bh) { float mx = 0.f;
          for (int r0 = (F.bid * 8 + F.wid) * 4; r0 < SEQ; r0 += F.G * 32) {
              const u32x4 w = *(const u32x4*)(kbt + ((size_t)bh * SEQ + r0 + (lane >> 4)) * 128 + (lane & 15) * 8);
              float ss = bflo(w.x) * bflo(w.x) + bfhi(w.x) * bfhi(w.x) + bflo(w.y) * bflo(w.y) + bfhi(w.y) * bfhi(w.y) + bflo(w.z) * bflo(w.z) + bfhi(w.z) * bfhi(w.z) + bflo(w.w) * bflo(w.w) + bfhi(w.w) * bfhi(w.w);
              ss += __shfl_xor(ss, 1); ss += __shfl_xor(ss, 2); ss += __shfl_xor(ss, 4); ss += __shfl_xor(ss, 8); mx = fmaxf(mx, ss); }
          mx = fmaxf(mx, __shfl_xor(mx, 16)); mx = fmaxf(mx, __shfl_xor(mx, 32));
          if (lane == 0) ((float*)F.lds)[F.wid * 16 + bh] = mx; }
      __syncthreads();
      if (F.tid < 16) { float mx = 0.f;
#pragma unroll
          for (int w = 0; w < 8; ++w) mx = fmaxf(mx, ((const float*)F.lds)[w * 16 + F.tid]);
          const unsigned bits = __float_as_uint(mx);
          if (bits > __hip_atomic_load(&kmx[F.tid], __ATOMIC_RELAXED, __HIP_MEMORY_SCOPE_AGENT)) atomicMax(&kmx[F.tid], bits); }
      __syncthreads(); }
}
__device__ __forceinline__ void phase_cumsum(const Frame& F0) { const Frame F = fresh(F0);
    const int gw = F.bid * 8 + F.wid; if (gw >= 16) return;
    const float* lf = (const float*)(F.ws + WS_LF) + (size_t)gw * SEQ; float* cum = (float*)(F.ws + WS_CUM) + (size_t)gw * SEQ;
    const int lane = F.lane; double tot = 0.0;
    for (int j = 0; j < 128; ++j) tot += (double)lf[lane * 128 + j];
    double inc = tot;
    for (int o = 1; o < 64; o <<= 1) { const double n = __shfl_up(inc, o); if (lane >= o) inc += n; }
    double run = inc - tot;
    for (int j = 0; j < 128; ++j) { run += (double)lf[lane * 128 + j]; cum[lane * 128 + j] = (float)run; }
}

__device__ __forceinline__ void idx_unit(const Frame& F, int b, int pi, int half) {
    const int tid = F.tid, lane = F.lane, rho = lane & 31, hh = lane >> 5; unsigned char* ws = F.ws;
    const bf16_t* qidx = (const bf16_t*)(ws + R_QIDX); const bf16_t* ki = (const bf16_t*)(ws + R_KI) + (size_t)b * SEQ * 64; const float* wi = (const float*)(ws + R_WI);
    float* scores = (float*)(ws + R_SCORES) + (size_t)b * SEQ * SEQ;
    LAS unsigned char* kl = F.ldsl;
    const int gl = pi, gh = 127 - pi, nl = (64 * gl + 63) / 128 + 1, nh = (64 * gh + 63) / 128 + 1, tot = nl + nh;
    const int x0 = half ? tot / 2 : 0, x1 = half ? tot : tot / 2;
    bf16x8 af[4][4]; float wv[4][16]; int t0 = 0, curg = -1;
    const int r0 = tid >> 3, p0 = tid & 7;
    const unsigned d0 = (unsigned)(r0 * 128 + ((p0 ^ (r0 & 7)) << 4)), d1 = d0 + 64 * 128;
    u32x4 s0, s1;
    { const int c = x0 < nl ? x0 : x0 - nl; const bf16_t* kp = ki + (size_t)(c * 128) * 64; s0 = *(const u32x4*)(kp + (size_t)r0 * 64 + p0 * 8); s1 = *(const u32x4*)(kp + (size_t)(r0 + 64) * 64 + p0 * 8); }
    __syncthreads();
    *(LAS u32x4*)(kl + d0) = s0; *(LAS u32x4*)(kl + d1) = s1;
    __syncthreads();
    const unsigned rdo = (unsigned)(rho * 128);
#pragma unroll 1
    for (int x = x0; x < x1; ++x) {
        const int g = x < nl ? gl : gh, c = x < nl ? x : x - nl;
        if (g != curg) { curg = g; t0 = g * 64 + F.wid * 8;
#pragma unroll
            for (int mt = 0; mt < 4; ++mt) {
                const int tokA = b * SEQ + t0 + 2 * mt + ((rho >> 2) & 1), head = (rho & 3) + 4 * (rho >> 3);
#pragma unroll
                for (int kk = 0; kk < 4; ++kk) af[mt][kk] = *(const bf16x8*)(qidx + (size_t)tokA * 1024 + head * 64 + kk * 16 + 8 * hh);
                const float* wp = wi + (size_t)(b * SEQ + t0 + 2 * mt + hh) * 16;
#pragma unroll
                for (int q = 0; q < 4; ++q) { const f32x4 v = *(const f32x4*)(wp + 4 * q); wv[mt][4 * q] = v[0]; wv[mt][4 * q + 1] = v[1]; wv[mt][4 * q + 2] = v[2]; wv[mt][4 * q + 3] = v[3]; } } }
        const unsigned bo = (unsigned)((x - x0) & 1) * 16384u;
        if (x + 1 < x1) { const int cn = (x + 1) < nl ? (x + 1) : (x + 1) - nl; const bf16_t* kp = ki + (size_t)(cn * 128) * 64; s0 = *(const u32x4*)(kp + (size_t)r0 * 64 + p0 * 8); s1 = *(const u32x4*)(kp + (size_t)(r0 + 64) * 64 + p0 * 8); }
#pragma unroll
        for (int tl = 0; tl < 4; ++tl) {
            const int kb = c * 128 + tl * 32;
            if (kb <= t0 + 7) {
                bf16x8 bc[4];
#pragma unroll
                for (int kk = 0; kk < 4; ++kk) bc[kk] = *(const LAS bf16x8*)(kl + bo + tl * 4096 + rdo + (((kk * 2 + hh) ^ (rho & 7)) << 4));
                f32x16 a0 = {}, a1 = {}, a2 = {}, a3 = {};
#pragma unroll
                for (int kk = 0; kk < 4; ++kk) { a0 = __builtin_amdgcn_mfma_f32_32x32x16_bf16(af[0][kk], bc[kk], a0, 0, 0, 0); a1 = __builtin_amdgcn_mfma_f32_32x32x16_bf16(af[1][kk], bc[kk], a1, 0, 0, 0);
                                                  a2 = __builtin_amdgcn_mfma_f32_32x32x16_bf16(af[2][kk], bc[kk], a2, 0, 0, 0); a3 = __builtin_amdgcn_mfma_f32_32x32x16_bf16(af[3][kk], bc[kk], a3, 0, 0, 0); }
#define IDX_EPI(A_, mt_) do { float x_0 = 0.f, x_1 = 0.f, x_2 = 0.f, x_3 = 0.f; _Pragma("unroll") for (int r = 0; r < 16; r += 4) { \
                    x_0 = fmaf(wv[mt_][r], fmaxf(A_[r], 0.f), x_0); x_1 = fmaf(wv[mt_][r + 1], fmaxf(A_[r + 1], 0.f), x_1); x_2 = fmaf(wv[mt_][r + 2], fmaxf(A_[r + 2], 0.f), x_2); x_3 = fmaf(wv[mt_][r + 3], fmaxf(A_[r + 3], 0.f), x_3); } \
                    scores[(size_t)(t0 + 2 * (mt_) + hh) * SEQ + kb + rho] = (x_0 + x_1) + (x_2 + x_3); } while (0)
                IDX_EPI(a0, 0); IDX_EPI(a1, 1); IDX_EPI(a2, 2); IDX_EPI(a3, 3);
#undef IDX_EPI
            }
        }
        if (x + 1 < x1) { *(LAS u32x4*)(kl + (bo ^ 16384u) + d0) = s0; *(LAS u32x4*)(kl + (bo ^ 16384u) + d1) = s1; }
        __syncthreads();
    }
}
__device__ __forceinline__ void phase_idx(const Frame& F0) { const Frame F = fresh(F0);
#pragma unroll 1
    for (int it = F.bid; it < 256; it += F.G) { const int b = it >> 7, pi = (it >> 1) & 63, half = it & 1; idx_unit(F, b, pi, half); }
}

__device__ __forceinline__ unsigned sortable(float f) { const unsigned u = __float_as_uint(f); return (u & 0x80000000u) ? ~u : (u | 0x80000000u); }
__device__ __forceinline__ void topk_row(const Frame& F, int b, int t) {
    int lane = F.lane; asm volatile("" : "+v"(lane));
    const int L = t + 1, tok = b * SEQ + t; unsigned char* ws = F.ws;
    int* sel = (int*)(ws + R_SEL) + (size_t)tok * 256; int* nsel = (int*)(ws + R_NSEL);
    if (lane == 0) nsel[tok] = L < 256 ? L : 256;
    if (L <= 256) { for (int j = lane; j < 256; j += 64) sel[j] = j < L ? j : 0; return; }
    const float* row = (const float*)(ws + R_SCORES) + ((size_t)b * SEQ + t) * SEQ;
    const int nch = (L + 1023) >> 10;
#define TOPK_LOAD_ROW() do { _Pragma("unroll") for (int c = 0; c < 8; ++c) { \
        if (c < nch) { _Pragma("unroll") for (int jj = 0; jj < 4; ++jj) { const int j = c * 4 + jj; const f32x4 v = *(const f32x4*)(row + j * 256 + lane * 4); \
                _Pragma("unroll") for (int e_ = 0; e_ < 4; ++e_) { const int idx = j * 256 + lane * 4 + e_; u[j * 4 + e_] = idx < L ? sortable(v[e_]) : 0u; } } } \
        else { _Pragma("unroll") for (int q = 0; q < 16; ++q) u[c * 16 + q] = 0u; } } } while (0)
    unsigned u[128];
    TOPK_LOAD_ROW();
    unsigned g0 = 0u, g1 = 0u, g2 = 0u, g3 = 0u;
#pragma unroll
    for (int c = 0; c < 8; ++c) if (c < nch) {
#pragma unroll
        for (int jj = 0; jj < 4; ++jj) { const int j = c * 4 + jj; g0 = u[4 * j] > g0 ? u[4 * j] : g0; g1 = u[4 * j + 1] > g1 ? u[4 * j + 1] : g1; g2 = u[4 * j + 2] > g2 ? u[4 * j + 2] : g2; g3 = u[4 * j + 3] > g3 ? u[4 * j + 3] : g3; } }
    unsigned tl = g0 < g1 ? g0 : g1; { const unsigned t2 = g2 < g3 ? g2 : g3; tl = tl < t2 ? tl : t2; }
#pragma unroll
    for (int o = 32; o > 0; o >>= 1) { const unsigned x = (unsigned)__shfl_xor((int)tl, o); tl = x < tl ? x : tl; }
    constexpr int CAP = 2048;
    LAS unsigned* candk = (LAS unsigned*)(F.ldsl + F.wid * (CAP * 8)); LAS unsigned* candi = candk + CAP;
    int C = 0;
#pragma unroll
    for (int c = 0; c < 8; ++c) if (c < nch) {
#pragma unroll
        for (int q = 0; q < 16; ++q) { const int rq = c * 16 + q; const bool pr = u[rq] >= tl; const unsigned long long mm = __ballot(pr);
            const int pos = C + __popcll(mm & ((1ull << lane) - 1ull));
            if (pr && pos < CAP) { candk[pos] = u[rq]; candi[pos] = (unsigned)((rq >> 2) * 256 + lane * 4 + (rq & 3)); }
            C += __popcll(mm); if ((q & 3) == 3) SBAR(); } }
    if (C <= CAP) {
        const int ng = (C + 255) >> 8;
        unsigned ck[32]; int ci[32];
#pragma unroll
        for (int g = 0; g < 8; ++g) {
#pragma unroll
            for (int q = 0; q < 4; ++q) { const int r = g * 4 + q, p = r * 64 + lane; ck[r] = 0u; ci[r] = 0;
                if (g < ng && p < C) { ck[r] = candk[p]; ci[r] = (int)candi[p]; } } }
        unsigned T = 0u, thr_gt = 0u; int need_eq = 0; bool early = false;
        for (int bit = 31; bit >= 0; --bit) {
            const unsigned cnd = T | (1u << bit); int cnt = 0;
#pragma unroll
            for (int g = 0; g < 8; ++g) if (g < ng) {
#pragma unroll
                for (int q = 0; q < 4; ++q) cnt += __popcll(__ballot(ck[g * 4 + q] >= cnd)); }
            if (cnt >= 256) { T = cnd; if (cnt == 256) { early = true; break; } }
        }
        if (early) { thr_gt = T - 1u; need_eq = 0; }
        else { int gtc = 0;
#pragma unroll
            for (int g = 0; g < 8; ++g) if (g < ng) {
#pragma unroll
                for (int q = 0; q < 4; ++q) gtc += __popcll(__ballot(ck[g * 4 + q] > T)); }
            thr_gt = T; need_eq = 256 - gtc; }
        int base = 0, eq_taken = 0;
#pragma unroll
        for (int g = 0; g < 8; ++g) if (g < ng) {
#pragma unroll
            for (int q = 0; q < 4; ++q) { const int r = g * 4 + q; const unsigned v = ck[r];
                const bool iseq = (v == thr_gt) && (need_eq > 0);
                const unsigned long long meq = __ballot(iseq);
                const int eqr = __popcll(meq & ((1ull << lane) - 1ull));
                const bool take = (v > thr_gt) || (iseq && (eq_taken + eqr < need_eq));
                const unsigned long long mt = __ballot(take);
                const int pos = base + __popcll(mt & ((1ull << lane) - 1ull));
                if (take && pos < 256) sel[pos] = ci[r];
                base += __popcll(mt); eq_taken += __popcll(meq); } }
        return;
    }
    asm volatile("" ::: "memory");
    TOPK_LOAD_ROW();
    unsigned T = 0u, thr_gt = 0u; int need_eq = 0; bool early = false;
    for (int bit = 31; bit >= 0; --bit) {
        const unsigned cand = T | (1u << bit); int cnt = 0;
#pragma unroll
        for (int c = 0; c < 8; ++c) if (c < nch) {
#pragma unroll
            for (int q = 0; q < 16; ++q) cnt += __popcll(__ballot(u[c * 16 + q] >= cand)); }
        if (cnt >= 256) { T = cand; if (cnt == 256) { early = true; break; } }
    }
    if (early) { thr_gt = T - 1u; need_eq = 0; }
    else { int gtc = 0;
#pragma unroll
        for (int c = 0; c < 8; ++c) if (c < nch) {
#pragma unroll
            for (int q = 0; q < 16; ++q) gtc += __popcll(__ballot(u[c * 16 + q] > T)); }
        thr_gt = T; need_eq = 256 - gtc; }
    int base = 0, eq_taken = 0;
#pragma unroll
    for (int c = 0; c < 8; ++c) if (c < nch) {
#pragma unroll
        for (int q = 0; q < 16; ++q) { const int rq = c * 16 + q; const unsigned v = u[rq];
            const bool iseq = (v == thr_gt) && (need_eq > 0);
            const unsigned long long meq = __ballot(iseq);
            const int eqr = __popcll(meq & ((1ull << lane) - 1ull));
            const bool take = (v > thr_gt) || (iseq && (eq_taken + eqr < need_eq));
            const unsigned long long mt = __ballot(take);
            const int pos = base + __popcll(mt & ((1ull << lane) - 1ull));
            if (take && pos < 256) sel[pos] = (rq >> 2) * 256 + lane * 4 + (rq & 3);
            base += __popcll(mt); eq_taken += __popcll(meq); } }
}
__device__ __forceinline__ void phase_topk(const Frame& F0) { const Frame F = fresh(F0);
    for (int q = F.bid * 8 + F.wid; q < 8192; q += F.G * 8) { const int b = q >> 12, p = q & 4095; topk_row(F, b, p); topk_row(F, b, SEQ - 1 - p); }
}

namespace att {
constexpr int D = 128, KVBLK = 64, QBLK = 32, SHM_V = 16384, SHM_K = 16384;
constexpr int OFF_K = 2 * SHM_V, OFF_BIAS = 2 * SHM_V + 2 * SHM_K, OFF_WS = OFF_BIAS + 512, OFF_FLAGS = OFF_WS + 2048, OFF_QITEM = OFF_FLAGS + 64;
constexpr float EXIT_T = 44.0f;
#define KSWZ(row, colB) ((row) * 256 + ((colB) ^ (((row) & 7) << 4)))
__device__ __forceinline__ int v_st(int k, int c) { const int kk = (k & ~0xC) | ((k & 4) << 1) | ((k & 8) >> 1); return ((kk >> 3) * 4 + (c >> 5)) * 512 + ((kk & 7) * 32 + (c & 31)) * 2; }
__device__ __forceinline__ int v_rd_base(int lane) { return ((lane & 3) << 3) | (((lane >> 2) & 3) << 6) | (((lane >> 4) & 1) << 5) | (((lane >> 5) & 1) << 8); }
constexpr int v_rd_off(int d0, int ks, int half) { return d0 * 512 + ks * 4096 + half * 2048; }
template <int KB>
__device__ __forceinline__ void qkt(f32x16& p0, f32x16& p1, const char* K_lds, int r32, int hi, const bf16x8* qr) {
    p0 = f32x16{}; p1 = f32x16{};
    const char* kb[4];
#pragma unroll
    for (int dd = 0; dd < 4; ++dd) kb[dd] = K_lds + KB * SHM_K + KSWZ(r32, (dd * 16 + hi * 8) * 2);
#pragma unroll
    for (int d0 = 0; d0 < 8; ++d0) { const char* a = kb[d0 & 3] + (d0 >> 2) * 128;
        bf16x8 b0 = *reinterpret_cast<const bf16x8*>(a);
        bf16x8 b1 = *reinterpret_cast<const bf16x8*>(a + 32 * 256);
        p0 = __builtin_amdgcn_mfma_f32_32x32x16_bf16(b0, qr[d0], p0, 0, 0, 0);
        p1 = __builtin_amdgcn_mfma_f32_32x32x16_bf16(b1, qr[d0], p1, 0, 0, 0); }
}
template <int VB>
__device__ __forceinline__ void pv_tile(f32x16* o, int vb0, bf16x8 pa0, bf16x8 pa1, bf16x8 pa2, bf16x8 pa3) {
#define TRRD(dst, off) asm volatile("ds_read_b64_tr_b16 %0, %1 offset:%2" : "=&v"(dst) : "v"(vb0), "i"(off) : "memory")
#define PV_D0(d0) do { s16x4 l0, l1, l2, l3, h0, h1, h2, h3; constexpr int b_ = VB * SHM_V + v_rd_off(d0, 0, 0); \
        TRRD(l0, b_); TRRD(h0, b_ + 2048); TRRD(l1, b_ + 4096); TRRD(h1, b_ + 6144); TRRD(l2, b_ + 8192); TRRD(h2, b_ + 10240); TRRD(l3, b_ + 12288); TRRD(h3, b_ + 14336); \
        asm volatile("s_waitcnt lgkmcnt(0)" ::: "memory"); SBAR(); \
        o[d0] = __builtin_amdgcn_mfma_f32_32x32x16_bf16(pa0, (bf16x8){l0[0], l0[1], l0[2], l0[3], h0[0], h0[1], h0[2], h0[3]}, o[d0], 0, 0, 0); \
        o[d0] = __builtin_amdgcn_mfma_f32_32x32x16_bf16(pa1, (bf16x8){l1[0], l1[1], l1[2], l1[3], h1[0], h1[1], h1[2], h1[3]}, o[d0], 0, 0, 0); \
        o[d0] = __builtin_amdgcn_mfma_f32_32x32x16_bf16(pa2, (bf16x8){l2[0], l2[1], l2[2], l2[3], h2[0], h2[1], h2[2], h2[3]}, o[d0], 0, 0, 0); \
        o[d0] = __builtin_amdgcn_mfma_f32_32x32x16_bf16(pa3, (bf16x8){l3[0], l3[1], l3[2], l3[3], h3[0], h3[1], h3[2], h3[3]}, o[d0], 0, 0, 0); } while (0)
    PV_D0(0); PV_D0(1); PV_D0(2); PV_D0(3);
#undef PV_D0
#undef TRRD
}
#define PK4(P, B_, OUT) do { unsigned a0 = cvtpk(P[B_+0], P[B_+1]), a1 = cvtpk(P[B_+2], P[B_+3]); \
        unsigned b0 = cvtpk(P[B_+4], P[B_+5]), b1 = cvtpk(P[B_+6], P[B_+7]); \
        auto r0 = __builtin_amdgcn_permlane32_swap(a0, b0, false, false); auto r1 = __builtin_amdgcn_permlane32_swap(a1, b1, false, false); \
        u32x4 w = {r0[0], r1[0], r0[1], r1[1]}; OUT = *reinterpret_cast<bf16x8*>(&w); } while (0)
__device__ __forceinline__ float swap_max(float x) { auto rr = __builtin_amdgcn_permlane32_swap(__float_as_uint(x), __float_as_uint(x), false, false); return fmaxf(__uint_as_float(rr[0]), __uint_as_float(rr[1])); }
__device__ __forceinline__ float swap_sum(float x) { auto rr = __builtin_amdgcn_permlane32_swap(__float_as_uint(x), __float_as_uint(x), false, false); return __uint_as_float(rr[0]) + __uint_as_float(rr[1]); }
__device__ __forceinline__ float swap_lo(float x) { auto rr = __builtin_amdgcn_permlane32_swap(__float_as_uint(x), __float_as_uint(x), false, false); return __uint_as_float(rr[0]); }


__device__ __forceinline__ void fox_sm(f32x16& p0, f32x16& p1, const float* bl, int kb_, int qlo, int qrow, int hi, int r32, float& m_reg, float& l_reg, f32x16* o, float* al_l,
                                       bf16x8& pa0, bf16x8& pa1, bf16x8& pa2, bf16x8& pa3) {
#pragma unroll
    for (int g = 0; g < 4; ++g) { const f32x4 b0v = *(const f32x4*)(bl + 8 * g + 4 * hi), b1v = *(const f32x4*)(bl + 32 + 8 * g + 4 * hi);
#pragma unroll
        for (int i = 0; i < 4; ++i) { p0[4 * g + i] = fmaf(p0[4 * g + i], C2, b0v[i]); p1[4 * g + i] = fmaf(p1[4 * g + i], C2, b1v[i]); } }
    if (kb_ + KVBLK - 1 > qlo) { const float NEG = -__builtin_inff();
#pragma unroll
        for (int r = 0; r < 16; ++r) { const int key = kb_ + crow(r, hi); if (key > qrow) p0[r] = NEG; if (key + 32 > qrow) p1[r] = NEG; } }
    float pmax = p0[0];
#pragma unroll
    for (int r = 1; r < 16; ++r) pmax = fmaxf(pmax, p0[r]);
#pragma unroll
    for (int r = 0; r < 16; ++r) pmax = fmaxf(pmax, p1[r]);
    pmax = swap_max(pmax);
    const float mn = fmaxf(m_reg, pmax), alpha = __builtin_amdgcn_exp2f(m_reg - mn); m_reg = mn;
    float ps = 0.f;
#pragma unroll
    for (int r = 0; r < 16; ++r) { p0[r] = __builtin_amdgcn_exp2f(p0[r] - mn); p1[r] = __builtin_amdgcn_exp2f(p1[r] - mn); ps += p0[r] + p1[r]; }
    ps = swap_sum(ps); l_reg = l_reg * alpha + ps;
    if (__any(alpha < 1.f)) { if (hi == 0) al_l[r32] = alpha; asm volatile("s_waitcnt lgkmcnt(0)" ::: "memory");
#pragma unroll
        for (int r = 0; r < 16; ++r) { const float a = al_l[crow(r, hi)];
#pragma unroll
            for (int d_ = 0; d_ < 4; ++d_) o[d_][r] *= a; } }
    PK4(p0, 0, pa0); PK4(p0, 8, pa1); PK4(p1, 0, pa2); PK4(p1, 8, pa3);
}
__device__ __forceinline__ void sb_half(f32x16& pz, int keybase, int qrow, int hi, float& R, const bf16x8* triA, bool needmask) {
    f32x16 X;
#pragma unroll
    for (int r = 0; r < 16; ++r) { const float zz = pz[r] * C2; const bool valid = !needmask || (keybase + crow(r, hi) < qrow);
        const float l2 = fmaxf(zz, 0.f) + __builtin_amdgcn_logf(1.0f + __builtin_amdgcn_exp2f(-fabsf(zz)));
        X[r] = valid ? -l2 : 0.f; pz[r] = valid ? zz : -__builtin_inff(); }
    f32x16 Y;
#pragma unroll
    for (int r = 0; r < 16; ++r) Y[r] = R;
#pragma unroll
    for (int s = 0; s < 2; ++s) {
        const unsigned h0 = cvtpk(X[8 * s + 0], X[8 * s + 1]), h1 = cvtpk(X[8 * s + 2], X[8 * s + 3]), h2 = cvtpk(X[8 * s + 4], X[8 * s + 5]), h3 = cvtpk(X[8 * s + 6], X[8 * s + 7]);
        const unsigned l0 = cvtpk(X[8 * s + 0] - bflo(h0), X[8 * s + 1] - bfhi(h0)), l1 = cvtpk(X[8 * s + 2] - bflo(h1), X[8 * s + 3] - bfhi(h1));
        const unsigned l2 = cvtpk(X[8 * s + 4] - bflo(h2), X[8 * s + 5] - bfhi(h2)), l3 = cvtpk(X[8 * s + 6] - bflo(h3), X[8 * s + 7] - bfhi(h3));
        u32x4 wh = {h0, h1, h2, h3}, wl = {l0, l1, l2, l3};
        Y = __builtin_amdgcn_mfma_f32_32x32x16_bf16(triA[s], *reinterpret_cast<bf16x8*>(&wh), Y, 0, 0, 0);
        Y = __builtin_amdgcn_mfma_f32_32x32x16_bf16(triA[s], *reinterpret_cast<bf16x8*>(&wl), Y, 0, 0, 0); }
#pragma unroll
    for (int r = 0; r < 16; ++r) pz[r] = __builtin_amdgcn_exp2f(pz[r] + Y[r]);
    R = swap_lo(Y[0]);
}
__device__ __forceinline__ void sb_sm(f32x16& p0, f32x16& p1, int kb_, int qlo, int qrow, int hi, float& R, const bf16x8* triA, bf16x8& pa0, bf16x8& pa1, bf16x8& pa2, bf16x8& pa3) {
    const bool needmask = (kb_ + KVBLK - 1 >= qlo);
    sb_half(p1, kb_ + 32, qrow, hi, R, triA, needmask);
    sb_half(p0, kb_, qrow, hi, R, triA, needmask);
    PK4(p0, 0, pa0); PK4(p0, 8, pa1); PK4(p1, 0, pa2); PK4(p1, 8, pa3);
}

template <int MODE>
__device__ __forceinline__ void attn_unit(const bf16_t* Q, const bf16_t* Kh, const bf16_t* Vh, const float* cum, bf16_t* O, int P0, char* lds, float kmaxc) {
    int tid = threadIdx.x; asm volatile("" : "+v"(tid));
    const int wid = __builtin_amdgcn_readfirstlane(tid >> 6), lane = tid & 63, r32 = lane & 31, hi = lane >> 5;
    const int NT = P0 / KVBLK + 4;
    char* V_lds = lds; char* K_lds = lds + OFF_K; float* bias_l = (float*)(lds + OFF_BIAS);
    float* wsl = (float*)(lds + OFF_WS) + wid * 64; float* li_l = wsl; float* al_l = wsl + 32;
    const int qlo = P0 + wid * QBLK, qrow = qlo + r32;
    bf16x8 qr[8];
#pragma unroll
    for (int d0 = 0; d0 < 8; ++d0) qr[d0] = *(const bf16x8*)(Q + (size_t)qrow * D + d0 * 16 + hi * 8);
    const int sr = tid >> 4, sc = (tid & 15) * 8, vst0 = v_st(sr, sc), vst1 = v_st(32 + sr, sc), kws = KSWZ(sr, sc * 2);
    const int vb0 = (int)(uintptr_t)V_lds + v_rd_base(lane);
    const float cumref = (MODE == 0) ? cum[P0] : 0.f;
    int* flg = (int*)(lds + OFF_FLAGS);
    float qn = 0.f;
    if (MODE == 0) { float ss = 0.f;
#pragma unroll
        for (int d0 = 0; d0 < 8; ++d0)
#pragma unroll
            for (int j = 0; j < 8; ++j) { const float x = bf2f((bf16_t)qr[d0][j]); ss = fmaf(x, x, ss); }
        ss = swap_sum(ss); qn = sqrtf(ss) * kmaxc * 1.001f; }
    float m_reg = -1e30f, l_reg = 0.f, R = 0.f; f32x16 o[4] = {};
    bf16x8 triA[2];
    if (MODE == 1) {
#pragma unroll
        for (int s = 0; s < 2; ++s)
#pragma unroll
            for (int j = 0; j < 8; ++j) { const int rho = 16 * s + 8 * (j >> 2) + 4 * hi + (j & 3); triA[s][j] = (rho >= r32) ? (short)0x3F80 : (short)0; }
    }
    bf16x8 st_k0, st_k1, st_v0, st_v1; float st_b = 0.f;
#define TILE_KB(t) ((NT - 1 - (t)) * KVBLK)
#define SLOAD(kb_) do { st_v0 = *(const bf16x8*)(Vh + (size_t)((kb_) + sr) * D + sc); st_v1 = *(const bf16x8*)(Vh + (size_t)((kb_) + 32 + sr) * D + sc); \
                        st_k0 = *(const bf16x8*)(Kh + (size_t)((kb_) + sr) * D + sc); st_k1 = *(const bf16x8*)(Kh + (size_t)((kb_) + 32 + sr) * D + sc); \
                        if (MODE == 0 && tid < 64) st_b = (cumref - cum[(kb_) + tid]) * LOG2E; } while (0)
#define SWRITE(bf) do { *(bf16x8*)(V_lds + (bf) * SHM_V + vst0) = st_v0; *(bf16x8*)(V_lds + (bf) * SHM_V + vst1) = st_v1; \
                        *(bf16x8*)(K_lds + (bf) * SHM_K + kws) = st_k0; *(bf16x8*)(K_lds + (bf) * SHM_K + kws + 32 * 256) = st_k1; \
                        if (MODE == 0 && tid < 64) bias_l[(bf) * 64 + tid] = st_b; } while (0)
    __syncthreads();
    SLOAD(TILE_KB(0)); SWRITE(0);
    __syncthreads();
    f32x16 p0, p1; bf16x8 pa0, pa1, pa2, pa3;
#define STEP(BUF, t) do { const int kb_ = TILE_KB(t); \
        if ((t) + 1 < NT) SLOAD(TILE_KB((t) + 1)); \
        SBAR(); qkt<BUF>(p0, p1, K_lds, r32, hi, qr); \
        if (MODE == 0) fox_sm(p0, p1, bias_l + (BUF) * 64, kb_, qlo, qrow, hi, r32, m_reg, l_reg, o, al_l, pa0, pa1, pa2, pa3); \
        else sb_sm(p0, p1, kb_, qlo, qrow, hi, R, triA, pa0, pa1, pa2, pa3); \
        SBAR(); pv_tile<BUF>(o, vb0, pa0, pa1, pa2, pa3); \
        if ((t) + 1 < NT) SWRITE((BUF) ^ 1); \
        __syncthreads(); } while (0)
    for (int t = 0; t < NT; t += 2) {
        STEP(0, t); STEP(1, t + 1);
        const int kbc = TILE_KB(t + 1); if (kbc == 0) break;
        bool done;
        if (MODE == 0) { const float edge = (cumref - cum[kbc - 1]) * LOG2E; done = (qn + edge - m_reg) < -EXIT_T; }
        else done = R < -EXIT_T;
        const int par = (t >> 1) & 1;
        if (lane == 0) flg[par * 8 + wid] = 0;
        const bool wdone = __all(done);
        if (lane == 0 && wdone) flg[par * 8 + wid] = 1;
        __syncthreads();
        int alld = 1;
#pragma unroll
        for (int w = 0; w < 8; ++w) alld &= flg[par * 8 + w];
        if (alld) break;
    }
    __syncthreads();
#undef STEP
#undef SLOAD
#undef SWRITE
#undef TILE_KB
    float rli[16];
    if (MODE == 0) { if (hi == 0) li_l[r32] = l_reg; asm volatile("s_waitcnt lgkmcnt(0)" ::: "memory");
#pragma unroll
        for (int r = 0; r < 16; ++r) rli[r] = __builtin_amdgcn_rcpf(li_l[crow(r, hi)]); }
    bf16_t* Ow = O + (size_t)(wid * QBLK) * 3072;
#pragma unroll
    for (int r = 0; r < 16; ++r) { const int orow = crow(r, hi);
#pragma unroll
        for (int d0 = 0; d0 < 4; ++d0) { const float v = (MODE == 0) ? o[d0][r] * rli[r] : o[d0][r];
            const float vn = __shfl_xor(v, 1);
            if ((r32 & 1) == 0) *(unsigned*)(Ow + (size_t)orow * 3072 + d0 * 32 + r32) = cvtpk(v, vn); } }
}
}

__device__ __forceinline__ void sparse_query(const Frame& F, int tok, char* ldsw) {
    unsigned char* ws = F.ws; const int lane = F.lane, g = lane >> 4, i16 = lane & 15;
    const bf16_t* qcat = (const bf16_t*)(ws + R_QCAT) + (size_t)tok * 2304; const bf16_t* kbase = (const bf16_t*)(ws + R_KCAT) + (size_t)(tok >> 13) * SEQ * 288;
    const int* sel = (const int*)(ws + R_SEL) + (size_t)tok * 256; const int ns = ((const int*)(ws + R_NSEL))[tok]; const int ntile = (ns + 31) >> 5;
    bf16x8 qf[9];
#pragma unroll
    for (int st = 0; st < 9; ++st) { qf[st] = (bf16x8){0, 0, 0, 0, 0, 0, 0, 0}; if (i16 < 8) qf[st] = *(const bf16x8*)(qcat + i16 * 288 + st * 32 + 8 * g); }
    const int rA = lane >> 2, cq = lane & 3;
    float m = -1e30f, l = 0.f; f32x4 oT[16];
#pragma unroll
    for (int rb = 0; rb < 16; ++rb) oT[rb] = (f32x4){0.f, 0.f, 0.f, 0.f};
    const unsigned ldso = (unsigned)(uintptr_t)ldsw;
    const unsigned vb = ldso + (unsigned)((4 * g + (i16 >> 2)) * 592 + (i16 & 3) * 8);
    constexpr float SC2 = SCALE * LOG2E;
    bf16x8 stg[18];
#define GATHER(tile_) do { const int j0 = (tile_) * 32 + rA, j1 = j0 + 16; const int s0 = j0 < ns ? sel[j0] : 0, s1 = j1 < ns ? sel[j1] : 0; \
        const bf16_t* p0_ = kbase + (size_t)s0 * 288 + cq * 8; const bf16_t* p1_ = kbase + (size_t)s1 * 288 + cq * 8; \
        _Pragma("unroll") for (int c = 0; c < 9; ++c) { stg[2 * c] = *(const bf16x8*)(p0_ + c * 32); stg[2 * c + 1] = *(const bf16x8*)(p1_ + c * 32); } } while (0)
    GATHER(0);
    for (int tile = 0; tile < ntile; ++tile) {
#pragma unroll
        for (int c = 0; c < 9; ++c) { *(bf16x8*)(ldsw + rA * 592 + c * 64 + cq * 16) = stg[2 * c]; *(bf16x8*)(ldsw + (16 + rA) * 592 + c * 64 + cq * 16) = stg[2 * c + 1]; }
        if (tile + 1 < ntile) GATHER(tile + 1);
        asm volatile("s_waitcnt lgkmcnt(0)" ::: "memory"); SBAR();
        f32x4 acc[2];
#pragma unroll
        for (int mt = 0; mt < 2; ++mt) { acc[mt] = (f32x4){0.f, 0.f, 0.f, 0.f};
#pragma unroll
            for (int st = 0; st < 9; ++st) { const bf16x8 a = *(const bf16x8*)(ldsw + (16 * mt + i16) * 592 + st * 64 + g * 16);
                acc[mt] = __builtin_amdgcn_mfma_f32_16x16x32_bf16(a, qf[st], acc[mt], 0, 0, 0); } }
        float tmax = -__builtin_inff();
#pragma unroll
        for (int mt = 0; mt < 2; ++mt)
#pragma unroll
            for (int r = 0; r < 4; ++r) { const int key = tile * 32 + 16 * mt + 4 * g + r; float x = acc[mt][r] * SC2; if (key >= ns) x = -__builtin_inff(); acc[mt][r] = x; tmax = fmaxf(tmax, x); }
        tmax = fmaxf(tmax, __shfl_xor(tmax, 16)); tmax = fmaxf(tmax, __shfl_xor(tmax, 32));
        const float mn = fmaxf(m, tmax), alpha = __builtin_amdgcn_exp2f(m - mn); m = mn;
        float ps = 0.f;
#pragma unroll
        for (int mt = 0; mt < 2; ++mt)
#pragma unroll
            for (int r = 0; r < 4; ++r) { acc[mt][r] = __builtin_amdgcn_exp2f(acc[mt][r] - mn); ps += acc[mt][r]; }
        ps += __shfl_xor(ps, 16); ps += __shfl_xor(ps, 32);
        l = l * alpha + ps;
#pragma unroll
        for (int rb = 0; rb < 16; ++rb) oT[rb] *= alpha;
        const bf16x8 pf = pack8(acc[0], acc[1]);
#define TRRD2(dst, off) asm volatile("ds_read_b64_tr_b16 %0, %1 offset:%2" : "=&v"(dst) : "v"(vb), "i"(off) : "memory")
#define PVRB4(rb) do { s16x4 ta0, tb0, ta1, tb1, ta2, tb2, ta3, tb3; \
        TRRD2(ta0, ((rb) + 0) * 32); TRRD2(tb0, ((rb) + 0) * 32 + 16 * 592); TRRD2(ta1, ((rb) + 1) * 32); TRRD2(tb1, ((rb) + 1) * 32 + 16 * 592); \
        TRRD2(ta2, ((rb) + 2) * 32); TRRD2(tb2, ((rb) + 2) * 32 + 16 * 592); TRRD2(ta3, ((rb) + 3) * 32); TRRD2(tb3, ((rb) + 3) * 32 + 16 * 592); \
        asm volatile("s_waitcnt lgkmcnt(0)" ::: "memory"); SBAR(); \
        oT[(rb) + 0] = __builtin_amdgcn_mfma_f32_16x16x32_bf16((bf16x8){ta0[0], ta0[1], ta0[2], ta0[3], tb0[0], tb0[1], tb0[2], tb0[3]}, pf, oT[(rb) + 0], 0, 0, 0); \
        oT[(rb) + 1] = __builtin_amdgcn_mfma_f32_16x16x32_bf16((bf16x8){ta1[0], ta1[1], ta1[2], ta1[3], tb1[0], tb1[1], tb1[2], tb1[3]}, pf, oT[(rb) + 1], 0, 0, 0); \
        oT[(rb) + 2] = __builtin_amdgcn_mfma_f32_16x16x32_bf16((bf16x8){ta2[0], ta2[1], ta2[2], ta2[3], tb2[0], tb2[1], tb2[2], tb2[3]}, pf, oT[(rb) + 2], 0, 0, 0); \
        oT[(rb) + 3] = __builtin_amdgcn_mfma_f32_16x16x32_bf16((bf16x8){ta3[0], ta3[1], ta3[2], ta3[3], tb3[0], tb3[1], tb3[2], tb3[3]}, pf, oT[(rb) + 3], 0, 0, 0); } while (0)
        PVRB4(0); PVRB4(4); PVRB4(8); PVRB4(12);
#undef PVRB4
#undef TRRD2
        SBAR();
    }
#undef GATHER
    const float rl = 1.0f / l;
    if (i16 < 8) { bf16_t* op = (bf16_t*)(ws + R_OLAT) + (size_t)tok * 2048 + i16 * 256 + 4 * g;
#pragma unroll
        for (int rb = 0; rb < 16; ++rb) { u32x2 w; w.x = cvtpk(oT[rb][0] * rl, oT[rb][1] * rl); w.y = cvtpk(oT[rb][2] * rl, oT[rb][3] * rl); *(u32x2*)(op + rb * 16) = w; } }
}
#ifdef ATT_SUB
#define ASUB(k) ((k) == ATT_SUB)
#else
#define ASUB(k) true
#endif
__device__ __forceinline__ void phase_attn(const Frame& F0, int l, int rep) { const Frame F = fresh(F0);
    unsigned char* ws = F.ws; char* lds = (char*)F.lds;
    const bf16_t* qkv = (const bf16_t*)(ws + R_QKV); const size_t TS = (size_t)NTOK * 1024;
    unsigned* qctr = (unsigned*)(ws + WS_CTL) + CW_QCTR + l * 64 + rep * 16; const unsigned* kmx = (const unsigned*)(ws + WS_CTL) + CW_KMAX + l * 16;
    int* qitem = (int*)(lds + att::OFF_QITEM);
    int* hord = qitem + 4;
    if (F.tid < 16) { const float* cumb = (const float*)(ws + WS_CUM); const float mine = -cumb[(size_t)F.tid * SEQ + SEQ - 1]; int rank = 0;
        for (int o = 0; o < 16; ++o) { const float v = -cumb[(size_t)o * SEQ + SEQ - 1]; rank += (v < mine || (v == mine && o < F.tid)) ? 1 : 0; }
        hord[rank] = F.tid; }
#pragma unroll 1
    for (;;) {
        __syncthreads();
        if (F.tid == 0) qitem[0] = (int)atomicAdd(qctr, 1u);
        __syncthreads();
        const int it = qitem[0];
        if (it >= 1024) break;
        const int md = it >> 9, j = it & 511;
        const int qb = md == 0 ? 31 - (j & 31) : 31 - (j >> 4), bh = md == 0 ? hord[j >> 5] : (j & 15), b = bh >> 3, h = bh & 7, P0 = qb * 256;
        if (!ASUB(md)) continue;
        const bf16_t* Q = qkv + (size_t)(md * 3 + 0) * TS + (size_t)bh * SEQ * 128; const bf16_t* K = qkv + (size_t)(md * 3 + 1) * TS + (size_t)bh * SEQ * 128; const bf16_t* V = qkv + (size_t)(md * 3 + 2) * TS + (size_t)bh * SEQ * 128;
        const float* cum = (const float*)(ws + WS_CUM) + (size_t)bh * SEQ;
        bf16_t* Ob = (bf16_t*)(ws + R_OA) + (size_t)b * SEQ * 3072 + (md + 1) * 1024 + h * 128;
        if (md == 0) { const float kmaxc = sqrtf(__uint_as_float(kmx[bh])) * C2; att::attn_unit<0>(Q, K, V, cum, Ob + (size_t)P0 * 3072, P0, lds, kmaxc); }
        else att::attn_unit<1>(Q, K, V, cum, Ob + (size_t)P0 * 3072, P0, lds, 0.f);
    }
    __syncthreads();
    char* ldsw = lds + F.wid * 18944;
#pragma unroll 1
    for (int rep = 0; rep < NREP(2); ++rep)
#pragma unroll 1
    for (int tok = F.bid * 8 + F.wid; tok < NTOK; tok += F.G * 8) if (ASUB(2)) sparse_query(F, tok, ldsw);
}

__device__ __forceinline__ void ln_row(const bf16_t* src, const float* g, const float* bta, float* of, bf16_t* ob, int lane, unsigned char* oq = nullptr, float* osc = nullptr, float* ost = nullptr) {
    f32x4 v[8]; float s = 0.f;
#pragma unroll
    for (int i = 0; i < 4; ++i) { const u32x4 w = *(const u32x4*)(src + (i * 64 + lane) * 8);
        v[2 * i] = (f32x4){bflo(w.x), bfhi(w.x), bflo(w.y), bfhi(w.y)}; v[2 * i + 1] = (f32x4){bflo(w.z), bfhi(w.z), bflo(w.w), bfhi(w.w)};
        s += (v[2 * i][0] + v[2 * i][1]) + (v[2 * i][2] + v[2 * i][3]) + (v[2 * i + 1][0] + v[2 * i + 1][1]) + (v[2 * i + 1][2] + v[2 * i + 1][3]); }
    s = wave_sum(s); const float mu = s * (1.0f / 2048.0f); float q = 0.f;
#pragma unroll
    for (int i = 0; i < 8; ++i) { const f32x4 d = v[i] - mu; q += (d[0] * d[0] + d[1] * d[1]) + (d[2] * d[2] + d[3] * d[3]); }
    q = wave_sum(q); const float rstd = rsqrtf(q * (1.0f / 2048.0f) + 1e-5f);
    if (ost && lane == 0) { ost[0] = mu; ost[1] = rstd; }
    float amax = 0.f;
#pragma unroll
    for (int i = 0; i < 4; ++i) { const int c = (i * 64 + lane) * 8; const f32x4 g0 = *(const f32x4*)(g + c), g1 = *(const f32x4*)(g + c + 4), b0 = *(const f32x4*)(bta + c), b1 = *(const f32x4*)(bta + c + 4);
        const f32x4 y0 = (v[2 * i] - mu) * rstd * g0 + b0, y1 = (v[2 * i + 1] - mu) * rstd * g1 + b1; v[2 * i] = y0; v[2 * i + 1] = y1;
        if (of) { *(f32x4*)(of + c) = y0; *(f32x4*)(of + c + 4) = y1; }
        if (ob) pg8::st_bf16x8(ob + c, y0, y1);
        if (oq) { amax = fmaxf(amax, fmaxf(fmaxf(fmaxf(fabsf(y0[0]), fabsf(y0[1])), fmaxf(fabsf(y0[2]), fabsf(y0[3]))), fmaxf(fmaxf(fabsf(y1[0]), fabsf(y1[1])), fmaxf(fabsf(y1[2]), fabsf(y1[3]))))); } }
    if (oq) {
        for (int o = 32; o > 0; o >>= 1) amax = fmaxf(amax, __shfl_xor(amax, o));
        amax = fmaxf(amax, 1e-20f); const float qi = 127.0f / amax; if (lane == 0) *osc = amax * (1.0f / 127.0f);
#pragma unroll
        for (int i = 0; i < 4; ++i) { u32x2 w;
#pragma unroll
            for (int h = 0; h < 2; ++h) { const f32x4 y = v[2 * i + h]; unsigned pk = 0u;
#pragma unroll
                for (int j = 0; j < 4; ++j) pk |= ((unsigned)(int)rintf(y[j] * qi) & 0xffu) << (8 * j);
                w[h] = pk; }
            *(u32x2*)(oq + (i * 64 + lane) * 8) = w; } }
}
__device__ __forceinline__ void phase_ln1_router(const Frame& F0, const Params& P, int l) { const Frame F = fresh(F0);
    unsigned char* ws = F.ws; const int lane = F.lane, wid = F.wid;
    const bf16_t* pre1 = (const bf16_t*)(ws + R_PRE1); float* x1f = (float*)(ws + M_X1F); bf16_t* x1b = (bf16_t*)(ws + M_X1B); unsigned char* x1q = (unsigned char*)(ws + M_X1Q); float* x1s = (float*)(ws + M_X1S);
    const float* g = F.in(11) + l * DM; const float* bt = F.in(12) + l * DM; const float* wr = F.in(13) + (size_t)l * DM * NEXP; const float* br = F.in(14) + l * NEXP;
    unsigned* cnt = (unsigned*)(ws + WS_CTL) + CW_CNT + l * 2048;
    int* tok_e = (int*)(ws + M_TOKE); int* tok_pos = (int*)(ws + M_TOKPOS); float* tok_w = (float*)(ws + M_TOKW);
    float* red = (float*)F.lds;
    float* lg = (float*)(F.lds + 32768); float* stats = (float*)(F.lds + 32768 + 16384);
#pragma unroll 1
    for (int blk = F.bid; blk < NTOK / 64; blk += F.G) {
        const int tok0 = blk * 64;
#pragma unroll 1
        for (int i = 0; i < 8; ++i) { const int tok = tok0 + wid * 8 + i; ln_row(pre1 + (size_t)tok * DM, g, bt, (float*)nullptr, x1b + (size_t)tok * DM, lane, x1q + (size_t)tok * DM, x1s + tok, stats + 2 * (wid * 8 + i)); }
        asm volatile("s_waitcnt vmcnt(0)" ::: "memory"); __syncthreads();
        { const int grp = wid >> 2, kq = wid & 3, i32 = lane & 31, hk = lane >> 5; f32x16 acc = {};
          const bf16_t* arow = pre1 + (size_t)(tok0 + grp * 32 + i32) * DM + kq * 512 + 4 * hk; const float* bcol = wr + (size_t)(kq * 512 + 4 * hk) * NEXP + i32;
          const float* gp = g + kq * 512 + 4 * hk; const float* bp = bt + kq * 512 + 4 * hk; const float mu = stats[2 * (grp * 32 + i32)], rstd = stats[2 * (grp * 32 + i32) + 1];
#pragma unroll 4
          for (int c8 = 0; c8 < 64; ++c8) { const u32x2 xw = *(const u32x2*)(arow + c8 * 8); const f32x4 g4 = *(const f32x4*)(gp + c8 * 8), b4 = *(const f32x4*)(bp + c8 * 8);
              const f32x4 a4 = ((f32x4){bflo(xw.x), bfhi(xw.x), bflo(xw.y), bfhi(xw.y)} - mu) * rstd * g4 + b4;
              const float b0 = bcol[(size_t)(c8 * 8 + 0) * NEXP], b1 = bcol[(size_t)(c8 * 8 + 1) * NEXP], b2 = bcol[(size_t)(c8 * 8 + 2) * NEXP], b3 = bcol[(size_t)(c8 * 8 + 3) * NEXP];
              acc = __builtin_amdgcn_mfma_f32_32x32x2f32(a4[0], b0, acc, 0, 0, 0); acc = __builtin_amdgcn_mfma_f32_32x32x2f32(a4[1], b1, acc, 0, 0, 0);
              acc = __builtin_amdgcn_mfma_f32_32x32x2f32(a4[2], b2, acc, 0, 0, 0); acc = __builtin_amdgcn_mfma_f32_32x32x2f32(a4[3], b3, acc, 0, 0, 0); }
#pragma unroll
          for (int r = 0; r < 16; ++r) red[(wid * 16 + r) * 64 + lane] = acc[r]; }
        __syncthreads();
        if ((wid & 3) == 0) { const int grp = wid >> 2, hk = lane >> 5, e = lane & 31; const float be = br[e];
#pragma unroll
            for (int r = 0; r < 16; ++r) { const float v = red[((wid + 0) * 16 + r) * 64 + lane] + red[((wid + 1) * 16 + r) * 64 + lane] + red[((wid + 2) * 16 + r) * 64 + lane] + red[((wid + 3) * 16 + r) * 64 + lane] + be;
                lg[(grp * 32 + crow(r, hk)) * 33 + e] = v; }
            asm volatile("s_waitcnt lgkmcnt(0)" ::: "memory"); SBAR();
            const int tk = lane & 31; float v[32];
#pragma unroll
            for (int e2 = 0; e2 < 32; ++e2) v[e2] = lg[(grp * 32 + tk) * 33 + e2];
            int ek[4]; float vk[4];
#pragma unroll
            for (int k = 0; k < 4; ++k) { float best = -__builtin_inff(); int bi = 0;
#pragma unroll
                for (int e2 = 0; e2 < 32; ++e2) if (v[e2] > best) { best = v[e2]; bi = e2; }
                ek[k] = bi; vk[k] = best;
#pragma unroll
                for (int e2 = 0; e2 < 32; ++e2) v[e2] = (e2 == bi) ? -__builtin_inff() : v[e2]; }
            float wk[4], sw = 0.f;
#pragma unroll
            for (int k = 0; k < 4; ++k) { wk[k] = __expf(vk[k] - vk[0]); sw += wk[k]; }
            const float rs = 1.0f / sw;
            const bool act = lane < 32; unsigned myc = 0u;
#pragma unroll 1
            for (int E = 0; E < 32; ++E) { unsigned c = 0u;
#pragma unroll
                for (int k = 0; k < 4; ++k) c += (unsigned)__popcll(__ballot(act && ek[k] == E));
                if (lane == E) myc = c; }
            unsigned run = 0u; if (lane < 32 && myc > 0u) run = atomicAdd(&cnt[lane * 64], myc);
            int pk[4];
#pragma unroll
            for (int k = 0; k < 4; ++k) { pk[k] = 0;
#pragma unroll 1
                for (int E = 0; E < 32; ++E) { const unsigned long long mm = __ballot(act && ek[k] == E); const unsigned basev = (unsigned)__shfl((int)run, E);
                    if (act && ek[k] == E) pk[k] = (int)(basev + (unsigned)__popcll(mm & ((1ull << lane) - 1ull)));
                    if (lane == E) run += (unsigned)__popcll(mm); } }
            if (act) { const int tok = tok0 + grp * 32 + tk;
#pragma unroll
                for (int k = 0; k < 4; ++k) { tok_e[tok * 4 + k] = ek[k]; tok_pos[tok * 4 + k] = pk[k]; tok_w[tok * 4 + k] = wk[k] * rs; } }
        }
        __syncthreads();
    }
}
__device__ __forceinline__ void phase_moe_gather(const Frame& F0, int l) { const Frame F = fresh(F0);
    unsigned char* ws = F.ws; const int lane = F.lane;
    const unsigned* cnt = (const unsigned*)(ws + WS_CTL) + CW_CNT + l * 2048; unsigned* meta = (unsigned*)(ws + WS_CTL) + CW_META + l * 512;
    unsigned* offs = (unsigned*)(F.lds + LDS_MISC + 64);
    if (F.tid == 0) { unsigned o = 0u; for (int e = 0; e < 32; ++e) { offs[e] = o; o += (cnt[e * 64] + 255u) & ~255u; } offs[32] = o;
        if (F.bid == 0) { meta[0] = o >> 8; for (int e = 0; e < 32; ++e) for (unsigned t = offs[e] >> 8; t < (offs[e + 1] >> 8); ++t) meta[1 + t] = (unsigned)e; } }
    __syncthreads();
    const int* tok_e = (const int*)(ws + M_TOKE); const int* tok_pos = (const int*)(ws + M_TOKPOS); const float* tok_w = (const float*)(ws + M_TOKW);
    int* tok_dst = (int*)(ws + M_TOKDST); float* roww = (float*)(ws + M_ROWW);
    const unsigned char* x1q = (const unsigned char*)(ws + M_X1Q); const float* x1s = (const float*)(ws + M_X1S); unsigned char* xs = (unsigned char*)(ws + M_XS); float* rowsx = (float*)(ws + M_ROWSX);
    unsigned* rowtok = (unsigned*)(ws + M_ROWTOK);
    for (int it = F.bid * 512 + F.tid; it < NTOK * 4; it += F.G * 512) { const int tok = it >> 2;
        const int e = tok_e[it]; const unsigned dst = offs[e] + (unsigned)tok_pos[it];
        tok_dst[it] = (int)dst; roww[dst] = tok_w[it]; rowsx[dst] = x1s[tok]; rowtok[dst] = (unsigned)tok; }
    if (F.bid < 32) { const unsigned e = (unsigned)F.bid, c0 = offs[e] + cnt[e * 64];
        for (unsigned r = c0 + (unsigned)F.tid; r < offs[e + 1]; r += 512u) rowtok[r] = 0u; }
    __syncthreads();
}
__device__ __forceinline__ void phase_quant_h(const Frame& F0, int l) { const Frame F = fresh(F0);
    unsigned char* ws = F.ws; const int lane = F.lane;
    const int nrows = (int)((const unsigned*)(ws + WS_CTL))[CW_META + l * 512] * 256;
    const float* hm = (const float*)(ws + M_HM); const bf16_t* hid = (const bf16_t*)(ws + M_HID); unsigned char* h8 = (unsigned char*)(ws + M_H8); float* h8s = (float*)(ws + M_H8S);
    for (int row = F.bid * 8 + F.wid; row < nrows; row += F.G * 8) {
        float am = hm[(size_t)row * 32 + (lane & 31)];
        const u32x4 a = *(const u32x4*)(hid + (size_t)row * DEXP + lane * 16), b = *(const u32x4*)(hid + (size_t)row * DEXP + lane * 16 + 8);
        for (int o = 16; o > 0; o >>= 1) am = fmaxf(am, __shfl_xor(am, o));
        am = fmaxf(am, 1e-20f); const float qi = 127.0f / am; if (lane == 0) h8s[row] = am * (1.0f / 127.0f);
        const unsigned wv[8] = {a.x, a.y, a.z, a.w, b.x, b.y, b.z, b.w}; u32x4 w;
#pragma unroll
        for (int d = 0; d < 4; ++d) { unsigned pk = 0u;
#pragma unroll
            for (int j = 0; j < 2; ++j) { const unsigned x = wv[d * 2 + j];
                const float q0 = fminf(fmaxf(rintf(bflo(x) * qi), -127.f), 127.f), q1 = fminf(fmaxf(rintf(bfhi(x) * qi), -127.f), 127.f);
                pk |= (((unsigned)(int)q0 & 0xffu) | (((unsigned)(int)q1 & 0xffu) << 8)) << (16 * j); }
            w[d] = pk; }
        *(u32x4*)(h8 + (size_t)row * DEXP + lane * 16) = w; }
}
__device__ __forceinline__ void phase_combine(const Frame& F0) { const Frame F = fresh(F0);
    unsigned char* ws = F.ws; const int lane = F.lane;
    const bf16_t* x1b = (const bf16_t*)(ws + M_X1B); const bf16_t* ys = (const bf16_t*)(ws + M_XS); const int* tok_dst = (const int*)(ws + M_TOKDST);
    bf16_t* hb = (bf16_t*)(ws + M_HB); unsigned char* hq = (unsigned char*)(ws + M_HQ); float* hsc = (float*)(ws + M_HSC);
    for (int tok = F.bid * 8 + F.wid; tok < NTOK; tok += F.G * 8) {
        const int d0 = tok_dst[tok * 4], d1 = tok_dst[tok * 4 + 1], d2 = tok_dst[tok * 4 + 2], d3 = tok_dst[tok * 4 + 3];
        f32x4 hv[8]; float amax = 0.f;
#pragma unroll
        for (int i = 0; i < 4; ++i) { const int c = (i * 64 + lane) * 8; const size_t o = (size_t)tok * DM + c;
            const u32x4 xw = *(const u32x4*)(x1b + o);
            f32x4 a = (f32x4){bflo(xw.x), bfhi(xw.x), bflo(xw.y), bfhi(xw.y)} * ALPHA, b = (f32x4){bflo(xw.z), bfhi(xw.z), bflo(xw.w), bfhi(xw.w)} * ALPHA;
            const u32x4 y0 = *(const u32x4*)(ys + (size_t)d0 * DM + c), y1 = *(const u32x4*)(ys + (size_t)d1 * DM + c), y2 = *(const u32x4*)(ys + (size_t)d2 * DM + c), y3 = *(const u32x4*)(ys + (size_t)d3 * DM + c);
            a[0] += (bflo(y0.x) + bflo(y1.x)) + (bflo(y2.x) + bflo(y3.x)); a[1] += (bfhi(y0.x) + bfhi(y1.x)) + (bfhi(y2.x) + bfhi(y3.x));
            a[2] += (bflo(y0.y) + bflo(y1.y)) + (bflo(y2.y) + bflo(y3.y)); a[3] += (bfhi(y0.y) + bfhi(y1.y)) + (bfhi(y2.y) + bfhi(y3.y));
            b[0] += (bflo(y0.z) + bflo(y1.z)) + (bflo(y2.z) + bflo(y3.z)); b[1] += (bfhi(y0.z) + bfhi(y1.z)) + (bfhi(y2.z) + bfhi(y3.z));
            b[2] += (bflo(y0.w) + bflo(y1.w)) + (bflo(y2.w) + bflo(y3.w)); b[3] += (bfhi(y0.w) + bfhi(y1.w)) + (bfhi(y2.w) + bfhi(y3.w));
            pg8::st_bf16x8(hb + o, a, b); hv[2 * i] = a; hv[2 * i + 1] = b;
#pragma unroll
            for (int j = 0; j < 4; ++j) amax = fmaxf(amax, fmaxf(fabsf(a[j]), fabsf(b[j]))); }
        for (int o = 32; o > 0; o >>= 1) amax = fmaxf(amax, __shfl_xor(amax, o));
        amax = fmaxf(amax, 1e-20f); const float qi = 127.0f / amax; if (lane == 0) hsc[tok] = amax * (1.0f / 127.0f);
#pragma unroll
        for (int i = 0; i < 4; ++i) { u32x2 w;
#pragma unroll
            for (int h = 0; h < 2; ++h) { unsigned pk = 0u;
#pragma unroll
                for (int j = 0; j < 4; ++j) pk |= ((unsigned)(int)rintf(hv[2 * i + h][j] * qi) & 0xffu) << (8 * j);
                w[h] = pk; }
            *(u32x2*)(hq + (size_t)tok * DM + (i * 64 + lane) * 8) = w; } }
}
__device__ __forceinline__ void phase_ln2(const Frame& F0, const Params& P, int l) { const Frame F = fresh(F0);
    unsigned char* ws = F.ws; const bf16_t* pre2 = (const bf16_t*)(ws + M_X1F); bf16_t* xb = (bf16_t*)(ws + WS_XB);
    const float* g = F.in(23) + l * DM; const float* bt = F.in(24) + l * DM; float* outp = F.out();
    for (int tok = F.bid * 8 + F.wid; tok < NTOK; tok += F.G * 8) ln_row(pre2 + (size_t)tok * DM, g, bt, (l + 1 == NLAYER) ? outp + (size_t)tok * DM : (float*)nullptr, (l + 1 == NLAYER) ? (bf16_t*)nullptr : xb + (size_t)tok * DM, F.lane,
                                                                          (l + 1 == NLAYER) ? (unsigned char*)nullptr : (unsigned char*)(ws + WS_XQ) + (size_t)tok * DM, (l + 1 == NLAYER) ? (float*)nullptr : (float*)(ws + WS_XSC) + tok);
}

constexpr int NPHASE = 2 + 15 * NLAYER;
#ifdef PH_ONLY
#define PEN(kind) ((kind) == PH_ONLY)
#else
#define PEN(kind) true
#endif
#define IN(k) (lo <= (k) && (k) < hi)
#define SEAM(k) do { if (IN((k) + 1)) xcd_barrier(bar); } while (0)

template <int l>
__device__ __forceinline__ void layer_phases(const Frame& F, const Params& P, const XcdBarrier& bar, const int lo, const int hi, unsigned char* ws0) {
    using namespace pg8;

        const int pb = 2 + 15 * l;
        if (IN(pb + 0) && PEN(0)) { size_t wz = 0; asm volatile("" : "+s"(wz)); unsigned char* ws = ws0 + wz;
            { SchedS S; S.init(NTOK, 5 * 256, F.G, F.bid, (const bf16_t*)(ws + WS_XB), DM, (const bf16_t*)(ws + W_IN), DM); S.skip_from = 0; S.skip_by = 4; S.skip_from2 = 4; S.skip_by2 = 49;
              EpiInProj<false> E{(bf16_t*)(ws + R_QA), (bf16_t*)(ws + R_QIDX), (bf16_t*)(ws + R_QKV), (bf16_t*)(ws + R_GATES), (float*)(ws + R_SMALL), nullptr, nullptr};
              for (int rep = 0; rep < NREP(5); ++rep) gemm_phase(F.ldsl, DM, DM, DM, S, E); }
            { SchedS S; S.init(NTOK, 53 * 256, F.G, (F.bid + F.G / 2) % F.G, (const bf16_t*)(ws + WS_XQ), DM / 2, (const bf16_t*)(ws + W_IN8), DM / 2); S.skip_from = 4; S.skip_by = 4; S.b_compact = 1;
              EpiInProj<true> E{(bf16_t*)(ws + R_QA), (bf16_t*)(ws + R_QIDX), (bf16_t*)(ws + R_QKV), (bf16_t*)(ws + R_GATES), (float*)(ws + R_SMALL), (const float*)(ws + WS_XSC), (const unsigned*)(ws + WS_CTL) + CW_WMAXG + l};
              for (int rep = 0; rep < NREP(5); ++rep) gemm_phase(F.ldsl, DM / 2, DM / 2, DM / 2, S, E); }
            SEAM(pb + 0); }
        if (IN(pb + 1) && PEN(1)) { size_t wz = 0; asm volatile("" : "+s"(wz)); unsigned char* ws = ws0 + wz;
            phase_prep(F, P, l);
            SchedS S; S.init(NTOK, 2048, F.G, F.bid, (const bf16_t*)(ws + R_QA), 1024, (const bf16_t*)(ws + W_UK2), 256, 1, 256);
            EpiBf16 E{(bf16_t*)(ws + R_QCAT), 2304, 288};
            for (int rep = 0; rep < NREP(10); ++rep) gemm_phase(F.ldsl, 256, 1024, 256, S, E); SEAM(pb + 1); }
        if (IN(pb + 2) && PEN(2)) { size_t wz = 0; asm volatile("" : "+s"(wz)); unsigned char* ws = ws0 + wz; phase_cumsum(F); for (int rep = 0; rep < NREP(3); ++rep) phase_idx(F); SEAM(pb + 2); }
        if (IN(pb + 3) && PEN(3)) { size_t wz = 0; asm volatile("" : "+s"(wz)); unsigned char* ws = ws0 + wz; for (int rep = 0; rep < NREP(4); ++rep) phase_topk(F); SEAM(pb + 3); }
        if (IN(pb + 4) && PEN(4)) { size_t wz = 0; asm volatile("" : "+s"(wz)); unsigned char* ws = ws0 + wz; for (int rep = 0; rep < NREP(1); ++rep) phase_attn(F, l, rep); SEAM(pb + 4); }
        if (IN(pb + 5) && PEN(5)) { size_t wz = 0; asm volatile("" : "+s"(wz)); unsigned char* ws = ws0 + wz;
            SchedS S; S.init(NTOK, 1024, F.G, F.bid, (const bf16_t*)(ws + R_OLAT), 2048, (const bf16_t*)(ws + W_UV2), 512, 0, 512);
            EpiBf16 E{(bf16_t*)(ws + R_OA), 3072, 256}; for (int rep = 0; rep < NREP(10); ++rep) gemm_phase(F.ldsl, 512, 2048, 512, S, E);
            SEAM(pb + 5); }
        if (IN(pb + 6) && PEN(6)) { size_t wz = 0; asm volatile("" : "+s"(wz)); unsigned char* ws = ws0 + wz;
            SchedS S; S.init(NTOK, 2048, F.G, F.bid, (const bf16_t*)(ws + R_OA), 3072, (const bf16_t*)(ws + W_BRA), 3072);
            EpiBranch3 E{(const unsigned char*)(ws + R_GATES), (bf16_t*)(ws + R_MERGED)}; for (int rep = 0; rep < NREP(11); ++rep) gemm_phase(F.ldsl, 3072, 3072, 3072, S, E); SEAM(pb + 6); }
        if (IN(pb + 7) && PEN(7)) { size_t wz = 0; asm volatile("" : "+s"(wz)); unsigned char* ws = ws0 + wz;
            SchedS S; S.init(NTOK, 2048, F.G, F.bid, (const bf16_t*)(ws + R_MERGED), DM, (const bf16_t*)(ws + W_OUT), DM);
            EpiOut E{(const bf16_t*)(ws + WS_XB), (bf16_t*)(ws + R_PRE1)}; for (int rep = 0; rep < NREP(8); ++rep) gemm_phase(F.ldsl, DM, DM, DM, S, E); SEAM(pb + 7); }
        if (IN(pb + 8) && PEN(8)) { size_t wz = 0; asm volatile("" : "+s"(wz)); unsigned char* ws = ws0 + wz; phase_ln1_router(F, P, l); SEAM(pb + 8); }
        if (IN(pb + 9) && PEN(9)) { size_t wz = 0; asm volatile("" : "+s"(wz)); unsigned char* ws = ws0 + wz;
            for (int rep = 0; rep < NREP(12); ++rep) phase_moe_gather(F, l);
            SchedS S; S.init(NTOK, 2048, F.G, F.bid, (const bf16_t*)(ws + WS_PB) + (size_t)l * NTOK * 256, 256, (const bf16_t*)(ws + W_PLE), 256);
            EpiBf16 E{(bf16_t*)(ws + M_PP), 2048, 256}; for (int rep = 0; rep < NREP(10); ++rep) gemm_phase(F.ldsl, 256, 256, 256, S, E); SEAM(pb + 9); }
        if (IN(pb + 10) && PEN(10)) { size_t wz = 0; asm volatile("" : "+s"(wz)); unsigned char* ws = ws0 + wz;
            SchedMG S; S.init((const unsigned*)(ws + WS_CTL) + CW_META + l * 512, F.G, F.bid, (const bf16_t*)(ws + M_X1Q), DM / 2, (const bf16_t*)(ws + W_GU), DM / 2);
            { LAS unsigned* gt = (LAS unsigned*)(F.ldsl + pg8::GTAB_OFF); const unsigned* rowtok = (const unsigned*)(ws + M_ROWTOK);
              for (int ui = 0; ui * F.G + F.bid < S.ntiles * 8; ++ui) { const int pm = (ui * F.G + F.bid) >> 3; if (F.tid < 256) gt[ui * 256 + F.tid] = rowtok[pm * 256 + F.tid] * 2048u; }
              __syncthreads(); }
            EpiGateUpI8 E{F.in(16) + (size_t)l * NEXP * DEXP, F.in(18) + (size_t)l * NEXP * DEXP, (bf16_t*)(ws + M_HID), (const float*)(ws + M_ROWSX), (const unsigned*)(ws + WS_CTL) + CW_WMAX + l, (float*)(ws + M_HM)};
            for (int rep = 0; rep < NREP(6); ++rep) gemm_phase(F.ldsl, DM / 2, DM / 2, DM / 2, S, E); SEAM(pb + 10); }
        if (IN(pb + 11) && PEN(11)) { size_t wz = 0; asm volatile("" : "+s"(wz)); unsigned char* ws = ws0 + wz;
            phase_quant_h(F, l); xcd_barrier(bar);
            SchedM S; S.init((const unsigned*)(ws + WS_CTL) + CW_META + l * 512, F.G, F.bid, (const bf16_t*)(ws + M_H8), DEXP / 2, (const bf16_t*)(ws + W_DN), DEXP / 2);
            EpiDownI8 E{F.in(20) + (size_t)l * NEXP * DM, (const float*)(ws + M_ROWW), (bf16_t*)(ws + M_XS), (const float*)(ws + M_H8S), (const unsigned*)(ws + WS_CTL) + CW_WMAXD + l};
            for (int rep = 0; rep < NREP(7); ++rep) gemm_phase(F.ldsl, DEXP / 2, DEXP / 2, DEXP / 2, S, E); SEAM(pb + 11); }
        if (IN(pb + 12) && PEN(12)) { size_t wz = 0; asm volatile("" : "+s"(wz)); unsigned char* ws = ws0 + wz; for (int rep = 0; rep < NREP(9); ++rep) phase_combine(F); SEAM(pb + 12); }
        if (IN(pb + 13) && PEN(13)) { size_t wz = 0; asm volatile("" : "+s"(wz)); unsigned char* ws = ws0 + wz;
            SchedS S; S.init(NTOK, 2048, F.G, F.bid, (const bf16_t*)(ws + M_HQ), DM / 2, (const bf16_t*)(ws + W_PG), DM / 2);
            EpiPleGateI8 E{(const bf16_t*)(ws + M_HB), (const bf16_t*)(ws + M_PP), (bf16_t*)(ws + M_X1F), (const float*)(ws + M_HSC), (const unsigned*)(ws + WS_CTL) + CW_WMAXP + l};
            for (int rep = 0; rep < NREP(8); ++rep) gemm_phase(F.ldsl, DM / 2, DM / 2, DM / 2, S, E); SEAM(pb + 13); }
        if (IN(pb + 14) && PEN(14)) { size_t wz = 0; asm volatile("" : "+s"(wz)); unsigned char* ws = ws0 + wz; for (int rep = 0; rep < NREP(13); ++rep) phase_ln2(F, P, l); if (l + 1 < NLAYER) for (int rep = 0; rep < NREP(0); ++rep) convert_layer_weights(F, P, l + 1); SEAM(pb + 14); }
}
__global__ void __launch_bounds__(512, 2) fwd(Params P) {
    extern __shared__ __attribute__((aligned(16))) unsigned char lds[];
    Frame F; F.lds = lds; F.ldsl = (LAS unsigned char*)lds; F.ws = P.ws; F.tid = threadIdx.x; F.lane = F.tid & 63; F.wid = __builtin_amdgcn_readfirstlane(F.tid >> 6); F.G = gridDim.x; F.bid = blockIdx.x;
    unsigned char* ws0 = P.ws; unsigned char* ws = ws0;
    const bool fused = (P.ph_hi - P.ph_lo) > 1;
    if (F.tid < 4) ((LAS unsigned*)(F.ldsl + LDS_MISC))[F.tid] = 0u;
    if (F.tid == 0) { LAS unsigned long long* t = (LAS unsigned long long*)(F.ldsl + LDS_PTRS);
#pragma unroll
        for (int k = 0; k < 25; ++k) t[k] = (unsigned long long)P.in[k];
        t[25] = (unsigned long long)P.out; }
    __syncthreads();
    XcdBarrier bar; bar.bar = (unsigned*)(ws + WS_CTL) + CW_BAR; bar.x = 0; bar.st = (volatile LAS unsigned*)(F.ldsl + LDS_MISC);
    if (fused) bar = xcd_barrier_post((unsigned*)(ws + WS_CTL) + CW_BAR, (volatile LAS unsigned*)(F.ldsl + LDS_MISC));
    const int lo = P.ph_lo, hi = P.ph_hi;
    using namespace pg8;
    if (IN(0) && PEN(15)) { size_t wz = 0; asm volatile("" : "+s"(wz)); unsigned char* ws = ws0 + wz;
        quant_rows(F, F.in(0), (bf16_t*)(ws + WS_XB), (unsigned char*)(ws + WS_XQ), (float*)(ws + WS_XSC));
        conv_rows(F, F.in(1), (bf16_t*)(ws + WS_PB), (size_t)2 * NTOK * 256 / 8);
        sample_wmax(F);
        SEAM(0);
    }
    if (IN(1) && PEN(15)) { for (int rep = 0; rep < NREP(0); ++rep) convert_layer_weights(F, P, 0); SEAM(1); }
    layer_phases<0>(F, P, bar, lo, hi, ws0);
    layer_phases<1>(F, P, bar, lo, hi, ws0);
}

#ifdef DEBUG_NAN
constexpr int CW_FLAGS = 12288;
__global__ void dbg_scan_bf16(const unsigned short* p, size_t n, unsigned* flag) { unsigned c = 0; for (size_t i = (size_t)blockIdx.x * blockDim.x + threadIdx.x; i < n; i += (size_t)gridDim.x * blockDim.x) if ((p[i] & 0x7F80u) == 0x7F80u) ++c; if (c) atomicAdd(flag, c); }
__global__ void dbg_scan_f32(const unsigned* p, size_t n, unsigned* flag) { unsigned c = 0; for (size_t i = (size_t)blockIdx.x * blockDim.x + threadIdx.x; i < n; i += (size_t)gridDim.x * blockDim.x) if ((p[i] & 0x7F800000u) == 0x7F800000u) ++c; if (c) atomicAdd(flag, c); }
__global__ void dbg_scan_sel(const int* sel, const int* nsel, unsigned* flag) { unsigned c = 0; for (size_t i = (size_t)blockIdx.x * blockDim.x + threadIdx.x; i < (size_t)NTOK * 256; i += (size_t)gridDim.x * blockDim.x) { const int tok = (int)(i >> 8), j = (int)(i & 255), t = tok & (SEQ - 1); const int ns = nsel[tok]; if (j == 0 && ns != (t + 1 < 256 ? t + 1 : 256)) ++c; if (j < ns && (sel[i] < 0 || sel[i] > t)) ++c; } if (c) atomicAdd(flag, c); }
__global__ void dbg_scan_scores(const unsigned* p, unsigned* flag) { unsigned c = 0; for (size_t i = (size_t)blockIdx.x * blockDim.x + threadIdx.x; i < 2ull * SEQ * SEQ; i += (size_t)gridDim.x * blockDim.x) { const int s = (int)(i & (SEQ - 1)), t = (int)((i >> 13) & (SEQ - 1)); if (s <= t && (p[i] & 0x7F800000u) == 0x7F800000u) ++c; } if (c) atomicAdd(flag, c); }
__global__ void dbg_probe_bf16(const unsigned short* p, size_t n, unsigned* cnt, unsigned* minidx) { unsigned c = 0; unsigned mi = 0xFFFFFFFFu; for (size_t i = (size_t)blockIdx.x * blockDim.x + threadIdx.x; i < n; i += (size_t)gridDim.x * blockDim.x) if ((p[i] & 0x7F80u) == 0x7F80u) { ++c; if ((unsigned)i < mi) mi = (unsigned)i; } if (c) { atomicAdd(cnt, c); atomicMax(minidx, ~mi); } }
__global__ void dbg_final(float* out, size_t n, const unsigned* flags) { int code = 0; for (int k = 0; k < 32; ++k) if (flags[k] && !code) code = k + 1; const int mask = (flags[32] ? 1 : 0) | (flags[33] ? 2 : 0) | (flags[34] ? 4 : 0); if (mask) code = 20 + 5 * mask; if (!code) return; for (size_t i = (size_t)blockIdx.x * blockDim.x + threadIdx.x; i < n; i += (size_t)gridDim.x * blockDim.x) out[i] = (float)code; }
#endif
extern "C" void kernel_launch(void* const* d_in, const int* in_sizes, int n_in, void* d_out, int out_size, void* d_ws, size_t ws_size, hipStream_t stream) {
    static int grid = 0;
    if (grid == 0) {
        if (n_in != 25 || out_size != NTOK * DM || ws_size < WS_NEED) { fprintf(stderr, "kernel_launch: unexpected shapes (n_in %d out %d ws %zu need %zu)\n", n_in, out_size, ws_size, (size_t)WS_NEED); grid = -1; return; }
        int dev = 0, cus = 0, per_cu = 0;
        if (hipGetDevice(&dev) != hipSuccess || hipDeviceGetAttribute(&cus, hipDeviceAttributeMultiprocessorCount, dev) != hipSuccess) { grid = -1; return; }
        if (hipFuncSetAttribute((const void*)fwd, hipFuncAttributeMaxDynamicSharedMemorySize, LDS_BYTES) != hipSuccess) { fprintf(stderr, "kernel_launch: hipFuncSetAttribute failed\n"); grid = -1; return; }
        if (hipOccupancyMaxActiveBlocksPerMultiprocessor(&per_cu, (const void*)fwd, 512, LDS_BYTES) != hipSuccess || per_cu < 1) fprintf(stderr, "kernel_launch: occupancy query says %d\n", per_cu);
        (void)hipGetLastError();
        grid = cus;
    }
    if (grid < 0) return;
    unsigned char* ws = (unsigned char*)d_ws;
    hipMemsetAsync(ws + WS_CTL, 0, CTL_BYTES, stream);
    hipMemsetAsync(ws + W_UK2, 0, 8ull * 256 * 256 * 2 + 4ull * 256 * 512 * 2, stream);
    hipMemsetAsync(ws + W_IN + (size_t)INW * 2048 * 2, 0, (size_t)(INWP - INW) * 2048 * 2, stream);
    Params p{};
    for (int i = 0; i < 25; ++i) p.in[i] = (const float*)d_in[i];
    p.out = (float*)d_out; p.ws = ws;
#if PHASES_PER_LAUNCH == 0
    p.ph_lo = 0; p.ph_hi = NPHASE;
    hipLaunchKernelGGL(fwd, dim3(grid), dim3(512), LDS_BYTES, stream, p);
#else
    for (int k = 0; k < NPHASE; ++k) { p.ph_lo = k; p.ph_hi = k + 1; hipLaunchKernelGGL(fwd, dim3(grid), dim3(512), LDS_BYTES, stream, p);
#ifdef DEBUG_NAN
        unsigned* fl = (unsigned*)(ws + WS_CTL) + CW_FLAGS + k;
#define SB16(off, n) hipLaunchKernelGGL(dbg_scan_bf16, dim3(1024), dim3(256), 0, stream, (const unsigned short*)(ws + (off)), (size_t)(n), fl)
#define SF32(off, n) hipLaunchKernelGGL(dbg_scan_f32, dim3(1024), dim3(256), 0, stream, (const unsigned*)(ws + (off)), (size_t)(n), fl)
        if (k == 0) { SB16(WS_XB, (size_t)NTOK * DM); SB16(WS_PB, 2ull * NTOK * 256); SB16(WS_W, (W_END - WS_W) / 2); }
        else { const int kind = (k - 1) % 15;
            if (kind == 0) { SB16(R_QA, (size_t)NTOK * 1024); SB16(R_QIDX, (size_t)NTOK * 1024); SB16(R_QKV, 6ull * NTOK * 1024); SB16(R_GATES, (size_t)NTOK * 6144); SF32(R_SMALL, (size_t)NTOK * 512); }
            if (kind == 1) { SB16(R_QCAT, (size_t)NTOK * 2304); SB16(R_KCAT, (size_t)NTOK * 288); SB16(R_KI, (size_t)NTOK * 64); SB16(R_QIDX, (size_t)NTOK * 1024); SF32(R_WI, (size_t)NTOK * 16); SF32(WS_LF, 16ull * 8192); }
            if (kind == 2) { SF32(WS_CUM, 16ull * 8192); hipLaunchKernelGGL(dbg_scan_scores, dim3(1024), dim3(256), 0, stream, (const unsigned*)(ws + R_SCORES), fl); }
            if (kind == 3) { hipLaunchKernelGGL(dbg_scan_sel, dim3(1024), dim3(256), 0, stream, (const int*)(ws + R_SEL), (const int*)(ws + R_NSEL), fl); }
            if (k == 5) { unsigned* fl0 = fl; fl = (unsigned*)(ws + WS_CTL) + CW_FLAGS + 32; SB16(R_OLAT, (size_t)NTOK * 2048); fl += 1; SB16(R_OA, (size_t)NTOK * 3072); fl += 1; fl = fl0; hipLaunchKernelGGL(dbg_probe_bf16, dim3(1024), dim3(256), 0, stream, (const unsigned short*)(ws + R_OC), (size_t)NTOK * 1024, (unsigned*)(ws + WS_CTL) + CW_FLAGS + 40, (unsigned*)(ws + WS_CTL) + CW_FLAGS + 41); }
            if (kind == 5) { SB16(R_OA, (size_t)NTOK * 3072); }
            if (kind == 6) { SB16(R_MERGED, (size_t)NTOK * 2048); }
            if (kind == 7) { SF32(R_PRE1, (size_t)NTOK * 2048); }
            if (kind == 8) { SF32(M_X1F, (size_t)NTOK * 2048); SF32(M_TOKW, (size_t)NTOK * 4); }
            if (kind == 9) { SB16(M_PP, (size_t)NTOK * 2048); }
            if (kind == 12) { SF32(M_HF, (size_t)NTOK * 2048); }
            if (kind == 13) { SF32(M_X1F, (size_t)NTOK * 2048); }
            if (kind == 14) { hipLaunchKernelGGL(dbg_scan_f32, dim3(1024), dim3(256), 0, stream, (const unsigned*)d_out, (size_t)NTOK * DM, fl); if (k + 1 < NPHASE) SB16(WS_W, (W_END - WS_W) / 2); } }
#endif
    }
#ifdef DEBUG_NAN
    hipLaunchKernelGGL(dbg_final, dim3(1024), dim3(256), 0, stream, (float*)d_out, (size_t)NTOK * DM, (const unsigned*)(ws + WS_CTL) + CW_FLAGS);
#endif
#endif
}
```

```cpp
#include <hip/hip_runtime.h>
#include <stdint.h>
#include <stdio.h>
#include <math.h>

#ifndef PHASES_PER_LAUNCH
#define PHASES_PER_LAUNCH 0
#endif

#define LAS __attribute__((address_space(3)))
#define GAS __attribute__((address_space(1)))
#ifndef REP_MASK
#define REP_MASK 0
#endif
#define NREP(bit) (((REP_MASK) >> (bit)) & 1 ? 2 : 1)
typedef unsigned short bf16_t;
typedef short bf16x8 __attribute__((ext_vector_type(8)));
typedef short s16x4 __attribute__((ext_vector_type(4)));
typedef float f32x4 __attribute__((ext_vector_type(4)));
typedef float f32x16 __attribute__((ext_vector_type(16)));
typedef unsigned u32x4 __attribute__((ext_vector_type(4)));
typedef unsigned u32x2 __attribute__((ext_vector_type(2)));
typedef int i32x4 __attribute__((ext_vector_type(4)));

constexpr int NTOK = 16384, DM = 2048, SEQ = 8192, NB = 2, NLAYER = 2;
constexpr int INW = 14712, INWP = 14848;
constexpr int NEXP = 32, DEXP = 1024;
constexpr int PMAX = 65536 + 8192;
constexpr float ALPHA = 1.41421356237309515f;
constexpr float LOG2E = 1.4426950408889634f;
constexpr float SCALE = 0.08838834764831845f;
constexpr float C2 = LOG2E * SCALE;

constexpr size_t MiB = 1ull << 20;
constexpr size_t WS_CTL   = 0;
constexpr size_t WS_W     = 1 * MiB;
constexpr size_t W_IN     = WS_W;
constexpr size_t W_IN8    = W_IN   + 2048ull * 2048 * 2;
constexpr size_t W_UK2    = W_IN   + (size_t)INWP * 2048 * 2;
constexpr size_t W_UV2    = W_UK2  + 8ull * 256 * 256 * 2;
constexpr size_t W_BRA    = W_UV2  + 4ull * 256 * 512 * 2;
constexpr size_t W_BRB    = W_BRA  + 2048ull * 1024 * 2;
constexpr size_t W_BRC    = W_BRB  + 2048ull * 1024 * 2;
constexpr size_t W_OUT    = W_BRC  + 2048ull * 1024 * 2;
constexpr size_t W_PG     = W_OUT  + 2048ull * 2048 * 2;
constexpr size_t W_PLE    = W_PG   + 2048ull * 2048 * 2;
constexpr size_t W_GU     = W_PLE  + 2048ull * 256 * 2;
constexpr size_t W_DN     = W_GU   + 32ull * 2048 * 2048 * 2;
constexpr size_t W_END    = W_DN   + 32ull * 2048 * 1024 * 2;
constexpr size_t WS_XB    = (W_END + MiB - 1) / MiB * MiB;
constexpr size_t WS_PB    = WS_XB  + (size_t)NTOK * DM * 2;
constexpr size_t WS_CUM   = WS_PB  + 2ull * NTOK * 256 * 2;
constexpr size_t WS_LF    = WS_CUM + 16ull * 8192 * 4;
constexpr size_t WS_XQ    = WS_LF  + 16ull * 8192 * 4;
constexpr size_t WS_XSC   = WS_XQ  + (size_t)NTOK * DM;
constexpr size_t WS_R     = (WS_XSC + (size_t)NTOK * 4 + MiB - 1) / MiB * MiB;
constexpr size_t R_SCORES = WS_R;
constexpr size_t R_OLAT   = WS_R;
constexpr size_t R_OA     = WS_R + 64 * MiB;
constexpr size_t R_OB     = WS_R + 96 * MiB;
constexpr size_t R_OC     = WS_R + 128 * MiB;
constexpr size_t R_TMP    = WS_R + 160 * MiB;
constexpr size_t R_MERGED = WS_R + 288 * MiB;
constexpr size_t R_PRE1   = WS_R + 384 * MiB;
constexpr size_t R_QA     = WS_R + 512 * MiB;
constexpr size_t R_QIDX   = WS_R + 544 * MiB;
constexpr size_t R_QKV    = WS_R + 576 * MiB;
constexpr size_t R_GATES  = WS_R + 768 * MiB;
constexpr size_t R_SMALL  = WS_R + 960 * MiB;
constexpr size_t R_QCAT   = WS_R + 992 * MiB;
constexpr size_t R_KCAT   = WS_R + 1064 * MiB;
constexpr size_t R_KI     = WS_R + 1073 * MiB;
constexpr size_t R_WI     = WS_R + 1075 * MiB;
constexpr size_t R_SEL    = WS_R + 1076 * MiB;
constexpr size_t R_NSEL   = WS_R + 1092 * MiB;
constexpr size_t R_END    = WS_R + 1093 * MiB;
constexpr size_t M_XS     = WS_R;
constexpr size_t M_HID    = WS_R + 288 * MiB;
constexpr size_t M_PP     = WS_R + 432 * MiB;
constexpr size_t M_X1F    = WS_R + 512 * MiB;
constexpr size_t M_X1B    = WS_R + 640 * MiB;
constexpr size_t M_HF     = WS_R + 704 * MiB;
constexpr size_t M_HQ     = WS_R + 704 * MiB;
constexpr size_t M_HSC    = WS_R + 736 * MiB;
constexpr size_t M_HB     = WS_R + 832 * MiB;
constexpr size_t M_TOKE   = WS_R + 896 * MiB;
constexpr size_t M_TOKPOS = M_TOKE + (size_t)NTOK * 16;
constexpr size_t M_TOKW   = M_TOKPOS + (size_t)NTOK * 16;
constexpr size_t M_TOKDST = M_TOKW + (size_t)NTOK * 16;
constexpr size_t M_ROWW   = M_TOKDST + (size_t)NTOK * 16;
constexpr size_t M_ROWSX  = M_ROWW + (size_t)PMAX * 4;
constexpr size_t M_X1S    = M_ROWSX + (size_t)PMAX * 4;
constexpr size_t M_X1Q    = WS_R + 900 * MiB;
constexpr size_t M_ROWTOK = WS_R + 750 * MiB;
constexpr size_t M_HM     = WS_R + 740 * MiB;
constexpr size_t M_H8     = WS_R + 752 * MiB;
constexpr size_t M_H8S    = WS_R + 826 * MiB;
constexpr size_t WS_NEED  = R_END;
constexpr int CW_BAR = 0;
constexpr int CW_CNT = 8192;
constexpr int CW_META = 4096 + 64;
constexpr int CW_QCTR = 6144;
constexpr int CW_WMAX = 6272;
constexpr int CW_WMAXG = 6336;
constexpr int CW_WMAXP = 6368;
constexpr int CW_WMAXD = 6384;
constexpr int CW_KMAX = 6400;
constexpr size_t CTL_BYTES = 65536;

constexpr int LDS_BYTES = 152576;
constexpr int LDS_MISC = 151552;

typedef float f32x2 __attribute__((ext_vector_type(2)));
typedef __bf16 bf16n2 __attribute__((ext_vector_type(2)));
__device__ __forceinline__ unsigned cvtpk(float lo, float hi) { f32x2 v = {lo, hi}; bf16n2 b = __builtin_convertvector(v, bf16n2); return __builtin_bit_cast(unsigned, b); }
__device__ __forceinline__ bf16_t f2bf(float x) { return (bf16_t)(cvtpk(x, 0.f) & 0xffffu); }
__device__ __forceinline__ float bf2f(bf16_t b) { return __uint_as_float(((unsigned)b) << 16); }
__device__ __forceinline__ float bflo(unsigned w) { return __uint_as_float(w << 16); }
__device__ __forceinline__ float bfhi(unsigned w) { return __uint_as_float(w & 0xffff0000u); }
__device__ __forceinline__ bf16x8 pack8(f32x4 a, f32x4 b) { u32x4 w = {cvtpk(a[0], a[1]), cvtpk(a[2], a[3]), cvtpk(b[0], b[1]), cvtpk(b[2], b[3])}; return *reinterpret_cast<bf16x8*>(&w); }
__device__ __forceinline__ float sigmoidf_(float x) { return 1.0f / (1.0f + __expf(-x)); }
__device__ __forceinline__ float wave_sum(float v) { for (int o = 32; o > 0; o >>= 1) v += __shfl_xor(v, o); return v; }
__device__ __forceinline__ int crow(int r, int hi) { return (r & 3) + 8 * (r >> 2) + 4 * hi; }
#define SBAR() __builtin_amdgcn_sched_barrier(0)

#define XB_TMO      128
#define XB_XCNT(j)  (256  + 64 * (j))
#define XB_XSUB(j)  (1280 + 64 * (j))
#define XB_XGEN(j)  (2304 + 64 * (j))
#define XB_TOP      3328
#define XB_TOPGEN   3392
#define XCD_BAR_WORDS 3456
#define XB_SPIN_CAP (1u << 22)
__device__ __forceinline__ unsigned xb_ld(unsigned* p)              { return __hip_atomic_load(p, __ATOMIC_RELAXED, __HIP_MEMORY_SCOPE_AGENT); }
__device__ __forceinline__ unsigned xb_add(unsigned* p, unsigned v) { return __hip_atomic_fetch_add(p, v, __ATOMIC_RELAXED, __HIP_MEMORY_SCOPE_AGENT); }
__device__ __forceinline__ unsigned xb_xcc_id() { return (unsigned)__builtin_amdgcn_s_getreg((3 << 11) | 20) & 0xFu; }
#define XB_SPIN(cond, bar) do { unsigned _sp = 0; while (cond) { __builtin_amdgcn_s_sleep(1); \
    if ((++_sp & 255u) == 0u) { if (xb_ld(&(bar)[XB_TMO])) break; if (_sp > XB_SPIN_CAP) { atomicAdd(&(bar)[XB_TMO], 1u); break; } } } } while (0)
struct XcdBarrier { unsigned* bar; unsigned x; volatile LAS unsigned* st; };
__device__ __forceinline__ XcdBarrier xcd_barrier_post(unsigned* bar, volatile LAS unsigned* st) {
    XcdBarrier b; b.bar = bar; b.x = xb_xcc_id(); b.st = st;
    if (threadIdx.x == 0) (void)xb_add(&bar[XB_XCNT(b.x)], 1u);
    return b;
}
__device__ __forceinline__ void xcd_barrier_complete(unsigned* bar, unsigned x, unsigned& nloc, unsigned& nx) {
    const unsigned G = gridDim.x * gridDim.y * gridDim.z;
    unsigned sum, cnt, mine, sp = 0u;
    for (;;) {
        sum = 0u; cnt = 0u; mine = 0u;
#pragma unroll
        for (unsigned j = 0; j < 16; ++j) { const unsigned c = xb_ld(&bar[XB_XCNT(j)]); sum += c; cnt += (c > 0u) ? 1u : 0u; mine = (j == x) ? c : mine; }
        if (sum == G) break;
        __builtin_amdgcn_s_sleep(1);
        if ((++sp & 255u) == 0u) { if (xb_ld(&bar[XB_TMO])) break; if (sp > XB_SPIN_CAP) { atomicAdd(&bar[XB_TMO], 1u); break; } }
    }
    nloc = mine > 0u ? mine : 1u; nx = cnt > 0u ? cnt : 1u;
}
__device__ __forceinline__ void xcd_barrier(const XcdBarrier& b) {
    asm volatile("s_waitcnt vmcnt(0)" ::: "memory");
    __syncthreads();
    if (threadIdx.x == 0) {
        unsigned* bar = b.bar;
        __builtin_amdgcn_s_waitcnt(0);
        unsigned nloc = b.st[0], nx = b.st[1];
        if (nloc == 0u) { xcd_barrier_complete(bar, b.x, nloc, nx); b.st[0] = nloc; b.st[1] = nx; }
        const unsigned old = xb_add(&bar[XB_XSUB(b.x)], 1u);
        const unsigned gen = old / nloc;
        if (old + 1u == (gen + 1u) * nloc) {
            __builtin_amdgcn_fence(__ATOMIC_RELEASE, "agent");
            asm volatile("s_waitcnt vmcnt(0)" ::: "memory");
            const unsigned og = xb_add(&bar[XB_TOP], 1u);
            const unsigned tg = og / nx;
            if (og + 1u == (tg + 1u) * nx) xb_add(&bar[XB_TOPGEN], 1u);
            else XB_SPIN(xb_ld(&bar[XB_TOPGEN]) == tg, bar);
            __builtin_amdgcn_fence(__ATOMIC_ACQUIRE, "agent");
            xb_add(&bar[XB_XGEN(b.x)], 1u);
            asm volatile("s_waitcnt vmcnt(0)" ::: "memory");
        } else {
            XB_SPIN(xb_ld(&bar[XB_XGEN(b.x)]) == gen, bar);
            __builtin_amdgcn_fence(__ATOMIC_ACQUIRE, "agent");
            asm volatile("s_waitcnt vmcnt(0)" ::: "memory");
        }
    }
    __syncthreads();
}

namespace pg8 {
constexpr int BM = 256, BK = 64, HALF = 128, HTB = HALF * BK * 2, STAGE_BYTES = 8 * HTB, NXCD = 8, WGM = 8;
__device__ __forceinline__ int lds_byte(int r, int c) { const int st = (r >> 4) * 2 + (c >> 5), rr = r & 15, cc = c & 31, ob = rr * 64 + cc * 2; return st * 1024 + (ob ^ (((ob >> 9) & 1) << 5)); }
__device__ __forceinline__ void stage_rc(int b, int& R, int& C) { const int st = b / 1024, sb = b % 1024, swz = sb ^ (((sb >> 9) & 1) << 5); R = (st >> 1) * 16 + swz / 64; C = (st & 1) * 32 + (swz % 64) / 2; }
__device__ __forceinline__ int perm32(int rho) { const int n = rho >> 4, i = rho & 15; return 8 * (i >> 2) + 4 * n + (i & 3); }
struct Unit { int pm, pn, e; };
struct SchedS {
    static constexpr bool GATHER = false;
    int nM, nN, nwg, G, c; const bf16_t* A; const bf16_t* B; int lda, ldb, a_sh, a_mul, skip_from = 1 << 30, skip_by = 0, skip_from2 = 1 << 30, skip_by2 = 0, b_compact = 0, cut = 1 << 30, extra_n = 0, extra_c = -1;
    __device__ void init(int M, int N, int G_, int c_, const bf16_t* A_, int lda_, const bf16_t* B_, int ldb_, int a_sh_ = 0, int a_mul_ = 0) {
        nM = M / BM; nN = N / BM; nwg = nM * nN; G = G_; c = c_; A = A_; B = B_; lda = lda_; ldb = ldb_; a_sh = a_sh_; a_mul = a_mul_; }
    __device__ __forceinline__ bool next(int i, Unit& u) const {
        long L = (long)i * G + c; if (i >= cut) { const int j = i - cut; if (extra_c < 0 || j >= 2) return false; L = (long)cut * G + (long)j * extra_n + extra_c; }
        if (L >= nwg) return false;
        int wgid = (int)L; { const int q = nwg / NXCD, r = nwg % NXCD, xcd = wgid % NXCD, off = wgid / NXCD; wgid = (xcd < r ? xcd * (q + 1) : r * (q + 1) + (xcd - r) * q) + off; }
        const int nig = WGM * nN, gid = wgid / nig, fm = gid * WGM, gsz = (nM - fm) < WGM ? (nM - fm) : WGM;
        u.pm = fm + ((wgid % nig) % gsz); u.pn = (wgid % nig) / gsz; u.e = 0;
        u.e = u.pn;
        { const int ci = u.pn; if (ci >= skip_from) u.pn += skip_by; if (ci >= skip_from2) u.pn += skip_by2; }
        return true;
    }
    __device__ __forceinline__ const char* pa(const Unit& u) const { return (const char*)(A + (size_t)u.pm * BM * lda + (size_t)((u.pn >> a_sh) * a_mul)); }
    __device__ __forceinline__ const char* pb(const Unit& u) const { return (const char*)(B + (size_t)(b_compact ? u.e : u.pn) * BM * ldb); }
};
struct SchedM {
    static constexpr bool GATHER = false;
    int ntiles, G, c; const bf16_t* A; const bf16_t* W; int lda, ldb; const unsigned* tile_e;
    __device__ void init(const unsigned* meta, int G_, int c_, const bf16_t* A_, int lda_, const bf16_t* W_, int ldb_) {
        ntiles = (int)meta[0]; tile_e = meta + 1; G = G_; c = c_; A = A_; W = W_; lda = lda_; ldb = ldb_; }
    __device__ __forceinline__ bool next(int i, Unit& u) const {
        const long L = (long)i * G + c; if (L >= (long)ntiles * 8) return false;
        u.pm = (int)(L >> 3); u.pn = (int)(L & 7); u.e = (int)tile_e[u.pm];
        return true;
    }
    __device__ __forceinline__ const char* pa(const Unit& u) const { return (const char*)(A + (size_t)u.pm * BM * lda); }
    __device__ __forceinline__ const char* pb(const Unit& u) const { return (const char*)(W + ((size_t)u.e * 2048 + (size_t)u.pn * BM) * ldb); }
};

constexpr int GTAB_OFF = 131072;
struct SchedMG {
    static constexpr bool GATHER = true;
    int ntiles, G, c; const bf16_t* A; const bf16_t* W; int lda, ldb; const unsigned* tile_e;
    __device__ __forceinline__ void init(const unsigned* meta, int G_, int c_, const bf16_t* A_, int lda_, const bf16_t* W_, int ldb_) {
        ntiles = (int)meta[0]; tile_e = meta + 1; G = G_; c = c_; A = A_; W = W_; lda = lda_; ldb = ldb_; }
    __device__ __forceinline__ bool next(int i, Unit& u) const {
        const long L = (long)i * G + c; if (L >= (long)ntiles * 8) return false;
        u.pm = (int)(L >> 3); u.pn = (int)(L & 7); u.e = (int)tile_e[u.pm];
        return true;
    }
    __device__ __forceinline__ const char* pa(const Unit& u) const { return (const char*)A; }
    __device__ __forceinline__ const char* pb(const Unit& u) const { return (const char*)(W + ((size_t)u.e * 2048 + (size_t)u.pn * BM) * ldb); }
};

template <class Epi, class Sched>
__device__ __forceinline__ void gemm_phase(LAS unsigned char* lds, const int K, const int lda, const int ldb, const Sched& S, const Epi& E) {
    int tid = threadIdx.x; asm volatile("" : "+v"(tid));
    const int wid = __builtin_amdgcn_readfirstlane(tid >> 6), lane = tid & 63, wr = wid >> 2, wc = wid & 3, fr = lane & 15, fq = lane >> 4;
    const int nt = K / BK;
    constexpr bool GA = Sched::GATHER;
    unsigned voffA[2], voffB[2]; int gR[2]; unsigned gC[2];
#pragma unroll
    for (int i = 0; i < 2; ++i) { int R, C; stage_rc(tid * 16 + i * 8192, R, C); const int Rb = (R & ~31) + perm32(R & 31);
        voffA[i] = (unsigned)(R * lda + C) * 2u; voffB[i] = (unsigned)(Rb * ldb + C) * 2u; gR[i] = R; gC[i] = (unsigned)C * 2u; }
    unsigned gv[2][2] = {{0u, 0u}, {0u, 0u}}, gn[2][2] = {{0u, 0u}, {0u, 0u}};
    LAS const unsigned* gtab = (LAS const unsigned*)(lds + GTAB_OFF);
#define PG8_GLOAD(dst, uidx) do { _Pragma("unroll") for (int h_ = 0; h_ < 2; ++h_) _Pragma("unroll") for (int i_ = 0; i_ < 2; ++i_) dst[h_][i_] = gtab[(uidx) * 256 + h_ * 128 + gR[i_]] + gC[i_]; } while (0)
#define PG8_STAGE_A(bufoff, ptr, h, nx) do { if constexpr (GA) { unsigned vo_[2] = {(nx) ? gn[h][0] : gv[h][0], (nx) ? gn[h][1] : gv[h][1]}; PG8_STAGE(bufoff, ptr, vo_); } \
        else { PG8_STAGE(bufoff, (ptr) + (h) * hstepA, voffA); } } while (0)
    const size_t kstep = (size_t)(BK * 2);
    const size_t hstepA = (size_t)HALF * lda * 2, hstepB = (size_t)HALF * ldb * 2;
    const unsigned ldsw = (unsigned)wid * 1024u;
    const int aoff = lds_byte(wr * 64 + fr, fq * 8), boff = lds_byte(wc * 32 + fr, fq * 8);
#define PG8_SA(b, h) (((b) * 2 + (h)) * HTB)
#define PG8_SB(b, h) ((4 + (b) * 2 + (h)) * HTB)
#define PG8_STAGE(bufoff, gbase, voff) do { _Pragma("unroll") for (int _i = 0; _i < 2; ++_i) \
        __builtin_amdgcn_global_load_lds((const unsigned*)((const char*)(gbase) + (voff)[_i]), (LAS unsigned*)(lds + (bufoff) + ldsw + _i * 8192), 16, 0, 0); } while (0)
#define PG8_LDA(dst, b, h) do { _Pragma("unroll") for (int m = 0; m < 4; ++m) _Pragma("unroll") for (int k = 0; k < 2; ++k) dst[m][k] = *(const LAS bf16x8*)(lds + PG8_SA(b, h) + aoff + m * 2048 + k * 1024); } while (0)
#define PG8_LDB(dst, b, h) do { _Pragma("unroll") for (int n = 0; n < 2; ++n) _Pragma("unroll") for (int k = 0; k < 2; ++k) dst[n][k] = *(const LAS bf16x8*)(lds + PG8_SB(b, h) + boff + n * 2048 + k * 1024); } while (0)
#define PG8_MMA(ai, bj, At, Bt) do { __builtin_amdgcn_s_setprio(1); _Pragma("unroll") for (int m = 0; m < 4; ++m) _Pragma("unroll") for (int n = 0; n < 2; ++n) _Pragma("unroll") for (int k = 0; k < 2; ++k) \
        { if constexpr (Epi::I8) acc[ai][bj][m][n] = __builtin_bit_cast(f32x4, __builtin_amdgcn_mfma_i32_16x16x64_i8(__builtin_bit_cast(i32x4, Bt[n][k]), __builtin_bit_cast(i32x4, At[m][k]), __builtin_bit_cast(i32x4, acc[ai][bj][m][n]), 0, 0, 0)); \
          else acc[ai][bj][m][n] = __builtin_amdgcn_mfma_f32_16x16x32_bf16(Bt[n][k], At[m][k], acc[ai][bj][m][n], 0, 0, 0); } __builtin_amdgcn_s_setprio(0); } while (0)
#define PG8_WAIT_V(n) asm volatile("s_waitcnt vmcnt(" #n ")" ::: "memory")
#define PG8_WAIT_L(n) asm volatile("s_waitcnt lgkmcnt(" #n ")" ::: "memory")
#define PG8_BAR __builtin_amdgcn_s_barrier()
#define PG8_SCHED __builtin_amdgcn_sched_barrier(0)
    Unit cur, nxt; int ui = 0;
    if (!S.next(0, cur)) return;
    f32x4 acc[2][2][4][2];
#pragma unroll
    for (int a = 0; a < 2; ++a)
#pragma unroll
        for (int b = 0; b < 2; ++b)
#pragma unroll
            for (int m = 0; m < 4; ++m)
#pragma unroll
                for (int n = 0; n < 2; ++n) acc[a][b][m][n] = (f32x4){0.f, 0.f, 0.f, 0.f};
    bf16x8 At[4][2], B0[2][2], B1[2][2];
    const char* cA = S.pa(cur); const char* cB = S.pb(cur);
    if constexpr (GA) { PG8_GLOAD(gv, 0); }
    PG8_STAGE(PG8_SB(0, 0), cB, voffB); PG8_STAGE_A(PG8_SA(0, 0), cA, 0, false); PG8_STAGE(PG8_SB(0, 1), cB + hstepB, voffB); PG8_STAGE_A(PG8_SA(0, 1), cA, 1, false);
    if (wr == 1) PG8_BAR;
    PG8_WAIT_V(4); PG8_BAR;
    PG8_STAGE(PG8_SB(1, 0), cB + kstep, voffB); PG8_STAGE_A(PG8_SA(1, 0), cA + kstep, 0, false); PG8_STAGE(PG8_SB(1, 1), cB + hstepB + kstep, voffB);
    PG8_WAIT_V(6); PG8_BAR;
    for (;;) {
        const bool has_next = S.next(ui + 1, nxt);
        const char* nA = has_next ? S.pa(nxt) : cA; const char* nB = has_next ? S.pb(nxt) : cB;
        if constexpr (GA) { if (has_next) { PG8_GLOAD(gn, ui + 1); } else {
#pragma unroll
                for (int h_ = 0; h_ < 2; ++h_) { gn[h_][0] = gv[h_][0]; gn[h_][1] = gv[h_][1]; } }
            asm volatile("" : "+v"(gn[0][0]), "+v"(gn[0][1]), "+v"(gn[1][0]), "+v"(gn[1][1])); }
        for (int t = 0; t < nt; t += 2) {
            const bool last = (t == nt - 2);
            if constexpr (Epi::HAS_MID) { if (t == Epi::MID1 || t == Epi::MID2) { int frM = fr, fqM = fq; asm volatile("" : "+v"(frM), "+v"(fqM)); E.mid(acc, cur, t, wr, wc, frM, fqM); } }
            const char* a1 = cA + (size_t)(t + 1) * kstep;
            const char* a2 = last ? nA : cA + (size_t)(t + 2) * kstep; const char* b2 = last ? nB : cB + (size_t)(t + 2) * kstep;
            const char* a3 = a2 + kstep; const char* b3 = b2 + kstep;
            PG8_LDB(B0, 0, 0); PG8_SCHED; PG8_LDA(At, 0, 0); PG8_STAGE_A(PG8_SA(1, 1), a1, 1, false);
            PG8_WAIT_L(8); PG8_BAR; PG8_WAIT_L(0); PG8_MMA(0, 0, At, B0); PG8_BAR; PG8_SCHED;
            PG8_LDB(B1, 0, 1); PG8_STAGE(PG8_SB(0, 0), b2, voffB);
            PG8_BAR; PG8_WAIT_L(0); PG8_MMA(0, 1, At, B1); PG8_BAR;
            PG8_LDA(At, 0, 1); PG8_STAGE_A(PG8_SA(0, 0), a2, 0, last);
            PG8_BAR; PG8_WAIT_L(0); PG8_MMA(1, 0, At, B0); PG8_BAR; PG8_SCHED;
            PG8_STAGE(PG8_SB(0, 1), b2 + hstepB, voffB);
            PG8_WAIT_V(6); PG8_BAR; PG8_MMA(1, 1, At, B1); PG8_BAR;
            PG8_LDB(B0, 1, 0); PG8_SCHED; PG8_LDA(At, 1, 0); PG8_STAGE_A(PG8_SA(0, 1), a2, 1, last);
            PG8_WAIT_L(8); PG8_BAR; PG8_WAIT_L(0); PG8_MMA(0, 0, At, B0); PG8_BAR; PG8_SCHED;
            PG8_LDB(B1, 1, 1); PG8_STAGE(PG8_SB(1, 0), b3, voffB);
            PG8_BAR; PG8_WAIT_L(0); PG8_MMA(0, 1, At, B1); PG8_BAR;
            PG8_LDA(At, 1, 1); PG8_STAGE_A(PG8_SA(1, 0), a3, 0, last);
            PG8_BAR; PG8_WAIT_L(0); PG8_MMA(1, 0, At, B0); PG8_BAR; PG8_SCHED;
            PG8_STAGE(PG8_SB(1, 1), b3 + hstepB, voffB);
            PG8_WAIT_V(6); PG8_BAR; PG8_MMA(1, 1, At, B1); PG8_BAR;
        }
        { int frE = fr, fqE = fq; asm volatile("" : "+v"(frE), "+v"(fqE)); E(acc, cur, wr, wc, frE, fqE); }
        if (!has_next) break;
#pragma unroll
        for (int a = 0; a < 2; ++a)
#pragma unroll
            for (int b = 0; b < 2; ++b)
#pragma unroll
                for (int m = 0; m < 4; ++m)
#pragma unroll
                    for (int n = 0; n < 2; ++n) acc[a][b][m][n] = (f32x4){0.f, 0.f, 0.f, 0.f};
        cur = nxt; cA = nA; cB = nB; ++ui;
        if constexpr (GA) {
#pragma unroll
            for (int h_ = 0; h_ < 2; ++h_) { gv[h_][0] = gn[h_][0]; gv[h_][1] = gn[h_][1]; } }
    }
    PG8_WAIT_V(0);
    if (wr == 0) PG8_BAR;
    PG8_BAR;
#undef PG8_SA
#undef PG8_SB
#undef PG8_STAGE
#undef PG8_STAGE_A
#undef PG8_GLOAD
#undef PG8_LDA
#undef PG8_LDB
#undef PG8_MMA
#undef PG8_WAIT_V
#undef PG8_WAIT_L
#undef PG8_BAR
#undef PG8_SCHED
}

#define EPI_LOOP_ROWS _Pragma("unroll") for (int ai = 0; ai < 2; ++ai) _Pragma("unroll") for (int m = 0; m < 4; ++m)
__device__ __forceinline__ void st_bf16x8(bf16_t* p, f32x4 v0, f32x4 v1) { u32x4 w; w.x = cvtpk(v0[0], v0[1]); w.y = cvtpk(v0[2], v0[3]); w.z = cvtpk(v1[0], v1[1]); w.w = cvtpk(v1[2], v1[3]); *(u32x4*)p = w; }

template <bool I8_> struct EpiInProj {
    static constexpr bool HAS_MID = false; static constexpr bool I8 = I8_;
    bf16_t* qa; bf16_t* qidx; bf16_t* qkv; bf16_t* gates; float* small_; const float* xs; const unsigned* wmaxbits;
    __device__ __forceinline__ f32x4 val(const f32x4& a, float sc) const { if constexpr (I8_) { const i32x4 v = __builtin_bit_cast(i32x4, a); return (f32x4){(float)v[0], (float)v[1], (float)v[2], (float)v[3]} * sc; } else return a; }
    __device__ __forceinline__ void operator()(const f32x4 (&acc)[2][2][4][2], const Unit& u, int wr, int wc, int fr, int fq) const {
        const int pn = u.pn, row0 = u.pm * BM + wr * 64 + fr, lc0 = wc * 32 + fq * 8;
        float sw = 0.f; if constexpr (I8_) sw = __uint_as_float(*wmaxbits) * (1.3f / 127.0f);
        float scs[2][4];
#pragma unroll
        for (int ai = 0; ai < 2; ++ai)
#pragma unroll
            for (int m = 0; m < 4; ++m) { scs[ai][m] = 0.f; if constexpr (I8_) scs[ai][m] = xs[row0 + ai * HALF + m * 16] * sw; }
        if (pn < 8) {
            bf16_t* base = (pn < 4 ? qa + pn * 256 : qidx + (pn - 4) * 256) + lc0;
            EPI_LOOP_ROWS { const int row = row0 + ai * HALF + m * 16; const float sc = scs[ai][m];
#pragma unroll
                for (int bj = 0; bj < 2; ++bj) st_bf16x8(base + (size_t)row * 1024 + bj * HALF, val(acc[ai][bj][m][0], sc), val(acc[ai][bj][m][1], sc)); }
        } else if (pn < 32) {
            const int id = (pn - 8) >> 2, hb = ((pn - 8) & 3) * 2, b = u.pm >> 5;
            bf16_t* base = qkv + (size_t)id * ((size_t)NTOK * 1024) + lc0;
            EPI_LOOP_ROWS { const int row = row0 + ai * HALF + m * 16, s = row & (SEQ - 1); const float sc = scs[ai][m];
#pragma unroll
                for (int bj = 0; bj < 2; ++bj) st_bf16x8(base + ((size_t)(b * 8 + hb + bj) * SEQ + s) * 128, val(acc[ai][bj][m][0], sc), val(acc[ai][bj][m][1], sc)); }
        } else if (pn < 56) {
            unsigned char* base = (unsigned char*)gates + (pn - 32) * 256 + lc0;
            EPI_LOOP_ROWS { const int row = row0 + ai * HALF + m * 16; const float sc = scs[ai][m];
#pragma unroll
                for (int bj = 0; bj < 2; ++bj) { const f32x4 v0 = val(acc[ai][bj][m][0], sc), v1 = val(acc[ai][bj][m][1], sc); u32x2 w; unsigned p0 = 0u, p1 = 0u;
#pragma unroll
                    for (int j = 0; j < 4; ++j) { p0 |= (unsigned)(int)fmaxf(rintf(255.0f * sigmoidf_(v0[j])), 1.0f) << (8 * j); p1 |= (unsigned)(int)fmaxf(rintf(255.0f * sigmoidf_(v1[j])), 1.0f) << (8 * j); }
                    w.x = p0; w.y = p1; *(u32x2*)(base + (size_t)row * 6144 + bj * HALF) = w; } }
        } else {
            float* base = small_ + (pn - 56) * 256 + lc0;
            EPI_LOOP_ROWS { const int row = row0 + ai * HALF + m * 16; const float sc = scs[ai][m];
#pragma unroll
                for (int bj = 0; bj < 2; ++bj) { float* p = base + (size_t)row * 512 + bj * HALF; *(f32x4*)p = val(acc[ai][bj][m][0], sc); *(f32x4*)(p + 4) = val(acc[ai][bj][m][1], sc); } }
        }
    }
};
struct EpiBf16 {
    static constexpr bool HAS_MID = false; static constexpr bool I8 = false;
    bf16_t* out; int ld, cstep;
    __device__ __forceinline__ void operator()(const f32x4 (&acc)[2][2][4][2], const Unit& u, int wr, int wc, int fr, int fq) const {
        const int row0 = u.pm * BM + wr * 64 + fr; bf16_t* base = out + (size_t)u.pn * cstep + wc * 32 + fq * 8;
        EPI_LOOP_ROWS { const int row = row0 + ai * HALF + m * 16;
#pragma unroll
            for (int bj = 0; bj < 2; ++bj) st_bf16x8(base + (size_t)row * ld + bj * HALF, acc[ai][bj][m][0], acc[ai][bj][m][1]); }
    }
};
struct EpiBranch3 {
    static constexpr bool HAS_MID = true; static constexpr bool I8 = false; static constexpr int MID1 = 16, MID2 = 32;
    const unsigned char* gates; bf16_t* merged;
    __device__ __forceinline__ static f32x4 rat(unsigned n, unsigned d) {
        f32x4 r; r[0] = (float)(n & 255u) * __builtin_amdgcn_rcpf((float)(d & 255u)); r[1] = (float)((n >> 8) & 255u) * __builtin_amdgcn_rcpf((float)((d >> 8) & 255u));
        r[2] = (float)((n >> 16) & 255u) * __builtin_amdgcn_rcpf((float)((d >> 16) & 255u)); r[3] = (float)(n >> 24) * __builtin_amdgcn_rcpf((float)(d >> 24)); return r; }
    __device__ __forceinline__ void mid(f32x4 (&acc)[2][2][4][2], const Unit& u, int t, int wr, int wc, int fr, int fq) const {
        const int row0 = u.pm * BM + wr * 64 + fr, col0 = u.pn * BM + wc * 32 + fq * 8, bn = (t == MID1) ? 0 : 2048;
        u32x2 gn[2][4][2], gd[2][4][2];
        EPI_LOOP_ROWS {
#pragma unroll
            for (int bj = 0; bj < 2; ++bj) { const unsigned char* gp = gates + (size_t)(row0 + ai * HALF + m * 16) * 6144 + bn + col0 + bj * HALF; gn[ai][m][bj] = *(const u32x2*)gp; gd[ai][m][bj] = *(const u32x2*)(gp + 2048); } }
        EPI_LOOP_ROWS {
#pragma unroll
            for (int bj = 0; bj < 2; ++bj) { acc[ai][bj][m][0] *= rat(gn[ai][m][bj].x, gd[ai][m][bj].x); acc[ai][bj][m][1] *= rat(gn[ai][m][bj].y, gd[ai][m][bj].y); } }
    }
    __device__ __forceinline__ void operator()(const f32x4 (&acc)[2][2][4][2], const Unit& u, int wr, int wc, int fr, int fq) const {
        const int row0 = u.pm * BM + wr * 64 + fr, col0 = u.pn * BM + wc * 32 + fq * 8;
        u32x2 gl[2][4][2];
        EPI_LOOP_ROWS {
#pragma unroll
            for (int bj = 0; bj < 2; ++bj) gl[ai][m][bj] = *(const u32x2*)(gates + (size_t)(row0 + ai * HALF + m * 16) * 6144 + 4096 + col0 + bj * HALF); }
        EPI_LOOP_ROWS { const int row = row0 + ai * HALF + m * 16;
#pragma unroll
            for (int bj = 0; bj < 2; ++bj) { const int col = col0 + bj * HALF; const u32x2 gw = gl[ai][m][bj]; constexpr float I255 = 1.0f / 255.0f;
                f32x4 v0 = acc[ai][bj][m][0], v1 = acc[ai][bj][m][1];
                v0[0] *= (float)(gw.x & 255u) * I255; v0[1] *= (float)((gw.x >> 8) & 255u) * I255; v0[2] *= (float)((gw.x >> 16) & 255u) * I255; v0[3] *= (float)(gw.x >> 24) * I255;
                v1[0] *= (float)(gw.y & 255u) * I255; v1[1] *= (float)((gw.y >> 8) & 255u) * I255; v1[2] *= (float)((gw.y >> 16) & 255u) * I255; v1[3] *= (float)(gw.y >> 24) * I255;
                st_bf16x8(merged + (size_t)row * 2048 + col, v0, v1); } }
    }
};
struct EpiOut {
    static constexpr bool HAS_MID = false; static constexpr bool I8 = false;
    const bf16_t* res; bf16_t* pre;
    __device__ __forceinline__ void operator()(const f32x4 (&acc)[2][2][4][2], const Unit& u, int wr, int wc, int fr, int fq) const {
        const int row0 = u.pm * BM + wr * 64 + fr, col0 = u.pn * BM + wc * 32 + fq * 8;
        u32x4 rl[2][4][2];
        EPI_LOOP_ROWS { const int row = row0 + ai * HALF + m * 16;
#pragma unroll
            for (int bj = 0; bj < 2; ++bj) rl[ai][m][bj] = *(const u32x4*)(res + (size_t)row * 2048 + col0 + bj * HALF); }
        EPI_LOOP_ROWS { const int row = row0 + ai * HALF + m * 16;
#pragma unroll
            for (int bj = 0; bj < 2; ++bj) { const size_t o = (size_t)row * 2048 + col0 + bj * HALF;
                const u32x4 rw = rl[ai][m][bj]; f32x4 v0 = acc[ai][bj][m][0], v1 = acc[ai][bj][m][1];
                v0[0] += ALPHA * bflo(rw.x); v0[1] += ALPHA * bfhi(rw.x); v0[2] += ALPHA * bflo(rw.y); v0[3] += ALPHA * bfhi(rw.y);
                v1[0] += ALPHA * bflo(rw.z); v1[1] += ALPHA * bfhi(rw.z); v1[2] += ALPHA * bflo(rw.w); v1[3] += ALPHA * bfhi(rw.w);
                st_bf16x8(pre + o, v0, v1); } }
    }
};
struct EpiGateUpI8 {
    static constexpr bool HAS_MID = false; static constexpr bool I8 = true;
    const float* bg; const float* bu; bf16_t* hid; const float* rowsx; const unsigned* wmaxbits; float* hm;
    __device__ __forceinline__ void operator()(const f32x4 (&acc)[2][2][4][2], const Unit& u, int wr, int wc, int fr, int fq) const {
        const int row0 = u.pm * BM + wr * 64 + fr, j0 = u.pn * 128 + wc * 32 + fq * 8;
        const float sw = __uint_as_float(*wmaxbits) * (1.3f / 127.0f);
        const float* pg = bg + (size_t)u.e * DEXP + j0; const float* pu = bu + (size_t)u.e * DEXP + j0;
        const f32x4 g0b = *(const f32x4*)pg, g1b = *(const f32x4*)(pg + 4), u0b = *(const f32x4*)pu, u1b = *(const f32x4*)(pu + 4);
        float scs[2][4];
#pragma unroll
        for (int ai = 0; ai < 2; ++ai)
#pragma unroll
            for (int m = 0; m < 4; ++m) scs[ai][m] = rowsx[row0 + ai * HALF + m * 16] * sw;
        EPI_LOOP_ROWS { const int row = row0 + ai * HALF + m * 16; const float sc = scs[ai][m];
            const i32x4 ag0 = __builtin_bit_cast(i32x4, acc[ai][0][m][0]), ag1 = __builtin_bit_cast(i32x4, acc[ai][0][m][1]), au0 = __builtin_bit_cast(i32x4, acc[ai][1][m][0]), au1 = __builtin_bit_cast(i32x4, acc[ai][1][m][1]);
            f32x4 h0, h1;
#pragma unroll
            for (int j = 0; j < 4; ++j) {
                float g = fminf((float)ag0[j] * sc + g0b[j], 7.0f), uu = fminf(fmaxf((float)au0[j] * sc + u0b[j], -7.0f), 7.0f);
                h0[j] = (uu + 1.0f) * (g * sigmoidf_(1.702f * g));
                g = fminf((float)ag1[j] * sc + g1b[j], 7.0f); uu = fminf(fmaxf((float)au1[j] * sc + u1b[j], -7.0f), 7.0f);
                h1[j] = (uu + 1.0f) * (g * sigmoidf_(1.702f * g)); }
            st_bf16x8(hid + (size_t)row * DEXP + j0, h0, h1);
            float am = fmaxf(fmaxf(fmaxf(fabsf(h0[0]), fabsf(h0[1])), fmaxf(fabsf(h0[2]), fabsf(h0[3]))), fmaxf(fmaxf(fabsf(h1[0]), fabsf(h1[1])), fmaxf(fabsf(h1[2]), fabsf(h1[3]))));
            am = fmaxf(am, __shfl_xor(am, 16)); am = fmaxf(am, __shfl_xor(am, 32));
            if (fq == 0) hm[(size_t)row * 32 + u.pn * 4 + wc] = am; }
    }
};
struct EpiDown {
    static constexpr bool HAS_MID = false; static constexpr bool I8 = false;
    const float* bd; const float* roww; bf16_t* ys;
    __device__ __forceinline__ void operator()(const f32x4 (&acc)[2][2][4][2], const Unit& u, int wr, int wc, int fr, int fq) const {
        const int row0 = u.pm * BM + wr * 64 + fr, col0 = u.pn * BM + wc * 32 + fq * 8;
        f32x4 b[2][2];
#pragma unroll
        for (int bj = 0; bj < 2; ++bj) { const float* p = bd + (size_t)u.e * DM + col0 + bj * HALF; b[bj][0] = *(const f32x4*)p; b[bj][1] = *(const f32x4*)(p + 4); }
        float rws[2][4];
#pragma unroll
        for (int ai = 0; ai < 2; ++ai)
#pragma unroll
            for (int m = 0; m < 4; ++m) rws[ai][m] = roww[row0 + ai * HALF + m * 16];
        EPI_LOOP_ROWS { const int row = row0 + ai * HALF + m * 16; const float w = rws[ai][m];
#pragma unroll
            for (int bj = 0; bj < 2; ++bj) st_bf16x8(ys + (size_t)row * 2048 + col0 + bj * HALF, (acc[ai][bj][m][0] + b[bj][0]) * w, (acc[ai][bj][m][1] + b[bj][1]) * w); }
    }
};
struct EpiDownI8 {
    static constexpr bool HAS_MID = false; static constexpr bool I8 = true;
    const float* bd; const float* roww; bf16_t* ys; const float* h8s; const unsigned* wmaxbits;
    __device__ __forceinline__ void operator()(const f32x4 (&acc)[2][2][4][2], const Unit& u, int wr, int wc, int fr, int fq) const {
        const int row0 = u.pm * BM + wr * 64 + fr, col0 = u.pn * BM + wc * 32 + fq * 8;
        const float sw = __uint_as_float(*wmaxbits) * (1.3f / 127.0f);
        f32x4 b[2][2];
#pragma unroll
        for (int bj = 0; bj < 2; ++bj) { const float* p = bd + (size_t)u.e * DM + col0 + bj * HALF; b[bj][0] = *(const f32x4*)p; b[bj][1] = *(const f32x4*)(p + 4); }
        float rws[2][4], scs[2][4];
#pragma unroll
        for (int ai = 0; ai < 2; ++ai)
#pragma unroll
            for (int m = 0; m < 4; ++m) { rws[ai][m] = roww[row0 + ai * HALF + m * 16]; scs[ai][m] = h8s[row0 + ai * HALF + m * 16] * sw; }
        EPI_LOOP_ROWS { const int row = row0 + ai * HALF + m * 16; const float w = rws[ai][m], sc = scs[ai][m];
#pragma unroll
            for (int bj = 0; bj < 2; ++bj) { const i32x4 a0 = __builtin_bit_cast(i32x4, acc[ai][bj][m][0]), a1 = __builtin_bit_cast(i32x4, acc[ai][bj][m][1]);
                const f32x4 v0 = (f32x4){(float)a0[0], (float)a0[1], (float)a0[2], (float)a0[3]} * sc, v1 = (f32x4){(float)a1[0], (float)a1[1], (float)a1[2], (float)a1[3]} * sc;
                st_bf16x8(ys + (size_t)row * 2048 + col0 + bj * HALF, (v0 + b[bj][0]) * w, (v1 + b[bj][1]) * w); } }
    }
};
struct EpiPleGateI8 {
    static constexpr bool HAS_MID = false; static constexpr bool I8 = true;
    const bf16_t* hb; const bf16_t* pp; bf16_t* pre; const float* hs; const unsigned* wmaxbits;
    __device__ __forceinline__ void operator()(const f32x4 (&acc)[2][2][4][2], const Unit& u, int wr, int wc, int fr, int fq) const {
        const int row0 = u.pm * BM + wr * 64 + fr, col0 = u.pn * BM + wc * 32 + fq * 8;
        const float sw = __uint_as_float(*wmaxbits) * (1.3f / 127.0f);
#pragma unroll
        for (int ai = 0; ai < 2; ++ai) { u32x4 pl[4][2], hl[4][2]; float scs[4];
#pragma unroll
            for (int m = 0; m < 4; ++m) { scs[m] = hs[row0 + ai * HALF + m * 16] * sw;
#pragma unroll
                for (int bj = 0; bj < 2; ++bj) { const size_t o = (size_t)(row0 + ai * HALF + m * 16) * 2048 + col0 + bj * HALF; pl[m][bj] = *(const u32x4*)(pp + o); hl[m][bj] = *(const u32x4*)(hb + o); } }
#pragma unroll
            for (int m = 0; m < 4; ++m) { const float sc = scs[m];
#pragma unroll
                for (int bj = 0; bj < 2; ++bj) { const size_t o = (size_t)(row0 + ai * HALF + m * 16) * 2048 + col0 + bj * HALF; const u32x4 pw = pl[m][bj], hw = hl[m][bj];
                    const i32x4 a0 = __builtin_bit_cast(i32x4, acc[ai][bj][m][0]), a1 = __builtin_bit_cast(i32x4, acc[ai][bj][m][1]); f32x4 o0, o1;
                    o0[0] = bflo(hw.x) + sigmoidf_((float)a0[0] * sc) * bflo(pw.x); o0[1] = bfhi(hw.x) + sigmoidf_((float)a0[1] * sc) * bfhi(pw.x); o0[2] = bflo(hw.y) + sigmoidf_((float)a0[2] * sc) * bflo(pw.y); o0[3] = bfhi(hw.y) + sigmoidf_((float)a0[3] * sc) * bfhi(pw.y);
                    o1[0] = bflo(hw.z) + sigmoidf_((float)a1[0] * sc) * bflo(pw.z); o1[1] = bfhi(hw.z) + sigmoidf_((float)a1[1] * sc) * bfhi(pw.z); o1[2] = bflo(hw.w) + sigmoidf_((float)a1[2] * sc) * bflo(pw.w); o1[3] = bfhi(hw.w) + sigmoidf_((float)a1[3] * sc) * bfhi(pw.w);
                    st_bf16x8(pre + o, o0, o1); } } }
    }
};
}

struct Params { const float* in[25]; float* out; unsigned char* ws; int ph_lo, ph_hi; };
__constant__ float c_invf_r[16] = {1.000000000e+00f, 4.403665960e-01f, 1.939227432e-01f, 8.539710194e-02f, 3.760603070e-02f, 1.656043902e-02f, 7.292664610e-03f, 3.211445874e-03f, 1.414213562e-03f, 6.227723788e-04f, 2.742481884e-04f, 1.207697351e-04f, 5.318296098e-05f, 2.341999971e-05f, 1.031338616e-05f, 4.541670478e-06f};
__constant__ float c_invf_i[8] = {1.000000000e+00f, 1.939227432e-01f, 3.760603070e-02f, 7.292664610e-03f, 1.414213562e-03f, 2.742481884e-04f, 5.318296098e-05f, 1.031338616e-05f};
constexpr int LDS_PTRS = LDS_MISC + 256;
struct Frame { unsigned char* lds; LAS unsigned char* ldsl; unsigned char* ws; int tid, lane, wid, G, bid;
    __device__ __forceinline__ const float* in(int k) const { const LAS unsigned* t = (const LAS unsigned*)(ldsl + LDS_PTRS) + 2 * k;
        const unsigned lo = __builtin_amdgcn_readfirstlane(t[0]), hi = __builtin_amdgcn_readfirstlane(t[1]); return (const float*)(const GAS float*)(((unsigned long long)hi << 32) | lo); }
    __device__ __forceinline__ float* out() const { return (float*)in(25); } };
__device__ __forceinline__ Frame fresh(const Frame& F0) { Frame F = F0; int t = threadIdx.x; asm volatile("" : "+v"(t)); F.tid = t; F.lane = t & 63; F.wid = __builtin_amdgcn_readfirstlane(t >> 6); size_t z = 0; asm volatile("" : "+s"(z)); F.ws = F0.ws + z; return F; }

struct TcTile { const float* src; long sld; bf16_t* dst; long dld; int nvalid; float qinv; };
template <class Dec>
__device__ __forceinline__ void tconv_run(const Frame& F, int total, const Dec& dec, int& rot) {
    float* tile = (float*)F.lds;
    const int tid = F.tid, G = F.G;
    const int start = (F.bid - (rot % G) + G) % G; rot += total >> 2;
    const int lr = tid >> 4, lc4 = (tid & 15) * 4, sn = tid >> 3, skc = (tid & 7) * 8;
    f32x4 v[4][2];
#define TC_ISSUE(t0_) do { _Pragma("unroll") for (int q = 0; q < 4; ++q) { const int t = (t0_) * 4 + q; \
        if (t < total) { const TcTile ti = dec(dec.remap(t)); _Pragma("unroll") for (int h = 0; h < 2; ++h) { v[q][h] = (f32x4){0.f, 0.f, 0.f, 0.f}; \
            if (lc4 < ti.nvalid) v[q][h] = *(const GAS f32x4*)((const GAS float*)ti.src + (size_t)(lr + 32 * h) * ti.sld + lc4); } } } } while (0)
    if (start * 4 < total) TC_ISSUE(start);
    for (int t0 = start; t0 * 4 < total; t0 += G) {
#pragma unroll
        for (int q = 0; q < 4; ++q) { if (t0 * 4 + q < total) { float* tl = tile + q * (64 * 65);
#pragma unroll
                for (int h = 0; h < 2; ++h) { float* p = tl + (lr + 32 * h) * 65 + lc4; p[0] = v[q][h][0]; p[1] = v[q][h][1]; p[2] = v[q][h][2]; p[3] = v[q][h][3]; } } }
        __syncthreads();
        if ((t0 + G) * 4 < total) TC_ISSUE(t0 + G);
#pragma unroll
        for (int q = 0; q < 4; ++q) { const int t = t0 * 4 + q;
            if (t < total) { const TcTile ti = dec(dec.remap(t)); const float* tl = tile + q * (64 * 65);
                if (ti.qinv > 0.f) { if (tid < 256) { const int n8 = tid >> 2, kc = (tid & 3) * 16; u32x4 w;
#pragma unroll
                        for (int d = 0; d < 4; ++d) { unsigned pk = 0u;
#pragma unroll
                            for (int j = 0; j < 4; ++j) { float q = rintf(tl[(kc + d * 4 + j) * 65 + n8] * ti.qinv); q = fminf(fmaxf(q, -127.f), 127.f); pk |= ((unsigned)(int)q & 0xffu) << (8 * j); }
                            w[d] = pk; }
                        *(u32x4*)((unsigned char*)ti.dst + (size_t)n8 * ti.dld + kc) = w; } }
                else if (sn < ti.nvalid) { f32x4 a, b;
#pragma unroll
                    for (int j = 0; j < 4; ++j) { a[j] = tl[(skc + j) * 65 + sn]; b[j] = tl[(skc + 4 + j) * 65 + sn]; }
                    pg8::st_bf16x8(ti.dst + (size_t)sn * ti.dld + skc, a, b); } } }
        __syncthreads();
    }
#undef TC_ISSUE
}
struct TcMat {
    const float* src; long src_ld; int tk, ncols; bf16_t* dst; long dst_ld; float qinv;
    __device__ __forceinline__ int remap(int i) const { const int ntn = (ncols + 63) >> 6; if (ntn & 1) return i;
        const int g = i >> 2, q = i & 3, tkh = tk >> 1, gk = g % tkh, gn = g / tkh; return (2 * gn + (q >> 1)) * tk + 2 * gk + (q & 1); }
    __device__ __forceinline__ TcTile operator()(int t) const { const int k0 = (t % tk) * 64, n0 = (t / tk) * 64; TcTile ti;
        ti.src = src + (size_t)k0 * src_ld + n0; ti.sld = src_ld; ti.dst = qinv > 0.f ? (bf16_t*)((unsigned char*)dst + (size_t)n0 * dst_ld + k0) : dst + (size_t)n0 * dst_ld + k0; ti.dld = dst_ld; ti.nvalid = (ncols - n0) < 64 ? (ncols - n0) : 64; ti.qinv = qinv; return ti; }
};
__device__ __forceinline__ void tconv(const Frame& F, const float* src, long src_ld, int K, int ncols, bf16_t* dst, long dst_ld, int& rot) {
    TcMat d{src, src_ld, K >> 6, ncols, dst, dst_ld, 0.f}; tconv_run(F, (K >> 6) * ((ncols + 63) >> 6), d, rot);
}
struct TcExperts {
    const float* wg; const float* wu; const float* wd; unsigned char* dgu; unsigned char* ddn; float qinv, qinvd;
    __device__ __forceinline__ int remap(int i) const { const int e = i / 1536, ri = i - e * 1536;
        if (ri < 1024) { const int g = ri >> 2, q = ri & 3, gk = g & 15, gn = g >> 4; return e * 1536 + (2 * gn + (q >> 1)) * 32 + 2 * gk + (q & 1); }
        const int r2 = ri - 1024, g = r2 >> 2, q = r2 & 3, gk = g & 7, gn = g >> 3; return e * 1536 + 1024 + (2 * gn + (q >> 1)) * 16 + 2 * gk + (q & 1); }
    __device__ __forceinline__ TcTile operator()(int t) const { const int e = t / 1536, r = t - e * 1536; TcTile ti; ti.nvalid = 64; ti.qinv = 0.f;
        if (r < 1024) { const int k0 = (r & 31) * 64, dt = r >> 5, jb = dt >> 2, gu = (dt >> 1) & 1, half = dt & 1;
            ti.src = (const float*)((unsigned long long)wg + (unsigned long long)gu * ((unsigned long long)wu - (unsigned long long)wg)) + (size_t)e * DM * DEXP + (size_t)k0 * DEXP + jb * 128 + half * 64; ti.sld = DEXP;
            ti.dst = (bf16_t*)(dgu + (size_t)e * 2048 * 2048 + (size_t)(dt * 64) * 2048 + k0); ti.dld = 2048; ti.qinv = qinv; }
        else { const int r2 = r - 1024, k0 = (r2 & 15) * 64, n0 = (r2 >> 4) * 64;
            ti.src = wd + (size_t)e * DEXP * DM + (size_t)k0 * DM + n0; ti.sld = DM;
            ti.dst = (bf16_t*)(ddn + (size_t)e * 2048 * 1024 + (size_t)n0 * 1024 + k0); ti.dld = 1024; ti.qinv = qinvd; }
        return ti; }
};
__device__ __forceinline__ void sample_wmax(const Frame& F) {
    unsigned* wm = (unsigned*)(F.ws + WS_CTL) + CW_WMAX;
#pragma unroll 1
    for (int l = 0; l < NLAYER; ++l) { float mx = 0.f;
#pragma unroll 1
        for (int which = 0; which < 2; ++which) { const f32x4* p = (const f32x4*)(F.in(which ? 17 : 15) + (size_t)l * NEXP * DM * DEXP);
            for (size_t i = (size_t)F.bid * 512 + F.tid; i < (size_t)NEXP * DM * DEXP / 4 / 64; i += (size_t)F.G * 512) { const size_t j = i >> 3; const f32x4 v = p[j * 512 + 8 * (j & 63) + (i & 7)];
                mx = fmaxf(mx, fmaxf(fmaxf(fabsf(v[0]), fabsf(v[1])), fmaxf(fabsf(v[2]), fabsf(v[3])))); } }
        for (int o = 32; o > 0; o >>= 1) mx = fmaxf(mx, __shfl_xor(mx, o));
        if (F.lane == 0 && mx > 0.f) atomicMax(&wm[l], __float_as_uint(mx));
        float mg = 0.f; const f32x4* wi_ = (const f32x4*)(F.in(2) + (size_t)l * DM * INW);
        for (int i = F.bid * 512 + F.tid; i < DM * (INW / 4) / 16; i += F.G * 512) { const size_t j = (size_t)(i >> 3); const f32x4 v = wi_[j * 128 + 8 * (j & 15) + (i & 7)];
            mg = fmaxf(mg, fmaxf(fmaxf(fabsf(v[0]), fabsf(v[1])), fmaxf(fabsf(v[2]), fabsf(v[3])))); }
        for (int o = 32; o > 0; o >>= 1) mg = fmaxf(mg, __shfl_xor(mg, o));
        if (F.lane == 0 && mg > 0.f) atomicMax(&wm[CW_WMAXG - CW_WMAX + l], __float_as_uint(mg));
        float mp = 0.f; const f32x4* wp_ = (const f32x4*)(F.in(21) + (size_t)l * DM * DM);
        for (int i = F.bid * 512 + F.tid; i < DM * DM / 4 / 16; i += F.G * 512) { const int j = i >> 3; const f32x4 v = wp_[j * 128 + 8 * (j & 15) + (i & 7)];
            mp = fmaxf(mp, fmaxf(fmaxf(fabsf(v[0]), fabsf(v[1])), fmaxf(fabsf(v[2]), fabsf(v[3])))); }
        for (int o = 32; o > 0; o >>= 1) mp = fmaxf(mp, __shfl_xor(mp, o));
        if (F.lane == 0 && mp > 0.f) atomicMax(&wm[CW_WMAXP - CW_WMAX + l], __float_as_uint(mp));
        float md = 0.f; const f32x4* wd_ = (const f32x4*)(F.in(19) + (size_t)l * NEXP * DEXP * DM);
        for (size_t i = (size_t)F.bid * 512 + F.tid; i < (size_t)NEXP * DEXP * DM / 4 / 64; i += (size_t)F.G * 512) { const size_t j = i >> 3; const f32x4 v = wd_[j * 512 + 8 * (j & 63) + (i & 7)];
            md = fmaxf(md, fmaxf(fmaxf(fabsf(v[0]), fabsf(v[1])), fmaxf(fabsf(v[2]), fabsf(v[3])))); }
        for (int o = 32; o > 0; o >>= 1) md = fmaxf(md, __shfl_xor(md, o));
        if (F.lane == 0 && md > 0.f) atomicMax(&wm[CW_WMAXD - CW_WMAX + l], __float_as_uint(md)); }
}
__device__ __forceinline__ void conv_rows(const Frame& F, const float* src, bf16_t* dst, size_t n8) {
    for (size_t i = (size_t)F.bid * 512 + F.tid; i < n8; i += (size_t)F.G * 512) { const f32x4 a = *(const f32x4*)(src + i * 8), b = *(const f32x4*)(src + i * 8 + 4); pg8::st_bf16x8(dst + i * 8, a, b); }
}
__device__ __forceinline__ void quant_rows(const Frame& F, const float* src, bf16_t* xb, unsigned char* xq, float* xsc) {
    const int lane = F.lane;
    for (int tok = F.bid * 8 + F.wid; tok < NTOK; tok += F.G * 8) { f32x4 v[8]; float amax = 0.f;
#pragma unroll
        for (int i = 0; i < 4; ++i) { const int c = (i * 64 + lane) * 8; v[2 * i] = *(const f32x4*)(src + (size_t)tok * DM + c); v[2 * i + 1] = *(const f32x4*)(src + (size_t)tok * DM + c + 4);
            pg8::st_bf16x8(xb + (size_t)tok * DM + c, v[2 * i], v[2 * i + 1]);
#pragma unroll
            for (int h = 0; h < 2; ++h)
#pragma unroll
                for (int j = 0; j < 4; ++j) amax = fmaxf(amax, fabsf(v[2 * i + h][j])); }
        for (int o = 32; o > 0; o >>= 1) amax = fmaxf(amax, __shfl_xor(amax, o));
        amax = fmaxf(amax, 1e-20f); const float qi = 127.0f / amax; if (lane == 0) xsc[tok] = amax * (1.0f / 127.0f);
#pragma unroll
        for (int i = 0; i < 4; ++i) { u32x2 w;
#pragma unroll
            for (int h = 0; h < 2; ++h) { unsigned pk = 0u;
#pragma unroll
                for (int j = 0; j < 4; ++j) pk |= ((unsigned)(int)rintf(v[2 * i + h][j] * qi) & 0xffu) << (8 * j);
                w[h] = pk; }
            *(u32x2*)(xq + (size_t)tok * DM + (i * 64 + lane) * 8) = w; } }
}
__constant__ int c_so[14] = {0, 1312, 2416, 3440, 4464, 5496, 6520, 7544, 8568, 1024, 1280, 2336, 2400, 5488};
__constant__ int c_dn[14] = {0, 1024, 2048, 3072, 4096, 5120, 6144, 7168, 8192, 14336, 14592, 14624, 14688, 14704};
__constant__ int c_nc[14] = {1024, 1024, 1024, 1024, 1024, 1024, 1024, 1024, 6144, 256, 32, 64, 16, 8};
__device__ __forceinline__ void convert_layer_weights(const Frame& F0, const Params& P, int l) { const Frame F = fresh(F0);
    unsigned char* ws = F.ws; int rot = 0;
    { const float* w = F.in(2) + (size_t)l * DM * INW; bf16_t* d = (bf16_t*)(ws + W_IN);
      const float wmaxg = __uint_as_float(((const unsigned*)(ws + WS_CTL))[CW_WMAXG + l]); const float qinv = 127.0f / (1.3f * fmaxf(wmaxg, 1e-30f));
#pragma unroll 1
      for (int s = 0; s < 14; ++s) {
          if (s == 1 || s >= 10) tconv(F, w + c_so[s], INW, DM, c_nc[s], d + (size_t)c_dn[s] * DM, DM, rot);
          else { const int crow = (s == 0) ? 0 : (s <= 7 ? 1024 + (s - 2) * 1024 : (s == 8 ? 7168 : 13312));
              TcMat dq{w + c_so[s], INW, DM >> 6, c_nc[s], (bf16_t*)(ws + W_IN8 + (size_t)crow * 2048), 2048, qinv}; tconv_run(F, (DM >> 6) * (c_nc[s] >> 6), dq, rot); } } }
    tconv(F, F.in(7) + (size_t)l * 1024 * DM, DM, 1024, DM, (bf16_t*)(ws + W_BRA), 3072, rot);
    tconv(F, F.in(8) + (size_t)l * 1024 * DM, DM, 1024, DM, (bf16_t*)(ws + W_BRA) + 1024, 3072, rot);
    tconv(F, F.in(9) + (size_t)l * 1024 * DM, DM, 1024, DM, (bf16_t*)(ws + W_BRA) + 2048, 3072, rot);
    tconv(F, F.in(10) + (size_t)l * DM * DM, DM, DM, DM, (bf16_t*)(ws + W_OUT), DM, rot);
    { const float wmp = __uint_as_float(((const unsigned*)(ws + WS_CTL))[CW_WMAXP + l]);
      TcMat dq{F.in(21) + (size_t)l * DM * DM, DM, DM >> 6, DM, (bf16_t*)(ws + W_PG), 2048, 127.0f / (1.3f * fmaxf(wmp, 1e-30f))}; tconv_run(F, (DM >> 6) * (DM >> 6), dq, rot); }
    tconv(F, F.in(22) + (size_t)l * 256 * DM, DM, 256, DM, (bf16_t*)(ws + W_PLE), 256, rot);
#pragma unroll 1
    for (int h = 0; h < 8; ++h) tconv(F, F.in(6) + (size_t)l * 256 * 1024 + h * 128, 1024, 256, 128, (bf16_t*)(ws + W_UV2) + ((size_t)(h >> 1) * 256 + (h & 1) * 128) * 512 + (h & 1) * 256, 512, rot);
    { const float wmax = __uint_as_float(((const unsigned*)(ws + WS_CTL))[CW_WMAX + l]);
      const float wmaxd = __uint_as_float(((const unsigned*)(ws + WS_CTL))[CW_WMAXD + l]);
      TcExperts d{F.in(15) + (size_t)l * NEXP * DM * DEXP, F.in(17) + (size_t)l * NEXP * DM * DEXP, F.in(19) + (size_t)l * NEXP * DEXP * DM, (unsigned char*)(ws + W_GU), (unsigned char*)(ws + W_DN), 127.0f / (1.3f * fmaxf(wmax, 1e-30f)), 127.0f / (1.3f * fmaxf(wmaxd, 1e-30f))};
      tconv_run(F, NEXP * 1536, d, rot); }
    { const float* w = F.in(5) + (size_t)l * 256 * 8 * 96; bf16_t* d = (bf16_t*)(ws + W_UK2);
      for (int i = F.bid * 512 + F.tid; i < 256 * 8 * 96; i += F.G * 512) { const int n = i % 96, h = (i / 96) & 7, r = i / 768; d[((size_t)h * 256 + r) * 256 + (h & 1) * 128 + 32 + n] = f2bf(w[i]); } }
}

__device__ __forceinline__ void rope_cs(float pos, float invf, float& c, float& s) {
    const float a = pos * invf; const double ad = (double)a * 0.15915494309189535; const float fr = (float)(ad - rint(ad));
    s = __builtin_amdgcn_sinf(fr); c = __builtin_amdgcn_cosf(fr);
}
__device__ __forceinline__ void phase_prep(const Frame& F0, const Params& P, int l) { const Frame F = fresh(F0);
    unsigned char* ws = F.ws; const int lane = F.lane;
    const float* smallb = (const float*)(ws + R_SMALL); bf16_t* kcat = (bf16_t*)(ws + R_KCAT); bf16_t* qcat = (bf16_t*)(ws + R_QCAT);
    bf16_t* ki = (bf16_t*)(ws + R_KI); float* wi = (float*)(ws + R_WI); float* lf = (float*)(ws + WS_LF);
    const bf16_t* qa = (const bf16_t*)(ws + R_QA); bf16_t* qidx = (bf16_t*)(ws + R_QIDX);
    const f32x4 gck = *(const f32x4*)(F.in(4) + l * 256 + lane * 4);
    const float bfo = lane < 8 ? F.in(3)[l * 8 + lane] : 0.f;
    const float ifr = c_invf_r[lane & 15], ifi = c_invf_i[lane & 7];
    for (int tok = F.bid * 8 + F.wid; tok < NTOK; tok += F.G * 8) {
        const int s = tok & (SEQ - 1), b = tok >> 13; const float* sm = smallb + (size_t)tok * 512;
        float cr, sr, ci, si; rope_cs((float)s, ifr, cr, sr); rope_cs((float)s, ifi, ci, si);
        { const f32x4 v = *(const f32x4*)(sm + lane * 4); float ss = v[0] * v[0] + v[1] * v[1] + v[2] * v[2] + v[3] * v[3]; ss = wave_sum(ss);
          const float rs = rsqrtf(ss * (1.0f / 256.0f) + 1e-6f); u32x2 w; w.x = cvtpk(v[0] * rs * gck[0], v[1] * rs * gck[1]); w.y = cvtpk(v[2] * rs * gck[2], v[3] * rs * gck[3]);
          *(u32x2*)(kcat + (size_t)tok * 288 + lane * 4) = w; }
        if (lane < 16) { const float x1 = sm[256 + lane], x2 = sm[272 + lane]; kcat[(size_t)tok * 288 + 256 + lane] = f2bf(x1 * cr - x2 * sr); kcat[(size_t)tok * 288 + 272 + lane] = f2bf(x2 * cr + x1 * sr); }
        { float o = sm[288 + lane];
          if (lane < 8) { const float x2 = sm[296 + lane]; o = o * ci - x2 * si; } else if (lane < 16) { const float x1 = sm[288 + lane - 8]; o = o * ci + x1 * si; }
          ki[(size_t)tok * 64 + lane] = f2bf(o); }
        if (lane < 16) wi[(size_t)tok * 16 + lane] = sm[352 + lane] * (1.0f / 32.0f);
        if (lane < 8) { const float f = sm[368 + lane] + bfo; lf[(size_t)(b * 8 + lane) * SEQ + s] = fminf(f, 0.f) - log1pf(__expf(-fabsf(f))); }
#pragma unroll
        for (int pp = 0; pp < 2; ++pp) { const int p = lane + 64 * pp, h = p >> 4, i = p & 15;
            const float x1 = bf2f(qa[(size_t)tok * 1024 + h * 128 + i]), x2 = bf2f(qa[(size_t)tok * 1024 + h * 128 + 16 + i]);
            qcat[(size_t)tok * 2304 + h * 288 + 256 + i] = f2bf(x1 * cr - x2 * sr); qcat[(size_t)tok * 2304 + h * 288 + 272 + i] = f2bf(x2 * cr + x1 * sr); }
#pragma unroll
        for (int pp = 0; pp < 2; ++pp) { const int p = lane + 64 * pp, hh = p >> 3, i = p & 7; bf16_t* q = qidx + (size_t)tok * 1024 + hh * 64;
            const float x1 = bf2f(q[i]), x2 = bf2f(q[8 + i]); q[i] = f2bf(x1 * ci - x2 * si); q[8 + i] = f2bf(x2 * ci + x1 * si); }
    }
    { const bf16_t* kbt = (const bf16_t*)(ws + R_QKV) + (size_t)NTOK * 1024; unsigned* kmx = (unsigned*)(ws + WS_CTL) + CW_KMAX + l * 16;
#pragma unroll 1
      for (int bh = 0; bh < 16; ++bh) { float mx = 0.f;
          for (int r0 = (F.bid * 8 + F.wid) * 4; r0 < SEQ; r0 += F.G * 32) {
              const u32x4 w = *(const u32x4*)(kbt + ((size_t)bh * SEQ + r0 + (lane >> 4)) * 128 + (lane & 15) * 8);
              float ss = bflo(w.x) * bflo(w.x) + bfhi(w.x) * bfhi(w.x) + bflo(w.y) * bflo(w.y) + bfhi(w.y) * bfhi(w.y) + bflo(w.z) * bflo(w.z) + bfhi(w.z) * bfhi(w.z) + bflo(w.w) * bflo(w.w) + bfhi(w.w) * bfhi(w.w);
              ss += __shfl_xor(ss, 1); ss += __shfl_xor(ss, 2); ss += __shfl_xor(ss, 4); ss += __shfl_xor(ss, 8); mx = fmaxf(mx, ss); }
          mx = fmaxf(mx, __shfl_xor(mx, 16)); mx = fmaxf(mx, __shfl_xor(mx, 32));
          if (lane == 0) ((float*)F.lds)[F.wid * 16 + bh] = mx; }
      __syncthreads();
      if (F.tid < 16) { float mx = 0.f;
#pragma unroll
          for (int w = 0; w < 8; ++w) mx = fmaxf(mx, ((const float*)F.lds)[w * 16 + F.tid]);
          const unsigned bits = __float_as_uint(mx);
          if (bits > __hip_atomic_load(&kmx[F.tid], __ATOMIC_RELAXED, __HIP_MEMORY_SCOPE_AGENT)) atomicMax(&kmx[F.tid], bits); }
      __syncthreads(); }
}
__device__ __forceinline__ void phase_cumsum(const Frame& F0) { const Frame F = fresh(F0);
    const int gw = F.bid * 8 + F.wid; if (gw >= 16) return;
    const float* lf = (const float*)(F.ws + WS_LF) + (size_t)gw * SEQ; float* cum = (float*)(F.ws + WS_CUM) + (size_t)gw * SEQ;
    const int lane = F.lane; double tot = 0.0;
    for (int j = 0; j < 128; ++j) tot += (double)lf[lane * 128 + j];
    double inc = tot;
    for (int o = 1; o < 64; o <<= 1) { const double n = __shfl_up(inc, o); if (lane >= o) inc += n; }
    double run = inc - tot;
    for (int j = 0; j < 128; ++j) { run += (double)lf[lane * 128 + j]; cum[lane * 128 + j] = (float)run; }
}

__device__ __forceinline__ void idx_unit(const Frame& F, int b, int pi, int half) {
    const int tid = F.tid, lane = F.lane, rho = lane & 31, hh = lane >> 5; unsigned char* ws = F.ws;
    const bf16_t* qidx = (const bf16_t*)(ws + R_QIDX); const bf16_t* ki = (const bf16_t*)(ws + R_KI) + (size_t)b * SEQ * 64; const float* wi = (const float*)(ws + R_WI);
    float* scores = (float*)(ws + R_SCORES) + (size_t)b * SEQ * SEQ;
    LAS unsigned char* kl = F.ldsl;
    const int gl = pi, gh = 127 - pi, nl = (64 * gl + 63) / 128 + 1, nh = (64 * gh + 63) / 128 + 1, tot = nl + nh;
    const int x0 = half ? tot / 2 : 0, x1 = half ? tot : tot / 2;
    bf16x8 af[4][4]; float wv[4][16]; int t0 = 0, curg = -1;
    const int r0 = tid >> 3, p0 = tid & 7;
    const unsigned d0 = (unsigned)(r0 * 128 + ((p0 ^ (r0 & 7)) << 4)), d1 = d0 + 64 * 128;
    u32x4 s0, s1;
    { const int c = x0 < nl ? x0 : x0 - nl; const bf16_t* kp = ki + (size_t)(c * 128) * 64; s0 = *(const u32x4*)(kp + (size_t)r0 * 64 + p0 * 8); s1 = *(const u32x4*)(kp + (size_t)(r0 + 64) * 64 + p0 * 8); }
    __syncthreads();
    *(LAS u32x4*)(kl + d0) = s0; *(LAS u32x4*)(kl + d1) = s1;
    __syncthreads();
    const unsigned rdo = (unsigned)(rho * 128);
#pragma unroll 1
    for (int x = x0; x < x1; ++x) {
        const int g = x < nl ? gl : gh, c = x < nl ? x : x - nl;
        if (g != curg) { curg = g; t0 = g * 64 + F.wid * 8;
#pragma unroll
            for (int mt = 0; mt < 4; ++mt) {
                const int tokA = b * SEQ + t0 + 2 * mt + ((rho >> 2) & 1), head = (rho & 3) + 4 * (rho >> 3);
#pragma unroll
                for (int kk = 0; kk < 4; ++kk) af[mt][kk] = *(const bf16x8*)(qidx + (size_t)tokA * 1024 + head * 64 + kk * 16 + 8 * hh);
                const float* wp = wi + (size_t)(b * SEQ + t0 + 2 * mt + hh) * 16;
#pragma unroll
                for (int q = 0; q < 4; ++q) { const f32x4 v = *(const f32x4*)(wp + 4 * q); wv[mt][4 * q] = v[0]; wv[mt][4 * q + 1] = v[1]; wv[mt][4 * q + 2] = v[2]; wv[mt][4 * q + 3] = v[3]; } } }
        const unsigned bo = (unsigned)((x - x0) & 1) * 16384u;
        if (x + 1 < x1) { const int cn = (x + 1) < nl ? (x + 1) : (x + 1) - nl; const bf16_t* kp = ki + (size_t)(cn * 128) * 64; s0 = *(const u32x4*)(kp + (size_t)r0 * 64 + p0 * 8); s1 = *(const u32x4*)(kp + (size_t)(r0 + 64) * 64 + p0 * 8); }
#pragma unroll
        for (int tl = 0; tl < 4; ++tl) {
            const int kb = c * 128 + tl * 32;
            if (kb <= t0 + 7) {
                bf16x8 bc[4];
#pragma unroll
                for (int kk = 0; kk < 4; ++kk) bc[kk] = *(const LAS bf16x8*)(kl + bo + tl * 4096 + rdo + (((kk * 2 + hh) ^ (rho & 7)) << 4));
                f32x16 a0 = {}, a1 = {}, a2 = {}, a3 = {};
#pragma unroll
                for (int kk = 0; kk < 4; ++kk) { a0 = __builtin_amdgcn_mfma_f32_32x32x16_bf16(af[0][kk], bc[kk], a0, 0, 0, 0); a1 = __builtin_amdgcn_mfma_f32_32x32x16_bf16(af[1][kk], bc[kk], a1, 0, 0, 0);
                                                  a2 = __builtin_amdgcn_mfma_f32_32x32x16_bf16(af[2][kk], bc[kk], a2, 0, 0, 0); a3 = __builtin_amdgcn_mfma_f32_32x32x16_bf16(af[3][kk], bc[kk], a3, 0, 0, 0); }
#define IDX_EPI(A_, mt_) do { float x_0 = 0.f, x_1 = 0.f, x_2 = 0.f, x_3 = 0.f; _Pragma("unroll") for (int r = 0; r < 16; r += 4) { \
                    x_0 = fmaf(wv[mt_][r], fmaxf(A_[r], 0.f), x_0); x_1 = fmaf(wv[mt_][r + 1], fmaxf(A_[r + 1], 0.f), x_1); x_2 = fmaf(wv[mt_][r + 2], fmaxf(A_[r + 2], 0.f), x_2); x_3 = fmaf(wv[mt_][r + 3], fmaxf(A_[r + 3], 0.f), x_3); } \
                    scores[(size_t)(t0 + 2 * (mt_) + hh) * SEQ + kb + rho] = (x_0 + x_1) + (x_2 + x_3); } while (0)
                IDX_EPI(a0, 0); IDX_EPI(a1, 1); IDX_EPI(a2, 2); IDX_EPI(a3, 3);
#undef IDX_EPI
            }
        }
        if (x + 1 < x1) { *(LAS u32x4*)(kl + (bo ^ 16384u) + d0) = s0; *(LAS u32x4*)(kl + (bo ^ 16384u) + d1) = s1; }
        __syncthreads();
    }
}
__device__ __forceinline__ void phase_idx(const Frame& F0) { const Frame F = fresh(F0);
#pragma unroll 1
    for (int it = F.bid; it < 256; it += F.G) { const int b = it >> 7, pi = (it >> 1) & 63, half = it & 1; idx_unit(F, b, pi, half); }
}

__device__ __forceinline__ unsigned sortable(float f) { const unsigned u = __float_as_uint(f); return (u & 0x80000000u) ? ~u : (u | 0x80000000u); }
__device__ __forceinline__ void topk_row(const Frame& F, int b, int t) {
    int lane = F.lane; asm volatile("" : "+v"(lane));
    const int L = t + 1, tok = b * SEQ + t; unsigned char* ws = F.ws;
    int* sel = (int*)(ws + R_SEL) + (size_t)tok * 256; int* nsel = (int*)(ws + R_NSEL);
    if (lane == 0) nsel[tok] = L < 256 ? L : 256;
    if (L <= 256) { for (int j = lane; j < 256; j += 64) sel[j] = j < L ? j : 0; return; }
    const float* row = (const float*)(ws + R_SCORES) + ((size_t)b * SEQ + t) * SEQ;
    const int nch = (L + 1023) >> 10;
#define TOPK_LOAD_ROW() do { _Pragma("unroll") for (int c = 0; c < 8; ++c) { \
        if (c < nch) { _Pragma("unroll") for (int jj = 0; jj < 4; ++jj) { const int j = c * 4 + jj; const f32x4 v = *(const f32x4*)(row + j * 256 + lane * 4); \
                _Pragma("unroll") for (int e_ = 0; e_ < 4; ++e_) { const int idx = j * 256 + lane * 4 + e_; u[j * 4 + e_] = idx < L ? sortable(v[e_]) : 0u; } } } \
        else { _Pragma("unroll") for (int q = 0; q < 16; ++q) u[c * 16 + q] = 0u; } } } while (0)
    unsigned u[128];
    TOPK_LOAD_ROW();
    unsigned g0 = 0u, g1 = 0u, g2 = 0u, g3 = 0u;
#pragma unroll
    for (int c = 0; c < 8; ++c) if (c < nch) {
#pragma unroll
        for (int jj = 0; jj < 4; ++jj) { const int j = c * 4 + jj; g0 = u[4 * j] > g0 ? u[4 * j] : g0; g1 = u[4 * j + 1] > g1 ? u[4 * j + 1] : g1; g2 = u[4 * j + 2] > g2 ? u[4 * j + 2] : g2; g3 = u[4 * j + 3] > g3 ? u[4 * j + 3] : g3; } }
    unsigned tl = g0 < g1 ? g0 : g1; { const unsigned t2 = g2 < g3 ? g2 : g3; tl = tl < t2 ? tl : t2; }
#pragma unroll
    for (int o = 32; o > 0; o >>= 1) { const unsigned x = (unsigned)__shfl_xor((int)tl, o); tl = x < tl ? x : tl; }
    constexpr int CAP = 2048;
    LAS unsigned* candk = (LAS unsigned*)(F.ldsl + F.wid * (CAP * 8)); LAS unsigned* candi = candk + CAP;
    int C = 0;
#pragma unroll
    for (int c = 0; c < 8; ++c) if (c < nch) {
#pragma unroll
        for (int q = 0; q < 16; ++q) { const int rq = c * 16 + q; const bool pr = u[rq] >= tl; const unsigned long long mm = __ballot(pr);
            const int pos = C + __popcll(mm & ((1ull << lane) - 1ull));
            if (pr && pos < CAP) { candk[pos] = u[rq]; candi[pos] = (unsigned)((rq >> 2) * 256 + lane * 4 + (rq & 3)); }
            C += __popcll(mm); if ((q & 3) == 3) SBAR(); } }
    if (C <= CAP) {
        const int ng = (C + 255) >> 8;
        unsigned ck[32]; int ci[32];
#pragma unroll
        for (int g = 0; g < 8; ++g) {
#pragma unroll
            for (int q = 0; q < 4; ++q) { const int r = g * 4 + q, p = r * 64 + lane; ck[r] = 0u; ci[r] = 0;
                if (g < ng && p < C) { ck[r] = candk[p]; ci[r] = (int)candi[p]; } } }
        unsigned T = 0u, thr_gt = 0u; int need_eq = 0; bool early = false;
        for (int bit = 31; bit >= 0; --bit) {
            const unsigned cnd = T | (1u << bit); int cnt = 0;
#pragma unroll
            for (int g = 0; g < 8; ++g) if (g < ng) {
#pragma unroll
                for (int q = 0; q < 4; ++q) cnt += __popcll(__ballot(ck[g * 4 + q] >= cnd)); }
            if (cnt >= 256) { T = cnd; if (cnt == 256) { early = true; break; } }
        }
        if (early) { thr_gt = T - 1u; need_eq = 0; }
        else { int gtc = 0;
#pragma unroll
            for (int g = 0; g < 8; ++g) if (g < ng) {
#pragma unroll
                for (int q = 0; q < 4; ++q) gtc += __popcll(__ballot(ck[g * 4 + q] > T)); }
            thr_gt = T; need_eq = 256 - gtc; }
        int base = 0, eq_taken = 0;
#pragma unroll
        for (int g = 0; g < 8; ++g) if (g < ng) {
#pragma unroll
            for (int q = 0; q < 4; ++q) { const int r = g * 4 + q; const unsigned v = ck[r];
                const bool iseq = (v == thr_gt) && (need_eq > 0);
                const unsigned long long meq = __ballot(iseq);
                const int eqr = __popcll(meq & ((1ull << lane) - 1ull));
                const bool take = (v > thr_gt) || (iseq && (eq_taken + eqr < need_eq));
                const unsigned long long mt = __ballot(take);
                const int pos = base + __popcll(mt & ((1ull << lane) - 1ull));
                if (take && pos < 256) sel[pos] = ci[r];
                base += __popcll(mt); eq_taken += __popcll(meq); } }
        return;
    }
    asm volatile("" ::: "memory");
    TOPK_LOAD_ROW();
    unsigned T = 0u, thr_gt = 0u; int need_eq = 0; bool early = false;
    for (int bit = 31; bit >= 0; --bit) {
        const unsigned cand = T | (1u << bit); int cnt = 0;
#pragma unroll
        for (int c = 0; c < 8; ++c) if (c < nch) {
#pragma unroll
            for (int q = 0; q < 16; ++q) cnt += __popcll(__ballot(u[c * 16 + q] >= cand)); }
        if (cnt >= 256) { T = cand; if (cnt == 256) { early = true; break; } }
    }
    if (early) { thr_gt = T - 1u; need_eq = 0; }
    else { int gtc = 0;
#pragma unroll
        for (int c = 0; c < 8; ++c) if (c < nch) {
#pragma unroll
            for (int q = 0; q < 16; ++q) gtc += __popcll(__ballot(u[c * 16 + q] > T)); }
        thr_gt = T; need_eq = 256 - gtc; }
    int base = 0, eq_taken = 0;
#pragma unroll
    for (int c = 0; c < 8; ++c) if (c < nch) {
#pragma unroll
        for (int q = 0; q < 16; ++q) { const int rq = c * 16 + q; const unsigned v = u[rq];
            const bool iseq = (v == thr_gt) && (need_eq > 0);
            const unsigned long long meq = __ballot(iseq);
            const int eqr = __popcll(meq & ((1ull << lane) - 1ull));
            const bool take = (v > thr_gt) || (iseq && (eq_taken + eqr < need_eq));
            const unsigned long long mt = __ballot(take);
            const int pos = base + __popcll(mt & ((1ull << lane) - 1ull));
            if (take && pos < 256) sel[pos] = (rq >> 2) * 256 + lane * 4 + (rq & 3);
            base += __popcll(mt); eq_taken += __popcll(meq); } }
}
__device__ __forceinline__ void phase_topk(const Frame& F0) { const Frame F = fresh(F0);
    for (int q = F.bid * 8 + F.wid; q < 8192; q += F.G * 8) { const int b = q >> 12, p = q & 4095; topk_row(F, b, p); topk_row(F, b, SEQ - 1 - p); }
}

namespace att {
constexpr int D = 128, KVBLK = 64, QBLK = 32, SHM_V = 16384, SHM_K = 16384;
constexpr int OFF_K = 2 * SHM_V, OFF_BIAS = 2 * SHM_V + 2 * SHM_K, OFF_WS = OFF_BIAS + 512, OFF_FLAGS = OFF_WS + 2048, OFF_QITEM = OFF_FLAGS + 64;
constexpr float EXIT_T = 44.0f;
#define KSWZ(row, colB) ((row) * 256 + ((colB) ^ (((row) & 7) << 4)))
__device__ __forceinline__ int v_st(int k, int c) { const int kk = (k & ~0xC) | ((k & 4) << 1) | ((k & 8) >> 1); return ((kk >> 3) * 4 + (c >> 5)) * 512 + ((kk & 7) * 32 + (c & 31)) * 2; }
__device__ __forceinline__ int v_rd_base(int lane) { return ((lane & 3) << 3) | (((lane >> 2) & 3) << 6) | (((lane >> 4) & 1) << 5) | (((lane >> 5) & 1) << 8); }
constexpr int v_rd_off(int d0, int ks, int half) { return d0 * 512 + ks * 4096 + half * 2048; }
template <int KB>
__device__ __forceinline__ void qkt(f32x16& p0, f32x16& p1, const char* K_lds, int r32, int hi, const bf16x8* qr) {
    p0 = f32x16{}; p1 = f32x16{};
    const char* kb[4];
#pragma unroll
    for (int dd = 0; dd < 4; ++dd) kb[dd] = K_lds + KB * SHM_K + KSWZ(r32, (dd * 16 + hi * 8) * 2);
#pragma unroll
    for (int d0 = 0; d0 < 8; ++d0) { const char* a = kb[d0 & 3] + (d0 >> 2) * 128;
        bf16x8 b0 = *reinterpret_cast<const bf16x8*>(a);
        bf16x8 b1 = *reinterpret_cast<const bf16x8*>(a + 32 * 256);
        p0 = __builtin_amdgcn_mfma_f32_32x32x16_bf16(b0, qr[d0], p0, 0, 0, 0);
        p1 = __builtin_amdgcn_mfma_f32_32x32x16_bf16(b1, qr[d0], p1, 0, 0, 0); }
}
template <int VB>
__device__ __forceinline__ void pv_tile(f32x16* o, int vb0, bf16x8 pa0, bf16x8 pa1, bf16x8 pa2, bf16x8 pa3) {
#define TRRD(dst, off) asm volatile("ds_read_b64_tr_b16 %0, %1 offset:%2" : "=&v"(dst) : "v"(vb0), "i"(off) : "memory")
#define PV_D0(d0) do { s16x4 l0, l1, l2, l3, h0, h1, h2, h3; constexpr int b_ = VB * SHM_V + v_rd_off(d0, 0, 0); \
        TRRD(l0, b_); TRRD(h0, b_ + 2048); TRRD(l1, b_ + 4096); TRRD(h1, b_ + 6144); TRRD(l2, b_ + 8192); TRRD(h2, b_ + 10240); TRRD(l3, b_ + 12288); TRRD(h3, b_ + 14336); \
        asm volatile("s_waitcnt lgkmcnt(0)" ::: "memory"); SBAR(); \
        o[d0] = __builtin_amdgcn_mfma_f32_32x32x16_bf16(pa0, (bf16x8){l0[0], l0[1], l0[2], l0[3], h0[0], h0[1], h0[2], h0[3]}, o[d0], 0, 0, 0); \
        o[d0] = __builtin_amdgcn_mfma_f32_32x32x16_bf16(pa1, (bf16x8){l1[0], l1[1], l1[2], l1[3], h1[0], h1[1], h1[2], h1[3]}, o[d0], 0, 0, 0); \
        o[d0] = __builtin_amdgcn_mfma_f32_32x32x16_bf16(pa2, (bf16x8){l2[0], l2[1], l2[2], l2[3], h2[0], h2[1], h2[2], h2[3]}, o[d0], 0, 0, 0); \
        o[d0] = __builtin_amdgcn_mfma_f32_32x32x16_bf16(pa3, (bf16x8){l3[0], l3[1], l3[2], l3[3], h3[0], h3[1], h3[2], h3[3]}, o[d0], 0, 0, 0); } while (0)
    PV_D0(0); PV_D0(1); PV_D0(2); PV_D0(3);
#undef PV_D0
#undef TRRD
}
#define PK4(P, B_, OUT) do { unsigned a0 = cvtpk(P[B_+0], P[B_+1]), a1 = cvtpk(P[B_+2], P[B_+3]); \
        unsigned b0 = cvtpk(P[B_+4], P[B_+5]), b1 = cvtpk(P[B_+6], P[B_+7]); \
        auto r0 = __builtin_amdgcn_permlane32_swap(a0, b0, false, false); auto r1 = __builtin_amdgcn_permlane32_swap(a1, b1, false, false); \
        u32x4 w = {r0[0], r1[0], r0[1], r1[1]}; OUT = *reinterpret_cast<bf16x8*>(&w); } while (0)
__device__ __forceinline__ float swap_max(float x) { auto rr = __builtin_amdgcn_permlane32_swap(__float_as_uint(x), __float_as_uint(x), false, false); return fmaxf(__uint_as_float(rr[0]), __uint_as_float(rr[1])); }
__device__ __forceinline__ float swap_sum(float x) { auto rr = __builtin_amdgcn_permlane32_swap(__float_as_uint(x), __float_as_uint(x), false, false); return __uint_as_float(rr[0]) + __uint_as_float(rr[1]); }
__device__ __forceinline__ float swap_lo(float x) { auto rr = __builtin_amdgcn_permlane32_swap(__float_as_uint(x), __float_as_uint(x), false, false); return __uint_as_float(rr[0]); }


__device__ __forceinline__ void fox_sm(f32x16& p0, f32x16& p1, const float* bl, int kb_, int qlo, int qrow, int hi, int r32, float& m_reg, float& l_reg, f32x16* o, float* al_l,
                                       bf16x8& pa0, bf16x8& pa1, bf16x8& pa2, bf16x8& pa3) {
#pragma unroll
    for (int g = 0; g < 4; ++g) { const f32x4 b0v = *(const f32x4*)(bl + 8 * g + 4 * hi), b1v = *(const f32x4*)(bl + 32 + 8 * g + 4 * hi);
#pragma unroll
        for (int i = 0; i < 4; ++i) { p0[4 * g + i] = fmaf(p0[4 * g + i], C2, b0v[i]); p1[4 * g + i] = fmaf(p1[4 * g + i], C2, b1v[i]); } }
    if (kb_ + KVBLK - 1 > qlo) { const float NEG = -__builtin_inff();
#pragma unroll
        for (int r = 0; r < 16; ++r) { const int key = kb_ + crow(r, hi); if (key > qrow) p0[r] = NEG; if (key + 32 > qrow) p1[r] = NEG; } }
    float pmax = p0[0];
#pragma unroll
    for (int r = 1; r < 16; ++r) pmax = fmaxf(pmax, p0[r]);
#pragma unroll
    for (int r = 0; r < 16; ++r) pmax = fmaxf(pmax, p1[r]);
    pmax = swap_max(pmax);
    const float mn = fmaxf(m_reg, pmax), alpha = __builtin_amdgcn_exp2f(m_reg - mn); m_reg = mn;
    float ps = 0.f;
#pragma unroll
    for (int r = 0; r < 16; ++r) { p0[r] = __builtin_amdgcn_exp2f(p0[r] - mn); p1[r] = __builtin_amdgcn_exp2f(p1[r] - mn); ps += p0[r] + p1[r]; }
    ps = swap_sum(ps); l_reg = l_reg * alpha + ps;
    if (__any(alpha < 1.f)) { if (hi == 0) al_l[r32] = alpha; asm volatile("s_waitcnt lgkmcnt(0)" ::: "memory");
#pragma unroll
        for (int r = 0; r < 16; ++r) { const float a = al_l[crow(r, hi)];
#pragma unroll
            for (int d_ = 0; d_ < 4; ++d_) o[d_][r] *= a; } }
    PK4(p0, 0, pa0); PK4(p0, 8, pa1); PK4(p1, 0, pa2); PK4(p1, 8, pa3);
}
__device__ __forceinline__ void sb_half(f32x16& pz, int keybase, int qrow, int hi, float& R, const bf16x8* triA, bool needmask) {
    f32x16 X;
#pragma unroll
    for (int r = 0; r < 16; ++r) { const float zz = pz[r] * C2; const bool valid = !needmask || (keybase + crow(r, hi) < qrow);
        const float l2 = fmaxf(zz, 0.f) + __builtin_amdgcn_logf(1.0f + __builtin_amdgcn_exp2f(-fabsf(zz)));
        X[r] = valid ? -l2 : 0.f; pz[r] = valid ? zz : -__builtin_inff(); }
    f32x16 Y;
#pragma unroll
    for (int r = 0; r < 16; ++r) Y[r] = R;
#pragma unroll
    for (int s = 0; s < 2; ++s) {
        const unsigned h0 = cvtpk(X[8 * s + 0], X[8 * s + 1]), h1 = cvtpk(X[8 * s + 2], X[8 * s + 3]), h2 = cvtpk(X[8 * s + 4], X[8 * s + 5]), h3 = cvtpk(X[8 * s + 6], X[8 * s + 7]);
        const unsigned l0 = cvtpk(X[8 * s + 0] - bflo(h0), X[8 * s + 1] - bfhi(h0)), l1 = cvtpk(X[8 * s + 2] - bflo(h1), X[8 * s + 3] - bfhi(h1));
        const unsigned l2 = cvtpk(X[8 * s + 4] - bflo(h2), X[8 * s + 5] - bfhi(h2)), l3 = cvtpk(X[8 * s + 6] - bflo(h3), X[8 * s + 7] - bfhi(h3));
        u32x4 wh = {h0, h1, h2, h3}, wl = {l0, l1, l2, l3};
        Y = __builtin_amdgcn_mfma_f32_32x32x16_bf16(triA[s], *reinterpret_cast<bf16x8*>(&wh), Y, 0, 0, 0);
        Y = __builtin_amdgcn_mfma_f32_32x32x16_bf16(triA[s], *reinterpret_cast<bf16x8*>(&wl), Y, 0, 0, 0); }
#pragma unroll
    for (int r = 0; r < 16; ++r) pz[r] = __builtin_amdgcn_exp2f(pz[r] + Y[r]);
    R = swap_lo(Y[0]);
}
__device__ __forceinline__ void sb_sm(f32x16& p0, f32x16& p1, int kb_, int qlo, int qrow, int hi, float& R, const bf16x8* triA, bf16x8& pa0, bf16x8& pa1, bf16x8& pa2, bf16x8& pa3) {
    const bool needmask = (kb_ + KVBLK - 1 >= qlo);
    sb_half(p1, kb_ + 32, qrow, hi, R, triA, needmask);
    sb_half(p0, kb_, qrow, hi, R, triA, needmask);
    PK4(p0, 0, pa0); PK4(p0, 8, pa1); PK4(p1, 0, pa2); PK4(p1, 8, pa3);
}

template <int MODE>
__device__ __forceinline__ void attn_unit(const bf16_t* Q, const bf16_t* Kh, const bf16_t* Vh, const float* cum, bf16_t* O, int P0, char* lds, float kmaxc) {
    int tid = threadIdx.x; asm volatile("" : "+v"(tid));
    const int wid = __builtin_amdgcn_readfirstlane(tid >> 6), lane = tid & 63, r32 = lane & 31, hi = lane >> 5;
    const int NT = P0 / KVBLK + 4;
    char* V_lds = lds; char* K_lds = lds + OFF_K; float* bias_l = (float*)(lds + OFF_BIAS);
    float* wsl = (float*)(lds + OFF_WS) + wid * 64; float* li_l = wsl; float* al_l = wsl + 32;
    const int qlo = P0 + wid * QBLK, qrow = qlo + r32;
    bf16x8 qr[8];
#pragma unroll
    for (int d0 = 0; d0 < 8; ++d0) qr[d0] = *(const bf16x8*)(Q + (size_t)qrow * D + d0 * 16 + hi * 8);
    const int sr = tid >> 4, sc = (tid & 15) * 8, vst0 = v_st(sr, sc), vst1 = v_st(32 + sr, sc), kws = KSWZ(sr, sc * 2);
    const int vb0 = (int)(uintptr_t)V_lds + v_rd_base(lane);
    const float cumref = (MODE == 0) ? cum[P0] : 0.f;
    int* flg = (int*)(lds + OFF_FLAGS);
    float qn = 0.f;
    if (MODE == 0) { float ss = 0.f;
#pragma unroll
        for (int d0 = 0; d0 < 8; ++d0)
#pragma unroll
            for (int j = 0; j < 8; ++j) { const float x = bf2f((bf16_t)qr[d0][j]); ss = fmaf(x, x, ss); }
        ss = swap_sum(ss); qn = sqrtf(ss) * kmaxc * 1.001f; }
    float m_reg = -1e30f, l_reg = 0.f, R = 0.f; f32x16 o[4] = {};
    bf16x8 triA[2];
    if (MODE == 1) {
#pragma unroll
        for (int s = 0; s < 2; ++s)
#pragma unroll
            for (int j = 0; j < 8; ++j) { const int rho = 16 * s + 8 * (j >> 2) + 4 * hi + (j & 3); triA[s][j] = (rho >= r32) ? (short)0x3F80 : (short)0; }
    }
    bf16x8 st_k0, st_k1, st_v0, st_v1; float st_b = 0.f;
#define TILE_KB(t) ((NT - 1 - (t)) * KVBLK)
#define SLOAD(kb_) do { st_v0 = *(const bf16x8*)(Vh + (size_t)((kb_) + sr) * D + sc); st_v1 = *(const bf16x8*)(Vh + (size_t)((kb_) + 32 + sr) * D + sc); \
                        st_k0 = *(const bf16x8*)(Kh + (size_t)((kb_) + sr) * D + sc); st_k1 = *(const bf16x8*)(Kh + (size_t)((kb_) + 32 + sr) * D + sc); \
                        if (MODE == 0 && tid < 64) st_b = (cumref - cum[(kb_) + tid]) * LOG2E; } while (0)
#define SWRITE(bf) do { *(bf16x8*)(V_lds + (bf) * SHM_V + vst0) = st_v0; *(bf16x8*)(V_lds + (bf) * SHM_V + vst1) = st_v1; \
                        *(bf16x8*)(K_lds + (bf) * SHM_K + kws) = st_k0; *(bf16x8*)(K_lds + (bf) * SHM_K + kws + 32 * 256) = st_k1; \
                        if (MODE == 0 && tid < 64) bias_l[(bf) * 64 + tid] = st_b; } while (0)
    __syncthreads();
    SLOAD(TILE_KB(0)); SWRITE(0);
    __syncthreads();
    f32x16 p0, p1; bf16x8 pa0, pa1, pa2, pa3;
#define STEP(BUF, t) do { const int kb_ = TILE_KB(t); \
        if ((t) + 1 < NT) SLOAD(TILE_KB((t) + 1)); \
        SBAR(); qkt<BUF>(p0, p1, K_lds, r32, hi, qr); \
        if (MODE == 0) fox_sm(p0, p1, bias_l + (BUF) * 64, kb_, qlo, qrow, hi, r32, m_reg, l_reg, o, al_l, pa0, pa1, pa2, pa3); \
        else sb_sm(p0, p1, kb_, qlo, qrow, hi, R, triA, pa0, pa1, pa2, pa3); \
        SBAR(); pv_tile<BUF>(o, vb0, pa0, pa1, pa2, pa3); \
        if ((t) + 1 < NT) SWRITE((BUF) ^ 1); \
        __syncthreads(); } while (0)
    for (int t = 0; t < NT; t += 2) {
        STEP(0, t); STEP(1, t + 1);
        const int kbc = TILE_KB(t + 1); if (kbc == 0) break;
        bool done;
        if (MODE == 0) { const float edge = (cumref - cum[kbc - 1]) * LOG2E; done = (qn + edge - m_reg) < -EXIT_T; }
        else done = R < -EXIT_T;
        const int par = (t >> 1) & 1;
        if (lane == 0) flg[par * 8 + wid] = 0;
        const bool wdone = __all(done);
        if (lane == 0 && wdone) flg[par * 8 + wid] = 1;
        __syncthreads();
        int alld = 1;
#pragma unroll
        for (int w = 0; w < 8; ++w) alld &= flg[par * 8 + w];
        if (alld) break;
    }
    __syncthreads();
#undef STEP
#undef SLOAD
#undef SWRITE
#undef TILE_KB
    float rli[16];
    if (MODE == 0) { if (hi == 0) li_l[r32] = l_reg; asm volatile("s_waitcnt lgkmcnt(0)" ::: "memory");
#pragma unroll
        for (int r = 0; r < 16; ++r) rli[r] = __builtin_amdgcn_rcpf(li_l[crow(r, hi)]); }
    bf16_t* Ow = O + (size_t)(wid * QBLK) * 3072;
#pragma unroll
    for (int r = 0; r < 16; ++r) { const int orow = crow(r, hi);
#pragma unroll
        for (int d0 = 0; d0 < 4; ++d0) { const float v = (MODE == 0) ? o[d0][r] * rli[r] : o[d0][r];
            const float vn = __shfl_xor(v, 1);
            if ((r32 & 1) == 0) *(unsigned*)(Ow + (size_t)orow * 3072 + d0 * 32 + r32) = cvtpk(v, vn); } }
}
}

__device__ __forceinline__ void sparse_query(const Frame& F, int tok, char* ldsw) {
    unsigned char* ws = F.ws; const int lane = F.lane, g = lane >> 4, i16 = lane & 15;
    const bf16_t* qcat = (const bf16_t*)(ws + R_QCAT) + (size_t)tok * 2304; const bf16_t* kbase = (const bf16_t*)(ws + R_KCAT) + (size_t)(tok >> 13) * SEQ * 288;
    const int* sel = (const int*)(ws + R_SEL) + (size_t)tok * 256; const int ns = ((const int*)(ws + R_NSEL))[tok]; const int ntile = (ns + 31) >> 5;
    bf16x8 qf[9];
#pragma unroll
    for (int st = 0; st < 9; ++st) { qf[st] = (bf16x8){0, 0, 0, 0, 0, 0, 0, 0}; if (i16 < 8) qf[st] = *(const bf16x8*)(qcat + i16 * 288 + st * 32 + 8 * g); }
    const int rA = lane >> 2, cq = lane & 3;
    float m = -1e30f, l = 0.f; f32x4 oT[16];
#pragma unroll
    for (int rb = 0; rb < 16; ++rb) oT[rb] = (f32x4){0.f, 0.f, 0.f, 0.f};
    const unsigned ldso = (unsigned)(uintptr_t)ldsw;
    const unsigned vb = ldso + (unsigned)((4 * g + (i16 >> 2)) * 592 + (i16 & 3) * 8);
    constexpr float SC2 = SCALE * LOG2E;
    bf16x8 stg[18];
#define GATHER(tile_) do { const int j0 = (tile_) * 32 + rA, j1 = j0 + 16; const int s0 = j0 < ns ? sel[j0] : 0, s1 = j1 < ns ? sel[j1] : 0; \
        const bf16_t* p0_ = kbase + (size_t)s0 * 288 + cq * 8; const bf16_t* p1_ = kbase + (size_t)s1 * 288 + cq * 8; \
        _Pragma("unroll") for (int c = 0; c < 9; ++c) { stg[2 * c] = *(const bf16x8*)(p0_ + c * 32); stg[2 * c + 1] = *(const bf16x8*)(p1_ + c * 32); } } while (0)
    GATHER(0);
    for (int tile = 0; tile < ntile; ++tile) {
#pragma unroll
        for (int c = 0; c < 9; ++c) { *(bf16x8*)(ldsw + rA * 592 + c * 64 + cq * 16) = stg[2 * c]; *(bf16x8*)(ldsw + (16 + rA) * 592 + c * 64 + cq * 16) = stg[2 * c + 1]; }
        if (tile + 1 < ntile) GATHER(tile + 1);
        asm volatile("s_waitcnt lgkmcnt(0)" ::: "memory"); SBAR();
        f32x4 acc[2];
#pragma unroll
        for (int mt = 0; mt < 2; ++mt) { acc[mt] = (f32x4){0.f, 0.f, 0.f, 0.f};
#pragma unroll
            for (int st = 0; st < 9; ++st) { const bf16x8 a = *(const bf16x8*)(ldsw + (16 * mt + i16) * 592 + st * 64 + g * 16);
                acc[mt] = __builtin_amdgcn_mfma_f32_16x16x32_bf16(a, qf[st], acc[mt], 0, 0, 0); } }
        float tmax = -__builtin_inff();
#pragma unroll
        for (int mt = 0; mt < 2; ++mt)
#pragma unroll
            for (int r = 0; r < 4; ++r) { const int key = tile * 32 + 16 * mt + 4 * g + r; float x = acc[mt][r] * SC2; if (key >= ns) x = -__builtin_inff(); acc[mt][r] = x; tmax = fmaxf(tmax, x); }
        tmax = fmaxf(tmax, __shfl_xor(tmax, 16)); tmax = fmaxf(tmax, __shfl_xor(tmax, 32));
        const float mn = fmaxf(m, tmax), alpha = __builtin_amdgcn_exp2f(m - mn); m = mn;
        float ps = 0.f;
#pragma unroll
        for (int mt = 0; mt < 2; ++mt)
#pragma unroll
            for (int r = 0; r < 4; ++r) { acc[mt][r] = __builtin_amdgcn_exp2f(acc[mt][r] - mn); ps += acc[mt][r]; }
        ps += __shfl_xor(ps, 16); ps += __shfl_xor(ps, 32);
        l = l * alpha + ps;
#pragma unroll
        for (int rb = 0; rb < 16; ++rb) oT[rb] *= alpha;
        const bf16x8 pf = pack8(acc[0], acc[1]);
#define TRRD2(dst, off) asm volatile("ds_read_b64_tr_b16 %0, %1 offset:%2" : "=&v"(dst) : "v"(vb), "i"(off) : "memory")
#define PVRB4(rb) do { s16x4 ta0, tb0, ta1, tb1, ta2, tb2, ta3, tb3; \
        TRRD2(ta0, ((rb) + 0) * 32); TRRD2(tb0, ((rb) + 0) * 32 + 16 * 592); TRRD2(ta1, ((rb) + 1) * 32); TRRD2(tb1, ((rb) + 1) * 32 + 16 * 592); \
        TRRD2(ta2, ((rb) + 2) * 32); TRRD2(tb2, ((rb) + 2) * 32 + 16 * 592); TRRD2(ta3, ((rb) + 3) * 32); TRRD2(tb3, ((rb) + 3) * 32 + 16 * 592); \
        asm volatile("s_waitcnt lgkmcnt(0)" ::: "memory"); SBAR(); \
        oT[(rb) + 0] = __builtin_amdgcn_mfma_f32_16x16x32_bf16((bf16x8){ta0[0], ta0[1], ta0[2], ta0[3], tb0[0], tb0[1], tb0[2], tb0[3]}, pf, oT[(rb) + 0], 0, 0, 0); \
        oT[(rb) + 1] = __builtin_amdgcn_mfma_f32_16x16x32_bf16((bf16x8){ta1[0], ta1[1], ta1[2], ta1[3], tb1[0], tb1[1], tb1[2], tb1[3]}, pf, oT[(rb) + 1], 0, 0, 0); \
        oT[(rb) + 2] = __builtin_amdgcn_mfma_f32_16x16x32_bf16((bf16x8){ta2[0], ta2[1], ta2[2], ta2[3], tb2[0], tb2[1], tb2[2], tb2[3]}, pf, oT[(rb) + 2], 0, 0, 0); \
        oT[(rb) + 3] = __builtin_amdgcn_mfma_f32_16x16x32_bf16((bf16x8){ta3[0], ta3[1], ta3[2], ta3[3], tb3[0], tb3[1], tb3[2], tb3[3]}, pf, oT[(rb) + 3], 0, 0, 0); } while (0)
        PVRB4(0); PVRB4(4); PVRB4(8); PVRB4(12);
#undef PVRB4
#undef TRRD2
        SBAR();
    }
#undef GATHER
    const float rl = 1.0f / l;
    if (i16 < 8) { bf16_t* op = (bf16_t*)(ws + R_OLAT) + (size_t)tok * 2048 + i16 * 256 + 4 * g;
#pragma unroll
        for (int rb = 0; rb < 16; ++rb) { u32x2 w; w.x = cvtpk(oT[rb][0] * rl, oT[rb][1] * rl); w.y = cvtpk(oT[rb][2] * rl, oT[rb][3] * rl); *(u32x2*)(op + rb * 16) = w; } }
}
#ifdef ATT_SUB
#define ASUB(k) ((k) == ATT_SUB)
#else
#define ASUB(k) true
#endif
__device__ __forceinline__ void phase_attn(const Frame& F0, int l, int rep) { const Frame F = fresh(F0);
    unsigned char* ws = F.ws; char* lds = (char*)F.lds;
    const bf16_t* qkv = (const bf16_t*)(ws + R_QKV); const size_t TS = (size_t)NTOK * 1024;
    unsigned* qctr = (unsigned*)(ws + WS_CTL) + CW_QCTR + l * 64 + rep * 16; const unsigned* kmx = (const unsigned*)(ws + WS_CTL) + CW_KMAX + l * 16;
    int* qitem = (int*)(lds + att::OFF_QITEM);
    int* hord = qitem + 4;
    if (F.tid < 16) { const float* cumb = (const float*)(ws + WS_CUM); const float mine = -cumb[(size_t)F.tid * SEQ + SEQ - 1]; int rank = 0;
        for (int o = 0; o < 16; ++o) { const float v = -cumb[(size_t)o * SEQ + SEQ - 1]; rank += (v < mine || (v == mine && o < F.tid)) ? 1 : 0; }
        hord[rank] = F.tid; }
#pragma unroll 1
    for (;;) {
        __syncthreads();
        if (F.tid == 0) qitem[0] = (int)atomicAdd(qctr, 1u);
        __syncthreads();
        const int it = qitem[0];
        if (it >= 1024) break;
        const int md = it >> 9, j = it & 511;
        const int qb = md == 0 ? 31 - (j & 31) : 31 - (j >> 4), bh = md == 0 ? hord[j >> 5] : (j & 15), b = bh >> 3, h = bh & 7, P0 = qb * 256;
        if (!ASUB(md)) continue;
        const bf16_t* Q = qkv + (size_t)(md * 3 + 0) * TS + (size_t)bh * SEQ * 128; const bf16_t* K = qkv + (size_t)(md * 3 + 1) * TS + (size_t)bh * SEQ * 128; const bf16_t* V = qkv + (size_t)(md * 3 + 2) * TS + (size_t)bh * SEQ * 128;
        const float* cum = (const float*)(ws + WS_CUM) + (size_t)bh * SEQ;
        bf16_t* Ob = (bf16_t*)(ws + R_OA) + (size_t)b * SEQ * 3072 + (md + 1) * 1024 + h * 128;
        if (md == 0) { const float kmaxc = sqrtf(__uint_as_float(kmx[bh])) * C2; att::attn_unit<0>(Q, K, V, cum, Ob + (size_t)P0 * 3072, P0, lds, kmaxc); }
        else att::attn_unit<1>(Q, K, V, cum, Ob + (size_t)P0 * 3072, P0, lds, 0.f);
    }
    __syncthreads();
    char* ldsw = lds + F.wid * 18944;
#pragma unroll 1
    for (int rep = 0; rep < NREP(2); ++rep)
#pragma unroll 1
    for (int tok = F.bid * 8 + F.wid; tok < NTOK; tok += F.G * 8) if (ASUB(2)) sparse_query(F, tok, ldsw);
}

__device__ __forceinline__ void ln_row(const bf16_t* src, const float* g, const float* bta, float* of, bf16_t* ob, int lane, unsigned char* oq = nullptr, float* osc = nullptr, float* ost = nullptr) {
    f32x4 v[8]; float s = 0.f;
#pragma unroll
    for (int i = 0; i < 4; ++i) { const u32x4 w = *(const u32x4*)(src + (i * 64 + lane) * 8);
        v[2 * i] = (f32x4){bflo(w.x), bfhi(w.x), bflo(w.y), bfhi(w.y)}; v[2 * i + 1] = (f32x4){bflo(w.z), bfhi(w.z), bflo(w.w), bfhi(w.w)};
        s += (v[2 * i][0] + v[2 * i][1]) + (v[2 * i][2] + v[2 * i][3]) + (v[2 * i + 1][0] + v[2 * i + 1][1]) + (v[2 * i + 1][2] + v[2 * i + 1][3]); }
    s = wave_sum(s); const float mu = s * (1.0f / 2048.0f); float q = 0.f;
#pragma unroll
    for (int i = 0; i < 8; ++i) { const f32x4 d = v[i] - mu; q += (d[0] * d[0] + d[1] * d[1]) + (d[2] * d[2] + d[3] * d[3]); }
    q = wave_sum(q); const float rstd = rsqrtf(q * (1.0f / 2048.0f) + 1e-5f);
    if (ost && lane == 0) { ost[0] = mu; ost[1] = rstd; }
    float amax = 0.f;
#pragma unroll
    for (int i = 0; i < 4; ++i) { const int c = (i * 64 + lane) * 8; const f32x4 g0 = *(const f32x4*)(g + c), g1 = *(const f32x4*)(g + c + 4), b0 = *(const f32x4*)(bta + c), b1 = *(const f32x4*)(bta + c + 4);
        const f32x4 y0 = (v[2 * i] - mu) * rstd * g0 + b0, y1 = (v[2 * i + 1] - mu) * rstd * g1 + b1; v[2 * i] = y0; v[2 * i + 1] = y1;
        if (of) { *(f32x4*)(of + c) = y0; *(f32x4*)(of + c + 4) = y1; }
        if (ob) pg8::st_bf16x8(ob + c, y0, y1);
        if (oq) { amax = fmaxf(amax, fmaxf(fmaxf(fmaxf(fabsf(y0[0]), fabsf(y0[1])), fmaxf(fabsf(y0[2]), fabsf(y0[3]))), fmaxf(fmaxf(fabsf(y1[0]), fabsf(y1[1])), fmaxf(fabsf(y1[2]), fabsf(y1[3]))))); } }
    if (oq) {
        for (int o = 32; o > 0; o >>= 1) amax = fmaxf(amax, __shfl_xor(amax, o));
        amax = fmaxf(amax, 1e-20f); const float qi = 127.0f / amax; if (lane == 0) *osc = amax * (1.0f / 127.0f);
#pragma unroll
        for (int i = 0; i < 4; ++i) { u32x2 w;
#pragma unroll
            for (int h = 0; h < 2; ++h) { const f32x4 y = v[2 * i + h]; unsigned pk = 0u;
#pragma unroll
                for (int j = 0; j < 4; ++j) pk |= ((unsigned)(int)rintf(y[j] * qi) & 0xffu) << (8 * j);
                w[h] = pk; }
            *(u32x2*)(oq + (i * 64 + lane) * 8) = w; } }
}
__device__ __forceinline__ void phase_ln1_router(const Frame& F0, const Params& P, int l) { const Frame F = fresh(F0);
    unsigned char* ws = F.ws; const int lane = F.lane, wid = F.wid;
    const bf16_t* pre1 = (const bf16_t*)(ws + R_PRE1); float* x1f = (float*)(ws + M_X1F); bf16_t* x1b = (bf16_t*)(ws + M_X1B); unsigned char* x1q = (unsigned char*)(ws + M_X1Q); float* x1s = (float*)(ws + M_X1S);
    const float* g = F.in(11) + l * DM; const float* bt = F.in(12) + l * DM; const float* wr = F.in(13) + (size_t)l * DM * NEXP; const float* br = F.in(14) + l * NEXP;
    unsigned* cnt = (unsigned*)(ws + WS_CTL) + CW_CNT + l * 2048;
    int* tok_e = (int*)(ws + M_TOKE); int* tok_pos = (int*)(ws + M_TOKPOS); float* tok_w = (float*)(ws + M_TOKW);
    float* red = (float*)F.lds;
    float* lg = (float*)(F.lds + 32768); float* stats = (float*)(F.lds + 32768 + 16384);
#pragma unroll 1
    for (int blk = F.bid; blk < NTOK / 64; blk += F.G) {
        const int tok0 = blk * 64;
#pragma unroll 1
        for (int i = 0; i < 8; ++i) { const int tok = tok0 + wid * 8 + i; ln_row(pre1 + (size_t)tok * DM, g, bt, (float*)nullptr, x1b + (size_t)tok * DM, lane, x1q + (size_t)tok * DM, x1s + tok, stats + 2 * (wid * 8 + i)); }
        asm volatile("s_waitcnt vmcnt(0)" ::: "memory"); __syncthreads();
        { const int grp = wid >> 2, kq = wid & 3, i32 = lane & 31, hk = lane >> 5; f32x16 acc = {};
          const bf16_t* arow = pre1 + (size_t)(tok0 + grp * 32 + i32) * DM + kq * 512 + 4 * hk; const float* bcol = wr + (size_t)(kq * 512 + 4 * hk) * NEXP + i32;
          const float* gp = g + kq * 512 + 4 * hk; const float* bp = bt + kq * 512 + 4 * hk; const float mu = stats[2 * (grp * 32 + i32)], rstd = stats[2 * (grp * 32 + i32) + 1];
#pragma unroll 4
          for (int c8 = 0; c8 < 64; ++c8) { const u32x2 xw = *(const u32x2*)(arow + c8 * 8); const f32x4 g4 = *(const f32x4*)(gp + c8 * 8), b4 = *(const f32x4*)(bp + c8 * 8);
              const f32x4 a4 = ((f32x4){bflo(xw.x), bfhi(xw.x), bflo(xw.y), bfhi(xw.y)} - mu) * rstd * g4 + b4;
              const float b0 = bcol[(size_t)(c8 * 8 + 0) * NEXP], b1 = bcol[(size_t)(c8 * 8 + 1) * NEXP], b2 = bcol[(size_t)(c8 * 8 + 2) * NEXP], b3 = bcol[(size_t)(c8 * 8 + 3) * NEXP];
              acc = __builtin_amdgcn_mfma_f32_32x32x2f32(a4[0], b0, acc, 0, 0, 0); acc = __builtin_amdgcn_mfma_f32_32x32x2f32(a4[1], b1, acc, 0, 0, 0);
              acc = __builtin_amdgcn_mfma_f32_32x32x2f32(a4[2], b2, acc, 0, 0, 0); acc = __builtin_amdgcn_mfma_f32_32x32x2f32(a4[3], b3, acc, 0, 0, 0); }
#pragma unroll
          for (int r = 0; r < 16; ++r) red[(wid * 16 + r) * 64 + lane] = acc[r]; }
        __syncthreads();
        if ((wid & 3) == 0) { const int grp = wid >> 2, hk = lane >> 5, e = lane & 31; const float be = br[e];
#pragma unroll
            for (int r = 0; r < 16; ++r) { const float v = red[((wid + 0) * 16 + r) * 64 + lane] + red[((wid + 1) * 16 + r) * 64 + lane] + red[((wid + 2) * 16 + r) * 64 + lane] + red[((wid + 3) * 16 + r) * 64 + lane] + be;
                lg[(grp * 32 + crow(r, hk)) * 33 + e] = v; }
            asm volatile("s_waitcnt lgkmcnt(0)" ::: "memory"); SBAR();
            const int tk = lane & 31; float v[32];
#pragma unroll
            for (int e2 = 0; e2 < 32; ++e2) v[e2] = lg[(grp * 32 + tk) * 33 + e2];
            int ek[4]; float vk[4];
#pragma unroll
            for (int k = 0; k < 4; ++k) { float best = -__builtin_inff(); int bi = 0;
#pragma unroll
                for (int e2 = 0; e2 < 32; ++e2) if (v[e2] > best) { best = v[e2]; bi = e2; }
                ek[k] = bi; vk[k] = best;
#pragma unroll
                for (int e2 = 0; e2 < 32; ++e2) v[e2] = (e2 == bi) ? -__builtin_inff() : v[e2]; }
            float wk[4], sw = 0.f;
#pragma unroll
            for (int k = 0; k < 4; ++k) { wk[k] = __expf(vk[k] - vk[0]); sw += wk[k]; }
            const float rs = 1.0f / sw;
            const bool act = lane < 32; unsigned myc = 0u;
#pragma unroll 1
            for (int E = 0; E < 32; ++E) { unsigned c = 0u;
#pragma unroll
                for (int k = 0; k < 4; ++k) c += (unsigned)__popcll(__ballot(act && ek[k] == E));
                if (lane == E) myc = c; }
            unsigned run = 0u; if (lane < 32 && myc > 0u) run = atomicAdd(&cnt[lane * 64], myc);
            int pk[4];
#pragma unroll
            for (int k = 0; k < 4; ++k) { pk[k] = 0;
#pragma unroll 1
                for (int E = 0; E < 32; ++E) { const unsigned long long mm = __ballot(act && ek[k] == E); const unsigned basev = (unsigned)__shfl((int)run, E);
                    if (act && ek[k] == E) pk[k] = (int)(basev + (unsigned)__popcll(mm & ((1ull << lane) - 1ull)));
                    if (lane == E) run += (unsigned)__popcll(mm); } }
            if (act) { const int tok = tok0 + grp * 32 + tk;
#pragma unroll
                for (int k = 0; k < 4; ++k) { tok_e[tok * 4 + k] = ek[k]; tok_pos[tok * 4 + k] = pk[k]; tok_w[tok * 4 + k] = wk[k] * rs; } }
        }
        __syncthreads();
    }
}
__device__ __forceinline__ void phase_moe_gather(const Frame& F0, int l) { const Frame F = fresh(F0);
    unsigned char* ws = F.ws; const int lane = F.lane;
    const unsigned* cnt = (const unsigned*)(ws + WS_CTL) + CW_CNT + l * 2048; unsigned* meta = (unsigned*)(ws + WS_CTL) + CW_META + l * 512;
    unsigned* offs = (unsigned*)(F.lds + LDS_MISC + 64);
    if (F.tid == 0) { unsigned o = 0u; for (int e = 0; e < 32; ++e) { offs[e] = o; o += (cnt[e * 64] + 255u) & ~255u; } offs[32] = o;
        if (F.bid == 0) { meta[0] = o >> 8; for (int e = 0; e < 32; ++e) for (unsigned t = offs[e] >> 8; t < (offs[e + 1] >> 8); ++t) meta[1 + t] = (unsigned)e; } }
    __syncthreads();
    const int* tok_e = (const int*)(ws + M_TOKE); const int* tok_pos = (const int*)(ws + M_TOKPOS); const float* tok_w = (const float*)(ws + M_TOKW);
    int* tok_dst = (int*)(ws + M_TOKDST); float* roww = (float*)(ws + M_ROWW);
    const unsigned char* x1q = (const unsigned char*)(ws + M_X1Q); const float* x1s = (const float*)(ws + M_X1S); unsigned char* xs = (unsigned char*)(ws + M_XS); float* rowsx = (float*)(ws + M_ROWSX);
    unsigned* rowtok = (unsigned*)(ws + M_ROWTOK);
    for (int it = F.bid * 512 + F.tid; it < NTOK * 4; it += F.G * 512) { const int tok = it >> 2;
        const int e = tok_e[it]; const unsigned dst = offs[e] + (unsigned)tok_pos[it];
        tok_dst[it] = (int)dst; roww[dst] = tok_w[it]; rowsx[dst] = x1s[tok]; rowtok[dst] = (unsigned)tok; }
    if (F.bid < 32) { const unsigned e = (unsigned)F.bid, c0 = offs[e] + cnt[e * 64];
        for (unsigned r = c0 + (unsigned)F.tid; r < offs[e + 1]; r += 512u) rowtok[r] = 0u; }
    __syncthreads();
}
__device__ __forceinline__ void phase_quant_h(const Frame& F0, int l) { const Frame F = fresh(F0);
    unsigned char* ws = F.ws; const int lane = F.lane;
    const int nrows = (int)((const unsigned*)(ws + WS_CTL))[CW_META + l * 512] * 256;
    const float* hm = (const float*)(ws + M_HM); const bf16_t* hid = (const bf16_t*)(ws + M_HID); unsigned char* h8 = (unsigned char*)(ws + M_H8); float* h8s = (float*)(ws + M_H8S);
    for (int row = F.bid * 8 + F.wid; row < nrows; row += F.G * 8) {
        float am = hm[(size_t)row * 32 + (lane & 31)];
        const u32x4 a = *(const u32x4*)(hid + (size_t)row * DEXP + lane * 16), b = *(const u32x4*)(hid + (size_t)row * DEXP + lane * 16 + 8);
        for (int o = 16; o > 0; o >>= 1) am = fmaxf(am, __shfl_xor(am, o));
        am = fmaxf(am, 1e-20f); const float qi = 127.0f / am; if (lane == 0) h8s[row] = am * (1.0f / 127.0f);
        const unsigned wv[8] = {a.x, a.y, a.z, a.w, b.x, b.y, b.z, b.w}; u32x4 w;
#pragma unroll
        for (int d = 0; d < 4; ++d) { unsigned pk = 0u;
#pragma unroll
            for (int j = 0; j < 2; ++j) { const unsigned x = wv[d * 2 + j];
                const float q0 = fminf(fmaxf(rintf(bflo(x) * qi), -127.f), 127.f), q1 = fminf(fmaxf(rintf(bfhi(x) * qi), -127.f), 127.f);
                pk |= (((unsigned)(int)q0 & 0xffu) | (((unsigned)(int)q1 & 0xffu) << 8)) << (16 * j); }
            w[d] = pk; }
        *(u32x4*)(h8 + (size_t)row * DEXP + lane * 16) = w; }
}
__device__ __forceinline__ void phase_combine(const Frame& F0) { const Frame F = fresh(F0);
    unsigned char* ws = F.ws; const int lane = F.lane;
    const bf16_t* x1b = (const bf16_t*)(ws + M_X1B); const bf16_t* ys = (const bf16_t*)(ws + M_XS); const int* tok_dst = (const int*)(ws + M_TOKDST);
    bf16_t* hb = (bf16_t*)(ws + M_HB); unsigned char* hq = (unsigned char*)(ws + M_HQ); float* hsc = (float*)(ws + M_HSC);
    for (int tok = F.bid * 8 + F.wid; tok < NTOK; tok += F.G * 8) {
        const int d0 = tok_dst[tok * 4], d1 = tok_dst[tok * 4 + 1], d2 = tok_dst[tok * 4 + 2], d3 = tok_dst[tok * 4 + 3];
        f32x4 hv[8]; float amax = 0.f;
#pragma unroll
        for (int i = 0; i < 4; ++i) { const int c = (i * 64 + lane) * 8; const size_t o = (size_t)tok * DM + c;
            const u32x4 xw = *(const u32x4*)(x1b + o);
            f32x4 a = (f32x4){bflo(xw.x), bfhi(xw.x), bflo(xw.y), bfhi(xw.y)} * ALPHA, b = (f32x4){bflo(xw.z), bfhi(xw.z), bflo(xw.w), bfhi(xw.w)} * ALPHA;
            const u32x4 y0 = *(const u32x4*)(ys + (size_t)d0 * DM + c), y1 = *(const u32x4*)(ys + (size_t)d1 * DM + c), y2 = *(const u32x4*)(ys + (size_t)d2 * DM + c), y3 = *(const u32x4*)(ys + (size_t)d3 * DM + c);
            a[0] += (bflo(y0.x) + bflo(y1.x)) + (bflo(y2.x) + bflo(y3.x)); a[1] += (bfhi(y0.x) + bfhi(y1.x)) + (bfhi(y2.x) + bfhi(y3.x));
            a[2] += (bflo(y0.y) + bflo(y1.y)) + (bflo(y2.y) + bflo(y3.y)); a[3] += (bfhi(y0.y) + bfhi(y1.y)) + (bfhi(y2.y) + bfhi(y3.y));
            b[0] += (bflo(y0.z) + bflo(y1.z)) + (bflo(y2.z) + bflo(y3.z)); b[1] += (bfhi(y0.z) + bfhi(y1.z)) + (bfhi(y2.z) + bfhi(y3.z));
            b[2] += (bflo(y0.w) + bflo(y1.w)) + (bflo(y2.w) + bflo(y3.w)); b[3] += (bfhi(y0.w) + bfhi(y1.w)) + (bfhi(y2.w) + bfhi(y3.w));
            pg8::st_bf16x8(hb + o, a, b); hv[2 * i] = a; hv[2 * i + 1] = b;
#pragma unroll
            for (int j = 0; j < 4; ++j) amax = fmaxf(amax, fmaxf(fabsf(a[j]), fabsf(b[j]))); }
        for (int o = 32; o > 0; o >>= 1) amax = fmaxf(amax, __shfl_xor(amax, o));
        amax = fmaxf(amax, 1e-20f); const float qi = 127.0f / amax; if (lane == 0) hsc[tok] = amax * (1.0f / 127.0f);
#pragma unroll
        for (int i = 0; i < 4; ++i) { u32x2 w;
#pragma unroll
            for (int h = 0; h < 2; ++h) { unsigned pk = 0u;
#pragma unroll
                for (int j = 0; j < 4; ++j) pk |= ((unsigned)(int)rintf(hv[2 * i + h][j] * qi) & 0xffu) << (8 * j);
                w[h] = pk; }
            *(u32x2*)(hq + (size_t)tok * DM + (i * 64 + lane) * 8) = w; } }
}
__device__ __forceinline__ void phase_ln2(const Frame& F0, const Params& P, int l) { const Frame F = fresh(F0);
    unsigned char* ws = F.ws; const bf16_t* pre2 = (const bf16_t*)(ws + M_X1F); bf16_t* xb = (bf16_t*)(ws + WS_XB);
    const float* g = F.in(23) + l * DM; const float* bt = F.in(24) + l * DM; float* outp = F.out();
    for (int tok = F.bid * 8 + F.wid; tok < NTOK; tok += F.G * 8) ln_row(pre2 + (size_t)tok * DM, g, bt, (l + 1 == NLAYER) ? outp + (size_t)tok * DM : (float*)nullptr, (l + 1 == NLAYER) ? (bf16_t*)nullptr : xb + (size_t)tok * DM, F.lane,
                                                                          (l + 1 == NLAYER) ? (unsigned char*)nullptr : (unsigned char*)(ws + WS_XQ) + (size_t)tok * DM, (l + 1 == NLAYER) ? (float*)nullptr : (float*)(ws + WS_XSC) + tok);
}

constexpr int NPHASE = 2 + 15 * NLAYER;
#ifdef PH_ONLY
#define PEN(kind) ((kind) == PH_ONLY)
#else
#define PEN(kind) true
#endif
#define IN(k) (lo <= (k) && (k) < hi)
#define SEAM(k) do { if (IN((k) + 1)) xcd_barrier(bar); } while (0)

template <int l>
__device__ __forceinline__ void layer_phases(const Frame& F, const Params& P, const XcdBarrier& bar, const int lo, const int hi, unsigned char* ws0) {
    using namespace pg8;

        const int pb = 2 + 15 * l;
        if (IN(pb + 0) && PEN(0)) { size_t wz = 0; asm volatile("" : "+s"(wz)); unsigned char* ws = ws0 + wz;
            { SchedS S; S.init(NTOK, 5 * 256, F.G, F.bid, (const bf16_t*)(ws + WS_XB), DM, (const bf16_t*)(ws + W_IN), DM); S.skip_from = 0; S.skip_by = 4; S.skip_from2 = 4; S.skip_by2 = 49;
              EpiInProj<false> E{(bf16_t*)(ws + R_QA), (bf16_t*)(ws + R_QIDX), (bf16_t*)(ws + R_QKV), (bf16_t*)(ws + R_GATES), (float*)(ws + R_SMALL), nullptr, nullptr};
              for (int rep = 0; rep < NREP(5); ++rep) gemm_phase(F.ldsl, DM, DM, DM, S, E); }
            { SchedS S; S.init(NTOK, 53 * 256, F.G, (F.bid + F.G / 2) % F.G, (const bf16_t*)(ws + WS_XQ), DM / 2, (const bf16_t*)(ws + W_IN8), DM / 2); S.skip_from = 4; S.skip_by = 4; S.b_compact = 1;
              if (F.G == 256) { S.c = F.bid; S.cut = 12; S.extra_n = 192; S.extra_c = F.bid >= 64 ? F.bid - 64 : -1; }
              EpiInProj<true> E{(bf16_t*)(ws + R_QA), (bf16_t*)(ws + R_QIDX), (bf16_t*)(ws + R_QKV), (bf16_t*)(ws + R_GATES), (float*)(ws + R_SMALL), (const float*)(ws + WS_XSC), (const unsigned*)(ws + WS_CTL) + CW_WMAXG + l};
              for (int rep = 0; rep < NREP(5); ++rep) gemm_phase(F.ldsl, DM / 2, DM / 2, DM / 2, S, E); }
            SEAM(pb + 0); }
        if (IN(pb + 1) && PEN(1)) { size_t wz = 0; asm volatile("" : "+s"(wz)); unsigned char* ws = ws0 + wz;
            phase_prep(F, P, l);
            SchedS S; S.init(NTOK, 2048, F.G, F.bid, (const bf16_t*)(ws + R_QA), 1024, (const bf16_t*)(ws + W_UK2), 256, 1, 256);
            EpiBf16 E{(bf16_t*)(ws + R_QCAT), 2304, 288};
            for (int rep = 0; rep < NREP(10); ++rep) gemm_phase(F.ldsl, 256, 1024, 256, S, E); SEAM(pb + 1); }
        if (IN(pb + 2) && PEN(2)) { size_t wz = 0; asm volatile("" : "+s"(wz)); unsigned char* ws = ws0 + wz; phase_cumsum(F); for (int rep = 0; rep < NREP(3); ++rep) phase_idx(F); SEAM(pb + 2); }
        if (IN(pb + 3) && PEN(3)) { size_t wz = 0; asm volatile("" : "+s"(wz)); unsigned char* ws = ws0 + wz; for (int rep = 0; rep < NREP(4); ++rep) phase_topk(F); SEAM(pb + 3); }
        if (IN(pb + 4) && PEN(4)) { size_t wz = 0; asm volatile("" : "+s"(wz)); unsigned char* ws = ws0 + wz; for (int rep = 0; rep < NREP(1); ++rep) phase_attn(F, l, rep); SEAM(pb + 4); }
        if (IN(pb + 5) && PEN(5)) { size_t wz = 0; asm volatile("" : "+s"(wz)); unsigned char* ws = ws0 + wz;
            SchedS S; S.init(NTOK, 1024, F.G, F.bid, (const bf16_t*)(ws + R_OLAT), 2048, (const bf16_t*)(ws + W_UV2), 512, 0, 512);
            EpiBf16 E{(bf16_t*)(ws + R_OA), 3072, 256}; for (int rep = 0; rep < NREP(10); ++rep) gemm_phase(F.ldsl, 512, 2048, 512, S, E);
            SEAM(pb + 5); }
        if (IN(pb + 6) && PEN(6)) { size_t wz = 0; asm volatile("" : "+s"(wz)); unsigned char* ws = ws0 + wz;
            SchedS S; S.init(NTOK, 2048, F.G, F.bid, (const bf16_t*)(ws + R_OA), 3072, (const bf16_t*)(ws + W_BRA), 3072);
            EpiBranch3 E{(const unsigned char*)(ws + R_GATES), (bf16_t*)(ws + R_MERGED)}; for (int rep = 0; rep < NREP(11); ++rep) gemm_phase(F.ldsl, 3072, 3072, 3072, S, E); SEAM(pb + 6); }
        if (IN(pb + 7) && PEN(7)) { size_t wz = 0; asm volatile("" : "+s"(wz)); unsigned char* ws = ws0 + wz;
            SchedS S; S.init(NTOK, 2048, F.G, F.bid, (const bf16_t*)(ws + R_MERGED), DM, (const bf16_t*)(ws + W_OUT), DM);
            EpiOut E{(const bf16_t*)(ws + WS_XB), (bf16_t*)(ws + R_PRE1)}; for (int rep = 0; rep < NREP(8); ++rep) gemm_phase(F.ldsl, DM, DM, DM, S, E); SEAM(pb + 7); }
        if (IN(pb + 8) && PEN(8)) { size_t wz = 0; asm volatile("" : "+s"(wz)); unsigned char* ws = ws0 + wz; phase_ln1_router(F, P, l); SEAM(pb + 8); }
        if (IN(pb + 9) && PEN(9)) { size_t wz = 0; asm volatile("" : "+s"(wz)); unsigned char* ws = ws0 + wz;
            for (int rep = 0; rep < NREP(12); ++rep) phase_moe_gather(F, l);
            SchedS S; S.init(NTOK, 2048, F.G, F.bid, (const bf16_t*)(ws + WS_PB) + (size_t)l * NTOK * 256, 256, (const bf16_t*)(ws + W_PLE), 256);
            EpiBf16 E{(bf16_t*)(ws + M_PP), 2048, 256}; for (int rep = 0; rep < NREP(10); ++rep) gemm_phase(F.ldsl, 256, 256, 256, S, E); SEAM(pb + 9); }
        if (IN(pb + 10) && PEN(10)) { size_t wz = 0; asm volatile("" : "+s"(wz)); unsigned char* ws = ws0 + wz;
            SchedMG S; S.init((const unsigned*)(ws + WS_CTL) + CW_META + l * 512, F.G, F.bid, (const bf16_t*)(ws + M_X1Q), DM / 2, (const bf16_t*)(ws + W_GU), DM / 2);
            { LAS unsigned* gt = (LAS unsigned*)(F.ldsl + pg8::GTAB_OFF); const unsigned* rowtok = (const unsigned*)(ws + M_ROWTOK);
              for (int ui = 0; ui * F.G + F.bid < S.ntiles * 8; ++ui) { const int pm = (ui * F.G + F.bid) >> 3; if (F.tid < 256) gt[ui * 256 + F.tid] = rowtok[pm * 256 + F.tid] * 2048u; }
              __syncthreads(); }
            EpiGateUpI8 E{F.in(16) + (size_t)l * NEXP * DEXP, F.in(18) + (size_t)l * NEXP * DEXP, (bf16_t*)(ws + M_HID), (const float*)(ws + M_ROWSX), (const unsigned*)(ws + WS_CTL) + CW_WMAX + l, (float*)(ws + M_HM)};
            for (int rep = 0; rep < NREP(6); ++rep) gemm_phase(F.ldsl, DM / 2, DM / 2, DM / 2, S, E); SEAM(pb + 10); }
        if (IN(pb + 11) && PEN(11)) { size_t wz = 0; asm volatile("" : "+s"(wz)); unsigned char* ws = ws0 + wz;
            phase_quant_h(F, l); xcd_barrier(bar);
            SchedM S; S.init((const unsigned*)(ws + WS_CTL) + CW_META + l * 512, F.G, F.bid, (const bf16_t*)(ws + M_H8), DEXP / 2, (const bf16_t*)(ws + W_DN), DEXP / 2);
            EpiDownI8 E{F.in(20) + (size_t)l * NEXP * DM, (const float*)(ws + M_ROWW), (bf16_t*)(ws + M_XS), (const float*)(ws + M_H8S), (const unsigned*)(ws + WS_CTL) + CW_WMAXD + l};
            for (int rep = 0; rep < NREP(7); ++rep) gemm_phase(F.ldsl, DEXP / 2, DEXP / 2, DEXP / 2, S, E); SEAM(pb + 11); }
        if (IN(pb + 12) && PEN(12)) { size_t wz = 0; asm volatile("" : "+s"(wz)); unsigned char* ws = ws0 + wz; for (int rep = 0; rep < NREP(9); ++rep) phase_combine(F); SEAM(pb + 12); }
        if (IN(pb + 13) && PEN(13)) { size_t wz = 0; asm volatile("" : "+s"(wz)); unsigned char* ws = ws0 + wz;
            SchedS S; S.init(NTOK, 2048, F.G, F.bid, (const bf16_t*)(ws + M_HQ), DM / 2, (const bf16_t*)(ws + W_PG), DM / 2);
            EpiPleGateI8 E{(const bf16_t*)(ws + M_HB), (const bf16_t*)(ws + M_PP), (bf16_t*)(ws + M_X1F), (const float*)(ws + M_HSC), (const unsigned*)(ws + WS_CTL) + CW_WMAXP + l};
            for (int rep = 0; rep < NREP(8); ++rep) gemm_phase(F.ldsl, DM / 2, DM / 2, DM / 2, S, E); SEAM(pb + 13); }
        if (IN(pb + 14) && PEN(14)) { size_t wz = 0; asm volatile("" : "+s"(wz)); unsigned char* ws = ws0 + wz; for (int rep = 0; rep < NREP(13); ++rep) phase_ln2(F, P, l); if (l + 1 < NLAYER) for (int rep = 0; rep < NREP(0); ++rep) convert_layer_weights(F, P, l + 1); SEAM(pb + 14); }
}
__global__ void __launch_bounds__(512, 2) fwd(Params P) {
    extern __shared__ __attribute__((aligned(16))) unsigned char lds[];
    Frame F; F.lds = lds; F.ldsl = (LAS unsigned char*)lds; F.ws = P.ws; F.tid = threadIdx.x; F.lane = F.tid & 63; F.wid = __builtin_amdgcn_readfirstlane(F.tid >> 6); F.G = gridDim.x; F.bid = blockIdx.x;
    unsigned char* ws0 = P.ws; unsigned char* ws = ws0;
    const bool fused = (P.ph_hi - P.ph_lo) > 1;
    if (F.tid < 4) ((LAS unsigned*)(F.ldsl + LDS_MISC))[F.tid] = 0u;
    if (F.tid == 0) { LAS unsigned long long* t = (LAS unsigned long long*)(F.ldsl + LDS_PTRS);
#pragma unroll
        for (int k = 0; k < 25; ++k) t[k] = (unsigned long long)P.in[k];
        t[25] = (unsigned long long)P.out; }
    __syncthreads();
    XcdBarrier bar; bar.bar = (unsigned*)(ws + WS_CTL) + CW_BAR; bar.x = 0; bar.st = (volatile LAS unsigned*)(F.ldsl + LDS_MISC);
    if (fused) bar = xcd_barrier_post((unsigned*)(ws + WS_CTL) + CW_BAR, (volatile LAS unsigned*)(F.ldsl + LDS_MISC));
    const int lo = P.ph_lo, hi = P.ph_hi;
    using namespace pg8;
    if (IN(0) && PEN(15)) { size_t wz = 0; asm volatile("" : "+s"(wz)); unsigned char* ws = ws0 + wz;
        quant_rows(F, F.in(0), (bf16_t*)(ws + WS_XB), (unsigned char*)(ws + WS_XQ), (float*)(ws + WS_XSC));
        conv_rows(F, F.in(1), (bf16_t*)(ws + WS_PB), (size_t)2 * NTOK * 256 / 8);
        sample_wmax(F);
        SEAM(0);
    }
    if (IN(1) && PEN(15)) { for (int rep = 0; rep < NREP(0); ++rep) convert_layer_weights(F, P, 0); SEAM(1); }
    layer_phases<0>(F, P, bar, lo, hi, ws0);
    layer_phases<1>(F, P, bar, lo, hi, ws0);
}

#ifdef DEBUG_NAN
constexpr int CW_FLAGS = 12288;
__global__ void dbg_scan_bf16(const unsigned short* p, size_t n, unsigned* flag) { unsigned c = 0; for (size_t i = (size_t)blockIdx.x * blockDim.x + threadIdx.x; i < n; i += (size_t)gridDim.x * blockDim.x) if ((p[i] & 0x7F80u) == 0x7F80u) ++c; if (c) atomicAdd(flag, c); }
__global__ void dbg_scan_f32(const unsigned* p, size_t n, unsigned* flag) { unsigned c = 0; for (size_t i = (size_t)blockIdx.x * blockDim.x + threadIdx.x; i < n; i += (size_t)gridDim.x * blockDim.x) if ((p[i] & 0x7F800000u) == 0x7F800000u) ++c; if (c) atomicAdd(flag, c); }
__global__ void dbg_scan_sel(const int* sel, const int* nsel, unsigned* flag) { unsigned c = 0; for (size_t i = (size_t)blockIdx.x * blockDim.x + threadIdx.x; i < (size_t)NTOK * 256; i += (size_t)gridDim.x * blockDim.x) { const int tok = (int)(i >> 8), j = (int)(i & 255), t = tok & (SEQ - 1); const int ns = nsel[tok]; if (j == 0 && ns != (t + 1 < 256 ? t + 1 : 256)) ++c; if (j < ns && (sel[i] < 0 || sel[i] > t)) ++c; } if (c) atomicAdd(flag, c); }
__global__ void dbg_scan_scores(const unsigned* p, unsigned* flag) { unsigned c = 0; for (size_t i = (size_t)blockIdx.x * blockDim.x + threadIdx.x; i < 2ull * SEQ * SEQ; i += (size_t)gridDim.x * blockDim.x) { const int s = (int)(i & (SEQ - 1)), t = (int)((i >> 13) & (SEQ - 1)); if (s <= t && (p[i] & 0x7F800000u) == 0x7F800000u) ++c; } if (c) atomicAdd(flag, c); }
__global__ void dbg_probe_bf16(const unsigned short* p, size_t n, unsigned* cnt, unsigned* minidx) { unsigned c = 0; unsigned mi = 0xFFFFFFFFu; for (size_t i = (size_t)blockIdx.x * blockDim.x + threadIdx.x; i < n; i += (size_t)gridDim.x * blockDim.x) if ((p[i] & 0x7F80u) == 0x7F80u) { ++c; if ((unsigned)i < mi) mi = (unsigned)i; } if (c) { atomicAdd(cnt, c); atomicMax(minidx, ~mi); } }
__global__ void dbg_final(float* out, size_t n, const unsigned* flags) { int code = 0; for (int k = 0; k < 32; ++k) if (flags[k] && !code) code = k + 1; const int mask = (flags[32] ? 1 : 0) | (flags[33] ? 2 : 0) | (flags[34] ? 4 : 0); if (mask) code = 20 + 5 * mask; if (!code) return; for (size_t i = (size_t)blockIdx.x * blockDim.x + threadIdx.x; i < n; i += (size_t)gridDim.x * blockDim.x) out[i] = (float)code; }
#endif
extern "C" void kernel_launch(void* const* d_in, const int* in_sizes, int n_in, void* d_out, int out_size, void* d_ws, size_t ws_size, hipStream_t stream) {
    static int grid = 0;
    if (grid == 0) {
        if (n_in != 25 || out_size != NTOK * DM || ws_size < WS_NEED) { fprintf(stderr, "kernel_launch: unexpected shapes (n_in %d out %d ws %zu need %zu)\n", n_in, out_size, ws_size, (size_t)WS_NEED); grid = -1; return; }
        int dev = 0, cus = 0, per_cu = 0;
        if (hipGetDevice(&dev) != hipSuccess || hipDeviceGetAttribute(&cus, hipDeviceAttributeMultiprocessorCount, dev) != hipSuccess) { grid = -1; return; }
        if (hipFuncSetAttribute((const void*)fwd, hipFuncAttributeMaxDynamicSharedMemorySize, LDS_BYTES) != hipSuccess) { fprintf(stderr, "kernel_launch: hipFuncSetAttribute failed\n"); grid = -1; return; }
        if (hipOccupancyMaxActiveBlocksPerMultiprocessor(&per_cu, (const void*)fwd, 512, LDS_BYTES) != hipSuccess || per_cu < 1) fprintf(stderr, "kernel_launch: occupancy query says %d\n", per_cu);
        (void)hipGetLastError();
        grid = cus;
    }
    if (grid < 0) return;
    unsigned char* ws = (unsigned char*)d_ws;
    hipMemsetAsync(ws + WS_CTL, 0, CTL_BYTES, stream);
    hipMemsetAsync(ws + W_UK2, 0, 8ull * 256 * 256 * 2 + 4ull * 256 * 512 * 2, stream);
    hipMemsetAsync(ws + W_IN + (size_t)INW * 2048 * 2, 0, (size_t)(INWP - INW) * 2048 * 2, stream);
    Params p{};
    for (int i = 0; i < 25; ++i) p.in[i] = (const float*)d_in[i];
    p.out = (float*)d_out; p.ws = ws;
#if PHASES_PER_LAUNCH == 0
    p.ph_lo = 0; p.ph_hi = NPHASE;
    hipLaunchKernelGGL(fwd, dim3(grid), dim3(512), LDS_BYTES, stream, p);
#else
    for (int k = 0; k < NPHASE; ++k) { p.ph_lo = k; p.ph_hi = k + 1; hipLaunchKernelGGL(fwd, dim3(grid), dim3(512), LDS_BYTES, stream, p);
#ifdef DEBUG_NAN
        unsigned* fl = (unsigned*)(ws + WS_CTL) + CW_FLAGS + k;
#define SB16(off, n) hipLaunchKernelGGL(dbg_scan_bf16, dim3(1024), dim3(256), 0, stream, (const unsigned short*)(ws + (off)), (size_t)(n), fl)
#define SF32(off, n) hipLaunchKernelGGL(dbg_scan_f32, dim3(1024), dim3(256), 0, stream, (const unsigned*)(ws + (off)), (size_t)(n), fl)
        if (k == 0) { SB16(WS_XB, (size_t)NTOK * DM); SB16(WS_PB, 2ull * NTOK * 256); SB16(WS_W, (W_END - WS_W) / 2); }
        else { const int kind = (k - 1) % 15;
            if (kind == 0) { SB16(R_QA, (size_t)NTOK * 1024); SB16(R_QIDX, (size_t)NTOK * 1024); SB16(R_QKV, 6ull * NTOK * 1024); SB16(R_GATES, (size_t)NTOK * 6144); SF32(R_SMALL, (size_t)NTOK * 512); }
            if (kind == 1) { SB16(R_QCAT, (size_t)NTOK * 2304); SB16(R_KCAT, (size_t)NTOK * 288); SB16(R_KI, (size_t)NTOK * 64); SB16(R_QIDX, (size_t)NTOK * 1024); SF32(R_WI, (size_t)NTOK * 16); SF32(WS_LF, 16ull * 8192); }
            if (kind == 2) { SF32(WS_CUM, 16ull * 8192); hipLaunchKernelGGL(dbg_scan_scores, dim3(1024), dim3(256), 0, stream, (const unsigned*)(ws + R_SCORES), fl); }
            if (kind == 3) { hipLaunchKernelGGL(dbg_scan_sel, dim3(1024), dim3(256), 0, stream, (const int*)(ws + R_SEL), (const int*)(ws + R_NSEL), fl); }
            if (k == 5) { unsigned* fl0 = fl; fl = (unsigned*)(ws + WS_CTL) + CW_FLAGS + 32; SB16(R_OLAT, (size_t)NTOK * 2048); fl += 1; SB16(R_OA, (size_t)NTOK * 3072); fl += 1; fl = fl0; hipLaunchKernelGGL(dbg_probe_bf16, dim3(1024), dim3(256), 0, stream, (const unsigned short*)(ws + R_OC), (size_t)NTOK * 1024, (unsigned*)(ws + WS_CTL) + CW_FLAGS + 40, (unsigned*)(ws + WS_CTL) + CW_FLAGS + 41); }
            if (kind == 5) { SB16(R_OA, (size_t)NTOK * 3072); }
            if (kind == 6) { SB16(R_MERGED, (size_t)NTOK * 2048); }
            if (kind == 7) { SF32(R_PRE1, (size_t)NTOK * 2048); }
            if (kind == 8) { SF32(M_X1F, (size_t)NTOK * 2048); SF32(M_TOKW, (size_t)NTOK * 4); }
            if (kind == 9) { SB16(M_PP, (size_t)NTOK * 2048); }
            if (kind == 12) { SF32(M_HF, (size_t)NTOK * 2048); }
            if (kind == 13) { SF32(M_X1F, (size_t)NTOK * 2048); }
            if (kind == 14) { hipLaunchKernelGGL(dbg_scan_f32, dim3(1024), dim3(256), 0, stream, (const unsigned*)d_out, (size_t)NTOK * DM, fl); if (k + 1 < NPHASE) SB16(WS_W, (W_END - WS_W) / 2); } }
#endif
    }
#ifdef DEBUG_NAN
    hipLaunchKernelGGL(dbg_final, dim3(1024), dim3(256), 0, stream, (float*)d_out, (size_t)NTOK * DM, (const unsigned*)(ws + WS_CTL) + CW_FLAGS);
#endif
#endif
}
```

```cpp
#include <hip/hip_runtime.h>
#include <stdint.h>
#include <stdio.h>
#include <math.h>

#ifndef PHASES_PER_LAUNCH
#define PHASES_PER_LAUNCH 0
#endif

#define LAS __attribute__((address_space(3)))
#define GAS __attribute__((address_space(1)))
#ifndef REP_MASK
#define REP_MASK 0
#endif
#define NREP(bit) (((REP_MASK) >> (bit)) & 1 ? 2 : 1)
typedef unsigned short bf16_t;
typedef short bf16x8 __attribute__((ext_vector_type(8)));
typedef short s16x4 __attribute__((ext_vector_type(4)));
typedef float f32x4 __attribute__((ext_vector_type(4)));
typedef float f32x16 __attribute__((ext_vector_type(16)));
typedef unsigned u32x4 __attribute__((ext_vector_type(4)));
typedef unsigned u32x2 __attribute__((ext_vector_type(2)));
typedef int i32x4 __attribute__((ext_vector_type(4)));

constexpr int NTOK = 16384, DM = 2048, SEQ = 8192, NB = 2, NLAYER = 2;
constexpr int INW = 14712, INWP = 14848;
constexpr int NEXP = 32, DEXP = 1024;
constexpr int PMAX = 65536 + 8192;
constexpr float ALPHA = 1.41421356237309515f;
constexpr float LOG2E = 1.4426950408889634f;
constexpr float SCALE = 0.08838834764831845f;
constexpr float C2 = LOG2E * SCALE;

constexpr size_t MiB = 1ull << 20;
constexpr size_t WS_CTL   = 0;
constexpr size_t WS_W     = 1 * MiB;
constexpr size_t W_IN     = WS_W;
constexpr size_t W_IN8    = W_IN   + 2048ull * 2048 * 2;
constexpr size_t W_UK2    = W_IN   + (size_t)INWP * 2048 * 2;
constexpr size_t W_UV2    = W_UK2  + 8ull * 256 * 256 * 2;
constexpr size_t W_BRA    = W_UV2  + 4ull * 256 * 512 * 2;
constexpr size_t W_BRB    = W_BRA  + 2048ull * 1024 * 2;
constexpr size_t W_BRC    = W_BRB  + 2048ull * 1024 * 2;
constexpr size_t W_OUT    = W_BRC  + 2048ull * 1024 * 2;
constexpr size_t W_PG     = W_OUT  + 2048ull * 2048 * 2;
constexpr size_t W_PLE    = W_PG   + 2048ull * 2048 * 2;
constexpr size_t W_GU     = W_PLE  + 2048ull * 256 * 2;
constexpr size_t W_DN     = W_GU   + 32ull * 2048 * 2048 * 2;
constexpr size_t W_END    = W_DN   + 32ull * 2048 * 1024 * 2;
constexpr size_t WS_XB    = (W_END + MiB - 1) / MiB * MiB;
constexpr size_t WS_PB    = WS_XB  + (size_t)NTOK * DM * 2;
constexpr size_t WS_CUM   = WS_PB  + 2ull * NTOK * 256 * 2;
constexpr size_t WS_LF    = WS_CUM + 16ull * 8192 * 4;
constexpr size_t WS_XQ    = WS_LF  + 16ull * 8192 * 4;
constexpr size_t WS_XSC   = WS_XQ  + (size_t)NTOK * DM;
constexpr size_t WS_R     = (WS_XSC + (size_t)NTOK * 4 + MiB - 1) / MiB * MiB;
constexpr size_t R_SCORES = WS_R;
constexpr size_t R_OLAT   = WS_R;
constexpr size_t R_OA     = WS_R + 64 * MiB;
constexpr size_t R_OB     = WS_R + 96 * MiB;
constexpr size_t R_OC     = WS_R + 128 * MiB;
constexpr size_t R_TMP    = WS_R + 160 * MiB;
constexpr size_t R_MERGED = WS_R + 288 * MiB;
constexpr size_t R_PRE1   = WS_R + 384 * MiB;
constexpr size_t R_QA     = WS_R + 512 * MiB;
constexpr size_t R_QIDX   = WS_R + 544 * MiB;
constexpr size_t R_QKV    = WS_R + 576 * MiB;
constexpr size_t R_GATES  = WS_R + 768 * MiB;
constexpr size_t R_SMALL  = WS_R + 960 * MiB;
constexpr size_t R_QCAT   = WS_R + 992 * MiB;
constexpr size_t R_KCAT   = WS_R + 1064 * MiB;
constexpr size_t R_KI     = WS_R + 1073 * MiB;
constexpr size_t R_WI     = WS_R + 1075 * MiB;
constexpr size_t R_SEL    = WS_R + 1076 * MiB;
constexpr size_t R_NSEL   = WS_R + 1092 * MiB;
constexpr size_t R_END    = WS_R + 1093 * MiB;
constexpr size_t M_XS     = WS_R;
constexpr size_t M_HID    = WS_R + 288 * MiB;
constexpr size_t M_PP     = WS_R + 432 * MiB;
constexpr size_t M_X1F    = WS_R + 512 * MiB;
constexpr size_t M_X1B    = WS_R + 640 * MiB;
constexpr size_t M_HF     = WS_R + 704 * MiB;
constexpr size_t M_HQ     = WS_R + 704 * MiB;
constexpr size_t M_HSC    = WS_R + 736 * MiB;
constexpr size_t M_HB     = WS_R + 832 * MiB;
constexpr size_t M_TOKE   = WS_R + 896 * MiB;
constexpr size_t M_TOKPOS = M_TOKE + (size_t)NTOK * 16;
constexpr size_t M_TOKW   = M_TOKPOS + (size_t)NTOK * 16;
constexpr size_t M_TOKDST = M_TOKW + (size_t)NTOK * 16;
constexpr size_t M_ROWW   = M_TOKDST + (size_t)NTOK * 16;
constexpr size_t M_ROWSX  = M_ROWW + (size_t)PMAX * 4;
constexpr size_t M_X1S    = M_ROWSX + (size_t)PMAX * 4;
constexpr size_t M_X1Q    = WS_R + 900 * MiB;
constexpr size_t M_ROWTOK = WS_R + 750 * MiB;
constexpr size_t M_HM     = WS_R + 740 * MiB;
constexpr size_t M_H8     = WS_R + 752 * MiB;
constexpr size_t M_H8S    = WS_R + 826 * MiB;
constexpr size_t WS_NEED  = R_END;
constexpr int CW_BAR = 0;
constexpr int CW_CNT = 8192;
constexpr int CW_META = 4096 + 64;
constexpr int CW_QCTR = 6144;
constexpr int CW_WMAX = 6272;
constexpr int CW_WMAXG = 6336;
constexpr int CW_WMAXP = 6368;
constexpr int CW_WMAXD = 6384;
constexpr int CW_KMAX = 6400;
constexpr size_t CTL_BYTES = 65536;

constexpr int LDS_BYTES = 152576;
constexpr int LDS_MISC = 151552;

typedef float f32x2 __attribute__((ext_vector_type(2)));
typedef __bf16 bf16n2 __attribute__((ext_vector_type(2)));
__device__ __forceinline__ unsigned cvtpk(float lo, float hi) { f32x2 v = {lo, hi}; bf16n2 b = __builtin_convertvector(v, bf16n2); return __builtin_bit_cast(unsigned, b); }
__device__ __forceinline__ bf16_t f2bf(float x) { return (bf16_t)(cvtpk(x, 0.f) & 0xffffu); }
__device__ __forceinline__ float bf2f(bf16_t b) { return __uint_as_float(((unsigned)b) << 16); }
__device__ __forceinline__ float bflo(unsigned w) { return __uint_as_float(w << 16); }
__device__ __forceinline__ float bfhi(unsigned w) { return __uint_as_float(w & 0xffff0000u); }
__device__ __forceinline__ bf16x8 pack8(f32x4 a, f32x4 b) { u32x4 w = {cvtpk(a[0], a[1]), cvtpk(a[2], a[3]), cvtpk(b[0], b[1]), cvtpk(b[2], b[3])}; return *reinterpret_cast<bf16x8*>(&w); }
__device__ __forceinline__ float sigmoidf_(float x) { return 1.0f / (1.0f + __expf(-x)); }
__device__ __forceinline__ float wave_sum(float v) { for (int o = 32; o > 0; o >>= 1) v += __shfl_xor(v, o); return v; }
__device__ __forceinline__ int crow(int r, int hi) { return (r & 3) + 8 * (r >> 2) + 4 * hi; }
#define SBAR() __builtin_amdgcn_sched_barrier(0)

#define XB_TMO      128
#define XB_XCNT(j)  (256  + 64 * (j))
#define XB_XSUB(j)  (1280 + 64 * (j))
#define XB_XGEN(j)  (2304 + 64 * (j))
#define XB_TOP      3328
#define XB_TOPGEN   3392
#define XCD_BAR_WORDS 3456
#define XB_SPIN_CAP (1u << 22)
__device__ __forceinline__ unsigned xb_ld(unsigned* p)              { return __hip_atomic_load(p, __ATOMIC_RELAXED, __HIP_MEMORY_SCOPE_AGENT); }
__device__ __forceinline__ unsigned xb_add(unsigned* p, unsigned v) { return __hip_atomic_fetch_add(p, v, __ATOMIC_RELAXED, __HIP_MEMORY_SCOPE_AGENT); }
__device__ __forceinline__ unsigned xb_xcc_id() { return (unsigned)__builtin_amdgcn_s_getreg((3 << 11) | 20) & 0xFu; }
#define XB_SPIN(cond, bar) do { unsigned _sp = 0; while (cond) { __builtin_amdgcn_s_sleep(1); \
    if ((++_sp & 255u) == 0u) { if (xb_ld(&(bar)[XB_TMO])) break; if (_sp > XB_SPIN_CAP) { atomicAdd(&(bar)[XB_TMO], 1u); break; } } } } while (0)
struct XcdBarrier { unsigned* bar; unsigned x; volatile LAS unsigned* st; };
__device__ __forceinline__ XcdBarrier xcd_barrier_post(unsigned* bar, volatile LAS unsigned* st) {
    XcdBarrier b; b.bar = bar; b.x = xb_xcc_id(); b.st = st;
    if (threadIdx.x == 0) (void)xb_add(&bar[XB_XCNT(b.x)], 1u);
    return b;
}
__device__ __forceinline__ void xcd_barrier_complete(unsigned* bar, unsigned x, unsigned& nloc, unsigned& nx) {
    const unsigned G = gridDim.x * gridDim.y * gridDim.z;
    unsigned sum, cnt, mine, sp = 0u;
    for (;;) {
        sum = 0u; cnt = 0u; mine = 0u;
#pragma unroll
        for (unsigned j = 0; j < 16; ++j) { const unsigned c = xb_ld(&bar[XB_XCNT(j)]); sum += c; cnt += (c > 0u) ? 1u : 0u; mine = (j == x) ? c : mine; }
        if (sum == G) break;
        __builtin_amdgcn_s_sleep(1);
        if ((++sp & 255u) == 0u) { if (xb_ld(&bar[XB_TMO])) break; if (sp > XB_SPIN_CAP) { atomicAdd(&bar[XB_TMO], 1u); break; } }
    }
    nloc = mine > 0u ? mine : 1u; nx = cnt > 0u ? cnt : 1u;
}
__device__ __forceinline__ void xcd_barrier(const XcdBarrier& b) {
    asm volatile("s_waitcnt vmcnt(0)" ::: "memory");
    __syncthreads();
    if (threadIdx.x == 0) {
        unsigned* bar = b.bar;
        __builtin_amdgcn_s_waitcnt(0);
        unsigned nloc = b.st[0], nx = b.st[1];
        if (nloc == 0u) { xcd_barrier_complete(bar, b.x, nloc, nx); b.st[0] = nloc; b.st[1] = nx; }
        const unsigned old = xb_add(&bar[XB_XSUB(b.x)], 1u);
        const unsigned gen = old / nloc;
        if (old + 1u == (gen + 1u) * nloc) {
            __builtin_amdgcn_fence(__ATOMIC_RELEASE, "agent");
            asm volatile("s_waitcnt vmcnt(0)" ::: "memory");
            const unsigned og = xb_add(&bar[XB_TOP], 1u);
            const unsigned tg = og / nx;
            if (og + 1u == (tg + 1u) * nx) xb_add(&bar[XB_TOPGEN], 1u);
            else XB_SPIN(xb_ld(&bar[XB_TOPGEN]) == tg, bar);
            __builtin_amdgcn_fence(__ATOMIC_ACQUIRE, "agent");
            xb_add(&bar[XB_XGEN(b.x)], 1u);
            asm volatile("s_waitcnt vmcnt(0)" ::: "memory");
        } else {
            XB_SPIN(xb_ld(&bar[XB_XGEN(b.x)]) == gen, bar);
            __builtin_amdgcn_fence(__ATOMIC_ACQUIRE, "agent");
            asm volatile("s_waitcnt vmcnt(0)" ::: "memory");
        }
    }
    __syncthreads();
}

namespace pg8 {
constexpr int BM = 256, BK = 64, HALF = 128, HTB = HALF * BK * 2, STAGE_BYTES = 8 * HTB, NXCD = 8, WGM = 8;
__device__ __forceinline__ int lds_byte(int r, int c) { const int st = (r >> 4) * 2 + (c >> 5), rr = r & 15, cc = c & 31, ob = rr * 64 + cc * 2; return st * 1024 + (ob ^ (((ob >> 9) & 1) << 5)); }
__device__ __forceinline__ void stage_rc(int b, int& R, int& C) { const int st = b / 1024, sb = b % 1024, swz = sb ^ (((sb >> 9) & 1) << 5); R = (st >> 1) * 16 + swz / 64; C = (st & 1) * 32 + (swz % 64) / 2; }
__device__ __forceinline__ int perm32(int rho) { const int n = rho >> 4, i = rho & 15; return 8 * (i >> 2) + 4 * n + (i & 3); }
struct Unit { int pm, pn, e; };
struct SchedS {
    static constexpr bool GATHER = false;
    int nM, nN, nwg, G, c; const bf16_t* A; const bf16_t* B; int lda, ldb, a_sh, a_mul, skip_from = 1 << 30, skip_by = 0, skip_from2 = 1 << 30, skip_by2 = 0, b_compact = 0, cut = 1 << 30, extra_n = 0, extra_c = -1;
    __device__ void init(int M, int N, int G_, int c_, const bf16_t* A_, int lda_, const bf16_t* B_, int ldb_, int a_sh_ = 0, int a_mul_ = 0) {
        nM = M / BM; nN = N / BM; nwg = nM * nN; G = G_; c = c_; A = A_; B = B_; lda = lda_; ldb = ldb_; a_sh = a_sh_; a_mul = a_mul_; }
    __device__ __forceinline__ bool next(int i, Unit& u) const {
        long L = (long)i * G + c; if (i >= cut) { const int j = i - cut; if (extra_c < 0 || j >= 2) return false; L = (long)cut * G + (long)j * extra_n + extra_c; }
        if (L >= nwg) return false;
        int wgid = (int)L; { const int q = nwg / NXCD, r = nwg % NXCD, xcd = wgid % NXCD, off = wgid / NXCD; wgid = (xcd < r ? xcd * (q + 1) : r * (q + 1) + (xcd - r) * q) + off; }
        const int nig = WGM * nN, gid = wgid / nig, fm = gid * WGM, gsz = (nM - fm) < WGM ? (nM - fm) : WGM;
        u.pm = fm + ((wgid % nig) % gsz); u.pn = (wgid % nig) / gsz; u.e = 0;
        u.e = u.pn;
        { const int ci = u.pn; if (ci >= skip_from) u.pn += skip_by; if (ci >= skip_from2) u.pn += skip_by2; }
        return true;
    }
    __device__ __forceinline__ const char* pa(const Unit& u) const { return (const char*)(A + (size_t)u.pm * BM * lda + (size_t)((u.pn >> a_sh) * a_mul)); }
    __device__ __forceinline__ const char* pb(const Unit& u) const { return (const char*)(B + (size_t)(b_compact ? u.e : u.pn) * BM * ldb); }
};
struct SchedM {
    static constexpr bool GATHER = false;
    int ntiles, G, c; const bf16_t* A; const bf16_t* W; int lda, ldb; const unsigned* tile_e;
    __device__ void init(const unsigned* meta, int G_, int c_, const bf16_t* A_, int lda_, const bf16_t* W_, int ldb_) {
        ntiles = (int)meta[0]; tile_e = meta + 1; G = G_; c = c_; A = A_; W = W_; lda = lda_; ldb = ldb_; }
    __device__ __forceinline__ bool next(int i, Unit& u) const {
        const long L = (long)i * G + c; if (L >= (long)ntiles * 8) return false;
        u.pm = (int)(L >> 3); u.pn = (int)(L & 7); u.e = (int)tile_e[u.pm];
        return true;
    }
    __device__ __forceinline__ const char* pa(const Unit& u) const { return (const char*)(A + (size_t)u.pm * BM * lda); }
    __device__ __forceinline__ const char* pb(const Unit& u) const { return (const char*)(W + ((size_t)u.e * 2048 + (size_t)u.pn * BM) * ldb); }
};

constexpr int GTAB_OFF = 131072;
struct SchedMG {
    static constexpr bool GATHER = true;
    int ntiles, G, c; const bf16_t* A; const bf16_t* W; int lda, ldb; const unsigned* tile_e;
    __device__ __forceinline__ void init(const unsigned* meta, int G_, int c_, const bf16_t* A_, int lda_, const bf16_t* W_, int ldb_) {
        ntiles = (int)meta[0]; tile_e = meta + 1; G = G_; c = c_; A = A_; W = W_; lda = lda_; ldb = ldb_; }
    __device__ __forceinline__ bool next(int i, Unit& u) const {
        const long L = (long)i * G + c; if (L >= (long)ntiles * 8) return false;
        u.pm = (int)(L >> 3); u.pn = (int)(L & 7); u.e = (int)tile_e[u.pm];
        return true;
    }
    __device__ __forceinline__ const char* pa(const Unit& u) const { return (const char*)A; }
    __device__ __forceinline__ const char* pb(const Unit& u) const { return (const char*)(W + ((size_t)u.e * 2048 + (size_t)u.pn * BM) * ldb); }
};

template <class Epi, class Sched>
__device__ __forceinline__ void gemm_phase(LAS unsigned char* lds, const int K, const int lda, const int ldb, const Sched& S, const Epi& E) {
    int tid = threadIdx.x; asm volatile("" : "+v"(tid));
    const int wid = __builtin_amdgcn_readfirstlane(tid >> 6), lane = tid & 63, wr = wid >> 2, wc = wid & 3, fr = lane & 15, fq = lane >> 4;
    const int nt = K / BK;
    constexpr bool GA = Sched::GATHER;
    unsigned voffA[2], voffB[2]; int gR[2]; unsigned gC[2];
#pragma unroll
    for (int i = 0; i < 2; ++i) { int R, C; stage_rc(tid * 16 + i * 8192, R, C); const int Rb = (R & ~31) + perm32(R & 31);
        voffA[i] = (unsigned)(R * lda + C) * 2u; voffB[i] = (unsigned)(Rb * ldb + C) * 2u; gR[i] = R; gC[i] = (unsigned)C * 2u; }
    unsigned gv[2][2] = {{0u, 0u}, {0u, 0u}}, gn[2][2] = {{0u, 0u}, {0u, 0u}};
    LAS const unsigned* gtab = (LAS const unsigned*)(lds + GTAB_OFF);
#define PG8_GLOAD(dst, uidx) do { _Pragma("unroll") for (int h_ = 0; h_ < 2; ++h_) _Pragma("unroll") for (int i_ = 0; i_ < 2; ++i_) dst[h_][i_] = gtab[(uidx) * 256 + h_ * 128 + gR[i_]] + gC[i_]; } while (0)
#define PG8_STAGE_A(bufoff, ptr, h, nx) do { if constexpr (GA) { unsigned vo_[2] = {(nx) ? gn[h][0] : gv[h][0], (nx) ? gn[h][1] : gv[h][1]}; PG8_STAGE(bufoff, ptr, vo_); } \
        else { PG8_STAGE(bufoff, (ptr) + (h) * hstepA, voffA); } } while (0)
    const size_t kstep = (size_t)(BK * 2);
    const size_t hstepA = (size_t)HALF * lda * 2, hstepB = (size_t)HALF * ldb * 2;
    const unsigned ldsw = (unsigned)wid * 1024u;
    const int aoff = lds_byte(wr * 64 + fr, fq * 8), boff = lds_byte(wc * 32 + fr, fq * 8);
#define PG8_SA(b, h) (((b) * 2 + (h)) * HTB)
#define PG8_SB(b, h) ((4 + (b) * 2 + (h)) * HTB)
#define PG8_STAGE(bufoff, gbase, voff) do { _Pragma("unroll") for (int _i = 0; _i < 2; ++_i) \
        __builtin_amdgcn_global_load_lds((const unsigned*)((const char*)(gbase) + (voff)[_i]), (LAS unsigned*)(lds + (bufoff) + ldsw + _i * 8192), 16, 0, 0); } while (0)
#define PG8_LDA(dst, b, h) do { _Pragma("unroll") for (int m = 0; m < 4; ++m) _Pragma("unroll") for (int k = 0; k < 2; ++k) dst[m][k] = *(const LAS bf16x8*)(lds + PG8_SA(b, h) + aoff + m * 2048 + k * 1024); } while (0)
#define PG8_LDB(dst, b, h) do { _Pragma("unroll") for (int n = 0; n < 2; ++n) _Pragma("unroll") for (int k = 0; k < 2; ++k) dst[n][k] = *(const LAS bf16x8*)(lds + PG8_SB(b, h) + boff + n * 2048 + k * 1024); } while (0)
#define PG8_MMA(ai, bj, At, Bt) do { __builtin_amdgcn_s_setprio(1); _Pragma("unroll") for (int m = 0; m < 4; ++m) _Pragma("unroll") for (int n = 0; n < 2; ++n) _Pragma("unroll") for (int k = 0; k < 2; ++k) \
        { if constexpr (Epi::I8) acc[ai][bj][m][n] = __builtin_bit_cast(f32x4, __builtin_amdgcn_mfma_i32_16x16x64_i8(__builtin_bit_cast(i32x4, Bt[n][k]), __builtin_bit_cast(i32x4, At[m][k]), __builtin_bit_cast(i32x4, acc[ai][bj][m][n]), 0, 0, 0)); \
          else acc[ai][bj][m][n] = __builtin_amdgcn_mfma_f32_16x16x32_bf16(Bt[n][k], At[m][k], acc[ai][bj][m][n], 0, 0, 0); } __builtin_amdgcn_s_setprio(0); } while (0)
#define PG8_WAIT_V(n) asm volatile("s_waitcnt vmcnt(" #n ")" ::: "memory")
#define PG8_WAIT_L(n) asm volatile("s_waitcnt lgkmcnt(" #n ")" ::: "memory")
#define PG8_BAR __builtin_amdgcn_s_barrier()
#define PG8_SCHED __builtin_amdgcn_sched_barrier(0)
    Unit cur, nxt; int ui = 0;
    if (!S.next(0, cur)) return;
    f32x4 acc[2][2][4][2];
#pragma unroll
    for (int a = 0; a < 2; ++a)
#pragma unroll
        for (int b = 0; b < 2; ++b)
#pragma unroll
            for (int m = 0; m < 4; ++m)
#pragma unroll
                for (int n = 0; n < 2; ++n) acc[a][b][m][n] = (f32x4){0.f, 0.f, 0.f, 0.f};
    bf16x8 At[4][2], B0[2][2], B1[2][2];
    const char* cA = S.pa(cur); const char* cB = S.pb(cur);
    if constexpr (GA) { PG8_GLOAD(gv, 0); }
    PG8_STAGE(PG8_SB(0, 0), cB, voffB); PG8_STAGE_A(PG8_SA(0, 0), cA, 0, false); PG8_STAGE(PG8_SB(0, 1), cB + hstepB, voffB); PG8_STAGE_A(PG8_SA(0, 1), cA, 1, false);
    if (wr == 1) PG8_BAR;
    PG8_WAIT_V(4); PG8_BAR;
    PG8_STAGE(PG8_SB(1, 0), cB + kstep, voffB); PG8_STAGE_A(PG8_SA(1, 0), cA + kstep, 0, false); PG8_STAGE(PG8_SB(1, 1), cB + hstepB + kstep, voffB);
    PG8_WAIT_V(6); PG8_BAR;
    for (;;) {
        const bool has_next = S.next(ui + 1, nxt);
        const char* nA = has_next ? S.pa(nxt) : cA; const char* nB = has_next ? S.pb(nxt) : cB;
        if constexpr (GA) { if (has_next) { PG8_GLOAD(gn, ui + 1); } else {
#pragma unroll
                for (int h_ = 0; h_ < 2; ++h_) { gn[h_][0] = gv[h_][0]; gn[h_][1] = gv[h_][1]; } }
            asm volatile("" : "+v"(gn[0][0]), "+v"(gn[0][1]), "+v"(gn[1][0]), "+v"(gn[1][1])); }
        for (int t = 0; t < nt; t += 2) {
            const bool last = (t == nt - 2);
            if constexpr (Epi::HAS_MID) { if (t == Epi::MID1 || t == Epi::MID2) { int frM = fr, fqM = fq; asm volatile("" : "+v"(frM), "+v"(fqM)); E.mid(acc, cur, t, wr, wc, frM, fqM); } }
            const char* a1 = cA + (size_t)(t + 1) * kstep;
            const char* a2 = last ? nA : cA + (size_t)(t + 2) * kstep; const char* b2 = last ? nB : cB + (size_t)(t + 2) * kstep;
            const char* a3 = a2 + kstep; const char* b3 = b2 + kstep;
            PG8_LDB(B0, 0, 0); PG8_SCHED; PG8_LDA(At, 0, 0); PG8_STAGE_A(PG8_SA(1, 1), a1, 1, false);
            PG8_WAIT_L(8); PG8_BAR; PG8_WAIT_L(0); PG8_MMA(0, 0, At, B0); PG8_BAR; PG8_SCHED;
            PG8_LDB(B1, 0, 1); PG8_STAGE(PG8_SB(0, 0), b2, voffB);
            PG8_BAR; PG8_WAIT_L(0); PG8_MMA(0, 1, At, B1); PG8_BAR;
            PG8_LDA(At, 0, 1); PG8_STAGE_A(PG8_SA(0, 0), a2, 0, last);
            PG8_BAR; PG8_WAIT_L(0); PG8_MMA(1, 0, At, B0); PG8_BAR; PG8_SCHED;
            PG8_STAGE(PG8_SB(0, 1), b2 + hstepB, voffB);
            PG8_WAIT_V(6); PG8_BAR; PG8_MMA(1, 1, At, B1); PG8_BAR;
            PG8_LDB(B0, 1, 0); PG8_SCHED; PG8_LDA(At, 1, 0); PG8_STAGE_A(PG8_SA(0, 1), a2, 1, last);
            PG8_WAIT_L(8); PG8_BAR; PG8_WAIT_L(0); PG8_MMA(0, 0, At, B0); PG8_BAR; PG8_SCHED;
            PG8_LDB(B1, 1, 1); PG8_STAGE(PG8_SB(1, 0), b3, voffB);
            PG8_BAR; PG8_WAIT_L(0); PG8_MMA(0, 1, At, B1); PG8_BAR;
            PG8_LDA(At, 1, 1); PG8_STAGE_A(PG8_SA(1, 0), a3, 0, last);
            PG8_BAR; PG8_WAIT_L(0); PG8_MMA(1, 0, At, B0); PG8_BAR; PG8_SCHED;
            PG8_STAGE(PG8_SB(1, 1), b3 + hstepB, voffB);
            PG8_WAIT_V(6); PG8_BAR; PG8_MMA(1, 1, At, B1); PG8_BAR;
        }
        { int frE = fr, fqE = fq; asm volatile("" : "+v"(frE), "+v"(fqE)); E(acc, cur, wr, wc, frE, fqE); }
        if (!has_next) break;
#pragma unroll
        for (int a = 0; a < 2; ++a)
#pragma unroll
            for (int b = 0; b < 2; ++b)
#pragma unroll
                for (int m = 0; m < 4; ++m)
#pragma unroll
                    for (int n = 0; n < 2; ++n) acc[a][b][m][n] = (f32x4){0.f, 0.f, 0.f, 0.f};
        cur = nxt; cA = nA; cB = nB; ++ui;
        if constexpr (GA) {
#pragma unroll
            for (int h_ = 0; h_ < 2; ++h_) { gv[h_][0] = gn[h_][0]; gv[h_][1] = gn[h_][1]; } }
    }
    PG8_WAIT_V(0);
    if (wr == 0) PG8_BAR;
    PG8_BAR;
#undef PG8_SA
#undef PG8_SB
#undef PG8_STAGE
#undef PG8_STAGE_A
#undef PG8_GLOAD
#undef PG8_LDA
#undef PG8_LDB
#undef PG8_MMA
#undef PG8_WAIT_V
#undef PG8_WAIT_L
#undef PG8_BAR
#undef PG8_SCHED
}

#define EPI_LOOP_ROWS _Pragma("unroll") for (int ai = 0; ai < 2; ++ai) _Pragma("unroll") for (int m = 0; m < 4; ++m)
__device__ __forceinline__ void st_bf16x8(bf16_t* p, f32x4 v0, f32x4 v1) { u32x4 w; w.x = cvtpk(v0[0], v0[1]); w.y = cvtpk(v0[2], v0[3]); w.z = cvtpk(v1[0], v1[1]); w.w = cvtpk(v1[2], v1[3]); *(u32x4*)p = w; }

template <bool I8_> struct EpiInProj {
    static constexpr bool HAS_MID = false; static constexpr bool I8 = I8_;
    bf16_t* qa; bf16_t* qidx; bf16_t* qkv; bf16_t* gates; float* small_; const float* xs; const unsigned* wmaxbits;
    __device__ __forceinline__ f32x4 val(const f32x4& a, float sc) const { if constexpr (I8_) { const i32x4 v = __builtin_bit_cast(i32x4, a); return (f32x4){(float)v[0], (float)v[1], (float)v[2], (float)v[3]} * sc; } else return a; }
    __device__ __forceinline__ void operator()(const f32x4 (&acc)[2][2][4][2], const Unit& u, int wr, int wc, int fr, int fq) const {
        const int pn = u.pn, row0 = u.pm * BM + wr * 64 + fr, lc0 = wc * 32 + fq * 8;
        float sw = 0.f; if constexpr (I8_) sw = __uint_as_float(*wmaxbits) * (1.3f / 127.0f);
        float scs[2][4];
#pragma unroll
        for (int ai = 0; ai < 2; ++ai)
#pragma unroll
            for (int m = 0; m < 4; ++m) { scs[ai][m] = 0.f; if constexpr (I8_) scs[ai][m] = xs[row0 + ai * HALF + m * 16] * sw; }
        if (pn < 8) {
            bf16_t* base = (pn < 4 ? qa + pn * 256 : qidx + (pn - 4) * 256) + lc0;
            EPI_LOOP_ROWS { const int row = row0 + ai * HALF + m * 16; const float sc = scs[ai][m];
#pragma unroll
                for (int bj = 0; bj < 2; ++bj) st_bf16x8(base + (size_t)row * 1024 + bj * HALF, val(acc[ai][bj][m][0], sc), val(acc[ai][bj][m][1], sc)); }
        } else if (pn < 32) {
            const int id = (pn - 8) >> 2, hb = ((pn - 8) & 3) * 2, b = u.pm >> 5;
            bf16_t* base = qkv + (size_t)id * ((size_t)NTOK * 1024) + lc0;
            EPI_LOOP_ROWS { const int row = row0 + ai * HALF + m * 16, s = row & (SEQ - 1); const float sc = scs[ai][m];
#pragma unroll
                for (int bj = 0; bj < 2; ++bj) st_bf16x8(base + ((size_t)(b * 8 + hb + bj) * SEQ + s) * 128, val(acc[ai][bj][m][0], sc), val(acc[ai][bj][m][1], sc)); }
        } else if (pn < 56) {
            unsigned char* base = (unsigned char*)gates + (pn - 32) * 256 + lc0;
            EPI_LOOP_ROWS { const int row = row0 + ai * HALF + m * 16; const float sc = scs[ai][m];
#pragma unroll
                for (int bj = 0; bj < 2; ++bj) { const f32x4 v0 = val(acc[ai][bj][m][0], sc), v1 = val(acc[ai][bj][m][1], sc); u32x2 w; unsigned p0 = 0u, p1 = 0u;
#pragma unroll
                    for (int j = 0; j < 4; ++j) { p0 |= (unsigned)(int)fmaxf(rintf(255.0f * sigmoidf_(v0[j])), 1.0f) << (8 * j); p1 |= (unsigned)(int)fmaxf(rintf(255.0f * sigmoidf_(v1[j])), 1.0f) << (8 * j); }
                    w.x = p0; w.y = p1; *(u32x2*)(base + (size_t)row * 6144 + bj * HALF) = w; } }
        } else {
            float* base = small_ + (pn - 56) * 256 + lc0;
            EPI_LOOP_ROWS { const int row = row0 + ai * HALF + m * 16; const float sc = scs[ai][m];
#pragma unroll
                for (int bj = 0; bj < 2; ++bj) { float* p = base + (size_t)row * 512 + bj * HALF; *(f32x4*)p = val(acc[ai][bj][m][0], sc); *(f32x4*)(p + 4) = val(acc[ai][bj][m][1], sc); } }
        }
    }
};
struct EpiBf16 {
    static constexpr bool HAS_MID = false; static constexpr bool I8 = false;
    bf16_t* out; int ld, cstep;
    __device__ __forceinline__ void operator()(const f32x4 (&acc)[2][2][4][2], const Unit& u, int wr, int wc, int fr, int fq) const {
        const int row0 = u.pm * BM + wr * 64 + fr; bf16_t* base = out + (size_t)u.pn * cstep + wc * 32 + fq * 8;
        EPI_LOOP_ROWS { const int row = row0 + ai * HALF + m * 16;
#pragma unroll
            for (int bj = 0; bj < 2; ++bj) st_bf16x8(base + (size_t)row * ld + bj * HALF, acc[ai][bj][m][0], acc[ai][bj][m][1]); }
    }
};
struct EpiBranch3 {
    static constexpr bool HAS_MID = true; static constexpr bool I8 = false; static constexpr int MID1 = 16, MID2 = 32;
    const unsigned char* gates; bf16_t* merged;
    __device__ __forceinline__ static f32x4 rat(unsigned n, unsigned d) {
        f32x4 r; r[0] = (float)(n & 255u) * __builtin_amdgcn_rcpf((float)(d & 255u)); r[1] = (float)((n >> 8) & 255u) * __builtin_amdgcn_rcpf((float)((d >> 8) & 255u));
        r[2] = (float)((n >> 16) & 255u) * __builtin_amdgcn_rcpf((float)((d >> 16) & 255u)); r[3] = (float)(n >> 24) * __builtin_amdgcn_rcpf((float)(d >> 24)); return r; }
    __device__ __forceinline__ void mid(f32x4 (&acc)[2][2][4][2], const Unit& u, int t, int wr, int wc, int fr, int fq) const {
        const int row0 = u.pm * BM + wr * 64 + fr, col0 = u.pn * BM + wc * 32 + fq * 8, bn = (t == MID1) ? 0 : 2048;
        u32x2 gn[2][4][2], gd[2][4][2];
        EPI_LOOP_ROWS {
#pragma unroll
            for (int bj = 0; bj < 2; ++bj) { const unsigned char* gp = gates + (size_t)(row0 + ai * HALF + m * 16) * 6144 + bn + col0 + bj * HALF; gn[ai][m][bj] = *(const u32x2*)gp; gd[ai][m][bj] = *(const u32x2*)(gp + 2048); } }
        EPI_LOOP_ROWS {
#pragma unroll
            for (int bj = 0; bj < 2; ++bj) { acc[ai][bj][m][0] *= rat(gn[ai][m][bj].x, gd[ai][m][bj].x); acc[ai][bj][m][1] *= rat(gn[ai][m][bj].y, gd[ai][m][bj].y); } }
    }
    __device__ __forceinline__ void operator()(const f32x4 (&acc)[2][2][4][2], const Unit& u, int wr, int wc, int fr, int fq) const {
        const int row0 = u.pm * BM + wr * 64 + fr, col0 = u.pn * BM + wc * 32 + fq * 8;
        u32x2 gl[2][4][2];
        EPI_LOOP_ROWS {
#pragma unroll
            for (int bj = 0; bj < 2; ++bj) gl[ai][m][bj] = *(const u32x2*)(gates + (size_t)(row0 + ai * HALF + m * 16) * 6144 + 4096 + col0 + bj * HALF); }
        EPI_LOOP_ROWS { const int row = row0 + ai * HALF + m * 16;
#pragma unroll
            for (int bj = 0; bj < 2; ++bj) { const int col = col0 + bj * HALF; const u32x2 gw = gl[ai][m][bj]; constexpr float I255 = 1.0f / 255.0f;
                f32x4 v0 = acc[ai][bj][m][0], v1 = acc[ai][bj][m][1];
                v0[0] *= (float)(gw.x & 255u) * I255; v0[1] *= (float)((gw.x >> 8) & 255u) * I255; v0[2] *= (float)((gw.x >> 16) & 255u) * I255; v0[3] *= (float)(gw.x >> 24) * I255;
                v1[0] *= (float)(gw.y & 255u) * I255; v1[1] *= (float)((gw.y >> 8) & 255u) * I255; v1[2] *= (float)((gw.y >> 16) & 255u) * I255; v1[3] *= (float)(gw.y >> 24) * I255;
                st_bf16x8(merged + (size_t)row * 2048 + col, v0, v1); } }
    }
};
struct EpiOut {
    static constexpr bool HAS_MID = false; static constexpr bool I8 = false;
    const bf16_t* res; bf16_t* pre;
    __device__ __forceinline__ void operator()(const f32x4 (&acc)[2][2][4][2], const Unit& u, int wr, int wc, int fr, int fq) const {
        const int row0 = u.pm * BM + wr * 64 + fr, col0 = u.pn * BM + wc * 32 + fq * 8;
        u32x4 rl[2][4][2];
        EPI_LOOP_ROWS { const int row = row0 + ai * HALF + m * 16;
#pragma unroll
            for (int bj = 0; bj < 2; ++bj) rl[ai][m][bj] = *(const u32x4*)(res + (size_t)row * 2048 + col0 + bj * HALF); }
        EPI_LOOP_ROWS { const int row = row0 + ai * HALF + m * 16;
#pragma unroll
            for (int bj = 0; bj < 2; ++bj) { const size_t o = (size_t)row * 2048 + col0 + bj * HALF;
                const u32x4 rw = rl[ai][m][bj]; f32x4 v0 = acc[ai][bj][m][0], v1 = acc[ai][bj][m][1];
                v0[0] += ALPHA * bflo(rw.x); v0[1] += ALPHA * bfhi(rw.x); v0[2] += ALPHA * bflo(rw.y); v0[3] += ALPHA * bfhi(rw.y);
                v1[0] += ALPHA * bflo(rw.z); v1[1] += ALPHA * bfhi(rw.z); v1[2] += ALPHA * bflo(rw.w); v1[3] += ALPHA * bfhi(rw.w);
                st_bf16x8(pre + o, v0, v1); } }
    }
};
struct EpiGateUpI8 {
    static constexpr bool HAS_MID = false; static constexpr bool I8 = true;
    const float* bg; const float* bu; bf16_t* hid; const float* rowsx; const unsigned* wmaxbits; float* hm;
    __device__ __forceinline__ void operator()(const f32x4 (&acc)[2][2][4][2], const Unit& u, int wr, int wc, int fr, int fq) const {
        const int row0 = u.pm * BM + wr * 64 + fr, j0 = u.pn * 128 + wc * 32 + fq * 8;
        const float sw = __uint_as_float(*wmaxbits) * (1.3f / 127.0f);
        const float* pg = bg + (size_t)u.e * DEXP + j0; const float* pu = bu + (size_t)u.e * DEXP + j0;
        const f32x4 g0b = *(const f32x4*)pg, g1b = *(const f32x4*)(pg + 4), u0b = *(const f32x4*)pu, u1b = *(const f32x4*)(pu + 4);
        float scs[2][4];
#pragma unroll
        for (int ai = 0; ai < 2; ++ai)
#pragma unroll
            for (int m = 0; m < 4; ++m) scs[ai][m] = rowsx[row0 + ai * HALF + m * 16] * sw;
        EPI_LOOP_ROWS { const int row = row0 + ai * HALF + m * 16; const float sc = scs[ai][m];
            const i32x4 ag0 = __builtin_bit_cast(i32x4, acc[ai][0][m][0]), ag1 = __builtin_bit_cast(i32x4, acc[ai][0][m][1]), au0 = __builtin_bit_cast(i32x4, acc[ai][1][m][0]), au1 = __builtin_bit_cast(i32x4, acc[ai][1][m][1]);
            f32x4 h0, h1;
#pragma unroll
            for (int j = 0; j < 4; ++j) {
                float g = fminf((float)ag0[j] * sc + g0b[j], 7.0f), uu = fminf(fmaxf((float)au0[j] * sc + u0b[j], -7.0f), 7.0f);
                h0[j] = (uu + 1.0f) * (g * sigmoidf_(1.702f * g));
                g = fminf((float)ag1[j] * sc + g1b[j], 7.0f); uu = fminf(fmaxf((float)au1[j] * sc + u1b[j], -7.0f), 7.0f);
                h1[j] = (uu + 1.0f) * (g * sigmoidf_(1.702f * g)); }
            st_bf16x8(hid + (size_t)row * DEXP + j0, h0, h1);
            float am = fmaxf(fmaxf(fmaxf(fabsf(h0[0]), fabsf(h0[1])), fmaxf(fabsf(h0[2]), fabsf(h0[3]))), fmaxf(fmaxf(fabsf(h1[0]), fabsf(h1[1])), fmaxf(fabsf(h1[2]), fabsf(h1[3]))));
            am = fmaxf(am, __shfl_xor(am, 16)); am = fmaxf(am, __shfl_xor(am, 32));
            if (fq == 0) hm[(size_t)row * 32 + u.pn * 4 + wc] = am; }
    }
};
struct EpiDown {
    static constexpr bool HAS_MID = false; static constexpr bool I8 = false;
    const float* bd; const float* roww; bf16_t* ys;
    __device__ __forceinline__ void operator()(const f32x4 (&acc)[2][2][4][2], const Unit& u, int wr, int wc, int fr, int fq) const {
        const int row0 = u.pm * BM + wr * 64 + fr, col0 = u.pn * BM + wc * 32 + fq * 8;
        f32x4 b[2][2];
#pragma unroll
        for (int bj = 0; bj < 2; ++bj) { const float* p = bd + (size_t)u.e * DM + col0 + bj * HALF; b[bj][0] = *(const f32x4*)p; b[bj][1] = *(const f32x4*)(p + 4); }
        float rws[2][4];
#pragma unroll
        for (int ai = 0; ai < 2; ++ai)
#pragma unroll
            for (int m = 0; m < 4; ++m) rws[ai][m] = roww[row0 + ai * HALF + m * 16];
        EPI_LOOP_ROWS { const int row = row0 + ai * HALF + m * 16; const float w = rws[ai][m];
#pragma unroll
            for (int bj = 0; bj < 2; ++bj) st_bf16x8(ys + (size_t)row * 2048 + col0 + bj * HALF, (acc[ai][bj][m][0] + b[bj][0]) * w, (acc[ai][bj][m][1] + b[bj][1]) * w); }
    }
};
struct EpiDownI8 {
    static constexpr bool HAS_MID = false; static constexpr bool I8 = true;
    const float* bd; const float* roww; bf16_t* ys; const float* h8s; const unsigned* wmaxbits;
    __device__ __forceinline__ void operator()(const f32x4 (&acc)[2][2][4][2], const Unit& u, int wr, int wc, int fr, int fq) const {
        const int row0 = u.pm * BM + wr * 64 + fr, col0 = u.pn * BM + wc * 32 + fq * 8;
        const float sw = __uint_as_float(*wmaxbits) * (1.3f / 127.0f);
        f32x4 b[2][2];
#pragma unroll
        for (int bj = 0; bj < 2; ++bj) { const float* p = bd + (size_t)u.e * DM + col0 + bj * HALF; b[bj][0] = *(const f32x4*)p; b[bj][1] = *(const f32x4*)(p + 4); }
        float rws[2][4], scs[2][4];
#pragma unroll
        for (int ai = 0; ai < 2; ++ai)
#pragma unroll
            for (int m = 0; m < 4; ++m) { rws[ai][m] = roww[row0 + ai * HALF + m * 16]; scs[ai][m] = h8s[row0 + ai * HALF + m * 16] * sw; }
        EPI_LOOP_ROWS { const int row = row0 + ai * HALF + m * 16; const float w = rws[ai][m], sc = scs[ai][m];
#pragma unroll
            for (int bj = 0; bj < 2; ++bj) { const i32x4 a0 = __builtin_bit_cast(i32x4, acc[ai][bj][m][0]), a1 = __builtin_bit_cast(i32x4, acc[ai][bj][m][1]);
                const f32x4 v0 = (f32x4){(float)a0[0], (float)a0[1], (float)a0[2], (float)a0[3]} * sc, v1 = (f32x4){(float)a1[0], (float)a1[1], (float)a1[2], (float)a1[3]} * sc;
                st_bf16x8(ys + (size_t)row * 2048 + col0 + bj * HALF, (v0 + b[bj][0]) * w, (v1 + b[bj][1]) * w); } }
    }
};
struct EpiPleGateI8 {
    static constexpr bool HAS_MID = false; static constexpr bool I8 = true;
    const bf16_t* hb; const bf16_t* pp; bf16_t* pre; const float* hs; const unsigned* wmaxbits;
    __device__ __forceinline__ void operator()(const f32x4 (&acc)[2][2][4][2], const Unit& u, int wr, int wc, int fr, int fq) const {
        const int row0 = u.pm * BM + wr * 64 + fr, col0 = u.pn * BM + wc * 32 + fq * 8;
        const float sw = __uint_as_float(*wmaxbits) * (1.3f / 127.0f);
#pragma unroll
        for (int ai = 0; ai < 2; ++ai) { u32x4 pl[4][2], hl[4][2]; float scs[4];
#pragma unroll
            for (int m = 0; m < 4; ++m) { scs[m] = hs[row0 + ai * HALF + m * 16] * sw;
#pragma unroll
                for (int bj = 0; bj < 2; ++bj) { const size_t o = (size_t)(row0 + ai * HALF + m * 16) * 2048 + col0 + bj * HALF; pl[m][bj] = *(const u32x4*)(pp + o); hl[m][bj] = *(const u32x4*)(hb + o); } }
#pragma unroll
            for (int m = 0; m < 4; ++m) { const float sc = scs[m];
#pragma unroll
                for (int bj = 0; bj < 2; ++bj) { const size_t o = (size_t)(row0 + ai * HALF + m * 16) * 2048 + col0 + bj * HALF; const u32x4 pw = pl[m][bj], hw = hl[m][bj];
                    const i32x4 a0 = __builtin_bit_cast(i32x4, acc[ai][bj][m][0]), a1 = __builtin_bit_cast(i32x4, acc[ai][bj][m][1]); f32x4 o0, o1;
                    o0[0] = bflo(hw.x) + sigmoidf_((float)a0[0] * sc) * bflo(pw.x); o0[1] = bfhi(hw.x) + sigmoidf_((float)a0[1] * sc) * bfhi(pw.x); o0[2] = bflo(hw.y) + sigmoidf_((float)a0[2] * sc) * bflo(pw.y); o0[3] = bfhi(hw.y) + sigmoidf_((float)a0[3] * sc) * bfhi(pw.y);
                    o1[0] = bflo(hw.z) + sigmoidf_((float)a1[0] * sc) * bflo(pw.z); o1[1] = bfhi(hw.z) + sigmoidf_((float)a1[1] * sc) * bfhi(pw.z); o1[2] = bflo(hw.w) + sigmoidf_((float)a1[2] * sc) * bflo(pw.w); o1[3] = bfhi(hw.w) + sigmoidf_((float)a1[3] * sc) * bfhi(pw.w);
                    st_bf16x8(pre + o, o0, o1); } } }
    }
};
}

struct Params { const float* in[25]; float* out; unsigned char* ws; int ph_lo, ph_hi; };
__constant__ float c_invf_r[16] = {1.000000000e+00f, 4.403665960e-01f, 1.939227432e-01f, 8.539710194e-02f, 3.760603070e-02f, 1.656043902e-02f, 7.292664610e-03f, 3.211445874e-03f, 1.414213562e-03f, 6.227723788e-04f, 2.742481884e-04f, 1.207697351e-04f, 5.318296098e-05f, 2.341999971e-05f, 1.031338616e-05f, 4.541670478e-06f};
__constant__ float c_invf_i[8] = {1.000000000e+00f, 1.939227432e-01f, 3.760603070e-02f, 7.292664610e-03f, 1.414213562e-03f, 2.742481884e-04f, 5.318296098e-05f, 1.031338616e-05f};
constexpr int LDS_PTRS = LDS_MISC + 256;
struct Frame { unsigned char* lds; LAS unsigned char* ldsl; unsigned char* ws; int tid, lane, wid, G, bid;
    __device__ __forceinline__ const float* in(int k) const { const LAS unsigned* t = (const LAS unsigned*)(ldsl + LDS_PTRS) + 2 * k;
        const unsigned lo = __builtin_amdgcn_readfirstlane(t[0]), hi = __builtin_amdgcn_readfirstlane(t[1]); return (const float*)(const GAS float*)(((unsigned long long)hi << 32) | lo); }
    __device__ __forceinline__ float* out() const { return (float*)in(25); } };
__device__ __forceinline__ Frame fresh(const Frame& F0) { Frame F = F0; int t = threadIdx.x; asm volatile("" : "+v"(t)); F.tid = t; F.lane = t & 63; F.wid = __builtin_amdgcn_readfirstlane(t >> 6); size_t z = 0; asm volatile("" : "+s"(z)); F.ws = F0.ws + z; return F; }

struct TcTile { const float* src; long sld; bf16_t* dst; long dld; int nvalid; float qinv; };
template <class Dec>
__device__ __forceinline__ void tconv_run(const Frame& F, int total, const Dec& dec, int& rot) {
    float* tile = (float*)F.lds;
    const int tid = F.tid, G = F.G;
    const int start = (F.bid - (rot % G) + G) % G; rot += total >> 2;
    const int lr = tid >> 4, lc4 = (tid & 15) * 4, sn = tid >> 3, skc = (tid & 7) * 8;
    f32x4 v[4][2];
#define TC_ISSUE(t0_) do { _Pragma("unroll") for (int q = 0; q < 4; ++q) { const int t = (t0_) * 4 + q; \
        if (t < total) { const TcTile ti = dec(dec.remap(t)); _Pragma("unroll") for (int h = 0; h < 2; ++h) { v[q][h] = (f32x4){0.f, 0.f, 0.f, 0.f}; \
            if (lc4 < ti.nvalid) v[q][h] = *(const GAS f32x4*)((const GAS float*)ti.src + (size_t)(lr + 32 * h) * ti.sld + lc4); } } } } while (0)
    if (start * 4 < total) TC_ISSUE(start);
    for (int t0 = start; t0 * 4 < total; t0 += G) {
#pragma unroll
        for (int q = 0; q < 4; ++q) { if (t0 * 4 + q < total) { float* tl = tile + q * (64 * 65);
#pragma unroll
                for (int h = 0; h < 2; ++h) { float* p = tl + (lr + 32 * h) * 65 + lc4; p[0] = v[q][h][0]; p[1] = v[q][h][1]; p[2] = v[q][h][2]; p[3] = v[q][h][3]; } } }
        __syncthreads();
        if ((t0 + G) * 4 < total) TC_ISSUE(t0 + G);
#pragma unroll
        for (int q = 0; q < 4; ++q) { const int t = t0 * 4 + q;
            if (t < total) { const TcTile ti = dec(dec.remap(t)); const float* tl = tile + q * (64 * 65);
                if (ti.qinv > 0.f) { if (tid < 256) { const int n8 = tid >> 2, kc = (tid & 3) * 16; u32x4 w;
#pragma unroll
                        for (int d = 0; d < 4; ++d) { unsigned pk = 0u;
#pragma unroll
                            for (int j = 0; j < 4; ++j) { float q = rintf(tl[(kc + d * 4 + j) * 65 + n8] * ti.qinv); q = fminf(fmaxf(q, -127.f), 127.f); pk |= ((unsigned)(int)q & 0xffu) << (8 * j); }
                            w[d] = pk; }
                        *(u32x4*)((unsigned char*)ti.dst + (size_t)n8 * ti.dld + kc) = w; } }
                else if (sn < ti.nvalid) { f32x4 a, b;
#pragma unroll
                    for (int j = 0; j < 4; ++j) { a[j] = tl[(skc + j) * 65 + sn]; b[j] = tl[(skc + 4 + j) * 65 + sn]; }
                    pg8::st_bf16x8(ti.dst + (size_t)sn * ti.dld + skc, a, b); } } }
        __syncthreads();
    }
#undef TC_ISSUE
}
struct TcMat {
    const float* src; long src_ld; int tk, ncols; bf16_t* dst; long dst_ld; float qinv;
    __device__ __forceinline__ int remap(int i) const { const int ntn = (ncols + 63) >> 6; if (ntn & 1) return i;
        const int g = i >> 2, q = i & 3, tkh = tk >> 1, gk = g % tkh, gn = g / tkh; return (2 * gn + (q >> 1)) * tk + 2 * gk + (q & 1); }
    __device__ __forceinline__ TcTile operator()(int t) const { const int k0 = (t % tk) * 64, n0 = (t / tk) * 64; TcTile ti;
        ti.src = src + (size_t)k0 * src_ld + n0; ti.sld = src_ld; ti.dst = qinv > 0.f ? (bf16_t*)((unsigned char*)dst + (size_t)n0 * dst_ld + k0) : dst + (size_t)n0 * dst_ld + k0; ti.dld = dst_ld; ti.nvalid = (ncols - n0) < 64 ? (ncols - n0) : 64; ti.qinv = qinv; return ti; }
};
__device__ __forceinline__ void tconv(const Frame& F, const float* src, long src_ld, int K, int ncols, bf16_t* dst, long dst_ld, int& rot) {
    TcMat d{src, src_ld, K >> 6, ncols, dst, dst_ld, 0.f}; tconv_run(F, (K >> 6) * ((ncols + 63) >> 6), d, rot);
}
struct TcExperts {
    const float* wg; const float* wu; const float* wd; unsigned char* dgu; unsigned char* ddn; float qinv, qinvd;
    __device__ __forceinline__ int remap(int i) const { const int e = i / 1536, ri = i - e * 1536;
        if (ri < 1024) { const int g = ri >> 2, q = ri & 3, gk = g & 15, gn = g >> 4; return e * 1536 + (2 * gn + (q >> 1)) * 32 + 2 * gk + (q & 1); }
        const int r2 = ri - 1024, g = r2 >> 2, q = r2 & 3, gk = g & 7, gn = g >> 3; return e * 1536 + 1024 + (2 * gn + (q >> 1)) * 16 + 2 * gk + (q & 1); }
    __device__ __forceinline__ TcTile operator()(int t) const { const int e = t / 1536, r = t - e * 1536; TcTile ti; ti.nvalid = 64; ti.qinv = 0.f;
        if (r < 1024) { const int k0 = (r & 31) * 64, dt = r >> 5, jb = dt >> 2, gu = (dt >> 1) & 1, half = dt & 1;
            ti.src = (const float*)((unsigned long long)wg + (unsigned long long)gu * ((unsigned long long)wu - (unsigned long long)wg)) + (size_t)e * DM * DEXP + (size_t)k0 * DEXP + jb * 128 + half * 64; ti.sld = DEXP;
            ti.dst = (bf16_t*)(dgu + (size_t)e * 2048 * 2048 + (size_t)(dt * 64) * 2048 + k0); ti.dld = 2048; ti.qinv = qinv; }
        else { const int r2 = r - 1024, k0 = (r2 & 15) * 64, n0 = (r2 >> 4) * 64;
            ti.src = wd + (size_t)e * DEXP * DM + (size_t)k0 * DM + n0; ti.sld = DM;
            ti.dst = (bf16_t*)(ddn + (size_t)e * 2048 * 1024 + (size_t)n0 * 1024 + k0); ti.dld = 1024; ti.qinv = qinvd; }
        return ti; }
};
__device__ __forceinline__ void sample_wmax(const Frame& F) {
    unsigned* wm = (unsigned*)(F.ws + WS_CTL) + CW_WMAX;
#pragma unroll 1
    for (int l = 0; l < NLAYER; ++l) { float mx = 0.f;
#pragma unroll 1
        for (int which = 0; which < 2; ++which) { const f32x4* p = (const f32x4*)(F.in(which ? 17 : 15) + (size_t)l * NEXP * DM * DEXP);
            for (size_t i = (size_t)F.bid * 512 + F.tid; i < (size_t)NEXP * DM * DEXP / 4 / 64; i += (size_t)F.G * 512) { const size_t j = i >> 3; const f32x4 v = p[j * 512 + 8 * (j & 63) + (i & 7)];
                mx = fmaxf(mx, fmaxf(fmaxf(fabsf(v[0]), fabsf(v[1])), fmaxf(fabsf(v[2]), fabsf(v[3])))); } }
        for (int o = 32; o > 0; o >>= 1) mx = fmaxf(mx, __shfl_xor(mx, o));
        if (F.lane == 0 && mx > 0.f) atomicMax(&wm[l], __float_as_uint(mx));
        float mg = 0.f; const f32x4* wi_ = (const f32x4*)(F.in(2) + (size_t)l * DM * INW);
        for (int i = F.bid * 512 + F.tid; i < DM * (INW / 4) / 16; i += F.G * 512) { const size_t j = (size_t)(i >> 3); const f32x4 v = wi_[j * 128 + 8 * (j & 15) + (i & 7)];
            mg = fmaxf(mg, fmaxf(fmaxf(fabsf(v[0]), fabsf(v[1])), fmaxf(fabsf(v[2]), fabsf(v[3])))); }
        for (int o = 32; o > 0; o >>= 1) mg = fmaxf(mg, __shfl_xor(mg, o));
        if (F.lane == 0 && mg > 0.f) atomicMax(&wm[CW_WMAXG - CW_WMAX + l], __float_as_uint(mg));
        float mp = 0.f; const f32x4* wp_ = (const f32x4*)(F.in(21) + (size_t)l * DM * DM);
        for (int i = F.bid * 512 + F.tid; i < DM * DM / 4 / 16; i += F.G * 512) { const int j = i >> 3; const f32x4 v = wp_[j * 128 + 8 * (j & 15) + (i & 7)];
            mp = fmaxf(mp, fmaxf(fmaxf(fabsf(v[0]), fabsf(v[1])), fmaxf(fabsf(v[2]), fabsf(v[3])))); }
        for (int o = 32; o > 0; o >>= 1) mp = fmaxf(mp, __shfl_xor(mp, o));
        if (F.lane == 0 && mp > 0.f) atomicMax(&wm[CW_WMAXP - CW_WMAX + l], __float_as_uint(mp));
        float md = 0.f; const f32x4* wd_ = (const f32x4*)(F.in(19) + (size_t)l * NEXP * DEXP * DM);
        for (size_t i = (size_t)F.bid * 512 + F.tid; i < (size_t)NEXP * DEXP * DM / 4 / 64; i += (size_t)F.G * 512) { const size_t j = i >> 3; const f32x4 v = wd_[j * 512 + 8 * (j & 63) + (i & 7)];
            md = fmaxf(md, fmaxf(fmaxf(fabsf(v[0]), fabsf(v[1])), fmaxf(fabsf(v[2]), fabsf(v[3])))); }
        for (int o = 32; o > 0; o >>= 1) md = fmaxf(md, __shfl_xor(md, o));
        if (F.lane == 0 && md > 0.f) atomicMax(&wm[CW_WMAXD - CW_WMAX + l], __float_as_uint(md)); }
}
__device__ __forceinline__ void conv_rows(const Frame& F, const float* src, bf16_t* dst, size_t n8) {
    for (size_t i = (size_t)F.bid * 512 + F.tid; i < n8; i += (size_t)F.G * 512) { const f32x4 a = *(const f32x4*)(src + i * 8), b = *(const f32x4*)(src + i * 8 + 4); pg8::st_bf16x8(dst + i * 8, a, b); }
}
__device__ __forceinline__ void quant_rows(const Frame& F, const float* src, bf16_t* xb, unsigned char* xq, float* xsc) {
    const int lane = F.lane;
    for (int tok = F.bid * 8 + F.wid; tok < NTOK; tok += F.G * 8) { f32x4 v[8]; float amax = 0.f;
#pragma unroll
        for (int i = 0; i < 4; ++i) { const int c = (i * 64 + lane) * 8; v[2 * i] = *(const f32x4*)(src + (size_t)tok * DM + c); v[2 * i + 1] = *(const f32x4*)(src + (size_t)tok * DM + c + 4);
            pg8::st_bf16x8(xb + (size_t)tok * DM + c, v[2 * i], v[2 * i + 1]);
#pragma unroll
            for (int h = 0; h < 2; ++h)
#pragma unroll
                for (int j = 0; j < 4; ++j) amax = fmaxf(amax, fabsf(v[2 * i + h][j])); }
        for (int o = 32; o > 0; o >>= 1) amax = fmaxf(amax, __shfl_xor(amax, o));
        amax = fmaxf(amax, 1e-20f); const float qi = 127.0f / amax; if (lane == 0) xsc[tok] = amax * (1.0f / 127.0f);
#pragma unroll
        for (int i = 0; i < 4; ++i) { u32x2 w;
#pragma unroll
            for (int h = 0; h < 2; ++h) { unsigned pk = 0u;
#pragma unroll
                for (int j = 0; j < 4; ++j) pk |= ((unsigned)(int)rintf(v[2 * i + h][j] * qi) & 0xffu) << (8 * j);
                w[h] = pk; }
            *(u32x2*)(xq + (size_t)tok * DM + (i * 64 + lane) * 8) = w; } }
}
__constant__ int c_so[14] = {0, 1312, 2416, 3440, 4464, 5496, 6520, 7544, 8568, 1024, 1280, 2336, 2400, 5488};
__constant__ int c_dn[14] = {0, 1024, 2048, 3072, 4096, 5120, 6144, 7168, 8192, 14336, 14592, 14624, 14688, 14704};
__constant__ int c_nc[14] = {1024, 1024, 1024, 1024, 1024, 1024, 1024, 1024, 6144, 256, 32, 64, 16, 8};
__device__ __forceinline__ void convert_layer_weights(const Frame& F0, const Params& P, int l) { const Frame F = fresh(F0);
    unsigned char* ws = F.ws; int rot = 0;
    { const float* w = F.in(2) + (size_t)l * DM * INW; bf16_t* d = (bf16_t*)(ws + W_IN);
      const float wmaxg = __uint_as_float(((const unsigned*)(ws + WS_CTL))[CW_WMAXG + l]); const float qinv = 127.0f / (1.3f * fmaxf(wmaxg, 1e-30f));
#pragma unroll 1
      for (int s = 0; s < 14; ++s) {
          if (s == 1 || s >= 10) tconv(F, w + c_so[s], INW, DM, c_nc[s], d + (size_t)c_dn[s] * DM, DM, rot);
          else { const int crow = (s == 0) ? 0 : (s <= 7 ? 1024 + (s - 2) * 1024 : (s == 8 ? 7168 : 13312));
              TcMat dq{w + c_so[s], INW, DM >> 6, c_nc[s], (bf16_t*)(ws + W_IN8 + (size_t)crow * 2048), 2048, qinv}; tconv_run(F, (DM >> 6) * (c_nc[s] >> 6), dq, rot); } } }
    tconv(F, F.in(7) + (size_t)l * 1024 * DM, DM, 1024, DM, (bf16_t*)(ws + W_BRA), 3072, rot);
    tconv(F, F.in(8) + (size_t)l * 1024 * DM, DM, 1024, DM, (bf16_t*)(ws + W_BRA) + 1024, 3072, rot);
    tconv(F, F.in(9) + (size_t)l * 1024 * DM, DM, 1024, DM, (bf16_t*)(ws + W_BRA) + 2048, 3072, rot);
    tconv(F, F.in(10) + (size_t)l * DM * DM, DM, DM, DM, (bf16_t*)(ws + W_OUT), DM, rot);
    { const float wmp = __uint_as_float(((const unsigned*)(ws + WS_CTL))[CW_WMAXP + l]);
      TcMat dq{F.in(21) + (size_t)l * DM * DM, DM, DM >> 6, DM, (bf16_t*)(ws + W_PG), 2048, 127.0f / (1.3f * fmaxf(wmp, 1e-30f))}; tconv_run(F, (DM >> 6) * (DM >> 6), dq, rot); }
    tconv(F, F.in(22) + (size_t)l * 256 * DM, DM, 256, DM, (bf16_t*)(ws + W_PLE), 256, rot);
#pragma unroll 1
    for (int h = 0; h < 8; ++h) tconv(F, F.in(6) + (size_t)l * 256 * 1024 + h * 128, 1024, 256, 128, (bf16_t*)(ws + W_UV2) + ((size_t)(h >> 1) * 256 + (h & 1) * 128) * 512 + (h & 1) * 256, 512, rot);
    { const float wmax = __uint_as_float(((const unsigned*)(ws + WS_CTL))[CW_WMAX + l]);
      const float wmaxd = __uint_as_float(((const unsigned*)(ws + WS_CTL))[CW_WMAXD + l]);
      TcExperts d{F.in(15) + (size_t)l * NEXP * DM * DEXP, F.in(17) + (size_t)l * NEXP * DM * DEXP, F.in(19) + (size_t)l * NEXP * DEXP * DM, (unsigned char*)(ws + W_GU), (unsigned char*)(ws + W_DN), 127.0f / (1.3f * fmaxf(wmax, 1e-30f)), 127.0f / (1.3f * fmaxf(wmaxd, 1e-30f))};
      tconv_run(F, NEXP * 1536, d, rot); }
    { const float* w = F.in(5) + (size_t)l * 256 * 8 * 96; bf16_t* d = (bf16_t*)(ws + W_UK2);
      for (int i = F.bid * 512 + F.tid; i < 256 * 8 * 96; i += F.G * 512) { const int n = i % 96, h = (i / 96) & 7, r = i / 768; d[((size_t)h * 256 + r) * 256 + (h & 1) * 128 + 32 + n] = f2bf(w[i]); } }
}

__device__ __forceinline__ void rope_cs(float pos, float invf, float& c, float& s) {
    const float a = pos * invf; const double ad = (double)a * 0.15915494309189535; const float fr = (float)(ad - rint(ad));
    s = __builtin_amdgcn_sinf(fr); c = __builtin_amdgcn_cosf(fr);
}
__device__ __forceinline__ void phase_prep(const Frame& F0, const Params& P, int l) { const Frame F = fresh(F0);
    unsigned char* ws = F.ws; const int lane = F.lane;
    const float* smallb = (const float*)(ws + R_SMALL); bf16_t* kcat = (bf16_t*)(ws + R_KCAT); bf16_t* qcat = (bf16_t*)(ws + R_QCAT);
    bf16_t* ki = (bf16_t*)(ws + R_KI); float* wi = (float*)(ws + R_WI); float* lf = (float*)(ws + WS_LF);
    const bf16_t* qa = (const bf16_t*)(ws + R_QA); bf16_t* qidx = (bf16_t*)(ws + R_QIDX);
    const f32x4 gck = *(const f32x4*)(F.in(4) + l * 256 + lane * 4);
    const float bfo = lane < 8 ? F.in(3)[l * 8 + lane] : 0.f;
    const float ifr = c_invf_r[lane & 15], ifi = c_invf_i[lane & 7];
    for (int tok = F.bid * 8 + F.wid; tok < NTOK; tok += F.G * 8) {
        const int s = tok & (SEQ - 1), b = tok >> 13; const float* sm = smallb + (size_t)tok * 512;
        float cr, sr, ci, si; rope_cs((float)s, ifr, cr, sr); rope_cs((float)s, ifi, ci, si);
        { const f32x4 v = *(const f32x4*)(sm + lane * 4); float ss = v[0] * v[0] + v[1] * v[1] + v[2] * v[2] + v[3] * v[3]; ss = wave_sum(ss);
          const float rs = rsqrtf(ss * (1.0f / 256.0f) + 1e-6f); u32x2 w; w.x = cvtpk(v[0] * rs * gck[0], v[1] * rs * gck[1]); w.y = cvtpk(v[2] * rs * gck[2], v[3] * rs * gck[3]);
          *(u32x2*)(kcat + (size_t)tok * 288 + lane * 4) = w; }
        if (lane < 16) { const float x1 = sm[256 + lane], x2 = sm[272 + lane]; kcat[(size_t)tok * 288 + 256 + lane] = f2bf(x1 * cr - x2 * sr); kcat[(size_t)tok * 288 + 272 + lane] = f2bf(x2 * cr + x1 * sr); }
        { float o = sm[288 + lane];
          if (lane < 8) { const float x2 = sm[296 + lane]; o = o * ci - x2 * si; } else if (lane < 16) { const float x1 = sm[288 + lane - 8]; o = o * ci + x1 * si; }
          ki[(size_t)tok * 64 + lane] = f2bf(o); }
        if (lane < 16) wi[(size_t)tok * 16 + lane] = sm[352 + lane] * (1.0f / 32.0f);
        if (lane < 8) { const float f = sm[368 + lane] + bfo; lf[(size_t)(b * 8 + lane) * SEQ + s] = fminf(f, 0.f) - log1pf(__expf(-fabsf(f))); }
#pragma unroll
        for (int pp = 0; pp < 2; ++pp) { const int p = lane + 64 * pp, h = p >> 4, i = p & 15;
            const float x1 = bf2f(qa[(size_t)tok * 1024 + h * 128 + i]), x2 = bf2f(qa[(size_t)tok * 1024 + h * 128 + 16 + i]);
            qcat[(size_t)tok * 2304 + h * 288 + 256 + i] = f2bf(x1 * cr - x2 * sr); qcat[(size_t)tok * 2304 + h * 288 + 272 + i] = f2bf(x2 * cr + x1 * sr); }
#pragma unroll
        for (int pp = 0; pp < 2; ++pp) { const int p = lane + 64 * pp, hh = p >> 3, i = p & 7; bf16_t* q = qidx + (size_t)tok * 1024 + hh * 64;
            const float x1 = bf2f(q[i]), x2 = bf2f(q[8 + i]); q[i] = f2bf(x1 * ci - x2 * si); q[8 + i] = f2bf(x2 * ci + x1 * si); }
    }
    { const bf16_t* kbt = (const bf16_t*)(ws + R_QKV) + (size_t)NTOK * 1024; unsigned* kmx = (unsigned*)(ws + WS_CTL) + CW_KMAX + l * 16;
#pragma unroll 1
      for (int bh = 0; bh < 16; ++bh) { float mx = 0.f;
          for (int r0 = (F.bid * 8 + F.wid) * 4; r0 < SEQ; r0 += F.G * 32) {
              const u32x4 w = *(const u32x4*)(kbt + ((size_t)bh * SEQ + r0 + (lane >> 4)) * 128 + (lane & 15) * 8);
              float ss = bflo(w.x) * bflo(w.x) + bfhi(w.x) * bfhi(w.x) + bflo(w.y) * bflo(w.y) + bfhi(w.y) * bfhi(w.y) + bflo(w.z) * bflo(w.z) + bfhi(w.z) * bfhi(w.z) + bflo(w.w) * bflo(w.w) + bfhi(w.w) * bfhi(w.w);
              ss += __shfl_xor(ss, 1); ss += __shfl_xor(ss, 2); ss += __shfl_xor(ss, 4); ss += __shfl_xor(ss, 8); mx = fmaxf(mx, ss); }
          mx = fmaxf(mx, __shfl_xor(mx, 16)); mx = fmaxf(mx, __shfl_xor(mx, 32));
          if (lane == 0) ((float*)F.lds)[F.wid * 16 + bh] = mx; }
      __syncthreads();
      if (F.tid < 16) { float mx = 0.f;
#pragma unroll
          for (int w = 0; w < 8; ++w) mx = fmaxf(mx, ((const float*)F.lds)[w * 16 + F.tid]);
          const unsigned bits = __float_as_uint(mx);
          if (bits > __hip_atomic_load(&kmx[F.tid], __ATOMIC_RELAXED, __HIP_MEMORY_SCOPE_AGENT)) atomicMax(&kmx[F.tid], bits); }
      __syncthreads(); }
}
__device__ __forceinline__ void phase_cumsum(const Frame& F0) { const Frame F = fresh(F0);
    const int gw = F.bid * 8 + F.wid; if (gw >= 16) return;
    const float* lf = (const float*)(F.ws + WS_LF) + (size_t)gw * SEQ; float* cum = (float*)(F.ws + WS_CUM) + (size_t)gw * SEQ;
    const int lane = F.lane; double tot = 0.0;
#pragma unroll 1
    for (int hb = 0; hb < 2; ++hb) { f32x4 v[16];
#pragma unroll
        for (int j = 0; j < 16; ++j) v[j] = *(const f32x4*)(lf + lane * 128 + hb * 64 + j * 4);
#pragma unroll
        for (int j = 0; j < 16; ++j)
#pragma unroll
            for (int e = 0; e < 4; ++e) tot += (double)v[j][e]; }
    double inc = tot;
    for (int o = 1; o < 64; o <<= 1) { const double n = __shfl_up(inc, o); if (lane >= o) inc += n; }
    double run = inc - tot;
#pragma unroll 1
    for (int hb = 0; hb < 2; ++hb) { f32x4 v[16];
#pragma unroll
        for (int j = 0; j < 16; ++j) v[j] = *(const f32x4*)(lf + lane * 128 + hb * 64 + j * 4);
#pragma unroll
        for (int j = 0; j < 16; ++j) { f32x4 o;
#pragma unroll
            for (int e = 0; e < 4; ++e) { run += (double)v[j][e]; o[e] = (float)run; }
            v[j] = o; }
#pragma unroll
        for (int j = 0; j < 16; ++j) *(f32x4*)(cum + lane * 128 + hb * 64 + j * 4) = v[j]; }
}

__device__ __forceinline__ void idx_unit(const Frame& F, int b, int pi, int half) {
    const int tid = F.tid, lane = F.lane, rho = lane & 31, hh = lane >> 5; unsigned char* ws = F.ws;
    const bf16_t* qidx = (const bf16_t*)(ws + R_QIDX); const bf16_t* ki = (const bf16_t*)(ws + R_KI) + (size_t)b * SEQ * 64; const float* wi = (const float*)(ws + R_WI);
    float* scores = (float*)(ws + R_SCORES) + (size_t)b * SEQ * SEQ;
    LAS unsigned char* kl = F.ldsl;
    const int gl = pi, gh = 127 - pi, nl = (64 * gl + 63) / 128 + 1, nh = (64 * gh + 63) / 128 + 1, tot = nl + nh;
    const int x0 = half ? tot / 2 : 0, x1 = half ? tot : tot / 2;
    bf16x8 af[4][4]; float wv[4][16]; int t0 = 0, curg = -1;
    const int r0 = tid >> 3, p0 = tid & 7;
    const unsigned d0 = (unsigned)(r0 * 128 + ((p0 ^ (r0 & 7)) << 4)), d1 = d0 + 64 * 128;
    u32x4 s0, s1;
    { const int c = x0 < nl ? x0 : x0 - nl; const bf16_t* kp = ki + (size_t)(c * 128) * 64; s0 = *(const u32x4*)(kp + (size_t)r0 * 64 + p0 * 8); s1 = *(const u32x4*)(kp + (size_t)(r0 + 64) * 64 + p0 * 8); }
    __syncthreads();
    *(LAS u32x4*)(kl + d0) = s0; *(LAS u32x4*)(kl + d1) = s1;
    __syncthreads();
    const unsigned rdo = (unsigned)(rho * 128);
#pragma unroll 1
    for (int x = x0; x < x1; ++x) {
        const int g = x < nl ? gl : gh, c = x < nl ? x : x - nl;
        if (g != curg) { curg = g; t0 = g * 64 + F.wid * 8;
#pragma unroll
            for (int mt = 0; mt < 4; ++mt) {
                const int tokA = b * SEQ + t0 + 2 * mt + ((rho >> 2) & 1), head = (rho & 3) + 4 * (rho >> 3);
#pragma unroll
                for (int kk = 0; kk < 4; ++kk) af[mt][kk] = *(const bf16x8*)(qidx + (size_t)tokA * 1024 + head * 64 + kk * 16 + 8 * hh);
                const float* wp = wi + (size_t)(b * SEQ + t0 + 2 * mt + hh) * 16;
#pragma unroll
                for (int q = 0; q < 4; ++q) { const f32x4 v = *(const f32x4*)(wp + 4 * q); wv[mt][4 * q] = v[0]; wv[mt][4 * q + 1] = v[1]; wv[mt][4 * q + 2] = v[2]; wv[mt][4 * q + 3] = v[3]; } } }
        const unsigned bo = (unsigned)((x - x0) & 1) * 16384u;
        if (x + 1 < x1) { const int cn = (x + 1) < nl ? (x + 1) : (x + 1) - nl; const bf16_t* kp = ki + (size_t)(cn * 128) * 64; s0 = *(const u32x4*)(kp + (size_t)r0 * 64 + p0 * 8); s1 = *(const u32x4*)(kp + (size_t)(r0 + 64) * 64 + p0 * 8); }
#pragma unroll
        for (int tl = 0; tl < 4; ++tl) {
            const int kb = c * 128 + tl * 32;
            if (kb <= t0 + 7) {
                bf16x8 bc[4];
#pragma unroll
                for (int kk = 0; kk < 4; ++kk) bc[kk] = *(const LAS bf16x8*)(kl + bo + tl * 4096 + rdo + (((kk * 2 + hh) ^ (rho & 7)) << 4));
                f32x16 a0 = {}, a1 = {}, a2 = {}, a3 = {};
#pragma unroll
                for (int kk = 0; kk < 4; ++kk) { a0 = __builtin_amdgcn_mfma_f32_32x32x16_bf16(af[0][kk], bc[kk], a0, 0, 0, 0); a1 = __builtin_amdgcn_mfma_f32_32x32x16_bf16(af[1][kk], bc[kk], a1, 0, 0, 0);
                                                  a2 = __builtin_amdgcn_mfma_f32_32x32x16_bf16(af[2][kk], bc[kk], a2, 0, 0, 0); a3 = __builtin_amdgcn_mfma_f32_32x32x16_bf16(af[3][kk], bc[kk], a3, 0, 0, 0); }
#define IDX_EPI(A_, mt_) do { float x_0 = 0.f, x_1 = 0.f, x_2 = 0.f, x_3 = 0.f; _Pragma("unroll") for (int r = 0; r < 16; r += 4) { \
                    x_0 = fmaf(wv[mt_][r], fmaxf(A_[r], 0.f), x_0); x_1 = fmaf(wv[mt_][r + 1], fmaxf(A_[r + 1], 0.f), x_1); x_2 = fmaf(wv[mt_][r + 2], fmaxf(A_[r + 2], 0.f), x_2); x_3 = fmaf(wv[mt_][r + 3], fmaxf(A_[r + 3], 0.f), x_3); } \
                    scores[(size_t)(t0 + 2 * (mt_) + hh) * SEQ + kb + rho] = (x_0 + x_1) + (x_2 + x_3); } while (0)
                IDX_EPI(a0, 0); IDX_EPI(a1, 1); IDX_EPI(a2, 2); IDX_EPI(a3, 3);
#undef IDX_EPI
            }
        }
        if (x + 1 < x1) { *(LAS u32x4*)(kl + (bo ^ 16384u) + d0) = s0; *(LAS u32x4*)(kl + (bo ^ 16384u) + d1) = s1; }
        __syncthreads();
    }
}
__device__ __forceinline__ void phase_idx(const Frame& F0) { const Frame F = fresh(F0);
#pragma unroll 1
    for (int it = F.bid; it < 256; it += F.G) { const int b = it >> 7, pi = (it >> 1) & 63, half = it & 1; idx_unit(F, b, pi, half); }
}

__device__ __forceinline__ unsigned sortable(float f) { const unsigned u = __float_as_uint(f); return (u & 0x80000000u) ? ~u : (u | 0x80000000u); }
__device__ __forceinline__ void topk_row(const Frame& F, int b, int t) {
    int lane = F.lane; asm volatile("" : "+v"(lane));
    const int L = t + 1, tok = b * SEQ + t; unsigned char* ws = F.ws;
    int* sel = (int*)(ws + R_SEL) + (size_t)tok * 256; int* nsel = (int*)(ws + R_NSEL);
    if (lane == 0) nsel[tok] = L < 256 ? L : 256;
    if (L <= 256) { for (int j = lane; j < 256; j += 64) sel[j] = j < L ? j : 0; return; }
    const float* row = (const float*)(ws + R_SCORES) + ((size_t)b * SEQ + t) * SEQ;
    const int nch = (L + 1023) >> 10;
#define TOPK_LOAD_ROW() do { _Pragma("unroll") for (int c = 0; c < 8; ++c) { \
        if (c < nch) { _Pragma("unroll") for (int jj = 0; jj < 4; ++jj) { const int j = c * 4 + jj; const f32x4 v = *(const f32x4*)(row + j * 256 + lane * 4); \
                _Pragma("unroll") for (int e_ = 0; e_ < 4; ++e_) { const int idx = j * 256 + lane * 4 + e_; u[j * 4 + e_] = idx < L ? sortable(v[e_]) : 0u; } } } \
        else { _Pragma("unroll") for (int q = 0; q < 16; ++q) u[c * 16 + q] = 0u; } } } while (0)
    unsigned u[128];
    TOPK_LOAD_ROW();
    unsigned g0 = 0u, g1 = 0u, g2 = 0u, g3 = 0u;
#pragma unroll
    for (int c = 0; c < 8; ++c) if (c < nch) {
#pragma unroll
        for (int jj = 0; jj < 4; ++jj) { const int j = c * 4 + jj; g0 = u[4 * j] > g0 ? u[4 * j] : g0; g1 = u[4 * j + 1] > g1 ? u[4 * j + 1] : g1; g2 = u[4 * j + 2] > g2 ? u[4 * j + 2] : g2; g3 = u[4 * j + 3] > g3 ? u[4 * j + 3] : g3; } }
    unsigned tl = g0 < g1 ? g0 : g1; { const unsigned t2 = g2 < g3 ? g2 : g3; tl = tl < t2 ? tl : t2; }
#pragma unroll
    for (int o = 32; o > 0; o >>= 1) { const unsigned x = (unsigned)__shfl_xor((int)tl, o); tl = x < tl ? x : tl; }
    constexpr int CAP = 2048;
    LAS unsigned* candk = (LAS unsigned*)(F.ldsl + F.wid * (CAP * 8)); LAS unsigned* candi = candk + CAP;
    int C = 0;
#pragma unroll
    for (int c = 0; c < 8; ++c) if (c < nch) {
#pragma unroll
        for (int q = 0; q < 16; ++q) { const int rq = c * 16 + q; const bool pr = u[rq] >= tl; const unsigned long long mm = __ballot(pr);
            const int pos = C + __popcll(mm & ((1ull << lane) - 1ull));
            if (pr && pos < CAP) { candk[pos] = u[rq]; candi[pos] = (unsigned)((rq >> 2) * 256 + lane * 4 + (rq & 3)); }
            C += __popcll(mm); if ((q & 3) == 3) SBAR(); } }
    if (C <= CAP) {
        const int ng = (C + 255) >> 8;
        unsigned ck[32]; int ci[32];
#pragma unroll
        for (int g = 0; g < 8; ++g) {
#pragma unroll
            for (int q = 0; q < 4; ++q) { const int r = g * 4 + q, p = r * 64 + lane; ck[r] = 0u; ci[r] = 0;
                if (g < ng && p < C) { ck[r] = candk[p]; ci[r] = (int)candi[p]; } } }
        unsigned T = 0u, thr_gt = 0u; int need_eq = 0; bool early = false;
        for (int bit = 31; bit >= 0; --bit) {
            const unsigned cnd = T | (1u << bit); int cnt = 0;
#pragma unroll
            for (int g = 0; g < 8; ++g) if (g < ng) {
#pragma unroll
                for (int q = 0; q < 4; ++q) cnt += __popcll(__ballot(ck[g * 4 + q] >= cnd)); }
            if (cnt >= 256) { T = cnd; if (cnt == 256) { early = true; break; } }
        }
        if (early) { thr_gt = T - 1u; need_eq = 0; }
        else { int gtc = 0;
#pragma unroll
            for (int g = 0; g < 8; ++g) if (g < ng) {
#pragma unroll
                for (int q = 0; q < 4; ++q) gtc += __popcll(__ballot(ck[g * 4 + q] > T)); }
            thr_gt = T; need_eq = 256 - gtc; }
        int base = 0, eq_taken = 0;
#pragma unroll
        for (int g = 0; g < 8; ++g) if (g < ng) {
#pragma unroll
            for (int q = 0; q < 4; ++q) { const int r = g * 4 + q; const unsigned v = ck[r];
                const bool iseq = (v == thr_gt) && (need_eq > 0);
                const unsigned long long meq = __ballot(iseq);
                const int eqr = __popcll(meq & ((1ull << lane) - 1ull));
                const bool take = (v > thr_gt) || (iseq && (eq_taken + eqr < need_eq));
                const unsigned long long mt = __ballot(take);
                const int pos = base + __popcll(mt & ((1ull << lane) - 1ull));
                if (take && pos < 256) sel[pos] = ci[r];
                base += __popcll(mt); eq_taken += __popcll(meq); } }
        return;
    }
    asm volatile("" ::: "memory");
    TOPK_LOAD_ROW();
    unsigned T = 0u, thr_gt = 0u; int need_eq = 0; bool early = false;
    for (int bit = 31; bit >= 0; --bit) {
        const unsigned cand = T | (1u << bit); int cnt = 0;
#pragma unroll
        for (int c = 0; c < 8; ++c) if (c < nch) {
#pragma unroll
            for (int q = 0; q < 16; ++q) cnt += __popcll(__ballot(u[c * 16 + q] >= cand)); }
        if (cnt >= 256) { T = cand; if (cnt == 256) { early = true; break; } }
    }
    if (early) { thr_gt = T - 1u; need_eq = 0; }
    else { int gtc = 0;
#pragma unroll
        for (int c = 0; c < 8; ++c) if (c < nch) {
#pragma unroll
            for (int q = 0; q < 16; ++q) gtc += __popcll(__ballot(u[c * 16 + q] > T)); }
        thr_gt = T; need_eq = 256 - gtc; }
    int base = 0, eq_taken = 0;
#pragma unroll
    for (int c = 0; c < 8; ++c) if (c < nch) {
#pragma unroll
        for (int q = 0; q < 16; ++q) { const int rq = c * 16 + q; const unsigned v = u[rq];
            const bool iseq = (v == thr_gt) && (need_eq > 0);
            const unsigned long long meq = __ballot(iseq);
            const int eqr = __popcll(meq & ((1ull << lane) - 1ull));
            const bool take = (v > thr_gt) || (iseq && (eq_taken + eqr < need_eq));
            const unsigned long long mt = __ballot(take);
            const int pos = base + __popcll(mt & ((1ull << lane) - 1ull));
            if (take && pos < 256) sel[pos] = (rq >> 2) * 256 + lane * 4 + (rq & 3);
            base += __popcll(mt); eq_taken += __popcll(meq); } }
}
__device__ __forceinline__ void phase_topk(const Frame& F0) { const Frame F = fresh(F0);
    for (int q = F.bid * 8 + F.wid; q < 8192; q += F.G * 8) { const int b = q >> 12, p = q & 4095; topk_row(F, b, p); topk_row(F, b, SEQ - 1 - p); }
}

namespace att {
constexpr int D = 128, KVBLK = 64, QBLK = 32, SHM_V = 16384, SHM_K = 16384;
constexpr int OFF_K = 2 * SHM_V, OFF_BIAS = 2 * SHM_V + 2 * SHM_K, OFF_WS = OFF_BIAS + 512, OFF_FLAGS = OFF_WS + 2048, OFF_QITEM = OFF_FLAGS + 64;
constexpr float EXIT_T = 44.0f;
#define KSWZ(row, colB) ((row) * 256 + ((colB) ^ (((row) & 7) << 4)))
__device__ __forceinline__ int v_st(int k, int c) { const int kk = (k & ~0xC) | ((k & 4) << 1) | ((k & 8) >> 1); return ((kk >> 3) * 4 + (c >> 5)) * 512 + ((kk & 7) * 32 + (c & 31)) * 2; }
__device__ __forceinline__ int v_rd_base(int lane) { return ((lane & 3) << 3) | (((lane >> 2) & 3) << 6) | (((lane >> 4) & 1) << 5) | (((lane >> 5) & 1) << 8); }
constexpr int v_rd_off(int d0, int ks, int half) { return d0 * 512 + ks * 4096 + half * 2048; }
template <int KB>
__device__ __forceinline__ void qkt(f32x16& p0, f32x16& p1, const char* K_lds, int r32, int hi, const bf16x8* qr) {
    p0 = f32x16{}; p1 = f32x16{};
    const char* kb[4];
#pragma unroll
    for (int dd = 0; dd < 4; ++dd) kb[dd] = K_lds + KB * SHM_K + KSWZ(r32, (dd * 16 + hi * 8) * 2);
#pragma unroll
    for (int d0 = 0; d0 < 8; ++d0) { const char* a = kb[d0 & 3] + (d0 >> 2) * 128;
        bf16x8 b0 = *reinterpret_cast<const bf16x8*>(a);
        bf16x8 b1 = *reinterpret_cast<const bf16x8*>(a + 32 * 256);
        p0 = __builtin_amdgcn_mfma_f32_32x32x16_bf16(b0, qr[d0], p0, 0, 0, 0);
        p1 = __builtin_amdgcn_mfma_f32_32x32x16_bf16(b1, qr[d0], p1, 0, 0, 0); }
}
template <int VB>
__device__ __forceinline__ void pv_tile(f32x16* o, int vb0, bf16x8 pa0, bf16x8 pa1, bf16x8 pa2, bf16x8 pa3) {
#define TRRD(dst, off) asm volatile("ds_read_b64_tr_b16 %0, %1 offset:%2" : "=&v"(dst) : "v"(vb0), "i"(off) : "memory")
#define PV_D0(d0) do { s16x4 l0, l1, l2, l3, h0, h1, h2, h3; constexpr int b_ = VB * SHM_V + v_rd_off(d0, 0, 0); \
        TRRD(l0, b_); TRRD(h0, b_ + 2048); TRRD(l1, b_ + 4096); TRRD(h1, b_ + 6144); TRRD(l2, b_ + 8192); TRRD(h2, b_ + 10240); TRRD(l3, b_ + 12288); TRRD(h3, b_ + 14336); \
        asm volatile("s_waitcnt lgkmcnt(0)" ::: "memory"); SBAR(); \
        o[d0] = __builtin_amdgcn_mfma_f32_32x32x16_bf16(pa0, (bf16x8){l0[0], l0[1], l0[2], l0[3], h0[0], h0[1], h0[2], h0[3]}, o[d0], 0, 0, 0); \
        o[d0] = __builtin_amdgcn_mfma_f32_32x32x16_bf16(pa1, (bf16x8){l1[0], l1[1], l1[2], l1[3], h1[0], h1[1], h1[2], h1[3]}, o[d0], 0, 0, 0); \
        o[d0] = __builtin_amdgcn_mfma_f32_32x32x16_bf16(pa2, (bf16x8){l2[0], l2[1], l2[2], l2[3], h2[0], h2[1], h2[2], h2[3]}, o[d0], 0, 0, 0); \
        o[d0] = __builtin_amdgcn_mfma_f32_32x32x16_bf16(pa3, (bf16x8){l3[0], l3[1], l3[2], l3[3], h3[0], h3[1], h3[2], h3[3]}, o[d0], 0, 0, 0); } while (0)
    PV_D0(0); PV_D0(1); PV_D0(2); PV_D0(3);
#undef PV_D0
#undef TRRD
}
#define PK4(P, B_, OUT) do { unsigned a0 = cvtpk(P[B_+0], P[B_+1]), a1 = cvtpk(P[B_+2], P[B_+3]); \
        unsigned b0 = cvtpk(P[B_+4], P[B_+5]), b1 = cvtpk(P[B_+6], P[B_+7]); \
        auto r0 = __builtin_amdgcn_permlane32_swap(a0, b0, false, false); auto r1 = __builtin_amdgcn_permlane32_swap(a1, b1, false, false); \
        u32x4 w = {r0[0], r1[0], r0[1], r1[1]}; OUT = *reinterpret_cast<bf16x8*>(&w); } while (0)
__device__ __forceinline__ float swap_max(float x) { auto rr = __builtin_amdgcn_permlane32_swap(__float_as_uint(x), __float_as_uint(x), false, false); return fmaxf(__uint_as_float(rr[0]), __uint_as_float(rr[1])); }
__device__ __forceinline__ float swap_sum(float x) { auto rr = __builtin_amdgcn_permlane32_swap(__float_as_uint(x), __float_as_uint(x), false, false); return __uint_as_float(rr[0]) + __uint_as_float(rr[1]); }
__device__ __forceinline__ float swap_lo(float x) { auto rr = __builtin_amdgcn_permlane32_swap(__float_as_uint(x), __float_as_uint(x), false, false); return __uint_as_float(rr[0]); }


__device__ __forceinline__ void fox_sm(f32x16& p0, f32x16& p1, const float* bl, int kb_, int qlo, int qrow, int hi, int r32, float& m_reg, float& l_reg, f32x16* o, float* al_l,
                                       bf16x8& pa0, bf16x8& pa1, bf16x8& pa2, bf16x8& pa3) {
#pragma unroll
    for (int g = 0; g < 4; ++g) { const f32x4 b0v = *(const f32x4*)(bl + 8 * g + 4 * hi), b1v = *(const f32x4*)(bl + 32 + 8 * g + 4 * hi);
#pragma unroll
        for (int i = 0; i < 4; ++i) { p0[4 * g + i] = fmaf(p0[4 * g + i], C2, b0v[i]); p1[4 * g + i] = fmaf(p1[4 * g + i], C2, b1v[i]); } }
    if (kb_ + KVBLK - 1 > qlo) { const float NEG = -__builtin_inff();
#pragma unroll
        for (int r = 0; r < 16; ++r) { const int key = kb_ + crow(r, hi); if (key > qrow) p0[r] = NEG; if (key + 32 > qrow) p1[r] = NEG; } }
    float pmax = p0[0];
#pragma unroll
    for (int r = 1; r < 16; ++r) pmax = fmaxf(pmax, p0[r]);
#pragma unroll
    for (int r = 0; r < 16; ++r) pmax = fmaxf(pmax, p1[r]);
    pmax = swap_max(pmax);
    const float mn = fmaxf(m_reg, pmax), alpha = __builtin_amdgcn_exp2f(m_reg - mn); m_reg = mn;
    float ps = 0.f;
#pragma unroll
    for (int r = 0; r < 16; ++r) { p0[r] = __builtin_amdgcn_exp2f(p0[r] - mn); p1[r] = __builtin_amdgcn_exp2f(p1[r] - mn); ps += p0[r] + p1[r]; }
    ps = swap_sum(ps); l_reg = l_reg * alpha + ps;
    if (__any(alpha < 1.f)) { if (hi == 0) al_l[r32] = alpha; asm volatile("s_waitcnt lgkmcnt(0)" ::: "memory");
#pragma unroll
        for (int r = 0; r < 16; ++r) { const float a = al_l[crow(r, hi)];
#pragma unroll
            for (int d_ = 0; d_ < 4; ++d_) o[d_][r] *= a; } }
    PK4(p0, 0, pa0); PK4(p0, 8, pa1); PK4(p1, 0, pa2); PK4(p1, 8, pa3);
}
__device__ __forceinline__ void sb_half(f32x16& pz, int keybase, int qrow, int hi, float& R, const bf16x8* triA, bool needmask) {
    f32x16 X;
#pragma unroll
    for (int r = 0; r < 16; ++r) { const float zz = pz[r] * C2; const bool valid = !needmask || (keybase + crow(r, hi) < qrow);
        const float l2 = fmaxf(zz, 0.f) + __builtin_amdgcn_logf(1.0f + __builtin_amdgcn_exp2f(-fabsf(zz)));
        X[r] = valid ? -l2 : 0.f; pz[r] = valid ? zz : -__builtin_inff(); }
    f32x16 Y;
#pragma unroll
    for (int r = 0; r < 16; ++r) Y[r] = R;
#pragma unroll
    for (int s = 0; s < 2; ++s) {
        const unsigned h0 = cvtpk(X[8 * s + 0], X[8 * s + 1]), h1 = cvtpk(X[8 * s + 2], X[8 * s + 3]), h2 = cvtpk(X[8 * s + 4], X[8 * s + 5]), h3 = cvtpk(X[8 * s + 6], X[8 * s + 7]);
        const unsigned l0 = cvtpk(X[8 * s + 0] - bflo(h0), X[8 * s + 1] - bfhi(h0)), l1 = cvtpk(X[8 * s + 2] - bflo(h1), X[8 * s + 3] - bfhi(h1));
        const unsigned l2 = cvtpk(X[8 * s + 4] - bflo(h2), X[8 * s + 5] - bfhi(h2)), l3 = cvtpk(X[8 * s + 6] - bflo(h3), X[8 * s + 7] - bfhi(h3));
        u32x4 wh = {h0, h1, h2, h3}, wl = {l0, l1, l2, l3};
        Y = __builtin_amdgcn_mfma_f32_32x32x16_bf16(triA[s], *reinterpret_cast<bf16x8*>(&wh), Y, 0, 0, 0);
        Y = __builtin_amdgcn_mfma_f32_32x32x16_bf16(triA[s], *reinterpret_cast<bf16x8*>(&wl), Y, 0, 0, 0); }
#pragma unroll
    for (int r = 0; r < 16; ++r) pz[r] = __builtin_amdgcn_exp2f(pz[r] + Y[r]);
    R = swap_lo(Y[0]);
}
__device__ __forceinline__ void sb_sm(f32x16& p0, f32x16& p1, int kb_, int qlo, int qrow, int hi, float& R, const bf16x8* triA, bf16x8& pa0, bf16x8& pa1, bf16x8& pa2, bf16x8& pa3) {
    const bool needmask = (kb_ + KVBLK - 1 >= qlo);
    sb_half(p1, kb_ + 32, qrow, hi, R, triA, needmask);
    sb_half(p0, kb_, qrow, hi, R, triA, needmask);
    PK4(p0, 0, pa0); PK4(p0, 8, pa1); PK4(p1, 0, pa2); PK4(p1, 8, pa3);
}

template <int MODE>
__device__ __forceinline__ void attn_unit(const bf16_t* Q, const bf16_t* Kh, const bf16_t* Vh, const float* cum, bf16_t* O, int P0, char* lds, float kmaxc) {
    int tid = threadIdx.x; asm volatile("" : "+v"(tid));
    const int wid = __builtin_amdgcn_readfirstlane(tid >> 6), lane = tid & 63, r32 = lane & 31, hi = lane >> 5;
    const int NT = P0 / KVBLK + 4;
    char* V_lds = lds; char* K_lds = lds + OFF_K; float* bias_l = (float*)(lds + OFF_BIAS);
    float* wsl = (float*)(lds + OFF_WS) + wid * 64; float* li_l = wsl; float* al_l = wsl + 32;
    const int qlo = P0 + wid * QBLK, qrow = qlo + r32;
    bf16x8 qr[8];
#pragma unroll
    for (int d0 = 0; d0 < 8; ++d0) qr[d0] = *(const bf16x8*)(Q + (size_t)qrow * D + d0 * 16 + hi * 8);
    const int sr = tid >> 4, sc = (tid & 15) * 8, vst0 = v_st(sr, sc), vst1 = v_st(32 + sr, sc), kws = KSWZ(sr, sc * 2);
    const int vb0 = (int)(uintptr_t)V_lds + v_rd_base(lane);
    const float cumref = (MODE == 0) ? cum[P0] : 0.f;
    int* flg = (int*)(lds + OFF_FLAGS);
    float qn = 0.f;
    if (MODE == 0) { float ss = 0.f;
#pragma unroll
        for (int d0 = 0; d0 < 8; ++d0)
#pragma unroll
            for (int j = 0; j < 8; ++j) { const float x = bf2f((bf16_t)qr[d0][j]); ss = fmaf(x, x, ss); }
        ss = swap_sum(ss); qn = sqrtf(ss) * kmaxc * 1.001f; }
    float m_reg = -1e30f, l_reg = 0.f, R = 0.f; f32x16 o[4] = {};
    bf16x8 triA[2];
    if (MODE == 1) {
#pragma unroll
        for (int s = 0; s < 2; ++s)
#pragma unroll
            for (int j = 0; j < 8; ++j) { const int rho = 16 * s + 8 * (j >> 2) + 4 * hi + (j & 3); triA[s][j] = (rho >= r32) ? (short)0x3F80 : (short)0; }
    }
    bf16x8 st_k0, st_k1, st_v0, st_v1; float st_b = 0.f;
#define TILE_KB(t) ((NT - 1 - (t)) * KVBLK)
#define SLOAD(kb_) do { st_v0 = *(const bf16x8*)(Vh + (size_t)((kb_) + sr) * D + sc); st_v1 = *(const bf16x8*)(Vh + (size_t)((kb_) + 32 + sr) * D + sc); \
                        st_k0 = *(const bf16x8*)(Kh + (size_t)((kb_) + sr) * D + sc); st_k1 = *(const bf16x8*)(Kh + (size_t)((kb_) + 32 + sr) * D + sc); \
                        if (MODE == 0 && tid < 64) st_b = (cumref - cum[(kb_) + tid]) * LOG2E; } while (0)
#define SWRITE(bf) do { *(bf16x8*)(V_lds + (bf) * SHM_V + vst0) = st_v0; *(bf16x8*)(V_lds + (bf) * SHM_V + vst1) = st_v1; \
                        *(bf16x8*)(K_lds + (bf) * SHM_K + kws) = st_k0; *(bf16x8*)(K_lds + (bf) * SHM_K + kws + 32 * 256) = st_k1; \
                        if (MODE == 0 && tid < 64) bias_l[(bf) * 64 + tid] = st_b; } while (0)
    __syncthreads();
    SLOAD(TILE_KB(0)); SWRITE(0);
    __syncthreads();
    f32x16 p0, p1; bf16x8 pa0, pa1, pa2, pa3;
#define STEP(BUF, t) do { const int kb_ = TILE_KB(t); \
        if ((t) + 1 < NT) SLOAD(TILE_KB((t) + 1)); \
        SBAR(); qkt<BUF>(p0, p1, K_lds, r32, hi, qr); \
        if (MODE == 0) fox_sm(p0, p1, bias_l + (BUF) * 64, kb_, qlo, qrow, hi, r32, m_reg, l_reg, o, al_l, pa0, pa1, pa2, pa3); \
        else sb_sm(p0, p1, kb_, qlo, qrow, hi, R, triA, pa0, pa1, pa2, pa3); \
        SBAR(); pv_tile<BUF>(o, vb0, pa0, pa1, pa2, pa3); \
        if ((t) + 1 < NT) SWRITE((BUF) ^ 1); \
        __syncthreads(); } while (0)
    for (int t = 0; t < NT; t += 2) {
        STEP(0, t); STEP(1, t + 1);
        const int kbc = TILE_KB(t + 1); if (kbc == 0) break;
        bool done;
        if (MODE == 0) { const float edge = (cumref - cum[kbc - 1]) * LOG2E; done = (qn + edge - m_reg) < -EXIT_T; }
        else done = R < -EXIT_T;
        const int par = (t >> 1) & 1;
        if (lane == 0) flg[par * 8 + wid] = 0;
        const bool wdone = __all(done);
        if (lane == 0 && wdone) flg[par * 8 + wid] = 1;
        __syncthreads();
        int alld = 1;
#pragma unroll
        for (int w = 0; w < 8; ++w) alld &= flg[par * 8 + w];
        if (alld) break;
    }
    __syncthreads();
#undef STEP
#undef SLOAD
#undef SWRITE
#undef TILE_KB
    float rli[16];
    if (MODE == 0) { if (hi == 0) li_l[r32] = l_reg; asm volatile("s_waitcnt lgkmcnt(0)" ::: "memory");
#pragma unroll
        for (int r = 0; r < 16; ++r) rli[r] = __builtin_amdgcn_rcpf(li_l[crow(r, hi)]); }
    bf16_t* Ow = O + (size_t)(wid * QBLK) * 3072;
#pragma unroll
    for (int r = 0; r < 16; ++r) { const int orow = crow(r, hi);
#pragma unroll
        for (int d0 = 0; d0 < 4; ++d0) { const float v = (MODE == 0) ? o[d0][r] * rli[r] : o[d0][r];
            const float vn = __shfl_xor(v, 1);
            if ((r32 & 1) == 0) *(unsigned*)(Ow + (size_t)orow * 3072 + d0 * 32 + r32) = cvtpk(v, vn); } }
}
}

__device__ __forceinline__ void sparse_query(const Frame& F, int tok, char* ldsw) {
    unsigned char* ws = F.ws; const int lane = F.lane, g = lane >> 4, i16 = lane & 15;
    const bf16_t* qcat = (const bf16_t*)(ws + R_QCAT) + (size_t)tok * 2304; const bf16_t* kbase = (const bf16_t*)(ws + R_KCAT) + (size_t)(tok >> 13) * SEQ * 288;
    const int* sel = (const int*)(ws + R_SEL) + (size_t)tok * 256; const int ns = ((const int*)(ws + R_NSEL))[tok]; const int ntile = (ns + 31) >> 5;
    bf16x8 qf[9];
#pragma unroll
    for (int st = 0; st < 9; ++st) { qf[st] = (bf16x8){0, 0, 0, 0, 0, 0, 0, 0}; if (i16 < 8) qf[st] = *(const bf16x8*)(qcat + i16 * 288 + st * 32 + 8 * g); }
    const int rA = lane >> 2, cq = lane & 3;
    float m = -1e30f, l = 0.f; f32x4 oT[16];
#pragma unroll
    for (int rb = 0; rb < 16; ++rb) oT[rb] = (f32x4){0.f, 0.f, 0.f, 0.f};
    const unsigned ldso = (unsigned)(uintptr_t)ldsw;
    const unsigned vb = ldso + (unsigned)((4 * g + (i16 >> 2)) * 592 + (i16 & 3) * 8);
    constexpr float SC2 = SCALE * LOG2E;
    bf16x8 stg[18];
#define GATHER(tile_) do { const int j0 = (tile_) * 32 + rA, j1 = j0 + 16; const int s0 = j0 < ns ? sel[j0] : 0, s1 = j1 < ns ? sel[j1] : 0; \
        const bf16_t* p0_ = kbase + (size_t)s0 * 288 + cq * 8; const bf16_t* p1_ = kbase + (size_t)s1 * 288 + cq * 8; \
        _Pragma("unroll") for (int c = 0; c < 9; ++c) { stg[2 * c] = *(const bf16x8*)(p0_ + c * 32); stg[2 * c + 1] = *(const bf16x8*)(p1_ + c * 32); } } while (0)
    GATHER(0);
    for (int tile = 0; tile < ntile; ++tile) {
#pragma unroll
        for (int c = 0; c < 9; ++c) { *(bf16x8*)(ldsw + rA * 592 + c * 64 + cq * 16) = stg[2 * c]; *(bf16x8*)(ldsw + (16 + rA) * 592 + c * 64 + cq * 16) = stg[2 * c + 1]; }
        if (tile + 1 < ntile) GATHER(tile + 1);
        asm volatile("s_waitcnt lgkmcnt(0)" ::: "memory"); SBAR();
        f32x4 acc[2];
#pragma unroll
        for (int mt = 0; mt < 2; ++mt) { acc[mt] = (f32x4){0.f, 0.f, 0.f, 0.f};
#pragma unroll
            for (int st = 0; st < 9; ++st) { const bf16x8 a = *(const bf16x8*)(ldsw + (16 * mt + i16) * 592 + st * 64 + g * 16);
                acc[mt] = __builtin_amdgcn_mfma_f32_16x16x32_bf16(a, qf[st], acc[mt], 0, 0, 0); } }
        float tmax = -__builtin_inff();
#pragma unroll
        for (int mt = 0; mt < 2; ++mt)
#pragma unroll
            for (int r = 0; r < 4; ++r) { const int key = tile * 32 + 16 * mt + 4 * g + r; float x = acc[mt][r] * SC2; if (key >= ns) x = -__builtin_inff(); acc[mt][r] = x; tmax = fmaxf(tmax, x); }
        tmax = fmaxf(tmax, __shfl_xor(tmax, 16)); tmax = fmaxf(tmax, __shfl_xor(tmax, 32));
        const float mn = fmaxf(m, tmax), alpha = __builtin_amdgcn_exp2f(m - mn); m = mn;
        float ps = 0.f;
#pragma unroll
        for (int mt = 0; mt < 2; ++mt)
#pragma unroll
            for (int r = 0; r < 4; ++r) { acc[mt][r] = __builtin_amdgcn_exp2f(acc[mt][r] - mn); ps += acc[mt][r]; }
        ps += __shfl_xor(ps, 16); ps += __shfl_xor(ps, 32);
        l = l * alpha + ps;
#pragma unroll
        for (int rb = 0; rb < 16; ++rb) oT[rb] *= alpha;
        const bf16x8 pf = pack8(acc[0], acc[1]);
#define TRRD2(dst, off) asm volatile("ds_read_b64_tr_b16 %0, %1 offset:%2" : "=&v"(dst) : "v"(vb), "i"(off) : "memory")
#define PVRB4(rb) do { s16x4 ta0, tb0, ta1, tb1, ta2, tb2, ta3, tb3; \
        TRRD2(ta0, ((rb) + 0) * 32); TRRD2(tb0, ((rb) + 0) * 32 + 16 * 592); TRRD2(ta1, ((rb) + 1) * 32); TRRD2(tb1, ((rb) + 1) * 32 + 16 * 592); \
        TRRD2(ta2, ((rb) + 2) * 32); TRRD2(tb2, ((rb) + 2) * 32 + 16 * 592); TRRD2(ta3, ((rb) + 3) * 32); TRRD2(tb3, ((rb) + 3) * 32 + 16 * 592); \
        asm volatile("s_waitcnt lgkmcnt(0)" ::: "memory"); SBAR(); \
        oT[(rb) + 0] = __builtin_amdgcn_mfma_f32_16x16x32_bf16((bf16x8){ta0[0], ta0[1], ta0[2], ta0[3], tb0[0], tb0[1], tb0[2], tb0[3]}, pf, oT[(rb) + 0], 0, 0, 0); \
        oT[(rb) + 1] = __builtin_amdgcn_mfma_f32_16x16x32_bf16((bf16x8){ta1[0], ta1[1], ta1[2], ta1[3], tb1[0], tb1[1], tb1[2], tb1[3]}, pf, oT[(rb) + 1], 0, 0, 0); \
        oT[(rb) + 2] = __builtin_amdgcn_mfma_f32_16x16x32_bf16((bf16x8){ta2[0], ta2[1], ta2[2], ta2[3], tb2[0], tb2[1], tb2[2], tb2[3]}, pf, oT[(rb) + 2], 0, 0, 0); \
        oT[(rb) + 3] = __builtin_amdgcn_mfma_f32_16x16x32_bf16((bf16x8){ta3[0], ta3[1], ta3[2], ta3[3], tb3[0], tb3[1], tb3[2], tb3[3]}, pf, oT[(rb) + 3], 0, 0, 0); } while (0)
        PVRB4(0); PVRB4(4); PVRB4(8); PVRB4(12);
#undef PVRB4
#undef TRRD2
        SBAR();
    }
#undef GATHER
    const float rl = 1.0f / l;
    if (i16 < 8) { bf16_t* op = (bf16_t*)(ws + R_OLAT) + (size_t)tok * 2048 + i16 * 256 + 4 * g;
#pragma unroll
        for (int rb = 0; rb < 16; ++rb) { u32x2 w; w.x = cvtpk(oT[rb][0] * rl, oT[rb][1] * rl); w.y = cvtpk(oT[rb][2] * rl, oT[rb][3] * rl); *(u32x2*)(op + rb * 16) = w; } }
}
#ifdef ATT_SUB
#define ASUB(k) ((k) == ATT_SUB)
#else
#define ASUB(k) true
#endif
__device__ __forceinline__ void phase_attn(const Frame& F0, int l, int rep) { const Frame F = fresh(F0);
    unsigned char* ws = F.ws; char* lds = (char*)F.lds;
    const bf16_t* qkv = (const bf16_t*)(ws + R_QKV); const size_t TS = (size_t)NTOK * 1024;
    unsigned* qctr = (unsigned*)(ws + WS_CTL) + CW_QCTR + l * 64 + rep * 16; const unsigned* kmx = (const unsigned*)(ws + WS_CTL) + CW_KMAX + l * 16;
    int* qitem = (int*)(lds + att::OFF_QITEM);
    int* hord = qitem + 4;
    if (F.tid < 16) { const float* cumb = (const float*)(ws + WS_CUM); const float mine = -cumb[(size_t)F.tid * SEQ + SEQ - 1]; int rank = 0;
        for (int o = 0; o < 16; ++o) { const float v = -cumb[(size_t)o * SEQ + SEQ - 1]; rank += (v < mine || (v == mine && o < F.tid)) ? 1 : 0; }
        hord[rank] = F.tid; }
#pragma unroll 1
    for (;;) {
        __syncthreads();
        if (F.tid == 0) qitem[0] = (int)atomicAdd(qctr, 1u);
        __syncthreads();
        const int it = qitem[0];
        if (it >= 1024) break;
        const int md = it >> 9, j = it & 511;
        const int qb = md == 0 ? 31 - (j & 31) : 31 - (j >> 4), bh = md == 0 ? hord[j >> 5] : (j & 15), b = bh >> 3, h = bh & 7, P0 = qb * 256;
        if (!ASUB(md)) continue;
        const bf16_t* Q = qkv + (size_t)(md * 3 + 0) * TS + (size_t)bh * SEQ * 128; const bf16_t* K = qkv + (size_t)(md * 3 + 1) * TS + (size_t)bh * SEQ * 128; const bf16_t* V = qkv + (size_t)(md * 3 + 2) * TS + (size_t)bh * SEQ * 128;
        const float* cum = (const float*)(ws + WS_CUM) + (size_t)bh * SEQ;
        bf16_t* Ob = (bf16_t*)(ws + R_OA) + (size_t)b * SEQ * 3072 + (md + 1) * 1024 + h * 128;
        if (md == 0) { const float kmaxc = sqrtf(__uint_as_float(kmx[bh])) * C2; att::attn_unit<0>(Q, K, V, cum, Ob + (size_t)P0 * 3072, P0, lds, kmaxc); }
        else att::attn_unit<1>(Q, K, V, cum, Ob + (size_t)P0 * 3072, P0, lds, 0.f);
    }
    __syncthreads();
    char* ldsw = lds + F.wid * 18944;
#pragma unroll 1
    for (int rep = 0; rep < NREP(2); ++rep)
#pragma unroll 1
    for (int tok = F.bid * 8 + F.wid; tok < NTOK; tok += F.G * 8) if (ASUB(2)) sparse_query(F, tok, ldsw);
}

__device__ __forceinline__ void ln_row(const bf16_t* src, const float* g, const float* bta, float* of, bf16_t* ob, int lane, unsigned char* oq = nullptr, float* osc = nullptr, float* ost = nullptr) {
    f32x4 v[8]; float s = 0.f;
#pragma unroll
    for (int i = 0; i < 4; ++i) { const u32x4 w = *(const u32x4*)(src + (i * 64 + lane) * 8);
        v[2 * i] = (f32x4){bflo(w.x), bfhi(w.x), bflo(w.y), bfhi(w.y)}; v[2 * i + 1] = (f32x4){bflo(w.z), bfhi(w.z), bflo(w.w), bfhi(w.w)};
        s += (v[2 * i][0] + v[2 * i][1]) + (v[2 * i][2] + v[2 * i][3]) + (v[2 * i + 1][0] + v[2 * i + 1][1]) + (v[2 * i + 1][2] + v[2 * i + 1][3]); }
    s = wave_sum(s); const float mu = s * (1.0f / 2048.0f); float q = 0.f;
#pragma unroll
    for (int i = 0; i < 8; ++i) { const f32x4 d = v[i] - mu; q += (d[0] * d[0] + d[1] * d[1]) + (d[2] * d[2] + d[3] * d[3]); }
    q = wave_sum(q); const float rstd = rsqrtf(q * (1.0f / 2048.0f) + 1e-5f);
    if (ost && lane == 0) { ost[0] = mu; ost[1] = rstd; }
    float amax = 0.f;
#pragma unroll
    for (int i = 0; i < 4; ++i) { const int c = (i * 64 + lane) * 8; const f32x4 g0 = *(const f32x4*)(g + c), g1 = *(const f32x4*)(g + c + 4), b0 = *(const f32x4*)(bta + c), b1 = *(const f32x4*)(bta + c + 4);
        const f32x4 y0 = (v[2 * i] - mu) * rstd * g0 + b0, y1 = (v[2 * i + 1] - mu) * rstd * g1 + b1; v[2 * i] = y0; v[2 * i + 1] = y1;
        if (of) { *(f32x4*)(of + c) = y0; *(f32x4*)(of + c + 4) = y1; }
        if (ob) pg8::st_bf16x8(ob + c, y0, y1);
        if (oq) { amax = fmaxf(amax, fmaxf(fmaxf(fmaxf(fabsf(y0[0]), fabsf(y0[1])), fmaxf(fabsf(y0[2]), fabsf(y0[3]))), fmaxf(fmaxf(fabsf(y1[0]), fabsf(y1[1])), fmaxf(fabsf(y1[2]), fabsf(y1[3]))))); } }
    if (oq) {
        for (int o = 32; o > 0; o >>= 1) amax = fmaxf(amax, __shfl_xor(amax, o));
        amax = fmaxf(amax, 1e-20f); const float qi = 127.0f / amax; if (lane == 0) *osc = amax * (1.0f / 127.0f);
#pragma unroll
        for (int i = 0; i < 4; ++i) { u32x2 w;
#pragma unroll
            for (int h = 0; h < 2; ++h) { const f32x4 y = v[2 * i + h]; unsigned pk = 0u;
#pragma unroll
                for (int j = 0; j < 4; ++j) pk |= ((unsigned)(int)rintf(y[j] * qi) & 0xffu) << (8 * j);
                w[h] = pk; }
            *(u32x2*)(oq + (i * 64 + lane) * 8) = w; } }
}
__device__ __forceinline__ void phase_ln1_router(const Frame& F0, const Params& P, int l) { const Frame F = fresh(F0);
    unsigned char* ws = F.ws; const int lane = F.lane, wid = F.wid;
    const bf16_t* pre1 = (const bf16_t*)(ws + R_PRE1); float* x1f = (float*)(ws + M_X1F); bf16_t* x1b = (bf16_t*)(ws + M_X1B); unsigned char* x1q = (unsigned char*)(ws + M_X1Q); float* x1s = (float*)(ws + M_X1S);
    const float* g = F.in(11) + l * DM; const float* bt = F.in(12) + l * DM; const float* wr = F.in(13) + (size_t)l * DM * NEXP; const float* br = F.in(14) + l * NEXP;
    unsigned* cnt = (unsigned*)(ws + WS_CTL) + CW_CNT + l * 2048;
    int* tok_e = (int*)(ws + M_TOKE); int* tok_pos = (int*)(ws + M_TOKPOS); float* tok_w = (float*)(ws + M_TOKW);
    float* red = (float*)F.lds;
    float* lg = (float*)(F.lds + 32768); float* stats = (float*)(F.lds + 32768 + 16384);
#pragma unroll 1
    for (int blk = F.bid; blk < NTOK / 64; blk += F.G) {
        const int tok0 = blk * 64;
#pragma unroll 1
        for (int i = 0; i < 8; ++i) { const int tok = tok0 + wid * 8 + i; ln_row(pre1 + (size_t)tok * DM, g, bt, (float*)nullptr, x1b + (size_t)tok * DM, lane, x1q + (size_t)tok * DM, x1s + tok, stats + 2 * (wid * 8 + i)); }
        asm volatile("s_waitcnt vmcnt(0)" ::: "memory"); __syncthreads();
        { const int grp = wid >> 2, kq = wid & 3, i32 = lane & 31, hk = lane >> 5; f32x16 acc = {};
          const bf16_t* arow = pre1 + (size_t)(tok0 + grp * 32 + i32) * DM + kq * 512 + 4 * hk; const float* bcol = wr + (size_t)(kq * 512 + 4 * hk) * NEXP + i32;
          const float* gp = g + kq * 512 + 4 * hk; const float* bp = bt + kq * 512 + 4 * hk; const float mu = stats[2 * (grp * 32 + i32)], rstd = stats[2 * (grp * 32 + i32) + 1];
#pragma unroll 4
          for (int c8 = 0; c8 < 64; ++c8) { const u32x2 xw = *(const u32x2*)(arow + c8 * 8); const f32x4 g4 = *(const f32x4*)(gp + c8 * 8), b4 = *(const f32x4*)(bp + c8 * 8);
              const f32x4 a4 = ((f32x4){bflo(xw.x), bfhi(xw.x), bflo(xw.y), bfhi(xw.y)} - mu) * rstd * g4 + b4;
              const float b0 = bcol[(size_t)(c8 * 8 + 0) * NEXP], b1 = bcol[(size_t)(c8 * 8 + 1) * NEXP], b2 = bcol[(size_t)(c8 * 8 + 2) * NEXP], b3 = bcol[(size_t)(c8 * 8 + 3) * NEXP];
              acc = __builtin_amdgcn_mfma_f32_32x32x2f32(a4[0], b0, acc, 0, 0, 0); acc = __builtin_amdgcn_mfma_f32_32x32x2f32(a4[1], b1, acc, 0, 0, 0);
              acc = __builtin_amdgcn_mfma_f32_32x32x2f32(a4[2], b2, acc, 0, 0, 0); acc = __builtin_amdgcn_mfma_f32_32x32x2f32(a4[3], b3, acc, 0, 0, 0); }
#pragma unroll
          for (int r = 0; r < 16; ++r) red[(wid * 16 + r) * 64 + lane] = acc[r]; }
        __syncthreads();
        if ((wid & 3) == 0) { const int grp = wid >> 2, hk = lane >> 5, e = lane & 31; const float be = br[e];
#pragma unroll
            for (int r = 0; r < 16; ++r) { const float v = red[((wid + 0) * 16 + r) * 64 + lane] + red[((wid + 1) * 16 + r) * 64 + lane] + red[((wid + 2) * 16 + r) * 64 + lane] + red[((wid + 3) * 16 + r) * 64 + lane] + be;
                lg[(grp * 32 + crow(r, hk)) * 33 + e] = v; }
            asm volatile("s_waitcnt lgkmcnt(0)" ::: "memory"); SBAR();
            const int tk = lane & 31; float v[32];
#pragma unroll
            for (int e2 = 0; e2 < 32; ++e2) v[e2] = lg[(grp * 32 + tk) * 33 + e2];
            int ek[4]; float vk[4];
#pragma unroll
            for (int k = 0; k < 4; ++k) { float best = -__builtin_inff(); int bi = 0;
#pragma unroll
                for (int e2 = 0; e2 < 32; ++e2) if (v[e2] > best) { best = v[e2]; bi = e2; }
                ek[k] = bi; vk[k] = best;
#pragma unroll
                for (int e2 = 0; e2 < 32; ++e2) v[e2] = (e2 == bi) ? -__builtin_inff() : v[e2]; }
            float wk[4], sw = 0.f;
#pragma unroll
            for (int k = 0; k < 4; ++k) { wk[k] = __expf(vk[k] - vk[0]); sw += wk[k]; }
            const float rs = 1.0f / sw;
            const bool act = lane < 32; unsigned myc = 0u;
#pragma unroll 1
            for (int E = 0; E < 32; ++E) { unsigned c = 0u;
#pragma unroll
                for (int k = 0; k < 4; ++k) c += (unsigned)__popcll(__ballot(act && ek[k] == E));
                if (lane == E) myc = c; }
            unsigned run = 0u; if (lane < 32 && myc > 0u) run = atomicAdd(&cnt[lane * 64], myc);
            int pk[4];
#pragma unroll
            for (int k = 0; k < 4; ++k) { pk[k] = 0;
#pragma unroll 1
                for (int E = 0; E < 32; ++E) { const unsigned long long mm = __ballot(act && ek[k] == E); const unsigned basev = (unsigned)__shfl((int)run, E);
                    if (act && ek[k] == E) pk[k] = (int)(basev + (unsigned)__popcll(mm & ((1ull << lane) - 1ull)));
                    if (lane == E) run += (unsigned)__popcll(mm); } }
            if (act) { const int tok = tok0 + grp * 32 + tk;
#pragma unroll
                for (int k = 0; k < 4; ++k) { tok_e[tok * 4 + k] = ek[k]; tok_pos[tok * 4 + k] = pk[k]; tok_w[tok * 4 + k] = wk[k] * rs; } }
        }
        __syncthreads();
    }
}
__device__ __forceinline__ void phase_moe_gather(const Frame& F0, int l) { const Frame F = fresh(F0);
    unsigned char* ws = F.ws; const int lane = F.lane;
    const unsigned* cnt = (const unsigned*)(ws + WS_CTL) + CW_CNT + l * 2048; unsigned* meta = (unsigned*)(ws + WS_CTL) + CW_META + l * 512;
    unsigned* offs = (unsigned*)(F.lds + LDS_MISC + 64);
    if (F.tid == 0) { unsigned o = 0u; for (int e = 0; e < 32; ++e) { offs[e] = o; o += (cnt[e * 64] + 255u) & ~255u; } offs[32] = o;
        if (F.bid == 0) { meta[0] = o >> 8; for (int e = 0; e < 32; ++e) for (unsigned t = offs[e] >> 8; t < (offs[e + 1] >> 8); ++t) meta[1 + t] = (unsigned)e; } }
    __syncthreads();
    const int* tok_e = (const int*)(ws + M_TOKE); const int* tok_pos = (const int*)(ws + M_TOKPOS); const float* tok_w = (const float*)(ws + M_TOKW);
    int* tok_dst = (int*)(ws + M_TOKDST); float* roww = (float*)(ws + M_ROWW);
    const unsigned char* x1q = (const unsigned char*)(ws + M_X1Q); const float* x1s = (const float*)(ws + M_X1S); unsigned char* xs = (unsigned char*)(ws + M_XS); float* rowsx = (float*)(ws + M_ROWSX);
    unsigned* rowtok = (unsigned*)(ws + M_ROWTOK);
    for (int it = F.bid * 512 + F.tid; it < NTOK * 4; it += F.G * 512) { const int tok = it >> 2;
        const int e = tok_e[it]; const unsigned dst = offs[e] + (unsigned)tok_pos[it];
        tok_dst[it] = (int)dst; roww[dst] = tok_w[it]; rowsx[dst] = x1s[tok]; rowtok[dst] = (unsigned)tok; }
    if (F.bid < 32) { const unsigned e = (unsigned)F.bid, c0 = offs[e] + cnt[e * 64];
        for (unsigned r = c0 + (unsigned)F.tid; r < offs[e + 1]; r += 512u) rowtok[r] = 0u; }
    __syncthreads();
}
__device__ __forceinline__ void phase_quant_h(const Frame& F0, int l) { const Frame F = fresh(F0);
    unsigned char* ws = F.ws; const int lane = F.lane;
    const int nrows = (int)((const unsigned*)(ws + WS_CTL))[CW_META + l * 512] * 256;
    const float* hm = (const float*)(ws + M_HM); const bf16_t* hid = (const bf16_t*)(ws + M_HID); unsigned char* h8 = (unsigned char*)(ws + M_H8); float* h8s = (float*)(ws + M_H8S);
    for (int row = F.bid * 8 + F.wid; row < nrows; row += F.G * 8) {
        float am = hm[(size_t)row * 32 + (lane & 31)];
        const u32x4 a = *(const u32x4*)(hid + (size_t)row * DEXP + lane * 16), b = *(const u32x4*)(hid + (size_t)row * DEXP + lane * 16 + 8);
        for (int o = 16; o > 0; o >>= 1) am = fmaxf(am, __shfl_xor(am, o));
        am = fmaxf(am, 1e-20f); const float qi = 127.0f / am; if (lane == 0) h8s[row] = am * (1.0f / 127.0f);
        const unsigned wv[8] = {a.x, a.y, a.z, a.w, b.x, b.y, b.z, b.w}; u32x4 w;
#pragma unroll
        for (int d = 0; d < 4; ++d) { unsigned pk = 0u;
#pragma unroll
            for (int j = 0; j < 2; ++j) { const unsigned x = wv[d * 2 + j];
                const float q0 = fminf(fmaxf(rintf(bflo(x) * qi), -127.f), 127.f), q1 = fminf(fmaxf(rintf(bfhi(x) * qi), -127.f), 127.f);
                pk |= (((unsigned)(int)q0 & 0xffu) | (((unsigned)(int)q1 & 0xffu) << 8)) << (16 * j); }
            w[d] = pk; }
        *(u32x4*)(h8 + (size_t)row * DEXP + lane * 16) = w; }
}
__device__ __forceinline__ void phase_combine(const Frame& F0) { const Frame F = fresh(F0);
    unsigned char* ws = F.ws; const int lane = F.lane;
    const bf16_t* x1b = (const bf16_t*)(ws + M_X1B); const bf16_t* ys = (const bf16_t*)(ws + M_XS); const int* tok_dst = (const int*)(ws + M_TOKDST);
    bf16_t* hb = (bf16_t*)(ws + M_HB); unsigned char* hq = (unsigned char*)(ws + M_HQ); float* hsc = (float*)(ws + M_HSC);
    for (int tok = F.bid * 8 + F.wid; tok < NTOK; tok += F.G * 8) {
        const int d0 = tok_dst[tok * 4], d1 = tok_dst[tok * 4 + 1], d2 = tok_dst[tok * 4 + 2], d3 = tok_dst[tok * 4 + 3];
        f32x4 hv[8]; float amax = 0.f;
#pragma unroll
        for (int i = 0; i < 4; ++i) { const int c = (i * 64 + lane) * 8; const size_t o = (size_t)tok * DM + c;
            const u32x4 xw = *(const u32x4*)(x1b + o);
            f32x4 a = (f32x4){bflo(xw.x), bfhi(xw.x), bflo(xw.y), bfhi(xw.y)} * ALPHA, b = (f32x4){bflo(xw.z), bfhi(xw.z), bflo(xw.w), bfhi(xw.w)} * ALPHA;
            const u32x4 y0 = *(const u32x4*)(ys + (size_t)d0 * DM + c), y1 = *(const u32x4*)(ys + (size_t)d1 * DM + c), y2 = *(const u32x4*)(ys + (size_t)d2 * DM + c), y3 = *(const u32x4*)(ys + (size_t)d3 * DM + c);
            a[0] += (bflo(y0.x) + bflo(y1.x)) + (bflo(y2.x) + bflo(y3.x)); a[1] += (bfhi(y0.x) + bfhi(y1.x)) + (bfhi(y2.x) + bfhi(y3.x));
            a[2] += (bflo(y0.y) + bflo(y1.y)) + (bflo(y2.y) + bflo(y3.y)); a[3] += (bfhi(y0.y) + bfhi(y1.y)) + (bfhi(y2.y) + bfhi(y3.y));
            b[0] += (bflo(y0.z) + bflo(y1.z)) + (bflo(y2.z) + bflo(y3.z)); b[1] += (bfhi(y0.z) + bfhi(y1.z)) + (bfhi(y2.z) + bfhi(y3.z));
            b[2] += (bflo(y0.w) + bflo(y1.w)) + (bflo(y2.w) + bflo(y3.w)); b[3] += (bfhi(y0.w) + bfhi(y1.w)) + (bfhi(y2.w) + bfhi(y3.w));
            pg8::st_bf16x8(hb + o, a, b); hv[2 * i] = a; hv[2 * i + 1] = b;
#pragma unroll
            for (int j = 0; j < 4; ++j) amax = fmaxf(amax, fmaxf(fabsf(a[j]), fabsf(b[j]))); }
        for (int o = 32; o > 0; o >>= 1) amax = fmaxf(amax, __shfl_xor(amax, o));
        amax = fmaxf(amax, 1e-20f); const float qi = 127.0f / amax; if (lane == 0) hsc[tok] = amax * (1.0f / 127.0f);
#pragma unroll
        for (int i = 0; i < 4; ++i) { u32x2 w;
#pragma unroll
            for (int h = 0; h < 2; ++h) { unsigned pk = 0u;
#pragma unroll
                for (int j = 0; j < 4; ++j) pk |= ((unsigned)(int)rintf(hv[2 * i + h][j] * qi) & 0xffu) << (8 * j);
                w[h] = pk; }
            *(u32x2*)(hq + (size_t)tok * DM + (i * 64 + lane) * 8) = w; } }
}
__device__ __forceinline__ void phase_ln2(const Frame& F0, const Params& P, int l) { const Frame F = fresh(F0);
    unsigned char* ws = F.ws; const bf16_t* pre2 = (const bf16_t*)(ws + M_X1F); bf16_t* xb = (bf16_t*)(ws + WS_XB);
    const float* g = F.in(23) + l * DM; const float* bt = F.in(24) + l * DM; float* outp = F.out();
    for (int tok = F.bid * 8 + F.wid; tok < NTOK; tok += F.G * 8) ln_row(pre2 + (size_t)tok * DM, g, bt, (l + 1 == NLAYER) ? outp + (size_t)tok * DM : (float*)nullptr, (l + 1 == NLAYER) ? (bf16_t*)nullptr : xb + (size_t)tok * DM, F.lane,
                                                                          (l + 1 == NLAYER) ? (unsigned char*)nullptr : (unsigned char*)(ws + WS_XQ) + (size_t)tok * DM, (l + 1 == NLAYER) ? (float*)nullptr : (float*)(ws + WS_XSC) + tok);
}

constexpr int NPHASE = 2 + 15 * NLAYER;
#ifdef PH_ONLY
#define PEN(kind) ((kind) == PH_ONLY)
#else
#define PEN(kind) true
#endif
#define IN(k) (lo <= (k) && (k) < hi)
#define SEAM(k) do { if (IN((k) + 1)) xcd_barrier(bar); } while (0)

template <int l>
__device__ __forceinline__ void layer_phases(const Frame& F, const Params& P, const XcdBarrier& bar, const int lo, const int hi, unsigned char* ws0) {
    using namespace pg8;

        const int pb = 2 + 15 * l;
        if (IN(pb + 0) && PEN(0)) { size_t wz = 0; asm volatile("" : "+s"(wz)); unsigned char* ws = ws0 + wz;
            { SchedS S; S.init(NTOK, 5 * 256, F.G, F.bid, (const bf16_t*)(ws + WS_XB), DM, (const bf16_t*)(ws + W_IN), DM); S.skip_from = 0; S.skip_by = 4; S.skip_from2 = 4; S.skip_by2 = 49;
              EpiInProj<false> E{(bf16_t*)(ws + R_QA), (bf16_t*)(ws + R_QIDX), (bf16_t*)(ws + R_QKV), (bf16_t*)(ws + R_GATES), (float*)(ws + R_SMALL), nullptr, nullptr};
              for (int rep = 0; rep < NREP(5); ++rep) gemm_phase(F.ldsl, DM, DM, DM, S, E); }
            { SchedS S; S.init(NTOK, 53 * 256, F.G, (F.bid + F.G / 2) % F.G, (const bf16_t*)(ws + WS_XQ), DM / 2, (const bf16_t*)(ws + W_IN8), DM / 2); S.skip_from = 4; S.skip_by = 4; S.b_compact = 1;
              if (F.G == 256) { S.c = F.bid; S.cut = 12; S.extra_n = 192; S.extra_c = F.bid >= 64 ? F.bid - 64 : -1; }
              EpiInProj<true> E{(bf16_t*)(ws + R_QA), (bf16_t*)(ws + R_QIDX), (bf16_t*)(ws + R_QKV), (bf16_t*)(ws + R_GATES), (float*)(ws + R_SMALL), (const float*)(ws + WS_XSC), (const unsigned*)(ws + WS_CTL) + CW_WMAXG + l};
              for (int rep = 0; rep < NREP(5); ++rep) gemm_phase(F.ldsl, DM / 2, DM / 2, DM / 2, S, E); }
            SEAM(pb + 0); }
        if (IN(pb + 1) && PEN(1)) { size_t wz = 0; asm volatile("" : "+s"(wz)); unsigned char* ws = ws0 + wz;
            phase_prep(F, P, l);
            SchedS S; S.init(NTOK, 2048, F.G, F.bid, (const bf16_t*)(ws + R_QA), 1024, (const bf16_t*)(ws + W_UK2), 256, 1, 256);
            EpiBf16 E{(bf16_t*)(ws + R_QCAT), 2304, 288};
            for (int rep = 0; rep < NREP(10); ++rep) gemm_phase(F.ldsl, 256, 1024, 256, S, E); SEAM(pb + 1); }
        if (IN(pb + 2) && PEN(2)) { size_t wz = 0; asm volatile("" : "+s"(wz)); unsigned char* ws = ws0 + wz; phase_cumsum(F); for (int rep = 0; rep < NREP(3); ++rep) phase_idx(F); SEAM(pb + 2); }
        if (IN(pb + 3) && PEN(3)) { size_t wz = 0; asm volatile("" : "+s"(wz)); unsigned char* ws = ws0 + wz; for (int rep = 0; rep < NREP(4); ++rep) phase_topk(F); SEAM(pb + 3); }
        if (IN(pb + 4) && PEN(4)) { size_t wz = 0; asm volatile("" : "+s"(wz)); unsigned char* ws = ws0 + wz; for (int rep = 0; rep < NREP(1); ++rep) phase_attn(F, l, rep); SEAM(pb + 4); }
        if (IN(pb + 5) && PEN(5)) { size_t wz = 0; asm volatile("" : "+s"(wz)); unsigned char* ws = ws0 + wz;
            SchedS S; S.init(NTOK, 1024, F.G, F.bid, (const bf16_t*)(ws + R_OLAT), 2048, (const bf16_t*)(ws + W_UV2), 512, 0, 512);
            EpiBf16 E{(bf16_t*)(ws + R_OA), 3072, 256}; for (int rep = 0; rep < NREP(10); ++rep) gemm_phase(F.ldsl, 512, 2048, 512, S, E);
            SEAM(pb + 5); }
        if (IN(pb + 6) && PEN(6)) { size_t wz = 0; asm volatile("" : "+s"(wz)); unsigned char* ws = ws0 + wz;
            SchedS S; S.init(NTOK, 2048, F.G, F.bid, (const bf16_t*)(ws + R_OA), 3072, (const bf16_t*)(ws + W_BRA), 3072);
            EpiBranch3 E{(const unsigned char*)(ws + R_GATES), (bf16_t*)(ws + R_MERGED)}; for (int rep = 0; rep < NREP(11); ++rep) gemm_phase(F.ldsl, 3072, 3072, 3072, S, E); SEAM(pb + 6); }
        if (IN(pb + 7) && PEN(7)) { size_t wz = 0; asm volatile("" : "+s"(wz)); unsigned char* ws = ws0 + wz;
            SchedS S; S.init(NTOK, 2048, F.G, F.bid, (const bf16_t*)(ws + R_MERGED), DM, (const bf16_t*)(ws + W_OUT), DM);
            EpiOut E{(const bf16_t*)(ws + WS_XB), (bf16_t*)(ws + R_PRE1)}; for (int rep = 0; rep < NREP(8); ++rep) gemm_phase(F.ldsl, DM, DM, DM, S, E); SEAM(pb + 7); }
        if (IN(pb + 8) && PEN(8)) { size_t wz = 0; asm volatile("" : "+s"(wz)); unsigned char* ws = ws0 + wz; phase_ln1_router(F, P, l); SEAM(pb + 8); }
        if (IN(pb + 9) && PEN(9)) { size_t wz = 0; asm volatile("" : "+s"(wz)); unsigned char* ws = ws0 + wz;
            for (int rep = 0; rep < NREP(12); ++rep) phase_moe_gather(F, l);
            SchedS S; S.init(NTOK, 2048, F.G, F.bid, (const bf16_t*)(ws + WS_PB) + (size_t)l * NTOK * 256, 256, (const bf16_t*)(ws + W_PLE), 256);
            EpiBf16 E{(bf16_t*)(ws + M_PP), 2048, 256}; for (int rep = 0; rep < NREP(10); ++rep) gemm_phase(F.ldsl, 256, 256, 256, S, E); SEAM(pb + 9); }
        if (IN(pb + 10) && PEN(10)) { size_t wz = 0; asm volatile("" : "+s"(wz)); unsigned char* ws = ws0 + wz;
            SchedMG S; S.init((const unsigned*)(ws + WS_CTL) + CW_META + l * 512, F.G, F.bid, (const bf16_t*)(ws + M_X1Q), DM / 2, (const bf16_t*)(ws + W_GU), DM / 2);
            { LAS unsigned* gt = (LAS unsigned*)(F.ldsl + pg8::GTAB_OFF); const unsigned* rowtok = (const unsigned*)(ws + M_ROWTOK);
              for (int ui = 0; ui * F.G + F.bid < S.ntiles * 8; ++ui) { const int pm = (ui * F.G + F.bid) >> 3; if (F.tid < 256) gt[ui * 256 + F.tid] = rowtok[pm * 256 + F.tid] * 2048u; }
              __syncthreads(); }
            EpiGateUpI8 E{F.in(16) + (size_t)l * NEXP * DEXP, F.in(18) + (size_t)l * NEXP * DEXP, (bf16_t*)(ws + M_HID), (const float*)(ws + M_ROWSX), (const unsigned*)(ws + WS_CTL) + CW_WMAX + l, (float*)(ws + M_HM)};
            for (int rep = 0; rep < NREP(6); ++rep) gemm_phase(F.ldsl, DM / 2, DM / 2, DM / 2, S, E); SEAM(pb + 10); }
        if (IN(pb + 11) && PEN(11)) { size_t wz = 0; asm volatile("" : "+s"(wz)); unsigned char* ws = ws0 + wz;
            phase_quant_h(F, l); xcd_barrier(bar);
            SchedM S; S.init((const unsigned*)(ws + WS_CTL) + CW_META + l * 512, F.G, F.bid, (const bf16_t*)(ws + M_H8), DEXP / 2, (const bf16_t*)(ws + W_DN), DEXP / 2);
            EpiDownI8 E{F.in(20) + (size_t)l * NEXP * DM, (const float*)(ws + M_ROWW), (bf16_t*)(ws + M_XS), (const float*)(ws + M_H8S), (const unsigned*)(ws + WS_CTL) + CW_WMAXD + l};
            for (int rep = 0; rep < NREP(7); ++rep) gemm_phase(F.ldsl, DEXP / 2, DEXP / 2, DEXP / 2, S, E); SEAM(pb + 11); }
        if (IN(pb + 12) && PEN(12)) { size_t wz = 0; asm volatile("" : "+s"(wz)); unsigned char* ws = ws0 + wz; for (int rep = 0; rep < NREP(9); ++rep) phase_combine(F); SEAM(pb + 12); }
        if (IN(pb + 13) && PEN(13)) { size_t wz = 0; asm volatile("" : "+s"(wz)); unsigned char* ws = ws0 + wz;
            SchedS S; S.init(NTOK, 2048, F.G, F.bid, (const bf16_t*)(ws + M_HQ), DM / 2, (const bf16_t*)(ws + W_PG), DM / 2);
            EpiPleGateI8 E{(const bf16_t*)(ws + M_HB), (const bf16_t*)(ws + M_PP), (bf16_t*)(ws + M_X1F), (const float*)(ws + M_HSC), (const unsigned*)(ws + WS_CTL) + CW_WMAXP + l};
            for (int rep = 0; rep < NREP(8); ++rep) gemm_phase(F.ldsl, DM / 2, DM / 2, DM / 2, S, E); SEAM(pb + 13); }
        if (IN(pb + 14) && PEN(14)) { size_t wz = 0; asm volatile("" : "+s"(wz)); unsigned char* ws = ws0 + wz; for (int rep = 0; rep < NREP(13); ++rep) phase_ln2(F, P, l); if (l + 1 < NLAYER) for (int rep = 0; rep < NREP(0); ++rep) convert_layer_weights(F, P, l + 1); SEAM(pb + 14); }
}
__global__ void __launch_bounds__(512, 2) fwd(Params P) {
    extern __shared__ __attribute__((aligned(16))) unsigned char lds[];
    Frame F; F.lds = lds; F.ldsl = (LAS unsigned char*)lds; F.ws = P.ws; F.tid = threadIdx.x; F.lane = F.tid & 63; F.wid = __builtin_amdgcn_readfirstlane(F.tid >> 6); F.G = gridDim.x; F.bid = blockIdx.x;
    unsigned char* ws0 = P.ws; unsigned char* ws = ws0;
    const bool fused = (P.ph_hi - P.ph_lo) > 1;
    if (F.tid < 4) ((LAS unsigned*)(F.ldsl + LDS_MISC))[F.tid] = 0u;
    if (F.tid == 0) { LAS unsigned long long* t = (LAS unsigned long long*)(F.ldsl + LDS_PTRS);
#pragma unroll
        for (int k = 0; k < 25; ++k) t[k] = (unsigned long long)P.in[k];
        t[25] = (unsigned long long)P.out; }
    __syncthreads();
    XcdBarrier bar; bar.bar = (unsigned*)(ws + WS_CTL) + CW_BAR; bar.x = 0; bar.st = (volatile LAS unsigned*)(F.ldsl + LDS_MISC);
    if (fused) bar = xcd_barrier_post((unsigned*)(ws + WS_CTL) + CW_BAR, (volatile LAS unsigned*)(F.ldsl + LDS_MISC));
    const int lo = P.ph_lo, hi = P.ph_hi;
    using namespace pg8;
    if (IN(0) && PEN(15)) { size_t wz = 0; asm volatile("" : "+s"(wz)); unsigned char* ws = ws0 + wz;
        quant_rows(F, F.in(0), (bf16_t*)(ws + WS_XB), (unsigned char*)(ws + WS_XQ), (float*)(ws + WS_XSC));
        conv_rows(F, F.in(1), (bf16_t*)(ws + WS_PB), (size_t)2 * NTOK * 256 / 8);
        sample_wmax(F);
        SEAM(0);
    }
    if (IN(1) && PEN(15)) { for (int rep = 0; rep < NREP(0); ++rep) convert_layer_weights(F, P, 0); SEAM(1); }
    layer_phases<0>(F, P, bar, lo, hi, ws0);
    layer_phases<1>(F, P, bar, lo, hi, ws0);
}

#ifdef DEBUG_NAN
constexpr int CW_FLAGS = 12288;
__global__ void dbg_scan_bf16(const unsigned short* p, size_t n, unsigned* flag) { unsigned c = 0; for (size_t i = (size_t)blockIdx.x * blockDim.x + threadIdx.x; i < n; i += (size_t)gridDim.x * blockDim.x) if ((p[i] & 0x7F80u) == 0x7F80u) ++c; if (c) atomicAdd(flag, c); }
__global__ void dbg_scan_f32(const unsigned* p, size_t n, unsigned* flag) { unsigned c = 0; for (size_t i = (size_t)blockIdx.x * blockDim.x + threadIdx.x; i < n; i += (size_t)gridDim.x * blockDim.x) if ((p[i] & 0x7F800000u) == 0x7F800000u) ++c; if (c) atomicAdd(flag, c); }
__global__ void dbg_scan_sel(const int* sel, const int* nsel, unsigned* flag) { unsigned c = 0; for (size_t i = (size_t)blockIdx.x * blockDim.x + threadIdx.x; i < (size_t)NTOK * 256; i += (size_t)gridDim.x * blockDim.x) { const int tok = (int)(i >> 8), j = (int)(i & 255), t = tok & (SEQ - 1); const int ns = nsel[tok]; if (j == 0 && ns != (t + 1 < 256 ? t + 1 : 256)) ++c; if (j < ns && (sel[i] < 0 || sel[i] > t)) ++c; } if (c) atomicAdd(flag, c); }
__global__ void dbg_scan_scores(const unsigned* p, unsigned* flag) { unsigned c = 0; for (size_t i = (size_t)blockIdx.x * blockDim.x + threadIdx.x; i < 2ull * SEQ * SEQ; i += (size_t)gridDim.x * blockDim.x) { const int s = (int)(i & (SEQ - 1)), t = (int)((i >> 13) & (SEQ - 1)); if (s <= t && (p[i] & 0x7F800000u) == 0x7F800000u) ++c; } if (c) atomicAdd(flag, c); }
__global__ void dbg_probe_bf16(const unsigned short* p, size_t n, unsigned* cnt, unsigned* minidx) { unsigned c = 0; unsigned mi = 0xFFFFFFFFu; for (size_t i = (size_t)blockIdx.x * blockDim.x + threadIdx.x; i < n; i += (size_t)gridDim.x * blockDim.x) if ((p[i] & 0x7F80u) == 0x7F80u) { ++c; if ((unsigned)i < mi) mi = (unsigned)i; } if (c) { atomicAdd(cnt, c); atomicMax(minidx, ~mi); } }
__global__ void dbg_final(float* out, size_t n, const unsigned* flags) { int code = 0; for (int k = 0; k < 32; ++k) if (flags[k] && !code) code = k + 1; const int mask = (flags[32] ? 1 : 0) | (flags[33] ? 2 : 0) | (flags[34] ? 4 : 0); if (mask) code = 20 + 5 * mask; if (!code) return; for (size_t i = (size_t)blockIdx.x * blockDim.x + threadIdx.x; i < n; i += (size_t)gridDim.x * blockDim.x) out[i] = (float)code; }
#endif
extern "C" void kernel_launch(void* const* d_in, const int* in_sizes, int n_in, void* d_out, int out_size, void* d_ws, size_t ws_size, hipStream_t stream) {
    static int grid = 0;
    if (grid == 0) {
        if (n_in != 25 || out_size != NTOK * DM || ws_size < WS_NEED) { fprintf(stderr, "kernel_launch: unexpected shapes (n_in %d out %d ws %zu need %zu)\n", n_in, out_size, ws_size, (size_t)WS_NEED); grid = -1; return; }
        int dev = 0, cus = 0, per_cu = 0;
        if (hipGetDevice(&dev) != hipSuccess || hipDeviceGetAttribute(&cus, hipDeviceAttributeMultiprocessorCount, dev) != hipSuccess) { grid = -1; return; }
        if (hipFuncSetAttribute((const void*)fwd, hipFuncAttributeMaxDynamicSharedMemorySize, LDS_BYTES) != hipSuccess) { fprintf(stderr, "kernel_launch: hipFuncSetAttribute failed\n"); grid = -1; return; }
        if (hipOccupancyMaxActiveBlocksPerMultiprocessor(&per_cu, (const void*)fwd, 512, LDS_BYTES) != hipSuccess || per_cu < 1) fprintf(stderr, "kernel_launch: occupancy query says %d\n", per_cu);
        (void)hipGetLastError();
        grid = cus;
    }
    if (grid < 0) return;
    unsigned char* ws = (unsigned char*)d_ws;
    hipMemsetAsync(ws + WS_CTL, 0, CTL_BYTES, stream);
    hipMemsetAsync(ws + W_UK2, 0, 8ull * 256 * 256 * 2 + 4ull * 256 * 512 * 2, stream);
    hipMemsetAsync(ws + W_IN + (size_t)INW * 2048 * 2, 0, (size_t)(INWP - INW) * 2048 * 2, stream);
    Params p{};
    for (int i = 0; i < 25; ++i) p.in[i] = (const float*)d_in[i];
    p.out = (float*)d_out; p.ws = ws;
#if PHASES_PER_LAUNCH == 0
    p.ph_lo = 0; p.ph_hi = NPHASE;
    hipLaunchKernelGGL(fwd, dim3(grid), dim3(512), LDS_BYTES, stream, p);
#else
    for (int k = 0; k < NPHASE; ++k) { p.ph_lo = k; p.ph_hi = k + 1; hipLaunchKernelGGL(fwd, dim3(grid), dim3(512), LDS_BYTES, stream, p);
#ifdef DEBUG_NAN
        unsigned* fl = (unsigned*)(ws + WS_CTL) + CW_FLAGS + k;
#define SB16(off, n) hipLaunchKernelGGL(dbg_scan_bf16, dim3(1024), dim3(256), 0, stream, (const unsigned short*)(ws + (off)), (size_t)(n), fl)
#define SF32(off, n) hipLaunchKernelGGL(dbg_scan_f32, dim3(1024), dim3(256), 0, stream, (const unsigned*)(ws + (off)), (size_t)(n), fl)
        if (k == 0) { SB16(WS_XB, (size_t)NTOK * DM); SB16(WS_PB, 2ull * NTOK * 256); SB16(WS_W, (W_END - WS_W) / 2); }
        else { const int kind = (k - 1) % 15;
            if (kind == 0) { SB16(R_QA, (size_t)NTOK * 1024); SB16(R_QIDX, (size_t)NTOK * 1024); SB16(R_QKV, 6ull * NTOK * 1024); SB16(R_GATES, (size_t)NTOK * 6144); SF32(R_SMALL, (size_t)NTOK * 512); }
            if (kind == 1) { SB16(R_QCAT, (size_t)NTOK * 2304); SB16(R_KCAT, (size_t)NTOK * 288); SB16(R_KI, (size_t)NTOK * 64); SB16(R_QIDX, (size_t)NTOK * 1024); SF32(R_WI, (size_t)NTOK * 16); SF32(WS_LF, 16ull * 8192); }
            if (kind == 2) { SF32(WS_CUM, 16ull * 8192); hipLaunchKernelGGL(dbg_scan_scores, dim3(1024), dim3(256), 0, stream, (const unsigned*)(ws + R_SCORES), fl); }
            if (kind == 3) { hipLaunchKernelGGL(dbg_scan_sel, dim3(1024), dim3(256), 0, stream, (const int*)(ws + R_SEL), (const int*)(ws + R_NSEL), fl); }
            if (k == 5) { unsigned* fl0 = fl; fl = (unsigned*)(ws + WS_CTL) + CW_FLAGS + 32; SB16(R_OLAT, (size_t)NTOK * 2048); fl += 1; SB16(R_OA, (size_t)NTOK * 3072); fl += 1; fl = fl0; hipLaunchKernelGGL(dbg_probe_bf16, dim3(1024), dim3(256), 0, stream, (const unsigned short*)(ws + R_OC), (size_t)NTOK * 1024, (unsigned*)(ws + WS_CTL) + CW_FLAGS + 40, (unsigned*)(ws + WS_CTL) + CW_FLAGS + 41); }
            if (kind == 5) { SB16(R_OA, (size_t)NTOK * 3072); }
            if (kind == 6) { SB16(R_MERGED, (size_t)NTOK * 2048); }
            if (kind == 7) { SF32(R_PRE1, (size_t)NTOK * 2048); }
            if (kind == 8) { SF32(M_X1F, (size_t)NTOK * 2048); SF32(M_TOKW, (size_t)NTOK * 4); }
            if (kind == 9) { SB16(M_PP, (size_t)NTOK * 2048); }
            if (kind == 12) { SF32(M_HF, (size_t)NTOK * 2048); }
            if (kind == 13) { SF32(M_X1F, (size_t)NTOK * 2048); }
            if (kind == 14) { hipLaunchKernelGGL(dbg_scan_f32, dim3(1024), dim3(256), 0, stream, (const unsigned*)d_out, (size_t)NTOK * DM, fl); if (k + 1 < NPHASE) SB16(WS_W, (W_END - WS_W) / 2); } }
#endif
    }
#ifdef DEBUG_NAN
    hipLaunchKernelGGL(dbg_final, dim3(1024), dim3(256), 0, stream, (float*)d_out, (size_t)NTOK * DM, (const unsigned*)(ws + WS_CTL) + CW_FLAGS);
#endif
#endif
}
```

```cpp
#include <hip/hip_runtime.h>
#include <stdint.h>
#include <stdio.h>
#include <math.h>

#ifndef PHASES_PER_LAUNCH
#define PHASES_PER_LAUNCH 0
#endif

#define LAS __attribute__((address_space(3)))
#define GAS __attribute__((address_space(1)))
#ifndef REP_MASK
#define REP_MASK 0
#endif
#define NREP(bit) (((REP_MASK) >> (bit)) & 1 ? 2 : 1)
typedef unsigned short bf16_t;
typedef short bf16x8 __attribute__((ext_vector_type(8)));
typedef short s16x4 __attribute__((ext_vector_type(4)));
typedef float f32x4 __attribute__((ext_vector_type(4)));
typedef float f32x16 __attribute__((ext_vector_type(16)));
typedef unsigned u32x4 __attribute__((ext_vector_type(4)));
typedef unsigned u32x2 __attribute__((ext_vector_type(2)));
typedef int i32x4 __attribute__((ext_vector_type(4)));

constexpr int NTOK = 16384, DM = 2048, SEQ = 8192, NB = 2, NLAYER = 2;
constexpr int INW = 14712, INWP = 14848;
constexpr int NEXP = 32, DEXP = 1024;
constexpr int PMAX = 65536 + 8192;
constexpr float ALPHA = 1.41421356237309515f;
constexpr float LOG2E = 1.4426950408889634f;
constexpr float SCALE = 0.08838834764831845f;
constexpr float C2 = LOG2E * SCALE;

constexpr size_t MiB = 1ull << 20;
constexpr size_t WS_CTL   = 0;
constexpr size_t WS_W     = 1 * MiB;
constexpr size_t W_IN     = WS_W;
constexpr size_t W_IN8    = W_IN   + 2048ull * 2048 * 2;
constexpr size_t W_UK2    = W_IN   + (size_t)INWP * 2048 * 2;
constexpr size_t W_UV2    = W_UK2  + 8ull * 256 * 256 * 2;
constexpr size_t W_BRA    = W_UV2  + 4ull * 256 * 512 * 2;
constexpr size_t W_BRB    = W_BRA  + 2048ull * 1024 * 2;
constexpr size_t W_BRC    = W_BRB  + 2048ull * 1024 * 2;
constexpr size_t W_OUT    = W_BRC  + 2048ull * 1024 * 2;
constexpr size_t W_PG     = W_OUT  + 2048ull * 2048 * 2;
constexpr size_t W_PLE    = W_PG   + 2048ull * 2048 * 2;
constexpr size_t W_GU     = W_PLE  + 2048ull * 256 * 2;
constexpr size_t W_DN     = W_GU   + 32ull * 2048 * 2048 * 2;
constexpr size_t W_END    = W_DN   + 32ull * 2048 * 1024 * 2;
constexpr size_t WS_XB    = (W_END + MiB - 1) / MiB * MiB;
constexpr size_t WS_PB    = WS_XB  + (size_t)NTOK * DM * 2;
constexpr size_t WS_CUM   = WS_PB  + 2ull * NTOK * 256 * 2;
constexpr size_t WS_LF    = WS_CUM + 16ull * 8192 * 4;
constexpr size_t WS_XQ    = WS_LF  + 16ull * 8192 * 4;
constexpr size_t WS_XSC   = WS_XQ  + (size_t)NTOK * DM;
constexpr size_t WS_R     = (WS_XSC + (size_t)NTOK * 4 + MiB - 1) / MiB * MiB;
constexpr size_t R_SCORES = WS_R;
constexpr size_t R_OLAT   = WS_R;
constexpr size_t R_OA     = WS_R + 64 * MiB;
constexpr size_t R_OB     = WS_R + 96 * MiB;
constexpr size_t R_OC     = WS_R + 128 * MiB;
constexpr size_t R_TMP    = WS_R + 160 * MiB;
constexpr size_t R_MERGED = WS_R + 288 * MiB;
constexpr size_t R_PRE1   = WS_R + 384 * MiB;
constexpr size_t R_QA     = WS_R + 512 * MiB;
constexpr size_t R_QIDX   = WS_R + 544 * MiB;
constexpr size_t R_QKV    = WS_R + 576 * MiB;
constexpr size_t R_GATES  = WS_R + 768 * MiB;
constexpr size_t R_SMALL  = WS_R + 960 * MiB;
constexpr size_t R_QCAT   = WS_R + 992 * MiB;
constexpr size_t R_KCAT   = WS_R + 1064 * MiB;
constexpr size_t R_KI     = WS_R + 1073 * MiB;
constexpr size_t R_WI     = WS_R + 1075 * MiB;
constexpr size_t R_SEL    = WS_R + 1076 * MiB;
constexpr size_t R_NSEL   = WS_R + 1092 * MiB;
constexpr size_t R_END    = WS_R + 1093 * MiB;
constexpr size_t M_XS     = WS_R;
constexpr size_t M_HID    = WS_R + 288 * MiB;
constexpr size_t M_PP     = WS_R + 432 * MiB;
constexpr size_t M_X1F    = WS_R + 512 * MiB;
constexpr size_t M_X1B    = WS_R + 640 * MiB;
constexpr size_t M_HF     = WS_R + 704 * MiB;
constexpr size_t M_HQ     = WS_R + 704 * MiB;
constexpr size_t M_HSC    = WS_R + 736 * MiB;
constexpr size_t M_HB     = WS_R + 832 * MiB;
constexpr size_t M_TOKE   = WS_R + 896 * MiB;
constexpr size_t M_TOKPOS = M_TOKE + (size_t)NTOK * 16;
constexpr size_t M_TOKW   = M_TOKPOS + (size_t)NTOK * 16;
constexpr size_t M_TOKDST = M_TOKW + (size_t)NTOK * 16;
constexpr size_t M_ROWW   = M_TOKDST + (size_t)NTOK * 16;
constexpr size_t M_ROWSX  = M_ROWW + (size_t)PMAX * 4;
constexpr size_t M_X1S    = M_ROWSX + (size_t)PMAX * 4;
constexpr size_t M_X1Q    = WS_R + 900 * MiB;
constexpr size_t M_ROWTOK = WS_R + 750 * MiB;
constexpr size_t M_HM     = WS_R + 740 * MiB;
constexpr size_t M_H8     = WS_R + 752 * MiB;
constexpr size_t M_H8S    = WS_R + 826 * MiB;
constexpr size_t WS_NEED  = R_END;
constexpr int CW_BAR = 0;
constexpr int CW_CNT = 8192;
constexpr int CW_META = 4096 + 64;
constexpr int CW_QCTR = 6144;
constexpr int CW_WMAX = 6272;
constexpr int CW_WMAXG = 6336;
constexpr int CW_WMAXP = 6368;
constexpr int CW_WMAXD = 6384;
constexpr int CW_KMAX = 6400;
constexpr size_t CTL_BYTES = 65536;

constexpr int LDS_BYTES = 152576;
constexpr int LDS_MISC = 151552;

typedef float f32x2 __attribute__((ext_vector_type(2)));
typedef __bf16 bf16n2 __attribute__((ext_vector_type(2)));
__device__ __forceinline__ unsigned cvtpk(float lo, float hi) { f32x2 v = {lo, hi}; bf16n2 b = __builtin_convertvector(v, bf16n2); return __builtin_bit_cast(unsigned, b); }
__device__ __forceinline__ bf16_t f2bf(float x) { return (bf16_t)(cvtpk(x, 0.f) & 0xffffu); }
__device__ __forceinline__ float bf2f(bf16_t b) { return __uint_as_float(((unsigned)b) << 16); }
__device__ __forceinline__ float bflo(unsigned w) { return __uint_as_float(w << 16); }
__device__ __forceinline__ float bfhi(unsigned w) { return __uint_as_float(w & 0xffff0000u); }
__device__ __forceinline__ bf16x8 pack8(f32x4 a, f32x4 b) { u32x4 w = {cvtpk(a[0], a[1]), cvtpk(a[2], a[3]), cvtpk(b[0], b[1]), cvtpk(b[2], b[3])}; return *reinterpret_cast<bf16x8*>(&w); }
__device__ __forceinline__ float sigmoidf_(float x) { return 1.0f / (1.0f + __expf(-x)); }
__device__ __forceinline__ float wave_sum(float v) { for (int o = 32; o > 0; o >>= 1) v += __shfl_xor(v, o); return v; }
__device__ __forceinline__ int crow(int r, int hi) { return (r & 3) + 8 * (r >> 2) + 4 * hi; }
#define SBAR() __builtin_amdgcn_sched_barrier(0)

#define XB_TMO      128
#define XB_XCNT(j)  (256  + 64 * (j))
#define XB_XSUB(j)  (1280 + 64 * (j))
#define XB_XGEN(j)  (2304 + 64 * (j))
#define XB_TOP      3328
#define XB_TOPGEN   3392
#define XCD_BAR_WORDS 3456
#define XB_SPIN_CAP (1u << 22)
__device__ __forceinline__ unsigned xb_ld(unsigned* p)              { return __hip_atomic_load(p, __ATOMIC_RELAXED, __HIP_MEMORY_SCOPE_AGENT); }
__device__ __forceinline__ unsigned xb_add(unsigned* p, unsigned v) { return __hip_atomic_fetch_add(p, v, __ATOMIC_RELAXED, __HIP_MEMORY_SCOPE_AGENT); }
__device__ __forceinline__ unsigned xb_xcc_id() { return (unsigned)__builtin_amdgcn_s_getreg((3 << 11) | 20) & 0xFu; }
#define XB_SPIN(cond, bar) do { unsigned _sp = 0; while (cond) { __builtin_amdgcn_s_sleep(1); \
    if ((++_sp & 255u) == 0u) { if (xb_ld(&(bar)[XB_TMO])) break; if (_sp > XB_SPIN_CAP) { atomicAdd(&(bar)[XB_TMO], 1u); break; } } } } while (0)
struct XcdBarrier { unsigned* bar; unsigned x; volatile LAS unsigned* st; };
__device__ __forceinline__ XcdBarrier xcd_barrier_post(unsigned* bar, volatile LAS unsigned* st) {
    XcdBarrier b; b.bar = bar; b.x = xb_xcc_id(); b.st = st;
    if (threadIdx.x == 0) (void)xb_add(&bar[XB_XCNT(b.x)], 1u);
    return b;
}
__device__ __forceinline__ void xcd_barrier_complete(unsigned* bar, unsigned x, unsigned& nloc, unsigned& nx) {
    const unsigned G = gridDim.x * gridDim.y * gridDim.z;
    unsigned sum, cnt, mine, sp = 0u;
    for (;;) {
        sum = 0u; cnt = 0u; mine = 0u;
#pragma unroll
        for (unsigned j = 0; j < 16; ++j) { const unsigned c = xb_ld(&bar[XB_XCNT(j)]); sum += c; cnt += (c > 0u) ? 1u : 0u; mine = (j == x) ? c : mine; }
        if (sum == G) break;
        __builtin_amdgcn_s_sleep(1);
        if ((++sp & 255u) == 0u) { if (xb_ld(&bar[XB_TMO])) break; if (sp > XB_SPIN_CAP) { atomicAdd(&bar[XB_TMO], 1u); break; } }
    }
    nloc = mine > 0u ? mine : 1u; nx = cnt > 0u ? cnt : 1u;
}
__device__ __forceinline__ void xcd_barrier(const XcdBarrier& b) {
    asm volatile("s_waitcnt vmcnt(0)" ::: "memory");
    __syncthreads();
    if (threadIdx.x == 0) {
        unsigned* bar = b.bar;
        __builtin_amdgcn_s_waitcnt(0);
        unsigned nloc = b.st[0], nx = b.st[1];
        if (nloc == 0u) { xcd_barrier_complete(bar, b.x, nloc, nx); b.st[0] = nloc; b.st[1] = nx; }
        const unsigned old = xb_add(&bar[XB_XSUB(b.x)], 1u);
        const unsigned gen = old / nloc;
        if (old + 1u == (gen + 1u) * nloc) {
            __builtin_amdgcn_fence(__ATOMIC_RELEASE, "agent");
            asm volatile("s_waitcnt vmcnt(0)" ::: "memory");
            const unsigned og = xb_add(&bar[XB_TOP], 1u);
            const unsigned tg = og / nx;
            if (og + 1u == (tg + 1u) * nx) xb_add(&bar[XB_TOPGEN], 1u);
            else XB_SPIN(xb_ld(&bar[XB_TOPGEN]) == tg, bar);
            __builtin_amdgcn_fence(__ATOMIC_ACQUIRE, "agent");
            xb_add(&bar[XB_XGEN(b.x)], 1u);
            asm volatile("s_waitcnt vmcnt(0)" ::: "memory");
        } else {
            XB_SPIN(xb_ld(&bar[XB_XGEN(b.x)]) == gen, bar);
            __builtin_amdgcn_fence(__ATOMIC_ACQUIRE, "agent");
            asm volatile("s_waitcnt vmcnt(0)" ::: "memory");
        }
    }
    __syncthreads();
}

namespace pg8 {
constexpr int BM = 256, BK = 64, HALF = 128, HTB = HALF * BK * 2, STAGE_BYTES = 8 * HTB, NXCD = 8, WGM = 8;
__device__ __forceinline__ int lds_byte(int r, int c) { const int st = (r >> 4) * 2 + (c >> 5), rr = r & 15, cc = c & 31, ob = rr * 64 + cc * 2; return st * 1024 + (ob ^ (((ob >> 9) & 1) << 5)); }
__device__ __forceinline__ void stage_rc(int b, int& R, int& C) { const int st = b / 1024, sb = b % 1024, swz = sb ^ (((sb >> 9) & 1) << 5); R = (st >> 1) * 16 + swz / 64; C = (st & 1) * 32 + (swz % 64) / 2; }
__device__ __forceinline__ int perm32(int rho) { const int n = rho >> 4, i = rho & 15; return 8 * (i >> 2) + 4 * n + (i & 3); }
struct Unit { int pm, pn, e; };
struct SchedS {
    static constexpr bool GATHER = false;
    int nM, nN, nwg, G, c; const bf16_t* A; const bf16_t* B; int lda, ldb, a_sh, a_mul, skip_from = 1 << 30, skip_by = 0, skip_from2 = 1 << 30, skip_by2 = 0, b_compact = 0, cut = 1 << 30, extra_n = 0, extra_c = -1;
    __device__ void init(int M, int N, int G_, int c_, const bf16_t* A_, int lda_, const bf16_t* B_, int ldb_, int a_sh_ = 0, int a_mul_ = 0) {
        nM = M / BM; nN = N / BM; nwg = nM * nN; G = G_; c = c_; A = A_; B = B_; lda = lda_; ldb = ldb_; a_sh = a_sh_; a_mul = a_mul_; }
    __device__ __forceinline__ bool next(int i, Unit& u) const {
        long L = (long)i * G + c; if (i >= cut) { const int j = i - cut; if (extra_c < 0 || j >= 2) return false; L = (long)cut * G + (long)j * extra_n + extra_c; }
        if (L >= nwg) return false;
        int wgid = (int)L; { const int q = nwg / NXCD, r = nwg % NXCD, xcd = wgid % NXCD, off = wgid / NXCD; wgid = (xcd < r ? xcd * (q + 1) : r * (q + 1) + (xcd - r) * q) + off; }
        const int nig = WGM * nN, gid = wgid / nig, fm = gid * WGM, gsz = (nM - fm) < WGM ? (nM - fm) : WGM;
        u.pm = fm + ((wgid % nig) % gsz); u.pn = (wgid % nig) / gsz; u.e = 0;
        u.e = u.pn;
        { const int ci = u.pn; if (ci >= skip_from) u.pn += skip_by; if (ci >= skip_from2) u.pn += skip_by2; }
        return true;
    }
    __device__ __forceinline__ const char* pa(const Unit& u) const { return (const char*)(A + (size_t)u.pm * BM * lda + (size_t)((u.pn >> a_sh) * a_mul)); }
    __device__ __forceinline__ const char* pb(const Unit& u) const { return (const char*)(B + (size_t)(b_compact ? u.e : u.pn) * BM * ldb); }
};
struct SchedM {
    static constexpr bool GATHER = false;
    int ntiles, G, c; const bf16_t* A; const bf16_t* W; int lda, ldb; const unsigned* tile_e;
    __device__ void init(const unsigned* meta, int G_, int c_, const bf16_t* A_, int lda_, const bf16_t* W_, int ldb_) {
        ntiles = (int)meta[0]; tile_e = meta + 1; G = G_; c = c_; A = A_; W = W_; lda = lda_; ldb = ldb_; }
    __device__ __forceinline__ bool next(int i, Unit& u) const {
        const long L = (long)i * G + c; if (L >= (long)ntiles * 8) return false;
        u.pm = (int)(L >> 3); u.pn = (int)(L & 7); u.e = (int)tile_e[u.pm];
        return true;
    }
    __device__ __forceinline__ const char* pa(const Unit& u) const { return (const char*)(A + (size_t)u.pm * BM * lda); }
    __device__ __forceinline__ const char* pb(const Unit& u) const { return (const char*)(W + ((size_t)u.e * 2048 + (size_t)u.pn * BM) * ldb); }
};

constexpr int GTAB_OFF = 131072;
struct SchedMG {
    static constexpr bool GATHER = true;
    int ntiles, G, c; const bf16_t* A; const bf16_t* W; int lda, ldb; const unsigned* tile_e;
    __device__ __forceinline__ void init(const unsigned* meta, int G_, int c_, const bf16_t* A_, int lda_, const bf16_t* W_, int ldb_) {
        ntiles = (int)meta[0]; tile_e = meta + 1; G = G_; c = c_; A = A_; W = W_; lda = lda_; ldb = ldb_; }
    __device__ __forceinline__ bool next(int i, Unit& u) const {
        const long L = (long)i * G + c; if (L >= (long)ntiles * 8) return false;
        u.pm = (int)(L >> 3); u.pn = (int)(L & 7); u.e = (int)tile_e[u.pm];
        return true;
    }
    __device__ __forceinline__ const char* pa(const Unit& u) const { return (const char*)A; }
    __device__ __forceinline__ const char* pb(const Unit& u) const { return (const char*)(W + ((size_t)u.e * 2048 + (size_t)u.pn * BM) * ldb); }
};

template <class Epi, class Sched>
__device__ __forceinline__ void gemm_phase(LAS unsigned char* lds, const int K, const int lda, const int ldb, const Sched& S, const Epi& E) {
    int tid = threadIdx.x; asm volatile("" : "+v"(tid));
    const int wid = __builtin_amdgcn_readfirstlane(tid >> 6), lane = tid & 63, wr = wid >> 2, wc = wid & 3, fr = lane & 15, fq = lane >> 4;
    const int nt = K / BK;
    constexpr bool GA = Sched::GATHER;
    unsigned voffA[2], voffB[2]; int gR[2]; unsigned gC[2];
#pragma unroll
    for (int i = 0; i < 2; ++i) { int R, C; stage_rc(tid * 16 + i * 8192, R, C); const int Rb = (R & ~31) + perm32(R & 31);
        voffA[i] = (unsigned)(R * lda + C) * 2u; voffB[i] = (unsigned)(Rb * ldb + C) * 2u; gR[i] = R; gC[i] = (unsigned)C * 2u; }
    unsigned gv[2][2] = {{0u, 0u}, {0u, 0u}}, gn[2][2] = {{0u, 0u}, {0u, 0u}};
    LAS const unsigned* gtab = (LAS const unsigned*)(lds + GTAB_OFF);
#define PG8_GLOAD(dst, uidx) do { _Pragma("unroll") for (int h_ = 0; h_ < 2; ++h_) _Pragma("unroll") for (int i_ = 0; i_ < 2; ++i_) dst[h_][i_] = gtab[(uidx) * 256 + h_ * 128 + gR[i_]] + gC[i_]; } while (0)
#define PG8_STAGE_A(bufoff, ptr, h, nx) do { if constexpr (GA) { unsigned vo_[2] = {(nx) ? gn[h][0] : gv[h][0], (nx) ? gn[h][1] : gv[h][1]}; PG8_STAGE(bufoff, ptr, vo_); } \
        else { PG8_STAGE(bufoff, (ptr) + (h) * hstepA, voffA); } } while (0)
    const size_t kstep = (size_t)(BK * 2);
    const size_t hstepA = (size_t)HALF * lda * 2, hstepB = (size_t)HALF * ldb * 2;
    const unsigned ldsw = (unsigned)wid * 1024u;
    const int aoff = lds_byte(wr * 64 + fr, fq * 8), boff = lds_byte(wc * 32 + fr, fq * 8);
#define PG8_SA(b, h) (((b) * 2 + (h)) * HTB)
#define PG8_SB(b, h) ((4 + (b) * 2 + (h)) * HTB)
#define PG8_STAGE(bufoff, gbase, voff) do { _Pragma("unroll") for (int _i = 0; _i < 2; ++_i) \
        __builtin_amdgcn_global_load_lds((const unsigned*)((const char*)(gbase) + (voff)[_i]), (LAS unsigned*)(lds + (bufoff) + ldsw + _i * 8192), 16, 0, 0); } while (0)
#define PG8_LDA(dst, b, h) do { _Pragma("unroll") for (int m = 0; m < 4; ++m) _Pragma("unroll") for (int k = 0; k < 2; ++k) dst[m][k] = *(const LAS bf16x8*)(lds + PG8_SA(b, h) + aoff + m * 2048 + k * 1024); } while (0)
#define PG8_LDB(dst, b, h) do { _Pragma("unroll") for (int n = 0; n < 2; ++n) _Pragma("unroll") for (int k = 0; k < 2; ++k) dst[n][k] = *(const LAS bf16x8*)(lds + PG8_SB(b, h) + boff + n * 2048 + k * 1024); } while (0)
#define PG8_MMA(ai, bj, At, Bt) do { __builtin_amdgcn_s_setprio(1); _Pragma("unroll") for (int m = 0; m < 4; ++m) _Pragma("unroll") for (int n = 0; n < 2; ++n) _Pragma("unroll") for (int k = 0; k < 2; ++k) \
        { if constexpr (Epi::I8) acc[ai][bj][m][n] = __builtin_bit_cast(f32x4, __builtin_amdgcn_mfma_i32_16x16x64_i8(__builtin_bit_cast(i32x4, Bt[n][k]), __builtin_bit_cast(i32x4, At[m][k]), __builtin_bit_cast(i32x4, acc[ai][bj][m][n]), 0, 0, 0)); \
          else acc[ai][bj][m][n] = __builtin_amdgcn_mfma_f32_16x16x32_bf16(Bt[n][k], At[m][k], acc[ai][bj][m][n], 0, 0, 0); } __builtin_amdgcn_s_setprio(0); } while (0)
#define PG8_WAIT_V(n) asm volatile("s_waitcnt vmcnt(" #n ")" ::: "memory")
#define PG8_WAIT_L(n) asm volatile("s_waitcnt lgkmcnt(" #n ")" ::: "memory")
#define PG8_BAR __builtin_amdgcn_s_barrier()
#define PG8_SCHED __builtin_amdgcn_sched_barrier(0)
    Unit cur, nxt; int ui = 0;
    if (!S.next(0, cur)) return;
    f32x4 acc[2][2][4][2];
#pragma unroll
    for (int a = 0; a < 2; ++a)
#pragma unroll
        for (int b = 0; b < 2; ++b)
#pragma unroll
            for (int m = 0; m < 4; ++m)
#pragma unroll
                for (int n = 0; n < 2; ++n) acc[a][b][m][n] = (f32x4){0.f, 0.f, 0.f, 0.f};
    bf16x8 At[4][2], B0[2][2], B1[2][2];
    const char* cA = S.pa(cur); const char* cB = S.pb(cur);
    if constexpr (GA) { PG8_GLOAD(gv, 0); }
    PG8_STAGE(PG8_SB(0, 0), cB, voffB); PG8_STAGE_A(PG8_SA(0, 0), cA, 0, false); PG8_STAGE(PG8_SB(0, 1), cB + hstepB, voffB); PG8_STAGE_A(PG8_SA(0, 1), cA, 1, false);
    if (wr == 1) PG8_BAR;
    PG8_WAIT_V(4); PG8_BAR;
    PG8_STAGE(PG8_SB(1, 0), cB + kstep, voffB); PG8_STAGE_A(PG8_SA(1, 0), cA + kstep, 0, false); PG8_STAGE(PG8_SB(1, 1), cB + hstepB + kstep, voffB);
    PG8_WAIT_V(6); PG8_BAR;
    for (;;) {
        const bool has_next = S.next(ui + 1, nxt);
        const char* nA = has_next ? S.pa(nxt) : cA; const char* nB = has_next ? S.pb(nxt) : cB;
        if constexpr (GA) { if (has_next) { PG8_GLOAD(gn, ui + 1); } else {
#pragma unroll
                for (int h_ = 0; h_ < 2; ++h_) { gn[h_][0] = gv[h_][0]; gn[h_][1] = gv[h_][1]; } }
            asm volatile("" : "+v"(gn[0][0]), "+v"(gn[0][1]), "+v"(gn[1][0]), "+v"(gn[1][1])); }
        for (int t = 0; t < nt; t += 2) {
            const bool last = (t == nt - 2);
            if constexpr (Epi::HAS_MID) { if (t == Epi::MID1 || t == Epi::MID2) { int frM = fr, fqM = fq; asm volatile("" : "+v"(frM), "+v"(fqM)); E.mid(acc, cur, t, wr, wc, frM, fqM); } }
            const char* a1 = cA + (size_t)(t + 1) * kstep;
            const char* a2 = last ? nA : cA + (size_t)(t + 2) * kstep; const char* b2 = last ? nB : cB + (size_t)(t + 2) * kstep;
            const char* a3 = a2 + kstep; const char* b3 = b2 + kstep;
            PG8_LDB(B0, 0, 0); PG8_SCHED; PG8_LDA(At, 0, 0); PG8_STAGE_A(PG8_SA(1, 1), a1, 1, false);
            PG8_WAIT_L(8); PG8_BAR; PG8_WAIT_L(0); PG8_MMA(0, 0, At, B0); PG8_BAR; PG8_SCHED;
            PG8_LDB(B1, 0, 1); PG8_STAGE(PG8_SB(0, 0), b2, voffB);
            PG8_BAR; PG8_WAIT_L(0); PG8_MMA(0, 1, At, B1); PG8_BAR;
            PG8_LDA(At, 0, 1); PG8_STAGE_A(PG8_SA(0, 0), a2, 0, last);
            PG8_BAR; PG8_WAIT_L(0); PG8_MMA(1, 0, At, B0); PG8_BAR; PG8_SCHED;
            PG8_STAGE(PG8_SB(0, 1), b2 + hstepB, voffB);
            PG8_WAIT_V(6); PG8_BAR; PG8_MMA(1, 1, At, B1); PG8_BAR;
            PG8_LDB(B0, 1, 0); PG8_SCHED; PG8_LDA(At, 1, 0); PG8_STAGE_A(PG8_SA(0, 1), a2, 1, last);
            PG8_WAIT_L(8); PG8_BAR; PG8_WAIT_L(0); PG8_MMA(0, 0, At, B0); PG8_BAR; PG8_SCHED;
            PG8_LDB(B1, 1, 1); PG8_STAGE(PG8_SB(1, 0), b3, voffB);
            PG8_BAR; PG8_WAIT_L(0); PG8_MMA(0, 1, At, B1); PG8_BAR;
            PG8_LDA(At, 1, 1); PG8_STAGE_A(PG8_SA(1, 0), a3, 0, last);
            PG8_BAR; PG8_WAIT_L(0); PG8_MMA(1, 0, At, B0); PG8_BAR; PG8_SCHED;
            PG8_STAGE(PG8_SB(1, 1), b3 + hstepB, voffB);
            PG8_WAIT_V(6); PG8_BAR; PG8_MMA(1, 1, At, B1); PG8_BAR;
        }
        { int frE = fr, fqE = fq; asm volatile("" : "+v"(frE), "+v"(fqE)); E(acc, cur, wr, wc, frE, fqE); }
        if (!has_next) break;
#pragma unroll
        for (int a = 0; a < 2; ++a)
#pragma unroll
            for (int b = 0; b < 2; ++b)
#pragma unroll
                for (int m = 0; m < 4; ++m)
#pragma unroll
                    for (int n = 0; n < 2; ++n) acc[a][b][m][n] = (f32x4){0.f, 0.f, 0.f, 0.f};
        cur = nxt; cA = nA; cB = nB; ++ui;
        if constexpr (GA) {
#pragma unroll
            for (int h_ = 0; h_ < 2; ++h_) { gv[h_][0] = gn[h_][0]; gv[h_][1] = gn[h_][1]; } }
    }
    PG8_WAIT_V(0);
    if (wr == 0) PG8_BAR;
    PG8_BAR;
#undef PG8_SA
#undef PG8_SB
#undef PG8_STAGE
#undef PG8_STAGE_A
#undef PG8_GLOAD
#undef PG8_LDA
#undef PG8_LDB
#undef PG8_MMA
#undef PG8_WAIT_V
#undef PG8_WAIT_L
#undef PG8_BAR
#undef PG8_SCHED
}

#define EPI_LOOP_ROWS _Pragma("unroll") for (int ai = 0; ai < 2; ++ai) _Pragma("unroll") for (int m = 0; m < 4; ++m)
__device__ __forceinline__ void st_bf16x8(bf16_t* p, f32x4 v0, f32x4 v1) { u32x4 w; w.x = cvtpk(v0[0], v0[1]); w.y = cvtpk(v0[2], v0[3]); w.z = cvtpk(v1[0], v1[1]); w.w = cvtpk(v1[2], v1[3]); *(u32x4*)p = w; }

template <bool I8_> struct EpiInProj {
    static constexpr bool HAS_MID = false; static constexpr bool I8 = I8_;
    bf16_t* qa; bf16_t* qidx; bf16_t* qkv; bf16_t* gates; float* small_; const float* xs; const unsigned* wmaxbits;
    __device__ __forceinline__ f32x4 val(const f32x4& a, float sc) const { if constexpr (I8_) { const i32x4 v = __builtin_bit_cast(i32x4, a); return (f32x4){(float)v[0], (float)v[1], (float)v[2], (float)v[3]} * sc; } else return a; }
    __device__ __forceinline__ void operator()(const f32x4 (&acc)[2][2][4][2], const Unit& u, int wr, int wc, int fr, int fq) const {
        const int pn = u.pn, row0 = u.pm * BM + wr * 64 + fr, lc0 = wc * 32 + fq * 8;
        float sw = 0.f; if constexpr (I8_) sw = __uint_as_float(*wmaxbits) * (1.3f / 127.0f);
        float scs[2][4];
#pragma unroll
        for (int ai = 0; ai < 2; ++ai)
#pragma unroll
            for (int m = 0; m < 4; ++m) { scs[ai][m] = 0.f; if constexpr (I8_) scs[ai][m] = xs[row0 + ai * HALF + m * 16] * sw; }
        if (pn < 8) {
            bf16_t* base = (pn < 4 ? qa + pn * 256 : qidx + (pn - 4) * 256) + lc0;
            EPI_LOOP_ROWS { const int row = row0 + ai * HALF + m * 16; const float sc = scs[ai][m];
#pragma unroll
                for (int bj = 0; bj < 2; ++bj) st_bf16x8(base + (size_t)row * 1024 + bj * HALF, val(acc[ai][bj][m][0], sc), val(acc[ai][bj][m][1], sc)); }
        } else if (pn < 32) {
            const int id = (pn - 8) >> 2, hb = ((pn - 8) & 3) * 2, b = u.pm >> 5;
            bf16_t* base = qkv + (size_t)id * ((size_t)NTOK * 1024) + lc0;
            EPI_LOOP_ROWS { const int row = row0 + ai * HALF + m * 16, s = row & (SEQ - 1); const float sc = scs[ai][m];
#pragma unroll
                for (int bj = 0; bj < 2; ++bj) st_bf16x8(base + ((size_t)(b * 8 + hb + bj) * SEQ + s) * 128, val(acc[ai][bj][m][0], sc), val(acc[ai][bj][m][1], sc)); }
        } else if (pn < 56) {
            unsigned char* base = (unsigned char*)gates + (pn - 32) * 256 + lc0;
            EPI_LOOP_ROWS { const int row = row0 + ai * HALF + m * 16; const float sc = scs[ai][m];
#pragma unroll
                for (int bj = 0; bj < 2; ++bj) { const f32x4 v0 = val(acc[ai][bj][m][0], sc), v1 = val(acc[ai][bj][m][1], sc); u32x2 w; unsigned p0 = 0u, p1 = 0u;
#pragma unroll
                    for (int j = 0; j < 4; ++j) { p0 |= (unsigned)(int)fmaxf(rintf(255.0f * sigmoidf_(v0[j])), 1.0f) << (8 * j); p1 |= (unsigned)(int)fmaxf(rintf(255.0f * sigmoidf_(v1[j])), 1.0f) << (8 * j); }
                    w.x = p0; w.y = p1; *(u32x2*)(base + (size_t)row * 6144 + bj * HALF) = w; } }
        } else {
            float* base = small_ + (pn - 56) * 256 + lc0;
            EPI_LOOP_ROWS { const int row = row0 + ai * HALF + m * 16; const float sc = scs[ai][m];
#pragma unroll
                for (int bj = 0; bj < 2; ++bj) { float* p = base + (size_t)row * 512 + bj * HALF; *(f32x4*)p = val(acc[ai][bj][m][0], sc); *(f32x4*)(p + 4) = val(acc[ai][bj][m][1], sc); } }
        }
    }
};
struct EpiBf16 {
    static constexpr bool HAS_MID = false; static constexpr bool I8 = false;
    bf16_t* out; int ld, cstep;
    __device__ __forceinline__ void operator()(const f32x4 (&acc)[2][2][4][2], const Unit& u, int wr, int wc, int fr, int fq) const {
        const int row0 = u.pm * BM + wr * 64 + fr; bf16_t* base = out + (size_t)u.pn * cstep + wc * 32 + fq * 8;
        EPI_LOOP_ROWS { const int row = row0 + ai * HALF + m * 16;
#pragma unroll
            for (int bj = 0; bj < 2; ++bj) st_bf16x8(base + (size_t)row * ld + bj * HALF, acc[ai][bj][m][0], acc[ai][bj][m][1]); }
    }
};
struct EpiBranch3 {
    static constexpr bool HAS_MID = true; static constexpr bool I8 = false; static constexpr int MID1 = 16, MID2 = 32;
    const unsigned char* gates; bf16_t* merged;
    __device__ __forceinline__ static f32x4 rat(unsigned n, unsigned d) {
        f32x4 r; r[0] = (float)(n & 255u) * __builtin_amdgcn_rcpf((float)(d & 255u)); r[1] = (float)((n >> 8) & 255u) * __builtin_amdgcn_rcpf((float)((d >> 8) & 255u));
        r[2] = (float)((n >> 16) & 255u) * __builtin_amdgcn_rcpf((float)((d >> 16) & 255u)); r[3] = (float)(n >> 24) * __builtin_amdgcn_rcpf((float)(d >> 24)); return r; }
    __device__ __forceinline__ void mid(f32x4 (&acc)[2][2][4][2], const Unit& u, int t, int wr, int wc, int fr, int fq) const {
        const int row0 = u.pm * BM + wr * 64 + fr, col0 = u.pn * BM + wc * 32 + fq * 8, bn = (t == MID1) ? 0 : 2048;
        u32x2 gn[2][4][2], gd[2][4][2];
        EPI_LOOP_ROWS {
#pragma unroll
            for (int bj = 0; bj < 2; ++bj) { const unsigned char* gp = gates + (size_t)(row0 + ai * HALF + m * 16) * 6144 + bn + col0 + bj * HALF; gn[ai][m][bj] = *(const u32x2*)gp; gd[ai][m][bj] = *(const u32x2*)(gp + 2048); } }
        EPI_LOOP_ROWS {
#pragma unroll
            for (int bj = 0; bj < 2; ++bj) { acc[ai][bj][m][0] *= rat(gn[ai][m][bj].x, gd[ai][m][bj].x); acc[ai][bj][m][1] *= rat(gn[ai][m][bj].y, gd[ai][m][bj].y); } }
    }
    __device__ __forceinline__ void operator()(const f32x4 (&acc)[2][2][4][2], const Unit& u, int wr, int wc, int fr, int fq) const {
        const int row0 = u.pm * BM + wr * 64 + fr, col0 = u.pn * BM + wc * 32 + fq * 8;
        u32x2 gl[2][4][2];
        EPI_LOOP_ROWS {
#pragma unroll
            for (int bj = 0; bj < 2; ++bj) gl[ai][m][bj] = *(const u32x2*)(gates + (size_t)(row0 + ai * HALF + m * 16) * 6144 + 4096 + col0 + bj * HALF); }
        EPI_LOOP_ROWS { const int row = row0 + ai * HALF + m * 16;
#pragma unroll
            for (int bj = 0; bj < 2; ++bj) { const int col = col0 + bj * HALF; const u32x2 gw = gl[ai][m][bj]; constexpr float I255 = 1.0f / 255.0f;
                f32x4 v0 = acc[ai][bj][m][0], v1 = acc[ai][bj][m][1];
                v0[0] *= (float)(gw.x & 255u) * I255; v0[1] *= (float)((gw.x >> 8) & 255u) * I255; v0[2] *= (float)((gw.x >> 16) & 255u) * I255; v0[3] *= (float)(gw.x >> 24) * I255;
                v1[0] *= (float)(gw.y & 255u) * I255; v1[1] *= (float)((gw.y >> 8) & 255u) * I255; v1[2] *= (float)((gw.y >> 16) & 255u) * I255; v1[3] *= (float)(gw.y >> 24) * I255;
                st_bf16x8(merged + (size_t)row * 2048 + col, v0, v1); } }
    }
};
struct EpiOut {
    static constexpr bool HAS_MID = false; static constexpr bool I8 = false;
    const bf16_t* res; bf16_t* pre;
    __device__ __forceinline__ void operator()(const f32x4 (&acc)[2][2][4][2], const Unit& u, int wr, int wc, int fr, int fq) const {
        const int row0 = u.pm * BM + wr * 64 + fr, col0 = u.pn * BM + wc * 32 + fq * 8;
        u32x4 rl[2][4][2];
        EPI_LOOP_ROWS { const int row = row0 + ai * HALF + m * 16;
#pragma unroll
            for (int bj = 0; bj < 2; ++bj) rl[ai][m][bj] = *(const u32x4*)(res + (size_t)row * 2048 + col0 + bj * HALF); }
        EPI_LOOP_ROWS { const int row = row0 + ai * HALF + m * 16;
#pragma unroll
            for (int bj = 0; bj < 2; ++bj) { const size_t o = (size_t)row * 2048 + col0 + bj * HALF;
                const u32x4 rw = rl[ai][m][bj]; f32x4 v0 = acc[ai][bj][m][0], v1 = acc[ai][bj][m][1];
                v0[0] += ALPHA * bflo(rw.x); v0[1] += ALPHA * bfhi(rw.x); v0[2] += ALPHA * bflo(rw.y); v0[3] += ALPHA * bfhi(rw.y);
                v1[0] += ALPHA * bflo(rw.z); v1[1] += ALPHA * bfhi(rw.z); v1[2] += ALPHA * bflo(rw.w); v1[3] += ALPHA * bfhi(rw.w);
                st_bf16x8(pre + o, v0, v1); } }
    }
};
struct EpiGateUpI8 {
    static constexpr bool HAS_MID = false; static constexpr bool I8 = true;
    const float* bg; const float* bu; bf16_t* hid; const float* rowsx; const unsigned* wmaxbits; float* hm;
    __device__ __forceinline__ void operator()(const f32x4 (&acc)[2][2][4][2], const Unit& u, int wr, int wc, int fr, int fq) const {
        const int row0 = u.pm * BM + wr * 64 + fr, j0 = u.pn * 128 + wc * 32 + fq * 8;
        const float sw = __uint_as_float(*wmaxbits) * (1.3f / 127.0f);
        const float* pg = bg + (size_t)u.e * DEXP + j0; const float* pu = bu + (size_t)u.e * DEXP + j0;
        const f32x4 g0b = *(const f32x4*)pg, g1b = *(const f32x4*)(pg + 4), u0b = *(const f32x4*)pu, u1b = *(const f32x4*)(pu + 4);
        float scs[2][4];
#pragma unroll
        for (int ai = 0; ai < 2; ++ai)
#pragma unroll
            for (int m = 0; m < 4; ++m) scs[ai][m] = rowsx[row0 + ai * HALF + m * 16] * sw;
        EPI_LOOP_ROWS { const int row = row0 + ai * HALF + m * 16; const float sc = scs[ai][m];
            const i32x4 ag0 = __builtin_bit_cast(i32x4, acc[ai][0][m][0]), ag1 = __builtin_bit_cast(i32x4, acc[ai][0][m][1]), au0 = __builtin_bit_cast(i32x4, acc[ai][1][m][0]), au1 = __builtin_bit_cast(i32x4, acc[ai][1][m][1]);
            f32x4 h0, h1;
#pragma unroll
            for (int j = 0; j < 4; ++j) {
                float g = fminf((float)ag0[j] * sc + g0b[j], 7.0f), uu = fminf(fmaxf((float)au0[j] * sc + u0b[j], -7.0f), 7.0f);
                h0[j] = (uu + 1.0f) * (g * sigmoidf_(1.702f * g));
                g = fminf((float)ag1[j] * sc + g1b[j], 7.0f); uu = fminf(fmaxf((float)au1[j] * sc + u1b[j], -7.0f), 7.0f);
                h1[j] = (uu + 1.0f) * (g * sigmoidf_(1.702f * g)); }
            st_bf16x8(hid + (size_t)row * DEXP + j0, h0, h1);
            float am = fmaxf(fmaxf(fmaxf(fabsf(h0[0]), fabsf(h0[1])), fmaxf(fabsf(h0[2]), fabsf(h0[3]))), fmaxf(fmaxf(fabsf(h1[0]), fabsf(h1[1])), fmaxf(fabsf(h1[2]), fabsf(h1[3]))));
            am = fmaxf(am, __shfl_xor(am, 16)); am = fmaxf(am, __shfl_xor(am, 32));
            if (fq == 0) hm[(size_t)row * 32 + u.pn * 4 + wc] = am; }
    }
};
struct EpiDown {
    static constexpr bool HAS_MID = false; static constexpr bool I8 = false;
    const float* bd; const float* roww; bf16_t* ys;
    __device__ __forceinline__ void operator()(const f32x4 (&acc)[2][2][4][2], const Unit& u, int wr, int wc, int fr, int fq) const {
        const int row0 = u.pm * BM + wr * 64 + fr, col0 = u.pn * BM + wc * 32 + fq * 8;
        f32x4 b[2][2];
#pragma unroll
        for (int bj = 0; bj < 2; ++bj) { const float* p = bd + (size_t)u.e * DM + col0 + bj * HALF; b[bj][0] = *(const f32x4*)p; b[bj][1] = *(const f32x4*)(p + 4); }
        float rws[2][4];
#pragma unroll
        for (int ai = 0; ai < 2; ++ai)
#pragma unroll
            for (int m = 0; m < 4; ++m) rws[ai][m] = roww[row0 + ai * HALF + m * 16];
        EPI_LOOP_ROWS { const int row = row0 + ai * HALF + m * 16; const float w = rws[ai][m];
#pragma unroll
            for (int bj = 0; bj < 2; ++bj) st_bf16x8(ys + (size_t)row * 2048 + col0 + bj * HALF, (acc[ai][bj][m][0] + b[bj][0]) * w, (acc[ai][bj][m][1] + b[bj][1]) * w); }
    }
};
struct EpiDownI8 {
    static constexpr bool HAS_MID = false; static constexpr bool I8 = true;
    const float* bd; const float* roww; bf16_t* ys; const float* h8s; const unsigned* wmaxbits;
    __device__ __forceinline__ void operator()(const f32x4 (&acc)[2][2][4][2], const Unit& u, int wr, int wc, int fr, int fq) const {
        const int row0 = u.pm * BM + wr * 64 + fr, col0 = u.pn * BM + wc * 32 + fq * 8;
        const float sw = __uint_as_float(*wmaxbits) * (1.3f / 127.0f);
        f32x4 b[2][2];
#pragma unroll
        for (int bj = 0; bj < 2; ++bj) { const float* p = bd + (size_t)u.e * DM + col0 + bj * HALF; b[bj][0] = *(const f32x4*)p; b[bj][1] = *(const f32x4*)(p + 4); }
        float rws[2][4], scs[2][4];
#pragma unroll
        for (int ai = 0; ai < 2; ++ai)
#pragma unroll
            for (int m = 0; m < 4; ++m) { rws[ai][m] = roww[row0 + ai * HALF + m * 16]; scs[ai][m] = h8s[row0 + ai * HALF + m * 16] * sw; }
        EPI_LOOP_ROWS { const int row = row0 + ai * HALF + m * 16; const float w = rws[ai][m], sc = scs[ai][m];
#pragma unroll
            for (int bj = 0; bj < 2; ++bj) { const i32x4 a0 = __builtin_bit_cast(i32x4, acc[ai][bj][m][0]), a1 = __builtin_bit_cast(i32x4, acc[ai][bj][m][1]);
                const f32x4 v0 = (f32x4){(float)a0[0], (float)a0[1], (float)a0[2], (float)a0[3]} * sc, v1 = (f32x4){(float)a1[0], (float)a1[1], (float)a1[2], (float)a1[3]} * sc;
                st_bf16x8(ys + (size_t)row * 2048 + col0 + bj * HALF, (v0 + b[bj][0]) * w, (v1 + b[bj][1]) * w); } }
    }
};
struct EpiPleGateI8 {
    static constexpr bool HAS_MID = false; static constexpr bool I8 = true;
    const bf16_t* hb; const bf16_t* pp; bf16_t* pre; const float* hs; const unsigned* wmaxbits;
    __device__ __forceinline__ void operator()(const f32x4 (&acc)[2][2][4][2], const Unit& u, int wr, int wc, int fr, int fq) const {
        const int row0 = u.pm * BM + wr * 64 + fr, col0 = u.pn * BM + wc * 32 + fq * 8;
        const float sw = __uint_as_float(*wmaxbits) * (1.3f / 127.0f);
#pragma unroll
        for (int ai = 0; ai < 2; ++ai) { u32x4 pl[4][2], hl[4][2]; float scs[4];
#pragma unroll
            for (int m = 0; m < 4; ++m) { scs[m] = hs[row0 + ai * HALF + m * 16] * sw;
#pragma unroll
                for (int bj = 0; bj < 2; ++bj) { const size_t o = (size_t)(row0 + ai * HALF + m * 16) * 2048 + col0 + bj * HALF; pl[m][bj] = *(const u32x4*)(pp + o); hl[m][bj] = *(const u32x4*)(hb + o); } }
#pragma unroll
            for (int m = 0; m < 4; ++m) { const float sc = scs[m];
#pragma unroll
                for (int bj = 0; bj < 2; ++bj) { const size_t o = (size_t)(row0 + ai * HALF + m * 16) * 2048 + col0 + bj * HALF; const u32x4 pw = pl[m][bj], hw = hl[m][bj];
                    const i32x4 a0 = __builtin_bit_cast(i32x4, acc[ai][bj][m][0]), a1 = __builtin_bit_cast(i32x4, acc[ai][bj][m][1]); f32x4 o0, o1;
                    o0[0] = bflo(hw.x) + sigmoidf_((float)a0[0] * sc) * bflo(pw.x); o0[1] = bfhi(hw.x) + sigmoidf_((float)a0[1] * sc) * bfhi(pw.x); o0[2] = bflo(hw.y) + sigmoidf_((float)a0[2] * sc) * bflo(pw.y); o0[3] = bfhi(hw.y) + sigmoidf_((float)a0[3] * sc) * bfhi(pw.y);
                    o1[0] = bflo(hw.z) + sigmoidf_((float)a1[0] * sc) * bflo(pw.z); o1[1] = bfhi(hw.z) + sigmoidf_((float)a1[1] * sc) * bfhi(pw.z); o1[2] = bflo(hw.w) + sigmoidf_((float)a1[2] * sc) * bflo(pw.w); o1[3] = bfhi(hw.w) + sigmoidf_((float)a1[3] * sc) * bfhi(pw.w);
                    st_bf16x8(pre + o, o0, o1); } } }
    }
};
}

struct Params { const float* in[25]; float* out; unsigned char* ws; int ph_lo, ph_hi; };
__constant__ float c_invf_r[16] = {1.000000000e+00f, 4.403665960e-01f, 1.939227432e-01f, 8.539710194e-02f, 3.760603070e-02f, 1.656043902e-02f, 7.292664610e-03f, 3.211445874e-03f, 1.414213562e-03f, 6.227723788e-04f, 2.742481884e-04f, 1.207697351e-04f, 5.318296098e-05f, 2.341999971e-05f, 1.031338616e-05f, 4.541670478e-06f};
__constant__ float c_invf_i[8] = {1.000000000e+00f, 1.939227432e-01f, 3.760603070e-02f, 7.292664610e-03f, 1.414213562e-03f, 2.742481884e-04f, 5.318296098e-05f, 1.031338616e-05f};
constexpr int LDS_PTRS = LDS_MISC + 256;
struct Frame { unsigned char* lds; LAS unsigned char* ldsl; unsigned char* ws; int tid, lane, wid, G, bid;
    __device__ __forceinline__ const float* in(int k) const { const LAS unsigned* t = (const LAS unsigned*)(ldsl + LDS_PTRS) + 2 * k;
        const unsigned lo = __builtin_amdgcn_readfirstlane(t[0]), hi = __builtin_amdgcn_readfirstlane(t[1]); return (const float*)(const GAS float*)(((unsigned long long)hi << 32) | lo); }
    __device__ __forceinline__ float* out() const { return (float*)in(25); } };
__device__ __forceinline__ Frame fresh(const Frame& F0) { Frame F = F0; int t = threadIdx.x; asm volatile("" : "+v"(t)); F.tid = t; F.lane = t & 63; F.wid = __builtin_amdgcn_readfirstlane(t >> 6); size_t z = 0; asm volatile("" : "+s"(z)); F.ws = F0.ws + z; return F; }

struct TcTile { const float* src; long sld; bf16_t* dst; long dld; int nvalid; float qinv; };
template <class Dec>
__device__ __forceinline__ void tconv_run(const Frame& F, int total, const Dec& dec, int& rot) {
    float* tile = (float*)F.lds;
    const int tid = F.tid, G = F.G;
    const int start = (F.bid - (rot % G) + G) % G; rot += total >> 2;
    const int lr = tid >> 4, lc4 = (tid & 15) * 4, sn = tid >> 3, skc = (tid & 7) * 8;
    f32x4 v[4][2];
#define TC_ISSUE(t0_) do { _Pragma("unroll") for (int q = 0; q < 4; ++q) { const int t = (t0_) * 4 + q; \
        if (t < total) { const TcTile ti = dec(dec.remap(t)); _Pragma("unroll") for (int h = 0; h < 2; ++h) { v[q][h] = (f32x4){0.f, 0.f, 0.f, 0.f}; \
            if (lc4 < ti.nvalid) v[q][h] = *(const GAS f32x4*)((const GAS float*)ti.src + (size_t)(lr + 32 * h) * ti.sld + lc4); } } } } while (0)
    if (start * 4 < total) TC_ISSUE(start);
    for (int t0 = start; t0 * 4 < total; t0 += G) {
#pragma unroll
        for (int q = 0; q < 4; ++q) { if (t0 * 4 + q < total) { float* tl = tile + q * (64 * 65);
#pragma unroll
                for (int h = 0; h < 2; ++h) { float* p = tl + (lr + 32 * h) * 65 + lc4; p[0] = v[q][h][0]; p[1] = v[q][h][1]; p[2] = v[q][h][2]; p[3] = v[q][h][3]; } } }
        __syncthreads();
        if ((t0 + G) * 4 < total) TC_ISSUE(t0 + G);
#pragma unroll
        for (int q = 0; q < 4; ++q) { const int t = t0 * 4 + q;
            if (t < total) { const TcTile ti = dec(dec.remap(t)); const float* tl = tile + q * (64 * 65);
                if (ti.qinv > 0.f) { if (tid < 256) { const int n8 = tid >> 2, kc = (tid & 3) * 16; u32x4 w;
#pragma unroll
                        for (int d = 0; d < 4; ++d) { unsigned pk = 0u;
#pragma unroll
                            for (int j = 0; j < 4; ++j) { float q = rintf(tl[(kc + d * 4 + j) * 65 + n8] * ti.qinv); q = fminf(fmaxf(q, -127.f), 127.f); pk |= ((unsigned)(int)q & 0xffu) << (8 * j); }
                            w[d] = pk; }
                        *(u32x4*)((unsigned char*)ti.dst + (size_t)n8 * ti.dld + kc) = w; } }
                else if (sn < ti.nvalid) { f32x4 a, b;
#pragma unroll
                    for (int j = 0; j < 4; ++j) { a[j] = tl[(skc + j) * 65 + sn]; b[j] = tl[(skc + 4 + j) * 65 + sn]; }
                    pg8::st_bf16x8(ti.dst + (size_t)sn * ti.dld + skc, a, b); } } }
        __syncthreads();
    }
#undef TC_ISSUE
}
struct TcMat {
    const float* src; long src_ld; int tk, ncols; bf16_t* dst; long dst_ld; float qinv;
    __device__ __forceinline__ int remap(int i) const { const int ntn = (ncols + 63) >> 6; if (ntn & 1) return i;
        const int g = i >> 2, q = i & 3, tkh = tk >> 1, gk = g % tkh, gn = g / tkh; return (2 * gn + (q >> 1)) * tk + 2 * gk + (q & 1); }
    __device__ __forceinline__ TcTile operator()(int t) const { const int k0 = (t % tk) * 64, n0 = (t / tk) * 64; TcTile ti;
        ti.src = src + (size_t)k0 * src_ld + n0; ti.sld = src_ld; ti.dst = qinv > 0.f ? (bf16_t*)((unsigned char*)dst + (size_t)n0 * dst_ld + k0) : dst + (size_t)n0 * dst_ld + k0; ti.dld = dst_ld; ti.nvalid = (ncols - n0) < 64 ? (ncols - n0) : 64; ti.qinv = qinv; return ti; }
};
__device__ __forceinline__ void tconv(const Frame& F, const float* src, long src_ld, int K, int ncols, bf16_t* dst, long dst_ld, int& rot) {
    TcMat d{src, src_ld, K >> 6, ncols, dst, dst_ld, 0.f}; tconv_run(F, (K >> 6) * ((ncols + 63) >> 6), d, rot);
}
struct TcExperts {
    const float* wg; const float* wu; const float* wd; unsigned char* dgu; unsigned char* ddn; float qinv, qinvd;
    __device__ __forceinline__ int remap(int i) const { const int e = i / 1536, ri = i - e * 1536;
        if (ri < 1024) { const int g = ri >> 2, q = ri & 3, gk = g & 15, gn = g >> 4; return e * 1536 + (2 * gn + (q >> 1)) * 32 + 2 * gk + (q & 1); }
        const int r2 = ri - 1024, g = r2 >> 2, q = r2 & 3, gk = g & 7, gn = g >> 3; return e * 1536 + 1024 + (2 * gn + (q >> 1)) * 16 + 2 * gk + (q & 1); }
    __device__ __forceinline__ TcTile operator()(int t) const { const int e = t / 1536, r = t - e * 1536; TcTile ti; ti.nvalid = 64; ti.qinv = 0.f;
        if (r < 1024) { const int k0 = (r & 31) * 64, dt = r >> 5, jb = dt >> 2, gu = (dt >> 1) & 1, half = dt & 1;
            ti.src = (const float*)((unsigned long long)wg + (unsigned long long)gu * ((unsigned long long)wu - (unsigned long long)wg)) + (size_t)e * DM * DEXP + (size_t)k0 * DEXP + jb * 128 + half * 64; ti.sld = DEXP;
            ti.dst = (bf16_t*)(dgu + (size_t)e * 2048 * 2048 + (size_t)(dt * 64) * 2048 + k0); ti.dld = 2048; ti.qinv = qinv; }
        else { const int r2 = r - 1024, k0 = (r2 & 15) * 64, n0 = (r2 >> 4) * 64;
            ti.src = wd + (size_t)e * DEXP * DM + (size_t)k0 * DM + n0; ti.sld = DM;
            ti.dst = (bf16_t*)(ddn + (size_t)e * 2048 * 1024 + (size_t)n0 * 1024 + k0); ti.dld = 1024; ti.qinv = qinvd; }
        return ti; }
};
__device__ __forceinline__ void sample_wmax(const Frame& F) {
    unsigned* wm = (unsigned*)(F.ws + WS_CTL) + CW_WMAX;
#pragma unroll 1
    for (int l = 0; l < NLAYER; ++l) { float mx = 0.f;
#pragma unroll 1
        for (int which = 0; which < 2; ++which) { const f32x4* p = (const f32x4*)(F.in(which ? 17 : 15) + (size_t)l * NEXP * DM * DEXP);
            for (size_t i = (size_t)F.bid * 512 + F.tid; i < (size_t)NEXP * DM * DEXP / 4 / 64; i += (size_t)F.G * 512) { const size_t j = i >> 3; const f32x4 v = p[j * 512 + 8 * (j & 63) + (i & 7)];
                mx = fmaxf(mx, fmaxf(fmaxf(fabsf(v[0]), fabsf(v[1])), fmaxf(fabsf(v[2]), fabsf(v[3])))); } }
        for (int o = 32; o > 0; o >>= 1) mx = fmaxf(mx, __shfl_xor(mx, o));
        if (F.lane == 0 && mx > 0.f) atomicMax(&wm[l], __float_as_uint(mx));
        float mg = 0.f; const f32x4* wi_ = (const f32x4*)(F.in(2) + (size_t)l * DM * INW);
        for (int i = F.bid * 512 + F.tid; i < DM * (INW / 4) / 16; i += F.G * 512) { const size_t j = (size_t)(i >> 3); const f32x4 v = wi_[j * 128 + 8 * (j & 15) + (i & 7)];
            mg = fmaxf(mg, fmaxf(fmaxf(fabsf(v[0]), fabsf(v[1])), fmaxf(fabsf(v[2]), fabsf(v[3])))); }
        for (int o = 32; o > 0; o >>= 1) mg = fmaxf(mg, __shfl_xor(mg, o));
        if (F.lane == 0 && mg > 0.f) atomicMax(&wm[CW_WMAXG - CW_WMAX + l], __float_as_uint(mg));
        float mp = 0.f; const f32x4* wp_ = (const f32x4*)(F.in(21) + (size_t)l * DM * DM);
        for (int i = F.bid * 512 + F.tid; i < DM * DM / 4 / 16; i += F.G * 512) { const int j = i >> 3; const f32x4 v = wp_[j * 128 + 8 * (j & 15) + (i & 7)];
            mp = fmaxf(mp, fmaxf(fmaxf(fabsf(v[0]), fabsf(v[1])), fmaxf(fabsf(v[2]), fabsf(v[3])))); }
        for (int o = 32; o > 0; o >>= 1) mp = fmaxf(mp, __shfl_xor(mp, o));
        if (F.lane == 0 && mp > 0.f) atomicMax(&wm[CW_WMAXP - CW_WMAX + l], __float_as_uint(mp));
        float md = 0.f; const f32x4* wd_ = (const f32x4*)(F.in(19) + (size_t)l * NEXP * DEXP * DM);
        for (size_t i = (size_t)F.bid * 512 + F.tid; i < (size_t)NEXP * DEXP * DM / 4 / 64; i += (size_t)F.G * 512) { const size_t j = i >> 3; const f32x4 v = wd_[j * 512 + 8 * (j & 63) + (i & 7)];
            md = fmaxf(md, fmaxf(fmaxf(fabsf(v[0]), fabsf(v[1])), fmaxf(fabsf(v[2]), fabsf(v[3])))); }
        for (int o = 32; o > 0; o >>= 1) md = fmaxf(md, __shfl_xor(md, o));
        if (F.lane == 0 && md > 0.f) atomicMax(&wm[CW_WMAXD - CW_WMAX + l], __float_as_uint(md)); }
}
__device__ __forceinline__ void conv_rows(const Frame& F, const float* src, bf16_t* dst, size_t n8) {
    for (size_t i = (size_t)F.bid * 512 + F.tid; i < n8; i += (size_t)F.G * 512) { const f32x4 a = *(const f32x4*)(src + i * 8), b = *(const f32x4*)(src + i * 8 + 4); pg8::st_bf16x8(dst + i * 8, a, b); }
}
__device__ __forceinline__ void quant_rows(const Frame& F, const float* src, bf16_t* xb, unsigned char* xq, float* xsc) {
    const int lane = F.lane;
    for (int tok = F.bid * 8 + F.wid; tok < NTOK; tok += F.G * 8) { f32x4 v[8]; float amax = 0.f;
#pragma unroll
        for (int i = 0; i < 4; ++i) { const int c = (i * 64 + lane) * 8; v[2 * i] = *(const f32x4*)(src + (size_t)tok * DM + c); v[2 * i + 1] = *(const f32x4*)(src + (size_t)tok * DM + c + 4);
            pg8::st_bf16x8(xb + (size_t)tok * DM + c, v[2 * i], v[2 * i + 1]);
#pragma unroll
            for (int h = 0; h < 2; ++h)
#pragma unroll
                for (int j = 0; j < 4; ++j) amax = fmaxf(amax, fabsf(v[2 * i + h][j])); }
        for (int o = 32; o > 0; o >>= 1) amax = fmaxf(amax, __shfl_xor(amax, o));
        amax = fmaxf(amax, 1e-20f); const float qi = 127.0f / amax; if (lane == 0) xsc[tok] = amax * (1.0f / 127.0f);
#pragma unroll
        for (int i = 0; i < 4; ++i) { u32x2 w;
#pragma unroll
            for (int h = 0; h < 2; ++h) { unsigned pk = 0u;
#pragma unroll
                for (int j = 0; j < 4; ++j) pk |= ((unsigned)(int)rintf(v[2 * i + h][j] * qi) & 0xffu) << (8 * j);
                w[h] = pk; }
            *(u32x2*)(xq + (size_t)tok * DM + (i * 64 + lane) * 8) = w; } }
}
__constant__ int c_so[14] = {0, 1312, 2416, 3440, 4464, 5496, 6520, 7544, 8568, 1024, 1280, 2336, 2400, 5488};
__constant__ int c_dn[14] = {0, 1024, 2048, 3072, 4096, 5120, 6144, 7168, 8192, 14336, 14592, 14624, 14688, 14704};
__constant__ int c_nc[14] = {1024, 1024, 1024, 1024, 1024, 1024, 1024, 1024, 6144, 256, 32, 64, 16, 8};
__device__ __forceinline__ void convert_layer_weights(const Frame& F0, const Params& P, int l) { const Frame F = fresh(F0);
    unsigned char* ws = F.ws; int rot = 0;
    { const float* w = F.in(2) + (size_t)l * DM * INW; bf16_t* d = (bf16_t*)(ws + W_IN);
      const float wmaxg = __uint_as_float(((const unsigned*)(ws + WS_CTL))[CW_WMAXG + l]); const float qinv = 127.0f / (1.3f * fmaxf(wmaxg, 1e-30f));
#pragma unroll 1
      for (int s = 0; s < 14; ++s) {
          if (s == 1 || s >= 10) tconv(F, w + c_so[s], INW, DM, c_nc[s], d + (size_t)c_dn[s] * DM, DM, rot);
          else { const int crow = (s == 0) ? 0 : (s <= 7 ? 1024 + (s - 2) * 1024 : (s == 8 ? 7168 : 13312));
              TcMat dq{w + c_so[s], INW, DM >> 6, c_nc[s], (bf16_t*)(ws + W_IN8 + (size_t)crow * 2048), 2048, qinv}; tconv_run(F, (DM >> 6) * (c_nc[s] >> 6), dq, rot); } } }
    tconv(F, F.in(7) + (size_t)l * 1024 * DM, DM, 1024, DM, (bf16_t*)(ws + W_BRA), 3072, rot);
    tconv(F, F.in(8) + (size_t)l * 1024 * DM, DM, 1024, DM, (bf16_t*)(ws + W_BRA) + 1024, 3072, rot);
    tconv(F, F.in(9) + (size_t)l * 1024 * DM, DM, 1024, DM, (bf16_t*)(ws + W_BRA) + 2048, 3072, rot);
    tconv(F, F.in(10) + (size_t)l * DM * DM, DM, DM, DM, (bf16_t*)(ws + W_OUT), DM, rot);
    { const float wmp = __uint_as_float(((const unsigned*)(ws + WS_CTL))[CW_WMAXP + l]);
      TcMat dq{F.in(21) + (size_t)l * DM * DM, DM, DM >> 6, DM, (bf16_t*)(ws + W_PG), 2048, 127.0f / (1.3f * fmaxf(wmp, 1e-30f))}; tconv_run(F, (DM >> 6) * (DM >> 6), dq, rot); }
    tconv(F, F.in(22) + (size_t)l * 256 * DM, DM, 256, DM, (bf16_t*)(ws + W_PLE), 256, rot);
#pragma unroll 1
    for (int h = 0; h < 8; ++h) tconv(F, F.in(6) + (size_t)l * 256 * 1024 + h * 128, 1024, 256, 128, (bf16_t*)(ws + W_UV2) + ((size_t)(h >> 1) * 256 + (h & 1) * 128) * 512 + (h & 1) * 256, 512, rot);
    { const float wmax = __uint_as_float(((const unsigned*)(ws + WS_CTL))[CW_WMAX + l]);
      const float wmaxd = __uint_as_float(((const unsigned*)(ws + WS_CTL))[CW_WMAXD + l]);
      TcExperts d{F.in(15) + (size_t)l * NEXP * DM * DEXP, F.in(17) + (size_t)l * NEXP * DM * DEXP, F.in(19) + (size_t)l * NEXP * DEXP * DM, (unsigned char*)(ws + W_GU), (unsigned char*)(ws + W_DN), 127.0f / (1.3f * fmaxf(wmax, 1e-30f)), 127.0f / (1.3f * fmaxf(wmaxd, 1e-30f))};
      tconv_run(F, NEXP * 1536, d, rot); }
    { const float* w = F.in(5) + (size_t)l * 256 * 8 * 96; bf16_t* d = (bf16_t*)(ws + W_UK2);
      for (int i = F.bid * 512 + F.tid; i < 256 * 8 * 96; i += F.G * 512) { const int n = i % 96, h = (i / 96) & 7, r = i / 768; d[((size_t)h * 256 + r) * 256 + (h & 1) * 128 + 32 + n] = f2bf(w[i]); } }
}

__device__ __forceinline__ void rope_cs(float pos, float invf, float& c, float& s) {
    const float a = pos * invf; const double ad = (double)a * 0.15915494309189535; const float fr = (float)(ad - rint(ad));
    s = __builtin_amdgcn_sinf(fr); c = __builtin_amdgcn_cosf(fr);
}
__device__ __forceinline__ void phase_prep(const Frame& F0, const Params& P, int l) { const Frame F = fresh(F0);
    unsigned char* ws = F.ws; const int lane = F.lane;
    const float* smallb = (const float*)(ws + R_SMALL); bf16_t* kcat = (bf16_t*)(ws + R_KCAT); bf16_t* qcat = (bf16_t*)(ws + R_QCAT);
    bf16_t* ki = (bf16_t*)(ws + R_KI); float* wi = (float*)(ws + R_WI); float* lf = (float*)(ws + WS_LF);
    const bf16_t* qa = (const bf16_t*)(ws + R_QA); bf16_t* qidx = (bf16_t*)(ws + R_QIDX);
    const f32x4 gck = *(const f32x4*)(F.in(4) + l * 256 + lane * 4);
    const float bfo = lane < 8 ? F.in(3)[l * 8 + lane] : 0.f;
    const float ifr = c_invf_r[lane & 15], ifi = c_invf_i[lane & 7];
    for (int tok = F.bid * 8 + F.wid; tok < NTOK; tok += F.G * 8) {
        const int s = tok & (SEQ - 1), b = tok >> 13; const float* sm = smallb + (size_t)tok * 512;
        float cr, sr, ci, si; rope_cs((float)s, ifr, cr, sr); rope_cs((float)s, ifi, ci, si);
        { const f32x4 v = *(const f32x4*)(sm + lane * 4); float ss = v[0] * v[0] + v[1] * v[1] + v[2] * v[2] + v[3] * v[3]; ss = wave_sum(ss);
          const float rs = rsqrtf(ss * (1.0f / 256.0f) + 1e-6f); u32x2 w; w.x = cvtpk(v[0] * rs * gck[0], v[1] * rs * gck[1]); w.y = cvtpk(v[2] * rs * gck[2], v[3] * rs * gck[3]);
          *(u32x2*)(kcat + (size_t)tok * 288 + lane * 4) = w; }
        if (lane < 16) { const float x1 = sm[256 + lane], x2 = sm[272 + lane]; kcat[(size_t)tok * 288 + 256 + lane] = f2bf(x1 * cr - x2 * sr); kcat[(size_t)tok * 288 + 272 + lane] = f2bf(x2 * cr + x1 * sr); }
        { float o = sm[288 + lane];
          if (lane < 8) { const float x2 = sm[296 + lane]; o = o * ci - x2 * si; } else if (lane < 16) { const float x1 = sm[288 + lane - 8]; o = o * ci + x1 * si; }
          ki[(size_t)tok * 64 + lane] = f2bf(o); }
        if (lane < 16) wi[(size_t)tok * 16 + lane] = sm[352 + lane] * (1.0f / 32.0f);
        if (lane < 8) { const float f = sm[368 + lane] + bfo; lf[(size_t)(b * 8 + lane) * SEQ + s] = fminf(f, 0.f) - log1pf(__expf(-fabsf(f))); }
#pragma unroll
        for (int pp = 0; pp < 2; ++pp) { const int p = lane + 64 * pp, h = p >> 4, i = p & 15;
            const float x1 = bf2f(qa[(size_t)tok * 1024 + h * 128 + i]), x2 = bf2f(qa[(size_t)tok * 1024 + h * 128 + 16 + i]);
            qcat[(size_t)tok * 2304 + h * 288 + 256 + i] = f2bf(x1 * cr - x2 * sr); qcat[(size_t)tok * 2304 + h * 288 + 272 + i] = f2bf(x2 * cr + x1 * sr); }
#pragma unroll
        for (int pp = 0; pp < 2; ++pp) { const int p = lane + 64 * pp, hh = p >> 3, i = p & 7; bf16_t* q = qidx + (size_t)tok * 1024 + hh * 64;
            const float x1 = bf2f(q[i]), x2 = bf2f(q[8 + i]); q[i] = f2bf(x1 * ci - x2 * si); q[8 + i] = f2bf(x2 * ci + x1 * si); }
    }
    { const bf16_t* kbt = (const bf16_t*)(ws + R_QKV) + (size_t)NTOK * 1024; unsigned* kmx = (unsigned*)(ws + WS_CTL) + CW_KMAX + l * 16;
#pragma unroll 1
      for (int bh = 0; bh < 16; ++bh) { float mx = 0.f;
          for (int r0 = (F.bid * 8 + F.wid) * 4; r0 < SEQ; r0 += F.G * 32) {
              const u32x4 w = *(const u32x4*)(kbt + ((size_t)bh * SEQ + r0 + (lane >> 4)) * 128 + (lane & 15) * 8);
              float ss = bflo(w.x) * bflo(w.x) + bfhi(w.x) * bfhi(w.x) + bflo(w.y) * bflo(w.y) + bfhi(w.y) * bfhi(w.y) + bflo(w.z) * bflo(w.z) + bfhi(w.z) * bfhi(w.z) + bflo(w.w) * bflo(w.w) + bfhi(w.w) * bfhi(w.w);
              ss += __shfl_xor(ss, 1); ss += __shfl_xor(ss, 2); ss += __shfl_xor(ss, 4); ss += __shfl_xor(ss, 8); mx = fmaxf(mx, ss); }
          mx = fmaxf(mx, __shfl_xor(mx, 16)); mx = fmaxf(mx, __shfl_xor(mx, 32));
          if (lane == 0) ((float*)F.lds)[F.wid * 16 + bh] = mx; }
      __syncthreads();
      if (F.tid < 16) { float mx = 0.f;
#pragma unroll
          for (int w = 0; w < 8; ++w) mx = fmaxf(mx, ((const float*)F.lds)[w * 16 + F.tid]);
          const unsigned bits = __float_as_uint(mx);
          if (bits > __hip_atomic_load(&kmx[F.tid], __ATOMIC_RELAXED, __HIP_MEMORY_SCOPE_AGENT)) atomicMax(&kmx[F.tid], bits); }
      __syncthreads(); }
}
__device__ __forceinline__ void phase_cumsum(const Frame& F0) { const Frame F = fresh(F0);
    const int gw = F.bid * 8 + F.wid; if (gw >= 16) return;
    const float* lf = (const float*)(F.ws + WS_LF) + (size_t)gw * SEQ; float* cum = (float*)(F.ws + WS_CUM) + (size_t)gw * SEQ;
    const int lane = F.lane; double tot = 0.0;
#pragma unroll 1
    for (int hb = 0; hb < 2; ++hb) { f32x4 v[16];
#pragma unroll
        for (int j = 0; j < 16; ++j) v[j] = *(const f32x4*)(lf + lane * 128 + hb * 64 + j * 4);
#pragma unroll
        for (int j = 0; j < 16; ++j)
#pragma unroll
            for (int e = 0; e < 4; ++e) tot += (double)v[j][e]; }
    double inc = tot;
    for (int o = 1; o < 64; o <<= 1) { const double n = __shfl_up(inc, o); if (lane >= o) inc += n; }
    double run = inc - tot;
#pragma unroll 1
    for (int hb = 0; hb < 2; ++hb) { f32x4 v[16];
#pragma unroll
        for (int j = 0; j < 16; ++j) v[j] = *(const f32x4*)(lf + lane * 128 + hb * 64 + j * 4);
#pragma unroll
        for (int j = 0; j < 16; ++j) { f32x4 o;
#pragma unroll
            for (int e = 0; e < 4; ++e) { run += (double)v[j][e]; o[e] = (float)run; }
            v[j] = o; }
#pragma unroll
        for (int j = 0; j < 16; ++j) *(f32x4*)(cum + lane * 128 + hb * 64 + j * 4) = v[j]; }
}

__device__ __forceinline__ void idx_unit(const Frame& F, int b, int pi, int half) {
    const int tid = F.tid, lane = F.lane, rho = lane & 31, hh = lane >> 5; unsigned char* ws = F.ws;
    const bf16_t* qidx = (const bf16_t*)(ws + R_QIDX); const bf16_t* ki = (const bf16_t*)(ws + R_KI) + (size_t)b * SEQ * 64; const float* wi = (const float*)(ws + R_WI);
    float* scores = (float*)(ws + R_SCORES) + (size_t)b * SEQ * SEQ;
    LAS unsigned char* kl = F.ldsl;
    const int gl = pi, gh = 127 - pi, nl = (64 * gl + 63) / 128 + 1, nh = (64 * gh + 63) / 128 + 1, tot = nl + nh;
    const int x0 = half ? tot / 2 : 0, x1 = half ? tot : tot / 2;
    bf16x8 af[4][4]; float wv[4][16]; int t0 = 0, curg = -1;
    const int r0 = tid >> 3, p0 = tid & 7;
    const unsigned d0 = (unsigned)(r0 * 128 + ((p0 ^ (r0 & 7)) << 4)), d1 = d0 + 64 * 128;
    u32x4 s0, s1;
    { const int c = x0 < nl ? x0 : x0 - nl; const bf16_t* kp = ki + (size_t)(c * 128) * 64; s0 = *(const u32x4*)(kp + (size_t)r0 * 64 + p0 * 8); s1 = *(const u32x4*)(kp + (size_t)(r0 + 64) * 64 + p0 * 8); }
    __syncthreads();
    *(LAS u32x4*)(kl + d0) = s0; *(LAS u32x4*)(kl + d1) = s1;
    __syncthreads();
    const unsigned rdo = (unsigned)(rho * 128);
#pragma unroll 1
    for (int x = x0; x < x1; ++x) {
        const int g = x < nl ? gl : gh, c = x < nl ? x : x - nl;
        if (g != curg) { curg = g; t0 = g * 64 + F.wid * 8;
#pragma unroll
            for (int mt = 0; mt < 4; ++mt) {
                const int tokA = b * SEQ + t0 + 2 * mt + ((rho >> 2) & 1), head = (rho & 3) + 4 * (rho >> 3);
#pragma unroll
                for (int kk = 0; kk < 4; ++kk) af[mt][kk] = *(const bf16x8*)(qidx + (size_t)tokA * 1024 + head * 64 + kk * 16 + 8 * hh);
                const float* wp = wi + (size_t)(b * SEQ + t0 + 2 * mt + hh) * 16;
#pragma unroll
                for (int q = 0; q < 4; ++q) { const f32x4 v = *(const f32x4*)(wp + 4 * q); wv[mt][4 * q] = v[0]; wv[mt][4 * q + 1] = v[1]; wv[mt][4 * q + 2] = v[2]; wv[mt][4 * q + 3] = v[3]; } } }
        const unsigned bo = (unsigned)((x - x0) & 1) * 16384u;
        if (x + 1 < x1) { const int cn = (x + 1) < nl ? (x + 1) : (x + 1) - nl; const bf16_t* kp = ki + (size_t)(cn * 128) * 64; s0 = *(const u32x4*)(kp + (size_t)r0 * 64 + p0 * 8); s1 = *(const u32x4*)(kp + (size_t)(r0 + 64) * 64 + p0 * 8); }
#pragma unroll
        for (int tl = 0; tl < 4; ++tl) {
            const int kb = c * 128 + tl * 32;
            if (kb <= t0 + 7) {
                bf16x8 bc[4];
#pragma unroll
                for (int kk = 0; kk < 4; ++kk) bc[kk] = *(const LAS bf16x8*)(kl + bo + tl * 4096 + rdo + (((kk * 2 + hh) ^ (rho & 7)) << 4));
                f32x16 a0 = {}, a1 = {}, a2 = {}, a3 = {};
#pragma unroll
                for (int kk = 0; kk < 4; ++kk) { a0 = __builtin_amdgcn_mfma_f32_32x32x16_bf16(af[0][kk], bc[kk], a0, 0, 0, 0); a1 = __builtin_amdgcn_mfma_f32_32x32x16_bf16(af[1][kk], bc[kk], a1, 0, 0, 0);
                                                  a2 = __builtin_amdgcn_mfma_f32_32x32x16_bf16(af[2][kk], bc[kk], a2, 0, 0, 0); a3 = __builtin_amdgcn_mfma_f32_32x32x16_bf16(af[3][kk], bc[kk], a3, 0, 0, 0); }
#define IDX_EPI(A_, mt_) do { float x_0 = 0.f, x_1 = 0.f, x_2 = 0.f, x_3 = 0.f; _Pragma("unroll") for (int r = 0; r < 16; r += 4) { \
                    x_0 = fmaf(wv[mt_][r], fmaxf(A_[r], 0.f), x_0); x_1 = fmaf(wv[mt_][r + 1], fmaxf(A_[r + 1], 0.f), x_1); x_2 = fmaf(wv[mt_][r + 2], fmaxf(A_[r + 2], 0.f), x_2); x_3 = fmaf(wv[mt_][r + 3], fmaxf(A_[r + 3], 0.f), x_3); } \
                    scores[(size_t)(t0 + 2 * (mt_) + hh) * SEQ + kb + rho] = (x_0 + x_1) + (x_2 + x_3); } while (0)
                IDX_EPI(a0, 0); IDX_EPI(a1, 1); IDX_EPI(a2, 2); IDX_EPI(a3, 3);
#undef IDX_EPI
            }
        }
        if (x + 1 < x1) { *(LAS u32x4*)(kl + (bo ^ 16384u) + d0) = s0; *(LAS u32x4*)(kl + (bo ^ 16384u) + d1) = s1; }
        __syncthreads();
    }
}
__device__ __forceinline__ void phase_idx(const Frame& F0) { const Frame F = fresh(F0);
#pragma unroll 1
    for (int it = F.bid; it < 256; it += F.G) { const int b = it >> 7, pi = (it >> 1) & 63, half = it & 1; idx_unit(F, b, pi, half); }
}

__device__ __forceinline__ unsigned sortable(float f) { const unsigned u = __float_as_uint(f); return (u & 0x80000000u) ? ~u : (u | 0x80000000u); }
__device__ __forceinline__ void topk_row(const Frame& F, int b, int t) {
    int lane = F.lane; asm volatile("" : "+v"(lane));
    const int L = t + 1, tok = b * SEQ + t; unsigned char* ws = F.ws;
    int* sel = (int*)(ws + R_SEL) + (size_t)tok * 256; int* nsel = (int*)(ws + R_NSEL);
    if (lane == 0) nsel[tok] = L < 256 ? L : 256;
    if (L <= 256) { for (int j = lane; j < 256; j += 64) sel[j] = j < L ? j : 0; return; }
    const float* row = (const float*)(ws + R_SCORES) + ((size_t)b * SEQ + t) * SEQ;
    const int nch = (L + 1023) >> 10;
#define TOPK_LOAD_ROW() do { _Pragma("unroll") for (int c = 0; c < 8; ++c) { \
        if (c < nch) { _Pragma("unroll") for (int jj = 0; jj < 4; ++jj) { const int j = c * 4 + jj; const f32x4 v = *(const f32x4*)(row + j * 256 + lane * 4); \
                _Pragma("unroll") for (int e_ = 0; e_ < 4; ++e_) { const int idx = j * 256 + lane * 4 + e_; u[j * 4 + e_] = idx < L ? sortable(v[e_]) : 0u; } } } \
        else { _Pragma("unroll") for (int q = 0; q < 16; ++q) u[c * 16 + q] = 0u; } } } while (0)
    unsigned u[128];
    TOPK_LOAD_ROW();
    unsigned g0 = 0u, g1 = 0u, g2 = 0u, g3 = 0u;
#pragma unroll
    for (int c = 0; c < 8; ++c) if (c < nch) {
#pragma unroll
        for (int jj = 0; jj < 4; ++jj) { const int j = c * 4 + jj; g0 = u[4 * j] > g0 ? u[4 * j] : g0; g1 = u[4 * j + 1] > g1 ? u[4 * j + 1] : g1; g2 = u[4 * j + 2] > g2 ? u[4 * j + 2] : g2; g3 = u[4 * j + 3] > g3 ? u[4 * j + 3] : g3; } }
    unsigned tl = g0 < g1 ? g0 : g1; { const unsigned t2 = g2 < g3 ? g2 : g3; tl = tl < t2 ? tl : t2; }
#pragma unroll
    for (int o = 32; o > 0; o >>= 1) { const unsigned x = (unsigned)__shfl_xor((int)tl, o); tl = x < tl ? x : tl; }
    constexpr int CAP = 2048;
    LAS unsigned* candk = (LAS unsigned*)(F.ldsl + F.wid * (CAP * 8)); LAS unsigned* candi = candk + CAP;
    int C = 0;
#pragma unroll
    for (int c = 0; c < 8; ++c) if (c < nch) {
#pragma unroll
        for (int q = 0; q < 16; ++q) { const int rq = c * 16 + q; const bool pr = u[rq] >= tl; const unsigned long long mm = __ballot(pr);
            const int pos = C + __popcll(mm & ((1ull << lane) - 1ull));
            if (pr && pos < CAP) { candk[pos] = u[rq]; candi[pos] = (unsigned)((rq >> 2) * 256 + lane * 4 + (rq & 3)); }
            C += __popcll(mm); if ((q & 3) == 3) SBAR(); } }
    if (C <= CAP) {
        const int ng = (C + 255) >> 8;
        unsigned ck[32]; int ci[32];
#pragma unroll
        for (int g = 0; g < 8; ++g) {
#pragma unroll
            for (int q = 0; q < 4; ++q) { const int r = g * 4 + q, p = r * 64 + lane; ck[r] = 0u; ci[r] = 0;
                if (g < ng && p < C) { ck[r] = candk[p]; ci[r] = (int)candi[p]; } } }
        unsigned T = 0u, thr_gt = 0u; int need_eq = 0; bool early = false;
        for (int bit = 31; bit >= 0; --bit) {
            const unsigned cnd = T | (1u << bit); int cnt = 0;
#pragma unroll
            for (int g = 0; g < 8; ++g) if (g < ng) {
#pragma unroll
                for (int q = 0; q < 4; ++q) cnt += __popcll(__ballot(ck[g * 4 + q] >= cnd)); }
            if (cnt >= 256) { T = cnd; if (cnt == 256) { early = true; break; } }
        }
        if (early) { thr_gt = T - 1u; need_eq = 0; }
        else { int gtc = 0;
#pragma unroll
            for (int g = 0; g < 8; ++g) if (g < ng) {
#pragma unroll
                for (int q = 0; q < 4; ++q) gtc += __popcll(__ballot(ck[g * 4 + q] > T)); }
            thr_gt = T; need_eq = 256 - gtc; }
        int base = 0, eq_taken = 0;
#pragma unroll
        for (int g = 0; g < 8; ++g) if (g < ng) {
#pragma unroll
            for (int q = 0; q < 4; ++q) { const int r = g * 4 + q; const unsigned v = ck[r];
                const bool iseq = (v == thr_gt) && (need_eq > 0);
                const unsigned long long meq = __ballot(iseq);
                const int eqr = __popcll(meq & ((1ull << lane) - 1ull));
                const bool take = (v > thr_gt) || (iseq && (eq_taken + eqr < need_eq));
                const unsigned long long mt = __ballot(take);
                const int pos = base + __popcll(mt & ((1ull << lane) - 1ull));
                if (take && pos < 256) sel[pos] = ci[r];
                base += __popcll(mt); eq_taken += __popcll(meq); } }
        return;
    }
    asm volatile("" ::: "memory");
    TOPK_LOAD_ROW();
    unsigned T = 0u, thr_gt = 0u; int need_eq = 0; bool early = false;
    for (int bit = 31; bit >= 0; --bit) {
        const unsigned cand = T | (1u << bit); int cnt = 0;
#pragma unroll
        for (int c = 0; c < 8; ++c) if (c < nch) {
#pragma unroll
            for (int q = 0; q < 16; ++q) cnt += __popcll(__ballot(u[c * 16 + q] >= cand)); }
        if (cnt >= 256) { T = cand; if (cnt == 256) { early = true; break; } }
    }
    if (early) { thr_gt = T - 1u; need_eq = 0; }
    else { int gtc = 0;
#pragma unroll
        for (int c = 0; c < 8; ++c) if (c < nch) {
#pragma unroll
            for (int q = 0; q < 16; ++q) gtc += __popcll(__ballot(u[c * 16 + q] > T)); }
        thr_gt = T; need_eq = 256 - gtc; }
    int base = 0, eq_taken = 0;
#pragma unroll
    for (int c = 0; c < 8; ++c) if (c < nch) {
#pragma unroll
        for (int q = 0; q < 16; ++q) { const int rq = c * 16 + q; const unsigned v = u[rq];
            const bool iseq = (v == thr_gt) && (need_eq > 0);
            const unsigned long long meq = __ballot(iseq);
            const int eqr = __popcll(meq & ((1ull << lane) - 1ull));
            const bool take = (v > thr_gt) || (iseq && (eq_taken + eqr < need_eq));
            const unsigned long long mt = __ballot(take);
            const int pos = base + __popcll(mt & ((1ull << lane) - 1ull));
            if (take && pos < 256) sel[pos] = (rq >> 2) * 256 + lane * 4 + (rq & 3);
            base += __popcll(mt); eq_taken += __popcll(meq); } }
}
__device__ __forceinline__ void phase_topk(const Frame& F0) { const Frame F = fresh(F0);
    for (int q = F.bid * 8 + F.wid; q < 8192; q += F.G * 8) { const int b = q >> 12, p = q & 4095; topk_row(F, b, p); topk_row(F, b, SEQ - 1 - p); }
}

namespace att {
constexpr int D = 128, KVBLK = 64, QBLK = 32, SHM_V = 16384, SHM_K = 16384;
constexpr int OFF_K = 2 * SHM_V, OFF_BIAS = 2 * SHM_V + 2 * SHM_K, OFF_WS = OFF_BIAS + 512, OFF_FLAGS = OFF_WS + 2048, OFF_QITEM = OFF_FLAGS + 64;
constexpr float EXIT_T = 44.0f;
#define KSWZ(row, colB) ((row) * 256 + ((colB) ^ (((row) & 7) << 4)))
__device__ __forceinline__ int v_st(int k, int c) { const int kk = (k & ~0xC) | ((k & 4) << 1) | ((k & 8) >> 1); return ((kk >> 3) * 4 + (c >> 5)) * 512 + ((kk & 7) * 32 + (c & 31)) * 2; }
__device__ __forceinline__ int v_rd_base(int lane) { return ((lane & 3) << 3) | (((lane >> 2) & 3) << 6) | (((lane >> 4) & 1) << 5) | (((lane >> 5) & 1) << 8); }
constexpr int v_rd_off(int d0, int ks, int half) { return d0 * 512 + ks * 4096 + half * 2048; }
template <int KB>
__device__ __forceinline__ void qkt(f32x16& p0, f32x16& p1, const char* K_lds, int r32, int hi, const bf16x8* qr) {
    p0 = f32x16{}; p1 = f32x16{};
    const char* kb[4];
#pragma unroll
    for (int dd = 0; dd < 4; ++dd) kb[dd] = K_lds + KB * SHM_K + KSWZ(r32, (dd * 16 + hi * 8) * 2);
#pragma unroll
    for (int d0 = 0; d0 < 8; ++d0) { const char* a = kb[d0 & 3] + (d0 >> 2) * 128;
        bf16x8 b0 = *reinterpret_cast<const bf16x8*>(a);
        bf16x8 b1 = *reinterpret_cast<const bf16x8*>(a + 32 * 256);
        p0 = __builtin_amdgcn_mfma_f32_32x32x16_bf16(b0, qr[d0], p0, 0, 0, 0);
        p1 = __builtin_amdgcn_mfma_f32_32x32x16_bf16(b1, qr[d0], p1, 0, 0, 0); }
}
template <int VB>
__device__ __forceinline__ void pv_tile(f32x16* o, int vb0, bf16x8 pa0, bf16x8 pa1, bf16x8 pa2, bf16x8 pa3) {
#define TRRD(dst, off) asm volatile("ds_read_b64_tr_b16 %0, %1 offset:%2" : "=&v"(dst) : "v"(vb0), "i"(off) : "memory")
#define PV_D0(d0) do { s16x4 l0, l1, l2, l3, h0, h1, h2, h3; constexpr int b_ = VB * SHM_V + v_rd_off(d0, 0, 0); \
        TRRD(l0, b_); TRRD(h0, b_ + 2048); TRRD(l1, b_ + 4096); TRRD(h1, b_ + 6144); TRRD(l2, b_ + 8192); TRRD(h2, b_ + 10240); TRRD(l3, b_ + 12288); TRRD(h3, b_ + 14336); \
        asm volatile("s_waitcnt lgkmcnt(0)" ::: "memory"); SBAR(); \
        o[d0] = __builtin_amdgcn_mfma_f32_32x32x16_bf16(pa0, (bf16x8){l0[0], l0[1], l0[2], l0[3], h0[0], h0[1], h0[2], h0[3]}, o[d0], 0, 0, 0); \
        o[d0] = __builtin_amdgcn_mfma_f32_32x32x16_bf16(pa1, (bf16x8){l1[0], l1[1], l1[2], l1[3], h1[0], h1[1], h1[2], h1[3]}, o[d0], 0, 0, 0); \
        o[d0] = __builtin_amdgcn_mfma_f32_32x32x16_bf16(pa2, (bf16x8){l2[0], l2[1], l2[2], l2[3], h2[0], h2[1], h2[2], h2[3]}, o[d0], 0, 0, 0); \
        o[d0] = __builtin_amdgcn_mfma_f32_32x32x16_bf16(pa3, (bf16x8){l3[0], l3[1], l3[2], l3[3], h3[0], h3[1], h3[2], h3[3]}, o[d0], 0, 0, 0); } while (0)
    PV_D0(0); PV_D0(1); PV_D0(2); PV_D0(3);
#undef PV_D0
#undef TRRD
}
#define PK4(P, B_, OUT) do { unsigned a0 = cvtpk(P[B_+0], P[B_+1]), a1 = cvtpk(P[B_+2], P[B_+3]); \
        unsigned b0 = cvtpk(P[B_+4], P[B_+5]), b1 = cvtpk(P[B_+6], P[B_+7]); \
        auto r0 = __builtin_amdgcn_permlane32_swap(a0, b0, false, false); auto r1 = __builtin_amdgcn_permlane32_swap(a1, b1, false, false); \
        u32x4 w = {r0[0], r1[0], r0[1], r1[1]}; OUT = *reinterpret_cast<bf16x8*>(&w); } while (0)
__device__ __forceinline__ float swap_max(float x) { auto rr = __builtin_amdgcn_permlane32_swap(__float_as_uint(x), __float_as_uint(x), false, false); return fmaxf(__uint_as_float(rr[0]), __uint_as_float(rr[1])); }
__device__ __forceinline__ float swap_sum(float x) { auto rr = __builtin_amdgcn_permlane32_swap(__float_as_uint(x), __float_as_uint(x), false, false); return __uint_as_float(rr[0]) + __uint_as_float(rr[1]); }
__device__ __forceinline__ float swap_lo(float x) { auto rr = __builtin_amdgcn_permlane32_swap(__float_as_uint(x), __float_as_uint(x), false, false); return __uint_as_float(rr[0]); }


__device__ __forceinline__ void fox_sm(f32x16& p0, f32x16& p1, const float* bl, int kb_, int qlo, int qrow, int hi, int r32, float& m_reg, float& l_reg, f32x16* o, float* al_l,
                                       bf16x8& pa0, bf16x8& pa1, bf16x8& pa2, bf16x8& pa3) {
#pragma unroll
    for (int g = 0; g < 4; ++g) { const f32x4 b0v = *(const f32x4*)(bl + 8 * g + 4 * hi), b1v = *(const f32x4*)(bl + 32 + 8 * g + 4 * hi);
#pragma unroll
        for (int i = 0; i < 4; ++i) { p0[4 * g + i] = fmaf(p0[4 * g + i], C2, b0v[i]); p1[4 * g + i] = fmaf(p1[4 * g + i], C2, b1v[i]); } }
    if (kb_ + KVBLK - 1 > qlo) { const float NEG = -__builtin_inff();
#pragma unroll
        for (int r = 0; r < 16; ++r) { const int key = kb_ + crow(r, hi); if (key > qrow) p0[r] = NEG; if (key + 32 > qrow) p1[r] = NEG; } }
    float pmax = p0[0];
#pragma unroll
    for (int r = 1; r < 16; ++r) pmax = fmaxf(pmax, p0[r]);
#pragma unroll
    for (int r = 0; r < 16; ++r) pmax = fmaxf(pmax, p1[r]);
    pmax = swap_max(pmax);
    const float mn = fmaxf(m_reg, pmax), alpha = __builtin_amdgcn_exp2f(m_reg - mn); m_reg = mn;
    float ps = 0.f;
#pragma unroll
    for (int r = 0; r < 16; ++r) { p0[r] = __builtin_amdgcn_exp2f(p0[r] - mn); p1[r] = __builtin_amdgcn_exp2f(p1[r] - mn); ps += p0[r] + p1[r]; }
    ps = swap_sum(ps); l_reg = l_reg * alpha + ps;
    if (__any(alpha < 1.f)) { if (hi == 0) al_l[r32] = alpha; asm volatile("s_waitcnt lgkmcnt(0)" ::: "memory");
#pragma unroll
        for (int r = 0; r < 16; ++r) { const float a = al_l[crow(r, hi)];
#pragma unroll
            for (int d_ = 0; d_ < 4; ++d_) o[d_][r] *= a; } }
    PK4(p0, 0, pa0); PK4(p0, 8, pa1); PK4(p1, 0, pa2); PK4(p1, 8, pa3);
}
__device__ __forceinline__ void sb_half(f32x16& pz, int keybase, int qrow, int hi, float& R, const bf16x8* triA, bool needmask) {
    f32x16 X;
#pragma unroll
    for (int r = 0; r < 16; ++r) { const float zz = pz[r] * C2; const bool valid = !needmask || (keybase + crow(r, hi) < qrow);
        const float l2 = fmaxf(zz, 0.f) + __builtin_amdgcn_logf(1.0f + __builtin_amdgcn_exp2f(-fabsf(zz)));
        X[r] = valid ? -l2 : 0.f; pz[r] = valid ? zz : -__builtin_inff(); }
    f32x16 Y;
#pragma unroll
    for (int r = 0; r < 16; ++r) Y[r] = R;
#pragma unroll
    for (int s = 0; s < 2; ++s) {
        const unsigned h0 = cvtpk(X[8 * s + 0], X[8 * s + 1]), h1 = cvtpk(X[8 * s + 2], X[8 * s + 3]), h2 = cvtpk(X[8 * s + 4], X[8 * s + 5]), h3 = cvtpk(X[8 * s + 6], X[8 * s + 7]);
        const unsigned l0 = cvtpk(X[8 * s + 0] - bflo(h0), X[8 * s + 1] - bfhi(h0)), l1 = cvtpk(X[8 * s + 2] - bflo(h1), X[8 * s + 3] - bfhi(h1));
        const unsigned l2 = cvtpk(X[8 * s + 4] - bflo(h2), X[8 * s + 5] - bfhi(h2)), l3 = cvtpk(X[8 * s + 6] - bflo(h3), X[8 * s + 7] - bfhi(h3));
        u32x4 wh = {h0, h1, h2, h3}, wl = {l0, l1, l2, l3};
        Y = __builtin_amdgcn_mfma_f32_32x32x16_bf16(triA[s], *reinterpret_cast<bf16x8*>(&wh), Y, 0, 0, 0);
        Y = __builtin_amdgcn_mfma_f32_32x32x16_bf16(triA[s], *reinterpret_cast<bf16x8*>(&wl), Y, 0, 0, 0); }
#pragma unroll
    for (int r = 0; r < 16; ++r) pz[r] = __builtin_amdgcn_exp2f(pz[r] + Y[r]);
    R = swap_lo(Y[0]);
}
__device__ __forceinline__ void sb_sm(f32x16& p0, f32x16& p1, int kb_, int qlo, int qrow, int hi, float& R, const bf16x8* triA, bf16x8& pa0, bf16x8& pa1, bf16x8& pa2, bf16x8& pa3) {
    const bool needmask = (kb_ + KVBLK - 1 >= qlo);
    sb_half(p1, kb_ + 32, qrow, hi, R, triA, needmask);
    sb_half(p0, kb_, qrow, hi, R, triA, needmask);
    PK4(p0, 0, pa0); PK4(p0, 8, pa1); PK4(p1, 0, pa2); PK4(p1, 8, pa3);
}

template <int MODE>
__device__ __forceinline__ void attn_unit(const bf16_t* Q, const bf16_t* Kh, const bf16_t* Vh, const float* cum, bf16_t* O, int P0, char* lds, float kmaxc) {
    int tid = threadIdx.x; asm volatile("" : "+v"(tid));
    const int wid = __builtin_amdgcn_readfirstlane(tid >> 6), lane = tid & 63, r32 = lane & 31, hi = lane >> 5;
    const int NT = P0 / KVBLK + 4;
    char* V_lds = lds; char* K_lds = lds + OFF_K; float* bias_l = (float*)(lds + OFF_BIAS);
    float* wsl = (float*)(lds + OFF_WS) + wid * 64; float* li_l = wsl; float* al_l = wsl + 32;
    const int qlo = P0 + wid * QBLK, qrow = qlo + r32;
    bf16x8 qr[8];
#pragma unroll
    for (int d0 = 0; d0 < 8; ++d0) qr[d0] = *(const bf16x8*)(Q + (size_t)qrow * D + d0 * 16 + hi * 8);
    const int sr = tid >> 4, sc = (tid & 15) * 8, vst0 = v_st(sr, sc), vst1 = v_st(32 + sr, sc), kws = KSWZ(sr, sc * 2);
    const int vb0 = (int)(uintptr_t)V_lds + v_rd_base(lane);
    const float cumref = (MODE == 0) ? cum[P0] : 0.f;
    int* flg = (int*)(lds + OFF_FLAGS);
    float qn = 0.f;
    if (MODE == 0) { float ss = 0.f;
#pragma unroll
        for (int d0 = 0; d0 < 8; ++d0)
#pragma unroll
            for (int j = 0; j < 8; ++j) { const float x = bf2f((bf16_t)qr[d0][j]); ss = fmaf(x, x, ss); }
        ss = swap_sum(ss); qn = sqrtf(ss) * kmaxc * 1.001f; }
    float m_reg = -1e30f, l_reg = 0.f, R = 0.f; f32x16 o[4] = {};
    bf16x8 triA[2];
    if (MODE == 1) {
#pragma unroll
        for (int s = 0; s < 2; ++s)
#pragma unroll
            for (int j = 0; j < 8; ++j) { const int rho = 16 * s + 8 * (j >> 2) + 4 * hi + (j & 3); triA[s][j] = (rho >= r32) ? (short)0x3F80 : (short)0; }
    }
    bf16x8 st_k0, st_k1, st_v0, st_v1; float st_b = 0.f;
#define TILE_KB(t) ((NT - 1 - (t)) * KVBLK)
#define SLOAD(kb_) do { st_v0 = *(const bf16x8*)(Vh + (size_t)((kb_) + sr) * D + sc); st_v1 = *(const bf16x8*)(Vh + (size_t)((kb_) + 32 + sr) * D + sc); \
                        st_k0 = *(const bf16x8*)(Kh + (size_t)((kb_) + sr) * D + sc); st_k1 = *(const bf16x8*)(Kh + (size_t)((kb_) + 32 + sr) * D + sc); \
                        if (MODE == 0 && tid < 64) st_b = (cumref - cum[(kb_) + tid]) * LOG2E; } while (0)
#define SWRITE(bf) do { *(bf16x8*)(V_lds + (bf) * SHM_V + vst0) = st_v0; *(bf16x8*)(V_lds + (bf) * SHM_V + vst1) = st_v1; \
                        *(bf16x8*)(K_lds + (bf) * SHM_K + kws) = st_k0; *(bf16x8*)(K_lds + (bf) * SHM_K + kws + 32 * 256) = st_k1; \
                        if (MODE == 0 && tid < 64) bias_l[(bf) * 64 + tid] = st_b; } while (0)
    __syncthreads();
    SLOAD(TILE_KB(0)); SWRITE(0);
    __syncthreads();
    f32x16 p0, p1; bf16x8 pa0, pa1, pa2, pa3;
#define STEP(BUF, t) do { const int kb_ = TILE_KB(t); \
        if ((t) + 1 < NT) SLOAD(TILE_KB((t) + 1)); \
        SBAR(); qkt<BUF>(p0, p1, K_lds, r32, hi, qr); \
        if (MODE == 0) fox_sm(p0, p1, bias_l + (BUF) * 64, kb_, qlo, qrow, hi, r32, m_reg, l_reg, o, al_l, pa0, pa1, pa2, pa3); \
        else sb_sm(p0, p1, kb_, qlo, qrow, hi, R, triA, pa0, pa1, pa2, pa3); \
        SBAR(); pv_tile<BUF>(o, vb0, pa0, pa1, pa2, pa3); \
        if ((t) + 1 < NT) SWRITE((BUF) ^ 1); \
        __syncthreads(); } while (0)
    for (int t = 0; t < NT; t += 2) {
        STEP(0, t); STEP(1, t + 1);
        const int kbc = TILE_KB(t + 1); if (kbc == 0) break;
        bool done;
        if (MODE == 0) { const float edge = (cumref - cum[kbc - 1]) * LOG2E; done = (qn + edge - m_reg) < -EXIT_T; }
        else done = R < -EXIT_T;
        const int par = (t >> 1) & 1;
        if (lane == 0) flg[par * 8 + wid] = 0;
        const bool wdone = __all(done);
        if (lane == 0 && wdone) flg[par * 8 + wid] = 1;
        __syncthreads();
        int alld = 1;
#pragma unroll
        for (int w = 0; w < 8; ++w) alld &= flg[par * 8 + w];
        if (alld) break;
    }
    __syncthreads();
#undef STEP
#undef SLOAD
#undef SWRITE
#undef TILE_KB
    float rli[16];
    if (MODE == 0) { if (hi == 0) li_l[r32] = l_reg; asm volatile("s_waitcnt lgkmcnt(0)" ::: "memory");
#pragma unroll
        for (int r = 0; r < 16; ++r) rli[r] = __builtin_amdgcn_rcpf(li_l[crow(r, hi)]); }
    bf16_t* Ow = O + (size_t)(wid * QBLK) * 3072;
#pragma unroll
    for (int r = 0; r < 16; ++r) { const int orow = crow(r, hi);
#pragma unroll
        for (int d0 = 0; d0 < 4; ++d0) { const float v = (MODE == 0) ? o[d0][r] * rli[r] : o[d0][r];
            const float vn = __shfl_xor(v, 1);
            if ((r32 & 1) == 0) *(unsigned*)(Ow + (size_t)orow * 3072 + d0 * 32 + r32) = cvtpk(v, vn); } }
}
}

__device__ __forceinline__ void sparse_query(const Frame& F, int tok, char* ldsw) {
    unsigned char* ws = F.ws; const int lane = F.lane, g = lane >> 4, i16 = lane & 15;
    const bf16_t* qcat = (const bf16_t*)(ws + R_QCAT) + (size_t)tok * 2304; const bf16_t* kbase = (const bf16_t*)(ws + R_KCAT) + (size_t)(tok >> 13) * SEQ * 288;
    const int* sel = (const int*)(ws + R_SEL) + (size_t)tok * 256; const int ns = ((const int*)(ws + R_NSEL))[tok]; const int ntile = (ns + 31) >> 5;
    bf16x8 qf[9];
#pragma unroll
    for (int st = 0; st < 9; ++st) { qf[st] = (bf16x8){0, 0, 0, 0, 0, 0, 0, 0}; if (i16 < 8) qf[st] = *(const bf16x8*)(qcat + i16 * 288 + st * 32 + 8 * g); }
    const int rA = lane >> 2, cq = lane & 3;
    float m = -1e30f, l = 0.f; f32x4 oT[16];
#pragma unroll
    for (int rb = 0; rb < 16; ++rb) oT[rb] = (f32x4){0.f, 0.f, 0.f, 0.f};
    const unsigned ldso = (unsigned)(uintptr_t)ldsw;
    const unsigned vb = ldso + (unsigned)((4 * g + (i16 >> 2)) * 592 + (i16 & 3) * 8);
    constexpr float SC2 = SCALE * LOG2E;
    bf16x8 stg[18];
#define GATHER(tile_) do { const int j0 = (tile_) * 32 + rA, j1 = j0 + 16; const int s0 = j0 < ns ? sel[j0] : 0, s1 = j1 < ns ? sel[j1] : 0; \
        const bf16_t* p0_ = kbase + (size_t)s0 * 288 + cq * 8; const bf16_t* p1_ = kbase + (size_t)s1 * 288 + cq * 8; \
        _Pragma("unroll") for (int c = 0; c < 9; ++c) { stg[2 * c] = *(const bf16x8*)(p0_ + c * 32); stg[2 * c + 1] = *(const bf16x8*)(p1_ + c * 32); } } while (0)
    GATHER(0);
    for (int tile = 0; tile < ntile; ++tile) {
#pragma unroll
        for (int c = 0; c < 9; ++c) { *(bf16x8*)(ldsw + rA * 592 + c * 64 + cq * 16) = stg[2 * c]; *(bf16x8*)(ldsw + (16 + rA) * 592 + c * 64 + cq * 16) = stg[2 * c + 1]; }
        if (tile + 1 < ntile) GATHER(tile + 1);
        asm volatile("s_waitcnt lgkmcnt(0)" ::: "memory"); SBAR();
        f32x4 acc[2];
#pragma unroll
        for (int mt = 0; mt < 2; ++mt) { acc[mt] = (f32x4){0.f, 0.f, 0.f, 0.f};
#pragma unroll
            for (int st = 0; st < 9; ++st) { const bf16x8 a = *(const bf16x8*)(ldsw + (16 * mt + i16) * 592 + st * 64 + g * 16);
                acc[mt] = __builtin_amdgcn_mfma_f32_16x16x32_bf16(a, qf[st], acc[mt], 0, 0, 0); } }
        float tmax = -__builtin_inff();
#pragma unroll
        for (int mt = 0; mt < 2; ++mt)
#pragma unroll
            for (int r = 0; r < 4; ++r) { const int key = tile * 32 + 16 * mt + 4 * g + r; float x = acc[mt][r] * SC2; if (key >= ns) x = -__builtin_inff(); acc[mt][r] = x; tmax = fmaxf(tmax, x); }
        tmax = fmaxf(tmax, __shfl_xor(tmax, 16)); tmax = fmaxf(tmax, __shfl_xor(tmax, 32));
        const float mn = fmaxf(m, tmax), alpha = __builtin_amdgcn_exp2f(m - mn); m = mn;
        float ps = 0.f;
#pragma unroll
        for (int mt = 0; mt < 2; ++mt)
#pragma unroll
            for (int r = 0; r < 4; ++r) { acc[mt][r] = __builtin_amdgcn_exp2f(acc[mt][r] - mn); ps += acc[mt][r]; }
        ps += __shfl_xor(ps, 16); ps += __shfl_xor(ps, 32);
        l = l * alpha + ps;
#pragma unroll
        for (int rb = 0; rb < 16; ++rb) oT[rb] *= alpha;
        const bf16x8 pf = pack8(acc[0], acc[1]);
#define TRRD2(dst, off) asm volatile("ds_read_b64_tr_b16 %0, %1 offset:%2" : "=&v"(dst) : "v"(vb), "i"(off) : "memory")
#define PVRB4(rb) do { s16x4 ta0, tb0, ta1, tb1, ta2, tb2, ta3, tb3; \
        TRRD2(ta0, ((rb) + 0) * 32); TRRD2(tb0, ((rb) + 0) * 32 + 16 * 592); TRRD2(ta1, ((rb) + 1) * 32); TRRD2(tb1, ((rb) + 1) * 32 + 16 * 592); \
        TRRD2(ta2, ((rb) + 2) * 32); TRRD2(tb2, ((rb) + 2) * 32 + 16 * 592); TRRD2(ta3, ((rb) + 3) * 32); TRRD2(tb3, ((rb) + 3) * 32 + 16 * 592); \
        asm volatile("s_waitcnt lgkmcnt(0)" ::: "memory"); SBAR(); \
        oT[(rb) + 0] = __builtin_amdgcn_mfma_f32_16x16x32_bf16((bf16x8){ta0[0], ta0[1], ta0[2], ta0[3], tb0[0], tb0[1], tb0[2], tb0[3]}, pf, oT[(rb) + 0], 0, 0, 0); \
        oT[(rb) + 1] = __builtin_amdgcn_mfma_f32_16x16x32_bf16((bf16x8){ta1[0], ta1[1], ta1[2], ta1[3], tb1[0], tb1[1], tb1[2], tb1[3]}, pf, oT[(rb) + 1], 0, 0, 0); \
        oT[(rb) + 2] = __builtin_amdgcn_mfma_f32_16x16x32_bf16((bf16x8){ta2[0], ta2[1], ta2[2], ta2[3], tb2[0], tb2[1], tb2[2], tb2[3]}, pf, oT[(rb) + 2], 0, 0, 0); \
        oT[(rb) + 3] = __builtin_amdgcn_mfma_f32_16x16x32_bf16((bf16x8){ta3[0], ta3[1], ta3[2], ta3[3], tb3[0], tb3[1], tb3[2], tb3[3]}, pf, oT[(rb) + 3], 0, 0, 0); } while (0)
        PVRB4(0); PVRB4(4); PVRB4(8); PVRB4(12);
#undef PVRB4
#undef TRRD2
        SBAR();
    }
#undef GATHER
    const float rl = 1.0f / l;
    if (i16 < 8) { bf16_t* op = (bf16_t*)(ws + R_OLAT) + (size_t)tok * 2048 + i16 * 256 + 4 * g;
#pragma unroll
        for (int rb = 0; rb < 16; ++rb) { u32x2 w; w.x = cvtpk(oT[rb][0] * rl, oT[rb][1] * rl); w.y = cvtpk(oT[rb][2] * rl, oT[rb][3] * rl); *(u32x2*)(op + rb * 16) = w; } }
}
#ifdef ATT_SUB
#define ASUB(k) ((k) == ATT_SUB)
#else
#define ASUB(k) true
#endif
__device__ __forceinline__ void phase_attn(const Frame& F0, int l, int rep) { const Frame F = fresh(F0);
    unsigned char* ws = F.ws; char* lds = (char*)F.lds;
    const bf16_t* qkv = (const bf16_t*)(ws + R_QKV); const size_t TS = (size_t)NTOK * 1024;
    unsigned* qctr = (unsigned*)(ws + WS_CTL) + CW_QCTR + l * 64 + rep * 16; const unsigned* kmx = (const unsigned*)(ws + WS_CTL) + CW_KMAX + l * 16;
    int* qitem = (int*)(lds + att::OFF_QITEM);
    int* hord = qitem + 4;
    if (F.tid < 16) { const float* cumb = (const float*)(ws + WS_CUM); const float mine = -cumb[(size_t)F.tid * SEQ + SEQ - 1]; int rank = 0;
        for (int o = 0; o < 16; ++o) { const float v = -cumb[(size_t)o * SEQ + SEQ - 1]; rank += (v < mine || (v == mine && o < F.tid)) ? 1 : 0; }
        hord[rank] = F.tid; }
#pragma unroll 1
    for (;;) {
        __syncthreads();
        if (F.tid == 0) qitem[0] = (int)atomicAdd(qctr, 1u);
        __syncthreads();
        const int it = qitem[0];
        if (it >= 1024) break;
        const int md = it >> 9, j = it & 511;
        const int qb = md == 0 ? 31 - (j & 31) : 31 - (j >> 4), bh = md == 0 ? hord[j >> 5] : (j & 15), b = bh >> 3, h = bh & 7, P0 = qb * 256;
        if (!ASUB(md)) continue;
        const bf16_t* Q = qkv + (size_t)(md * 3 + 0) * TS + (size_t)bh * SEQ * 128; const bf16_t* K = qkv + (size_t)(md * 3 + 1) * TS + (size_t)bh * SEQ * 128; const bf16_t* V = qkv + (size_t)(md * 3 + 2) * TS + (size_t)bh * SEQ * 128;
        const float* cum = (const float*)(ws + WS_CUM) + (size_t)bh * SEQ;
        bf16_t* Ob = (bf16_t*)(ws + R_OA) + (size_t)b * SEQ * 3072 + (md + 1) * 1024 + h * 128;
        if (md == 0) { const float kmaxc = sqrtf(__uint_as_float(kmx[bh])) * C2; att::attn_unit<0>(Q, K, V, cum, Ob + (size_t)P0 * 3072, P0, lds, kmaxc); }
        else att::attn_unit<1>(Q, K, V, cum, Ob + (size_t)P0 * 3072, P0, lds, 0.f);
    }
    __syncthreads();
    char* ldsw = lds + F.wid * 18944;
#pragma unroll 1
    for (int rep = 0; rep < NREP(2); ++rep)
#pragma unroll 1
    for (int tok = F.bid * 8 + F.wid; tok < NTOK; tok += F.G * 8) if (ASUB(2)) sparse_query(F, tok, ldsw);
}

__device__ __forceinline__ void ln_row_w(const u32x4 (&w4)[4], const float* g, const float* bta, float* of, bf16_t* ob, int lane, unsigned char* oq = nullptr, float* osc = nullptr, float* ost = nullptr) {
    f32x4 v[8]; float s = 0.f;
#pragma unroll
    for (int i = 0; i < 4; ++i) { const u32x4 w = w4[i];
        v[2 * i] = (f32x4){bflo(w.x), bfhi(w.x), bflo(w.y), bfhi(w.y)}; v[2 * i + 1] = (f32x4){bflo(w.z), bfhi(w.z), bflo(w.w), bfhi(w.w)};
        s += (v[2 * i][0] + v[2 * i][1]) + (v[2 * i][2] + v[2 * i][3]) + (v[2 * i + 1][0] + v[2 * i + 1][1]) + (v[2 * i + 1][2] + v[2 * i + 1][3]); }
    s = wave_sum(s); const float mu = s * (1.0f / 2048.0f); float q = 0.f;
#pragma unroll
    for (int i = 0; i < 8; ++i) { const f32x4 d = v[i] - mu; q += (d[0] * d[0] + d[1] * d[1]) + (d[2] * d[2] + d[3] * d[3]); }
    q = wave_sum(q); const float rstd = rsqrtf(q * (1.0f / 2048.0f) + 1e-5f);
    if (ost && lane == 0) { ost[0] = mu; ost[1] = rstd; }
    float amax = 0.f;
#pragma unroll
    for (int i = 0; i < 4; ++i) { const int c = (i * 64 + lane) * 8; const f32x4 g0 = *(const f32x4*)(g + c), g1 = *(const f32x4*)(g + c + 4), b0 = *(const f32x4*)(bta + c), b1 = *(const f32x4*)(bta + c + 4);
        const f32x4 y0 = (v[2 * i] - mu) * rstd * g0 + b0, y1 = (v[2 * i + 1] - mu) * rstd * g1 + b1; v[2 * i] = y0; v[2 * i + 1] = y1;
        if (of) { *(f32x4*)(of + c) = y0; *(f32x4*)(of + c + 4) = y1; }
        if (ob) pg8::st_bf16x8(ob + c, y0, y1);
        if (oq) { amax = fmaxf(amax, fmaxf(fmaxf(fmaxf(fabsf(y0[0]), fabsf(y0[1])), fmaxf(fabsf(y0[2]), fabsf(y0[3]))), fmaxf(fmaxf(fabsf(y1[0]), fabsf(y1[1])), fmaxf(fabsf(y1[2]), fabsf(y1[3]))))); } }
    if (oq) {
        for (int o = 32; o > 0; o >>= 1) amax = fmaxf(amax, __shfl_xor(amax, o));
        amax = fmaxf(amax, 1e-20f); const float qi = 127.0f / amax; if (lane == 0) *osc = amax * (1.0f / 127.0f);
#pragma unroll
        for (int i = 0; i < 4; ++i) { u32x2 w;
#pragma unroll
            for (int h = 0; h < 2; ++h) { const f32x4 y = v[2 * i + h]; unsigned pk = 0u;
#pragma unroll
                for (int j = 0; j < 4; ++j) pk |= ((unsigned)(int)rintf(y[j] * qi) & 0xffu) << (8 * j);
                w[h] = pk; }
            *(u32x2*)(oq + (i * 64 + lane) * 8) = w; } }
}
__device__ __forceinline__ void phase_ln1_router(const Frame& F0, const Params& P, int l) { const Frame F = fresh(F0);
    unsigned char* ws = F.ws; const int lane = F.lane, wid = F.wid;
    const bf16_t* pre1 = (const bf16_t*)(ws + R_PRE1); float* x1f = (float*)(ws + M_X1F); bf16_t* x1b = (bf16_t*)(ws + M_X1B); unsigned char* x1q = (unsigned char*)(ws + M_X1Q); float* x1s = (float*)(ws + M_X1S);
    const float* g = F.in(11) + l * DM; const float* bt = F.in(12) + l * DM; const float* wr = F.in(13) + (size_t)l * DM * NEXP; const float* br = F.in(14) + l * NEXP;
    unsigned* cnt = (unsigned*)(ws + WS_CTL) + CW_CNT + l * 2048;
    int* tok_e = (int*)(ws + M_TOKE); int* tok_pos = (int*)(ws + M_TOKPOS); float* tok_w = (float*)(ws + M_TOKW);
    float* red = (float*)F.lds;
    float* lg = (float*)(F.lds + 32768); float* stats = (float*)(F.lds + 32768 + 16384);
#pragma unroll 1
    for (int blk = F.bid; blk < NTOK / 64; blk += F.G) {
        const int tok0 = blk * 64;
#pragma unroll 1
        for (int ib = 0; ib < 2; ++ib) { u32x4 w4[4][4];
#pragma unroll
            for (int r = 0; r < 4; ++r)
#pragma unroll
                for (int i = 0; i < 4; ++i) w4[r][i] = *(const u32x4*)(pre1 + (size_t)(tok0 + wid * 8 + ib * 4 + r) * DM + (i * 64 + lane) * 8);
#pragma unroll
            for (int r = 0; r < 4; ++r) { const int i8 = ib * 4 + r, tok = tok0 + wid * 8 + i8; ln_row_w(w4[r], g, bt, (float*)nullptr, x1b + (size_t)tok * DM, lane, x1q + (size_t)tok * DM, x1s + tok, stats + 2 * (wid * 8 + i8)); } }
        asm volatile("s_waitcnt vmcnt(0)" ::: "memory"); __syncthreads();
        { const int grp = wid >> 2, kq = wid & 3, i32 = lane & 31, hk = lane >> 5; f32x16 acc = {};
          const bf16_t* arow = pre1 + (size_t)(tok0 + grp * 32 + i32) * DM + kq * 512 + 4 * hk; const float* bcol = wr + (size_t)(kq * 512 + 4 * hk) * NEXP + i32;
          const float* gp = g + kq * 512 + 4 * hk; const float* bp = bt + kq * 512 + 4 * hk; const float mu = stats[2 * (grp * 32 + i32)], rstd = stats[2 * (grp * 32 + i32) + 1];
#pragma unroll 8
          for (int c8 = 0; c8 < 64; ++c8) { const u32x2 xw = *(const u32x2*)(arow + c8 * 8); const f32x4 g4 = *(const f32x4*)(gp + c8 * 8), b4 = *(const f32x4*)(bp + c8 * 8);
              const f32x4 a4 = ((f32x4){bflo(xw.x), bfhi(xw.x), bflo(xw.y), bfhi(xw.y)} - mu) * rstd * g4 + b4;
              const float b0 = bcol[(size_t)(c8 * 8 + 0) * NEXP], b1 = bcol[(size_t)(c8 * 8 + 1) * NEXP], b2 = bcol[(size_t)(c8 * 8 + 2) * NEXP], b3 = bcol[(size_t)(c8 * 8 + 3) * NEXP];
              acc = __builtin_amdgcn_mfma_f32_32x32x2f32(a4[0], b0, acc, 0, 0, 0); acc = __builtin_amdgcn_mfma_f32_32x32x2f32(a4[1], b1, acc, 0, 0, 0);
              acc = __builtin_amdgcn_mfma_f32_32x32x2f32(a4[2], b2, acc, 0, 0, 0); acc = __builtin_amdgcn_mfma_f32_32x32x2f32(a4[3], b3, acc, 0, 0, 0); }
#pragma unroll
          for (int r = 0; r < 16; ++r) red[(wid * 16 + r) * 64 + lane] = acc[r]; }
        __syncthreads();
        if ((wid & 3) == 0) { const int grp = wid >> 2, hk = lane >> 5, e = lane & 31; const float be = br[e];
#pragma unroll
            for (int r = 0; r < 16; ++r) { const float v = red[((wid + 0) * 16 + r) * 64 + lane] + red[((wid + 1) * 16 + r) * 64 + lane] + red[((wid + 2) * 16 + r) * 64 + lane] + red[((wid + 3) * 16 + r) * 64 + lane] + be;
                lg[(grp * 32 + crow(r, hk)) * 33 + e] = v; }
            asm volatile("s_waitcnt lgkmcnt(0)" ::: "memory"); SBAR();
            const int tk = lane & 31; float v[32];
#pragma unroll
            for (int e2 = 0; e2 < 32; ++e2) v[e2] = lg[(grp * 32 + tk) * 33 + e2];
            int ek[4]; float vk[4];
#pragma unroll
            for (int k = 0; k < 4; ++k) { float best = -__builtin_inff(); int bi = 0;
#pragma unroll
                for (int e2 = 0; e2 < 32; ++e2) if (v[e2] > best) { best = v[e2]; bi = e2; }
                ek[k] = bi; vk[k] = best;
#pragma unroll
                for (int e2 = 0; e2 < 32; ++e2) v[e2] = (e2 == bi) ? -__builtin_inff() : v[e2]; }
            float wk[4], sw = 0.f;
#pragma unroll
            for (int k = 0; k < 4; ++k) { wk[k] = __expf(vk[k] - vk[0]); sw += wk[k]; }
            const float rs = 1.0f / sw;
            const bool act = lane < 32; unsigned myc = 0u;
#pragma unroll 1
            for (int E = 0; E < 32; ++E) { unsigned c = 0u;
#pragma unroll
                for (int k = 0; k < 4; ++k) c += (unsigned)__popcll(__ballot(act && ek[k] == E));
                if (lane == E) myc = c; }
            unsigned run = 0u; if (lane < 32 && myc > 0u) run = atomicAdd(&cnt[lane * 64], myc);
            int pk[4];
#pragma unroll
            for (int k = 0; k < 4; ++k) { pk[k] = 0;
#pragma unroll 1
                for (int E = 0; E < 32; ++E) { const unsigned long long mm = __ballot(act && ek[k] == E); const unsigned basev = (unsigned)__shfl((int)run, E);
                    if (act && ek[k] == E) pk[k] = (int)(basev + (unsigned)__popcll(mm & ((1ull << lane) - 1ull)));
                    if (lane == E) run += (unsigned)__popcll(mm); } }
            if (act) { const int tok = tok0 + grp * 32 + tk;
#pragma unroll
                for (int k = 0; k < 4; ++k) { tok_e[tok * 4 + k] = ek[k]; tok_pos[tok * 4 + k] = pk[k]; tok_w[tok * 4 + k] = wk[k] * rs; } }
        }
        __syncthreads();
    }
}
__device__ __forceinline__ void phase_moe_gather(const Frame& F0, int l) { const Frame F = fresh(F0);
    unsigned char* ws = F.ws; const int lane = F.lane;
    const unsigned* cnt = (const unsigned*)(ws + WS_CTL) + CW_CNT + l * 2048; unsigned* meta = (unsigned*)(ws + WS_CTL) + CW_META + l * 512;
    unsigned* offs = (unsigned*)(F.lds + LDS_MISC + 64);
    if (F.tid < 64) {
        const unsigned ce = lane < 32 ? cnt[lane * 64] : 0u, pc = (ce + 255u) & ~255u; unsigned inc = pc;
#pragma unroll
        for (int o = 1; o < 64; o <<= 1) { const unsigned n = (unsigned)__shfl_up((int)inc, o); if (lane >= o) inc += n; }
        if (lane < 32) offs[lane] = inc - pc; if (lane == 32) offs[32] = inc;
        if (F.bid == 0) { const unsigned t0 = (inc - pc) >> 8, nte = pc >> 8; for (unsigned t = 0; t < nte; ++t) meta[1 + t0 + t] = (unsigned)lane; if (lane == 32) meta[0] = inc >> 8; } }
    __syncthreads();
    const int* tok_e = (const int*)(ws + M_TOKE); const int* tok_pos = (const int*)(ws + M_TOKPOS); const float* tok_w = (const float*)(ws + M_TOKW);
    int* tok_dst = (int*)(ws + M_TOKDST); float* roww = (float*)(ws + M_ROWW);
    const unsigned char* x1q = (const unsigned char*)(ws + M_X1Q); const float* x1s = (const float*)(ws + M_X1S); unsigned char* xs = (unsigned char*)(ws + M_XS); float* rowsx = (float*)(ws + M_ROWSX);
    unsigned* rowtok = (unsigned*)(ws + M_ROWTOK);
    for (int it = F.bid * 512 + F.tid; it < NTOK * 4; it += F.G * 512) { const int tok = it >> 2;
        const int e = tok_e[it]; const unsigned dst = offs[e] + (unsigned)tok_pos[it];
        tok_dst[it] = (int)dst; roww[dst] = tok_w[it]; rowsx[dst] = x1s[tok]; rowtok[dst] = (unsigned)tok; }
    if (F.bid < 32) { const unsigned e = (unsigned)F.bid, c0 = offs[e] + cnt[e * 64];
        for (unsigned r = c0 + (unsigned)F.tid; r < offs[e + 1]; r += 512u) rowtok[r] = 0u; }
    __syncthreads();
}
__device__ __forceinline__ void phase_quant_h(const Frame& F0, int l) { const Frame F = fresh(F0);
    unsigned char* ws = F.ws; const int lane = F.lane;
    const int nrows = (int)((const unsigned*)(ws + WS_CTL))[CW_META + l * 512] * 256;
    const float* hm = (const float*)(ws + M_HM); const bf16_t* hid = (const bf16_t*)(ws + M_HID); unsigned char* h8 = (unsigned char*)(ws + M_H8); float* h8s = (float*)(ws + M_H8S);
    for (int row = F.bid * 8 + F.wid; row < nrows; row += F.G * 8) {
        float am = hm[(size_t)row * 32 + (lane & 31)];
        const u32x4 a = *(const u32x4*)(hid + (size_t)row * DEXP + lane * 16), b = *(const u32x4*)(hid + (size_t)row * DEXP + lane * 16 + 8);
        for (int o = 16; o > 0; o >>= 1) am = fmaxf(am, __shfl_xor(am, o));
        am = fmaxf(am, 1e-20f); const float qi = 127.0f / am; if (lane == 0) h8s[row] = am * (1.0f / 127.0f);
        const unsigned wv[8] = {a.x, a.y, a.z, a.w, b.x, b.y, b.z, b.w}; u32x4 w;
#pragma unroll
        for (int d = 0; d < 4; ++d) { unsigned pk = 0u;
#pragma unroll
            for (int j = 0; j < 2; ++j) { const unsigned x = wv[d * 2 + j];
                const float q0 = fminf(fmaxf(rintf(bflo(x) * qi), -127.f), 127.f), q1 = fminf(fmaxf(rintf(bfhi(x) * qi), -127.f), 127.f);
                pk |= (((unsigned)(int)q0 & 0xffu) | (((unsigned)(int)q1 & 0xffu) << 8)) << (16 * j); }
            w[d] = pk; }
        *(u32x4*)(h8 + (size_t)row * DEXP + lane * 16) = w; }
}
__device__ __forceinline__ void phase_combine(const Frame& F0) { const Frame F = fresh(F0);
    unsigned char* ws = F.ws; const int lane = F.lane;
    const bf16_t* x1b = (const bf16_t*)(ws + M_X1B); const bf16_t* ys = (const bf16_t*)(ws + M_XS); const int* tok_dst = (const int*)(ws + M_TOKDST);
    bf16_t* hb = (bf16_t*)(ws + M_HB); unsigned char* hq = (unsigned char*)(ws + M_HQ); float* hsc = (float*)(ws + M_HSC);
    for (int tok = F.bid * 8 + F.wid; tok < NTOK; tok += F.G * 8) {
        const int d0 = tok_dst[tok * 4], d1 = tok_dst[tok * 4 + 1], d2 = tok_dst[tok * 4 + 2], d3 = tok_dst[tok * 4 + 3];
        f32x4 hv[8]; float amax = 0.f;
#pragma unroll
        for (int i = 0; i < 4; ++i) { const int c = (i * 64 + lane) * 8; const size_t o = (size_t)tok * DM + c;
            const u32x4 xw = *(const u32x4*)(x1b + o);
            f32x4 a = (f32x4){bflo(xw.x), bfhi(xw.x), bflo(xw.y), bfhi(xw.y)} * ALPHA, b = (f32x4){bflo(xw.z), bfhi(xw.z), bflo(xw.w), bfhi(xw.w)} * ALPHA;
            const u32x4 y0 = *(const u32x4*)(ys + (size_t)d0 * DM + c), y1 = *(const u32x4*)(ys + (size_t)d1 * DM + c), y2 = *(const u32x4*)(ys + (size_t)d2 * DM + c), y3 = *(const u32x4*)(ys + (size_t)d3 * DM + c);
            a[0] += (bflo(y0.x) + bflo(y1.x)) + (bflo(y2.x) + bflo(y3.x)); a[1] += (bfhi(y0.x) + bfhi(y1.x)) + (bfhi(y2.x) + bfhi(y3.x));
            a[2] += (bflo(y0.y) + bflo(y1.y)) + (bflo(y2.y) + bflo(y3.y)); a[3] += (bfhi(y0.y) + bfhi(y1.y)) + (bfhi(y2.y) + bfhi(y3.y));
            b[0] += (bflo(y0.z) + bflo(y1.z)) + (bflo(y2.z) + bflo(y3.z)); b[1] += (bfhi(y0.z) + bfhi(y1.z)) + (bfhi(y2.z) + bfhi(y3.z));
            b[2] += (bflo(y0.w) + bflo(y1.w)) + (bflo(y2.w) + bflo(y3.w)); b[3] += (bfhi(y0.w) + bfhi(y1.w)) + (bfhi(y2.w) + bfhi(y3.w));
            pg8::st_bf16x8(hb + o, a, b); hv[2 * i] = a; hv[2 * i + 1] = b;
#pragma unroll
            for (int j = 0; j < 4; ++j) amax = fmaxf(amax, fmaxf(fabsf(a[j]), fabsf(b[j]))); }
        for (int o = 32; o > 0; o >>= 1) amax = fmaxf(amax, __shfl_xor(amax, o));
        amax = fmaxf(amax, 1e-20f); const float qi = 127.0f / amax; if (lane == 0) hsc[tok] = amax * (1.0f / 127.0f);
#pragma unroll
        for (int i = 0; i < 4; ++i) { u32x2 w;
#pragma unroll
            for (int h = 0; h < 2; ++h) { unsigned pk = 0u;
#pragma unroll
                for (int j = 0; j < 4; ++j) pk |= ((unsigned)(int)rintf(hv[2 * i + h][j] * qi) & 0xffu) << (8 * j);
                w[h] = pk; }
            *(u32x2*)(hq + (size_t)tok * DM + (i * 64 + lane) * 8) = w; } }
}
__device__ __forceinline__ void phase_ln2(const Frame& F0, const Params& P, int l) { const Frame F = fresh(F0);
    unsigned char* ws = F.ws; const bf16_t* pre2 = (const bf16_t*)(ws + M_X1F); bf16_t* xb = (bf16_t*)(ws + WS_XB);
    const float* g = F.in(23) + l * DM; const float* bt = F.in(24) + l * DM; float* outp = F.out();
    const int lane = F.lane, step = F.G * 8;
#pragma unroll 1
    for (int tok0 = F.bid * 8 + F.wid; tok0 < NTOK; tok0 += 4 * step) { u32x4 w4[4][4];
#pragma unroll
        for (int r = 0; r < 4; ++r) { const int tk = (tok0 + r * step) < NTOK ? tok0 + r * step : tok0;
#pragma unroll
            for (int i = 0; i < 4; ++i) w4[r][i] = *(const u32x4*)(pre2 + (size_t)tk * DM + (i * 64 + lane) * 8); }
#pragma unroll
        for (int r = 0; r < 4; ++r) { const int tok = tok0 + r * step; if (tok < NTOK)
            ln_row_w(w4[r], g, bt, (l + 1 == NLAYER) ? outp + (size_t)tok * DM : (float*)nullptr, (l + 1 == NLAYER) ? (bf16_t*)nullptr : xb + (size_t)tok * DM, lane,
                     (l + 1 == NLAYER) ? (unsigned char*)nullptr : (unsigned char*)(ws + WS_XQ) + (size_t)tok * DM, (l + 1 == NLAYER) ? (float*)nullptr : (float*)(ws + WS_XSC) + tok); } }
}

constexpr int NPHASE = 2 + 15 * NLAYER;
#ifdef PH_ONLY
#define PEN(kind) ((kind) == PH_ONLY)
#else
#define PEN(kind) true
#endif
#define IN(k) (lo <= (k) && (k) < hi)
#define SEAM(k) do { if (IN((k) + 1)) xcd_barrier(bar); } while (0)

template <int l>
__device__ __forceinline__ void layer_phases(const Frame& F, const Params& P, const XcdBarrier& bar, const int lo, const int hi, unsigned char* ws0) {
    using namespace pg8;

        const int pb = 2 + 15 * l;
        if (IN(pb + 0) && PEN(0)) { size_t wz = 0; asm volatile("" : "+s"(wz)); unsigned char* ws = ws0 + wz;
            { SchedS S; S.init(NTOK, 5 * 256, F.G, F.bid, (const bf16_t*)(ws + WS_XB), DM, (const bf16_t*)(ws + W_IN), DM); S.skip_from = 0; S.skip_by = 4; S.skip_from2 = 4; S.skip_by2 = 49;
              EpiInProj<false> E{(bf16_t*)(ws + R_QA), (bf16_t*)(ws + R_QIDX), (bf16_t*)(ws + R_QKV), (bf16_t*)(ws + R_GATES), (float*)(ws + R_SMALL), nullptr, nullptr};
              for (int rep = 0; rep < NREP(5); ++rep) gemm_phase(F.ldsl, DM, DM, DM, S, E); }
            { SchedS S; S.init(NTOK, 53 * 256, F.G, (F.bid + F.G / 2) % F.G, (const bf16_t*)(ws + WS_XQ), DM / 2, (const bf16_t*)(ws + W_IN8), DM / 2); S.skip_from = 4; S.skip_by = 4; S.b_compact = 1;
              if (F.G == 256) { S.c = F.bid; S.cut = 12; S.extra_n = 192; S.extra_c = F.bid >= 64 ? F.bid - 64 : -1; }
              EpiInProj<true> E{(bf16_t*)(ws + R_QA), (bf16_t*)(ws + R_QIDX), (bf16_t*)(ws + R_QKV), (bf16_t*)(ws + R_GATES), (float*)(ws + R_SMALL), (const float*)(ws + WS_XSC), (const unsigned*)(ws + WS_CTL) + CW_WMAXG + l};
              for (int rep = 0; rep < NREP(5); ++rep) gemm_phase(F.ldsl, DM / 2, DM / 2, DM / 2, S, E); }
            SEAM(pb + 0); }
        if (IN(pb + 1) && PEN(1)) { size_t wz = 0; asm volatile("" : "+s"(wz)); unsigned char* ws = ws0 + wz;
            phase_prep(F, P, l);
            SchedS S; S.init(NTOK, 2048, F.G, F.bid, (const bf16_t*)(ws + R_QA), 1024, (const bf16_t*)(ws + W_UK2), 256, 1, 256);
            EpiBf16 E{(bf16_t*)(ws + R_QCAT), 2304, 288};
            for (int rep = 0; rep < NREP(10); ++rep) gemm_phase(F.ldsl, 256, 1024, 256, S, E); SEAM(pb + 1); }
        if (IN(pb + 2) && PEN(2)) { size_t wz = 0; asm volatile("" : "+s"(wz)); unsigned char* ws = ws0 + wz; phase_cumsum(F); for (int rep = 0; rep < NREP(3); ++rep) phase_idx(F); SEAM(pb + 2); }
        if (IN(pb + 3) && PEN(3)) { size_t wz = 0; asm volatile("" : "+s"(wz)); unsigned char* ws = ws0 + wz; for (int rep = 0; rep < NREP(4); ++rep) phase_topk(F); SEAM(pb + 3); }
        if (IN(pb + 4) && PEN(4)) { size_t wz = 0; asm volatile("" : "+s"(wz)); unsigned char* ws = ws0 + wz; for (int rep = 0; rep < NREP(1); ++rep) phase_attn(F, l, rep); SEAM(pb + 4); }
        if (IN(pb + 5) && PEN(5)) { size_t wz = 0; asm volatile("" : "+s"(wz)); unsigned char* ws = ws0 + wz;
            SchedS S; S.init(NTOK, 1024, F.G, F.bid, (const bf16_t*)(ws + R_OLAT), 2048, (const bf16_t*)(ws + W_UV2), 512, 0, 512);
            EpiBf16 E{(bf16_t*)(ws + R_OA), 3072, 256}; for (int rep = 0; rep < NREP(10); ++rep) gemm_phase(F.ldsl, 512, 2048, 512, S, E);
            SEAM(pb + 5); }
        if (IN(pb + 6) && PEN(6)) { size_t wz = 0; asm volatile("" : "+s"(wz)); unsigned char* ws = ws0 + wz;
            SchedS S; S.init(NTOK, 2048, F.G, F.bid, (const bf16_t*)(ws + R_OA), 3072, (const bf16_t*)(ws + W_BRA), 3072);
            EpiBranch3 E{(const unsigned char*)(ws + R_GATES), (bf16_t*)(ws + R_MERGED)}; for (int rep = 0; rep < NREP(11); ++rep) gemm_phase(F.ldsl, 3072, 3072, 3072, S, E); SEAM(pb + 6); }
        if (IN(pb + 7) && PEN(7)) { size_t wz = 0; asm volatile("" : "+s"(wz)); unsigned char* ws = ws0 + wz;
            SchedS S; S.init(NTOK, 2048, F.G, F.bid, (const bf16_t*)(ws + R_MERGED), DM, (const bf16_t*)(ws + W_OUT), DM);
            EpiOut E{(const bf16_t*)(ws + WS_XB), (bf16_t*)(ws + R_PRE1)}; for (int rep = 0; rep < NREP(8); ++rep) gemm_phase(F.ldsl, DM, DM, DM, S, E); SEAM(pb + 7); }
        if (IN(pb + 8) && PEN(8)) { size_t wz = 0; asm volatile("" : "+s"(wz)); unsigned char* ws = ws0 + wz; phase_ln1_router(F, P, l); SEAM(pb + 8); }
        if (IN(pb + 9) && PEN(9)) { size_t wz = 0; asm volatile("" : "+s"(wz)); unsigned char* ws = ws0 + wz;
            for (int rep = 0; rep < NREP(12); ++rep) phase_moe_gather(F, l);
            SchedS S; S.init(NTOK, 2048, F.G, F.bid, (const bf16_t*)(ws + WS_PB) + (size_t)l * NTOK * 256, 256, (const bf16_t*)(ws + W_PLE), 256);
            EpiBf16 E{(bf16_t*)(ws + M_PP), 2048, 256}; for (int rep = 0; rep < NREP(10); ++rep) gemm_phase(F.ldsl, 256, 256, 256, S, E); SEAM(pb + 9); }
        if (IN(pb + 10) && PEN(10)) { size_t wz = 0; asm volatile("" : "+s"(wz)); unsigned char* ws = ws0 + wz;
            SchedMG S; S.init((const unsigned*)(ws + WS_CTL) + CW_META + l * 512, F.G, F.bid, (const bf16_t*)(ws + M_X1Q), DM / 2, (const bf16_t*)(ws + W_GU), DM / 2);
            { LAS unsigned* gt = (LAS unsigned*)(F.ldsl + pg8::GTAB_OFF); const unsigned* rowtok = (const unsigned*)(ws + M_ROWTOK);
              for (int ui = 0; ui * F.G + F.bid < S.ntiles * 8; ++ui) { const int pm = (ui * F.G + F.bid) >> 3; if (F.tid < 256) gt[ui * 256 + F.tid] = rowtok[pm * 256 + F.tid] * 2048u; }
              __syncthreads(); }
            EpiGateUpI8 E{F.in(16) + (size_t)l * NEXP * DEXP, F.in(18) + (size_t)l * NEXP * DEXP, (bf16_t*)(ws + M_HID), (const float*)(ws + M_ROWSX), (const unsigned*)(ws + WS_CTL) + CW_WMAX + l, (float*)(ws + M_HM)};
            for (int rep = 0; rep < NREP(6); ++rep) gemm_phase(F.ldsl, DM / 2, DM / 2, DM / 2, S, E); SEAM(pb + 10); }
        if (IN(pb + 11) && PEN(11)) { size_t wz = 0; asm volatile("" : "+s"(wz)); unsigned char* ws = ws0 + wz;
            phase_quant_h(F, l); xcd_barrier(bar);
            SchedM S; S.init((const unsigned*)(ws + WS_CTL) + CW_META + l * 512, F.G, F.bid, (const bf16_t*)(ws + M_H8), DEXP / 2, (const bf16_t*)(ws + W_DN), DEXP / 2);
            EpiDownI8 E{F.in(20) + (size_t)l * NEXP * DM, (const float*)(ws + M_ROWW), (bf16_t*)(ws + M_XS), (const float*)(ws + M_H8S), (const unsigned*)(ws + WS_CTL) + CW_WMAXD + l};
            for (int rep = 0; rep < NREP(7); ++rep) gemm_phase(F.ldsl, DEXP / 2, DEXP / 2, DEXP / 2, S, E); SEAM(pb + 11); }
        if (IN(pb + 12) && PEN(12)) { size_t wz = 0; asm volatile("" : "+s"(wz)); unsigned char* ws = ws0 + wz; for (int rep = 0; rep < NREP(9); ++rep) phase_combine(F); SEAM(pb + 12); }
        if (IN(pb + 13) && PEN(13)) { size_t wz = 0; asm volatile("" : "+s"(wz)); unsigned char* ws = ws0 + wz;
            SchedS S; S.init(NTOK, 2048, F.G, F.bid, (const bf16_t*)(ws + M_HQ), DM / 2, (const bf16_t*)(ws + W_PG), DM / 2);
            EpiPleGateI8 E{(const bf16_t*)(ws + M_HB), (const bf16_t*)(ws + M_PP), (bf16_t*)(ws + M_X1F), (const float*)(ws + M_HSC), (const unsigned*)(ws + WS_CTL) + CW_WMAXP + l};
            for (int rep = 0; rep < NREP(8); ++rep) gemm_phase(F.ldsl, DM / 2, DM / 2, DM / 2, S, E); SEAM(pb + 13); }
        if (IN(pb + 14) && PEN(14)) { size_t wz = 0; asm volatile("" : "+s"(wz)); unsigned char* ws = ws0 + wz; for (int rep = 0; rep < NREP(13); ++rep) phase_ln2(F, P, l); if (l + 1 < NLAYER) for (int rep = 0; rep < NREP(0); ++rep) convert_layer_weights(F, P, l + 1); SEAM(pb + 14); }
}
__global__ void __launch_bounds__(512, 2) fwd(Params P) {
    extern __shared__ __attribute__((aligned(16))) unsigned char lds[];
    Frame F; F.lds = lds; F.ldsl = (LAS unsigned char*)lds; F.ws = P.ws; F.tid = threadIdx.x; F.lane = F.tid & 63; F.wid = __builtin_amdgcn_readfirstlane(F.tid >> 6); F.G = gridDim.x; F.bid = blockIdx.x;
    unsigned char* ws0 = P.ws; unsigned char* ws = ws0;
    const bool fused = (P.ph_hi - P.ph_lo) > 1;
    if (F.tid < 4) ((LAS unsigned*)(F.ldsl + LDS_MISC))[F.tid] = 0u;
    if (F.tid == 0) { LAS unsigned long long* t = (LAS unsigned long long*)(F.ldsl + LDS_PTRS);
#pragma unroll
        for (int k = 0; k < 25; ++k) t[k] = (unsigned long long)P.in[k];
        t[25] = (unsigned long long)P.out; }
    __syncthreads();
    XcdBarrier bar; bar.bar = (unsigned*)(ws + WS_CTL) + CW_BAR; bar.x = 0; bar.st = (volatile LAS unsigned*)(F.ldsl + LDS_MISC);
    if (fused) bar = xcd_barrier_post((unsigned*)(ws + WS_CTL) + CW_BAR, (volatile LAS unsigned*)(F.ldsl + LDS_MISC));
    const int lo = P.ph_lo, hi = P.ph_hi;
    using namespace pg8;
    if (IN(0) && PEN(15)) { size_t wz = 0; asm volatile("" : "+s"(wz)); unsigned char* ws = ws0 + wz;
        quant_rows(F, F.in(0), (bf16_t*)(ws + WS_XB), (unsigned char*)(ws + WS_XQ), (float*)(ws + WS_XSC));
        conv_rows(F, F.in(1), (bf16_t*)(ws + WS_PB), (size_t)2 * NTOK * 256 / 8);
        sample_wmax(F);
        SEAM(0);
    }
    if (IN(1) && PEN(15)) { for (int rep = 0; rep < NREP(0); ++rep) convert_layer_weights(F, P, 0); SEAM(1); }
    layer_phases<0>(F, P, bar, lo, hi, ws0);
    layer_phases<1>(F, P, bar, lo, hi, ws0);
}

#ifdef DEBUG_NAN
constexpr int CW_FLAGS = 12288;
__global__ void dbg_scan_bf16(const unsigned short* p, size_t n, unsigned* flag) { unsigned c = 0; for (size_t i = (size_t)blockIdx.x * blockDim.x + threadIdx.x; i < n; i += (size_t)gridDim.x * blockDim.x) if ((p[i] & 0x7F80u) == 0x7F80u) ++c; if (c) atomicAdd(flag, c); }
__global__ void dbg_scan_f32(const unsigned* p, size_t n, unsigned* flag) { unsigned c = 0; for (size_t i = (size_t)blockIdx.x * blockDim.x + threadIdx.x; i < n; i += (size_t)gridDim.x * blockDim.x) if ((p[i] & 0x7F800000u) == 0x7F800000u) ++c; if (c) atomicAdd(flag, c); }
__global__ void dbg_scan_sel(const int* sel, const int* nsel, unsigned* flag) { unsigned c = 0; for (size_t i = (size_t)blockIdx.x * blockDim.x + threadIdx.x; i < (size_t)NTOK * 256; i += (size_t)gridDim.x * blockDim.x) { const int tok = (int)(i >> 8), j = (int)(i & 255), t = tok & (SEQ - 1); const int ns = nsel[tok]; if (j == 0 && ns != (t + 1 < 256 ? t + 1 : 256)) ++c; if (j < ns && (sel[i] < 0 || sel[i] > t)) ++c; } if (c) atomicAdd(flag, c); }
__global__ void dbg_scan_scores(const unsigned* p, unsigned* flag) { unsigned c = 0; for (size_t i = (size_t)blockIdx.x * blockDim.x + threadIdx.x; i < 2ull * SEQ * SEQ; i += (size_t)gridDim.x * blockDim.x) { const int s = (int)(i & (SEQ - 1)), t = (int)((i >> 13) & (SEQ - 1)); if (s <= t && (p[i] & 0x7F800000u) == 0x7F800000u) ++c; } if (c) atomicAdd(flag, c); }
__global__ void dbg_probe_bf16(const unsigned short* p, size_t n, unsigned* cnt, unsigned* minidx) { unsigned c = 0; unsigned mi = 0xFFFFFFFFu; for (size_t i = (size_t)blockIdx.x * blockDim.x + threadIdx.x; i < n; i += (size_t)gridDim.x * blockDim.x) if ((p[i] & 0x7F80u) == 0x7F80u) { ++c; if ((unsigned)i < mi) mi = (unsigned)i; } if (c) { atomicAdd(cnt, c); atomicMax(minidx, ~mi); } }
__global__ void dbg_final(float* out, size_t n, const unsigned* flags) { int code = 0; for (int k = 0; k < 32; ++k) if (flags[k] && !code) code = k + 1; const int mask = (flags[32] ? 1 : 0) | (flags[33] ? 2 : 0) | (flags[34] ? 4 : 0); if (mask) code = 20 + 5 * mask; if (!code) return; for (size_t i = (size_t)blockIdx.x * blockDim.x + threadIdx.x; i < n; i += (size_t)gridDim.x * blockDim.x) out[i] = (float)code; }
#endif
extern "C" void kernel_launch(void* const* d_in, const int* in_sizes, int n_in, void* d_out, int out_size, void* d_ws, size_t ws_size, hipStream_t stream) {
    static int grid = 0;
    if (grid == 0) {
        if (n_in != 25 || out_size != NTOK * DM || ws_size < WS_NEED) { fprintf(stderr, "kernel_launch: unexpected shapes (n_in %d out %d ws %zu need %zu)\n", n_in, out_size, ws_size, (size_t)WS_NEED); grid = -1; return; }
        int dev = 0, cus = 0, per_cu = 0;
        if (hipGetDevice(&dev) != hipSuccess || hipDeviceGetAttribute(&cus, hipDeviceAttributeMultiprocessorCount, dev) != hipSuccess) { grid = -1; return; }
        if (hipFuncSetAttribute((const void*)fwd, hipFuncAttributeMaxDynamicSharedMemorySize, LDS_BYTES) != hipSuccess) { fprintf(stderr, "kernel_launch: hipFuncSetAttribute failed\n"); grid = -1; return; }
        if (hipOccupancyMaxActiveBlocksPerMultiprocessor(&per_cu, (const void*)fwd, 512, LDS_BYTES) != hipSuccess || per_cu < 1) fprintf(stderr, "kernel_launch: occupancy query says %d\n", per_cu);
        (void)hipGetLastError();
        grid = cus;
    }
    if (grid < 0) return;
    unsigned char* ws = (unsigned char*)d_ws;
    hipMemsetAsync(ws + WS_CTL, 0, CTL_BYTES, stream);
    hipMemsetAsync(ws + W_UK2, 0, 8ull * 256 * 256 * 2 + 4ull * 256 * 512 * 2, stream);
    hipMemsetAsync(ws + W_IN + (size_t)INW * 2048 * 2, 0, (size_t)(INWP - INW) * 2048 * 2, stream);
    Params p{};
    for (int i = 0; i < 25; ++i) p.in[i] = (const float*)d_in[i];
    p.out = (float*)d_out; p.ws = ws;
#if PHASES_PER_LAUNCH == 0
    p.ph_lo = 0; p.ph_hi = NPHASE;
    hipLaunchKernelGGL(fwd, dim3(grid), dim3(512), LDS_BYTES, stream, p);
#else
    for (int k = 0; k < NPHASE; ++k) { p.ph_lo = k; p.ph_hi = k + 1; hipLaunchKernelGGL(fwd, dim3(grid), dim3(512), LDS_BYTES, stream, p);
#ifdef DEBUG_NAN
        unsigned* fl = (unsigned*)(ws + WS_CTL) + CW_FLAGS + k;
#define SB16(off, n) hipLaunchKernelGGL(dbg_scan_bf16, dim3(1024), dim3(256), 0, stream, (const unsigned short*)(ws + (off)), (size_t)(n), fl)
#define SF32(off, n) hipLaunchKernelGGL(dbg_scan_f32, dim3(1024), dim3(256), 0, stream, (const unsigned*)(ws + (off)), (size_t)(n), fl)
        if (k == 0) { SB16(WS_XB, (size_t)NTOK * DM); SB16(WS_PB, 2ull * NTOK * 256); SB16(WS_W, (W_END - WS_W) / 2); }
        else { const int kind = (k - 1) % 15;
            if (kind == 0) { SB16(R_QA, (size_t)NTOK * 1024); SB16(R_QIDX, (size_t)NTOK * 1024); SB16(R_QKV, 6ull * NTOK * 1024); SB16(R_GATES, (size_t)NTOK * 6144); SF32(R_SMALL, (size_t)NTOK * 512); }
            if (kind == 1) { SB16(R_QCAT, (size_t)NTOK * 2304); SB16(R_KCAT, (size_t)NTOK * 288); SB16(R_KI, (size_t)NTOK * 64); SB16(R_QIDX, (size_t)NTOK * 1024); SF32(R_WI, (size_t)NTOK * 16); SF32(WS_LF, 16ull * 8192); }
            if (kind == 2) { SF32(WS_CUM, 16ull * 8192); hipLaunchKernelGGL(dbg_scan_scores, dim3(1024), dim3(256), 0, stream, (const unsigned*)(ws + R_SCORES), fl); }
            if (kind == 3) { hipLaunchKernelGGL(dbg_scan_sel, dim3(1024), dim3(256), 0, stream, (const int*)(ws + R_SEL), (const int*)(ws + R_NSEL), fl); }
            if (k == 5) { unsigned* fl0 = fl; fl = (unsigned*)(ws + WS_CTL) + CW_FLAGS + 32; SB16(R_OLAT, (size_t)NTOK * 2048); fl += 1; SB16(R_OA, (size_t)NTOK * 3072); fl += 1; fl = fl0; hipLaunchKernelGGL(dbg_probe_bf16, dim3(1024), dim3(256), 0, stream, (const unsigned short*)(ws + R_OC), (size_t)NTOK * 1024, (unsigned*)(ws + WS_CTL) + CW_FLAGS + 40, (unsigned*)(ws + WS_CTL) + CW_FLAGS + 41); }
            if (kind == 5) { SB16(R_OA, (size_t)NTOK * 3072); }
            if (kind == 6) { SB16(R_MERGED, (size_t)NTOK * 2048); }
            if (kind == 7) { SF32(R_PRE1, (size_t)NTOK * 2048); }
            if (kind == 8) { SF32(M_X1F, (size_t)NTOK * 2048); SF32(M_TOKW, (size_t)NTOK * 4); }
            if (kind == 9) { SB16(M_PP, (size_t)NTOK * 2048); }
            if (kind == 12) { SF32(M_HF, (size_t)NTOK * 2048); }
            if (kind == 13) { SF32(M_X1F, (size_t)NTOK * 2048); }
            if (kind == 14) { hipLaunchKernelGGL(dbg_scan_f32, dim3(1024), dim3(256), 0, stream, (const unsigned*)d_out, (size_t)NTOK * DM, fl); if (k + 1 < NPHASE) SB16(WS_W, (W_END - WS_W) / 2); } }
#endif
    }
#ifdef DEBUG_NAN
    hipLaunchKernelGGL(dbg_final, dim3(1024), dim3(256), 0, stream, (float*)d_out, (size_t)NTOK * DM, (const unsigned*)(ws + WS_CTL) + CW_FLAGS);
#endif
#endif
}
```

```cpp
#include <hip/hip_runtime.h>
#include <stdint.h>
#include <stdio.h>
#include <math.h>

#ifndef PHASES_PER_LAUNCH
#define PHASES_PER_LAUNCH 0
#endif

#define LAS __attribute__((address_space(3)))
#define GAS __attribute__((address_space(1)))
#ifndef REP_MASK
#define REP_MASK 0
#endif
#define NREP(bit) (((REP_MASK) >> (bit)) & 1 ? 2 : 1)
typedef unsigned short bf16_t;
typedef short bf16x8 __attribute__((ext_vector_type(8)));
typedef short s16x4 __attribute__((ext_vector_type(4)));
typedef float f32x4 __attribute__((ext_vector_type(4)));
typedef float f32x16 __attribute__((ext_vector_type(16)));
typedef unsigned u32x4 __attribute__((ext_vector_type(4)));
typedef unsigned u32x2 __attribute__((ext_vector_type(2)));
typedef int i32x4 __attribute__((ext_vector_type(4)));

constexpr int NTOK = 16384, DM = 2048, SEQ = 8192, NB = 2, NLAYER = 2;
constexpr int INW = 14712, INWP = 14848;
constexpr int NEXP = 32, DEXP = 1024;
constexpr int PMAX = 65536 + 8192;
constexpr float ALPHA = 1.41421356237309515f;
constexpr float LOG2E = 1.4426950408889634f;
constexpr float SCALE = 0.08838834764831845f;
constexpr float C2 = LOG2E * SCALE;

constexpr size_t MiB = 1ull << 20;
constexpr size_t WS_CTL   = 0;
constexpr size_t WS_W     = 1 * MiB;
constexpr size_t W_IN     = WS_W;
constexpr size_t W_IN8    = W_IN   + 2048ull * 2048 * 2;
constexpr size_t W_UK2    = W_IN   + (size_t)INWP * 2048 * 2;
constexpr size_t W_UV2    = W_UK2  + 8ull * 256 * 256 * 2;
constexpr size_t W_BRA    = W_UV2  + 4ull * 256 * 512 * 2;
constexpr size_t W_BRB    = W_BRA  + 2048ull * 1024 * 2;
constexpr size_t W_BRC    = W_BRB  + 2048ull * 1024 * 2;
constexpr size_t W_OUT    = W_BRC  + 2048ull * 1024 * 2;
constexpr size_t W_PG     = W_OUT  + 2048ull * 2048 * 2;
constexpr size_t W_PLE    = W_PG   + 2048ull * 2048 * 2;
constexpr size_t W_GU     = W_PLE  + 2048ull * 256 * 2;
constexpr size_t W_DN     = W_GU   + 32ull * 2048 * 2048 * 2;
constexpr size_t W_END    = W_DN   + 32ull * 2048 * 1024 * 2;
constexpr size_t WS_XB    = (W_END + MiB - 1) / MiB * MiB;
constexpr size_t WS_PB    = WS_XB  + (size_t)NTOK * DM * 2;
constexpr size_t WS_CUM   = WS_PB  + 2ull * NTOK * 256 * 2;
constexpr size_t WS_LF    = WS_CUM + 16ull * 8192 * 4;
constexpr size_t WS_XQ    = WS_LF  + 16ull * 8192 * 4;
constexpr size_t WS_XSC   = WS_XQ  + (size_t)NTOK * DM;
constexpr size_t WS_R     = (WS_XSC + (size_t)NTOK * 4 + MiB - 1) / MiB * MiB;
constexpr size_t R_SCORES = WS_R;
constexpr size_t R_OLAT   = WS_R;
constexpr size_t R_OA     = WS_R + 64 * MiB;
constexpr size_t R_OB     = WS_R + 96 * MiB;
constexpr size_t R_OC     = WS_R + 128 * MiB;
constexpr size_t R_TMP    = WS_R + 160 * MiB;
constexpr size_t R_MERGED = WS_R + 288 * MiB;
constexpr size_t R_PRE1   = WS_R + 384 * MiB;
constexpr size_t R_QA     = WS_R + 512 * MiB;
constexpr size_t R_QIDX   = WS_R + 544 * MiB;
constexpr size_t R_QKV    = WS_R + 576 * MiB;
constexpr size_t R_GATES  = WS_R + 768 * MiB;
constexpr size_t R_SMALL  = WS_R + 960 * MiB;
constexpr size_t R_QCAT   = WS_R + 992 * MiB;
constexpr size_t R_KCAT   = WS_R + 1064 * MiB;
constexpr size_t R_KI     = WS_R + 1073 * MiB;
constexpr size_t R_WI     = WS_R + 1075 * MiB;
constexpr size_t R_SEL    = WS_R + 1076 * MiB;
constexpr size_t R_NSEL   = WS_R + 1092 * MiB;
constexpr size_t R_END    = WS_R + 1093 * MiB;
constexpr size_t M_XS     = WS_R;
constexpr size_t M_HID    = WS_R + 288 * MiB;
constexpr size_t M_PP     = WS_R + 432 * MiB;
constexpr size_t M_X1F    = WS_R + 512 * MiB;
constexpr size_t M_X1B    = WS_R + 640 * MiB;
constexpr size_t M_HF     = WS_R + 704 * MiB;
constexpr size_t M_HQ     = WS_R + 704 * MiB;
constexpr size_t M_HSC    = WS_R + 736 * MiB;
constexpr size_t M_HB     = WS_R + 832 * MiB;
constexpr size_t M_TOKE   = WS_R + 896 * MiB;
constexpr size_t M_TOKPOS = M_TOKE + (size_t)NTOK * 16;
constexpr size_t M_TOKW   = M_TOKPOS + (size_t)NTOK * 16;
constexpr size_t M_TOKDST = M_TOKW + (size_t)NTOK * 16;
constexpr size_t M_ROWW   = M_TOKDST + (size_t)NTOK * 16;
constexpr size_t M_ROWSX  = M_ROWW + (size_t)PMAX * 4;
constexpr size_t M_X1S    = M_ROWSX + (size_t)PMAX * 4;
constexpr size_t M_X1Q    = WS_R + 900 * MiB;
constexpr size_t M_ROWTOK = WS_R + 750 * MiB;
constexpr size_t M_HM     = WS_R + 740 * MiB;
constexpr size_t M_H8     = WS_R + 752 * MiB;
constexpr size_t M_H8S    = WS_R + 826 * MiB;
constexpr size_t WS_NEED  = R_END;
constexpr int CW_BAR = 0;
constexpr int CW_CNT = 8192;
constexpr int CW_META = 4096 + 64;
constexpr int CW_QCTR = 6144;
constexpr int CW_WMAX = 6272;
constexpr int CW_WMAXG = 6336;
constexpr int CW_WMAXP = 6368;
constexpr int CW_WMAXD = 6384;
constexpr int CW_KMAX = 6400;
constexpr size_t CTL_BYTES = 65536;

constexpr int LDS_BYTES = 152576;
constexpr int LDS_MISC = 151552;

typedef float f32x2 __attribute__((ext_vector_type(2)));
typedef __bf16 bf16n2 __attribute__((ext_vector_type(2)));
__device__ __forceinline__ unsigned cvtpk(float lo, float hi) { f32x2 v = {lo, hi}; bf16n2 b = __builtin_convertvector(v, bf16n2); return __builtin_bit_cast(unsigned, b); }
__device__ __forceinline__ bf16_t f2bf(float x) { return (bf16_t)(cvtpk(x, 0.f) & 0xffffu); }
__device__ __forceinline__ float bf2f(bf16_t b) { return __uint_as_float(((unsigned)b) << 16); }
__device__ __forceinline__ float bflo(unsigned w) { return __uint_as_float(w << 16); }
__device__ __forceinline__ float bfhi(unsigned w) { return __uint_as_float(w & 0xffff0000u); }
__device__ __forceinline__ bf16x8 pack8(f32x4 a, f32x4 b) { u32x4 w = {cvtpk(a[0], a[1]), cvtpk(a[2], a[3]), cvtpk(b[0], b[1]), cvtpk(b[2], b[3])}; return *reinterpret_cast<bf16x8*>(&w); }
__device__ __forceinline__ float sigmoidf_(float x) { return 1.0f / (1.0f + __expf(-x)); }
__device__ __forceinline__ float wave_sum(float v) { for (int o = 32; o > 0; o >>= 1) v += __shfl_xor(v, o); return v; }
__device__ __forceinline__ int crow(int r, int hi) { return (r & 3) + 8 * (r >> 2) + 4 * hi; }
#define SBAR() __builtin_amdgcn_sched_barrier(0)

#define XB_TMO      128
#define XB_XCNT(j)  (256  + 64 * (j))
#define XB_XSUB(j)  (1280 + 64 * (j))
#define XB_XGEN(j)  (2304 + 64 * (j))
#define XB_TOP      3328
#define XB_TOPGEN   3392
#define XCD_BAR_WORDS 3456
#define XB_SPIN_CAP (1u << 22)
__device__ __forceinline__ unsigned xb_ld(unsigned* p)              { return __hip_atomic_load(p, __ATOMIC_RELAXED, __HIP_MEMORY_SCOPE_AGENT); }
__device__ __forceinline__ unsigned xb_add(unsigned* p, unsigned v) { return __hip_atomic_fetch_add(p, v, __ATOMIC_RELAXED, __HIP_MEMORY_SCOPE_AGENT); }
__device__ __forceinline__ unsigned xb_xcc_id() { return (unsigned)__builtin_amdgcn_s_getreg((3 << 11) | 20) & 0xFu; }
#define XB_SPIN(cond, bar) do { unsigned _sp = 0; while (cond) { __builtin_amdgcn_s_sleep(1); \
    if ((++_sp & 255u) == 0u) { if (xb_ld(&(bar)[XB_TMO])) break; if (_sp > XB_SPIN_CAP) { atomicAdd(&(bar)[XB_TMO], 1u); break; } } } } while (0)
struct XcdBarrier { unsigned* bar; unsigned x; volatile LAS unsigned* st; };
__device__ __forceinline__ XcdBarrier xcd_barrier_post(unsigned* bar, volatile LAS unsigned* st) {
    XcdBarrier b; b.bar = bar; b.x = xb_xcc_id(); b.st = st;
    if (threadIdx.x == 0) (void)xb_add(&bar[XB_XCNT(b.x)], 1u);
    return b;
}
__device__ __forceinline__ void xcd_barrier_complete(unsigned* bar, unsigned x, unsigned& nloc, unsigned& nx) {
    const unsigned G = gridDim.x * gridDim.y * gridDim.z;
    unsigned sum, cnt, mine, sp = 0u;
    for (;;) {
        sum = 0u; cnt = 0u; mine = 0u;
#pragma unroll
        for (unsigned j = 0; j < 16; ++j) { const unsigned c = xb_ld(&bar[XB_XCNT(j)]); sum += c; cnt += (c > 0u) ? 1u : 0u; mine = (j == x) ? c : mine; }
        if (sum == G) break;
        __builtin_amdgcn_s_sleep(1);
        if ((++sp & 255u) == 0u) { if (xb_ld(&bar[XB_TMO])) break; if (sp > XB_SPIN_CAP) { atomicAdd(&bar[XB_TMO], 1u); break; } }
    }
    nloc = mine > 0u ? mine : 1u; nx = cnt > 0u ? cnt : 1u;
}
__device__ __forceinline__ void xcd_barrier(const XcdBarrier& b) {
    asm volatile("s_waitcnt vmcnt(0)" ::: "memory");
    __syncthreads();
    if (threadIdx.x == 0) {
        unsigned* bar = b.bar;
        __builtin_amdgcn_s_waitcnt(0);
        unsigned nloc = b.st[0], nx = b.st[1];
        if (nloc == 0u) { xcd_barrier_complete(bar, b.x, nloc, nx); b.st[0] = nloc; b.st[1] = nx; }
        const unsigned old = xb_add(&bar[XB_XSUB(b.x)], 1u);
        const unsigned gen = old / nloc;
        if (old + 1u == (gen + 1u) * nloc) {
            __builtin_amdgcn_fence(__ATOMIC_RELEASE, "agent");
            asm volatile("s_waitcnt vmcnt(0)" ::: "memory");
            const unsigned og = xb_add(&bar[XB_TOP], 1u);
            const unsigned tg = og / nx;
            if (og + 1u == (tg + 1u) * nx) xb_add(&bar[XB_TOPGEN], 1u);
            else XB_SPIN(xb_ld(&bar[XB_TOPGEN]) == tg, bar);
            __builtin_amdgcn_fence(__ATOMIC_ACQUIRE, "agent");
            xb_add(&bar[XB_XGEN(b.x)], 1u);
            asm volatile("s_waitcnt vmcnt(0)" ::: "memory");
        } else {
            XB_SPIN(xb_ld(&bar[XB_XGEN(b.x)]) == gen, bar);
            __builtin_amdgcn_fence(__ATOMIC_ACQUIRE, "agent");
            asm volatile("s_waitcnt vmcnt(0)" ::: "memory");
        }
    }
    __syncthreads();
}

namespace pg8 {
constexpr int BM = 256, BK = 64, HALF = 128, HTB = HALF * BK * 2, STAGE_BYTES = 8 * HTB, NXCD = 8, WGM = 8;
__device__ __forceinline__ int lds_byte(int r, int c) { const int st = (r >> 4) * 2 + (c >> 5), rr = r & 15, cc = c & 31, ob = rr * 64 + cc * 2; return st * 1024 + (ob ^ (((ob >> 9) & 1) << 5)); }
__device__ __forceinline__ void stage_rc(int b, int& R, int& C) { const int st = b / 1024, sb = b % 1024, swz = sb ^ (((sb >> 9) & 1) << 5); R = (st >> 1) * 16 + swz / 64; C = (st & 1) * 32 + (swz % 64) / 2; }
__device__ __forceinline__ int perm32(int rho) { const int n = rho >> 4, i = rho & 15; return 8 * (i >> 2) + 4 * n + (i & 3); }
struct Unit { int pm, pn, e; };
struct SchedS {
    static constexpr bool GATHER = false;
    int nM, nN, nwg, G, c; const bf16_t* A; const bf16_t* B; int lda, ldb, a_sh, a_mul, skip_from = 1 << 30, skip_by = 0, skip_from2 = 1 << 30, skip_by2 = 0, b_compact = 0, cut = 1 << 30, extra_n = 0, extra_c = -1;
    __device__ void init(int M, int N, int G_, int c_, const bf16_t* A_, int lda_, const bf16_t* B_, int ldb_, int a_sh_ = 0, int a_mul_ = 0) {
        nM = M / BM; nN = N / BM; nwg = nM * nN; G = G_; c = c_; A = A_; B = B_; lda = lda_; ldb = ldb_; a_sh = a_sh_; a_mul = a_mul_; }
    __device__ __forceinline__ bool next(int i, Unit& u) const {
        long L = (long)i * G + c; if (i >= cut) { const int j = i - cut; if (extra_c < 0 || j >= 2) return false; L = (long)cut * G + (long)j * extra_n + extra_c; }
        if (L >= nwg) return false;
        int wgid = (int)L; { const int q = nwg / NXCD, r = nwg % NXCD, xcd = wgid % NXCD, off = wgid / NXCD; wgid = (xcd < r ? xcd * (q + 1) : r * (q + 1) + (xcd - r) * q) + off; }
        const int nig = WGM * nN, gid = wgid / nig, fm = gid * WGM, gsz = (nM - fm) < WGM ? (nM - fm) : WGM;
        u.pm = fm + ((wgid % nig) % gsz); u.pn = (wgid % nig) / gsz; u.e = 0;
        u.e = u.pn;
        { const int ci = u.pn; if (ci >= skip_from) u.pn += skip_by; if (ci >= skip_from2) u.pn += skip_by2; }
        return true;
    }
    __device__ __forceinline__ const char* pa(const Unit& u) const { return (const char*)(A + (size_t)u.pm * BM * lda + (size_t)((u.pn >> a_sh) * a_mul)); }
    __device__ __forceinline__ const char* pb(const Unit& u) const { return (const char*)(B + (size_t)(b_compact ? u.e : u.pn) * BM * ldb); }
};
struct SchedM {
    static constexpr bool GATHER = false;
    int ntiles, G, c; const bf16_t* A; const bf16_t* W; int lda, ldb; const unsigned* tile_e;
    __device__ void init(const unsigned* meta, int G_, int c_, const bf16_t* A_, int lda_, const bf16_t* W_, int ldb_) {
        ntiles = (int)meta[0]; tile_e = meta + 1; G = G_; c = c_; A = A_; W = W_; lda = lda_; ldb = ldb_; }
    __device__ __forceinline__ bool next(int i, Unit& u) const {
        const long L = (long)i * G + c; if (L >= (long)ntiles * 8) return false;
        u.pm = (int)(L >> 3); u.pn = (int)(L & 7); u.e = (int)tile_e[u.pm];
        return true;
    }
    __device__ __forceinline__ const char* pa(const Unit& u) const { return (const char*)(A + (size_t)u.pm * BM * lda); }
    __device__ __forceinline__ const char* pb(const Unit& u) const { return (const char*)(W + ((size_t)u.e * 2048 + (size_t)u.pn * BM) * ldb); }
};

constexpr int GTAB_OFF = 131072;
struct SchedMG {
    static constexpr bool GATHER = true;
    int ntiles, G, c; const bf16_t* A; const bf16_t* W; int lda, ldb; const unsigned* tile_e;
    __device__ __forceinline__ void init(const unsigned* meta, int G_, int c_, const bf16_t* A_, int lda_, const bf16_t* W_, int ldb_) {
        ntiles = (int)meta[0]; tile_e = meta + 1; G = G_; c = c_; A = A_; W = W_; lda = lda_; ldb = ldb_; }
    __device__ __forceinline__ bool next(int i, Unit& u) const {
        const long L = (long)i * G + c; if (L >= (long)ntiles * 8) return false;
        u.pm = (int)(L >> 3); u.pn = (int)(L & 7); u.e = (int)tile_e[u.pm];
        return true;
    }
    __device__ __forceinline__ const char* pa(const Unit& u) const { return (const char*)A; }
    __device__ __forceinline__ const char* pb(const Unit& u) const { return (const char*)(W + ((size_t)u.e * 2048 + (size_t)u.pn * BM) * ldb); }
};

template <class Epi, class Sched>
__device__ __forceinline__ void gemm_phase(LAS unsigned char* lds, const int K, const int lda, const int ldb, const Sched& S, const Epi& E) {
    int tid = threadIdx.x; asm volatile("" : "+v"(tid));
    const int wid = __builtin_amdgcn_readfirstlane(tid >> 6), lane = tid & 63, wr = wid >> 2, wc = wid & 3, fr = lane & 15, fq = lane >> 4;
    const int nt = K / BK;
    constexpr bool GA = Sched::GATHER;
    unsigned voffA[2], voffB[2]; int gR[2]; unsigned gC[2];
#pragma unroll
    for (int i = 0; i < 2; ++i) { int R, C; stage_rc(tid * 16 + i * 8192, R, C); const int Rb = (R & ~31) + perm32(R & 31);
        voffA[i] = (unsigned)(R * lda + C) * 2u; voffB[i] = (unsigned)(Rb * ldb + C) * 2u; gR[i] = R; gC[i] = (unsigned)C * 2u; }
    unsigned gv[2][2] = {{0u, 0u}, {0u, 0u}}, gn[2][2] = {{0u, 0u}, {0u, 0u}};
    LAS const unsigned* gtab = (LAS const unsigned*)(lds + GTAB_OFF);
#define PG8_GLOAD(dst, uidx) do { _Pragma("unroll") for (int h_ = 0; h_ < 2; ++h_) _Pragma("unroll") for (int i_ = 0; i_ < 2; ++i_) dst[h_][i_] = gtab[(uidx) * 256 + h_ * 128 + gR[i_]] + gC[i_]; } while (0)
#define PG8_STAGE_A(bufoff, ptr, h, nx) do { if constexpr (GA) { unsigned vo_[2] = {(nx) ? gn[h][0] : gv[h][0], (nx) ? gn[h][1] : gv[h][1]}; PG8_STAGE(bufoff, ptr, vo_); } \
        else { PG8_STAGE(bufoff, (ptr) + (h) * hstepA, voffA); } } while (0)
    const size_t kstep = (size_t)(BK * 2);
    const size_t hstepA = (size_t)HALF * lda * 2, hstepB = (size_t)HALF * ldb * 2;
    const unsigned ldsw = (unsigned)wid * 1024u;
    const int aoff = lds_byte(wr * 64 + fr, fq * 8), boff = lds_byte(wc * 32 + fr, fq * 8);
#define PG8_SA(b, h) (((b) * 2 + (h)) * HTB)
#define PG8_SB(b, h) ((4 + (b) * 2 + (h)) * HTB)
#define PG8_STAGE(bufoff, gbase, voff) do { _Pragma("unroll") for (int _i = 0; _i < 2; ++_i) \
        __builtin_amdgcn_global_load_lds((const unsigned*)((const char*)(gbase) + (voff)[_i]), (LAS unsigned*)(lds + (bufoff) + ldsw + _i * 8192), 16, 0, 0); } while (0)
#define PG8_LDA(dst, b, h) do { _Pragma("unroll") for (int m = 0; m < 4; ++m) _Pragma("unroll") for (int k = 0; k < 2; ++k) dst[m][k] = *(const LAS bf16x8*)(lds + PG8_SA(b, h) + aoff + m * 2048 + k * 1024); } while (0)
#define PG8_LDB(dst, b, h) do { _Pragma("unroll") for (int n = 0; n < 2; ++n) _Pragma("unroll") for (int k = 0; k < 2; ++k) dst[n][k] = *(const LAS bf16x8*)(lds + PG8_SB(b, h) + boff + n * 2048 + k * 1024); } while (0)
#define PG8_MMA(ai, bj, At, Bt) do { __builtin_amdgcn_s_setprio(1); _Pragma("unroll") for (int m = 0; m < 4; ++m) _Pragma("unroll") for (int n = 0; n < 2; ++n) _Pragma("unroll") for (int k = 0; k < 2; ++k) \
        { if constexpr (Epi::I8) acc[ai][bj][m][n] = __builtin_bit_cast(f32x4, __builtin_amdgcn_mfma_i32_16x16x64_i8(__builtin_bit_cast(i32x4, Bt[n][k]), __builtin_bit_cast(i32x4, At[m][k]), __builtin_bit_cast(i32x4, acc[ai][bj][m][n]), 0, 0, 0)); \
          else acc[ai][bj][m][n] = __builtin_amdgcn_mfma_f32_16x16x32_bf16(Bt[n][k], At[m][k], acc[ai][bj][m][n], 0, 0, 0); } __builtin_amdgcn_s_setprio(0); } while (0)
#define PG8_WAIT_V(n) asm volatile("s_waitcnt vmcnt(" #n ")" ::: "memory")
#define PG8_WAIT_L(n) asm volatile("s_waitcnt lgkmcnt(" #n ")" ::: "memory")
#define PG8_BAR __builtin_amdgcn_s_barrier()
#define PG8_SCHED __builtin_amdgcn_sched_barrier(0)
    Unit cur, nxt; int ui = 0;
    if (!S.next(0, cur)) return;
    f32x4 acc[2][2][4][2];
#pragma unroll
    for (int a = 0; a < 2; ++a)
#pragma unroll
        for (int b = 0; b < 2; ++b)
#pragma unroll
            for (int m = 0; m < 4; ++m)
#pragma unroll
                for (int n = 0; n < 2; ++n) acc[a][b][m][n] = (f32x4){0.f, 0.f, 0.f, 0.f};
    bf16x8 At[4][2], B0[2][2], B1[2][2];
    const char* cA = S.pa(cur); const char* cB = S.pb(cur);
    if constexpr (GA) { PG8_GLOAD(gv, 0); }
    PG8_STAGE(PG8_SB(0, 0), cB, voffB); PG8_STAGE_A(PG8_SA(0, 0), cA, 0, false); PG8_STAGE(PG8_SB(0, 1), cB + hstepB, voffB); PG8_STAGE_A(PG8_SA(0, 1), cA, 1, false);
    if (wr == 1) PG8_BAR;
    PG8_WAIT_V(4); PG8_BAR;
    PG8_STAGE(PG8_SB(1, 0), cB + kstep, voffB); PG8_STAGE_A(PG8_SA(1, 0), cA + kstep, 0, false); PG8_STAGE(PG8_SB(1, 1), cB + hstepB + kstep, voffB);
    PG8_WAIT_V(6); PG8_BAR;
    for (;;) {
        const bool has_next = S.next(ui + 1, nxt);
        const char* nA = has_next ? S.pa(nxt) : cA; const char* nB = has_next ? S.pb(nxt) : cB;
        if constexpr (GA) { if (has_next) { PG8_GLOAD(gn, ui + 1); } else {
#pragma unroll
                for (int h_ = 0; h_ < 2; ++h_) { gn[h_][0] = gv[h_][0]; gn[h_][1] = gv[h_][1]; } }
            asm volatile("" : "+v"(gn[0][0]), "+v"(gn[0][1]), "+v"(gn[1][0]), "+v"(gn[1][1])); }
        for (int t = 0; t < nt; t += 2) {
            const bool last = (t == nt - 2);
            if constexpr (Epi::HAS_MID) { if (t == Epi::MID1 || t == Epi::MID2) { int frM = fr, fqM = fq; asm volatile("" : "+v"(frM), "+v"(fqM)); E.mid(acc, cur, t, wr, wc, frM, fqM); } }
            const char* a1 = cA + (size_t)(t + 1) * kstep;
            const char* a2 = last ? nA : cA + (size_t)(t + 2) * kstep; const char* b2 = last ? nB : cB + (size_t)(t + 2) * kstep;
            const char* a3 = a2 + kstep; const char* b3 = b2 + kstep;
            PG8_LDB(B0, 0, 0); PG8_SCHED; PG8_LDA(At, 0, 0); PG8_STAGE_A(PG8_SA(1, 1), a1, 1, false);
            PG8_WAIT_L(8); PG8_BAR; PG8_WAIT_L(0); PG8_MMA(0, 0, At, B0); PG8_BAR; PG8_SCHED;
            PG8_LDB(B1, 0, 1); PG8_STAGE(PG8_SB(0, 0), b2, voffB);
            PG8_BAR; PG8_WAIT_L(0); PG8_MMA(0, 1, At, B1); PG8_BAR;
            PG8_LDA(At, 0, 1); PG8_STAGE_A(PG8_SA(0, 0), a2, 0, last);
            PG8_BAR; PG8_WAIT_L(0); PG8_MMA(1, 0, At, B0); PG8_BAR; PG8_SCHED;
            PG8_STAGE(PG8_SB(0, 1), b2 + hstepB, voffB);
            PG8_WAIT_V(6); PG8_BAR; PG8_MMA(1, 1, At, B1); PG8_BAR;
            PG8_LDB(B0, 1, 0); PG8_SCHED; PG8_LDA(At, 1, 0); PG8_STAGE_A(PG8_SA(0, 1), a2, 1, last);
            PG8_WAIT_L(8); PG8_BAR; PG8_WAIT_L(0); PG8_MMA(0, 0, At, B0); PG8_BAR; PG8_SCHED;
            PG8_LDB(B1, 1, 1); PG8_STAGE(PG8_SB(1, 0), b3, voffB);
            PG8_BAR; PG8_WAIT_L(0); PG8_MMA(0, 1, At, B1); PG8_BAR;
            PG8_LDA(At, 1, 1); PG8_STAGE_A(PG8_SA(1, 0), a3, 0, last);
            PG8_BAR; PG8_WAIT_L(0); PG8_MMA(1, 0, At, B0); PG8_BAR; PG8_SCHED;
            PG8_STAGE(PG8_SB(1, 1), b3 + hstepB, voffB);
            PG8_WAIT_V(6); PG8_BAR; PG8_MMA(1, 1, At, B1); PG8_BAR;
        }
        { int frE = fr, fqE = fq; asm volatile("" : "+v"(frE), "+v"(fqE)); E(acc, cur, wr, wc, frE, fqE); }
        if (!has_next) break;
#pragma unroll
        for (int a = 0; a < 2; ++a)
#pragma unroll
            for (int b = 0; b < 2; ++b)
#pragma unroll
                for (int m = 0; m < 4; ++m)
#pragma unroll
                    for (int n = 0; n < 2; ++n) acc[a][b][m][n] = (f32x4){0.f, 0.f, 0.f, 0.f};
        cur = nxt; cA = nA; cB = nB; ++ui;
        if constexpr (GA) {
#pragma unroll
            for (int h_ = 0; h_ < 2; ++h_) { gv[h_][0] = gn[h_][0]; gv[h_][1] = gn[h_][1]; } }
    }
    PG8_WAIT_V(0);
    if (wr == 0) PG8_BAR;
    PG8_BAR;
#undef PG8_SA
#undef PG8_SB
#undef PG8_STAGE
#undef PG8_STAGE_A
#undef PG8_GLOAD
#undef PG8_LDA
#undef PG8_LDB
#undef PG8_MMA
#undef PG8_WAIT_V
#undef PG8_WAIT_L
#undef PG8_BAR
#undef PG8_SCHED
}

#define EPI_LOOP_ROWS _Pragma("unroll") for (int ai = 0; ai < 2; ++ai) _Pragma("unroll") for (int m = 0; m < 4; ++m)
__device__ __forceinline__ void st_bf16x8(bf16_t* p, f32x4 v0, f32x4 v1) { u32x4 w; w.x = cvtpk(v0[0], v0[1]); w.y = cvtpk(v0[2], v0[3]); w.z = cvtpk(v1[0], v1[1]); w.w = cvtpk(v1[2], v1[3]); *(u32x4*)p = w; }

template <bool I8_> struct EpiInProj {
    static constexpr bool HAS_MID = false; static constexpr bool I8 = I8_;
    bf16_t* qa; bf16_t* qidx; bf16_t* qkv; bf16_t* gates; float* small_; const float* xs; const unsigned* wmaxbits;
    __device__ __forceinline__ f32x4 val(const f32x4& a, float sc) const { if constexpr (I8_) { const i32x4 v = __builtin_bit_cast(i32x4, a); return (f32x4){(float)v[0], (float)v[1], (float)v[2], (float)v[3]} * sc; } else return a; }
    __device__ __forceinline__ void operator()(const f32x4 (&acc)[2][2][4][2], const Unit& u, int wr, int wc, int fr, int fq) const {
        const int pn = u.pn, row0 = u.pm * BM + wr * 64 + fr, lc0 = wc * 32 + fq * 8;
        float sw = 0.f; if constexpr (I8_) sw = __uint_as_float(*wmaxbits) * (1.3f / 127.0f);
        float scs[2][4];
#pragma unroll
        for (int ai = 0; ai < 2; ++ai)
#pragma unroll
            for (int m = 0; m < 4; ++m) { scs[ai][m] = 0.f; if constexpr (I8_) scs[ai][m] = xs[row0 + ai * HALF + m * 16] * sw; }
        if (pn < 8) {
            bf16_t* base = (pn < 4 ? qa + pn * 256 : qidx + (pn - 4) * 256) + lc0;
            EPI_LOOP_ROWS { const int row = row0 + ai * HALF + m * 16; const float sc = scs[ai][m];
#pragma unroll
                for (int bj = 0; bj < 2; ++bj) st_bf16x8(base + (size_t)row * 1024 + bj * HALF, val(acc[ai][bj][m][0], sc), val(acc[ai][bj][m][1], sc)); }
        } else if (pn < 32) {
            const int id = (pn - 8) >> 2, hb = ((pn - 8) & 3) * 2, b = u.pm >> 5;
            bf16_t* base = qkv + (size_t)id * ((size_t)NTOK * 1024) + lc0;
            EPI_LOOP_ROWS { const int row = row0 + ai * HALF + m * 16, s = row & (SEQ - 1); const float sc = scs[ai][m];
#pragma unroll
                for (int bj = 0; bj < 2; ++bj) st_bf16x8(base + ((size_t)(b * 8 + hb + bj) * SEQ + s) * 128, val(acc[ai][bj][m][0], sc), val(acc[ai][bj][m][1], sc)); }
        } else if (pn < 56) {
            unsigned char* base = (unsigned char*)gates + (pn - 32) * 256 + lc0;
            EPI_LOOP_ROWS { const int row = row0 + ai * HALF + m * 16; const float sc = scs[ai][m];
#pragma unroll
                for (int bj = 0; bj < 2; ++bj) { const f32x4 v0 = val(acc[ai][bj][m][0], sc), v1 = val(acc[ai][bj][m][1], sc); u32x2 w; unsigned p0 = 0u, p1 = 0u;
#pragma unroll
                    for (int j = 0; j < 4; ++j) { p0 |= (unsigned)(int)fmaxf(rintf(255.0f * sigmoidf_(v0[j])), 1.0f) << (8 * j); p1 |= (unsigned)(int)fmaxf(rintf(255.0f * sigmoidf_(v1[j])), 1.0f) << (8 * j); }
                    w.x = p0; w.y = p1; *(u32x2*)(base + (size_t)row * 6144 + bj * HALF) = w; } }
        } else {
            float* base = small_ + (pn - 56) * 256 + lc0;
            EPI_LOOP_ROWS { const int row = row0 + ai * HALF + m * 16; const float sc = scs[ai][m];
#pragma unroll
                for (int bj = 0; bj < 2; ++bj) { float* p = base + (size_t)row * 512 + bj * HALF; *(f32x4*)p = val(acc[ai][bj][m][0], sc); *(f32x4*)(p + 4) = val(acc[ai][bj][m][1], sc); } }
        }
    }
};
struct EpiBf16 {
    static constexpr bool HAS_MID = false; static constexpr bool I8 = false;
    bf16_t* out; int ld, cstep;
    __device__ __forceinline__ void operator()(const f32x4 (&acc)[2][2][4][2], const Unit& u, int wr, int wc, int fr, int fq) const {
        const int row0 = u.pm * BM + wr * 64 + fr; bf16_t* base = out + (size_t)u.pn * cstep + wc * 32 + fq * 8;
        EPI_LOOP_ROWS { const int row = row0 + ai * HALF + m * 16;
#pragma unroll
            for (int bj = 0; bj < 2; ++bj) st_bf16x8(base + (size_t)row * ld + bj * HALF, acc[ai][bj][m][0], acc[ai][bj][m][1]); }
    }
};
struct EpiBranch3 {
    static constexpr bool HAS_MID = true; static constexpr bool I8 = false; static constexpr int MID1 = 16, MID2 = 32;
    const unsigned char* gates; bf16_t* merged;
    __device__ __forceinline__ static f32x4 rat(unsigned n, unsigned d) {
        f32x4 r; r[0] = (float)(n & 255u) * __builtin_amdgcn_rcpf((float)(d & 255u)); r[1] = (float)((n >> 8) & 255u) * __builtin_amdgcn_rcpf((float)((d >> 8) & 255u));
        r[2] = (float)((n >> 16) & 255u) * __builtin_amdgcn_rcpf((float)((d >> 16) & 255u)); r[3] = (float)(n >> 24) * __builtin_amdgcn_rcpf((float)(d >> 24)); return r; }
    __device__ __forceinline__ void mid(f32x4 (&acc)[2][2][4][2], const Unit& u, int t, int wr, int wc, int fr, int fq) const {
        const int row0 = u.pm * BM + wr * 64 + fr, col0 = u.pn * BM + wc * 32 + fq * 8, bn = (t == MID1) ? 0 : 2048;
        u32x2 gn[2][4][2], gd[2][4][2];
        EPI_LOOP_ROWS {
#pragma unroll
            for (int bj = 0; bj < 2; ++bj) { const unsigned char* gp = gates + (size_t)(row0 + ai * HALF + m * 16) * 6144 + bn + col0 + bj * HALF; gn[ai][m][bj] = *(const u32x2*)gp; gd[ai][m][bj] = *(const u32x2*)(gp + 2048); } }
        EPI_LOOP_ROWS {
#pragma unroll
            for (int bj = 0; bj < 2; ++bj) { acc[ai][bj][m][0] *= rat(gn[ai][m][bj].x, gd[ai][m][bj].x); acc[ai][bj][m][1] *= rat(gn[ai][m][bj].y, gd[ai][m][bj].y); } }
    }
    __device__ __forceinline__ void operator()(const f32x4 (&acc)[2][2][4][2], const Unit& u, int wr, int wc, int fr, int fq) const {
        const int row0 = u.pm * BM + wr * 64 + fr, col0 = u.pn * BM + wc * 32 + fq * 8;
        u32x2 gl[2][4][2];
        EPI_LOOP_ROWS {
#pragma unroll
            for (int bj = 0; bj < 2; ++bj) gl[ai][m][bj] = *(const u32x2*)(gates + (size_t)(row0 + ai * HALF + m * 16) * 6144 + 4096 + col0 + bj * HALF); }
        EPI_LOOP_ROWS { const int row = row0 + ai * HALF + m * 16;
#pragma unroll
            for (int bj = 0; bj < 2; ++bj) { const int col = col0 + bj * HALF; const u32x2 gw = gl[ai][m][bj]; constexpr float I255 = 1.0f / 255.0f;
                f32x4 v0 = acc[ai][bj][m][0], v1 = acc[ai][bj][m][1];
                v0[0] *= (float)(gw.x & 255u) * I255; v0[1] *= (float)((gw.x >> 8) & 255u) * I255; v0[2] *= (float)((gw.x >> 16) & 255u) * I255; v0[3] *= (float)(gw.x >> 24) * I255;
                v1[0] *= (float)(gw.y & 255u) * I255; v1[1] *= (float)((gw.y >> 8) & 255u) * I255; v1[2] *= (float)((gw.y >> 16) & 255u) * I255; v1[3] *= (float)(gw.y >> 24) * I255;
                st_bf16x8(merged + (size_t)row * 2048 + col, v0, v1); } }
    }
};
struct EpiOut {
    static constexpr bool HAS_MID = false; static constexpr bool I8 = false;
    const bf16_t* res; bf16_t* pre;
    __device__ __forceinline__ void operator()(const f32x4 (&acc)[2][2][4][2], const Unit& u, int wr, int wc, int fr, int fq) const {
        const int row0 = u.pm * BM + wr * 64 + fr, col0 = u.pn * BM + wc * 32 + fq * 8;
        u32x4 rl[2][4][2];
        EPI_LOOP_ROWS { const int row = row0 + ai * HALF + m * 16;
#pragma unroll
            for (int bj = 0; bj < 2; ++bj) rl[ai][m][bj] = *(const u32x4*)(res + (size_t)row * 2048 + col0 + bj * HALF); }
        EPI_LOOP_ROWS { const int row = row0 + ai * HALF + m * 16;
#pragma unroll
            for (int bj = 0; bj < 2; ++bj) { const size_t o = (size_t)row * 2048 + col0 + bj * HALF;
                const u32x4 rw = rl[ai][m][bj]; f32x4 v0 = acc[ai][bj][m][0], v1 = acc[ai][bj][m][1];
                v0[0] += ALPHA * bflo(rw.x); v0[1] += ALPHA * bfhi(rw.x); v0[2] += ALPHA * bflo(rw.y); v0[3] += ALPHA * bfhi(rw.y);
                v1[0] += ALPHA * bflo(rw.z); v1[1] += ALPHA * bfhi(rw.z); v1[2] += ALPHA * bflo(rw.w); v1[3] += ALPHA * bfhi(rw.w);
                st_bf16x8(pre + o, v0, v1); } }
    }
};
struct EpiGateUpI8 {
    static constexpr bool HAS_MID = false; static constexpr bool I8 = true;
    const float* bg; const float* bu; bf16_t* hid; const float* rowsx; const unsigned* wmaxbits; float* hm;
    __device__ __forceinline__ void operator()(const f32x4 (&acc)[2][2][4][2], const Unit& u, int wr, int wc, int fr, int fq) const {
        const int row0 = u.pm * BM + wr * 64 + fr, j0 = u.pn * 128 + wc * 32 + fq * 8;
        const float sw = __uint_as_float(*wmaxbits) * (1.3f / 127.0f);
        const float* pg = bg + (size_t)u.e * DEXP + j0; const float* pu = bu + (size_t)u.e * DEXP + j0;
        const f32x4 g0b = *(const f32x4*)pg, g1b = *(const f32x4*)(pg + 4), u0b = *(const f32x4*)pu, u1b = *(const f32x4*)(pu + 4);
        float scs[2][4];
#pragma unroll
        for (int ai = 0; ai < 2; ++ai)
#pragma unroll
            for (int m = 0; m < 4; ++m) scs[ai][m] = rowsx[row0 + ai * HALF + m * 16] * sw;
        EPI_LOOP_ROWS { const int row = row0 + ai * HALF + m * 16; const float sc = scs[ai][m];
            const i32x4 ag0 = __builtin_bit_cast(i32x4, acc[ai][0][m][0]), ag1 = __builtin_bit_cast(i32x4, acc[ai][0][m][1]), au0 = __builtin_bit_cast(i32x4, acc[ai][1][m][0]), au1 = __builtin_bit_cast(i32x4, acc[ai][1][m][1]);
            f32x4 h0, h1;
#pragma unroll
            for (int j = 0; j < 4; ++j) {
                float g = fminf((float)ag0[j] * sc + g0b[j], 7.0f), uu = fminf(fmaxf((float)au0[j] * sc + u0b[j], -7.0f), 7.0f);
                h0[j] = (uu + 1.0f) * (g * sigmoidf_(1.702f * g));
                g = fminf((float)ag1[j] * sc + g1b[j], 7.0f); uu = fminf(fmaxf((float)au1[j] * sc + u1b[j], -7.0f), 7.0f);
                h1[j] = (uu + 1.0f) * (g * sigmoidf_(1.702f * g)); }
            st_bf16x8(hid + (size_t)row * DEXP + j0, h0, h1);
            float am = fmaxf(fmaxf(fmaxf(fabsf(h0[0]), fabsf(h0[1])), fmaxf(fabsf(h0[2]), fabsf(h0[3]))), fmaxf(fmaxf(fabsf(h1[0]), fabsf(h1[1])), fmaxf(fabsf(h1[2]), fabsf(h1[3]))));
            am = fmaxf(am, __shfl_xor(am, 16)); am = fmaxf(am, __shfl_xor(am, 32));
            if (fq == 0) hm[(size_t)row * 32 + u.pn * 4 + wc] = am; }
    }
};
struct EpiDown {
    static constexpr bool HAS_MID = false; static constexpr bool I8 = false;
    const float* bd; const float* roww; bf16_t* ys;
    __device__ __forceinline__ void operator()(const f32x4 (&acc)[2][2][4][2], const Unit& u, int wr, int wc, int fr, int fq) const {
        const int row0 = u.pm * BM + wr * 64 + fr, col0 = u.pn * BM + wc * 32 + fq * 8;
        f32x4 b[2][2];
#pragma unroll
        for (int bj = 0; bj < 2; ++bj) { const float* p = bd + (size_t)u.e * DM + col0 + bj * HALF; b[bj][0] = *(const f32x4*)p; b[bj][1] = *(const f32x4*)(p + 4); }
        float rws[2][4];
#pragma unroll
        for (int ai = 0; ai < 2; ++ai)
#pragma unroll
            for (int m = 0; m < 4; ++m) rws[ai][m] = roww[row0 + ai * HALF + m * 16];
        EPI_LOOP_ROWS { const int row = row0 + ai * HALF + m * 16; const float w = rws[ai][m];
#pragma unroll
            for (int bj = 0; bj < 2; ++bj) st_bf16x8(ys + (size_t)row * 2048 + col0 + bj * HALF, (acc[ai][bj][m][0] + b[bj][0]) * w, (acc[ai][bj][m][1] + b[bj][1]) * w); }
    }
};
struct EpiDownI8 {
    static constexpr bool HAS_MID = false; static constexpr bool I8 = true;
    const float* bd; const float* roww; bf16_t* ys; const float* h8s; const unsigned* wmaxbits;
    __device__ __forceinline__ void operator()(const f32x4 (&acc)[2][2][4][2], const Unit& u, int wr, int wc, int fr, int fq) const {
        const int row0 = u.pm * BM + wr * 64 + fr, col0 = u.pn * BM + wc * 32 + fq * 8;
        const float sw = __uint_as_float(*wmaxbits) * (1.3f / 127.0f);
        f32x4 b[2][2];
#pragma unroll
        for (int bj = 0; bj < 2; ++bj) { const float* p = bd + (size_t)u.e * DM + col0 + bj * HALF; b[bj][0] = *(const f32x4*)p; b[bj][1] = *(const f32x4*)(p + 4); }
        float rws[2][4], scs[2][4];
#pragma unroll
        for (int ai = 0; ai < 2; ++ai)
#pragma unroll
            for (int m = 0; m < 4; ++m) { rws[ai][m] = roww[row0 + ai * HALF + m * 16]; scs[ai][m] = h8s[row0 + ai * HALF + m * 16] * sw; }
        EPI_LOOP_ROWS { const int row = row0 + ai * HALF + m * 16; const float w = rws[ai][m], sc = scs[ai][m];
#pragma unroll
            for (int bj = 0; bj < 2; ++bj) { const i32x4 a0 = __builtin_bit_cast(i32x4, acc[ai][bj][m][0]), a1 = __builtin_bit_cast(i32x4, acc[ai][bj][m][1]);
                const f32x4 v0 = (f32x4){(float)a0[0], (float)a0[1], (float)a0[2], (float)a0[3]} * sc, v1 = (f32x4){(float)a1[0], (float)a1[1], (float)a1[2], (float)a1[3]} * sc;
                st_bf16x8(ys + (size_t)row * 2048 + col0 + bj * HALF, (v0 + b[bj][0]) * w, (v1 + b[bj][1]) * w); } }
    }
};
struct EpiPleGateI8 {
    static constexpr bool HAS_MID = false; static constexpr bool I8 = true;
    const bf16_t* hb; const bf16_t* pp; bf16_t* pre; const float* hs; const unsigned* wmaxbits;
    __device__ __forceinline__ void operator()(const f32x4 (&acc)[2][2][4][2], const Unit& u, int wr, int wc, int fr, int fq) const {
        const int row0 = u.pm * BM + wr * 64 + fr, col0 = u.pn * BM + wc * 32 + fq * 8;
        const float sw = __uint_as_float(*wmaxbits) * (1.3f / 127.0f);
#pragma unroll
        for (int ai = 0; ai < 2; ++ai) { u32x4 pl[4][2], hl[4][2]; float scs[4];
#pragma unroll
            for (int m = 0; m < 4; ++m) { scs[m] = hs[row0 + ai * HALF + m * 16] * sw;
#pragma unroll
                for (int bj = 0; bj < 2; ++bj) { const size_t o = (size_t)(row0 + ai * HALF + m * 16) * 2048 + col0 + bj * HALF; pl[m][bj] = *(const u32x4*)(pp + o); hl[m][bj] = *(const u32x4*)(hb + o); } }
#pragma unroll
            for (int m = 0; m < 4; ++m) { const float sc = scs[m];
#pragma unroll
                for (int bj = 0; bj < 2; ++bj) { const size_t o = (size_t)(row0 + ai * HALF + m * 16) * 2048 + col0 + bj * HALF; const u32x4 pw = pl[m][bj], hw = hl[m][bj];
                    const i32x4 a0 = __builtin_bit_cast(i32x4, acc[ai][bj][m][0]), a1 = __builtin_bit_cast(i32x4, acc[ai][bj][m][1]); f32x4 o0, o1;
                    o0[0] = bflo(hw.x) + sigmoidf_((float)a0[0] * sc) * bflo(pw.x); o0[1] = bfhi(hw.x) + sigmoidf_((float)a0[1] * sc) * bfhi(pw.x); o0[2] = bflo(hw.y) + sigmoidf_((float)a0[2] * sc) * bflo(pw.y); o0[3] = bfhi(hw.y) + sigmoidf_((float)a0[3] * sc) * bfhi(pw.y);
                    o1[0] = bflo(hw.z) + sigmoidf_((float)a1[0] * sc) * bflo(pw.z); o1[1] = bfhi(hw.z) + sigmoidf_((float)a1[1] * sc) * bfhi(pw.z); o1[2] = bflo(hw.w) + sigmoidf_((float)a1[2] * sc) * bflo(pw.w); o1[3] = bfhi(hw.w) + sigmoidf_((float)a1[3] * sc) * bfhi(pw.w);
                    st_bf16x8(pre + o, o0, o1); } } }
    }
};
}

struct Params { const float* in[25]; float* out; unsigned char* ws; int ph_lo, ph_hi; };
__constant__ float c_invf_r[16] = {1.000000000e+00f, 4.403665960e-01f, 1.939227432e-01f, 8.539710194e-02f, 3.760603070e-02f, 1.656043902e-02f, 7.292664610e-03f, 3.211445874e-03f, 1.414213562e-03f, 6.227723788e-04f, 2.742481884e-04f, 1.207697351e-04f, 5.318296098e-05f, 2.341999971e-05f, 1.031338616e-05f, 4.541670478e-06f};
__constant__ float c_invf_i[8] = {1.000000000e+00f, 1.939227432e-01f, 3.760603070e-02f, 7.292664610e-03f, 1.414213562e-03f, 2.742481884e-04f, 5.318296098e-05f, 1.031338616e-05f};
constexpr int LDS_PTRS = LDS_MISC + 256;
struct Frame { unsigned char* lds; LAS unsigned char* ldsl; unsigned char* ws; int tid, lane, wid, G, bid;
    __device__ __forceinline__ const float* in(int k) const { const LAS unsigned* t = (const LAS unsigned*)(ldsl + LDS_PTRS) + 2 * k;
        const unsigned lo = __builtin_amdgcn_readfirstlane(t[0]), hi = __builtin_amdgcn_readfirstlane(t[1]); return (const float*)(const GAS float*)(((unsigned long long)hi << 32) | lo); }
    __device__ __forceinline__ float* out() const { return (float*)in(25); } };
__device__ __forceinline__ Frame fresh(const Frame& F0) { Frame F = F0; int t = threadIdx.x; asm volatile("" : "+v"(t)); F.tid = t; F.lane = t & 63; F.wid = __builtin_amdgcn_readfirstlane(t >> 6); size_t z = 0; asm volatile("" : "+s"(z)); F.ws = F0.ws + z; return F; }

struct TcTile { const float* src; long sld; bf16_t* dst; long dld; int nvalid; float qinv; };
template <class Dec>
__device__ __forceinline__ void tconv_run(const Frame& F, int total, const Dec& dec, int& rot) {
    float* tile = (float*)F.lds;
    const int tid = F.tid, G = F.G;
    const int start = (F.bid - (rot % G) + G) % G; rot += total >> 2;
    const int lr = tid >> 4, lc4 = (tid & 15) * 4, sn = tid >> 3, skc = (tid & 7) * 8;
    f32x4 v[4][2];
#define TC_ISSUE(t0_) do { _Pragma("unroll") for (int q = 0; q < 4; ++q) { const int t = (t0_) * 4 + q; \
        if (t < total) { const TcTile ti = dec(dec.remap(t)); _Pragma("unroll") for (int h = 0; h < 2; ++h) { v[q][h] = (f32x4){0.f, 0.f, 0.f, 0.f}; \
            if (lc4 < ti.nvalid) v[q][h] = *(const GAS f32x4*)((const GAS float*)ti.src + (size_t)(lr + 32 * h) * ti.sld + lc4); } } } } while (0)
    if (start * 4 < total) TC_ISSUE(start);
    for (int t0 = start; t0 * 4 < total; t0 += G) {
#pragma unroll
        for (int q = 0; q < 4; ++q) { if (t0 * 4 + q < total) { float* tl = tile + q * (64 * 65);
#pragma unroll
                for (int h = 0; h < 2; ++h) { float* p = tl + (lr + 32 * h) * 65 + lc4; p[0] = v[q][h][0]; p[1] = v[q][h][1]; p[2] = v[q][h][2]; p[3] = v[q][h][3]; } } }
        __syncthreads();
        if ((t0 + G) * 4 < total) TC_ISSUE(t0 + G);
#pragma unroll
        for (int q = 0; q < 4; ++q) { const int t = t0 * 4 + q;
            if (t < total) { const TcTile ti = dec(dec.remap(t)); const float* tl = tile + q * (64 * 65);
                if (ti.qinv > 0.f) { if (tid < 256) { const int n8 = tid >> 2, kc = (tid & 3) * 16; u32x4 w;
#pragma unroll
                        for (int d = 0; d < 4; ++d) { unsigned pk = 0u;
#pragma unroll
                            for (int j = 0; j < 4; ++j) { float q = rintf(tl[(kc + d * 4 + j) * 65 + n8] * ti.qinv); q = fminf(fmaxf(q, -127.f), 127.f); pk |= ((unsigned)(int)q & 0xffu) << (8 * j); }
                            w[d] = pk; }
                        *(u32x4*)((unsigned char*)ti.dst + (size_t)n8 * ti.dld + kc) = w; } }
                else if (sn < ti.nvalid) { f32x4 a, b;
#pragma unroll
                    for (int j = 0; j < 4; ++j) { a[j] = tl[(skc + j) * 65 + sn]; b[j] = tl[(skc + 4 + j) * 65 + sn]; }
                    pg8::st_bf16x8(ti.dst + (size_t)sn * ti.dld + skc, a, b); } } }
        __syncthreads();
    }
#undef TC_ISSUE
}
struct TcMat {
    const float* src; long src_ld; int tk, ncols; bf16_t* dst; long dst_ld; float qinv;
    __device__ __forceinline__ int remap(int i) const { const int ntn = (ncols + 63) >> 6; if (ntn & 1) return i;
        const int g = i >> 2, q = i & 3, tkh = tk >> 1, gk = g % tkh, gn = g / tkh; return (2 * gn + (q >> 1)) * tk + 2 * gk + (q & 1); }
    __device__ __forceinline__ TcTile operator()(int t) const { const int k0 = (t % tk) * 64, n0 = (t / tk) * 64; TcTile ti;
        ti.src = src + (size_t)k0 * src_ld + n0; ti.sld = src_ld; ti.dst = qinv > 0.f ? (bf16_t*)((unsigned char*)dst + (size_t)n0 * dst_ld + k0) : dst + (size_t)n0 * dst_ld + k0; ti.dld = dst_ld; ti.nvalid = (ncols - n0) < 64 ? (ncols - n0) : 64; ti.qinv = qinv; return ti; }
};
__device__ __forceinline__ void tconv(const Frame& F, const float* src, long src_ld, int K, int ncols, bf16_t* dst, long dst_ld, int& rot) {
    TcMat d{src, src_ld, K >> 6, ncols, dst, dst_ld, 0.f}; tconv_run(F, (K >> 6) * ((ncols + 63) >> 6), d, rot);
}
struct TcExperts {
    const float* wg; const float* wu; const float* wd; unsigned char* dgu; unsigned char* ddn; float qinv, qinvd;
    __device__ __forceinline__ int remap(int i) const { const int e = i / 1536, ri = i - e * 1536;
        if (ri < 1024) { const int g = ri >> 2, q = ri & 3, gk = g & 15, gn = g >> 4; return e * 1536 + (2 * gn + (q >> 1)) * 32 + 2 * gk + (q & 1); }
        const int r2 = ri - 1024, g = r2 >> 2, q = r2 & 3, gk = g & 7, gn = g >> 3; return e * 1536 + 1024 + (2 * gn + (q >> 1)) * 16 + 2 * gk + (q & 1); }
    __device__ __forceinline__ TcTile operator()(int t) const { const int e = t / 1536, r = t - e * 1536; TcTile ti; ti.nvalid = 64; ti.qinv = 0.f;
        if (r < 1024) { const int k0 = (r & 31) * 64, dt = r >> 5, jb = dt >> 2, gu = (dt >> 1) & 1, half = dt & 1;
            ti.src = (const float*)((unsigned long long)wg + (unsigned long long)gu * ((unsigned long long)wu - (unsigned long long)wg)) + (size_t)e * DM * DEXP + (size_t)k0 * DEXP + jb * 128 + half * 64; ti.sld = DEXP;
            ti.dst = (bf16_t*)(dgu + (size_t)e * 2048 * 2048 + (size_t)(dt * 64) * 2048 + k0); ti.dld = 2048; ti.qinv = qinv; }
        else { const int r2 = r - 1024, k0 = (r2 & 15) * 64, n0 = (r2 >> 4) * 64;
            ti.src = wd + (size_t)e * DEXP * DM + (size_t)k0 * DM + n0; ti.sld = DM;
            ti.dst = (bf16_t*)(ddn + (size_t)e * 2048 * 1024 + (size_t)n0 * 1024 + k0); ti.dld = 1024; ti.qinv = qinvd; }
        return ti; }
};
__device__ __forceinline__ void sample_wmax(const Frame& F) {
    unsigned* wm = (unsigned*)(F.ws + WS_CTL) + CW_WMAX;
#pragma unroll 1
    for (int l = 0; l < NLAYER; ++l) { float mx = 0.f;
#pragma unroll 1
        for (int which = 0; which < 2; ++which) { const f32x4* p = (const f32x4*)(F.in(which ? 17 : 15) + (size_t)l * NEXP * DM * DEXP);
            for (size_t i = (size_t)F.bid * 512 + F.tid; i < (size_t)NEXP * DM * DEXP / 4 / 64; i += (size_t)F.G * 512) { const size_t j = i >> 3; const f32x4 v = p[j * 512 + 8 * (j & 63) + (i & 7)];
                mx = fmaxf(mx, fmaxf(fmaxf(fabsf(v[0]), fabsf(v[1])), fmaxf(fabsf(v[2]), fabsf(v[3])))); } }
        for (int o = 32; o > 0; o >>= 1) mx = fmaxf(mx, __shfl_xor(mx, o));
        if (F.lane == 0 && mx > 0.f) atomicMax(&wm[l], __float_as_uint(mx));
        float mg = 0.f; const f32x4* wi_ = (const f32x4*)(F.in(2) + (size_t)l * DM * INW);
        for (int i = F.bid * 512 + F.tid; i < DM * (INW / 4) / 16; i += F.G * 512) { const size_t j = (size_t)(i >> 3); const f32x4 v = wi_[j * 128 + 8 * (j & 15) + (i & 7)];
            mg = fmaxf(mg, fmaxf(fmaxf(fabsf(v[0]), fabsf(v[1])), fmaxf(fabsf(v[2]), fabsf(v[3])))); }
        for (int o = 32; o > 0; o >>= 1) mg = fmaxf(mg, __shfl_xor(mg, o));
        if (F.lane == 0 && mg > 0.f) atomicMax(&wm[CW_WMAXG - CW_WMAX + l], __float_as_uint(mg));
        float mp = 0.f; const f32x4* wp_ = (const f32x4*)(F.in(21) + (size_t)l * DM * DM);
        for (int i = F.bid * 512 + F.tid; i < DM * DM / 4 / 16; i += F.G * 512) { const int j = i >> 3; const f32x4 v = wp_[j * 128 + 8 * (j & 15) + (i & 7)];
            mp = fmaxf(mp, fmaxf(fmaxf(fabsf(v[0]), fabsf(v[1])), fmaxf(fabsf(v[2]), fabsf(v[3])))); }
        for (int o = 32; o > 0; o >>= 1) mp = fmaxf(mp, __shfl_xor(mp, o));
        if (F.lane == 0 && mp > 0.f) atomicMax(&wm[CW_WMAXP - CW_WMAX + l], __float_as_uint(mp));
        float md = 0.f; const f32x4* wd_ = (const f32x4*)(F.in(19) + (size_t)l * NEXP * DEXP * DM);
        for (size_t i = (size_t)F.bid * 512 + F.tid; i < (size_t)NEXP * DEXP * DM / 4 / 64; i += (size_t)F.G * 512) { const size_t j = i >> 3; const f32x4 v = wd_[j * 512 + 8 * (j & 63) + (i & 7)];
            md = fmaxf(md, fmaxf(fmaxf(fabsf(v[0]), fabsf(v[1])), fmaxf(fabsf(v[2]), fabsf(v[3])))); }
        for (int o = 32; o > 0; o >>= 1) md = fmaxf(md, __shfl_xor(md, o));
        if (F.lane == 0 && md > 0.f) atomicMax(&wm[CW_WMAXD - CW_WMAX + l], __float_as_uint(md)); }
}
__device__ __forceinline__ void conv_rows(const Frame& F, const float* src, bf16_t* dst, size_t n8) {
    for (size_t i = (size_t)F.bid * 512 + F.tid; i < n8; i += (size_t)F.G * 512) { const f32x4 a = *(const f32x4*)(src + i * 8), b = *(const f32x4*)(src + i * 8 + 4); pg8::st_bf16x8(dst + i * 8, a, b); }
}
__device__ __forceinline__ void quant_rows(const Frame& F, const float* src, bf16_t* xb, unsigned char* xq, float* xsc) {
    const int lane = F.lane;
    for (int tok = F.bid * 8 + F.wid; tok < NTOK; tok += F.G * 8) { f32x4 v[8]; float amax = 0.f;
#pragma unroll
        for (int i = 0; i < 4; ++i) { const int c = (i * 64 + lane) * 8; v[2 * i] = *(const f32x4*)(src + (size_t)tok * DM + c); v[2 * i + 1] = *(const f32x4*)(src + (size_t)tok * DM + c + 4);
            pg8::st_bf16x8(xb + (size_t)tok * DM + c, v[2 * i], v[2 * i + 1]);
#pragma unroll
            for (int h = 0; h < 2; ++h)
#pragma unroll
                for (int j = 0; j < 4; ++j) amax = fmaxf(amax, fabsf(v[2 * i + h][j])); }
        for (int o = 32; o > 0; o >>= 1) amax = fmaxf(amax, __shfl_xor(amax, o));
        amax = fmaxf(amax, 1e-20f); const float qi = 127.0f / amax; if (lane == 0) xsc[tok] = amax * (1.0f / 127.0f);
#pragma unroll
        for (int i = 0; i < 4; ++i) { u32x2 w;
#pragma unroll
            for (int h = 0; h < 2; ++h) { unsigned pk = 0u;
#pragma unroll
                for (int j = 0; j < 4; ++j) pk |= ((unsigned)(int)rintf(v[2 * i + h][j] * qi) & 0xffu) << (8 * j);
                w[h] = pk; }
            *(u32x2*)(xq + (size_t)tok * DM + (i * 64 + lane) * 8) = w; } }
}
__constant__ int c_so[14] = {0, 1312, 2416, 3440, 4464, 5496, 6520, 7544, 8568, 1024, 1280, 2336, 2400, 5488};
__constant__ int c_dn[14] = {0, 1024, 2048, 3072, 4096, 5120, 6144, 7168, 8192, 14336, 14592, 14624, 14688, 14704};
__constant__ int c_nc[14] = {1024, 1024, 1024, 1024, 1024, 1024, 1024, 1024, 6144, 256, 32, 64, 16, 8};
__device__ __forceinline__ void convert_layer_weights(const Frame& F0, const Params& P, int l) { const Frame F = fresh(F0);
    unsigned char* ws = F.ws; int rot = 0;
    { const float* w = F.in(2) + (size_t)l * DM * INW; bf16_t* d = (bf16_t*)(ws + W_IN);
      const float wmaxg = __uint_as_float(((const unsigned*)(ws + WS_CTL))[CW_WMAXG + l]); const float qinv = 127.0f / (1.3f * fmaxf(wmaxg, 1e-30f));
#pragma unroll 1
      for (int s = 0; s < 14; ++s) {
          if (s == 1 || s >= 10) tconv(F, w + c_so[s], INW, DM, c_nc[s], d + (size_t)c_dn[s] * DM, DM, rot);
          else { const int crow = (s == 0) ? 0 : (s <= 7 ? 1024 + (s - 2) * 1024 : (s == 8 ? 7168 : 13312));
              TcMat dq{w + c_so[s], INW, DM >> 6, c_nc[s], (bf16_t*)(ws + W_IN8 + (size_t)crow * 2048), 2048, qinv}; tconv_run(F, (DM >> 6) * (c_nc[s] >> 6), dq, rot); } } }
    tconv(F, F.in(7) + (size_t)l * 1024 * DM, DM, 1024, DM, (bf16_t*)(ws + W_BRA), 3072, rot);
    tconv(F, F.in(8) + (size_t)l * 1024 * DM, DM, 1024, DM, (bf16_t*)(ws + W_BRA) + 1024, 3072, rot);
    tconv(F, F.in(9) + (size_t)l * 1024 * DM, DM, 1024, DM, (bf16_t*)(ws + W_BRA) + 2048, 3072, rot);
    tconv(F, F.in(10) + (size_t)l * DM * DM, DM, DM, DM, (bf16_t*)(ws + W_OUT), DM, rot);
    { const float wmp = __uint_as_float(((const unsigned*)(ws + WS_CTL))[CW_WMAXP + l]);
      TcMat dq{F.in(21) + (size_t)l * DM * DM, DM, DM >> 6, DM, (bf16_t*)(ws + W_PG), 2048, 127.0f / (1.3f * fmaxf(wmp, 1e-30f))}; tconv_run(F, (DM >> 6) * (DM >> 6), dq, rot); }
    tconv(F, F.in(22) + (size_t)l * 256 * DM, DM, 256, DM, (bf16_t*)(ws + W_PLE), 256, rot);
#pragma unroll 1
    for (int h = 0; h < 8; ++h) tconv(F, F.in(6) + (size_t)l * 256 * 1024 + h * 128, 1024, 256, 128, (bf16_t*)(ws + W_UV2) + ((size_t)(h >> 1) * 256 + (h & 1) * 128) * 512 + (h & 1) * 256, 512, rot);
    { const float wmax = __uint_as_float(((const unsigned*)(ws + WS_CTL))[CW_WMAX + l]);
      const float wmaxd = __uint_as_float(((const unsigned*)(ws + WS_CTL))[CW_WMAXD + l]);
      TcExperts d{F.in(15) + (size_t)l * NEXP * DM * DEXP, F.in(17) + (size_t)l * NEXP * DM * DEXP, F.in(19) + (size_t)l * NEXP * DEXP * DM, (unsigned char*)(ws + W_GU), (unsigned char*)(ws + W_DN), 127.0f / (1.3f * fmaxf(wmax, 1e-30f)), 127.0f / (1.3f * fmaxf(wmaxd, 1e-30f))};
      tconv_run(F, NEXP * 1536, d, rot); }
    { const float* w = F.in(5) + (size_t)l * 256 * 8 * 96; bf16_t* d = (bf16_t*)(ws + W_UK2);
      for (int i = F.bid * 512 + F.tid; i < 256 * 8 * 96; i += F.G * 512) { const int n = i % 96, h = (i / 96) & 7, r = i / 768; d[((size_t)h * 256 + r) * 256 + (h & 1) * 128 + 32 + n] = f2bf(w[i]); } }
}

__device__ __forceinline__ void rope_cs(float pos, float invf, float& c, float& s) {
    const float a = pos * invf; const double ad = (double)a * 0.15915494309189535; const float fr = (float)(ad - rint(ad));
    s = __builtin_amdgcn_sinf(fr); c = __builtin_amdgcn_cosf(fr);
}
__device__ __forceinline__ void phase_prep(const Frame& F0, const Params& P, int l) { const Frame F = fresh(F0);
    unsigned char* ws = F.ws; const int lane = F.lane;
    const float* smallb = (const float*)(ws + R_SMALL); bf16_t* kcat = (bf16_t*)(ws + R_KCAT); bf16_t* qcat = (bf16_t*)(ws + R_QCAT);
    bf16_t* ki = (bf16_t*)(ws + R_KI); float* wi = (float*)(ws + R_WI); float* lf = (float*)(ws + WS_LF);
    const bf16_t* qa = (const bf16_t*)(ws + R_QA); bf16_t* qidx = (bf16_t*)(ws + R_QIDX);
    const f32x4 gck = *(const f32x4*)(F.in(4) + l * 256 + lane * 4);
    const float bfo = lane < 8 ? F.in(3)[l * 8 + lane] : 0.f;
    const float ifr = c_invf_r[lane & 15], ifi = c_invf_i[lane & 7];
    for (int tok = F.bid * 8 + F.wid; tok < NTOK; tok += F.G * 8) {
        const int s = tok & (SEQ - 1), b = tok >> 13; const float* sm = smallb + (size_t)tok * 512;
        float cr, sr, ci, si; rope_cs((float)s, ifr, cr, sr); rope_cs((float)s, ifi, ci, si);
        { const f32x4 v = *(const f32x4*)(sm + lane * 4); float ss = v[0] * v[0] + v[1] * v[1] + v[2] * v[2] + v[3] * v[3]; ss = wave_sum(ss);
          const float rs = rsqrtf(ss * (1.0f / 256.0f) + 1e-6f); u32x2 w; w.x = cvtpk(v[0] * rs * gck[0], v[1] * rs * gck[1]); w.y = cvtpk(v[2] * rs * gck[2], v[3] * rs * gck[3]);
          *(u32x2*)(kcat + (size_t)tok * 288 + lane * 4) = w; }
        if (lane < 16) { const float x1 = sm[256 + lane], x2 = sm[272 + lane]; kcat[(size_t)tok * 288 + 256 + lane] = f2bf(x1 * cr - x2 * sr); kcat[(size_t)tok * 288 + 272 + lane] = f2bf(x2 * cr + x1 * sr); }
        { float o = sm[288 + lane];
          if (lane < 8) { const float x2 = sm[296 + lane]; o = o * ci - x2 * si; } else if (lane < 16) { const float x1 = sm[288 + lane - 8]; o = o * ci + x1 * si; }
          ki[(size_t)tok * 64 + lane] = f2bf(o); }
        if (lane < 16) wi[(size_t)tok * 16 + lane] = sm[352 + lane] * (1.0f / 32.0f);
        if (lane < 8) { const float f = sm[368 + lane] + bfo; lf[(size_t)(b * 8 + lane) * SEQ + s] = fminf(f, 0.f) - log1pf(__expf(-fabsf(f))); }
#pragma unroll
        for (int pp = 0; pp < 2; ++pp) { const int p = lane + 64 * pp, h = p >> 4, i = p & 15;
            const float x1 = bf2f(qa[(size_t)tok * 1024 + h * 128 + i]), x2 = bf2f(qa[(size_t)tok * 1024 + h * 128 + 16 + i]);
            qcat[(size_t)tok * 2304 + h * 288 + 256 + i] = f2bf(x1 * cr - x2 * sr); qcat[(size_t)tok * 2304 + h * 288 + 272 + i] = f2bf(x2 * cr + x1 * sr); }
#pragma unroll
        for (int pp = 0; pp < 2; ++pp) { const int p = lane + 64 * pp, hh = p >> 3, i = p & 7; bf16_t* q = qidx + (size_t)tok * 1024 + hh * 64;
            const float x1 = bf2f(q[i]), x2 = bf2f(q[8 + i]); q[i] = f2bf(x1 * ci - x2 * si); q[8 + i] = f2bf(x2 * ci + x1 * si); }
    }
    { const bf16_t* kbt = (const bf16_t*)(ws + R_QKV) + (size_t)NTOK * 1024; unsigned* kmx = (unsigned*)(ws + WS_CTL) + CW_KMAX + l * 16;
#pragma unroll 1
      for (int bh = 0; bh < 16; ++bh) { float mx = 0.f;
          for (int r0 = (F.bid * 8 + F.wid) * 4; r0 < SEQ; r0 += F.G * 32) {
              const u32x4 w = *(const u32x4*)(kbt + ((size_t)bh * SEQ + r0 + (lane >> 4)) * 128 + (lane & 15) * 8);
              float ss = bflo(w.x) * bflo(w.x) + bfhi(w.x) * bfhi(w.x) + bflo(w.y) * bflo(w.y) + bfhi(w.y) * bfhi(w.y) + bflo(w.z) * bflo(w.z) + bfhi(w.z) * bfhi(w.z) + bflo(w.w) * bflo(w.w) + bfhi(w.w) * bfhi(w.w);
              ss += __shfl_xor(ss, 1); ss += __shfl_xor(ss, 2); ss += __shfl_xor(ss, 4); ss += __shfl_xor(ss, 8); mx = fmaxf(mx, ss); }
          mx = fmaxf(mx, __shfl_xor(mx, 16)); mx = fmaxf(mx, __shfl_xor(mx, 32));
          if (lane == 0) ((float*)F.lds)[F.wid * 16 + bh] = mx; }
      __syncthreads();
      if (F.tid < 16) { float mx = 0.f;
#pragma unroll
          for (int w = 0; w < 8; ++w) mx = fmaxf(mx, ((const float*)F.lds)[w * 16 + F.tid]);
          const unsigned bits = __float_as_uint(mx);
          if (bits > __hip_atomic_load(&kmx[F.tid], __ATOMIC_RELAXED, __HIP_MEMORY_SCOPE_AGENT)) atomicMax(&kmx[F.tid], bits); }
      __syncthreads(); }
}
__device__ __forceinline__ void phase_cumsum(const Frame& F0) { const Frame F = fresh(F0);
    const int gw = F.bid * 8 + F.wid; if (gw >= 16) return;
    const float* lf = (const float*)(F.ws + WS_LF) + (size_t)gw * SEQ; float* cum = (float*)(F.ws + WS_CUM) + (size_t)gw * SEQ;
    const int lane = F.lane; double tot = 0.0;
#pragma unroll 1
    for (int hb = 0; hb < 2; ++hb) { f32x4 v[16];
#pragma unroll
        for (int j = 0; j < 16; ++j) v[j] = *(const f32x4*)(lf + lane * 128 + hb * 64 + j * 4);
#pragma unroll
        for (int j = 0; j < 16; ++j)
#pragma unroll
            for (int e = 0; e < 4; ++e) tot += (double)v[j][e]; }
    double inc = tot;
    for (int o = 1; o < 64; o <<= 1) { const double n = __shfl_up(inc, o); if (lane >= o) inc += n; }
    double run = inc - tot;
#pragma unroll 1
    for (int hb = 0; hb < 2; ++hb) { f32x4 v[16];
#pragma unroll
        for (int j = 0; j < 16; ++j) v[j] = *(const f32x4*)(lf + lane * 128 + hb * 64 + j * 4);
#pragma unroll
        for (int j = 0; j < 16; ++j) { f32x4 o;
#pragma unroll
            for (int e = 0; e < 4; ++e) { run += (double)v[j][e]; o[e] = (float)run; }
            v[j] = o; }
#pragma unroll
        for (int j = 0; j < 16; ++j) *(f32x4*)(cum + lane * 128 + hb * 64 + j * 4) = v[j]; }
}

__device__ __forceinline__ void idx_unit(const Frame& F, int b, int pi, int half) {
    const int tid = F.tid, lane = F.lane, rho = lane & 31, hh = lane >> 5; unsigned char* ws = F.ws;
    const bf16_t* qidx = (const bf16_t*)(ws + R_QIDX); const bf16_t* ki = (const bf16_t*)(ws + R_KI) + (size_t)b * SEQ * 64; const float* wi = (const float*)(ws + R_WI);
    float* scores = (float*)(ws + R_SCORES) + (size_t)b * SEQ * SEQ;
    LAS unsigned char* kl = F.ldsl;
    const int gl = pi, gh = 127 - pi, nl = (64 * gl + 63) / 128 + 1, nh = (64 * gh + 63) / 128 + 1, tot = nl + nh;
    const int x0 = half ? tot / 2 : 0, x1 = half ? tot : tot / 2;
    bf16x8 af[4][4]; float wv[4][16]; int t0 = 0, curg = -1;
    const int r0 = tid >> 3, p0 = tid & 7;
    const unsigned d0 = (unsigned)(r0 * 128 + ((p0 ^ (r0 & 7)) << 4)), d1 = d0 + 64 * 128;
    u32x4 s0, s1;
    { const int c = x0 < nl ? x0 : x0 - nl; const bf16_t* kp = ki + (size_t)(c * 128) * 64; s0 = *(const u32x4*)(kp + (size_t)r0 * 64 + p0 * 8); s1 = *(const u32x4*)(kp + (size_t)(r0 + 64) * 64 + p0 * 8); }
    __syncthreads();
    *(LAS u32x4*)(kl + d0) = s0; *(LAS u32x4*)(kl + d1) = s1;
    __syncthreads();
    const unsigned rdo = (unsigned)(rho * 128);
#pragma unroll 1
    for (int x = x0; x < x1; ++x) {
        const int g = x < nl ? gl : gh, c = x < nl ? x : x - nl;
        if (g != curg) { curg = g; t0 = g * 64 + F.wid * 8;
#pragma unroll
            for (int mt = 0; mt < 4; ++mt) {
                const int tokA = b * SEQ + t0 + 2 * mt + ((rho >> 2) & 1), head = (rho & 3) + 4 * (rho >> 3);
#pragma unroll
                for (int kk = 0; kk < 4; ++kk) af[mt][kk] = *(const bf16x8*)(qidx + (size_t)tokA * 1024 + head * 64 + kk * 16 + 8 * hh);
                const float* wp = wi + (size_t)(b * SEQ + t0 + 2 * mt + hh) * 16;
#pragma unroll
                for (int q = 0; q < 4; ++q) { const f32x4 v = *(const f32x4*)(wp + 4 * q); wv[mt][4 * q] = v[0]; wv[mt][4 * q + 1] = v[1]; wv[mt][4 * q + 2] = v[2]; wv[mt][4 * q + 3] = v[3]; } } }
        const unsigned bo = (unsigned)((x - x0) & 1) * 16384u;
        if (x + 1 < x1) { const int cn = (x + 1) < nl ? (x + 1) : (x + 1) - nl; const bf16_t* kp = ki + (size_t)(cn * 128) * 64; s0 = *(const u32x4*)(kp + (size_t)r0 * 64 + p0 * 8); s1 = *(const u32x4*)(kp + (size_t)(r0 + 64) * 64 + p0 * 8); }
#pragma unroll
        for (int tl = 0; tl < 4; ++tl) {
            const int kb = c * 128 + tl * 32;
            if (kb <= t0 + 7) {
                bf16x8 bc[4];
#pragma unroll
                for (int kk = 0; kk < 4; ++kk) bc[kk] = *(const LAS bf16x8*)(kl + bo + tl * 4096 + rdo + (((kk * 2 + hh) ^ (rho & 7)) << 4));
                f32x16 a0 = {}, a1 = {}, a2 = {}, a3 = {};
#pragma unroll
                for (int kk = 0; kk < 4; ++kk) { a0 = __builtin_amdgcn_mfma_f32_32x32x16_bf16(af[0][kk], bc[kk], a0, 0, 0, 0); a1 = __builtin_amdgcn_mfma_f32_32x32x16_bf16(af[1][kk], bc[kk], a1, 0, 0, 0);
                                                  a2 = __builtin_amdgcn_mfma_f32_32x32x16_bf16(af[2][kk], bc[kk], a2, 0, 0, 0); a3 = __builtin_amdgcn_mfma_f32_32x32x16_bf16(af[3][kk], bc[kk], a3, 0, 0, 0); }
#define IDX_EPI(A_, mt_) do { float x_0 = 0.f, x_1 = 0.f, x_2 = 0.f, x_3 = 0.f; _Pragma("unroll") for (int r = 0; r < 16; r += 4) { \
                    x_0 = fmaf(wv[mt_][r], fmaxf(A_[r], 0.f), x_0); x_1 = fmaf(wv[mt_][r + 1], fmaxf(A_[r + 1], 0.f), x_1); x_2 = fmaf(wv[mt_][r + 2], fmaxf(A_[r + 2], 0.f), x_2); x_3 = fmaf(wv[mt_][r + 3], fmaxf(A_[r + 3], 0.f), x_3); } \
                    scores[(size_t)(t0 + 2 * (mt_) + hh) * SEQ + kb + rho] = (x_0 + x_1) + (x_2 + x_3); } while (0)
                IDX_EPI(a0, 0); IDX_EPI(a1, 1); IDX_EPI(a2, 2); IDX_EPI(a3, 3);
#undef IDX_EPI
            }
        }
        if (x + 1 < x1) { *(LAS u32x4*)(kl + (bo ^ 16384u) + d0) = s0; *(LAS u32x4*)(kl + (bo ^ 16384u) + d1) = s1; }
        __syncthreads();
    }
}
__device__ __forceinline__ void phase_idx(const Frame& F0) { const Frame F = fresh(F0);
#pragma unroll 1
    for (int it = F.bid; it < 256; it += F.G) { const int b = it >> 7, pi = (it >> 1) & 63, half = it & 1; idx_unit(F, b, pi, half); }
}

__device__ __forceinline__ unsigned sortable(float f) { const unsigned u = __float_as_uint(f); return (u & 0x80000000u) ? ~u : (u | 0x80000000u); }
__device__ __forceinline__ void topk_row(const Frame& F, int b, int t) {
    int lane = F.lane; asm volatile("" : "+v"(lane));
    const int L = t + 1, tok = b * SEQ + t; unsigned char* ws = F.ws;
    int* sel = (int*)(ws + R_SEL) + (size_t)tok * 256; int* nsel = (int*)(ws + R_NSEL);
    if (lane == 0) nsel[tok] = L < 256 ? L : 256;
    if (L <= 256) { for (int j = lane; j < 256; j += 64) sel[j] = j < L ? j : 0; return; }
    const float* row = (const float*)(ws + R_SCORES) + ((size_t)b * SEQ + t) * SEQ;
    const int nch = (L + 1023) >> 10;
#define TOPK_LOAD_ROW() do { _Pragma("unroll") for (int c = 0; c < 8; ++c) { \
        if (c < nch) { _Pragma("unroll") for (int jj = 0; jj < 4; ++jj) { const int j = c * 4 + jj; const f32x4 v = *(const f32x4*)(row + j * 256 + lane * 4); \
                _Pragma("unroll") for (int e_ = 0; e_ < 4; ++e_) { const int idx = j * 256 + lane * 4 + e_; u[j * 4 + e_] = idx < L ? sortable(v[e_]) : 0u; } } } \
        else { _Pragma("unroll") for (int q = 0; q < 16; ++q) u[c * 16 + q] = 0u; } } } while (0)
    unsigned u[128];
    TOPK_LOAD_ROW();
    unsigned g0 = 0u, g1 = 0u, g2 = 0u, g3 = 0u;
#pragma unroll
    for (int c = 0; c < 8; ++c) if (c < nch) {
#pragma unroll
        for (int jj = 0; jj < 4; ++jj) { const int j = c * 4 + jj; g0 = u[4 * j] > g0 ? u[4 * j] : g0; g1 = u[4 * j + 1] > g1 ? u[4 * j + 1] : g1; g2 = u[4 * j + 2] > g2 ? u[4 * j + 2] : g2; g3 = u[4 * j + 3] > g3 ? u[4 * j + 3] : g3; } }
    unsigned tl = g0 < g1 ? g0 : g1; { const unsigned t2 = g2 < g3 ? g2 : g3; tl = tl < t2 ? tl : t2; }
#pragma unroll
    for (int o = 32; o > 0; o >>= 1) { const unsigned x = (unsigned)__shfl_xor((int)tl, o); tl = x < tl ? x : tl; }
    unsigned gmx = g0 > g1 ? g0 : g1; { const unsigned t2 = g2 > g3 ? g2 : g3; gmx = gmx > t2 ? gmx : t2; }
#pragma unroll
    for (int o = 32; o > 0; o >>= 1) { const unsigned x = (unsigned)__shfl_xor((int)gmx, o); gmx = x > gmx ? x : gmx; }
    unsigned thr = tl;
    if (nch >= 2) { const unsigned d = tl ^ gmx; const int hb = d ? 31 - __clz(d) : -1; const unsigned low = hb < 0 ? 0u : (hb == 31 ? 0xffffffffu : ((2u << hb) - 1u));
        unsigned T2 = gmx & ~low;
        for (int bit = hb; bit >= 0; --bit) { const unsigned cnd = T2 | (1u << bit);
            const int cnt = __popcll(__ballot(g0 >= cnd)) + __popcll(__ballot(g1 >= cnd)) + __popcll(__ballot(g2 >= cnd)) + __popcll(__ballot(g3 >= cnd));
            if (cnt >= 200) T2 = cnd; }
        thr = T2; }
    constexpr int CAP = 2048;
    LAS unsigned* candk = (LAS unsigned*)(F.ldsl + F.wid * (CAP * 8)); LAS unsigned* candi = candk + CAP;
    int C = 0;
#pragma unroll 1
    for (int att = 0; att < 2; ++att) { C = 0; int ln = lane; asm volatile("" : "+v"(ln));
#pragma unroll
    for (int c = 0; c < 8; ++c) if (c < nch) {
#pragma unroll
        for (int q = 0; q < 16; ++q) { const int rq = c * 16 + q; const bool pr = u[rq] >= thr; const unsigned long long mm = __ballot(pr);
            const int pos = C + __popcll(mm & ((1ull << ln) - 1ull));
            if (pr && pos < CAP) { candk[pos] = u[rq]; candi[pos] = (unsigned)((rq >> 2) * 256 + ln * 4 + (rq & 3)); }
            C += __popcll(mm); if ((q & 3) == 3) SBAR(); } }
        if (C >= 256 || thr == tl) break;
        thr = tl; }
    if (C <= CAP) {
        const int ng = (C + 255) >> 8;
        unsigned ck[32]; int ci[32];
#pragma unroll
        for (int g = 0; g < 8; ++g) {
#pragma unroll
            for (int q = 0; q < 4; ++q) { const int r = g * 4 + q, p = r * 64 + lane; ck[r] = 0u; ci[r] = 0;
                if (g < ng && p < C) { ck[r] = candk[p]; ci[r] = (int)candi[p]; } } }
        unsigned thr_gt = 0u; int need_eq = 0; bool early = false;
        const unsigned d2 = thr ^ gmx; const int hb2 = d2 ? 31 - __clz(d2) : -1; const unsigned low2 = hb2 < 0 ? 0u : (hb2 == 31 ? 0xffffffffu : ((2u << hb2) - 1u));
        unsigned T = gmx & ~low2;
        for (int bit = hb2; bit >= 0; --bit) {
            const unsigned cnd = T | (1u << bit); int cnt = 0;
#pragma unroll
            for (int g = 0; g < 8; ++g) if (g < ng) {
#pragma unroll
                for (int q = 0; q < 4; ++q) cnt += __popcll(__ballot(ck[g * 4 + q] >= cnd)); }
            if (cnt >= 256) { T = cnd; if (cnt == 256) { early = true; break; } }
        }
        if (early) { thr_gt = T - 1u; need_eq = 0; }
        else { int gtc = 0;
#pragma unroll
            for (int g = 0; g < 8; ++g) if (g < ng) {
#pragma unroll
                for (int q = 0; q < 4; ++q) gtc += __popcll(__ballot(ck[g * 4 + q] > T)); }
            thr_gt = T; need_eq = 256 - gtc; }
        int base = 0, eq_taken = 0;
#pragma unroll
        for (int g = 0; g < 8; ++g) if (g < ng) {
#pragma unroll
            for (int q = 0; q < 4; ++q) { const int r = g * 4 + q; const unsigned v = ck[r];
                const bool iseq = (v == thr_gt) && (need_eq > 0);
                const unsigned long long meq = __ballot(iseq);
                const int eqr = __popcll(meq & ((1ull << lane) - 1ull));
                const bool take = (v > thr_gt) || (iseq && (eq_taken + eqr < need_eq));
                const unsigned long long mt = __ballot(take);
                const int pos = base + __popcll(mt & ((1ull << lane) - 1ull));
                if (take && pos < 256) sel[pos] = ci[r];
                base += __popcll(mt); eq_taken += __popcll(meq); } }
        return;
    }
    asm volatile("" ::: "memory");
    TOPK_LOAD_ROW();
    unsigned T = 0u, thr_gt = 0u; int need_eq = 0; bool early = false;
    for (int bit = 31; bit >= 0; --bit) {
        const unsigned cand = T | (1u << bit); int cnt = 0;
#pragma unroll
        for (int c = 0; c < 8; ++c) if (c < nch) {
#pragma unroll
            for (int q = 0; q < 16; ++q) cnt += __popcll(__ballot(u[c * 16 + q] >= cand)); }
        if (cnt >= 256) { T = cand; if (cnt == 256) { early = true; break; } }
    }
    if (early) { thr_gt = T - 1u; need_eq = 0; }
    else { int gtc = 0;
#pragma unroll
        for (int c = 0; c < 8; ++c) if (c < nch) {
#pragma unroll
            for (int q = 0; q < 16; ++q) gtc += __popcll(__ballot(u[c * 16 + q] > T)); }
        thr_gt = T; need_eq = 256 - gtc; }
    int base = 0, eq_taken = 0;
#pragma unroll
    for (int c = 0; c < 8; ++c) if (c < nch) {
#pragma unroll
        for (int q = 0; q < 16; ++q) { const int rq = c * 16 + q; const unsigned v = u[rq];
            const bool iseq = (v == thr_gt) && (need_eq > 0);
            const unsigned long long meq = __ballot(iseq);
            const int eqr = __popcll(meq & ((1ull << lane) - 1ull));
            const bool take = (v > thr_gt) || (iseq && (eq_taken + eqr < need_eq));
            const unsigned long long mt = __ballot(take);
            const int pos = base + __popcll(mt & ((1ull << lane) - 1ull));
            if (take && pos < 256) sel[pos] = (rq >> 2) * 256 + lane * 4 + (rq & 3);
            base += __popcll(mt); eq_taken += __popcll(meq); } }
}
__device__ __forceinline__ void phase_topk(const Frame& F0) { const Frame F = fresh(F0);
    for (int q = F.bid * 8 + F.wid; q < 8192; q += F.G * 8) { const int b = q >> 12, p = q & 4095; topk_row(F, b, p); topk_row(F, b, SEQ - 1 - p); }
}

namespace att {
constexpr int D = 128, KVBLK = 64, QBLK = 32, SHM_V = 16384, SHM_K = 16384;
constexpr int OFF_K = 2 * SHM_V, OFF_BIAS = 2 * SHM_V + 2 * SHM_K, OFF_WS = OFF_BIAS + 512, OFF_FLAGS = OFF_WS + 2048, OFF_QITEM = OFF_FLAGS + 64;
constexpr float EXIT_T = 44.0f;
#define KSWZ(row, colB) ((row) * 256 + ((colB) ^ (((row) & 7) << 4)))
__device__ __forceinline__ int v_st(int k, int c) { const int kk = (k & ~0xC) | ((k & 4) << 1) | ((k & 8) >> 1); return ((kk >> 3) * 4 + (c >> 5)) * 512 + ((kk & 7) * 32 + (c & 31)) * 2; }
__device__ __forceinline__ int v_rd_base(int lane) { return ((lane & 3) << 3) | (((lane >> 2) & 3) << 6) | (((lane >> 4) & 1) << 5) | (((lane >> 5) & 1) << 8); }
constexpr int v_rd_off(int d0, int ks, int half) { return d0 * 512 + ks * 4096 + half * 2048; }
template <int KB>
__device__ __forceinline__ void qkt(f32x16& p0, f32x16& p1, const char* K_lds, int r32, int hi, const bf16x8* qr) {
    p0 = f32x16{}; p1 = f32x16{};
    const char* kb[4];
#pragma unroll
    for (int dd = 0; dd < 4; ++dd) kb[dd] = K_lds + KB * SHM_K + KSWZ(r32, (dd * 16 + hi * 8) * 2);
#pragma unroll
    for (int d0 = 0; d0 < 8; ++d0) { const char* a = kb[d0 & 3] + (d0 >> 2) * 128;
        bf16x8 b0 = *reinterpret_cast<const bf16x8*>(a);
        bf16x8 b1 = *reinterpret_cast<const bf16x8*>(a + 32 * 256);
        p0 = __builtin_amdgcn_mfma_f32_32x32x16_bf16(b0, qr[d0], p0, 0, 0, 0);
        p1 = __builtin_amdgcn_mfma_f32_32x32x16_bf16(b1, qr[d0], p1, 0, 0, 0); }
}
template <int VB>
__device__ __forceinline__ void pv_tile(f32x16* o, int vb0, bf16x8 pa0, bf16x8 pa1, bf16x8 pa2, bf16x8 pa3) {
#define TRRD(dst, off) asm volatile("ds_read_b64_tr_b16 %0, %1 offset:%2" : "=&v"(dst) : "v"(vb0), "i"(off) : "memory")
#define PV_D0(d0) do { s16x4 l0, l1, l2, l3, h0, h1, h2, h3; constexpr int b_ = VB * SHM_V + v_rd_off(d0, 0, 0); \
        TRRD(l0, b_); TRRD(h0, b_ + 2048); TRRD(l1, b_ + 4096); TRRD(h1, b_ + 6144); TRRD(l2, b_ + 8192); TRRD(h2, b_ + 10240); TRRD(l3, b_ + 12288); TRRD(h3, b_ + 14336); \
        asm volatile("s_waitcnt lgkmcnt(0)" ::: "memory"); SBAR(); \
        o[d0] = __builtin_amdgcn_mfma_f32_32x32x16_bf16(pa0, (bf16x8){l0[0], l0[1], l0[2], l0[3], h0[0], h0[1], h0[2], h0[3]}, o[d0], 0, 0, 0); \
        o[d0] = __builtin_amdgcn_mfma_f32_32x32x16_bf16(pa1, (bf16x8){l1[0], l1[1], l1[2], l1[3], h1[0], h1[1], h1[2], h1[3]}, o[d0], 0, 0, 0); \
        o[d0] = __builtin_amdgcn_mfma_f32_32x32x16_bf16(pa2, (bf16x8){l2[0], l2[1], l2[2], l2[3], h2[0], h2[1], h2[2], h2[3]}, o[d0], 0, 0, 0); \
        o[d0] = __builtin_amdgcn_mfma_f32_32x32x16_bf16(pa3, (bf16x8){l3[0], l3[1], l3[2], l3[3], h3[0], h3[1], h3[2], h3[3]}, o[d0], 0, 0, 0); } while (0)
    PV_D0(0); PV_D0(1); PV_D0(2); PV_D0(3);
#undef PV_D0
#undef TRRD
}
#define PK4(P, B_, OUT) do { unsigned a0 = cvtpk(P[B_+0], P[B_+1]), a1 = cvtpk(P[B_+2], P[B_+3]); \
        unsigned b0 = cvtpk(P[B_+4], P[B_+5]), b1 = cvtpk(P[B_+6], P[B_+7]); \
        auto r0 = __builtin_amdgcn_permlane32_swap(a0, b0, false, false); auto r1 = __builtin_amdgcn_permlane32_swap(a1, b1, false, false); \
        u32x4 w = {r0[0], r1[0], r0[1], r1[1]}; OUT = *reinterpret_cast<bf16x8*>(&w); } while (0)
__device__ __forceinline__ float swap_max(float x) { auto rr = __builtin_amdgcn_permlane32_swap(__float_as_uint(x), __float_as_uint(x), false, false); return fmaxf(__uint_as_float(rr[0]), __uint_as_float(rr[1])); }
__device__ __forceinline__ float swap_sum(float x) { auto rr = __builtin_amdgcn_permlane32_swap(__float_as_uint(x), __float_as_uint(x), false, false); return __uint_as_float(rr[0]) + __uint_as_float(rr[1]); }
__device__ __forceinline__ float swap_lo(float x) { auto rr = __builtin_amdgcn_permlane32_swap(__float_as_uint(x), __float_as_uint(x), false, false); return __uint_as_float(rr[0]); }


__device__ __forceinline__ void fox_sm(f32x16& p0, f32x16& p1, const float* bl, int kb_, int qlo, int qrow, int hi, int r32, float& m_reg, float& l_reg, f32x16* o, float* al_l,
                                       bf16x8& pa0, bf16x8& pa1, bf16x8& pa2, bf16x8& pa3) {
#pragma unroll
    for (int g = 0; g < 4; ++g) { const f32x4 b0v = *(const f32x4*)(bl + 8 * g + 4 * hi), b1v = *(const f32x4*)(bl + 32 + 8 * g + 4 * hi);
#pragma unroll
        for (int i = 0; i < 4; ++i) { p0[4 * g + i] = fmaf(p0[4 * g + i], C2, b0v[i]); p1[4 * g + i] = fmaf(p1[4 * g + i], C2, b1v[i]); } }
    if (kb_ + KVBLK - 1 > qlo) { const float NEG = -__builtin_inff();
#pragma unroll
        for (int r = 0; r < 16; ++r) { const int key = kb_ + crow(r, hi); if (key > qrow) p0[r] = NEG; if (key + 32 > qrow) p1[r] = NEG; } }
    float pmax = p0[0];
#pragma unroll
    for (int r = 1; r < 16; ++r) pmax = fmaxf(pmax, p0[r]);
#pragma unroll
    for (int r = 0; r < 16; ++r) pmax = fmaxf(pmax, p1[r]);
    pmax = swap_max(pmax);
    const float mn = fmaxf(m_reg, pmax), alpha = __builtin_amdgcn_exp2f(m_reg - mn); m_reg = mn;
    float ps = 0.f;
#pragma unroll
    for (int r = 0; r < 16; ++r) { p0[r] = __builtin_amdgcn_exp2f(p0[r] - mn); p1[r] = __builtin_amdgcn_exp2f(p1[r] - mn); ps += p0[r] + p1[r]; }
    ps = swap_sum(ps); l_reg = l_reg * alpha + ps;
    if (__any(alpha < 1.f)) { if (hi == 0) al_l[r32] = alpha; asm volatile("s_waitcnt lgkmcnt(0)" ::: "memory");
#pragma unroll
        for (int r = 0; r < 16; ++r) { const float a = al_l[crow(r, hi)];
#pragma unroll
            for (int d_ = 0; d_ < 4; ++d_) o[d_][r] *= a; } }
    PK4(p0, 0, pa0); PK4(p0, 8, pa1); PK4(p1, 0, pa2); PK4(p1, 8, pa3);
}
__device__ __forceinline__ void sb_half(f32x16& pz, int keybase, int qrow, int hi, float& R, const bf16x8* triA, bool needmask) {
    f32x16 X;
#pragma unroll
    for (int r = 0; r < 16; ++r) { const float zz = pz[r] * C2; const bool valid = !needmask || (keybase + crow(r, hi) < qrow);
        const float l2 = fmaxf(zz, 0.f) + __builtin_amdgcn_logf(1.0f + __builtin_amdgcn_exp2f(-fabsf(zz)));
        X[r] = valid ? -l2 : 0.f; pz[r] = valid ? zz : -__builtin_inff(); }
    f32x16 Y;
#pragma unroll
    for (int r = 0; r < 16; ++r) Y[r] = R;
#pragma unroll
    for (int s = 0; s < 2; ++s) {
        const unsigned h0 = cvtpk(X[8 * s + 0], X[8 * s + 1]), h1 = cvtpk(X[8 * s + 2], X[8 * s + 3]), h2 = cvtpk(X[8 * s + 4], X[8 * s + 5]), h3 = cvtpk(X[8 * s + 6], X[8 * s + 7]);
        const unsigned l0 = cvtpk(X[8 * s + 0] - bflo(h0), X[8 * s + 1] - bfhi(h0)), l1 = cvtpk(X[8 * s + 2] - bflo(h1), X[8 * s + 3] - bfhi(h1));
        const unsigned l2 = cvtpk(X[8 * s + 4] - bflo(h2), X[8 * s + 5] - bfhi(h2)), l3 = cvtpk(X[8 * s + 6] - bflo(h3), X[8 * s + 7] - bfhi(h3));
        u32x4 wh = {h0, h1, h2, h3}, wl = {l0, l1, l2, l3};
        Y = __builtin_amdgcn_mfma_f32_32x32x16_bf16(triA[s], *reinterpret_cast<bf16x8*>(&wh), Y, 0, 0, 0);
        Y = __builtin_amdgcn_mfma_f32_32x32x16_bf16(triA[s], *reinterpret_cast<bf16x8*>(&wl), Y, 0, 0, 0); }
#pragma unroll
    for (int r = 0; r < 16; ++r) pz[r] = __builtin_amdgcn_exp2f(pz[r] + Y[r]);
    R = swap_lo(Y[0]);
}
__device__ __forceinline__ void sb_sm(f32x16& p0, f32x16& p1, int kb_, int qlo, int qrow, int hi, float& R, const bf16x8* triA, bf16x8& pa0, bf16x8& pa1, bf16x8& pa2, bf16x8& pa3) {
    const bool needmask = (kb_ + KVBLK - 1 >= qlo);
    sb_half(p1, kb_ + 32, qrow, hi, R, triA, needmask);
    sb_half(p0, kb_, qrow, hi, R, triA, needmask);
    PK4(p0, 0, pa0); PK4(p0, 8, pa1); PK4(p1, 0, pa2); PK4(p1, 8, pa3);
}

template <int MODE>
__device__ __forceinline__ void attn_unit(const bf16_t* Q, const bf16_t* Kh, const bf16_t* Vh, const float* cum, bf16_t* O, int P0, char* lds, float kmaxc) {
    int tid = threadIdx.x; asm volatile("" : "+v"(tid));
    const int wid = __builtin_amdgcn_readfirstlane(tid >> 6), lane = tid & 63, r32 = lane & 31, hi = lane >> 5;
    const int NT = P0 / KVBLK + 4;
    char* V_lds = lds; char* K_lds = lds + OFF_K; float* bias_l = (float*)(lds + OFF_BIAS);
    float* wsl = (float*)(lds + OFF_WS) + wid * 64; float* li_l = wsl; float* al_l = wsl + 32;
    const int qlo = P0 + wid * QBLK, qrow = qlo + r32;
    bf16x8 qr[8];
#pragma unroll
    for (int d0 = 0; d0 < 8; ++d0) qr[d0] = *(const bf16x8*)(Q + (size_t)qrow * D + d0 * 16 + hi * 8);
    const int sr = tid >> 4, sc = (tid & 15) * 8, vst0 = v_st(sr, sc), vst1 = v_st(32 + sr, sc), kws = KSWZ(sr, sc * 2);
    const int vb0 = (int)(uintptr_t)V_lds + v_rd_base(lane);
    const float cumref = (MODE == 0) ? cum[P0] : 0.f;
    int* flg = (int*)(lds + OFF_FLAGS);
    float qn = 0.f;
    if (MODE == 0) { float ss = 0.f;
#pragma unroll
        for (int d0 = 0; d0 < 8; ++d0)
#pragma unroll
            for (int j = 0; j < 8; ++j) { const float x = bf2f((bf16_t)qr[d0][j]); ss = fmaf(x, x, ss); }
        ss = swap_sum(ss); qn = sqrtf(ss) * kmaxc * 1.001f; }
    float m_reg = -1e30f, l_reg = 0.f, R = 0.f; f32x16 o[4] = {};
    bf16x8 triA[2];
    if (MODE == 1) {
#pragma unroll
        for (int s = 0; s < 2; ++s)
#pragma unroll
            for (int j = 0; j < 8; ++j) { const int rho = 16 * s + 8 * (j >> 2) + 4 * hi + (j & 3); triA[s][j] = (rho >= r32) ? (short)0x3F80 : (short)0; }
    }
    bf16x8 st_k0, st_k1, st_v0, st_v1; float st_b = 0.f;
#define TILE_KB(t) ((NT - 1 - (t)) * KVBLK)
#define SLOAD(kb_) do { st_v0 = *(const bf16x8*)(Vh + (size_t)((kb_) + sr) * D + sc); st_v1 = *(const bf16x8*)(Vh + (size_t)((kb_) + 32 + sr) * D + sc); \
                        st_k0 = *(const bf16x8*)(Kh + (size_t)((kb_) + sr) * D + sc); st_k1 = *(const bf16x8*)(Kh + (size_t)((kb_) + 32 + sr) * D + sc); \
                        if (MODE == 0 && tid < 64) st_b = (cumref - cum[(kb_) + tid]) * LOG2E; } while (0)
#define SWRITE(bf) do { *(bf16x8*)(V_lds + (bf) * SHM_V + vst0) = st_v0; *(bf16x8*)(V_lds + (bf) * SHM_V + vst1) = st_v1; \
                        *(bf16x8*)(K_lds + (bf) * SHM_K + kws) = st_k0; *(bf16x8*)(K_lds + (bf) * SHM_K + kws + 32 * 256) = st_k1; \
                        if (MODE == 0 && tid < 64) bias_l[(bf) * 64 + tid] = st_b; } while (0)
    __syncthreads();
    SLOAD(TILE_KB(0)); SWRITE(0);
    __syncthreads();
    f32x16 p0, p1; bf16x8 pa0, pa1, pa2, pa3;
#define STEP(BUF, t) do { const int kb_ = TILE_KB(t); \
        if ((t) + 1 < NT) SLOAD(TILE_KB((t) + 1)); \
        SBAR(); qkt<BUF>(p0, p1, K_lds, r32, hi, qr); \
        if (MODE == 0) fox_sm(p0, p1, bias_l + (BUF) * 64, kb_, qlo, qrow, hi, r32, m_reg, l_reg, o, al_l, pa0, pa1, pa2, pa3); \
        else sb_sm(p0, p1, kb_, qlo, qrow, hi, R, triA, pa0, pa1, pa2, pa3); \
        SBAR(); pv_tile<BUF>(o, vb0, pa0, pa1, pa2, pa3); \
        if ((t) + 1 < NT) SWRITE((BUF) ^ 1); \
        __syncthreads(); } while (0)
    for (int t = 0; t < NT; t += 2) {
        STEP(0, t); STEP(1, t + 1);
        const int kbc = TILE_KB(t + 1); if (kbc == 0) break;
        bool done;
        if (MODE == 0) { const float edge = (cumref - cum[kbc - 1]) * LOG2E; done = (qn + edge - m_reg) < -EXIT_T; }
        else done = R < -EXIT_T;
        const int par = (t >> 1) & 1;
        if (lane == 0) flg[par * 8 + wid] = 0;
        const bool wdone = __all(done);
        if (lane == 0 && wdone) flg[par * 8 + wid] = 1;
        __syncthreads();
        int alld = 1;
#pragma unroll
        for (int w = 0; w < 8; ++w) alld &= flg[par * 8 + w];
        if (alld) break;
    }
    __syncthreads();
#undef STEP
#undef SLOAD
#undef SWRITE
#undef TILE_KB
    float rli[16];
    if (MODE == 0) { if (hi == 0) li_l[r32] = l_reg; asm volatile("s_waitcnt lgkmcnt(0)" ::: "memory");
#pragma unroll
        for (int r = 0; r < 16; ++r) rli[r] = __builtin_amdgcn_rcpf(li_l[crow(r, hi)]); }
    bf16_t* Ow = O + (size_t)(wid * QBLK) * 3072;
#pragma unroll
    for (int r = 0; r < 16; ++r) { const int orow = crow(r, hi);
#pragma unroll
        for (int d0 = 0; d0 < 4; ++d0) { const float v = (MODE == 0) ? o[d0][r] * rli[r] : o[d0][r];
            const float vn = __shfl_xor(v, 1);
            if ((r32 & 1) == 0) *(unsigned*)(Ow + (size_t)orow * 3072 + d0 * 32 + r32) = cvtpk(v, vn); } }
}
}

__device__ __forceinline__ void sparse_query(const Frame& F, int tok, char* ldsw) {
    unsigned char* ws = F.ws; const int lane = F.lane, g = lane >> 4, i16 = lane & 15;
    const bf16_t* qcat = (const bf16_t*)(ws + R_QCAT) + (size_t)tok * 2304; const bf16_t* kbase = (const bf16_t*)(ws + R_KCAT) + (size_t)(tok >> 13) * SEQ * 288;
    const int* sel = (const int*)(ws + R_SEL) + (size_t)tok * 256; const int ns = ((const int*)(ws + R_NSEL))[tok]; const int ntile = (ns + 31) >> 5;
    bf16x8 qf[9];
#pragma unroll
    for (int st = 0; st < 9; ++st) { qf[st] = (bf16x8){0, 0, 0, 0, 0, 0, 0, 0}; if (i16 < 8) qf[st] = *(const bf16x8*)(qcat + i16 * 288 + st * 32 + 8 * g); }
    const int rA = lane >> 2, cq = lane & 3;
    float m = -1e30f, l = 0.f; f32x4 oT[16];
#pragma unroll
    for (int rb = 0; rb < 16; ++rb) oT[rb] = (f32x4){0.f, 0.f, 0.f, 0.f};
    const unsigned ldso = (unsigned)(uintptr_t)ldsw;
    const unsigned vb = ldso + (unsigned)((4 * g + (i16 >> 2)) * 592 + (i16 & 3) * 8);
    constexpr float SC2 = SCALE * LOG2E;
    bf16x8 stg[18];
#define GATHER(tile_) do { const int j0 = (tile_) * 32 + rA, j1 = j0 + 16; const int s0 = j0 < ns ? sel[j0] : 0, s1 = j1 < ns ? sel[j1] : 0; \
        const bf16_t* p0_ = kbase + (size_t)s0 * 288 + cq * 8; const bf16_t* p1_ = kbase + (size_t)s1 * 288 + cq * 8; \
        _Pragma("unroll") for (int c = 0; c < 9; ++c) { stg[2 * c] = *(const bf16x8*)(p0_ + c * 32); stg[2 * c + 1] = *(const bf16x8*)(p1_ + c * 32); } } while (0)
    GATHER(0);
    for (int tile = 0; tile < ntile; ++tile) {
#pragma unroll
        for (int c = 0; c < 9; ++c) { *(bf16x8*)(ldsw + rA * 592 + c * 64 + cq * 16) = stg[2 * c]; *(bf16x8*)(ldsw + (16 + rA) * 592 + c * 64 + cq * 16) = stg[2 * c + 1]; }
        if (tile + 1 < ntile) GATHER(tile + 1);
        asm volatile("s_waitcnt lgkmcnt(0)" ::: "memory"); SBAR();
        f32x4 acc[2];
#pragma unroll
        for (int mt = 0; mt < 2; ++mt) { acc[mt] = (f32x4){0.f, 0.f, 0.f, 0.f};
#pragma unroll
            for (int st = 0; st < 9; ++st) { const bf16x8 a = *(const bf16x8*)(ldsw + (16 * mt + i16) * 592 + st * 64 + g * 16);
                acc[mt] = __builtin_amdgcn_mfma_f32_16x16x32_bf16(a, qf[st], acc[mt], 0, 0, 0); } }
        float tmax = -__builtin_inff();
#pragma unroll
        for (int mt = 0; mt < 2; ++mt)
#pragma unroll
            for (int r = 0; r < 4; ++r) { const int key = tile * 32 + 16 * mt + 4 * g + r; float x = acc[mt][r] * SC2; if (key >= ns) x = -__builtin_inff(); acc[mt][r] = x; tmax = fmaxf(tmax, x); }
        tmax = fmaxf(tmax, __shfl_xor(tmax, 16)); tmax = fmaxf(tmax, __shfl_xor(tmax, 32));
        const float mn = fmaxf(m, tmax), alpha = __builtin_amdgcn_exp2f(m - mn); m = mn;
        float ps = 0.f;
#pragma unroll
        for (int mt = 0; mt < 2; ++mt)
#pragma unroll
            for (int r = 0; r < 4; ++r) { acc[mt][r] = __builtin_amdgcn_exp2f(acc[mt][r] - mn); ps += acc[mt][r]; }
        ps += __shfl_xor(ps, 16); ps += __shfl_xor(ps, 32);
        l = l * alpha + ps;
#pragma unroll
        for (int rb = 0; rb < 16; ++rb) oT[rb] *= alpha;
        const bf16x8 pf = pack8(acc[0], acc[1]);
#define TRRD2(dst, off) asm volatile("ds_read_b64_tr_b16 %0, %1 offset:%2" : "=&v"(dst) : "v"(vb), "i"(off) : "memory")
#define PVRB4(rb) do { s16x4 ta0, tb0, ta1, tb1, ta2, tb2, ta3, tb3; \
        TRRD2(ta0, ((rb) + 0) * 32); TRRD2(tb0, ((rb) + 0) * 32 + 16 * 592); TRRD2(ta1, ((rb) + 1) * 32); TRRD2(tb1, ((rb) + 1) * 32 + 16 * 592); \
        TRRD2(ta2, ((rb) + 2) * 32); TRRD2(tb2, ((rb) + 2) * 32 + 16 * 592); TRRD2(ta3, ((rb) + 3) * 32); TRRD2(tb3, ((rb) + 3) * 32 + 16 * 592); \
        asm volatile("s_waitcnt lgkmcnt(0)" ::: "memory"); SBAR(); \
        oT[(rb) + 0] = __builtin_amdgcn_mfma_f32_16x16x32_bf16((bf16x8){ta0[0], ta0[1], ta0[2], ta0[3], tb0[0], tb0[1], tb0[2], tb0[3]}, pf, oT[(rb) + 0], 0, 0, 0); \
        oT[(rb) + 1] = __builtin_amdgcn_mfma_f32_16x16x32_bf16((bf16x8){ta1[0], ta1[1], ta1[2], ta1[3], tb1[0], tb1[1], tb1[2], tb1[3]}, pf, oT[(rb) + 1], 0, 0, 0); \
        oT[(rb) + 2] = __builtin_amdgcn_mfma_f32_16x16x32_bf16((bf16x8){ta2[0], ta2[1], ta2[2], ta2[3], tb2[0], tb2[1], tb2[2], tb2[3]}, pf, oT[(rb) + 2], 0, 0, 0); \
        oT[(rb) + 3] = __builtin_amdgcn_mfma_f32_16x16x32_bf16((bf16x8){ta3[0], ta3[1], ta3[2], ta3[3], tb3[0], tb3[1], tb3[2], tb3[3]}, pf, oT[(rb) + 3], 0, 0, 0); } while (0)
        PVRB4(0); PVRB4(4); PVRB4(8); PVRB4(12);
#undef PVRB4
#undef TRRD2
        SBAR();
    }
#undef GATHER
    const float rl = 1.0f / l;
    if (i16 < 8) { bf16_t* op = (bf16_t*)(ws + R_OLAT) + (size_t)tok * 2048 + i16 * 256 + 4 * g;
#pragma unroll
        for (int rb = 0; rb < 16; ++rb) { u32x2 w; w.x = cvtpk(oT[rb][0] * rl, oT[rb][1] * rl); w.y = cvtpk(oT[rb][2] * rl, oT[rb][3] * rl); *(u32x2*)(op + rb * 16) = w; } }
}
#ifdef ATT_SUB
#define ASUB(k) ((k) == ATT_SUB)
#else
#define ASUB(k) true
#endif
__device__ __forceinline__ void phase_attn(const Frame& F0, int l, int rep) { const Frame F = fresh(F0);
    unsigned char* ws = F.ws; char* lds = (char*)F.lds;
    const bf16_t* qkv = (const bf16_t*)(ws + R_QKV); const size_t TS = (size_t)NTOK * 1024;
    unsigned* qctr = (unsigned*)(ws + WS_CTL) + CW_QCTR + l * 64 + rep * 16; const unsigned* kmx = (const unsigned*)(ws + WS_CTL) + CW_KMAX + l * 16;
    int* qitem = (int*)(lds + att::OFF_QITEM);
    int* hord = qitem + 4;
    if (F.tid < 16) { const float* cumb = (const float*)(ws + WS_CUM); const float mine = -cumb[(size_t)F.tid * SEQ + SEQ - 1]; int rank = 0;
        for (int o = 0; o < 16; ++o) { const float v = -cumb[(size_t)o * SEQ + SEQ - 1]; rank += (v < mine || (v == mine && o < F.tid)) ? 1 : 0; }
        hord[rank] = F.tid; }
#pragma unroll 1
    for (;;) {
        __syncthreads();
        if (F.tid == 0) qitem[0] = (int)atomicAdd(qctr, 1u);
        __syncthreads();
        const int it = qitem[0];
        if (it >= 1024) break;
        const int md = it >> 9, j = it & 511;
        const int qb = md == 0 ? 31 - (j & 31) : 31 - (j >> 4), bh = md == 0 ? hord[j >> 5] : (j & 15), b = bh >> 3, h = bh & 7, P0 = qb * 256;
        if (!ASUB(md)) continue;
        const bf16_t* Q = qkv + (size_t)(md * 3 + 0) * TS + (size_t)bh * SEQ * 128; const bf16_t* K = qkv + (size_t)(md * 3 + 1) * TS + (size_t)bh * SEQ * 128; const bf16_t* V = qkv + (size_t)(md * 3 + 2) * TS + (size_t)bh * SEQ * 128;
        const float* cum = (const float*)(ws + WS_CUM) + (size_t)bh * SEQ;
        bf16_t* Ob = (bf16_t*)(ws + R_OA) + (size_t)b * SEQ * 3072 + (md + 1) * 1024 + h * 128;
        if (md == 0) { const float kmaxc = sqrtf(__uint_as_float(kmx[bh])) * C2; att::attn_unit<0>(Q, K, V, cum, Ob + (size_t)P0 * 3072, P0, lds, kmaxc); }
        else att::attn_unit<1>(Q, K, V, cum, Ob + (size_t)P0 * 3072, P0, lds, 0.f);
    }
    __syncthreads();
    char* ldsw = lds + F.wid * 18944;
#pragma unroll 1
    for (int rep = 0; rep < NREP(2); ++rep)
#pragma unroll 1
    for (int tok = F.bid * 8 + F.wid; tok < NTOK; tok += F.G * 8) if (ASUB(2)) sparse_query(F, tok, ldsw);
}

__device__ __forceinline__ void ln_row_w(const u32x4 (&w4)[4], const float* g, const float* bta, float* of, bf16_t* ob, int lane, unsigned char* oq = nullptr, float* osc = nullptr, float* ost = nullptr) {
    f32x4 v[8]; float s = 0.f;
#pragma unroll
    for (int i = 0; i < 4; ++i) { const u32x4 w = w4[i];
        v[2 * i] = (f32x4){bflo(w.x), bfhi(w.x), bflo(w.y), bfhi(w.y)}; v[2 * i + 1] = (f32x4){bflo(w.z), bfhi(w.z), bflo(w.w), bfhi(w.w)};
        s += (v[2 * i][0] + v[2 * i][1]) + (v[2 * i][2] + v[2 * i][3]) + (v[2 * i + 1][0] + v[2 * i + 1][1]) + (v[2 * i + 1][2] + v[2 * i + 1][3]); }
    s = wave_sum(s); const float mu = s * (1.0f / 2048.0f); float q = 0.f;
#pragma unroll
    for (int i = 0; i < 8; ++i) { const f32x4 d = v[i] - mu; q += (d[0] * d[0] + d[1] * d[1]) + (d[2] * d[2] + d[3] * d[3]); }
    q = wave_sum(q); const float rstd = rsqrtf(q * (1.0f / 2048.0f) + 1e-5f);
    if (ost && lane == 0) { ost[0] = mu; ost[1] = rstd; }
    float amax = 0.f;
#pragma unroll
    for (int i = 0; i < 4; ++i) { const int c = (i * 64 + lane) * 8; const f32x4 g0 = *(const f32x4*)(g + c), g1 = *(const f32x4*)(g + c + 4), b0 = *(const f32x4*)(bta + c), b1 = *(const f32x4*)(bta + c + 4);
        const f32x4 y0 = (v[2 * i] - mu) * rstd * g0 + b0, y1 = (v[2 * i + 1] - mu) * rstd * g1 + b1; v[2 * i] = y0; v[2 * i + 1] = y1;
        if (of) { *(f32x4*)(of + c) = y0; *(f32x4*)(of + c + 4) = y1; }
        if (ob) pg8::st_bf16x8(ob + c, y0, y1);
        if (oq) { amax = fmaxf(amax, fmaxf(fmaxf(fmaxf(fabsf(y0[0]), fabsf(y0[1])), fmaxf(fabsf(y0[2]), fabsf(y0[3]))), fmaxf(fmaxf(fabsf(y1[0]), fabsf(y1[1])), fmaxf(fabsf(y1[2]), fabsf(y1[3]))))); } }
    if (oq) {
        for (int o = 32; o > 0; o >>= 1) amax = fmaxf(amax, __shfl_xor(amax, o));
        amax = fmaxf(amax, 1e-20f); const float qi = 127.0f / amax; if (lane == 0) *osc = amax * (1.0f / 127.0f);
#pragma unroll
        for (int i = 0; i < 4; ++i) { u32x2 w;
#pragma unroll
            for (int h = 0; h < 2; ++h) { const f32x4 y = v[2 * i + h]; unsigned pk = 0u;
#pragma unroll
                for (int j = 0; j < 4; ++j) pk |= ((unsigned)(int)rintf(y[j] * qi) & 0xffu) << (8 * j);
                w[h] = pk; }
            *(u32x2*)(oq + (i * 64 + lane) * 8) = w; } }
}
__device__ __forceinline__ void phase_ln1_router(const Frame& F0, const Params& P, int l) { const Frame F = fresh(F0);
    unsigned char* ws = F.ws; const int lane = F.lane, wid = F.wid;
    const bf16_t* pre1 = (const bf16_t*)(ws + R_PRE1); float* x1f = (float*)(ws + M_X1F); bf16_t* x1b = (bf16_t*)(ws + M_X1B); unsigned char* x1q = (unsigned char*)(ws + M_X1Q); float* x1s = (float*)(ws + M_X1S);
    const float* g = F.in(11) + l * DM; const float* bt = F.in(12) + l * DM; const float* wr = F.in(13) + (size_t)l * DM * NEXP; const float* br = F.in(14) + l * NEXP;
    unsigned* cnt = (unsigned*)(ws + WS_CTL) + CW_CNT + l * 2048;
    int* tok_e = (int*)(ws + M_TOKE); int* tok_pos = (int*)(ws + M_TOKPOS); float* tok_w = (float*)(ws + M_TOKW);
    float* red = (float*)F.lds;
    float* lg = (float*)(F.lds + 32768); float* stats = (float*)(F.lds + 32768 + 16384);
#pragma unroll 1
    for (int blk = F.bid; blk < NTOK / 64; blk += F.G) {
        const int tok0 = blk * 64;
#pragma unroll 1
        for (int ib = 0; ib < 2; ++ib) { u32x4 w4[4][4];
#pragma unroll
            for (int r = 0; r < 4; ++r)
#pragma unroll
                for (int i = 0; i < 4; ++i) w4[r][i] = *(const u32x4*)(pre1 + (size_t)(tok0 + wid * 8 + ib * 4 + r) * DM + (i * 64 + lane) * 8);
#pragma unroll
            for (int r = 0; r < 4; ++r) { const int i8 = ib * 4 + r, tok = tok0 + wid * 8 + i8; ln_row_w(w4[r], g, bt, (float*)nullptr, x1b + (size_t)tok * DM, lane, x1q + (size_t)tok * DM, x1s + tok, stats + 2 * (wid * 8 + i8)); } }
        asm volatile("s_waitcnt vmcnt(0)" ::: "memory"); __syncthreads();
        { const int grp = wid >> 2, kq = wid & 3, i32 = lane & 31, hk = lane >> 5; f32x16 acc = {};
          const bf16_t* arow = pre1 + (size_t)(tok0 + grp * 32 + i32) * DM + kq * 512 + 4 * hk; const float* bcol = wr + (size_t)(kq * 512 + 4 * hk) * NEXP + i32;
          const float* gp = g + kq * 512 + 4 * hk; const float* bp = bt + kq * 512 + 4 * hk; const float mu = stats[2 * (grp * 32 + i32)], rstd = stats[2 * (grp * 32 + i32) + 1];
#pragma unroll 8
          for (int c8 = 0; c8 < 64; ++c8) { const u32x2 xw = *(const u32x2*)(arow + c8 * 8); const f32x4 g4 = *(const f32x4*)(gp + c8 * 8), b4 = *(const f32x4*)(bp + c8 * 8);
              const f32x4 a4 = ((f32x4){bflo(xw.x), bfhi(xw.x), bflo(xw.y), bfhi(xw.y)} - mu) * rstd * g4 + b4;
              const float b0 = bcol[(size_t)(c8 * 8 + 0) * NEXP], b1 = bcol[(size_t)(c8 * 8 + 1) * NEXP], b2 = bcol[(size_t)(c8 * 8 + 2) * NEXP], b3 = bcol[(size_t)(c8 * 8 + 3) * NEXP];
              acc = __builtin_amdgcn_mfma_f32_32x32x2f32(a4[0], b0, acc, 0, 0, 0); acc = __builtin_amdgcn_mfma_f32_32x32x2f32(a4[1], b1, acc, 0, 0, 0);
              acc = __builtin_amdgcn_mfma_f32_32x32x2f32(a4[2], b2, acc, 0, 0, 0); acc = __builtin_amdgcn_mfma_f32_32x32x2f32(a4[3], b3, acc, 0, 0, 0); }
#pragma unroll
          for (int r = 0; r < 16; ++r) red[(wid * 16 + r) * 64 + lane] = acc[r]; }
        __syncthreads();
        if ((wid & 3) == 0) { const int grp = wid >> 2, hk = lane >> 5, e = lane & 31; const float be = br[e];
#pragma unroll
            for (int r = 0; r < 16; ++r) { const float v = red[((wid + 0) * 16 + r) * 64 + lane] + red[((wid + 1) * 16 + r) * 64 + lane] + red[((wid + 2) * 16 + r) * 64 + lane] + red[((wid + 3) * 16 + r) * 64 + lane] + be;
                lg[(grp * 32 + crow(r, hk)) * 33 + e] = v; }
            asm volatile("s_waitcnt lgkmcnt(0)" ::: "memory"); SBAR();
            const int tk = lane & 31; float v[32];
#pragma unroll
            for (int e2 = 0; e2 < 32; ++e2) v[e2] = lg[(grp * 32 + tk) * 33 + e2];
            int ek[4]; float vk[4];
#pragma unroll
            for (int k = 0; k < 4; ++k) { float best = -__builtin_inff(); int bi = 0;
#pragma unroll
                for (int e2 = 0; e2 < 32; ++e2) if (v[e2] > best) { best = v[e2]; bi = e2; }
                ek[k] = bi; vk[k] = best;
#pragma unroll
                for (int e2 = 0; e2 < 32; ++e2) v[e2] = (e2 == bi) ? -__builtin_inff() : v[e2]; }
            float wk[4], sw = 0.f;
#pragma unroll
            for (int k = 0; k < 4; ++k) { wk[k] = __expf(vk[k] - vk[0]); sw += wk[k]; }
            const float rs = 1.0f / sw;
            const bool act = lane < 32; unsigned myc = 0u;
#pragma unroll 1
            for (int E = 0; E < 32; ++E) { unsigned c = 0u;
#pragma unroll
                for (int k = 0; k < 4; ++k) c += (unsigned)__popcll(__ballot(act && ek[k] == E));
                if (lane == E) myc = c; }
            unsigned run = 0u; if (lane < 32 && myc > 0u) run = atomicAdd(&cnt[lane * 64], myc);
            int pk[4];
#pragma unroll
            for (int k = 0; k < 4; ++k) { pk[k] = 0;
#pragma unroll 1
                for (int E = 0; E < 32; ++E) { const unsigned long long mm = __ballot(act && ek[k] == E); const unsigned basev = (unsigned)__shfl((int)run, E);
                    if (act && ek[k] == E) pk[k] = (int)(basev + (unsigned)__popcll(mm & ((1ull << lane) - 1ull)));
                    if (lane == E) run += (unsigned)__popcll(mm); } }
            if (act) { const int tok = tok0 + grp * 32 + tk;
#pragma unroll
                for (int k = 0; k < 4; ++k) { tok_e[tok * 4 + k] = ek[k]; tok_pos[tok * 4 + k] = pk[k]; tok_w[tok * 4 + k] = wk[k] * rs; } }
        }
        __syncthreads();
    }
}
__device__ __forceinline__ void phase_moe_gather(const Frame& F0, int l) { const Frame F = fresh(F0);
    unsigned char* ws = F.ws; const int lane = F.lane;
    const unsigned* cnt = (const unsigned*)(ws + WS_CTL) + CW_CNT + l * 2048; unsigned* meta = (unsigned*)(ws + WS_CTL) + CW_META + l * 512;
    unsigned* offs = (unsigned*)(F.lds + LDS_MISC + 64);
    if (F.tid < 64) {
        const unsigned ce = lane < 32 ? cnt[lane * 64] : 0u, pc = (ce + 255u) & ~255u; unsigned inc = pc;
#pragma unroll
        for (int o = 1; o < 64; o <<= 1) { const unsigned n = (unsigned)__shfl_up((int)inc, o); if (lane >= o) inc += n; }
        if (lane < 32) offs[lane] = inc - pc; if (lane == 32) offs[32] = inc;
        if (F.bid == 0) { const unsigned t0 = (inc - pc) >> 8, nte = pc >> 8; for (unsigned t = 0; t < nte; ++t) meta[1 + t0 + t] = (unsigned)lane; if (lane == 32) meta[0] = inc >> 8; } }
    __syncthreads();
    const int* tok_e = (const int*)(ws + M_TOKE); const int* tok_pos = (const int*)(ws + M_TOKPOS); const float* tok_w = (const float*)(ws + M_TOKW);
    int* tok_dst = (int*)(ws + M_TOKDST); float* roww = (float*)(ws + M_ROWW);
    const unsigned char* x1q = (const unsigned char*)(ws + M_X1Q); const float* x1s = (const float*)(ws + M_X1S); unsigned char* xs = (unsigned char*)(ws + M_XS); float* rowsx = (float*)(ws + M_ROWSX);
    unsigned* rowtok = (unsigned*)(ws + M_ROWTOK);
    for (int it = F.bid * 512 + F.tid; it < NTOK * 4; it += F.G * 512) { const int tok = it >> 2;
        const int e = tok_e[it]; const unsigned dst = offs[e] + (unsigned)tok_pos[it];
        tok_dst[it] = (int)dst; roww[dst] = tok_w[it]; rowsx[dst] = x1s[tok]; rowtok[dst] = (unsigned)tok; }
    if (F.bid < 32) { const unsigned e = (unsigned)F.bid, c0 = offs[e] + cnt[e * 64];
        for (unsigned r = c0 + (unsigned)F.tid; r < offs[e + 1]; r += 512u) rowtok[r] = 0u; }
    __syncthreads();
}
__device__ __forceinline__ void phase_quant_h(const Frame& F0, int l) { const Frame F = fresh(F0);
    unsigned char* ws = F.ws; const int lane = F.lane;
    const int nrows = (int)((const unsigned*)(ws + WS_CTL))[CW_META + l * 512] * 256;
    const float* hm = (const float*)(ws + M_HM); const bf16_t* hid = (const bf16_t*)(ws + M_HID); unsigned char* h8 = (unsigned char*)(ws + M_H8); float* h8s = (float*)(ws + M_H8S);
    for (int row = F.bid * 8 + F.wid; row < nrows; row += F.G * 8) {
        float am = hm[(size_t)row * 32 + (lane & 31)];
        const u32x4 a = *(const u32x4*)(hid + (size_t)row * DEXP + lane * 16), b = *(const u32x4*)(hid + (size_t)row * DEXP + lane * 16 + 8);
        for (int o = 16; o > 0; o >>= 1) am = fmaxf(am, __shfl_xor(am, o));
        am = fmaxf(am, 1e-20f); const float qi = 127.0f / am; if (lane == 0) h8s[row] = am * (1.0f / 127.0f);
        const unsigned wv[8] = {a.x, a.y, a.z, a.w, b.x, b.y, b.z, b.w}; u32x4 w;
#pragma unroll
        for (int d = 0; d < 4; ++d) { unsigned pk = 0u;
#pragma unroll
            for (int j = 0; j < 2; ++j) { const unsigned x = wv[d * 2 + j];
                const float q0 = fminf(fmaxf(rintf(bflo(x) * qi), -127.f), 127.f), q1 = fminf(fmaxf(rintf(bfhi(x) * qi), -127.f), 127.f);
                pk |= (((unsigned)(int)q0 & 0xffu) | (((unsigned)(int)q1 & 0xffu) << 8)) << (16 * j); }
            w[d] = pk; }
        *(u32x4*)(h8 + (size_t)row * DEXP + lane * 16) = w; }
}
__device__ __forceinline__ void phase_combine(const Frame& F0) { const Frame F = fresh(F0);
    unsigned char* ws = F.ws; const int lane = F.lane;
    const bf16_t* x1b = (const bf16_t*)(ws + M_X1B); const bf16_t* ys = (const bf16_t*)(ws + M_XS); const int* tok_dst = (const int*)(ws + M_TOKDST);
    bf16_t* hb = (bf16_t*)(ws + M_HB); unsigned char* hq = (unsigned char*)(ws + M_HQ); float* hsc = (float*)(ws + M_HSC);
    for (int tok = F.bid * 8 + F.wid; tok < NTOK; tok += F.G * 8) {
        const int d0 = tok_dst[tok * 4], d1 = tok_dst[tok * 4 + 1], d2 = tok_dst[tok * 4 + 2], d3 = tok_dst[tok * 4 + 3];
        f32x4 hv[8]; float amax = 0.f;
#pragma unroll
        for (int i = 0; i < 4; ++i) { const int c = (i * 64 + lane) * 8; const size_t o = (size_t)tok * DM + c;
            const u32x4 xw = *(const u32x4*)(x1b + o);
            f32x4 a = (f32x4){bflo(xw.x), bfhi(xw.x), bflo(xw.y), bfhi(xw.y)} * ALPHA, b = (f32x4){bflo(xw.z), bfhi(xw.z), bflo(xw.w), bfhi(xw.w)} * ALPHA;
            const u32x4 y0 = *(const u32x4*)(ys + (size_t)d0 * DM + c), y1 = *(const u32x4*)(ys + (size_t)d1 * DM + c), y2 = *(const u32x4*)(ys + (size_t)d2 * DM + c), y3 = *(const u32x4*)(ys + (size_t)d3 * DM + c);
            a[0] += (bflo(y0.x) + bflo(y1.x)) + (bflo(y2.x) + bflo(y3.x)); a[1] += (bfhi(y0.x) + bfhi(y1.x)) + (bfhi(y2.x) + bfhi(y3.x));
            a[2] += (bflo(y0.y) + bflo(y1.y)) + (bflo(y2.y) + bflo(y3.y)); a[3] += (bfhi(y0.y) + bfhi(y1.y)) + (bfhi(y2.y) + bfhi(y3.y));
            b[0] += (bflo(y0.z) + bflo(y1.z)) + (bflo(y2.z) + bflo(y3.z)); b[1] += (bfhi(y0.z) + bfhi(y1.z)) + (bfhi(y2.z) + bfhi(y3.z));
            b[2] += (bflo(y0.w) + bflo(y1.w)) + (bflo(y2.w) + bflo(y3.w)); b[3] += (bfhi(y0.w) + bfhi(y1.w)) + (bfhi(y2.w) + bfhi(y3.w));
            pg8::st_bf16x8(hb + o, a, b); hv[2 * i] = a; hv[2 * i + 1] = b;
#pragma unroll
            for (int j = 0; j < 4; ++j) amax = fmaxf(amax, fmaxf(fabsf(a[j]), fabsf(b[j]))); }
        for (int o = 32; o > 0; o >>= 1) amax = fmaxf(amax, __shfl_xor(amax, o));
        amax = fmaxf(amax, 1e-20f); const float qi = 127.0f / amax; if (lane == 0) hsc[tok] = amax * (1.0f / 127.0f);
#pragma unroll
        for (int i = 0; i < 4; ++i) { u32x2 w;
#pragma unroll
            for (int h = 0; h < 2; ++h) { unsigned pk = 0u;
#pragma unroll
                for (int j = 0; j < 4; ++j) pk |= ((unsigned)(int)rintf(hv[2 * i + h][j] * qi) & 0xffu) << (8 * j);
                w[h] = pk; }
            *(u32x2*)(hq + (size_t)tok * DM + (i * 64 + lane) * 8) = w; } }
}
__device__ __forceinline__ void phase_ln2(const Frame& F0, const Params& P, int l) { const Frame F = fresh(F0);
    unsigned char* ws = F.ws; const bf16_t* pre2 = (const bf16_t*)(ws + M_X1F); bf16_t* xb = (bf16_t*)(ws + WS_XB);
    const float* g = F.in(23) + l * DM; const float* bt = F.in(24) + l * DM; float* outp = F.out();
    const int lane = F.lane, step = F.G * 8;
#pragma unroll 1
    for (int tok0 = F.bid * 8 + F.wid; tok0 < NTOK; tok0 += 4 * step) { u32x4 w4[4][4];
#pragma unroll
        for (int r = 0; r < 4; ++r) { const int tk = (tok0 + r * step) < NTOK ? tok0 + r * step : tok0;
#pragma unroll
            for (int i = 0; i < 4; ++i) w4[r][i] = *(const u32x4*)(pre2 + (size_t)tk * DM + (i * 64 + lane) * 8); }
#pragma unroll
        for (int r = 0; r < 4; ++r) { const int tok = tok0 + r * step; if (tok < NTOK)
            ln_row_w(w4[r], g, bt, (l + 1 == NLAYER) ? outp + (size_t)tok * DM : (float*)nullptr, (l + 1 == NLAYER) ? (bf16_t*)nullptr : xb + (size_t)tok * DM, lane,
                     (l + 1 == NLAYER) ? (unsigned char*)nullptr : (unsigned char*)(ws + WS_XQ) + (size_t)tok * DM, (l + 1 == NLAYER) ? (float*)nullptr : (float*)(ws + WS_XSC) + tok); } }
}

constexpr int NPHASE = 2 + 15 * NLAYER;
#ifdef PH_ONLY
#define PEN(kind) ((kind) == PH_ONLY)
#else
#define PEN(kind) true
#endif
#define IN(k) (lo <= (k) && (k) < hi)
#define SEAM(k) do { if (IN((k) + 1)) xcd_barrier(bar); } while (0)

template <int l>
__device__ __forceinline__ void layer_phases(const Frame& F, const Params& P, const XcdBarrier& bar, const int lo, const int hi, unsigned char* ws0) {
    using namespace pg8;

        const int pb = 2 + 15 * l;
        if (IN(pb + 0) && PEN(0)) { size_t wz = 0; asm volatile("" : "+s"(wz)); unsigned char* ws = ws0 + wz;
            { SchedS S; S.init(NTOK, 5 * 256, F.G, F.bid, (const bf16_t*)(ws + WS_XB), DM, (const bf16_t*)(ws + W_IN), DM); S.skip_from = 0; S.skip_by = 4; S.skip_from2 = 4; S.skip_by2 = 49;
              EpiInProj<false> E{(bf16_t*)(ws + R_QA), (bf16_t*)(ws + R_QIDX), (bf16_t*)(ws + R_QKV), (bf16_t*)(ws + R_GATES), (float*)(ws + R_SMALL), nullptr, nullptr};
              for (int rep = 0; rep < NREP(5); ++rep) gemm_phase(F.ldsl, DM, DM, DM, S, E); }
            { SchedS S; S.init(NTOK, 53 * 256, F.G, (F.bid + F.G / 2) % F.G, (const bf16_t*)(ws + WS_XQ), DM / 2, (const bf16_t*)(ws + W_IN8), DM / 2); S.skip_from = 4; S.skip_by = 4; S.b_compact = 1;
              if (F.G == 256) { S.c = F.bid; S.cut = 12; S.extra_n = 192; S.extra_c = F.bid >= 64 ? F.bid - 64 : -1; }
              EpiInProj<true> E{(bf16_t*)(ws + R_QA), (bf16_t*)(ws + R_QIDX), (bf16_t*)(ws + R_QKV), (bf16_t*)(ws + R_GATES), (float*)(ws + R_SMALL), (const float*)(ws + WS_XSC), (const unsigned*)(ws + WS_CTL) + CW_WMAXG + l};
              for (int rep = 0; rep < NREP(5); ++rep) gemm_phase(F.ldsl, DM / 2, DM / 2, DM / 2, S, E); }
            SEAM(pb + 0); }
        if (IN(pb + 1) && PEN(1)) { size_t wz = 0; asm volatile("" : "+s"(wz)); unsigned char* ws = ws0 + wz;
            phase_prep(F, P, l);
            SchedS S; S.init(NTOK, 2048, F.G, F.bid, (const bf16_t*)(ws + R_QA), 1024, (const bf16_t*)(ws + W_UK2), 256, 1, 256);
            EpiBf16 E{(bf16_t*)(ws + R_QCAT), 2304, 288};
            for (int rep = 0; rep < NREP(10); ++rep) gemm_phase(F.ldsl, 256, 1024, 256, S, E); SEAM(pb + 1); }
        if (IN(pb + 2) && PEN(2)) { size_t wz = 0; asm volatile("" : "+s"(wz)); unsigned char* ws = ws0 + wz; phase_cumsum(F); for (int rep = 0; rep < NREP(3); ++rep) phase_idx(F); SEAM(pb + 2); }
        if (IN(pb + 3) && PEN(3)) { size_t wz = 0; asm volatile("" : "+s"(wz)); unsigned char* ws = ws0 + wz; for (int rep = 0; rep < NREP(4); ++rep) phase_topk(F); SEAM(pb + 3); }
        if (IN(pb + 4) && PEN(4)) { size_t wz = 0; asm volatile("" : "+s"(wz)); unsigned char* ws = ws0 + wz; for (int rep = 0; rep < NREP(1); ++rep) phase_attn(F, l, rep); SEAM(pb + 4); }
        if (IN(pb + 5) && PEN(5)) { size_t wz = 0; asm volatile("" : "+s"(wz)); unsigned char* ws = ws0 + wz;
            SchedS S; S.init(NTOK, 1024, F.G, F.bid, (const bf16_t*)(ws + R_OLAT), 2048, (const bf16_t*)(ws + W_UV2), 512, 0, 512);
            EpiBf16 E{(bf16_t*)(ws + R_OA), 3072, 256}; for (int rep = 0; rep < NREP(10); ++rep) gemm_phase(F.ldsl, 512, 2048, 512, S, E);
            SEAM(pb + 5); }
        if (IN(pb + 6) && PEN(6)) { size_t wz = 0; asm volatile("" : "+s"(wz)); unsigned char* ws = ws0 + wz;
            SchedS S; S.init(NTOK, 2048, F.G, F.bid, (const bf16_t*)(ws + R_OA), 3072, (const bf16_t*)(ws + W_BRA), 3072);
            EpiBranch3 E{(const unsigned char*)(ws + R_GATES), (bf16_t*)(ws + R_MERGED)}; for (int rep = 0; rep < NREP(11); ++rep) gemm_phase(F.ldsl, 3072, 3072, 3072, S, E); SEAM(pb + 6); }
        if (IN(pb + 7) && PEN(7)) { size_t wz = 0; asm volatile("" : "+s"(wz)); unsigned char* ws = ws0 + wz;
            SchedS S; S.init(NTOK, 2048, F.G, F.bid, (const bf16_t*)(ws + R_MERGED), DM, (const bf16_t*)(ws + W_OUT), DM);
            EpiOut E{(const bf16_t*)(ws + WS_XB), (bf16_t*)(ws + R_PRE1)}; for (int rep = 0; rep < NREP(8); ++rep) gemm_phase(F.ldsl, DM, DM, DM, S, E); SEAM(pb + 7); }
        if (IN(pb + 8) && PEN(8)) { size_t wz = 0; asm volatile("" : "+s"(wz)); unsigned char* ws = ws0 + wz; phase_ln1_router(F, P, l); SEAM(pb + 8); }
        if (IN(pb + 9) && PEN(9)) { size_t wz = 0; asm volatile("" : "+s"(wz)); unsigned char* ws = ws0 + wz;
            for (int rep = 0; rep < NREP(12); ++rep) phase_moe_gather(F, l);
            SchedS S; S.init(NTOK, 2048, F.G, F.bid, (const bf16_t*)(ws + WS_PB) + (size_t)l * NTOK * 256, 256, (const bf16_t*)(ws + W_PLE), 256);
            EpiBf16 E{(bf16_t*)(ws + M_PP), 2048, 256}; for (int rep = 0; rep < NREP(10); ++rep) gemm_phase(F.ldsl, 256, 256, 256, S, E); SEAM(pb + 9); }
        if (IN(pb + 10) && PEN(10)) { size_t wz = 0; asm volatile("" : "+s"(wz)); unsigned char* ws = ws0 + wz;
            SchedMG S; S.init((const unsigned*)(ws + WS_CTL) + CW_META + l * 512, F.G, F.bid, (const bf16_t*)(ws + M_X1Q), DM / 2, (const bf16_t*)(ws + W_GU), DM / 2);
            { LAS unsigned* gt = (LAS unsigned*)(F.ldsl + pg8::GTAB_OFF); const unsigned* rowtok = (const unsigned*)(ws + M_ROWTOK);
              for (int ui = 0; ui * F.G + F.bid < S.ntiles * 8; ++ui) { const int pm = (ui * F.G + F.bid) >> 3; if (F.tid < 256) gt[ui * 256 + F.tid] = rowtok[pm * 256 + F.tid] * 2048u; }
              __syncthreads(); }
            EpiGateUpI8 E{F.in(16) + (size_t)l * NEXP * DEXP, F.in(18) + (size_t)l * NEXP * DEXP, (bf16_t*)(ws + M_HID), (const float*)(ws + M_ROWSX), (const unsigned*)(ws + WS_CTL) + CW_WMAX + l, (float*)(ws + M_HM)};
            for (int rep = 0; rep < NREP(6); ++rep) gemm_phase(F.ldsl, DM / 2, DM / 2, DM / 2, S, E); SEAM(pb + 10); }
        if (IN(pb + 11) && PEN(11)) { size_t wz = 0; asm volatile("" : "+s"(wz)); unsigned char* ws = ws0 + wz;
            phase_quant_h(F, l); xcd_barrier(bar);
            SchedM S; S.init((const unsigned*)(ws + WS_CTL) + CW_META + l * 512, F.G, F.bid, (const bf16_t*)(ws + M_H8), DEXP / 2, (const bf16_t*)(ws + W_DN), DEXP / 2);
            EpiDownI8 E{F.in(20) + (size_t)l * NEXP * DM, (const float*)(ws + M_ROWW), (bf16_t*)(ws + M_XS), (const float*)(ws + M_H8S), (const unsigned*)(ws + WS_CTL) + CW_WMAXD + l};
            for (int rep = 0; rep < NREP(7); ++rep) gemm_phase(F.ldsl, DEXP / 2, DEXP / 2, DEXP / 2, S, E); SEAM(pb + 11); }
        if (IN(pb + 12) && PEN(12)) { size_t wz = 0; asm volatile("" : "+s"(wz)); unsigned char* ws = ws0 + wz; for (int rep = 0; rep < NREP(9); ++rep) phase_combine(F); SEAM(pb + 12); }
        if (IN(pb + 13) && PEN(13)) { size_t wz = 0; asm volatile("" : "+s"(wz)); unsigned char* ws = ws0 + wz;
            SchedS S; S.init(NTOK, 2048, F.G, F.bid, (const bf16_t*)(ws + M_HQ), DM / 2, (const bf16_t*)(ws + W_PG), DM / 2);
            EpiPleGateI8 E{(const bf16_t*)(ws + M_HB), (const bf16_t*)(ws + M_PP), (bf16_t*)(ws + M_X1F), (const float*)(ws + M_HSC), (const unsigned*)(ws + WS_CTL) + CW_WMAXP + l};
            for (int rep = 0; rep < NREP(8); ++rep) gemm_phase(F.ldsl, DM / 2, DM / 2, DM / 2, S, E); SEAM(pb + 13); }
        if (IN(pb + 14) && PEN(14)) { size_t wz = 0; asm volatile("" : "+s"(wz)); unsigned char* ws = ws0 + wz; for (int rep = 0; rep < NREP(13); ++rep) phase_ln2(F, P, l); if (l + 1 < NLAYER) for (int rep = 0; rep < NREP(0); ++rep) convert_layer_weights(F, P, l + 1); SEAM(pb + 14); }
}
__global__ void __launch_bounds__(512, 2) fwd(Params P) {
    extern __shared__ __attribute__((aligned(16))) unsigned char lds[];
    Frame F; F.lds = lds; F.ldsl = (LAS unsigned char*)lds; F.ws = P.ws; F.tid = threadIdx.x; F.lane = F.tid & 63; F.wid = __builtin_amdgcn_readfirstlane(F.tid >> 6); F.G = gridDim.x; F.bid = blockIdx.x;
    unsigned char* ws0 = P.ws; unsigned char* ws = ws0;
    const bool fused = (P.ph_hi - P.ph_lo) > 1;
    if (F.tid < 4) ((LAS unsigned*)(F.ldsl + LDS_MISC))[F.tid] = 0u;
    if (F.tid == 0) { LAS unsigned long long* t = (LAS unsigned long long*)(F.ldsl + LDS_PTRS);
#pragma unroll
        for (int k = 0; k < 25; ++k) t[k] = (unsigned long long)P.in[k];
        t[25] = (unsigned long long)P.out; }
    __syncthreads();
    XcdBarrier bar; bar.bar = (unsigned*)(ws + WS_CTL) + CW_BAR; bar.x = 0; bar.st = (volatile LAS unsigned*)(F.ldsl + LDS_MISC);
    if (fused) bar = xcd_barrier_post((unsigned*)(ws + WS_CTL) + CW_BAR, (volatile LAS unsigned*)(F.ldsl + LDS_MISC));
    const int lo = P.ph_lo, hi = P.ph_hi;
    using namespace pg8;
    if (IN(0) && PEN(15)) { size_t wz = 0; asm volatile("" : "+s"(wz)); unsigned char* ws = ws0 + wz;
        quant_rows(F, F.in(0), (bf16_t*)(ws + WS_XB), (unsigned char*)(ws + WS_XQ), (float*)(ws + WS_XSC));
        conv_rows(F, F.in(1), (bf16_t*)(ws + WS_PB), (size_t)2 * NTOK * 256 / 8);
        sample_wmax(F);
        SEAM(0);
    }
    if (IN(1) && PEN(15)) { for (int rep = 0; rep < NREP(0); ++rep) convert_layer_weights(F, P, 0); SEAM(1); }
    layer_phases<0>(F, P, bar, lo, hi, ws0);
    layer_phases<1>(F, P, bar, lo, hi, ws0);
}

#ifdef DEBUG_NAN
constexpr int CW_FLAGS = 12288;
__global__ void dbg_scan_bf16(const unsigned short* p, size_t n, unsigned* flag) { unsigned c = 0; for (size_t i = (size_t)blockIdx.x * blockDim.x + threadIdx.x; i < n; i += (size_t)gridDim.x * blockDim.x) if ((p[i] & 0x7F80u) == 0x7F80u) ++c; if (c) atomicAdd(flag, c); }
__global__ void dbg_scan_f32(const unsigned* p, size_t n, unsigned* flag) { unsigned c = 0; for (size_t i = (size_t)blockIdx.x * blockDim.x + threadIdx.x; i < n; i += (size_t)gridDim.x * blockDim.x) if ((p[i] & 0x7F800000u) == 0x7F800000u) ++c; if (c) atomicAdd(flag, c); }
__global__ void dbg_scan_sel(const int* sel, const int* nsel, unsigned* flag) { unsigned c = 0; for (size_t i = (size_t)blockIdx.x * blockDim.x + threadIdx.x; i < (size_t)NTOK * 256; i += (size_t)gridDim.x * blockDim.x) { const int tok = (int)(i >> 8), j = (int)(i & 255), t = tok & (SEQ - 1); const int ns = nsel[tok]; if (j == 0 && ns != (t + 1 < 256 ? t + 1 : 256)) ++c; if (j < ns && (sel[i] < 0 || sel[i] > t)) ++c; } if (c) atomicAdd(flag, c); }
__global__ void dbg_scan_scores(const unsigned* p, unsigned* flag) { unsigned c = 0; for (size_t i = (size_t)blockIdx.x * blockDim.x + threadIdx.x; i < 2ull * SEQ * SEQ; i += (size_t)gridDim.x * blockDim.x) { const int s = (int)(i & (SEQ - 1)), t = (int)((i >> 13) & (SEQ - 1)); if (s <= t && (p[i] & 0x7F800000u) == 0x7F800000u) ++c; } if (c) atomicAdd(flag, c); }
__global__ void dbg_probe_bf16(const unsigned short* p, size_t n, unsigned* cnt, unsigned* minidx) { unsigned c = 0; unsigned mi = 0xFFFFFFFFu; for (size_t i = (size_t)blockIdx.x * blockDim.x + threadIdx.x; i < n; i += (size_t)gridDim.x * blockDim.x) if ((p[i] & 0x7F80u) == 0x7F80u) { ++c; if ((unsigned)i < mi) mi = (unsigned)i; } if (c) { atomicAdd(cnt, c); atomicMax(minidx, ~mi); } }
__global__ void dbg_final(float* out, size_t n, const unsigned* flags) { int code = 0; for (int k = 0; k < 32; ++k) if (flags[k] && !code) code = k + 1; const int mask = (flags[32] ? 1 : 0) | (flags[33] ? 2 : 0) | (flags[34] ? 4 : 0); if (mask) code = 20 + 5 * mask; if (!code) return; for (size_t i = (size_t)blockIdx.x * blockDim.x + threadIdx.x; i < n; i += (size_t)gridDim.x * blockDim.x) out[i] = (float)code; }
#endif
extern "C" void kernel_launch(void* const* d_in, const int* in_sizes, int n_in, void* d_out, int out_size, void* d_ws, size_t ws_size, hipStream_t stream) {
    static int grid = 0;
    if (grid == 0) {
        if (n_in != 25 || out_size != NTOK * DM || ws_size < WS_NEED) { fprintf(stderr, "kernel_launch: unexpected shapes (n_in %d out %d ws %zu need %zu)\n", n_in, out_size, ws_size, (size_t)WS_NEED); grid = -1; return; }
        int dev = 0, cus = 0, per_cu = 0;
        if (hipGetDevice(&dev) != hipSuccess || hipDeviceGetAttribute(&cus, hipDeviceAttributeMultiprocessorCount, dev) != hipSuccess) { grid = -1; return; }
        if (hipFuncSetAttribute((const void*)fwd, hipFuncAttributeMaxDynamicSharedMemorySize, LDS_BYTES) != hipSuccess) { fprintf(stderr, "kernel_launch: hipFuncSetAttribute failed\n"); grid = -1; return; }
        if (hipOccupancyMaxActiveBlocksPerMultiprocessor(&per_cu, (const void*)fwd, 512, LDS_BYTES) != hipSuccess || per_cu < 1) fprintf(stderr, "kernel_launch: occupancy query says %d\n", per_cu);
        (void)hipGetLastError();
        grid = cus;
    }
    if (grid < 0) return;
    unsigned char* ws = (unsigned char*)d_ws;
    hipMemsetAsync(ws + WS_CTL, 0, CTL_BYTES, stream);
    hipMemsetAsync(ws + W_UK2, 0, 8ull * 256 * 256 * 2 + 4ull * 256 * 512 * 2, stream);
    hipMemsetAsync(ws + W_IN + (size_t)INW * 2048 * 2, 0, (size_t)(INWP - INW) * 2048 * 2, stream);
    Params p{};
    for (int i = 0; i < 25; ++i) p.in[i] = (const float*)d_in[i];
    p.out = (float*)d_out; p.ws = ws;
#if PHASES_PER_LAUNCH == 0
    p.ph_lo = 0; p.ph_hi = NPHASE;
    hipLaunchKernelGGL(fwd, dim3(grid), dim3(512), LDS_BYTES, stream, p);
#else
    for (int k = 0; k < NPHASE; ++k) { p.ph_lo = k; p.ph_hi = k + 1; hipLaunchKernelGGL(fwd, dim3(grid), dim3(512), LDS_BYTES, stream, p);
#ifdef DEBUG_NAN
        unsigned* fl = (unsigned*)(ws + WS_CTL) + CW_FLAGS + k;
#define SB16(off, n) hipLaunchKernelGGL(dbg_scan_bf16, dim3(1024), dim3(256), 0, stream, (const unsigned short*)(ws + (off)), (size_t)(n), fl)
#define SF32(off, n) hipLaunchKernelGGL(dbg_scan_f32, dim3(1024), dim3(256), 0, stream, (const unsigned*)(ws + (off)), (size_t)(n), fl)
        if (k == 0) { SB16(WS_XB, (size_t)NTOK * DM); SB16(WS_PB, 2ull * NTOK * 256); SB16(WS_W, (W_END - WS_W) / 2); }
        else { const int kind = (k - 1) % 15;
            if (kind == 0) { SB16(R_QA, (size_t)NTOK * 1024); SB16(R_QIDX, (size_t)NTOK * 1024); SB16(R_QKV, 6ull * NTOK * 1024); SB16(R_GATES, (size_t)NTOK * 6144); SF32(R_SMALL, (size_t)NTOK * 512); }
            if (kind == 1) { SB16(R_QCAT, (size_t)NTOK * 2304); SB16(R_KCAT, (size_t)NTOK * 288); SB16(R_KI, (size_t)NTOK * 64); SB16(R_QIDX, (size_t)NTOK * 1024); SF32(R_WI, (size_t)NTOK * 16); SF32(WS_LF, 16ull * 8192); }
            if (kind == 2) { SF32(WS_CUM, 16ull * 8192); hipLaunchKernelGGL(dbg_scan_scores, dim3(1024), dim3(256), 0, stream, (const unsigned*)(ws + R_SCORES), fl); }
            if (kind == 3) { hipLaunchKernelGGL(dbg_scan_sel, dim3(1024), dim3(256), 0, stream, (const int*)(ws + R_SEL), (const int*)(ws + R_NSEL), fl); }
            if (k == 5) { unsigned* fl0 = fl; fl = (unsigned*)(ws + WS_CTL) + CW_FLAGS + 32; SB16(R_OLAT, (size_t)NTOK * 2048); fl += 1; SB16(R_OA, (size_t)NTOK * 3072); fl += 1; fl = fl0; hipLaunchKernelGGL(dbg_probe_bf16, dim3(1024), dim3(256), 0, stream, (const unsigned short*)(ws + R_OC), (size_t)NTOK * 1024, (unsigned*)(ws + WS_CTL) + CW_FLAGS + 40, (unsigned*)(ws + WS_CTL) + CW_FLAGS + 41); }
            if (kind == 5) { SB16(R_OA, (size_t)NTOK * 3072); }
            if (kind == 6) { SB16(R_MERGED, (size_t)NTOK * 2048); }
            if (kind == 7) { SF32(R_PRE1, (size_t)NTOK * 2048); }
            if (kind == 8) { SF32(M_X1F, (size_t)NTOK * 2048); SF32(M_TOKW, (size_t)NTOK * 4); }
            if (kind == 9) { SB16(M_PP, (size_t)NTOK * 2048); }
            if (kind == 12) { SF32(M_HF, (size_t)NTOK * 2048); }
            if (kind == 13) { SF32(M_X1F, (size_t)NTOK * 2048); }
            if (kind == 14) { hipLaunchKernelGGL(dbg_scan_f32, dim3(1024), dim3(256), 0, stream, (const unsigned*)d_out, (size_t)NTOK * DM, fl); if (k + 1 < NPHASE) SB16(WS_W, (W_END - WS_W) / 2); } }
#endif
    }
#ifdef DEBUG_NAN
    hipLaunchKernelGGL(dbg_final, dim3(1024), dim3(256), 0, stream, (float*)d_out, (size_t)NTOK * DM, (const unsigned*)(ws + WS_CTL) + CW_FLAGS);
#endif
#endif
}
```

```cpp
#include <hip/hip_runtime.h>
#include <stdint.h>
#include <stdio.h>
#include <math.h>

#ifndef PHASES_PER_LAUNCH
#define PHASES_PER_LAUNCH 0
#endif

#define LAS __attribute__((address_space(3)))
#define GAS __attribute__((address_space(1)))
#ifndef REP_MASK
#define REP_MASK 0
#endif
#define NREP(bit) (((REP_MASK) >> (bit)) & 1 ? 2 : 1)
typedef unsigned short bf16_t;
typedef short bf16x8 __attribute__((ext_vector_type(8)));
typedef short s16x4 __attribute__((ext_vector_type(4)));
typedef float f32x4 __attribute__((ext_vector_type(4)));
typedef float f32x16 __attribute__((ext_vector_type(16)));
typedef unsigned u32x4 __attribute__((ext_vector_type(4)));
typedef unsigned u32x2 __attribute__((ext_vector_type(2)));
typedef int i32x4 __attribute__((ext_vector_type(4)));

constexpr int NTOK = 16384, DM = 2048, SEQ = 8192, NB = 2, NLAYER = 2;
constexpr int INW = 14712, INWP = 14848;
constexpr int NEXP = 32, DEXP = 1024;
constexpr int PMAX = 65536 + 8192;
constexpr float ALPHA = 1.41421356237309515f;
constexpr float LOG2E = 1.4426950408889634f;
constexpr float SCALE = 0.08838834764831845f;
constexpr float C2 = LOG2E * SCALE;

constexpr size_t MiB = 1ull << 20;
constexpr size_t WS_CTL   = 0;
constexpr size_t WS_W     = 1 * MiB;
constexpr size_t W_IN     = WS_W;
constexpr size_t W_IN8    = W_IN   + 2048ull * 2048 * 2;
constexpr size_t W_UK2    = W_IN   + (size_t)INWP * 2048 * 2;
constexpr size_t W_UV2    = W_UK2  + 8ull * 256 * 256 * 2;
constexpr size_t W_BRA    = W_UV2  + 4ull * 256 * 512 * 2;
constexpr size_t W_BRB    = W_BRA  + 2048ull * 1024 * 2;
constexpr size_t W_BRC    = W_BRB  + 2048ull * 1024 * 2;
constexpr size_t W_OUT    = W_BRC  + 2048ull * 1024 * 2;
constexpr size_t W_PG     = W_OUT  + 2048ull * 2048 * 2;
constexpr size_t W_PLE    = W_PG   + 2048ull * 2048 * 2;
constexpr size_t W_GU     = W_PLE  + 2048ull * 256 * 2;
constexpr size_t W_DN     = W_GU   + 32ull * 2048 * 2048 * 2;
constexpr size_t W_END    = W_DN   + 32ull * 2048 * 1024 * 2;
constexpr size_t WS_XB    = (W_END + MiB - 1) / MiB * MiB;
constexpr size_t WS_PB    = WS_XB  + (size_t)NTOK * DM * 2;
constexpr size_t WS_CUM   = WS_PB  + 2ull * NTOK * 256 * 2;
constexpr size_t WS_LF    = WS_CUM + 16ull * 8192 * 4;
constexpr size_t WS_XQ    = WS_LF  + 16ull * 8192 * 4;
constexpr size_t WS_XSC   = WS_XQ  + (size_t)NTOK * DM;
constexpr size_t WS_R     = (WS_XSC + (size_t)NTOK * 4 + MiB - 1) / MiB * MiB;
constexpr size_t R_SCORES = WS_R;
constexpr size_t R_OLAT   = WS_R;
constexpr size_t R_OA     = WS_R + 64 * MiB;
constexpr size_t R_OB     = WS_R + 96 * MiB;
constexpr size_t R_OC     = WS_R + 128 * MiB;
constexpr size_t R_TMP    = WS_R + 160 * MiB;
constexpr size_t R_MERGED = WS_R + 288 * MiB;
constexpr size_t R_PRE1   = WS_R + 384 * MiB;
constexpr size_t R_QA     = WS_R + 512 * MiB;
constexpr size_t R_QIDX   = WS_R + 544 * MiB;
constexpr size_t R_QKV    = WS_R + 576 * MiB;
constexpr size_t R_GATES  = WS_R + 768 * MiB;
constexpr size_t R_SMALL  = WS_R + 960 * MiB;
constexpr size_t R_QCAT   = WS_R + 992 * MiB;
constexpr size_t R_KCAT   = WS_R + 1064 * MiB;
constexpr size_t R_KI     = WS_R + 1073 * MiB;
constexpr size_t R_WI     = WS_R + 1075 * MiB;
constexpr size_t R_SEL    = WS_R + 1076 * MiB;
constexpr size_t R_NSEL   = WS_R + 1092 * MiB;
constexpr size_t R_END    = WS_R + 1093 * MiB;
constexpr size_t M_XS     = WS_R;
constexpr size_t M_HID    = WS_R + 288 * MiB;
constexpr size_t M_PP     = WS_R + 432 * MiB;
constexpr size_t M_X1F    = WS_R + 512 * MiB;
constexpr size_t M_X1B    = WS_R + 640 * MiB;
constexpr size_t M_HF     = WS_R + 704 * MiB;
constexpr size_t M_HQ     = WS_R + 704 * MiB;
constexpr size_t M_HSC    = WS_R + 736 * MiB;
constexpr size_t M_HB     = WS_R + 832 * MiB;
constexpr size_t M_TOKE   = WS_R + 896 * MiB;
constexpr size_t M_TOKPOS = M_TOKE + (size_t)NTOK * 16;
constexpr size_t M_TOKW   = M_TOKPOS + (size_t)NTOK * 16;
constexpr size_t M_TOKDST = M_TOKW + (size_t)NTOK * 16;
constexpr size_t M_ROWW   = M_TOKDST + (size_t)NTOK * 16;
constexpr size_t M_ROWSX  = M_ROWW + (size_t)PMAX * 4;
constexpr size_t M_X1S    = M_ROWSX + (size_t)PMAX * 4;
constexpr size_t M_X1Q    = WS_R + 900 * MiB;
constexpr size_t M_ROWTOK = WS_R + 750 * MiB;
constexpr size_t M_HM     = WS_R + 740 * MiB;
constexpr size_t M_H8     = WS_R + 752 * MiB;
constexpr size_t M_H8S    = WS_R + 826 * MiB;
constexpr size_t WS_NEED  = R_END;
constexpr int CW_BAR = 0;
constexpr int CW_CNT = 8192;
constexpr int CW_META = 4096 + 64;
constexpr int CW_QCTR = 6144;
constexpr int CW_WMAX = 6272;
constexpr int CW_WMAXG = 6336;
constexpr int CW_WMAXP = 6368;
constexpr int CW_WMAXD = 6384;
constexpr int CW_KMAX = 6400;
constexpr size_t CTL_BYTES = 65536;

constexpr int LDS_BYTES = 152576;
constexpr int LDS_MISC = 151552;

typedef float f32x2 __attribute__((ext_vector_type(2)));
typedef __bf16 bf16n2 __attribute__((ext_vector_type(2)));
__device__ __forceinline__ unsigned cvtpk(float lo, float hi) { f32x2 v = {lo, hi}; bf16n2 b = __builtin_convertvector(v, bf16n2); return __builtin_bit_cast(unsigned, b); }
__device__ __forceinline__ bf16_t f2bf(float x) { return (bf16_t)(cvtpk(x, 0.f) & 0xffffu); }
__device__ __forceinline__ float bf2f(bf16_t b) { return __uint_as_float(((unsigned)b) << 16); }
__device__ __forceinline__ float bflo(unsigned w) { return __uint_as_float(w << 16); }
__device__ __forceinline__ float bfhi(unsigned w) { return __uint_as_float(w & 0xffff0000u); }
__device__ __forceinline__ bf16x8 pack8(f32x4 a, f32x4 b) { u32x4 w = {cvtpk(a[0], a[1]), cvtpk(a[2], a[3]), cvtpk(b[0], b[1]), cvtpk(b[2], b[3])}; return *reinterpret_cast<bf16x8*>(&w); }
__device__ __forceinline__ float sigmoidf_(float x) { return 1.0f / (1.0f + __expf(-x)); }
__device__ __forceinline__ float wave_sum(float v) { for (int o = 32; o > 0; o >>= 1) v += __shfl_xor(v, o); return v; }
__device__ __forceinline__ int crow(int r, int hi) { return (r & 3) + 8 * (r >> 2) + 4 * hi; }
#define SBAR() __builtin_amdgcn_sched_barrier(0)

#define XB_TMO      128
#define XB_XCNT(j)  (256  + 64 * (j))
#define XB_XSUB(j)  (1280 + 64 * (j))
#define XB_XGEN(j)  (2304 + 64 * (j))
#define XB_TOP      3328
#define XB_TOPGEN   3392
#define XCD_BAR_WORDS 3456
#define XB_SPIN_CAP (1u << 22)
__device__ __forceinline__ unsigned xb_ld(unsigned* p)              { return __hip_atomic_load(p, __ATOMIC_RELAXED, __HIP_MEMORY_SCOPE_AGENT); }
__device__ __forceinline__ unsigned xb_add(unsigned* p, unsigned v) { return __hip_atomic_fetch_add(p, v, __ATOMIC_RELAXED, __HIP_MEMORY_SCOPE_AGENT); }
__device__ __forceinline__ unsigned xb_xcc_id() { return (unsigned)__builtin_amdgcn_s_getreg((3 << 11) | 20) & 0xFu; }
#define XB_SPIN(cond, bar) do { unsigned _sp = 0; while (cond) { __builtin_amdgcn_s_sleep(1); \
    if ((++_sp & 255u) == 0u) { if (xb_ld(&(bar)[XB_TMO])) break; if (_sp > XB_SPIN_CAP) { atomicAdd(&(bar)[XB_TMO], 1u); break; } } } } while (0)
struct XcdBarrier { unsigned* bar; unsigned x; volatile LAS unsigned* st; };
__device__ __forceinline__ XcdBarrier xcd_barrier_post(unsigned* bar, volatile LAS unsigned* st) {
    XcdBarrier b; b.bar = bar; b.x = xb_xcc_id(); b.st = st;
    if (threadIdx.x == 0) (void)xb_add(&bar[XB_XCNT(b.x)], 1u);
    return b;
}
__device__ __forceinline__ void xcd_barrier_complete(unsigned* bar, unsigned x, unsigned& nloc, unsigned& nx) {
    const unsigned G = gridDim.x * gridDim.y * gridDim.z;
    unsigned sum, cnt, mine, sp = 0u;
    for (;;) {
        sum = 0u; cnt = 0u; mine = 0u;
#pragma unroll
        for (unsigned j = 0; j < 16; ++j) { const unsigned c = xb_ld(&bar[XB_XCNT(j)]); sum += c; cnt += (c > 0u) ? 1u : 0u; mine = (j == x) ? c : mine; }
        if (sum == G) break;
        __builtin_amdgcn_s_sleep(1);
        if ((++sp & 255u) == 0u) { if (xb_ld(&bar[XB_TMO])) break; if (sp > XB_SPIN_CAP) { atomicAdd(&bar[XB_TMO], 1u); break; } }
    }
    nloc = mine > 0u ? mine : 1u; nx = cnt > 0u ? cnt : 1u;
}
__device__ __forceinline__ void xcd_barrier(const XcdBarrier& b) {
    asm volatile("s_waitcnt vmcnt(0)" ::: "memory");
    __syncthreads();
    if (threadIdx.x == 0) {
        unsigned* bar = b.bar;
        __builtin_amdgcn_s_waitcnt(0);
        unsigned nloc = b.st[0], nx = b.st[1];
        if (nloc == 0u) { xcd_barrier_complete(bar, b.x, nloc, nx); b.st[0] = nloc; b.st[1] = nx; }
        const unsigned old = xb_add(&bar[XB_XSUB(b.x)], 1u);
        const unsigned gen = old / nloc;
        if (old + 1u == (gen + 1u) * nloc) {
            __builtin_amdgcn_fence(__ATOMIC_RELEASE, "agent");
            asm volatile("s_waitcnt vmcnt(0)" ::: "memory");
            const unsigned og = xb_add(&bar[XB_TOP], 1u);
            const unsigned tg = og / nx;
            if (og + 1u == (tg + 1u) * nx) xb_add(&bar[XB_TOPGEN], 1u);
            else XB_SPIN(xb_ld(&bar[XB_TOPGEN]) == tg, bar);
            __builtin_amdgcn_fence(__ATOMIC_ACQUIRE, "agent");
            xb_add(&bar[XB_XGEN(b.x)], 1u);
            asm volatile("s_waitcnt vmcnt(0)" ::: "memory");
        } else {
            XB_SPIN(xb_ld(&bar[XB_XGEN(b.x)]) == gen, bar);
            __builtin_amdgcn_fence(__ATOMIC_ACQUIRE, "agent");
            asm volatile("s_waitcnt vmcnt(0)" ::: "memory");
        }
    }
    __syncthreads();
}

namespace pg8 {
constexpr int BM = 256, BK = 64, HALF = 128, HTB = HALF * BK * 2, STAGE_BYTES = 8 * HTB, NXCD = 8, WGM = 8;
__device__ __forceinline__ int lds_byte(int r, int c) { const int st = (r >> 4) * 2 + (c >> 5), rr = r & 15, cc = c & 31, ob = rr * 64 + cc * 2; return st * 1024 + (ob ^ (((ob >> 9) & 1) << 5)); }
__device__ __forceinline__ void stage_rc(int b, int& R, int& C) { const int st = b / 1024, sb = b % 1024, swz = sb ^ (((sb >> 9) & 1) << 5); R = (st >> 1) * 16 + swz / 64; C = (st & 1) * 32 + (swz % 64) / 2; }
__device__ __forceinline__ int perm32(int rho) { const int n = rho >> 4, i = rho & 15; return 8 * (i >> 2) + 4 * n + (i & 3); }
struct Unit { int pm, pn, e; };
struct SchedS {
    static constexpr bool GATHER = false;
    int nM, nN, nwg, G, c; const bf16_t* A; const bf16_t* B; int lda, ldb, a_sh, a_mul, skip_from = 1 << 30, skip_by = 0, skip_from2 = 1 << 30, skip_by2 = 0, b_compact = 0, cut = 1 << 30, extra_n = 0, extra_c = -1;
    __device__ void init(int M, int N, int G_, int c_, const bf16_t* A_, int lda_, const bf16_t* B_, int ldb_, int a_sh_ = 0, int a_mul_ = 0) {
        nM = M / BM; nN = N / BM; nwg = nM * nN; G = G_; c = c_; A = A_; B = B_; lda = lda_; ldb = ldb_; a_sh = a_sh_; a_mul = a_mul_; }
    __device__ __forceinline__ bool next(int i, Unit& u) const {
        long L = (long)i * G + c; if (i >= cut) { const int j = i - cut; if (extra_c < 0 || j >= 2) return false; L = (long)cut * G + (long)j * extra_n + extra_c; }
        if (L >= nwg) return false;
        int wgid = (int)L; { const int q = nwg / NXCD, r = nwg % NXCD, xcd = wgid % NXCD, off = wgid / NXCD; wgid = (xcd < r ? xcd * (q + 1) : r * (q + 1) + (xcd - r) * q) + off; }
        const int nig = WGM * nN, gid = wgid / nig, fm = gid * WGM, gsz = (nM - fm) < WGM ? (nM - fm) : WGM;
        u.pm = fm + ((wgid % nig) % gsz); u.pn = (wgid % nig) / gsz; u.e = 0;
        u.e = u.pn;
        { const int ci = u.pn; if (ci >= skip_from) u.pn += skip_by; if (ci >= skip_from2) u.pn += skip_by2; }
        return true;
    }
    __device__ __forceinline__ const char* pa(const Unit& u) const { return (const char*)(A + (size_t)u.pm * BM * lda + (size_t)((u.pn >> a_sh) * a_mul)); }
    __device__ __forceinline__ const char* pb(const Unit& u) const { return (const char*)(B + (size_t)(b_compact ? u.e : u.pn) * BM * ldb); }
};
struct SchedM {
    static constexpr bool GATHER = false;
    int ntiles, G, c; const bf16_t* A; const bf16_t* W; int lda, ldb; const unsigned* tile_e;
    __device__ void init(const unsigned* meta, int G_, int c_, const bf16_t* A_, int lda_, const bf16_t* W_, int ldb_) {
        ntiles = (int)meta[0]; tile_e = meta + 1; G = G_; c = c_; A = A_; W = W_; lda = lda_; ldb = ldb_; }
    __device__ __forceinline__ bool next(int i, Unit& u) const {
        const long L = (long)i * G + c; if (L >= (long)ntiles * 8) return false;
        u.pm = (int)(L >> 3); u.pn = (int)(L & 7); u.e = (int)tile_e[u.pm];
        return true;
    }
    __device__ __forceinline__ const char* pa(const Unit& u) const { return (const char*)(A + (size_t)u.pm * BM * lda); }
    __device__ __forceinline__ const char* pb(const Unit& u) const { return (const char*)(W + ((size_t)u.e * 2048 + (size_t)u.pn * BM) * ldb); }
};

constexpr int GTAB_OFF = 131072;
struct SchedMG {
    static constexpr bool GATHER = true;
    int ntiles, G, c; const bf16_t* A; const bf16_t* W; int lda, ldb; const unsigned* tile_e;
    __device__ __forceinline__ void init(const unsigned* meta, int G_, int c_, const bf16_t* A_, int lda_, const bf16_t* W_, int ldb_) {
        ntiles = (int)meta[0]; tile_e = meta + 1; G = G_; c = c_; A = A_; W = W_; lda = lda_; ldb = ldb_; }
    __device__ __forceinline__ bool next(int i, Unit& u) const {
        const long L = (long)i * G + c; if (L >= (long)ntiles * 8) return false;
        u.pm = (int)(L >> 3); u.pn = (int)(L & 7); u.e = (int)tile_e[u.pm];
        return true;
    }
    __device__ __forceinline__ const char* pa(const Unit& u) const { return (const char*)A; }
    __device__ __forceinline__ const char* pb(const Unit& u) const { return (const char*)(W + ((size_t)u.e * 2048 + (size_t)u.pn * BM) * ldb); }
};

template <class Epi, class Sched>
__device__ __forceinline__ void gemm_phase(LAS unsigned char* lds, const int K, const int lda, const int ldb, const Sched& S, const Epi& E) {
    int tid = threadIdx.x; asm volatile("" : "+v"(tid));
    const int wid = __builtin_amdgcn_readfirstlane(tid >> 6), lane = tid & 63, wr = wid >> 2, wc = wid & 3, fr = lane & 15, fq = lane >> 4;
    const int nt = K / BK;
    constexpr bool GA = Sched::GATHER;
    unsigned voffA[2], voffB[2]; int gR[2]; unsigned gC[2];
#pragma unroll
    for (int i = 0; i < 2; ++i) { int R, C; stage_rc(tid * 16 + i * 8192, R, C); const int Rb = (R & ~31) + perm32(R & 31);
        voffA[i] = (unsigned)(R * lda + C) * 2u; voffB[i] = (unsigned)(Rb * ldb + C) * 2u; gR[i] = R; gC[i] = (unsigned)C * 2u; }
    unsigned gv[2][2] = {{0u, 0u}, {0u, 0u}}, gn[2][2] = {{0u, 0u}, {0u, 0u}};
    LAS const unsigned* gtab = (LAS const unsigned*)(lds + GTAB_OFF);
#define PG8_GLOAD(dst, uidx) do { _Pragma("unroll") for (int h_ = 0; h_ < 2; ++h_) _Pragma("unroll") for (int i_ = 0; i_ < 2; ++i_) dst[h_][i_] = gtab[(uidx) * 256 + h_ * 128 + gR[i_]] + gC[i_]; } while (0)
#define PG8_STAGE_A(bufoff, ptr, h, nx) do { if constexpr (GA) { unsigned vo_[2] = {(nx) ? gn[h][0] : gv[h][0], (nx) ? gn[h][1] : gv[h][1]}; PG8_STAGE(bufoff, ptr, vo_); } \
        else { PG8_STAGE(bufoff, (ptr) + (h) * hstepA, voffA); } } while (0)
    const size_t kstep = (size_t)(BK * 2);
    const size_t hstepA = (size_t)HALF * lda * 2, hstepB = (size_t)HALF * ldb * 2;
    const unsigned ldsw = (unsigned)wid * 1024u;
    const int aoff = lds_byte(wr * 64 + fr, fq * 8), boff = lds_byte(wc * 32 + fr, fq * 8);
#define PG8_SA(b, h) (((b) * 2 + (h)) * HTB)
#define PG8_SB(b, h) ((4 + (b) * 2 + (h)) * HTB)
#define PG8_STAGE(bufoff, gbase, voff) do { _Pragma("unroll") for (int _i = 0; _i < 2; ++_i) \
        __builtin_amdgcn_global_load_lds((const unsigned*)((const char*)(gbase) + (voff)[_i]), (LAS unsigned*)(lds + (bufoff) + ldsw + _i * 8192), 16, 0, 0); } while (0)
#define PG8_LDA(dst, b, h) do { _Pragma("unroll") for (int m = 0; m < 4; ++m) _Pragma("unroll") for (int k = 0; k < 2; ++k) dst[m][k] = *(const LAS bf16x8*)(lds + PG8_SA(b, h) + aoff + m * 2048 + k * 1024); } while (0)
#define PG8_LDB(dst, b, h) do { _Pragma("unroll") for (int n = 0; n < 2; ++n) _Pragma("unroll") for (int k = 0; k < 2; ++k) dst[n][k] = *(const LAS bf16x8*)(lds + PG8_SB(b, h) + boff + n * 2048 + k * 1024); } while (0)
#define PG8_MMA(ai, bj, At, Bt) do { __builtin_amdgcn_s_setprio(1); _Pragma("unroll") for (int m = 0; m < 4; ++m) _Pragma("unroll") for (int n = 0; n < 2; ++n) _Pragma("unroll") for (int k = 0; k < 2; ++k) \
        { if constexpr (Epi::I8) acc[ai][bj][m][n] = __builtin_bit_cast(f32x4, __builtin_amdgcn_mfma_i32_16x16x64_i8(__builtin_bit_cast(i32x4, Bt[n][k]), __builtin_bit_cast(i32x4, At[m][k]), __builtin_bit_cast(i32x4, acc[ai][bj][m][n]), 0, 0, 0)); \
          else acc[ai][bj][m][n] = __builtin_amdgcn_mfma_f32_16x16x32_bf16(Bt[n][k], At[m][k], acc[ai][bj][m][n], 0, 0, 0); } __builtin_amdgcn_s_setprio(0); } while (0)
#define PG8_WAIT_V(n) asm volatile("s_waitcnt vmcnt(" #n ")" ::: "memory")
#define PG8_WAIT_L(n) asm volatile("s_waitcnt lgkmcnt(" #n ")" ::: "memory")
#define PG8_BAR __builtin_amdgcn_s_barrier()
#define PG8_SCHED __builtin_amdgcn_sched_barrier(0)
    Unit cur, nxt; int ui = 0;
    if (!S.next(0, cur)) return;
    f32x4 acc[2][2][4][2];
#pragma unroll
    for (int a = 0; a < 2; ++a)
#pragma unroll
        for (int b = 0; b < 2; ++b)
#pragma unroll
            for (int m = 0; m < 4; ++m)
#pragma unroll
                for (int n = 0; n < 2; ++n) acc[a][b][m][n] = (f32x4){0.f, 0.f, 0.f, 0.f};
    bf16x8 At[4][2], B0[2][2], B1[2][2];
    const char* cA = S.pa(cur); const char* cB = S.pb(cur);
    if constexpr (GA) { PG8_GLOAD(gv, 0); }
    PG8_STAGE(PG8_SB(0, 0), cB, voffB); PG8_STAGE_A(PG8_SA(0, 0), cA, 0, false); PG8_STAGE(PG8_SB(0, 1), cB + hstepB, voffB); PG8_STAGE_A(PG8_SA(0, 1), cA, 1, false);
    if (wr == 1) PG8_BAR;
    PG8_WAIT_V(4); PG8_BAR;
    PG8_STAGE(PG8_SB(1, 0), cB + kstep, voffB); PG8_STAGE_A(PG8_SA(1, 0), cA + kstep, 0, false); PG8_STAGE(PG8_SB(1, 1), cB + hstepB + kstep, voffB);
    PG8_WAIT_V(6); PG8_BAR;
    for (;;) {
        const bool has_next = S.next(ui + 1, nxt);
        const char* nA = has_next ? S.pa(nxt) : cA; const char* nB = has_next ? S.pb(nxt) : cB;
        if constexpr (GA) { if (has_next) { PG8_GLOAD(gn, ui + 1); } else {
#pragma unroll
                for (int h_ = 0; h_ < 2; ++h_) { gn[h_][0] = gv[h_][0]; gn[h_][1] = gv[h_][1]; } }
            asm volatile("" : "+v"(gn[0][0]), "+v"(gn[0][1]), "+v"(gn[1][0]), "+v"(gn[1][1])); }
        for (int t = 0; t < nt; t += 2) {
            const bool last = (t == nt - 2);
            if constexpr (Epi::HAS_MID) { if (t == Epi::MID1 || t == Epi::MID2) { int frM = fr, fqM = fq; asm volatile("" : "+v"(frM), "+v"(fqM)); E.mid(acc, cur, t, wr, wc, frM, fqM); } }
            const char* a1 = cA + (size_t)(t + 1) * kstep;
            const char* a2 = last ? nA : cA + (size_t)(t + 2) * kstep; const char* b2 = last ? nB : cB + (size_t)(t + 2) * kstep;
            const char* a3 = a2 + kstep; const char* b3 = b2 + kstep;
            PG8_LDB(B0, 0, 0); PG8_SCHED; PG8_LDA(At, 0, 0); PG8_STAGE_A(PG8_SA(1, 1), a1, 1, false);
            PG8_WAIT_L(8); PG8_BAR; PG8_WAIT_L(0); PG8_MMA(0, 0, At, B0); PG8_BAR; PG8_SCHED;
            PG8_LDB(B1, 0, 1); PG8_STAGE(PG8_SB(0, 0), b2, voffB);
            PG8_BAR; PG8_WAIT_L(0); PG8_MMA(0, 1, At, B1); PG8_BAR;
            PG8_LDA(At, 0, 1); PG8_STAGE_A(PG8_SA(0, 0), a2, 0, last);
            PG8_BAR; PG8_WAIT_L(0); PG8_MMA(1, 0, At, B0); PG8_BAR; PG8_SCHED;
            PG8_STAGE(PG8_SB(0, 1), b2 + hstepB, voffB);
            PG8_WAIT_V(6); PG8_BAR; PG8_MMA(1, 1, At, B1); PG8_BAR;
            PG8_LDB(B0, 1, 0); PG8_SCHED; PG8_LDA(At, 1, 0); PG8_STAGE_A(PG8_SA(0, 1), a2, 1, last);
            PG8_WAIT_L(8); PG8_BAR; PG8_WAIT_L(0); PG8_MMA(0, 0, At, B0); PG8_BAR; PG8_SCHED;
            PG8_LDB(B1, 1, 1); PG8_STAGE(PG8_SB(1, 0), b3, voffB);
            PG8_BAR; PG8_WAIT_L(0); PG8_MMA(0, 1, At, B1); PG8_BAR;
            PG8_LDA(At, 1, 1); PG8_STAGE_A(PG8_SA(1, 0), a3, 0, last);
            PG8_BAR; PG8_WAIT_L(0); PG8_MMA(1, 0, At, B0); PG8_BAR; PG8_SCHED;
            PG8_STAGE(PG8_SB(1, 1), b3 + hstepB, voffB);
            PG8_WAIT_V(6); PG8_BAR; PG8_MMA(1, 1, At, B1); PG8_BAR;
        }
        { int frE = fr, fqE = fq; asm volatile("" : "+v"(frE), "+v"(fqE)); E(acc, cur, wr, wc, frE, fqE); }
        if (!has_next) break;
#pragma unroll
        for (int a = 0; a < 2; ++a)
#pragma unroll
            for (int b = 0; b < 2; ++b)
#pragma unroll
                for (int m = 0; m < 4; ++m)
#pragma unroll
                    for (int n = 0; n < 2; ++n) acc[a][b][m][n] = (f32x4){0.f, 0.f, 0.f, 0.f};
        cur = nxt; cA = nA; cB = nB; ++ui;
        if constexpr (GA) {
#pragma unroll
            for (int h_ = 0; h_ < 2; ++h_) { gv[h_][0] = gn[h_][0]; gv[h_][1] = gn[h_][1]; } }
    }
    PG8_WAIT_V(0);
    if (wr == 0) PG8_BAR;
    PG8_BAR;
#undef PG8_SA
#undef PG8_SB
#undef PG8_STAGE
#undef PG8_STAGE_A
#undef PG8_GLOAD
#undef PG8_LDA
#undef PG8_LDB
#undef PG8_MMA
#undef PG8_WAIT_V
#undef PG8_WAIT_L
#undef PG8_BAR
#undef PG8_SCHED
}

#define EPI_LOOP_ROWS _Pragma("unroll") for (int ai = 0; ai < 2; ++ai) _Pragma("unroll") for (int m = 0; m < 4; ++m)
__device__ __forceinline__ void st_bf16x8(bf16_t* p, f32x4 v0, f32x4 v1) { u32x4 w; w.x = cvtpk(v0[0], v0[1]); w.y = cvtpk(v0[2], v0[3]); w.z = cvtpk(v1[0], v1[1]); w.w = cvtpk(v1[2], v1[3]); *(u32x4*)p = w; }

template <bool I8_> struct EpiInProj {
    static constexpr bool HAS_MID = false; static constexpr bool I8 = I8_;
    bf16_t* qa; bf16_t* qidx; bf16_t* qkv; bf16_t* gates; float* small_; const float* xs; const unsigned* wmaxbits;
    __device__ __forceinline__ f32x4 val(const f32x4& a, float sc) const { if constexpr (I8_) { const i32x4 v = __builtin_bit_cast(i32x4, a); return (f32x4){(float)v[0], (float)v[1], (float)v[2], (float)v[3]} * sc; } else return a; }
    __device__ __forceinline__ void operator()(const f32x4 (&acc)[2][2][4][2], const Unit& u, int wr, int wc, int fr, int fq) const {
        const int pn = u.pn, row0 = u.pm * BM + wr * 64 + fr, lc0 = wc * 32 + fq * 8;
        float sw = 0.f; if constexpr (I8_) sw = __uint_as_float(*wmaxbits) * (1.3f / 127.0f);
        float scs[2][4];
#pragma unroll
        for (int ai = 0; ai < 2; ++ai)
#pragma unroll
            for (int m = 0; m < 4; ++m) { scs[ai][m] = 0.f; if constexpr (I8_) scs[ai][m] = xs[row0 + ai * HALF + m * 16] * sw; }
        if (pn < 8) {
            bf16_t* base = (pn < 4 ? qa + pn * 256 : qidx + (pn - 4) * 256) + lc0;
            EPI_LOOP_ROWS { const int row = row0 + ai * HALF + m * 16; const float sc = scs[ai][m];
#pragma unroll
                for (int bj = 0; bj < 2; ++bj) st_bf16x8(base + (size_t)row * 1024 + bj * HALF, val(acc[ai][bj][m][0], sc), val(acc[ai][bj][m][1], sc)); }
        } else if (pn < 32) {
            const int id = (pn - 8) >> 2, hb = ((pn - 8) & 3) * 2, b = u.pm >> 5;
            bf16_t* base = qkv + (size_t)id * ((size_t)NTOK * 1024) + lc0;
            EPI_LOOP_ROWS { const int row = row0 + ai * HALF + m * 16, s = row & (SEQ - 1); const float sc = scs[ai][m];
#pragma unroll
                for (int bj = 0; bj < 2; ++bj) st_bf16x8(base + ((size_t)(b * 8 + hb + bj) * SEQ + s) * 128, val(acc[ai][bj][m][0], sc), val(acc[ai][bj][m][1], sc)); }
        } else if (pn < 56) {
            unsigned char* base = (unsigned char*)gates + (pn - 32) * 256 + lc0;
            EPI_LOOP_ROWS { const int row = row0 + ai * HALF + m * 16; const float sc = scs[ai][m];
#pragma unroll
                for (int bj = 0; bj < 2; ++bj) { const f32x4 v0 = val(acc[ai][bj][m][0], sc), v1 = val(acc[ai][bj][m][1], sc); u32x2 w; unsigned p0 = 0u, p1 = 0u;
#pragma unroll
                    for (int j = 0; j < 4; ++j) { p0 |= (unsigned)(int)fmaxf(rintf(255.0f * sigmoidf_(v0[j])), 1.0f) << (8 * j); p1 |= (unsigned)(int)fmaxf(rintf(255.0f * sigmoidf_(v1[j])), 1.0f) << (8 * j); }
                    w.x = p0; w.y = p1; *(u32x2*)(base + (size_t)row * 6144 + bj * HALF) = w; } }
        } else {
            float* base = small_ + (pn - 56) * 256 + lc0;
            EPI_LOOP_ROWS { const int row = row0 + ai * HALF + m * 16; const float sc = scs[ai][m];
#pragma unroll
                for (int bj = 0; bj < 2; ++bj) { float* p = base + (size_t)row * 512 + bj * HALF; *(f32x4*)p = val(acc[ai][bj][m][0], sc); *(f32x4*)(p + 4) = val(acc[ai][bj][m][1], sc); } }
        }
    }
};
struct EpiBf16 {
    static constexpr bool HAS_MID = false; static constexpr bool I8 = false;
    bf16_t* out; int ld, cstep;
    __device__ __forceinline__ void operator()(const f32x4 (&acc)[2][2][4][2], const Unit& u, int wr, int wc, int fr, int fq) const {
        const int row0 = u.pm * BM + wr * 64 + fr; bf16_t* base = out + (size_t)u.pn * cstep + wc * 32 + fq * 8;
        EPI_LOOP_ROWS { const int row = row0 + ai * HALF + m * 16;
#pragma unroll
            for (int bj = 0; bj < 2; ++bj) st_bf16x8(base + (size_t)row * ld + bj * HALF, acc[ai][bj][m][0], acc[ai][bj][m][1]); }
    }
};
struct EpiBranch3 {
    static constexpr bool HAS_MID = true; static constexpr bool I8 = false; static constexpr int MID1 = 16, MID2 = 32;
    const unsigned char* gates; bf16_t* merged;
    __device__ __forceinline__ static f32x4 rat(unsigned n, unsigned d) {
        f32x4 r; r[0] = (float)(n & 255u) * __builtin_amdgcn_rcpf((float)(d & 255u)); r[1] = (float)((n >> 8) & 255u) * __builtin_amdgcn_rcpf((float)((d >> 8) & 255u));
        r[2] = (float)((n >> 16) & 255u) * __builtin_amdgcn_rcpf((float)((d >> 16) & 255u)); r[3] = (float)(n >> 24) * __builtin_amdgcn_rcpf((float)(d >> 24)); return r; }
    __device__ __forceinline__ void mid(f32x4 (&acc)[2][2][4][2], const Unit& u, int t, int wr, int wc, int fr, int fq) const {
        const int row0 = u.pm * BM + wr * 64 + fr, col0 = u.pn * BM + wc * 32 + fq * 8, bn = (t == MID1) ? 0 : 2048;
        u32x2 gn[2][4][2], gd[2][4][2];
        EPI_LOOP_ROWS {
#pragma unroll
            for (int bj = 0; bj < 2; ++bj) { const unsigned char* gp = gates + (size_t)(row0 + ai * HALF + m * 16) * 6144 + bn + col0 + bj * HALF; gn[ai][m][bj] = *(const u32x2*)gp; gd[ai][m][bj] = *(const u32x2*)(gp + 2048); } }
        EPI_LOOP_ROWS {
#pragma unroll
            for (int bj = 0; bj < 2; ++bj) { acc[ai][bj][m][0] *= rat(gn[ai][m][bj].x, gd[ai][m][bj].x); acc[ai][bj][m][1] *= rat(gn[ai][m][bj].y, gd[ai][m][bj].y); } }
    }
    __device__ __forceinline__ void operator()(const f32x4 (&acc)[2][2][4][2], const Unit& u, int wr, int wc, int fr, int fq) const {
        const int row0 = u.pm * BM + wr * 64 + fr, col0 = u.pn * BM + wc * 32 + fq * 8;
        u32x2 gl[2][4][2];
        EPI_LOOP_ROWS {
#pragma unroll
            for (int bj = 0; bj < 2; ++bj) gl[ai][m][bj] = *(const u32x2*)(gates + (size_t)(row0 + ai * HALF + m * 16) * 6144 + 4096 + col0 + bj * HALF); }
        EPI_LOOP_ROWS { const int row = row0 + ai * HALF + m * 16;
#pragma unroll
            for (int bj = 0; bj < 2; ++bj) { const int col = col0 + bj * HALF; const u32x2 gw = gl[ai][m][bj]; constexpr float I255 = 1.0f / 255.0f;
                f32x4 v0 = acc[ai][bj][m][0], v1 = acc[ai][bj][m][1];
                v0[0] *= (float)(gw.x & 255u) * I255; v0[1] *= (float)((gw.x >> 8) & 255u) * I255; v0[2] *= (float)((gw.x >> 16) & 255u) * I255; v0[3] *= (float)(gw.x >> 24) * I255;
                v1[0] *= (float)(gw.y & 255u) * I255; v1[1] *= (float)((gw.y >> 8) & 255u) * I255; v1[2] *= (float)((gw.y >> 16) & 255u) * I255; v1[3] *= (float)(gw.y >> 24) * I255;
                st_bf16x8(merged + (size_t)row * 2048 + col, v0, v1); } }
    }
};
struct EpiOut {
    static constexpr bool HAS_MID = false; static constexpr bool I8 = false;
    const bf16_t* res; bf16_t* pre;
    __device__ __forceinline__ void operator()(const f32x4 (&acc)[2][2][4][2], const Unit& u, int wr, int wc, int fr, int fq) const {
        const int row0 = u.pm * BM + wr * 64 + fr, col0 = u.pn * BM + wc * 32 + fq * 8;
        u32x4 rl[2][4][2];
        EPI_LOOP_ROWS { const int row = row0 + ai * HALF + m * 16;
#pragma unroll
            for (int bj = 0; bj < 2; ++bj) rl[ai][m][bj] = *(const u32x4*)(res + (size_t)row * 2048 + col0 + bj * HALF); }
        EPI_LOOP_ROWS { const int row = row0 + ai * HALF + m * 16;
#pragma unroll
            for (int bj = 0; bj < 2; ++bj) { const size_t o = (size_t)row * 2048 + col0 + bj * HALF;
                const u32x4 rw = rl[ai][m][bj]; f32x4 v0 = acc[ai][bj][m][0], v1 = acc[ai][bj][m][1];
                v0[0] += ALPHA * bflo(rw.x); v0[1] += ALPHA * bfhi(rw.x); v0[2] += ALPHA * bflo(rw.y); v0[3] += ALPHA * bfhi(rw.y);
                v1[0] += ALPHA * bflo(rw.z); v1[1] += ALPHA * bfhi(rw.z); v1[2] += ALPHA * bflo(rw.w); v1[3] += ALPHA * bfhi(rw.w);
                st_bf16x8(pre + o, v0, v1); } }
    }
};
struct EpiGateUpI8 {
    static constexpr bool HAS_MID = false; static constexpr bool I8 = true;
    const float* bg; const float* bu; bf16_t* hid; const float* rowsx; const unsigned* wmaxbits; float* hm;
    __device__ __forceinline__ void operator()(const f32x4 (&acc)[2][2][4][2], const Unit& u, int wr, int wc, int fr, int fq) const {
        const int row0 = u.pm * BM + wr * 64 + fr, j0 = u.pn * 128 + wc * 32 + fq * 8;
        const float sw = __uint_as_float(*wmaxbits) * (1.3f / 127.0f);
        const float* pg = bg + (size_t)u.e * DEXP + j0; const float* pu = bu + (size_t)u.e * DEXP + j0;
        const f32x4 g0b = *(const f32x4*)pg, g1b = *(const f32x4*)(pg + 4), u0b = *(const f32x4*)pu, u1b = *(const f32x4*)(pu + 4);
        float scs[2][4];
#pragma unroll
        for (int ai = 0; ai < 2; ++ai)
#pragma unroll
            for (int m = 0; m < 4; ++m) scs[ai][m] = rowsx[row0 + ai * HALF + m * 16] * sw;
        EPI_LOOP_ROWS { const int row = row0 + ai * HALF + m * 16; const float sc = scs[ai][m];
            const i32x4 ag0 = __builtin_bit_cast(i32x4, acc[ai][0][m][0]), ag1 = __builtin_bit_cast(i32x4, acc[ai][0][m][1]), au0 = __builtin_bit_cast(i32x4, acc[ai][1][m][0]), au1 = __builtin_bit_cast(i32x4, acc[ai][1][m][1]);
            f32x4 h0, h1;
#pragma unroll
            for (int j = 0; j < 4; ++j) {
                float g = fminf((float)ag0[j] * sc + g0b[j], 7.0f), uu = fminf(fmaxf((float)au0[j] * sc + u0b[j], -7.0f), 7.0f);
                h0[j] = (uu + 1.0f) * (g * sigmoidf_(1.702f * g));
                g = fminf((float)ag1[j] * sc + g1b[j], 7.0f); uu = fminf(fmaxf((float)au1[j] * sc + u1b[j], -7.0f), 7.0f);
                h1[j] = (uu + 1.0f) * (g * sigmoidf_(1.702f * g)); }
            st_bf16x8(hid + (size_t)row * DEXP + j0, h0, h1);
            float am = fmaxf(fmaxf(fmaxf(fabsf(h0[0]), fabsf(h0[1])), fmaxf(fabsf(h0[2]), fabsf(h0[3]))), fmaxf(fmaxf(fabsf(h1[0]), fabsf(h1[1])), fmaxf(fabsf(h1[2]), fabsf(h1[3]))));
            am = fmaxf(am, __shfl_xor(am, 16)); am = fmaxf(am, __shfl_xor(am, 32));
            if (fq == 0) hm[(size_t)row * 32 + u.pn * 4 + wc] = am; }
    }
};
struct EpiDown {
    static constexpr bool HAS_MID = false; static constexpr bool I8 = false;
    const float* bd; const float* roww; bf16_t* ys;
    __device__ __forceinline__ void operator()(const f32x4 (&acc)[2][2][4][2], const Unit& u, int wr, int wc, int fr, int fq) const {
        const int row0 = u.pm * BM + wr * 64 + fr, col0 = u.pn * BM + wc * 32 + fq * 8;
        f32x4 b[2][2];
#pragma unroll
        for (int bj = 0; bj < 2; ++bj) { const float* p = bd + (size_t)u.e * DM + col0 + bj * HALF; b[bj][0] = *(const f32x4*)p; b[bj][1] = *(const f32x4*)(p + 4); }
        float rws[2][4];
#pragma unroll
        for (int ai = 0; ai < 2; ++ai)
#pragma unroll
            for (int m = 0; m < 4; ++m) rws[ai][m] = roww[row0 + ai * HALF + m * 16];
        EPI_LOOP_ROWS { const int row = row0 + ai * HALF + m * 16; const float w = rws[ai][m];
#pragma unroll
            for (int bj = 0; bj < 2; ++bj) st_bf16x8(ys + (size_t)row * 2048 + col0 + bj * HALF, (acc[ai][bj][m][0] + b[bj][0]) * w, (acc[ai][bj][m][1] + b[bj][1]) * w); }
    }
};
struct EpiDownI8 {
    static constexpr bool HAS_MID = false; static constexpr bool I8 = true;
    const float* bd; const float* roww; bf16_t* ys; const float* h8s; const unsigned* wmaxbits;
    __device__ __forceinline__ void operator()(const f32x4 (&acc)[2][2][4][2], const Unit& u, int wr, int wc, int fr, int fq) const {
        const int row0 = u.pm * BM + wr * 64 + fr, col0 = u.pn * BM + wc * 32 + fq * 8;
        const float sw = __uint_as_float(*wmaxbits) * (1.3f / 127.0f);
        f32x4 b[2][2];
#pragma unroll
        for (int bj = 0; bj < 2; ++bj) { const float* p = bd + (size_t)u.e * DM + col0 + bj * HALF; b[bj][0] = *(const f32x4*)p; b[bj][1] = *(const f32x4*)(p + 4); }
        float rws[2][4], scs[2][4];
#pragma unroll
        for (int ai = 0; ai < 2; ++ai)
#pragma unroll
            for (int m = 0; m < 4; ++m) { rws[ai][m] = roww[row0 + ai * HALF + m * 16]; scs[ai][m] = h8s[row0 + ai * HALF + m * 16] * sw; }
        EPI_LOOP_ROWS { const int row = row0 + ai * HALF + m * 16; const float w = rws[ai][m], sc = scs[ai][m];
#pragma unroll
            for (int bj = 0; bj < 2; ++bj) { const i32x4 a0 = __builtin_bit_cast(i32x4, acc[ai][bj][m][0]), a1 = __builtin_bit_cast(i32x4, acc[ai][bj][m][1]);
                const f32x4 v0 = (f32x4){(float)a0[0], (float)a0[1], (float)a0[2], (float)a0[3]} * sc, v1 = (f32x4){(float)a1[0], (float)a1[1], (float)a1[2], (float)a1[3]} * sc;
                st_bf16x8(ys + (size_t)row * 2048 + col0 + bj * HALF, (v0 + b[bj][0]) * w, (v1 + b[bj][1]) * w); } }
    }
};
struct EpiPleGateI8 {
    static constexpr bool HAS_MID = false; static constexpr bool I8 = true;
    const bf16_t* hb; const bf16_t* pp; bf16_t* pre; const float* hs; const unsigned* wmaxbits;
    __device__ __forceinline__ void operator()(const f32x4 (&acc)[2][2][4][2], const Unit& u, int wr, int wc, int fr, int fq) const {
        const int row0 = u.pm * BM + wr * 64 + fr, col0 = u.pn * BM + wc * 32 + fq * 8;
        const float sw = __uint_as_float(*wmaxbits) * (1.3f / 127.0f);
#pragma unroll
        for (int ai = 0; ai < 2; ++ai) { u32x4 pl[4][2], hl[4][2]; float scs[4];
#pragma unroll
            for (int m = 0; m < 4; ++m) { scs[m] = hs[row0 + ai * HALF + m * 16] * sw;
#pragma unroll
                for (int bj = 0; bj < 2; ++bj) { const size_t o = (size_t)(row0 + ai * HALF + m * 16) * 2048 + col0 + bj * HALF; pl[m][bj] = *(const u32x4*)(pp + o); hl[m][bj] = *(const u32x4*)(hb + o); } }
#pragma unroll
            for (int m = 0; m < 4; ++m) { const float sc = scs[m];
#pragma unroll
                for (int bj = 0; bj < 2; ++bj) { const size_t o = (size_t)(row0 + ai * HALF + m * 16) * 2048 + col0 + bj * HALF; const u32x4 pw = pl[m][bj], hw = hl[m][bj];
                    const i32x4 a0 = __builtin_bit_cast(i32x4, acc[ai][bj][m][0]), a1 = __builtin_bit_cast(i32x4, acc[ai][bj][m][1]); f32x4 o0, o1;
                    o0[0] = bflo(hw.x) + sigmoidf_((float)a0[0] * sc) * bflo(pw.x); o0[1] = bfhi(hw.x) + sigmoidf_((float)a0[1] * sc) * bfhi(pw.x); o0[2] = bflo(hw.y) + sigmoidf_((float)a0[2] * sc) * bflo(pw.y); o0[3] = bfhi(hw.y) + sigmoidf_((float)a0[3] * sc) * bfhi(pw.y);
                    o1[0] = bflo(hw.z) + sigmoidf_((float)a1[0] * sc) * bflo(pw.z); o1[1] = bfhi(hw.z) + sigmoidf_((float)a1[1] * sc) * bfhi(pw.z); o1[2] = bflo(hw.w) + sigmoidf_((float)a1[2] * sc) * bflo(pw.w); o1[3] = bfhi(hw.w) + sigmoidf_((float)a1[3] * sc) * bfhi(pw.w);
                    st_bf16x8(pre + o, o0, o1); } } }
    }
};
}

struct Params { const float* in[25]; float* out; unsigned char* ws; int ph_lo, ph_hi; };
__constant__ float c_invf_r[16] = {1.000000000e+00f, 4.403665960e-01f, 1.939227432e-01f, 8.539710194e-02f, 3.760603070e-02f, 1.656043902e-02f, 7.292664610e-03f, 3.211445874e-03f, 1.414213562e-03f, 6.227723788e-04f, 2.742481884e-04f, 1.207697351e-04f, 5.318296098e-05f, 2.341999971e-05f, 1.031338616e-05f, 4.541670478e-06f};
__constant__ float c_invf_i[8] = {1.000000000e+00f, 1.939227432e-01f, 3.760603070e-02f, 7.292664610e-03f, 1.414213562e-03f, 2.742481884e-04f, 5.318296098e-05f, 1.031338616e-05f};
constexpr int LDS_PTRS = LDS_MISC + 256;
struct Frame { unsigned char* lds; LAS unsigned char* ldsl; unsigned char* ws; int tid, lane, wid, G, bid;
    __device__ __forceinline__ const float* in(int k) const { const LAS unsigned* t = (const LAS unsigned*)(ldsl + LDS_PTRS) + 2 * k;
        const unsigned lo = __builtin_amdgcn_readfirstlane(t[0]), hi = __builtin_amdgcn_readfirstlane(t[1]); return (const float*)(const GAS float*)(((unsigned long long)hi << 32) | lo); }
    __device__ __forceinline__ float* out() const { return (float*)in(25); } };
__device__ __forceinline__ Frame fresh(const Frame& F0) { Frame F = F0; int t = threadIdx.x; asm volatile("" : "+v"(t)); F.tid = t; F.lane = t & 63; F.wid = __builtin_amdgcn_readfirstlane(t >> 6); size_t z = 0; asm volatile("" : "+s"(z)); F.ws = F0.ws + z; return F; }

struct TcTile { const float* src; long sld; bf16_t* dst; long dld; int nvalid; float qinv; };
template <class Dec>
__device__ __forceinline__ void tconv_run(const Frame& F, int total, const Dec& dec, int& rot) {
    float* tile = (float*)F.lds;
    const int tid = F.tid, G = F.G;
    const int start = (F.bid - (rot % G) + G) % G; rot += total >> 2;
    const int lr = tid >> 4, lc4 = (tid & 15) * 4, sn = tid >> 3, skc = (tid & 7) * 8;
    f32x4 v[4][2];
#define TC_ISSUE(t0_) do { _Pragma("unroll") for (int q = 0; q < 4; ++q) { const int t = (t0_) * 4 + q; \
        if (t < total) { const TcTile ti = dec(dec.remap(t)); _Pragma("unroll") for (int h = 0; h < 2; ++h) { v[q][h] = (f32x4){0.f, 0.f, 0.f, 0.f}; \
            if (lc4 < ti.nvalid) v[q][h] = *(const GAS f32x4*)((const GAS float*)ti.src + (size_t)(lr + 32 * h) * ti.sld + lc4); } } } } while (0)
    if (start * 4 < total) TC_ISSUE(start);
    for (int t0 = start; t0 * 4 < total; t0 += G) {
#pragma unroll
        for (int q = 0; q < 4; ++q) { if (t0 * 4 + q < total) { float* tl = tile + q * (64 * 65);
#pragma unroll
                for (int h = 0; h < 2; ++h) { float* p = tl + (lr + 32 * h) * 65 + lc4; p[0] = v[q][h][0]; p[1] = v[q][h][1]; p[2] = v[q][h][2]; p[3] = v[q][h][3]; } } }
        __syncthreads();
        if ((t0 + G) * 4 < total) TC_ISSUE(t0 + G);
#pragma unroll
        for (int q = 0; q < 4; ++q) { const int t = t0 * 4 + q;
            if (t < total) { const TcTile ti = dec(dec.remap(t)); const float* tl = tile + q * (64 * 65);
                if (ti.qinv > 0.f) { if (tid < 256) { const int n8 = tid >> 2, kc = (tid & 3) * 16; u32x4 w;
#pragma unroll
                        for (int d = 0; d < 4; ++d) { unsigned pk = 0u;
#pragma unroll
                            for (int j = 0; j < 4; ++j) { float q = rintf(tl[(kc + d * 4 + j) * 65 + n8] * ti.qinv); q = fminf(fmaxf(q, -127.f), 127.f); pk |= ((unsigned)(int)q & 0xffu) << (8 * j); }
                            w[d] = pk; }
                        *(u32x4*)((unsigned char*)ti.dst + (size_t)n8 * ti.dld + kc) = w; } }
                else if (sn < ti.nvalid) { f32x4 a, b;
#pragma unroll
                    for (int j = 0; j < 4; ++j) { a[j] = tl[(skc + j) * 65 + sn]; b[j] = tl[(skc + 4 + j) * 65 + sn]; }
                    pg8::st_bf16x8(ti.dst + (size_t)sn * ti.dld + skc, a, b); } } }
        __syncthreads();
    }
#undef TC_ISSUE
}
struct TcMat {
    const float* src; long src_ld; int tk, ncols; bf16_t* dst; long dst_ld; float qinv;
    __device__ __forceinline__ int remap(int i) const { const int ntn = (ncols + 63) >> 6; if (ntn & 1) return i;
        const int g = i >> 2, q = i & 3, tkh = tk >> 1, gk = g % tkh, gn = g / tkh; return (2 * gn + (q >> 1)) * tk + 2 * gk + (q & 1); }
    __device__ __forceinline__ TcTile operator()(int t) const { const int k0 = (t % tk) * 64, n0 = (t / tk) * 64; TcTile ti;
        ti.src = src + (size_t)k0 * src_ld + n0; ti.sld = src_ld; ti.dst = qinv > 0.f ? (bf16_t*)((unsigned char*)dst + (size_t)n0 * dst_ld + k0) : dst + (size_t)n0 * dst_ld + k0; ti.dld = dst_ld; ti.nvalid = (ncols - n0) < 64 ? (ncols - n0) : 64; ti.qinv = qinv; return ti; }
};
__device__ __forceinline__ void tconv(const Frame& F, const float* src, long src_ld, int K, int ncols, bf16_t* dst, long dst_ld, int& rot) {
    TcMat d{src, src_ld, K >> 6, ncols, dst, dst_ld, 0.f}; tconv_run(F, (K >> 6) * ((ncols + 63) >> 6), d, rot);
}
struct TcExperts {
    const float* wg; const float* wu; const float* wd; unsigned char* dgu; unsigned char* ddn; float qinv, qinvd;
    __device__ __forceinline__ int remap(int i) const { const int e = i / 1536, ri = i - e * 1536;
        if (ri < 1024) { const int g = ri >> 2, q = ri & 3, gk = g & 15, gn = g >> 4; return e * 1536 + (2 * gn + (q >> 1)) * 32 + 2 * gk + (q & 1); }
        const int r2 = ri - 1024, g = r2 >> 2, q = r2 & 3, gk = g & 7, gn = g >> 3; return e * 1536 + 1024 + (2 * gn + (q >> 1)) * 16 + 2 * gk + (q & 1); }
    __device__ __forceinline__ TcTile operator()(int t) const { const int e = t / 1536, r = t - e * 1536; TcTile ti; ti.nvalid = 64; ti.qinv = 0.f;
        if (r < 1024) { const int k0 = (r & 31) * 64, dt = r >> 5, jb = dt >> 2, gu = (dt >> 1) & 1, half = dt & 1;
            ti.src = (const float*)((unsigned long long)wg + (unsigned long long)gu * ((unsigned long long)wu - (unsigned long long)wg)) + (size_t)e * DM * DEXP + (size_t)k0 * DEXP + jb * 128 + half * 64; ti.sld = DEXP;
            ti.dst = (bf16_t*)(dgu + (size_t)e * 2048 * 2048 + (size_t)(dt * 64) * 2048 + k0); ti.dld = 2048; ti.qinv = qinv; }
        else { const int r2 = r - 1024, k0 = (r2 & 15) * 64, n0 = (r2 >> 4) * 64;
            ti.src = wd + (size_t)e * DEXP * DM + (size_t)k0 * DM + n0; ti.sld = DM;
            ti.dst = (bf16_t*)(ddn + (size_t)e * 2048 * 1024 + (size_t)n0 * 1024 + k0); ti.dld = 1024; ti.qinv = qinvd; }
        return ti; }
};
__device__ __forceinline__ void sample_wmax(const Frame& F) {
    unsigned* wm = (unsigned*)(F.ws + WS_CTL) + CW_WMAX;
#pragma unroll 1
    for (int l = 0; l < NLAYER; ++l) { float mx = 0.f;
#pragma unroll 1
        for (int which = 0; which < 2; ++which) { const f32x4* p = (const f32x4*)(F.in(which ? 17 : 15) + (size_t)l * NEXP * DM * DEXP);
            for (size_t i = (size_t)F.bid * 512 + F.tid; i < (size_t)NEXP * DM * DEXP / 4 / 64; i += (size_t)F.G * 512) { const size_t j = i >> 3; const f32x4 v = p[j * 512 + 8 * (j & 63) + (i & 7)];
                mx = fmaxf(mx, fmaxf(fmaxf(fabsf(v[0]), fabsf(v[1])), fmaxf(fabsf(v[2]), fabsf(v[3])))); } }
        for (int o = 32; o > 0; o >>= 1) mx = fmaxf(mx, __shfl_xor(mx, o));
        if (F.lane == 0 && mx > 0.f) atomicMax(&wm[l], __float_as_uint(mx));
        float mg = 0.f; const f32x4* wi_ = (const f32x4*)(F.in(2) + (size_t)l * DM * INW);
        for (int i = F.bid * 512 + F.tid; i < DM * (INW / 4) / 16; i += F.G * 512) { const size_t j = (size_t)(i >> 3); const f32x4 v = wi_[j * 128 + 8 * (j & 15) + (i & 7)];
            mg = fmaxf(mg, fmaxf(fmaxf(fabsf(v[0]), fabsf(v[1])), fmaxf(fabsf(v[2]), fabsf(v[3])))); }
        for (int o = 32; o > 0; o >>= 1) mg = fmaxf(mg, __shfl_xor(mg, o));
        if (F.lane == 0 && mg > 0.f) atomicMax(&wm[CW_WMAXG - CW_WMAX + l], __float_as_uint(mg));
        float mp = 0.f; const f32x4* wp_ = (const f32x4*)(F.in(21) + (size_t)l * DM * DM);
        for (int i = F.bid * 512 + F.tid; i < DM * DM / 4 / 16; i += F.G * 512) { const int j = i >> 3; const f32x4 v = wp_[j * 128 + 8 * (j & 15) + (i & 7)];
            mp = fmaxf(mp, fmaxf(fmaxf(fabsf(v[0]), fabsf(v[1])), fmaxf(fabsf(v[2]), fabsf(v[3])))); }
        for (int o = 32; o > 0; o >>= 1) mp = fmaxf(mp, __shfl_xor(mp, o));
        if (F.lane == 0 && mp > 0.f) atomicMax(&wm[CW_WMAXP - CW_WMAX + l], __float_as_uint(mp));
        float md = 0.f; const f32x4* wd_ = (const f32x4*)(F.in(19) + (size_t)l * NEXP * DEXP * DM);
        for (size_t i = (size_t)F.bid * 512 + F.tid; i < (size_t)NEXP * DEXP * DM / 4 / 64; i += (size_t)F.G * 512) { const size_t j = i >> 3; const f32x4 v = wd_[j * 512 + 8 * (j & 63) + (i & 7)];
            md = fmaxf(md, fmaxf(fmaxf(fabsf(v[0]), fabsf(v[1])), fmaxf(fabsf(v[2]), fabsf(v[3])))); }
        for (int o = 32; o > 0; o >>= 1) md = fmaxf(md, __shfl_xor(md, o));
        if (F.lane == 0 && md > 0.f) atomicMax(&wm[CW_WMAXD - CW_WMAX + l], __float_as_uint(md)); }
}
__device__ __forceinline__ void conv_rows(const Frame& F, const float* src, bf16_t* dst, size_t n8) {
    for (size_t i = (size_t)F.bid * 512 + F.tid; i < n8; i += (size_t)F.G * 512) { const f32x4 a = *(const f32x4*)(src + i * 8), b = *(const f32x4*)(src + i * 8 + 4); pg8::st_bf16x8(dst + i * 8, a, b); }
}
__device__ __forceinline__ void quant_rows(const Frame& F, const float* src, bf16_t* xb, unsigned char* xq, float* xsc) {
    const int lane = F.lane;
    for (int tok = F.bid * 8 + F.wid; tok < NTOK; tok += F.G * 8) { f32x4 v[8]; float amax = 0.f;
#pragma unroll
        for (int i = 0; i < 4; ++i) { const int c = (i * 64 + lane) * 8; v[2 * i] = *(const f32x4*)(src + (size_t)tok * DM + c); v[2 * i + 1] = *(const f32x4*)(src + (size_t)tok * DM + c + 4);
            pg8::st_bf16x8(xb + (size_t)tok * DM + c, v[2 * i], v[2 * i + 1]);
#pragma unroll
            for (int h = 0; h < 2; ++h)
#pragma unroll
                for (int j = 0; j < 4; ++j) amax = fmaxf(amax, fabsf(v[2 * i + h][j])); }
        for (int o = 32; o > 0; o >>= 1) amax = fmaxf(amax, __shfl_xor(amax, o));
        amax = fmaxf(amax, 1e-20f); const float qi = 127.0f / amax; if (lane == 0) xsc[tok] = amax * (1.0f / 127.0f);
#pragma unroll
        for (int i = 0; i < 4; ++i) { u32x2 w;
#pragma unroll
            for (int h = 0; h < 2; ++h) { unsigned pk = 0u;
#pragma unroll
                for (int j = 0; j < 4; ++j) pk |= ((unsigned)(int)rintf(v[2 * i + h][j] * qi) & 0xffu) << (8 * j);
                w[h] = pk; }
            *(u32x2*)(xq + (size_t)tok * DM + (i * 64 + lane) * 8) = w; } }
}
__constant__ int c_so[14] = {0, 1312, 2416, 3440, 4464, 5496, 6520, 7544, 8568, 1024, 1280, 2336, 2400, 5488};
__constant__ int c_dn[14] = {0, 1024, 2048, 3072, 4096, 5120, 6144, 7168, 8192, 14336, 14592, 14624, 14688, 14704};
__constant__ int c_nc[14] = {1024, 1024, 1024, 1024, 1024, 1024, 1024, 1024, 6144, 256, 32, 64, 16, 8};
__device__ __forceinline__ void convert_layer_weights(const Frame& F0, const Params& P, int l) { const Frame F = fresh(F0);
    unsigned char* ws = F.ws; int rot = 0;
    { const float* w = F.in(2) + (size_t)l * DM * INW; bf16_t* d = (bf16_t*)(ws + W_IN);
      const float wmaxg = __uint_as_float(((const unsigned*)(ws + WS_CTL))[CW_WMAXG + l]); const float qinv = 127.0f / (1.3f * fmaxf(wmaxg, 1e-30f));
#pragma unroll 1
      for (int s = 0; s < 14; ++s) {
          if (s == 1 || s >= 10) tconv(F, w + c_so[s], INW, DM, c_nc[s], d + (size_t)c_dn[s] * DM, DM, rot);
          else { const int crow = (s == 0) ? 0 : (s <= 7 ? 1024 + (s - 2) * 1024 : (s == 8 ? 7168 : 13312));
              TcMat dq{w + c_so[s], INW, DM >> 6, c_nc[s], (bf16_t*)(ws + W_IN8 + (size_t)crow * 2048), 2048, qinv}; tconv_run(F, (DM >> 6) * (c_nc[s] >> 6), dq, rot); } } }
    tconv(F, F.in(7) + (size_t)l * 1024 * DM, DM, 1024, DM, (bf16_t*)(ws + W_BRA), 3072, rot);
    tconv(F, F.in(8) + (size_t)l * 1024 * DM, DM, 1024, DM, (bf16_t*)(ws + W_BRA) + 1024, 3072, rot);
    tconv(F, F.in(9) + (size_t)l * 1024 * DM, DM, 1024, DM, (bf16_t*)(ws + W_BRA) + 2048, 3072, rot);
    tconv(F, F.in(10) + (size_t)l * DM * DM, DM, DM, DM, (bf16_t*)(ws + W_OUT), DM, rot);
    { const float wmp = __uint_as_float(((const unsigned*)(ws + WS_CTL))[CW_WMAXP + l]);
      TcMat dq{F.in(21) + (size_t)l * DM * DM, DM, DM >> 6, DM, (bf16_t*)(ws + W_PG), 2048, 127.0f / (1.3f * fmaxf(wmp, 1e-30f))}; tconv_run(F, (DM >> 6) * (DM >> 6), dq, rot); }
    tconv(F, F.in(22) + (size_t)l * 256 * DM, DM, 256, DM, (bf16_t*)(ws + W_PLE), 256, rot);
#pragma unroll 1
    for (int h = 0; h < 8; ++h) tconv(F, F.in(6) + (size_t)l * 256 * 1024 + h * 128, 1024, 256, 128, (bf16_t*)(ws + W_UV2) + ((size_t)(h >> 1) * 256 + (h & 1) * 128) * 512 + (h & 1) * 256, 512, rot);
    { const float wmax = __uint_as_float(((const unsigned*)(ws + WS_CTL))[CW_WMAX + l]);
      const float wmaxd = __uint_as_float(((const unsigned*)(ws + WS_CTL))[CW_WMAXD + l]);
      TcExperts d{F.in(15) + (size_t)l * NEXP * DM * DEXP, F.in(17) + (size_t)l * NEXP * DM * DEXP, F.in(19) + (size_t)l * NEXP * DEXP * DM, (unsigned char*)(ws + W_GU), (unsigned char*)(ws + W_DN), 127.0f / (1.3f * fmaxf(wmax, 1e-30f)), 127.0f / (1.3f * fmaxf(wmaxd, 1e-30f))};
      tconv_run(F, NEXP * 1536, d, rot); }
    { const float* w = F.in(5) + (size_t)l * 256 * 8 * 96; bf16_t* d = (bf16_t*)(ws + W_UK2);
      for (int i = F.bid * 512 + F.tid; i < 256 * 8 * 96; i += F.G * 512) { const int n = i % 96, h = (i / 96) & 7, r = i / 768; d[((size_t)h * 256 + r) * 256 + (h & 1) * 128 + 32 + n] = f2bf(w[i]); } }
}

__device__ __forceinline__ void rope_cs(float pos, float invf, float& c, float& s) {
    const float a = pos * invf; const double ad = (double)a * 0.15915494309189535; const float fr = (float)(ad - rint(ad));
    s = __builtin_amdgcn_sinf(fr); c = __builtin_amdgcn_cosf(fr);
}
__device__ __forceinline__ void phase_prep(const Frame& F0, const Params& P, int l) { const Frame F = fresh(F0);
    unsigned char* ws = F.ws; const int lane = F.lane;
    const float* smallb = (const float*)(ws + R_SMALL); bf16_t* kcat = (bf16_t*)(ws + R_KCAT); bf16_t* qcat = (bf16_t*)(ws + R_QCAT);
    bf16_t* ki = (bf16_t*)(ws + R_KI); float* wi = (float*)(ws + R_WI); float* lf = (float*)(ws + WS_LF);
    const bf16_t* qa = (const bf16_t*)(ws + R_QA); bf16_t* qidx = (bf16_t*)(ws + R_QIDX);
    const f32x4 gck = *(const f32x4*)(F.in(4) + l * 256 + lane * 4);
    const float bfo = lane < 8 ? F.in(3)[l * 8 + lane] : 0.f;
    const float ifr = c_invf_r[lane & 15], ifi = c_invf_i[lane & 7];
    for (int tok = F.bid * 8 + F.wid; tok < NTOK; tok += F.G * 8) {
        const int s = tok & (SEQ - 1), b = tok >> 13; const float* sm = smallb + (size_t)tok * 512;
        float cr, sr, ci, si; rope_cs((float)s, ifr, cr, sr); rope_cs((float)s, ifi, ci, si);
        { const f32x4 v = *(const f32x4*)(sm + lane * 4); float ss = v[0] * v[0] + v[1] * v[1] + v[2] * v[2] + v[3] * v[3]; ss = wave_sum(ss);
          const float rs = rsqrtf(ss * (1.0f / 256.0f) + 1e-6f); u32x2 w; w.x = cvtpk(v[0] * rs * gck[0], v[1] * rs * gck[1]); w.y = cvtpk(v[2] * rs * gck[2], v[3] * rs * gck[3]);
          *(u32x2*)(kcat + (size_t)tok * 288 + lane * 4) = w; }
        if (lane < 16) { const float x1 = sm[256 + lane], x2 = sm[272 + lane]; kcat[(size_t)tok * 288 + 256 + lane] = f2bf(x1 * cr - x2 * sr); kcat[(size_t)tok * 288 + 272 + lane] = f2bf(x2 * cr + x1 * sr); }
        { float o = sm[288 + lane];
          if (lane < 8) { const float x2 = sm[296 + lane]; o = o * ci - x2 * si; } else if (lane < 16) { const float x1 = sm[288 + lane - 8]; o = o * ci + x1 * si; }
          ki[(size_t)tok * 64 + lane] = f2bf(o); }
        if (lane < 16) wi[(size_t)tok * 16 + lane] = sm[352 + lane] * (1.0f / 32.0f);
        if (lane < 8) { const float f = sm[368 + lane] + bfo; lf[(size_t)(b * 8 + lane) * SEQ + s] = fminf(f, 0.f) - log1pf(__expf(-fabsf(f))); }
#pragma unroll
        for (int pp = 0; pp < 2; ++pp) { const int p = lane + 64 * pp, h = p >> 4, i = p & 15;
            const float x1 = bf2f(qa[(size_t)tok * 1024 + h * 128 + i]), x2 = bf2f(qa[(size_t)tok * 1024 + h * 128 + 16 + i]);
            qcat[(size_t)tok * 2304 + h * 288 + 256 + i] = f2bf(x1 * cr - x2 * sr); qcat[(size_t)tok * 2304 + h * 288 + 272 + i] = f2bf(x2 * cr + x1 * sr); }
#pragma unroll
        for (int pp = 0; pp < 2; ++pp) { const int p = lane + 64 * pp, hh = p >> 3, i = p & 7; bf16_t* q = qidx + (size_t)tok * 1024 + hh * 64;
            const float x1 = bf2f(q[i]), x2 = bf2f(q[8 + i]); q[i] = f2bf(x1 * ci - x2 * si); q[8 + i] = f2bf(x2 * ci + x1 * si); }
    }
    { const bf16_t* kbt = (const bf16_t*)(ws + R_QKV) + (size_t)NTOK * 1024; unsigned* kmx = (unsigned*)(ws + WS_CTL) + CW_KMAX + l * 16;
#pragma unroll 1
      for (int bh = 0; bh < 16; ++bh) { float mx = 0.f;
          for (int r0 = (F.bid * 8 + F.wid) * 4; r0 < SEQ; r0 += F.G * 32) {
              const u32x4 w = *(const u32x4*)(kbt + ((size_t)bh * SEQ + r0 + (lane >> 4)) * 128 + (lane & 15) * 8);
              float ss = bflo(w.x) * bflo(w.x) + bfhi(w.x) * bfhi(w.x) + bflo(w.y) * bflo(w.y) + bfhi(w.y) * bfhi(w.y) + bflo(w.z) * bflo(w.z) + bfhi(w.z) * bfhi(w.z) + bflo(w.w) * bflo(w.w) + bfhi(w.w) * bfhi(w.w);
              ss += __shfl_xor(ss, 1); ss += __shfl_xor(ss, 2); ss += __shfl_xor(ss, 4); ss += __shfl_xor(ss, 8); mx = fmaxf(mx, ss); }
          mx = fmaxf(mx, __shfl_xor(mx, 16)); mx = fmaxf(mx, __shfl_xor(mx, 32));
          if (lane == 0) ((float*)F.lds)[F.wid * 16 + bh] = mx; }
      __syncthreads();
      if (F.tid < 16) { float mx = 0.f;
#pragma unroll
          for (int w = 0; w < 8; ++w) mx = fmaxf(mx, ((const float*)F.lds)[w * 16 + F.tid]);
          const unsigned bits = __float_as_uint(mx);
          if (bits > __hip_atomic_load(&kmx[F.tid], __ATOMIC_RELAXED, __HIP_MEMORY_SCOPE_AGENT)) atomicMax(&kmx[F.tid], bits); }
      __syncthreads(); }
}
__device__ __forceinline__ void phase_cumsum(const Frame& F0) { const Frame F = fresh(F0);
    const int gw = F.bid * 8 + F.wid; if (gw >= 16) return;
    const float* lf = (const float*)(F.ws + WS_LF) + (size_t)gw * SEQ; float* cum = (float*)(F.ws + WS_CUM) + (size_t)gw * SEQ;
    const int lane = F.lane; double tot = 0.0;
#pragma unroll 1
    for (int hb = 0; hb < 2; ++hb) { f32x4 v[16];
#pragma unroll
        for (int j = 0; j < 16; ++j) v[j] = *(const f32x4*)(lf + lane * 128 + hb * 64 + j * 4);
#pragma unroll
        for (int j = 0; j < 16; ++j)
#pragma unroll
            for (int e = 0; e < 4; ++e) tot += (double)v[j][e]; }
    double inc = tot;
    for (int o = 1; o < 64; o <<= 1) { const double n = __shfl_up(inc, o); if (lane >= o) inc += n; }
    double run = inc - tot;
#pragma unroll 1
    for (int hb = 0; hb < 2; ++hb) { f32x4 v[16];
#pragma unroll
        for (int j = 0; j < 16; ++j) v[j] = *(const f32x4*)(lf + lane * 128 + hb * 64 + j * 4);
#pragma unroll
        for (int j = 0; j < 16; ++j) { f32x4 o;
#pragma unroll
            for (int e = 0; e < 4; ++e) { run += (double)v[j][e]; o[e] = (float)run; }
            v[j] = o; }
#pragma unroll
        for (int j = 0; j < 16; ++j) *(f32x4*)(cum + lane * 128 + hb * 64 + j * 4) = v[j]; }
}

__device__ __forceinline__ void idx_unit(const Frame& F, int b, int pi, int half) {
    const int tid = F.tid, lane = F.lane, rho = lane & 31, hh = lane >> 5; unsigned char* ws = F.ws;
    const bf16_t* qidx = (const bf16_t*)(ws + R_QIDX); const bf16_t* ki = (const bf16_t*)(ws + R_KI) + (size_t)b * SEQ * 64; const float* wi = (const float*)(ws + R_WI);
    float* scores = (float*)(ws + R_SCORES) + (size_t)b * SEQ * SEQ;
    LAS unsigned char* kl = F.ldsl;
    const int gl = pi, gh = 127 - pi, nl = (64 * gl + 63) / 128 + 1, nh = (64 * gh + 63) / 128 + 1, tot = nl + nh;
    const int x0 = half ? tot / 2 : 0, x1 = half ? tot : tot / 2;
    bf16x8 af[4][4]; float wv[4][16]; int t0 = 0, curg = -1;
    const int r0 = tid >> 3, p0 = tid & 7;
    const unsigned d0 = (unsigned)(r0 * 128 + ((p0 ^ (r0 & 7)) << 4)), d1 = d0 + 64 * 128;
    u32x4 s0, s1;
    { const int c = x0 < nl ? x0 : x0 - nl; const bf16_t* kp = ki + (size_t)(c * 128) * 64; s0 = *(const u32x4*)(kp + (size_t)r0 * 64 + p0 * 8); s1 = *(const u32x4*)(kp + (size_t)(r0 + 64) * 64 + p0 * 8); }
    __syncthreads();
    *(LAS u32x4*)(kl + d0) = s0; *(LAS u32x4*)(kl + d1) = s1;
    __syncthreads();
    const unsigned rdo = (unsigned)(rho * 128);
#pragma unroll 1
    for (int x = x0; x < x1; ++x) {
        const int g = x < nl ? gl : gh, c = x < nl ? x : x - nl;
        if (g != curg) { curg = g; t0 = g * 64 + F.wid * 8;
#pragma unroll
            for (int mt = 0; mt < 4; ++mt) {
                const int tokA = b * SEQ + t0 + 2 * mt + ((rho >> 2) & 1), head = (rho & 3) + 4 * (rho >> 3);
#pragma unroll
                for (int kk = 0; kk < 4; ++kk) af[mt][kk] = *(const bf16x8*)(qidx + (size_t)tokA * 1024 + head * 64 + kk * 16 + 8 * hh);
                const float* wp = wi + (size_t)(b * SEQ + t0 + 2 * mt + hh) * 16;
#pragma unroll
                for (int q = 0; q < 4; ++q) { const f32x4 v = *(const f32x4*)(wp + 4 * q); wv[mt][4 * q] = v[0]; wv[mt][4 * q + 1] = v[1]; wv[mt][4 * q + 2] = v[2]; wv[mt][4 * q + 3] = v[3]; } } }
        const unsigned bo = (unsigned)((x - x0) & 1) * 16384u;
        if (x + 1 < x1) { const int cn = (x + 1) < nl ? (x + 1) : (x + 1) - nl; const bf16_t* kp = ki + (size_t)(cn * 128) * 64; s0 = *(const u32x4*)(kp + (size_t)r0 * 64 + p0 * 8); s1 = *(const u32x4*)(kp + (size_t)(r0 + 64) * 64 + p0 * 8); }
#pragma unroll
        for (int tl = 0; tl < 4; ++tl) {
            const int kb = c * 128 + tl * 32;
            if (kb <= t0 + 7) {
                bf16x8 bc[4];
#pragma unroll
                for (int kk = 0; kk < 4; ++kk) bc[kk] = *(const LAS bf16x8*)(kl + bo + tl * 4096 + rdo + (((kk * 2 + hh) ^ (rho & 7)) << 4));
                f32x16 a0 = {}, a1 = {}, a2 = {}, a3 = {};
#pragma unroll
                for (int kk = 0; kk < 4; ++kk) { a0 = __builtin_amdgcn_mfma_f32_32x32x16_bf16(af[0][kk], bc[kk], a0, 0, 0, 0); a1 = __builtin_amdgcn_mfma_f32_32x32x16_bf16(af[1][kk], bc[kk], a1, 0, 0, 0);
                                                  a2 = __builtin_amdgcn_mfma_f32_32x32x16_bf16(af[2][kk], bc[kk], a2, 0, 0, 0); a3 = __builtin_amdgcn_mfma_f32_32x32x16_bf16(af[3][kk], bc[kk], a3, 0, 0, 0); }
#define IDX_EPI(A_, mt_) do { float x_0 = 0.f, x_1 = 0.f, x_2 = 0.f, x_3 = 0.f; _Pragma("unroll") for (int r = 0; r < 16; r += 4) { \
                    x_0 = fmaf(wv[mt_][r], fmaxf(A_[r], 0.f), x_0); x_1 = fmaf(wv[mt_][r + 1], fmaxf(A_[r + 1], 0.f), x_1); x_2 = fmaf(wv[mt_][r + 2], fmaxf(A_[r + 2], 0.f), x_2); x_3 = fmaf(wv[mt_][r + 3], fmaxf(A_[r + 3], 0.f), x_3); } \
                    scores[(size_t)(t0 + 2 * (mt_) + hh) * SEQ + kb + rho] = (x_0 + x_1) + (x_2 + x_3); } while (0)
                IDX_EPI(a0, 0); IDX_EPI(a1, 1); IDX_EPI(a2, 2); IDX_EPI(a3, 3);
#undef IDX_EPI
            }
        }
        if (x + 1 < x1) { *(LAS u32x4*)(kl + (bo ^ 16384u) + d0) = s0; *(LAS u32x4*)(kl + (bo ^ 16384u) + d1) = s1; }
        __syncthreads();
    }
}
__device__ __forceinline__ void phase_idx(const Frame& F0) { const Frame F = fresh(F0);
#pragma unroll 1
    for (int it = F.bid; it < 256; it += F.G) { const int b = it >> 7, pi = (it >> 1) & 63, half = it & 1; idx_unit(F, b, pi, half); }
}

__device__ __forceinline__ unsigned sortable(float f) { const unsigned u = __float_as_uint(f); return u ^ ((unsigned)((int)u >> 31) | 0x80000000u); }
__device__ __forceinline__ void topk_row(const Frame& F, int b, int t) {
    int lane = F.lane; asm volatile("" : "+v"(lane));
    const int L = t + 1, tok = b * SEQ + t; unsigned char* ws = F.ws;
    int* sel = (int*)(ws + R_SEL) + (size_t)tok * 256; int* nsel = (int*)(ws + R_NSEL);
    if (lane == 0) nsel[tok] = L < 256 ? L : 256;
    if (L <= 256) { for (int j = lane; j < 256; j += 64) sel[j] = j < L ? j : 0; return; }
    const float* row = (const float*)(ws + R_SCORES) + ((size_t)b * SEQ + t) * SEQ;
    const int nch = (L + 1023) >> 10;
#define TOPK_LOAD_ROW() do { _Pragma("unroll") for (int c = 0; c < 8; ++c) { \
        if (c + 1 < nch) { _Pragma("unroll") for (int jj = 0; jj < 4; ++jj) { const int j = c * 4 + jj; const f32x4 v = *(const f32x4*)(row + j * 256 + lane * 4); \
                _Pragma("unroll") for (int e_ = 0; e_ < 4; ++e_) u[j * 4 + e_] = sortable(v[e_]); } }     \
        else if (c < nch) { _Pragma("unroll") for (int jj = 0; jj < 4; ++jj) { const int j = c * 4 + jj; const f32x4 v = *(const f32x4*)(row + j * 256 + lane * 4); \
                _Pragma("unroll") for (int e_ = 0; e_ < 4; ++e_) { const int idx = j * 256 + lane * 4 + e_; u[j * 4 + e_] = idx < L ? sortable(v[e_]) : 0u; } } } \
        else { _Pragma("unroll") for (int q = 0; q < 16; ++q) u[c * 16 + q] = 0u; } } } while (0)
    unsigned u[128];
    TOPK_LOAD_ROW();
    unsigned g0 = 0u, g1 = 0u, g2 = 0u, g3 = 0u;
#pragma unroll
    for (int c = 0; c < 8; ++c) if (c < nch) {
#pragma unroll
        for (int jj = 0; jj < 4; ++jj) { const int j = c * 4 + jj; g0 = u[4 * j] > g0 ? u[4 * j] : g0; g1 = u[4 * j + 1] > g1 ? u[4 * j + 1] : g1; g2 = u[4 * j + 2] > g2 ? u[4 * j + 2] : g2; g3 = u[4 * j + 3] > g3 ? u[4 * j + 3] : g3; } }
    unsigned tl = g0 < g1 ? g0 : g1; { const unsigned t2 = g2 < g3 ? g2 : g3; tl = tl < t2 ? tl : t2; }
#pragma unroll
    for (int o = 32; o > 0; o >>= 1) { const unsigned x = (unsigned)__shfl_xor((int)tl, o); tl = x < tl ? x : tl; }
    unsigned gmx = g0 > g1 ? g0 : g1; { const unsigned t2 = g2 > g3 ? g2 : g3; gmx = gmx > t2 ? gmx : t2; }
#pragma unroll
    for (int o = 32; o > 0; o >>= 1) { const unsigned x = (unsigned)__shfl_xor((int)gmx, o); gmx = x > gmx ? x : gmx; }
    unsigned thr = tl;
    if (nch >= 2) { const unsigned d = tl ^ gmx; const int hb = d ? 31 - __clz(d) : -1; const unsigned low = hb < 0 ? 0u : (hb == 31 ? 0xffffffffu : ((2u << hb) - 1u));
        unsigned T2 = gmx & ~low;
        for (int bit = hb; bit >= 0; --bit) { const unsigned cnd = T2 | (1u << bit);
            const int cnt = __popcll(__ballot(g0 >= cnd)) + __popcll(__ballot(g1 >= cnd)) + __popcll(__ballot(g2 >= cnd)) + __popcll(__ballot(g3 >= cnd));
            if (cnt >= 200) T2 = cnd; }
        thr = T2; }
    constexpr int CAP = 2048;
    LAS unsigned* candk = (LAS unsigned*)(F.ldsl + F.wid * (CAP * 8)); LAS unsigned* candi = candk + CAP;
    int C = 0, myc = 0, inc = 0;
#pragma unroll 1
    for (int att = 0; att < 2; ++att) { myc = 0; unsigned th = thr; asm volatile("" : "+v"(th));
#pragma unroll
        for (int c = 0; c < 8; ++c) if (c < nch) {
#pragma unroll
            for (int q = 0; q < 16; ++q) myc += u[c * 16 + q] >= th ? 1 : 0; }
        inc = myc;
#pragma unroll
        for (int o = 1; o < 64; o <<= 1) { const int n = __shfl_up(inc, o); if (lane >= o) inc += n; }
        C = __shfl(inc, 63);
        if (C >= 256 || thr == tl) break;
        thr = tl; }
    if (C <= CAP) { int p = inc - myc;
#pragma unroll
        for (int c = 0; c < 8; ++c) if (c < nch) {
#pragma unroll
            for (int q = 0; q < 16; ++q) { const int rq = c * 16 + q;
                if (u[rq] >= thr) { candk[p] = u[rq]; candi[p] = (unsigned)((rq >> 2) * 256 + lane * 4 + (rq & 3)); ++p; }
                if ((q & 3) == 3) SBAR(); } }
        asm volatile("s_waitcnt lgkmcnt(0)" ::: "memory"); }
    if (C <= CAP) {
        const int ng = (C + 255) >> 8;
        unsigned ck[32]; int ci[32];
#pragma unroll
        for (int g = 0; g < 8; ++g) {
#pragma unroll
            for (int q = 0; q < 4; ++q) { const int r = g * 4 + q, p = r * 64 + lane; ck[r] = 0u; ci[r] = 0;
                if (g < ng && p < C) { ck[r] = candk[p]; ci[r] = (int)candi[p]; } } }
        unsigned thr_gt = 0u; int need_eq = 0; bool early = false;
        const unsigned d2 = thr ^ gmx; const int hb2 = d2 ? 31 - __clz(d2) : -1; const unsigned low2 = hb2 < 0 ? 0u : (hb2 == 31 ? 0xffffffffu : ((2u << hb2) - 1u));
        unsigned T = gmx & ~low2;
        for (int bit = hb2; bit >= 0; --bit) {
            const unsigned cnd = T | (1u << bit); int cnt = 0;
#pragma unroll
            for (int g = 0; g < 8; ++g) if (g < ng) {
#pragma unroll
                for (int q = 0; q < 4; ++q) cnt += __popcll(__ballot(ck[g * 4 + q] >= cnd)); }
            if (cnt >= 256) { T = cnd; if (cnt == 256) { early = true; break; } }
        }
        if (early) { thr_gt = T - 1u; need_eq = 0; }
        else { int gtc = 0;
#pragma unroll
            for (int g = 0; g < 8; ++g) if (g < ng) {
#pragma unroll
                for (int q = 0; q < 4; ++q) gtc += __popcll(__ballot(ck[g * 4 + q] > T)); }
            thr_gt = T; need_eq = 256 - gtc; }
        int base = 0, eq_taken = 0;
#pragma unroll
        for (int g = 0; g < 8; ++g) if (g < ng) {
#pragma unroll
            for (int q = 0; q < 4; ++q) { const int r = g * 4 + q; const unsigned v = ck[r];
                const bool iseq = (v == thr_gt) && (need_eq > 0);
                const unsigned long long meq = __ballot(iseq);
                const int eqr = __popcll(meq & ((1ull << lane) - 1ull));
                const bool take = (v > thr_gt) || (iseq && (eq_taken + eqr < need_eq));
                const unsigned long long mt = __ballot(take);
                const int pos = base + __popcll(mt & ((1ull << lane) - 1ull));
                if (take && pos < 256) sel[pos] = ci[r];
                base += __popcll(mt); eq_taken += __popcll(meq); } }
        return;
    }
    asm volatile("" ::: "memory");
    TOPK_LOAD_ROW();
    unsigned T = 0u, thr_gt = 0u; int need_eq = 0; bool early = false;
    for (int bit = 31; bit >= 0; --bit) {
        const unsigned cand = T | (1u << bit); int cnt = 0;
#pragma unroll
        for (int c = 0; c < 8; ++c) if (c < nch) {
#pragma unroll
            for (int q = 0; q < 16; ++q) cnt += __popcll(__ballot(u[c * 16 + q] >= cand)); }
        if (cnt >= 256) { T = cand; if (cnt == 256) { early = true; break; } }
    }
    if (early) { thr_gt = T - 1u; need_eq = 0; }
    else { int gtc = 0;
#pragma unroll
        for (int c = 0; c < 8; ++c) if (c < nch) {
#pragma unroll
            for (int q = 0; q < 16; ++q) gtc += __popcll(__ballot(u[c * 16 + q] > T)); }
        thr_gt = T; need_eq = 256 - gtc; }
    int base = 0, eq_taken = 0;
#pragma unroll
    for (int c = 0; c < 8; ++c) if (c < nch) {
#pragma unroll
        for (int q = 0; q < 16; ++q) { const int rq = c * 16 + q; const unsigned v = u[rq];
            const bool iseq = (v == thr_gt) && (need_eq > 0);
            const unsigned long long meq = __ballot(iseq);
            const int eqr = __popcll(meq & ((1ull << lane) - 1ull));
            const bool take = (v > thr_gt) || (iseq && (eq_taken + eqr < need_eq));
            const unsigned long long mt = __ballot(take);
            const int pos = base + __popcll(mt & ((1ull << lane) - 1ull));
            if (take && pos < 256) sel[pos] = (rq >> 2) * 256 + lane * 4 + (rq & 3);
            base += __popcll(mt); eq_taken += __popcll(meq); } }
}
__device__ __forceinline__ void phase_topk(const Frame& F0) { const Frame F = fresh(F0);
    for (int q = F.bid * 8 + F.wid; q < 8192; q += F.G * 8) { const int b = q >> 12, p = q & 4095; topk_row(F, b, p); topk_row(F, b, SEQ - 1 - p); }
}

namespace att {
constexpr int D = 128, KVBLK = 64, QBLK = 32, SHM_V = 16384, SHM_K = 16384;
constexpr int OFF_K = 2 * SHM_V, OFF_BIAS = 2 * SHM_V + 2 * SHM_K, OFF_WS = OFF_BIAS + 512, OFF_FLAGS = OFF_WS + 2048, OFF_QITEM = OFF_FLAGS + 64;
constexpr float EXIT_T = 44.0f;
#define KSWZ(row, colB) ((row) * 256 + ((colB) ^ (((row) & 7) << 4)))
__device__ __forceinline__ int v_st(int k, int c) { const int kk = (k & ~0xC) | ((k & 4) << 1) | ((k & 8) >> 1); return ((kk >> 3) * 4 + (c >> 5)) * 512 + ((kk & 7) * 32 + (c & 31)) * 2; }
__device__ __forceinline__ int v_rd_base(int lane) { return ((lane & 3) << 3) | (((lane >> 2) & 3) << 6) | (((lane >> 4) & 1) << 5) | (((lane >> 5) & 1) << 8); }
constexpr int v_rd_off(int d0, int ks, int half) { return d0 * 512 + ks * 4096 + half * 2048; }
template <int KB>
__device__ __forceinline__ void qkt(f32x16& p0, f32x16& p1, const char* K_lds, int r32, int hi, const bf16x8* qr) {
    p0 = f32x16{}; p1 = f32x16{};
    const char* kb[4];
#pragma unroll
    for (int dd = 0; dd < 4; ++dd) kb[dd] = K_lds + KB * SHM_K + KSWZ(r32, (dd * 16 + hi * 8) * 2);
#pragma unroll
    for (int d0 = 0; d0 < 8; ++d0) { const char* a = kb[d0 & 3] + (d0 >> 2) * 128;
        bf16x8 b0 = *reinterpret_cast<const bf16x8*>(a);
        bf16x8 b1 = *reinterpret_cast<const bf16x8*>(a + 32 * 256);
        p0 = __builtin_amdgcn_mfma_f32_32x32x16_bf16(b0, qr[d0], p0, 0, 0, 0);
        p1 = __builtin_amdgcn_mfma_f32_32x32x16_bf16(b1, qr[d0], p1, 0, 0, 0); }
}
template <int VB>
__device__ __forceinline__ void pv_tile(f32x16* o, int vb0, bf16x8 pa0, bf16x8 pa1, bf16x8 pa2, bf16x8 pa3) {
#define TRRD(dst, off) asm volatile("ds_read_b64_tr_b16 %0, %1 offset:%2" : "=&v"(dst) : "v"(vb0), "i"(off) : "memory")
#define PV_D0(d0) do { s16x4 l0, l1, l2, l3, h0, h1, h2, h3; constexpr int b_ = VB * SHM_V + v_rd_off(d0, 0, 0); \
        TRRD(l0, b_); TRRD(h0, b_ + 2048); TRRD(l1, b_ + 4096); TRRD(h1, b_ + 6144); TRRD(l2, b_ + 8192); TRRD(h2, b_ + 10240); TRRD(l3, b_ + 12288); TRRD(h3, b_ + 14336); \
        asm volatile("s_waitcnt lgkmcnt(0)" ::: "memory"); SBAR(); \
        o[d0] = __builtin_amdgcn_mfma_f32_32x32x16_bf16(pa0, (bf16x8){l0[0], l0[1], l0[2], l0[3], h0[0], h0[1], h0[2], h0[3]}, o[d0], 0, 0, 0); \
        o[d0] = __builtin_amdgcn_mfma_f32_32x32x16_bf16(pa1, (bf16x8){l1[0], l1[1], l1[2], l1[3], h1[0], h1[1], h1[2], h1[3]}, o[d0], 0, 0, 0); \
        o[d0] = __builtin_amdgcn_mfma_f32_32x32x16_bf16(pa2, (bf16x8){l2[0], l2[1], l2[2], l2[3], h2[0], h2[1], h2[2], h2[3]}, o[d0], 0, 0, 0); \
        o[d0] = __builtin_amdgcn_mfma_f32_32x32x16_bf16(pa3, (bf16x8){l3[0], l3[1], l3[2], l3[3], h3[0], h3[1], h3[2], h3[3]}, o[d0], 0, 0, 0); } while (0)
    PV_D0(0); PV_D0(1); PV_D0(2); PV_D0(3);
#undef PV_D0
#undef TRRD
}
#define PK4(P, B_, OUT) do { unsigned a0 = cvtpk(P[B_+0], P[B_+1]), a1 = cvtpk(P[B_+2], P[B_+3]); \
        unsigned b0 = cvtpk(P[B_+4], P[B_+5]), b1 = cvtpk(P[B_+6], P[B_+7]); \
        auto r0 = __builtin_amdgcn_permlane32_swap(a0, b0, false, false); auto r1 = __builtin_amdgcn_permlane32_swap(a1, b1, false, false); \
        u32x4 w = {r0[0], r1[0], r0[1], r1[1]}; OUT = *reinterpret_cast<bf16x8*>(&w); } while (0)
__device__ __forceinline__ float swap_max(float x) { auto rr = __builtin_amdgcn_permlane32_swap(__float_as_uint(x), __float_as_uint(x), false, false); return fmaxf(__uint_as_float(rr[0]), __uint_as_float(rr[1])); }
__device__ __forceinline__ float swap_sum(float x) { auto rr = __builtin_amdgcn_permlane32_swap(__float_as_uint(x), __float_as_uint(x), false, false); return __uint_as_float(rr[0]) + __uint_as_float(rr[1]); }
__device__ __forceinline__ float swap_lo(float x) { auto rr = __builtin_amdgcn_permlane32_swap(__float_as_uint(x), __float_as_uint(x), false, false); return __uint_as_float(rr[0]); }


__device__ __forceinline__ void fox_sm(f32x16& p0, f32x16& p1, const float* bl, int kb_, int qlo, int qrow, int hi, int r32, float& m_reg, float& l_reg, f32x16* o, float* al_l,
                                       bf16x8& pa0, bf16x8& pa1, bf16x8& pa2, bf16x8& pa3) {
#pragma unroll
    for (int g = 0; g < 4; ++g) { const f32x4 b0v = *(const f32x4*)(bl + 8 * g + 4 * hi), b1v = *(const f32x4*)(bl + 32 + 8 * g + 4 * hi);
#pragma unroll
        for (int i = 0; i < 4; ++i) { p0[4 * g + i] = fmaf(p0[4 * g + i], C2, b0v[i]); p1[4 * g + i] = fmaf(p1[4 * g + i], C2, b1v[i]); } }
    if (kb_ + KVBLK - 1 > qlo) { const float NEG = -__builtin_inff();
#pragma unroll
        for (int r = 0; r < 16; ++r) { const int key = kb_ + crow(r, hi); if (key > qrow) p0[r] = NEG; if (key + 32 > qrow) p1[r] = NEG; } }
    float pmax = p0[0];
#pragma unroll
    for (int r = 1; r < 16; ++r) pmax = fmaxf(pmax, p0[r]);
#pragma unroll
    for (int r = 0; r < 16; ++r) pmax = fmaxf(pmax, p1[r]);
    pmax = swap_max(pmax);
    const float mn = fmaxf(m_reg, pmax), alpha = __builtin_amdgcn_exp2f(m_reg - mn); m_reg = mn;
    float ps = 0.f;
#pragma unroll
    for (int r = 0; r < 16; ++r) { p0[r] = __builtin_amdgcn_exp2f(p0[r] - mn); p1[r] = __builtin_amdgcn_exp2f(p1[r] - mn); ps += p0[r] + p1[r]; }
    ps = swap_sum(ps); l_reg = l_reg * alpha + ps;
    if (__any(alpha < 1.f)) { if (hi == 0) al_l[r32] = alpha; asm volatile("s_waitcnt lgkmcnt(0)" ::: "memory");
#pragma unroll
        for (int r = 0; r < 16; ++r) { const float a = al_l[crow(r, hi)];
#pragma unroll
            for (int d_ = 0; d_ < 4; ++d_) o[d_][r] *= a; } }
    PK4(p0, 0, pa0); PK4(p0, 8, pa1); PK4(p1, 0, pa2); PK4(p1, 8, pa3);
}
__device__ __forceinline__ void sb_half(f32x16& pz, int keybase, int qrow, int hi, float& R, const bf16x8* triA, bool needmask) {
    f32x16 X;
#pragma unroll
    for (int r = 0; r < 16; ++r) { const float zz = pz[r] * C2; const bool valid = !needmask || (keybase + crow(r, hi) < qrow);
        const float l2 = fmaxf(zz, 0.f) + __builtin_amdgcn_logf(1.0f + __builtin_amdgcn_exp2f(-fabsf(zz)));
        X[r] = valid ? -l2 : 0.f; pz[r] = valid ? zz : -__builtin_inff(); }
    f32x16 Y;
#pragma unroll
    for (int r = 0; r < 16; ++r) Y[r] = R;
#pragma unroll
    for (int s = 0; s < 2; ++s) {
        const unsigned h0 = cvtpk(X[8 * s + 0], X[8 * s + 1]), h1 = cvtpk(X[8 * s + 2], X[8 * s + 3]), h2 = cvtpk(X[8 * s + 4], X[8 * s + 5]), h3 = cvtpk(X[8 * s + 6], X[8 * s + 7]);
        const unsigned l0 = cvtpk(X[8 * s + 0] - bflo(h0), X[8 * s + 1] - bfhi(h0)), l1 = cvtpk(X[8 * s + 2] - bflo(h1), X[8 * s + 3] - bfhi(h1));
        const unsigned l2 = cvtpk(X[8 * s + 4] - bflo(h2), X[8 * s + 5] - bfhi(h2)), l3 = cvtpk(X[8 * s + 6] - bflo(h3), X[8 * s + 7] - bfhi(h3));
        u32x4 wh = {h0, h1, h2, h3}, wl = {l0, l1, l2, l3};
        Y = __builtin_amdgcn_mfma_f32_32x32x16_bf16(triA[s], *reinterpret_cast<bf16x8*>(&wh), Y, 0, 0, 0);
        Y = __builtin_amdgcn_mfma_f32_32x32x16_bf16(triA[s], *reinterpret_cast<bf16x8*>(&wl), Y, 0, 0, 0); }
#pragma unroll
    for (int r = 0; r < 16; ++r) pz[r] = __builtin_amdgcn_exp2f(pz[r] + Y[r]);
    R = swap_lo(Y[0]);
}
__device__ __forceinline__ void sb_sm(f32x16& p0, f32x16& p1, int kb_, int qlo, int qrow, int hi, float& R, const bf16x8* triA, bf16x8& pa0, bf16x8& pa1, bf16x8& pa2, bf16x8& pa3) {
    const bool needmask = (kb_ + KVBLK - 1 >= qlo);
    sb_half(p1, kb_ + 32, qrow, hi, R, triA, needmask);
    sb_half(p0, kb_, qrow, hi, R, triA, needmask);
    PK4(p0, 0, pa0); PK4(p0, 8, pa1); PK4(p1, 0, pa2); PK4(p1, 8, pa3);
}

template <int MODE>
__device__ __forceinline__ void attn_unit(const bf16_t* Q, const bf16_t* Kh, const bf16_t* Vh, const float* cum, bf16_t* O, int P0, char* lds, float kmaxc) {
    int tid = threadIdx.x; asm volatile("" : "+v"(tid));
    const int wid = __builtin_amdgcn_readfirstlane(tid >> 6), lane = tid & 63, r32 = lane & 31, hi = lane >> 5;
    const int NT = P0 / KVBLK + 4;
    char* V_lds = lds; char* K_lds = lds + OFF_K; float* bias_l = (float*)(lds + OFF_BIAS);
    float* wsl = (float*)(lds + OFF_WS) + wid * 64; float* li_l = wsl; float* al_l = wsl + 32;
    const int qlo = P0 + wid * QBLK, qrow = qlo + r32;
    bf16x8 qr[8];
#pragma unroll
    for (int d0 = 0; d0 < 8; ++d0) qr[d0] = *(const bf16x8*)(Q + (size_t)qrow * D + d0 * 16 + hi * 8);
    const int sr = tid >> 4, sc = (tid & 15) * 8, vst0 = v_st(sr, sc), vst1 = v_st(32 + sr, sc), kws = KSWZ(sr, sc * 2);
    const int vb0 = (int)(uintptr_t)V_lds + v_rd_base(lane);
    const float cumref = (MODE == 0) ? cum[P0] : 0.f;
    int* flg = (int*)(lds + OFF_FLAGS);
    float qn = 0.f;
    if (MODE == 0) { float ss = 0.f;
#pragma unroll
        for (int d0 = 0; d0 < 8; ++d0)
#pragma unroll
            for (int j = 0; j < 8; ++j) { const float x = bf2f((bf16_t)qr[d0][j]); ss = fmaf(x, x, ss); }
        ss = swap_sum(ss); qn = sqrtf(ss) * kmaxc * 1.001f; }
    float m_reg = -1e30f, l_reg = 0.f, R = 0.f; f32x16 o[4] = {};
    bf16x8 triA[2];
    if (MODE == 1) {
#pragma unroll
        for (int s = 0; s < 2; ++s)
#pragma unroll
            for (int j = 0; j < 8; ++j) { const int rho = 16 * s + 8 * (j >> 2) + 4 * hi + (j & 3); triA[s][j] = (rho >= r32) ? (short)0x3F80 : (short)0; }
    }
    bf16x8 st_k0, st_k1, st_v0, st_v1; float st_b = 0.f;
#define TILE_KB(t) ((NT - 1 - (t)) * KVBLK)
#define SLOAD(kb_) do { st_v0 = *(const bf16x8*)(Vh + (size_t)((kb_) + sr) * D + sc); st_v1 = *(const bf16x8*)(Vh + (size_t)((kb_) + 32 + sr) * D + sc); \
                        st_k0 = *(const bf16x8*)(Kh + (size_t)((kb_) + sr) * D + sc); st_k1 = *(const bf16x8*)(Kh + (size_t)((kb_) + 32 + sr) * D + sc); \
                        if (MODE == 0 && tid < 64) st_b = (cumref - cum[(kb_) + tid]) * LOG2E; } while (0)
#define SWRITE(bf) do { *(bf16x8*)(V_lds + (bf) * SHM_V + vst0) = st_v0; *(bf16x8*)(V_lds + (bf) * SHM_V + vst1) = st_v1; \
                        *(bf16x8*)(K_lds + (bf) * SHM_K + kws) = st_k0; *(bf16x8*)(K_lds + (bf) * SHM_K + kws + 32 * 256) = st_k1; \
                        if (MODE == 0 && tid < 64) bias_l[(bf) * 64 + tid] = st_b; } while (0)
    __syncthreads();
    SLOAD(TILE_KB(0)); SWRITE(0);
    __syncthreads();
    f32x16 p0, p1; bf16x8 pa0, pa1, pa2, pa3;
#define STEP(BUF, t) do { const int kb_ = TILE_KB(t); \
        if ((t) + 1 < NT) SLOAD(TILE_KB((t) + 1)); \
        SBAR(); qkt<BUF>(p0, p1, K_lds, r32, hi, qr); \
        if (MODE == 0) fox_sm(p0, p1, bias_l + (BUF) * 64, kb_, qlo, qrow, hi, r32, m_reg, l_reg, o, al_l, pa0, pa1, pa2, pa3); \
        else sb_sm(p0, p1, kb_, qlo, qrow, hi, R, triA, pa0, pa1, pa2, pa3); \
        SBAR(); pv_tile<BUF>(o, vb0, pa0, pa1, pa2, pa3); \
        if ((t) + 1 < NT) SWRITE((BUF) ^ 1); \
        __syncthreads(); } while (0)
    for (int t = 0; t < NT; t += 2) {
        STEP(0, t); STEP(1, t + 1);
        const int kbc = TILE_KB(t + 1); if (kbc == 0) break;
        bool done;
        if (MODE == 0) { const float edge = (cumref - cum[kbc - 1]) * LOG2E; done = (qn + edge - m_reg) < -EXIT_T; }
        else done = R < -EXIT_T;
        const int par = (t >> 1) & 1;
        if (lane == 0) flg[par * 8 + wid] = 0;
        const bool wdone = __all(done);
        if (lane == 0 && wdone) flg[par * 8 + wid] = 1;
        __syncthreads();
        int alld = 1;
#pragma unroll
        for (int w = 0; w < 8; ++w) alld &= flg[par * 8 + w];
        if (alld) break;
    }
    __syncthreads();
#undef STEP
#undef SLOAD
#undef SWRITE
#undef TILE_KB
    float rli[16];
    if (MODE == 0) { if (hi == 0) li_l[r32] = l_reg; asm volatile("s_waitcnt lgkmcnt(0)" ::: "memory");
#pragma unroll
        for (int r = 0; r < 16; ++r) rli[r] = __builtin_amdgcn_rcpf(li_l[crow(r, hi)]); }
    bf16_t* Ow = O + (size_t)(wid * QBLK) * 3072;
#pragma unroll
    for (int r = 0; r < 16; ++r) { const int orow = crow(r, hi);
#pragma unroll
        for (int d0 = 0; d0 < 4; ++d0) { const float v = (MODE == 0) ? o[d0][r] * rli[r] : o[d0][r];
            const float vn = __shfl_xor(v, 1);
            if ((r32 & 1) == 0) *(unsigned*)(Ow + (size_t)orow * 3072 + d0 * 32 + r32) = cvtpk(v, vn); } }
}
}

__device__ __forceinline__ void sparse_query(const Frame& F, int tok, char* ldsw) {
    unsigned char* ws = F.ws; const int lane = F.lane, g = lane >> 4, i16 = lane & 15;
    const bf16_t* qcat = (const bf16_t*)(ws + R_QCAT) + (size_t)tok * 2304; const bf16_t* kbase = (const bf16_t*)(ws + R_KCAT) + (size_t)(tok >> 13) * SEQ * 288;
    const int* sel = (const int*)(ws + R_SEL) + (size_t)tok * 256; const int ns = ((const int*)(ws + R_NSEL))[tok]; const int ntile = (ns + 31) >> 5;
    bf16x8 qf[9];
#pragma unroll
    for (int st = 0; st < 9; ++st) { qf[st] = (bf16x8){0, 0, 0, 0, 0, 0, 0, 0}; if (i16 < 8) qf[st] = *(const bf16x8*)(qcat + i16 * 288 + st * 32 + 8 * g); }
    const int rA = lane >> 2, cq = lane & 3;
    float m = -1e30f, l = 0.f; f32x4 oT[16];
#pragma unroll
    for (int rb = 0; rb < 16; ++rb) oT[rb] = (f32x4){0.f, 0.f, 0.f, 0.f};
    const unsigned ldso = (unsigned)(uintptr_t)ldsw;
    const unsigned vb = ldso + (unsigned)((4 * g + (i16 >> 2)) * 592 + (i16 & 3) * 8);
    constexpr float SC2 = SCALE * LOG2E;
    bf16x8 stg[18];
#define GATHER(tile_) do { const int j0 = (tile_) * 32 + rA, j1 = j0 + 16; const int s0 = j0 < ns ? sel[j0] : 0, s1 = j1 < ns ? sel[j1] : 0; \
        const bf16_t* p0_ = kbase + (size_t)s0 * 288 + cq * 8; const bf16_t* p1_ = kbase + (size_t)s1 * 288 + cq * 8; \
        _Pragma("unroll") for (int c = 0; c < 9; ++c) { stg[2 * c] = *(const bf16x8*)(p0_ + c * 32); stg[2 * c + 1] = *(const bf16x8*)(p1_ + c * 32); } } while (0)
    GATHER(0);
    for (int tile = 0; tile < ntile; ++tile) {
#pragma unroll
        for (int c = 0; c < 9; ++c) { *(bf16x8*)(ldsw + rA * 592 + c * 64 + cq * 16) = stg[2 * c]; *(bf16x8*)(ldsw + (16 + rA) * 592 + c * 64 + cq * 16) = stg[2 * c + 1]; }
        if (tile + 1 < ntile) GATHER(tile + 1);
        asm volatile("s_waitcnt lgkmcnt(0)" ::: "memory"); SBAR();
        f32x4 acc[2];
#pragma unroll
        for (int mt = 0; mt < 2; ++mt) { acc[mt] = (f32x4){0.f, 0.f, 0.f, 0.f};
#pragma unroll
            for (int st = 0; st < 9; ++st) { const bf16x8 a = *(const bf16x8*)(ldsw + (16 * mt + i16) * 592 + st * 64 + g * 16);
                acc[mt] = __builtin_amdgcn_mfma_f32_16x16x32_bf16(a, qf[st], acc[mt], 0, 0, 0); } }
        float tmax = -__builtin_inff();
#pragma unroll
        for (int mt = 0; mt < 2; ++mt)
#pragma unroll
            for (int r = 0; r < 4; ++r) { const int key = tile * 32 + 16 * mt + 4 * g + r; float x = acc[mt][r] * SC2; if (key >= ns) x = -__builtin_inff(); acc[mt][r] = x; tmax = fmaxf(tmax, x); }
        tmax = fmaxf(tmax, __shfl_xor(tmax, 16)); tmax = fmaxf(tmax, __shfl_xor(tmax, 32));
        const float mn = fmaxf(m, tmax), alpha = __builtin_amdgcn_exp2f(m - mn); m = mn;
        float ps = 0.f;
#pragma unroll
        for (int mt = 0; mt < 2; ++mt)
#pragma unroll
            for (int r = 0; r < 4; ++r) { acc[mt][r] = __builtin_amdgcn_exp2f(acc[mt][r] - mn); ps += acc[mt][r]; }
        ps += __shfl_xor(ps, 16); ps += __shfl_xor(ps, 32);
        l = l * alpha + ps;
#pragma unroll
        for (int rb = 0; rb < 16; ++rb) oT[rb] *= alpha;
        const bf16x8 pf = pack8(acc[0], acc[1]);
#define TRRD2(dst, off) asm volatile("ds_read_b64_tr_b16 %0, %1 offset:%2" : "=&v"(dst) : "v"(vb), "i"(off) : "memory")
#define PVRB4(rb) do { s16x4 ta0, tb0, ta1, tb1, ta2, tb2, ta3, tb3; \
        TRRD2(ta0, ((rb) + 0) * 32); TRRD2(tb0, ((rb) + 0) * 32 + 16 * 592); TRRD2(ta1, ((rb) + 1) * 32); TRRD2(tb1, ((rb) + 1) * 32 + 16 * 592); \
        TRRD2(ta2, ((rb) + 2) * 32); TRRD2(tb2, ((rb) + 2) * 32 + 16 * 592); TRRD2(ta3, ((rb) + 3) * 32); TRRD2(tb3, ((rb) + 3) * 32 + 16 * 592); \
        asm volatile("s_waitcnt lgkmcnt(0)" ::: "memory"); SBAR(); \
        oT[(rb) + 0] = __builtin_amdgcn_mfma_f32_16x16x32_bf16((bf16x8){ta0[0], ta0[1], ta0[2], ta0[3], tb0[0], tb0[1], tb0[2], tb0[3]}, pf, oT[(rb) + 0], 0, 0, 0); \
        oT[(rb) + 1] = __builtin_amdgcn_mfma_f32_16x16x32_bf16((bf16x8){ta1[0], ta1[1], ta1[2], ta1[3], tb1[0], tb1[1], tb1[2], tb1[3]}, pf, oT[(rb) + 1], 0, 0, 0); \
        oT[(rb) + 2] = __builtin_amdgcn_mfma_f32_16x16x32_bf16((bf16x8){ta2[0], ta2[1], ta2[2], ta2[3], tb2[0], tb2[1], tb2[2], tb2[3]}, pf, oT[(rb) + 2], 0, 0, 0); \
        oT[(rb) + 3] = __builtin_amdgcn_mfma_f32_16x16x32_bf16((bf16x8){ta3[0], ta3[1], ta3[2], ta3[3], tb3[0], tb3[1], tb3[2], tb3[3]}, pf, oT[(rb) + 3], 0, 0, 0); } while (0)
        PVRB4(0); PVRB4(4); PVRB4(8); PVRB4(12);
#undef PVRB4
#undef TRRD2
        SBAR();
    }
#undef GATHER
    const float rl = 1.0f / l;
    if (i16 < 8) { bf16_t* op = (bf16_t*)(ws + R_OLAT) + (size_t)tok * 2048 + i16 * 256 + 4 * g;
#pragma unroll
        for (int rb = 0; rb < 16; ++rb) { u32x2 w; w.x = cvtpk(oT[rb][0] * rl, oT[rb][1] * rl); w.y = cvtpk(oT[rb][2] * rl, oT[rb][3] * rl); *(u32x2*)(op + rb * 16) = w; } }
}
#ifdef ATT_SUB
#define ASUB(k) ((k) == ATT_SUB)
#else
#define ASUB(k) true
#endif
__device__ __forceinline__ void phase_attn(const Frame& F0, int l, int rep) { const Frame F = fresh(F0);
    unsigned char* ws = F.ws; char* lds = (char*)F.lds;
    const bf16_t* qkv = (const bf16_t*)(ws + R_QKV); const size_t TS = (size_t)NTOK * 1024;
    unsigned* qctr = (unsigned*)(ws + WS_CTL) + CW_QCTR + l * 64 + rep * 16; const unsigned* kmx = (const unsigned*)(ws + WS_CTL) + CW_KMAX + l * 16;
    int* qitem = (int*)(lds + att::OFF_QITEM);
    int* hord = qitem + 4;
    if (F.tid < 16) { const float* cumb = (const float*)(ws + WS_CUM); const float mine = -cumb[(size_t)F.tid * SEQ + SEQ - 1]; int rank = 0;
        for (int o = 0; o < 16; ++o) { const float v = -cumb[(size_t)o * SEQ + SEQ - 1]; rank += (v < mine || (v == mine && o < F.tid)) ? 1 : 0; }
        hord[rank] = F.tid; }
#pragma unroll 1
    for (;;) {
        __syncthreads();
        if (F.tid == 0) qitem[0] = (int)atomicAdd(qctr, 1u);
        __syncthreads();
        const int it = qitem[0];
        if (it >= 1024) break;
        const int md = it >> 9, j = it & 511;
        const int qb = md == 0 ? 31 - (j & 31) : 31 - (j >> 4), bh = md == 0 ? hord[j >> 5] : (j & 15), b = bh >> 3, h = bh & 7, P0 = qb * 256;
        if (!ASUB(md)) continue;
        const bf16_t* Q = qkv + (size_t)(md * 3 + 0) * TS + (size_t)bh * SEQ * 128; const bf16_t* K = qkv + (size_t)(md * 3 + 1) * TS + (size_t)bh * SEQ * 128; const bf16_t* V = qkv + (size_t)(md * 3 + 2) * TS + (size_t)bh * SEQ * 128;
        const float* cum = (const float*)(ws + WS_CUM) + (size_t)bh * SEQ;
        bf16_t* Ob = (bf16_t*)(ws + R_OA) + (size_t)b * SEQ * 3072 + (md + 1) * 1024 + h * 128;
        if (md == 0) { const float kmaxc = sqrtf(__uint_as_float(kmx[bh])) * C2; att::attn_unit<0>(Q, K, V, cum, Ob + (size_t)P0 * 3072, P0, lds, kmaxc); }
        else att::attn_unit<1>(Q, K, V, cum, Ob + (size_t)P0 * 3072, P0, lds, 0.f);
    }
    __syncthreads();
    char* ldsw = lds + F.wid * 18944;
#pragma unroll 1
    for (int rep = 0; rep < NREP(2); ++rep)
#pragma unroll 1
    for (int tok = F.bid * 8 + F.wid; tok < NTOK; tok += F.G * 8) if (ASUB(2)) sparse_query(F, tok, ldsw);
}

__device__ __forceinline__ void ln_row_w(const u32x4 (&w4)[4], const float* g, const float* bta, float* of, bf16_t* ob, int lane, unsigned char* oq = nullptr, float* osc = nullptr, float* ost = nullptr) {
    f32x4 v[8]; float s = 0.f;
#pragma unroll
    for (int i = 0; i < 4; ++i) { const u32x4 w = w4[i];
        v[2 * i] = (f32x4){bflo(w.x), bfhi(w.x), bflo(w.y), bfhi(w.y)}; v[2 * i + 1] = (f32x4){bflo(w.z), bfhi(w.z), bflo(w.w), bfhi(w.w)};
        s += (v[2 * i][0] + v[2 * i][1]) + (v[2 * i][2] + v[2 * i][3]) + (v[2 * i + 1][0] + v[2 * i + 1][1]) + (v[2 * i + 1][2] + v[2 * i + 1][3]); }
    s = wave_sum(s); const float mu = s * (1.0f / 2048.0f); float q = 0.f;
#pragma unroll
    for (int i = 0; i < 8; ++i) { const f32x4 d = v[i] - mu; q += (d[0] * d[0] + d[1] * d[1]) + (d[2] * d[2] + d[3] * d[3]); }
    q = wave_sum(q); const float rstd = rsqrtf(q * (1.0f / 2048.0f) + 1e-5f);
    if (ost && lane == 0) { ost[0] = mu; ost[1] = rstd; }
    float amax = 0.f;
#pragma unroll
    for (int i = 0; i < 4; ++i) { const int c = (i * 64 + lane) * 8; const f32x4 g0 = *(const f32x4*)(g + c), g1 = *(const f32x4*)(g + c + 4), b0 = *(const f32x4*)(bta + c), b1 = *(const f32x4*)(bta + c + 4);
        const f32x4 y0 = (v[2 * i] - mu) * rstd * g0 + b0, y1 = (v[2 * i + 1] - mu) * rstd * g1 + b1; v[2 * i] = y0; v[2 * i + 1] = y1;
        if (of) { *(f32x4*)(of + c) = y0; *(f32x4*)(of + c + 4) = y1; }
        if (ob) pg8::st_bf16x8(ob + c, y0, y1);
        if (oq) { amax = fmaxf(amax, fmaxf(fmaxf(fmaxf(fabsf(y0[0]), fabsf(y0[1])), fmaxf(fabsf(y0[2]), fabsf(y0[3]))), fmaxf(fmaxf(fabsf(y1[0]), fabsf(y1[1])), fmaxf(fabsf(y1[2]), fabsf(y1[3]))))); } }
    if (oq) {
        for (int o = 32; o > 0; o >>= 1) amax = fmaxf(amax, __shfl_xor(amax, o));
        amax = fmaxf(amax, 1e-20f); const float qi = 127.0f / amax; if (lane == 0) *osc = amax * (1.0f / 127.0f);
#pragma unroll
        for (int i = 0; i < 4; ++i) { u32x2 w;
#pragma unroll
            for (int h = 0; h < 2; ++h) { const f32x4 y = v[2 * i + h]; unsigned pk = 0u;
#pragma unroll
                for (int j = 0; j < 4; ++j) pk |= ((unsigned)(int)rintf(y[j] * qi) & 0xffu) << (8 * j);
                w[h] = pk; }
            *(u32x2*)(oq + (i * 64 + lane) * 8) = w; } }
}
__device__ __forceinline__ void phase_ln1_router(const Frame& F0, const Params& P, int l) { const Frame F = fresh(F0);
    unsigned char* ws = F.ws; const int lane = F.lane, wid = F.wid;
    const bf16_t* pre1 = (const bf16_t*)(ws + R_PRE1); float* x1f = (float*)(ws + M_X1F); bf16_t* x1b = (bf16_t*)(ws + M_X1B); unsigned char* x1q = (unsigned char*)(ws + M_X1Q); float* x1s = (float*)(ws + M_X1S);
    const float* g = F.in(11) + l * DM; const float* bt = F.in(12) + l * DM; const float* wr = F.in(13) + (size_t)l * DM * NEXP; const float* br = F.in(14) + l * NEXP;
    unsigned* cnt = (unsigned*)(ws + WS_CTL) + CW_CNT + l * 2048;
    int* tok_e = (int*)(ws + M_TOKE); int* tok_pos = (int*)(ws + M_TOKPOS); float* tok_w = (float*)(ws + M_TOKW);
    float* red = (float*)F.lds;
    float* lg = (float*)(F.lds + 32768); float* stats = (float*)(F.lds + 32768 + 16384);
#pragma unroll 1
    for (int blk = F.bid; blk < NTOK / 64; blk += F.G) {
        const int tok0 = blk * 64;
#pragma unroll 1
        for (int ib = 0; ib < 2; ++ib) { u32x4 w4[4][4];
#pragma unroll
            for (int r = 0; r < 4; ++r)
#pragma unroll
                for (int i = 0; i < 4; ++i) w4[r][i] = *(const u32x4*)(pre1 + (size_t)(tok0 + wid * 8 + ib * 4 + r) * DM + (i * 64 + lane) * 8);
#pragma unroll
            for (int r = 0; r < 4; ++r) { const int i8 = ib * 4 + r, tok = tok0 + wid * 8 + i8; ln_row_w(w4[r], g, bt, (float*)nullptr, x1b + (size_t)tok * DM, lane, x1q + (size_t)tok * DM, x1s + tok, stats + 2 * (wid * 8 + i8)); } }
        asm volatile("s_waitcnt vmcnt(0)" ::: "memory"); __syncthreads();
        { const int grp = wid >> 2, kq = wid & 3, i32 = lane & 31, hk = lane >> 5; f32x16 acc = {};
          const bf16_t* arow = pre1 + (size_t)(tok0 + grp * 32 + i32) * DM + kq * 512 + 4 * hk; const float* bcol = wr + (size_t)(kq * 512 + 4 * hk) * NEXP + i32;
          const float* gp = g + kq * 512 + 4 * hk; const float* bp = bt + kq * 512 + 4 * hk; const float mu = stats[2 * (grp * 32 + i32)], rstd = stats[2 * (grp * 32 + i32) + 1];
#pragma unroll 8
          for (int c8 = 0; c8 < 64; ++c8) { const u32x2 xw = *(const u32x2*)(arow + c8 * 8); const f32x4 g4 = *(const f32x4*)(gp + c8 * 8), b4 = *(const f32x4*)(bp + c8 * 8);
              const f32x4 a4 = ((f32x4){bflo(xw.x), bfhi(xw.x), bflo(xw.y), bfhi(xw.y)} - mu) * rstd * g4 + b4;
              const float b0 = bcol[(size_t)(c8 * 8 + 0) * NEXP], b1 = bcol[(size_t)(c8 * 8 + 1) * NEXP], b2 = bcol[(size_t)(c8 * 8 + 2) * NEXP], b3 = bcol[(size_t)(c8 * 8 + 3) * NEXP];
              acc = __builtin_amdgcn_mfma_f32_32x32x2f32(a4[0], b0, acc, 0, 0, 0); acc = __builtin_amdgcn_mfma_f32_32x32x2f32(a4[1], b1, acc, 0, 0, 0);
              acc = __builtin_amdgcn_mfma_f32_32x32x2f32(a4[2], b2, acc, 0, 0, 0); acc = __builtin_amdgcn_mfma_f32_32x32x2f32(a4[3], b3, acc, 0, 0, 0); }
#pragma unroll
          for (int r = 0; r < 16; ++r) red[(wid * 16 + r) * 64 + lane] = acc[r]; }
        __syncthreads();
        if ((wid & 3) == 0) { const int grp = wid >> 2, hk = lane >> 5, e = lane & 31; const float be = br[e];
#pragma unroll
            for (int r = 0; r < 16; ++r) { const float v = red[((wid + 0) * 16 + r) * 64 + lane] + red[((wid + 1) * 16 + r) * 64 + lane] + red[((wid + 2) * 16 + r) * 64 + lane] + red[((wid + 3) * 16 + r) * 64 + lane] + be;
                lg[(grp * 32 + crow(r, hk)) * 33 + e] = v; }
            asm volatile("s_waitcnt lgkmcnt(0)" ::: "memory"); SBAR();
            const int tk = lane & 31; float v[32];
#pragma unroll
            for (int e2 = 0; e2 < 32; ++e2) v[e2] = lg[(grp * 32 + tk) * 33 + e2];
            int ek[4]; float vk[4];
#pragma unroll
            for (int k = 0; k < 4; ++k) { float best = -__builtin_inff(); int bi = 0;
#pragma unroll
                for (int e2 = 0; e2 < 32; ++e2) if (v[e2] > best) { best = v[e2]; bi = e2; }
                ek[k] = bi; vk[k] = best;
#pragma unroll
                for (int e2 = 0; e2 < 32; ++e2) v[e2] = (e2 == bi) ? -__builtin_inff() : v[e2]; }
            float wk[4], sw = 0.f;
#pragma unroll
            for (int k = 0; k < 4; ++k) { wk[k] = __expf(vk[k] - vk[0]); sw += wk[k]; }
            const float rs = 1.0f / sw;
            const bool act = lane < 32; unsigned myc = 0u;
#pragma unroll 1
            for (int E = 0; E < 32; ++E) { unsigned c = 0u;
#pragma unroll
                for (int k = 0; k < 4; ++k) c += (unsigned)__popcll(__ballot(act && ek[k] == E));
                if (lane == E) myc = c; }
            unsigned run = 0u; if (lane < 32 && myc > 0u) run = atomicAdd(&cnt[lane * 64], myc);
            int pk[4];
#pragma unroll
            for (int k = 0; k < 4; ++k) { pk[k] = 0;
#pragma unroll 1
                for (int E = 0; E < 32; ++E) { const unsigned long long mm = __ballot(act && ek[k] == E); const unsigned basev = (unsigned)__shfl((int)run, E);
                    if (act && ek[k] == E) pk[k] = (int)(basev + (unsigned)__popcll(mm & ((1ull << lane) - 1ull)));
                    if (lane == E) run += (unsigned)__popcll(mm); } }
            if (act) { const int tok = tok0 + grp * 32 + tk;
#pragma unroll
                for (int k = 0; k < 4; ++k) { tok_e[tok * 4 + k] = ek[k]; tok_pos[tok * 4 + k] = pk[k]; tok_w[tok * 4 + k] = wk[k] * rs; } }
        }
        __syncthreads();
    }
}
__device__ __forceinline__ void phase_moe_gather(const Frame& F0, int l) { const Frame F = fresh(F0);
    unsigned char* ws = F.ws; const int lane = F.lane;
    const unsigned* cnt = (const unsigned*)(ws + WS_CTL) + CW_CNT + l * 2048; unsigned* meta = (unsigned*)(ws + WS_CTL) + CW_META + l * 512;
    unsigned* offs = (unsigned*)(F.lds + LDS_MISC + 64);
    if (F.tid < 64) {
        const unsigned ce = lane < 32 ? cnt[lane * 64] : 0u, pc = (ce + 255u) & ~255u; unsigned inc = pc;
#pragma unroll
        for (int o = 1; o < 64; o <<= 1) { const unsigned n = (unsigned)__shfl_up((int)inc, o); if (lane >= o) inc += n; }
        if (lane < 32) offs[lane] = inc - pc; if (lane == 32) offs[32] = inc;
        if (F.bid == 0) { const unsigned t0 = (inc - pc) >> 8, nte = pc >> 8; for (unsigned t = 0; t < nte; ++t) meta[1 + t0 + t] = (unsigned)lane; if (lane == 32) meta[0] = inc >> 8; } }
    __syncthreads();
    const int* tok_e = (const int*)(ws + M_TOKE); const int* tok_pos = (const int*)(ws + M_TOKPOS); const float* tok_w = (const float*)(ws + M_TOKW);
    int* tok_dst = (int*)(ws + M_TOKDST); float* roww = (float*)(ws + M_ROWW);
    const unsigned char* x1q = (const unsigned char*)(ws + M_X1Q); const float* x1s = (const float*)(ws + M_X1S); unsigned char* xs = (unsigned char*)(ws + M_XS); float* rowsx = (float*)(ws + M_ROWSX);
    unsigned* rowtok = (unsigned*)(ws + M_ROWTOK);
    for (int it = F.bid * 512 + F.tid; it < NTOK * 4; it += F.G * 512) { const int tok = it >> 2;
        const int e = tok_e[it]; const unsigned dst = offs[e] + (unsigned)tok_pos[it];
        tok_dst[it] = (int)dst; roww[dst] = tok_w[it]; rowsx[dst] = x1s[tok]; rowtok[dst] = (unsigned)tok; }
    if (F.bid < 32) { const unsigned e = (unsigned)F.bid, c0 = offs[e] + cnt[e * 64];
        for (unsigned r = c0 + (unsigned)F.tid; r < offs[e + 1]; r += 512u) rowtok[r] = 0u; }
    __syncthreads();
}
__device__ __forceinline__ void phase_quant_h(const Frame& F0, int l) { const Frame F = fresh(F0);
    unsigned char* ws = F.ws; const int lane = F.lane;
    const int nrows = (int)((const unsigned*)(ws + WS_CTL))[CW_META + l * 512] * 256;
    const float* hm = (const float*)(ws + M_HM); const bf16_t* hid = (const bf16_t*)(ws + M_HID); unsigned char* h8 = (unsigned char*)(ws + M_H8); float* h8s = (float*)(ws + M_H8S);
    for (int row = F.bid * 8 + F.wid; row < nrows; row += F.G * 8) {
        float am = hm[(size_t)row * 32 + (lane & 31)];
        const u32x4 a = *(const u32x4*)(hid + (size_t)row * DEXP + lane * 16), b = *(const u32x4*)(hid + (size_t)row * DEXP + lane * 16 + 8);
        for (int o = 16; o > 0; o >>= 1) am = fmaxf(am, __shfl_xor(am, o));
        am = fmaxf(am, 1e-20f); const float qi = 127.0f / am; if (lane == 0) h8s[row] = am * (1.0f / 127.0f);
        const unsigned wv[8] = {a.x, a.y, a.z, a.w, b.x, b.y, b.z, b.w}; u32x4 w;
#pragma unroll
        for (int d = 0; d < 4; ++d) { unsigned pk = 0u;
#pragma unroll
            for (int j = 0; j < 2; ++j) { const unsigned x = wv[d * 2 + j];
                const float q0 = fminf(fmaxf(rintf(bflo(x) * qi), -127.f), 127.f), q1 = fminf(fmaxf(rintf(bfhi(x) * qi), -127.f), 127.f);
                pk |= (((unsigned)(int)q0 & 0xffu) | (((unsigned)(int)q1 & 0xffu) << 8)) << (16 * j); }
            w[d] = pk; }
        *(u32x4*)(h8 + (size_t)row * DEXP + lane * 16) = w; }
}
__device__ __forceinline__ void phase_combine(const Frame& F0) { const Frame F = fresh(F0);
    unsigned char* ws = F.ws; const int lane = F.lane;
    const bf16_t* x1b = (const bf16_t*)(ws + M_X1B); const bf16_t* ys = (const bf16_t*)(ws + M_XS); const int* tok_dst = (const int*)(ws + M_TOKDST);
    bf16_t* hb = (bf16_t*)(ws + M_HB); unsigned char* hq = (unsigned char*)(ws + M_HQ); float* hsc = (float*)(ws + M_HSC);
    for (int tok = F.bid * 8 + F.wid; tok < NTOK; tok += F.G * 8) {
        const int d0 = tok_dst[tok * 4], d1 = tok_dst[tok * 4 + 1], d2 = tok_dst[tok * 4 + 2], d3 = tok_dst[tok * 4 + 3];
        f32x4 hv[8]; float amax = 0.f;
#pragma unroll
        for (int i = 0; i < 4; ++i) { const int c = (i * 64 + lane) * 8; const size_t o = (size_t)tok * DM + c;
            const u32x4 xw = *(const u32x4*)(x1b + o);
            f32x4 a = (f32x4){bflo(xw.x), bfhi(xw.x), bflo(xw.y), bfhi(xw.y)} * ALPHA, b = (f32x4){bflo(xw.z), bfhi(xw.z), bflo(xw.w), bfhi(xw.w)} * ALPHA;
            const u32x4 y0 = *(const u32x4*)(ys + (size_t)d0 * DM + c), y1 = *(const u32x4*)(ys + (size_t)d1 * DM + c), y2 = *(const u32x4*)(ys + (size_t)d2 * DM + c), y3 = *(const u32x4*)(ys + (size_t)d3 * DM + c);
            a[0] += (bflo(y0.x) + bflo(y1.x)) + (bflo(y2.x) + bflo(y3.x)); a[1] += (bfhi(y0.x) + bfhi(y1.x)) + (bfhi(y2.x) + bfhi(y3.x));
            a[2] += (bflo(y0.y) + bflo(y1.y)) + (bflo(y2.y) + bflo(y3.y)); a[3] += (bfhi(y0.y) + bfhi(y1.y)) + (bfhi(y2.y) + bfhi(y3.y));
            b[0] += (bflo(y0.z) + bflo(y1.z)) + (bflo(y2.z) + bflo(y3.z)); b[1] += (bfhi(y0.z) + bfhi(y1.z)) + (bfhi(y2.z) + bfhi(y3.z));
            b[2] += (bflo(y0.w) + bflo(y1.w)) + (bflo(y2.w) + bflo(y3.w)); b[3] += (bfhi(y0.w) + bfhi(y1.w)) + (bfhi(y2.w) + bfhi(y3.w));
            pg8::st_bf16x8(hb + o, a, b); hv[2 * i] = a; hv[2 * i + 1] = b;
#pragma unroll
            for (int j = 0; j < 4; ++j) amax = fmaxf(amax, fmaxf(fabsf(a[j]), fabsf(b[j]))); }
        for (int o = 32; o > 0; o >>= 1) amax = fmaxf(amax, __shfl_xor(amax, o));
        amax = fmaxf(amax, 1e-20f); const float qi = 127.0f / amax; if (lane == 0) hsc[tok] = amax * (1.0f / 127.0f);
#pragma unroll
        for (int i = 0; i < 4; ++i) { u32x2 w;
#pragma unroll
            for (int h = 0; h < 2; ++h) { unsigned pk = 0u;
#pragma unroll
                for (int j = 0; j < 4; ++j) pk |= ((unsigned)(int)rintf(hv[2 * i + h][j] * qi) & 0xffu) << (8 * j);
                w[h] = pk; }
            *(u32x2*)(hq + (size_t)tok * DM + (i * 64 + lane) * 8) = w; } }
}
__device__ __forceinline__ void phase_ln2(const Frame& F0, const Params& P, int l) { const Frame F = fresh(F0);
    unsigned char* ws = F.ws; const bf16_t* pre2 = (const bf16_t*)(ws + M_X1F); bf16_t* xb = (bf16_t*)(ws + WS_XB);
    const float* g = F.in(23) + l * DM; const float* bt = F.in(24) + l * DM; float* outp = F.out();
    const int lane = F.lane, step = F.G * 8;
#pragma unroll 1
    for (int tok0 = F.bid * 8 + F.wid; tok0 < NTOK; tok0 += 4 * step) { u32x4 w4[4][4];
#pragma unroll
        for (int r = 0; r < 4; ++r) { const int tk = (tok0 + r * step) < NTOK ? tok0 + r * step : tok0;
#pragma unroll
            for (int i = 0; i < 4; ++i) w4[r][i] = *(const u32x4*)(pre2 + (size_t)tk * DM + (i * 64 + lane) * 8); }
#pragma unroll
        for (int r = 0; r < 4; ++r) { const int tok = tok0 + r * step; if (tok < NTOK)
            ln_row_w(w4[r], g, bt, (l + 1 == NLAYER) ? outp + (size_t)tok * DM : (float*)nullptr, (l + 1 == NLAYER) ? (bf16_t*)nullptr : xb + (size_t)tok * DM, lane,
                     (l + 1 == NLAYER) ? (unsigned char*)nullptr : (unsigned char*)(ws + WS_XQ) + (size_t)tok * DM, (l + 1 == NLAYER) ? (float*)nullptr : (float*)(ws + WS_XSC) + tok); } }
}

constexpr int NPHASE = 2 + 15 * NLAYER;
#ifdef PH_ONLY
#define PEN(kind) ((kind) == PH_ONLY)
#else
#define PEN(kind) true
#endif
#define IN(k) (lo <= (k) && (k) < hi)
#define SEAM(k) do { if (IN((k) + 1)) xcd_barrier(bar); } while (0)

template <int l>
__device__ __forceinline__ void layer_phases(const Frame& F, const Params& P, const XcdBarrier& bar, const int lo, const int hi, unsigned char* ws0) {
    using namespace pg8;

        const int pb = 2 + 15 * l;
        if (IN(pb + 0) && PEN(0)) { size_t wz = 0; asm volatile("" : "+s"(wz)); unsigned char* ws = ws0 + wz;
            { SchedS S; S.init(NTOK, 5 * 256, F.G, F.bid, (const bf16_t*)(ws + WS_XB), DM, (const bf16_t*)(ws + W_IN), DM); S.skip_from = 0; S.skip_by = 4; S.skip_from2 = 4; S.skip_by2 = 49;
              EpiInProj<false> E{(bf16_t*)(ws + R_QA), (bf16_t*)(ws + R_QIDX), (bf16_t*)(ws + R_QKV), (bf16_t*)(ws + R_GATES), (float*)(ws + R_SMALL), nullptr, nullptr};
              for (int rep = 0; rep < NREP(5); ++rep) gemm_phase(F.ldsl, DM, DM, DM, S, E); }
            { SchedS S; S.init(NTOK, 53 * 256, F.G, (F.bid + F.G / 2) % F.G, (const bf16_t*)(ws + WS_XQ), DM / 2, (const bf16_t*)(ws + W_IN8), DM / 2); S.skip_from = 4; S.skip_by = 4; S.b_compact = 1;
              if (F.G == 256) { S.c = F.bid; S.cut = 12; S.extra_n = 192; S.extra_c = F.bid >= 64 ? F.bid - 64 : -1; }
              EpiInProj<true> E{(bf16_t*)(ws + R_QA), (bf16_t*)(ws + R_QIDX), (bf16_t*)(ws + R_QKV), (bf16_t*)(ws + R_GATES), (float*)(ws + R_SMALL), (const float*)(ws + WS_XSC), (const unsigned*)(ws + WS_CTL) + CW_WMAXG + l};
              for (int rep = 0; rep < NREP(5); ++rep) gemm_phase(F.ldsl, DM / 2, DM / 2, DM / 2, S, E); }
            SEAM(pb + 0); }
        if (IN(pb + 1) && PEN(1)) { size_t wz = 0; asm volatile("" : "+s"(wz)); unsigned char* ws = ws0 + wz;
            phase_prep(F, P, l);
            SchedS S; S.init(NTOK, 2048, F.G, F.bid, (const bf16_t*)(ws + R_QA), 1024, (const bf16_t*)(ws + W_UK2), 256, 1, 256);
            EpiBf16 E{(bf16_t*)(ws + R_QCAT), 2304, 288};
            for (int rep = 0; rep < NREP(10); ++rep) gemm_phase(F.ldsl, 256, 1024, 256, S, E); SEAM(pb + 1); }
        if (IN(pb + 2) && PEN(2)) { size_t wz = 0; asm volatile("" : "+s"(wz)); unsigned char* ws = ws0 + wz; phase_cumsum(F); for (int rep = 0; rep < NREP(3); ++rep) phase_idx(F); SEAM(pb + 2); }
        if (IN(pb + 3) && PEN(3)) { size_t wz = 0; asm volatile("" : "+s"(wz)); unsigned char* ws = ws0 + wz; for (int rep = 0; rep < NREP(4); ++rep) phase_topk(F); SEAM(pb + 3); }
        if (IN(pb + 4) && PEN(4)) { size_t wz = 0; asm volatile("" : "+s"(wz)); unsigned char* ws = ws0 + wz; for (int rep = 0; rep < NREP(1); ++rep) phase_attn(F, l, rep); SEAM(pb + 4); }
        if (IN(pb + 5) && PEN(5)) { size_t wz = 0; asm volatile("" : "+s"(wz)); unsigned char* ws = ws0 + wz;
            SchedS S; S.init(NTOK, 1024, F.G, F.bid, (const bf16_t*)(ws + R_OLAT), 2048, (const bf16_t*)(ws + W_UV2), 512, 0, 512);
            EpiBf16 E{(bf16_t*)(ws + R_OA), 3072, 256}; for (int rep = 0; rep < NREP(10); ++rep) gemm_phase(F.ldsl, 512, 2048, 512, S, E);
            SEAM(pb + 5); }
        if (IN(pb + 6) && PEN(6)) { size_t wz = 0; asm volatile("" : "+s"(wz)); unsigned char* ws = ws0 + wz;
            SchedS S; S.init(NTOK, 2048, F.G, F.bid, (const bf16_t*)(ws + R_OA), 3072, (const bf16_t*)(ws + W_BRA), 3072);
            EpiBranch3 E{(const unsigned char*)(ws + R_GATES), (bf16_t*)(ws + R_MERGED)}; for (int rep = 0; rep < NREP(11); ++rep) gemm_phase(F.ldsl, 3072, 3072, 3072, S, E); SEAM(pb + 6); }
        if (IN(pb + 7) && PEN(7)) { size_t wz = 0; asm volatile("" : "+s"(wz)); unsigned char* ws = ws0 + wz;
            SchedS S; S.init(NTOK, 2048, F.G, F.bid, (const bf16_t*)(ws + R_MERGED), DM, (const bf16_t*)(ws + W_OUT), DM);
            EpiOut E{(const bf16_t*)(ws + WS_XB), (bf16_t*)(ws + R_PRE1)}; for (int rep = 0; rep < NREP(8); ++rep) gemm_phase(F.ldsl, DM, DM, DM, S, E); SEAM(pb + 7); }
        if (IN(pb + 8) && PEN(8)) { size_t wz = 0; asm volatile("" : "+s"(wz)); unsigned char* ws = ws0 + wz; phase_ln1_router(F, P, l); SEAM(pb + 8); }
        if (IN(pb + 9) && PEN(9)) { size_t wz = 0; asm volatile("" : "+s"(wz)); unsigned char* ws = ws0 + wz;
            for (int rep = 0; rep < NREP(12); ++rep) phase_moe_gather(F, l);
            SchedS S; S.init(NTOK, 2048, F.G, F.bid, (const bf16_t*)(ws + WS_PB) + (size_t)l * NTOK * 256, 256, (const bf16_t*)(ws + W_PLE), 256);
            EpiBf16 E{(bf16_t*)(ws + M_PP), 2048, 256}; for (int rep = 0; rep < NREP(10); ++rep) gemm_phase(F.ldsl, 256, 256, 256, S, E); SEAM(pb + 9); }
        if (IN(pb + 10) && PEN(10)) { size_t wz = 0; asm volatile("" : "+s"(wz)); unsigned char* ws = ws0 + wz;
            SchedMG S; S.init((const unsigned*)(ws + WS_CTL) + CW_META + l * 512, F.G, F.bid, (const bf16_t*)(ws + M_X1Q), DM / 2, (const bf16_t*)(ws + W_GU), DM / 2);
            { LAS unsigned* gt = (LAS unsigned*)(F.ldsl + pg8::GTAB_OFF); const unsigned* rowtok = (const unsigned*)(ws + M_ROWTOK);
              for (int ui = 0; ui * F.G + F.bid < S.ntiles * 8; ++ui) { const int pm = (ui * F.G + F.bid) >> 3; if (F.tid < 256) gt[ui * 256 + F.tid] = rowtok[pm * 256 + F.tid] * 2048u; }
              __syncthreads(); }
            EpiGateUpI8 E{F.in(16) + (size_t)l * NEXP * DEXP, F.in(18) + (size_t)l * NEXP * DEXP, (bf16_t*)(ws + M_HID), (const float*)(ws + M_ROWSX), (const unsigned*)(ws + WS_CTL) + CW_WMAX + l, (float*)(ws + M_HM)};
            for (int rep = 0; rep < NREP(6); ++rep) gemm_phase(F.ldsl, DM / 2, DM / 2, DM / 2, S, E); SEAM(pb + 10); }
        if (IN(pb + 11) && PEN(11)) { size_t wz = 0; asm volatile("" : "+s"(wz)); unsigned char* ws = ws0 + wz;
            phase_quant_h(F, l); xcd_barrier(bar);
            SchedM S; S.init((const unsigned*)(ws + WS_CTL) + CW_META + l * 512, F.G, F.bid, (const bf16_t*)(ws + M_H8), DEXP / 2, (const bf16_t*)(ws + W_DN), DEXP / 2);
            EpiDownI8 E{F.in(20) + (size_t)l * NEXP * DM, (const float*)(ws + M_ROWW), (bf16_t*)(ws + M_XS), (const float*)(ws + M_H8S), (const unsigned*)(ws + WS_CTL) + CW_WMAXD + l};
            for (int rep = 0; rep < NREP(7); ++rep) gemm_phase(F.ldsl, DEXP / 2, DEXP / 2, DEXP / 2, S, E); SEAM(pb + 11); }
        if (IN(pb + 12) && PEN(12)) { size_t wz = 0; asm volatile("" : "+s"(wz)); unsigned char* ws = ws0 + wz; for (int rep = 0; rep < NREP(9); ++rep) phase_combine(F); SEAM(pb + 12); }
        if (IN(pb + 13) && PEN(13)) { size_t wz = 0; asm volatile("" : "+s"(wz)); unsigned char* ws = ws0 + wz;
            SchedS S; S.init(NTOK, 2048, F.G, F.bid, (const bf16_t*)(ws + M_HQ), DM / 2, (const bf16_t*)(ws + W_PG), DM / 2);
            EpiPleGateI8 E{(const bf16_t*)(ws + M_HB), (const bf16_t*)(ws + M_PP), (bf16_t*)(ws + M_X1F), (const float*)(ws + M_HSC), (const unsigned*)(ws + WS_CTL) + CW_WMAXP + l};
            for (int rep = 0; rep < NREP(8); ++rep) gemm_phase(F.ldsl, DM / 2, DM / 2, DM / 2, S, E); SEAM(pb + 13); }
        if (IN(pb + 14) && PEN(14)) { size_t wz = 0; asm volatile("" : "+s"(wz)); unsigned char* ws = ws0 + wz; for (int rep = 0; rep < NREP(13); ++rep) phase_ln2(F, P, l); if (l + 1 < NLAYER) for (int rep = 0; rep < NREP(0); ++rep) convert_layer_weights(F, P, l + 1); SEAM(pb + 14); }
}
__global__ void __launch_bounds__(512, 2) fwd(Params P) {
    extern __shared__ __attribute__((aligned(16))) unsigned char lds[];
    Frame F; F.lds = lds; F.ldsl = (LAS unsigned char*)lds; F.ws = P.ws; F.tid = threadIdx.x; F.lane = F.tid & 63; F.wid = __builtin_amdgcn_readfirstlane(F.tid >> 6); F.G = gridDim.x; F.bid = blockIdx.x;
    unsigned char* ws0 = P.ws; unsigned char* ws = ws0;
    const bool fused = (P.ph_hi - P.ph_lo) > 1;
    if (F.tid < 4) ((LAS unsigned*)(F.ldsl + LDS_MISC))[F.tid] = 0u;
    if (F.tid == 0) { LAS unsigned long long* t = (LAS unsigned long long*)(F.ldsl + LDS_PTRS);
#pragma unroll
        for (int k = 0; k < 25; ++k) t[k] = (unsigned long long)P.in[k];
        t[25] = (unsigned long long)P.out; }
    __syncthreads();
    XcdBarrier bar; bar.bar = (unsigned*)(ws + WS_CTL) + CW_BAR; bar.x = 0; bar.st = (volatile LAS unsigned*)(F.ldsl + LDS_MISC);
    if (fused) bar = xcd_barrier_post((unsigned*)(ws + WS_CTL) + CW_BAR, (volatile LAS unsigned*)(F.ldsl + LDS_MISC));
    const int lo = P.ph_lo, hi = P.ph_hi;
    using namespace pg8;
    if (IN(0) && PEN(15)) { size_t wz = 0; asm volatile("" : "+s"(wz)); unsigned char* ws = ws0 + wz;
        quant_rows(F, F.in(0), (bf16_t*)(ws + WS_XB), (unsigned char*)(ws + WS_XQ), (float*)(ws + WS_XSC));
        conv_rows(F, F.in(1), (bf16_t*)(ws + WS_PB), (size_t)2 * NTOK * 256 / 8);
        sample_wmax(F);
        SEAM(0);
    }
    if (IN(1) && PEN(15)) { for (int rep = 0; rep < NREP(0); ++rep) convert_layer_weights(F, P, 0); SEAM(1); }
    layer_phases<0>(F, P, bar, lo, hi, ws0);
    layer_phases<1>(F, P, bar, lo, hi, ws0);
}

#ifdef DEBUG_NAN
constexpr int CW_FLAGS = 12288;
__global__ void dbg_scan_bf16(const unsigned short* p, size_t n, unsigned* flag) { unsigned c = 0; for (size_t i = (size_t)blockIdx.x * blockDim.x + threadIdx.x; i < n; i += (size_t)gridDim.x * blockDim.x) if ((p[i] & 0x7F80u) == 0x7F80u) ++c; if (c) atomicAdd(flag, c); }
__global__ void dbg_scan_f32(const unsigned* p, size_t n, unsigned* flag) { unsigned c = 0; for (size_t i = (size_t)blockIdx.x * blockDim.x + threadIdx.x; i < n; i += (size_t)gridDim.x * blockDim.x) if ((p[i] & 0x7F800000u) == 0x7F800000u) ++c; if (c) atomicAdd(flag, c); }
__global__ void dbg_scan_sel(const int* sel, const int* nsel, unsigned* flag) { unsigned c = 0; for (size_t i = (size_t)blockIdx.x * blockDim.x + threadIdx.x; i < (size_t)NTOK * 256; i += (size_t)gridDim.x * blockDim.x) { const int tok = (int)(i >> 8), j = (int)(i & 255), t = tok & (SEQ - 1); const int ns = nsel[tok]; if (j == 0 && ns != (t + 1 < 256 ? t + 1 : 256)) ++c; if (j < ns && (sel[i] < 0 || sel[i] > t)) ++c; } if (c) atomicAdd(flag, c); }
__global__ void dbg_scan_scores(const unsigned* p, unsigned* flag) { unsigned c = 0; for (size_t i = (size_t)blockIdx.x * blockDim.x + threadIdx.x; i < 2ull * SEQ * SEQ; i += (size_t)gridDim.x * blockDim.x) { const int s = (int)(i & (SEQ - 1)), t = (int)((i >> 13) & (SEQ - 1)); if (s <= t && (p[i] & 0x7F800000u) == 0x7F800000u) ++c; } if (c) atomicAdd(flag, c); }
__global__ void dbg_probe_bf16(const unsigned short* p, size_t n, unsigned* cnt, unsigned* minidx) { unsigned c = 0; unsigned mi = 0xFFFFFFFFu; for (size_t i = (size_t)blockIdx.x * blockDim.x + threadIdx.x; i < n; i += (size_t)gridDim.x * blockDim.x) if ((p[i] & 0x7F80u) == 0x7F80u) { ++c; if ((unsigned)i < mi) mi = (unsigned)i; } if (c) { atomicAdd(cnt, c); atomicMax(minidx, ~mi); } }
__global__ void dbg_final(float* out, size_t n, const unsigned* flags) { int code = 0; for (int k = 0; k < 32; ++k) if (flags[k] && !code) code = k + 1; const int mask = (flags[32] ? 1 : 0) | (flags[33] ? 2 : 0) | (flags[34] ? 4 : 0); if (mask) code = 20 + 5 * mask; if (!code) return; for (size_t i = (size_t)blockIdx.x * blockDim.x + threadIdx.x; i < n; i += (size_t)gridDim.x * blockDim.x) out[i] = (float)code; }
#endif
extern "C" void kernel_launch(void* const* d_in, const int* in_sizes, int n_in, void* d_out, int out_size, void* d_ws, size_t ws_size, hipStream_t stream) {
    static int grid = 0;
    if (grid == 0) {
        if (n_in != 25 || out_size != NTOK * DM || ws_size < WS_NEED) { fprintf(stderr, "kernel_launch: unexpected shapes (n_in %d out %d ws %zu need %zu)\n", n_in, out_size, ws_size, (size_t)WS_NEED); grid = -1; return; }
        int dev = 0, cus = 0, per_cu = 0;
        if (hipGetDevice(&dev) != hipSuccess || hipDeviceGetAttribute(&cus, hipDeviceAttributeMultiprocessorCount, dev) != hipSuccess) { grid = -1; return; }
        if (hipFuncSetAttribute((const void*)fwd, hipFuncAttributeMaxDynamicSharedMemorySize, LDS_BYTES) != hipSuccess) { fprintf(stderr, "kernel_launch: hipFuncSetAttribute failed\n"); grid = -1; return; }
        if (hipOccupancyMaxActiveBlocksPerMultiprocessor(&per_cu, (const void*)fwd, 512, LDS_BYTES) != hipSuccess || per_cu < 1) fprintf(stderr, "kernel_launch: occupancy query says %d\n", per_cu);
        (void)hipGetLastError();
        grid = cus;
    }
    if (grid < 0) return;
    unsigned char* ws = (unsigned char*)d_ws;
    hipMemsetAsync(ws + WS_CTL, 0, CTL_BYTES, stream);
    hipMemsetAsync(ws + W_UK2, 0, 8ull * 256 * 256 * 2 + 4ull * 256 * 512 * 2, stream);
    hipMemsetAsync(ws + W_IN + (size_t)INW * 2048 * 2, 0, (size_t)(INWP - INW) * 2048 * 2, stream);
    Params p{};
    for (int i = 0; i < 25; ++i) p.in[i] = (const float*)d_in[i];
    p.out = (float*)d_out; p.ws = ws;
#if PHASES_PER_LAUNCH == 0
    p.ph_lo = 0; p.ph_hi = NPHASE;
    hipLaunchKernelGGL(fwd, dim3(grid), dim3(512), LDS_BYTES, stream, p);
#else
    for (int k = 0; k < NPHASE; ++k) { p.ph_lo = k; p.ph_hi = k + 1; hipLaunchKernelGGL(fwd, dim3(grid), dim3(512), LDS_BYTES, stream, p);
#ifdef DEBUG_NAN
        unsigned* fl = (unsigned*)(ws + WS_CTL) + CW_FLAGS + k;
#define SB16(off, n) hipLaunchKernelGGL(dbg_scan_bf16, dim3(1024), dim3(256), 0, stream, (const unsigned short*)(ws + (off)), (size_t)(n), fl)
#define SF32(off, n) hipLaunchKernelGGL(dbg_scan_f32, dim3(1024), dim3(256), 0, stream, (const unsigned*)(ws + (off)), (size_t)(n), fl)
        if (k == 0) { SB16(WS_XB, (size_t)NTOK * DM); SB16(WS_PB, 2ull * NTOK * 256); SB16(WS_W, (W_END - WS_W) / 2); }
        else { const int kind = (k - 1) % 15;
            if (kind == 0) { SB16(R_QA, (size_t)NTOK * 1024); SB16(R_QIDX, (size_t)NTOK * 1024); SB16(R_QKV, 6ull * NTOK * 1024); SB16(R_GATES, (size_t)NTOK * 6144); SF32(R_SMALL, (size_t)NTOK * 512); }
            if (kind == 1) { SB16(R_QCAT, (size_t)NTOK * 2304); SB16(R_KCAT, (size_t)NTOK * 288); SB16(R_KI, (size_t)NTOK * 64); SB16(R_QIDX, (size_t)NTOK * 1024); SF32(R_WI, (size_t)NTOK * 16); SF32(WS_LF, 16ull * 8192); }
            if (kind == 2) { SF32(WS_CUM, 16ull * 8192); hipLaunchKernelGGL(dbg_scan_scores, dim3(1024), dim3(256), 0, stream, (const unsigned*)(ws + R_SCORES), fl); }
            if (kind == 3) { hipLaunchKernelGGL(dbg_scan_sel, dim3(1024), dim3(256), 0, stream, (const int*)(ws + R_SEL), (const int*)(ws + R_NSEL), fl); }
            if (k == 5) { unsigned* fl0 = fl; fl = (unsigned*)(ws + WS_CTL) + CW_FLAGS + 32; SB16(R_OLAT, (size_t)NTOK * 2048); fl += 1; SB16(R_OA, (size_t)NTOK * 3072); fl += 1; fl = fl0; hipLaunchKernelGGL(dbg_probe_bf16, dim3(1024), dim3(256), 0, stream, (const unsigned short*)(ws + R_OC), (size_t)NTOK * 1024, (unsigned*)(ws + WS_CTL) + CW_FLAGS + 40, (unsigned*)(ws + WS_CTL) + CW_FLAGS + 41); }
            if (kind == 5) { SB16(R_OA, (size_t)NTOK * 3072); }
            if (kind == 6) { SB16(R_MERGED, (size_t)NTOK * 2048); }
            if (kind == 7) { SF32(R_PRE1, (size_t)NTOK * 2048); }
            if (kind == 8) { SF32(M_X1F, (size_t)NTOK * 2048); SF32(M_TOKW, (size_t)NTOK * 4); }
            if (kind == 9) { SB16(M_PP, (size_t)NTOK * 2048); }
            if (kind == 12) { SF32(M_HF, (size_t)NTOK * 2048); }
            if (kind == 13) { SF32(M_X1F, (size_t)NTOK * 2048); }
            if (kind == 14) { hipLaunchKernelGGL(dbg_scan_f32, dim3(1024), dim3(256), 0, stream, (const unsigned*)d_out, (size_t)NTOK * DM, fl); if (k + 1 < NPHASE) SB16(WS_W, (W_END - WS_W) / 2); } }
#endif
    }
#ifdef DEBUG_NAN
    hipLaunchKernelGGL(dbg_final, dim3(1024), dim3(256), 0, stream, (float*)d_out, (size_t)NTOK * DM, (const unsigned*)(ws + WS_CTL) + CW_FLAGS);
#endif
#endif
}
```
